# Optimizing an MI355X kernel written in HIP

```python
import jax, jax.numpy as jnp
from jax import lax
import numpy as np

D_MODEL = 1024
BATCH = 2
SEQ = 8192
DEPTH = 1

GRID_W = 64
GDN_HEADS = 4
GDN_DK = 128
GDN_DV = 128
CONV_W = 5
CHUNK = 64
ATT_HEADS = 8
ATT_KV_HEADS = 2
ATT_HEAD_DIM = 64
Q_BLOCK = 128
ROPE_THETA = 10000.0
D_MIX = GDN_HEADS * GDN_DV + ATT_HEADS * ATT_HEAD_DIM
N_GROUPS = 4
EXPERTS_PER_GROUP = 8
N_EXPERTS = N_GROUPS * EXPERTS_PER_GROUP
TOP_K = 2
EXPERT_FF = D_MODEL // 2
ROUTE_BLOCK = 128
EPS = 1e-6

GDN_QK = GDN_HEADS * GDN_DK
GDN_V = GDN_HEADS * GDN_DV
GDN_CONV_C = 2 * GDN_QK + GDN_V
ATT_Q = ATT_HEADS * ATT_HEAD_DIM
ATT_KV = ATT_KV_HEADS * ATT_HEAD_DIM
IN_SPLITS = (GDN_QK, GDN_QK, GDN_V, GDN_V, GDN_HEADS, GDN_HEADS, GDN_HEADS, GDN_HEADS, ATT_Q, ATT_KV, ATT_KV)
D_IN = 2 * GDN_QK + 2 * GDN_V + 4 * GDN_HEADS + ATT_Q + 2 * ATT_KV

kernel_name = 'hybrid_gdn_axial_gqa_hmoe_encoder'


def rms_norm(x, w):
    x32 = x.astype(jnp.float32)
    y = x32 * lax.rsqrt(jnp.mean(x32 * x32, axis=-1, keepdims=True) + EPS)
    return (y * w.astype(jnp.float32)).astype(x.dtype)


def l2_norm(x):
    return x * lax.rsqrt(jnp.sum(x * x, axis=-1, keepdims=True) + EPS)


def gated_delta_chunked(q, k, v, g, beta):
    B, S, H, DK = q.shape
    DV = v.shape[-1]
    N = S // CHUNK
    q = q * (DK ** -0.5)
    to_chunks = lambda t: t.reshape(B, N, CHUNK, H, t.shape[-1]).transpose(0, 3, 1, 2, 4)
    q, k, v = to_chunks(q), to_chunks(k), to_chunks(v)
    g = g.reshape(B, N, CHUNK, H).transpose(0, 3, 1, 2)
    beta = beta.reshape(B, N, CHUNK, H).transpose(0, 3, 1, 2)
    g_cum = jnp.cumsum(g, axis=-1)
    tril = jnp.tril(jnp.ones((CHUNK, CHUNK), dtype=bool))
    strict = jnp.tril(jnp.ones((CHUNK, CHUNK), dtype=bool), k=-1)
    diff = g_cum[..., :, None] - g_cum[..., None, :]
    decay = jnp.where(tril, jnp.exp(jnp.where(tril, diff, 0.0)), 0.0)
    k_beta = k * beta[..., None]
    v_beta = v * beta[..., None]
    lower = jnp.where(strict, jnp.einsum('bhncd,bhnsd->bhncs', k_beta, k) * decay, 0.0)
    eye = jnp.eye(CHUNK, dtype=jnp.float32)
    rhs = jnp.concatenate([v_beta, k_beta * jnp.exp(g_cum)[..., None]], axis=-1)
    sol = lax.linalg.triangular_solve(eye + lower, rhs, left_side=True, lower=True, unit_diagonal=True)
    u = sol[..., :DV]
    w = sol[..., DV:]
    attn_intra = jnp.where(tril, jnp.einsum('bhncd,bhnsd->bhncs', q, k) * decay, 0.0)
    q_decay = q * jnp.exp(g_cum)[..., None]
    k_tail = k * jnp.exp(g_cum[..., -1:] - g_cum)[..., None]
    chunk_decay = jnp.exp(g_cum[..., -1])

    def step(state, xs):
        u_i, w_i, qd_i, kt_i, a_i, d_i = xs
        v_new = u_i - jnp.einsum('bhcd,bhde->bhce', w_i, state)
        o_i = jnp.einsum('bhcd,bhde->bhce', qd_i, state) + jnp.einsum('bhcs,bhse->bhce', a_i, v_new)
        state = state * d_i[..., None, None] + jnp.einsum('bhcd,bhce->bhde', kt_i, v_new)
        return state, o_i

    xs = tuple(jnp.moveaxis(t, 2, 0) for t in (u, w, q_decay, k_tail, attn_intra, chunk_decay))
    state0 = jnp.zeros((B, H, DK, DV), jnp.float32)
    _, o = lax.scan(step, state0, xs)
    return o.transpose(1, 0, 3, 2, 4).reshape(B, S, H, DV)


def gdn_group(q, k, v, z, b_f, b_b, a_f, a_b, conv_w, a_log, dt_bias, norm_w):
    B, S, _ = q.shape
    dtype = q.dtype
    qkv = jnp.concatenate([q, k, v], axis=-1)
    qkv = lax.conv_general_dilated(
        qkv, conv_w.reshape(CONV_W, 1, GDN_CONV_C).astype(dtype), window_strides=(1,),
        padding=((CONV_W // 2, CONV_W // 2),), dimension_numbers=('NWC', 'WIO', 'NWC'),
        feature_group_count=GDN_CONV_C)
    qkv = jax.nn.silu(qkv).astype(jnp.float32)
    q = l2_norm(qkv[..., :GDN_QK].reshape(B, S, GDN_HEADS, GDN_DK))
    k = l2_norm(qkv[..., GDN_QK:2 * GDN_QK].reshape(B, S, GDN_HEADS, GDN_DK))
    v = qkv[..., 2 * GDN_QK:].reshape(B, S, GDN_HEADS, GDN_DV)
    a_log = a_log.astype(jnp.float32)
    dt_bias = dt_bias.astype(jnp.float32)
    beta_f = jax.nn.sigmoid(b_f.astype(jnp.float32))
    beta_b = jax.nn.sigmoid(b_b.astype(jnp.float32))
    g_f = -jnp.exp(a_log[0]) * jax.nn.softplus(a_f.astype(jnp.float32) + dt_bias[0])
    g_b = -jnp.exp(a_log[1]) * jax.nn.softplus(a_b.astype(jnp.float32) + dt_bias[1])
    flip = lambda t: jnp.flip(t, axis=1)
    o_fwd = gated_delta_chunked(q, k, v, g_f, beta_f)
    o_bwd = flip(gated_delta_chunked(flip(q), flip(k), flip(v), flip(g_b), flip(beta_b)))
    o = o_fwd + o_bwd
    o = o * lax.rsqrt(jnp.mean(o * o, axis=-1, keepdims=True) + EPS) * norm_w.astype(jnp.float32)
    o = o * jax.nn.silu(z.astype(jnp.float32).reshape(B, S, GDN_HEADS, GDN_DV))
    return o.reshape(B, S, GDN_HEADS * GDN_DV).astype(dtype)


def axial_rope_tables(seq_len):
    rows = seq_len // GRID_W
    row = jnp.repeat(jnp.arange(rows), GRID_W).astype(jnp.float32)
    col = jnp.tile(jnp.arange(GRID_W), rows).astype(jnp.float32)
    axis_dims = ATT_HEAD_DIM // 2
    inv_freq = ROPE_THETA ** (-jnp.arange(0, axis_dims, 2, dtype=jnp.float32) / axis_dims)
    ang = jnp.concatenate([row[:, None] * inv_freq, col[:, None] * inv_freq], axis=-1)
    return jnp.cos(ang), jnp.sin(ang)


def apply_rope(x, cos, sin):
    x32 = x.astype(jnp.float32).reshape(*x.shape[:-1], x.shape[-1] // 2, 2)
    x0, x1 = x32[..., 0], x32[..., 1]
    c, s = cos[None, :, None, :], sin[None, :, None, :]
    out = jnp.stack([x0 * c - x1 * s, x0 * s + x1 * c], axis=-1)
    return out.reshape(x.shape).astype(x.dtype)


def bidir_gqa_blocks(q, k, v):
    B, S, H, D = q.shape
    kvh = k.shape[2]
    grp = H // kvh
    nb = S // Q_BLOCK
    qb = jnp.moveaxis(q.reshape(B, nb, Q_BLOCK, kvh, grp, D), 1, 0)
    scale = D ** -0.5

    def one_block(q_blk):
        s = jnp.einsum('bqkgd,bskd->bkgqs', q_blk, k).astype(jnp.float32) * scale
        p = jax.nn.softmax(s, axis=-1).astype(v.dtype)
        return jnp.einsum('bkgqs,bskd->bqkgd', p, v)

    o = lax.map(one_block, qb)
    return jnp.moveaxis(o, 0, 1).reshape(B, S, H * D)


def hierarchical_moe(h, w_router_group, w_router_expert, w_gate, w_up, w_down):
    B, S, D = h.shape
    T = B * S
    xf = h.reshape(T, D)
    gp = jax.nn.softmax((xf @ w_router_group).astype(jnp.float32), axis=-1)
    gp_top, g_sel = lax.top_k(gp, 1)
    fine = (xf @ w_router_expert).astype(jnp.float32).reshape(T, N_GROUPS, EXPERTS_PER_GROUP)
    fine_sel = jnp.take_along_axis(fine, g_sel[:, :, None], axis=1)[:, 0]
    pf_top, e_loc = lax.top_k(jax.nn.softmax(fine_sel, axis=-1), TOP_K)
    gate = gp_top * pf_top / jnp.sum(pf_top, axis=-1, keepdims=True)
    expert = g_sel * EXPERTS_PER_GROUP + e_loc

    n_assign = T * TOP_K
    n_blocks = -(-(n_assign + N_EXPERTS * (ROUTE_BLOCK - 1)) // ROUTE_BLOCK)
    e_flat = expert.reshape(-1)
    tok_flat = jnp.repeat(jnp.arange(T), TOP_K)
    gate_flat = gate.reshape(-1)
    order = jnp.argsort(e_flat, stable=True)
    e_sorted, tok_sorted, gate_sorted = e_flat[order], tok_flat[order], gate_flat[order]
    counts = jnp.bincount(e_flat, length=N_EXPERTS)
    padded = (counts + ROUTE_BLOCK - 1) // ROUTE_BLOCK * ROUTE_BLOCK
    count_start = jnp.cumsum(counts) - counts
    pad_end = jnp.cumsum(padded)
    pad_start = pad_end - padded
    dest = pad_start[e_sorted] + (jnp.arange(n_assign) - count_start[e_sorted])
    x_buf = jnp.zeros((n_blocks * ROUTE_BLOCK, D), h.dtype).at[dest].set(xf[tok_sorted])
    block_start = jnp.arange(n_blocks) * ROUTE_BLOCK
    block_expert = jnp.minimum(jnp.searchsorted(pad_end, block_start, side='right'), N_EXPERTS - 1)

    def one_block(args):
        xb, e = args
        hid = jax.nn.silu(xb @ w_gate[e]) * (xb @ w_up[e])
        return hid @ w_down[e]

    y_buf = lax.map(one_block, (x_buf.reshape(n_blocks, ROUTE_BLOCK, D), block_expert)).reshape(-1, D)
    y = y_buf[dest] * gate_sorted[:, None].astype(h.dtype)
    out = jnp.zeros((T, D), h.dtype).at[tok_sorted].add(y)
    return out.reshape(B, S, D)


def setup_inputs(seed: int = 0) -> dict:
    key = jax.random.key(seed)
    ks = jax.random.split(key, 20)
    f32 = jnp.float32
    nrm = lambda k, shape, fan_in: jax.random.normal(k, shape, f32) * (fan_in ** -0.5)
    gain = lambda k, shape: 1.0 + 0.02 * jax.random.normal(k, shape, f32)
    dt = jnp.exp(jax.random.uniform(ks[5], (DEPTH, 2, GDN_HEADS), f32, np.log(1e-3), np.log(1e-1)))
    return {
        'x': jax.random.normal(ks[0], (BATCH, SEQ, D_MODEL), f32),
        'norm_mix_w': gain(ks[1], (DEPTH, D_MODEL)),
        'w_in': nrm(ks[2], (DEPTH, D_MODEL, D_IN), D_MODEL),
        'conv_w': nrm(ks[3], (DEPTH, CONV_W, GDN_CONV_C), CONV_W),
        'a_log': jnp.log(jax.random.uniform(ks[4], (DEPTH, 2, GDN_HEADS), f32, 1.0, 16.0)),
        'dt_bias': dt + jnp.log(-jnp.expm1(-dt)),
        'gdn_norm_w': gain(ks[6], (DEPTH, GDN_DV)),
        'q_norm_w': gain(ks[7], (DEPTH, ATT_HEAD_DIM)),
        'k_norm_w': gain(ks[8], (DEPTH, ATT_HEAD_DIM)),
        'w_out': nrm(ks[9], (DEPTH, D_MIX, D_MODEL), D_MIX),
        'norm_ffn_w': gain(ks[10], (DEPTH, D_MODEL)),
        'w_router_group': nrm(ks[11], (DEPTH, D_MODEL, N_GROUPS), D_MODEL),
        'w_router_expert': nrm(ks[12], (DEPTH, D_MODEL, N_EXPERTS), D_MODEL),
        'w_gate': nrm(ks[13], (DEPTH, N_EXPERTS, D_MODEL, EXPERT_FF), D_MODEL),
        'w_up': nrm(ks[14], (DEPTH, N_EXPERTS, D_MODEL, EXPERT_FF), D_MODEL),
        'w_down': nrm(ks[15], (DEPTH, N_EXPERTS, EXPERT_FF, D_MODEL), EXPERT_FF),
        'final_norm_w': gain(ks[16], (D_MODEL,)),
    }


def reference(x, norm_mix_w, w_in, conv_w, a_log, dt_bias, gdn_norm_w, q_norm_w, k_norm_w, w_out,
              norm_ffn_w, w_router_group, w_router_expert, w_gate, w_up, w_down, final_norm_w):
    B, S, _ = x.shape
    cos, sin = axial_rope_tables(S)
    split_idx = np.cumsum(IN_SPLITS)[:-1].tolist()
    for l in range(DEPTH):
        h = rms_norm(x, norm_mix_w[l])
        proj = h @ w_in[l]
        (q_a, k_a, v_a, z_a, b_f, b_b, a_f, a_b, q_b, k_b, v_b) = jnp.split(proj, split_idx, axis=-1)
        o_a = gdn_group(q_a, k_a, v_a, z_a, b_f, b_b, a_f, a_b, conv_w[l], a_log[l], dt_bias[l], gdn_norm_w[l])
        q_b = apply_rope(rms_norm(q_b.reshape(B, S, ATT_HEADS, ATT_HEAD_DIM), q_norm_w[l]), cos, sin)
        k_b = apply_rope(rms_norm(k_b.reshape(B, S, ATT_KV_HEADS, ATT_HEAD_DIM), k_norm_w[l]), cos, sin)
        v_b = v_b.reshape(B, S, ATT_KV_HEADS, ATT_HEAD_DIM)
        o_b = bidir_gqa_blocks(q_b, k_b, v_b)
        x = x + jnp.concatenate([o_a, o_b], axis=-1) @ w_out[l]
        x = x + hierarchical_moe(rms_norm(x, norm_ffn_w[l]), w_router_group[l], w_router_expert[l],
                                 w_gate[l], w_up[l], w_down[l])
    return rms_norm(x, final_norm_w)
```

```cpp
#include <hip/hip_runtime.h>
#include <cstdio>
#include <cstdint>
namespace pg8 {
#define PG8_LAS __attribute__((address_space(3)))
typedef unsigned short bf16_t;
typedef short bf16x8 __attribute__((ext_vector_type(8)));
typedef float f32x4 __attribute__((ext_vector_type(4)));
typedef unsigned u32x4 __attribute__((ext_vector_type(4)));
constexpr int BM = 256, BK = 64, HALF = 128, HTB = HALF * BK * 2  , STAGE_BYTES = 8 * HTB, NXCD = 8, WGM = 8;

__host__ __device__ __forceinline__ int lds_byte(int r, int c) { const int st = (r >> 4) * 2 + (c >> 5), rr = r & 15, cc = c & 31, ob = rr * 64 + cc * 2; return st * 1024 + (ob ^ (((ob >> 9) & 1) << 5)); }
__host__ __device__ __forceinline__ void stage_rc(int b, int& R, int& C) { const int st = b / 1024, sb = b % 1024, swz = sb ^ (((sb >> 9) & 1) << 5); R = (st >> 1) * 16 + swz / 64; C = (st & 1) * 32 + (swz % 64) / 2; }
__host__ __device__ __forceinline__ int perm32(int rho) { const int n = rho >> 4, i = rho & 15; return 8 * (i >> 2) + 4 * n + (i & 3); }

struct Unit { int pm, pn; };
struct Gemm { const bf16_t* A; const bf16_t* Bt; int M, N, K; };

struct StaticOrder {
    int nM, nN, nwg, G, c;
    __host__ __device__ void init(int M, int N, int G_, int c_) { nM = M / BM; nN = N / BM; nwg = nM * nN; G = G_; c = c_; }
    __host__ __device__ bool next(int i, Unit& u) const {
        const long L = (long)i * G + c; if (L >= nwg) return false;
        int wgid = (int)L; { const int q = nwg / NXCD, r = nwg % NXCD, xcd = wgid % NXCD, off = wgid / NXCD; wgid = (xcd < r ? xcd * (q + 1) : r * (q + 1) + (xcd - r) * q) + off; }
        const int nig = WGM * nN, gid = wgid / nig, fm = gid * WGM, gsz = (nM - fm) < WGM ? (nM - fm) : WGM;
        u.pm = fm + ((wgid % nig) % gsz); u.pn = (wgid % nig) / gsz; return true;
    }
    __device__ __forceinline__ void a_ready(const Unit&) const {}
    __device__ __forceinline__ void done(const Unit&) const {}
};

__device__ __forceinline__ unsigned cvt_pk_bf16(float lo, float hi) { unsigned r; asm volatile("v_cvt_pk_bf16_f32 %0, %1, %2" : "=v"(r) : "v"(lo), "v"(hi)); return r; }
typedef float f32x2 __attribute__((ext_vector_type(2)));
template <class Epi, class Sched, bool ALIGN_EPI = false, bool SP2 = false>
__device__ __forceinline__ void gemm_phase(PG8_LAS unsigned char* lds, const Gemm g, const Sched& S, const Epi& E) {
    const int tid = threadIdx.x, wid = __builtin_amdgcn_readfirstlane(tid >> 6), lane = tid & 63, wr = wid >> 2, wc = wid & 3, fr = lane & 15, fq = lane >> 4;
    const int K = g.K, nt = K / BK;
    unsigned voffA[2], voffB[2];
#pragma unroll
    for (int i = 0; i < 2; ++i) { int R, C; stage_rc(tid * 16 + i * 8192, R, C); const int Rb = Epi::PERM ? ((R & ~31) + perm32(R & 31)) : R;
        voffA[i] = (unsigned)(R * K + C) * 2u; voffB[i] = (unsigned)(Rb * K + C) * 2u; }
    const size_t kstep = (size_t)(BK * 2);
    const size_t hstep = (size_t)HALF * K * 2;
    const size_t tstep = 2 * hstep;
    const unsigned ldsw = (unsigned)wid * 1024u;
    const int aoff = lds_byte(wr * 64 + fr, fq * 8), boff = lds_byte(wc * 32 + fr, fq * 8);
#define PG8_SA(b, h) (((b) * 2 + (h)) * HTB)
#define PG8_SB(b, h) ((4 + (b) * 2 + (h)) * HTB)
#define PG8_STAGE(bufoff, gbase, voff) do { _Pragma("unroll") for (int _i = 0; _i < 2; ++_i) \
        __builtin_amdgcn_global_load_lds((const unsigned*)((const char*)(gbase) + (voff)[_i]), (PG8_LAS unsigned*)(lds + (bufoff) + ldsw + _i * 8192), 16, 0, 0); } while (0)
#define PG8_LDA(dst, b, h) do { _Pragma("unroll") for (int m = 0; m < 4; ++m) _Pragma("unroll") for (int k = 0; k < 2; ++k) dst[m][k] = *(const PG8_LAS bf16x8*)(lds + PG8_SA(b, h) + aoff + m * 2048 + k * 1024); } while (0)
#define PG8_LDB(dst, b, h) do { _Pragma("unroll") for (int n = 0; n < 2; ++n) _Pragma("unroll") for (int k = 0; k < 2; ++k) dst[n][k] = *(const PG8_LAS bf16x8*)(lds + PG8_SB(b, h) + boff + n * 2048 + k * 1024); } while (0)
#define PG8_MMA(ai, bj, At, Bt) do { __builtin_amdgcn_s_setprio(1); _Pragma("unroll") for (int m = 0; m < 4; ++m) _Pragma("unroll") for (int n = 0; n < 2; ++n) _Pragma("unroll") for (int k = 0; k < 2; ++k) \
        acc[ai][bj][m][n] = __builtin_amdgcn_mfma_f32_16x16x32_bf16(Bt[n][k], At[m][k], acc[ai][bj][m][n], 0, 0, 0); __builtin_amdgcn_s_setprio(0); } while (0)
#define PG8_WAIT_V(n) asm volatile("s_waitcnt vmcnt(" #n ")" ::: "memory")
#define PG8_WAIT_L(n) asm volatile("s_waitcnt lgkmcnt(" #n ")" ::: "memory")
#define PG8_BAR __builtin_amdgcn_s_barrier()
#define PG8_SCHED __builtin_amdgcn_sched_barrier(0)
    Unit cur, nxt; int ui = 0;
    if (!S.next(0, cur)) return;
    f32x4 acc[2][2][4][2];
#pragma unroll
    for (int a = 0; a < 2; ++a)
#pragma unroll
        for (int b = 0; b < 2; ++b)
#pragma unroll
            for (int m = 0; m < 4; ++m)
#pragma unroll
                for (int n = 0; n < 2; ++n) acc[a][b][m][n] = (f32x4){0.f, 0.f, 0.f, 0.f};
    bf16x8 At[4][2], B0[2][2], B1[2][2];
    const char* cA = (const char*)g.A + (size_t)cur.pm * tstep; const char* cB = (const char*)g.Bt + (size_t)cur.pn * tstep;
    S.a_ready(cur);
    if constexpr (SP2) {
        PG8_STAGE(PG8_SB(0, 0), cB, voffB); PG8_STAGE(PG8_SB(0, 1), cB + hstep, voffB); PG8_STAGE(PG8_SA(0, 0), cA, voffA); PG8_STAGE(PG8_SA(0, 1), cA + hstep, voffA);
        if (wr == 1) PG8_BAR;
        PG8_WAIT_V(2); PG8_BAR;
        PG8_STAGE(PG8_SB(1, 0), cB + kstep, voffB); PG8_STAGE(PG8_SA(1, 0), cA + kstep, voffA); PG8_STAGE(PG8_SB(1, 1), cB + hstep + kstep, voffB);
        PG8_WAIT_V(6); PG8_BAR;
    } else {
        PG8_STAGE(PG8_SB(0, 0), cB, voffB); PG8_STAGE(PG8_SA(0, 0), cA, voffA); PG8_STAGE(PG8_SB(0, 1), cB + hstep, voffB); PG8_STAGE(PG8_SA(0, 1), cA + hstep, voffA);
        if (wr == 1) PG8_BAR;
        PG8_WAIT_V(4); PG8_BAR;
        PG8_STAGE(PG8_SB(1, 0), cB + kstep, voffB); PG8_STAGE(PG8_SA(1, 0), cA + kstep, voffA); PG8_STAGE(PG8_SB(1, 1), cB + hstep + kstep, voffB);
        PG8_WAIT_V(6); PG8_BAR;
    }
    for (;;) {
        const bool has_next = S.next(ui + 1, nxt);
        const char* nA = has_next ? (const char*)g.A + (size_t)nxt.pm * tstep : cA; const char* nB = has_next ? (const char*)g.Bt + (size_t)nxt.pn * tstep : cB;
        for (int t = 0; t < nt; t += 2) {
            const bool last = (t == nt - 2);
            const char* a1 = cA + (size_t)(t + 1) * kstep;
            const char* a2 = last ? nA : cA + (size_t)(t + 2) * kstep; const char* b2 = last ? nB : cB + (size_t)(t + 2) * kstep;
            const char* a3 = a2 + kstep; const char* b3 = b2 + kstep;
            if (last && has_next) S.a_ready(nxt);
            if constexpr (SP2) {
            PG8_LDB(B0, 0, 0); PG8_LDB(B1, 0, 1); PG8_SCHED; PG8_LDA(At, 0, 0); PG8_STAGE(PG8_SA(1, 1), a1 + hstep, voffA);
            PG8_WAIT_V(8); PG8_WAIT_L(0); PG8_BAR; PG8_MMA(0, 0, At, B0); PG8_MMA(0, 1, At, B1); PG8_BAR; PG8_SCHED;
            PG8_LDA(At, 0, 1); PG8_STAGE(PG8_SB(0, 0), b2, voffB); PG8_STAGE(PG8_SB(0, 1), b2 + hstep, voffB); PG8_STAGE(PG8_SA(0, 0), a2, voffA);
            PG8_WAIT_V(8); PG8_WAIT_L(0); PG8_BAR; PG8_MMA(1, 0, At, B0); PG8_MMA(1, 1, At, B1); PG8_BAR; PG8_SCHED;
            PG8_LDB(B0, 1, 0); PG8_LDB(B1, 1, 1); PG8_SCHED; PG8_LDA(At, 1, 0); PG8_STAGE(PG8_SA(0, 1), a2 + hstep, voffA);
            PG8_WAIT_V(8); PG8_WAIT_L(0); PG8_BAR; PG8_MMA(0, 0, At, B0); PG8_MMA(0, 1, At, B1); PG8_BAR; PG8_SCHED;
            PG8_LDA(At, 1, 1); PG8_STAGE(PG8_SB(1, 0), b3, voffB); PG8_STAGE(PG8_SB(1, 1), b3 + hstep, voffB); PG8_STAGE(PG8_SA(1, 0), a3, voffA);
            PG8_WAIT_V(8); PG8_WAIT_L(0); PG8_BAR; PG8_MMA(1, 0, At, B0); PG8_MMA(1, 1, At, B1); PG8_BAR; PG8_SCHED;
            } else {
            PG8_LDB(B0, 0, 0); PG8_SCHED; PG8_LDA(At, 0, 0); PG8_STAGE(PG8_SA(1, 1), a1 + hstep, voffA);
            PG8_WAIT_L(8); PG8_BAR; PG8_WAIT_L(0); PG8_MMA(0, 0, At, B0); PG8_BAR; PG8_SCHED;
            PG8_LDB(B1, 0, 1); PG8_STAGE(PG8_SB(0, 0), b2, voffB);
            PG8_BAR; PG8_WAIT_L(0); PG8_MMA(0, 1, At, B1); PG8_BAR;
            PG8_LDA(At, 0, 1); PG8_STAGE(PG8_SA(0, 0), a2, voffA);
            PG8_BAR; PG8_WAIT_L(0); PG8_MMA(1, 0, At, B0); PG8_BAR; PG8_SCHED;
            PG8_STAGE(PG8_SB(0, 1), b2 + hstep, voffB);
            PG8_WAIT_V(6); PG8_BAR; PG8_MMA(1, 1, At, B1); PG8_BAR;
            PG8_LDB(B0, 1, 0); PG8_SCHED; PG8_LDA(At, 1, 0); PG8_STAGE(PG8_SA(0, 1), a2 + hstep, voffA);
            PG8_WAIT_L(8); PG8_BAR; PG8_WAIT_L(0); PG8_MMA(0, 0, At, B0); PG8_BAR; PG8_SCHED;
            PG8_LDB(B1, 1, 1); PG8_STAGE(PG8_SB(1, 0), b3, voffB);
            PG8_BAR; PG8_WAIT_L(0); PG8_MMA(0, 1, At, B1); PG8_BAR;
            PG8_LDA(At, 1, 1); PG8_STAGE(PG8_SA(1, 0), a3, voffA);
            PG8_BAR; PG8_WAIT_L(0); PG8_MMA(1, 0, At, B0); PG8_BAR; PG8_SCHED;
            PG8_STAGE(PG8_SB(1, 1), b3 + hstep, voffB);
            PG8_WAIT_V(6); PG8_BAR; PG8_MMA(1, 1, At, B1); PG8_BAR;
            }
        }
        if constexpr (ALIGN_EPI) { if (wr == 0) PG8_BAR; }
        if constexpr (!Epi::AFTER_DRAIN) { E(acc, cur, wr, wc, fr, fq); S.done(cur); }
        if (!has_next) break;
#pragma unroll
        for (int a = 0; a < 2; ++a)
#pragma unroll
            for (int b = 0; b < 2; ++b)
#pragma unroll
                for (int m = 0; m < 4; ++m)
#pragma unroll
                    for (int n = 0; n < 2; ++n) acc[a][b][m][n] = (f32x4){0.f, 0.f, 0.f, 0.f};
        cur = nxt; cA = nA; cB = nB; ++ui;
        if constexpr (ALIGN_EPI) { if (wr == 1) PG8_BAR; }
    }
    PG8_WAIT_V(0);
    if constexpr (!ALIGN_EPI) { if (wr == 0) PG8_BAR; }
    PG8_BAR;
    if constexpr (Epi::AFTER_DRAIN) { E.fused(acc, cur, wr, wc, fr, fq, lds, wid, lane); S.done(cur); }
#undef PG8_SA
#undef PG8_SB
#undef PG8_STAGE
#undef PG8_LDA
#undef PG8_LDB
#undef PG8_MMA
#undef PG8_WAIT_V
#undef PG8_WAIT_L
#undef PG8_BAR
#undef PG8_SCHED
}
}
#include <hip/hip_bf16.h>
#include <cmath>
namespace attn_body {
using bf16=__hip_bfloat16;
using bf16x8=__attribute__((ext_vector_type(8)))short;
using s16x4=__attribute__((ext_vector_type(4)))short;
using f32x16=__attribute__((ext_vector_type(16)))float;
using u32x4=__attribute__((ext_vector_type(4)))unsigned;
constexpr int BATCH=2,NHEAD=8,NKVH=2,SEQ=8192,D=64,QP=512,KP=128,OP=1024;
constexpr int NW=8,QBLK=32,QB=QBLK*NW,KVBLK=64,NQB=SEQ/QB;
constexpr int ATTN_UNIT_ROWS=QB;
__device__ __forceinline__ int crow(int r,int hi){return (r&3)+8*(r>>2)+4*hi;}
#define SBAR() __builtin_amdgcn_sched_barrier(0)
__device__ __forceinline__ void cmask(f32x16&p0,f32x16&p1,int jb,int qrel,int hi){
  const float NEG=-INFINITY; int kb=64*jb+4*hi;
  #pragma unroll
  for(int r=0;r<16;++r){int kv=kb+(r&3)+8*(r>>2); if(kv>qrel)p0[r]=NEG; if(kv+32>qrel)p1[r]=NEG;}
}

constexpr int NSLOT=3, SLOTB=8192;
constexpr int LDS_K=0, LDS_V=NSLOT*SLOTB, LDS_WS=2*NSLOT*SLOTB, LDS_OST=LDS_WS+NW*64*4, LDS_BYTES=LDS_OST+NW*4096;
constexpr float C2=0.125f*1.4426950408889634f;
__device__ __forceinline__ void glds16(const void*gsrc,unsigned lds_dst){unsigned keep;
  asm volatile("s_mov_b32 %0, m0\n\ts_mov_b32 m0, %2\n\ts_nop 0\n\tglobal_load_lds_dwordx4 %1, off\n\ts_mov_b32 m0, %0":"=&s"(keep):"v"(gsrc),"s"(lds_dst):"memory");}
__device__ __forceinline__ float max3f(float a,float b,float c){float r;asm("v_max3_f32 %0, %1, %2, %3":"=v"(r):"v"(a),"v"(b),"v"(c));return r;}
__device__ __forceinline__ float max2f(float a,float b){float r;asm("v_max_f32_e32 %0, %1, %2":"=v"(r):"v"(a),"v"(b));return r;}
__device__ __forceinline__ float fadd_s(float a,float b){float r;asm("v_add_f32_e32 %0, %1, %2":"=v"(r):"v"(a),"v"(b));return r;}
__device__ __forceinline__ float fsub_s(float a,float b){float r;asm("v_sub_f32_e32 %0, %1, %2":"=v"(r):"v"(a),"v"(b));return r;}
typedef float f32x2_t __attribute__((ext_vector_type(2))); typedef __bf16 bf16x2_t __attribute__((ext_vector_type(2)));
__device__ __forceinline__ unsigned cvtpk_s(float lo,float hi){f32x2_t v={lo,hi};bf16x2_t b=__builtin_convertvector(v,bf16x2_t);return __builtin_bit_cast(unsigned,b);}
#define WAIT_BAR(N) asm volatile("s_waitcnt vmcnt(" #N ") lgkmcnt(0)\n\ts_barrier":::"memory")

__device__ __forceinline__ void qkt(f32x16&p0,f32x16&p1,const char*Kslot,const bf16x8*qr,const f32x16&negm,int r32,int hi){
  const char*kb=Kslot+hi*1024+r32*16;
  #pragma unroll
  for(int d0=0;d0<4;++d0){
    const bf16x8 b0=*reinterpret_cast<const bf16x8*>(kb+d0*2048);
    const bf16x8 b1=*reinterpret_cast<const bf16x8*>(kb+d0*2048+512);
    if(d0==0){p0=__builtin_amdgcn_mfma_f32_32x32x16_bf16(b0,qr[0],negm,0,0,0);p1=__builtin_amdgcn_mfma_f32_32x32x16_bf16(b1,qr[0],negm,0,0,0);}
    else{p0=__builtin_amdgcn_mfma_f32_32x32x16_bf16(b0,qr[d0],p0,0,0,0);p1=__builtin_amdgcn_mfma_f32_32x32x16_bf16(b1,qr[d0],p1,0,0,0);}}
}
typedef __attribute__((address_space(3))) const char* lds_cptr;
typedef short v4i16_t __attribute__((ext_vector_type(4)));
__device__ __forceinline__ void kload8(bf16x8*kf,lds_cptr kp){
  kf[0]=*(const __attribute__((address_space(3))) bf16x8*)(kp);      kf[1]=*(const __attribute__((address_space(3))) bf16x8*)(kp+512);
  kf[2]=*(const __attribute__((address_space(3))) bf16x8*)(kp+2048); kf[3]=*(const __attribute__((address_space(3))) bf16x8*)(kp+2560);
  kf[4]=*(const __attribute__((address_space(3))) bf16x8*)(kp+4096); kf[5]=*(const __attribute__((address_space(3))) bf16x8*)(kp+4608);
  kf[6]=*(const __attribute__((address_space(3))) bf16x8*)(kp+6144); kf[7]=*(const __attribute__((address_space(3))) bf16x8*)(kp+6656);
}
__device__ __forceinline__ void kload2(bf16x8*kf,lds_cptr kp,int j){ kf[2*j]=*(const __attribute__((address_space(3))) bf16x8*)(kp+j*2048); kf[2*j+1]=*(const __attribute__((address_space(3))) bf16x8*)(kp+j*2048+512); }
__device__ __forceinline__ s16x4 vtr(lds_cptr p){ return __builtin_bit_cast(s16x4,__builtin_amdgcn_ds_read_tr16_b64_v4i16((__attribute__((address_space(3))) v4i16_t*)p)); }
__device__ __forceinline__ float rowmax(const f32x16&p0,const f32x16&p1){
  float a=max3f(p0[0],p0[1],p1[0]),b=max3f(p0[2],p0[3],p1[1]);a=max3f(a,p1[2],p1[3]);
  #pragma unroll
  for(int r=4;r<16;r+=4){a=max3f(a,p0[r],p0[r+1]);b=max3f(b,p0[r+2],p0[r+3]);a=max3f(a,p1[r],p1[r+1]);b=max3f(b,p1[r+2],p1[r+3]);}
  const float m=max2f(a,b);
  auto rr=__builtin_amdgcn_permlane32_swap(__float_as_uint(m),__float_as_uint(m),false,false);
  return max2f(__uint_as_float(rr[0]),__uint_as_float(rr[1]));
}
__device__ __forceinline__ void pv(f32x16*o,int vb,bf16x8 pa0,bf16x8 pa1,bf16x8 pa2,bf16x8 pa3){
  #pragma unroll
  for(int d0=0;d0<2;++d0){s16x4 lo[4],hi[4];
    #pragma unroll
    for(int ks=0;ks<4;++ks){
      asm volatile("ds_read_b64_tr_b16 %0,%1 offset:%c2":"=&v"(lo[ks]):"v"(vb),"i"(d0*4096+ks*1024):"memory");
      asm volatile("ds_read_b64_tr_b16 %0,%1 offset:%c2":"=&v"(hi[ks]):"v"(vb),"i"(d0*4096+ks*1024+512):"memory");}
    asm volatile("s_waitcnt lgkmcnt(0)":::"memory");SBAR();
    #define PK(k) (bf16x8){lo[k][0],lo[k][1],lo[k][2],lo[k][3],hi[k][0],hi[k][1],hi[k][2],hi[k][3]}
    o[d0]=__builtin_amdgcn_mfma_f32_32x32x16_bf16(pa0,PK(0),o[d0],0,0,0);
    o[d0]=__builtin_amdgcn_mfma_f32_32x32x16_bf16(pa1,PK(1),o[d0],0,0,0);
    o[d0]=__builtin_amdgcn_mfma_f32_32x32x16_bf16(pa2,PK(2),o[d0],0,0,0);
    o[d0]=__builtin_amdgcn_mfma_f32_32x32x16_bf16(pa3,PK(3),o[d0],0,0,0);
    #undef PK
  }
}

#ifndef ATTN_STORE16
#define ATTN_STORE16(p,v) (*(u32x4*)(p)=(v))
#endif
template<int THRL> __device__ __forceinline__ void attn_unit(int b,int h,int qb,const bf16*Q,const bf16*__restrict__ K,const bf16*__restrict__ V,bf16*O,char*shm){
  const int tid=threadIdx.x,lane=tid&63,r32=lane&31,hi=lane>>5; const int wid=__builtin_amdgcn_readfirstlane(tid>>6);
  const long rowbase=(long)b*SEQ; const int q0=qb*QB;
  const bf16*Qw=Q+(rowbase+q0+wid*QBLK)*QP+h*D;
  const int hk=h/(NHEAD/NKVH); const bf16*Kh=K+rowbase*KP+hk*D,*Vh=V+rowbase*KP+hk*D;
  const unsigned lds0=(unsigned)(uintptr_t)shm;
  float*wsf=(float*)(shm+LDS_WS)+wid*64;
  const bf16*ksrc=Kh+(long)lane*KP+wid*8;
  const bf16*vsrc=Vh+(long)(16*(wid&3)+(lane>>2))*KP+(wid>>2)*32+(lane&3)*8;
  const unsigned kdst=lds0+LDS_K+wid*1024, vdst=lds0+LDS_V+wid*1024;
  #define DMA_K(t,slot) glds16(ksrc+(long)(t)*KVBLK*KP,(unsigned)__builtin_amdgcn_readfirstlane(kdst+(slot)))
  #define DMA_V(t,slot) glds16(vsrc+(long)(t)*KVBLK*KP,(unsigned)__builtin_amdgcn_readfirstlane(vdst+(slot)))
  const int vb0=(int)(lds0+LDS_V)+((lane>>4)&1)*32+(lane&3)*8+(4*hi+((lane&15)>>2))*64;
  const char*Kbase=shm+LDS_K; bf16x8 kf[8];
  const lds_cptr shm3=(lds_cptr)shm; const lds_cptr kp0=shm3+LDS_K+hi*1024+r32*16; const lds_cptr vp0=shm3+LDS_V+((lane>>4)&1)*32+(lane&3)*8+(4*hi+((lane&15)>>2))*64;
  constexpr int NT=SEQ/KVBLK;
  DMA_K(0,0);DMA_V(0,0);DMA_K(1,SLOTB);
  bf16x8 qr[4];
  #pragma unroll
  for(int d0=0;d0<4;++d0)qr[d0]=*reinterpret_cast<const bf16x8*>(&Qw[(long)r32*QP+d0*16+hi*8]);
  float mhat=0.f,l_reg=0.f;f32x16 o[2];o[0]=f32x16{};o[1]=f32x16{};f32x16 negm=f32x16{};asm volatile("":"+v"(negm));
  const int qrel=wid*QBLK+r32;
  #define CMASK(P0,P1,t) do{}while(0)
  bool resc=false;
  #define START(P0,P1) do{ const float rm=rowmax(P0,P1); resc=false; \
    { const float dl=rm; mhat=fadd_s(mhat,dl); \
      _Pragma("unroll") for(int r=0;r<16;++r){P0[r]=fsub_s(P0[r],dl);P1[r]=fsub_s(P1[r],dl);} \
      _Pragma("unroll") for(int r=0;r<16;++r)negm[r]=-mhat; asm volatile("":"+v"(negm)); } \
    _Pragma("unroll") for(int r=0;r<16;++r)P0[r]=__builtin_amdgcn_exp2f(P0[r]); }while(0)
  #define RESC() do{ if(resc){ asm volatile("s_waitcnt lgkmcnt(0)":::"memory"); \
      _Pragma("unroll") for(int d_=0;d_<2;++d_) _Pragma("unroll") for(int r=0;r<16;++r)o[d_][r]*=wsf[crow(r,hi)]; } }while(0)
  f32x16 pA0,pA1,pB0,pB1;
  int sl_prev=0,sl_cur=0,sl_next=SLOTB;
  #define ROT() do{sl_prev=sl_cur;sl_cur=sl_next;sl_next=(sl_next==(NSLOT-1)*SLOTB)?0:sl_next+SLOTB;}while(0)
  DMA_K(2,2*SLOTB);
  WAIT_BAR(3);
  qkt(pA0,pA1,Kbase,qr,negm,r32,hi);asm volatile("s_nop 15\n\ts_nop 7":"+v"(pA0),"+v"(pA1));CMASK(pA0,pA1,0);
  START(pA0,pA1);
  _Pragma("unroll") for(int r=0;r<16;++r)pA1[r]=__builtin_amdgcn_exp2f(pA1[r]);
  WAIT_BAR(0);
  DMA_K(3,0);DMA_V(1,SLOTB);
  ROT();
  kload8(kf,kp0+sl_cur);
  WAIT_BAR(2);
  s16x4 vlo[8],vhi[8]; u32x4 pw0,pw1,pw2,pw3;
  #define PKW(P,B) cvtpk_s(P[B],P[B+1])
  #define PAF(k) __builtin_bit_cast(bf16x8,pw##k)
  #define VFR(i) (bf16x8){vlo[i][0],vlo[i][1],vlo[i][2],vlo[i][3],vhi[i][0],vhi[i][1],vhi[i][2],vhi[i][3]}
  #define PIN(x) asm volatile("":"+v"(x))
  #define MX3(a,b,c) __builtin_fmaxf(__builtin_fmaxf((a),(b)),(c))
  #define GAPA(MF,A0,A1,A2,A3,W0,W1,PW) do{ MF; sacc+=A0; sacc+=A1; sacc+=A2; sacc+=A3; PIN(sacc); W0; W1; PIN(PW); SBAR(); }while(0)
  #define EX(v) __builtin_amdgcn_exp2f(v)
  #define GAPB(MF,X,B) do{ MF; X[B]=EX(X[B]); X[B+1]=EX(X[B+1]); X[B+2]=EX(X[B+2]); X[B+3]=EX(X[B+3]); PIN(X); SBAR(); }while(0)
  #define VRD(i) do{ vlo[i]=vtr(vp_+(((i)>>2)*4096+((i)&3)*1024)); vhi[i]=vtr(vp_+(((i)>>2)*4096+((i)&3)*1024+512)); }while(0)
  #define KRD(G,j) do{ if(G){ kload2(kf,kp0+sl_next,j); SBAR(); } }while(0)
  #define STEP(C0,C1,P0,P1,t,GK,GV,GL) do{ SBAR(); \
    const lds_cptr vp_=vp0+sl_prev; \
    VRD(0); SBAR(); float sacc=(P0[0]+P0[1]); \
    GAPA(C0=__builtin_amdgcn_mfma_f32_32x32x16_bf16(kf[0],qr[0],negm,0,0,0), P0[2],P0[3],P0[4],P0[5],     pw0[0]=PKW(P0,0), pw0[1]=PKW(P0,2), pw0); \
    VRD(4); SBAR(); GAPA(C1=__builtin_amdgcn_mfma_f32_32x32x16_bf16(kf[1],qr[0],negm,0,0,0), P0[6],P0[7],P0[8],P0[9],     pw0[2]=PKW(P0,4), pw0[3]=PKW(P0,6), pw0); \
    VRD(1); SBAR(); GAPA(C0=__builtin_amdgcn_mfma_f32_32x32x16_bf16(kf[2],qr[1],C0,0,0,0),   P0[10],P0[11],P0[12],P0[13], pw1[0]=PKW(P0,8), pw1[1]=PKW(P0,10), pw1); \
    VRD(5); SBAR(); GAPA(C1=__builtin_amdgcn_mfma_f32_32x32x16_bf16(kf[3],qr[1],C1,0,0,0),   P0[14],P0[15],P1[0],P1[1],   pw1[2]=PKW(P0,12),pw1[3]=PKW(P0,14), pw1); \
    VRD(2); SBAR(); GAPA(C0=__builtin_amdgcn_mfma_f32_32x32x16_bf16(kf[4],qr[2],C0,0,0,0),   P1[2],P1[3],P1[4],P1[5],     pw2[0]=PKW(P1,0), pw2[1]=PKW(P1,2), pw2); \
    VRD(6); SBAR(); GAPA(C1=__builtin_amdgcn_mfma_f32_32x32x16_bf16(kf[5],qr[2],C1,0,0,0),   P1[6],P1[7],P1[8],P1[9],     pw2[2]=PKW(P1,4), pw2[3]=PKW(P1,6), pw2); \
    VRD(3); SBAR(); GAPA(C0=__builtin_amdgcn_mfma_f32_32x32x16_bf16(kf[6],qr[3],C0,0,0,0),   P1[10],P1[11],P1[12],P1[13], pw3[0]=PKW(P1,8), pw3[1]=PKW(P1,10), pw3); \
    VRD(7); SBAR(); GAPA(C1=__builtin_amdgcn_mfma_f32_32x32x16_bf16(kf[7],qr[3],C1,0,0,0),   P1[14],P1[15],0.f,0.f,       pw3[2]=PKW(P1,12),pw3[3]=PKW(P1,14), pw3); \
    l_reg+=sacc; \
    if(GK){DMA_K((t)+3,sl_cur);} if(GV){DMA_V((t)+1,sl_next);} \
    CMASK(C0,C1,t); \
    { float a=MX3(C0[0],C0[1],C1[0]),b=MX3(C0[2],C0[3],C1[1]); a=MX3(a,C1[2],C1[3]); \
      _Pragma("unroll") for(int r=4;r<16;r+=4){a=MX3(a,C0[r],C0[r+1]);b=MX3(b,C0[r+2],C0[r+3]);a=MX3(a,C1[r],C1[r+1]);b=MX3(b,C1[r+2],C1[r+3]);} \
      float rm=__builtin_fmaxf(a,b); { auto rr=__builtin_amdgcn_permlane32_swap(__float_as_uint(rm),__float_as_uint(rm),false,false); rm=__builtin_fmaxf(__uint_as_float(rr[0]),__uint_as_float(rr[1])); } \
      resc=false; \
      if(__builtin_expect(__any(rm>(float)THRL),0)){ const float dl=__builtin_fmaxf(rm,0.f); mhat+=dl; \
        _Pragma("unroll") for(int r=0;r<16;++r){C0[r]-=dl;C1[r]-=dl;} \
        _Pragma("unroll") for(int r=0;r<16;++r)negm[r]=-mhat; asm volatile("":"+v"(negm)); \
        const float f=__builtin_amdgcn_exp2f(-dl); l_reg*=f; if(hi==0)wsf[r32]=f; resc=true; } } \
    SBAR(); \
    GAPB(o[0]=__builtin_amdgcn_mfma_f32_32x32x16_bf16(PAF(0),VFR(0),o[0],0,0,0), C0,0); \
    GAPB(o[1]=__builtin_amdgcn_mfma_f32_32x32x16_bf16(PAF(0),VFR(4),o[1],0,0,0), C0,4); \
    KRD(GL,0); GAPB(o[0]=__builtin_amdgcn_mfma_f32_32x32x16_bf16(PAF(1),VFR(1),o[0],0,0,0), C0,8); \
    KRD(GL,1); GAPB(o[1]=__builtin_amdgcn_mfma_f32_32x32x16_bf16(PAF(1),VFR(5),o[1],0,0,0), C0,12); \
    KRD(GL,2); GAPB(o[0]=__builtin_amdgcn_mfma_f32_32x32x16_bf16(PAF(2),VFR(2),o[0],0,0,0), C1,0); \
    KRD(GL,3); GAPB(o[1]=__builtin_amdgcn_mfma_f32_32x32x16_bf16(PAF(2),VFR(6),o[1],0,0,0), C1,4); \
    GAPB(o[0]=__builtin_amdgcn_mfma_f32_32x32x16_bf16(PAF(3),VFR(3),o[0],0,0,0), C1,8); \
    GAPB(o[1]=__builtin_amdgcn_mfma_f32_32x32x16_bf16(PAF(3),VFR(7),o[1],0,0,0), C1,12); \
    }while(0)
  int t=1;
  #undef CMASK
  #define CMASK(P0,P1,t) do{}while(0)
  for(;t+5<NT;t+=2){
    STEP(pB0,pB1,pA0,pA1,t,true,true,true);     WAIT_BAR(2); RESC(); ROT();
    STEP(pA0,pA1,pB0,pB1,t+1,true,true,true);   WAIT_BAR(2); RESC(); ROT();
  }
  #undef CMASK
  #define CMASK(P0,P1,t) do{}while(0)
  #define ENDW(tt) do{ if((tt)+3<NT){WAIT_BAR(2);} else if((tt)+2<NT){WAIT_BAR(1);} else {WAIT_BAR(0);} }while(0)
  for(;t+1<NT;t+=2){
    STEP(pB0,pB1,pA0,pA1,t,(t+3<NT),(t+1<NT),(t+1<NT));       ENDW(t);   RESC(); ROT();
    STEP(pA0,pA1,pB0,pB1,t+1,(t+4<NT),(t+2<NT),(t+2<NT));     ENDW(t+1); RESC(); ROT();
  }
  STEP(pB0,pB1,pA0,pA1,NT-1,false,false,false); RESC();
  { float sacc=pB0[0]+pB0[1]; _Pragma("unroll") for(int r=2;r<16;++r)sacc+=pB0[r]; _Pragma("unroll") for(int r=0;r<16;++r)sacc+=pB1[r]; l_reg+=sacc;
    pw0=(u32x4){PKW(pB0,0),PKW(pB0,2),PKW(pB0,4),PKW(pB0,6)};pw1=(u32x4){PKW(pB0,8),PKW(pB0,10),PKW(pB0,12),PKW(pB0,14)};pw2=(u32x4){PKW(pB1,0),PKW(pB1,2),PKW(pB1,4),PKW(pB1,6)};pw3=(u32x4){PKW(pB1,8),PKW(pB1,10),PKW(pB1,12),PKW(pB1,14)};
    SBAR(); pv(o,vb0+sl_cur,PAF(0),PAF(1),PAF(2),PAF(3)); }
  #undef PKW
  #undef PAF
  #undef VFR
  #undef PIN
  #undef MX3
  #undef GAPA
  #undef GAPB
  #undef EX
  #undef VRD
  #undef KRD
  #undef STEP
  #undef ENDW
  {auto rr=__builtin_amdgcn_permlane32_swap(__float_as_uint(l_reg),__float_as_uint(l_reg),false,false);l_reg=__uint_as_float(rr[0])+__uint_as_float(rr[1]);}
  if(hi==0)wsf[32+r32]=l_reg;asm volatile("s_waitcnt lgkmcnt(0)":::"memory");
  float rli[16];
  #pragma unroll
  for(int r=0;r<16;++r)rli[r]=__builtin_amdgcn_rcpf(wsf[32+crow(r,hi)]);
  bf16*Ow=O+(rowbase+q0+wid*QBLK)*OP+h*D;
  { bf16*stg=(bf16*)(shm+LDS_OST)+wid*2048;
    #pragma unroll
    for(int r=0;r<16;++r){const int orow=crow(r,hi);
      #pragma unroll
      for(int d0=0;d0<2;++d0)stg[orow*64+d0*32+r32]=__float2bfloat16(o[d0][r]*rli[r]);}
    asm volatile("s_waitcnt lgkmcnt(0)":::"memory");
    #pragma unroll
    for(int i=0;i<4;++i){const int row=i*8+(lane>>3),ch=lane&7; const u32x4 v=*(const u32x4*)(stg+row*64+ch*8); ATTN_STORE16(Ow+(long)row*OP+ch*8,v);} }
  asm volatile("s_waitcnt lgkmcnt(0)\n\ts_barrier":::"memory");
  #undef DMA_K
  #undef DMA_V
  #undef CMASK
  #undef START
  #undef RESC
  #undef ROT
}
constexpr int ATTN_LDS_BYTES=LDS_BYTES;
struct AttnTensors { const bf16* Q; const bf16* K; const bf16* V; bf16* O; };
struct AttnUnit { int bh; int qb; };
struct StaticOrder {
  int vcu, G;
  __device__ __forceinline__ explicit StaticOrder(int grid,int block):vcu((grid%8==0)?(block%8)*(grid/8)+block/8:block),G(grid){}
  __device__ __forceinline__ bool next(int i,AttnUnit&u)const{
    const int L=i*G+vcu; if(L>=BATCH*NHEAD*NQB)return false;
    if(G==256){ if(i>=2)return false; const int x=vcu>>5,j=vcu&31; const int b=x>>2,kvh=(x>>1)&1,hq=kvh*4+2*(x&1)+i; u.bh=b*NHEAD+hq; u.qb=j; return true; }
    u.bh=L/NQB; u.qb=L%NQB; return true; }
  __device__ __forceinline__ void a_ready(const AttnUnit&)const{}
  __device__ __forceinline__ void done(const AttnUnit&)const{}
};
template<class Sched,int THRL=8> __device__ __forceinline__ void attn_phase(char*lds,const AttnTensors&T,const Sched&S){
  AttnUnit u;
  for(int i=0;S.next(i,u);++i){ S.a_ready(u); attn_unit<THRL>(u.bh/NHEAD,u.bh%NHEAD,u.qb,T.Q,T.K,T.V,T.O,lds); S.done(u); }
}
#undef SBAR
#undef WAIT_BAR
}

#include <hip/hip_cooperative_groups.h>
namespace cg = cooperative_groups;
#ifndef MK_PER_PHASE
#define MK_PER_PHASE 0
#endif
constexpr int NWAVES = 8, NTHREADS = 512;
constexpr int NB = 2, SEQ = 8192, DMODEL = 1024, TT = NB * SEQ;
constexpr int NPROJ = 3072;
constexpr int NEXP = 32, FFE = 512;
constexpr float EPS = 1e-6f;
constexpr int N_PHASES = 12;

constexpr size_t MiB = 1u << 20;
constexpr size_t WS_CTL = 0, CTL_ZERO_BYTES = 64 * 1024;
constexpr size_t WS_WOUT = 1 * MiB;
constexpr size_t WS_WR = 3 * MiB;
constexpr size_t WS_TOK = 3 * MiB + 256 * 1024;
constexpr size_t WS_GATES = 4 * MiB;
constexpr size_t WS_WIN = 5 * MiB;
constexpr size_t WS_A = 11 * MiB;
constexpr size_t WS_XN = WS_A;
constexpr size_t GDN_SH_BYTES = 71680, GDN_D_BYTES = 19456;
constexpr size_t WS_GSH = WS_A;
constexpr size_t WS_GD = WS_A + 1024 * GDN_SH_BYTES;
constexpr size_t WS_WGU = WS_A;
constexpr size_t WS_WD = WS_A + 64 * MiB;
constexpr size_t WS_HID = WS_A + 96 * MiB;
constexpr size_t WS_B = 157 * MiB;
constexpr size_t WS_QKVA = WS_B;
constexpr size_t WS_QKVB = WS_B + 48 * MiB;
constexpr size_t WS_ZA = WS_B + 72 * MiB;
constexpr size_t WS_OCAT = WS_B;
constexpr size_t WS_XBUF = WS_B;
constexpr size_t WS_HN = WS_B + 80 * MiB;
constexpr size_t WS_END = 269 * MiB;
static_assert(WS_GD + 4096 * GDN_D_BYTES <= WS_B, "GDN records fit region A");
static_assert(WS_HID + 40928ull * 1024 <= WS_B, "HID fits region A");
static_assert(WS_HN + 32 * MiB <= WS_END, "HN");
constexpr size_t DO_QR = 0, DO_KR = 16 * MiB, DO_VR = 20 * MiB, DO_OF = 24 * MiB, DO_OB = 40 * MiB;
constexpr int CW_CNT = 64;
constexpr int CW_NTILE = 128;
constexpr int CW_TILES = 192;

constexpr int LDS_BYTES = 160 * 1024;

#define GAS __attribute__((address_space(1)))
#define LAS __attribute__((address_space(3)))
typedef unsigned short bf16;
typedef unsigned v4u __attribute__((ext_vector_type(4)));
typedef unsigned v2u __attribute__((ext_vector_type(2)));
typedef float f32x4 __attribute__((ext_vector_type(4)));
typedef short bf16x8 __attribute__((ext_vector_type(8)));
typedef short s16x4 __attribute__((ext_vector_type(4)));
#define DI __device__ __forceinline__

DI unsigned f2bf(float f) { unsigned u = __builtin_bit_cast(unsigned, f); return (u + 0x7fffu + ((u >> 16) & 1u)) >> 16; }
DI unsigned pk2(float lo, float hi) { return f2bf(lo) | (f2bf(hi) << 16); }
DI float bf2f(unsigned short h) { return __builtin_bit_cast(float, (unsigned)h << 16); }
DI float bflo(unsigned w) { return __builtin_bit_cast(float, w << 16); }
DI float bfhi(unsigned w) { return __builtin_bit_cast(float, w & 0xffff0000u); }
DI float wave_sum(float v) {
#pragma unroll
    for (int o = 1; o < 64; o <<= 1) v += __shfl_xor(v, o);
    return v;
}
DI float siluf(float x) { return x * __builtin_amdgcn_rcpf(1.0f + __expf(-x)); }
DI float sigmoidf_(float x) { return 1.0f / (1.0f + __expf(-x)); }
DI int perm32i(int idx) { return ((idx >> 2) & 3) * 8 + (idx >> 4) * 4 + (idx & 3); }
DI int permcol(int c) { return (c & ~31) + perm32i(c & 31); }
template <class T> DI T opaque(T p) { asm volatile("" : "+v"(p)); return p; }

struct Frame {
    LAS unsigned char* lds;
    int tid, lane, wave, vcu, G;
    const float* in[17];
    float* out; unsigned char* ws;
};

DI void p0_transpose_item(const float* W, int ldw, int nblk, bf16* WT, int K, int row_off, int rmul, LAS float* scr, int item, int lane) {
    const int kb = item / nblk, nb = item % nblk, k0 = 64 * kb, n0 = 32 * nb;
#pragma unroll 8
    for (int i = 0; i < 32; ++i) { const int kk = 2 * i + (lane >> 5); scr[kk * 33 + (lane & 31)] = W[(size_t)(k0 + kk) * ldw + n0 + (lane & 31)]; }
    asm volatile("s_waitcnt lgkmcnt(0)" ::: "memory");
    const int c = lane & 7;
#pragma unroll
    for (int j = 0; j < 4; ++j) { const int n = (lane >> 3) + 8 * j; const LAS float* s = scr + (8 * c) * 33 + n;
        v4u o; o.x = pk2(s[0 * 33], s[1 * 33]); o.y = pk2(s[2 * 33], s[3 * 33]); o.z = pk2(s[4 * 33], s[5 * 33]); o.w = pk2(s[6 * 33], s[7 * 33]);
        *(GAS v4u*)(WT + (size_t)(row_off + (n0 + n) * rmul) * K + k0 + 8 * c) = o; }
    asm volatile("s_waitcnt lgkmcnt(0)" ::: "memory");
}
DI void rms_row_to_bf16(const float* xrow, const float* w, bf16* orow, int lane) {
    const GAS f32x4* xr = (const GAS f32x4*)xrow + lane; const GAS f32x4* wr = (const GAS f32x4*)w + lane;
    f32x4 v[4]; float s = 0.f;
#pragma unroll
    for (int j = 0; j < 4; ++j) { v[j] = xr[64 * j]; s += (v[j].x * v[j].x + v[j].y * v[j].y) + (v[j].z * v[j].z + v[j].w * v[j].w); }
    const float rs = 1.0f / sqrtf(wave_sum(s) * (1.f / DMODEL) + EPS);
    GAS v2u* o8 = (GAS v2u*)orow + lane;
#pragma unroll
    for (int j = 0; j < 4; ++j) { const f32x4 ww = wr[64 * j]; v2u o; o.x = pk2(v[j].x * rs * ww.x, v[j].y * rs * ww.y); o.y = pk2(v[j].z * rs * ww.z, v[j].w * rs * ww.w); o8[64 * j] = o; }
}
DI void p0_prologue(Frame& F) {
    LAS float* scr = (LAS float*)(F.lds + F.wave * 16384);
    const int gw = F.vcu * NWAVES + F.wave, NGW = F.G * NWAVES;
    const float* w_in = F.in[2]; const float* w_out = F.in[9];
    bf16* WIN = (bf16*)(F.ws + WS_WIN); bf16* WOUT = (bf16*)(F.ws + WS_WOUT);
    constexpr int I1 = 16 * 64, I2 = 16 * 24, I3 = 16, I4 = 16 * 32, NITEMS = I1 + I2 + I3 + I4;
    for (int it = gw; it < NITEMS; it += NGW) {
        int r = it;
        if (r < I1) { p0_transpose_item(w_in, 2832, 64, WIN, 1024, 0, 1, scr, r, F.lane); continue; } r -= I1;
        if (r < I2) { p0_transpose_item(w_in + 2064, 2832, 24, WIN, 1024, 2048, 1, scr, r, F.lane); continue; } r -= I2;
        if (r < I3) { p0_transpose_item(w_in + 2048, 2832, 1, WIN, 1024, 2816, 1, scr, r, F.lane); continue; } r -= I3;
        p0_transpose_item(w_out, 1024, 32, WOUT, 1024, 0, 1, scr, r, F.lane);
    }
    { const int gt = F.vcu * NTHREADS + F.tid, GT = F.G * NTHREADS; GAS v4u* z = (GAS v4u*)(WIN + (size_t)2848 * 1024);
      for (int i = gt; i < 224 * 1024 * 2 / 16; i += GT) z[i] = (v4u){0u, 0u, 0u, 0u}; }
    { const int gt = F.vcu * NTHREADS + F.tid, GT = F.G * NTHREADS; bf16* WRH = (bf16*)(F.ws + WS_WR); bf16* WRL = WRH + 48 * 1024;
      const float* wrg = F.in[11]; const float* wre = F.in[12];
      for (int i = gt; i < 48 * 1024; i += GT) { const int j = i >> 10, k = i & 1023; float v = 0.f; if (j < 4) v = wrg[k * 4 + j]; else if (j < 36) v = wre[k * 32 + (j - 4)];
          const unsigned h = f2bf(v); const float hv = __builtin_bit_cast(float, h << 16); WRH[i] = (bf16)h; WRL[i] = (bf16)f2bf(v - hv); } }
    bf16* XN = (bf16*)(F.ws + WS_XN);
    for (int m = gw; m < TT; m += NGW) rms_row_to_bf16(F.in[0] + (size_t)m * DMODEL, F.in[1], XN + (size_t)m * DMODEL, F.lane);
}

struct EpiProj {
    static constexpr bool PERM = true, AFTER_DRAIN = false;
    bf16 *qkva, *za, *qkvb; float* gates;
    DI void operator()(const pg8::f32x4 (&acc)[2][2][4][2], const pg8::Unit& u, int wr, int wc, int fr, int fq) const {
        const int row0 = u.pm * 256 + wr * 64 + fr;
        if (u.pn == 11) {
            if (wc == 0 && fq < 2) {
#pragma unroll
                for (int ai = 0; ai < 2; ++ai)
#pragma unroll
                    for (int m = 0; m < 4; ++m) { float* rp = gates + (size_t)(row0 + ai * 128 + m * 16) * 16 + 8 * fq;
                        *(pg8::f32x4*)(rp) = acc[ai][0][m][0]; *(pg8::f32x4*)(rp + 4) = acc[ai][0][m][1]; }
            }
            return;
        }
        bf16* base; int ldc, colt;
        if (u.pn < 6) { base = qkva; ldc = 1536; colt = u.pn * 256; } else if (u.pn < 8) { base = za; ldc = 512; colt = (u.pn - 6) * 256; } else { base = qkvb; ldc = 768; colt = (u.pn - 8) * 256; }
        const int col0 = colt + wc * 32 + 8 * fq;
#pragma unroll
        for (int ai = 0; ai < 2; ++ai)
#pragma unroll
            for (int m = 0; m < 4; ++m) { bf16* rowp = base + (size_t)(row0 + ai * 128 + m * 16) * ldc + col0;
#pragma unroll
                for (int bj = 0; bj < 2; ++bj) { const pg8::f32x4 v0 = acc[ai][bj][m][0], v1 = acc[ai][bj][m][1]; pg8::u32x4 w;
                    w.x = pg8::cvt_pk_bf16(v0[0], v0[1]); w.y = pg8::cvt_pk_bf16(v0[2], v0[3]); w.z = pg8::cvt_pk_bf16(v1[0], v1[1]); w.w = pg8::cvt_pk_bf16(v1[2], v1[3]);
                    *(pg8::u32x4*)(rowp + bj * 128) = w; } }
    }
};
struct EpiResid {
    static constexpr bool PERM = false, AFTER_DRAIN = false;
    const float* x; float* x1;
    DI void operator()(const pg8::f32x4 (&acc)[2][2][4][2], const pg8::Unit& u, int wr, int wc, int fr, int fq) const {
        const int row0 = u.pm * 256 + wr * 64 + fr, col0 = u.pn * 256 + wc * 32 + 4 * fq;
#pragma unroll
        for (int ai = 0; ai < 2; ++ai)
#pragma unroll
            for (int m = 0; m < 4; ++m) { const size_t off = (size_t)(row0 + ai * 128 + m * 16) * DMODEL + col0;
#pragma unroll
                for (int bj = 0; bj < 2; ++bj)
#pragma unroll
                    for (int n = 0; n < 2; ++n) { const pg8::f32x4 b = *(const pg8::f32x4*)(x + off + bj * 128 + n * 16); *(pg8::f32x4*)(x1 + off + bj * 128 + n * 16) = b + acc[ai][bj][m][n]; } }
    }
};
struct EpiGU {
    static constexpr bool PERM = true, AFTER_DRAIN = false;
    bf16* hid;
    DI void operator()(const pg8::f32x4 (&acc)[2][2][4][2], const pg8::Unit& u, int wr, int wc, int fr, int fq) const {
        const int row0 = u.pm * 256 + wr * 64 + fr; const int jt = u.pn & 3;
        const int ff0 = jt * 128 + wc * 16 + 4 * fq;
#pragma unroll
        for (int ai = 0; ai < 2; ++ai)
#pragma unroll
            for (int m = 0; m < 4; ++m) { bf16* rowp = hid + (size_t)(row0 + ai * 128 + m * 16) * FFE + ff0;
#pragma unroll
                for (int bj = 0; bj < 2; ++bj) { const pg8::f32x4 v0 = acc[ai][bj][m][0], v1 = acc[ai][bj][m][1];
                    const float h0 = siluf(v0[0]) * v0[1], h1 = siluf(v0[2]) * v0[3], h2 = siluf(v1[0]) * v1[1], h3 = siluf(v1[2]) * v1[3];
                    v2u w; w.x = pg8::cvt_pk_bf16(h0, h1); w.y = pg8::cvt_pk_bf16(h2, h3);
                    *(v2u*)(rowp + bj * 64) = w; } }
    }
};
struct EpiY {
    static constexpr bool PERM = true, AFTER_DRAIN = false;
    bf16* y;
    DI void operator()(const pg8::f32x4 (&acc)[2][2][4][2], const pg8::Unit& u, int wr, int wc, int fr, int fq) const {
        const int row0 = u.pm * 256 + wr * 64 + fr; const int col0 = (u.pn & 3) * 256 + wc * 32 + 8 * fq;
#pragma unroll
        for (int ai = 0; ai < 2; ++ai)
#pragma unroll
            for (int m = 0; m < 4; ++m) { bf16* rowp = y + (size_t)(row0 + ai * 128 + m * 16) * DMODEL + col0;
#pragma unroll
                for (int bj = 0; bj < 2; ++bj) { const pg8::f32x4 v0 = acc[ai][bj][m][0], v1 = acc[ai][bj][m][1]; pg8::u32x4 w;
                    w.x = pg8::cvt_pk_bf16(v0[0], v0[1]); w.y = pg8::cvt_pk_bf16(v0[2], v0[3]); w.z = pg8::cvt_pk_bf16(v1[0], v1[1]); w.w = pg8::cvt_pk_bf16(v1[2], v1[3]);
                    *(pg8::u32x4*)(rowp + bj * 128) = w; } }
    }
};
struct MoeOrder {
    const unsigned* ctl; int G, c;
    DI bool next(int i, pg8::Unit& u) const {
        const int nt = (int)ctl[CW_NTILE]; const int L = i * G + c; if (L >= nt * 4) return false;
        const int t = L >> 2, j = L & 3; u.pm = (int)ctl[CW_TILES + 2 * t]; u.pn = (int)ctl[CW_TILES + 2 * t + 1] * 4 + j; return true; }
    DI void a_ready(const pg8::Unit&) const {}
    DI void done(const pg8::Unit&) const {}
};

DI void p2_rope(Frame& F) {
    const int gw = F.vcu * NWAVES + F.wave, NGW = F.G * NWAVES, lane = F.lane;
    const bf16* QKVB = (const bf16*)(F.ws + WS_QKVB);
    bf16* QR = (bf16*)((unsigned char*)F.out + DO_QR); bf16* KR = (bf16*)((unsigned char*)F.out + DO_KR); bf16* VR = (bf16*)((unsigned char*)F.out + DO_VR);
    const int pi = lane & 31, hsel = lane >> 5;
    const float qw0 = F.in[7][2 * pi], qw1 = F.in[7][2 * pi + 1], kw0 = F.in[8][2 * pi], kw1 = F.in[8][2 * pi + 1];
    const float invf = exp2f(-(float)(2 * (pi & 15)) * (13.287712379549449f / 32.0f));
    constexpr float C2 = 0.125f * 1.4426950408889634f;
    for (int t = gw; t < TT; t += NGW) {
        const int s = t & (SEQ - 1); const float pos = (pi < 16) ? (float)(s >> 6) : (float)(s & 63);
        const float ang = pos * invf;
        const double rev = (double)ang * 0.15915494309189535; const float fr = (float)(rev - floor(rev));
        const float sn = __builtin_amdgcn_sinf(fr), cs = __builtin_amdgcn_cosf(fr);
        const unsigned* src = (const unsigned*)(QKVB + (size_t)t * 768);
#pragma unroll
        for (int j = 0; j < 5; ++j) {
            const int head = 2 * j + hsel; const unsigned w = src[head * 32 + pi];
            const float x0 = bflo(w), x1 = bfhi(w);
            float ss = x0 * x0 + x1 * x1;
#pragma unroll
            for (int o = 1; o < 32; o <<= 1) ss += __shfl_xor(ss, o);
            const float rs = 1.0f / sqrtf(ss * (1.f / 64.f) + EPS);
            const bool isq = head < 8;
            const float y0 = x0 * rs * (isq ? qw0 : kw0), y1 = x1 * rs * (isq ? qw1 : kw1);
            float o0 = y0 * cs - y1 * sn, o1 = y0 * sn + y1 * cs;
            if (isq) { o0 *= C2; o1 *= C2; ((unsigned*)(QR + (size_t)t * 512))[head * 32 + pi] = pk2(o0, o1); }
            else ((unsigned*)(KR + (size_t)t * 128))[(head - 8) * 32 + pi] = pk2(o0, o1);
        }
        ((unsigned*)(VR + (size_t)t * 128))[lane] = src[320 + lane];
    }
}

constexpr int G_KNP = 0, G_QNP = 17408, G_KNTP = 34816, G_VCT = 53248;
constexpr int G_D0 = 71680, G_D1 = 71680 + 19456;
constexpr int GD_TBP = 0, GD_AP = 9216, GD_VEC = 18432;
constexpr int G_LM = 110592;
constexpr int G_GV = G_LM + 32768;
static_assert(G_GV + 1024 <= LDS_BYTES, "gdn pre lds");

template <bool REV> DI void tri_inverse(LAS float* L, const LAS float* beta, LAS bf16* TBP, int lane) {
    const float bcol = REV ? beta[63 - lane] : beta[lane];
    const int pc = REV ? permcol(63 - lane) : permcol(lane);
    LAS float* Xc = L + lane;
#pragma unroll 1
    for (int i = 0; i < 64; ++i) {
        float a0 = (lane == i) ? 1.0f : 0.0f, a1 = 0.f, a2 = 0.f, a3 = 0.f;
        const LAS float* Li = L + i * 64;
        const int nq = i >> 2;
#pragma unroll 4
        for (int j4 = 0; j4 < nq; ++j4) {
            const f32x4 l = *(const LAS f32x4*)(Li + 4 * j4);
            a0 -= l.x * Xc[(4 * j4 + 0) * 64]; a1 -= l.y * Xc[(4 * j4 + 1) * 64]; a2 -= l.z * Xc[(4 * j4 + 2) * 64]; a3 -= l.w * Xc[(4 * j4 + 3) * 64];
        }
        const int rem = i & 3;
        if (rem) {
            const f32x4 l = *(const LAS f32x4*)(Li + 4 * nq);
            a0 -= l.x * Xc[(4 * nq + 0) * 64];
            if (rem > 1) a1 -= l.y * Xc[(4 * nq + 1) * 64];
            if (rem > 2) a2 -= l.z * Xc[(4 * nq + 2) * 64];
        }
        const float a = (a0 + a1) + (a2 + a3);
        asm volatile("s_waitcnt lgkmcnt(0)" ::: "memory");
        Xc[i * 64] = a;
        const int row = REV ? 63 - i : i;
        TBP[row * 72 + pc] = (bf16)f2bf(a * bcol);
    }
}

DI void p2_gdn_pre(Frame& F) {
    const int tid = F.tid, lane = F.lane, wave = F.wave;
    const bf16* QKVA = (const bf16*)(F.ws + WS_QKVA); const float* GATES = (const float*)(F.ws + WS_GATES);
    const float* convw = F.in[3];
#pragma unroll 1
    for (int task = F.vcu; task < 1024; task += F.G) {
        LAS unsigned char* lds = opaque(F.lds);
        LAS float* sGf = (LAS float*)(lds + G_GV); LAS float* sRb = sGf + 64; LAS float* sBf = sGf + 128; LAS float* sBb = sGf + 192;
        const int b = task >> 9, h = (task >> 7) & 3, n = task & 127;
        const int t0 = b * SEQ + n * 64;
#ifndef NO_CONV
        if (tid < 384) {
            const int cgp = tid % 48, rg = tid / 48, mat = cgp >> 4, cc = (cgp & 15) * 8;
            const int col = mat * 512 + h * 128 + cc;
            float w[5][8];
#pragma unroll
            for (int j = 0; j < 5; ++j) { const f32x4 a = *(const f32x4*)(convw + j * 1536 + col), bq = *(const f32x4*)(convw + j * 1536 + col + 4);
                w[j][0] = a.x; w[j][1] = a.y; w[j][2] = a.z; w[j][3] = a.w; w[j][4] = bq.x; w[j][5] = bq.y; w[j][6] = bq.z; w[j][7] = bq.w; }
            const int a4 = (cc >> 3) & 3, p0 = (cc & ~31) + 16 * (a4 & 1) + 4 * (a4 >> 1);
            const int ra = rg & 3, q0 = (rg >> 2) * 32 + 16 * (ra & 1) + 4 * (ra >> 1);
#pragma unroll
            for (int hf = 0; hf < 2; ++hf) {
                float o[4][8];
#pragma unroll
                for (int r = 0; r < 4; ++r)
#pragma unroll
                    for (int c = 0; c < 8; ++c) o[r][c] = 0.f;
#pragma unroll
                for (int i = 0; i < 8; ++i) {
                    const int pos = n * 64 + rg * 8 + hf * 4 - 2 + i;
                    v4u raw = (v4u){0u, 0u, 0u, 0u};
                    if (pos >= 0 && pos < SEQ) raw = *(const v4u*)(QKVA + (size_t)(b * SEQ + pos) * 1536 + col);
                    float xin[8] = {bflo(raw.x), bfhi(raw.x), bflo(raw.y), bfhi(raw.y), bflo(raw.z), bfhi(raw.z), bflo(raw.w), bfhi(raw.w)};
#pragma unroll
                    for (int j = 0; j < 5; ++j) { const int r = i - j; if (r >= 0 && r < 4) {
#pragma unroll
                        for (int c = 0; c < 8; ++c) o[r][c] += w[j][c] * xin[c]; } }
                }
#pragma unroll
                for (int r = 0; r < 4; ++r) {
                    float ss = 0.f;
#pragma unroll
                    for (int c = 0; c < 8; ++c) { o[r][c] = siluf(o[r][c]); ss += o[r][c] * o[r][c]; }
                    ss += __shfl_xor(ss, 1); ss += __shfl_xor(ss, 2); ss += __shfl_xor(ss, 4); ss += __shfl_xor(ss, 8);
                    float sc = 1.0f;
                    if (mat < 2) { sc = 1.0f / sqrtf(ss + EPS); if (mat == 0) sc *= 0.08838834764831845f; }
#pragma unroll
                    for (int c = 0; c < 8; ++c) o[r][c] *= sc;
                }
                if (mat < 2) {
                    LAS unsigned char* tile = lds + (mat == 0 ? G_QNP : G_KNP);
#pragma unroll
                    for (int r = 0; r < 4; ++r) { const int c = rg * 8 + hf * 4 + r;
                        v2u lo, hi2; lo.x = pk2(o[r][0], o[r][1]); lo.y = pk2(o[r][2], o[r][3]); hi2.x = pk2(o[r][4], o[r][5]); hi2.y = pk2(o[r][6], o[r][7]);
                        *(LAS v2u*)(tile + c * 272 + p0 * 2) = lo; *(LAS v2u*)(tile + c * 272 + (p0 + 8) * 2) = hi2; }
                }
                if (mat >= 1) {
#pragma unroll
                    for (int c = 0; c < 8; ++c) {
                        v2u q4; q4.x = pk2(o[0][c], o[1][c]); q4.y = pk2(o[2][c], o[3][c]);
                        if (mat == 1) *(LAS v2u*)(lds + G_KNTP + (cc + c) * 144 + (q0 + 8 * hf) * 2) = q4;
                        else *(LAS v2u*)(lds + G_VCT + (cc + c) * 144 + rg * 16 + hf * 8) = q4;
                    }
                }
            }
        } else
#endif
        if (wave == 7) {
            const float* gp = GATES + (size_t)(t0 + lane) * 16;
            const float bfv = gp[h], bbv = gp[4 + h], afv = gp[8 + h], abv = gp[12 + h];
            const float betaf = sigmoidf_(bfv), betab = sigmoidf_(bbv);
            const float xf = afv + F.in[5][h], xb = abv + F.in[5][4 + h];
            const float spf = fmaxf(xf, 0.f) + log1pf(__expf(-fabsf(xf))), spb = fmaxf(xb, 0.f) + log1pf(__expf(-fabsf(xb)));
            const float gf = -__expf(F.in[4][h]) * spf, gb = -__expf(F.in[4][4 + h]) * spb;
            float Gf = gf, Rb = gb;
#pragma unroll
            for (int o = 1; o < 64; o <<= 1) { const float u1 = __shfl_up(Gf, o); if (lane >= o) Gf += u1; const float d1 = __shfl_down(Rb, o); if (lane + o < 64) Rb += d1; }
            sGf[lane] = Gf; sRb[lane] = Rb; sBf[lane] = betaf; sBb[lane] = betab;
            const float GfL = __shfl(Gf, 63), Rb0 = __shfl(Rb, 0);
            LAS float* v0 = (LAS float*)(lds + G_D0 + GD_VEC); LAS float* v1 = (LAS float*)(lds + G_D1 + GD_VEC);
            v0[lane] = __expf(Gf); v0[64 + lane] = __expf(GfL - Gf); v1[lane] = __expf(Rb); v1[64 + lane] = __expf(Rb0 - Rb);
            if (lane == 0) { v0[128] = __expf(GfL); v1[128] = __expf(Rb0); }
        }
        __syncthreads();
        {
            const int p = wave >> 2, mt = wave & 3, n16 = lane & 15, g = lane >> 4;
            const LAS unsigned char* At = lds + (p == 0 ? G_KNP : G_QNP) + (16 * mt + n16) * 272 + g * 16;
            bf16x8 af[4];
#pragma unroll
            for (int ks = 0; ks < 4; ++ks) af[ks] = *(const LAS bf16x8*)(At + ks * 64);
#pragma unroll
            for (int nt = 0; nt < 4; ++nt) {
                const LAS unsigned char* Bt = lds + G_KNP + (16 * nt + n16) * 272 + g * 16;
                f32x4 acc = (f32x4){0.f, 0.f, 0.f, 0.f};
#pragma unroll
                for (int ks = 0; ks < 4; ++ks) acc = __builtin_amdgcn_mfma_f32_16x16x32_bf16(af[ks], *(const LAS bf16x8*)(Bt + ks * 64), acc, 0, 0, 0);
                const int s = 16 * nt + n16; const float Gs = sGf[s], Rs = sRb[s];
#pragma unroll
                for (int r = 0; r < 4; ++r) {
                    const int c = 16 * mt + 4 * g + r; const float v = acc[r];
                    const float df = __expf(fminf(sGf[c] - Gs, 0.f)), db = __expf(fminf(sRb[c] - Rs, 0.f));
                    if (p == 0) {
                        if (s < c) ((LAS float*)(lds + G_LM))[c * 64 + s] = sBf[c] * v * df;
                        if (s > c) ((LAS float*)(lds + G_LM + 16384))[(63 - c) * 64 + (63 - s)] = sBb[c] * v * db;
                    } else {
                        const int ps = permcol(s);
                        ((LAS bf16*)(lds + G_D0 + GD_AP))[c * 72 + ps] = (bf16)f2bf(s <= c ? v * df : 0.f);
                        ((LAS bf16*)(lds + G_D1 + GD_AP))[c * 72 + ps] = (bf16)f2bf(s >= c ? v * db : 0.f);
                    }
                }
            }
        }
        __syncthreads();
#ifndef NO_TRI
        if (wave == 0) tri_inverse<false>((LAS float*)(lds + G_LM), sBf, (LAS bf16*)(lds + G_D0 + GD_TBP), lane);
        else if (wave == 1) tri_inverse<true>((LAS float*)(lds + G_LM + 16384), sBb, (LAS bf16*)(lds + G_D1 + GD_TBP), lane);
#endif
        __syncthreads();
        {
            const int bh = b * 4 + h;
            GAS v4u* gsh = (GAS v4u*)(F.ws + WS_GSH + (size_t)(bh * 128 + n) * GDN_SH_BYTES);
#pragma unroll 1
            for (int i = tid; i < (int)(GDN_SH_BYTES / 16); i += NTHREADS) gsh[i] = *(const LAS v4u*)(lds + i * 16);
            GAS v4u* gd0 = (GAS v4u*)(F.ws + WS_GD + (size_t)((bh * 2 + 0) * 128 + n) * GDN_D_BYTES);
            GAS v4u* gd1 = (GAS v4u*)(F.ws + WS_GD + (size_t)((bh * 2 + 1) * 128 + n) * GDN_D_BYTES);
#pragma unroll 1
            for (int i = tid; i < (int)(GDN_D_BYTES / 16); i += NTHREADS) { gd0[i] = *(const LAS v4u*)(lds + G_D0 + i * 16); gd1[i] = *(const LAS v4u*)(lds + G_D1 + i * 16); }
        }
        __syncthreads();
    }
}

DI bf16x8 pack8(const f32x4 a, const f32x4 b) {
    v4u p; p.x = pk2(a[0], a[1]); p.y = pk2(a[2], a[3]); p.z = pk2(b[0], b[1]); p.w = pk2(b[2], b[3]); return __builtin_bit_cast(bf16x8, p);
}
DI void p4_scan(Frame& F) {
    if (F.wave != 0) return;
    const int bx = blockIdx.x; if (bx >= 128) return;
    const int lane = F.lane, n16 = lane & 15, g = lane >> 4;
    const int x = bx & 7, j = bx >> 3; const int chain = 2 * x + (j >> 3), e = j & 7;
    const int bh = chain >> 1, dir = chain & 1, b = bh >> 2, h = bh & 3;
    bf16* Odir = (bf16*)((unsigned char*)F.out + (dir == 0 ? DO_OF : DO_OB));
    f32x4 S[8];
#pragma unroll
    for (int i = 0; i < 8; ++i) S[i] = (f32x4){0.f, 0.f, 0.f, 0.f};
    bf16x8 Sb[4];
#pragma unroll
    for (int i = 0; i < 4; ++i) Sb[i] = (bf16x8){0, 0, 0, 0, 0, 0, 0, 0};
    for (int step = 0; step < 128; ++step) {
        const int n = dir == 0 ? step : 127 - step;
        const unsigned char* rsh = F.ws + WS_GSH + (size_t)(bh * 128 + n) * GDN_SH_BYTES;
        const unsigned char* rd = F.ws + WS_GD + (size_t)((bh * 2 + dir) * 128 + n) * GDN_D_BYTES;
        const float* vec = (const float*)(rd + GD_VEC);
        f32x4 eG[4], ks[4];
#pragma unroll
        for (int m = 0; m < 4; ++m) { eG[m] = *(const f32x4*)(vec + 16 * m + 4 * g); ks[m] = *(const f32x4*)(vec + 64 + 16 * m + 4 * g); }
        const float dch = vec[128];
        f32x4 KS[4];
#pragma unroll
        for (int m = 0; m < 4; ++m) { KS[m] = (f32x4){0.f, 0.f, 0.f, 0.f}; const unsigned char* ap = rsh + G_KNP + (16 * m + n16) * 272 + g * 16;
#pragma unroll
            for (int i = 0; i < 4; ++i) KS[m] = __builtin_amdgcn_mfma_f32_16x16x32_bf16(*(const bf16x8*)(ap + i * 64), Sb[i], KS[m], 0, 0, 0); }
        f32x4 rr[4];
#pragma unroll
        for (int m = 0; m < 4; ++m) { const v2u vv = *(const v2u*)(rsh + G_VCT + (16 * e + n16) * 144 + (16 * m + 4 * g) * 2);
            rr[m][0] = bflo(vv.x) - eG[m][0] * KS[m][0]; rr[m][1] = bfhi(vv.x) - eG[m][1] * KS[m][1]; rr[m][2] = bflo(vv.y) - eG[m][2] * KS[m][2]; rr[m][3] = bfhi(vv.y) - eG[m][3] * KS[m][3]; }
        bf16x8 rb[2]; rb[0] = pack8(rr[0], rr[1]); rb[1] = pack8(rr[2], rr[3]);
        f32x4 vn[4];
#pragma unroll
        for (int m = 0; m < 4; ++m) { vn[m] = (f32x4){0.f, 0.f, 0.f, 0.f}; const unsigned char* ap = rd + GD_TBP + (16 * m + n16) * 144 + g * 16;
#pragma unroll
            for (int i = 0; i < 2; ++i) vn[m] = __builtin_amdgcn_mfma_f32_16x16x32_bf16(*(const bf16x8*)(ap + i * 64), rb[i], vn[m], 0, 0, 0); }
        bf16x8 vnb[2]; vnb[0] = pack8(vn[0], vn[1]); vnb[1] = pack8(vn[2], vn[3]);
        f32x4 o[4];
#pragma unroll
        for (int m = 0; m < 4; ++m) { o[m] = (f32x4){0.f, 0.f, 0.f, 0.f}; const unsigned char* ap = rsh + G_QNP + (16 * m + n16) * 272 + g * 16;
#pragma unroll
            for (int i = 0; i < 4; ++i) o[m] = __builtin_amdgcn_mfma_f32_16x16x32_bf16(*(const bf16x8*)(ap + i * 64), Sb[i], o[m], 0, 0, 0);
            o[m] = o[m] * eG[m];
            const unsigned char* aq = rd + GD_AP + (16 * m + n16) * 144 + g * 16;
#pragma unroll
            for (int i = 0; i < 2; ++i) o[m] = __builtin_amdgcn_mfma_f32_16x16x32_bf16(*(const bf16x8*)(aq + i * 64), vnb[i], o[m], 0, 0, 0); }
        bf16x8 vs[2]; vs[0] = pack8(vn[0] * ks[0], vn[1] * ks[1]); vs[1] = pack8(vn[2] * ks[2], vn[3] * ks[3]);
#pragma unroll
        for (int jt = 0; jt < 8; ++jt) { S[jt] = S[jt] * dch; const unsigned char* ap = rsh + G_KNTP + (16 * jt + n16) * 144 + g * 16;
#pragma unroll
            for (int i = 0; i < 2; ++i) S[jt] = __builtin_amdgcn_mfma_f32_16x16x32_bf16(*(const bf16x8*)(ap + i * 64), vs[i], S[jt], 0, 0, 0); }
#pragma unroll
        for (int i = 0; i < 4; ++i) Sb[i] = pack8(S[2 * i], S[2 * i + 1]);
        bf16* op = Odir + (size_t)(b * SEQ + n * 64) * 512 + h * 128 + 16 * e + n16;
#pragma unroll
        for (int m = 0; m < 4; ++m)
#pragma unroll
            for (int r = 0; r < 4; ++r) op[(size_t)(16 * m + 4 * g + r) * 512] = (bf16)f2bf(o[m][r]);
    }
}

DI void p5_combine(Frame& F) {
    const int gw = F.vcu * NWAVES + F.wave, NGW = F.G * NWAVES, lane = F.lane;
    const bf16* OFp = (const bf16*)((unsigned char*)F.out + DO_OF); const bf16* OBp = (const bf16*)((unsigned char*)F.out + DO_OB);
    const bf16* ZA = (const bf16*)(F.ws + WS_ZA); bf16* OCAT = (bf16*)(F.ws + WS_OCAT);
    const float* nw = F.in[6] + (lane & 15) * 8;
    float w8[8];
#pragma unroll
    for (int c = 0; c < 8; ++c) w8[c] = nw[c];
    for (int t = gw; t < TT; t += NGW) {
        const v4u a = *(const v4u*)(OFp + (size_t)t * 512 + lane * 8), bb = *(const v4u*)(OBp + (size_t)t * 512 + lane * 8), z = *(const v4u*)(ZA + (size_t)t * 512 + lane * 8);
        float o[8] = {bflo(a.x) + bflo(bb.x), bfhi(a.x) + bfhi(bb.x), bflo(a.y) + bflo(bb.y), bfhi(a.y) + bfhi(bb.y), bflo(a.z) + bflo(bb.z), bfhi(a.z) + bfhi(bb.z), bflo(a.w) + bflo(bb.w), bfhi(a.w) + bfhi(bb.w)};
        const float zz[8] = {bflo(z.x), bfhi(z.x), bflo(z.y), bfhi(z.y), bflo(z.z), bfhi(z.z), bflo(z.w), bfhi(z.w)};
        float ss = 0.f;
#pragma unroll
        for (int c = 0; c < 8; ++c) ss += o[c] * o[c];
        ss += __shfl_xor(ss, 1); ss += __shfl_xor(ss, 2); ss += __shfl_xor(ss, 4); ss += __shfl_xor(ss, 8);
        const float rn = 1.0f / sqrtf(ss * (1.f / 128.f) + EPS);
#pragma unroll
        for (int c = 0; c < 8; ++c) o[c] = o[c] * rn * w8[c] * siluf(zz[c]);
        v4u r; r.x = pk2(o[0], o[1]); r.y = pk2(o[2], o[3]); r.z = pk2(o[4], o[5]); r.w = pk2(o[6], o[7]);
        *(v4u*)(OCAT + (size_t)t * 1024 + lane * 8) = r;
    }
}
DI void p5_moe_weights(Frame& F) {
    LAS float* scr = (LAS float*)(F.lds + F.wave * 16384);
    const int gw = F.vcu * NWAVES + F.wave, NGW = F.G * NWAVES;
    bf16* WGU = (bf16*)(F.ws + WS_WGU); bf16* WD = (bf16*)(F.ws + WS_WD);
    constexpr int IG = 16 * 16, ID = 8 * 32, IPE = 2 * IG + ID;
    for (int it = gw; it < NEXP * IPE; it += NGW) {
        const int e = it / IPE; int r = it % IPE;
        if (r < IG) { p0_transpose_item(F.in[13] + (size_t)e * 1024 * 512, 512, 16, WGU + (size_t)e * 1024 * 1024, 1024, 0, 2, scr, r, F.lane); continue; } r -= IG;
        if (r < IG) { p0_transpose_item(F.in[14] + (size_t)e * 1024 * 512, 512, 16, WGU + (size_t)e * 1024 * 1024, 1024, 1, 2, scr, r, F.lane); continue; } r -= IG;
        p0_transpose_item(F.in[15] + (size_t)e * 512 * 1024, 1024, 32, WD + (size_t)e * 1024 * 512, 512, 0, 1, scr, r, F.lane);
    }
}

struct TokRec { int e[2]; int row[2]; float gate[2]; };
DI void p7_route(Frame& F) {
    const int gw = F.vcu * NWAVES + F.wave, NGW = F.G * NWAVES, lane = F.lane, n16 = lane & 15, g = lane >> 4;
    const float* X1 = F.out; const float* nfw = F.in[10];
    const bf16* WRH = (const bf16*)(F.ws + WS_WR); const bf16* WRL = WRH + 48 * 1024;
    bf16* HN = (bf16*)(F.ws + WS_HN); TokRec* TOK = (TokRec*)(F.ws + WS_TOK); unsigned* cnt = (unsigned*)(F.ws + WS_CTL) + CW_CNT;
    LAS float* lg = (LAS float*)(F.lds + F.wave * 4096);
    for (int rt = gw; rt < TT / 16; rt += NGW) {
        const int row = rt * 16 + n16; const float* xr = X1 + (size_t)row * DMODEL + 8 * g;
        float ss = 0.f;
        for (int i = 0; i < 32; ++i) { const f32x4 a = *(const f32x4*)(xr + 32 * i), b2 = *(const f32x4*)(xr + 32 * i + 4);
            ss += (a.x * a.x + a.y * a.y) + (a.z * a.z + a.w * a.w) + (b2.x * b2.x + b2.y * b2.y) + (b2.z * b2.z + b2.w * b2.w); }
        ss += __shfl_xor(ss, 16); ss += __shfl_xor(ss, 32);
        const float rs = 1.0f / sqrtf(ss * (1.f / DMODEL) + EPS);
        f32x4 acc[3];
#pragma unroll
        for (int q = 0; q < 3; ++q) acc[q] = (f32x4){0.f, 0.f, 0.f, 0.f};
        for (int i = 0; i < 32; ++i) {
            const f32x4 a = *(const f32x4*)(xr + 32 * i), b2 = *(const f32x4*)(xr + 32 * i + 4);
            const f32x4 wa = *(const f32x4*)(nfw + 32 * i + 8 * g), wb = *(const f32x4*)(nfw + 32 * i + 8 * g + 4);
            float hv[8] = {a.x * rs * wa.x, a.y * rs * wa.y, a.z * rs * wa.z, a.w * rs * wa.w, b2.x * rs * wb.x, b2.y * rs * wb.y, b2.z * rs * wb.z, b2.w * rs * wb.w};
            v4u hi, lo; unsigned hh[8], ll[8];
#pragma unroll
            for (int c = 0; c < 8; ++c) { hh[c] = f2bf(hv[c]); ll[c] = f2bf(hv[c] - __builtin_bit_cast(float, hh[c] << 16)); }
            hi.x = hh[0] | (hh[1] << 16); hi.y = hh[2] | (hh[3] << 16); hi.z = hh[4] | (hh[5] << 16); hi.w = hh[6] | (hh[7] << 16);
            lo.x = ll[0] | (ll[1] << 16); lo.y = ll[2] | (ll[3] << 16); lo.z = ll[4] | (ll[5] << 16); lo.w = ll[6] | (ll[7] << 16);
            *(v4u*)(HN + (size_t)row * DMODEL + 32 * i + 8 * g) = hi;
            const bf16x8 ah = __builtin_bit_cast(bf16x8, hi), al = __builtin_bit_cast(bf16x8, lo);
#pragma unroll
            for (int q = 0; q < 3; ++q) {
                const bf16x8 bh = *(const bf16x8*)(WRH + (size_t)(16 * q + n16) * 1024 + 32 * i + 8 * g), bl = *(const bf16x8*)(WRL + (size_t)(16 * q + n16) * 1024 + 32 * i + 8 * g);
                acc[q] = __builtin_amdgcn_mfma_f32_16x16x32_bf16(ah, bh, acc[q], 0, 0, 0);
                acc[q] = __builtin_amdgcn_mfma_f32_16x16x32_bf16(ah, bl, acc[q], 0, 0, 0);
                acc[q] = __builtin_amdgcn_mfma_f32_16x16x32_bf16(al, bh, acc[q], 0, 0, 0);
            }
        }
#pragma unroll
        for (int q = 0; q < 3; ++q)
#pragma unroll
            for (int r = 0; r < 4; ++r) lg[(4 * g + r) * 48 + 16 * q + n16] = acc[q][r];
        asm volatile("s_waitcnt lgkmcnt(0)" ::: "memory");
        if (lane < 16) {
            const LAS float* L = lg + lane * 48; const int tok = rt * 16 + lane;
            float gm = L[0]; int gs = 0;
#pragma unroll
            for (int q = 1; q < 4; ++q) if (L[q] > gm) { gm = L[q]; gs = q; }
            float gsum = 0.f;
#pragma unroll
            for (int q = 0; q < 4; ++q) gsum += __expf(L[q] - gm);
            const float gp_top = 1.0f / gsum;
            float fv[8];
#pragma unroll
            for (int q = 0; q < 8; ++q) { float v = L[4 + q]; v = (gs == 1) ? L[12 + q] : v; v = (gs == 2) ? L[20 + q] : v; v = (gs == 3) ? L[28 + q] : v; fv[q] = v; }
            float m1 = fv[0]; int i1 = 0;
#pragma unroll
            for (int q = 1; q < 8; ++q) if (fv[q] > m1) { m1 = fv[q]; i1 = q; }
            float m2 = -3.0e38f; int i2 = 0;
#pragma unroll
            for (int q = 0; q < 8; ++q) if (q != i1 && fv[q] > m2) { m2 = fv[q]; i2 = q; }
            const float e2 = __expf(m2 - m1); const float g1 = gp_top / (1.0f + e2), g2 = gp_top * e2 / (1.0f + e2);
            const int ex1 = gs * 8 + i1, ex2 = gs * 8 + i2;
            const int s1 = (int)atomicAdd(cnt + ex1, 1u), s2 = (int)atomicAdd(cnt + ex2, 1u);
            TokRec tr; tr.e[0] = ex1; tr.e[1] = ex2; tr.row[0] = s1; tr.row[1] = s2; tr.gate[0] = g1; tr.gate[1] = g2;
            TOK[tok] = tr;
        }
        asm volatile("s_waitcnt lgkmcnt(0)" ::: "memory");
    }
}

DI void p8_gather(Frame& F) {
    const int gw = F.vcu * NWAVES + F.wave, NGW = F.G * NWAVES, lane = F.lane;
    unsigned* ctl = (unsigned*)(F.ws + WS_CTL);
    LAS int* pst = (LAS int*)(F.lds);
    if (F.tid == 0) {
        int acc = 0, nt = 0;
        for (int e = 0; e < NEXP; ++e) { const int c = (int)__hip_atomic_load(ctl + CW_CNT + e, __ATOMIC_RELAXED, __HIP_MEMORY_SCOPE_AGENT); pst[e] = acc; const int ntile = (c + 255) >> 8;
            if (blockIdx.x == 0) for (int q = 0; q < ntile; ++q) { ctl[CW_TILES + 2 * (nt + q)] = (unsigned)((acc >> 8) + q); ctl[CW_TILES + 2 * (nt + q) + 1] = (unsigned)e; }
            nt += ntile; acc += ntile * 256; }
        if (blockIdx.x == 0) ctl[CW_NTILE] = (unsigned)nt;
    }
    __syncthreads();
    const bf16* HN = (const bf16*)(F.ws + WS_HN); bf16* XB = (bf16*)(F.ws + WS_XBUF); TokRec* TOK = (TokRec*)(F.ws + WS_TOK);
    for (int t = gw; t < TT; t += NGW) {
        TokRec tr = TOK[t];
        const int r0 = pst[tr.e[0]] + tr.row[0], r1 = pst[tr.e[1]] + tr.row[1];
        const v4u a = *(const v4u*)(HN + (size_t)t * DMODEL + lane * 8), b2 = *(const v4u*)(HN + (size_t)t * DMODEL + 512 + lane * 8);
        *(v4u*)(XB + (size_t)r0 * DMODEL + lane * 8) = a; *(v4u*)(XB + (size_t)r0 * DMODEL + 512 + lane * 8) = b2;
        *(v4u*)(XB + (size_t)r1 * DMODEL + lane * 8) = a; *(v4u*)(XB + (size_t)r1 * DMODEL + 512 + lane * 8) = b2;
        if (lane == 0) { TOK[t].row[0] = r0; TOK[t].row[1] = r1; }
    }
}

DI void p11_final(Frame& F) {
    const int gw = F.vcu * NWAVES + F.wave, NGW = F.G * NWAVES, lane = F.lane;
    const bf16* Y = (const bf16*)(F.ws + WS_XBUF); const TokRec* TOK = (const TokRec*)(F.ws + WS_TOK); const float* fw = F.in[16];
    for (int t = gw; t < TT; t += NGW) {
        const TokRec tr = TOK[t];
        float* xr = F.out + (size_t)t * DMODEL + lane * 8;
        const f32x4 a = *(const f32x4*)(xr), b2 = *(const f32x4*)(xr + 4), c = *(const f32x4*)(xr + 512), d = *(const f32x4*)(xr + 516);
        float v[16] = {a.x, a.y, a.z, a.w, b2.x, b2.y, b2.z, b2.w, c.x, c.y, c.z, c.w, d.x, d.y, d.z, d.w};
#pragma unroll
        for (int k = 0; k < 2; ++k) {
            const float gk = tr.gate[k]; const bf16* yr = Y + (size_t)tr.row[k] * DMODEL + lane * 8;
            const v4u y0 = *(const v4u*)(yr), y1 = *(const v4u*)(yr + 512);
            v[0] += gk * bflo(y0.x); v[1] += gk * bfhi(y0.x); v[2] += gk * bflo(y0.y); v[3] += gk * bfhi(y0.y); v[4] += gk * bflo(y0.z); v[5] += gk * bfhi(y0.z); v[6] += gk * bflo(y0.w); v[7] += gk * bfhi(y0.w);
            v[8] += gk * bflo(y1.x); v[9] += gk * bfhi(y1.x); v[10] += gk * bflo(y1.y); v[11] += gk * bfhi(y1.y); v[12] += gk * bflo(y1.z); v[13] += gk * bfhi(y1.z); v[14] += gk * bflo(y1.w); v[15] += gk * bfhi(y1.w);
        }
        float ss = 0.f;
#pragma unroll
        for (int i = 0; i < 16; ++i) ss += v[i] * v[i];
        const float rs = 1.0f / sqrtf(wave_sum(ss) * (1.f / DMODEL) + EPS);
        const f32x4 w0 = *(const f32x4*)(fw + lane * 8), w1 = *(const f32x4*)(fw + lane * 8 + 4), w2 = *(const f32x4*)(fw + 512 + lane * 8), w3 = *(const f32x4*)(fw + 516 + lane * 8);
        *(f32x4*)(xr) = (f32x4){v[0] * rs * w0.x, v[1] * rs * w0.y, v[2] * rs * w0.z, v[3] * rs * w0.w};
        *(f32x4*)(xr + 4) = (f32x4){v[4] * rs * w1.x, v[5] * rs * w1.y, v[6] * rs * w1.z, v[7] * rs * w1.w};
        *(f32x4*)(xr + 512) = (f32x4){v[8] * rs * w2.x, v[9] * rs * w2.y, v[10] * rs * w2.z, v[11] * rs * w2.w};
        *(f32x4*)(xr + 516) = (f32x4){v[12] * rs * w3.x, v[13] * rs * w3.y, v[14] * rs * w3.z, v[15] * rs * w3.w};
    }
}

struct Args { const float* in[17]; float* out; unsigned char* ws; int ph_lo, ph_hi; };
__global__ void __launch_bounds__(NTHREADS, 2) fwd_kernel(Args args) {
    extern __shared__ __attribute__((aligned(16))) unsigned char lds[];
    cg::grid_group grid = cg::this_grid();
    Frame F;
    F.lds = (LAS unsigned char*)lds; F.tid = threadIdx.x; F.lane = F.tid & 63; F.wave = __builtin_amdgcn_readfirstlane(F.tid >> 6);
    F.G = gridDim.x; { const int bx = blockIdx.x; F.vcu = (F.G % 8 == 0) ? (bx % 8) * (F.G / 8) + bx / 8 : bx; }
#pragma unroll
    for (int i = 0; i < 17; ++i) F.in[i] = args.in[i];
    F.out = args.out; F.ws = args.ws;
    const int lo = args.ph_lo, hi = args.ph_hi;
#ifndef PHSEL
#define PHSEL 0xfff
#endif
#define IN(k) (((PHSEL >> (k)) & 1) && lo <= (k) && (k) < hi)
#define SEAM(k) do { if (IN(k) && IN((k) + 1)) grid.sync(); } while (0)
    if (IN(0)) { p0_prologue(F); } SEAM(0);
    if (IN(1)) {
        pg8::Gemm gm{(const pg8::bf16_t*)(F.ws + WS_XN), (const pg8::bf16_t*)(F.ws + WS_WIN), TT, NPROJ, DMODEL}; pg8::StaticOrder S; S.init(TT, NPROJ, F.G, (int)blockIdx.x);
        EpiProj E{(bf16*)(F.ws + WS_QKVA), (bf16*)(F.ws + WS_ZA), (bf16*)(F.ws + WS_QKVB), (float*)(F.ws + WS_GATES)};
        pg8::gemm_phase<EpiProj, pg8::StaticOrder, true, true>(F.lds, gm, S, E);
    } SEAM(1);
    if (IN(2)) {
#ifndef NO_ROPE
        p2_rope(F);
#endif
#ifndef NO_PRE
        p2_gdn_pre(F);
#endif
    } SEAM(2);
    if (IN(3)) {
        const attn_body::AttnTensors AT{(const attn_body::bf16*)((unsigned char*)F.out + DO_QR), (const attn_body::bf16*)((unsigned char*)F.out + DO_KR), (const attn_body::bf16*)((unsigned char*)F.out + DO_VR),
                                        (attn_body::bf16*)(F.ws + WS_OCAT) + 512};
        const attn_body::StaticOrder S((int)F.G, (int)blockIdx.x);
        attn_body::attn_phase<attn_body::StaticOrder>((char*)lds, AT, S);
    } SEAM(3);
    if (IN(4)) { p4_scan(F); } SEAM(4);
    if (IN(5)) { p5_combine(F); p5_moe_weights(F); } SEAM(5);
    if (IN(6)) {
        pg8::Gemm gm{(const pg8::bf16_t*)(F.ws + WS_OCAT), (const pg8::bf16_t*)(F.ws + WS_WOUT), TT, DMODEL, DMODEL}; pg8::StaticOrder S; S.init(TT, DMODEL, F.G, (int)blockIdx.x);
        EpiResid E{F.in[0], F.out};
        pg8::gemm_phase<EpiResid, pg8::StaticOrder, true, true>(F.lds, gm, S, E);
    } SEAM(6);
    if (IN(7)) { p7_route(F); } SEAM(7);
    if (IN(8)) { p8_gather(F); } SEAM(8);
    if (IN(9)) {
        pg8::Gemm gm{(const pg8::bf16_t*)(F.ws + WS_XBUF), (const pg8::bf16_t*)(F.ws + WS_WGU), 0, 0, DMODEL}; MoeOrder S{(const unsigned*)(F.ws + WS_CTL), F.G, (int)blockIdx.x};
        EpiGU E{(bf16*)(F.ws + WS_HID)};
        pg8::gemm_phase<EpiGU, MoeOrder, true, true>(F.lds, gm, S, E);
    } SEAM(9);
    if (IN(10)) {
        pg8::Gemm gm{(const pg8::bf16_t*)(F.ws + WS_HID), (const pg8::bf16_t*)(F.ws + WS_WD), 0, 0, FFE}; MoeOrder S{(const unsigned*)(F.ws + WS_CTL), F.G, (int)blockIdx.x};
        EpiY E{(bf16*)(F.ws + WS_XBUF)};
        pg8::gemm_phase<EpiY, MoeOrder, true, true>(F.lds, gm, S, E);
    } SEAM(10);
    if (IN(11)) { p11_final(F); }
#undef IN
#undef SEAM
}

extern "C" void kernel_launch(void* const* d_in, const int* in_sizes, int n_in, void* d_out, int out_size, void* d_ws, size_t ws_size, hipStream_t stream) {
    static int grid = 0;
    if (grid == 0) {
        if (n_in != 17 || out_size != TT * DMODEL || ws_size < WS_END) { fprintf(stderr, "kernel_launch: unexpected problem (n_in %d out %d ws %zu)\n", n_in, out_size, ws_size); grid = -1; return; }
        int dev = 0, cus = 0, per_cu = 0;
        if (hipGetDevice(&dev) != hipSuccess || hipDeviceGetAttribute(&cus, hipDeviceAttributeMultiprocessorCount, dev) != hipSuccess) { grid = -1; return; }
        if (hipFuncSetAttribute((const void*)fwd_kernel, hipFuncAttributeMaxDynamicSharedMemorySize, LDS_BYTES) != hipSuccess) { fprintf(stderr, "hipFuncSetAttribute failed\n"); grid = -1; return; }
        if (hipOccupancyMaxActiveBlocksPerMultiprocessor(&per_cu, (const void*)fwd_kernel, NTHREADS, LDS_BYTES) != hipSuccess || per_cu < 1) { fprintf(stderr, "occupancy query: %d\n", per_cu); grid = -1; return; }
        grid = cus;
    }
    if (grid < 0) return;
    (void)hipMemsetAsync((char*)d_ws + WS_CTL, 0, CTL_ZERO_BYTES, stream);
    Args a{};
    for (int i = 0; i < 17; ++i) a.in[i] = (const float*)d_in[i];
    a.out = (float*)d_out; a.ws = (unsigned char*)d_ws;
#if MK_PER_PHASE
    for (int p = 0; p < N_PHASES; ++p) { a.ph_lo = p; a.ph_hi = p + 1; hipLaunchKernelGGL(fwd_kernel, dim3(grid), dim3(NTHREADS), LDS_BYTES, stream, a); }
#else
    a.ph_lo = 0; a.ph_hi = N_PHASES;
    void* kargs[] = {&a};
    hipError_t e = hipLaunchCooperativeKernel((void*)fwd_kernel, dim3(grid), dim3(NTHREADS), kargs, LDS_BYTES, stream);
    if (e != hipSuccess) fprintf(stderr, "cooperative launch failed: %s (grid %d)\n", hipGetErrorString(e), grid);
#endif
}
```

```cpp
#include <hip/hip_runtime.h>
#include <cstdio>
#include <cstdint>
namespace pg8 {
#define PG8_LAS __attribute__((address_space(3)))
typedef unsigned short bf16_t;
typedef short bf16x8 __attribute__((ext_vector_type(8)));
typedef float f32x4 __attribute__((ext_vector_type(4)));
typedef unsigned u32x4 __attribute__((ext_vector_type(4)));
constexpr int BM = 256, BK = 64, HALF = 128, HTB = HALF * BK * 2  , STAGE_BYTES = 8 * HTB, NXCD = 8, WGM = 8;

__host__ __device__ __forceinline__ int lds_byte(int r, int c) { const int st = (r >> 4) * 2 + (c >> 5), rr = r & 15, cc = c & 31, ob = rr * 64 + cc * 2; return st * 1024 + (ob ^ (((ob >> 9) & 1) << 5)); }
__host__ __device__ __forceinline__ void stage_rc(int b, int& R, int& C) { const int st = b / 1024, sb = b % 1024, swz = sb ^ (((sb >> 9) & 1) << 5); R = (st >> 1) * 16 + swz / 64; C = (st & 1) * 32 + (swz % 64) / 2; }
__host__ __device__ __forceinline__ int perm32(int rho) { const int n = rho >> 4, i = rho & 15; return 8 * (i >> 2) + 4 * n + (i & 3); }

struct Unit { int pm, pn; };
struct Gemm { const bf16_t* A; const bf16_t* Bt; int M, N, K; };

struct StaticOrder {
    int nM, nN, nwg, G, c;
    __host__ __device__ void init(int M, int N, int G_, int c_) { nM = M / BM; nN = N / BM; nwg = nM * nN; G = G_; c = c_; }
    __host__ __device__ bool next(int i, Unit& u) const {
        const long L = (long)i * G + c; if (L >= nwg) return false;
        int wgid = (int)L; { const int q = nwg / NXCD, r = nwg % NXCD, xcd = wgid % NXCD, off = wgid / NXCD; wgid = (xcd < r ? xcd * (q + 1) : r * (q + 1) + (xcd - r) * q) + off; }
        const int nig = WGM * nN, gid = wgid / nig, fm = gid * WGM, gsz = (nM - fm) < WGM ? (nM - fm) : WGM;
        u.pm = fm + ((wgid % nig) % gsz); u.pn = (wgid % nig) / gsz; return true;
    }
    __device__ __forceinline__ void a_ready(const Unit&) const {}
    __device__ __forceinline__ void done(const Unit&) const {}
};

__device__ __forceinline__ unsigned cvt_pk_bf16(float lo, float hi) { unsigned r; asm volatile("v_cvt_pk_bf16_f32 %0, %1, %2" : "=v"(r) : "v"(lo), "v"(hi)); return r; }
typedef float f32x2 __attribute__((ext_vector_type(2)));
template <class Epi, class Sched, bool ALIGN_EPI = false, bool SP2 = false>
__device__ __forceinline__ void gemm_phase(PG8_LAS unsigned char* lds, const Gemm g, const Sched& S, const Epi& E) {
    const int tid = threadIdx.x, wid = __builtin_amdgcn_readfirstlane(tid >> 6), lane = tid & 63, wr = wid >> 2, wc = wid & 3, fr = lane & 15, fq = lane >> 4;
    const int K = g.K, nt = K / BK;
    unsigned voffA[2], voffB[2];
#pragma unroll
    for (int i = 0; i < 2; ++i) { int R, C; stage_rc(tid * 16 + i * 8192, R, C); const int Rb = Epi::PERM ? ((R & ~31) + perm32(R & 31)) : R;
        voffA[i] = (unsigned)(R * K + C) * 2u; voffB[i] = (unsigned)(Rb * K + C) * 2u; }
    const size_t kstep = (size_t)(BK * 2);
    const size_t hstep = (size_t)HALF * K * 2;
    const size_t tstep = 2 * hstep;
    const unsigned ldsw = (unsigned)wid * 1024u;
    const int aoff = lds_byte(wr * 64 + fr, fq * 8), boff = lds_byte(wc * 32 + fr, fq * 8);
#define PG8_SA(b, h) (((b) * 2 + (h)) * HTB)
#define PG8_SB(b, h) ((4 + (b) * 2 + (h)) * HTB)
#define PG8_STAGE(bufoff, gbase, voff) do { _Pragma("unroll") for (int _i = 0; _i < 2; ++_i) \
        __builtin_amdgcn_global_load_lds((const unsigned*)((const char*)(gbase) + (voff)[_i]), (PG8_LAS unsigned*)(lds + (bufoff) + ldsw + _i * 8192), 16, 0, 0); } while (0)
#define PG8_LDA(dst, b, h) do { _Pragma("unroll") for (int m = 0; m < 4; ++m) _Pragma("unroll") for (int k = 0; k < 2; ++k) dst[m][k] = *(const PG8_LAS bf16x8*)(lds + PG8_SA(b, h) + aoff + m * 2048 + k * 1024); } while (0)
#define PG8_LDB(dst, b, h) do { _Pragma("unroll") for (int n = 0; n < 2; ++n) _Pragma("unroll") for (int k = 0; k < 2; ++k) dst[n][k] = *(const PG8_LAS bf16x8*)(lds + PG8_SB(b, h) + boff + n * 2048 + k * 1024); } while (0)
#define PG8_MMA(ai, bj, At, Bt) do { __builtin_amdgcn_s_setprio(1); _Pragma("unroll") for (int m = 0; m < 4; ++m) _Pragma("unroll") for (int n = 0; n < 2; ++n) _Pragma("unroll") for (int k = 0; k < 2; ++k) \
        acc[ai][bj][m][n] = __builtin_amdgcn_mfma_f32_16x16x32_bf16(Bt[n][k], At[m][k], acc[ai][bj][m][n], 0, 0, 0); __builtin_amdgcn_s_setprio(0); } while (0)
#define PG8_WAIT_V(n) asm volatile("s_waitcnt vmcnt(" #n ")" ::: "memory")
#define PG8_WAIT_L(n) asm volatile("s_waitcnt lgkmcnt(" #n ")" ::: "memory")
#define PG8_BAR __builtin_amdgcn_s_barrier()
#define PG8_SCHED __builtin_amdgcn_sched_barrier(0)
    Unit cur, nxt; int ui = 0;
    if (!S.next(0, cur)) return;
    f32x4 acc[2][2][4][2];
#pragma unroll
    for (int a = 0; a < 2; ++a)
#pragma unroll
        for (int b = 0; b < 2; ++b)
#pragma unroll
            for (int m = 0; m < 4; ++m)
#pragma unroll
                for (int n = 0; n < 2; ++n) acc[a][b][m][n] = (f32x4){0.f, 0.f, 0.f, 0.f};
    bf16x8 At[4][2], B0[2][2], B1[2][2];
    const char* cA = (const char*)g.A + (size_t)cur.pm * tstep; const char* cB = (const char*)g.Bt + (size_t)cur.pn * tstep;
    S.a_ready(cur);
    if constexpr (SP2) {
        PG8_STAGE(PG8_SB(0, 0), cB, voffB); PG8_STAGE(PG8_SB(0, 1), cB + hstep, voffB); PG8_STAGE(PG8_SA(0, 0), cA, voffA); PG8_STAGE(PG8_SA(0, 1), cA + hstep, voffA);
        if (wr == 1) PG8_BAR;
        PG8_WAIT_V(2); PG8_BAR;
        PG8_STAGE(PG8_SB(1, 0), cB + kstep, voffB); PG8_STAGE(PG8_SA(1, 0), cA + kstep, voffA); PG8_STAGE(PG8_SB(1, 1), cB + hstep + kstep, voffB);
        PG8_WAIT_V(6); PG8_BAR;
    } else {
        PG8_STAGE(PG8_SB(0, 0), cB, voffB); PG8_STAGE(PG8_SA(0, 0), cA, voffA); PG8_STAGE(PG8_SB(0, 1), cB + hstep, voffB); PG8_STAGE(PG8_SA(0, 1), cA + hstep, voffA);
        if (wr == 1) PG8_BAR;
        PG8_WAIT_V(4); PG8_BAR;
        PG8_STAGE(PG8_SB(1, 0), cB + kstep, voffB); PG8_STAGE(PG8_SA(1, 0), cA + kstep, voffA); PG8_STAGE(PG8_SB(1, 1), cB + hstep + kstep, voffB);
        PG8_WAIT_V(6); PG8_BAR;
    }
    for (;;) {
        const bool has_next = S.next(ui + 1, nxt);
        const char* nA = has_next ? (const char*)g.A + (size_t)nxt.pm * tstep : cA; const char* nB = has_next ? (const char*)g.Bt + (size_t)nxt.pn * tstep : cB;
        for (int t = 0; t < nt; t += 2) {
            const bool last = (t == nt - 2);
            const char* a1 = cA + (size_t)(t + 1) * kstep;
            const char* a2 = last ? nA : cA + (size_t)(t + 2) * kstep; const char* b2 = last ? nB : cB + (size_t)(t + 2) * kstep;
            const char* a3 = a2 + kstep; const char* b3 = b2 + kstep;
            if (last && has_next) S.a_ready(nxt);
            if constexpr (SP2) {
            PG8_LDB(B0, 0, 0); PG8_LDB(B1, 0, 1); PG8_SCHED; PG8_LDA(At, 0, 0); PG8_STAGE(PG8_SA(1, 1), a1 + hstep, voffA);
            PG8_WAIT_V(8); PG8_WAIT_L(0); PG8_BAR; PG8_MMA(0, 0, At, B0); PG8_MMA(0, 1, At, B1); PG8_BAR; PG8_SCHED;
            PG8_LDA(At, 0, 1); PG8_STAGE(PG8_SB(0, 0), b2, voffB); PG8_STAGE(PG8_SB(0, 1), b2 + hstep, voffB); PG8_STAGE(PG8_SA(0, 0), a2, voffA);
            PG8_WAIT_V(8); PG8_WAIT_L(0); PG8_BAR; PG8_MMA(1, 0, At, B0); PG8_MMA(1, 1, At, B1); PG8_BAR; PG8_SCHED;
            PG8_LDB(B0, 1, 0); PG8_LDB(B1, 1, 1); PG8_SCHED; PG8_LDA(At, 1, 0); PG8_STAGE(PG8_SA(0, 1), a2 + hstep, voffA);
            PG8_WAIT_V(8); PG8_WAIT_L(0); PG8_BAR; PG8_MMA(0, 0, At, B0); PG8_MMA(0, 1, At, B1); PG8_BAR; PG8_SCHED;
            PG8_LDA(At, 1, 1); PG8_STAGE(PG8_SB(1, 0), b3, voffB); PG8_STAGE(PG8_SB(1, 1), b3 + hstep, voffB); PG8_STAGE(PG8_SA(1, 0), a3, voffA);
            PG8_WAIT_V(8); PG8_WAIT_L(0); PG8_BAR; PG8_MMA(1, 0, At, B0); PG8_MMA(1, 1, At, B1); PG8_BAR; PG8_SCHED;
            } else {
            PG8_LDB(B0, 0, 0); PG8_SCHED; PG8_LDA(At, 0, 0); PG8_STAGE(PG8_SA(1, 1), a1 + hstep, voffA);
            PG8_WAIT_L(8); PG8_BAR; PG8_WAIT_L(0); PG8_MMA(0, 0, At, B0); PG8_BAR; PG8_SCHED;
            PG8_LDB(B1, 0, 1); PG8_STAGE(PG8_SB(0, 0), b2, voffB);
            PG8_BAR; PG8_WAIT_L(0); PG8_MMA(0, 1, At, B1); PG8_BAR;
            PG8_LDA(At, 0, 1); PG8_STAGE(PG8_SA(0, 0), a2, voffA);
            PG8_BAR; PG8_WAIT_L(0); PG8_MMA(1, 0, At, B0); PG8_BAR; PG8_SCHED;
            PG8_STAGE(PG8_SB(0, 1), b2 + hstep, voffB);
            PG8_WAIT_V(6); PG8_BAR; PG8_MMA(1, 1, At, B1); PG8_BAR;
            PG8_LDB(B0, 1, 0); PG8_SCHED; PG8_LDA(At, 1, 0); PG8_STAGE(PG8_SA(0, 1), a2 + hstep, voffA);
            PG8_WAIT_L(8); PG8_BAR; PG8_WAIT_L(0); PG8_MMA(0, 0, At, B0); PG8_BAR; PG8_SCHED;
            PG8_LDB(B1, 1, 1); PG8_STAGE(PG8_SB(1, 0), b3, voffB);
            PG8_BAR; PG8_WAIT_L(0); PG8_MMA(0, 1, At, B1); PG8_BAR;
            PG8_LDA(At, 1, 1); PG8_STAGE(PG8_SA(1, 0), a3, voffA);
            PG8_BAR; PG8_WAIT_L(0); PG8_MMA(1, 0, At, B0); PG8_BAR; PG8_SCHED;
            PG8_STAGE(PG8_SB(1, 1), b3 + hstep, voffB);
            PG8_WAIT_V(6); PG8_BAR; PG8_MMA(1, 1, At, B1); PG8_BAR;
            }
        }
        if constexpr (ALIGN_EPI) { if (wr == 0) PG8_BAR; }
        if constexpr (!Epi::AFTER_DRAIN) { E(acc, cur, wr, wc, fr, fq); S.done(cur); }
        if (!has_next) break;
#pragma unroll
        for (int a = 0; a < 2; ++a)
#pragma unroll
            for (int b = 0; b < 2; ++b)
#pragma unroll
                for (int m = 0; m < 4; ++m)
#pragma unroll
                    for (int n = 0; n < 2; ++n) acc[a][b][m][n] = (f32x4){0.f, 0.f, 0.f, 0.f};
        cur = nxt; cA = nA; cB = nB; ++ui;
        if constexpr (ALIGN_EPI) { if (wr == 1) PG8_BAR; }
    }
    PG8_WAIT_V(0);
    if constexpr (!ALIGN_EPI) { if (wr == 0) PG8_BAR; }
    PG8_BAR;
    if constexpr (Epi::AFTER_DRAIN) { E.fused(acc, cur, wr, wc, fr, fq, lds, wid, lane); S.done(cur); }
#undef PG8_SA
#undef PG8_SB
#undef PG8_STAGE
#undef PG8_LDA
#undef PG8_LDB
#undef PG8_MMA
#undef PG8_WAIT_V
#undef PG8_WAIT_L
#undef PG8_BAR
#undef PG8_SCHED
}
}
#include <hip/hip_bf16.h>
#include <cmath>
namespace attn_body {
using bf16=__hip_bfloat16;
using bf16x8=__attribute__((ext_vector_type(8)))short;
using s16x4=__attribute__((ext_vector_type(4)))short;
using f32x16=__attribute__((ext_vector_type(16)))float;
using u32x4=__attribute__((ext_vector_type(4)))unsigned;
constexpr int BATCH=2,NHEAD=8,NKVH=2,SEQ=8192,D=64,QP=512,KP=128,OP=1024;
constexpr int NW=8,QBLK=32,QB=QBLK*NW,KVBLK=64,NQB=SEQ/QB;
constexpr int ATTN_UNIT_ROWS=QB;
__device__ __forceinline__ int crow(int r,int hi){return (r&3)+8*(r>>2)+4*hi;}
#define SBAR() __builtin_amdgcn_sched_barrier(0)
__device__ __forceinline__ void cmask(f32x16&p0,f32x16&p1,int jb,int qrel,int hi){
  const float NEG=-INFINITY; int kb=64*jb+4*hi;
  #pragma unroll
  for(int r=0;r<16;++r){int kv=kb+(r&3)+8*(r>>2); if(kv>qrel)p0[r]=NEG; if(kv+32>qrel)p1[r]=NEG;}
}

constexpr int NSLOT=3, SLOTB=8192;
constexpr int LDS_K=0, LDS_V=NSLOT*SLOTB, LDS_WS=2*NSLOT*SLOTB, LDS_OST=LDS_WS+NW*64*4, LDS_BYTES=LDS_OST+NW*4096;
constexpr float C2=0.125f*1.4426950408889634f;
__device__ __forceinline__ void glds16(const void*gsrc,unsigned lds_dst){unsigned keep;
  asm volatile("s_mov_b32 %0, m0\n\ts_mov_b32 m0, %2\n\ts_nop 0\n\tglobal_load_lds_dwordx4 %1, off\n\ts_mov_b32 m0, %0":"=&s"(keep):"v"(gsrc),"s"(lds_dst):"memory");}
__device__ __forceinline__ float max3f(float a,float b,float c){float r;asm("v_max3_f32 %0, %1, %2, %3":"=v"(r):"v"(a),"v"(b),"v"(c));return r;}
__device__ __forceinline__ float max2f(float a,float b){float r;asm("v_max_f32_e32 %0, %1, %2":"=v"(r):"v"(a),"v"(b));return r;}
__device__ __forceinline__ float fadd_s(float a,float b){float r;asm("v_add_f32_e32 %0, %1, %2":"=v"(r):"v"(a),"v"(b));return r;}
__device__ __forceinline__ float fsub_s(float a,float b){float r;asm("v_sub_f32_e32 %0, %1, %2":"=v"(r):"v"(a),"v"(b));return r;}
typedef float f32x2_t __attribute__((ext_vector_type(2))); typedef __bf16 bf16x2_t __attribute__((ext_vector_type(2)));
__device__ __forceinline__ unsigned cvtpk_s(float lo,float hi){f32x2_t v={lo,hi};bf16x2_t b=__builtin_convertvector(v,bf16x2_t);return __builtin_bit_cast(unsigned,b);}
#define WAIT_BAR(N) asm volatile("s_waitcnt vmcnt(" #N ") lgkmcnt(0)\n\ts_barrier":::"memory")

__device__ __forceinline__ void qkt(f32x16&p0,f32x16&p1,const char*Kslot,const bf16x8*qr,const f32x16&negm,int r32,int hi){
  const char*kb=Kslot+hi*1024+r32*16;
  #pragma unroll
  for(int d0=0;d0<4;++d0){
    const bf16x8 b0=*reinterpret_cast<const bf16x8*>(kb+d0*2048);
    const bf16x8 b1=*reinterpret_cast<const bf16x8*>(kb+d0*2048+512);
    if(d0==0){p0=__builtin_amdgcn_mfma_f32_32x32x16_bf16(b0,qr[0],negm,0,0,0);p1=__builtin_amdgcn_mfma_f32_32x32x16_bf16(b1,qr[0],negm,0,0,0);}
    else{p0=__builtin_amdgcn_mfma_f32_32x32x16_bf16(b0,qr[d0],p0,0,0,0);p1=__builtin_amdgcn_mfma_f32_32x32x16_bf16(b1,qr[d0],p1,0,0,0);}}
}
typedef __attribute__((address_space(3))) const char* lds_cptr;
typedef short v4i16_t __attribute__((ext_vector_type(4)));
__device__ __forceinline__ void kload8(bf16x8*kf,lds_cptr kp){
  kf[0]=*(const __attribute__((address_space(3))) bf16x8*)(kp);      kf[1]=*(const __attribute__((address_space(3))) bf16x8*)(kp+512);
  kf[2]=*(const __attribute__((address_space(3))) bf16x8*)(kp+2048); kf[3]=*(const __attribute__((address_space(3))) bf16x8*)(kp+2560);
  kf[4]=*(const __attribute__((address_space(3))) bf16x8*)(kp+4096); kf[5]=*(const __attribute__((address_space(3))) bf16x8*)(kp+4608);
  kf[6]=*(const __attribute__((address_space(3))) bf16x8*)(kp+6144); kf[7]=*(const __attribute__((address_space(3))) bf16x8*)(kp+6656);
}
__device__ __forceinline__ void kload2(bf16x8*kf,lds_cptr kp,int j){ kf[2*j]=*(const __attribute__((address_space(3))) bf16x8*)(kp+j*2048); kf[2*j+1]=*(const __attribute__((address_space(3))) bf16x8*)(kp+j*2048+512); }
__device__ __forceinline__ s16x4 vtr(lds_cptr p){ return __builtin_bit_cast(s16x4,__builtin_amdgcn_ds_read_tr16_b64_v4i16((__attribute__((address_space(3))) v4i16_t*)p)); }
__device__ __forceinline__ float rowmax(const f32x16&p0,const f32x16&p1){
  float a=max3f(p0[0],p0[1],p1[0]),b=max3f(p0[2],p0[3],p1[1]);a=max3f(a,p1[2],p1[3]);
  #pragma unroll
  for(int r=4;r<16;r+=4){a=max3f(a,p0[r],p0[r+1]);b=max3f(b,p0[r+2],p0[r+3]);a=max3f(a,p1[r],p1[r+1]);b=max3f(b,p1[r+2],p1[r+3]);}
  const float m=max2f(a,b);
  auto rr=__builtin_amdgcn_permlane32_swap(__float_as_uint(m),__float_as_uint(m),false,false);
  return max2f(__uint_as_float(rr[0]),__uint_as_float(rr[1]));
}
__device__ __forceinline__ void pv(f32x16*o,int vb,bf16x8 pa0,bf16x8 pa1,bf16x8 pa2,bf16x8 pa3){
  #pragma unroll
  for(int d0=0;d0<2;++d0){s16x4 lo[4],hi[4];
    #pragma unroll
    for(int ks=0;ks<4;++ks){
      asm volatile("ds_read_b64_tr_b16 %0,%1 offset:%c2":"=&v"(lo[ks]):"v"(vb),"i"(d0*4096+ks*1024):"memory");
      asm volatile("ds_read_b64_tr_b16 %0,%1 offset:%c2":"=&v"(hi[ks]):"v"(vb),"i"(d0*4096+ks*1024+512):"memory");}
    asm volatile("s_waitcnt lgkmcnt(0)":::"memory");SBAR();
    #define PK(k) (bf16x8){lo[k][0],lo[k][1],lo[k][2],lo[k][3],hi[k][0],hi[k][1],hi[k][2],hi[k][3]}
    o[d0]=__builtin_amdgcn_mfma_f32_32x32x16_bf16(pa0,PK(0),o[d0],0,0,0);
    o[d0]=__builtin_amdgcn_mfma_f32_32x32x16_bf16(pa1,PK(1),o[d0],0,0,0);
    o[d0]=__builtin_amdgcn_mfma_f32_32x32x16_bf16(pa2,PK(2),o[d0],0,0,0);
    o[d0]=__builtin_amdgcn_mfma_f32_32x32x16_bf16(pa3,PK(3),o[d0],0,0,0);
    #undef PK
  }
}

#ifndef ATTN_STORE16
#define ATTN_STORE16(p,v) (*(u32x4*)(p)=(v))
#endif
template<int THRL> __device__ __forceinline__ void attn_unit(int b,int h,int qb,const bf16*Q,const bf16*__restrict__ K,const bf16*__restrict__ V,bf16*O,char*shm){
  const int tid=threadIdx.x,lane=tid&63,r32=lane&31,hi=lane>>5; const int wid=__builtin_amdgcn_readfirstlane(tid>>6);
  const long rowbase=(long)b*SEQ; const int q0=qb*QB;
  const bf16*Qw=Q+(rowbase+q0+wid*QBLK)*QP+h*D;
  const int hk=h/(NHEAD/NKVH); const bf16*Kh=K+rowbase*KP+hk*D,*Vh=V+rowbase*KP+hk*D;
  const unsigned lds0=(unsigned)(uintptr_t)shm;
  float*wsf=(float*)(shm+LDS_WS)+wid*64;
  const bf16*ksrc=Kh+(long)lane*KP+wid*8;
  const bf16*vsrc=Vh+(long)(16*(wid&3)+(lane>>2))*KP+(wid>>2)*32+(lane&3)*8;
  const unsigned kdst=lds0+LDS_K+wid*1024, vdst=lds0+LDS_V+wid*1024;
  #define DMA_K(t,slot) glds16(ksrc+(long)(t)*KVBLK*KP,(unsigned)__builtin_amdgcn_readfirstlane(kdst+(slot)))
  #define DMA_V(t,slot) glds16(vsrc+(long)(t)*KVBLK*KP,(unsigned)__builtin_amdgcn_readfirstlane(vdst+(slot)))
  const int vb0=(int)(lds0+LDS_V)+((lane>>4)&1)*32+(lane&3)*8+(4*hi+((lane&15)>>2))*64;
  const char*Kbase=shm+LDS_K; bf16x8 kf[8];
  const lds_cptr shm3=(lds_cptr)shm; const lds_cptr kp0=shm3+LDS_K+hi*1024+r32*16; const lds_cptr vp0=shm3+LDS_V+((lane>>4)&1)*32+(lane&3)*8+(4*hi+((lane&15)>>2))*64;
  constexpr int NT=SEQ/KVBLK;
  DMA_K(0,0);DMA_V(0,0);DMA_K(1,SLOTB);
  bf16x8 qr[4];
  #pragma unroll
  for(int d0=0;d0<4;++d0)qr[d0]=*reinterpret_cast<const bf16x8*>(&Qw[(long)r32*QP+d0*16+hi*8]);
  float mhat=0.f,l_reg=0.f;f32x16 o[2];o[0]=f32x16{};o[1]=f32x16{};f32x16 negm=f32x16{};asm volatile("":"+v"(negm));
  const int qrel=wid*QBLK+r32;
  #define CMASK(P0,P1,t) do{}while(0)
  bool resc=false;
  #define START(P0,P1) do{ const float rm=rowmax(P0,P1); resc=false; \
    { const float dl=rm; mhat=fadd_s(mhat,dl); \
      _Pragma("unroll") for(int r=0;r<16;++r){P0[r]=fsub_s(P0[r],dl);P1[r]=fsub_s(P1[r],dl);} \
      _Pragma("unroll") for(int r=0;r<16;++r)negm[r]=-mhat; asm volatile("":"+v"(negm)); } \
    _Pragma("unroll") for(int r=0;r<16;++r)P0[r]=__builtin_amdgcn_exp2f(P0[r]); }while(0)
  #define RESC() do{ if(resc){ asm volatile("s_waitcnt lgkmcnt(0)":::"memory"); \
      _Pragma("unroll") for(int d_=0;d_<2;++d_) _Pragma("unroll") for(int r=0;r<16;++r)o[d_][r]*=wsf[crow(r,hi)]; } }while(0)
  f32x16 pA0,pA1,pB0,pB1;
  int sl_prev=0,sl_cur=0,sl_next=SLOTB;
  #define ROT() do{sl_prev=sl_cur;sl_cur=sl_next;sl_next=(sl_next==(NSLOT-1)*SLOTB)?0:sl_next+SLOTB;}while(0)
  DMA_K(2,2*SLOTB);
  WAIT_BAR(3);
  qkt(pA0,pA1,Kbase,qr,negm,r32,hi);asm volatile("s_nop 15\n\ts_nop 7":"+v"(pA0),"+v"(pA1));CMASK(pA0,pA1,0);
  START(pA0,pA1);
  _Pragma("unroll") for(int r=0;r<16;++r)pA1[r]=__builtin_amdgcn_exp2f(pA1[r]);
  WAIT_BAR(0);
  DMA_K(3,0);DMA_V(1,SLOTB);
  ROT();
  kload8(kf,kp0+sl_cur);
  WAIT_BAR(2);
  s16x4 vlo[8],vhi[8]; u32x4 pw0,pw1,pw2,pw3;
  #define PKW(P,B) cvtpk_s(P[B],P[B+1])
  #define PAF(k) __builtin_bit_cast(bf16x8,pw##k)
  #define VFR(i) (bf16x8){vlo[i][0],vlo[i][1],vlo[i][2],vlo[i][3],vhi[i][0],vhi[i][1],vhi[i][2],vhi[i][3]}
  #define PIN(x) asm volatile("":"+v"(x))
  #define MX3(a,b,c) __builtin_fmaxf(__builtin_fmaxf((a),(b)),(c))
  #define GAPA(MF,A0,A1,A2,A3,W0,W1,PW) do{ MF; sacc+=A0; sacc+=A1; sacc+=A2; sacc+=A3; PIN(sacc); W0; W1; PIN(PW); SBAR(); }while(0)
  #define EX(v) __builtin_amdgcn_exp2f(v)
  #define GAPB(MF,X,B) do{ MF; X[B]=EX(X[B]); X[B+1]=EX(X[B+1]); X[B+2]=EX(X[B+2]); X[B+3]=EX(X[B+3]); PIN(X); SBAR(); }while(0)
  #define VRD(i) do{ vlo[i]=vtr(vp_+(((i)>>2)*4096+((i)&3)*1024)); vhi[i]=vtr(vp_+(((i)>>2)*4096+((i)&3)*1024+512)); }while(0)
  #define KRD(G,j) do{ if(G){ kload2(kf,kp0+sl_next,j); SBAR(); } }while(0)
  #define STEP(C0,C1,P0,P1,t,GK,GV,GL) do{ SBAR(); \
    const lds_cptr vp_=vp0+sl_prev; \
    VRD(0); SBAR(); float sacc=(P0[0]+P0[1]); \
    GAPA(C0=__builtin_amdgcn_mfma_f32_32x32x16_bf16(kf[0],qr[0],negm,0,0,0), P0[2],P0[3],P0[4],P0[5],     pw0[0]=PKW(P0,0), pw0[1]=PKW(P0,2), pw0); \
    VRD(4); SBAR(); GAPA(C1=__builtin_amdgcn_mfma_f32_32x32x16_bf16(kf[1],qr[0],negm,0,0,0), P0[6],P0[7],P0[8],P0[9],     pw0[2]=PKW(P0,4), pw0[3]=PKW(P0,6), pw0); \
    VRD(1); SBAR(); GAPA(C0=__builtin_amdgcn_mfma_f32_32x32x16_bf16(kf[2],qr[1],C0,0,0,0),   P0[10],P0[11],P0[12],P0[13], pw1[0]=PKW(P0,8), pw1[1]=PKW(P0,10), pw1); \
    VRD(5); SBAR(); GAPA(C1=__builtin_amdgcn_mfma_f32_32x32x16_bf16(kf[3],qr[1],C1,0,0,0),   P0[14],P0[15],P1[0],P1[1],   pw1[2]=PKW(P0,12),pw1[3]=PKW(P0,14), pw1); \
    VRD(2); SBAR(); GAPA(C0=__builtin_amdgcn_mfma_f32_32x32x16_bf16(kf[4],qr[2],C0,0,0,0),   P1[2],P1[3],P1[4],P1[5],     pw2[0]=PKW(P1,0), pw2[1]=PKW(P1,2), pw2); \
    VRD(6); SBAR(); GAPA(C1=__builtin_amdgcn_mfma_f32_32x32x16_bf16(kf[5],qr[2],C1,0,0,0),   P1[6],P1[7],P1[8],P1[9],     pw2[2]=PKW(P1,4), pw2[3]=PKW(P1,6), pw2); \
    VRD(3); SBAR(); GAPA(C0=__builtin_amdgcn_mfma_f32_32x32x16_bf16(kf[6],qr[3],C0,0,0,0),   P1[10],P1[11],P1[12],P1[13], pw3[0]=PKW(P1,8), pw3[1]=PKW(P1,10), pw3); \
    VRD(7); SBAR(); GAPA(C1=__builtin_amdgcn_mfma_f32_32x32x16_bf16(kf[7],qr[3],C1,0,0,0),   P1[14],P1[15],0.f,0.f,       pw3[2]=PKW(P1,12),pw3[3]=PKW(P1,14), pw3); \
    l_reg+=sacc; \
    if(GK){DMA_K((t)+3,sl_cur);} if(GV){DMA_V((t)+1,sl_next);} \
    CMASK(C0,C1,t); \
    { float a=MX3(C0[0],C0[1],C1[0]),b=MX3(C0[2],C0[3],C1[1]); a=MX3(a,C1[2],C1[3]); \
      _Pragma("unroll") for(int r=4;r<16;r+=4){a=MX3(a,C0[r],C0[r+1]);b=MX3(b,C0[r+2],C0[r+3]);a=MX3(a,C1[r],C1[r+1]);b=MX3(b,C1[r+2],C1[r+3]);} \
      float rm=__builtin_fmaxf(a,b); { auto rr=__builtin_amdgcn_permlane32_swap(__float_as_uint(rm),__float_as_uint(rm),false,false); rm=__builtin_fmaxf(__uint_as_float(rr[0]),__uint_as_float(rr[1])); } \
      resc=false; \
      if(__builtin_expect(__any(rm>(float)THRL),0)){ const float dl=__builtin_fmaxf(rm,0.f); mhat+=dl; \
        _Pragma("unroll") for(int r=0;r<16;++r){C0[r]-=dl;C1[r]-=dl;} \
        _Pragma("unroll") for(int r=0;r<16;++r)negm[r]=-mhat; asm volatile("":"+v"(negm)); \
        const float f=__builtin_amdgcn_exp2f(-dl); l_reg*=f; if(hi==0)wsf[r32]=f; resc=true; } } \
    SBAR(); \
    GAPB(o[0]=__builtin_amdgcn_mfma_f32_32x32x16_bf16(PAF(0),VFR(0),o[0],0,0,0), C0,0); \
    GAPB(o[1]=__builtin_amdgcn_mfma_f32_32x32x16_bf16(PAF(0),VFR(4),o[1],0,0,0), C0,4); \
    KRD(GL,0); GAPB(o[0]=__builtin_amdgcn_mfma_f32_32x32x16_bf16(PAF(1),VFR(1),o[0],0,0,0), C0,8); \
    KRD(GL,1); GAPB(o[1]=__builtin_amdgcn_mfma_f32_32x32x16_bf16(PAF(1),VFR(5),o[1],0,0,0), C0,12); \
    KRD(GL,2); GAPB(o[0]=__builtin_amdgcn_mfma_f32_32x32x16_bf16(PAF(2),VFR(2),o[0],0,0,0), C1,0); \
    KRD(GL,3); GAPB(o[1]=__builtin_amdgcn_mfma_f32_32x32x16_bf16(PAF(2),VFR(6),o[1],0,0,0), C1,4); \
    GAPB(o[0]=__builtin_amdgcn_mfma_f32_32x32x16_bf16(PAF(3),VFR(3),o[0],0,0,0), C1,8); \
    GAPB(o[1]=__builtin_amdgcn_mfma_f32_32x32x16_bf16(PAF(3),VFR(7),o[1],0,0,0), C1,12); \
    }while(0)
  int t=1;
  #undef CMASK
  #define CMASK(P0,P1,t) do{}while(0)
  for(;t+5<NT;t+=2){
    STEP(pB0,pB1,pA0,pA1,t,true,true,true);     WAIT_BAR(2); RESC(); ROT();
    STEP(pA0,pA1,pB0,pB1,t+1,true,true,true);   WAIT_BAR(2); RESC(); ROT();
  }
  #undef CMASK
  #define CMASK(P0,P1,t) do{}while(0)
  #define ENDW(tt) do{ if((tt)+3<NT){WAIT_BAR(2);} else if((tt)+2<NT){WAIT_BAR(1);} else {WAIT_BAR(0);} }while(0)
  for(;t+1<NT;t+=2){
    STEP(pB0,pB1,pA0,pA1,t,(t+3<NT),(t+1<NT),(t+1<NT));       ENDW(t);   RESC(); ROT();
    STEP(pA0,pA1,pB0,pB1,t+1,(t+4<NT),(t+2<NT),(t+2<NT));     ENDW(t+1); RESC(); ROT();
  }
  STEP(pB0,pB1,pA0,pA1,NT-1,false,false,false); RESC();
  { float sacc=pB0[0]+pB0[1]; _Pragma("unroll") for(int r=2;r<16;++r)sacc+=pB0[r]; _Pragma("unroll") for(int r=0;r<16;++r)sacc+=pB1[r]; l_reg+=sacc;
    pw0=(u32x4){PKW(pB0,0),PKW(pB0,2),PKW(pB0,4),PKW(pB0,6)};pw1=(u32x4){PKW(pB0,8),PKW(pB0,10),PKW(pB0,12),PKW(pB0,14)};pw2=(u32x4){PKW(pB1,0),PKW(pB1,2),PKW(pB1,4),PKW(pB1,6)};pw3=(u32x4){PKW(pB1,8),PKW(pB1,10),PKW(pB1,12),PKW(pB1,14)};
    SBAR(); pv(o,vb0+sl_cur,PAF(0),PAF(1),PAF(2),PAF(3)); }
  #undef PKW
  #undef PAF
  #undef VFR
  #undef PIN
  #undef MX3
  #undef GAPA
  #undef GAPB
  #undef EX
  #undef VRD
  #undef KRD
  #undef STEP
  #undef ENDW
  {auto rr=__builtin_amdgcn_permlane32_swap(__float_as_uint(l_reg),__float_as_uint(l_reg),false,false);l_reg=__uint_as_float(rr[0])+__uint_as_float(rr[1]);}
  if(hi==0)wsf[32+r32]=l_reg;asm volatile("s_waitcnt lgkmcnt(0)":::"memory");
  float rli[16];
  #pragma unroll
  for(int r=0;r<16;++r)rli[r]=__builtin_amdgcn_rcpf(wsf[32+crow(r,hi)]);
  bf16*Ow=O+(rowbase+q0+wid*QBLK)*OP+h*D;
  { bf16*stg=(bf16*)(shm+LDS_OST)+wid*2048;
    #pragma unroll
    for(int r=0;r<16;++r){const int orow=crow(r,hi);
      #pragma unroll
      for(int d0=0;d0<2;++d0)stg[orow*64+d0*32+r32]=__float2bfloat16(o[d0][r]*rli[r]);}
    asm volatile("s_waitcnt lgkmcnt(0)":::"memory");
    #pragma unroll
    for(int i=0;i<4;++i){const int row=i*8+(lane>>3),ch=lane&7; const u32x4 v=*(const u32x4*)(stg+row*64+ch*8); ATTN_STORE16(Ow+(long)row*OP+ch*8,v);} }
  asm volatile("s_waitcnt lgkmcnt(0)\n\ts_barrier":::"memory");
  #undef DMA_K
  #undef DMA_V
  #undef CMASK
  #undef START
  #undef RESC
  #undef ROT
}
constexpr int ATTN_LDS_BYTES=LDS_BYTES;
struct AttnTensors { const bf16* Q; const bf16* K; const bf16* V; bf16* O; };
struct AttnUnit { int bh; int qb; };
struct StaticOrder {
  int vcu, G;
  __device__ __forceinline__ explicit StaticOrder(int grid,int block):vcu((grid%8==0)?(block%8)*(grid/8)+block/8:block),G(grid){}
  __device__ __forceinline__ bool next(int i,AttnUnit&u)const{
    const int L=i*G+vcu; if(L>=BATCH*NHEAD*NQB)return false;
    if(G==256){ if(i>=2)return false; const int x=vcu>>5,j=vcu&31; const int b=x>>2,kvh=(x>>1)&1,hq=kvh*4+2*(x&1)+i; u.bh=b*NHEAD+hq; u.qb=j; return true; }
    u.bh=L/NQB; u.qb=L%NQB; return true; }
  __device__ __forceinline__ void a_ready(const AttnUnit&)const{}
  __device__ __forceinline__ void done(const AttnUnit&)const{}
};
template<class Sched,int THRL=8> __device__ __forceinline__ void attn_phase(char*lds,const AttnTensors&T,const Sched&S){
  AttnUnit u;
  for(int i=0;S.next(i,u);++i){ S.a_ready(u); attn_unit<THRL>(u.bh/NHEAD,u.bh%NHEAD,u.qb,T.Q,T.K,T.V,T.O,lds); S.done(u); }
}
#undef SBAR
#undef WAIT_BAR
}

#include <hip/hip_cooperative_groups.h>
namespace cg = cooperative_groups;
#ifndef MK_PER_PHASE
#define MK_PER_PHASE 0
#endif
constexpr int NWAVES = 8, NTHREADS = 512;
constexpr int NB = 2, SEQ = 8192, DMODEL = 1024, TT = NB * SEQ;
constexpr int NPROJ = 3072;
constexpr int NEXP = 32, FFE = 512;
constexpr float EPS = 1e-6f;
constexpr int N_PHASES = 12;

constexpr size_t MiB = 1u << 20;
constexpr size_t WS_CTL = 0, CTL_ZERO_BYTES = 64 * 1024;
constexpr size_t WS_WOUT = 1 * MiB;
constexpr size_t WS_WR = 3 * MiB;
constexpr size_t WS_TOK = 3 * MiB + 256 * 1024;
constexpr size_t WS_GATES = 4 * MiB;
constexpr size_t WS_WIN = 5 * MiB;
constexpr size_t WS_A = 11 * MiB;
constexpr size_t WS_XN = WS_A;
constexpr size_t GDN_SH_BYTES = 71680, GDN_D_BYTES = 19456;
constexpr size_t WS_GSH = WS_A;
constexpr size_t WS_GD = WS_A + 1024 * GDN_SH_BYTES;
constexpr size_t WS_WGU = WS_A;
constexpr size_t WS_WD = WS_A + 64 * MiB;
constexpr size_t WS_HID = WS_A + 96 * MiB;
constexpr size_t WS_B = 157 * MiB;
constexpr size_t WS_QKVA = WS_B;
constexpr size_t WS_QKVB = WS_B + 48 * MiB;
constexpr size_t WS_ZA = WS_B + 72 * MiB;
constexpr size_t WS_OCAT = WS_B;
constexpr size_t WS_XBUF = WS_B;
constexpr size_t WS_HN = WS_B + 80 * MiB;
constexpr size_t WS_END = 269 * MiB;
static_assert(WS_GD + 4096 * GDN_D_BYTES <= WS_B, "GDN records fit region A");
static_assert(WS_HID + 40928ull * 1024 <= WS_B, "HID fits region A");
static_assert(WS_HN + 32 * MiB <= WS_END, "HN");
constexpr size_t DO_QR = 0, DO_KR = 16 * MiB, DO_VR = 20 * MiB, DO_OF = 24 * MiB, DO_OB = 40 * MiB;
constexpr int CW_CNT = 64;
constexpr int CW_NTILE = 128;
constexpr int CW_TILES = 192;

constexpr int LDS_BYTES = 160 * 1024;

#define GAS __attribute__((address_space(1)))
#define LAS __attribute__((address_space(3)))
typedef unsigned short bf16;
typedef unsigned v4u __attribute__((ext_vector_type(4)));
typedef unsigned v2u __attribute__((ext_vector_type(2)));
typedef float f32x4 __attribute__((ext_vector_type(4)));
typedef short bf16x8 __attribute__((ext_vector_type(8)));
typedef short s16x4 __attribute__((ext_vector_type(4)));
#define DI __device__ __forceinline__

DI unsigned f2bf(float f) { unsigned u = __builtin_bit_cast(unsigned, f); return (u + 0x7fffu + ((u >> 16) & 1u)) >> 16; }
DI unsigned pk2(float lo, float hi) { return f2bf(lo) | (f2bf(hi) << 16); }
DI float bf2f(unsigned short h) { return __builtin_bit_cast(float, (unsigned)h << 16); }
DI float bflo(unsigned w) { return __builtin_bit_cast(float, w << 16); }
DI float bfhi(unsigned w) { return __builtin_bit_cast(float, w & 0xffff0000u); }
DI float wave_sum(float v) {
#pragma unroll
    for (int o = 1; o < 64; o <<= 1) v += __shfl_xor(v, o);
    return v;
}
DI float siluf(float x) { return x * __builtin_amdgcn_rcpf(1.0f + __expf(-x)); }
DI float sigmoidf_(float x) { return 1.0f / (1.0f + __expf(-x)); }
DI int perm32i(int idx) { return ((idx >> 2) & 3) * 8 + (idx >> 4) * 4 + (idx & 3); }
DI int permcol(int c) { return (c & ~31) + perm32i(c & 31); }
template <class T> DI T opaque(T p) { asm volatile("" : "+v"(p)); return p; }

struct Frame {
    LAS unsigned char* lds;
    int tid, lane, wave, vcu, G;
    const float* in[17];
    float* out; unsigned char* ws;
};

DI void p0_transpose_item(const float* W, int ldw, int nblk, bf16* WT, int K, int row_off, int rmul, LAS float* scr, int item, int lane) {
    const int kb = item / nblk, nb = item % nblk, k0 = 64 * kb, n0 = 32 * nb;
#pragma unroll 8
    for (int i = 0; i < 32; ++i) { const int kk = 2 * i + (lane >> 5); scr[kk * 33 + (lane & 31)] = W[(size_t)(k0 + kk) * ldw + n0 + (lane & 31)]; }
    asm volatile("s_waitcnt lgkmcnt(0)" ::: "memory");
    const int c = lane & 7;
#pragma unroll
    for (int j = 0; j < 4; ++j) { const int n = (lane >> 3) + 8 * j; const LAS float* s = scr + (8 * c) * 33 + n;
        v4u o; o.x = pk2(s[0 * 33], s[1 * 33]); o.y = pk2(s[2 * 33], s[3 * 33]); o.z = pk2(s[4 * 33], s[5 * 33]); o.w = pk2(s[6 * 33], s[7 * 33]);
        *(GAS v4u*)(WT + (size_t)(row_off + (n0 + n) * rmul) * K + k0 + 8 * c) = o; }
    asm volatile("s_waitcnt lgkmcnt(0)" ::: "memory");
}
DI void rms_row_to_bf16(const float* xrow, const float* w, bf16* orow, int lane) {
    const GAS f32x4* xr = (const GAS f32x4*)xrow + lane; const GAS f32x4* wr = (const GAS f32x4*)w + lane;
    f32x4 v[4]; float s = 0.f;
#pragma unroll
    for (int j = 0; j < 4; ++j) { v[j] = xr[64 * j]; s += (v[j].x * v[j].x + v[j].y * v[j].y) + (v[j].z * v[j].z + v[j].w * v[j].w); }
    const float rs = 1.0f / sqrtf(wave_sum(s) * (1.f / DMODEL) + EPS);
    GAS v2u* o8 = (GAS v2u*)orow + lane;
#pragma unroll
    for (int j = 0; j < 4; ++j) { const f32x4 ww = wr[64 * j]; v2u o; o.x = pk2(v[j].x * rs * ww.x, v[j].y * rs * ww.y); o.y = pk2(v[j].z * rs * ww.z, v[j].w * rs * ww.w); o8[64 * j] = o; }
}
DI void p0_prologue(Frame& F) {
    LAS float* scr = (LAS float*)(F.lds + F.wave * 16384);
    const int gw = F.vcu * NWAVES + F.wave, NGW = F.G * NWAVES;
    const float* w_in = F.in[2]; const float* w_out = F.in[9];
    bf16* WIN = (bf16*)(F.ws + WS_WIN); bf16* WOUT = (bf16*)(F.ws + WS_WOUT);
    constexpr int I1 = 16 * 64, I2 = 16 * 24, I3 = 16, I4 = 16 * 32, NITEMS = I1 + I2 + I3 + I4;
    for (int it = gw; it < NITEMS; it += NGW) {
        int r = it;
        if (r < I1) { p0_transpose_item(w_in, 2832, 64, WIN, 1024, 0, 1, scr, r, F.lane); continue; } r -= I1;
        if (r < I2) { p0_transpose_item(w_in + 2064, 2832, 24, WIN, 1024, 2048, 1, scr, r, F.lane); continue; } r -= I2;
        if (r < I3) { p0_transpose_item(w_in + 2048, 2832, 1, WIN, 1024, 2816, 1, scr, r, F.lane); continue; } r -= I3;
        p0_transpose_item(w_out, 1024, 32, WOUT, 1024, 0, 1, scr, r, F.lane);
    }
    { const int gt = F.vcu * NTHREADS + F.tid, GT = F.G * NTHREADS; GAS v4u* z = (GAS v4u*)(WIN + (size_t)2848 * 1024);
      for (int i = gt; i < 224 * 1024 * 2 / 16; i += GT) z[i] = (v4u){0u, 0u, 0u, 0u}; }
    { const int gt = F.vcu * NTHREADS + F.tid, GT = F.G * NTHREADS; bf16* WRH = (bf16*)(F.ws + WS_WR); bf16* WRL = WRH + 48 * 1024;
      const float* wrg = F.in[11]; const float* wre = F.in[12];
      for (int i = gt; i < 48 * 1024; i += GT) { const int j = i >> 10, k = i & 1023; float v = 0.f; if (j < 4) v = wrg[k * 4 + j]; else if (j < 36) v = wre[k * 32 + (j - 4)];
          const unsigned h = f2bf(v); const float hv = __builtin_bit_cast(float, h << 16); WRH[i] = (bf16)h; WRL[i] = (bf16)f2bf(v - hv); } }
    bf16* XN = (bf16*)(F.ws + WS_XN);
    for (int m = gw; m < TT; m += NGW) rms_row_to_bf16(F.in[0] + (size_t)m * DMODEL, F.in[1], XN + (size_t)m * DMODEL, F.lane);
}

struct EpiProj {
    static constexpr bool PERM = true, AFTER_DRAIN = false;
    bf16 *qkva, *za, *qkvb; float* gates;
    DI void operator()(const pg8::f32x4 (&acc)[2][2][4][2], const pg8::Unit& u, int wr, int wc, int fr, int fq) const {
        const int row0 = u.pm * 256 + wr * 64 + fr;
        if (u.pn == 11) {
            if (wc == 0 && fq < 2) {
#pragma unroll
                for (int ai = 0; ai < 2; ++ai)
#pragma unroll
                    for (int m = 0; m < 4; ++m) { float* rp = gates + (size_t)(row0 + ai * 128 + m * 16) * 16 + 8 * fq;
                        *(pg8::f32x4*)(rp) = acc[ai][0][m][0]; *(pg8::f32x4*)(rp + 4) = acc[ai][0][m][1]; }
            }
            return;
        }
        bf16* base; int ldc, colt;
        if (u.pn < 6) { base = qkva; ldc = 1536; colt = u.pn * 256; } else if (u.pn < 8) { base = za; ldc = 512; colt = (u.pn - 6) * 256; } else { base = qkvb; ldc = 768; colt = (u.pn - 8) * 256; }
        const int col0 = colt + wc * 32 + 8 * fq;
#pragma unroll
        for (int ai = 0; ai < 2; ++ai)
#pragma unroll
            for (int m = 0; m < 4; ++m) { bf16* rowp = base + (size_t)(row0 + ai * 128 + m * 16) * ldc + col0;
#pragma unroll
                for (int bj = 0; bj < 2; ++bj) { const pg8::f32x4 v0 = acc[ai][bj][m][0], v1 = acc[ai][bj][m][1]; pg8::u32x4 w;
                    w.x = pg8::cvt_pk_bf16(v0[0], v0[1]); w.y = pg8::cvt_pk_bf16(v0[2], v0[3]); w.z = pg8::cvt_pk_bf16(v1[0], v1[1]); w.w = pg8::cvt_pk_bf16(v1[2], v1[3]);
                    *(pg8::u32x4*)(rowp + bj * 128) = w; } }
    }
};
struct EpiResid {
    static constexpr bool PERM = false, AFTER_DRAIN = false;
    const float* x; float* x1;
    DI void operator()(const pg8::f32x4 (&acc)[2][2][4][2], const pg8::Unit& u, int wr, int wc, int fr, int fq) const {
        const int row0 = u.pm * 256 + wr * 64 + fr, col0 = u.pn * 256 + wc * 32 + 4 * fq;
#pragma unroll
        for (int ai = 0; ai < 2; ++ai)
#pragma unroll
            for (int m = 0; m < 4; ++m) { const size_t off = (size_t)(row0 + ai * 128 + m * 16) * DMODEL + col0;
#pragma unroll
                for (int bj = 0; bj < 2; ++bj)
#pragma unroll
                    for (int n = 0; n < 2; ++n) { const pg8::f32x4 b = *(const pg8::f32x4*)(x + off + bj * 128 + n * 16); *(pg8::f32x4*)(x1 + off + bj * 128 + n * 16) = b + acc[ai][bj][m][n]; } }
    }
};
struct EpiGU {
    static constexpr bool PERM = true, AFTER_DRAIN = false;
    bf16* hid;
    DI void operator()(const pg8::f32x4 (&acc)[2][2][4][2], const pg8::Unit& u, int wr, int wc, int fr, int fq) const {
        const int row0 = u.pm * 256 + wr * 64 + fr; const int jt = u.pn & 3;
        const int ff0 = jt * 128 + wc * 16 + 4 * fq;
#pragma unroll
        for (int ai = 0; ai < 2; ++ai)
#pragma unroll
            for (int m = 0; m < 4; ++m) { bf16* rowp = hid + (size_t)(row0 + ai * 128 + m * 16) * FFE + ff0;
#pragma unroll
                for (int bj = 0; bj < 2; ++bj) { const pg8::f32x4 v0 = acc[ai][bj][m][0], v1 = acc[ai][bj][m][1];
                    const float h0 = siluf(v0[0]) * v0[1], h1 = siluf(v0[2]) * v0[3], h2 = siluf(v1[0]) * v1[1], h3 = siluf(v1[2]) * v1[3];
                    v2u w; w.x = pg8::cvt_pk_bf16(h0, h1); w.y = pg8::cvt_pk_bf16(h2, h3);
                    *(v2u*)(rowp + bj * 64) = w; } }
    }
};
struct EpiY {
    static constexpr bool PERM = true, AFTER_DRAIN = false;
    bf16* y;
    DI void operator()(const pg8::f32x4 (&acc)[2][2][4][2], const pg8::Unit& u, int wr, int wc, int fr, int fq) const {
        const int row0 = u.pm * 256 + wr * 64 + fr; const int col0 = (u.pn & 3) * 256 + wc * 32 + 8 * fq;
#pragma unroll
        for (int ai = 0; ai < 2; ++ai)
#pragma unroll
            for (int m = 0; m < 4; ++m) { bf16* rowp = y + (size_t)(row0 + ai * 128 + m * 16) * DMODEL + col0;
#pragma unroll
                for (int bj = 0; bj < 2; ++bj) { const pg8::f32x4 v0 = acc[ai][bj][m][0], v1 = acc[ai][bj][m][1]; pg8::u32x4 w;
                    w.x = pg8::cvt_pk_bf16(v0[0], v0[1]); w.y = pg8::cvt_pk_bf16(v0[2], v0[3]); w.z = pg8::cvt_pk_bf16(v1[0], v1[1]); w.w = pg8::cvt_pk_bf16(v1[2], v1[3]);
                    *(pg8::u32x4*)(rowp + bj * 128) = w; } }
    }
};
struct MoeOrder {
    const unsigned* ctl; int G, c;
    DI bool next(int i, pg8::Unit& u) const {
        const int nt = (int)ctl[CW_NTILE]; const int L = i * G + c; if (L >= nt * 4) return false;
        const int t = L >> 2, j = L & 3; u.pm = (int)ctl[CW_TILES + 2 * t]; u.pn = (int)ctl[CW_TILES + 2 * t + 1] * 4 + j; return true; }
    DI void a_ready(const pg8::Unit&) const {}
    DI void done(const pg8::Unit&) const {}
};

DI void p2_rope(Frame& F) {
    const int gw = F.vcu * NWAVES + F.wave, NGW = F.G * NWAVES, lane = F.lane;
    const bf16* QKVB = (const bf16*)(F.ws + WS_QKVB);
    bf16* QR = (bf16*)((unsigned char*)F.out + DO_QR); bf16* KR = (bf16*)((unsigned char*)F.out + DO_KR); bf16* VR = (bf16*)((unsigned char*)F.out + DO_VR);
    const int pi = lane & 31, hsel = lane >> 5;
    const float qw0 = F.in[7][2 * pi], qw1 = F.in[7][2 * pi + 1], kw0 = F.in[8][2 * pi], kw1 = F.in[8][2 * pi + 1];
    const float invf = exp2f(-(float)(2 * (pi & 15)) * (13.287712379549449f / 32.0f));
    constexpr float C2 = 0.125f * 1.4426950408889634f;
    for (int t = gw; t < TT; t += NGW) {
        const int s = t & (SEQ - 1); const float pos = (pi < 16) ? (float)(s >> 6) : (float)(s & 63);
        const float ang = pos * invf;
        const double rev = (double)ang * 0.15915494309189535; const float fr = (float)(rev - floor(rev));
        const float sn = __builtin_amdgcn_sinf(fr), cs = __builtin_amdgcn_cosf(fr);
        const unsigned* src = (const unsigned*)(QKVB + (size_t)t * 768);
#pragma unroll
        for (int j = 0; j < 5; ++j) {
            const int head = 2 * j + hsel; const unsigned w = src[head * 32 + pi];
            const float x0 = bflo(w), x1 = bfhi(w);
            float ss = x0 * x0 + x1 * x1;
#pragma unroll
            for (int o = 1; o < 32; o <<= 1) ss += __shfl_xor(ss, o);
            const float rs = 1.0f / sqrtf(ss * (1.f / 64.f) + EPS);
            const bool isq = head < 8;
            const float y0 = x0 * rs * (isq ? qw0 : kw0), y1 = x1 * rs * (isq ? qw1 : kw1);
            float o0 = y0 * cs - y1 * sn, o1 = y0 * sn + y1 * cs;
            if (isq) { o0 *= C2; o1 *= C2; ((unsigned*)(QR + (size_t)t * 512))[head * 32 + pi] = pk2(o0, o1); }
            else ((unsigned*)(KR + (size_t)t * 128))[(head - 8) * 32 + pi] = pk2(o0, o1);
        }
        ((unsigned*)(VR + (size_t)t * 128))[lane] = src[320 + lane];
    }
}

constexpr int G_KNP = 0, G_QNP = 17408, G_KNTP = 34816, G_VCT = 53248;
constexpr int G_D0 = 71680, G_D1 = 71680 + 19456;
constexpr int GD_TBP = 0, GD_AP = 9216, GD_VEC = 18432;
constexpr int G_LM = 110592;
constexpr int G_GV = G_LM + 32768;
static_assert(G_GV + 1024 <= LDS_BYTES, "gdn pre lds");

template <bool REV> DI void tri_inverse(LAS float* L, const LAS float* beta, LAS bf16* TBP, int lane) {
    const float bcol = REV ? beta[63 - lane] : beta[lane];
    const int pc = REV ? permcol(63 - lane) : permcol(lane);
    LAS float* Xc = L + lane;
#pragma unroll 1
    for (int i = 0; i < 64; ++i) {
        float a0 = (lane == i) ? 1.0f : 0.0f, a1 = 0.f, a2 = 0.f, a3 = 0.f;
        const LAS float* Li = L + i * 64;
        const int nq = i >> 2;
#pragma unroll 4
        for (int j4 = 0; j4 < nq; ++j4) {
            const f32x4 l = *(const LAS f32x4*)(Li + 4 * j4);
            a0 -= l.x * Xc[(4 * j4 + 0) * 64]; a1 -= l.y * Xc[(4 * j4 + 1) * 64]; a2 -= l.z * Xc[(4 * j4 + 2) * 64]; a3 -= l.w * Xc[(4 * j4 + 3) * 64];
        }
        const int rem = i & 3;
        if (rem) {
            const f32x4 l = *(const LAS f32x4*)(Li + 4 * nq);
            a0 -= l.x * Xc[(4 * nq + 0) * 64];
            if (rem > 1) a1 -= l.y * Xc[(4 * nq + 1) * 64];
            if (rem > 2) a2 -= l.z * Xc[(4 * nq + 2) * 64];
        }
        const float a = (a0 + a1) + (a2 + a3);
        asm volatile("s_waitcnt lgkmcnt(0)" ::: "memory");
        Xc[i * 64] = a;
        const int row = REV ? 63 - i : i;
        TBP[row * 72 + pc] = (bf16)f2bf(a * bcol);
    }
}

DI void p2_gdn_pre(Frame& F) {
    const int tid = F.tid, lane = F.lane, wave = F.wave;
    const bf16* QKVA = (const bf16*)(F.ws + WS_QKVA); const float* GATES = (const float*)(F.ws + WS_GATES);
    const float* convw = F.in[3];
#pragma unroll 1
    for (int task = F.vcu; task < 1024; task += F.G) {
        LAS unsigned char* lds = opaque(F.lds);
        LAS float* sGf = (LAS float*)(lds + G_GV); LAS float* sRb = sGf + 64; LAS float* sBf = sGf + 128; LAS float* sBb = sGf + 192;
        const int b = task >> 9, h = (task >> 7) & 3, n = task & 127;
        const int t0 = b * SEQ + n * 64;
#ifndef NO_CONV
        if (tid < 384) {
            const int cgp = tid % 48, rg = tid / 48, mat = cgp >> 4, cc = (cgp & 15) * 8;
            const int col = mat * 512 + h * 128 + cc;
            float w[5][8];
#pragma unroll
            for (int j = 0; j < 5; ++j) { const f32x4 a = *(const f32x4*)(convw + j * 1536 + col), bq = *(const f32x4*)(convw + j * 1536 + col + 4);
                w[j][0] = a.x; w[j][1] = a.y; w[j][2] = a.z; w[j][3] = a.w; w[j][4] = bq.x; w[j][5] = bq.y; w[j][6] = bq.z; w[j][7] = bq.w; }
            const int a4 = (cc >> 3) & 3, p0 = (cc & ~31) + 16 * (a4 & 1) + 4 * (a4 >> 1);
            const int ra = rg & 3, q0 = (rg >> 2) * 32 + 16 * (ra & 1) + 4 * (ra >> 1);
#pragma unroll
            for (int hf = 0; hf < 2; ++hf) {
                float o[4][8];
#pragma unroll
                for (int r = 0; r < 4; ++r)
#pragma unroll
                    for (int c = 0; c < 8; ++c) o[r][c] = 0.f;
#pragma unroll
                for (int i = 0; i < 8; ++i) {
                    const int pos = n * 64 + rg * 8 + hf * 4 - 2 + i;
                    v4u raw = (v4u){0u, 0u, 0u, 0u};
                    if (pos >= 0 && pos < SEQ) raw = *(const v4u*)(QKVA + (size_t)(b * SEQ + pos) * 1536 + col);
                    float xin[8] = {bflo(raw.x), bfhi(raw.x), bflo(raw.y), bfhi(raw.y), bflo(raw.z), bfhi(raw.z), bflo(raw.w), bfhi(raw.w)};
#pragma unroll
                    for (int j = 0; j < 5; ++j) { const int r = i - j; if (r >= 0 && r < 4) {
#pragma unroll
                        for (int c = 0; c < 8; ++c) o[r][c] += w[j][c] * xin[c]; } }
                }
#pragma unroll
                for (int r = 0; r < 4; ++r) {
                    float ss = 0.f;
#pragma unroll
                    for (int c = 0; c < 8; ++c) { o[r][c] = siluf(o[r][c]); ss += o[r][c] * o[r][c]; }
                    ss += __shfl_xor(ss, 1); ss += __shfl_xor(ss, 2); ss += __shfl_xor(ss, 4); ss += __shfl_xor(ss, 8);
                    float sc = 1.0f;
                    if (mat < 2) { sc = 1.0f / sqrtf(ss + EPS); if (mat == 0) sc *= 0.08838834764831845f; }
#pragma unroll
                    for (int c = 0; c < 8; ++c) o[r][c] *= sc;
                }
                if (mat < 2) {
                    LAS unsigned char* tile = lds + (mat == 0 ? G_QNP : G_KNP);
#pragma unroll
                    for (int r = 0; r < 4; ++r) { const int c = rg * 8 + hf * 4 + r;
                        v2u lo, hi2; lo.x = pk2(o[r][0], o[r][1]); lo.y = pk2(o[r][2], o[r][3]); hi2.x = pk2(o[r][4], o[r][5]); hi2.y = pk2(o[r][6], o[r][7]);
                        *(LAS v2u*)(tile + c * 272 + p0 * 2) = lo; *(LAS v2u*)(tile + c * 272 + (p0 + 8) * 2) = hi2; }
                }
                if (mat >= 1) {
#pragma unroll
                    for (int c = 0; c < 8; ++c) {
                        v2u q4; q4.x = pk2(o[0][c], o[1][c]); q4.y = pk2(o[2][c], o[3][c]);
                        if (mat == 1) *(LAS v2u*)(lds + G_KNTP + (cc + c) * 144 + (q0 + 8 * hf) * 2) = q4;
                        else *(LAS v2u*)(lds + G_VCT + (cc + c) * 144 + rg * 16 + hf * 8) = q4;
                    }
                }
            }
        } else
#endif
        if (wave == 7) {
            const float* gp = GATES + (size_t)(t0 + lane) * 16;
            const float bfv = gp[h], bbv = gp[4 + h], afv = gp[8 + h], abv = gp[12 + h];
            const float betaf = sigmoidf_(bfv), betab = sigmoidf_(bbv);
            const float xf = afv + F.in[5][h], xb = abv + F.in[5][4 + h];
            const float spf = fmaxf(xf, 0.f) + log1pf(__expf(-fabsf(xf))), spb = fmaxf(xb, 0.f) + log1pf(__expf(-fabsf(xb)));
            const float gf = -__expf(F.in[4][h]) * spf, gb = -__expf(F.in[4][4 + h]) * spb;
            float Gf = gf, Rb = gb;
#pragma unroll
            for (int o = 1; o < 64; o <<= 1) { const float u1 = __shfl_up(Gf, o); if (lane >= o) Gf += u1; const float d1 = __shfl_down(Rb, o); if (lane + o < 64) Rb += d1; }
            sGf[lane] = Gf; sRb[lane] = Rb; sBf[lane] = betaf; sBb[lane] = betab;
            const float GfL = __shfl(Gf, 63), Rb0 = __shfl(Rb, 0);
            LAS float* v0 = (LAS float*)(lds + G_D0 + GD_VEC); LAS float* v1 = (LAS float*)(lds + G_D1 + GD_VEC);
            v0[lane] = __expf(Gf); v0[64 + lane] = __expf(GfL - Gf); v1[lane] = __expf(Rb); v1[64 + lane] = __expf(Rb0 - Rb);
            if (lane == 0) { v0[128] = __expf(GfL); v1[128] = __expf(Rb0); }
        }
        __syncthreads();
        {
            const int p = wave >> 2, mt = wave & 3, n16 = lane & 15, g = lane >> 4;
            const LAS unsigned char* At = lds + (p == 0 ? G_KNP : G_QNP) + (16 * mt + n16) * 272 + g * 16;
            bf16x8 af[4];
#pragma unroll
            for (int ks = 0; ks < 4; ++ks) af[ks] = *(const LAS bf16x8*)(At + ks * 64);
#pragma unroll
            for (int nt = 0; nt < 4; ++nt) {
                const LAS unsigned char* Bt = lds + G_KNP + (16 * nt + n16) * 272 + g * 16;
                f32x4 acc = (f32x4){0.f, 0.f, 0.f, 0.f};
#pragma unroll
                for (int ks = 0; ks < 4; ++ks) acc = __builtin_amdgcn_mfma_f32_16x16x32_bf16(af[ks], *(const LAS bf16x8*)(Bt + ks * 64), acc, 0, 0, 0);
                const int s = 16 * nt + n16; const float Gs = sGf[s], Rs = sRb[s];
#pragma unroll
                for (int r = 0; r < 4; ++r) {
                    const int c = 16 * mt + 4 * g + r; const float v = acc[r];
                    const float df = __expf(fminf(sGf[c] - Gs, 0.f)), db = __expf(fminf(sRb[c] - Rs, 0.f));
                    if (p == 0) {
                        if (s < c) ((LAS float*)(lds + G_LM))[c * 64 + s] = sBf[c] * v * df;
                        if (s > c) ((LAS float*)(lds + G_LM + 16384))[(63 - c) * 64 + (63 - s)] = sBb[c] * v * db;
                    } else {
                        const int ps = permcol(s);
                        ((LAS bf16*)(lds + G_D0 + GD_AP))[c * 72 + ps] = (bf16)f2bf(s <= c ? v * df : 0.f);
                        ((LAS bf16*)(lds + G_D1 + GD_AP))[c * 72 + ps] = (bf16)f2bf(s >= c ? v * db : 0.f);
                    }
                }
            }
        }
        __syncthreads();
#ifndef NO_TRI
        if (wave == 0) tri_inverse<false>((LAS float*)(lds + G_LM), sBf, (LAS bf16*)(lds + G_D0 + GD_TBP), lane);
        else if (wave == 1) tri_inverse<true>((LAS float*)(lds + G_LM + 16384), sBb, (LAS bf16*)(lds + G_D1 + GD_TBP), lane);
#endif
        __syncthreads();
        {
            const int bh = b * 4 + h;
            GAS v4u* gsh = (GAS v4u*)(F.ws + WS_GSH + (size_t)(bh * 128 + n) * GDN_SH_BYTES);
#pragma unroll 1
            for (int i = tid; i < (int)(GDN_SH_BYTES / 16); i += NTHREADS) gsh[i] = *(const LAS v4u*)(lds + i * 16);
            GAS v4u* gd0 = (GAS v4u*)(F.ws + WS_GD + (size_t)((bh * 2 + 0) * 128 + n) * GDN_D_BYTES);
            GAS v4u* gd1 = (GAS v4u*)(F.ws + WS_GD + (size_t)((bh * 2 + 1) * 128 + n) * GDN_D_BYTES);
#pragma unroll 1
            for (int i = tid; i < (int)(GDN_D_BYTES / 16); i += NTHREADS) { gd0[i] = *(const LAS v4u*)(lds + G_D0 + i * 16); gd1[i] = *(const LAS v4u*)(lds + G_D1 + i * 16); }
        }
        __syncthreads();
    }
}

DI bf16x8 pack8(const f32x4 a, const f32x4 b) {
    v4u p; p.x = pk2(a[0], a[1]); p.y = pk2(a[2], a[3]); p.z = pk2(b[0], b[1]); p.w = pk2(b[2], b[3]); return __builtin_bit_cast(bf16x8, p);
}
constexpr int SC_SLOT = 78848, SC_VCT = 53248, SC_D = 55552, SC_NCH = 11;
static_assert(2 * SC_SLOT <= LDS_BYTES, "scan slots");
DI void sc_issue(v4u (&R)[SC_NCH], const unsigned char* ws, const unsigned (&delta)[SC_NCH], const unsigned (&dmask)[SC_NCH], unsigned shbase, unsigned ddiff) {
#pragma unroll
    for (int j = 0; j < SC_NCH; ++j) { const unsigned off = shbase + delta[j] + (dmask[j] & ddiff);
#ifdef SC_PLAIN_LOADS
        R[j] = *(const v4u*)(ws + off); }
#else
        asm volatile("global_load_dwordx4 %0, %1, %2" : "=v"(R[j]) : "v"(off), "s"(ws) : "memory"); }
#endif
}
#ifdef SC_PLAIN_LOADS
#define SC_WAIT(R, n) do {} while (0)
#else
#define SC_WAIT(R, n) asm volatile("s_waitcnt vmcnt(" #n ")" : "+v"(R[0]), "+v"(R[1]), "+v"(R[2]), "+v"(R[3]), "+v"(R[4]), "+v"(R[5]), "+v"(R[6]), "+v"(R[7]), "+v"(R[8]), "+v"(R[9]), "+v"(R[10]) :: "memory")
#endif
DI void sc_write(const v4u (&R)[SC_NCH], LAS unsigned char* slot, int lid) {
#pragma unroll
    for (int j = 0; j < SC_NCH; ++j) *(LAS v4u*)(slot + 16 * (lid + 448 * j)) = R[j];
}
DI void p4_scan(Frame& F) {
    const int bx = blockIdx.x; if (bx >= 128) return;
    const int lane = F.lane, n16 = lane & 15, g = lane >> 4, wave = F.wave;
    const int x = bx & 7, jj = bx >> 3; const int chain = 2 * x + (jj >> 3), e = jj & 7;
    const int bh = chain >> 1, dir = chain & 1, b = bh >> 2, h = bh & 3;
    LAS unsigned char* lds = opaque(F.lds);
    if (wave != 0) {
        const int lid = (wave - 1) * 64 + lane;
        const unsigned sh0 = (unsigned)(WS_GSH + (size_t)(bh * 128) * GDN_SH_BYTES), d0 = (unsigned)(WS_GD + (size_t)((bh * 2 + dir) * 128) * GDN_D_BYTES);
        unsigned delta[SC_NCH], dmask[SC_NCH];
#pragma unroll
        for (int j = 0; j < SC_NCH; ++j) { const int c = lid + 448 * j;
            delta[j] = (c < 3328) ? 16u * c : ((c < 3472) ? (unsigned)(G_VCT + 16 * e * 144 + 16 * (c - 3328)) : 16u * (c - 3472));
            dmask[j] = (c < 3472) ? 0u : 0xffffffffu; }
        v4u R0[SC_NCH], R1[SC_NCH], R2[SC_NCH];
#define SC_SRC(st) const int n_ = (dir == 0) ? ((st) < 128 ? (st) : 127) : ((st) < 128 ? 127 - (st) : 0); \
                   const unsigned shb_ = sh0 + (unsigned)n_ * (unsigned)GDN_SH_BYTES, ddf_ = (d0 + (unsigned)n_ * (unsigned)GDN_D_BYTES) - shb_;
        { SC_SRC(0) sc_issue(R0, F.ws, delta, dmask, shb_, ddf_); }
        { SC_SRC(1) sc_issue(R1, F.ws, delta, dmask, shb_, ddf_); }
        { SC_SRC(2) sc_issue(R2, F.ws, delta, dmask, shb_, ddf_); }
#define SC_BODY(R, st) { SC_WAIT(R, 22); sc_write(R, lds + ((st) & 1) * SC_SLOT, lid); { SC_SRC((st) + 3) sc_issue(R, F.ws, delta, dmask, shb_, ddf_); } \
                        asm volatile("s_waitcnt lgkmcnt(0)" ::: "memory"); __builtin_amdgcn_s_barrier(); }
#pragma unroll 1
        for (int s0 = 0; s0 < 126; s0 += 3) { SC_BODY(R0, s0) SC_BODY(R1, s0 + 1) SC_BODY(R2, s0 + 2) }
        SC_BODY(R0, 126) SC_BODY(R1, 127)
        SC_WAIT(R0, 0); SC_WAIT(R1, 0); SC_WAIT(R2, 0);
#undef SC_BODY
#undef SC_SRC
        return;
    }
    bf16* Odir = (bf16*)((unsigned char*)F.out + (dir == 0 ? DO_OF : DO_OB));
    f32x4 S[8];
#pragma unroll
    for (int i = 0; i < 8; ++i) S[i] = (f32x4){0.f, 0.f, 0.f, 0.f};
    bf16x8 Sb[4];
#pragma unroll
    for (int i = 0; i < 4; ++i) Sb[i] = (bf16x8){0, 0, 0, 0, 0, 0, 0, 0};
#pragma unroll 1
    for (int step = 0; step < 128; ++step) {
        __builtin_amdgcn_s_barrier();
        asm volatile("" ::: "memory");
        const int n = dir == 0 ? step : 127 - step;
        const LAS unsigned char* rsh = lds + (step & 1) * SC_SLOT;
        const LAS unsigned char* rd = rsh + SC_D;
        const LAS float* vec = (const LAS float*)(rd + GD_VEC);
        f32x4 eG[4], ks[4];
#pragma unroll
        for (int m = 0; m < 4; ++m) { eG[m] = *(const LAS f32x4*)(vec + 16 * m + 4 * g); ks[m] = *(const LAS f32x4*)(vec + 64 + 16 * m + 4 * g); }
        const float dch = vec[128];
        f32x4 KS[4];
#pragma unroll
        for (int m = 0; m < 4; ++m) { KS[m] = (f32x4){0.f, 0.f, 0.f, 0.f}; const LAS unsigned char* ap = rsh + G_KNP + (16 * m + n16) * 272 + g * 16;
#pragma unroll
            for (int i = 0; i < 4; ++i) KS[m] = __builtin_amdgcn_mfma_f32_16x16x32_bf16(*(const LAS bf16x8*)(ap + i * 64), Sb[i], KS[m], 0, 0, 0); }
        f32x4 rr[4];
#pragma unroll
        for (int m = 0; m < 4; ++m) { const v2u vv = *(const LAS v2u*)(rsh + SC_VCT + n16 * 144 + (16 * m + 4 * g) * 2);
            rr[m][0] = bflo(vv.x) - eG[m][0] * KS[m][0]; rr[m][1] = bfhi(vv.x) - eG[m][1] * KS[m][1]; rr[m][2] = bflo(vv.y) - eG[m][2] * KS[m][2]; rr[m][3] = bfhi(vv.y) - eG[m][3] * KS[m][3]; }
        bf16x8 rb[2]; rb[0] = pack8(rr[0], rr[1]); rb[1] = pack8(rr[2], rr[3]);
        f32x4 vn[4];
#pragma unroll
        for (int m = 0; m < 4; ++m) { vn[m] = (f32x4){0.f, 0.f, 0.f, 0.f}; const LAS unsigned char* ap = rd + GD_TBP + (16 * m + n16) * 144 + g * 16;
#pragma unroll
            for (int i = 0; i < 2; ++i) vn[m] = __builtin_amdgcn_mfma_f32_16x16x32_bf16(*(const LAS bf16x8*)(ap + i * 64), rb[i], vn[m], 0, 0, 0); }
        bf16x8 vnb[2]; vnb[0] = pack8(vn[0], vn[1]); vnb[1] = pack8(vn[2], vn[3]);
        f32x4 o[4];
#pragma unroll
        for (int m = 0; m < 4; ++m) { o[m] = (f32x4){0.f, 0.f, 0.f, 0.f}; const LAS unsigned char* ap = rsh + G_QNP + (16 * m + n16) * 272 + g * 16;
#pragma unroll
            for (int i = 0; i < 4; ++i) o[m] = __builtin_amdgcn_mfma_f32_16x16x32_bf16(*(const LAS bf16x8*)(ap + i * 64), Sb[i], o[m], 0, 0, 0);
            o[m] = o[m] * eG[m];
            const LAS unsigned char* aq = rd + GD_AP + (16 * m + n16) * 144 + g * 16;
#pragma unroll
            for (int i = 0; i < 2; ++i) o[m] = __builtin_amdgcn_mfma_f32_16x16x32_bf16(*(const LAS bf16x8*)(aq + i * 64), vnb[i], o[m], 0, 0, 0); }
        bf16x8 vs[2]; vs[0] = pack8(vn[0] * ks[0], vn[1] * ks[1]); vs[1] = pack8(vn[2] * ks[2], vn[3] * ks[3]);
#pragma unroll
        for (int jt = 0; jt < 8; ++jt) { S[jt] = S[jt] * dch; const LAS unsigned char* ap = rsh + G_KNTP + (16 * jt + n16) * 144 + g * 16;
#pragma unroll
            for (int i = 0; i < 2; ++i) S[jt] = __builtin_amdgcn_mfma_f32_16x16x32_bf16(*(const LAS bf16x8*)(ap + i * 64), vs[i], S[jt], 0, 0, 0); }
#pragma unroll
        for (int i = 0; i < 4; ++i) Sb[i] = pack8(S[2 * i], S[2 * i + 1]);
        asm volatile("s_waitcnt lgkmcnt(0)" ::: "memory");
        bf16* op = Odir + (size_t)(b * SEQ + n * 64) * 512 + h * 128 + 16 * e + n16;
#pragma unroll
        for (int m = 0; m < 4; ++m)
#pragma unroll
            for (int r = 0; r < 4; ++r) op[(size_t)(16 * m + 4 * g + r) * 512] = (bf16)f2bf(o[m][r]);
    }
}

DI void p5_combine(Frame& F) {
    const int gw = F.vcu * NWAVES + F.wave, NGW = F.G * NWAVES, lane = F.lane;
    const bf16* OFp = (const bf16*)((unsigned char*)F.out + DO_OF); const bf16* OBp = (const bf16*)((unsigned char*)F.out + DO_OB);
    const bf16* ZA = (const bf16*)(F.ws + WS_ZA); bf16* OCAT = (bf16*)(F.ws + WS_OCAT);
    const float* nw = F.in[6] + (lane & 15) * 8;
    float w8[8];
#pragma unroll
    for (int c = 0; c < 8; ++c) w8[c] = nw[c];
    for (int t = gw; t < TT; t += NGW) {
        const v4u a = *(const v4u*)(OFp + (size_t)t * 512 + lane * 8), bb = *(const v4u*)(OBp + (size_t)t * 512 + lane * 8), z = *(const v4u*)(ZA + (size_t)t * 512 + lane * 8);
        float o[8] = {bflo(a.x) + bflo(bb.x), bfhi(a.x) + bfhi(bb.x), bflo(a.y) + bflo(bb.y), bfhi(a.y) + bfhi(bb.y), bflo(a.z) + bflo(bb.z), bfhi(a.z) + bfhi(bb.z), bflo(a.w) + bflo(bb.w), bfhi(a.w) + bfhi(bb.w)};
        const float zz[8] = {bflo(z.x), bfhi(z.x), bflo(z.y), bfhi(z.y), bflo(z.z), bfhi(z.z), bflo(z.w), bfhi(z.w)};
        float ss = 0.f;
#pragma unroll
        for (int c = 0; c < 8; ++c) ss += o[c] * o[c];
        ss += __shfl_xor(ss, 1); ss += __shfl_xor(ss, 2); ss += __shfl_xor(ss, 4); ss += __shfl_xor(ss, 8);
        const float rn = 1.0f / sqrtf(ss * (1.f / 128.f) + EPS);
#pragma unroll
        for (int c = 0; c < 8; ++c) o[c] = o[c] * rn * w8[c] * siluf(zz[c]);
        v4u r; r.x = pk2(o[0], o[1]); r.y = pk2(o[2], o[3]); r.z = pk2(o[4], o[5]); r.w = pk2(o[6], o[7]);
        *(v4u*)(OCAT + (size_t)t * 1024 + lane * 8) = r;
    }
}
DI void p5_moe_weights(Frame& F) {
    LAS float* scr = (LAS float*)(F.lds + F.wave * 16384);
    const int gw = F.vcu * NWAVES + F.wave, NGW = F.G * NWAVES;
    bf16* WGU = (bf16*)(F.ws + WS_WGU); bf16* WD = (bf16*)(F.ws + WS_WD);
    constexpr int IG = 16 * 16, ID = 8 * 32, IPE = 2 * IG + ID;
    for (int it = gw; it < NEXP * IPE; it += NGW) {
        const int e = it / IPE; int r = it % IPE;
        if (r < IG) { p0_transpose_item(F.in[13] + (size_t)e * 1024 * 512, 512, 16, WGU + (size_t)e * 1024 * 1024, 1024, 0, 2, scr, r, F.lane); continue; } r -= IG;
        if (r < IG) { p0_transpose_item(F.in[14] + (size_t)e * 1024 * 512, 512, 16, WGU + (size_t)e * 1024 * 1024, 1024, 1, 2, scr, r, F.lane); continue; } r -= IG;
        p0_transpose_item(F.in[15] + (size_t)e * 512 * 1024, 1024, 32, WD + (size_t)e * 1024 * 512, 512, 0, 1, scr, r, F.lane);
    }
}

struct TokRec { int e[2]; int row[2]; float gate[2]; };
DI void p7_route(Frame& F) {
    const int gw = F.vcu * NWAVES + F.wave, NGW = F.G * NWAVES, lane = F.lane, n16 = lane & 15, g = lane >> 4;
    const float* X1 = F.out; const float* nfw = F.in[10];
    const bf16* WRH = (const bf16*)(F.ws + WS_WR); const bf16* WRL = WRH + 48 * 1024;
    bf16* HN = (bf16*)(F.ws + WS_HN); TokRec* TOK = (TokRec*)(F.ws + WS_TOK); unsigned* cnt = (unsigned*)(F.ws + WS_CTL) + CW_CNT;
    LAS float* lg = (LAS float*)(F.lds + F.wave * 4096);
    for (int rt = gw; rt < TT / 16; rt += NGW) {
        const int row = rt * 16 + n16; const float* xr = X1 + (size_t)row * DMODEL + 8 * g;
        float ss = 0.f;
        for (int i = 0; i < 32; ++i) { const f32x4 a = *(const f32x4*)(xr + 32 * i), b2 = *(const f32x4*)(xr + 32 * i + 4);
            ss += (a.x * a.x + a.y * a.y) + (a.z * a.z + a.w * a.w) + (b2.x * b2.x + b2.y * b2.y) + (b2.z * b2.z + b2.w * b2.w); }
        ss += __shfl_xor(ss, 16); ss += __shfl_xor(ss, 32);
        const float rs = 1.0f / sqrtf(ss * (1.f / DMODEL) + EPS);
        f32x4 acc[3];
#pragma unroll
        for (int q = 0; q < 3; ++q) acc[q] = (f32x4){0.f, 0.f, 0.f, 0.f};
        for (int i = 0; i < 32; ++i) {
            const f32x4 a = *(const f32x4*)(xr + 32 * i), b2 = *(const f32x4*)(xr + 32 * i + 4);
            const f32x4 wa = *(const f32x4*)(nfw + 32 * i + 8 * g), wb = *(const f32x4*)(nfw + 32 * i + 8 * g + 4);
            float hv[8] = {a.x * rs * wa.x, a.y * rs * wa.y, a.z * rs * wa.z, a.w * rs * wa.w, b2.x * rs * wb.x, b2.y * rs * wb.y, b2.z * rs * wb.z, b2.w * rs * wb.w};
            v4u hi, lo; unsigned hh[8], ll[8];
#pragma unroll
            for (int c = 0; c < 8; ++c) { hh[c] = f2bf(hv[c]); ll[c] = f2bf(hv[c] - __builtin_bit_cast(float, hh[c] << 16)); }
            hi.x = hh[0] | (hh[1] << 16); hi.y = hh[2] | (hh[3] << 16); hi.z = hh[4] | (hh[5] << 16); hi.w = hh[6] | (hh[7] << 16);
            lo.x = ll[0] | (ll[1] << 16); lo.y = ll[2] | (ll[3] << 16); lo.z = ll[4] | (ll[5] << 16); lo.w = ll[6] | (ll[7] << 16);
            *(v4u*)(HN + (size_t)row * DMODEL + 32 * i + 8 * g) = hi;
            const bf16x8 ah = __builtin_bit_cast(bf16x8, hi), al = __builtin_bit_cast(bf16x8, lo);
#pragma unroll
            for (int q = 0; q < 3; ++q) {
                const bf16x8 bh = *(const bf16x8*)(WRH + (size_t)(16 * q + n16) * 1024 + 32 * i + 8 * g), bl = *(const bf16x8*)(WRL + (size_t)(16 * q + n16) * 1024 + 32 * i + 8 * g);
                acc[q] = __builtin_amdgcn_mfma_f32_16x16x32_bf16(ah, bh, acc[q], 0, 0, 0);
                acc[q] = __builtin_amdgcn_mfma_f32_16x16x32_bf16(ah, bl, acc[q], 0, 0, 0);
                acc[q] = __builtin_amdgcn_mfma_f32_16x16x32_bf16(al, bh, acc[q], 0, 0, 0);
            }
        }
#pragma unroll
        for (int q = 0; q < 3; ++q)
#pragma unroll
            for (int r = 0; r < 4; ++r) lg[(4 * g + r) * 48 + 16 * q + n16] = acc[q][r];
        asm volatile("s_waitcnt lgkmcnt(0)" ::: "memory");
        if (lane < 16) {
            const LAS float* L = lg + lane * 48; const int tok = rt * 16 + lane;
            float gm = L[0]; int gs = 0;
#pragma unroll
            for (int q = 1; q < 4; ++q) if (L[q] > gm) { gm = L[q]; gs = q; }
            float gsum = 0.f;
#pragma unroll
            for (int q = 0; q < 4; ++q) gsum += __expf(L[q] - gm);
            const float gp_top = 1.0f / gsum;
            float fv[8];
#pragma unroll
            for (int q = 0; q < 8; ++q) { float v = L[4 + q]; v = (gs == 1) ? L[12 + q] : v; v = (gs == 2) ? L[20 + q] : v; v = (gs == 3) ? L[28 + q] : v; fv[q] = v; }
            float m1 = fv[0]; int i1 = 0;
#pragma unroll
            for (int q = 1; q < 8; ++q) if (fv[q] > m1) { m1 = fv[q]; i1 = q; }
            float m2 = -3.0e38f; int i2 = 0;
#pragma unroll
            for (int q = 0; q < 8; ++q) if (q != i1 && fv[q] > m2) { m2 = fv[q]; i2 = q; }
            const float e2 = __expf(m2 - m1); const float g1 = gp_top / (1.0f + e2), g2 = gp_top * e2 / (1.0f + e2);
            const int ex1 = gs * 8 + i1, ex2 = gs * 8 + i2;
            const int s1 = (int)atomicAdd(cnt + ex1, 1u), s2 = (int)atomicAdd(cnt + ex2, 1u);
            TokRec tr; tr.e[0] = ex1; tr.e[1] = ex2; tr.row[0] = s1; tr.row[1] = s2; tr.gate[0] = g1; tr.gate[1] = g2;
            TOK[tok] = tr;
        }
        asm volatile("s_waitcnt lgkmcnt(0)" ::: "memory");
    }
}

DI void p8_gather(Frame& F) {
    const int gw = F.vcu * NWAVES + F.wave, NGW = F.G * NWAVES, lane = F.lane;
    unsigned* ctl = (unsigned*)(F.ws + WS_CTL);
    LAS int* pst = (LAS int*)(F.lds);
    if (F.tid == 0) {
        int acc = 0, nt = 0;
        for (int e = 0; e < NEXP; ++e) { const int c = (int)__hip_atomic_load(ctl + CW_CNT + e, __ATOMIC_RELAXED, __HIP_MEMORY_SCOPE_AGENT); pst[e] = acc; const int ntile = (c + 255) >> 8;
            if (blockIdx.x == 0) for (int q = 0; q < ntile; ++q) { ctl[CW_TILES + 2 * (nt + q)] = (unsigned)((acc >> 8) + q); ctl[CW_TILES + 2 * (nt + q) + 1] = (unsigned)e; }
            nt += ntile; acc += ntile * 256; }
        if (blockIdx.x == 0) ctl[CW_NTILE] = (unsigned)nt;
    }
    __syncthreads();
    const bf16* HN = (const bf16*)(F.ws + WS_HN); bf16* XB = (bf16*)(F.ws + WS_XBUF); TokRec* TOK = (TokRec*)(F.ws + WS_TOK);
    for (int t = gw; t < TT; t += NGW) {
        TokRec tr = TOK[t];
        const int r0 = pst[tr.e[0]] + tr.row[0], r1 = pst[tr.e[1]] + tr.row[1];
        const v4u a = *(const v4u*)(HN + (size_t)t * DMODEL + lane * 8), b2 = *(const v4u*)(HN + (size_t)t * DMODEL + 512 + lane * 8);
        *(v4u*)(XB + (size_t)r0 * DMODEL + lane * 8) = a; *(v4u*)(XB + (size_t)r0 * DMODEL + 512 + lane * 8) = b2;
        *(v4u*)(XB + (size_t)r1 * DMODEL + lane * 8) = a; *(v4u*)(XB + (size_t)r1 * DMODEL + 512 + lane * 8) = b2;
        if (lane == 0) { TOK[t].row[0] = r0; TOK[t].row[1] = r1; }
    }
}

DI void p11_final(Frame& F) {
    const int gw = F.vcu * NWAVES + F.wave, NGW = F.G * NWAVES, lane = F.lane;
    const bf16* Y = (const bf16*)(F.ws + WS_XBUF); const TokRec* TOK = (const TokRec*)(F.ws + WS_TOK); const float* fw = F.in[16];
    for (int t = gw; t < TT; t += NGW) {
        const TokRec tr = TOK[t];
        float* xr = F.out + (size_t)t * DMODEL + lane * 8;
        const f32x4 a = *(const f32x4*)(xr), b2 = *(const f32x4*)(xr + 4), c = *(const f32x4*)(xr + 512), d = *(const f32x4*)(xr + 516);
        float v[16] = {a.x, a.y, a.z, a.w, b2.x, b2.y, b2.z, b2.w, c.x, c.y, c.z, c.w, d.x, d.y, d.z, d.w};
#pragma unroll
        for (int k = 0; k < 2; ++k) {
            const float gk = tr.gate[k]; const bf16* yr = Y + (size_t)tr.row[k] * DMODEL + lane * 8;
            const v4u y0 = *(const v4u*)(yr), y1 = *(const v4u*)(yr + 512);
            v[0] += gk * bflo(y0.x); v[1] += gk * bfhi(y0.x); v[2] += gk * bflo(y0.y); v[3] += gk * bfhi(y0.y); v[4] += gk * bflo(y0.z); v[5] += gk * bfhi(y0.z); v[6] += gk * bflo(y0.w); v[7] += gk * bfhi(y0.w);
            v[8] += gk * bflo(y1.x); v[9] += gk * bfhi(y1.x); v[10] += gk * bflo(y1.y); v[11] += gk * bfhi(y1.y); v[12] += gk * bflo(y1.z); v[13] += gk * bfhi(y1.z); v[14] += gk * bflo(y1.w); v[15] += gk * bfhi(y1.w);
        }
        float ss = 0.f;
#pragma unroll
        for (int i = 0; i < 16; ++i) ss += v[i] * v[i];
        const float rs = 1.0f / sqrtf(wave_sum(ss) * (1.f / DMODEL) + EPS);
        const f32x4 w0 = *(const f32x4*)(fw + lane * 8), w1 = *(const f32x4*)(fw + lane * 8 + 4), w2 = *(const f32x4*)(fw + 512 + lane * 8), w3 = *(const f32x4*)(fw + 516 + lane * 8);
        *(f32x4*)(xr) = (f32x4){v[0] * rs * w0.x, v[1] * rs * w0.y, v[2] * rs * w0.z, v[3] * rs * w0.w};
        *(f32x4*)(xr + 4) = (f32x4){v[4] * rs * w1.x, v[5] * rs * w1.y, v[6] * rs * w1.z, v[7] * rs * w1.w};
        *(f32x4*)(xr + 512) = (f32x4){v[8] * rs * w2.x, v[9] * rs * w2.y, v[10] * rs * w2.z, v[11] * rs * w2.w};
        *(f32x4*)(xr + 516) = (f32x4){v[12] * rs * w3.x, v[13] * rs * w3.y, v[14] * rs * w3.z, v[15] * rs * w3.w};
    }
}

struct Args { const float* in[17]; float* out; unsigned char* ws; int ph_lo, ph_hi; };
__global__ void __launch_bounds__(NTHREADS, 2) fwd_kernel(Args args) {
    extern __shared__ __attribute__((aligned(16))) unsigned char lds[];
    cg::grid_group grid = cg::this_grid();
    Frame F;
    F.lds = (LAS unsigned char*)lds; F.tid = threadIdx.x; F.lane = F.tid & 63; F.wave = __builtin_amdgcn_readfirstlane(F.tid >> 6);
    F.G = gridDim.x; { const int bx = blockIdx.x; F.vcu = (F.G % 8 == 0) ? (bx % 8) * (F.G / 8) + bx / 8 : bx; }
#pragma unroll
    for (int i = 0; i < 17; ++i) F.in[i] = args.in[i];
    F.out = args.out; F.ws = args.ws;
    const int lo = args.ph_lo, hi = args.ph_hi;
#ifndef PHSEL
#define PHSEL 0xfff
#endif
#define IN(k) (((PHSEL >> (k)) & 1) && lo <= (k) && (k) < hi)
#define SEAM(k) do { if (IN(k) && IN((k) + 1)) grid.sync(); } while (0)
    if (IN(0)) { p0_prologue(F); } SEAM(0);
    if (IN(1)) {
        pg8::Gemm gm{(const pg8::bf16_t*)(F.ws + WS_XN), (const pg8::bf16_t*)(F.ws + WS_WIN), TT, NPROJ, DMODEL}; pg8::StaticOrder S; S.init(TT, NPROJ, F.G, (int)blockIdx.x);
        EpiProj E{(bf16*)(F.ws + WS_QKVA), (bf16*)(F.ws + WS_ZA), (bf16*)(F.ws + WS_QKVB), (float*)(F.ws + WS_GATES)};
        pg8::gemm_phase<EpiProj, pg8::StaticOrder, true, true>(F.lds, gm, S, E);
    } SEAM(1);
    if (IN(2)) {
#ifndef NO_ROPE
        p2_rope(F);
#endif
#ifndef NO_PRE
        p2_gdn_pre(F);
#endif
    } SEAM(2);
    if (IN(3)) {
        const attn_body::AttnTensors AT{(const attn_body::bf16*)((unsigned char*)F.out + DO_QR), (const attn_body::bf16*)((unsigned char*)F.out + DO_KR), (const attn_body::bf16*)((unsigned char*)F.out + DO_VR),
                                        (attn_body::bf16*)(F.ws + WS_OCAT) + 512};
        const attn_body::StaticOrder S((int)F.G, (int)blockIdx.x);
#ifdef PROBE_ZERO_ATTN
        { (void)AT; (void)S; bf16* OC = (bf16*)(F.ws + WS_OCAT); const int gt = blockIdx.x * NTHREADS + F.tid, GT = F.G * NTHREADS;
          for (int i = gt; i < TT * 64; i += GT) { const int t = i >> 6, c = i & 63; *(v4u*)(OC + (size_t)t * 1024 + 512 + c * 8) = (v4u){0u, 0u, 0u, 0u}; } }
#else
        attn_body::attn_phase<attn_body::StaticOrder>((char*)lds, AT, S);
#endif
    } SEAM(3);
    if (IN(4)) { p4_scan(F); } SEAM(4);
    if (IN(5)) { p5_combine(F); p5_moe_weights(F); } SEAM(5);
    if (IN(6)) {
        pg8::Gemm gm{(const pg8::bf16_t*)(F.ws + WS_OCAT), (const pg8::bf16_t*)(F.ws + WS_WOUT), TT, DMODEL, DMODEL}; pg8::StaticOrder S; S.init(TT, DMODEL, F.G, (int)blockIdx.x);
        EpiResid E{F.in[0], F.out};
        pg8::gemm_phase<EpiResid, pg8::StaticOrder, true, true>(F.lds, gm, S, E);
    } SEAM(6);
    if (IN(7)) { p7_route(F); } SEAM(7);
    if (IN(8)) { p8_gather(F); } SEAM(8);
    if (IN(9)) {
        pg8::Gemm gm{(const pg8::bf16_t*)(F.ws + WS_XBUF), (const pg8::bf16_t*)(F.ws + WS_WGU), 0, 0, DMODEL}; MoeOrder S{(const unsigned*)(F.ws + WS_CTL), F.G, (int)blockIdx.x};
        EpiGU E{(bf16*)(F.ws + WS_HID)};
        pg8::gemm_phase<EpiGU, MoeOrder, true, true>(F.lds, gm, S, E);
    } SEAM(9);
    if (IN(10)) {
        pg8::Gemm gm{(const pg8::bf16_t*)(F.ws + WS_HID), (const pg8::bf16_t*)(F.ws + WS_WD), 0, 0, FFE}; MoeOrder S{(const unsigned*)(F.ws + WS_CTL), F.G, (int)blockIdx.x};
        EpiY E{(bf16*)(F.ws + WS_XBUF)};
        pg8::gemm_phase<EpiY, MoeOrder, true, true>(F.lds, gm, S, E);
    } SEAM(10);
    if (IN(11)) { p11_final(F); }
#undef IN
#undef SEAM
}

extern "C" void kernel_launch(void* const* d_in, const int* in_sizes, int n_in, void* d_out, int out_size, void* d_ws, size_t ws_size, hipStream_t stream) {
    static int grid = 0;
    if (grid == 0) {
        if (n_in != 17 || out_size != TT * DMODEL || ws_size < WS_END) { fprintf(stderr, "kernel_launch: unexpected problem (n_in %d out %d ws %zu)\n", n_in, out_size, ws_size); grid = -1; return; }
        int dev = 0, cus = 0, per_cu = 0;
        if (hipGetDevice(&dev) != hipSuccess || hipDeviceGetAttribute(&cus, hipDeviceAttributeMultiprocessorCount, dev) != hipSuccess) { grid = -1; return; }
        if (hipFuncSetAttribute((const void*)fwd_kernel, hipFuncAttributeMaxDynamicSharedMemorySize, LDS_BYTES) != hipSuccess) { fprintf(stderr, "hipFuncSetAttribute failed\n"); grid = -1; return; }
        if (hipOccupancyMaxActiveBlocksPerMultiprocessor(&per_cu, (const void*)fwd_kernel, NTHREADS, LDS_BYTES) != hipSuccess || per_cu < 1) { fprintf(stderr, "occupancy query: %d\n", per_cu); grid = -1; return; }
        grid = cus;
    }
    if (grid < 0) return;
    (void)hipMemsetAsync((char*)d_ws + WS_CTL, 0, CTL_ZERO_BYTES, stream);
    Args a{};
    for (int i = 0; i < 17; ++i) a.in[i] = (const float*)d_in[i];
    a.out = (float*)d_out; a.ws = (unsigned char*)d_ws;
#if MK_PER_PHASE
    for (int p = 0; p < N_PHASES; ++p) { a.ph_lo = p; a.ph_hi = p + 1; hipLaunchKernelGGL(fwd_kernel, dim3(grid), dim3(NTHREADS), LDS_BYTES, stream, a); }
#else
    a.ph_lo = 0; a.ph_hi = N_PHASES;
    void* kargs[] = {&a};
    hipError_t e = hipLaunchCooperativeKernel((void*)fwd_kernel, dim3(grid), dim3(NTHREADS), kargs, LDS_BYTES, stream);
    if (e != hipSuccess) fprintf(stderr, "cooperative launch failed: %s (grid %d)\n", hipGetErrorString(e), grid);
#endif
}
```

```cpp
#include <hip/hip_runtime.h>
#include <cstdio>
#include <cstdint>
namespace pg8 {
#define PG8_LAS __attribute__((address_space(3)))
typedef unsigned short bf16_t;
typedef short bf16x8 __attribute__((ext_vector_type(8)));
typedef float f32x4 __attribute__((ext_vector_type(4)));
typedef unsigned u32x4 __attribute__((ext_vector_type(4)));
constexpr int BM = 256, BK = 64, HALF = 128, HTB = HALF * BK * 2  , STAGE_BYTES = 8 * HTB, NXCD = 8, WGM = 8;

__host__ __device__ __forceinline__ int lds_byte(int r, int c) { const int st = (r >> 4) * 2 + (c >> 5), rr = r & 15, cc = c & 31, ob = rr * 64 + cc * 2; return st * 1024 + (ob ^ (((ob >> 9) & 1) << 5)); }
__host__ __device__ __forceinline__ void stage_rc(int b, int& R, int& C) { const int st = b / 1024, sb = b % 1024, swz = sb ^ (((sb >> 9) & 1) << 5); R = (st >> 1) * 16 + swz / 64; C = (st & 1) * 32 + (swz % 64) / 2; }
__host__ __device__ __forceinline__ int perm32(int rho) { const int n = rho >> 4, i = rho & 15; return 8 * (i >> 2) + 4 * n + (i & 3); }

struct Unit { int pm, pn; };
struct Gemm { const bf16_t* A; const bf16_t* Bt; int M, N, K; };

struct StaticOrder {
    int nM, nN, nwg, G, c;
    __host__ __device__ void init(int M, int N, int G_, int c_) { nM = M / BM; nN = N / BM; nwg = nM * nN; G = G_; c = c_; }
    __host__ __device__ bool next(int i, Unit& u) const {
        const long L = (long)i * G + c; if (L >= nwg) return false;
        int wgid = (int)L; { const int q = nwg / NXCD, r = nwg % NXCD, xcd = wgid % NXCD, off = wgid / NXCD; wgid = (xcd < r ? xcd * (q + 1) : r * (q + 1) + (xcd - r) * q) + off; }
        const int nig = WGM * nN, gid = wgid / nig, fm = gid * WGM, gsz = (nM - fm) < WGM ? (nM - fm) : WGM;
        u.pm = fm + ((wgid % nig) % gsz); u.pn = (wgid % nig) / gsz; return true;
    }
    __device__ __forceinline__ void a_ready(const Unit&) const {}
    __device__ __forceinline__ void done(const Unit&) const {}
};

__device__ __forceinline__ unsigned cvt_pk_bf16(float lo, float hi) { unsigned r; asm volatile("v_cvt_pk_bf16_f32 %0, %1, %2" : "=v"(r) : "v"(lo), "v"(hi)); return r; }
typedef float f32x2 __attribute__((ext_vector_type(2)));
template <class Epi, class Sched, bool ALIGN_EPI = false, bool SP2 = false>
__device__ __forceinline__ void gemm_phase(PG8_LAS unsigned char* lds, const Gemm g, const Sched& S, const Epi& E) {
    const int tid = threadIdx.x, wid = __builtin_amdgcn_readfirstlane(tid >> 6), lane = tid & 63, wr = wid >> 2, wc = wid & 3, fr = lane & 15, fq = lane >> 4;
    const int K = g.K, nt = K / BK;
    unsigned voffA[2], voffB[2];
#pragma unroll
    for (int i = 0; i < 2; ++i) { int R, C; stage_rc(tid * 16 + i * 8192, R, C); const int Rb = Epi::PERM ? ((R & ~31) + perm32(R & 31)) : R;
        voffA[i] = (unsigned)(R * K + C) * 2u; voffB[i] = (unsigned)(Rb * K + C) * 2u; }
    const size_t kstep = (size_t)(BK * 2);
    const size_t hstep = (size_t)HALF * K * 2;
    const size_t tstep = 2 * hstep;
    const unsigned ldsw = (unsigned)wid * 1024u;
    const int aoff = lds_byte(wr * 64 + fr, fq * 8), boff = lds_byte(wc * 32 + fr, fq * 8);
#define PG8_SA(b, h) (((b) * 2 + (h)) * HTB)
#define PG8_SB(b, h) ((4 + (b) * 2 + (h)) * HTB)
#define PG8_STAGE(bufoff, gbase, voff) do { _Pragma("unroll") for (int _i = 0; _i < 2; ++_i) \
        __builtin_amdgcn_global_load_lds((const unsigned*)((const char*)(gbase) + (voff)[_i]), (PG8_LAS unsigned*)(lds + (bufoff) + ldsw + _i * 8192), 16, 0, 0); } while (0)
#define PG8_LDA(dst, b, h) do { _Pragma("unroll") for (int m = 0; m < 4; ++m) _Pragma("unroll") for (int k = 0; k < 2; ++k) dst[m][k] = *(const PG8_LAS bf16x8*)(lds + PG8_SA(b, h) + aoff + m * 2048 + k * 1024); } while (0)
#define PG8_LDB(dst, b, h) do { _Pragma("unroll") for (int n = 0; n < 2; ++n) _Pragma("unroll") for (int k = 0; k < 2; ++k) dst[n][k] = *(const PG8_LAS bf16x8*)(lds + PG8_SB(b, h) + boff + n * 2048 + k * 1024); } while (0)
#define PG8_MMA(ai, bj, At, Bt) do { __builtin_amdgcn_s_setprio(1); _Pragma("unroll") for (int m = 0; m < 4; ++m) _Pragma("unroll") for (int n = 0; n < 2; ++n) _Pragma("unroll") for (int k = 0; k < 2; ++k) \
        acc[ai][bj][m][n] = __builtin_amdgcn_mfma_f32_16x16x32_bf16(Bt[n][k], At[m][k], acc[ai][bj][m][n], 0, 0, 0); __builtin_amdgcn_s_setprio(0); } while (0)
#define PG8_WAIT_V(n) asm volatile("s_waitcnt vmcnt(" #n ")" ::: "memory")
#define PG8_WAIT_L(n) asm volatile("s_waitcnt lgkmcnt(" #n ")" ::: "memory")
#define PG8_BAR __builtin_amdgcn_s_barrier()
#define PG8_SCHED __builtin_amdgcn_sched_barrier(0)
    Unit cur, nxt; int ui = 0;
    if (!S.next(0, cur)) return;
    f32x4 acc[2][2][4][2];
#pragma unroll
    for (int a = 0; a < 2; ++a)
#pragma unroll
        for (int b = 0; b < 2; ++b)
#pragma unroll
            for (int m = 0; m < 4; ++m)
#pragma unroll
                for (int n = 0; n < 2; ++n) acc[a][b][m][n] = (f32x4){0.f, 0.f, 0.f, 0.f};
    bf16x8 At[4][2], B0[2][2], B1[2][2];
    const char* cA = (const char*)g.A + (size_t)cur.pm * tstep; const char* cB = (const char*)g.Bt + (size_t)cur.pn * tstep;
    S.a_ready(cur);
    if constexpr (SP2) {
        PG8_STAGE(PG8_SB(0, 0), cB, voffB); PG8_STAGE(PG8_SB(0, 1), cB + hstep, voffB); PG8_STAGE(PG8_SA(0, 0), cA, voffA); PG8_STAGE(PG8_SA(0, 1), cA + hstep, voffA);
        if (wr == 1) PG8_BAR;
        PG8_WAIT_V(2); PG8_BAR;
        PG8_STAGE(PG8_SB(1, 0), cB + kstep, voffB); PG8_STAGE(PG8_SA(1, 0), cA + kstep, voffA); PG8_STAGE(PG8_SB(1, 1), cB + hstep + kstep, voffB);
        PG8_WAIT_V(6); PG8_BAR;
    } else {
        PG8_STAGE(PG8_SB(0, 0), cB, voffB); PG8_STAGE(PG8_SA(0, 0), cA, voffA); PG8_STAGE(PG8_SB(0, 1), cB + hstep, voffB); PG8_STAGE(PG8_SA(0, 1), cA + hstep, voffA);
        if (wr == 1) PG8_BAR;
        PG8_WAIT_V(4); PG8_BAR;
        PG8_STAGE(PG8_SB(1, 0), cB + kstep, voffB); PG8_STAGE(PG8_SA(1, 0), cA + kstep, voffA); PG8_STAGE(PG8_SB(1, 1), cB + hstep + kstep, voffB);
        PG8_WAIT_V(6); PG8_BAR;
    }
    for (;;) {
        const bool has_next = S.next(ui + 1, nxt);
        const char* nA = has_next ? (const char*)g.A + (size_t)nxt.pm * tstep : cA; const char* nB = has_next ? (const char*)g.Bt + (size_t)nxt.pn * tstep : cB;
        for (int t = 0; t < nt; t += 2) {
            const bool last = (t == nt - 2);
            const char* a1 = cA + (size_t)(t + 1) * kstep;
            const char* a2 = last ? nA : cA + (size_t)(t + 2) * kstep; const char* b2 = last ? nB : cB + (size_t)(t + 2) * kstep;
            const char* a3 = a2 + kstep; const char* b3 = b2 + kstep;
            if (last && has_next) S.a_ready(nxt);
            if constexpr (SP2) {
            PG8_LDB(B0, 0, 0); PG8_LDB(B1, 0, 1); PG8_SCHED; PG8_LDA(At, 0, 0); PG8_STAGE(PG8_SA(1, 1), a1 + hstep, voffA);
            PG8_WAIT_V(8); PG8_WAIT_L(0); PG8_BAR; PG8_MMA(0, 0, At, B0); PG8_MMA(0, 1, At, B1); PG8_BAR; PG8_SCHED;
            PG8_LDA(At, 0, 1); PG8_STAGE(PG8_SB(0, 0), b2, voffB); PG8_STAGE(PG8_SB(0, 1), b2 + hstep, voffB); PG8_STAGE(PG8_SA(0, 0), a2, voffA);
            PG8_WAIT_V(8); PG8_WAIT_L(0); PG8_BAR; PG8_MMA(1, 0, At, B0); PG8_MMA(1, 1, At, B1); PG8_BAR; PG8_SCHED;
            PG8_LDB(B0, 1, 0); PG8_LDB(B1, 1, 1); PG8_SCHED; PG8_LDA(At, 1, 0); PG8_STAGE(PG8_SA(0, 1), a2 + hstep, voffA);
            PG8_WAIT_V(8); PG8_WAIT_L(0); PG8_BAR; PG8_MMA(0, 0, At, B0); PG8_MMA(0, 1, At, B1); PG8_BAR; PG8_SCHED;
            PG8_LDA(At, 1, 1); PG8_STAGE(PG8_SB(1, 0), b3, voffB); PG8_STAGE(PG8_SB(1, 1), b3 + hstep, voffB); PG8_STAGE(PG8_SA(1, 0), a3, voffA);
            PG8_WAIT_V(8); PG8_WAIT_L(0); PG8_BAR; PG8_MMA(1, 0, At, B0); PG8_MMA(1, 1, At, B1); PG8_BAR; PG8_SCHED;
            } else {
            PG8_LDB(B0, 0, 0); PG8_SCHED; PG8_LDA(At, 0, 0); PG8_STAGE(PG8_SA(1, 1), a1 + hstep, voffA);
            PG8_WAIT_L(8); PG8_BAR; PG8_WAIT_L(0); PG8_MMA(0, 0, At, B0); PG8_BAR; PG8_SCHED;
            PG8_LDB(B1, 0, 1); PG8_STAGE(PG8_SB(0, 0), b2, voffB);
            PG8_BAR; PG8_WAIT_L(0); PG8_MMA(0, 1, At, B1); PG8_BAR;
            PG8_LDA(At, 0, 1); PG8_STAGE(PG8_SA(0, 0), a2, voffA);
            PG8_BAR; PG8_WAIT_L(0); PG8_MMA(1, 0, At, B0); PG8_BAR; PG8_SCHED;
            PG8_STAGE(PG8_SB(0, 1), b2 + hstep, voffB);
            PG8_WAIT_V(6); PG8_BAR; PG8_MMA(1, 1, At, B1); PG8_BAR;
            PG8_LDB(B0, 1, 0); PG8_SCHED; PG8_LDA(At, 1, 0); PG8_STAGE(PG8_SA(0, 1), a2 + hstep, voffA);
            PG8_WAIT_L(8); PG8_BAR; PG8_WAIT_L(0); PG8_MMA(0, 0, At, B0); PG8_BAR; PG8_SCHED;
            PG8_LDB(B1, 1, 1); PG8_STAGE(PG8_SB(1, 0), b3, voffB);
            PG8_BAR; PG8_WAIT_L(0); PG8_MMA(0, 1, At, B1); PG8_BAR;
            PG8_LDA(At, 1, 1); PG8_STAGE(PG8_SA(1, 0), a3, voffA);
            PG8_BAR; PG8_WAIT_L(0); PG8_MMA(1, 0, At, B0); PG8_BAR; PG8_SCHED;
            PG8_STAGE(PG8_SB(1, 1), b3 + hstep, voffB);
            PG8_WAIT_V(6); PG8_BAR; PG8_MMA(1, 1, At, B1); PG8_BAR;
            }
        }
        if constexpr (ALIGN_EPI) { if (wr == 0) PG8_BAR; }
        if constexpr (!Epi::AFTER_DRAIN) { E(acc, cur, wr, wc, fr, fq); S.done(cur); }
        if (!has_next) break;
#pragma unroll
        for (int a = 0; a < 2; ++a)
#pragma unroll
            for (int b = 0; b < 2; ++b)
#pragma unroll
                for (int m = 0; m < 4; ++m)
#pragma unroll
                    for (int n = 0; n < 2; ++n) acc[a][b][m][n] = (f32x4){0.f, 0.f, 0.f, 0.f};
        cur = nxt; cA = nA; cB = nB; ++ui;
        if constexpr (ALIGN_EPI) { if (wr == 1) PG8_BAR; }
    }
    PG8_WAIT_V(0);
    if constexpr (!ALIGN_EPI) { if (wr == 0) PG8_BAR; }
    PG8_BAR;
    if constexpr (Epi::AFTER_DRAIN) { E.fused(acc, cur, wr, wc, fr, fq, lds, wid, lane); S.done(cur); }
#undef PG8_SA
#undef PG8_SB
#undef PG8_STAGE
#undef PG8_LDA
#undef PG8_LDB
#undef PG8_MMA
#undef PG8_WAIT_V
#undef PG8_WAIT_L
#undef PG8_BAR
#undef PG8_SCHED
}
}
#include <hip/hip_bf16.h>
#include <cmath>
namespace attn_body {
using bf16=__hip_bfloat16;
using bf16x8=__attribute__((ext_vector_type(8)))short;
using s16x4=__attribute__((ext_vector_type(4)))short;
using f32x16=__attribute__((ext_vector_type(16)))float;
using u32x4=__attribute__((ext_vector_type(4)))unsigned;
constexpr int BATCH=2,NHEAD=8,NKVH=2,SEQ=8192,D=64,QP=512,KP=128,OP=1024;
constexpr int NW=8,QBLK=32,QB=QBLK*NW,KVBLK=64,NQB=SEQ/QB;
constexpr int ATTN_UNIT_ROWS=QB;
__device__ __forceinline__ int crow(int r,int hi){return (r&3)+8*(r>>2)+4*hi;}
#define SBAR() __builtin_amdgcn_sched_barrier(0)
__device__ __forceinline__ void cmask(f32x16&p0,f32x16&p1,int jb,int qrel,int hi){
  const float NEG=-INFINITY; int kb=64*jb+4*hi;
  #pragma unroll
  for(int r=0;r<16;++r){int kv=kb+(r&3)+8*(r>>2); if(kv>qrel)p0[r]=NEG; if(kv+32>qrel)p1[r]=NEG;}
}

constexpr int NSLOT=3, SLOTB=8192;
constexpr int LDS_K=0, LDS_V=NSLOT*SLOTB, LDS_WS=2*NSLOT*SLOTB, LDS_OST=LDS_WS+NW*64*4, LDS_BYTES=LDS_OST+NW*4096;
constexpr float C2=0.125f*1.4426950408889634f;
__device__ __forceinline__ void glds16(const void*gsrc,unsigned lds_dst){unsigned keep;
  asm volatile("s_mov_b32 %0, m0\n\ts_mov_b32 m0, %2\n\ts_nop 0\n\tglobal_load_lds_dwordx4 %1, off\n\ts_mov_b32 m0, %0":"=&s"(keep):"v"(gsrc),"s"(lds_dst):"memory");}
__device__ __forceinline__ float max3f(float a,float b,float c){float r;asm("v_max3_f32 %0, %1, %2, %3":"=v"(r):"v"(a),"v"(b),"v"(c));return r;}
__device__ __forceinline__ float max2f(float a,float b){float r;asm("v_max_f32_e32 %0, %1, %2":"=v"(r):"v"(a),"v"(b));return r;}
__device__ __forceinline__ float fadd_s(float a,float b){float r;asm("v_add_f32_e32 %0, %1, %2":"=v"(r):"v"(a),"v"(b));return r;}
__device__ __forceinline__ float fsub_s(float a,float b){float r;asm("v_sub_f32_e32 %0, %1, %2":"=v"(r):"v"(a),"v"(b));return r;}
typedef float f32x2_t __attribute__((ext_vector_type(2))); typedef __bf16 bf16x2_t __attribute__((ext_vector_type(2)));
__device__ __forceinline__ unsigned cvtpk_s(float lo,float hi){f32x2_t v={lo,hi};bf16x2_t b=__builtin_convertvector(v,bf16x2_t);return __builtin_bit_cast(unsigned,b);}
#define WAIT_BAR(N) asm volatile("s_waitcnt vmcnt(" #N ") lgkmcnt(0)\n\ts_barrier":::"memory")

__device__ __forceinline__ void qkt(f32x16&p0,f32x16&p1,const char*Kslot,const bf16x8*qr,const f32x16&negm,int r32,int hi){
  const char*kb=Kslot+hi*1024+r32*16;
  #pragma unroll
  for(int d0=0;d0<4;++d0){
    const bf16x8 b0=*reinterpret_cast<const bf16x8*>(kb+d0*2048);
    const bf16x8 b1=*reinterpret_cast<const bf16x8*>(kb+d0*2048+512);
    if(d0==0){p0=__builtin_amdgcn_mfma_f32_32x32x16_bf16(b0,qr[0],negm,0,0,0);p1=__builtin_amdgcn_mfma_f32_32x32x16_bf16(b1,qr[0],negm,0,0,0);}
    else{p0=__builtin_amdgcn_mfma_f32_32x32x16_bf16(b0,qr[d0],p0,0,0,0);p1=__builtin_amdgcn_mfma_f32_32x32x16_bf16(b1,qr[d0],p1,0,0,0);}}
}
typedef __attribute__((address_space(3))) const char* lds_cptr;
typedef short v4i16_t __attribute__((ext_vector_type(4)));
__device__ __forceinline__ void kload8(bf16x8*kf,lds_cptr kp){
  kf[0]=*(const __attribute__((address_space(3))) bf16x8*)(kp);      kf[1]=*(const __attribute__((address_space(3))) bf16x8*)(kp+512);
  kf[2]=*(const __attribute__((address_space(3))) bf16x8*)(kp+2048); kf[3]=*(const __attribute__((address_space(3))) bf16x8*)(kp+2560);
  kf[4]=*(const __attribute__((address_space(3))) bf16x8*)(kp+4096); kf[5]=*(const __attribute__((address_space(3))) bf16x8*)(kp+4608);
  kf[6]=*(const __attribute__((address_space(3))) bf16x8*)(kp+6144); kf[7]=*(const __attribute__((address_space(3))) bf16x8*)(kp+6656);
}
__device__ __forceinline__ void kload2(bf16x8*kf,lds_cptr kp,int j){ kf[2*j]=*(const __attribute__((address_space(3))) bf16x8*)(kp+j*2048); kf[2*j+1]=*(const __attribute__((address_space(3))) bf16x8*)(kp+j*2048+512); }
__device__ __forceinline__ s16x4 vtr(lds_cptr p){ return __builtin_bit_cast(s16x4,__builtin_amdgcn_ds_read_tr16_b64_v4i16((__attribute__((address_space(3))) v4i16_t*)p)); }
__device__ __forceinline__ float rowmax(const f32x16&p0,const f32x16&p1){
  float a=max3f(p0[0],p0[1],p1[0]),b=max3f(p0[2],p0[3],p1[1]);a=max3f(a,p1[2],p1[3]);
  #pragma unroll
  for(int r=4;r<16;r+=4){a=max3f(a,p0[r],p0[r+1]);b=max3f(b,p0[r+2],p0[r+3]);a=max3f(a,p1[r],p1[r+1]);b=max3f(b,p1[r+2],p1[r+3]);}
  const float m=max2f(a,b);
  auto rr=__builtin_amdgcn_permlane32_swap(__float_as_uint(m),__float_as_uint(m),false,false);
  return max2f(__uint_as_float(rr[0]),__uint_as_float(rr[1]));
}
__device__ __forceinline__ void pv(f32x16*o,int vb,bf16x8 pa0,bf16x8 pa1,bf16x8 pa2,bf16x8 pa3){
  #pragma unroll
  for(int d0=0;d0<2;++d0){s16x4 lo[4],hi[4];
    #pragma unroll
    for(int ks=0;ks<4;++ks){
      asm volatile("ds_read_b64_tr_b16 %0,%1 offset:%c2":"=&v"(lo[ks]):"v"(vb),"i"(d0*4096+ks*1024):"memory");
      asm volatile("ds_read_b64_tr_b16 %0,%1 offset:%c2":"=&v"(hi[ks]):"v"(vb),"i"(d0*4096+ks*1024+512):"memory");}
    asm volatile("s_waitcnt lgkmcnt(0)":::"memory");SBAR();
    #define PK(k) (bf16x8){lo[k][0],lo[k][1],lo[k][2],lo[k][3],hi[k][0],hi[k][1],hi[k][2],hi[k][3]}
    o[d0]=__builtin_amdgcn_mfma_f32_32x32x16_bf16(pa0,PK(0),o[d0],0,0,0);
    o[d0]=__builtin_amdgcn_mfma_f32_32x32x16_bf16(pa1,PK(1),o[d0],0,0,0);
    o[d0]=__builtin_amdgcn_mfma_f32_32x32x16_bf16(pa2,PK(2),o[d0],0,0,0);
    o[d0]=__builtin_amdgcn_mfma_f32_32x32x16_bf16(pa3,PK(3),o[d0],0,0,0);
    #undef PK
  }
}

#ifndef ATTN_STORE16
#define ATTN_STORE16(p,v) (*(u32x4*)(p)=(v))
#endif
template<int THRL> __device__ __forceinline__ void attn_unit(int b,int h,int qb,const bf16*Q,const bf16*__restrict__ K,const bf16*__restrict__ V,bf16*O,char*shm){
  const int tid=threadIdx.x,lane=tid&63,r32=lane&31,hi=lane>>5; const int wid=__builtin_amdgcn_readfirstlane(tid>>6);
  const long rowbase=(long)b*SEQ; const int q0=qb*QB;
  const bf16*Qw=Q+(rowbase+q0+wid*QBLK)*QP+h*D;
  const int hk=h/(NHEAD/NKVH); const bf16*Kh=K+rowbase*KP+hk*D,*Vh=V+rowbase*KP+hk*D;
  const unsigned lds0=(unsigned)(uintptr_t)shm;
  float*wsf=(float*)(shm+LDS_WS)+wid*64;
  const bf16*ksrc=Kh+(long)lane*KP+wid*8;
  const bf16*vsrc=Vh+(long)(16*(wid&3)+(lane>>2))*KP+(wid>>2)*32+(lane&3)*8;
  const unsigned kdst=lds0+LDS_K+wid*1024, vdst=lds0+LDS_V+wid*1024;
  #define DMA_K(t,slot) glds16(ksrc+(long)(t)*KVBLK*KP,(unsigned)__builtin_amdgcn_readfirstlane(kdst+(slot)))
  #define DMA_V(t,slot) glds16(vsrc+(long)(t)*KVBLK*KP,(unsigned)__builtin_amdgcn_readfirstlane(vdst+(slot)))
  const int vb0=(int)(lds0+LDS_V)+((lane>>4)&1)*32+(lane&3)*8+(4*hi+((lane&15)>>2))*64;
  const char*Kbase=shm+LDS_K; bf16x8 kf[8];
  const lds_cptr shm3=(lds_cptr)shm; const lds_cptr kp0=shm3+LDS_K+hi*1024+r32*16; const lds_cptr vp0=shm3+LDS_V+((lane>>4)&1)*32+(lane&3)*8+(4*hi+((lane&15)>>2))*64;
  constexpr int NT=SEQ/KVBLK;
  DMA_K(0,0);DMA_V(0,0);DMA_K(1,SLOTB);
  bf16x8 qr[4];
  #pragma unroll
  for(int d0=0;d0<4;++d0)qr[d0]=*reinterpret_cast<const bf16x8*>(&Qw[(long)r32*QP+d0*16+hi*8]);
  float mhat=0.f,l_reg=0.f;f32x16 o[2];o[0]=f32x16{};o[1]=f32x16{};f32x16 negm=f32x16{};asm volatile("":"+v"(negm));
  const int qrel=wid*QBLK+r32;
  #define CMASK(P0,P1,t) do{}while(0)
  bool resc=false;
  #define START(P0,P1) do{ const float rm=rowmax(P0,P1); resc=false; \
    { const float dl=rm; mhat=fadd_s(mhat,dl); \
      _Pragma("unroll") for(int r=0;r<16;++r){P0[r]=fsub_s(P0[r],dl);P1[r]=fsub_s(P1[r],dl);} \
      _Pragma("unroll") for(int r=0;r<16;++r)negm[r]=-mhat; asm volatile("":"+v"(negm)); } \
    _Pragma("unroll") for(int r=0;r<16;++r)P0[r]=__builtin_amdgcn_exp2f(P0[r]); }while(0)
  #define RESC() do{ if(resc){ asm volatile("s_waitcnt lgkmcnt(0)":::"memory"); \
      _Pragma("unroll") for(int d_=0;d_<2;++d_) _Pragma("unroll") for(int r=0;r<16;++r)o[d_][r]*=wsf[crow(r,hi)]; } }while(0)
  f32x16 pA0,pA1,pB0,pB1;
  int sl_prev=0,sl_cur=0,sl_next=SLOTB;
  #define ROT() do{sl_prev=sl_cur;sl_cur=sl_next;sl_next=(sl_next==(NSLOT-1)*SLOTB)?0:sl_next+SLOTB;}while(0)
  DMA_K(2,2*SLOTB);
  WAIT_BAR(3);
  qkt(pA0,pA1,Kbase,qr,negm,r32,hi);asm volatile("s_nop 15\n\ts_nop 7":"+v"(pA0),"+v"(pA1));CMASK(pA0,pA1,0);
  START(pA0,pA1);
  _Pragma("unroll") for(int r=0;r<16;++r)pA1[r]=__builtin_amdgcn_exp2f(pA1[r]);
  WAIT_BAR(0);
  DMA_K(3,0);DMA_V(1,SLOTB);
  ROT();
  kload8(kf,kp0+sl_cur);
  WAIT_BAR(2);
  s16x4 vlo[8],vhi[8]; u32x4 pw0,pw1,pw2,pw3;
  #define PKW(P,B) cvtpk_s(P[B],P[B+1])
  #define PAF(k) __builtin_bit_cast(bf16x8,pw##k)
  #define VFR(i) (bf16x8){vlo[i][0],vlo[i][1],vlo[i][2],vlo[i][3],vhi[i][0],vhi[i][1],vhi[i][2],vhi[i][3]}
  #define PIN(x) asm volatile("":"+v"(x))
  #define MX3(a,b,c) __builtin_fmaxf(__builtin_fmaxf((a),(b)),(c))
  #define GAPA(MF,A0,A1,A2,A3,W0,W1,PW) do{ MF; sacc+=A0; sacc+=A1; sacc+=A2; sacc+=A3; PIN(sacc); W0; W1; PIN(PW); SBAR(); }while(0)
  #define EX(v) __builtin_amdgcn_exp2f(v)
  #define GAPB(MF,X,B) do{ MF; X[B]=EX(X[B]); X[B+1]=EX(X[B+1]); X[B+2]=EX(X[B+2]); X[B+3]=EX(X[B+3]); PIN(X); SBAR(); }while(0)
  #define VRD(i) do{ vlo[i]=vtr(vp_+(((i)>>2)*4096+((i)&3)*1024)); vhi[i]=vtr(vp_+(((i)>>2)*4096+((i)&3)*1024+512)); }while(0)
  #define KRD(G,j) do{ if(G){ kload2(kf,kp0+sl_next,j); SBAR(); } }while(0)
  #define STEP(C0,C1,P0,P1,t,GK,GV,GL) do{ SBAR(); \
    const lds_cptr vp_=vp0+sl_prev; \
    VRD(0); SBAR(); float sacc=(P0[0]+P0[1]); \
    GAPA(C0=__builtin_amdgcn_mfma_f32_32x32x16_bf16(kf[0],qr[0],negm,0,0,0), P0[2],P0[3],P0[4],P0[5],     pw0[0]=PKW(P0,0), pw0[1]=PKW(P0,2), pw0); \
    VRD(4); SBAR(); GAPA(C1=__builtin_amdgcn_mfma_f32_32x32x16_bf16(kf[1],qr[0],negm,0,0,0), P0[6],P0[7],P0[8],P0[9],     pw0[2]=PKW(P0,4), pw0[3]=PKW(P0,6), pw0); \
    VRD(1); SBAR(); GAPA(C0=__builtin_amdgcn_mfma_f32_32x32x16_bf16(kf[2],qr[1],C0,0,0,0),   P0[10],P0[11],P0[12],P0[13], pw1[0]=PKW(P0,8), pw1[1]=PKW(P0,10), pw1); \
    VRD(5); SBAR(); GAPA(C1=__builtin_amdgcn_mfma_f32_32x32x16_bf16(kf[3],qr[1],C1,0,0,0),   P0[14],P0[15],P1[0],P1[1],   pw1[2]=PKW(P0,12),pw1[3]=PKW(P0,14), pw1); \
    VRD(2); SBAR(); GAPA(C0=__builtin_amdgcn_mfma_f32_32x32x16_bf16(kf[4],qr[2],C0,0,0,0),   P1[2],P1[3],P1[4],P1[5],     pw2[0]=PKW(P1,0), pw2[1]=PKW(P1,2), pw2); \
    VRD(6); SBAR(); GAPA(C1=__builtin_amdgcn_mfma_f32_32x32x16_bf16(kf[5],qr[2],C1,0,0,0),   P1[6],P1[7],P1[8],P1[9],     pw2[2]=PKW(P1,4), pw2[3]=PKW(P1,6), pw2); \
    VRD(3); SBAR(); GAPA(C0=__builtin_amdgcn_mfma_f32_32x32x16_bf16(kf[6],qr[3],C0,0,0,0),   P1[10],P1[11],P1[12],P1[13], pw3[0]=PKW(P1,8), pw3[1]=PKW(P1,10), pw3); \
    VRD(7); SBAR(); GAPA(C1=__builtin_amdgcn_mfma_f32_32x32x16_bf16(kf[7],qr[3],C1,0,0,0),   P1[14],P1[15],0.f,0.f,       pw3[2]=PKW(P1,12),pw3[3]=PKW(P1,14), pw3); \
    l_reg+=sacc; \
    if(GK){DMA_K((t)+3,sl_cur);} if(GV){DMA_V((t)+1,sl_next);} \
    CMASK(C0,C1,t); \
    { float a=MX3(C0[0],C0[1],C1[0]),b=MX3(C0[2],C0[3],C1[1]); a=MX3(a,C1[2],C1[3]); \
      _Pragma("unroll") for(int r=4;r<16;r+=4){a=MX3(a,C0[r],C0[r+1]);b=MX3(b,C0[r+2],C0[r+3]);a=MX3(a,C1[r],C1[r+1]);b=MX3(b,C1[r+2],C1[r+3]);} \
      float rm=__builtin_fmaxf(a,b); { auto rr=__builtin_amdgcn_permlane32_swap(__float_as_uint(rm),__float_as_uint(rm),false,false); rm=__builtin_fmaxf(__uint_as_float(rr[0]),__uint_as_float(rr[1])); } \
      resc=false; \
      if(__builtin_expect(__any(rm>(float)THRL),0)){ const float dl=__builtin_fmaxf(rm,0.f); mhat+=dl; \
        _Pragma("unroll") for(int r=0;r<16;++r){C0[r]-=dl;C1[r]-=dl;} \
        _Pragma("unroll") for(int r=0;r<16;++r)negm[r]=-mhat; asm volatile("":"+v"(negm)); \
        const float f=__builtin_amdgcn_exp2f(-dl); l_reg*=f; if(hi==0)wsf[r32]=f; resc=true; } } \
    SBAR(); \
    GAPB(o[0]=__builtin_amdgcn_mfma_f32_32x32x16_bf16(PAF(0),VFR(0),o[0],0,0,0), C0,0); \
    GAPB(o[1]=__builtin_amdgcn_mfma_f32_32x32x16_bf16(PAF(0),VFR(4),o[1],0,0,0), C0,4); \
    KRD(GL,0); GAPB(o[0]=__builtin_amdgcn_mfma_f32_32x32x16_bf16(PAF(1),VFR(1),o[0],0,0,0), C0,8); \
    KRD(GL,1); GAPB(o[1]=__builtin_amdgcn_mfma_f32_32x32x16_bf16(PAF(1),VFR(5),o[1],0,0,0), C0,12); \
    KRD(GL,2); GAPB(o[0]=__builtin_amdgcn_mfma_f32_32x32x16_bf16(PAF(2),VFR(2),o[0],0,0,0), C1,0); \
    KRD(GL,3); GAPB(o[1]=__builtin_amdgcn_mfma_f32_32x32x16_bf16(PAF(2),VFR(6),o[1],0,0,0), C1,4); \
    GAPB(o[0]=__builtin_amdgcn_mfma_f32_32x32x16_bf16(PAF(3),VFR(3),o[0],0,0,0), C1,8); \
    GAPB(o[1]=__builtin_amdgcn_mfma_f32_32x32x16_bf16(PAF(3),VFR(7),o[1],0,0,0), C1,12); \
    }while(0)
  int t=1;
  #undef CMASK
  #define CMASK(P0,P1,t) do{}while(0)
  for(;t+5<NT;t+=2){
    STEP(pB0,pB1,pA0,pA1,t,true,true,true);     WAIT_BAR(2); RESC(); ROT();
    STEP(pA0,pA1,pB0,pB1,t+1,true,true,true);   WAIT_BAR(2); RESC(); ROT();
  }
  #undef CMASK
  #define CMASK(P0,P1,t) do{}while(0)
  #define ENDW(tt) do{ if((tt)+3<NT){WAIT_BAR(2);} else if((tt)+2<NT){WAIT_BAR(1);} else {WAIT_BAR(0);} }while(0)
  for(;t+1<NT;t+=2){
    STEP(pB0,pB1,pA0,pA1,t,(t+3<NT),(t+1<NT),(t+1<NT));       ENDW(t);   RESC(); ROT();
    STEP(pA0,pA1,pB0,pB1,t+1,(t+4<NT),(t+2<NT),(t+2<NT));     ENDW(t+1); RESC(); ROT();
  }
  STEP(pB0,pB1,pA0,pA1,NT-1,false,false,false); RESC();
  { float sacc=pB0[0]+pB0[1]; _Pragma("unroll") for(int r=2;r<16;++r)sacc+=pB0[r]; _Pragma("unroll") for(int r=0;r<16;++r)sacc+=pB1[r]; l_reg+=sacc;
    pw0=(u32x4){PKW(pB0,0),PKW(pB0,2),PKW(pB0,4),PKW(pB0,6)};pw1=(u32x4){PKW(pB0,8),PKW(pB0,10),PKW(pB0,12),PKW(pB0,14)};pw2=(u32x4){PKW(pB1,0),PKW(pB1,2),PKW(pB1,4),PKW(pB1,6)};pw3=(u32x4){PKW(pB1,8),PKW(pB1,10),PKW(pB1,12),PKW(pB1,14)};
    SBAR(); pv(o,vb0+sl_cur,PAF(0),PAF(1),PAF(2),PAF(3)); }
  #undef PKW
  #undef PAF
  #undef VFR
  #undef PIN
  #undef MX3
  #undef GAPA
  #undef GAPB
  #undef EX
  #undef VRD
  #undef KRD
  #undef STEP
  #undef ENDW
  {auto rr=__builtin_amdgcn_permlane32_swap(__float_as_uint(l_reg),__float_as_uint(l_reg),false,false);l_reg=__uint_as_float(rr[0])+__uint_as_float(rr[1]);}
  if(hi==0)wsf[32+r32]=l_reg;asm volatile("s_waitcnt lgkmcnt(0)":::"memory");
  float rli[16];
  #pragma unroll
  for(int r=0;r<16;++r)rli[r]=__builtin_amdgcn_rcpf(wsf[32+crow(r,hi)]);
  bf16*Ow=O+(rowbase+q0+wid*QBLK)*OP+h*D;
  { bf16*stg=(bf16*)(shm+LDS_OST)+wid*2048;
    #pragma unroll
    for(int r=0;r<16;++r){const int orow=crow(r,hi);
      #pragma unroll
      for(int d0=0;d0<2;++d0)stg[orow*64+d0*32+r32]=__float2bfloat16(o[d0][r]*rli[r]);}
    asm volatile("s_waitcnt lgkmcnt(0)":::"memory");
    #pragma unroll
    for(int i=0;i<4;++i){const int row=i*8+(lane>>3),ch=lane&7; const u32x4 v=*(const u32x4*)(stg+row*64+ch*8); ATTN_STORE16(Ow+(long)row*OP+ch*8,v);} }
  asm volatile("s_waitcnt lgkmcnt(0)\n\ts_barrier":::"memory");
  #undef DMA_K
  #undef DMA_V
  #undef CMASK
  #undef START
  #undef RESC
  #undef ROT
}
constexpr int ATTN_LDS_BYTES=LDS_BYTES;
struct AttnTensors { const bf16* Q; const bf16* K; const bf16* V; bf16* O; };
struct AttnUnit { int bh; int qb; };
struct StaticOrder {
  int vcu, G;
  __device__ __forceinline__ explicit StaticOrder(int grid,int block):vcu((grid%8==0)?(block%8)*(grid/8)+block/8:block),G(grid){}
  __device__ __forceinline__ bool next(int i,AttnUnit&u)const{
    const int L=i*G+vcu; if(L>=BATCH*NHEAD*NQB)return false;
    if(G==256){ if(i>=2)return false; const int x=vcu>>5,j=vcu&31; const int b=x>>2,kvh=(x>>1)&1,hq=kvh*4+2*(x&1)+i; u.bh=b*NHEAD+hq; u.qb=j; return true; }
    u.bh=L/NQB; u.qb=L%NQB; return true; }
  __device__ __forceinline__ void a_ready(const AttnUnit&)const{}
  __device__ __forceinline__ void done(const AttnUnit&)const{}
};
template<class Sched,int THRL=8> __device__ __forceinline__ void attn_phase(char*lds,const AttnTensors&T,const Sched&S){
  AttnUnit u;
  for(int i=0;S.next(i,u);++i){ S.a_ready(u); attn_unit<THRL>(u.bh/NHEAD,u.bh%NHEAD,u.qb,T.Q,T.K,T.V,T.O,lds); S.done(u); }
}
#undef SBAR
#undef WAIT_BAR
}

#include <hip/hip_cooperative_groups.h>
namespace cg = cooperative_groups;
#ifndef MK_PER_PHASE
#define MK_PER_PHASE 0
#endif
constexpr int NWAVES = 8, NTHREADS = 512;
constexpr int NB = 2, SEQ = 8192, DMODEL = 1024, TT = NB * SEQ;
constexpr int NPROJ = 3072;
constexpr int NEXP = 32, FFE = 512;
constexpr float EPS = 1e-6f;
constexpr int N_PHASES = 12;

constexpr size_t MiB = 1u << 20;
constexpr size_t WS_CTL = 0, CTL_ZERO_BYTES = 64 * 1024;
constexpr size_t WS_WOUT = 1 * MiB;
constexpr size_t WS_WR = 3 * MiB;
constexpr size_t WS_TOK = 3 * MiB + 256 * 1024;
constexpr size_t WS_GATES = 4 * MiB;
constexpr size_t WS_WIN = 5 * MiB;
constexpr size_t WS_A = 11 * MiB;
constexpr size_t WS_XN = WS_A;
constexpr size_t GDN_SH_BYTES = 71680, GDN_D_BYTES = 19456;
constexpr size_t WS_GSH = WS_A;
constexpr size_t WS_GD = WS_A + 1024 * GDN_SH_BYTES;
constexpr size_t WS_WGU = WS_A;
constexpr size_t WS_WD = WS_A + 64 * MiB;
constexpr size_t WS_HID = WS_A + 96 * MiB;
constexpr size_t WS_B = 157 * MiB;
constexpr size_t WS_QKVA = WS_B;
constexpr size_t WS_QKVB = WS_B + 48 * MiB;
constexpr size_t WS_ZA = WS_B + 72 * MiB;
constexpr size_t WS_OCAT = WS_B;
constexpr size_t WS_XBUF = WS_B;
constexpr size_t WS_HN = WS_B + 80 * MiB;
constexpr size_t WS_END = 269 * MiB;
static_assert(WS_GD + 4096 * GDN_D_BYTES <= WS_B, "GDN records fit region A");
static_assert(WS_HID + 40928ull * 1024 <= WS_B, "HID fits region A");
static_assert(WS_HN + 32 * MiB <= WS_END, "HN");
constexpr size_t DO_QR = 0, DO_KR = 16 * MiB, DO_VR = 20 * MiB, DO_OF = 24 * MiB, DO_OB = 40 * MiB;
constexpr int CW_CNT = 64;
constexpr int CW_NTILE = 128;
constexpr int CW_TILES = 192;

constexpr int LDS_BYTES = 160 * 1024;

#define GAS __attribute__((address_space(1)))
#define LAS __attribute__((address_space(3)))
typedef unsigned short bf16;
typedef unsigned v4u __attribute__((ext_vector_type(4)));
typedef unsigned v2u __attribute__((ext_vector_type(2)));
typedef float f32x4 __attribute__((ext_vector_type(4)));
typedef short bf16x8 __attribute__((ext_vector_type(8)));
typedef short s16x4 __attribute__((ext_vector_type(4)));
#define DI __device__ __forceinline__

DI unsigned f2bf(float f) { unsigned u = __builtin_bit_cast(unsigned, f); return (u + 0x7fffu + ((u >> 16) & 1u)) >> 16; }
typedef float f32x2_t __attribute__((ext_vector_type(2))); typedef __bf16 bf16x2_t __attribute__((ext_vector_type(2)));
DI unsigned pk2(float lo, float hi) { f32x2_t v = {lo, hi}; bf16x2_t b = __builtin_convertvector(v, bf16x2_t); return __builtin_bit_cast(unsigned, b); }
DI float bf2f(unsigned short h) { return __builtin_bit_cast(float, (unsigned)h << 16); }
DI float bflo(unsigned w) { return __builtin_bit_cast(float, w << 16); }
DI float bfhi(unsigned w) { return __builtin_bit_cast(float, w & 0xffff0000u); }
DI float wave_sum(float v) {
#pragma unroll
    for (int o = 1; o < 64; o <<= 1) v += __shfl_xor(v, o);
    return v;
}
DI float siluf(float x) { return x * __builtin_amdgcn_rcpf(1.0f + __expf(-x)); }
DI float sigmoidf_(float x) { return 1.0f / (1.0f + __expf(-x)); }
DI int perm32i(int idx) { return ((idx >> 2) & 3) * 8 + (idx >> 4) * 4 + (idx & 3); }
DI int permcol(int c) { return (c & ~31) + perm32i(c & 31); }
template <class T> DI T opaque(T p) { asm volatile("" : "+v"(p)); return p; }

struct Frame {
    LAS unsigned char* lds;
    int tid, lane, wave, vcu, G;
    const float* in[17];
    float* out; unsigned char* ws;
};

DI void p0_transpose_item(const float* W, int ldw, int nblk, bf16* WT, int K, int row_off, int rmul, LAS float* scr, int item, int lane) {
    const int kb = item / nblk, nb = item % nblk, k0 = 64 * kb, n0 = 32 * nb;
#pragma unroll 8
    for (int i = 0; i < 32; ++i) { const int kk = 2 * i + (lane >> 5); scr[kk * 33 + (lane & 31)] = W[(size_t)(k0 + kk) * ldw + n0 + (lane & 31)]; }
    asm volatile("s_waitcnt lgkmcnt(0)" ::: "memory");
    const int c = lane & 7;
#pragma unroll
    for (int j = 0; j < 4; ++j) { const int n = (lane >> 3) + 8 * j; const LAS float* s = scr + (8 * c) * 33 + n;
        v4u o; o.x = pk2(s[0 * 33], s[1 * 33]); o.y = pk2(s[2 * 33], s[3 * 33]); o.z = pk2(s[4 * 33], s[5 * 33]); o.w = pk2(s[6 * 33], s[7 * 33]);
        *(GAS v4u*)(WT + (size_t)(row_off + (n0 + n) * rmul) * K + k0 + 8 * c) = o; }
    asm volatile("s_waitcnt lgkmcnt(0)" ::: "memory");
}
DI void rms_row_to_bf16(const float* xrow, const float* w, bf16* orow, int lane) {
    const GAS f32x4* xr = (const GAS f32x4*)xrow + lane; const GAS f32x4* wr = (const GAS f32x4*)w + lane;
    f32x4 v[4]; float s = 0.f;
#pragma unroll
    for (int j = 0; j < 4; ++j) { v[j] = xr[64 * j]; s += (v[j].x * v[j].x + v[j].y * v[j].y) + (v[j].z * v[j].z + v[j].w * v[j].w); }
    const float rs = 1.0f / sqrtf(wave_sum(s) * (1.f / DMODEL) + EPS);
    GAS v2u* o8 = (GAS v2u*)orow + lane;
#pragma unroll
    for (int j = 0; j < 4; ++j) { const f32x4 ww = wr[64 * j]; v2u o; o.x = pk2(v[j].x * rs * ww.x, v[j].y * rs * ww.y); o.y = pk2(v[j].z * rs * ww.z, v[j].w * rs * ww.w); o8[64 * j] = o; }
}
DI void p0_prologue(Frame& F) {
    LAS float* scr = (LAS float*)(F.lds + F.wave * 16384);
    const int gw = F.vcu * NWAVES + F.wave, NGW = F.G * NWAVES;
    const float* w_in = F.in[2]; const float* w_out = F.in[9];
    bf16* WIN = (bf16*)(F.ws + WS_WIN); bf16* WOUT = (bf16*)(F.ws + WS_WOUT);
    constexpr int I1 = 16 * 64, I2 = 16 * 24, I3 = 16, I4 = 16 * 32, NITEMS = I1 + I2 + I3 + I4;
    for (int it = gw; it < NITEMS; it += NGW) {
        int r = it;
        if (r < I1) { p0_transpose_item(w_in, 2832, 64, WIN, 1024, 0, 1, scr, r, F.lane); continue; } r -= I1;
        if (r < I2) { p0_transpose_item(w_in + 2064, 2832, 24, WIN, 1024, 2048, 1, scr, r, F.lane); continue; } r -= I2;
        if (r < I3) { p0_transpose_item(w_in + 2048, 2832, 1, WIN, 1024, 2816, 1, scr, r, F.lane); continue; } r -= I3;
        p0_transpose_item(w_out, 1024, 32, WOUT, 1024, 0, 1, scr, r, F.lane);
    }
    { const int gt = F.vcu * NTHREADS + F.tid, GT = F.G * NTHREADS; GAS v4u* z = (GAS v4u*)(WIN + (size_t)2848 * 1024);
      for (int i = gt; i < 224 * 1024 * 2 / 16; i += GT) z[i] = (v4u){0u, 0u, 0u, 0u}; }
    { const int gt = F.vcu * NTHREADS + F.tid, GT = F.G * NTHREADS; bf16* WRH = (bf16*)(F.ws + WS_WR); bf16* WRL = WRH + 48 * 1024;
      const float* wrg = F.in[11]; const float* wre = F.in[12];
      for (int i = gt; i < 48 * 1024; i += GT) { const int j = i >> 10, k = i & 1023; float v = 0.f; if (j < 4) v = wrg[k * 4 + j]; else if (j < 36) v = wre[k * 32 + (j - 4)];
          const unsigned h = f2bf(v); const float hv = __builtin_bit_cast(float, h << 16); WRH[i] = (bf16)h; WRL[i] = (bf16)f2bf(v - hv); } }
    bf16* XN = (bf16*)(F.ws + WS_XN);
    for (int m = gw; m < TT; m += NGW) rms_row_to_bf16(F.in[0] + (size_t)m * DMODEL, F.in[1], XN + (size_t)m * DMODEL, F.lane);
}

struct EpiProj {
    static constexpr bool PERM = true, AFTER_DRAIN = false;
    bf16 *qkva, *za, *qkvb; float* gates;
    DI void operator()(const pg8::f32x4 (&acc)[2][2][4][2], const pg8::Unit& u, int wr, int wc, int fr, int fq) const {
        const int row0 = u.pm * 256 + wr * 64 + fr;
        if (u.pn == 11) {
            if (wc == 0 && fq < 2) {
#pragma unroll
                for (int ai = 0; ai < 2; ++ai)
#pragma unroll
                    for (int m = 0; m < 4; ++m) { float* rp = gates + (size_t)(row0 + ai * 128 + m * 16) * 16 + 8 * fq;
                        *(pg8::f32x4*)(rp) = acc[ai][0][m][0]; *(pg8::f32x4*)(rp + 4) = acc[ai][0][m][1]; }
            }
            return;
        }
        bf16* base; int ldc, colt;
        if (u.pn < 6) { base = qkva; ldc = 1536; colt = u.pn * 256; } else if (u.pn < 8) { base = za; ldc = 512; colt = (u.pn - 6) * 256; } else { base = qkvb; ldc = 768; colt = (u.pn - 8) * 256; }
        const int col0 = colt + wc * 32 + 8 * fq;
#pragma unroll
        for (int ai = 0; ai < 2; ++ai)
#pragma unroll
            for (int m = 0; m < 4; ++m) { bf16* rowp = base + (size_t)(row0 + ai * 128 + m * 16) * ldc + col0;
#pragma unroll
                for (int bj = 0; bj < 2; ++bj) { const pg8::f32x4 v0 = acc[ai][bj][m][0], v1 = acc[ai][bj][m][1]; pg8::u32x4 w;
                    w.x = pg8::cvt_pk_bf16(v0[0], v0[1]); w.y = pg8::cvt_pk_bf16(v0[2], v0[3]); w.z = pg8::cvt_pk_bf16(v1[0], v1[1]); w.w = pg8::cvt_pk_bf16(v1[2], v1[3]);
                    *(pg8::u32x4*)(rowp + bj * 128) = w; } }
    }
};
struct EpiResid {
    static constexpr bool PERM = false, AFTER_DRAIN = false;
    const float* x; float* x1;
    DI void operator()(const pg8::f32x4 (&acc)[2][2][4][2], const pg8::Unit& u, int wr, int wc, int fr, int fq) const {
        const int row0 = u.pm * 256 + wr * 64 + fr, col0 = u.pn * 256 + wc * 32 + 4 * fq;
#pragma unroll
        for (int ai = 0; ai < 2; ++ai)
#pragma unroll
            for (int m = 0; m < 4; ++m) { const size_t off = (size_t)(row0 + ai * 128 + m * 16) * DMODEL + col0;
#pragma unroll
                for (int bj = 0; bj < 2; ++bj)
#pragma unroll
                    for (int n = 0; n < 2; ++n) { const pg8::f32x4 b = *(const pg8::f32x4*)(x + off + bj * 128 + n * 16); *(pg8::f32x4*)(x1 + off + bj * 128 + n * 16) = b + acc[ai][bj][m][n]; } }
    }
};
struct EpiGU {
    static constexpr bool PERM = true, AFTER_DRAIN = false;
    bf16* hid;
    DI void operator()(const pg8::f32x4 (&acc)[2][2][4][2], const pg8::Unit& u, int wr, int wc, int fr, int fq) const {
        const int row0 = u.pm * 256 + wr * 64 + fr; const int jt = u.pn & 3;
        const int ff0 = jt * 128 + wc * 16 + 4 * fq;
#pragma unroll
        for (int ai = 0; ai < 2; ++ai)
#pragma unroll
            for (int m = 0; m < 4; ++m) { bf16* rowp = hid + (size_t)(row0 + ai * 128 + m * 16) * FFE + ff0;
#pragma unroll
                for (int bj = 0; bj < 2; ++bj) { const pg8::f32x4 v0 = acc[ai][bj][m][0], v1 = acc[ai][bj][m][1];
                    const float h0 = siluf(v0[0]) * v0[1], h1 = siluf(v0[2]) * v0[3], h2 = siluf(v1[0]) * v1[1], h3 = siluf(v1[2]) * v1[3];
                    v2u w; w.x = pg8::cvt_pk_bf16(h0, h1); w.y = pg8::cvt_pk_bf16(h2, h3);
                    *(v2u*)(rowp + bj * 64) = w; } }
    }
};
struct EpiY {
    static constexpr bool PERM = true, AFTER_DRAIN = false;
    bf16* y;
    DI void operator()(const pg8::f32x4 (&acc)[2][2][4][2], const pg8::Unit& u, int wr, int wc, int fr, int fq) const {
        const int row0 = u.pm * 256 + wr * 64 + fr; const int col0 = (u.pn & 3) * 256 + wc * 32 + 8 * fq;
#pragma unroll
        for (int ai = 0; ai < 2; ++ai)
#pragma unroll
            for (int m = 0; m < 4; ++m) { bf16* rowp = y + (size_t)(row0 + ai * 128 + m * 16) * DMODEL + col0;
#pragma unroll
                for (int bj = 0; bj < 2; ++bj) { const pg8::f32x4 v0 = acc[ai][bj][m][0], v1 = acc[ai][bj][m][1]; pg8::u32x4 w;
                    w.x = pg8::cvt_pk_bf16(v0[0], v0[1]); w.y = pg8::cvt_pk_bf16(v0[2], v0[3]); w.z = pg8::cvt_pk_bf16(v1[0], v1[1]); w.w = pg8::cvt_pk_bf16(v1[2], v1[3]);
                    *(pg8::u32x4*)(rowp + bj * 128) = w; } }
    }
};
struct MoeOrder {
    const unsigned* ctl; int G, c;
    DI bool next(int i, pg8::Unit& u) const {
        const int nt = (int)ctl[CW_NTILE]; const int L = i * G + c; if (L >= nt * 4) return false;
        const int t = L >> 2, j = L & 3; u.pm = (int)ctl[CW_TILES + 2 * t]; u.pn = (int)ctl[CW_TILES + 2 * t + 1] * 4 + j; return true; }
    DI void a_ready(const pg8::Unit&) const {}
    DI void done(const pg8::Unit&) const {}
};

DI void p2_rope(Frame& F) {
    const int gw = F.vcu * NWAVES + F.wave, NGW = F.G * NWAVES, lane = F.lane;
    const bf16* QKVB = (const bf16*)(F.ws + WS_QKVB);
    bf16* QR = (bf16*)((unsigned char*)F.out + DO_QR); bf16* KR = (bf16*)((unsigned char*)F.out + DO_KR); bf16* VR = (bf16*)((unsigned char*)F.out + DO_VR);
    const int pi = lane & 31, hsel = lane >> 5;
    const float qw0 = F.in[7][2 * pi], qw1 = F.in[7][2 * pi + 1], kw0 = F.in[8][2 * pi], kw1 = F.in[8][2 * pi + 1];
    const float invf = exp2f(-(float)(2 * (pi & 15)) * (13.287712379549449f / 32.0f));
    constexpr float C2 = 0.125f * 1.4426950408889634f;
    for (int t = gw; t < TT; t += NGW) {
        const int s = t & (SEQ - 1); const float pos = (pi < 16) ? (float)(s >> 6) : (float)(s & 63);
        const float ang = pos * invf;
        const double rev = (double)ang * 0.15915494309189535; const float fr = (float)(rev - floor(rev));
        const float sn = __builtin_amdgcn_sinf(fr), cs = __builtin_amdgcn_cosf(fr);
        const unsigned* src = (const unsigned*)(QKVB + (size_t)t * 768);
#pragma unroll
        for (int j = 0; j < 5; ++j) {
            const int head = 2 * j + hsel; const unsigned w = src[head * 32 + pi];
            const float x0 = bflo(w), x1 = bfhi(w);
            float ss = x0 * x0 + x1 * x1;
#pragma unroll
            for (int o = 1; o < 32; o <<= 1) ss += __shfl_xor(ss, o);
            const float rs = 1.0f / sqrtf(ss * (1.f / 64.f) + EPS);
            const bool isq = head < 8;
            const float y0 = x0 * rs * (isq ? qw0 : kw0), y1 = x1 * rs * (isq ? qw1 : kw1);
            float o0 = y0 * cs - y1 * sn, o1 = y0 * sn + y1 * cs;
            if (isq) { o0 *= C2; o1 *= C2; ((unsigned*)(QR + (size_t)t * 512))[head * 32 + pi] = pk2(o0, o1); }
            else ((unsigned*)(KR + (size_t)t * 128))[(head - 8) * 32 + pi] = pk2(o0, o1);
        }
        ((unsigned*)(VR + (size_t)t * 128))[lane] = src[320 + lane];
    }
}

constexpr int G_KNP = 0, G_QNP = 17408, G_KNTP = 34816, G_VCT = 53248;
constexpr int G_D0 = 71680, G_D1 = 71680 + 19456;
constexpr int GD_TBP = 0, GD_AP = 9216, GD_VEC = 18432;
constexpr int G_LM = 110592;
constexpr int G_GV = G_LM + 32768;
static_assert(G_GV + 1024 <= LDS_BYTES, "gdn pre lds");

template <bool REV> DI void tri_inverse(LAS float* L, const LAS float* beta, LAS bf16* TBP, int lane) {
    float x[64];
    L = opaque(L); TBP = opaque(TBP); lane = opaque(lane);
    const float bcol = REV ? beta[63 - lane] : beta[lane];
    const int pc = REV ? permcol(63 - lane) : permcol(lane);
#pragma unroll
    for (int i = 0; i < 64; ++i) {
        float a0 = (lane == i) ? 1.0f : 0.0f, a1 = 0.f;
#pragma unroll
        for (int j4 = 0; j4 < (i + 3) / 4; ++j4) {
            const f32x4 l = *(const LAS f32x4*)(L + i * 64 + 4 * j4);
            if (4 * j4 + 0 < i) a0 -= l.x * x[4 * j4 + 0];
            if (4 * j4 + 1 < i) a1 -= l.y * x[4 * j4 + 1];
            if (4 * j4 + 2 < i) a0 -= l.z * x[4 * j4 + 2];
            if (4 * j4 + 3 < i) a1 -= l.w * x[4 * j4 + 3];
            if ((j4 & 7) == 7) asm volatile("" ::: "memory");
        }
        const float a = a0 + a1;
        x[i] = a;
        asm volatile("" ::: "memory");
        const int row = REV ? 63 - i : i;
        TBP[row * 72 + pc] = (bf16)f2bf(a * bcol);
    }
}

DI void p2_gdn_pre(Frame& F) {
    const int tid = F.tid, lane = F.lane, wave = F.wave;
    const bf16* QKVA = (const bf16*)(F.ws + WS_QKVA); const float* GATES = (const float*)(F.ws + WS_GATES);
    const float* convw = F.in[3];
#pragma unroll 1
    for (int task = F.vcu; task < 1024; task += F.G) {
        LAS unsigned char* lds = opaque(F.lds);
        LAS float* sGf = (LAS float*)(lds + G_GV); LAS float* sRb = sGf + 64; LAS float* sBf = sGf + 128; LAS float* sBb = sGf + 192;
        const int b = task >> 9, h = (task >> 7) & 3, n = task & 127;
        const int t0 = b * SEQ + n * 64;
#ifndef NO_CONV
        if (tid < 384) {
            const int cgp = tid % 48, rg = tid / 48, mat = cgp >> 4, cc = (cgp & 15) * 8;
            const int col = mat * 512 + h * 128 + cc;
            float w[5][8];
#pragma unroll
            for (int j = 0; j < 5; ++j) { const f32x4 a = *(const f32x4*)(convw + j * 1536 + col), bq = *(const f32x4*)(convw + j * 1536 + col + 4);
                w[j][0] = a.x; w[j][1] = a.y; w[j][2] = a.z; w[j][3] = a.w; w[j][4] = bq.x; w[j][5] = bq.y; w[j][6] = bq.z; w[j][7] = bq.w; }
            const int a4 = (cc >> 3) & 3, p0 = (cc & ~31) + 16 * (a4 & 1) + 4 * (a4 >> 1);
            const int ra = rg & 3, q0 = (rg >> 2) * 32 + 16 * (ra & 1) + 4 * (ra >> 1);
#pragma unroll
            for (int hf = 0; hf < 2; ++hf) {
                float o[4][8];
#pragma unroll
                for (int r = 0; r < 4; ++r)
#pragma unroll
                    for (int c = 0; c < 8; ++c) o[r][c] = 0.f;
#pragma unroll
                for (int i = 0; i < 8; ++i) {
                    const int pos = n * 64 + rg * 8 + hf * 4 - 2 + i;
                    v4u raw = (v4u){0u, 0u, 0u, 0u};
                    if (pos >= 0 && pos < SEQ) raw = *(const v4u*)(QKVA + (size_t)(b * SEQ + pos) * 1536 + col);
                    float xin[8] = {bflo(raw.x), bfhi(raw.x), bflo(raw.y), bfhi(raw.y), bflo(raw.z), bfhi(raw.z), bflo(raw.w), bfhi(raw.w)};
#pragma unroll
                    for (int j = 0; j < 5; ++j) { const int r = i - j; if (r >= 0 && r < 4) {
#pragma unroll
                        for (int c = 0; c < 8; ++c) o[r][c] += w[j][c] * xin[c]; } }
                }
#pragma unroll
                for (int r = 0; r < 4; ++r) {
                    float ss = 0.f;
#pragma unroll
                    for (int c = 0; c < 8; ++c) { o[r][c] = siluf(o[r][c]); ss += o[r][c] * o[r][c]; }
                    ss += __shfl_xor(ss, 1); ss += __shfl_xor(ss, 2); ss += __shfl_xor(ss, 4); ss += __shfl_xor(ss, 8);
                    float sc = 1.0f;
                    if (mat < 2) { sc = 1.0f / sqrtf(ss + EPS); if (mat == 0) sc *= 0.08838834764831845f; }
#pragma unroll
                    for (int c = 0; c < 8; ++c) o[r][c] *= sc;
                }
                if (mat < 2) {
                    LAS unsigned char* tile = lds + (mat == 0 ? G_QNP : G_KNP);
#pragma unroll
                    for (int r = 0; r < 4; ++r) { const int c = rg * 8 + hf * 4 + r;
                        v2u lo, hi2; lo.x = pk2(o[r][0], o[r][1]); lo.y = pk2(o[r][2], o[r][3]); hi2.x = pk2(o[r][4], o[r][5]); hi2.y = pk2(o[r][6], o[r][7]);
                        *(LAS v2u*)(tile + c * 272 + p0 * 2) = lo; *(LAS v2u*)(tile + c * 272 + (p0 + 8) * 2) = hi2; }
                }
                if (mat >= 1) {
#pragma unroll
                    for (int c = 0; c < 8; ++c) {
                        v2u q4; q4.x = pk2(o[0][c], o[1][c]); q4.y = pk2(o[2][c], o[3][c]);
                        if (mat == 1) *(LAS v2u*)(lds + G_KNTP + (cc + c) * 144 + (q0 + 8 * hf) * 2) = q4;
                        else *(LAS v2u*)(lds + G_VCT + (cc + c) * 144 + rg * 16 + hf * 8) = q4;
                    }
                }
            }
        } else
#endif
        if (wave == 7) {
            const float* gp = GATES + (size_t)(t0 + lane) * 16;
            const float bfv = gp[h], bbv = gp[4 + h], afv = gp[8 + h], abv = gp[12 + h];
            const float betaf = sigmoidf_(bfv), betab = sigmoidf_(bbv);
            const float xf = afv + F.in[5][h], xb = abv + F.in[5][4 + h];
            const float spf = fmaxf(xf, 0.f) + log1pf(__expf(-fabsf(xf))), spb = fmaxf(xb, 0.f) + log1pf(__expf(-fabsf(xb)));
            const float gf = -__expf(F.in[4][h]) * spf, gb = -__expf(F.in[4][4 + h]) * spb;
            float Gf = gf, Rb = gb;
#pragma unroll
            for (int o = 1; o < 64; o <<= 1) { const float u1 = __shfl_up(Gf, o); if (lane >= o) Gf += u1; const float d1 = __shfl_down(Rb, o); if (lane + o < 64) Rb += d1; }
            sGf[lane] = Gf; sRb[lane] = Rb; sBf[lane] = betaf; sBb[lane] = betab;
            const float GfL = __shfl(Gf, 63), Rb0 = __shfl(Rb, 0);
            LAS float* v0 = (LAS float*)(lds + G_D0 + GD_VEC); LAS float* v1 = (LAS float*)(lds + G_D1 + GD_VEC);
            v0[lane] = __expf(Gf); v0[64 + lane] = __expf(GfL - Gf); v1[lane] = __expf(Rb); v1[64 + lane] = __expf(Rb0 - Rb);
            if (lane == 0) { v0[128] = __expf(GfL); v1[128] = __expf(Rb0); }
        }
        __syncthreads();
        {
            const int p = wave >> 2, mt = wave & 3, n16 = lane & 15, g = lane >> 4;
            const LAS unsigned char* At = lds + (p == 0 ? G_KNP : G_QNP) + (16 * mt + n16) * 272 + g * 16;
            bf16x8 af[4];
#pragma unroll
            for (int ks = 0; ks < 4; ++ks) af[ks] = *(const LAS bf16x8*)(At + ks * 64);
#pragma unroll
            for (int nt = 0; nt < 4; ++nt) {
                const LAS unsigned char* Bt = lds + G_KNP + (16 * nt + n16) * 272 + g * 16;
                f32x4 acc = (f32x4){0.f, 0.f, 0.f, 0.f};
#pragma unroll
                for (int ks = 0; ks < 4; ++ks) acc = __builtin_amdgcn_mfma_f32_16x16x32_bf16(af[ks], *(const LAS bf16x8*)(Bt + ks * 64), acc, 0, 0, 0);
                const int s = 16 * nt + n16; const float Gs = sGf[s], Rs = sRb[s];
#pragma unroll
                for (int r = 0; r < 4; ++r) {
                    const int c = 16 * mt + 4 * g + r; const float v = acc[r];
                    const float df = __expf(fminf(sGf[c] - Gs, 0.f)), db = __expf(fminf(sRb[c] - Rs, 0.f));
                    if (p == 0) {
                        if (s < c) ((LAS float*)(lds + G_LM))[c * 64 + s] = sBf[c] * v * df;
                        if (s > c) ((LAS float*)(lds + G_LM + 16384))[(63 - c) * 64 + (63 - s)] = sBb[c] * v * db;
                    } else {
                        const int ps = permcol(s);
                        ((LAS bf16*)(lds + G_D0 + GD_AP))[c * 72 + ps] = (bf16)f2bf(s <= c ? v * df : 0.f);
                        ((LAS bf16*)(lds + G_D1 + GD_AP))[c * 72 + ps] = (bf16)f2bf(s >= c ? v * db : 0.f);
                    }
                }
            }
        }
        __syncthreads();
#ifndef NO_TRI
        if (wave == 0) tri_inverse<false>((LAS float*)(lds + G_LM), sBf, (LAS bf16*)(lds + G_D0 + GD_TBP), lane);
        else if (wave == 1) tri_inverse<true>((LAS float*)(lds + G_LM + 16384), sBb, (LAS bf16*)(lds + G_D1 + GD_TBP), lane);
#endif
        __syncthreads();
        {
            const int bh = b * 4 + h;
            GAS v4u* gsh = (GAS v4u*)(F.ws + WS_GSH + (size_t)(bh * 128 + n) * GDN_SH_BYTES);
#pragma unroll 1
            for (int i = tid; i < (int)(GDN_SH_BYTES / 16); i += NTHREADS) gsh[i] = *(const LAS v4u*)(lds + i * 16);
            GAS v4u* gd0 = (GAS v4u*)(F.ws + WS_GD + (size_t)((bh * 2 + 0) * 128 + n) * GDN_D_BYTES);
            GAS v4u* gd1 = (GAS v4u*)(F.ws + WS_GD + (size_t)((bh * 2 + 1) * 128 + n) * GDN_D_BYTES);
#pragma unroll 1
            for (int i = tid; i < (int)(GDN_D_BYTES / 16); i += NTHREADS) { gd0[i] = *(const LAS v4u*)(lds + G_D0 + i * 16); gd1[i] = *(const LAS v4u*)(lds + G_D1 + i * 16); }
        }
        __syncthreads();
    }
}

DI bf16x8 pack8(const f32x4 a, const f32x4 b) {
    v4u p; p.x = pk2(a[0], a[1]); p.y = pk2(a[2], a[3]); p.z = pk2(b[0], b[1]); p.w = pk2(b[2], b[3]); return __builtin_bit_cast(bf16x8, p);
}
constexpr int SC_SLOT = 78848, SC_VCT = 53248, SC_D = 55552, SC_NCH = 11;
static_assert(2 * SC_SLOT <= LDS_BYTES, "scan slots");
DI void sc_issue(v4u (&R)[SC_NCH], const unsigned char* ws, const unsigned (&delta)[SC_NCH], const unsigned (&dmask)[SC_NCH], unsigned shbase, unsigned ddiff) {
#pragma unroll
    for (int j = 0; j < SC_NCH; ++j) { const unsigned off = shbase + delta[j] + (dmask[j] & ddiff);
#ifdef SC_PLAIN_LOADS
        R[j] = *(const v4u*)(ws + off); }
#else
        asm volatile("global_load_dwordx4 %0, %1, %2" : "=v"(R[j]) : "v"(off), "s"(ws) : "memory"); }
#endif
}
#ifdef SC_PLAIN_LOADS
#define SC_WAIT(R, n) do {} while (0)
#else
#define SC_WAIT(R, n) asm volatile("s_waitcnt vmcnt(" #n ")" : "+v"(R[0]), "+v"(R[1]), "+v"(R[2]), "+v"(R[3]), "+v"(R[4]), "+v"(R[5]), "+v"(R[6]), "+v"(R[7]), "+v"(R[8]), "+v"(R[9]), "+v"(R[10]) :: "memory")
#endif
DI void sc_write(const v4u (&R)[SC_NCH], LAS unsigned char* slot, int lid) {
#pragma unroll
    for (int j = 0; j < SC_NCH; ++j) *(LAS v4u*)(slot + 16 * (lid + 448 * j)) = R[j];
}
DI void p4_scan(Frame& F) {
    const int bx = blockIdx.x; if (bx >= 128) return;
    const int lane = F.lane, n16 = lane & 15, g = lane >> 4, wave = F.wave;
    const int x = bx & 7, jj = bx >> 3; const int chain = 2 * x + (jj >> 3), e = jj & 7;
    const int bh = chain >> 1, dir = chain & 1, b = bh >> 2, h = bh & 3;
    LAS unsigned char* lds = opaque(F.lds);
    if (wave != 0) {
        const int lid = (wave - 1) * 64 + lane;
        const unsigned sh0 = (unsigned)(WS_GSH + (size_t)(bh * 128) * GDN_SH_BYTES), d0 = (unsigned)(WS_GD + (size_t)((bh * 2 + dir) * 128) * GDN_D_BYTES);
        unsigned delta[SC_NCH], dmask[SC_NCH];
#pragma unroll
        for (int j = 0; j < SC_NCH; ++j) { const int c = lid + 448 * j;
            delta[j] = (c < 3328) ? 16u * c : ((c < 3472) ? (unsigned)(G_VCT + 16 * e * 144 + 16 * (c - 3328)) : 16u * (c - 3472));
            dmask[j] = (c < 3472) ? 0u : 0xffffffffu; }
        v4u R0[SC_NCH], R1[SC_NCH], R2[SC_NCH];
#define SC_SRC(st) const int n_ = (dir == 0) ? ((st) < 128 ? (st) : 127) : ((st) < 128 ? 127 - (st) : 0); \
                   const unsigned shb_ = sh0 + (unsigned)n_ * (unsigned)GDN_SH_BYTES, ddf_ = (d0 + (unsigned)n_ * (unsigned)GDN_D_BYTES) - shb_;
        { SC_SRC(0) sc_issue(R0, F.ws, delta, dmask, shb_, ddf_); }
        { SC_SRC(1) sc_issue(R1, F.ws, delta, dmask, shb_, ddf_); }
        { SC_SRC(2) sc_issue(R2, F.ws, delta, dmask, shb_, ddf_); }
#define SC_BODY(R, st) { SC_WAIT(R, 22); sc_write(R, lds + ((st) & 1) * SC_SLOT, lid); { SC_SRC((st) + 3) sc_issue(R, F.ws, delta, dmask, shb_, ddf_); } \
                        asm volatile("s_waitcnt lgkmcnt(0)" ::: "memory"); __builtin_amdgcn_s_barrier(); }
#pragma unroll 1
        for (int s0 = 0; s0 < 126; s0 += 3) { SC_BODY(R0, s0) SC_BODY(R1, s0 + 1) SC_BODY(R2, s0 + 2) }
        SC_BODY(R0, 126) SC_BODY(R1, 127)
        SC_WAIT(R0, 0); SC_WAIT(R1, 0); SC_WAIT(R2, 0);
#undef SC_BODY
#undef SC_SRC
        return;
    }
    bf16* Odir = (bf16*)((unsigned char*)F.out + (dir == 0 ? DO_OF : DO_OB));
    f32x4 S[8];
#pragma unroll
    for (int i = 0; i < 8; ++i) S[i] = (f32x4){0.f, 0.f, 0.f, 0.f};
    bf16x8 Sb[4];
#pragma unroll
    for (int i = 0; i < 4; ++i) Sb[i] = (bf16x8){0, 0, 0, 0, 0, 0, 0, 0};
    const int aoff272 = n16 * 272 + g * 16, aoff144 = n16 * 144 + g * 16;
#define SB_() __builtin_amdgcn_sched_barrier(0)
#pragma unroll 1
    for (int step = 0; step < 128; ++step) {
        __builtin_amdgcn_s_barrier();
        asm volatile("" ::: "memory");
        const int n = dir == 0 ? step : 127 - step;
        const LAS unsigned char* rsh = lds + (step & 1) * SC_SLOT;
        const LAS unsigned char* rd = rsh + SC_D;
        const LAS float* vec = (const LAS float*)(rd + GD_VEC);
        bf16x8 fa[16];
#pragma unroll
        for (int m = 0; m < 4; ++m)
#pragma unroll
            for (int i = 0; i < 4; ++i) fa[m * 4 + i] = *(const LAS bf16x8*)(rsh + G_KNP + m * (16 * 272) + aoff272 + i * 64);
        f32x4 eG[4], ks[4]; v2u vv[4];
#pragma unroll
        for (int m = 0; m < 4; ++m) { eG[m] = *(const LAS f32x4*)(vec + 16 * m + 4 * g); ks[m] = *(const LAS f32x4*)(vec + 64 + 16 * m + 4 * g);
            vv[m] = *(const LAS v2u*)(rsh + SC_VCT + n16 * 144 + (16 * m + 4 * g) * 2); }
        const float dch = vec[128];
        SB_();
        bf16x8 fq[16];
#pragma unroll
        for (int m = 0; m < 4; ++m)
#pragma unroll
            for (int i = 0; i < 4; ++i) fq[m * 4 + i] = *(const LAS bf16x8*)(rsh + G_QNP + m * (16 * 272) + aoff272 + i * 64);
        SB_();
        f32x4 KS[4];
#pragma unroll
        for (int m = 0; m < 4; ++m) KS[m] = (f32x4){0.f, 0.f, 0.f, 0.f};
#pragma unroll
        for (int i = 0; i < 4; ++i)
#pragma unroll
            for (int m = 0; m < 4; ++m) KS[m] = __builtin_amdgcn_mfma_f32_16x16x32_bf16(fa[m * 4 + i], Sb[i], KS[m], 0, 0, 0);
        SB_();
        bf16x8 ft[8];
#pragma unroll
        for (int m = 0; m < 4; ++m)
#pragma unroll
            for (int i = 0; i < 2; ++i) ft[m * 2 + i] = *(const LAS bf16x8*)(rd + GD_TBP + m * (16 * 144) + aoff144 + i * 64);
        SB_();
        f32x4 o[4];
#pragma unroll
        for (int m = 0; m < 4; ++m) o[m] = (f32x4){0.f, 0.f, 0.f, 0.f};
#pragma unroll
        for (int i = 0; i < 4; ++i)
#pragma unroll
            for (int m = 0; m < 4; ++m) o[m] = __builtin_amdgcn_mfma_f32_16x16x32_bf16(fq[m * 4 + i], Sb[i], o[m], 0, 0, 0);
        f32x4 rr[4];
#pragma unroll
        for (int m = 0; m < 4; ++m) { rr[m][0] = bflo(vv[m].x) - eG[m][0] * KS[m][0]; rr[m][1] = bfhi(vv[m].x) - eG[m][1] * KS[m][1]; rr[m][2] = bflo(vv[m].y) - eG[m][2] * KS[m][2]; rr[m][3] = bfhi(vv[m].y) - eG[m][3] * KS[m][3]; }
        bf16x8 rb[2]; rb[0] = pack8(rr[0], rr[1]); rb[1] = pack8(rr[2], rr[3]);
        SB_();
        bf16x8 fk[16];
#pragma unroll
        for (int jt = 0; jt < 8; ++jt)
#pragma unroll
            for (int i = 0; i < 2; ++i) fk[jt * 2 + i] = *(const LAS bf16x8*)(rsh + G_KNTP + jt * (16 * 144) + aoff144 + i * 64);
        SB_();
        f32x4 vn[4];
#pragma unroll
        for (int m = 0; m < 4; ++m) vn[m] = (f32x4){0.f, 0.f, 0.f, 0.f};
#pragma unroll
        for (int i = 0; i < 2; ++i)
#pragma unroll
            for (int m = 0; m < 4; ++m) vn[m] = __builtin_amdgcn_mfma_f32_16x16x32_bf16(ft[m * 2 + i], rb[i], vn[m], 0, 0, 0);
#pragma unroll
        for (int m = 0; m < 4; ++m) o[m] = o[m] * eG[m];
#pragma unroll
        for (int jt = 0; jt < 8; ++jt) S[jt] = S[jt] * dch;
        SB_();
        bf16x8 fp[8];
#pragma unroll
        for (int m = 0; m < 4; ++m)
#pragma unroll
            for (int i = 0; i < 2; ++i) fp[m * 2 + i] = *(const LAS bf16x8*)(rd + GD_AP + m * (16 * 144) + aoff144 + i * 64);
        SB_();
        bf16x8 vnb[2]; vnb[0] = pack8(vn[0], vn[1]); vnb[1] = pack8(vn[2], vn[3]);
        bf16x8 vs[2]; vs[0] = pack8(vn[0] * ks[0], vn[1] * ks[1]); vs[1] = pack8(vn[2] * ks[2], vn[3] * ks[3]);
#pragma unroll
        for (int i = 0; i < 2; ++i)
#pragma unroll
            for (int jt = 0; jt < 8; ++jt) S[jt] = __builtin_amdgcn_mfma_f32_16x16x32_bf16(fk[jt * 2 + i], vs[i], S[jt], 0, 0, 0);
#pragma unroll
        for (int i = 0; i < 2; ++i)
#pragma unroll
            for (int m = 0; m < 4; ++m) o[m] = __builtin_amdgcn_mfma_f32_16x16x32_bf16(fp[m * 2 + i], vnb[i], o[m], 0, 0, 0);
#pragma unroll
        for (int i = 0; i < 4; ++i) Sb[i] = pack8(S[2 * i], S[2 * i + 1]);
        asm volatile("s_waitcnt lgkmcnt(0)" ::: "memory");
        bf16* op = Odir + (size_t)(b * SEQ + n * 64) * 512 + h * 128 + 16 * e + n16;
#pragma unroll
        for (int m = 0; m < 4; ++m)
#pragma unroll
            for (int r = 0; r < 4; ++r) op[(size_t)(16 * m + 4 * g + r) * 512] = (bf16)(pk2(o[m][r], 0.f) & 0xffffu);
    }
#undef SB_
}

DI void p5_combine(Frame& F) {
    const int gw = F.vcu * NWAVES + F.wave, NGW = F.G * NWAVES, lane = F.lane;
    const bf16* OFp = (const bf16*)((unsigned char*)F.out + DO_OF); const bf16* OBp = (const bf16*)((unsigned char*)F.out + DO_OB);
    const bf16* ZA = (const bf16*)(F.ws + WS_ZA); bf16* OCAT = (bf16*)(F.ws + WS_OCAT);
    const float* nw = F.in[6] + (lane & 15) * 8;
    float w8[8];
#pragma unroll
    for (int c = 0; c < 8; ++c) w8[c] = nw[c];
    for (int t = gw; t < TT; t += NGW) {
        const v4u a = *(const v4u*)(OFp + (size_t)t * 512 + lane * 8), bb = *(const v4u*)(OBp + (size_t)t * 512 + lane * 8), z = *(const v4u*)(ZA + (size_t)t * 512 + lane * 8);
        float o[8] = {bflo(a.x) + bflo(bb.x), bfhi(a.x) + bfhi(bb.x), bflo(a.y) + bflo(bb.y), bfhi(a.y) + bfhi(bb.y), bflo(a.z) + bflo(bb.z), bfhi(a.z) + bfhi(bb.z), bflo(a.w) + bflo(bb.w), bfhi(a.w) + bfhi(bb.w)};
        const float zz[8] = {bflo(z.x), bfhi(z.x), bflo(z.y), bfhi(z.y), bflo(z.z), bfhi(z.z), bflo(z.w), bfhi(z.w)};
        float ss = 0.f;
#pragma unroll
        for (int c = 0; c < 8; ++c) ss += o[c] * o[c];
        ss += __shfl_xor(ss, 1); ss += __shfl_xor(ss, 2); ss += __shfl_xor(ss, 4); ss += __shfl_xor(ss, 8);
        const float rn = 1.0f / sqrtf(ss * (1.f / 128.f) + EPS);
#pragma unroll
        for (int c = 0; c < 8; ++c) o[c] = o[c] * rn * w8[c] * siluf(zz[c]);
        v4u r; r.x = pk2(o[0], o[1]); r.y = pk2(o[2], o[3]); r.z = pk2(o[4], o[5]); r.w = pk2(o[6], o[7]);
        *(v4u*)(OCAT + (size_t)t * 1024 + lane * 8) = r;
    }
}
DI void p5_moe_weights(Frame& F) {
    LAS float* scr = (LAS float*)(F.lds + F.wave * 16384);
    const int gw = F.vcu * NWAVES + F.wave, NGW = F.G * NWAVES;
    bf16* WGU = (bf16*)(F.ws + WS_WGU); bf16* WD = (bf16*)(F.ws + WS_WD);
    constexpr int IG = 16 * 16, ID = 8 * 32, IPE = 2 * IG + ID;
    for (int it = gw; it < NEXP * IPE; it += NGW) {
        const int e = it / IPE; int r = it % IPE;
        if (r < IG) { p0_transpose_item(F.in[13] + (size_t)e * 1024 * 512, 512, 16, WGU + (size_t)e * 1024 * 1024, 1024, 0, 2, scr, r, F.lane); continue; } r -= IG;
        if (r < IG) { p0_transpose_item(F.in[14] + (size_t)e * 1024 * 512, 512, 16, WGU + (size_t)e * 1024 * 1024, 1024, 1, 2, scr, r, F.lane); continue; } r -= IG;
        p0_transpose_item(F.in[15] + (size_t)e * 512 * 1024, 1024, 32, WD + (size_t)e * 1024 * 512, 512, 0, 1, scr, r, F.lane);
    }
}

struct TokRec { int e[2]; int row[2]; float gate[2]; };
DI void p7_route(Frame& F) {
    const int gw = F.vcu * NWAVES + F.wave, NGW = F.G * NWAVES, lane = F.lane, n16 = lane & 15, g = lane >> 4;
    const float* X1 = F.out; const float* nfw = F.in[10];
    const bf16* WRH = (const bf16*)(F.ws + WS_WR); const bf16* WRL = WRH + 48 * 1024;
    bf16* HN = (bf16*)(F.ws + WS_HN); TokRec* TOK = (TokRec*)(F.ws + WS_TOK); unsigned* cnt = (unsigned*)(F.ws + WS_CTL) + CW_CNT;
    LAS float* lg = (LAS float*)(F.lds + F.wave * 4096);
    for (int rt = gw; rt < TT / 16; rt += NGW) {
        const int row = rt * 16 + n16; const float* xr = X1 + (size_t)row * DMODEL + 8 * g;
        float ss = 0.f;
        for (int i = 0; i < 32; ++i) { const f32x4 a = *(const f32x4*)(xr + 32 * i), b2 = *(const f32x4*)(xr + 32 * i + 4);
            ss += (a.x * a.x + a.y * a.y) + (a.z * a.z + a.w * a.w) + (b2.x * b2.x + b2.y * b2.y) + (b2.z * b2.z + b2.w * b2.w); }
        ss += __shfl_xor(ss, 16); ss += __shfl_xor(ss, 32);
        const float rs = 1.0f / sqrtf(ss * (1.f / DMODEL) + EPS);
        f32x4 acc[3];
#pragma unroll
        for (int q = 0; q < 3; ++q) acc[q] = (f32x4){0.f, 0.f, 0.f, 0.f};
        for (int i = 0; i < 32; ++i) {
            const f32x4 a = *(const f32x4*)(xr + 32 * i), b2 = *(const f32x4*)(xr + 32 * i + 4);
            const f32x4 wa = *(const f32x4*)(nfw + 32 * i + 8 * g), wb = *(const f32x4*)(nfw + 32 * i + 8 * g + 4);
            float hv[8] = {a.x * rs * wa.x, a.y * rs * wa.y, a.z * rs * wa.z, a.w * rs * wa.w, b2.x * rs * wb.x, b2.y * rs * wb.y, b2.z * rs * wb.z, b2.w * rs * wb.w};
            v4u hi, lo; unsigned hh[8], ll[8];
#pragma unroll
            for (int c = 0; c < 8; ++c) { hh[c] = f2bf(hv[c]); ll[c] = f2bf(hv[c] - __builtin_bit_cast(float, hh[c] << 16)); }
            hi.x = hh[0] | (hh[1] << 16); hi.y = hh[2] | (hh[3] << 16); hi.z = hh[4] | (hh[5] << 16); hi.w = hh[6] | (hh[7] << 16);
            lo.x = ll[0] | (ll[1] << 16); lo.y = ll[2] | (ll[3] << 16); lo.z = ll[4] | (ll[5] << 16); lo.w = ll[6] | (ll[7] << 16);
            *(v4u*)(HN + (size_t)row * DMODEL + 32 * i + 8 * g) = hi;
            const bf16x8 ah = __builtin_bit_cast(bf16x8, hi), al = __builtin_bit_cast(bf16x8, lo);
#pragma unroll
            for (int q = 0; q < 3; ++q) {
                const bf16x8 bh = *(const bf16x8*)(WRH + (size_t)(16 * q + n16) * 1024 + 32 * i + 8 * g), bl = *(const bf16x8*)(WRL + (size_t)(16 * q + n16) * 1024 + 32 * i + 8 * g);
                acc[q] = __builtin_amdgcn_mfma_f32_16x16x32_bf16(ah, bh, acc[q], 0, 0, 0);
                acc[q] = __builtin_amdgcn_mfma_f32_16x16x32_bf16(ah, bl, acc[q], 0, 0, 0);
                acc[q] = __builtin_amdgcn_mfma_f32_16x16x32_bf16(al, bh, acc[q], 0, 0, 0);
            }
        }
#pragma unroll
        for (int q = 0; q < 3; ++q)
#pragma unroll
            for (int r = 0; r < 4; ++r) lg[(4 * g + r) * 48 + 16 * q + n16] = acc[q][r];
        asm volatile("s_waitcnt lgkmcnt(0)" ::: "memory");
        if (lane < 16) {
            const LAS float* L = lg + lane * 48; const int tok = rt * 16 + lane;
            float gm = L[0]; int gs = 0;
#pragma unroll
            for (int q = 1; q < 4; ++q) if (L[q] > gm) { gm = L[q]; gs = q; }
            float gsum = 0.f;
#pragma unroll
            for (int q = 0; q < 4; ++q) gsum += __expf(L[q] - gm);
            const float gp_top = 1.0f / gsum;
            float fv[8];
#pragma unroll
            for (int q = 0; q < 8; ++q) { float v = L[4 + q]; v = (gs == 1) ? L[12 + q] : v; v = (gs == 2) ? L[20 + q] : v; v = (gs == 3) ? L[28 + q] : v; fv[q] = v; }
            float m1 = fv[0]; int i1 = 0;
#pragma unroll
            for (int q = 1; q < 8; ++q) if (fv[q] > m1) { m1 = fv[q]; i1 = q; }
            float m2 = -3.0e38f; int i2 = 0;
#pragma unroll
            for (int q = 0; q < 8; ++q) if (q != i1 && fv[q] > m2) { m2 = fv[q]; i2 = q; }
            const float e2 = __expf(m2 - m1); const float g1 = gp_top / (1.0f + e2), g2 = gp_top * e2 / (1.0f + e2);
            const int ex1 = gs * 8 + i1, ex2 = gs * 8 + i2;
            const int s1 = (int)atomicAdd(cnt + ex1, 1u), s2 = (int)atomicAdd(cnt + ex2, 1u);
            TokRec tr; tr.e[0] = ex1; tr.e[1] = ex2; tr.row[0] = s1; tr.row[1] = s2; tr.gate[0] = g1; tr.gate[1] = g2;
            TOK[tok] = tr;
        }
        asm volatile("s_waitcnt lgkmcnt(0)" ::: "memory");
    }
}

DI void p8_gather(Frame& F) {
    const int gw = F.vcu * NWAVES + F.wave, NGW = F.G * NWAVES, lane = F.lane;
    unsigned* ctl = (unsigned*)(F.ws + WS_CTL);
    LAS int* pst = (LAS int*)(F.lds);
    if (F.tid == 0) {
        int acc = 0, nt = 0;
        for (int e = 0; e < NEXP; ++e) { const int c = (int)__hip_atomic_load(ctl + CW_CNT + e, __ATOMIC_RELAXED, __HIP_MEMORY_SCOPE_AGENT); pst[e] = acc; const int ntile = (c + 255) >> 8;
            if (blockIdx.x == 0) for (int q = 0; q < ntile; ++q) { ctl[CW_TILES + 2 * (nt + q)] = (unsigned)((acc >> 8) + q); ctl[CW_TILES + 2 * (nt + q) + 1] = (unsigned)e; }
            nt += ntile; acc += ntile * 256; }
        if (blockIdx.x == 0) ctl[CW_NTILE] = (unsigned)nt;
    }
    __syncthreads();
    const bf16* HN = (const bf16*)(F.ws + WS_HN); bf16* XB = (bf16*)(F.ws + WS_XBUF); TokRec* TOK = (TokRec*)(F.ws + WS_TOK);
    for (int t = gw; t < TT; t += NGW) {
        TokRec tr = TOK[t];
        const int r0 = pst[tr.e[0]] + tr.row[0], r1 = pst[tr.e[1]] + tr.row[1];
        const v4u a = *(const v4u*)(HN + (size_t)t * DMODEL + lane * 8), b2 = *(const v4u*)(HN + (size_t)t * DMODEL + 512 + lane * 8);
        *(v4u*)(XB + (size_t)r0 * DMODEL + lane * 8) = a; *(v4u*)(XB + (size_t)r0 * DMODEL + 512 + lane * 8) = b2;
        *(v4u*)(XB + (size_t)r1 * DMODEL + lane * 8) = a; *(v4u*)(XB + (size_t)r1 * DMODEL + 512 + lane * 8) = b2;
        if (lane == 0) { TOK[t].row[0] = r0; TOK[t].row[1] = r1; }
    }
}

DI void p11_final(Frame& F) {
    const int gw = F.vcu * NWAVES + F.wave, NGW = F.G * NWAVES, lane = F.lane;
    const bf16* Y = (const bf16*)(F.ws + WS_XBUF); const TokRec* TOK = (const TokRec*)(F.ws + WS_TOK); const float* fw = F.in[16];
    for (int t = gw; t < TT; t += NGW) {
        const TokRec tr = TOK[t];
        float* xr = F.out + (size_t)t * DMODEL + lane * 8;
        const f32x4 a = *(const f32x4*)(xr), b2 = *(const f32x4*)(xr + 4), c = *(const f32x4*)(xr + 512), d = *(const f32x4*)(xr + 516);
        float v[16] = {a.x, a.y, a.z, a.w, b2.x, b2.y, b2.z, b2.w, c.x, c.y, c.z, c.w, d.x, d.y, d.z, d.w};
#pragma unroll
        for (int k = 0; k < 2; ++k) {
            const float gk = tr.gate[k]; const bf16* yr = Y + (size_t)tr.row[k] * DMODEL + lane * 8;
            const v4u y0 = *(const v4u*)(yr), y1 = *(const v4u*)(yr + 512);
            v[0] += gk * bflo(y0.x); v[1] += gk * bfhi(y0.x); v[2] += gk * bflo(y0.y); v[3] += gk * bfhi(y0.y); v[4] += gk * bflo(y0.z); v[5] += gk * bfhi(y0.z); v[6] += gk * bflo(y0.w); v[7] += gk * bfhi(y0.w);
            v[8] += gk * bflo(y1.x); v[9] += gk * bfhi(y1.x); v[10] += gk * bflo(y1.y); v[11] += gk * bfhi(y1.y); v[12] += gk * bflo(y1.z); v[13] += gk * bfhi(y1.z); v[14] += gk * bflo(y1.w); v[15] += gk * bfhi(y1.w);
        }
        float ss = 0.f;
#pragma unroll
        for (int i = 0; i < 16; ++i) ss += v[i] * v[i];
        const float rs = 1.0f / sqrtf(wave_sum(ss) * (1.f / DMODEL) + EPS);
        const f32x4 w0 = *(const f32x4*)(fw + lane * 8), w1 = *(const f32x4*)(fw + lane * 8 + 4), w2 = *(const f32x4*)(fw + 512 + lane * 8), w3 = *(const f32x4*)(fw + 516 + lane * 8);
        *(f32x4*)(xr) = (f32x4){v[0] * rs * w0.x, v[1] * rs * w0.y, v[2] * rs * w0.z, v[3] * rs * w0.w};
        *(f32x4*)(xr + 4) = (f32x4){v[4] * rs * w1.x, v[5] * rs * w1.y, v[6] * rs * w1.z, v[7] * rs * w1.w};
        *(f32x4*)(xr + 512) = (f32x4){v[8] * rs * w2.x, v[9] * rs * w2.y, v[10] * rs * w2.z, v[11] * rs * w2.w};
        *(f32x4*)(xr + 516) = (f32x4){v[12] * rs * w3.x, v[13] * rs * w3.y, v[14] * rs * w3.z, v[15] * rs * w3.w};
    }
}

struct Args { const float* in[17]; float* out; unsigned char* ws; int ph_lo, ph_hi; };
__global__ void __launch_bounds__(NTHREADS, 2) fwd_kernel(Args args) {
    extern __shared__ __attribute__((aligned(16))) unsigned char lds[];
    cg::grid_group grid = cg::this_grid();
    Frame F;
    F.lds = (LAS unsigned char*)lds; F.tid = threadIdx.x; F.lane = F.tid & 63; F.wave = __builtin_amdgcn_readfirstlane(F.tid >> 6);
    F.G = gridDim.x; { const int bx = blockIdx.x; F.vcu = (F.G % 8 == 0) ? (bx % 8) * (F.G / 8) + bx / 8 : bx; }
#pragma unroll
    for (int i = 0; i < 17; ++i) F.in[i] = args.in[i];
    F.out = args.out; F.ws = args.ws;
    const int lo = args.ph_lo, hi = args.ph_hi;
#ifndef PHSEL
#define PHSEL 0xfff
#endif
#define IN(k) (((PHSEL >> (k)) & 1) && lo <= (k) && (k) < hi)
#define SEAM(k) do { if (IN(k) && IN((k) + 1)) grid.sync(); } while (0)
#ifndef REP_PH
#define REP_PH -1
#endif
#define REPS(k) for (int rep_ = 0; rep_ < ((k) == REP_PH ? 2 : 1); ++rep_, ((k) == REP_PH && rep_ < 2) ? grid.sync() : (void)0)
    if (IN(0)) REPS(0) { p0_prologue(F); } SEAM(0);
    if (IN(1)) REPS(1) {
        pg8::Gemm gm{(const pg8::bf16_t*)(F.ws + WS_XN), (const pg8::bf16_t*)(F.ws + WS_WIN), TT, NPROJ, DMODEL}; pg8::StaticOrder S; S.init(TT, NPROJ, F.G, (int)blockIdx.x);
        EpiProj E{(bf16*)(F.ws + WS_QKVA), (bf16*)(F.ws + WS_ZA), (bf16*)(F.ws + WS_QKVB), (float*)(F.ws + WS_GATES)};
        pg8::gemm_phase<EpiProj, pg8::StaticOrder, true, true>(F.lds, gm, S, E);
    } SEAM(1);
    if (IN(2)) REPS(2) {
#ifndef NO_ROPE
        p2_rope(F);
#endif
#ifndef NO_PRE
        p2_gdn_pre(F);
#endif
    } SEAM(2);
    if (IN(3)) REPS(3) {
        const attn_body::AttnTensors AT{(const attn_body::bf16*)((unsigned char*)F.out + DO_QR), (const attn_body::bf16*)((unsigned char*)F.out + DO_KR), (const attn_body::bf16*)((unsigned char*)F.out + DO_VR),
                                        (attn_body::bf16*)(F.ws + WS_OCAT) + 512};
        const attn_body::StaticOrder S((int)F.G, (int)blockIdx.x);
#ifdef PROBE_ZERO_ATTN
        { (void)AT; (void)S; bf16* OC = (bf16*)(F.ws + WS_OCAT); const int gt = blockIdx.x * NTHREADS + F.tid, GT = F.G * NTHREADS;
          for (int i = gt; i < TT * 64; i += GT) { const int t = i >> 6, c = i & 63; *(v4u*)(OC + (size_t)t * 1024 + 512 + c * 8) = (v4u){0u, 0u, 0u, 0u}; } }
#else
        attn_body::attn_phase<attn_body::StaticOrder>((char*)lds, AT, S);
#endif
    } SEAM(3);
    if (IN(4)) REPS(4) { p4_scan(F); } SEAM(4);
    if (IN(5)) REPS(5) { p5_combine(F); p5_moe_weights(F); } SEAM(5);
    if (IN(6)) REPS(6) {
        pg8::Gemm gm{(const pg8::bf16_t*)(F.ws + WS_OCAT), (const pg8::bf16_t*)(F.ws + WS_WOUT), TT, DMODEL, DMODEL}; pg8::StaticOrder S; S.init(TT, DMODEL, F.G, (int)blockIdx.x);
        EpiResid E{F.in[0], F.out};
        pg8::gemm_phase<EpiResid, pg8::StaticOrder, true, true>(F.lds, gm, S, E);
    } SEAM(6);
    if (IN(7)) { p7_route(F); } SEAM(7);
    if (IN(8)) { p8_gather(F); } SEAM(8);
    if (IN(9)) REPS(9) {
        pg8::Gemm gm{(const pg8::bf16_t*)(F.ws + WS_XBUF), (const pg8::bf16_t*)(F.ws + WS_WGU), 0, 0, DMODEL}; MoeOrder S{(const unsigned*)(F.ws + WS_CTL), F.G, (int)blockIdx.x};
        EpiGU E{(bf16*)(F.ws + WS_HID)};
        pg8::gemm_phase<EpiGU, MoeOrder, true, true>(F.lds, gm, S, E);
    } SEAM(9);
    if (IN(10)) REPS(10) {
        pg8::Gemm gm{(const pg8::bf16_t*)(F.ws + WS_HID), (const pg8::bf16_t*)(F.ws + WS_WD), 0, 0, FFE}; MoeOrder S{(const unsigned*)(F.ws + WS_CTL), F.G, (int)blockIdx.x};
        EpiY E{(bf16*)(F.ws + WS_XBUF)};
        pg8::gemm_phase<EpiY, MoeOrder, true, true>(F.lds, gm, S, E);
    } SEAM(10);
    if (IN(11)) { p11_final(F); }
#undef IN
#undef SEAM
}

extern "C" void kernel_launch(void* const* d_in, const int* in_sizes, int n_in, void* d_out, int out_size, void* d_ws, size_t ws_size, hipStream_t stream) {
    static int grid = 0;
    if (grid == 0) {
        if (n_in != 17 || out_size != TT * DMODEL || ws_size < WS_END) { fprintf(stderr, "kernel_launch: unexpected problem (n_in %d out %d ws %zu)\n", n_in, out_size, ws_size); grid = -1; return; }
        int dev = 0, cus = 0, per_cu = 0;
        if (hipGetDevice(&dev) != hipSuccess || hipDeviceGetAttribute(&cus, hipDeviceAttributeMultiprocessorCount, dev) != hipSuccess) { grid = -1; return; }
        if (hipFuncSetAttribute((const void*)fwd_kernel, hipFuncAttributeMaxDynamicSharedMemorySize, LDS_BYTES) != hipSuccess) { fprintf(stderr, "hipFuncSetAttribute failed\n"); grid = -1; return; }
        if (hipOccupancyMaxActiveBlocksPerMultiprocessor(&per_cu, (const void*)fwd_kernel, NTHREADS, LDS_BYTES) != hipSuccess || per_cu < 1) { fprintf(stderr, "occupancy query: %d\n", per_cu); grid = -1; return; }
        grid = cus;
    }
    if (grid < 0) return;
    (void)hipMemsetAsync((char*)d_ws + WS_CTL, 0, CTL_ZERO_BYTES, stream);
    Args a{};
    for (int i = 0; i < 17; ++i) a.in[i] = (const float*)d_in[i];
    a.out = (float*)d_out; a.ws = (unsigned char*)d_ws;
#if MK_PER_PHASE
    for (int p = 0; p < N_PHASES; ++p) { a.ph_lo = p; a.ph_hi = p + 1; hipLaunchKernelGGL(fwd_kernel, dim3(grid), dim3(NTHREADS), LDS_BYTES, stream, a); }
#else
    a.ph_lo = 0; a.ph_hi = N_PHASES;
    void* kargs[] = {&a};
    hipError_t e = hipLaunchCooperativeKernel((void*)fwd_kernel, dim3(grid), dim3(NTHREADS), kargs, LDS_BYTES, stream);
    if (e != hipSuccess) fprintf(stderr, "cooperative launch failed: %s (grid %d)\n", hipGetErrorString(e), grid);
#endif
}
```

```cpp
#include <hip/hip_runtime.h>
#include <cstdio>
#include <cstdint>
namespace pg8 {
#define PG8_LAS __attribute__((address_space(3)))
typedef unsigned short bf16_t;
typedef short bf16x8 __attribute__((ext_vector_type(8)));
typedef float f32x4 __attribute__((ext_vector_type(4)));
typedef unsigned u32x4 __attribute__((ext_vector_type(4)));
constexpr int BM = 256, BK = 64, HALF = 128, HTB = HALF * BK * 2  , STAGE_BYTES = 8 * HTB, NXCD = 8, WGM = 8;

__host__ __device__ __forceinline__ int lds_byte(int r, int c) { const int st = (r >> 4) * 2 + (c >> 5), rr = r & 15, cc = c & 31, ob = rr * 64 + cc * 2; return st * 1024 + (ob ^ (((ob >> 9) & 1) << 5)); }
__host__ __device__ __forceinline__ void stage_rc(int b, int& R, int& C) { const int st = b / 1024, sb = b % 1024, swz = sb ^ (((sb >> 9) & 1) << 5); R = (st >> 1) * 16 + swz / 64; C = (st & 1) * 32 + (swz % 64) / 2; }
__host__ __device__ __forceinline__ int perm32(int rho) { const int n = rho >> 4, i = rho & 15; return 8 * (i >> 2) + 4 * n + (i & 3); }

struct Unit { int pm, pn; };
struct Gemm { const bf16_t* A; const bf16_t* Bt; int M, N, K; };

struct StaticOrder {
    int nM, nN, nwg, G, c;
    __host__ __device__ void init(int M, int N, int G_, int c_) { nM = M / BM; nN = N / BM; nwg = nM * nN; G = G_; c = c_; }
    __host__ __device__ bool next(int i, Unit& u) const {
        const long L = (long)i * G + c; if (L >= nwg) return false;
        int wgid = (int)L; { const int q = nwg / NXCD, r = nwg % NXCD, xcd = wgid % NXCD, off = wgid / NXCD; wgid = (xcd < r ? xcd * (q + 1) : r * (q + 1) + (xcd - r) * q) + off; }
        const int nig = WGM * nN, gid = wgid / nig, fm = gid * WGM, gsz = (nM - fm) < WGM ? (nM - fm) : WGM;
        u.pm = fm + ((wgid % nig) % gsz); u.pn = (wgid % nig) / gsz; return true;
    }
    __device__ __forceinline__ void a_ready(const Unit&) const {}
    __device__ __forceinline__ void done(const Unit&) const {}
};

__device__ __forceinline__ unsigned cvt_pk_bf16(float lo, float hi) { unsigned r; asm volatile("v_cvt_pk_bf16_f32 %0, %1, %2" : "=v"(r) : "v"(lo), "v"(hi)); return r; }
typedef float f32x2 __attribute__((ext_vector_type(2)));
template <class Epi, class Sched, bool ALIGN_EPI = false, bool SP2 = false>
__device__ __forceinline__ void gemm_phase(PG8_LAS unsigned char* lds, const Gemm g, const Sched& S, const Epi& E) {
    const int tid = threadIdx.x, wid = __builtin_amdgcn_readfirstlane(tid >> 6), lane = tid & 63, wr = wid >> 2, wc = wid & 3, fr = lane & 15, fq = lane >> 4;
    const int K = g.K, nt = K / BK;
    unsigned voffA[2], voffB[2];
#pragma unroll
    for (int i = 0; i < 2; ++i) { int R, C; stage_rc(tid * 16 + i * 8192, R, C); const int Rb = Epi::PERM ? ((R & ~31) + perm32(R & 31)) : R;
        voffA[i] = (unsigned)(R * K + C) * 2u; voffB[i] = (unsigned)(Rb * K + C) * 2u; }
    const size_t kstep = (size_t)(BK * 2);
    const size_t hstep = (size_t)HALF * K * 2;
    const size_t tstep = 2 * hstep;
    const unsigned ldsw = (unsigned)wid * 1024u;
    const int aoff = lds_byte(wr * 64 + fr, fq * 8), boff = lds_byte(wc * 32 + fr, fq * 8);
#define PG8_SA(b, h) (((b) * 2 + (h)) * HTB)
#define PG8_SB(b, h) ((4 + (b) * 2 + (h)) * HTB)
#define PG8_STAGE(bufoff, gbase, voff) do { _Pragma("unroll") for (int _i = 0; _i < 2; ++_i) \
        __builtin_amdgcn_global_load_lds((const unsigned*)((const char*)(gbase) + (voff)[_i]), (PG8_LAS unsigned*)(lds + (bufoff) + ldsw + _i * 8192), 16, 0, 0); } while (0)
#define PG8_LDA(dst, b, h) do { _Pragma("unroll") for (int m = 0; m < 4; ++m) _Pragma("unroll") for (int k = 0; k < 2; ++k) dst[m][k] = *(const PG8_LAS bf16x8*)(lds + PG8_SA(b, h) + aoff + m * 2048 + k * 1024); } while (0)
#define PG8_LDB(dst, b, h) do { _Pragma("unroll") for (int n = 0; n < 2; ++n) _Pragma("unroll") for (int k = 0; k < 2; ++k) dst[n][k] = *(const PG8_LAS bf16x8*)(lds + PG8_SB(b, h) + boff + n * 2048 + k * 1024); } while (0)
#define PG8_MMA(ai, bj, At, Bt) do { __builtin_amdgcn_s_setprio(1); _Pragma("unroll") for (int m = 0; m < 4; ++m) _Pragma("unroll") for (int n = 0; n < 2; ++n) _Pragma("unroll") for (int k = 0; k < 2; ++k) \
        acc[ai][bj][m][n] = __builtin_amdgcn_mfma_f32_16x16x32_bf16(Bt[n][k], At[m][k], acc[ai][bj][m][n], 0, 0, 0); __builtin_amdgcn_s_setprio(0); } while (0)
#define PG8_WAIT_V(n) asm volatile("s_waitcnt vmcnt(" #n ")" ::: "memory")
#define PG8_WAIT_L(n) asm volatile("s_waitcnt lgkmcnt(" #n ")" ::: "memory")
#define PG8_BAR __builtin_amdgcn_s_barrier()
#define PG8_SCHED __builtin_amdgcn_sched_barrier(0)
    Unit cur, nxt; int ui = 0;
    if (!S.next(0, cur)) return;
    f32x4 acc[2][2][4][2];
#pragma unroll
    for (int a = 0; a < 2; ++a)
#pragma unroll
        for (int b = 0; b < 2; ++b)
#pragma unroll
            for (int m = 0; m < 4; ++m)
#pragma unroll
                for (int n = 0; n < 2; ++n) acc[a][b][m][n] = (f32x4){0.f, 0.f, 0.f, 0.f};
    bf16x8 At[4][2], B0[2][2], B1[2][2];
    const char* cA = (const char*)g.A + (size_t)cur.pm * tstep; const char* cB = (const char*)g.Bt + (size_t)cur.pn * tstep;
    S.a_ready(cur);
    if constexpr (SP2) {
        PG8_STAGE(PG8_SB(0, 0), cB, voffB); PG8_STAGE(PG8_SB(0, 1), cB + hstep, voffB); PG8_STAGE(PG8_SA(0, 0), cA, voffA); PG8_STAGE(PG8_SA(0, 1), cA + hstep, voffA);
        if (wr == 1) PG8_BAR;
        PG8_WAIT_V(2); PG8_BAR;
        PG8_STAGE(PG8_SB(1, 0), cB + kstep, voffB); PG8_STAGE(PG8_SA(1, 0), cA + kstep, voffA); PG8_STAGE(PG8_SB(1, 1), cB + hstep + kstep, voffB);
        PG8_WAIT_V(6); PG8_BAR;
    } else {
        PG8_STAGE(PG8_SB(0, 0), cB, voffB); PG8_STAGE(PG8_SA(0, 0), cA, voffA); PG8_STAGE(PG8_SB(0, 1), cB + hstep, voffB); PG8_STAGE(PG8_SA(0, 1), cA + hstep, voffA);
        if (wr == 1) PG8_BAR;
        PG8_WAIT_V(4); PG8_BAR;
        PG8_STAGE(PG8_SB(1, 0), cB + kstep, voffB); PG8_STAGE(PG8_SA(1, 0), cA + kstep, voffA); PG8_STAGE(PG8_SB(1, 1), cB + hstep + kstep, voffB);
        PG8_WAIT_V(6); PG8_BAR;
    }
    for (;;) {
        const bool has_next = S.next(ui + 1, nxt);
        const char* nA = has_next ? (const char*)g.A + (size_t)nxt.pm * tstep : cA; const char* nB = has_next ? (const char*)g.Bt + (size_t)nxt.pn * tstep : cB;
        for (int t = 0; t < nt; t += 2) {
            const bool last = (t == nt - 2);
            const char* a1 = cA + (size_t)(t + 1) * kstep;
            const char* a2 = last ? nA : cA + (size_t)(t + 2) * kstep; const char* b2 = last ? nB : cB + (size_t)(t + 2) * kstep;
            const char* a3 = a2 + kstep; const char* b3 = b2 + kstep;
            if (last && has_next) S.a_ready(nxt);
            if constexpr (SP2) {
            PG8_LDB(B0, 0, 0); PG8_LDB(B1, 0, 1); PG8_SCHED; PG8_LDA(At, 0, 0); PG8_STAGE(PG8_SA(1, 1), a1 + hstep, voffA);
            PG8_WAIT_V(8); PG8_WAIT_L(0); PG8_BAR; PG8_MMA(0, 0, At, B0); PG8_MMA(0, 1, At, B1); PG8_BAR; PG8_SCHED;
            PG8_LDA(At, 0, 1); PG8_STAGE(PG8_SB(0, 0), b2, voffB); PG8_STAGE(PG8_SB(0, 1), b2 + hstep, voffB); PG8_STAGE(PG8_SA(0, 0), a2, voffA);
            PG8_WAIT_V(8); PG8_WAIT_L(0); PG8_BAR; PG8_MMA(1, 0, At, B0); PG8_MMA(1, 1, At, B1); PG8_BAR; PG8_SCHED;
            PG8_LDB(B0, 1, 0); PG8_LDB(B1, 1, 1); PG8_SCHED; PG8_LDA(At, 1, 0); PG8_STAGE(PG8_SA(0, 1), a2 + hstep, voffA);
            PG8_WAIT_V(8); PG8_WAIT_L(0); PG8_BAR; PG8_MMA(0, 0, At, B0); PG8_MMA(0, 1, At, B1); PG8_BAR; PG8_SCHED;
            PG8_LDA(At, 1, 1); PG8_STAGE(PG8_SB(1, 0), b3, voffB); PG8_STAGE(PG8_SB(1, 1), b3 + hstep, voffB); PG8_STAGE(PG8_SA(1, 0), a3, voffA);
            PG8_WAIT_V(8); PG8_WAIT_L(0); PG8_BAR; PG8_MMA(1, 0, At, B0); PG8_MMA(1, 1, At, B1); PG8_BAR; PG8_SCHED;
            } else {
            PG8_LDB(B0, 0, 0); PG8_SCHED; PG8_LDA(At, 0, 0); PG8_STAGE(PG8_SA(1, 1), a1 + hstep, voffA);
            PG8_WAIT_L(8); PG8_BAR; PG8_WAIT_L(0); PG8_MMA(0, 0, At, B0); PG8_BAR; PG8_SCHED;
            PG8_LDB(B1, 0, 1); PG8_STAGE(PG8_SB(0, 0), b2, voffB);
            PG8_BAR; PG8_WAIT_L(0); PG8_MMA(0, 1, At, B1); PG8_BAR;
            PG8_LDA(At, 0, 1); PG8_STAGE(PG8_SA(0, 0), a2, voffA);
            PG8_BAR; PG8_WAIT_L(0); PG8_MMA(1, 0, At, B0); PG8_BAR; PG8_SCHED;
            PG8_STAGE(PG8_SB(0, 1), b2 + hstep, voffB);
            PG8_WAIT_V(6); PG8_BAR; PG8_MMA(1, 1, At, B1); PG8_BAR;
            PG8_LDB(B0, 1, 0); PG8_SCHED; PG8_LDA(At, 1, 0); PG8_STAGE(PG8_SA(0, 1), a2 + hstep, voffA);
            PG8_WAIT_L(8); PG8_BAR; PG8_WAIT_L(0); PG8_MMA(0, 0, At, B0); PG8_BAR; PG8_SCHED;
            PG8_LDB(B1, 1, 1); PG8_STAGE(PG8_SB(1, 0), b3, voffB);
            PG8_BAR; PG8_WAIT_L(0); PG8_MMA(0, 1, At, B1); PG8_BAR;
            PG8_LDA(At, 1, 1); PG8_STAGE(PG8_SA(1, 0), a3, voffA);
            PG8_BAR; PG8_WAIT_L(0); PG8_MMA(1, 0, At, B0); PG8_BAR; PG8_SCHED;
            PG8_STAGE(PG8_SB(1, 1), b3 + hstep, voffB);
            PG8_WAIT_V(6); PG8_BAR; PG8_MMA(1, 1, At, B1); PG8_BAR;
            }
        }
        if constexpr (ALIGN_EPI) { if (wr == 0) PG8_BAR; }
        if constexpr (!Epi::AFTER_DRAIN) { E(acc, cur, wr, wc, fr, fq); S.done(cur); }
        if (!has_next) break;
#pragma unroll
        for (int a = 0; a < 2; ++a)
#pragma unroll
            for (int b = 0; b < 2; ++b)
#pragma unroll
                for (int m = 0; m < 4; ++m)
#pragma unroll
                    for (int n = 0; n < 2; ++n) acc[a][b][m][n] = (f32x4){0.f, 0.f, 0.f, 0.f};
        cur = nxt; cA = nA; cB = nB; ++ui;
        if constexpr (ALIGN_EPI) { if (wr == 1) PG8_BAR; }
    }
    PG8_WAIT_V(0);
    if constexpr (!ALIGN_EPI) { if (wr == 0) PG8_BAR; }
    PG8_BAR;
    if constexpr (Epi::AFTER_DRAIN) { E.fused(acc, cur, wr, wc, fr, fq, lds, wid, lane); S.done(cur); }
#undef PG8_SA
#undef PG8_SB
#undef PG8_STAGE
#undef PG8_LDA
#undef PG8_LDB
#undef PG8_MMA
#undef PG8_WAIT_V
#undef PG8_WAIT_L
#undef PG8_BAR
#undef PG8_SCHED
}
}
#include <hip/hip_bf16.h>
#include <cmath>
namespace attn_body {
using bf16=__hip_bfloat16;
using bf16x8=__attribute__((ext_vector_type(8)))short;
using s16x4=__attribute__((ext_vector_type(4)))short;
using f32x16=__attribute__((ext_vector_type(16)))float;
using u32x4=__attribute__((ext_vector_type(4)))unsigned;
constexpr int BATCH=2,NHEAD=8,NKVH=2,SEQ=8192,D=64,QP=512,KP=128,OP=1024;
constexpr int NW=8,QBLK=32,QB=QBLK*NW,KVBLK=64,NQB=SEQ/QB;
constexpr int ATTN_UNIT_ROWS=QB;
__device__ __forceinline__ int crow(int r,int hi){return (r&3)+8*(r>>2)+4*hi;}
#define SBAR() __builtin_amdgcn_sched_barrier(0)
__device__ __forceinline__ void cmask(f32x16&p0,f32x16&p1,int jb,int qrel,int hi){
  const float NEG=-INFINITY; int kb=64*jb+4*hi;
  #pragma unroll
  for(int r=0;r<16;++r){int kv=kb+(r&3)+8*(r>>2); if(kv>qrel)p0[r]=NEG; if(kv+32>qrel)p1[r]=NEG;}
}

constexpr int NSLOT=3, SLOTB=8192;
constexpr int LDS_K=0, LDS_V=NSLOT*SLOTB, LDS_WS=2*NSLOT*SLOTB, LDS_OST=LDS_WS+NW*64*4, LDS_BYTES=LDS_OST+NW*4096;
constexpr float C2=0.125f*1.4426950408889634f;
__device__ __forceinline__ void glds16(const void*gsrc,unsigned lds_dst){unsigned keep;
  asm volatile("s_mov_b32 %0, m0\n\ts_mov_b32 m0, %2\n\ts_nop 0\n\tglobal_load_lds_dwordx4 %1, off\n\ts_mov_b32 m0, %0":"=&s"(keep):"v"(gsrc),"s"(lds_dst):"memory");}
__device__ __forceinline__ float max3f(float a,float b,float c){float r;asm("v_max3_f32 %0, %1, %2, %3":"=v"(r):"v"(a),"v"(b),"v"(c));return r;}
__device__ __forceinline__ float max2f(float a,float b){float r;asm("v_max_f32_e32 %0, %1, %2":"=v"(r):"v"(a),"v"(b));return r;}
__device__ __forceinline__ float fadd_s(float a,float b){float r;asm("v_add_f32_e32 %0, %1, %2":"=v"(r):"v"(a),"v"(b));return r;}
__device__ __forceinline__ float fsub_s(float a,float b){float r;asm("v_sub_f32_e32 %0, %1, %2":"=v"(r):"v"(a),"v"(b));return r;}
typedef float f32x2_t __attribute__((ext_vector_type(2))); typedef __bf16 bf16x2_t __attribute__((ext_vector_type(2)));
__device__ __forceinline__ unsigned cvtpk_s(float lo,float hi){f32x2_t v={lo,hi};bf16x2_t b=__builtin_convertvector(v,bf16x2_t);return __builtin_bit_cast(unsigned,b);}
#define WAIT_BAR(N) asm volatile("s_waitcnt vmcnt(" #N ") lgkmcnt(0)\n\ts_barrier":::"memory")

__device__ __forceinline__ void qkt(f32x16&p0,f32x16&p1,const char*Kslot,const bf16x8*qr,const f32x16&negm,int r32,int hi){
  const char*kb=Kslot+hi*1024+r32*16;
  #pragma unroll
  for(int d0=0;d0<4;++d0){
    const bf16x8 b0=*reinterpret_cast<const bf16x8*>(kb+d0*2048);
    const bf16x8 b1=*reinterpret_cast<const bf16x8*>(kb+d0*2048+512);
    if(d0==0){p0=__builtin_amdgcn_mfma_f32_32x32x16_bf16(b0,qr[0],negm,0,0,0);p1=__builtin_amdgcn_mfma_f32_32x32x16_bf16(b1,qr[0],negm,0,0,0);}
    else{p0=__builtin_amdgcn_mfma_f32_32x32x16_bf16(b0,qr[d0],p0,0,0,0);p1=__builtin_amdgcn_mfma_f32_32x32x16_bf16(b1,qr[d0],p1,0,0,0);}}
}
typedef __attribute__((address_space(3))) const char* lds_cptr;
typedef short v4i16_t __attribute__((ext_vector_type(4)));
__device__ __forceinline__ void kload8(bf16x8*kf,lds_cptr kp){
  kf[0]=*(const __attribute__((address_space(3))) bf16x8*)(kp);      kf[1]=*(const __attribute__((address_space(3))) bf16x8*)(kp+512);
  kf[2]=*(const __attribute__((address_space(3))) bf16x8*)(kp+2048); kf[3]=*(const __attribute__((address_space(3))) bf16x8*)(kp+2560);
  kf[4]=*(const __attribute__((address_space(3))) bf16x8*)(kp+4096); kf[5]=*(const __attribute__((address_space(3))) bf16x8*)(kp+4608);
  kf[6]=*(const __attribute__((address_space(3))) bf16x8*)(kp+6144); kf[7]=*(const __attribute__((address_space(3))) bf16x8*)(kp+6656);
}
__device__ __forceinline__ void kload2(bf16x8*kf,lds_cptr kp,int j){ kf[2*j]=*(const __attribute__((address_space(3))) bf16x8*)(kp+j*2048); kf[2*j+1]=*(const __attribute__((address_space(3))) bf16x8*)(kp+j*2048+512); }
__device__ __forceinline__ s16x4 vtr(lds_cptr p){ return __builtin_bit_cast(s16x4,__builtin_amdgcn_ds_read_tr16_b64_v4i16((__attribute__((address_space(3))) v4i16_t*)p)); }
__device__ __forceinline__ float rowmax(const f32x16&p0,const f32x16&p1){
  float a=max3f(p0[0],p0[1],p1[0]),b=max3f(p0[2],p0[3],p1[1]);a=max3f(a,p1[2],p1[3]);
  #pragma unroll
  for(int r=4;r<16;r+=4){a=max3f(a,p0[r],p0[r+1]);b=max3f(b,p0[r+2],p0[r+3]);a=max3f(a,p1[r],p1[r+1]);b=max3f(b,p1[r+2],p1[r+3]);}
  const float m=max2f(a,b);
  auto rr=__builtin_amdgcn_permlane32_swap(__float_as_uint(m),__float_as_uint(m),false,false);
  return max2f(__uint_as_float(rr[0]),__uint_as_float(rr[1]));
}
__device__ __forceinline__ void pv(f32x16*o,int vb,bf16x8 pa0,bf16x8 pa1,bf16x8 pa2,bf16x8 pa3){
  #pragma unroll
  for(int d0=0;d0<2;++d0){s16x4 lo[4],hi[4];
    #pragma unroll
    for(int ks=0;ks<4;++ks){
      asm volatile("ds_read_b64_tr_b16 %0,%1 offset:%c2":"=&v"(lo[ks]):"v"(vb),"i"(d0*4096+ks*1024):"memory");
      asm volatile("ds_read_b64_tr_b16 %0,%1 offset:%c2":"=&v"(hi[ks]):"v"(vb),"i"(d0*4096+ks*1024+512):"memory");}
    asm volatile("s_waitcnt lgkmcnt(0)":::"memory");SBAR();
    #define PK(k) (bf16x8){lo[k][0],lo[k][1],lo[k][2],lo[k][3],hi[k][0],hi[k][1],hi[k][2],hi[k][3]}
    o[d0]=__builtin_amdgcn_mfma_f32_32x32x16_bf16(pa0,PK(0),o[d0],0,0,0);
    o[d0]=__builtin_amdgcn_mfma_f32_32x32x16_bf16(pa1,PK(1),o[d0],0,0,0);
    o[d0]=__builtin_amdgcn_mfma_f32_32x32x16_bf16(pa2,PK(2),o[d0],0,0,0);
    o[d0]=__builtin_amdgcn_mfma_f32_32x32x16_bf16(pa3,PK(3),o[d0],0,0,0);
    #undef PK
  }
}

#ifndef ATTN_STORE16
#define ATTN_STORE16(p,v) (*(u32x4*)(p)=(v))
#endif
template<int THRL> __device__ __forceinline__ void attn_unit(int b,int h,int qb,const bf16*Q,const bf16*__restrict__ K,const bf16*__restrict__ V,bf16*O,char*shm){
  const int tid=threadIdx.x,lane=tid&63,r32=lane&31,hi=lane>>5; const int wid=__builtin_amdgcn_readfirstlane(tid>>6);
  const long rowbase=(long)b*SEQ; const int q0=qb*QB;
  const bf16*Qw=Q+(rowbase+q0+wid*QBLK)*QP+h*D;
  const int hk=h/(NHEAD/NKVH); const bf16*Kh=K+rowbase*KP+hk*D,*Vh=V+rowbase*KP+hk*D;
  const unsigned lds0=(unsigned)(uintptr_t)shm;
  float*wsf=(float*)(shm+LDS_WS)+wid*64;
  const bf16*ksrc=Kh+(long)lane*KP+wid*8;
  const bf16*vsrc=Vh+(long)(16*(wid&3)+(lane>>2))*KP+(wid>>2)*32+(lane&3)*8;
  const unsigned kdst=lds0+LDS_K+wid*1024, vdst=lds0+LDS_V+wid*1024;
  #define DMA_K(t,slot) glds16(ksrc+(long)(t)*KVBLK*KP,(unsigned)__builtin_amdgcn_readfirstlane(kdst+(slot)))
  #define DMA_V(t,slot) glds16(vsrc+(long)(t)*KVBLK*KP,(unsigned)__builtin_amdgcn_readfirstlane(vdst+(slot)))
  const int vb0=(int)(lds0+LDS_V)+((lane>>4)&1)*32+(lane&3)*8+(4*hi+((lane&15)>>2))*64;
  const char*Kbase=shm+LDS_K; bf16x8 kf[8];
  const lds_cptr shm3=(lds_cptr)shm; const lds_cptr kp0=shm3+LDS_K+hi*1024+r32*16; const lds_cptr vp0=shm3+LDS_V+((lane>>4)&1)*32+(lane&3)*8+(4*hi+((lane&15)>>2))*64;
  constexpr int NT=SEQ/KVBLK;
  DMA_K(0,0);DMA_V(0,0);DMA_K(1,SLOTB);
  bf16x8 qr[4];
  #pragma unroll
  for(int d0=0;d0<4;++d0)qr[d0]=*reinterpret_cast<const bf16x8*>(&Qw[(long)r32*QP+d0*16+hi*8]);
  float mhat=0.f,l_reg=0.f;f32x16 o[2];o[0]=f32x16{};o[1]=f32x16{};f32x16 negm=f32x16{};asm volatile("":"+v"(negm));
  const int qrel=wid*QBLK+r32;
  #define CMASK(P0,P1,t) do{}while(0)
  bool resc=false;
  #define START(P0,P1) do{ const float rm=rowmax(P0,P1); resc=false; \
    { const float dl=rm; mhat=fadd_s(mhat,dl); \
      _Pragma("unroll") for(int r=0;r<16;++r){P0[r]=fsub_s(P0[r],dl);P1[r]=fsub_s(P1[r],dl);} \
      _Pragma("unroll") for(int r=0;r<16;++r)negm[r]=-mhat; asm volatile("":"+v"(negm)); } \
    _Pragma("unroll") for(int r=0;r<16;++r)P0[r]=__builtin_amdgcn_exp2f(P0[r]); }while(0)
  #define RESC() do{ if(resc){ asm volatile("s_waitcnt lgkmcnt(0)":::"memory"); \
      _Pragma("unroll") for(int d_=0;d_<2;++d_) _Pragma("unroll") for(int r=0;r<16;++r)o[d_][r]*=wsf[crow(r,hi)]; } }while(0)
  f32x16 pA0,pA1,pB0,pB1;
  int sl_prev=0,sl_cur=0,sl_next=SLOTB;
  #define ROT() do{sl_prev=sl_cur;sl_cur=sl_next;sl_next=(sl_next==(NSLOT-1)*SLOTB)?0:sl_next+SLOTB;}while(0)
  DMA_K(2,2*SLOTB);
  WAIT_BAR(3);
  qkt(pA0,pA1,Kbase,qr,negm,r32,hi);asm volatile("s_nop 15\n\ts_nop 7":"+v"(pA0),"+v"(pA1));CMASK(pA0,pA1,0);
  START(pA0,pA1);
  _Pragma("unroll") for(int r=0;r<16;++r)pA1[r]=__builtin_amdgcn_exp2f(pA1[r]);
  WAIT_BAR(0);
  DMA_K(3,0);DMA_V(1,SLOTB);
  ROT();
  kload8(kf,kp0+sl_cur);
  WAIT_BAR(2);
  s16x4 vlo[8],vhi[8]; u32x4 pw0,pw1,pw2,pw3;
  #define PKW(P,B) cvtpk_s(P[B],P[B+1])
  #define PAF(k) __builtin_bit_cast(bf16x8,pw##k)
  #define VFR(i) (bf16x8){vlo[i][0],vlo[i][1],vlo[i][2],vlo[i][3],vhi[i][0],vhi[i][1],vhi[i][2],vhi[i][3]}
  #define PIN(x) asm volatile("":"+v"(x))
  #define MX3(a,b,c) __builtin_fmaxf(__builtin_fmaxf((a),(b)),(c))
  #define GAPA(MF,A0,A1,A2,A3,W0,W1,PW) do{ MF; sacc+=A0; sacc+=A1; sacc+=A2; sacc+=A3; PIN(sacc); W0; W1; PIN(PW); SBAR(); }while(0)
  #define EX(v) __builtin_amdgcn_exp2f(v)
  #define GAPB(MF,X,B) do{ MF; X[B]=EX(X[B]); X[B+1]=EX(X[B+1]); X[B+2]=EX(X[B+2]); X[B+3]=EX(X[B+3]); PIN(X); SBAR(); }while(0)
  #define VRD(i) do{ vlo[i]=vtr(vp_+(((i)>>2)*4096+((i)&3)*1024)); vhi[i]=vtr(vp_+(((i)>>2)*4096+((i)&3)*1024+512)); }while(0)
  #define KRD(G,j) do{ if(G){ kload2(kf,kp0+sl_next,j); SBAR(); } }while(0)
  #define STEP(C0,C1,P0,P1,t,GK,GV,GL) do{ SBAR(); \
    const lds_cptr vp_=vp0+sl_prev; \
    VRD(0); SBAR(); float sacc=(P0[0]+P0[1]); \
    GAPA(C0=__builtin_amdgcn_mfma_f32_32x32x16_bf16(kf[0],qr[0],negm,0,0,0), P0[2],P0[3],P0[4],P0[5],     pw0[0]=PKW(P0,0), pw0[1]=PKW(P0,2), pw0); \
    VRD(4); SBAR(); GAPA(C1=__builtin_amdgcn_mfma_f32_32x32x16_bf16(kf[1],qr[0],negm,0,0,0), P0[6],P0[7],P0[8],P0[9],     pw0[2]=PKW(P0,4), pw0[3]=PKW(P0,6), pw0); \
    VRD(1); SBAR(); GAPA(C0=__builtin_amdgcn_mfma_f32_32x32x16_bf16(kf[2],qr[1],C0,0,0,0),   P0[10],P0[11],P0[12],P0[13], pw1[0]=PKW(P0,8), pw1[1]=PKW(P0,10), pw1); \
    VRD(5); SBAR(); GAPA(C1=__builtin_amdgcn_mfma_f32_32x32x16_bf16(kf[3],qr[1],C1,0,0,0),   P0[14],P0[15],P1[0],P1[1],   pw1[2]=PKW(P0,12),pw1[3]=PKW(P0,14), pw1); \
    VRD(2); SBAR(); GAPA(C0=__builtin_amdgcn_mfma_f32_32x32x16_bf16(kf[4],qr[2],C0,0,0,0),   P1[2],P1[3],P1[4],P1[5],     pw2[0]=PKW(P1,0), pw2[1]=PKW(P1,2), pw2); \
    VRD(6); SBAR(); GAPA(C1=__builtin_amdgcn_mfma_f32_32x32x16_bf16(kf[5],qr[2],C1,0,0,0),   P1[6],P1[7],P1[8],P1[9],     pw2[2]=PKW(P1,4), pw2[3]=PKW(P1,6), pw2); \
    VRD(3); SBAR(); GAPA(C0=__builtin_amdgcn_mfma_f32_32x32x16_bf16(kf[6],qr[3],C0,0,0,0),   P1[10],P1[11],P1[12],P1[13], pw3[0]=PKW(P1,8), pw3[1]=PKW(P1,10), pw3); \
    VRD(7); SBAR(); GAPA(C1=__builtin_amdgcn_mfma_f32_32x32x16_bf16(kf[7],qr[3],C1,0,0,0),   P1[14],P1[15],0.f,0.f,       pw3[2]=PKW(P1,12),pw3[3]=PKW(P1,14), pw3); \
    l_reg+=sacc; \
    if(GK){DMA_K((t)+3,sl_cur);} if(GV){DMA_V((t)+1,sl_next);} \
    CMASK(C0,C1,t); \
    { float a=MX3(C0[0],C0[1],C1[0]),b=MX3(C0[2],C0[3],C1[1]); a=MX3(a,C1[2],C1[3]); \
      _Pragma("unroll") for(int r=4;r<16;r+=4){a=MX3(a,C0[r],C0[r+1]);b=MX3(b,C0[r+2],C0[r+3]);a=MX3(a,C1[r],C1[r+1]);b=MX3(b,C1[r+2],C1[r+3]);} \
      float rm=__builtin_fmaxf(a,b); { auto rr=__builtin_amdgcn_permlane32_swap(__float_as_uint(rm),__float_as_uint(rm),false,false); rm=__builtin_fmaxf(__uint_as_float(rr[0]),__uint_as_float(rr[1])); } \
      resc=false; \
      if(__builtin_expect(__any(rm>(float)THRL),0)){ const float dl=__builtin_fmaxf(rm,0.f); mhat+=dl; \
        _Pragma("unroll") for(int r=0;r<16;++r){C0[r]-=dl;C1[r]-=dl;} \
        _Pragma("unroll") for(int r=0;r<16;++r)negm[r]=-mhat; asm volatile("":"+v"(negm)); \
        const float f=__builtin_amdgcn_exp2f(-dl); l_reg*=f; if(hi==0)wsf[r32]=f; resc=true; } } \
    SBAR(); \
    GAPB(o[0]=__builtin_amdgcn_mfma_f32_32x32x16_bf16(PAF(0),VFR(0),o[0],0,0,0), C0,0); \
    GAPB(o[1]=__builtin_amdgcn_mfma_f32_32x32x16_bf16(PAF(0),VFR(4),o[1],0,0,0), C0,4); \
    KRD(GL,0); GAPB(o[0]=__builtin_amdgcn_mfma_f32_32x32x16_bf16(PAF(1),VFR(1),o[0],0,0,0), C0,8); \
    KRD(GL,1); GAPB(o[1]=__builtin_amdgcn_mfma_f32_32x32x16_bf16(PAF(1),VFR(5),o[1],0,0,0), C0,12); \
    KRD(GL,2); GAPB(o[0]=__builtin_amdgcn_mfma_f32_32x32x16_bf16(PAF(2),VFR(2),o[0],0,0,0), C1,0); \
    KRD(GL,3); GAPB(o[1]=__builtin_amdgcn_mfma_f32_32x32x16_bf16(PAF(2),VFR(6),o[1],0,0,0), C1,4); \
    GAPB(o[0]=__builtin_amdgcn_mfma_f32_32x32x16_bf16(PAF(3),VFR(3),o[0],0,0,0), C1,8); \
    GAPB(o[1]=__builtin_amdgcn_mfma_f32_32x32x16_bf16(PAF(3),VFR(7),o[1],0,0,0), C1,12); \
    }while(0)
  int t=1;
  #undef CMASK
  #define CMASK(P0,P1,t) do{}while(0)
  for(;t+5<NT;t+=2){
    STEP(pB0,pB1,pA0,pA1,t,true,true,true);     WAIT_BAR(2); RESC(); ROT();
    STEP(pA0,pA1,pB0,pB1,t+1,true,true,true);   WAIT_BAR(2); RESC(); ROT();
  }
  #undef CMASK
  #define CMASK(P0,P1,t) do{}while(0)
  #define ENDW(tt) do{ if((tt)+3<NT){WAIT_BAR(2);} else if((tt)+2<NT){WAIT_BAR(1);} else {WAIT_BAR(0);} }while(0)
  for(;t+1<NT;t+=2){
    STEP(pB0,pB1,pA0,pA1,t,(t+3<NT),(t+1<NT),(t+1<NT));       ENDW(t);   RESC(); ROT();
    STEP(pA0,pA1,pB0,pB1,t+1,(t+4<NT),(t+2<NT),(t+2<NT));     ENDW(t+1); RESC(); ROT();
  }
  STEP(pB0,pB1,pA0,pA1,NT-1,false,false,false); RESC();
  { float sacc=pB0[0]+pB0[1]; _Pragma("unroll") for(int r=2;r<16;++r)sacc+=pB0[r]; _Pragma("unroll") for(int r=0;r<16;++r)sacc+=pB1[r]; l_reg+=sacc;
    pw0=(u32x4){PKW(pB0,0),PKW(pB0,2),PKW(pB0,4),PKW(pB0,6)};pw1=(u32x4){PKW(pB0,8),PKW(pB0,10),PKW(pB0,12),PKW(pB0,14)};pw2=(u32x4){PKW(pB1,0),PKW(pB1,2),PKW(pB1,4),PKW(pB1,6)};pw3=(u32x4){PKW(pB1,8),PKW(pB1,10),PKW(pB1,12),PKW(pB1,14)};
    SBAR(); pv(o,vb0+sl_cur,PAF(0),PAF(1),PAF(2),PAF(3)); }
  #undef PKW
  #undef PAF
  #undef VFR
  #undef PIN
  #undef MX3
  #undef GAPA
  #undef GAPB
  #undef EX
  #undef VRD
  #undef KRD
  #undef STEP
  #undef ENDW
  {auto rr=__builtin_amdgcn_permlane32_swap(__float_as_uint(l_reg),__float_as_uint(l_reg),false,false);l_reg=__uint_as_float(rr[0])+__uint_as_float(rr[1]);}
  if(hi==0)wsf[32+r32]=l_reg;asm volatile("s_waitcnt lgkmcnt(0)":::"memory");
  float rli[16];
  #pragma unroll
  for(int r=0;r<16;++r)rli[r]=__builtin_amdgcn_rcpf(wsf[32+crow(r,hi)]);
  bf16*Ow=O+(rowbase+q0+wid*QBLK)*OP+h*D;
  { bf16*stg=(bf16*)(shm+LDS_OST)+wid*2048;
    #pragma unroll
    for(int r=0;r<16;++r){const int orow=crow(r,hi);
      #pragma unroll
      for(int d0=0;d0<2;++d0)stg[orow*64+d0*32+r32]=__float2bfloat16(o[d0][r]*rli[r]);}
    asm volatile("s_waitcnt lgkmcnt(0)":::"memory");
    #pragma unroll
    for(int i=0;i<4;++i){const int row=i*8+(lane>>3),ch=lane&7; const u32x4 v=*(const u32x4*)(stg+row*64+ch*8); ATTN_STORE16(Ow+(long)row*OP+ch*8,v);} }
  asm volatile("s_waitcnt lgkmcnt(0)\n\ts_barrier":::"memory");
  #undef DMA_K
  #undef DMA_V
  #undef CMASK
  #undef START
  #undef RESC
  #undef ROT
}
constexpr int ATTN_LDS_BYTES=LDS_BYTES;
struct AttnTensors { const bf16* Q; const bf16* K; const bf16* V; bf16* O; };
struct AttnUnit { int bh; int qb; };
struct StaticOrder {
  int vcu, G;
  __device__ __forceinline__ explicit StaticOrder(int grid,int block):vcu((grid%8==0)?(block%8)*(grid/8)+block/8:block),G(grid){}
  __device__ __forceinline__ bool next(int i,AttnUnit&u)const{
    const int L=i*G+vcu; if(L>=BATCH*NHEAD*NQB)return false;
    if(G==256){ if(i>=2)return false; const int x=vcu>>5,j=vcu&31; const int b=x>>2,kvh=(x>>1)&1,hq=kvh*4+2*(x&1)+i; u.bh=b*NHEAD+hq; u.qb=j; return true; }
    u.bh=L/NQB; u.qb=L%NQB; return true; }
  __device__ __forceinline__ void a_ready(const AttnUnit&)const{}
  __device__ __forceinline__ void done(const AttnUnit&)const{}
};
template<class Sched,int THRL=8> __device__ __forceinline__ void attn_phase(char*lds,const AttnTensors&T,const Sched&S){
  AttnUnit u;
  for(int i=0;S.next(i,u);++i){ S.a_ready(u); attn_unit<THRL>(u.bh/NHEAD,u.bh%NHEAD,u.qb,T.Q,T.K,T.V,T.O,lds); S.done(u); }
}
#undef SBAR
#undef WAIT_BAR
}

#include <hip/hip_cooperative_groups.h>
namespace cg = cooperative_groups;
#ifndef MK_PER_PHASE
#define MK_PER_PHASE 0
#endif
constexpr int NWAVES = 8, NTHREADS = 512;
constexpr int NB = 2, SEQ = 8192, DMODEL = 1024, TT = NB * SEQ;
constexpr int NPROJ = 3072;
constexpr int NEXP = 32, FFE = 512;
constexpr float EPS = 1e-6f;
constexpr int N_PHASES = 12;

constexpr size_t MiB = 1u << 20;
constexpr size_t WS_CTL = 0, CTL_ZERO_BYTES = 64 * 1024;
constexpr size_t WS_WOUT = 1 * MiB;
constexpr size_t WS_WR = 3 * MiB;
constexpr size_t WS_TOK = 3 * MiB + 256 * 1024;
constexpr size_t WS_GATES = 4 * MiB;
constexpr size_t WS_WIN = 5 * MiB;
constexpr size_t WS_A = 11 * MiB;
constexpr size_t WS_XN = WS_A;
constexpr size_t GDN_SH_BYTES = 71680, GDN_D_BYTES = 19456;
constexpr size_t WS_GSH = WS_A;
constexpr size_t WS_GD = WS_A + 1024 * GDN_SH_BYTES;
constexpr size_t WS_WGU = WS_A;
constexpr size_t WS_WD = WS_A + 64 * MiB;
constexpr size_t WS_HID = WS_A + 96 * MiB;
constexpr size_t WS_B = 157 * MiB;
constexpr size_t WS_QKVA = WS_B;
constexpr size_t WS_QKVB = WS_B + 48 * MiB;
constexpr size_t WS_ZA = WS_B + 72 * MiB;
constexpr size_t WS_OCAT = WS_B;
constexpr size_t WS_XBUF = WS_B;
constexpr size_t WS_HN = WS_B + 80 * MiB;
constexpr size_t WS_END = 269 * MiB;
static_assert(WS_GD + 4096 * GDN_D_BYTES <= WS_B, "GDN records fit region A");
static_assert(WS_HID + 40928ull * 1024 <= WS_B, "HID fits region A");
static_assert(WS_HN + 32 * MiB <= WS_END, "HN");
constexpr size_t DO_QR = 0, DO_KR = 16 * MiB, DO_VR = 20 * MiB, DO_OF = 24 * MiB, DO_OB = 40 * MiB;
constexpr int CW_CNT = 64;
constexpr int CW_NTILE = 128;
constexpr int CW_TILES = 192;

constexpr int LDS_BYTES = 160 * 1024;

#define GAS __attribute__((address_space(1)))
#define LAS __attribute__((address_space(3)))
typedef unsigned short bf16;
typedef unsigned v4u __attribute__((ext_vector_type(4)));
typedef unsigned v2u __attribute__((ext_vector_type(2)));
typedef float f32x4 __attribute__((ext_vector_type(4)));
typedef short bf16x8 __attribute__((ext_vector_type(8)));
typedef short s16x4 __attribute__((ext_vector_type(4)));
#define DI __device__ __forceinline__

DI unsigned f2bf(float f) { unsigned u = __builtin_bit_cast(unsigned, f); return (u + 0x7fffu + ((u >> 16) & 1u)) >> 16; }
typedef float f32x2_t __attribute__((ext_vector_type(2))); typedef __bf16 bf16x2_t __attribute__((ext_vector_type(2)));
DI unsigned pk2(float lo, float hi) { f32x2_t v = {lo, hi}; bf16x2_t b = __builtin_convertvector(v, bf16x2_t); return __builtin_bit_cast(unsigned, b); }
DI float bf2f(unsigned short h) { return __builtin_bit_cast(float, (unsigned)h << 16); }
DI float bflo(unsigned w) { return __builtin_bit_cast(float, w << 16); }
DI float bfhi(unsigned w) { return __builtin_bit_cast(float, w & 0xffff0000u); }
DI float wave_sum(float v) {
#pragma unroll
    for (int o = 1; o < 64; o <<= 1) v += __shfl_xor(v, o);
    return v;
}
DI float siluf(float x) { return x * __builtin_amdgcn_rcpf(1.0f + __expf(-x)); }
DI float sigmoidf_(float x) { return 1.0f / (1.0f + __expf(-x)); }
DI int perm32i(int idx) { return ((idx >> 2) & 3) * 8 + (idx >> 4) * 4 + (idx & 3); }
DI int permcol(int c) { return (c & ~31) + perm32i(c & 31); }
template <class T> DI T opaque(T p) { asm volatile("" : "+v"(p)); return p; }

typedef GAS unsigned gu32;
#define RLX_AGENT __ATOMIC_RELAXED, __HIP_MEMORY_SCOPE_AGENT
constexpr int CW_BAR = 4096;
constexpr int MISC_OFF = LDS_BYTES - 64;
#define XB_TMO      128
#define XB_XCNT(j)  (256  + 64 * (j))
#define XB_XSUB(j)  (1280 + 64 * (j))
#define XB_XGEN(j)  (2304 + 64 * (j))
#define XB_TOP      3328
#define XB_TOPGEN   3392
#define XCD_BAR_WORDS 3456
#define XB_SPIN_CAP (1u << 18)

__device__ __forceinline__ unsigned xb_ld(unsigned* p)              { return __hip_atomic_load(p, __ATOMIC_RELAXED, __HIP_MEMORY_SCOPE_AGENT); }
__device__ __forceinline__ unsigned xb_add(unsigned* p, unsigned v) { return __hip_atomic_fetch_add(p, v, __ATOMIC_RELAXED, __HIP_MEMORY_SCOPE_AGENT); }
__device__ __forceinline__ unsigned xb_xcc_id() { return (unsigned)__builtin_amdgcn_s_getreg((3 << 11) | 20) & 0xFu; }
#define XB_SPIN(cond, bar) do { unsigned _sp = 0; while (cond) { __builtin_amdgcn_s_sleep(1); \
    if ((++_sp & 255u) == 0u) { if (xb_ld(&(bar)[XB_TMO])) break; if (_sp > XB_SPIN_CAP) { atomicAdd(&(bar)[XB_TMO], 1u); break; } } } } while (0)

struct XcdBarrier {
    unsigned* bar; unsigned x;
    volatile LAS unsigned* st;
};

__device__ __forceinline__ XcdBarrier xcd_barrier_post(unsigned* bar, volatile LAS unsigned* st) {
    XcdBarrier b; b.bar = bar; b.x = xb_xcc_id(); b.st = st;
    if (threadIdx.x == 0) (void)xb_add(&bar[XB_XCNT(b.x)], 1u);
    return b;
}
__device__ __forceinline__ void xcd_barrier_complete(unsigned* bar, unsigned x, unsigned& nloc, unsigned& nx) {
    const unsigned G = gridDim.x * gridDim.y * gridDim.z;
    unsigned sum, cnt, mine, sp = 0u;
    for (;;) {
        sum = 0u; cnt = 0u; mine = 0u;
#pragma unroll
        for (unsigned j = 0; j < 16; ++j) { const unsigned c = xb_ld(&bar[XB_XCNT(j)]); sum += c; cnt += (c > 0u) ? 1u : 0u; mine = (j == x) ? c : mine; }
        if (sum == G) break;
        __builtin_amdgcn_s_sleep(1);
        if ((++sp & 255u) == 0u) { if (xb_ld(&bar[XB_TMO])) break; if (sp > XB_SPIN_CAP) { atomicAdd(&bar[XB_TMO], 1u); break; } }
    }
    nloc = mine > 0u ? mine : 1u; nx = cnt > 0u ? cnt : 1u;
}

__device__ __forceinline__ void xcd_barrier(const XcdBarrier& b) {
    asm volatile("s_waitcnt vmcnt(0)" ::: "memory");
    __syncthreads();
    if (threadIdx.x == 0) {
        unsigned* bar = b.bar;
        __builtin_amdgcn_s_waitcnt(0);
        unsigned nloc = b.st[0], nx = b.st[1];
        if (nloc == 0u) { xcd_barrier_complete(bar, b.x, nloc, nx); b.st[0] = nloc; b.st[1] = nx; }
        const unsigned old = xb_add(&bar[XB_XSUB(b.x)], 1u);
        const unsigned gen = old / nloc;
        if (old + 1u == (gen + 1u) * nloc) {
            __builtin_amdgcn_fence(__ATOMIC_RELEASE, "agent");
            asm volatile("s_waitcnt vmcnt(0)" ::: "memory");
            const unsigned og = xb_add(&bar[XB_TOP], 1u);
            const unsigned tg = og / nx;
            if (og + 1u == (tg + 1u) * nx) xb_add(&bar[XB_TOPGEN], 1u);
            else XB_SPIN(xb_ld(&bar[XB_TOPGEN]) == tg, bar);
            __builtin_amdgcn_fence(__ATOMIC_ACQUIRE, "agent");
            xb_add(&bar[XB_XGEN(b.x)], 1u);
            asm volatile("s_waitcnt vmcnt(0)" ::: "memory");
        } else {
            XB_SPIN(xb_ld(&bar[XB_XGEN(b.x)]) == gen, bar);
            __builtin_amdgcn_fence(__ATOMIC_ACQUIRE, "agent");
            asm volatile("s_waitcnt vmcnt(0)" ::: "memory");
        }
    }
    __syncthreads();
}

struct Frame {
    LAS unsigned char* lds;
    int tid, lane, wave, vcu, G;
    const float* in[17];
    float* out; unsigned char* ws;
};

DI void p0_transpose_item(const float* W, int ldw, int nblk, bf16* WT, int K, int row_off, int rmul, LAS float* scr, int item, int lane) {
    const int kb = item / nblk, nb = item % nblk, k0 = 64 * kb, n0 = 32 * nb;
#pragma unroll 8
    for (int i = 0; i < 32; ++i) { const int kk = 2 * i + (lane >> 5); scr[kk * 33 + (lane & 31)] = W[(size_t)(k0 + kk) * ldw + n0 + (lane & 31)]; }
    asm volatile("s_waitcnt lgkmcnt(0)" ::: "memory");
    const int c = lane & 7;
#pragma unroll
    for (int j = 0; j < 4; ++j) { const int n = (lane >> 3) + 8 * j; const LAS float* s = scr + (8 * c) * 33 + n;
        v4u o; o.x = pk2(s[0 * 33], s[1 * 33]); o.y = pk2(s[2 * 33], s[3 * 33]); o.z = pk2(s[4 * 33], s[5 * 33]); o.w = pk2(s[6 * 33], s[7 * 33]);
        *(GAS v4u*)(WT + (size_t)(row_off + (n0 + n) * rmul) * K + k0 + 8 * c) = o; }
    asm volatile("s_waitcnt lgkmcnt(0)" ::: "memory");
}
DI void rms_row_to_bf16(const float* xrow, const float* w, bf16* orow, int lane) {
    const GAS f32x4* xr = (const GAS f32x4*)xrow + lane; const GAS f32x4* wr = (const GAS f32x4*)w + lane;
    f32x4 v[4]; float s = 0.f;
#pragma unroll
    for (int j = 0; j < 4; ++j) { v[j] = xr[64 * j]; s += (v[j].x * v[j].x + v[j].y * v[j].y) + (v[j].z * v[j].z + v[j].w * v[j].w); }
    const float rs = 1.0f / sqrtf(wave_sum(s) * (1.f / DMODEL) + EPS);
    GAS v2u* o8 = (GAS v2u*)orow + lane;
#pragma unroll
    for (int j = 0; j < 4; ++j) { const f32x4 ww = wr[64 * j]; v2u o; o.x = pk2(v[j].x * rs * ww.x, v[j].y * rs * ww.y); o.y = pk2(v[j].z * rs * ww.z, v[j].w * rs * ww.w); o8[64 * j] = o; }
}
DI void p0_prologue(Frame& F) {
    LAS float* scr = (LAS float*)(F.lds + F.wave * 16384);
    const int gw = F.vcu * NWAVES + F.wave, NGW = F.G * NWAVES;
    const float* w_in = F.in[2]; const float* w_out = F.in[9];
    bf16* WIN = (bf16*)(F.ws + WS_WIN); bf16* WOUT = (bf16*)(F.ws + WS_WOUT);
    constexpr int I1 = 16 * 64, I2 = 16 * 24, I3 = 16, I4 = 16 * 32, NITEMS = I1 + I2 + I3 + I4;
    for (int it = gw; it < NITEMS; it += NGW) {
        int r = it;
        if (r < I1) { p0_transpose_item(w_in, 2832, 64, WIN, 1024, 0, 1, scr, r, F.lane); continue; } r -= I1;
        if (r < I2) { p0_transpose_item(w_in + 2064, 2832, 24, WIN, 1024, 2048, 1, scr, r, F.lane); continue; } r -= I2;
        if (r < I3) { p0_transpose_item(w_in + 2048, 2832, 1, WIN, 1024, 2816, 1, scr, r, F.lane); continue; } r -= I3;
        p0_transpose_item(w_out, 1024, 32, WOUT, 1024, 0, 1, scr, r, F.lane);
    }
    { const int gt = F.vcu * NTHREADS + F.tid, GT = F.G * NTHREADS; GAS v4u* z = (GAS v4u*)(WIN + (size_t)2848 * 1024);
      for (int i = gt; i < 224 * 1024 * 2 / 16; i += GT) z[i] = (v4u){0u, 0u, 0u, 0u}; }
    { const int gt = F.vcu * NTHREADS + F.tid, GT = F.G * NTHREADS; bf16* WRH = (bf16*)(F.ws + WS_WR); bf16* WRL = WRH + 48 * 1024;
      const float* wrg = F.in[11]; const float* wre = F.in[12];
      for (int i = gt; i < 48 * 1024; i += GT) { const int j = i >> 10, k = i & 1023; float v = 0.f; if (j < 4) v = wrg[k * 4 + j]; else if (j < 36) v = wre[k * 32 + (j - 4)];
          const unsigned h = f2bf(v); const float hv = __builtin_bit_cast(float, h << 16); WRH[i] = (bf16)h; WRL[i] = (bf16)f2bf(v - hv); } }
    bf16* XN = (bf16*)(F.ws + WS_XN);
    for (int m = gw; m < TT; m += NGW) rms_row_to_bf16(F.in[0] + (size_t)m * DMODEL, F.in[1], XN + (size_t)m * DMODEL, F.lane);
}

struct EpiProj {
    static constexpr bool PERM = true, AFTER_DRAIN = false;
    bf16 *qkva, *za, *qkvb; float* gates;
    DI void operator()(const pg8::f32x4 (&acc)[2][2][4][2], const pg8::Unit& u, int wr, int wc, int fr, int fq) const {
        const int row0 = u.pm * 256 + wr * 64 + fr;
        if (u.pn == 11) {
            if (wc == 0 && fq < 2) {
#pragma unroll
                for (int ai = 0; ai < 2; ++ai)
#pragma unroll
                    for (int m = 0; m < 4; ++m) { float* rp = gates + (size_t)(row0 + ai * 128 + m * 16) * 16 + 8 * fq;
                        *(pg8::f32x4*)(rp) = acc[ai][0][m][0]; *(pg8::f32x4*)(rp + 4) = acc[ai][0][m][1]; }
            }
            return;
        }
        bf16* base; int ldc, colt;
        if (u.pn < 6) { base = qkva; ldc = 1536; colt = u.pn * 256; } else if (u.pn < 8) { base = za; ldc = 512; colt = (u.pn - 6) * 256; } else { base = qkvb; ldc = 768; colt = (u.pn - 8) * 256; }
        const int col0 = colt + wc * 32 + 8 * fq;
#pragma unroll
        for (int ai = 0; ai < 2; ++ai)
#pragma unroll
            for (int m = 0; m < 4; ++m) { bf16* rowp = base + (size_t)(row0 + ai * 128 + m * 16) * ldc + col0;
#pragma unroll
                for (int bj = 0; bj < 2; ++bj) { const pg8::f32x4 v0 = acc[ai][bj][m][0], v1 = acc[ai][bj][m][1]; pg8::u32x4 w;
                    w.x = pg8::cvt_pk_bf16(v0[0], v0[1]); w.y = pg8::cvt_pk_bf16(v0[2], v0[3]); w.z = pg8::cvt_pk_bf16(v1[0], v1[1]); w.w = pg8::cvt_pk_bf16(v1[2], v1[3]);
                    *(pg8::u32x4*)(rowp + bj * 128) = w; } }
    }
};
struct EpiResid {
    static constexpr bool PERM = false, AFTER_DRAIN = false;
    const float* x; float* x1;
    DI void operator()(const pg8::f32x4 (&acc)[2][2][4][2], const pg8::Unit& u, int wr, int wc, int fr, int fq) const {
        const int row0 = u.pm * 256 + wr * 64 + fr, col0 = u.pn * 256 + wc * 32 + 4 * fq;
#pragma unroll
        for (int ai = 0; ai < 2; ++ai)
#pragma unroll
            for (int m = 0; m < 4; ++m) { const size_t off = (size_t)(row0 + ai * 128 + m * 16) * DMODEL + col0;
#pragma unroll
                for (int bj = 0; bj < 2; ++bj)
#pragma unroll
                    for (int n = 0; n < 2; ++n) { const pg8::f32x4 b = *(const pg8::f32x4*)(x + off + bj * 128 + n * 16); *(pg8::f32x4*)(x1 + off + bj * 128 + n * 16) = b + acc[ai][bj][m][n]; } }
    }
};
struct EpiGU {
    static constexpr bool PERM = true, AFTER_DRAIN = false;
    bf16* hid;
    DI void operator()(const pg8::f32x4 (&acc)[2][2][4][2], const pg8::Unit& u, int wr, int wc, int fr, int fq) const {
        const int row0 = u.pm * 256 + wr * 64 + fr; const int jt = u.pn & 3;
        const int ff0 = jt * 128 + wc * 16 + 4 * fq;
#pragma unroll
        for (int ai = 0; ai < 2; ++ai)
#pragma unroll
            for (int m = 0; m < 4; ++m) { bf16* rowp = hid + (size_t)(row0 + ai * 128 + m * 16) * FFE + ff0;
#pragma unroll
                for (int bj = 0; bj < 2; ++bj) { const pg8::f32x4 v0 = acc[ai][bj][m][0], v1 = acc[ai][bj][m][1];
                    const float h0 = siluf(v0[0]) * v0[1], h1 = siluf(v0[2]) * v0[3], h2 = siluf(v1[0]) * v1[1], h3 = siluf(v1[2]) * v1[3];
                    v2u w; w.x = pg8::cvt_pk_bf16(h0, h1); w.y = pg8::cvt_pk_bf16(h2, h3);
                    *(v2u*)(rowp + bj * 64) = w; } }
    }
};
struct EpiY {
    static constexpr bool PERM = true, AFTER_DRAIN = false;
    bf16* y;
    DI void operator()(const pg8::f32x4 (&acc)[2][2][4][2], const pg8::Unit& u, int wr, int wc, int fr, int fq) const {
        const int row0 = u.pm * 256 + wr * 64 + fr; const int col0 = (u.pn & 3) * 256 + wc * 32 + 8 * fq;
#pragma unroll
        for (int ai = 0; ai < 2; ++ai)
#pragma unroll
            for (int m = 0; m < 4; ++m) { bf16* rowp = y + (size_t)(row0 + ai * 128 + m * 16) * DMODEL + col0;
#pragma unroll
                for (int bj = 0; bj < 2; ++bj) { const pg8::f32x4 v0 = acc[ai][bj][m][0], v1 = acc[ai][bj][m][1]; pg8::u32x4 w;
                    w.x = pg8::cvt_pk_bf16(v0[0], v0[1]); w.y = pg8::cvt_pk_bf16(v0[2], v0[3]); w.z = pg8::cvt_pk_bf16(v1[0], v1[1]); w.w = pg8::cvt_pk_bf16(v1[2], v1[3]);
                    *(pg8::u32x4*)(rowp + bj * 128) = w; } }
    }
};
struct MoeOrder {
    const unsigned* ctl; int G, c;
    DI bool next(int i, pg8::Unit& u) const {
        const int nt = (int)ctl[CW_NTILE]; const int L = i * G + c; if (L >= nt * 4) return false;
        const int t = L >> 2, j = L & 3; u.pm = (int)ctl[CW_TILES + 2 * t]; u.pn = (int)ctl[CW_TILES + 2 * t + 1] * 4 + j; return true; }
    DI void a_ready(const pg8::Unit&) const {}
    DI void done(const pg8::Unit&) const {}
};

DI void p2_rope(Frame& F) {
    const int gw = F.vcu * NWAVES + F.wave, NGW = F.G * NWAVES, lane = F.lane;
    const bf16* QKVB = (const bf16*)(F.ws + WS_QKVB);
    bf16* QR = (bf16*)((unsigned char*)F.out + DO_QR); bf16* KR = (bf16*)((unsigned char*)F.out + DO_KR); bf16* VR = (bf16*)((unsigned char*)F.out + DO_VR);
    const int pi = lane & 31, hsel = lane >> 5;
    const float qw0 = F.in[7][2 * pi], qw1 = F.in[7][2 * pi + 1], kw0 = F.in[8][2 * pi], kw1 = F.in[8][2 * pi + 1];
    const float invf = exp2f(-(float)(2 * (pi & 15)) * (13.287712379549449f / 32.0f));
    constexpr float C2 = 0.125f * 1.4426950408889634f;
    for (int t = gw; t < TT; t += NGW) {
        const int s = t & (SEQ - 1); const float pos = (pi < 16) ? (float)(s >> 6) : (float)(s & 63);
        const float ang = pos * invf;
        const double rev = (double)ang * 0.15915494309189535; const float fr = (float)(rev - floor(rev));
        const float sn = __builtin_amdgcn_sinf(fr), cs = __builtin_amdgcn_cosf(fr);
        const unsigned* src = (const unsigned*)(QKVB + (size_t)t * 768);
#pragma unroll
        for (int j = 0; j < 5; ++j) {
            const int head = 2 * j + hsel; const unsigned w = src[head * 32 + pi];
            const float x0 = bflo(w), x1 = bfhi(w);
            float ss = x0 * x0 + x1 * x1;
#pragma unroll
            for (int o = 1; o < 32; o <<= 1) ss += __shfl_xor(ss, o);
            const float rs = 1.0f / sqrtf(ss * (1.f / 64.f) + EPS);
            const bool isq = head < 8;
            const float y0 = x0 * rs * (isq ? qw0 : kw0), y1 = x1 * rs * (isq ? qw1 : kw1);
            float o0 = y0 * cs - y1 * sn, o1 = y0 * sn + y1 * cs;
            if (isq) { o0 *= C2; o1 *= C2; ((unsigned*)(QR + (size_t)t * 512))[head * 32 + pi] = pk2(o0, o1); }
            else ((unsigned*)(KR + (size_t)t * 128))[(head - 8) * 32 + pi] = pk2(o0, o1);
        }
        ((unsigned*)(VR + (size_t)t * 128))[lane] = src[320 + lane];
    }
}

constexpr int G_KNP = 0, G_QNP = 17408, G_KNTP = 34816, G_VCT = 53248;
constexpr int G_D0 = 71680, G_D1 = 71680 + 19456;
constexpr int GD_TBP = 0, GD_AP = 9216, GD_VEC = 18432;
constexpr int G_LM = 110592;
constexpr int G_GV = G_LM + 32768;
static_assert(G_GV + 1024 <= LDS_BYTES, "gdn pre lds");

#define TRI_ROW(i, LC, LN) { \
        if ((i) + 1 < 64) { _Pragma("unroll") for (int j4 = 0; j4 < ((i) + 1 + 3) / 4 && j4 < 8; ++j4) LN[j4] = *(const LAS f32x4*)(L + ((i) + 1) * 64 + 4 * j4); } \
        _Pragma("unroll") for (int j4 = 8; j4 < ((i) + 3) / 4; ++j4) lt[j4 - 8] = *(const LAS f32x4*)(L + (i) * 64 + 4 * j4); \
        __builtin_amdgcn_sched_barrier(0); \
        float a0 = (lane == (i)) ? 1.0f : 0.0f, a1 = 0.f; \
        _Pragma("unroll") for (int j4 = 0; j4 < ((i) + 3) / 4; ++j4) { const f32x4 l = (j4 < 8) ? LC[j4 & 7] : lt[(j4 - 8) & 7]; \
            if (4 * j4 + 0 < (i)) a0 -= l.x * x[4 * j4 + 0]; if (4 * j4 + 1 < (i)) a1 -= l.y * x[4 * j4 + 1]; \
            if (4 * j4 + 2 < (i)) a0 -= l.z * x[4 * j4 + 2]; if (4 * j4 + 3 < (i)) a1 -= l.w * x[4 * j4 + 3]; } \
        const float a = a0 + a1; x[(i)] = a; \
        TBP[(REV ? 63 - (i) : (i)) * 72 + pc] = (bf16)f2bf(a * bcol); \
        __builtin_amdgcn_sched_barrier(0); }
template <bool REV> DI void tri_inverse(LAS float* L, const LAS float* beta, LAS bf16* TBP, int lane) {
    float x[64];
    L = opaque(L); TBP = opaque(TBP); lane = opaque(lane);
    const float bcol = REV ? beta[63 - lane] : beta[lane];
    const int pc = REV ? permcol(63 - lane) : permcol(lane);
    f32x4 la[8], lb[8], lt[8];
#pragma unroll
    for (int ii = 0; ii < 64; ii += 2) { TRI_ROW(ii, la, lb) TRI_ROW(ii + 1, lb, la) }
}
#undef TRI_ROW

DI void p2_gdn_pre(Frame& F) {
    const int tid = F.tid, lane = F.lane, wave = F.wave;
    const bf16* QKVA = (const bf16*)(F.ws + WS_QKVA); const float* GATES = (const float*)(F.ws + WS_GATES);
    const float* convw = F.in[3];
#pragma unroll 1
    for (int task = F.vcu; task < 1024; task += F.G) {
        LAS unsigned char* lds = opaque(F.lds);
        LAS float* sGf = (LAS float*)(lds + G_GV); LAS float* sRb = sGf + 64; LAS float* sBf = sGf + 128; LAS float* sBb = sGf + 192;
        const int b = task >> 9, h = (task >> 7) & 3, n = task & 127;
        const int t0 = b * SEQ + n * 64;
#ifndef NO_CONV
        if (tid < 384) {
            const int cgp = tid % 48, rg = tid / 48, mat = cgp >> 4, cc = (cgp & 15) * 8;
            const int col = mat * 512 + h * 128 + cc;
            float w[5][8];
#pragma unroll
            for (int j = 0; j < 5; ++j) { const f32x4 a = *(const f32x4*)(convw + j * 1536 + col), bq = *(const f32x4*)(convw + j * 1536 + col + 4);
                w[j][0] = a.x; w[j][1] = a.y; w[j][2] = a.z; w[j][3] = a.w; w[j][4] = bq.x; w[j][5] = bq.y; w[j][6] = bq.z; w[j][7] = bq.w; }
            const int a4 = (cc >> 3) & 3, p0 = (cc & ~31) + 16 * (a4 & 1) + 4 * (a4 >> 1);
            const int ra = rg & 3, q0 = (rg >> 2) * 32 + 16 * (ra & 1) + 4 * (ra >> 1);
#pragma unroll
            for (int hf = 0; hf < 2; ++hf) {
                float o[4][8];
#pragma unroll
                for (int r = 0; r < 4; ++r)
#pragma unroll
                    for (int c = 0; c < 8; ++c) o[r][c] = 0.f;
#pragma unroll
                for (int i = 0; i < 8; ++i) {
                    const int pos = n * 64 + rg * 8 + hf * 4 - 2 + i;
                    v4u raw = (v4u){0u, 0u, 0u, 0u};
                    if (pos >= 0 && pos < SEQ) raw = *(const v4u*)(QKVA + (size_t)(b * SEQ + pos) * 1536 + col);
                    float xin[8] = {bflo(raw.x), bfhi(raw.x), bflo(raw.y), bfhi(raw.y), bflo(raw.z), bfhi(raw.z), bflo(raw.w), bfhi(raw.w)};
#pragma unroll
                    for (int j = 0; j < 5; ++j) { const int r = i - j; if (r >= 0 && r < 4) {
#pragma unroll
                        for (int c = 0; c < 8; ++c) o[r][c] += w[j][c] * xin[c]; } }
                }
#pragma unroll
                for (int r = 0; r < 4; ++r) {
                    float ss = 0.f;
#pragma unroll
                    for (int c = 0; c < 8; ++c) { o[r][c] = siluf(o[r][c]); ss += o[r][c] * o[r][c]; }
                    ss += __shfl_xor(ss, 1); ss += __shfl_xor(ss, 2); ss += __shfl_xor(ss, 4); ss += __shfl_xor(ss, 8);
                    float sc = 1.0f;
                    if (mat < 2) { sc = 1.0f / sqrtf(ss + EPS); if (mat == 0) sc *= 0.08838834764831845f; }
#pragma unroll
                    for (int c = 0; c < 8; ++c) o[r][c] *= sc;
                }
                if (mat < 2) {
                    LAS unsigned char* tile = lds + (mat == 0 ? G_QNP : G_KNP);
#pragma unroll
                    for (int r = 0; r < 4; ++r) { const int c = rg * 8 + hf * 4 + r;
                        v2u lo, hi2; lo.x = pk2(o[r][0], o[r][1]); lo.y = pk2(o[r][2], o[r][3]); hi2.x = pk2(o[r][4], o[r][5]); hi2.y = pk2(o[r][6], o[r][7]);
                        *(LAS v2u*)(tile + c * 272 + p0 * 2) = lo; *(LAS v2u*)(tile + c * 272 + (p0 + 8) * 2) = hi2; }
                }
                if (mat >= 1) {
#pragma unroll
                    for (int c = 0; c < 8; ++c) {
                        v2u q4; q4.x = pk2(o[0][c], o[1][c]); q4.y = pk2(o[2][c], o[3][c]);
                        if (mat == 1) *(LAS v2u*)(lds + G_KNTP + (cc + c) * 144 + (q0 + 8 * hf) * 2) = q4;
                        else *(LAS v2u*)(lds + G_VCT + (cc + c) * 144 + rg * 16 + hf * 8) = q4;
                    }
                }
            }
        } else
#endif
        if (wave == 7) {
            const float* gp = GATES + (size_t)(t0 + lane) * 16;
            const float bfv = gp[h], bbv = gp[4 + h], afv = gp[8 + h], abv = gp[12 + h];
            const float betaf = sigmoidf_(bfv), betab = sigmoidf_(bbv);
            const float xf = afv + F.in[5][h], xb = abv + F.in[5][4 + h];
            const float spf = fmaxf(xf, 0.f) + log1pf(__expf(-fabsf(xf))), spb = fmaxf(xb, 0.f) + log1pf(__expf(-fabsf(xb)));
            const float gf = -__expf(F.in[4][h]) * spf, gb = -__expf(F.in[4][4 + h]) * spb;
            float Gf = gf, Rb = gb;
#pragma unroll
            for (int o = 1; o < 64; o <<= 1) { const float u1 = __shfl_up(Gf, o); if (lane >= o) Gf += u1; const float d1 = __shfl_down(Rb, o); if (lane + o < 64) Rb += d1; }
            sGf[lane] = Gf; sRb[lane] = Rb; sBf[lane] = betaf; sBb[lane] = betab;
            const float GfL = __shfl(Gf, 63), Rb0 = __shfl(Rb, 0);
            LAS float* v0 = (LAS float*)(lds + G_D0 + GD_VEC); LAS float* v1 = (LAS float*)(lds + G_D1 + GD_VEC);
            v0[lane] = __expf(Gf); v0[64 + lane] = __expf(GfL - Gf); v1[lane] = __expf(Rb); v1[64 + lane] = __expf(Rb0 - Rb);
            if (lane == 0) { v0[128] = __expf(GfL); v1[128] = __expf(Rb0); }
        }
        __syncthreads();
        {
            const int p = wave >> 2, mt = wave & 3, n16 = lane & 15, g = lane >> 4;
            const LAS unsigned char* At = lds + (p == 0 ? G_KNP : G_QNP) + (16 * mt + n16) * 272 + g * 16;
            bf16x8 af[4];
#pragma unroll
            for (int ks = 0; ks < 4; ++ks) af[ks] = *(const LAS bf16x8*)(At + ks * 64);
#pragma unroll
            for (int nt = 0; nt < 4; ++nt) {
                const LAS unsigned char* Bt = lds + G_KNP + (16 * nt + n16) * 272 + g * 16;
                f32x4 acc = (f32x4){0.f, 0.f, 0.f, 0.f};
#pragma unroll
                for (int ks = 0; ks < 4; ++ks) acc = __builtin_amdgcn_mfma_f32_16x16x32_bf16(af[ks], *(const LAS bf16x8*)(Bt + ks * 64), acc, 0, 0, 0);
                const int s = 16 * nt + n16; const float Gs = sGf[s], Rs = sRb[s];
#pragma unroll
                for (int r = 0; r < 4; ++r) {
                    const int c = 16 * mt + 4 * g + r; const float v = acc[r];
                    const float df = __expf(fminf(sGf[c] - Gs, 0.f)), db = __expf(fminf(sRb[c] - Rs, 0.f));
                    if (p == 0) {
                        if (s < c) ((LAS float*)(lds + G_LM))[c * 64 + s] = sBf[c] * v * df;
                        if (s > c) ((LAS float*)(lds + G_LM + 16384))[(63 - c) * 64 + (63 - s)] = sBb[c] * v * db;
                    } else {
                        const int ps = permcol(s);
                        ((LAS bf16*)(lds + G_D0 + GD_AP))[c * 72 + ps] = (bf16)f2bf(s <= c ? v * df : 0.f);
                        ((LAS bf16*)(lds + G_D1 + GD_AP))[c * 72 + ps] = (bf16)f2bf(s >= c ? v * db : 0.f);
                    }
                }
            }
        }
        __syncthreads();
#ifndef NO_TRI
#ifdef PROBE_TRI2
        if (wave == 0) tri_inverse<false>((LAS float*)(lds + G_LM), sBf, (LAS bf16*)(lds + G_D0 + GD_TBP), lane);
        else if (wave == 1) tri_inverse<true>((LAS float*)(lds + G_LM + 16384), sBb, (LAS bf16*)(lds + G_D1 + GD_TBP), lane);
        __syncthreads();
#endif
        if (wave == 0) tri_inverse<false>((LAS float*)(lds + G_LM), sBf, (LAS bf16*)(lds + G_D0 + GD_TBP), lane);
        else if (wave == 1) tri_inverse<true>((LAS float*)(lds + G_LM + 16384), sBb, (LAS bf16*)(lds + G_D1 + GD_TBP), lane);
#endif
        __syncthreads();
        {
            const int bh = b * 4 + h;
            GAS v4u* gsh = (GAS v4u*)(F.ws + WS_GSH + (size_t)(bh * 128 + n) * GDN_SH_BYTES);
#pragma unroll 1
            for (int i = tid; i < (int)(GDN_SH_BYTES / 16); i += NTHREADS) gsh[i] = *(const LAS v4u*)(lds + i * 16);
            GAS v4u* gd0 = (GAS v4u*)(F.ws + WS_GD + (size_t)((bh * 2 + 0) * 128 + n) * GDN_D_BYTES);
            GAS v4u* gd1 = (GAS v4u*)(F.ws + WS_GD + (size_t)((bh * 2 + 1) * 128 + n) * GDN_D_BYTES);
#pragma unroll 1
            for (int i = tid; i < (int)(GDN_D_BYTES / 16); i += NTHREADS) { gd0[i] = *(const LAS v4u*)(lds + G_D0 + i * 16); gd1[i] = *(const LAS v4u*)(lds + G_D1 + i * 16); }
        }
        __syncthreads();
    }
}

DI bf16x8 pack8(const f32x4 a, const f32x4 b) {
    v4u p; p.x = pk2(a[0], a[1]); p.y = pk2(a[2], a[3]); p.z = pk2(b[0], b[1]); p.w = pk2(b[2], b[3]); return __builtin_bit_cast(bf16x8, p);
}
constexpr int SC_SLOT = 78848, SC_VCT = 53248, SC_D = 55552, SC_NCH = 11;
static_assert(2 * SC_SLOT <= LDS_BYTES, "scan slots");
DI void sc_issue(v4u (&R)[SC_NCH], const unsigned char* ws, const unsigned (&delta)[SC_NCH], const unsigned (&dmask)[SC_NCH], unsigned shbase, unsigned ddiff) {
#pragma unroll
    for (int j = 0; j < SC_NCH; ++j) { const unsigned off = shbase + delta[j] + (dmask[j] & ddiff);
#ifdef SC_PLAIN_LOADS
        R[j] = *(const v4u*)(ws + off); }
#else
        asm volatile("global_load_dwordx4 %0, %1, %2" : "=v"(R[j]) : "v"(off), "s"(ws) : "memory"); }
#endif
}
#ifdef SC_PLAIN_LOADS
#define SC_WAIT(R, n) do {} while (0)
#else
#define SC_WAIT(R, n) asm volatile("s_waitcnt vmcnt(" #n ")" : "+v"(R[0]), "+v"(R[1]), "+v"(R[2]), "+v"(R[3]), "+v"(R[4]), "+v"(R[5]), "+v"(R[6]), "+v"(R[7]), "+v"(R[8]), "+v"(R[9]), "+v"(R[10]) :: "memory")
#endif
DI void sc_write(const v4u (&R)[SC_NCH], LAS unsigned char* slot, int lid) {
#pragma unroll
    for (int j = 0; j < SC_NCH; ++j) *(LAS v4u*)(slot + 16 * (lid + 448 * j)) = R[j];
}
DI void p4_scan(Frame& F) {
    const int bx = blockIdx.x; if (bx >= 128) return;
    const int lane = F.lane, n16 = lane & 15, g = lane >> 4, wave = F.wave;
    const int x = bx & 7, jj = bx >> 3; const int chain = 2 * x + (jj >> 3), e = jj & 7;
    const int bh = chain >> 1, dir = chain & 1, b = bh >> 2, h = bh & 3;
    LAS unsigned char* lds = opaque(F.lds);
    if (wave != 0) {
        const int lid = (wave - 1) * 64 + lane;
        const unsigned sh0 = (unsigned)(WS_GSH + (size_t)(bh * 128) * GDN_SH_BYTES), d0 = (unsigned)(WS_GD + (size_t)((bh * 2 + dir) * 128) * GDN_D_BYTES);
        unsigned delta[SC_NCH], dmask[SC_NCH];
#pragma unroll
        for (int j = 0; j < SC_NCH; ++j) { const int c = lid + 448 * j;
            delta[j] = (c < 3328) ? 16u * c : ((c < 3472) ? (unsigned)(G_VCT + 16 * e * 144 + 16 * (c - 3328)) : 16u * (c - 3472));
            dmask[j] = (c < 3472) ? 0u : 0xffffffffu; }
        v4u R0[SC_NCH], R1[SC_NCH], R2[SC_NCH];
#define SC_SRC(st) const int n_ = (dir == 0) ? ((st) < 128 ? (st) : 127) : ((st) < 128 ? 127 - (st) : 0); \
                   const unsigned shb_ = sh0 + (unsigned)n_ * (unsigned)GDN_SH_BYTES, ddf_ = (d0 + (unsigned)n_ * (unsigned)GDN_D_BYTES) - shb_;
        { SC_SRC(0) sc_issue(R0, F.ws, delta, dmask, shb_, ddf_); }
        { SC_SRC(1) sc_issue(R1, F.ws, delta, dmask, shb_, ddf_); }
        { SC_SRC(2) sc_issue(R2, F.ws, delta, dmask, shb_, ddf_); }
#define SC_BODY(R, st) { SC_WAIT(R, 22); sc_write(R, lds + ((st) & 1) * SC_SLOT, lid); { SC_SRC((st) + 3) sc_issue(R, F.ws, delta, dmask, shb_, ddf_); } \
                        asm volatile("s_waitcnt lgkmcnt(0)" ::: "memory"); __builtin_amdgcn_s_barrier(); }
#pragma unroll 1
        for (int s0 = 0; s0 < 126; s0 += 3) { SC_BODY(R0, s0) SC_BODY(R1, s0 + 1) SC_BODY(R2, s0 + 2) }
        SC_BODY(R0, 126) SC_BODY(R1, 127)
        SC_WAIT(R0, 0); SC_WAIT(R1, 0); SC_WAIT(R2, 0);
#undef SC_BODY
#undef SC_SRC
        return;
    }
    bf16* Odir = (bf16*)((unsigned char*)F.out + (dir == 0 ? DO_OF : DO_OB));
    f32x4 S[8];
#pragma unroll
    for (int i = 0; i < 8; ++i) S[i] = (f32x4){0.f, 0.f, 0.f, 0.f};
    bf16x8 Sb[4];
#pragma unroll
    for (int i = 0; i < 4; ++i) Sb[i] = (bf16x8){0, 0, 0, 0, 0, 0, 0, 0};
    const int aoff272 = n16 * 272 + g * 16, aoff144 = n16 * 144 + g * 16;
#define SB_() __builtin_amdgcn_sched_barrier(0)
#pragma unroll 1
    for (int step = 0; step < 128; ++step) {
        __builtin_amdgcn_s_barrier();
        asm volatile("" ::: "memory");
        const int n = dir == 0 ? step : 127 - step;
        const LAS unsigned char* rsh = lds + (step & 1) * SC_SLOT;
        const LAS unsigned char* rd = rsh + SC_D;
        const LAS float* vec = (const LAS float*)(rd + GD_VEC);
        bf16x8 fa[16];
#pragma unroll
        for (int m = 0; m < 4; ++m)
#pragma unroll
            for (int i = 0; i < 4; ++i) fa[m * 4 + i] = *(const LAS bf16x8*)(rsh + G_KNP + m * (16 * 272) + aoff272 + i * 64);
        f32x4 eG[4], ks[4]; v2u vv[4];
#pragma unroll
        for (int m = 0; m < 4; ++m) { eG[m] = *(const LAS f32x4*)(vec + 16 * m + 4 * g); ks[m] = *(const LAS f32x4*)(vec + 64 + 16 * m + 4 * g);
            vv[m] = *(const LAS v2u*)(rsh + SC_VCT + n16 * 144 + (16 * m + 4 * g) * 2); }
        const float dch = vec[128];
        SB_();
        bf16x8 fq[16];
#pragma unroll
        for (int m = 0; m < 4; ++m)
#pragma unroll
            for (int i = 0; i < 4; ++i) fq[m * 4 + i] = *(const LAS bf16x8*)(rsh + G_QNP + m * (16 * 272) + aoff272 + i * 64);
        SB_();
        f32x4 KS[4];
#pragma unroll
        for (int m = 0; m < 4; ++m) KS[m] = (f32x4){0.f, 0.f, 0.f, 0.f};
#pragma unroll
        for (int i = 0; i < 4; ++i)
#pragma unroll
            for (int m = 0; m < 4; ++m) KS[m] = __builtin_amdgcn_mfma_f32_16x16x32_bf16(fa[m * 4 + i], Sb[i], KS[m], 0, 0, 0);
        SB_();
        bf16x8 ft[8];
#pragma unroll
        for (int m = 0; m < 4; ++m)
#pragma unroll
            for (int i = 0; i < 2; ++i) ft[m * 2 + i] = *(const LAS bf16x8*)(rd + GD_TBP + m * (16 * 144) + aoff144 + i * 64);
        SB_();
        f32x4 o[4];
#pragma unroll
        for (int m = 0; m < 4; ++m) o[m] = (f32x4){0.f, 0.f, 0.f, 0.f};
#pragma unroll
        for (int i = 0; i < 4; ++i)
#pragma unroll
            for (int m = 0; m < 4; ++m) o[m] = __builtin_amdgcn_mfma_f32_16x16x32_bf16(fq[m * 4 + i], Sb[i], o[m], 0, 0, 0);
        f32x4 rr[4];
#pragma unroll
        for (int m = 0; m < 4; ++m) { rr[m][0] = bflo(vv[m].x) - eG[m][0] * KS[m][0]; rr[m][1] = bfhi(vv[m].x) - eG[m][1] * KS[m][1]; rr[m][2] = bflo(vv[m].y) - eG[m][2] * KS[m][2]; rr[m][3] = bfhi(vv[m].y) - eG[m][3] * KS[m][3]; }
        bf16x8 rb[2]; rb[0] = pack8(rr[0], rr[1]); rb[1] = pack8(rr[2], rr[3]);
        SB_();
        bf16x8 fk[16];
#pragma unroll
        for (int jt = 0; jt < 8; ++jt)
#pragma unroll
            for (int i = 0; i < 2; ++i) fk[jt * 2 + i] = *(const LAS bf16x8*)(rsh + G_KNTP + jt * (16 * 144) + aoff144 + i * 64);
        SB_();
        f32x4 vn[4];
#pragma unroll
        for (int m = 0; m < 4; ++m) vn[m] = (f32x4){0.f, 0.f, 0.f, 0.f};
#pragma unroll
        for (int i = 0; i < 2; ++i)
#pragma unroll
            for (int m = 0; m < 4; ++m) vn[m] = __builtin_amdgcn_mfma_f32_16x16x32_bf16(ft[m * 2 + i], rb[i], vn[m], 0, 0, 0);
#pragma unroll
        for (int m = 0; m < 4; ++m) o[m] = o[m] * eG[m];
#pragma unroll
        for (int jt = 0; jt < 8; ++jt) S[jt] = S[jt] * dch;
        SB_();
        bf16x8 fp[8];
#pragma unroll
        for (int m = 0; m < 4; ++m)
#pragma unroll
            for (int i = 0; i < 2; ++i) fp[m * 2 + i] = *(const LAS bf16x8*)(rd + GD_AP + m * (16 * 144) + aoff144 + i * 64);
        SB_();
        bf16x8 vnb[2]; vnb[0] = pack8(vn[0], vn[1]); vnb[1] = pack8(vn[2], vn[3]);
        bf16x8 vs[2]; vs[0] = pack8(vn[0] * ks[0], vn[1] * ks[1]); vs[1] = pack8(vn[2] * ks[2], vn[3] * ks[3]);
#pragma unroll
        for (int i = 0; i < 2; ++i)
#pragma unroll
            for (int jt = 0; jt < 8; ++jt) S[jt] = __builtin_amdgcn_mfma_f32_16x16x32_bf16(fk[jt * 2 + i], vs[i], S[jt], 0, 0, 0);
#pragma unroll
        for (int i = 0; i < 2; ++i)
#pragma unroll
            for (int m = 0; m < 4; ++m) o[m] = __builtin_amdgcn_mfma_f32_16x16x32_bf16(fp[m * 2 + i], vnb[i], o[m], 0, 0, 0);
#pragma unroll
        for (int i = 0; i < 4; ++i) Sb[i] = pack8(S[2 * i], S[2 * i + 1]);
        asm volatile("s_waitcnt lgkmcnt(0)" ::: "memory");
        bf16* op = Odir + (size_t)(b * SEQ + n * 64) * 512 + h * 128 + 16 * e + n16;
#pragma unroll
        for (int m = 0; m < 4; ++m)
#pragma unroll
            for (int r = 0; r < 4; ++r) op[(size_t)(16 * m + 4 * g + r) * 512] = (bf16)(pk2(o[m][r], 0.f) & 0xffffu);
    }
#undef SB_
}

DI void p5_combine(Frame& F) {
    const int gw = F.vcu * NWAVES + F.wave, NGW = F.G * NWAVES, lane = F.lane;
    const bf16* OFp = (const bf16*)((unsigned char*)F.out + DO_OF); const bf16* OBp = (const bf16*)((unsigned char*)F.out + DO_OB);
    const bf16* ZA = (const bf16*)(F.ws + WS_ZA); bf16* OCAT = (bf16*)(F.ws + WS_OCAT);
    const float* nw = F.in[6] + (lane & 15) * 8;
    float w8[8];
#pragma unroll
    for (int c = 0; c < 8; ++c) w8[c] = nw[c];
    for (int t = gw; t < TT; t += NGW) {
        const v4u a = *(const v4u*)(OFp + (size_t)t * 512 + lane * 8), bb = *(const v4u*)(OBp + (size_t)t * 512 + lane * 8), z = *(const v4u*)(ZA + (size_t)t * 512 + lane * 8);
        float o[8] = {bflo(a.x) + bflo(bb.x), bfhi(a.x) + bfhi(bb.x), bflo(a.y) + bflo(bb.y), bfhi(a.y) + bfhi(bb.y), bflo(a.z) + bflo(bb.z), bfhi(a.z) + bfhi(bb.z), bflo(a.w) + bflo(bb.w), bfhi(a.w) + bfhi(bb.w)};
        const float zz[8] = {bflo(z.x), bfhi(z.x), bflo(z.y), bfhi(z.y), bflo(z.z), bfhi(z.z), bflo(z.w), bfhi(z.w)};
        float ss = 0.f;
#pragma unroll
        for (int c = 0; c < 8; ++c) ss += o[c] * o[c];
        ss += __shfl_xor(ss, 1); ss += __shfl_xor(ss, 2); ss += __shfl_xor(ss, 4); ss += __shfl_xor(ss, 8);
        const float rn = 1.0f / sqrtf(ss * (1.f / 128.f) + EPS);
#pragma unroll
        for (int c = 0; c < 8; ++c) o[c] = o[c] * rn * w8[c] * siluf(zz[c]);
        v4u r; r.x = pk2(o[0], o[1]); r.y = pk2(o[2], o[3]); r.z = pk2(o[4], o[5]); r.w = pk2(o[6], o[7]);
        *(v4u*)(OCAT + (size_t)t * 1024 + lane * 8) = r;
    }
}
DI void p5_moe_weights(Frame& F) {
    LAS float* scr = (LAS float*)(F.lds + F.wave * 16384);
    const int gw = F.vcu * NWAVES + F.wave, NGW = F.G * NWAVES;
    bf16* WGU = (bf16*)(F.ws + WS_WGU); bf16* WD = (bf16*)(F.ws + WS_WD);
    constexpr int IG = 16 * 16, ID = 8 * 32, IPE = 2 * IG + ID;
    for (int it = gw; it < NEXP * IPE; it += NGW) {
        const int e = it / IPE; int r = it % IPE;
        if (r < IG) { p0_transpose_item(F.in[13] + (size_t)e * 1024 * 512, 512, 16, WGU + (size_t)e * 1024 * 1024, 1024, 0, 2, scr, r, F.lane); continue; } r -= IG;
        if (r < IG) { p0_transpose_item(F.in[14] + (size_t)e * 1024 * 512, 512, 16, WGU + (size_t)e * 1024 * 1024, 1024, 1, 2, scr, r, F.lane); continue; } r -= IG;
        p0_transpose_item(F.in[15] + (size_t)e * 512 * 1024, 1024, 32, WD + (size_t)e * 1024 * 512, 512, 0, 1, scr, r, F.lane);
    }
}

struct TokRec { int e[2]; int row[2]; float gate[2]; };
DI void p7_route(Frame& F) {
    const int gw = F.vcu * NWAVES + F.wave, NGW = F.G * NWAVES, lane = F.lane, n16 = lane & 15, g = lane >> 4;
    const float* X1 = F.out; const float* nfw = F.in[10];
    const bf16* WRH = (const bf16*)(F.ws + WS_WR); const bf16* WRL = WRH + 48 * 1024;
    bf16* HN = (bf16*)(F.ws + WS_HN); TokRec* TOK = (TokRec*)(F.ws + WS_TOK); unsigned* cnt = (unsigned*)(F.ws + WS_CTL) + CW_CNT;
    LAS float* lg = (LAS float*)(F.lds + F.wave * 4096);
    for (int rt = gw; rt < TT / 16; rt += NGW) {
        const int row = rt * 16 + n16; const float* xr = X1 + (size_t)row * DMODEL + 8 * g;
        float ss = 0.f;
        for (int i = 0; i < 32; ++i) { const f32x4 a = *(const f32x4*)(xr + 32 * i), b2 = *(const f32x4*)(xr + 32 * i + 4);
            ss += (a.x * a.x + a.y * a.y) + (a.z * a.z + a.w * a.w) + (b2.x * b2.x + b2.y * b2.y) + (b2.z * b2.z + b2.w * b2.w); }
        ss += __shfl_xor(ss, 16); ss += __shfl_xor(ss, 32);
        const float rs = 1.0f / sqrtf(ss * (1.f / DMODEL) + EPS);
        f32x4 acc[3];
#pragma unroll
        for (int q = 0; q < 3; ++q) acc[q] = (f32x4){0.f, 0.f, 0.f, 0.f};
        for (int i = 0; i < 32; ++i) {
            const f32x4 a = *(const f32x4*)(xr + 32 * i), b2 = *(const f32x4*)(xr + 32 * i + 4);
            const f32x4 wa = *(const f32x4*)(nfw + 32 * i + 8 * g), wb = *(const f32x4*)(nfw + 32 * i + 8 * g + 4);
            float hv[8] = {a.x * rs * wa.x, a.y * rs * wa.y, a.z * rs * wa.z, a.w * rs * wa.w, b2.x * rs * wb.x, b2.y * rs * wb.y, b2.z * rs * wb.z, b2.w * rs * wb.w};
            v4u hi, lo; unsigned hh[8], ll[8];
#pragma unroll
            for (int c = 0; c < 8; ++c) { hh[c] = f2bf(hv[c]); ll[c] = f2bf(hv[c] - __builtin_bit_cast(float, hh[c] << 16)); }
            hi.x = hh[0] | (hh[1] << 16); hi.y = hh[2] | (hh[3] << 16); hi.z = hh[4] | (hh[5] << 16); hi.w = hh[6] | (hh[7] << 16);
            lo.x = ll[0] | (ll[1] << 16); lo.y = ll[2] | (ll[3] << 16); lo.z = ll[4] | (ll[5] << 16); lo.w = ll[6] | (ll[7] << 16);
            *(v4u*)(HN + (size_t)row * DMODEL + 32 * i + 8 * g) = hi;
            const bf16x8 ah = __builtin_bit_cast(bf16x8, hi), al = __builtin_bit_cast(bf16x8, lo);
#pragma unroll
            for (int q = 0; q < 3; ++q) {
                const bf16x8 bh = *(const bf16x8*)(WRH + (size_t)(16 * q + n16) * 1024 + 32 * i + 8 * g), bl = *(const bf16x8*)(WRL + (size_t)(16 * q + n16) * 1024 + 32 * i + 8 * g);
                acc[q] = __builtin_amdgcn_mfma_f32_16x16x32_bf16(ah, bh, acc[q], 0, 0, 0);
                acc[q] = __builtin_amdgcn_mfma_f32_16x16x32_bf16(ah, bl, acc[q], 0, 0, 0);
                acc[q] = __builtin_amdgcn_mfma_f32_16x16x32_bf16(al, bh, acc[q], 0, 0, 0);
            }
        }
#pragma unroll
        for (int q = 0; q < 3; ++q)
#pragma unroll
            for (int r = 0; r < 4; ++r) lg[(4 * g + r) * 48 + 16 * q + n16] = acc[q][r];
        asm volatile("s_waitcnt lgkmcnt(0)" ::: "memory");
        if (lane < 16) {
            const LAS float* L = lg + lane * 48; const int tok = rt * 16 + lane;
            float gm = L[0]; int gs = 0;
#pragma unroll
            for (int q = 1; q < 4; ++q) if (L[q] > gm) { gm = L[q]; gs = q; }
            float gsum = 0.f;
#pragma unroll
            for (int q = 0; q < 4; ++q) gsum += __expf(L[q] - gm);
            const float gp_top = 1.0f / gsum;
            float fv[8];
#pragma unroll
            for (int q = 0; q < 8; ++q) { float v = L[4 + q]; v = (gs == 1) ? L[12 + q] : v; v = (gs == 2) ? L[20 + q] : v; v = (gs == 3) ? L[28 + q] : v; fv[q] = v; }
            float m1 = fv[0]; int i1 = 0;
#pragma unroll
            for (int q = 1; q < 8; ++q) if (fv[q] > m1) { m1 = fv[q]; i1 = q; }
            float m2 = -3.0e38f; int i2 = 0;
#pragma unroll
            for (int q = 0; q < 8; ++q) if (q != i1 && fv[q] > m2) { m2 = fv[q]; i2 = q; }
            const float e2 = __expf(m2 - m1); const float g1 = gp_top / (1.0f + e2), g2 = gp_top * e2 / (1.0f + e2);
            const int ex1 = gs * 8 + i1, ex2 = gs * 8 + i2;
            const int s1 = (int)atomicAdd(cnt + ex1, 1u), s2 = (int)atomicAdd(cnt + ex2, 1u);
            TokRec tr; tr.e[0] = ex1; tr.e[1] = ex2; tr.row[0] = s1; tr.row[1] = s2; tr.gate[0] = g1; tr.gate[1] = g2;
            TOK[tok] = tr;
        }
        asm volatile("s_waitcnt lgkmcnt(0)" ::: "memory");
    }
}

DI void p8_gather(Frame& F) {
    const int gw = F.vcu * NWAVES + F.wave, NGW = F.G * NWAVES, lane = F.lane;
    unsigned* ctl = (unsigned*)(F.ws + WS_CTL);
    LAS int* pst = (LAS int*)(F.lds);
    if (F.tid == 0) {
        int acc = 0, nt = 0;
        for (int e = 0; e < NEXP; ++e) { const int c = (int)__hip_atomic_load(ctl + CW_CNT + e, __ATOMIC_RELAXED, __HIP_MEMORY_SCOPE_AGENT); pst[e] = acc; const int ntile = (c + 255) >> 8;
            if (blockIdx.x == 0) for (int q = 0; q < ntile; ++q) { ctl[CW_TILES + 2 * (nt + q)] = (unsigned)((acc >> 8) + q); ctl[CW_TILES + 2 * (nt + q) + 1] = (unsigned)e; }
            nt += ntile; acc += ntile * 256; }
        if (blockIdx.x == 0) ctl[CW_NTILE] = (unsigned)nt;
    }
    __syncthreads();
    const bf16* HN = (const bf16*)(F.ws + WS_HN); bf16* XB = (bf16*)(F.ws + WS_XBUF); TokRec* TOK = (TokRec*)(F.ws + WS_TOK);
    for (int t = gw; t < TT; t += NGW) {
        TokRec tr = TOK[t];
        const int r0 = pst[tr.e[0]] + tr.row[0], r1 = pst[tr.e[1]] + tr.row[1];
        const v4u a = *(const v4u*)(HN + (size_t)t * DMODEL + lane * 8), b2 = *(const v4u*)(HN + (size_t)t * DMODEL + 512 + lane * 8);
        *(v4u*)(XB + (size_t)r0 * DMODEL + lane * 8) = a; *(v4u*)(XB + (size_t)r0 * DMODEL + 512 + lane * 8) = b2;
        *(v4u*)(XB + (size_t)r1 * DMODEL + lane * 8) = a; *(v4u*)(XB + (size_t)r1 * DMODEL + 512 + lane * 8) = b2;
        if (lane == 0) { TOK[t].row[0] = r0; TOK[t].row[1] = r1; }
    }
}

DI void p11_final(Frame& F) {
    const int gw = F.vcu * NWAVES + F.wave, NGW = F.G * NWAVES, lane = F.lane;
    const bf16* Y = (const bf16*)(F.ws + WS_XBUF); const TokRec* TOK = (const TokRec*)(F.ws + WS_TOK); const float* fw = F.in[16];
    for (int t = gw; t < TT; t += NGW) {
        const TokRec tr = TOK[t];
        float* xr = F.out + (size_t)t * DMODEL + lane * 8;
        const f32x4 a = *(const f32x4*)(xr), b2 = *(const f32x4*)(xr + 4), c = *(const f32x4*)(xr + 512), d = *(const f32x4*)(xr + 516);
        float v[16] = {a.x, a.y, a.z, a.w, b2.x, b2.y, b2.z, b2.w, c.x, c.y, c.z, c.w, d.x, d.y, d.z, d.w};
#pragma unroll
        for (int k = 0; k < 2; ++k) {
            const float gk = tr.gate[k]; const bf16* yr = Y + (size_t)tr.row[k] * DMODEL + lane * 8;
            const v4u y0 = *(const v4u*)(yr), y1 = *(const v4u*)(yr + 512);
            v[0] += gk * bflo(y0.x); v[1] += gk * bfhi(y0.x); v[2] += gk * bflo(y0.y); v[3] += gk * bfhi(y0.y); v[4] += gk * bflo(y0.z); v[5] += gk * bfhi(y0.z); v[6] += gk * bflo(y0.w); v[7] += gk * bfhi(y0.w);
            v[8] += gk * bflo(y1.x); v[9] += gk * bfhi(y1.x); v[10] += gk * bflo(y1.y); v[11] += gk * bfhi(y1.y); v[12] += gk * bflo(y1.z); v[13] += gk * bfhi(y1.z); v[14] += gk * bflo(y1.w); v[15] += gk * bfhi(y1.w);
        }
        float ss = 0.f;
#pragma unroll
        for (int i = 0; i < 16; ++i) ss += v[i] * v[i];
        const float rs = 1.0f / sqrtf(wave_sum(ss) * (1.f / DMODEL) + EPS);
        const f32x4 w0 = *(const f32x4*)(fw + lane * 8), w1 = *(const f32x4*)(fw + lane * 8 + 4), w2 = *(const f32x4*)(fw + 512 + lane * 8), w3 = *(const f32x4*)(fw + 516 + lane * 8);
        *(f32x4*)(xr) = (f32x4){v[0] * rs * w0.x, v[1] * rs * w0.y, v[2] * rs * w0.z, v[3] * rs * w0.w};
        *(f32x4*)(xr + 4) = (f32x4){v[4] * rs * w1.x, v[5] * rs * w1.y, v[6] * rs * w1.z, v[7] * rs * w1.w};
        *(f32x4*)(xr + 512) = (f32x4){v[8] * rs * w2.x, v[9] * rs * w2.y, v[10] * rs * w2.z, v[11] * rs * w2.w};
        *(f32x4*)(xr + 516) = (f32x4){v[12] * rs * w3.x, v[13] * rs * w3.y, v[14] * rs * w3.z, v[15] * rs * w3.w};
    }
}

struct Args { const float* in[17]; float* out; unsigned char* ws; int ph_lo, ph_hi; };
__global__ void __launch_bounds__(NTHREADS, 2) fwd_kernel(Args args) {
    extern __shared__ __attribute__((aligned(16))) unsigned char lds[];
    cg::grid_group grid = cg::this_grid();
    Frame F;
    F.lds = (LAS unsigned char*)lds; F.tid = threadIdx.x; F.lane = F.tid & 63; F.wave = __builtin_amdgcn_readfirstlane(F.tid >> 6);
    F.G = gridDim.x; { const int bx = blockIdx.x; F.vcu = (F.G % 8 == 0) ? (bx % 8) * (F.G / 8) + bx / 8 : bx; }
#pragma unroll
    for (int i = 0; i < 17; ++i) F.in[i] = args.in[i];
    F.out = args.out; F.ws = args.ws;
    const int lo = args.ph_lo, hi = args.ph_hi;
    if (F.tid < 16) ((volatile LAS unsigned*)(F.lds + MISC_OFF))[F.tid] = 0u;
    __syncthreads();
    XcdBarrier bar = xcd_barrier_post((unsigned*)(F.ws + WS_CTL) + CW_BAR, (volatile LAS unsigned*)(F.lds + MISC_OFF));
    if (lo > 1000) grid.sync();
#ifndef PHSEL
#define PHSEL 0xfff
#endif
#define IN(k) (((PHSEL >> (k)) & 1) && lo <= (k) && (k) < hi)
#define SEAM(k) do { if (IN(k) && IN((k) + 1)) xcd_barrier(bar); } while (0)
#ifndef REP_PH
#define REP_PH -1
#endif
#define REPS(k) for (int rep_ = 0; rep_ < ((k) == REP_PH ? 2 : 1); ++rep_, ((k) == REP_PH && rep_ < 2) ? xcd_barrier(bar) : (void)0)
    if (IN(0)) REPS(0) { p0_prologue(F); } SEAM(0);
    if (IN(1)) REPS(1) {
        pg8::Gemm gm{(const pg8::bf16_t*)(F.ws + WS_XN), (const pg8::bf16_t*)(F.ws + WS_WIN), TT, NPROJ, DMODEL}; pg8::StaticOrder S; S.init(TT, NPROJ, F.G, (int)blockIdx.x);
        EpiProj E{(bf16*)(F.ws + WS_QKVA), (bf16*)(F.ws + WS_ZA), (bf16*)(F.ws + WS_QKVB), (float*)(F.ws + WS_GATES)};
        pg8::gemm_phase<EpiProj, pg8::StaticOrder, true, true>(F.lds, gm, S, E);
    } SEAM(1);
    if (IN(2)) REPS(2) {
#ifndef NO_ROPE
        p2_rope(F);
#endif
#ifndef NO_PRE
        p2_gdn_pre(F);
#endif
    } SEAM(2);
    if (IN(3)) REPS(3) {
        const attn_body::AttnTensors AT{(const attn_body::bf16*)((unsigned char*)F.out + DO_QR), (const attn_body::bf16*)((unsigned char*)F.out + DO_KR), (const attn_body::bf16*)((unsigned char*)F.out + DO_VR),
                                        (attn_body::bf16*)(F.ws + WS_OCAT) + 512};
        const attn_body::StaticOrder S((int)F.G, (int)blockIdx.x);
#ifdef PROBE_ZERO_ATTN
        { (void)AT; (void)S; bf16* OC = (bf16*)(F.ws + WS_OCAT); const int gt = blockIdx.x * NTHREADS + F.tid, GT = F.G * NTHREADS;
          for (int i = gt; i < TT * 64; i += GT) { const int t = i >> 6, c = i & 63; *(v4u*)(OC + (size_t)t * 1024 + 512 + c * 8) = (v4u){0u, 0u, 0u, 0u}; } }
#else
        attn_body::attn_phase<attn_body::StaticOrder>((char*)lds, AT, S);
#endif
    } SEAM(3);
    if (IN(4)) REPS(4) { p4_scan(F); } SEAM(4);
    if (IN(5)) REPS(5) { p5_combine(F); p5_moe_weights(F); } SEAM(5);
    if (IN(6)) REPS(6) {
        pg8::Gemm gm{(const pg8::bf16_t*)(F.ws + WS_OCAT), (const pg8::bf16_t*)(F.ws + WS_WOUT), TT, DMODEL, DMODEL}; pg8::StaticOrder S; S.init(TT, DMODEL, F.G, (int)blockIdx.x);
        EpiResid E{F.in[0], F.out};
        pg8::gemm_phase<EpiResid, pg8::StaticOrder, true, true>(F.lds, gm, S, E);
    } SEAM(6);
    if (IN(7)) { p7_route(F); } SEAM(7);
    if (IN(8)) { p8_gather(F); } SEAM(8);
    if (IN(9)) REPS(9) {
        pg8::Gemm gm{(const pg8::bf16_t*)(F.ws + WS_XBUF), (const pg8::bf16_t*)(F.ws + WS_WGU), 0, 0, DMODEL}; MoeOrder S{(const unsigned*)(F.ws + WS_CTL), F.G, (int)blockIdx.x};
        EpiGU E{(bf16*)(F.ws + WS_HID)};
        pg8::gemm_phase<EpiGU, MoeOrder, true, true>(F.lds, gm, S, E);
    } SEAM(9);
    if (IN(10)) REPS(10) {
        pg8::Gemm gm{(const pg8::bf16_t*)(F.ws + WS_HID), (const pg8::bf16_t*)(F.ws + WS_WD), 0, 0, FFE}; MoeOrder S{(const unsigned*)(F.ws + WS_CTL), F.G, (int)blockIdx.x};
        EpiY E{(bf16*)(F.ws + WS_XBUF)};
        pg8::gemm_phase<EpiY, MoeOrder, true, true>(F.lds, gm, S, E);
    } SEAM(10);
#ifdef EXTRA_SYNCS
    for (int q_ = 0; q_ < EXTRA_SYNCS; ++q_) xcd_barrier(bar);
#endif
    if (IN(11)) { p11_final(F); }
#undef IN
#undef SEAM
}

extern "C" void kernel_launch(void* const* d_in, const int* in_sizes, int n_in, void* d_out, int out_size, void* d_ws, size_t ws_size, hipStream_t stream) {
    static int grid = 0;
    if (grid == 0) {
        if (n_in != 17 || out_size != TT * DMODEL || ws_size < WS_END) { fprintf(stderr, "kernel_launch: unexpected problem (n_in %d out %d ws %zu)\n", n_in, out_size, ws_size); grid = -1; return; }
        int dev = 0, cus = 0, per_cu = 0;
        if (hipGetDevice(&dev) != hipSuccess || hipDeviceGetAttribute(&cus, hipDeviceAttributeMultiprocessorCount, dev) != hipSuccess) { grid = -1; return; }
        if (hipFuncSetAttribute((const void*)fwd_kernel, hipFuncAttributeMaxDynamicSharedMemorySize, LDS_BYTES) != hipSuccess) { fprintf(stderr, "hipFuncSetAttribute failed\n"); grid = -1; return; }
        if (hipOccupancyMaxActiveBlocksPerMultiprocessor(&per_cu, (const void*)fwd_kernel, NTHREADS, LDS_BYTES) != hipSuccess || per_cu < 1) { fprintf(stderr, "occupancy query: %d\n", per_cu); grid = -1; return; }
        grid = cus;
    }
    if (grid < 0) return;
    (void)hipMemsetAsync((char*)d_ws + WS_CTL, 0, CTL_ZERO_BYTES, stream);
    Args a{};
    for (int i = 0; i < 17; ++i) a.in[i] = (const float*)d_in[i];
    a.out = (float*)d_out; a.ws = (unsigned char*)d_ws;
#if MK_PER_PHASE
    for (int p = 0; p < N_PHASES; ++p) { a.ph_lo = p; a.ph_hi = p + 1; hipLaunchKernelGGL(fwd_kernel, dim3(grid), dim3(NTHREADS), LDS_BYTES, stream, a); }
#else
    a.ph_lo = 0; a.ph_hi = N_PHASES;
    void* kargs[] = {&a};
    hipError_t e = hipLaunchCooperativeKernel((void*)fwd_kernel, dim3(grid), dim3(NTHREADS), kargs, LDS_BYTES, stream);
    if (e != hipSuccess) fprintf(stderr, "cooperative launch failed: %s (grid %d)\n", hipGetErrorString(e), grid);
#endif
}
```

```cpp
#include <hip/hip_runtime.h>
#include <cstdio>
#include <cstdint>
namespace pg8 {
#define PG8_LAS __attribute__((address_space(3)))
typedef unsigned short bf16_t;
typedef short bf16x8 __attribute__((ext_vector_type(8)));
typedef float f32x4 __attribute__((ext_vector_type(4)));
typedef unsigned u32x4 __attribute__((ext_vector_type(4)));
constexpr int BM = 256, BK = 64, HALF = 128, HTB = HALF * BK * 2  , STAGE_BYTES = 8 * HTB, NXCD = 8, WGM = 8;

__host__ __device__ __forceinline__ int lds_byte(int r, int c) { const int st = (r >> 4) * 2 + (c >> 5), rr = r & 15, cc = c & 31, ob = rr * 64 + cc * 2; return st * 1024 + (ob ^ (((ob >> 9) & 1) << 5)); }
__host__ __device__ __forceinline__ void stage_rc(int b, int& R, int& C) { const int st = b / 1024, sb = b % 1024, swz = sb ^ (((sb >> 9) & 1) << 5); R = (st >> 1) * 16 + swz / 64; C = (st & 1) * 32 + (swz % 64) / 2; }
__host__ __device__ __forceinline__ int perm32(int rho) { const int n = rho >> 4, i = rho & 15; return 8 * (i >> 2) + 4 * n + (i & 3); }

struct Unit { int pm, pn; };
struct Gemm { const bf16_t* A; const bf16_t* Bt; int M, N, K; };

struct StaticOrder {
    int nM, nN, nwg, G, c;
    __host__ __device__ void init(int M, int N, int G_, int c_) { nM = M / BM; nN = N / BM; nwg = nM * nN; G = G_; c = c_; }
    __host__ __device__ bool next(int i, Unit& u) const {
        const long L = (long)i * G + c; if (L >= nwg) return false;
        int wgid = (int)L; { const int q = nwg / NXCD, r = nwg % NXCD, xcd = wgid % NXCD, off = wgid / NXCD; wgid = (xcd < r ? xcd * (q + 1) : r * (q + 1) + (xcd - r) * q) + off; }
        const int nig = WGM * nN, gid = wgid / nig, fm = gid * WGM, gsz = (nM - fm) < WGM ? (nM - fm) : WGM;
        u.pm = fm + ((wgid % nig) % gsz); u.pn = (wgid % nig) / gsz; return true;
    }
    __device__ __forceinline__ void a_ready(const Unit&) const {}
    __device__ __forceinline__ void done(const Unit&) const {}
};

__device__ __forceinline__ unsigned cvt_pk_bf16(float lo, float hi) { unsigned r; asm volatile("v_cvt_pk_bf16_f32 %0, %1, %2" : "=v"(r) : "v"(lo), "v"(hi)); return r; }
typedef float f32x2 __attribute__((ext_vector_type(2)));
template <class Epi, class Sched, bool ALIGN_EPI = false, bool SP2 = false>
__device__ __forceinline__ void gemm_phase(PG8_LAS unsigned char* lds, const Gemm g, const Sched& S, const Epi& E) {
    const int tid = threadIdx.x, wid = __builtin_amdgcn_readfirstlane(tid >> 6), lane = tid & 63, wr = wid >> 2, wc = wid & 3, fr = lane & 15, fq = lane >> 4;
    const int K = g.K, nt = K / BK;
    unsigned voffA[2], voffB[2];
#pragma unroll
    for (int i = 0; i < 2; ++i) { int R, C; stage_rc(tid * 16 + i * 8192, R, C); const int Rb = Epi::PERM ? ((R & ~31) + perm32(R & 31)) : R;
        voffA[i] = (unsigned)(R * K + C) * 2u; voffB[i] = (unsigned)(Rb * K + C) * 2u; }
    const size_t kstep = (size_t)(BK * 2);
    const size_t hstep = (size_t)HALF * K * 2;
    const size_t tstep = 2 * hstep;
    const unsigned ldsw = (unsigned)wid * 1024u;
    const int aoff = lds_byte(wr * 64 + fr, fq * 8), boff = lds_byte(wc * 32 + fr, fq * 8);
#define PG8_SA(b, h) (((b) * 2 + (h)) * HTB)
#define PG8_SB(b, h) ((4 + (b) * 2 + (h)) * HTB)
#define PG8_STAGE(bufoff, gbase, voff) do { _Pragma("unroll") for (int _i = 0; _i < 2; ++_i) \
        __builtin_amdgcn_global_load_lds((const unsigned*)((const char*)(gbase) + (voff)[_i]), (PG8_LAS unsigned*)(lds + (bufoff) + ldsw + _i * 8192), 16, 0, 0); } while (0)
#define PG8_LDA(dst, b, h) do { _Pragma("unroll") for (int m = 0; m < 4; ++m) _Pragma("unroll") for (int k = 0; k < 2; ++k) dst[m][k] = *(const PG8_LAS bf16x8*)(lds + PG8_SA(b, h) + aoff + m * 2048 + k * 1024); } while (0)
#define PG8_LDB(dst, b, h) do { _Pragma("unroll") for (int n = 0; n < 2; ++n) _Pragma("unroll") for (int k = 0; k < 2; ++k) dst[n][k] = *(const PG8_LAS bf16x8*)(lds + PG8_SB(b, h) + boff + n * 2048 + k * 1024); } while (0)
#define PG8_MMA(ai, bj, At, Bt) do { __builtin_amdgcn_s_setprio(1); _Pragma("unroll") for (int m = 0; m < 4; ++m) _Pragma("unroll") for (int n = 0; n < 2; ++n) _Pragma("unroll") for (int k = 0; k < 2; ++k) \
        acc[ai][bj][m][n] = __builtin_amdgcn_mfma_f32_16x16x32_bf16(Bt[n][k], At[m][k], acc[ai][bj][m][n], 0, 0, 0); __builtin_amdgcn_s_setprio(0); } while (0)
#define PG8_WAIT_V(n) asm volatile("s_waitcnt vmcnt(" #n ")" ::: "memory")
#define PG8_WAIT_L(n) asm volatile("s_waitcnt lgkmcnt(" #n ")" ::: "memory")
#define PG8_BAR __builtin_amdgcn_s_barrier()
#define PG8_SCHED __builtin_amdgcn_sched_barrier(0)
    Unit cur, nxt; int ui = 0;
    if (!S.next(0, cur)) return;
    f32x4 acc[2][2][4][2];
#pragma unroll
    for (int a = 0; a < 2; ++a)
#pragma unroll
        for (int b = 0; b < 2; ++b)
#pragma unroll
            for (int m = 0; m < 4; ++m)
#pragma unroll
                for (int n = 0; n < 2; ++n) acc[a][b][m][n] = (f32x4){0.f, 0.f, 0.f, 0.f};
    bf16x8 At[4][2], B0[2][2], B1[2][2];
    const char* cA = (const char*)g.A + (size_t)cur.pm * tstep; const char* cB = (const char*)g.Bt + (size_t)cur.pn * tstep;
    S.a_ready(cur);
    if constexpr (SP2) {
        PG8_STAGE(PG8_SB(0, 0), cB, voffB); PG8_STAGE(PG8_SB(0, 1), cB + hstep, voffB); PG8_STAGE(PG8_SA(0, 0), cA, voffA); PG8_STAGE(PG8_SA(0, 1), cA + hstep, voffA);
        if (wr == 1) PG8_BAR;
        PG8_WAIT_V(2); PG8_BAR;
        PG8_STAGE(PG8_SB(1, 0), cB + kstep, voffB); PG8_STAGE(PG8_SA(1, 0), cA + kstep, voffA); PG8_STAGE(PG8_SB(1, 1), cB + hstep + kstep, voffB);
        PG8_WAIT_V(6); PG8_BAR;
    } else {
        PG8_STAGE(PG8_SB(0, 0), cB, voffB); PG8_STAGE(PG8_SA(0, 0), cA, voffA); PG8_STAGE(PG8_SB(0, 1), cB + hstep, voffB); PG8_STAGE(PG8_SA(0, 1), cA + hstep, voffA);
        if (wr == 1) PG8_BAR;
        PG8_WAIT_V(4); PG8_BAR;
        PG8_STAGE(PG8_SB(1, 0), cB + kstep, voffB); PG8_STAGE(PG8_SA(1, 0), cA + kstep, voffA); PG8_STAGE(PG8_SB(1, 1), cB + hstep + kstep, voffB);
        PG8_WAIT_V(6); PG8_BAR;
    }
    for (;;) {
        const bool has_next = S.next(ui + 1, nxt);
        const char* nA = has_next ? (const char*)g.A + (size_t)nxt.pm * tstep : cA; const char* nB = has_next ? (const char*)g.Bt + (size_t)nxt.pn * tstep : cB;
        for (int t = 0; t < nt; t += 2) {
            const bool last = (t == nt - 2);
            const char* a1 = cA + (size_t)(t + 1) * kstep;
            const char* a2 = last ? nA : cA + (size_t)(t + 2) * kstep; const char* b2 = last ? nB : cB + (size_t)(t + 2) * kstep;
            const char* a3 = a2 + kstep; const char* b3 = b2 + kstep;
            if (last && has_next) S.a_ready(nxt);
            if constexpr (SP2) {
            PG8_LDB(B0, 0, 0); PG8_LDB(B1, 0, 1); PG8_SCHED; PG8_LDA(At, 0, 0); PG8_STAGE(PG8_SA(1, 1), a1 + hstep, voffA);
            PG8_WAIT_V(8); PG8_WAIT_L(0); PG8_BAR; PG8_MMA(0, 0, At, B0); PG8_MMA(0, 1, At, B1); PG8_BAR; PG8_SCHED;
            PG8_LDA(At, 0, 1); PG8_STAGE(PG8_SB(0, 0), b2, voffB); PG8_STAGE(PG8_SB(0, 1), b2 + hstep, voffB); PG8_STAGE(PG8_SA(0, 0), a2, voffA);
            PG8_WAIT_V(8); PG8_WAIT_L(0); PG8_BAR; PG8_MMA(1, 0, At, B0); PG8_MMA(1, 1, At, B1); PG8_BAR; PG8_SCHED;
            PG8_LDB(B0, 1, 0); PG8_LDB(B1, 1, 1); PG8_SCHED; PG8_LDA(At, 1, 0); PG8_STAGE(PG8_SA(0, 1), a2 + hstep, voffA);
            PG8_WAIT_V(8); PG8_WAIT_L(0); PG8_BAR; PG8_MMA(0, 0, At, B0); PG8_MMA(0, 1, At, B1); PG8_BAR; PG8_SCHED;
            PG8_LDA(At, 1, 1); PG8_STAGE(PG8_SB(1, 0), b3, voffB); PG8_STAGE(PG8_SB(1, 1), b3 + hstep, voffB); PG8_STAGE(PG8_SA(1, 0), a3, voffA);
            PG8_WAIT_V(8); PG8_WAIT_L(0); PG8_BAR; PG8_MMA(1, 0, At, B0); PG8_MMA(1, 1, At, B1); PG8_BAR; PG8_SCHED;
            } else {
            PG8_LDB(B0, 0, 0); PG8_SCHED; PG8_LDA(At, 0, 0); PG8_STAGE(PG8_SA(1, 1), a1 + hstep, voffA);
            PG8_WAIT_L(8); PG8_BAR; PG8_WAIT_L(0); PG8_MMA(0, 0, At, B0); PG8_BAR; PG8_SCHED;
            PG8_LDB(B1, 0, 1); PG8_STAGE(PG8_SB(0, 0), b2, voffB);
            PG8_BAR; PG8_WAIT_L(0); PG8_MMA(0, 1, At, B1); PG8_BAR;
            PG8_LDA(At, 0, 1); PG8_STAGE(PG8_SA(0, 0), a2, voffA);
            PG8_BAR; PG8_WAIT_L(0); PG8_MMA(1, 0, At, B0); PG8_BAR; PG8_SCHED;
            PG8_STAGE(PG8_SB(0, 1), b2 + hstep, voffB);
            PG8_WAIT_V(6); PG8_BAR; PG8_MMA(1, 1, At, B1); PG8_BAR;
            PG8_LDB(B0, 1, 0); PG8_SCHED; PG8_LDA(At, 1, 0); PG8_STAGE(PG8_SA(0, 1), a2 + hstep, voffA);
            PG8_WAIT_L(8); PG8_BAR; PG8_WAIT_L(0); PG8_MMA(0, 0, At, B0); PG8_BAR; PG8_SCHED;
            PG8_LDB(B1, 1, 1); PG8_STAGE(PG8_SB(1, 0), b3, voffB);
            PG8_BAR; PG8_WAIT_L(0); PG8_MMA(0, 1, At, B1); PG8_BAR;
            PG8_LDA(At, 1, 1); PG8_STAGE(PG8_SA(1, 0), a3, voffA);
            PG8_BAR; PG8_WAIT_L(0); PG8_MMA(1, 0, At, B0); PG8_BAR; PG8_SCHED;
            PG8_STAGE(PG8_SB(1, 1), b3 + hstep, voffB);
            PG8_WAIT_V(6); PG8_BAR; PG8_MMA(1, 1, At, B1); PG8_BAR;
            }
        }
        if constexpr (ALIGN_EPI) { if (wr == 0) PG8_BAR; }
        if constexpr (!Epi::AFTER_DRAIN) { E(acc, cur, wr, wc, fr, fq); S.done(cur); }
        if (!has_next) break;
#pragma unroll
        for (int a = 0; a < 2; ++a)
#pragma unroll
            for (int b = 0; b < 2; ++b)
#pragma unroll
                for (int m = 0; m < 4; ++m)
#pragma unroll
                    for (int n = 0; n < 2; ++n) acc[a][b][m][n] = (f32x4){0.f, 0.f, 0.f, 0.f};
        cur = nxt; cA = nA; cB = nB; ++ui;
        if constexpr (ALIGN_EPI) { if (wr == 1) PG8_BAR; }
    }
    PG8_WAIT_V(0);
    if constexpr (!ALIGN_EPI) { if (wr == 0) PG8_BAR; }
    PG8_BAR;
    if constexpr (Epi::AFTER_DRAIN) { E.fused(acc, cur, wr, wc, fr, fq, lds, wid, lane); S.done(cur); }
#undef PG8_SA
#undef PG8_SB
#undef PG8_STAGE
#undef PG8_LDA
#undef PG8_LDB
#undef PG8_MMA
#undef PG8_WAIT_V
#undef PG8_WAIT_L
#undef PG8_BAR
#undef PG8_SCHED
}
}
#include <hip/hip_bf16.h>
#include <cmath>
namespace attn_body {
using bf16=__hip_bfloat16;
using bf16x8=__attribute__((ext_vector_type(8)))short;
using s16x4=__attribute__((ext_vector_type(4)))short;
using f32x16=__attribute__((ext_vector_type(16)))float;
using u32x4=__attribute__((ext_vector_type(4)))unsigned;
constexpr int BATCH=2,NHEAD=8,NKVH=2,SEQ=8192,D=64,QP=512,KP=128,OP=1024;
constexpr int NW=8,QBLK=32,QB=QBLK*NW,KVBLK=64,NQB=SEQ/QB;
constexpr int ATTN_UNIT_ROWS=QB;
__device__ __forceinline__ int crow(int r,int hi){return (r&3)+8*(r>>2)+4*hi;}
#define SBAR() __builtin_amdgcn_sched_barrier(0)
__device__ __forceinline__ void cmask(f32x16&p0,f32x16&p1,int jb,int qrel,int hi){
  const float NEG=-INFINITY; int kb=64*jb+4*hi;
  #pragma unroll
  for(int r=0;r<16;++r){int kv=kb+(r&3)+8*(r>>2); if(kv>qrel)p0[r]=NEG; if(kv+32>qrel)p1[r]=NEG;}
}

constexpr int NSLOT=3, SLOTB=8192;
constexpr int LDS_K=0, LDS_V=NSLOT*SLOTB, LDS_WS=2*NSLOT*SLOTB, LDS_OST=LDS_WS+NW*64*4, LDS_BYTES=LDS_OST+NW*4096;
constexpr float C2=0.125f*1.4426950408889634f;
__device__ __forceinline__ void glds16(const void*gsrc,unsigned lds_dst){unsigned keep;
  asm volatile("s_mov_b32 %0, m0\n\ts_mov_b32 m0, %2\n\ts_nop 0\n\tglobal_load_lds_dwordx4 %1, off\n\ts_mov_b32 m0, %0":"=&s"(keep):"v"(gsrc),"s"(lds_dst):"memory");}
__device__ __forceinline__ float max3f(float a,float b,float c){float r;asm("v_max3_f32 %0, %1, %2, %3":"=v"(r):"v"(a),"v"(b),"v"(c));return r;}
__device__ __forceinline__ float max2f(float a,float b){float r;asm("v_max_f32_e32 %0, %1, %2":"=v"(r):"v"(a),"v"(b));return r;}
__device__ __forceinline__ float fadd_s(float a,float b){float r;asm("v_add_f32_e32 %0, %1, %2":"=v"(r):"v"(a),"v"(b));return r;}
__device__ __forceinline__ float fsub_s(float a,float b){float r;asm("v_sub_f32_e32 %0, %1, %2":"=v"(r):"v"(a),"v"(b));return r;}
typedef float f32x2_t __attribute__((ext_vector_type(2))); typedef __bf16 bf16x2_t __attribute__((ext_vector_type(2)));
__device__ __forceinline__ unsigned cvtpk_s(float lo,float hi){f32x2_t v={lo,hi};bf16x2_t b=__builtin_convertvector(v,bf16x2_t);return __builtin_bit_cast(unsigned,b);}
#define WAIT_BAR(N) asm volatile("s_waitcnt vmcnt(" #N ") lgkmcnt(0)\n\ts_barrier":::"memory")

__device__ __forceinline__ void qkt(f32x16&p0,f32x16&p1,const char*Kslot,const bf16x8*qr,const f32x16&negm,int r32,int hi){
  const char*kb=Kslot+hi*1024+r32*16;
  #pragma unroll
  for(int d0=0;d0<4;++d0){
    const bf16x8 b0=*reinterpret_cast<const bf16x8*>(kb+d0*2048);
    const bf16x8 b1=*reinterpret_cast<const bf16x8*>(kb+d0*2048+512);
    if(d0==0){p0=__builtin_amdgcn_mfma_f32_32x32x16_bf16(b0,qr[0],negm,0,0,0);p1=__builtin_amdgcn_mfma_f32_32x32x16_bf16(b1,qr[0],negm,0,0,0);}
    else{p0=__builtin_amdgcn_mfma_f32_32x32x16_bf16(b0,qr[d0],p0,0,0,0);p1=__builtin_amdgcn_mfma_f32_32x32x16_bf16(b1,qr[d0],p1,0,0,0);}}
}
typedef __attribute__((address_space(3))) const char* lds_cptr;
typedef short v4i16_t __attribute__((ext_vector_type(4)));
__device__ __forceinline__ void kload8(bf16x8*kf,lds_cptr kp){
  kf[0]=*(const __attribute__((address_space(3))) bf16x8*)(kp);      kf[1]=*(const __attribute__((address_space(3))) bf16x8*)(kp+512);
  kf[2]=*(const __attribute__((address_space(3))) bf16x8*)(kp+2048); kf[3]=*(const __attribute__((address_space(3))) bf16x8*)(kp+2560);
  kf[4]=*(const __attribute__((address_space(3))) bf16x8*)(kp+4096); kf[5]=*(const __attribute__((address_space(3))) bf16x8*)(kp+4608);
  kf[6]=*(const __attribute__((address_space(3))) bf16x8*)(kp+6144); kf[7]=*(const __attribute__((address_space(3))) bf16x8*)(kp+6656);
}
__device__ __forceinline__ void kload2(bf16x8*kf,lds_cptr kp,int j){ kf[2*j]=*(const __attribute__((address_space(3))) bf16x8*)(kp+j*2048); kf[2*j+1]=*(const __attribute__((address_space(3))) bf16x8*)(kp+j*2048+512); }
__device__ __forceinline__ s16x4 vtr(lds_cptr p){ return __builtin_bit_cast(s16x4,__builtin_amdgcn_ds_read_tr16_b64_v4i16((__attribute__((address_space(3))) v4i16_t*)p)); }
__device__ __forceinline__ float rowmax(const f32x16&p0,const f32x16&p1){
  float a=max3f(p0[0],p0[1],p1[0]),b=max3f(p0[2],p0[3],p1[1]);a=max3f(a,p1[2],p1[3]);
  #pragma unroll
  for(int r=4;r<16;r+=4){a=max3f(a,p0[r],p0[r+1]);b=max3f(b,p0[r+2],p0[r+3]);a=max3f(a,p1[r],p1[r+1]);b=max3f(b,p1[r+2],p1[r+3]);}
  const float m=max2f(a,b);
  auto rr=__builtin_amdgcn_permlane32_swap(__float_as_uint(m),__float_as_uint(m),false,false);
  return max2f(__uint_as_float(rr[0]),__uint_as_float(rr[1]));
}
__device__ __forceinline__ void pv(f32x16*o,int vb,bf16x8 pa0,bf16x8 pa1,bf16x8 pa2,bf16x8 pa3){
  #pragma unroll
  for(int d0=0;d0<2;++d0){s16x4 lo[4],hi[4];
    #pragma unroll
    for(int ks=0;ks<4;++ks){
      asm volatile("ds_read_b64_tr_b16 %0,%1 offset:%c2":"=&v"(lo[ks]):"v"(vb),"i"(d0*4096+ks*1024):"memory");
      asm volatile("ds_read_b64_tr_b16 %0,%1 offset:%c2":"=&v"(hi[ks]):"v"(vb),"i"(d0*4096+ks*1024+512):"memory");}
    asm volatile("s_waitcnt lgkmcnt(0)":::"memory");SBAR();
    #define PK(k) (bf16x8){lo[k][0],lo[k][1],lo[k][2],lo[k][3],hi[k][0],hi[k][1],hi[k][2],hi[k][3]}
    o[d0]=__builtin_amdgcn_mfma_f32_32x32x16_bf16(pa0,PK(0),o[d0],0,0,0);
    o[d0]=__builtin_amdgcn_mfma_f32_32x32x16_bf16(pa1,PK(1),o[d0],0,0,0);
    o[d0]=__builtin_amdgcn_mfma_f32_32x32x16_bf16(pa2,PK(2),o[d0],0,0,0);
    o[d0]=__builtin_amdgcn_mfma_f32_32x32x16_bf16(pa3,PK(3),o[d0],0,0,0);
    #undef PK
  }
}

#ifndef ATTN_STORE16
#define ATTN_STORE16(p,v) (*(u32x4*)(p)=(v))
#endif
template<int THRL> __device__ __forceinline__ void attn_unit(int b,int h,int qb,const bf16*Q,const bf16*__restrict__ K,const bf16*__restrict__ V,bf16*O,char*shm){
  const int tid=threadIdx.x,lane=tid&63,r32=lane&31,hi=lane>>5; const int wid=__builtin_amdgcn_readfirstlane(tid>>6);
  const long rowbase=(long)b*SEQ; const int q0=qb*QB;
  const bf16*Qw=Q+(rowbase+q0+wid*QBLK)*QP+h*D;
  const int hk=h/(NHEAD/NKVH); const bf16*Kh=K+rowbase*KP+hk*D,*Vh=V+rowbase*KP+hk*D;
  const unsigned lds0=(unsigned)(uintptr_t)shm;
  float*wsf=(float*)(shm+LDS_WS)+wid*64;
  const bf16*ksrc=Kh+(long)lane*KP+wid*8;
  const bf16*vsrc=Vh+(long)(16*(wid&3)+(lane>>2))*KP+(wid>>2)*32+(lane&3)*8;
  const unsigned kdst=lds0+LDS_K+wid*1024, vdst=lds0+LDS_V+wid*1024;
  #define DMA_K(t,slot) glds16(ksrc+(long)(t)*KVBLK*KP,(unsigned)__builtin_amdgcn_readfirstlane(kdst+(slot)))
  #define DMA_V(t,slot) glds16(vsrc+(long)(t)*KVBLK*KP,(unsigned)__builtin_amdgcn_readfirstlane(vdst+(slot)))
  const int vb0=(int)(lds0+LDS_V)+((lane>>4)&1)*32+(lane&3)*8+(4*hi+((lane&15)>>2))*64;
  const char*Kbase=shm+LDS_K; bf16x8 kf[8];
  const lds_cptr shm3=(lds_cptr)shm; const lds_cptr kp0=shm3+LDS_K+hi*1024+r32*16; const lds_cptr vp0=shm3+LDS_V+((lane>>4)&1)*32+(lane&3)*8+(4*hi+((lane&15)>>2))*64;
  constexpr int NT=SEQ/KVBLK;
  DMA_K(0,0);DMA_V(0,0);DMA_K(1,SLOTB);
  bf16x8 qr[4];
  #pragma unroll
  for(int d0=0;d0<4;++d0)qr[d0]=*reinterpret_cast<const bf16x8*>(&Qw[(long)r32*QP+d0*16+hi*8]);
  float mhat=0.f,l_reg=0.f;f32x16 o[2];o[0]=f32x16{};o[1]=f32x16{};f32x16 negm=f32x16{};asm volatile("":"+v"(negm));
  const int qrel=wid*QBLK+r32;
  #define CMASK(P0,P1,t) do{}while(0)
  bool resc=false;
  #define START(P0,P1) do{ const float rm=rowmax(P0,P1); resc=false; \
    { const float dl=rm; mhat=fadd_s(mhat,dl); \
      _Pragma("unroll") for(int r=0;r<16;++r){P0[r]=fsub_s(P0[r],dl);P1[r]=fsub_s(P1[r],dl);} \
      _Pragma("unroll") for(int r=0;r<16;++r)negm[r]=-mhat; asm volatile("":"+v"(negm)); } \
    _Pragma("unroll") for(int r=0;r<16;++r)P0[r]=__builtin_amdgcn_exp2f(P0[r]); }while(0)
  #define RESC() do{ if(resc){ asm volatile("s_waitcnt lgkmcnt(0)":::"memory"); \
      _Pragma("unroll") for(int d_=0;d_<2;++d_) _Pragma("unroll") for(int r=0;r<16;++r)o[d_][r]*=wsf[crow(r,hi)]; } }while(0)
  f32x16 pA0,pA1,pB0,pB1;
  int sl_prev=0,sl_cur=0,sl_next=SLOTB;
  #define ROT() do{sl_prev=sl_cur;sl_cur=sl_next;sl_next=(sl_next==(NSLOT-1)*SLOTB)?0:sl_next+SLOTB;}while(0)
  DMA_K(2,2*SLOTB);
  WAIT_BAR(3);
  qkt(pA0,pA1,Kbase,qr,negm,r32,hi);asm volatile("s_nop 15\n\ts_nop 7":"+v"(pA0),"+v"(pA1));CMASK(pA0,pA1,0);
  START(pA0,pA1);
  _Pragma("unroll") for(int r=0;r<16;++r)pA1[r]=__builtin_amdgcn_exp2f(pA1[r]);
  WAIT_BAR(0);
  DMA_K(3,0);DMA_V(1,SLOTB);
  ROT();
  kload8(kf,kp0+sl_cur);
  WAIT_BAR(2);
  s16x4 vlo[8],vhi[8]; u32x4 pw0,pw1,pw2,pw3;
  #define PKW(P,B) cvtpk_s(P[B],P[B+1])
  #define PAF(k) __builtin_bit_cast(bf16x8,pw##k)
  #define VFR(i) (bf16x8){vlo[i][0],vlo[i][1],vlo[i][2],vlo[i][3],vhi[i][0],vhi[i][1],vhi[i][2],vhi[i][3]}
  #define PIN(x) asm volatile("":"+v"(x))
  #define MX3(a,b,c) __builtin_fmaxf(__builtin_fmaxf((a),(b)),(c))
  #define GAPA(MF,A0,A1,A2,A3,W0,W1,PW) do{ MF; sacc+=A0; sacc+=A1; sacc+=A2; sacc+=A3; PIN(sacc); W0; W1; PIN(PW); SBAR(); }while(0)
  #define EX(v) __builtin_amdgcn_exp2f(v)
  #define GAPB(MF,X,B) do{ MF; X[B]=EX(X[B]); X[B+1]=EX(X[B+1]); X[B+2]=EX(X[B+2]); X[B+3]=EX(X[B+3]); PIN(X); SBAR(); }while(0)
  #define VRD(i) do{ vlo[i]=vtr(vp_+(((i)>>2)*4096+((i)&3)*1024)); vhi[i]=vtr(vp_+(((i)>>2)*4096+((i)&3)*1024+512)); }while(0)
  #define KRD(G,j) do{ if(G){ kload2(kf,kp0+sl_next,j); SBAR(); } }while(0)
  #define STEP(C0,C1,P0,P1,t,GK,GV,GL) do{ SBAR(); \
    const lds_cptr vp_=vp0+sl_prev; \
    VRD(0); SBAR(); float sacc=(P0[0]+P0[1]); \
    GAPA(C0=__builtin_amdgcn_mfma_f32_32x32x16_bf16(kf[0],qr[0],negm,0,0,0), P0[2],P0[3],P0[4],P0[5],     pw0[0]=PKW(P0,0), pw0[1]=PKW(P0,2), pw0); \
    VRD(4); SBAR(); GAPA(C1=__builtin_amdgcn_mfma_f32_32x32x16_bf16(kf[1],qr[0],negm,0,0,0), P0[6],P0[7],P0[8],P0[9],     pw0[2]=PKW(P0,4), pw0[3]=PKW(P0,6), pw0); \
    VRD(1); SBAR(); GAPA(C0=__builtin_amdgcn_mfma_f32_32x32x16_bf16(kf[2],qr[1],C0,0,0,0),   P0[10],P0[11],P0[12],P0[13], pw1[0]=PKW(P0,8), pw1[1]=PKW(P0,10), pw1); \
    VRD(5); SBAR(); GAPA(C1=__builtin_amdgcn_mfma_f32_32x32x16_bf16(kf[3],qr[1],C1,0,0,0),   P0[14],P0[15],P1[0],P1[1],   pw1[2]=PKW(P0,12),pw1[3]=PKW(P0,14), pw1); \
    VRD(2); SBAR(); GAPA(C0=__builtin_amdgcn_mfma_f32_32x32x16_bf16(kf[4],qr[2],C0,0,0,0),   P1[2],P1[3],P1[4],P1[5],     pw2[0]=PKW(P1,0), pw2[1]=PKW(P1,2), pw2); \
    VRD(6); SBAR(); GAPA(C1=__builtin_amdgcn_mfma_f32_32x32x16_bf16(kf[5],qr[2],C1,0,0,0),   P1[6],P1[7],P1[8],P1[9],     pw2[2]=PKW(P1,4), pw2[3]=PKW(P1,6), pw2); \
    VRD(3); SBAR(); GAPA(C0=__builtin_amdgcn_mfma_f32_32x32x16_bf16(kf[6],qr[3],C0,0,0,0),   P1[10],P1[11],P1[12],P1[13], pw3[0]=PKW(P1,8), pw3[1]=PKW(P1,10), pw3); \
    VRD(7); SBAR(); GAPA(C1=__builtin_amdgcn_mfma_f32_32x32x16_bf16(kf[7],qr[3],C1,0,0,0),   P1[14],P1[15],0.f,0.f,       pw3[2]=PKW(P1,12),pw3[3]=PKW(P1,14), pw3); \
    l_reg+=sacc; \
    if(GK){DMA_K((t)+3,sl_cur);} if(GV){DMA_V((t)+1,sl_next);} \
    CMASK(C0,C1,t); \
    { float a=MX3(C0[0],C0[1],C1[0]),b=MX3(C0[2],C0[3],C1[1]); a=MX3(a,C1[2],C1[3]); \
      _Pragma("unroll") for(int r=4;r<16;r+=4){a=MX3(a,C0[r],C0[r+1]);b=MX3(b,C0[r+2],C0[r+3]);a=MX3(a,C1[r],C1[r+1]);b=MX3(b,C1[r+2],C1[r+3]);} \
      float rm=__builtin_fmaxf(a,b); { auto rr=__builtin_amdgcn_permlane32_swap(__float_as_uint(rm),__float_as_uint(rm),false,false); rm=__builtin_fmaxf(__uint_as_float(rr[0]),__uint_as_float(rr[1])); } \
      resc=false; \
      if(__builtin_expect(__any(rm>(float)THRL),0)){ const float dl=__builtin_fmaxf(rm,0.f); mhat+=dl; \
        _Pragma("unroll") for(int r=0;r<16;++r){C0[r]-=dl;C1[r]-=dl;} \
        _Pragma("unroll") for(int r=0;r<16;++r)negm[r]=-mhat; asm volatile("":"+v"(negm)); \
        const float f=__builtin_amdgcn_exp2f(-dl); l_reg*=f; if(hi==0)wsf[r32]=f; resc=true; } } \
    SBAR(); \
    GAPB(o[0]=__builtin_amdgcn_mfma_f32_32x32x16_bf16(PAF(0),VFR(0),o[0],0,0,0), C0,0); \
    GAPB(o[1]=__builtin_amdgcn_mfma_f32_32x32x16_bf16(PAF(0),VFR(4),o[1],0,0,0), C0,4); \
    KRD(GL,0); GAPB(o[0]=__builtin_amdgcn_mfma_f32_32x32x16_bf16(PAF(1),VFR(1),o[0],0,0,0), C0,8); \
    KRD(GL,1); GAPB(o[1]=__builtin_amdgcn_mfma_f32_32x32x16_bf16(PAF(1),VFR(5),o[1],0,0,0), C0,12); \
    KRD(GL,2); GAPB(o[0]=__builtin_amdgcn_mfma_f32_32x32x16_bf16(PAF(2),VFR(2),o[0],0,0,0), C1,0); \
    KRD(GL,3); GAPB(o[1]=__builtin_amdgcn_mfma_f32_32x32x16_bf16(PAF(2),VFR(6),o[1],0,0,0), C1,4); \
    GAPB(o[0]=__builtin_amdgcn_mfma_f32_32x32x16_bf16(PAF(3),VFR(3),o[0],0,0,0), C1,8); \
    GAPB(o[1]=__builtin_amdgcn_mfma_f32_32x32x16_bf16(PAF(3),VFR(7),o[1],0,0,0), C1,12); \
    }while(0)
  int t=1;
  #undef CMASK
  #define CMASK(P0,P1,t) do{}while(0)
  for(;t+5<NT;t+=2){
    STEP(pB0,pB1,pA0,pA1,t,true,true,true);     WAIT_BAR(2); RESC(); ROT();
    STEP(pA0,pA1,pB0,pB1,t+1,true,true,true);   WAIT_BAR(2); RESC(); ROT();
  }
  #undef CMASK
  #define CMASK(P0,P1,t) do{}while(0)
  #define ENDW(tt) do{ if((tt)+3<NT){WAIT_BAR(2);} else if((tt)+2<NT){WAIT_BAR(1);} else {WAIT_BAR(0);} }while(0)
  for(;t+1<NT;t+=2){
    STEP(pB0,pB1,pA0,pA1,t,(t+3<NT),(t+1<NT),(t+1<NT));       ENDW(t);   RESC(); ROT();
    STEP(pA0,pA1,pB0,pB1,t+1,(t+4<NT),(t+2<NT),(t+2<NT));     ENDW(t+1); RESC(); ROT();
  }
  STEP(pB0,pB1,pA0,pA1,NT-1,false,false,false); RESC();
  { float sacc=pB0[0]+pB0[1]; _Pragma("unroll") for(int r=2;r<16;++r)sacc+=pB0[r]; _Pragma("unroll") for(int r=0;r<16;++r)sacc+=pB1[r]; l_reg+=sacc;
    pw0=(u32x4){PKW(pB0,0),PKW(pB0,2),PKW(pB0,4),PKW(pB0,6)};pw1=(u32x4){PKW(pB0,8),PKW(pB0,10),PKW(pB0,12),PKW(pB0,14)};pw2=(u32x4){PKW(pB1,0),PKW(pB1,2),PKW(pB1,4),PKW(pB1,6)};pw3=(u32x4){PKW(pB1,8),PKW(pB1,10),PKW(pB1,12),PKW(pB1,14)};
    SBAR(); pv(o,vb0+sl_cur,PAF(0),PAF(1),PAF(2),PAF(3)); }
  #undef PKW
  #undef PAF
  #undef VFR
  #undef PIN
  #undef MX3
  #undef GAPA
  #undef GAPB
  #undef EX
  #undef VRD
  #undef KRD
  #undef STEP
  #undef ENDW
  {auto rr=__builtin_amdgcn_permlane32_swap(__float_as_uint(l_reg),__float_as_uint(l_reg),false,false);l_reg=__uint_as_float(rr[0])+__uint_as_float(rr[1]);}
  if(hi==0)wsf[32+r32]=l_reg;asm volatile("s_waitcnt lgkmcnt(0)":::"memory");
  float rli[16];
  #pragma unroll
  for(int r=0;r<16;++r)rli[r]=__builtin_amdgcn_rcpf(wsf[32+crow(r,hi)]);
  bf16*Ow=O+(rowbase+q0+wid*QBLK)*OP+h*D;
  { bf16*stg=(bf16*)(shm+LDS_OST)+wid*2048;
    #pragma unroll
    for(int r=0;r<16;++r){const int orow=crow(r,hi);
      #pragma unroll
      for(int d0=0;d0<2;++d0)stg[orow*64+d0*32+r32]=__float2bfloat16(o[d0][r]*rli[r]);}
    asm volatile("s_waitcnt lgkmcnt(0)":::"memory");
    #pragma unroll
    for(int i=0;i<4;++i){const int row=i*8+(lane>>3),ch=lane&7; const u32x4 v=*(const u32x4*)(stg+row*64+ch*8); ATTN_STORE16(Ow+(long)row*OP+ch*8,v);} }
  asm volatile("s_waitcnt lgkmcnt(0)\n\ts_barrier":::"memory");
  #undef DMA_K
  #undef DMA_V
  #undef CMASK
  #undef START
  #undef RESC
  #undef ROT
}
constexpr int ATTN_LDS_BYTES=LDS_BYTES;
struct AttnTensors { const bf16* Q; const bf16* K; const bf16* V; bf16* O; };
struct AttnUnit { int bh; int qb; };
struct StaticOrder {
  int vcu, G;
  __device__ __forceinline__ explicit StaticOrder(int grid,int block):vcu((grid%8==0)?(block%8)*(grid/8)+block/8:block),G(grid){}
  __device__ __forceinline__ bool next(int i,AttnUnit&u)const{
    const int L=i*G+vcu; if(L>=BATCH*NHEAD*NQB)return false;
    if(G==256){ if(i>=2)return false; const int x=vcu>>5,j=vcu&31; const int b=x>>2,kvh=(x>>1)&1,hq=kvh*4+2*(x&1)+i; u.bh=b*NHEAD+hq; u.qb=j; return true; }
    u.bh=L/NQB; u.qb=L%NQB; return true; }
  __device__ __forceinline__ void a_ready(const AttnUnit&)const{}
  __device__ __forceinline__ void done(const AttnUnit&)const{}
};
template<class Sched,int THRL=8> __device__ __forceinline__ void attn_phase(char*lds,const AttnTensors&T,const Sched&S){
  AttnUnit u;
  for(int i=0;S.next(i,u);++i){ S.a_ready(u); attn_unit<THRL>(u.bh/NHEAD,u.bh%NHEAD,u.qb,T.Q,T.K,T.V,T.O,lds); S.done(u); }
}
#undef SBAR
#undef WAIT_BAR
}

#include <hip/hip_cooperative_groups.h>
namespace cg = cooperative_groups;
#ifndef MK_PER_PHASE
#define MK_PER_PHASE 0
#endif
constexpr int NWAVES = 8, NTHREADS = 512;
constexpr int NB = 2, SEQ = 8192, DMODEL = 1024, TT = NB * SEQ;
constexpr int NPROJ = 3072;
constexpr int NEXP = 32, FFE = 512;
constexpr float EPS = 1e-6f;
constexpr int N_PHASES = 12;

constexpr size_t MiB = 1u << 20;
constexpr size_t WS_CTL = 0, CTL_ZERO_BYTES = 64 * 1024;
constexpr size_t WS_WOUT = 1 * MiB;
constexpr size_t WS_WR = 3 * MiB;
constexpr size_t WS_TOK = 3 * MiB + 256 * 1024;
constexpr size_t WS_GATES = 4 * MiB;
constexpr size_t WS_WIN = 5 * MiB;
constexpr size_t WS_A = 11 * MiB;
constexpr size_t WS_XN = WS_A;
constexpr size_t GDN_SH_BYTES = 71680, GDN_D_BYTES = 19456;
constexpr size_t WS_GSH = WS_A;
constexpr size_t WS_GD = WS_A + 1024 * GDN_SH_BYTES;
constexpr size_t WS_X1 = 5 * MiB;
constexpr size_t WS_HID = 69 * MiB;
constexpr size_t WS_XBUF = 109 * MiB;
constexpr size_t WS_B = 157 * MiB;
constexpr size_t WS_QKVA = WS_B;
constexpr size_t WS_QKVB = WS_B + 48 * MiB;
constexpr size_t WS_ZA = WS_B + 72 * MiB;
constexpr size_t WS_OCAT = WS_B;
constexpr size_t WS_WGU0 = 189 * MiB, WS_WGU1 = 245 * MiB; constexpr int WGU_SPLIT = 20;
constexpr size_t DO_WD0 = 0, DO_WD1 = 56 * MiB; constexpr int WD_SPLIT = 24;
constexpr size_t DO_HN = 24 * MiB;
constexpr size_t WS_END = 269 * MiB;
static_assert(WS_GD + 4096 * GDN_D_BYTES <= WS_B, "GDN records fit region A");
static_assert(WS_X1 + 64 * MiB <= WS_HID && WS_HID + 40928ull * 1024 <= WS_XBUF && WS_XBUF + 40928ull * 2048 <= WS_WGU0, "post-scan map");
static_assert(WS_WGU0 + WGU_SPLIT * 2 * MiB <= WS_B + 72 * MiB && WS_WGU1 + (32 - WGU_SPLIT) * 2 * MiB <= 269 * MiB, "WGU fragments");
constexpr size_t DO_QR = 0, DO_KR = 16 * MiB, DO_VR = 20 * MiB, DO_OF = 24 * MiB, DO_OB = 40 * MiB;
constexpr int CW_CNT = 64;
constexpr int CW_NTILE = 128;
constexpr int CW_TILES = 192;
constexpr int CW_SCANQ = 1024;

constexpr int LDS_BYTES = 160 * 1024;

#define GAS __attribute__((address_space(1)))
#define LAS __attribute__((address_space(3)))
typedef unsigned short bf16;
typedef unsigned v4u __attribute__((ext_vector_type(4)));
typedef unsigned v2u __attribute__((ext_vector_type(2)));
typedef float f32x4 __attribute__((ext_vector_type(4)));
typedef short bf16x8 __attribute__((ext_vector_type(8)));
typedef short s16x4 __attribute__((ext_vector_type(4)));
#define DI __device__ __forceinline__

DI unsigned f2bf(float f) { unsigned u = __builtin_bit_cast(unsigned, f); return (u + 0x7fffu + ((u >> 16) & 1u)) >> 16; }
typedef float f32x2_t __attribute__((ext_vector_type(2))); typedef __bf16 bf16x2_t __attribute__((ext_vector_type(2)));
DI unsigned pk2(float lo, float hi) { f32x2_t v = {lo, hi}; bf16x2_t b = __builtin_convertvector(v, bf16x2_t); return __builtin_bit_cast(unsigned, b); }
DI float bf2f(unsigned short h) { return __builtin_bit_cast(float, (unsigned)h << 16); }
DI float bflo(unsigned w) { return __builtin_bit_cast(float, w << 16); }
DI float bfhi(unsigned w) { return __builtin_bit_cast(float, w & 0xffff0000u); }
DI float wave_sum(float v) {
#pragma unroll
    for (int o = 1; o < 64; o <<= 1) v += __shfl_xor(v, o);
    return v;
}
DI float siluf(float x) { return x * __builtin_amdgcn_rcpf(1.0f + __expf(-x)); }
DI float sigmoidf_(float x) { return 1.0f / (1.0f + __expf(-x)); }
DI int perm32i(int idx) { return ((idx >> 2) & 3) * 8 + (idx >> 4) * 4 + (idx & 3); }
DI int permcol(int c) { return (c & ~31) + perm32i(c & 31); }
template <class T> DI T opaque(T p) { asm volatile("" : "+v"(p)); return p; }

typedef GAS unsigned gu32;
#define RLX_AGENT __ATOMIC_RELAXED, __HIP_MEMORY_SCOPE_AGENT
constexpr int CW_BAR = 4096;
constexpr int MISC_OFF = LDS_BYTES - 64;
#define XB_TMO      128
#define XB_XCNT(j)  (256  + 64 * (j))
#define XB_XSUB(j)  (1280 + 64 * (j))
#define XB_XGEN(j)  (2304 + 64 * (j))
#define XB_TOP      3328
#define XB_TOPGEN   3392
#define XCD_BAR_WORDS 3456
#define XB_SPIN_CAP (1u << 18)

__device__ __forceinline__ unsigned xb_ld(unsigned* p)              { return __hip_atomic_load(p, __ATOMIC_RELAXED, __HIP_MEMORY_SCOPE_AGENT); }
__device__ __forceinline__ unsigned xb_add(unsigned* p, unsigned v) { return __hip_atomic_fetch_add(p, v, __ATOMIC_RELAXED, __HIP_MEMORY_SCOPE_AGENT); }
__device__ __forceinline__ unsigned xb_xcc_id() { return (unsigned)__builtin_amdgcn_s_getreg((3 << 11) | 20) & 0xFu; }
#define XB_SPIN(cond, bar) do { unsigned _sp = 0; while (cond) { __builtin_amdgcn_s_sleep(1); \
    if ((++_sp & 255u) == 0u) { if (xb_ld(&(bar)[XB_TMO])) break; if (_sp > XB_SPIN_CAP) { atomicAdd(&(bar)[XB_TMO], 1u); break; } } } } while (0)

struct XcdBarrier {
    unsigned* bar; unsigned x;
    volatile LAS unsigned* st;
};

__device__ __forceinline__ XcdBarrier xcd_barrier_post(unsigned* bar, volatile LAS unsigned* st) {
    XcdBarrier b; b.bar = bar; b.x = xb_xcc_id(); b.st = st;
    if (threadIdx.x == 0) (void)xb_add(&bar[XB_XCNT(b.x)], 1u);
    return b;
}
__device__ __forceinline__ void xcd_barrier_complete(unsigned* bar, unsigned x, unsigned& nloc, unsigned& nx) {
    const unsigned G = gridDim.x * gridDim.y * gridDim.z;
    unsigned sum, cnt, mine, sp = 0u;
    for (;;) {
        sum = 0u; cnt = 0u; mine = 0u;
#pragma unroll
        for (unsigned j = 0; j < 16; ++j) { const unsigned c = xb_ld(&bar[XB_XCNT(j)]); sum += c; cnt += (c > 0u) ? 1u : 0u; mine = (j == x) ? c : mine; }
        if (sum == G) break;
        __builtin_amdgcn_s_sleep(1);
        if ((++sp & 255u) == 0u) { if (xb_ld(&bar[XB_TMO])) break; if (sp > XB_SPIN_CAP) { atomicAdd(&bar[XB_TMO], 1u); break; } }
    }
    nloc = mine > 0u ? mine : 1u; nx = cnt > 0u ? cnt : 1u;
}

__device__ __forceinline__ void xcd_barrier(const XcdBarrier& b) {
    asm volatile("s_waitcnt vmcnt(0)" ::: "memory");
    __syncthreads();
    if (threadIdx.x == 0) {
        unsigned* bar = b.bar;
        __builtin_amdgcn_s_waitcnt(0);
        unsigned nloc = b.st[0], nx = b.st[1];
        if (nloc == 0u) { xcd_barrier_complete(bar, b.x, nloc, nx); b.st[0] = nloc; b.st[1] = nx; }
        const unsigned old = xb_add(&bar[XB_XSUB(b.x)], 1u);
        const unsigned gen = old / nloc;
        if (old + 1u == (gen + 1u) * nloc) {
            __builtin_amdgcn_fence(__ATOMIC_RELEASE, "agent");
            asm volatile("s_waitcnt vmcnt(0)" ::: "memory");
            const unsigned og = xb_add(&bar[XB_TOP], 1u);
            const unsigned tg = og / nx;
            if (og + 1u == (tg + 1u) * nx) xb_add(&bar[XB_TOPGEN], 1u);
            else XB_SPIN(xb_ld(&bar[XB_TOPGEN]) == tg, bar);
            __builtin_amdgcn_fence(__ATOMIC_ACQUIRE, "agent");
            xb_add(&bar[XB_XGEN(b.x)], 1u);
            asm volatile("s_waitcnt vmcnt(0)" ::: "memory");
        } else {
            XB_SPIN(xb_ld(&bar[XB_XGEN(b.x)]) == gen, bar);
            __builtin_amdgcn_fence(__ATOMIC_ACQUIRE, "agent");
            asm volatile("s_waitcnt vmcnt(0)" ::: "memory");
        }
    }
    __syncthreads();
}

struct Frame {
    LAS unsigned char* lds;
    int tid, lane, wave, vcu, G;
    const float* in[17];
    float* out; unsigned char* ws;
};

DI void p0_transpose_item(const float* W, int ldw, int nblk, bf16* WT, int K, int row_off, int rmul, LAS float* scr, int item, int lane) {
    const int kb = item / nblk, nb = item % nblk, k0 = 64 * kb, n0 = 32 * nb;
    const int r8 = lane >> 3, c4 = (lane & 7) * 4;
    f32x4 v[8];
#pragma unroll
    for (int i = 0; i < 8; ++i) v[i] = __builtin_nontemporal_load((const f32x4*)(W + (size_t)(k0 + 8 * i + r8) * ldw + n0 + c4));
#pragma unroll
    for (int i = 0; i < 8; ++i) { LAS float* d = scr + (8 * i + r8) * 33 + c4; d[0] = v[i].x; d[1] = v[i].y; d[2] = v[i].z; d[3] = v[i].w; }
    asm volatile("s_waitcnt lgkmcnt(0)" ::: "memory");
    const int c = lane & 7;
#pragma unroll
    for (int j = 0; j < 4; ++j) { const int n = (lane >> 3) + 8 * j; const LAS float* s = scr + (8 * c) * 33 + n;
        v4u o; o.x = pk2(s[0 * 33], s[1 * 33]); o.y = pk2(s[2 * 33], s[3 * 33]); o.z = pk2(s[4 * 33], s[5 * 33]); o.w = pk2(s[6 * 33], s[7 * 33]);
        *(GAS v4u*)(WT + (size_t)(row_off + (n0 + n) * rmul) * K + k0 + 8 * c) = o; }
    asm volatile("s_waitcnt lgkmcnt(0)" ::: "memory");
}
DI void rms_row_to_bf16(const float* xrow, const float* w, bf16* orow, int lane) {
    const GAS f32x4* xr = (const GAS f32x4*)xrow + lane; const GAS f32x4* wr = (const GAS f32x4*)w + lane;
    f32x4 v[4]; float s = 0.f;
#pragma unroll
    for (int j = 0; j < 4; ++j) { v[j] = xr[64 * j]; s += (v[j].x * v[j].x + v[j].y * v[j].y) + (v[j].z * v[j].z + v[j].w * v[j].w); }
    const float rs = 1.0f / sqrtf(wave_sum(s) * (1.f / DMODEL) + EPS);
    GAS v2u* o8 = (GAS v2u*)orow + lane;
#pragma unroll
    for (int j = 0; j < 4; ++j) { const f32x4 ww = wr[64 * j]; v2u o; o.x = pk2(v[j].x * rs * ww.x, v[j].y * rs * ww.y); o.y = pk2(v[j].z * rs * ww.z, v[j].w * rs * ww.w); o8[64 * j] = o; }
}
DI void p0_prologue(Frame& F) {
    LAS float* scr = (LAS float*)(F.lds + F.wave * 16384);
    const int gw = F.vcu * NWAVES + F.wave, NGW = F.G * NWAVES;
    const float* w_in = F.in[2]; const float* w_out = F.in[9];
    bf16* WIN = (bf16*)(F.ws + WS_WIN); bf16* WOUT = (bf16*)(F.ws + WS_WOUT);
    constexpr int I1 = 16 * 64, I2 = 16 * 24, I3 = 16, I4 = 16 * 32, NITEMS = I1 + I2 + I3 + I4;
    for (int it = gw; it < NITEMS; it += NGW) {
        int r = it;
        if (r < I1) { p0_transpose_item(w_in, 2832, 64, WIN, 1024, 0, 1, scr, r, F.lane); continue; } r -= I1;
        if (r < I2) { p0_transpose_item(w_in + 2064, 2832, 24, WIN, 1024, 2048, 1, scr, r, F.lane); continue; } r -= I2;
        if (r < I3) { p0_transpose_item(w_in + 2048, 2832, 1, WIN, 1024, 2816, 1, scr, r, F.lane); continue; } r -= I3;
        p0_transpose_item(w_out, 1024, 32, WOUT, 1024, 0, 1, scr, r, F.lane);
    }
    { const int gt = F.vcu * NTHREADS + F.tid, GT = F.G * NTHREADS; GAS v4u* z = (GAS v4u*)(WIN + (size_t)2848 * 1024);
      for (int i = gt; i < 224 * 1024 * 2 / 16; i += GT) z[i] = (v4u){0u, 0u, 0u, 0u}; }
    { const int gt = F.vcu * NTHREADS + F.tid, GT = F.G * NTHREADS; bf16* WRH = (bf16*)(F.ws + WS_WR); bf16* WRL = WRH + 48 * 1024;
      const float* wrg = F.in[11]; const float* wre = F.in[12];
      for (int i = gt; i < 48 * 1024; i += GT) { const int j = i >> 10, k = i & 1023; float v = 0.f; if (j < 4) v = wrg[k * 4 + j]; else if (j < 36) v = wre[k * 32 + (j - 4)];
          const unsigned h = f2bf(v); const float hv = __builtin_bit_cast(float, h << 16); WRH[i] = (bf16)h; WRL[i] = (bf16)f2bf(v - hv); } }
    bf16* XN = (bf16*)(F.ws + WS_XN);
    for (int m = gw; m < TT; m += NGW) rms_row_to_bf16(F.in[0] + (size_t)m * DMODEL, F.in[1], XN + (size_t)m * DMODEL, F.lane);
}

struct EpiProj {
    static constexpr bool PERM = true, AFTER_DRAIN = false;
    bf16 *qkva, *za, *qkvb; float* gates;
    DI void operator()(const pg8::f32x4 (&acc)[2][2][4][2], const pg8::Unit& u, int wr, int wc, int fr, int fq) const {
        const int row0 = u.pm * 256 + wr * 64 + fr;
        if (u.pn == 11) {
            if (wc == 0 && fq < 2) {
#pragma unroll
                for (int ai = 0; ai < 2; ++ai)
#pragma unroll
                    for (int m = 0; m < 4; ++m) { float* rp = gates + (size_t)(row0 + ai * 128 + m * 16) * 16 + 8 * fq;
                        *(pg8::f32x4*)(rp) = acc[ai][0][m][0]; *(pg8::f32x4*)(rp + 4) = acc[ai][0][m][1]; }
            }
            return;
        }
        bf16* base; int ldc, colt;
        if (u.pn < 6) { base = qkva; ldc = 1536; colt = u.pn * 256; } else if (u.pn < 8) { base = za; ldc = 512; colt = (u.pn - 6) * 256; } else { base = qkvb; ldc = 768; colt = (u.pn - 8) * 256; }
        const int col0 = colt + wc * 32 + 8 * fq;
#pragma unroll
        for (int ai = 0; ai < 2; ++ai)
#pragma unroll
            for (int m = 0; m < 4; ++m) { bf16* rowp = base + (size_t)(row0 + ai * 128 + m * 16) * ldc + col0;
#pragma unroll
                for (int bj = 0; bj < 2; ++bj) { const pg8::f32x4 v0 = acc[ai][bj][m][0], v1 = acc[ai][bj][m][1]; pg8::u32x4 w;
                    w.x = pg8::cvt_pk_bf16(v0[0], v0[1]); w.y = pg8::cvt_pk_bf16(v0[2], v0[3]); w.z = pg8::cvt_pk_bf16(v1[0], v1[1]); w.w = pg8::cvt_pk_bf16(v1[2], v1[3]);
                    *(pg8::u32x4*)(rowp + bj * 128) = w; } }
    }
};
struct EpiResid {
    static constexpr bool PERM = false, AFTER_DRAIN = false;
    const float* x; float* x1;
    DI void operator()(const pg8::f32x4 (&acc)[2][2][4][2], const pg8::Unit& u, int wr, int wc, int fr, int fq) const {
        const int row0 = u.pm * 256 + wr * 64 + fr, col0 = u.pn * 256 + wc * 32 + 4 * fq;
#pragma unroll
        for (int ai = 0; ai < 2; ++ai)
#pragma unroll
            for (int m = 0; m < 4; ++m) { const size_t off = (size_t)(row0 + ai * 128 + m * 16) * DMODEL + col0;
#pragma unroll
                for (int bj = 0; bj < 2; ++bj)
#pragma unroll
                    for (int n = 0; n < 2; ++n) { const pg8::f32x4 b = *(const pg8::f32x4*)(x + off + bj * 128 + n * 16); *(pg8::f32x4*)(x1 + off + bj * 128 + n * 16) = b + acc[ai][bj][m][n]; } }
    }
};
struct EpiGU {
    static constexpr bool PERM = true, AFTER_DRAIN = false;
    bf16* hid;
    DI void operator()(const pg8::f32x4 (&acc)[2][2][4][2], const pg8::Unit& u, int wr, int wc, int fr, int fq) const {
        const int row0 = u.pm * 256 + wr * 64 + fr; const int jt = u.pn & 3;
        const int ff0 = jt * 128 + wc * 16 + 4 * fq;
#pragma unroll
        for (int ai = 0; ai < 2; ++ai)
#pragma unroll
            for (int m = 0; m < 4; ++m) { bf16* rowp = hid + (size_t)(row0 + ai * 128 + m * 16) * FFE + ff0;
#pragma unroll
                for (int bj = 0; bj < 2; ++bj) { const pg8::f32x4 v0 = acc[ai][bj][m][0], v1 = acc[ai][bj][m][1];
                    const float h0 = siluf(v0[0]) * v0[1], h1 = siluf(v0[2]) * v0[3], h2 = siluf(v1[0]) * v1[1], h3 = siluf(v1[2]) * v1[3];
                    v2u w; w.x = pg8::cvt_pk_bf16(h0, h1); w.y = pg8::cvt_pk_bf16(h2, h3);
                    *(v2u*)(rowp + bj * 64) = w; } }
    }
};
struct EpiY {
    static constexpr bool PERM = true, AFTER_DRAIN = false;
    bf16* y;
    DI void operator()(const pg8::f32x4 (&acc)[2][2][4][2], const pg8::Unit& u, int wr, int wc, int fr, int fq) const {
        const int row0 = u.pm * 256 + wr * 64 + fr; const int col0 = (u.pn & 3) * 256 + wc * 32 + 8 * fq;
#pragma unroll
        for (int ai = 0; ai < 2; ++ai)
#pragma unroll
            for (int m = 0; m < 4; ++m) { bf16* rowp = y + (size_t)(row0 + ai * 128 + m * 16) * DMODEL + col0;
#pragma unroll
                for (int bj = 0; bj < 2; ++bj) { const pg8::f32x4 v0 = acc[ai][bj][m][0], v1 = acc[ai][bj][m][1]; pg8::u32x4 w;
                    w.x = pg8::cvt_pk_bf16(v0[0], v0[1]); w.y = pg8::cvt_pk_bf16(v0[2], v0[3]); w.z = pg8::cvt_pk_bf16(v1[0], v1[1]); w.w = pg8::cvt_pk_bf16(v1[2], v1[3]);
                    *(pg8::u32x4*)(rowp + bj * 128) = w; } }
    }
};
struct MoeOrder {
    const unsigned* ctl; int G, c, esplit, pnoff;
    DI bool next(int i, pg8::Unit& u) const {
        const int nt = (int)ctl[CW_NTILE]; const int L = i * G + c; if (L >= nt * 4) return false;
        const int t = L >> 2, j = L & 3; u.pm = (int)ctl[CW_TILES + 2 * t]; const int e = (int)ctl[CW_TILES + 2 * t + 1]; u.pn = (e < esplit ? 4 * e : pnoff + 4 * (e - esplit)) + j; return true; }
    DI void a_ready(const pg8::Unit&) const {}
    DI void done(const pg8::Unit&) const {}
};

DI void p2_rope(Frame& F) {
    const int gw = F.vcu * NWAVES + F.wave, NGW = F.G * NWAVES, lane = F.lane;
    const bf16* QKVB = (const bf16*)(F.ws + WS_QKVB);
    bf16* QR = (bf16*)((unsigned char*)F.out + DO_QR); bf16* KR = (bf16*)((unsigned char*)F.out + DO_KR); bf16* VR = (bf16*)((unsigned char*)F.out + DO_VR);
    const int pi = lane & 31, hsel = lane >> 5;
    const float qw0 = F.in[7][2 * pi], qw1 = F.in[7][2 * pi + 1], kw0 = F.in[8][2 * pi], kw1 = F.in[8][2 * pi + 1];
    const float invf = exp2f(-(float)(2 * (pi & 15)) * (13.287712379549449f / 32.0f));
    constexpr float C2 = 0.125f * 1.4426950408889634f;
    for (int t = gw; t < TT; t += NGW) {
        const int s = t & (SEQ - 1); const float pos = (pi < 16) ? (float)(s >> 6) : (float)(s & 63);
        const float ang = pos * invf;
        const double rev = (double)ang * 0.15915494309189535; const float fr = (float)(rev - floor(rev));
        const float sn = __builtin_amdgcn_sinf(fr), cs = __builtin_amdgcn_cosf(fr);
        const unsigned* src = (const unsigned*)(QKVB + (size_t)t * 768);
#pragma unroll
        for (int j = 0; j < 5; ++j) {
            const int head = 2 * j + hsel; const unsigned w = src[head * 32 + pi];
            const float x0 = bflo(w), x1 = bfhi(w);
            float ss = x0 * x0 + x1 * x1;
#pragma unroll
            for (int o = 1; o < 32; o <<= 1) ss += __shfl_xor(ss, o);
            const float rs = 1.0f / sqrtf(ss * (1.f / 64.f) + EPS);
            const bool isq = head < 8;
            const float y0 = x0 * rs * (isq ? qw0 : kw0), y1 = x1 * rs * (isq ? qw1 : kw1);
            float o0 = y0 * cs - y1 * sn, o1 = y0 * sn + y1 * cs;
            if (isq) { o0 *= C2; o1 *= C2; ((unsigned*)(QR + (size_t)t * 512))[head * 32 + pi] = pk2(o0, o1); }
            else ((unsigned*)(KR + (size_t)t * 128))[(head - 8) * 32 + pi] = pk2(o0, o1);
        }
        ((unsigned*)(VR + (size_t)t * 128))[lane] = src[320 + lane];
    }
}

constexpr int G_KNP = 0, G_QNP = 17408, G_KNTP = 34816, G_VCT = 53248;
constexpr int G_D0 = 71680, G_D1 = 71680 + 19456;
constexpr int GD_TBP = 0, GD_AP = 9216, GD_VEC = 18432;
constexpr int G_LM = 110592;
constexpr int G_GV = G_LM + 32768;
static_assert(G_GV + 1024 <= LDS_BYTES, "gdn pre lds");

#define TRI_ROW(i, LC, LN) { \
        if ((i) + 1 < 64) { _Pragma("unroll") for (int j4 = 0; j4 < ((i) + 1 + 3) / 4 && j4 < 8; ++j4) LN[j4] = *(const LAS f32x4*)(L + ((i) + 1) * 64 + 4 * j4); } \
        _Pragma("unroll") for (int j4 = 8; j4 < ((i) + 3) / 4; ++j4) lt[j4 - 8] = *(const LAS f32x4*)(L + (i) * 64 + 4 * j4); \
        __builtin_amdgcn_sched_barrier(0); \
        float a0 = (lane == (i)) ? 1.0f : 0.0f, a1 = 0.f; \
        _Pragma("unroll") for (int j4 = 0; j4 < ((i) + 3) / 4; ++j4) { const f32x4 l = (j4 < 8) ? LC[j4 & 7] : lt[(j4 - 8) & 7]; \
            if (4 * j4 + 0 < (i)) a0 -= l.x * x[4 * j4 + 0]; if (4 * j4 + 1 < (i)) a1 -= l.y * x[4 * j4 + 1]; \
            if (4 * j4 + 2 < (i)) a0 -= l.z * x[4 * j4 + 2]; if (4 * j4 + 3 < (i)) a1 -= l.w * x[4 * j4 + 3]; } \
        const float a = a0 + a1; x[(i)] = a; \
        TBP[(REV ? 63 - (i) : (i)) * 72 + pc] = (bf16)f2bf(a * bcol); \
        __builtin_amdgcn_sched_barrier(0); }
template <bool REV> DI void tri_inverse(LAS float* L, const LAS float* beta, LAS bf16* TBP, int lane) {
    float x[64];
    L = opaque(L); TBP = opaque(TBP); lane = opaque(lane);
    const float bcol = REV ? beta[63 - lane] : beta[lane];
    const int pc = REV ? permcol(63 - lane) : permcol(lane);
    f32x4 la[8], lb[8], lt[8];
#pragma unroll
    for (int ii = 0; ii < 64; ii += 2) { TRI_ROW(ii, la, lb) TRI_ROW(ii + 1, lb, la) }
}
#undef TRI_ROW

DI void p2_gdn_pre(Frame& F) {
    const int tid = F.tid, lane = F.lane, wave = F.wave;
    const bf16* QKVA = (const bf16*)(F.ws + WS_QKVA); const float* GATES = (const float*)(F.ws + WS_GATES);
    const float* convw = F.in[3];
#pragma unroll 1
    for (int task = F.vcu; task < 1024; task += F.G) {
        LAS unsigned char* lds = opaque(F.lds);
        LAS float* sGf = (LAS float*)(lds + G_GV); LAS float* sRb = sGf + 64; LAS float* sBf = sGf + 128; LAS float* sBb = sGf + 192;
        const int b = task >> 9, h = (task >> 7) & 3, n = task & 127;
        const int t0 = b * SEQ + n * 64;
#ifndef NO_CONV
        if (tid < 384) {
            const int cgp = tid % 48, rg = tid / 48, mat = cgp >> 4, cc = (cgp & 15) * 8;
            const int col = mat * 512 + h * 128 + cc;
            float w[5][8];
#pragma unroll
            for (int j = 0; j < 5; ++j) { const f32x4 a = *(const f32x4*)(convw + j * 1536 + col), bq = *(const f32x4*)(convw + j * 1536 + col + 4);
                w[j][0] = a.x; w[j][1] = a.y; w[j][2] = a.z; w[j][3] = a.w; w[j][4] = bq.x; w[j][5] = bq.y; w[j][6] = bq.z; w[j][7] = bq.w; }
            const int a4 = (cc >> 3) & 3, p0 = (cc & ~31) + 16 * (a4 & 1) + 4 * (a4 >> 1);
            const int ra = rg & 3, q0 = (rg >> 2) * 32 + 16 * (ra & 1) + 4 * (ra >> 1);
#pragma unroll
            for (int hf = 0; hf < 2; ++hf) {
                float o[4][8];
#pragma unroll
                for (int r = 0; r < 4; ++r)
#pragma unroll
                    for (int c = 0; c < 8; ++c) o[r][c] = 0.f;
#pragma unroll
                for (int i = 0; i < 8; ++i) {
                    const int pos = n * 64 + rg * 8 + hf * 4 - 2 + i;
                    v4u raw = (v4u){0u, 0u, 0u, 0u};
                    if (pos >= 0 && pos < SEQ) raw = *(const v4u*)(QKVA + (size_t)(b * SEQ + pos) * 1536 + col);
                    float xin[8] = {bflo(raw.x), bfhi(raw.x), bflo(raw.y), bfhi(raw.y), bflo(raw.z), bfhi(raw.z), bflo(raw.w), bfhi(raw.w)};
#pragma unroll
                    for (int j = 0; j < 5; ++j) { const int r = i - j; if (r >= 0 && r < 4) {
#pragma unroll
                        for (int c = 0; c < 8; ++c) o[r][c] += w[j][c] * xin[c]; } }
                }
#pragma unroll
                for (int r = 0; r < 4; ++r) {
                    float ss = 0.f;
#pragma unroll
                    for (int c = 0; c < 8; ++c) { o[r][c] = siluf(o[r][c]); ss += o[r][c] * o[r][c]; }
                    ss += __shfl_xor(ss, 1); ss += __shfl_xor(ss, 2); ss += __shfl_xor(ss, 4); ss += __shfl_xor(ss, 8);
                    float sc = 1.0f;
                    if (mat < 2) { sc = 1.0f / sqrtf(ss + EPS); if (mat == 0) sc *= 0.08838834764831845f; }
#pragma unroll
                    for (int c = 0; c < 8; ++c) o[r][c] *= sc;
                }
                if (mat < 2) {
                    LAS unsigned char* tile = lds + (mat == 0 ? G_QNP : G_KNP);
#pragma unroll
                    for (int r = 0; r < 4; ++r) { const int c = rg * 8 + hf * 4 + r;
                        v2u lo, hi2; lo.x = pk2(o[r][0], o[r][1]); lo.y = pk2(o[r][2], o[r][3]); hi2.x = pk2(o[r][4], o[r][5]); hi2.y = pk2(o[r][6], o[r][7]);
                        *(LAS v2u*)(tile + c * 272 + p0 * 2) = lo; *(LAS v2u*)(tile + c * 272 + (p0 + 8) * 2) = hi2; }
                }
                if (mat >= 1) {
#pragma unroll
                    for (int c = 0; c < 8; ++c) {
                        v2u q4; q4.x = pk2(o[0][c], o[1][c]); q4.y = pk2(o[2][c], o[3][c]);
                        if (mat == 1) *(LAS v2u*)(lds + G_KNTP + (cc + c) * 144 + (q0 + 8 * hf) * 2) = q4;
                        else *(LAS v2u*)(lds + G_VCT + (cc + c) * 144 + rg * 16 + hf * 8) = q4;
                    }
                }
            }
        } else
#endif
        if (wave == 7) {
            const float* gp = GATES + (size_t)(t0 + lane) * 16;
            const float bfv = gp[h], bbv = gp[4 + h], afv = gp[8 + h], abv = gp[12 + h];
            const float betaf = sigmoidf_(bfv), betab = sigmoidf_(bbv);
            const float xf = afv + F.in[5][h], xb = abv + F.in[5][4 + h];
            const float spf = fmaxf(xf, 0.f) + log1pf(__expf(-fabsf(xf))), spb = fmaxf(xb, 0.f) + log1pf(__expf(-fabsf(xb)));
            const float gf = -__expf(F.in[4][h]) * spf, gb = -__expf(F.in[4][4 + h]) * spb;
            float Gf = gf, Rb = gb;
#pragma unroll
            for (int o = 1; o < 64; o <<= 1) { const float u1 = __shfl_up(Gf, o); if (lane >= o) Gf += u1; const float d1 = __shfl_down(Rb, o); if (lane + o < 64) Rb += d1; }
            sGf[lane] = Gf; sRb[lane] = Rb; sBf[lane] = betaf; sBb[lane] = betab;
            const float GfL = __shfl(Gf, 63), Rb0 = __shfl(Rb, 0);
            LAS float* v0 = (LAS float*)(lds + G_D0 + GD_VEC); LAS float* v1 = (LAS float*)(lds + G_D1 + GD_VEC);
            v0[lane] = __expf(Gf); v0[64 + lane] = __expf(GfL - Gf); v1[lane] = __expf(Rb); v1[64 + lane] = __expf(Rb0 - Rb);
            if (lane == 0) { v0[128] = __expf(GfL); v1[128] = __expf(Rb0); }
        }
        __syncthreads();
        {
            const int p = wave >> 2, mt = wave & 3, n16 = lane & 15, g = lane >> 4;
            const LAS unsigned char* At = lds + (p == 0 ? G_KNP : G_QNP) + (16 * mt + n16) * 272 + g * 16;
            bf16x8 af[4];
#pragma unroll
            for (int ks = 0; ks < 4; ++ks) af[ks] = *(const LAS bf16x8*)(At + ks * 64);
#pragma unroll
            for (int nt = 0; nt < 4; ++nt) {
                const LAS unsigned char* Bt = lds + G_KNP + (16 * nt + n16) * 272 + g * 16;
                f32x4 acc = (f32x4){0.f, 0.f, 0.f, 0.f};
#pragma unroll
                for (int ks = 0; ks < 4; ++ks) acc = __builtin_amdgcn_mfma_f32_16x16x32_bf16(af[ks], *(const LAS bf16x8*)(Bt + ks * 64), acc, 0, 0, 0);
                const int s = 16 * nt + n16; const float Gs = sGf[s], Rs = sRb[s];
#pragma unroll
                for (int r = 0; r < 4; ++r) {
                    const int c = 16 * mt + 4 * g + r; const float v = acc[r];
                    const float df = __expf(fminf(sGf[c] - Gs, 0.f)), db = __expf(fminf(sRb[c] - Rs, 0.f));
                    if (p == 0) {
                        if (s < c) ((LAS float*)(lds + G_LM))[c * 64 + s] = sBf[c] * v * df;
                        if (s > c) ((LAS float*)(lds + G_LM + 16384))[(63 - c) * 64 + (63 - s)] = sBb[c] * v * db;
                    } else {
                        const int ps = permcol(s);
                        ((LAS bf16*)(lds + G_D0 + GD_AP))[c * 72 + ps] = (bf16)f2bf(s <= c ? v * df : 0.f);
                        ((LAS bf16*)(lds + G_D1 + GD_AP))[c * 72 + ps] = (bf16)f2bf(s >= c ? v * db : 0.f);
                    }
                }
            }
        }
        __syncthreads();
#ifndef NO_TRI
#ifdef PROBE_TRI2
        if (wave == 0) tri_inverse<false>((LAS float*)(lds + G_LM), sBf, (LAS bf16*)(lds + G_D0 + GD_TBP), lane);
        else if (wave == 1) tri_inverse<true>((LAS float*)(lds + G_LM + 16384), sBb, (LAS bf16*)(lds + G_D1 + GD_TBP), lane);
        __syncthreads();
#endif
        if (wave == 0) tri_inverse<false>((LAS float*)(lds + G_LM), sBf, (LAS bf16*)(lds + G_D0 + GD_TBP), lane);
        else if (wave == 1) tri_inverse<true>((LAS float*)(lds + G_LM + 16384), sBb, (LAS bf16*)(lds + G_D1 + GD_TBP), lane);
#endif
        __syncthreads();
        {
            const int bh = b * 4 + h;
            GAS v4u* gsh = (GAS v4u*)(F.ws + WS_GSH + (size_t)(bh * 128 + n) * GDN_SH_BYTES);
#pragma unroll 1
            for (int i = tid; i < (int)(GDN_SH_BYTES / 16); i += NTHREADS) gsh[i] = *(const LAS v4u*)(lds + i * 16);
            GAS v4u* gd0 = (GAS v4u*)(F.ws + WS_GD + (size_t)((bh * 2 + 0) * 128 + n) * GDN_D_BYTES);
            GAS v4u* gd1 = (GAS v4u*)(F.ws + WS_GD + (size_t)((bh * 2 + 1) * 128 + n) * GDN_D_BYTES);
#pragma unroll 1
            for (int i = tid; i < (int)(GDN_D_BYTES / 16); i += NTHREADS) { gd0[i] = *(const LAS v4u*)(lds + G_D0 + i * 16); gd1[i] = *(const LAS v4u*)(lds + G_D1 + i * 16); }
        }
        __syncthreads();
    }
}

DI bf16x8 pack8(const f32x4 a, const f32x4 b) {
    v4u p; p.x = pk2(a[0], a[1]); p.y = pk2(a[2], a[3]); p.z = pk2(b[0], b[1]); p.w = pk2(b[2], b[3]); return __builtin_bit_cast(bf16x8, p);
}
DI bf16* wgu_ptr(Frame& F, int e) { return (bf16*)(F.ws + (e < WGU_SPLIT ? WS_WGU0 + (size_t)e * 2 * MiB : WS_WGU1 + (size_t)(e - WGU_SPLIT) * 2 * MiB)); }
DI bf16* wd_ptr(Frame& F, int e) { return (bf16*)((unsigned char*)F.out + (e < WD_SPLIT ? DO_WD0 + (size_t)e * MiB : DO_WD1 + (size_t)(e - WD_SPLIT) * MiB)); }
DI void moe_weights(Frame& F, int gw, int NGW) {
    LAS float* scr = (LAS float*)(F.lds + F.wave * 16384);
    constexpr int IG = 16 * 16, ID = 8 * 32, IPE = 2 * IG + ID;
    for (int it = gw; it < NEXP * IPE; it += NGW) {
        const int e = it / IPE; int r = it % IPE;
        if (r < IG) { p0_transpose_item(F.in[13] + (size_t)e * 1024 * 512, 512, 16, wgu_ptr(F, e), 1024, 0, 2, scr, r, F.lane); continue; } r -= IG;
        if (r < IG) { p0_transpose_item(F.in[14] + (size_t)e * 1024 * 512, 512, 16, wgu_ptr(F, e), 1024, 1, 2, scr, r, F.lane); continue; } r -= IG;
        p0_transpose_item(F.in[15] + (size_t)e * 512 * 1024, 1024, 32, wd_ptr(F, e), 512, 0, 1, scr, r, F.lane);
    }
}

constexpr int SC_SLOT = 78848, SC_VCT = 53248, SC_D = 55552, SC_NCH = 11;
static_assert(2 * SC_SLOT <= LDS_BYTES, "scan slots");
DI void sc_issue(v4u (&R)[SC_NCH], const unsigned char* ws, const unsigned (&delta)[SC_NCH], const unsigned (&dmask)[SC_NCH], unsigned shbase, unsigned ddiff) {
#pragma unroll
    for (int j = 0; j < SC_NCH; ++j) { const unsigned off = shbase + delta[j] + (dmask[j] & ddiff);
#ifdef SC_PLAIN_LOADS
        R[j] = *(const v4u*)(ws + off); }
#else
        asm volatile("global_load_dwordx4 %0, %1, %2" : "=v"(R[j]) : "v"(off), "s"(ws) : "memory"); }
#endif
}
#ifdef SC_PLAIN_LOADS
#define SC_WAIT(R, n) do {} while (0)
#else
#define SC_WAIT(R, n) asm volatile("s_waitcnt vmcnt(" #n ")" : "+v"(R[0]), "+v"(R[1]), "+v"(R[2]), "+v"(R[3]), "+v"(R[4]), "+v"(R[5]), "+v"(R[6]), "+v"(R[7]), "+v"(R[8]), "+v"(R[9]), "+v"(R[10]) :: "memory")
#endif
DI void sc_write(const v4u (&R)[SC_NCH], LAS unsigned char* slot, int lid) {
#pragma unroll
    for (int j = 0; j < SC_NCH; ++j) *(LAS v4u*)(slot + 16 * (lid + 448 * j)) = R[j];
}
DI void p4_scan(Frame& F) {
    const int lane = F.lane, n16 = lane & 15, g = lane >> 4, wave = F.wave;
    {
        volatile LAS int* tsk = (volatile LAS int*)(F.lds + MISC_OFF + 32);
        if (F.tid == 0) {
            unsigned* q = (unsigned*)(F.ws + WS_CTL) + CW_SCANQ; const unsigned xcc = xb_xcc_id() & 7u; int task = -1;
            for (unsigned t = 0; t < 8 && task < 0; ++t) { const unsigned y = (xcc + t) & 7u; const unsigned j = xb_add(q + 64 * y, 1u); if (j < 16u) task = (int)(y * 16 + j); }
            *tsk = task; if (task < 0) tsk[1] = (int)xb_add(q + 64 * 8, 1u);
        }
        __syncthreads();
    }
    const int task = *(volatile LAS int*)(F.lds + MISC_OFF + 32);
    if (task < 0) {
        if (F.G > 128) moe_weights(F, *(volatile LAS int*)(F.lds + MISC_OFF + 36) * NWAVES + wave, (F.G - 128) * NWAVES);
        return; }
    const int chain = 2 * (task >> 4) + ((task & 15) >> 3), e = task & 7;
    const int bh = chain >> 1, dir = chain & 1, b = bh >> 2, h = bh & 3;
    LAS unsigned char* lds = opaque(F.lds);
    if (wave != 0) {
        const int lid = (wave - 1) * 64 + lane;
        const unsigned sh0 = (unsigned)(WS_GSH + (size_t)(bh * 128) * GDN_SH_BYTES), d0 = (unsigned)(WS_GD + (size_t)((bh * 2 + dir) * 128) * GDN_D_BYTES);
        unsigned delta[SC_NCH], dmask[SC_NCH];
#pragma unroll
        for (int j = 0; j < SC_NCH; ++j) { const int c = lid + 448 * j;
            delta[j] = (c < 3328) ? 16u * c : ((c < 3472) ? (unsigned)(G_VCT + 16 * e * 144 + 16 * (c - 3328)) : 16u * (c - 3472));
            dmask[j] = (c < 3472) ? 0u : 0xffffffffu; }
        v4u R0[SC_NCH], R1[SC_NCH], R2[SC_NCH];
#define SC_SRC(st) const int n_ = (dir == 0) ? ((st) < 128 ? (st) : 127) : ((st) < 128 ? 127 - (st) : 0); \
                   const unsigned shb_ = sh0 + (unsigned)n_ * (unsigned)GDN_SH_BYTES, ddf_ = (d0 + (unsigned)n_ * (unsigned)GDN_D_BYTES) - shb_;
        { SC_SRC(0) sc_issue(R0, F.ws, delta, dmask, shb_, ddf_); }
        { SC_SRC(1) sc_issue(R1, F.ws, delta, dmask, shb_, ddf_); }
        { SC_SRC(2) sc_issue(R2, F.ws, delta, dmask, shb_, ddf_); }
#define SC_BODY(R, st) { SC_WAIT(R, 22); sc_write(R, lds + ((st) & 1) * SC_SLOT, lid); { SC_SRC((st) + 3) sc_issue(R, F.ws, delta, dmask, shb_, ddf_); } \
                        asm volatile("s_waitcnt lgkmcnt(0)" ::: "memory"); __builtin_amdgcn_s_barrier(); }
#pragma unroll 1
        for (int s0 = 0; s0 < 126; s0 += 3) { SC_BODY(R0, s0) SC_BODY(R1, s0 + 1) SC_BODY(R2, s0 + 2) }
        SC_BODY(R0, 126) SC_BODY(R1, 127)
        SC_WAIT(R0, 0); SC_WAIT(R1, 0); SC_WAIT(R2, 0);
#undef SC_BODY
#undef SC_SRC
        return;
    }
    bf16* Odir = (bf16*)((unsigned char*)F.out + (dir == 0 ? DO_OF : DO_OB));
    f32x4 S[8];
#pragma unroll
    for (int i = 0; i < 8; ++i) S[i] = (f32x4){0.f, 0.f, 0.f, 0.f};
    bf16x8 Sb[4];
#pragma unroll
    for (int i = 0; i < 4; ++i) Sb[i] = (bf16x8){0, 0, 0, 0, 0, 0, 0, 0};
    const unsigned aoff272 = n16 * 272 + g * 16, aoff144 = n16 * 144 + g * 16;
    const unsigned lds0 = (unsigned)(uintptr_t)lds;
#define SB_() __builtin_amdgcn_sched_barrier(0)
#define LDR128(dst, base, off) asm volatile("ds_read_b128 %0, %1 offset:%2" : "=v"(dst) : "v"(base), "i"(off) : "memory")
#define LDR64(dst, base, off) asm volatile("ds_read_b64 %0, %1 offset:%2" : "=v"(dst) : "v"(base), "i"(off) : "memory")
#define LDR32(dst, base, off) asm volatile("ds_read_b32 %0, %1 offset:%2" : "=v"(dst) : "v"(base), "i"(off) : "memory")
#pragma unroll 1
    for (int step = 0; step < 128; ++step) {
        __builtin_amdgcn_s_barrier();
        asm volatile("" ::: "memory");
        const int n = dir == 0 ? step : 127 - step;
        const unsigned slot = lds0 + (unsigned)(step & 1) * SC_SLOT;
        const unsigned bK = slot + G_KNP + aoff272, bQ = slot + G_QNP + aoff272, bKT = slot + G_KNTP + aoff144, bT = slot + SC_D + GD_TBP + aoff144;
        const unsigned bV = slot + SC_VCT + n16 * 144 + g * 8, bvec = slot + SC_D + GD_VEC + g * 16, bd = slot + SC_D + GD_VEC;
        f32x4 eG[4], ks[4]; v2u vv[4]; float dch; bf16x8 fa[16];
        LDR128(eG[0], bvec, 0); LDR128(eG[1], bvec, 64); LDR128(eG[2], bvec, 128); LDR128(eG[3], bvec, 192);
        LDR128(ks[0], bvec, 256); LDR128(ks[1], bvec, 320); LDR128(ks[2], bvec, 384); LDR128(ks[3], bvec, 448);
        LDR32(dch, bd, 512);
        LDR64(vv[0], bV, 0); LDR64(vv[1], bV, 32); LDR64(vv[2], bV, 64); LDR64(vv[3], bV, 96);
#pragma unroll
        for (int m = 0; m < 4; ++m) { LDR128(fa[m * 4 + 0], bK, m * 4352 + 0); LDR128(fa[m * 4 + 1], bK, m * 4352 + 64); LDR128(fa[m * 4 + 2], bK, m * 4352 + 128); LDR128(fa[m * 4 + 3], bK, m * 4352 + 192); }
        bf16x8 fq[16];
#pragma unroll
        for (int m = 0; m < 4; ++m) { LDR128(fq[m * 4 + 0], bQ, m * 4352 + 0); LDR128(fq[m * 4 + 1], bQ, m * 4352 + 64); LDR128(fq[m * 4 + 2], bQ, m * 4352 + 128); LDR128(fq[m * 4 + 3], bQ, m * 4352 + 192); }
        asm volatile("s_waitcnt lgkmcnt(15)" : "+v"(eG[0]), "+v"(eG[1]), "+v"(eG[2]), "+v"(eG[3]), "+v"(ks[0]), "+v"(ks[1]), "+v"(ks[2]), "+v"(ks[3]), "+v"(dch), "+v"(vv[0]), "+v"(vv[1]), "+v"(vv[2]), "+v"(vv[3]),
                     "+v"(fa[0]), "+v"(fa[1]), "+v"(fa[2]), "+v"(fa[3]), "+v"(fa[4]), "+v"(fa[5]), "+v"(fa[6]), "+v"(fa[7]), "+v"(fa[8]), "+v"(fa[9]), "+v"(fa[10]), "+v"(fa[11]), "+v"(fa[12]), "+v"(fa[13]), "+v"(fa[14]), "+v"(fa[15]) :: "memory");
        SB_();
        f32x4 KS[4];
#pragma unroll
        for (int m = 0; m < 4; ++m) KS[m] = (f32x4){0.f, 0.f, 0.f, 0.f};
#pragma unroll
        for (int i = 0; i < 4; ++i)
#pragma unroll
            for (int m = 0; m < 4; ++m) KS[m] = __builtin_amdgcn_mfma_f32_16x16x32_bf16(fa[m * 4 + i], Sb[i], KS[m], 0, 0, 0);
        SB_();
        bf16x8 ft[8];
#pragma unroll
        for (int m = 0; m < 4; ++m) { LDR128(ft[m * 2 + 0], bT, m * 2304 + 0); LDR128(ft[m * 2 + 1], bT, m * 2304 + 64); }
        asm volatile("s_waitcnt lgkmcnt(8)" : "+v"(fq[0]), "+v"(fq[1]), "+v"(fq[2]), "+v"(fq[3]), "+v"(fq[4]), "+v"(fq[5]), "+v"(fq[6]), "+v"(fq[7]), "+v"(fq[8]), "+v"(fq[9]), "+v"(fq[10]), "+v"(fq[11]), "+v"(fq[12]), "+v"(fq[13]), "+v"(fq[14]), "+v"(fq[15]) :: "memory");
        SB_();
        f32x4 o[4];
#pragma unroll
        for (int m = 0; m < 4; ++m) o[m] = (f32x4){0.f, 0.f, 0.f, 0.f};
#pragma unroll
        for (int i = 0; i < 4; ++i)
#pragma unroll
            for (int m = 0; m < 4; ++m) o[m] = __builtin_amdgcn_mfma_f32_16x16x32_bf16(fq[m * 4 + i], Sb[i], o[m], 0, 0, 0);
        f32x4 rr[4];
#pragma unroll
        for (int m = 0; m < 4; ++m) { rr[m][0] = bflo(vv[m].x) - eG[m][0] * KS[m][0]; rr[m][1] = bfhi(vv[m].x) - eG[m][1] * KS[m][1]; rr[m][2] = bflo(vv[m].y) - eG[m][2] * KS[m][2]; rr[m][3] = bfhi(vv[m].y) - eG[m][3] * KS[m][3]; }
        bf16x8 rb[2]; rb[0] = pack8(rr[0], rr[1]); rb[1] = pack8(rr[2], rr[3]);
        SB_();
        bf16x8 fk[16];
#pragma unroll
        for (int jt = 0; jt < 8; ++jt) { LDR128(fk[jt * 2 + 0], bKT, jt * 2304 + 0); LDR128(fk[jt * 2 + 1], bKT, jt * 2304 + 64); }
        asm volatile("s_waitcnt lgkmcnt(15)" : "+v"(ft[0]), "+v"(ft[1]), "+v"(ft[2]), "+v"(ft[3]), "+v"(ft[4]), "+v"(ft[5]), "+v"(ft[6]), "+v"(ft[7]) :: "memory");
        SB_();
        f32x4 vn[4];
#pragma unroll
        for (int m = 0; m < 4; ++m) vn[m] = (f32x4){0.f, 0.f, 0.f, 0.f};
#pragma unroll
        for (int i = 0; i < 2; ++i)
#pragma unroll
            for (int m = 0; m < 4; ++m) vn[m] = __builtin_amdgcn_mfma_f32_16x16x32_bf16(ft[m * 2 + i], rb[i], vn[m], 0, 0, 0);
#pragma unroll
        for (int m = 0; m < 4; ++m) o[m] = o[m] * eG[m];
#pragma unroll
        for (int jt = 0; jt < 8; ++jt) S[jt] = S[jt] * dch;
        SB_();
        bf16x8 fp[8];
#pragma unroll
        for (int m = 0; m < 4; ++m) { LDR128(fp[m * 2 + 0], bT, GD_AP + m * 2304 + 0); LDR128(fp[m * 2 + 1], bT, GD_AP + m * 2304 + 64); }
        bf16x8 vnb[2]; vnb[0] = pack8(vn[0], vn[1]); vnb[1] = pack8(vn[2], vn[3]);
        bf16x8 vs[2]; vs[0] = pack8(vn[0] * ks[0], vn[1] * ks[1]); vs[1] = pack8(vn[2] * ks[2], vn[3] * ks[3]);
        asm volatile("s_waitcnt lgkmcnt(8)" : "+v"(fk[0]), "+v"(fk[1]), "+v"(fk[2]), "+v"(fk[3]), "+v"(fk[4]), "+v"(fk[5]), "+v"(fk[6]), "+v"(fk[7]), "+v"(fk[8]), "+v"(fk[9]), "+v"(fk[10]), "+v"(fk[11]), "+v"(fk[12]), "+v"(fk[13]), "+v"(fk[14]), "+v"(fk[15]) :: "memory");
        SB_();
#pragma unroll
        for (int i = 0; i < 2; ++i)
#pragma unroll
            for (int jt = 0; jt < 8; ++jt) S[jt] = __builtin_amdgcn_mfma_f32_16x16x32_bf16(fk[jt * 2 + i], vs[i], S[jt], 0, 0, 0);
        asm volatile("s_waitcnt lgkmcnt(0)" : "+v"(fp[0]), "+v"(fp[1]), "+v"(fp[2]), "+v"(fp[3]), "+v"(fp[4]), "+v"(fp[5]), "+v"(fp[6]), "+v"(fp[7]) :: "memory");
#pragma unroll
        for (int i = 0; i < 2; ++i)
#pragma unroll
            for (int m = 0; m < 4; ++m) o[m] = __builtin_amdgcn_mfma_f32_16x16x32_bf16(fp[m * 2 + i], vnb[i], o[m], 0, 0, 0);
#pragma unroll
        for (int i = 0; i < 4; ++i) Sb[i] = pack8(S[2 * i], S[2 * i + 1]);
        SB_();
        bf16* op = Odir + (size_t)(b * SEQ + n * 64) * 512 + h * 128 + 16 * e + n16;
#pragma unroll
        for (int m = 0; m < 4; ++m)
#pragma unroll
            for (int r = 0; r < 4; ++r) op[(size_t)(16 * m + 4 * g + r) * 512] = (bf16)(pk2(o[m][r], 0.f) & 0xffffu);
    }
#undef SB_
#undef LDR128
#undef LDR64
#undef LDR32
}

DI void p5_combine(Frame& F) {
    const int gw = F.vcu * NWAVES + F.wave, NGW = F.G * NWAVES, lane = F.lane;
    const bf16* OFp = (const bf16*)((unsigned char*)F.out + DO_OF); const bf16* OBp = (const bf16*)((unsigned char*)F.out + DO_OB);
    const bf16* ZA = (const bf16*)(F.ws + WS_ZA); bf16* OCAT = (bf16*)(F.ws + WS_OCAT);
    const float* nw = F.in[6] + (lane & 15) * 8;
    float w8[8];
#pragma unroll
    for (int c = 0; c < 8; ++c) w8[c] = nw[c];
    for (int t = gw; t < TT; t += NGW) {
        const v4u a = *(const v4u*)(OFp + (size_t)t * 512 + lane * 8), bb = *(const v4u*)(OBp + (size_t)t * 512 + lane * 8), z = *(const v4u*)(ZA + (size_t)t * 512 + lane * 8);
        float o[8] = {bflo(a.x) + bflo(bb.x), bfhi(a.x) + bfhi(bb.x), bflo(a.y) + bflo(bb.y), bfhi(a.y) + bfhi(bb.y), bflo(a.z) + bflo(bb.z), bfhi(a.z) + bfhi(bb.z), bflo(a.w) + bflo(bb.w), bfhi(a.w) + bfhi(bb.w)};
        const float zz[8] = {bflo(z.x), bfhi(z.x), bflo(z.y), bfhi(z.y), bflo(z.z), bfhi(z.z), bflo(z.w), bfhi(z.w)};
        float ss = 0.f;
#pragma unroll
        for (int c = 0; c < 8; ++c) ss += o[c] * o[c];
        ss += __shfl_xor(ss, 1); ss += __shfl_xor(ss, 2); ss += __shfl_xor(ss, 4); ss += __shfl_xor(ss, 8);
        const float rn = 1.0f / sqrtf(ss * (1.f / 128.f) + EPS);
#pragma unroll
        for (int c = 0; c < 8; ++c) o[c] = o[c] * rn * w8[c] * siluf(zz[c]);
        v4u r; r.x = pk2(o[0], o[1]); r.y = pk2(o[2], o[3]); r.z = pk2(o[4], o[5]); r.w = pk2(o[6], o[7]);
        *(v4u*)(OCAT + (size_t)t * 1024 + lane * 8) = r;
    }
}
struct TokRec { int e[2]; int row[2]; float gate[2]; };
DI void p7_route(Frame& F) {
    const int gw = F.vcu * NWAVES + F.wave, NGW = F.G * NWAVES, lane = F.lane, n16 = lane & 15, g = lane >> 4;
    const float* X1 = (const float*)(F.ws + WS_X1); const float* nfw = F.in[10];
    const bf16* WRH = (const bf16*)(F.ws + WS_WR); const bf16* WRL = WRH + 48 * 1024;
    bf16* HN = (bf16*)((unsigned char*)F.out + DO_HN); TokRec* TOK = (TokRec*)(F.ws + WS_TOK); unsigned* cnt = (unsigned*)(F.ws + WS_CTL) + CW_CNT;
    LAS float* lg = (LAS float*)(F.lds + F.wave * 4096);
    for (int rt = gw; rt < TT / 16; rt += NGW) {
        const int row = rt * 16 + n16; const float* xr = X1 + (size_t)row * DMODEL + 8 * g;
        float ss = 0.f;
        for (int i = 0; i < 32; ++i) { const f32x4 a = *(const f32x4*)(xr + 32 * i), b2 = *(const f32x4*)(xr + 32 * i + 4);
            ss += (a.x * a.x + a.y * a.y) + (a.z * a.z + a.w * a.w) + (b2.x * b2.x + b2.y * b2.y) + (b2.z * b2.z + b2.w * b2.w); }
        ss += __shfl_xor(ss, 16); ss += __shfl_xor(ss, 32);
        const float rs = 1.0f / sqrtf(ss * (1.f / DMODEL) + EPS);
        f32x4 acc[3];
#pragma unroll
        for (int q = 0; q < 3; ++q) acc[q] = (f32x4){0.f, 0.f, 0.f, 0.f};
        for (int i = 0; i < 32; ++i) {
            const f32x4 a = *(const f32x4*)(xr + 32 * i), b2 = *(const f32x4*)(xr + 32 * i + 4);
            const f32x4 wa = *(const f32x4*)(nfw + 32 * i + 8 * g), wb = *(const f32x4*)(nfw + 32 * i + 8 * g + 4);
            float hv[8] = {a.x * rs * wa.x, a.y * rs * wa.y, a.z * rs * wa.z, a.w * rs * wa.w, b2.x * rs * wb.x, b2.y * rs * wb.y, b2.z * rs * wb.z, b2.w * rs * wb.w};
            v4u hi, lo; unsigned hh[8], ll[8];
#pragma unroll
            for (int c = 0; c < 8; ++c) { hh[c] = f2bf(hv[c]); ll[c] = f2bf(hv[c] - __builtin_bit_cast(float, hh[c] << 16)); }
            hi.x = hh[0] | (hh[1] << 16); hi.y = hh[2] | (hh[3] << 16); hi.z = hh[4] | (hh[5] << 16); hi.w = hh[6] | (hh[7] << 16);
            lo.x = ll[0] | (ll[1] << 16); lo.y = ll[2] | (ll[3] << 16); lo.z = ll[4] | (ll[5] << 16); lo.w = ll[6] | (ll[7] << 16);
            *(v4u*)(HN + (size_t)row * DMODEL + 32 * i + 8 * g) = hi;
            const bf16x8 ah = __builtin_bit_cast(bf16x8, hi), al = __builtin_bit_cast(bf16x8, lo);
#pragma unroll
            for (int q = 0; q < 3; ++q) {
                const bf16x8 bh = *(const bf16x8*)(WRH + (size_t)(16 * q + n16) * 1024 + 32 * i + 8 * g), bl = *(const bf16x8*)(WRL + (size_t)(16 * q + n16) * 1024 + 32 * i + 8 * g);
                acc[q] = __builtin_amdgcn_mfma_f32_16x16x32_bf16(ah, bh, acc[q], 0, 0, 0);
                acc[q] = __builtin_amdgcn_mfma_f32_16x16x32_bf16(ah, bl, acc[q], 0, 0, 0);
                acc[q] = __builtin_amdgcn_mfma_f32_16x16x32_bf16(al, bh, acc[q], 0, 0, 0);
            }
        }
#pragma unroll
        for (int q = 0; q < 3; ++q)
#pragma unroll
            for (int r = 0; r < 4; ++r) lg[(4 * g + r) * 48 + 16 * q + n16] = acc[q][r];
        asm volatile("s_waitcnt lgkmcnt(0)" ::: "memory");
        if (lane < 16) {
            const LAS float* L = lg + lane * 48; const int tok = rt * 16 + lane;
            float gm = L[0]; int gs = 0;
#pragma unroll
            for (int q = 1; q < 4; ++q) if (L[q] > gm) { gm = L[q]; gs = q; }
            float gsum = 0.f;
#pragma unroll
            for (int q = 0; q < 4; ++q) gsum += __expf(L[q] - gm);
            const float gp_top = 1.0f / gsum;
            float fv[8];
#pragma unroll
            for (int q = 0; q < 8; ++q) { float v = L[4 + q]; v = (gs == 1) ? L[12 + q] : v; v = (gs == 2) ? L[20 + q] : v; v = (gs == 3) ? L[28 + q] : v; fv[q] = v; }
            float m1 = fv[0]; int i1 = 0;
#pragma unroll
            for (int q = 1; q < 8; ++q) if (fv[q] > m1) { m1 = fv[q]; i1 = q; }
            float m2 = -3.0e38f; int i2 = 0;
#pragma unroll
            for (int q = 0; q < 8; ++q) if (q != i1 && fv[q] > m2) { m2 = fv[q]; i2 = q; }
            const float e2 = __expf(m2 - m1); const float g1 = gp_top / (1.0f + e2), g2 = gp_top * e2 / (1.0f + e2);
            const int ex1 = gs * 8 + i1, ex2 = gs * 8 + i2;
            const int s1 = (int)atomicAdd(cnt + ex1, 1u), s2 = (int)atomicAdd(cnt + ex2, 1u);
            TokRec tr; tr.e[0] = ex1; tr.e[1] = ex2; tr.row[0] = s1; tr.row[1] = s2; tr.gate[0] = g1; tr.gate[1] = g2;
            TOK[tok] = tr;
        }
        asm volatile("s_waitcnt lgkmcnt(0)" ::: "memory");
    }
}

DI void p8_gather(Frame& F) {
    const int gw = F.vcu * NWAVES + F.wave, NGW = F.G * NWAVES, lane = F.lane;
    unsigned* ctl = (unsigned*)(F.ws + WS_CTL);
    LAS int* pst = (LAS int*)(F.lds);
    if (F.tid == 0) {
        int acc = 0, nt = 0;
        for (int e = 0; e < NEXP; ++e) { const int c = (int)__hip_atomic_load(ctl + CW_CNT + e, __ATOMIC_RELAXED, __HIP_MEMORY_SCOPE_AGENT); pst[e] = acc; const int ntile = (c + 255) >> 8;
            if (blockIdx.x == 0) for (int q = 0; q < ntile; ++q) { ctl[CW_TILES + 2 * (nt + q)] = (unsigned)((acc >> 8) + q); ctl[CW_TILES + 2 * (nt + q) + 1] = (unsigned)e; }
            nt += ntile; acc += ntile * 256; }
        if (blockIdx.x == 0) ctl[CW_NTILE] = (unsigned)nt;
    }
    __syncthreads();
    const bf16* HN = (const bf16*)((unsigned char*)F.out + DO_HN); bf16* XB = (bf16*)(F.ws + WS_XBUF); TokRec* TOK = (TokRec*)(F.ws + WS_TOK);
    for (int t = gw; t < TT; t += NGW) {
        TokRec tr = TOK[t];
        const int r0 = pst[tr.e[0]] + tr.row[0], r1 = pst[tr.e[1]] + tr.row[1];
        const v4u a = *(const v4u*)(HN + (size_t)t * DMODEL + lane * 8), b2 = *(const v4u*)(HN + (size_t)t * DMODEL + 512 + lane * 8);
        *(v4u*)(XB + (size_t)r0 * DMODEL + lane * 8) = a; *(v4u*)(XB + (size_t)r0 * DMODEL + 512 + lane * 8) = b2;
        *(v4u*)(XB + (size_t)r1 * DMODEL + lane * 8) = a; *(v4u*)(XB + (size_t)r1 * DMODEL + 512 + lane * 8) = b2;
        if (lane == 0) { TOK[t].row[0] = r0; TOK[t].row[1] = r1; }
    }
}

DI void p11_final(Frame& F) {
    const int gw = F.vcu * NWAVES + F.wave, NGW = F.G * NWAVES, lane = F.lane;
    const bf16* Y = (const bf16*)(F.ws + WS_XBUF); const TokRec* TOK = (const TokRec*)(F.ws + WS_TOK); const float* fw = F.in[16];
    for (int t = gw; t < TT; t += NGW) {
        const TokRec tr = TOK[t];
        const float* xr = (const float*)(F.ws + WS_X1) + (size_t)t * DMODEL + lane * 8; float* orow = F.out + (size_t)t * DMODEL + lane * 8;
        const f32x4 a = *(const f32x4*)(xr), b2 = *(const f32x4*)(xr + 4), c = *(const f32x4*)(xr + 512), d = *(const f32x4*)(xr + 516);
        float v[16] = {a.x, a.y, a.z, a.w, b2.x, b2.y, b2.z, b2.w, c.x, c.y, c.z, c.w, d.x, d.y, d.z, d.w};
#pragma unroll
        for (int k = 0; k < 2; ++k) {
            const float gk = tr.gate[k]; const bf16* yr = Y + (size_t)tr.row[k] * DMODEL + lane * 8;
            const v4u y0 = *(const v4u*)(yr), y1 = *(const v4u*)(yr + 512);
            v[0] += gk * bflo(y0.x); v[1] += gk * bfhi(y0.x); v[2] += gk * bflo(y0.y); v[3] += gk * bfhi(y0.y); v[4] += gk * bflo(y0.z); v[5] += gk * bfhi(y0.z); v[6] += gk * bflo(y0.w); v[7] += gk * bfhi(y0.w);
            v[8] += gk * bflo(y1.x); v[9] += gk * bfhi(y1.x); v[10] += gk * bflo(y1.y); v[11] += gk * bfhi(y1.y); v[12] += gk * bflo(y1.z); v[13] += gk * bfhi(y1.z); v[14] += gk * bflo(y1.w); v[15] += gk * bfhi(y1.w);
        }
        float ss = 0.f;
#pragma unroll
        for (int i = 0; i < 16; ++i) ss += v[i] * v[i];
        const float rs = 1.0f / sqrtf(wave_sum(ss) * (1.f / DMODEL) + EPS);
        const f32x4 w0 = *(const f32x4*)(fw + lane * 8), w1 = *(const f32x4*)(fw + lane * 8 + 4), w2 = *(const f32x4*)(fw + 512 + lane * 8), w3 = *(const f32x4*)(fw + 516 + lane * 8);
        *(f32x4*)(orow) = (f32x4){v[0] * rs * w0.x, v[1] * rs * w0.y, v[2] * rs * w0.z, v[3] * rs * w0.w};
        *(f32x4*)(orow + 4) = (f32x4){v[4] * rs * w1.x, v[5] * rs * w1.y, v[6] * rs * w1.z, v[7] * rs * w1.w};
        *(f32x4*)(orow + 512) = (f32x4){v[8] * rs * w2.x, v[9] * rs * w2.y, v[10] * rs * w2.z, v[11] * rs * w2.w};
        *(f32x4*)(orow + 516) = (f32x4){v[12] * rs * w3.x, v[13] * rs * w3.y, v[14] * rs * w3.z, v[15] * rs * w3.w};
    }
}

struct Args { const float* in[17]; float* out; unsigned char* ws; int ph_lo, ph_hi; };
__global__ void __launch_bounds__(NTHREADS, 2) fwd_kernel(Args args) {
    extern __shared__ __attribute__((aligned(16))) unsigned char lds[];
    cg::grid_group grid = cg::this_grid();
    Frame F;
    F.lds = (LAS unsigned char*)lds; F.tid = threadIdx.x; F.lane = F.tid & 63; F.wave = __builtin_amdgcn_readfirstlane(F.tid >> 6);
    F.G = gridDim.x; { const int bx = blockIdx.x; F.vcu = (F.G % 8 == 0) ? (bx % 8) * (F.G / 8) + bx / 8 : bx; }
#pragma unroll
    for (int i = 0; i < 17; ++i) F.in[i] = args.in[i];
    F.out = args.out; F.ws = args.ws;
    const int lo = args.ph_lo, hi = args.ph_hi;
    if (F.tid < 16) ((volatile LAS unsigned*)(F.lds + MISC_OFF))[F.tid] = 0u;
    __syncthreads();
    XcdBarrier bar = xcd_barrier_post((unsigned*)(F.ws + WS_CTL) + CW_BAR, (volatile LAS unsigned*)(F.lds + MISC_OFF));
    if (lo > 1000) grid.sync();
#ifndef PHSEL
#define PHSEL 0xfff
#endif
#define IN(k) (((PHSEL >> (k)) & 1) && lo <= (k) && (k) < hi)
#define SEAM(k) do { if (IN(k) && IN((k) + 1)) xcd_barrier(bar); } while (0)
#ifndef REP_PH
#define REP_PH -1
#endif
#define REPS(k) for (int rep_ = 0; rep_ < ((k) == REP_PH ? 2 : 1); ++rep_, ((k) == REP_PH && rep_ < 2) ? xcd_barrier(bar) : (void)0)
    if (IN(0)) REPS(0) { p0_prologue(F); } SEAM(0);
    if (IN(1)) REPS(1) {
        pg8::Gemm gm{(const pg8::bf16_t*)(F.ws + WS_XN), (const pg8::bf16_t*)(F.ws + WS_WIN), TT, NPROJ, DMODEL}; pg8::StaticOrder S; S.init(TT, NPROJ, F.G, (int)blockIdx.x);
        EpiProj E{(bf16*)(F.ws + WS_QKVA), (bf16*)(F.ws + WS_ZA), (bf16*)(F.ws + WS_QKVB), (float*)(F.ws + WS_GATES)};
        pg8::gemm_phase<EpiProj, pg8::StaticOrder, true, true>(F.lds, gm, S, E);
    } SEAM(1);
    if (IN(2)) REPS(2) {
#ifndef NO_ROPE
        p2_rope(F);
#endif
#ifndef NO_PRE
        p2_gdn_pre(F);
#endif
    } SEAM(2);
    if (IN(3)) REPS(3) {
        const attn_body::AttnTensors AT{(const attn_body::bf16*)((unsigned char*)F.out + DO_QR), (const attn_body::bf16*)((unsigned char*)F.out + DO_KR), (const attn_body::bf16*)((unsigned char*)F.out + DO_VR),
                                        (attn_body::bf16*)(F.ws + WS_OCAT) + 512};
        const attn_body::StaticOrder S((int)F.G, (int)blockIdx.x);
#ifdef PROBE_ZERO_ATTN
        { (void)AT; (void)S; bf16* OC = (bf16*)(F.ws + WS_OCAT); const int gt = blockIdx.x * NTHREADS + F.tid, GT = F.G * NTHREADS;
          for (int i = gt; i < TT * 64; i += GT) { const int t = i >> 6, c = i & 63; *(v4u*)(OC + (size_t)t * 1024 + 512 + c * 8) = (v4u){0u, 0u, 0u, 0u}; } }
#else
        attn_body::attn_phase<attn_body::StaticOrder>((char*)lds, AT, S);
#endif
    } SEAM(3);
#ifdef PROBE_SCAN2
    if (IN(4)) { p4_scan(F); xcd_barrier(bar); p4_scan(F); } SEAM(4);
#else
    if (IN(4)) REPS(4) { p4_scan(F); } SEAM(4);
#endif
    if (IN(5)) REPS(5) { p5_combine(F); if (F.G <= 128) moe_weights(F, F.vcu * NWAVES + F.wave, F.G * NWAVES); } SEAM(5);
    if (IN(6)) REPS(6) {
        pg8::Gemm gm{(const pg8::bf16_t*)(F.ws + WS_OCAT), (const pg8::bf16_t*)(F.ws + WS_WOUT), TT, DMODEL, DMODEL}; pg8::StaticOrder S; S.init(TT, DMODEL, F.G, (int)blockIdx.x);
        EpiResid E{F.in[0], (float*)(F.ws + WS_X1)};
        pg8::gemm_phase<EpiResid, pg8::StaticOrder, true, true>(F.lds, gm, S, E);
    } SEAM(6);
    if (IN(7)) { p7_route(F); } SEAM(7);
    if (IN(8)) { p8_gather(F); } SEAM(8);
    if (IN(9)) REPS(9) {
        pg8::Gemm gm{(const pg8::bf16_t*)(F.ws + WS_XBUF), (const pg8::bf16_t*)(F.ws + WS_WGU0), 0, 0, DMODEL}; MoeOrder S{(const unsigned*)(F.ws + WS_CTL), F.G, (int)blockIdx.x, WGU_SPLIT, (int)((WS_WGU1 - WS_WGU0) / (512 * 1024))};
        EpiGU E{(bf16*)(F.ws + WS_HID)};
        pg8::gemm_phase<EpiGU, MoeOrder, true, true>(F.lds, gm, S, E);
    } SEAM(9);
    if (IN(10)) REPS(10) {
        pg8::Gemm gm{(const pg8::bf16_t*)(F.ws + WS_HID), (const pg8::bf16_t*)((unsigned char*)F.out + DO_WD0), 0, 0, FFE}; MoeOrder S{(const unsigned*)(F.ws + WS_CTL), F.G, (int)blockIdx.x, WD_SPLIT, (int)((DO_WD1 - DO_WD0) / (256 * 1024))};
        EpiY E{(bf16*)(F.ws + WS_XBUF)};
        pg8::gemm_phase<EpiY, MoeOrder, true, true>(F.lds, gm, S, E);
    } SEAM(10);
#ifdef EXTRA_SYNCS
    for (int q_ = 0; q_ < EXTRA_SYNCS; ++q_) xcd_barrier(bar);
#endif
    if (IN(11)) { p11_final(F); }
#undef IN
#undef SEAM
}

extern "C" void kernel_launch(void* const* d_in, const int* in_sizes, int n_in, void* d_out, int out_size, void* d_ws, size_t ws_size, hipStream_t stream) {
    static int grid = 0;
    if (grid == 0) {
        if (n_in != 17 || out_size != TT * DMODEL || ws_size < WS_END) { fprintf(stderr, "kernel_launch: unexpected problem (n_in %d out %d ws %zu)\n", n_in, out_size, ws_size); grid = -1; return; }
        int dev = 0, cus = 0, per_cu = 0;
        if (hipGetDevice(&dev) != hipSuccess || hipDeviceGetAttribute(&cus, hipDeviceAttributeMultiprocessorCount, dev) != hipSuccess) { grid = -1; return; }
        if (hipFuncSetAttribute((const void*)fwd_kernel, hipFuncAttributeMaxDynamicSharedMemorySize, LDS_BYTES) != hipSuccess) { fprintf(stderr, "hipFuncSetAttribute failed\n"); grid = -1; return; }
        if (hipOccupancyMaxActiveBlocksPerMultiprocessor(&per_cu, (const void*)fwd_kernel, NTHREADS, LDS_BYTES) != hipSuccess || per_cu < 1) { fprintf(stderr, "occupancy query: %d\n", per_cu); grid = -1; return; }
        grid = cus;
    }
    if (grid < 0) return;
    (void)hipMemsetAsync((char*)d_ws + WS_CTL, 0, CTL_ZERO_BYTES, stream);
    Args a{};
    for (int i = 0; i < 17; ++i) a.in[i] = (const float*)d_in[i];
    a.out = (float*)d_out; a.ws = (unsigned char*)d_ws;
#if MK_PER_PHASE
    for (int p = 0; p < N_PHASES; ++p) { a.ph_lo = p; a.ph_hi = p + 1; hipLaunchKernelGGL(fwd_kernel, dim3(grid), dim3(NTHREADS), LDS_BYTES, stream, a); }
#else
    a.ph_lo = 0; a.ph_hi = N_PHASES;
    void* kargs[] = {&a};
    hipError_t e = hipLaunchCooperativeKernel((void*)fwd_kernel, dim3(grid), dim3(NTHREADS), kargs, LDS_BYTES, stream);
    if (e != hipSuccess) fprintf(stderr, "cooperative launch failed: %s (grid %d)\n", hipGetErrorString(e), grid);
#endif
}
```

```cpp
#include <hip/hip_runtime.h>
#include <cstdio>
#include <cstdint>
namespace pg8 {
#define PG8_LAS __attribute__((address_space(3)))
typedef unsigned short bf16_t;
typedef short bf16x8 __attribute__((ext_vector_type(8)));
typedef float f32x4 __attribute__((ext_vector_type(4)));
typedef unsigned u32x4 __attribute__((ext_vector_type(4)));
constexpr int BM = 256, BK = 64, HALF = 128, HTB = HALF * BK * 2  , STAGE_BYTES = 8 * HTB, NXCD = 8, WGM = 8;

__host__ __device__ __forceinline__ int lds_byte(int r, int c) { const int st = (r >> 4) * 2 + (c >> 5), rr = r & 15, cc = c & 31, ob = rr * 64 + cc * 2; return st * 1024 + (ob ^ (((ob >> 9) & 1) << 5)); }
__host__ __device__ __forceinline__ void stage_rc(int b, int& R, int& C) { const int st = b / 1024, sb = b % 1024, swz = sb ^ (((sb >> 9) & 1) << 5); R = (st >> 1) * 16 + swz / 64; C = (st & 1) * 32 + (swz % 64) / 2; }
__host__ __device__ __forceinline__ int perm32(int rho) { const int n = rho >> 4, i = rho & 15; return 8 * (i >> 2) + 4 * n + (i & 3); }

struct Unit { int pm, pn; };
struct Gemm { const bf16_t* A; const bf16_t* Bt; int M, N, K; };

struct StaticOrder {
    int nM, nN, nwg, G, c;
    __host__ __device__ void init(int M, int N, int G_, int c_) { nM = M / BM; nN = N / BM; nwg = nM * nN; G = G_; c = c_; }
    __host__ __device__ bool next(int i, Unit& u) const {
        const long L = (long)i * G + c; if (L >= nwg) return false;
        int wgid = (int)L; { const int q = nwg / NXCD, r = nwg % NXCD, xcd = wgid % NXCD, off = wgid / NXCD; wgid = (xcd < r ? xcd * (q + 1) : r * (q + 1) + (xcd - r) * q) + off; }
        const int nig = WGM * nN, gid = wgid / nig, fm = gid * WGM, gsz = (nM - fm) < WGM ? (nM - fm) : WGM;
        u.pm = fm + ((wgid % nig) % gsz); u.pn = (wgid % nig) / gsz; return true;
    }
    __device__ __forceinline__ void a_ready(const Unit&) const {}
    __device__ __forceinline__ void done(const Unit&) const {}
};

__device__ __forceinline__ unsigned cvt_pk_bf16(float lo, float hi) { unsigned r; asm volatile("v_cvt_pk_bf16_f32 %0, %1, %2" : "=v"(r) : "v"(lo), "v"(hi)); return r; }
typedef float f32x2 __attribute__((ext_vector_type(2)));
template <class Epi, class Sched, bool ALIGN_EPI = false, bool SP2 = false>
__device__ __forceinline__ void gemm_phase(PG8_LAS unsigned char* lds, const Gemm g, const Sched& S, const Epi& E) {
    const int tid = threadIdx.x, wid = __builtin_amdgcn_readfirstlane(tid >> 6), lane = tid & 63, wr = wid >> 2, wc = wid & 3, fr = lane & 15, fq = lane >> 4;
    const int K = g.K, nt = K / BK;
    unsigned voffA[2], voffB[2];
#pragma unroll
    for (int i = 0; i < 2; ++i) { int R, C; stage_rc(tid * 16 + i * 8192, R, C); const int Rb = Epi::PERM ? ((R & ~31) + perm32(R & 31)) : R;
        voffA[i] = (unsigned)(R * K + C) * 2u; voffB[i] = (unsigned)(Rb * K + C) * 2u; }
    const size_t kstep = (size_t)(BK * 2);
    const size_t hstep = (size_t)HALF * K * 2;
    const size_t tstep = 2 * hstep;
    const unsigned ldsw = (unsigned)wid * 1024u;
    const int aoff = lds_byte(wr * 64 + fr, fq * 8), boff = lds_byte(wc * 32 + fr, fq * 8);
#define PG8_SA(b, h) (((b) * 2 + (h)) * HTB)
#define PG8_SB(b, h) ((4 + (b) * 2 + (h)) * HTB)
#define PG8_STAGE(bufoff, gbase, voff) do { _Pragma("unroll") for (int _i = 0; _i < 2; ++_i) \
        __builtin_amdgcn_global_load_lds((const unsigned*)((const char*)(gbase) + (voff)[_i]), (PG8_LAS unsigned*)(lds + (bufoff) + ldsw + _i * 8192), 16, 0, 0); } while (0)
#define PG8_LDA(dst, b, h) do { _Pragma("unroll") for (int m = 0; m < 4; ++m) _Pragma("unroll") for (int k = 0; k < 2; ++k) dst[m][k] = *(const PG8_LAS bf16x8*)(lds + PG8_SA(b, h) + aoff + m * 2048 + k * 1024); } while (0)
#define PG8_LDB(dst, b, h) do { _Pragma("unroll") for (int n = 0; n < 2; ++n) _Pragma("unroll") for (int k = 0; k < 2; ++k) dst[n][k] = *(const PG8_LAS bf16x8*)(lds + PG8_SB(b, h) + boff + n * 2048 + k * 1024); } while (0)
#define PG8_MMA(ai, bj, At, Bt) do { __builtin_amdgcn_s_setprio(1); _Pragma("unroll") for (int m = 0; m < 4; ++m) _Pragma("unroll") for (int n = 0; n < 2; ++n) _Pragma("unroll") for (int k = 0; k < 2; ++k) \
        acc[ai][bj][m][n] = __builtin_amdgcn_mfma_f32_16x16x32_bf16(Bt[n][k], At[m][k], acc[ai][bj][m][n], 0, 0, 0); __builtin_amdgcn_s_setprio(0); } while (0)
#define PG8_WAIT_V(n) asm volatile("s_waitcnt vmcnt(" #n ")" ::: "memory")
#define PG8_WAIT_L(n) asm volatile("s_waitcnt lgkmcnt(" #n ")" ::: "memory")
#define PG8_BAR __builtin_amdgcn_s_barrier()
#define PG8_SCHED __builtin_amdgcn_sched_barrier(0)
    Unit cur, nxt; int ui = 0;
    if (!S.next(0, cur)) return;
    f32x4 acc[2][2][4][2];
#pragma unroll
    for (int a = 0; a < 2; ++a)
#pragma unroll
        for (int b = 0; b < 2; ++b)
#pragma unroll
            for (int m = 0; m < 4; ++m)
#pragma unroll
                for (int n = 0; n < 2; ++n) acc[a][b][m][n] = (f32x4){0.f, 0.f, 0.f, 0.f};
    bf16x8 At[4][2], B0[2][2], B1[2][2];
    const char* cA = (const char*)g.A + (size_t)cur.pm * tstep; const char* cB = (const char*)g.Bt + (size_t)cur.pn * tstep;
    S.a_ready(cur);
    if constexpr (SP2) {
        PG8_STAGE(PG8_SB(0, 0), cB, voffB); PG8_STAGE(PG8_SB(0, 1), cB + hstep, voffB); PG8_STAGE(PG8_SA(0, 0), cA, voffA); PG8_STAGE(PG8_SA(0, 1), cA + hstep, voffA);
        if (wr == 1) PG8_BAR;
        PG8_WAIT_V(2); PG8_BAR;
        PG8_STAGE(PG8_SB(1, 0), cB + kstep, voffB); PG8_STAGE(PG8_SA(1, 0), cA + kstep, voffA); PG8_STAGE(PG8_SB(1, 1), cB + hstep + kstep, voffB);
        PG8_WAIT_V(6); PG8_BAR;
    } else {
        PG8_STAGE(PG8_SB(0, 0), cB, voffB); PG8_STAGE(PG8_SA(0, 0), cA, voffA); PG8_STAGE(PG8_SB(0, 1), cB + hstep, voffB); PG8_STAGE(PG8_SA(0, 1), cA + hstep, voffA);
        if (wr == 1) PG8_BAR;
        PG8_WAIT_V(4); PG8_BAR;
        PG8_STAGE(PG8_SB(1, 0), cB + kstep, voffB); PG8_STAGE(PG8_SA(1, 0), cA + kstep, voffA); PG8_STAGE(PG8_SB(1, 1), cB + hstep + kstep, voffB);
        PG8_WAIT_V(6); PG8_BAR;
    }
    for (;;) {
        const bool has_next = S.next(ui + 1, nxt);
        const char* nA = has_next ? (const char*)g.A + (size_t)nxt.pm * tstep : cA; const char* nB = has_next ? (const char*)g.Bt + (size_t)nxt.pn * tstep : cB;
        for (int t = 0; t < nt; t += 2) {
            const bool last = (t == nt - 2);
            const char* a1 = cA + (size_t)(t + 1) * kstep;
            const char* a2 = last ? nA : cA + (size_t)(t + 2) * kstep; const char* b2 = last ? nB : cB + (size_t)(t + 2) * kstep;
            const char* a3 = a2 + kstep; const char* b3 = b2 + kstep;
            if (last && has_next) S.a_ready(nxt);
            if constexpr (SP2) {
            PG8_LDB(B0, 0, 0); PG8_LDB(B1, 0, 1); PG8_SCHED; PG8_LDA(At, 0, 0); PG8_STAGE(PG8_SA(1, 1), a1 + hstep, voffA);
            PG8_WAIT_V(8); PG8_WAIT_L(0); PG8_BAR; PG8_MMA(0, 0, At, B0); PG8_MMA(0, 1, At, B1); PG8_BAR; PG8_SCHED;
            PG8_LDA(At, 0, 1); PG8_STAGE(PG8_SB(0, 0), b2, voffB); PG8_STAGE(PG8_SB(0, 1), b2 + hstep, voffB); PG8_STAGE(PG8_SA(0, 0), a2, voffA);
            PG8_WAIT_V(8); PG8_WAIT_L(0); PG8_BAR; PG8_MMA(1, 0, At, B0); PG8_MMA(1, 1, At, B1); PG8_BAR; PG8_SCHED;
            PG8_LDB(B0, 1, 0); PG8_LDB(B1, 1, 1); PG8_SCHED; PG8_LDA(At, 1, 0); PG8_STAGE(PG8_SA(0, 1), a2 + hstep, voffA);
            PG8_WAIT_V(8); PG8_WAIT_L(0); PG8_BAR; PG8_MMA(0, 0, At, B0); PG8_MMA(0, 1, At, B1); PG8_BAR; PG8_SCHED;
            PG8_LDA(At, 1, 1); PG8_STAGE(PG8_SB(1, 0), b3, voffB); PG8_STAGE(PG8_SB(1, 1), b3 + hstep, voffB); PG8_STAGE(PG8_SA(1, 0), a3, voffA);
            PG8_WAIT_V(8); PG8_WAIT_L(0); PG8_BAR; PG8_MMA(1, 0, At, B0); PG8_MMA(1, 1, At, B1); PG8_BAR; PG8_SCHED;
            } else {
            PG8_LDB(B0, 0, 0); PG8_SCHED; PG8_LDA(At, 0, 0); PG8_STAGE(PG8_SA(1, 1), a1 + hstep, voffA);
            PG8_WAIT_L(8); PG8_BAR; PG8_WAIT_L(0); PG8_MMA(0, 0, At, B0); PG8_BAR; PG8_SCHED;
            PG8_LDB(B1, 0, 1); PG8_STAGE(PG8_SB(0, 0), b2, voffB);
            PG8_BAR; PG8_WAIT_L(0); PG8_MMA(0, 1, At, B1); PG8_BAR;
            PG8_LDA(At, 0, 1); PG8_STAGE(PG8_SA(0, 0), a2, voffA);
            PG8_BAR; PG8_WAIT_L(0); PG8_MMA(1, 0, At, B0); PG8_BAR; PG8_SCHED;
            PG8_STAGE(PG8_SB(0, 1), b2 + hstep, voffB);
            PG8_WAIT_V(6); PG8_BAR; PG8_MMA(1, 1, At, B1); PG8_BAR;
            PG8_LDB(B0, 1, 0); PG8_SCHED; PG8_LDA(At, 1, 0); PG8_STAGE(PG8_SA(0, 1), a2 + hstep, voffA);
            PG8_WAIT_L(8); PG8_BAR; PG8_WAIT_L(0); PG8_MMA(0, 0, At, B0); PG8_BAR; PG8_SCHED;
            PG8_LDB(B1, 1, 1); PG8_STAGE(PG8_SB(1, 0), b3, voffB);
            PG8_BAR; PG8_WAIT_L(0); PG8_MMA(0, 1, At, B1); PG8_BAR;
            PG8_LDA(At, 1, 1); PG8_STAGE(PG8_SA(1, 0), a3, voffA);
            PG8_BAR; PG8_WAIT_L(0); PG8_MMA(1, 0, At, B0); PG8_BAR; PG8_SCHED;
            PG8_STAGE(PG8_SB(1, 1), b3 + hstep, voffB);
            PG8_WAIT_V(6); PG8_BAR; PG8_MMA(1, 1, At, B1); PG8_BAR;
            }
        }
        if constexpr (ALIGN_EPI) { if (wr == 0) PG8_BAR; }
        if constexpr (!Epi::AFTER_DRAIN) { E(acc, cur, wr, wc, fr, fq); S.done(cur); }
        if (!has_next) break;
#pragma unroll
        for (int a = 0; a < 2; ++a)
#pragma unroll
            for (int b = 0; b < 2; ++b)
#pragma unroll
                for (int m = 0; m < 4; ++m)
#pragma unroll
                    for (int n = 0; n < 2; ++n) acc[a][b][m][n] = (f32x4){0.f, 0.f, 0.f, 0.f};
        cur = nxt; cA = nA; cB = nB; ++ui;
        if constexpr (ALIGN_EPI) { if (wr == 1) PG8_BAR; }
    }
    PG8_WAIT_V(0);
    if constexpr (!ALIGN_EPI) { if (wr == 0) PG8_BAR; }
    PG8_BAR;
    if constexpr (Epi::AFTER_DRAIN) { E.fused(acc, cur, wr, wc, fr, fq, lds, wid, lane); S.done(cur); }
#undef PG8_SA
#undef PG8_SB
#undef PG8_STAGE
#undef PG8_LDA
#undef PG8_LDB
#undef PG8_MMA
#undef PG8_WAIT_V
#undef PG8_WAIT_L
#undef PG8_BAR
#undef PG8_SCHED
}
}
#include <hip/hip_bf16.h>
#include <cmath>
namespace attn_body {
using bf16=__hip_bfloat16;
using bf16x8=__attribute__((ext_vector_type(8)))short;
using s16x4=__attribute__((ext_vector_type(4)))short;
using f32x16=__attribute__((ext_vector_type(16)))float;
using u32x4=__attribute__((ext_vector_type(4)))unsigned;
constexpr int BATCH=2,NHEAD=8,NKVH=2,SEQ=8192,D=64,QP=512,KP=128,OP=1024;
constexpr int NW=8,QBLK=32,QB=QBLK*NW,KVBLK=64,NQB=SEQ/QB;
constexpr int ATTN_UNIT_ROWS=QB;
__device__ __forceinline__ int crow(int r,int hi){return (r&3)+8*(r>>2)+4*hi;}
#define SBAR() __builtin_amdgcn_sched_barrier(0)
__device__ __forceinline__ void cmask(f32x16&p0,f32x16&p1,int jb,int qrel,int hi){
  const float NEG=-INFINITY; int kb=64*jb+4*hi;
  #pragma unroll
  for(int r=0;r<16;++r){int kv=kb+(r&3)+8*(r>>2); if(kv>qrel)p0[r]=NEG; if(kv+32>qrel)p1[r]=NEG;}
}

constexpr int NSLOT=3, SLOTB=8192;
constexpr int LDS_K=0, LDS_V=NSLOT*SLOTB, LDS_WS=2*NSLOT*SLOTB, LDS_OST=LDS_WS+NW*64*4, LDS_BYTES=LDS_OST+NW*4096;
constexpr float C2=0.125f*1.4426950408889634f;
__device__ __forceinline__ void glds16(const void*gsrc,unsigned lds_dst){unsigned keep;
  asm volatile("s_mov_b32 %0, m0\n\ts_mov_b32 m0, %2\n\ts_nop 0\n\tglobal_load_lds_dwordx4 %1, off\n\ts_mov_b32 m0, %0":"=&s"(keep):"v"(gsrc),"s"(lds_dst):"memory");}
__device__ __forceinline__ float max3f(float a,float b,float c){float r;asm("v_max3_f32 %0, %1, %2, %3":"=v"(r):"v"(a),"v"(b),"v"(c));return r;}
__device__ __forceinline__ float max2f(float a,float b){float r;asm("v_max_f32_e32 %0, %1, %2":"=v"(r):"v"(a),"v"(b));return r;}
__device__ __forceinline__ float fadd_s(float a,float b){float r;asm("v_add_f32_e32 %0, %1, %2":"=v"(r):"v"(a),"v"(b));return r;}
__device__ __forceinline__ float fsub_s(float a,float b){float r;asm("v_sub_f32_e32 %0, %1, %2":"=v"(r):"v"(a),"v"(b));return r;}
typedef float f32x2_t __attribute__((ext_vector_type(2))); typedef __bf16 bf16x2_t __attribute__((ext_vector_type(2)));
__device__ __forceinline__ unsigned cvtpk_s(float lo,float hi){f32x2_t v={lo,hi};bf16x2_t b=__builtin_convertvector(v,bf16x2_t);return __builtin_bit_cast(unsigned,b);}
#define WAIT_BAR(N) asm volatile("s_waitcnt vmcnt(" #N ") lgkmcnt(0)\n\ts_barrier":::"memory")

__device__ __forceinline__ void qkt(f32x16&p0,f32x16&p1,const char*Kslot,const bf16x8*qr,const f32x16&negm,int r32,int hi){
  const char*kb=Kslot+hi*1024+r32*16;
  #pragma unroll
  for(int d0=0;d0<4;++d0){
    const bf16x8 b0=*reinterpret_cast<const bf16x8*>(kb+d0*2048);
    const bf16x8 b1=*reinterpret_cast<const bf16x8*>(kb+d0*2048+512);
    if(d0==0){p0=__builtin_amdgcn_mfma_f32_32x32x16_bf16(b0,qr[0],negm,0,0,0);p1=__builtin_amdgcn_mfma_f32_32x32x16_bf16(b1,qr[0],negm,0,0,0);}
    else{p0=__builtin_amdgcn_mfma_f32_32x32x16_bf16(b0,qr[d0],p0,0,0,0);p1=__builtin_amdgcn_mfma_f32_32x32x16_bf16(b1,qr[d0],p1,0,0,0);}}
}
typedef __attribute__((address_space(3))) const char* lds_cptr;
typedef short v4i16_t __attribute__((ext_vector_type(4)));
__device__ __forceinline__ void kload8(bf16x8*kf,lds_cptr kp){
  kf[0]=*(const __attribute__((address_space(3))) bf16x8*)(kp);      kf[1]=*(const __attribute__((address_space(3))) bf16x8*)(kp+512);
  kf[2]=*(const __attribute__((address_space(3))) bf16x8*)(kp+2048); kf[3]=*(const __attribute__((address_space(3))) bf16x8*)(kp+2560);
  kf[4]=*(const __attribute__((address_space(3))) bf16x8*)(kp+4096); kf[5]=*(const __attribute__((address_space(3))) bf16x8*)(kp+4608);
  kf[6]=*(const __attribute__((address_space(3))) bf16x8*)(kp+6144); kf[7]=*(const __attribute__((address_space(3))) bf16x8*)(kp+6656);
}
__device__ __forceinline__ void kload2(bf16x8*kf,lds_cptr kp,int j){ kf[2*j]=*(const __attribute__((address_space(3))) bf16x8*)(kp+j*2048); kf[2*j+1]=*(const __attribute__((address_space(3))) bf16x8*)(kp+j*2048+512); }
__device__ __forceinline__ s16x4 vtr(lds_cptr p){ return __builtin_bit_cast(s16x4,__builtin_amdgcn_ds_read_tr16_b64_v4i16((__attribute__((address_space(3))) v4i16_t*)p)); }
__device__ __forceinline__ float rowmax(const f32x16&p0,const f32x16&p1){
  float a=max3f(p0[0],p0[1],p1[0]),b=max3f(p0[2],p0[3],p1[1]);a=max3f(a,p1[2],p1[3]);
  #pragma unroll
  for(int r=4;r<16;r+=4){a=max3f(a,p0[r],p0[r+1]);b=max3f(b,p0[r+2],p0[r+3]);a=max3f(a,p1[r],p1[r+1]);b=max3f(b,p1[r+2],p1[r+3]);}
  const float m=max2f(a,b);
  auto rr=__builtin_amdgcn_permlane32_swap(__float_as_uint(m),__float_as_uint(m),false,false);
  return max2f(__uint_as_float(rr[0]),__uint_as_float(rr[1]));
}
__device__ __forceinline__ void pv(f32x16*o,int vb,bf16x8 pa0,bf16x8 pa1,bf16x8 pa2,bf16x8 pa3){
  #pragma unroll
  for(int d0=0;d0<2;++d0){s16x4 lo[4],hi[4];
    #pragma unroll
    for(int ks=0;ks<4;++ks){
      asm volatile("ds_read_b64_tr_b16 %0,%1 offset:%c2":"=&v"(lo[ks]):"v"(vb),"i"(d0*4096+ks*1024):"memory");
      asm volatile("ds_read_b64_tr_b16 %0,%1 offset:%c2":"=&v"(hi[ks]):"v"(vb),"i"(d0*4096+ks*1024+512):"memory");}
    asm volatile("s_waitcnt lgkmcnt(0)":::"memory");SBAR();
    #define PK(k) (bf16x8){lo[k][0],lo[k][1],lo[k][2],lo[k][3],hi[k][0],hi[k][1],hi[k][2],hi[k][3]}
    o[d0]=__builtin_amdgcn_mfma_f32_32x32x16_bf16(pa0,PK(0),o[d0],0,0,0);
    o[d0]=__builtin_amdgcn_mfma_f32_32x32x16_bf16(pa1,PK(1),o[d0],0,0,0);
    o[d0]=__builtin_amdgcn_mfma_f32_32x32x16_bf16(pa2,PK(2),o[d0],0,0,0);
    o[d0]=__builtin_amdgcn_mfma_f32_32x32x16_bf16(pa3,PK(3),o[d0],0,0,0);
    #undef PK
  }
}

#ifndef ATTN_STORE16
#define ATTN_STORE16(p,v) (*(u32x4*)(p)=(v))
#endif
template<int THRL> __device__ __forceinline__ void attn_unit(int b,int h,int qb,const bf16*Q,const bf16*__restrict__ K,const bf16*__restrict__ V,bf16*O,char*shm){
  const int tid=threadIdx.x,lane=tid&63,r32=lane&31,hi=lane>>5; const int wid=__builtin_amdgcn_readfirstlane(tid>>6);
  const long rowbase=(long)b*SEQ; const int q0=qb*QB;
  const bf16*Qw=Q+(rowbase+q0+wid*QBLK)*QP+h*D;
  const int hk=h/(NHEAD/NKVH); const bf16*Kh=K+rowbase*KP+hk*D,*Vh=V+rowbase*KP+hk*D;
  const unsigned lds0=(unsigned)(uintptr_t)shm;
  float*wsf=(float*)(shm+LDS_WS)+wid*64;
  const bf16*ksrc=Kh+(long)lane*KP+wid*8;
  const bf16*vsrc=Vh+(long)(16*(wid&3)+(lane>>2))*KP+(wid>>2)*32+(lane&3)*8;
  const unsigned kdst=lds0+LDS_K+wid*1024, vdst=lds0+LDS_V+wid*1024;
  #define DMA_K(t,slot) glds16(ksrc+(long)(t)*KVBLK*KP,(unsigned)__builtin_amdgcn_readfirstlane(kdst+(slot)))
  #define DMA_V(t,slot) glds16(vsrc+(long)(t)*KVBLK*KP,(unsigned)__builtin_amdgcn_readfirstlane(vdst+(slot)))
  const int vb0=(int)(lds0+LDS_V)+((lane>>4)&1)*32+(lane&3)*8+(4*hi+((lane&15)>>2))*64;
  const char*Kbase=shm+LDS_K; bf16x8 kf[8];
  const lds_cptr shm3=(lds_cptr)shm; const lds_cptr kp0=shm3+LDS_K+hi*1024+r32*16; const lds_cptr vp0=shm3+LDS_V+((lane>>4)&1)*32+(lane&3)*8+(4*hi+((lane&15)>>2))*64;
  constexpr int NT=SEQ/KVBLK;
  DMA_K(0,0);DMA_V(0,0);DMA_K(1,SLOTB);
  bf16x8 qr[4];
  #pragma unroll
  for(int d0=0;d0<4;++d0)qr[d0]=*reinterpret_cast<const bf16x8*>(&Qw[(long)r32*QP+d0*16+hi*8]);
  float mhat=0.f,l_reg=0.f;f32x16 o[2];o[0]=f32x16{};o[1]=f32x16{};f32x16 negm=f32x16{};asm volatile("":"+v"(negm));
  const int qrel=wid*QBLK+r32;
  #define CMASK(P0,P1,t) do{}while(0)
  bool resc=false;
  #define START(P0,P1) do{ const float rm=rowmax(P0,P1); resc=false; \
    { const float dl=rm; mhat=fadd_s(mhat,dl); \
      _Pragma("unroll") for(int r=0;r<16;++r){P0[r]=fsub_s(P0[r],dl);P1[r]=fsub_s(P1[r],dl);} \
      _Pragma("unroll") for(int r=0;r<16;++r)negm[r]=-mhat; asm volatile("":"+v"(negm)); } \
    _Pragma("unroll") for(int r=0;r<16;++r)P0[r]=__builtin_amdgcn_exp2f(P0[r]); }while(0)
  #define RESC() do{ if(resc){ asm volatile("s_waitcnt lgkmcnt(0)":::"memory"); \
      _Pragma("unroll") for(int d_=0;d_<2;++d_) _Pragma("unroll") for(int r=0;r<16;++r)o[d_][r]*=wsf[crow(r,hi)]; } }while(0)
  f32x16 pA0,pA1,pB0,pB1;
  int sl_prev=0,sl_cur=0,sl_next=SLOTB;
  #define ROT() do{sl_prev=sl_cur;sl_cur=sl_next;sl_next=(sl_next==(NSLOT-1)*SLOTB)?0:sl_next+SLOTB;}while(0)
  DMA_K(2,2*SLOTB);
  WAIT_BAR(3);
  qkt(pA0,pA1,Kbase,qr,negm,r32,hi);asm volatile("s_nop 15\n\ts_nop 7":"+v"(pA0),"+v"(pA1));CMASK(pA0,pA1,0);
  START(pA0,pA1);
  _Pragma("unroll") for(int r=0;r<16;++r)pA1[r]=__builtin_amdgcn_exp2f(pA1[r]);
  WAIT_BAR(0);
  DMA_K(3,0);DMA_V(1,SLOTB);
  ROT();
  kload8(kf,kp0+sl_cur);
  WAIT_BAR(2);
  s16x4 vlo[8],vhi[8]; u32x4 pw0,pw1,pw2,pw3;
  #define PKW(P,B) cvtpk_s(P[B],P[B+1])
  #define PAF(k) __builtin_bit_cast(bf16x8,pw##k)
  #define VFR(i) (bf16x8){vlo[i][0],vlo[i][1],vlo[i][2],vlo[i][3],vhi[i][0],vhi[i][1],vhi[i][2],vhi[i][3]}
  #define PIN(x) asm volatile("":"+v"(x))
  #define MX3(a,b,c) __builtin_fmaxf(__builtin_fmaxf((a),(b)),(c))
  #define GAPA(MF,A0,A1,A2,A3,W0,W1,PW) do{ MF; sacc+=A0; sacc+=A1; sacc+=A2; sacc+=A3; PIN(sacc); W0; W1; PIN(PW); SBAR(); }while(0)
  #define EX(v) __builtin_amdgcn_exp2f(v)
  #define GAPB(MF,X,B) do{ MF; X[B]=EX(X[B]); X[B+1]=EX(X[B+1]); X[B+2]=EX(X[B+2]); X[B+3]=EX(X[B+3]); PIN(X); SBAR(); }while(0)
  #define VRD(i) do{ vlo[i]=vtr(vp_+(((i)>>2)*4096+((i)&3)*1024)); vhi[i]=vtr(vp_+(((i)>>2)*4096+((i)&3)*1024+512)); }while(0)
  #define KRD(G,j) do{ if(G){ kload2(kf,kp0+sl_next,j); SBAR(); } }while(0)
  #define STEP(C0,C1,P0,P1,t,GK,GV,GL) do{ SBAR(); \
    const lds_cptr vp_=vp0+sl_prev; \
    VRD(0); SBAR(); float sacc=(P0[0]+P0[1]); \
    GAPA(C0=__builtin_amdgcn_mfma_f32_32x32x16_bf16(kf[0],qr[0],negm,0,0,0), P0[2],P0[3],P0[4],P0[5],     pw0[0]=PKW(P0,0), pw0[1]=PKW(P0,2), pw0); \
    VRD(4); SBAR(); GAPA(C1=__builtin_amdgcn_mfma_f32_32x32x16_bf16(kf[1],qr[0],negm,0,0,0), P0[6],P0[7],P0[8],P0[9],     pw0[2]=PKW(P0,4), pw0[3]=PKW(P0,6), pw0); \
    VRD(1); SBAR(); GAPA(C0=__builtin_amdgcn_mfma_f32_32x32x16_bf16(kf[2],qr[1],C0,0,0,0),   P0[10],P0[11],P0[12],P0[13], pw1[0]=PKW(P0,8), pw1[1]=PKW(P0,10), pw1); \
    VRD(5); SBAR(); GAPA(C1=__builtin_amdgcn_mfma_f32_32x32x16_bf16(kf[3],qr[1],C1,0,0,0),   P0[14],P0[15],P1[0],P1[1],   pw1[2]=PKW(P0,12),pw1[3]=PKW(P0,14), pw1); \
    VRD(2); SBAR(); GAPA(C0=__builtin_amdgcn_mfma_f32_32x32x16_bf16(kf[4],qr[2],C0,0,0,0),   P1[2],P1[3],P1[4],P1[5],     pw2[0]=PKW(P1,0), pw2[1]=PKW(P1,2), pw2); \
    VRD(6); SBAR(); GAPA(C1=__builtin_amdgcn_mfma_f32_32x32x16_bf16(kf[5],qr[2],C1,0,0,0),   P1[6],P1[7],P1[8],P1[9],     pw2[2]=PKW(P1,4), pw2[3]=PKW(P1,6), pw2); \
    VRD(3); SBAR(); GAPA(C0=__builtin_amdgcn_mfma_f32_32x32x16_bf16(kf[6],qr[3],C0,0,0,0),   P1[10],P1[11],P1[12],P1[13], pw3[0]=PKW(P1,8), pw3[1]=PKW(P1,10), pw3); \
    VRD(7); SBAR(); GAPA(C1=__builtin_amdgcn_mfma_f32_32x32x16_bf16(kf[7],qr[3],C1,0,0,0),   P1[14],P1[15],0.f,0.f,       pw3[2]=PKW(P1,12),pw3[3]=PKW(P1,14), pw3); \
    l_reg+=sacc; \
    if(GK){DMA_K((t)+3,sl_cur);} if(GV){DMA_V((t)+1,sl_next);} \
    CMASK(C0,C1,t); \
    { float a=MX3(C0[0],C0[1],C1[0]),b=MX3(C0[2],C0[3],C1[1]); a=MX3(a,C1[2],C1[3]); \
      _Pragma("unroll") for(int r=4;r<16;r+=4){a=MX3(a,C0[r],C0[r+1]);b=MX3(b,C0[r+2],C0[r+3]);a=MX3(a,C1[r],C1[r+1]);b=MX3(b,C1[r+2],C1[r+3]);} \
      float rm=__builtin_fmaxf(a,b); { auto rr=__builtin_amdgcn_permlane32_swap(__float_as_uint(rm),__float_as_uint(rm),false,false); rm=__builtin_fmaxf(__uint_as_float(rr[0]),__uint_as_float(rr[1])); } \
      resc=false; \
      if(__builtin_expect(__any(rm>(float)THRL),0)){ const float dl=__builtin_fmaxf(rm,0.f); mhat+=dl; \
        _Pragma("unroll") for(int r=0;r<16;++r){C0[r]-=dl;C1[r]-=dl;} \
        _Pragma("unroll") for(int r=0;r<16;++r)negm[r]=-mhat; asm volatile("":"+v"(negm)); \
        const float f=__builtin_amdgcn_exp2f(-dl); l_reg*=f; if(hi==0)wsf[r32]=f; resc=true; } } \
    SBAR(); \
    GAPB(o[0]=__builtin_amdgcn_mfma_f32_32x32x16_bf16(PAF(0),VFR(0),o[0],0,0,0), C0,0); \
    GAPB(o[1]=__builtin_amdgcn_mfma_f32_32x32x16_bf16(PAF(0),VFR(4),o[1],0,0,0), C0,4); \
    KRD(GL,0); GAPB(o[0]=__builtin_amdgcn_mfma_f32_32x32x16_bf16(PAF(1),VFR(1),o[0],0,0,0), C0,8); \
    KRD(GL,1); GAPB(o[1]=__builtin_amdgcn_mfma_f32_32x32x16_bf16(PAF(1),VFR(5),o[1],0,0,0), C0,12); \
    KRD(GL,2); GAPB(o[0]=__builtin_amdgcn_mfma_f32_32x32x16_bf16(PAF(2),VFR(2),o[0],0,0,0), C1,0); \
    KRD(GL,3); GAPB(o[1]=__builtin_amdgcn_mfma_f32_32x32x16_bf16(PAF(2),VFR(6),o[1],0,0,0), C1,4); \
    GAPB(o[0]=__builtin_amdgcn_mfma_f32_32x32x16_bf16(PAF(3),VFR(3),o[0],0,0,0), C1,8); \
    GAPB(o[1]=__builtin_amdgcn_mfma_f32_32x32x16_bf16(PAF(3),VFR(7),o[1],0,0,0), C1,12); \
    }while(0)
  int t=1;
  #undef CMASK
  #define CMASK(P0,P1,t) do{}while(0)
  for(;t+5<NT;t+=2){
    STEP(pB0,pB1,pA0,pA1,t,true,true,true);     WAIT_BAR(2); RESC(); ROT();
    STEP(pA0,pA1,pB0,pB1,t+1,true,true,true);   WAIT_BAR(2); RESC(); ROT();
  }
  #undef CMASK
  #define CMASK(P0,P1,t) do{}while(0)
  #define ENDW(tt) do{ if((tt)+3<NT){WAIT_BAR(2);} else if((tt)+2<NT){WAIT_BAR(1);} else {WAIT_BAR(0);} }while(0)
  for(;t+1<NT;t+=2){
    STEP(pB0,pB1,pA0,pA1,t,(t+3<NT),(t+1<NT),(t+1<NT));       ENDW(t);   RESC(); ROT();
    STEP(pA0,pA1,pB0,pB1,t+1,(t+4<NT),(t+2<NT),(t+2<NT));     ENDW(t+1); RESC(); ROT();
  }
  STEP(pB0,pB1,pA0,pA1,NT-1,false,false,false); RESC();
  { float sacc=pB0[0]+pB0[1]; _Pragma("unroll") for(int r=2;r<16;++r)sacc+=pB0[r]; _Pragma("unroll") for(int r=0;r<16;++r)sacc+=pB1[r]; l_reg+=sacc;
    pw0=(u32x4){PKW(pB0,0),PKW(pB0,2),PKW(pB0,4),PKW(pB0,6)};pw1=(u32x4){PKW(pB0,8),PKW(pB0,10),PKW(pB0,12),PKW(pB0,14)};pw2=(u32x4){PKW(pB1,0),PKW(pB1,2),PKW(pB1,4),PKW(pB1,6)};pw3=(u32x4){PKW(pB1,8),PKW(pB1,10),PKW(pB1,12),PKW(pB1,14)};
    SBAR(); pv(o,vb0+sl_cur,PAF(0),PAF(1),PAF(2),PAF(3)); }
  #undef PKW
  #undef PAF
  #undef VFR
  #undef PIN
  #undef MX3
  #undef GAPA
  #undef GAPB
  #undef EX
  #undef VRD
  #undef KRD
  #undef STEP
  #undef ENDW
  {auto rr=__builtin_amdgcn_permlane32_swap(__float_as_uint(l_reg),__float_as_uint(l_reg),false,false);l_reg=__uint_as_float(rr[0])+__uint_as_float(rr[1]);}
  if(hi==0)wsf[32+r32]=l_reg;asm volatile("s_waitcnt lgkmcnt(0)":::"memory");
  float rli[16];
  #pragma unroll
  for(int r=0;r<16;++r)rli[r]=__builtin_amdgcn_rcpf(wsf[32+crow(r,hi)]);
  bf16*Ow=O+(rowbase+q0+wid*QBLK)*OP+h*D;
  { bf16*stg=(bf16*)(shm+LDS_OST)+wid*2048;
    #pragma unroll
    for(int r=0;r<16;++r){const int orow=crow(r,hi);
      #pragma unroll
      for(int d0=0;d0<2;++d0)stg[orow*64+d0*32+r32]=__float2bfloat16(o[d0][r]*rli[r]);}
    asm volatile("s_waitcnt lgkmcnt(0)":::"memory");
    #pragma unroll
    for(int i=0;i<4;++i){const int row=i*8+(lane>>3),ch=lane&7; const u32x4 v=*(const u32x4*)(stg+row*64+ch*8); ATTN_STORE16(Ow+(long)row*OP+ch*8,v);} }
  asm volatile("s_waitcnt lgkmcnt(0)\n\ts_barrier":::"memory");
  #undef DMA_K
  #undef DMA_V
  #undef CMASK
  #undef START
  #undef RESC
  #undef ROT
}
constexpr int ATTN_LDS_BYTES=LDS_BYTES;
struct AttnTensors { const bf16* Q; const bf16* K; const bf16* V; bf16* O; };
struct AttnUnit { int bh; int qb; };
struct StaticOrder {
  int vcu, G;
  __device__ __forceinline__ explicit StaticOrder(int grid,int block):vcu((grid%8==0)?(block%8)*(grid/8)+block/8:block),G(grid){}
  __device__ __forceinline__ bool next(int i,AttnUnit&u)const{
    const int L=i*G+vcu; if(L>=BATCH*NHEAD*NQB)return false;
    if(G==256){ if(i>=2)return false; const int x=vcu>>5,j=vcu&31; const int b=x>>2,kvh=(x>>1)&1,hq=kvh*4+2*(x&1)+i; u.bh=b*NHEAD+hq; u.qb=j; return true; }
    u.bh=L/NQB; u.qb=L%NQB; return true; }
  __device__ __forceinline__ void a_ready(const AttnUnit&)const{}
  __device__ __forceinline__ void done(const AttnUnit&)const{}
};
template<class Sched,int THRL=8> __device__ __forceinline__ void attn_phase(char*lds,const AttnTensors&T,const Sched&S){
  AttnUnit u;
  for(int i=0;S.next(i,u);++i){ S.a_ready(u); attn_unit<THRL>(u.bh/NHEAD,u.bh%NHEAD,u.qb,T.Q,T.K,T.V,T.O,lds); S.done(u); }
}
#undef SBAR
#undef WAIT_BAR
}

#include <hip/hip_cooperative_groups.h>
namespace cg = cooperative_groups;
#ifndef MK_PER_PHASE
#define MK_PER_PHASE 0
#endif
constexpr int NWAVES = 8, NTHREADS = 512;
constexpr int NB = 2, SEQ = 8192, DMODEL = 1024, TT = NB * SEQ;
constexpr int NPROJ = 3072;
constexpr int NEXP = 32, FFE = 512;
constexpr float EPS = 1e-6f;
constexpr int N_PHASES = 12;

constexpr size_t MiB = 1u << 20;
constexpr size_t WS_CTL = 0, CTL_ZERO_BYTES = 64 * 1024;
constexpr size_t WS_WOUT = 1 * MiB;
constexpr size_t WS_WR = 3 * MiB;
constexpr size_t WS_TOK = 3 * MiB + 256 * 1024;
constexpr size_t WS_GATES = 4 * MiB;
constexpr size_t WS_WIN = 5 * MiB;
constexpr size_t WS_A = 11 * MiB;
constexpr size_t WS_XN = WS_A;
constexpr size_t GDN_SH_BYTES = 71680, GDN_D_BYTES = 19456;
constexpr size_t WS_GSH = WS_A;
constexpr size_t WS_GD = WS_A + 1024 * GDN_SH_BYTES;
constexpr size_t WS_X1 = 5 * MiB;
constexpr size_t WS_HID = 69 * MiB;
constexpr size_t WS_XBUF = 109 * MiB;
constexpr size_t WS_B = 157 * MiB;
constexpr size_t WS_QKVA = WS_B;
constexpr size_t WS_QKVB = WS_B + 48 * MiB;
constexpr size_t WS_ZA = WS_B + 72 * MiB;
constexpr size_t WS_OCAT = WS_B;
constexpr size_t WS_WGU0 = 189 * MiB, WS_WGU1 = 245 * MiB; constexpr int WGU_SPLIT = 20;
constexpr size_t DO_WD0 = 0, DO_WD1 = 56 * MiB; constexpr int WD_SPLIT = 24;
constexpr size_t DO_HN = 24 * MiB;
constexpr size_t WS_END = 269 * MiB;
static_assert(WS_GD + 4096 * GDN_D_BYTES <= WS_B, "GDN records fit region A");
static_assert(WS_X1 + 64 * MiB <= WS_HID && WS_HID + 40928ull * 1024 <= WS_XBUF && WS_XBUF + 40928ull * 2048 <= WS_WGU0, "post-scan map");
static_assert(WS_WGU0 + WGU_SPLIT * 2 * MiB <= WS_B + 72 * MiB && WS_WGU1 + (32 - WGU_SPLIT) * 2 * MiB <= 269 * MiB, "WGU fragments");
constexpr size_t DO_QR = 0, DO_KR = 16 * MiB, DO_VR = 20 * MiB, DO_OF = 24 * MiB, DO_OB = 40 * MiB;
constexpr int CW_CNT = 64;
constexpr int CW_NTILE = 128;
constexpr int CW_ETAB = 192;
constexpr int CW_SCANQ = 1024;

constexpr int LDS_BYTES = 160 * 1024;

#define GAS __attribute__((address_space(1)))
#define LAS __attribute__((address_space(3)))
typedef unsigned short bf16;
typedef unsigned v4u __attribute__((ext_vector_type(4)));
typedef unsigned v2u __attribute__((ext_vector_type(2)));
typedef float f32x4 __attribute__((ext_vector_type(4)));
typedef short bf16x8 __attribute__((ext_vector_type(8)));
typedef short s16x4 __attribute__((ext_vector_type(4)));
#define DI __device__ __forceinline__

DI unsigned f2bf(float f) { unsigned u = __builtin_bit_cast(unsigned, f); return (u + 0x7fffu + ((u >> 16) & 1u)) >> 16; }
typedef float f32x2_t __attribute__((ext_vector_type(2))); typedef __bf16 bf16x2_t __attribute__((ext_vector_type(2)));
DI unsigned pk2(float lo, float hi) { f32x2_t v = {lo, hi}; bf16x2_t b = __builtin_convertvector(v, bf16x2_t); return __builtin_bit_cast(unsigned, b); }
DI float bf2f(unsigned short h) { return __builtin_bit_cast(float, (unsigned)h << 16); }
DI float bflo(unsigned w) { return __builtin_bit_cast(float, w << 16); }
DI float bfhi(unsigned w) { return __builtin_bit_cast(float, w & 0xffff0000u); }
DI float wave_sum(float v) {
#pragma unroll
    for (int o = 1; o < 64; o <<= 1) v += __shfl_xor(v, o);
    return v;
}
DI float siluf(float x) { return x * __builtin_amdgcn_rcpf(1.0f + __expf(-x)); }
DI float sigmoidf_(float x) { return 1.0f / (1.0f + __expf(-x)); }
DI int perm32i(int idx) { return ((idx >> 2) & 3) * 8 + (idx >> 4) * 4 + (idx & 3); }
DI int permcol(int c) { return (c & ~31) + perm32i(c & 31); }
template <class T> DI T opaque(T p) { asm volatile("" : "+v"(p)); return p; }

typedef GAS unsigned gu32;
#define RLX_AGENT __ATOMIC_RELAXED, __HIP_MEMORY_SCOPE_AGENT
constexpr int CW_BAR = 4096;
constexpr int MISC_OFF = LDS_BYTES - 64;
#define XB_TMO      128
#define XB_XCNT(j)  (256  + 64 * (j))
#define XB_XSUB(j)  (1280 + 64 * (j))
#define XB_XGEN(j)  (2304 + 64 * (j))
#define XB_TOP      3328
#define XB_TOPGEN   3392
#define XCD_BAR_WORDS 3456
#define XB_SPIN_CAP (1u << 18)

__device__ __forceinline__ unsigned xb_ld(unsigned* p)              { return __hip_atomic_load(p, __ATOMIC_RELAXED, __HIP_MEMORY_SCOPE_AGENT); }
__device__ __forceinline__ unsigned xb_add(unsigned* p, unsigned v) { return __hip_atomic_fetch_add(p, v, __ATOMIC_RELAXED, __HIP_MEMORY_SCOPE_AGENT); }
__device__ __forceinline__ unsigned xb_xcc_id() { return (unsigned)__builtin_amdgcn_s_getreg((3 << 11) | 20) & 0xFu; }
#define XB_SPIN(cond, bar) do { unsigned _sp = 0; while (cond) { __builtin_amdgcn_s_sleep(1); \
    if ((++_sp & 255u) == 0u) { if (xb_ld(&(bar)[XB_TMO])) break; if (_sp > XB_SPIN_CAP) { atomicAdd(&(bar)[XB_TMO], 1u); break; } } } } while (0)

struct XcdBarrier {
    unsigned* bar; unsigned x;
    volatile LAS unsigned* st;
};

__device__ __forceinline__ XcdBarrier xcd_barrier_post(unsigned* bar, volatile LAS unsigned* st) {
    XcdBarrier b; b.bar = bar; b.x = xb_xcc_id(); b.st = st;
    if (threadIdx.x == 0) (void)xb_add(&bar[XB_XCNT(b.x)], 1u);
    return b;
}
__device__ __forceinline__ void xcd_barrier_complete(unsigned* bar, unsigned x, unsigned& nloc, unsigned& nx) {
    const unsigned G = gridDim.x * gridDim.y * gridDim.z;
    unsigned sum, cnt, mine, sp = 0u;
    for (;;) {
        sum = 0u; cnt = 0u; mine = 0u;
#pragma unroll
        for (unsigned j = 0; j < 16; ++j) { const unsigned c = xb_ld(&bar[XB_XCNT(j)]); sum += c; cnt += (c > 0u) ? 1u : 0u; mine = (j == x) ? c : mine; }
        if (sum == G) break;
        __builtin_amdgcn_s_sleep(1);
        if ((++sp & 255u) == 0u) { if (xb_ld(&bar[XB_TMO])) break; if (sp > XB_SPIN_CAP) { atomicAdd(&bar[XB_TMO], 1u); break; } }
    }
    nloc = mine > 0u ? mine : 1u; nx = cnt > 0u ? cnt : 1u;
}

__device__ __forceinline__ void xcd_barrier(const XcdBarrier& b) {
    asm volatile("s_waitcnt vmcnt(0)" ::: "memory");
    __syncthreads();
    if (threadIdx.x == 0) {
        unsigned* bar = b.bar;
        __builtin_amdgcn_s_waitcnt(0);
        unsigned nloc = b.st[0], nx = b.st[1];
        if (nloc == 0u) { xcd_barrier_complete(bar, b.x, nloc, nx); b.st[0] = nloc; b.st[1] = nx; }
        const unsigned old = xb_add(&bar[XB_XSUB(b.x)], 1u);
        const unsigned gen = old / nloc;
        if (old + 1u == (gen + 1u) * nloc) {
            __builtin_amdgcn_fence(__ATOMIC_RELEASE, "agent");
            asm volatile("s_waitcnt vmcnt(0)" ::: "memory");
            const unsigned og = xb_add(&bar[XB_TOP], 1u);
            const unsigned tg = og / nx;
            if (og + 1u == (tg + 1u) * nx) xb_add(&bar[XB_TOPGEN], 1u);
            else XB_SPIN(xb_ld(&bar[XB_TOPGEN]) == tg, bar);
            __builtin_amdgcn_fence(__ATOMIC_ACQUIRE, "agent");
            xb_add(&bar[XB_XGEN(b.x)], 1u);
            asm volatile("s_waitcnt vmcnt(0)" ::: "memory");
        } else {
            XB_SPIN(xb_ld(&bar[XB_XGEN(b.x)]) == gen, bar);
            __builtin_amdgcn_fence(__ATOMIC_ACQUIRE, "agent");
            asm volatile("s_waitcnt vmcnt(0)" ::: "memory");
        }
    }
    __syncthreads();
}

struct Frame {
    LAS unsigned char* lds;
    int tid, lane, wave, vcu, G;
    const float* in[17];
    float* out; unsigned char* ws;
};

DI void p0_transpose_item(const float* W, int ldw, int nblk, bf16* WT, int K, int row_off, int rmul, LAS float* scr, int item, int lane) {
    const int kb = item / nblk, nb = item % nblk, k0 = 64 * kb, n0 = 32 * nb;
    const int r8 = lane >> 3, c4 = (lane & 7) * 4;
    f32x4 v[8];
#pragma unroll
    for (int i = 0; i < 8; ++i) v[i] = __builtin_nontemporal_load((const f32x4*)(W + (size_t)(k0 + 8 * i + r8) * ldw + n0 + c4));
#pragma unroll
    for (int i = 0; i < 8; ++i) { LAS float* d = scr + (8 * i + r8) * 33 + c4; d[0] = v[i].x; d[1] = v[i].y; d[2] = v[i].z; d[3] = v[i].w; }
    asm volatile("s_waitcnt lgkmcnt(0)" ::: "memory");
    const int c = lane & 7;
#pragma unroll
    for (int j = 0; j < 4; ++j) { const int n = (lane >> 3) + 8 * j; const LAS float* s = scr + (8 * c) * 33 + n;
        v4u o; o.x = pk2(s[0 * 33], s[1 * 33]); o.y = pk2(s[2 * 33], s[3 * 33]); o.z = pk2(s[4 * 33], s[5 * 33]); o.w = pk2(s[6 * 33], s[7 * 33]);
        *(GAS v4u*)(WT + (size_t)(row_off + (n0 + n) * rmul) * K + k0 + 8 * c) = o; }
    asm volatile("s_waitcnt lgkmcnt(0)" ::: "memory");
}
template <int NR> DI void rms_rows_to_bf16(const float* const (&xrow)[NR], const float* w, bf16* const (&orow)[NR], int lane) {
    const GAS f32x4* wr = (const GAS f32x4*)w + lane;
    f32x4 v[NR][4];
#pragma unroll
    for (int r = 0; r < NR; ++r) { const GAS f32x4* xr = (const GAS f32x4*)xrow[r] + lane;
#pragma unroll
        for (int j = 0; j < 4; ++j) v[r][j] = xr[64 * j]; }
    f32x4 ww[4];
#pragma unroll
    for (int j = 0; j < 4; ++j) ww[j] = wr[64 * j];
#pragma unroll
    for (int r = 0; r < NR; ++r) {
        float s_ = 0.f;
#pragma unroll
        for (int j = 0; j < 4; ++j) s_ += (v[r][j].x * v[r][j].x + v[r][j].y * v[r][j].y) + (v[r][j].z * v[r][j].z + v[r][j].w * v[r][j].w);
        const float rs = 1.0f / sqrtf(wave_sum(s_) * (1.f / DMODEL) + EPS);
        GAS v2u* o8 = (GAS v2u*)orow[r] + lane;
#pragma unroll
        for (int j = 0; j < 4; ++j) { v2u o; o.x = pk2(v[r][j].x * rs * ww[j].x, v[r][j].y * rs * ww[j].y); o.y = pk2(v[r][j].z * rs * ww[j].z, v[r][j].w * rs * ww[j].w); o8[64 * j] = o; }
    }
}
DI void p0_prologue(Frame& F) {
    LAS float* scr = (LAS float*)(F.lds + F.wave * 16384);
    const int gw = F.vcu * NWAVES + F.wave, NGW = F.G * NWAVES;
    const float* w_in = F.in[2];
    bf16* WIN = (bf16*)(F.ws + WS_WIN);
    constexpr int I1 = 16 * 64, I2 = 16 * 24, I3 = 16, NITEMS = I1 + I2 + I3;
    for (int it = gw; it < NITEMS; it += NGW) {
        int r = it;
        if (r < I1) { p0_transpose_item(w_in, 2832, 64, WIN, 1024, 0, 1, scr, r, F.lane); continue; } r -= I1;
        if (r < I2) { p0_transpose_item(w_in + 2064, 2832, 24, WIN, 1024, 2048, 1, scr, r, F.lane); continue; } r -= I2;
        p0_transpose_item(w_in + 2048, 2832, 1, WIN, 1024, 2816, 1, scr, r, F.lane);
    }
    { const int gt = F.vcu * NTHREADS + F.tid, GT = F.G * NTHREADS; GAS v4u* z = (GAS v4u*)(WIN + (size_t)2848 * 1024);
      for (int i = gt; i < 224 * 1024 * 2 / 16; i += GT) z[i] = (v4u){0u, 0u, 0u, 0u}; }
    bf16* XN = (bf16*)(F.ws + WS_XN);
    for (int m = gw; m < TT; m += 2 * NGW) { const int m1 = (m + NGW < TT) ? m + NGW : m;
        const float* const xr[2] = {F.in[0] + (size_t)m * DMODEL, F.in[0] + (size_t)m1 * DMODEL}; bf16* const orw[2] = {XN + (size_t)m * DMODEL, XN + (size_t)m1 * DMODEL};
        rms_rows_to_bf16<2>(xr, F.in[1], orw, F.lane); }
}

struct EpiProj {
    static constexpr bool PERM = true, AFTER_DRAIN = false;
    bf16 *qkva, *za, *qkvb; float* gates;
    DI void operator()(const pg8::f32x4 (&acc)[2][2][4][2], const pg8::Unit& u, int wr, int wc, int fr, int fq) const {
        const int row0 = u.pm * 256 + wr * 64 + fr;
        if (u.pn == 11) {
            if (wc == 0 && fq < 2) {
#pragma unroll
                for (int ai = 0; ai < 2; ++ai)
#pragma unroll
                    for (int m = 0; m < 4; ++m) { float* rp = gates + (size_t)(row0 + ai * 128 + m * 16) * 16 + 8 * fq;
                        *(pg8::f32x4*)(rp) = acc[ai][0][m][0]; *(pg8::f32x4*)(rp + 4) = acc[ai][0][m][1]; }
            }
            return;
        }
        bf16* base; int ldc, colt;
        if (u.pn < 6) { base = qkva; ldc = 1536; colt = u.pn * 256; } else if (u.pn < 8) { base = za; ldc = 512; colt = (u.pn - 6) * 256; } else { base = qkvb; ldc = 768; colt = (u.pn - 8) * 256; }
        const int col0 = colt + wc * 32 + 8 * fq;
#pragma unroll
        for (int ai = 0; ai < 2; ++ai)
#pragma unroll
            for (int m = 0; m < 4; ++m) { bf16* rowp = base + (size_t)(row0 + ai * 128 + m * 16) * ldc + col0;
#pragma unroll
                for (int bj = 0; bj < 2; ++bj) { const pg8::f32x4 v0 = acc[ai][bj][m][0], v1 = acc[ai][bj][m][1]; pg8::u32x4 w;
                    w.x = pg8::cvt_pk_bf16(v0[0], v0[1]); w.y = pg8::cvt_pk_bf16(v0[2], v0[3]); w.z = pg8::cvt_pk_bf16(v1[0], v1[1]); w.w = pg8::cvt_pk_bf16(v1[2], v1[3]);
                    *(pg8::u32x4*)(rowp + bj * 128) = w; } }
    }
};
struct EpiResid {
    static constexpr bool PERM = false, AFTER_DRAIN = false;
    const float* x; float* x1;
    DI void operator()(const pg8::f32x4 (&acc)[2][2][4][2], const pg8::Unit& u, int wr, int wc, int fr, int fq) const {
        const int row0 = u.pm * 256 + wr * 64 + fr, col0 = u.pn * 256 + wc * 32 + 4 * fq;
#pragma unroll
        for (int ai = 0; ai < 2; ++ai)
#pragma unroll
            for (int m = 0; m < 4; ++m) { const size_t off = (size_t)(row0 + ai * 128 + m * 16) * DMODEL + col0;
#pragma unroll
                for (int bj = 0; bj < 2; ++bj)
#pragma unroll
                    for (int n = 0; n < 2; ++n) { const pg8::f32x4 b = *(const pg8::f32x4*)(x + off + bj * 128 + n * 16); *(pg8::f32x4*)(x1 + off + bj * 128 + n * 16) = b + acc[ai][bj][m][n]; } }
    }
};
struct EpiGU {
    static constexpr bool PERM = true, AFTER_DRAIN = false;
    bf16* hid;
    DI void operator()(const pg8::f32x4 (&acc)[2][2][4][2], const pg8::Unit& u, int wr, int wc, int fr, int fq) const {
        const int row0 = u.pm * 256 + wr * 64 + fr; const int jt = u.pn & 3;
        const int ff0 = jt * 128 + wc * 16 + 4 * fq;
#pragma unroll
        for (int ai = 0; ai < 2; ++ai)
#pragma unroll
            for (int m = 0; m < 4; ++m) { bf16* rowp = hid + (size_t)(row0 + ai * 128 + m * 16) * FFE + ff0;
#pragma unroll
                for (int bj = 0; bj < 2; ++bj) { const pg8::f32x4 v0 = acc[ai][bj][m][0], v1 = acc[ai][bj][m][1];
                    const float h0 = siluf(v0[0]) * v0[1], h1 = siluf(v0[2]) * v0[3], h2 = siluf(v1[0]) * v1[1], h3 = siluf(v1[2]) * v1[3];
                    v2u w; w.x = pg8::cvt_pk_bf16(h0, h1); w.y = pg8::cvt_pk_bf16(h2, h3);
                    *(v2u*)(rowp + bj * 64) = w; } }
    }
};
struct EpiY {
    static constexpr bool PERM = true, AFTER_DRAIN = false;
    bf16* y;
    DI void operator()(const pg8::f32x4 (&acc)[2][2][4][2], const pg8::Unit& u, int wr, int wc, int fr, int fq) const {
        const int row0 = u.pm * 256 + wr * 64 + fr; const int col0 = (u.pn & 3) * 256 + wc * 32 + 8 * fq;
#pragma unroll
        for (int ai = 0; ai < 2; ++ai)
#pragma unroll
            for (int m = 0; m < 4; ++m) { bf16* rowp = y + (size_t)(row0 + ai * 128 + m * 16) * DMODEL + col0;
#pragma unroll
                for (int bj = 0; bj < 2; ++bj) { const pg8::f32x4 v0 = acc[ai][bj][m][0], v1 = acc[ai][bj][m][1]; pg8::u32x4 w;
                    w.x = pg8::cvt_pk_bf16(v0[0], v0[1]); w.y = pg8::cvt_pk_bf16(v0[2], v0[3]); w.z = pg8::cvt_pk_bf16(v1[0], v1[1]); w.w = pg8::cvt_pk_bf16(v1[2], v1[3]);
                    *(pg8::u32x4*)(rowp + bj * 128) = w; } }
    }
};
struct MoeOrder {
    const unsigned* ctl; int G, c, esplit, pnoff;
    DI bool next(int i, pg8::Unit& u) const {
        if (G % 8 != 0) {
            int L = i * G + c;
            for (int e = 0; e < NEXP; ++e) { const int n4 = 4 * (int)ctl[CW_ETAB + 2 * e + 1]; if (L < n4) { u.pm = (int)ctl[CW_ETAB + 2 * e] + (L >> 2); u.pn = (e < esplit ? 4 * e : pnoff + 4 * (e - esplit)) + (L & 3); return true; } L -= n4; }
            return false; }
        const int x = c & 7; int L = i * (G >> 3) + (c >> 3);
#pragma unroll
        for (int q = 0; q < NEXP / 8; ++q) { const int e = x + 8 * q; const int n4 = 4 * (int)ctl[CW_ETAB + 2 * e + 1];
            if (L < n4) { u.pm = (int)ctl[CW_ETAB + 2 * e] + (L >> 2); u.pn = (e < esplit ? 4 * e : pnoff + 4 * (e - esplit)) + (L & 3); return true; } L -= n4; }
        return false; }
    DI void a_ready(const pg8::Unit&) const {}
    DI void done(const pg8::Unit&) const {}
};

DI void p2_rope(Frame& F) {
    const int gw = F.vcu * NWAVES + F.wave, NGW = F.G * NWAVES, lane = F.lane;
    const bf16* QKVB = (const bf16*)(F.ws + WS_QKVB);
    bf16* QR = (bf16*)((unsigned char*)F.out + DO_QR); bf16* KR = (bf16*)((unsigned char*)F.out + DO_KR); bf16* VR = (bf16*)((unsigned char*)F.out + DO_VR);
    const int pi = lane & 31, hsel = lane >> 5;
    const float qw0 = F.in[7][2 * pi], qw1 = F.in[7][2 * pi + 1], kw0 = F.in[8][2 * pi], kw1 = F.in[8][2 * pi + 1];
    const float invf = exp2f(-(float)(2 * (pi & 15)) * (13.287712379549449f / 32.0f));
    constexpr float C2 = 0.125f * 1.4426950408889634f;
    constexpr int NB4 = 4;
    for (int t0 = gw; t0 < TT; t0 += NB4 * NGW) {
        unsigned w[NB4][5], vw[NB4];
#pragma unroll
        for (int u = 0; u < NB4; ++u) { const int t = t0 + u * NGW; const unsigned* src = (const unsigned*)(QKVB + (size_t)(t < TT ? t : t0) * 768);
#pragma unroll
            for (int j = 0; j < 5; ++j) w[u][j] = src[(2 * j + hsel) * 32 + pi];
            vw[u] = src[320 + lane]; }
#pragma unroll
        for (int u = 0; u < NB4; ++u) {
            const int t = t0 + u * NGW; if (t >= TT) break;
            const int s_ = t & (SEQ - 1); const float pos = (pi < 16) ? (float)(s_ >> 6) : (float)(s_ & 63);
            const float ang = pos * invf;
            const double rev = (double)ang * 0.15915494309189535; const float fr = (float)(rev - floor(rev));
            const float sn = __builtin_amdgcn_sinf(fr), cs = __builtin_amdgcn_cosf(fr);
#pragma unroll
            for (int j = 0; j < 5; ++j) {
                const int head = 2 * j + hsel;
                const float x0 = bflo(w[u][j]), x1 = bfhi(w[u][j]);
                float ss = x0 * x0 + x1 * x1;
#pragma unroll
                for (int o = 1; o < 32; o <<= 1) ss += __shfl_xor(ss, o);
                const float rs = 1.0f / sqrtf(ss * (1.f / 64.f) + EPS);
                const bool isq = head < 8;
                const float y0 = x0 * rs * (isq ? qw0 : kw0), y1 = x1 * rs * (isq ? qw1 : kw1);
                float o0 = y0 * cs - y1 * sn, o1 = y0 * sn + y1 * cs;
                if (isq) { o0 *= C2; o1 *= C2; ((unsigned*)(QR + (size_t)t * 512))[head * 32 + pi] = pk2(o0, o1); }
                else ((unsigned*)(KR + (size_t)t * 128))[(head - 8) * 32 + pi] = pk2(o0, o1);
            }
            ((unsigned*)(VR + (size_t)t * 128))[lane] = vw[u];
        }
    }
}

constexpr int G_KNP = 0, G_QNP = 17408, G_KNTP = 34816, G_VCT = 53248;
constexpr int G_D0 = 71680, G_D1 = 71680 + 19456;
constexpr int GD_TBP = 0, GD_AP = 9216, GD_VEC = 18432;
constexpr int G_LM = 110592;
constexpr int G_GV = G_LM + 32768;
static_assert(G_GV + 2048 <= LDS_BYTES - 64, "gdn pre lds");

#define TRI_ROW(i, LC, LN) { \
        if ((i) + 1 < 64) { _Pragma("unroll") for (int j4 = 0; j4 < ((i) + 1 + 3) / 4 && j4 < 8; ++j4) LN[j4] = *(const LAS f32x4*)(L + ((i) + 1) * 64 + 4 * j4); } \
        _Pragma("unroll") for (int j4 = 8; j4 < ((i) + 3) / 4; ++j4) lt[j4 - 8] = *(const LAS f32x4*)(L + (i) * 64 + 4 * j4); \
        __builtin_amdgcn_sched_barrier(0); \
        f32x2_t a0 = {(lane == (i)) ? 1.0f : 0.0f, 0.f}, a1 = {0.f, 0.f}; \
        _Pragma("unroll") for (int j4 = 0; j4 < ((i) + 3) / 4; ++j4) { const f32x4 l = (j4 < 8) ? LC[j4 & 7] : lt[(j4 - 8) & 7]; \
            f32x2_t l0 = {l.x, (4 * j4 + 1 < (i)) ? l.y : 0.f}, l1 = {(4 * j4 + 2 < (i)) ? l.z : 0.f, (4 * j4 + 3 < (i)) ? l.w : 0.f}; \
            a0 -= l0 * xp[2 * j4]; if (4 * j4 + 2 < (i)) a1 -= l1 * xp[2 * j4 + 1]; } \
        const float a = (a0.x + a0.y) + (a1.x + a1.y); \
        if ((i) & 1) xp[(i) >> 1].y = a; else { xp[(i) >> 1].x = a; xp[(i) >> 1].y = 0.f; } \
        TBP[(REV ? 63 - (i) : (i)) * 72 + pc] = (bf16)(pk2(a * bcol, 0.f) & 0xffffu); \
        __builtin_amdgcn_sched_barrier(0); }
template <bool REV> DI void tri_inverse(LAS float* L, const LAS float* beta, LAS bf16* TBP, int lane) {
    f32x2_t xp[32];
    L = opaque(L); TBP = opaque(TBP); lane = opaque(lane);
    const float bcol = REV ? beta[63 - lane] : beta[lane];
    const int pc = REV ? permcol(63 - lane) : permcol(lane);
    f32x4 la[8], lb[8], lt[8];
#pragma unroll
    for (int ii = 0; ii < 64; ii += 2) { TRI_ROW(ii, la, lb) TRI_ROW(ii + 1, lb, la) }
}
#undef TRI_ROW

DI void gdn_conv(Frame& F, LAS unsigned char* lds, int t384, int b, int h, int n) {
    const bf16* QKVA = (const bf16*)(F.ws + WS_QKVA); const float* convw = F.in[3];
    const int cgp = t384 % 48, rg = t384 / 48, mat = cgp >> 4, cc = (cgp & 15) * 8;
    const int col = mat * 512 + h * 128 + cc;
    float w[5][8];
#pragma unroll
    for (int j = 0; j < 5; ++j) { const f32x4 a = *(const f32x4*)(convw + j * 1536 + col), bq = *(const f32x4*)(convw + j * 1536 + col + 4);
        w[j][0] = a.x; w[j][1] = a.y; w[j][2] = a.z; w[j][3] = a.w; w[j][4] = bq.x; w[j][5] = bq.y; w[j][6] = bq.z; w[j][7] = bq.w; }
    const int a4 = (cc >> 3) & 3, p0 = (cc & ~31) + 16 * (a4 & 1) + 4 * (a4 >> 1);
    const int ra = rg & 3, q0 = (rg >> 2) * 32 + 16 * (ra & 1) + 4 * (ra >> 1);
#pragma unroll
    for (int hf = 0; hf < 2; ++hf) {
        float o[4][8];
#pragma unroll
        for (int r = 0; r < 4; ++r)
#pragma unroll
            for (int c = 0; c < 8; ++c) o[r][c] = 0.f;
#pragma unroll
        for (int i = 0; i < 8; ++i) {
            const int pos = n * 64 + rg * 8 + hf * 4 - 2 + i;
            v4u raw = (v4u){0u, 0u, 0u, 0u};
            if (pos >= 0 && pos < SEQ) raw = *(const v4u*)(QKVA + (size_t)(b * SEQ + pos) * 1536 + col);
            float xin[8] = {bflo(raw.x), bfhi(raw.x), bflo(raw.y), bfhi(raw.y), bflo(raw.z), bfhi(raw.z), bflo(raw.w), bfhi(raw.w)};
#pragma unroll
            for (int j = 0; j < 5; ++j) { const int r = i - j; if (r >= 0 && r < 4) {
#pragma unroll
                for (int c = 0; c < 8; ++c) o[r][c] += w[j][c] * xin[c]; } }
        }
#pragma unroll
        for (int r = 0; r < 4; ++r) {
            float ss = 0.f;
#pragma unroll
            for (int c = 0; c < 8; ++c) { o[r][c] = siluf(o[r][c]); ss += o[r][c] * o[r][c]; }
            ss += __shfl_xor(ss, 1); ss += __shfl_xor(ss, 2); ss += __shfl_xor(ss, 4); ss += __shfl_xor(ss, 8);
            float sc = 1.0f;
            if (mat < 2) { sc = 1.0f / sqrtf(ss + EPS); if (mat == 0) sc *= 0.08838834764831845f; }
#pragma unroll
            for (int c = 0; c < 8; ++c) o[r][c] *= sc;
        }
        if (mat < 2) {
            LAS unsigned char* tile = lds + (mat == 0 ? G_QNP : G_KNP);
#pragma unroll
            for (int r = 0; r < 4; ++r) { const int c = rg * 8 + hf * 4 + r;
                v2u lo, hi2; lo.x = pk2(o[r][0], o[r][1]); lo.y = pk2(o[r][2], o[r][3]); hi2.x = pk2(o[r][4], o[r][5]); hi2.y = pk2(o[r][6], o[r][7]);
                *(LAS v2u*)(tile + c * 272 + p0 * 2) = lo; *(LAS v2u*)(tile + c * 272 + (p0 + 8) * 2) = hi2; }
        }
        if (mat >= 1) {
#pragma unroll
            for (int c = 0; c < 8; ++c) {
                v2u q4; q4.x = pk2(o[0][c], o[1][c]); q4.y = pk2(o[2][c], o[3][c]);
                if (mat == 1) *(LAS v2u*)(lds + G_KNTP + (cc + c) * 144 + (q0 + 8 * hf) * 2) = q4;
                else *(LAS v2u*)(lds + G_VCT + (cc + c) * 144 + rg * 16 + hf * 8) = q4;
            }
        }
    }
}
DI void gdn_gates(Frame& F, LAS unsigned char* lds, LAS float* gv, int lane, int b, int h, int n) {
    const float* gp = (const float*)(F.ws + WS_GATES) + (size_t)(b * SEQ + n * 64 + lane) * 16;
    const float bfv = gp[h], bbv = gp[4 + h], afv = gp[8 + h], abv = gp[12 + h];
    const float betaf = sigmoidf_(bfv), betab = sigmoidf_(bbv);
    const float xf = afv + F.in[5][h], xb = abv + F.in[5][4 + h];
    const float spf = fmaxf(xf, 0.f) + log1pf(__expf(-fabsf(xf))), spb = fmaxf(xb, 0.f) + log1pf(__expf(-fabsf(xb)));
    const float gf = -__expf(F.in[4][h]) * spf, gb = -__expf(F.in[4][4 + h]) * spb;
    float Gf = gf, Rb = gb;
#pragma unroll
    for (int o = 1; o < 64; o <<= 1) { const float u1 = __shfl_up(Gf, o); if (lane >= o) Gf += u1; const float d1 = __shfl_down(Rb, o); if (lane + o < 64) Rb += d1; }
    gv[lane] = Gf; gv[64 + lane] = Rb; gv[128 + lane] = betaf; gv[192 + lane] = betab;
    const float GfL = __shfl(Gf, 63), Rb0 = __shfl(Rb, 0);
    LAS float* v0 = (LAS float*)(lds + G_D0 + GD_VEC); LAS float* v1 = (LAS float*)(lds + G_D1 + GD_VEC);
    v0[lane] = __expf(Gf); v0[64 + lane] = __expf(GfL - Gf); v1[lane] = __expf(Rb); v1[64 + lane] = __expf(Rb0 - Rb);
    if (lane == 0) { v0[128] = __expf(GfL); v1[128] = __expf(Rb0); }
}
DI void p2_gdn_pre(Frame& F) {
    const int tid = F.tid, lane = F.lane, wave = F.wave;
    int task = F.vcu;
    if (task < 1024) {
        LAS unsigned char* lds = opaque(F.lds);
        const int b = task >> 9, h = (task >> 7) & 3, n = task & 127;
        if (wave >= 2) gdn_conv(F, lds, tid - 128, b, h, n);
        if (wave == 2) gdn_gates(F, lds, (LAS float*)(lds + G_GV), lane, b, h, n);
    }
    __syncthreads();
    int par = 0;
#pragma unroll 1
    for (; task < 1024; task += F.G, par ^= 1) {
        LAS unsigned char* lds = opaque(F.lds);
        const int b = task >> 9, h = (task >> 7) & 3, n = task & 127, bh = b * 4 + h;
        LAS float* gv = (LAS float*)(lds + G_GV + par * 1024);
        LAS float* sGf = gv; LAS float* sRb = gv + 64; LAS float* sBf = gv + 128; LAS float* sBb = gv + 192;
        {
            const int p = wave >> 2, mt = wave & 3, n16 = lane & 15, g = lane >> 4;
            const LAS unsigned char* At = lds + (p == 0 ? G_KNP : G_QNP) + (16 * mt + n16) * 272 + g * 16;
            bf16x8 af[4], bfr[16];
#pragma unroll
            for (int ks = 0; ks < 4; ++ks) af[ks] = *(const LAS bf16x8*)(At + ks * 64);
#pragma unroll
            for (int nt = 0; nt < 4; ++nt)
#pragma unroll
                for (int ks = 0; ks < 4; ++ks) bfr[nt * 4 + ks] = *(const LAS bf16x8*)(lds + G_KNP + (16 * nt + n16) * 272 + g * 16 + ks * 64);
            float Gc[4], Rc[4], Bfc[4], Bbc[4];
#pragma unroll
            for (int r = 0; r < 4; ++r) { const int c = 16 * mt + 4 * g + r; Gc[r] = sGf[c]; Rc[r] = sRb[c]; Bfc[r] = sBf[c]; Bbc[r] = sBb[c]; }
#pragma unroll
            for (int nt = 0; nt < 4; ++nt) {
                f32x4 acc = (f32x4){0.f, 0.f, 0.f, 0.f};
#pragma unroll
                for (int ks = 0; ks < 4; ++ks) acc = __builtin_amdgcn_mfma_f32_16x16x32_bf16(af[ks], bfr[nt * 4 + ks], acc, 0, 0, 0);
                const int s_ = 16 * nt + n16; const float Gs = sGf[s_], Rs = sRb[s_]; const int ps = permcol(s_);
#pragma unroll
                for (int r = 0; r < 4; ++r) {
                    const int c = 16 * mt + 4 * g + r; const float v = acc[r];
                    const float df = __expf(fminf(Gc[r] - Gs, 0.f)), db = __expf(fminf(Rc[r] - Rs, 0.f));
                    if (p == 0) {
                        ((LAS float*)(lds + G_LM))[c * 64 + s_] = Bfc[r] * v * df;
                        ((LAS float*)(lds + G_LM + 16384))[(63 - c) * 64 + (63 - s_)] = Bbc[r] * v * db;
                    } else {
                        ((LAS bf16*)(lds + G_D0 + GD_AP))[c * 72 + ps] = (bf16)(pk2(s_ <= c ? v * df : 0.f, 0.f) & 0xffffu);
                        ((LAS bf16*)(lds + G_D1 + GD_AP))[c * 72 + ps] = (bf16)(pk2(s_ >= c ? v * db : 0.f, 0.f) & 0xffffu);
                    }
                }
            }
        }
        __syncthreads();
        GAS v4u* gd0 = (GAS v4u*)(F.ws + WS_GD + (size_t)((bh * 2 + 0) * 128 + n) * GDN_D_BYTES);
        GAS v4u* gd1 = (GAS v4u*)(F.ws + WS_GD + (size_t)((bh * 2 + 1) * 128 + n) * GDN_D_BYTES);
        {
            GAS v4u* gsh = (GAS v4u*)(F.ws + WS_GSH + (size_t)(bh * 128 + n) * GDN_SH_BYTES);
#pragma unroll 3
            for (int i = tid; i < (int)(GDN_SH_BYTES / 16); i += NTHREADS) gsh[i] = *(const LAS v4u*)(lds + i * 16);
#pragma unroll 1
            for (int i = GD_AP / 16 + tid; i < (int)(GDN_D_BYTES / 16); i += NTHREADS) { gd0[i] = *(const LAS v4u*)(lds + G_D0 + i * 16); gd1[i] = *(const LAS v4u*)(lds + G_D1 + i * 16); }
        }
        __syncthreads();
        if (wave == 0) { tri_inverse<false>((LAS float*)(lds + G_LM), sBf, (LAS bf16*)(lds + G_D0 + GD_TBP), lane);
#pragma unroll 3
            for (int i = lane; i < GD_AP / 16; i += 64) gd0[i] = *(const LAS v4u*)(lds + G_D0 + i * 16); }
        else if (wave == 1) { tri_inverse<true>((LAS float*)(lds + G_LM + 16384), sBb, (LAS bf16*)(lds + G_D1 + GD_TBP), lane);
#pragma unroll 3
            for (int i = lane; i < GD_AP / 16; i += 64) gd1[i] = *(const LAS v4u*)(lds + G_D1 + i * 16); }
        else {
            const int t2 = task + F.G;
            if (t2 < 1024) { const int b2 = t2 >> 9, h2 = (t2 >> 7) & 3, n2 = t2 & 127;
                gdn_conv(F, lds, tid - 128, b2, h2, n2);
                if (wave == 2) gdn_gates(F, lds, (LAS float*)(lds + G_GV + (par ^ 1) * 1024), lane, b2, h2, n2); }
        }
        __syncthreads();
    }
}

DI bf16x8 pack8(const f32x4 a, const f32x4 b) {
    v4u p; p.x = pk2(a[0], a[1]); p.y = pk2(a[2], a[3]); p.z = pk2(b[0], b[1]); p.w = pk2(b[2], b[3]); return __builtin_bit_cast(bf16x8, p);
}
DI void small_weights(Frame& F, int gw, int NGW) {
    LAS float* scr = (LAS float*)(F.lds + F.wave * 16384);
    bf16* WOUT = (bf16*)(F.ws + WS_WOUT);
    for (int it = gw; it < 16 * 32; it += NGW) p0_transpose_item(F.in[9], 1024, 32, WOUT, 1024, 0, 1, scr, it, F.lane);
    bf16* WRH = (bf16*)(F.ws + WS_WR); bf16* WRL = WRH + 48 * 1024; const float* wrg = F.in[11]; const float* wre = F.in[12];
    for (int i = gw * 64 + F.lane; i < 48 * 1024; i += NGW * 64) { const int j = i >> 10, k = i & 1023; float v = 0.f; if (j < 4) v = wrg[k * 4 + j]; else if (j < 36) v = wre[k * 32 + (j - 4)];
        const unsigned h = f2bf(v); const float hv = __builtin_bit_cast(float, h << 16); WRH[i] = (bf16)h; WRL[i] = (bf16)f2bf(v - hv); }
}
DI bf16* wgu_ptr(Frame& F, int e) { return (bf16*)(F.ws + (e < WGU_SPLIT ? WS_WGU0 + (size_t)e * 2 * MiB : WS_WGU1 + (size_t)(e - WGU_SPLIT) * 2 * MiB)); }
DI bf16* wd_ptr(Frame& F, int e) { return (bf16*)((unsigned char*)F.out + (e < WD_SPLIT ? DO_WD0 + (size_t)e * MiB : DO_WD1 + (size_t)(e - WD_SPLIT) * MiB)); }
DI void moe_weights(Frame& F, int gw, int NGW) {
    LAS float* scr = (LAS float*)(F.lds + F.wave * 16384);
    constexpr int IG = 16 * 16, ID = 8 * 32, IPE = 2 * IG + ID;
    for (int it = gw; it < NEXP * IPE; it += NGW) {
        const int e = it / IPE; int r = it % IPE;
        if (r < IG) { p0_transpose_item(F.in[13] + (size_t)e * 1024 * 512, 512, 16, wgu_ptr(F, e), 1024, 0, 2, scr, r, F.lane); continue; } r -= IG;
        if (r < IG) { p0_transpose_item(F.in[14] + (size_t)e * 1024 * 512, 512, 16, wgu_ptr(F, e), 1024, 1, 2, scr, r, F.lane); continue; } r -= IG;
        p0_transpose_item(F.in[15] + (size_t)e * 512 * 1024, 1024, 32, wd_ptr(F, e), 512, 0, 1, scr, r, F.lane);
    }
}

constexpr int SC_SLOT = 78848, SC_VCT = 53248, SC_D = 55552, SC_NCH = 11;
static_assert(2 * SC_SLOT <= LDS_BYTES, "scan slots");
DI void sc_issue(v4u (&R)[SC_NCH], const unsigned char* ws, const unsigned (&delta)[SC_NCH], const unsigned (&dmask)[SC_NCH], unsigned shbase, unsigned ddiff) {
#pragma unroll
    for (int j = 0; j < SC_NCH; ++j) { const unsigned off = shbase + delta[j] + (dmask[j] & ddiff);
#ifdef SC_PLAIN_LOADS
        R[j] = *(const v4u*)(ws + off); }
#else
        asm volatile("global_load_dwordx4 %0, %1, %2" : "=v"(R[j]) : "v"(off), "s"(ws) : "memory"); }
#endif
}
#ifdef SC_PLAIN_LOADS
#define SC_WAIT(R, n) do {} while (0)
#else
#define SC_WAIT(R, n) asm volatile("s_waitcnt vmcnt(" #n ")" : "+v"(R[0]), "+v"(R[1]), "+v"(R[2]), "+v"(R[3]), "+v"(R[4]), "+v"(R[5]), "+v"(R[6]), "+v"(R[7]), "+v"(R[8]), "+v"(R[9]), "+v"(R[10]) :: "memory")
#endif
DI void sc_write(const v4u (&R)[SC_NCH], LAS unsigned char* slot, int lid) {
#pragma unroll
    for (int j = 0; j < SC_NCH; ++j) *(LAS v4u*)(slot + 16 * (lid + 448 * j)) = R[j];
}
DI void p4_scan(Frame& F) {
    const int lane = F.lane, n16 = lane & 15, g = lane >> 4, wave = F.wave;
    {
        volatile LAS int* tsk = (volatile LAS int*)(F.lds + MISC_OFF + 32);
        if (F.tid == 0) {
            unsigned* q = (unsigned*)(F.ws + WS_CTL) + CW_SCANQ; const unsigned xcc = xb_xcc_id() & 7u; int task = -1;
            for (unsigned t = 0; t < 8 && task < 0; ++t) { const unsigned y = (xcc + t) & 7u; const unsigned j = xb_add(q + 64 * y, 1u); if (j < 16u) task = (int)(y * 16 + j); }
            *tsk = task; if (task < 0) tsk[1] = (int)xb_add(q + 64 * 8, 1u);
        }
        __syncthreads();
    }
    const int task = *(volatile LAS int*)(F.lds + MISC_OFF + 32);
    if (task < 0) {
        if (F.G > 128) { const int cgw = *(volatile LAS int*)(F.lds + MISC_OFF + 36) * NWAVES + wave, cng = (F.G - 128) * NWAVES; small_weights(F, cgw, cng); moe_weights(F, cgw, cng); }
        return; }
    const int chain = 2 * (task >> 4) + ((task & 15) >> 3), e = task & 7;
    const int bh = chain >> 1, dir = chain & 1, b = bh >> 2, h = bh & 3;
    LAS unsigned char* lds = opaque(F.lds);
    if (wave != 0) {
        const int lid = (wave - 1) * 64 + lane;
        const unsigned sh0 = (unsigned)(WS_GSH + (size_t)(bh * 128) * GDN_SH_BYTES), d0 = (unsigned)(WS_GD + (size_t)((bh * 2 + dir) * 128) * GDN_D_BYTES);
        unsigned delta[SC_NCH], dmask[SC_NCH];
#pragma unroll
        for (int j = 0; j < SC_NCH; ++j) { const int c = lid + 448 * j;
            delta[j] = (c < 3328) ? 16u * c : ((c < 3472) ? (unsigned)(G_VCT + 16 * e * 144 + 16 * (c - 3328)) : 16u * (c - 3472));
            dmask[j] = (c < 3472) ? 0u : 0xffffffffu; }
        v4u R0[SC_NCH], R1[SC_NCH], R2[SC_NCH];
#define SC_SRC(st) const int n_ = (dir == 0) ? ((st) < 128 ? (st) : 127) : ((st) < 128 ? 127 - (st) : 0); \
                   const unsigned shb_ = sh0 + (unsigned)n_ * (unsigned)GDN_SH_BYTES, ddf_ = (d0 + (unsigned)n_ * (unsigned)GDN_D_BYTES) - shb_;
        { SC_SRC(0) sc_issue(R0, F.ws, delta, dmask, shb_, ddf_); }
        { SC_SRC(1) sc_issue(R1, F.ws, delta, dmask, shb_, ddf_); }
        { SC_SRC(2) sc_issue(R2, F.ws, delta, dmask, shb_, ddf_); }
#define SC_BODY(R, st) { SC_WAIT(R, 22); sc_write(R, lds + ((st) & 1) * SC_SLOT, lid); { SC_SRC((st) + 3) sc_issue(R, F.ws, delta, dmask, shb_, ddf_); } \
                        asm volatile("s_waitcnt lgkmcnt(0)" ::: "memory"); __builtin_amdgcn_s_barrier(); }
#pragma unroll 1
        for (int s0 = 0; s0 < 126; s0 += 3) { SC_BODY(R0, s0) SC_BODY(R1, s0 + 1) SC_BODY(R2, s0 + 2) }
        SC_BODY(R0, 126) SC_BODY(R1, 127)
        SC_WAIT(R0, 0); SC_WAIT(R1, 0); SC_WAIT(R2, 0);
#undef SC_BODY
#undef SC_SRC
        return;
    }
    bf16* Odir = (bf16*)((unsigned char*)F.out + (dir == 0 ? DO_OF : DO_OB));
    f32x4 S[8];
#pragma unroll
    for (int i = 0; i < 8; ++i) S[i] = (f32x4){0.f, 0.f, 0.f, 0.f};
    bf16x8 Sb[4];
#pragma unroll
    for (int i = 0; i < 4; ++i) Sb[i] = (bf16x8){0, 0, 0, 0, 0, 0, 0, 0};
    const unsigned aoff272 = n16 * 272 + g * 16, aoff144 = n16 * 144 + g * 16;
    const unsigned lds0 = (unsigned)(uintptr_t)lds;
#define SB_() __builtin_amdgcn_sched_barrier(0)
#define LDR128(dst, base, off) asm volatile("ds_read_b128 %0, %1 offset:%2" : "=v"(dst) : "v"(base), "i"(off) : "memory")
#define LDR64(dst, base, off) asm volatile("ds_read_b64 %0, %1 offset:%2" : "=v"(dst) : "v"(base), "i"(off) : "memory")
#define LDR32(dst, base, off) asm volatile("ds_read_b32 %0, %1 offset:%2" : "=v"(dst) : "v"(base), "i"(off) : "memory")
#pragma unroll 1
    for (int step = 0; step < 128; ++step) {
        __builtin_amdgcn_s_barrier();
        asm volatile("" ::: "memory");
        const int n = dir == 0 ? step : 127 - step;
        const unsigned slot = lds0 + (unsigned)(step & 1) * SC_SLOT;
        const unsigned bK = slot + G_KNP + aoff272, bQ = slot + G_QNP + aoff272, bKT = slot + G_KNTP + aoff144, bT = slot + SC_D + GD_TBP + aoff144;
        const unsigned bV = slot + SC_VCT + n16 * 144 + g * 8, bvec = slot + SC_D + GD_VEC + g * 16, bd = slot + SC_D + GD_VEC;
        f32x4 eG[4], ks[4]; v2u vv[4]; float dch; bf16x8 fa[16];
        LDR128(eG[0], bvec, 0); LDR128(eG[1], bvec, 64); LDR128(eG[2], bvec, 128); LDR128(eG[3], bvec, 192);
        LDR128(ks[0], bvec, 256); LDR128(ks[1], bvec, 320); LDR128(ks[2], bvec, 384); LDR128(ks[3], bvec, 448);
        LDR32(dch, bd, 512);
        LDR64(vv[0], bV, 0); LDR64(vv[1], bV, 32); LDR64(vv[2], bV, 64); LDR64(vv[3], bV, 96);
#pragma unroll
        for (int m = 0; m < 4; ++m) { LDR128(fa[m * 4 + 0], bK, m * 4352 + 0); LDR128(fa[m * 4 + 1], bK, m * 4352 + 64); LDR128(fa[m * 4 + 2], bK, m * 4352 + 128); LDR128(fa[m * 4 + 3], bK, m * 4352 + 192); }
        bf16x8 fq[16];
#pragma unroll
        for (int m = 0; m < 4; ++m) { LDR128(fq[m * 4 + 0], bQ, m * 4352 + 0); LDR128(fq[m * 4 + 1], bQ, m * 4352 + 64); LDR128(fq[m * 4 + 2], bQ, m * 4352 + 128); LDR128(fq[m * 4 + 3], bQ, m * 4352 + 192); }
        asm volatile("s_waitcnt lgkmcnt(15)" : "+v"(eG[0]), "+v"(eG[1]), "+v"(eG[2]), "+v"(eG[3]), "+v"(ks[0]), "+v"(ks[1]), "+v"(ks[2]), "+v"(ks[3]), "+v"(dch), "+v"(vv[0]), "+v"(vv[1]), "+v"(vv[2]), "+v"(vv[3]),
                     "+v"(fa[0]), "+v"(fa[1]), "+v"(fa[2]), "+v"(fa[3]), "+v"(fa[4]), "+v"(fa[5]), "+v"(fa[6]), "+v"(fa[7]), "+v"(fa[8]), "+v"(fa[9]), "+v"(fa[10]), "+v"(fa[11]), "+v"(fa[12]), "+v"(fa[13]), "+v"(fa[14]), "+v"(fa[15]) :: "memory");
        SB_();
        f32x4 KS[4];
#pragma unroll
        for (int m = 0; m < 4; ++m) KS[m] = (f32x4){0.f, 0.f, 0.f, 0.f};
#pragma unroll
        for (int i = 0; i < 4; ++i)
#pragma unroll
            for (int m = 0; m < 4; ++m) KS[m] = __builtin_amdgcn_mfma_f32_16x16x32_bf16(fa[m * 4 + i], Sb[i], KS[m], 0, 0, 0);
        SB_();
        bf16x8 ft[8];
#pragma unroll
        for (int m = 0; m < 4; ++m) { LDR128(ft[m * 2 + 0], bT, m * 2304 + 0); LDR128(ft[m * 2 + 1], bT, m * 2304 + 64); }
        asm volatile("s_waitcnt lgkmcnt(8)" : "+v"(fq[0]), "+v"(fq[1]), "+v"(fq[2]), "+v"(fq[3]), "+v"(fq[4]), "+v"(fq[5]), "+v"(fq[6]), "+v"(fq[7]), "+v"(fq[8]), "+v"(fq[9]), "+v"(fq[10]), "+v"(fq[11]), "+v"(fq[12]), "+v"(fq[13]), "+v"(fq[14]), "+v"(fq[15]) :: "memory");
        SB_();
        f32x4 o[4];
#pragma unroll
        for (int m = 0; m < 4; ++m) o[m] = (f32x4){0.f, 0.f, 0.f, 0.f};
#pragma unroll
        for (int i = 0; i < 4; ++i)
#pragma unroll
            for (int m = 0; m < 4; ++m) o[m] = __builtin_amdgcn_mfma_f32_16x16x32_bf16(fq[m * 4 + i], Sb[i], o[m], 0, 0, 0);
        f32x4 rr[4];
#pragma unroll
        for (int m = 0; m < 4; ++m) { rr[m][0] = bflo(vv[m].x) - eG[m][0] * KS[m][0]; rr[m][1] = bfhi(vv[m].x) - eG[m][1] * KS[m][1]; rr[m][2] = bflo(vv[m].y) - eG[m][2] * KS[m][2]; rr[m][3] = bfhi(vv[m].y) - eG[m][3] * KS[m][3]; }
        bf16x8 rb[2]; rb[0] = pack8(rr[0], rr[1]); rb[1] = pack8(rr[2], rr[3]);
        SB_();
        bf16x8 fk[16];
#pragma unroll
        for (int jt = 0; jt < 8; ++jt) { LDR128(fk[jt * 2 + 0], bKT, jt * 2304 + 0); LDR128(fk[jt * 2 + 1], bKT, jt * 2304 + 64); }
        asm volatile("s_waitcnt lgkmcnt(15)" : "+v"(ft[0]), "+v"(ft[1]), "+v"(ft[2]), "+v"(ft[3]), "+v"(ft[4]), "+v"(ft[5]), "+v"(ft[6]), "+v"(ft[7]) :: "memory");
        SB_();
        f32x4 vn[4];
#pragma unroll
        for (int m = 0; m < 4; ++m) vn[m] = (f32x4){0.f, 0.f, 0.f, 0.f};
#pragma unroll
        for (int i = 0; i < 2; ++i)
#pragma unroll
            for (int m = 0; m < 4; ++m) vn[m] = __builtin_amdgcn_mfma_f32_16x16x32_bf16(ft[m * 2 + i], rb[i], vn[m], 0, 0, 0);
#pragma unroll
        for (int m = 0; m < 4; ++m) o[m] = o[m] * eG[m];
#pragma unroll
        for (int jt = 0; jt < 8; ++jt) S[jt] = S[jt] * dch;
        SB_();
        bf16x8 fp[8];
#pragma unroll
        for (int m = 0; m < 4; ++m) { LDR128(fp[m * 2 + 0], bT, GD_AP + m * 2304 + 0); LDR128(fp[m * 2 + 1], bT, GD_AP + m * 2304 + 64); }
        bf16x8 vnb[2]; vnb[0] = pack8(vn[0], vn[1]); vnb[1] = pack8(vn[2], vn[3]);
        bf16x8 vs[2]; vs[0] = pack8(vn[0] * ks[0], vn[1] * ks[1]); vs[1] = pack8(vn[2] * ks[2], vn[3] * ks[3]);
        asm volatile("s_waitcnt lgkmcnt(8)" : "+v"(fk[0]), "+v"(fk[1]), "+v"(fk[2]), "+v"(fk[3]), "+v"(fk[4]), "+v"(fk[5]), "+v"(fk[6]), "+v"(fk[7]), "+v"(fk[8]), "+v"(fk[9]), "+v"(fk[10]), "+v"(fk[11]), "+v"(fk[12]), "+v"(fk[13]), "+v"(fk[14]), "+v"(fk[15]) :: "memory");
        SB_();
#pragma unroll
        for (int i = 0; i < 2; ++i)
#pragma unroll
            for (int jt = 0; jt < 8; ++jt) S[jt] = __builtin_amdgcn_mfma_f32_16x16x32_bf16(fk[jt * 2 + i], vs[i], S[jt], 0, 0, 0);
        asm volatile("s_waitcnt lgkmcnt(0)" : "+v"(fp[0]), "+v"(fp[1]), "+v"(fp[2]), "+v"(fp[3]), "+v"(fp[4]), "+v"(fp[5]), "+v"(fp[6]), "+v"(fp[7]) :: "memory");
#pragma unroll
        for (int i = 0; i < 2; ++i)
#pragma unroll
            for (int m = 0; m < 4; ++m) o[m] = __builtin_amdgcn_mfma_f32_16x16x32_bf16(fp[m * 2 + i], vnb[i], o[m], 0, 0, 0);
#pragma unroll
        for (int i = 0; i < 4; ++i) Sb[i] = pack8(S[2 * i], S[2 * i + 1]);
        SB_();
        bf16* op = Odir + (size_t)(b * SEQ + n * 64) * 512 + h * 128 + 16 * e + n16;
#pragma unroll
        for (int m = 0; m < 4; ++m)
#pragma unroll
            for (int r = 0; r < 4; ++r) op[(size_t)(16 * m + 4 * g + r) * 512] = (bf16)(pk2(o[m][r], 0.f) & 0xffffu);
    }
#undef SB_
#undef LDR128
#undef LDR64
#undef LDR32
}

DI void p5_combine(Frame& F) {
    const int gw = F.vcu * NWAVES + F.wave, NGW = F.G * NWAVES, lane = F.lane;
    const bf16* OFp = (const bf16*)((unsigned char*)F.out + DO_OF); const bf16* OBp = (const bf16*)((unsigned char*)F.out + DO_OB);
    const bf16* ZA = (const bf16*)(F.ws + WS_ZA); bf16* OCAT = (bf16*)(F.ws + WS_OCAT);
    const float* nw = F.in[6] + (lane & 15) * 8;
    float w8[8];
#pragma unroll
    for (int c = 0; c < 8; ++c) w8[c] = nw[c];
    constexpr int NB4 = 4;
    for (int t0 = gw; t0 < TT; t0 += NB4 * NGW) {
        v4u a[NB4], bb[NB4], z[NB4];
#pragma unroll
        for (int u = 0; u < NB4; ++u) { const int t = (t0 + u * NGW < TT) ? t0 + u * NGW : t0;
            a[u] = *(const v4u*)(OFp + (size_t)t * 512 + lane * 8); bb[u] = *(const v4u*)(OBp + (size_t)t * 512 + lane * 8); z[u] = *(const v4u*)(ZA + (size_t)t * 512 + lane * 8); }
#pragma unroll
        for (int u = 0; u < NB4; ++u) {
            const int t = t0 + u * NGW; if (t >= TT) break;
            float o[8] = {bflo(a[u].x) + bflo(bb[u].x), bfhi(a[u].x) + bfhi(bb[u].x), bflo(a[u].y) + bflo(bb[u].y), bfhi(a[u].y) + bfhi(bb[u].y), bflo(a[u].z) + bflo(bb[u].z), bfhi(a[u].z) + bfhi(bb[u].z), bflo(a[u].w) + bflo(bb[u].w), bfhi(a[u].w) + bfhi(bb[u].w)};
            const float zz[8] = {bflo(z[u].x), bfhi(z[u].x), bflo(z[u].y), bfhi(z[u].y), bflo(z[u].z), bfhi(z[u].z), bflo(z[u].w), bfhi(z[u].w)};
            float ss = 0.f;
#pragma unroll
            for (int c = 0; c < 8; ++c) ss += o[c] * o[c];
            ss += __shfl_xor(ss, 1); ss += __shfl_xor(ss, 2); ss += __shfl_xor(ss, 4); ss += __shfl_xor(ss, 8);
            const float rn = 1.0f / sqrtf(ss * (1.f / 128.f) + EPS);
#pragma unroll
            for (int c = 0; c < 8; ++c) o[c] = o[c] * rn * w8[c] * siluf(zz[c]);
            v4u r; r.x = pk2(o[0], o[1]); r.y = pk2(o[2], o[3]); r.z = pk2(o[4], o[5]); r.w = pk2(o[6], o[7]);
            *(v4u*)(OCAT + (size_t)t * 1024 + lane * 8) = r;
        }
    }
}

struct TokRec { int e[2]; int row[2]; float gate[2]; };
DI void p7_route(Frame& F) {
    const int gw = F.vcu * NWAVES + F.wave, NGW = F.G * NWAVES, lane = F.lane, n16 = lane & 15, g = lane >> 4;
    const float* X1 = (const float*)(F.ws + WS_X1); const float* nfw = F.in[10];
    const bf16* WRH = (const bf16*)(F.ws + WS_WR); const bf16* WRL = WRH + 48 * 1024;
    bf16* HN = (bf16*)((unsigned char*)F.out + DO_HN); TokRec* TOK = (TokRec*)(F.ws + WS_TOK); unsigned* cnt = (unsigned*)(F.ws + WS_CTL) + CW_CNT;
    LAS float* lg = (LAS float*)(F.lds + F.wave * 4096);
    for (int rt = gw; rt < TT / 16; rt += NGW) {
        const int row = rt * 16 + n16; const float* xr = X1 + (size_t)row * DMODEL + 8 * g;
        float ss = 0.f;
#pragma unroll 16
        for (int i = 0; i < 32; ++i) { const f32x4 a = *(const f32x4*)(xr + 32 * i), b2 = *(const f32x4*)(xr + 32 * i + 4);
            ss += (a.x * a.x + a.y * a.y) + (a.z * a.z + a.w * a.w) + (b2.x * b2.x + b2.y * b2.y) + (b2.z * b2.z + b2.w * b2.w); }
        ss += __shfl_xor(ss, 16); ss += __shfl_xor(ss, 32);
        const float rs = 1.0f / sqrtf(ss * (1.f / DMODEL) + EPS);
        f32x4 acc[3];
#pragma unroll
        for (int q = 0; q < 3; ++q) acc[q] = (f32x4){0.f, 0.f, 0.f, 0.f};
#pragma unroll 4
        for (int i = 0; i < 32; ++i) {
            const f32x4 a = *(const f32x4*)(xr + 32 * i), b2 = *(const f32x4*)(xr + 32 * i + 4);
            const f32x4 wa = *(const f32x4*)(nfw + 32 * i + 8 * g), wb = *(const f32x4*)(nfw + 32 * i + 8 * g + 4);
            float hv[8] = {a.x * rs * wa.x, a.y * rs * wa.y, a.z * rs * wa.z, a.w * rs * wa.w, b2.x * rs * wb.x, b2.y * rs * wb.y, b2.z * rs * wb.z, b2.w * rs * wb.w};
            v4u hi, lo; unsigned hh[8], ll[8];
#pragma unroll
            for (int c = 0; c < 8; ++c) { hh[c] = f2bf(hv[c]); ll[c] = f2bf(hv[c] - __builtin_bit_cast(float, hh[c] << 16)); }
            hi.x = hh[0] | (hh[1] << 16); hi.y = hh[2] | (hh[3] << 16); hi.z = hh[4] | (hh[5] << 16); hi.w = hh[6] | (hh[7] << 16);
            lo.x = ll[0] | (ll[1] << 16); lo.y = ll[2] | (ll[3] << 16); lo.z = ll[4] | (ll[5] << 16); lo.w = ll[6] | (ll[7] << 16);
            *(v4u*)(HN + (size_t)row * DMODEL + 32 * i + 8 * g) = hi;
            const bf16x8 ah = __builtin_bit_cast(bf16x8, hi), al = __builtin_bit_cast(bf16x8, lo);
#pragma unroll
            for (int q = 0; q < 3; ++q) {
                const bf16x8 bh = *(const bf16x8*)(WRH + (size_t)(16 * q + n16) * 1024 + 32 * i + 8 * g), bl = *(const bf16x8*)(WRL + (size_t)(16 * q + n16) * 1024 + 32 * i + 8 * g);
                acc[q] = __builtin_amdgcn_mfma_f32_16x16x32_bf16(ah, bh, acc[q], 0, 0, 0);
                acc[q] = __builtin_amdgcn_mfma_f32_16x16x32_bf16(ah, bl, acc[q], 0, 0, 0);
                acc[q] = __builtin_amdgcn_mfma_f32_16x16x32_bf16(al, bh, acc[q], 0, 0, 0);
            }
        }
#pragma unroll
        for (int q = 0; q < 3; ++q)
#pragma unroll
            for (int r = 0; r < 4; ++r) lg[(4 * g + r) * 48 + 16 * q + n16] = acc[q][r];
        asm volatile("s_waitcnt lgkmcnt(0)" ::: "memory");
        if (lane < 16) {
            const LAS float* L = lg + lane * 48; const int tok = rt * 16 + lane;
            float gm = L[0]; int gs = 0;
#pragma unroll
            for (int q = 1; q < 4; ++q) if (L[q] > gm) { gm = L[q]; gs = q; }
            float gsum = 0.f;
#pragma unroll
            for (int q = 0; q < 4; ++q) gsum += __expf(L[q] - gm);
            const float gp_top = 1.0f / gsum;
            float fv[8];
#pragma unroll
            for (int q = 0; q < 8; ++q) { float v = L[4 + q]; v = (gs == 1) ? L[12 + q] : v; v = (gs == 2) ? L[20 + q] : v; v = (gs == 3) ? L[28 + q] : v; fv[q] = v; }
            float m1 = fv[0]; int i1 = 0;
#pragma unroll
            for (int q = 1; q < 8; ++q) if (fv[q] > m1) { m1 = fv[q]; i1 = q; }
            float m2 = -3.0e38f; int i2 = 0;
#pragma unroll
            for (int q = 0; q < 8; ++q) if (q != i1 && fv[q] > m2) { m2 = fv[q]; i2 = q; }
            const float e2 = __expf(m2 - m1); const float g1 = gp_top / (1.0f + e2), g2 = gp_top * e2 / (1.0f + e2);
            const int ex1 = gs * 8 + i1, ex2 = gs * 8 + i2;
            const int s1 = (int)atomicAdd(cnt + ex1, 1u), s2 = (int)atomicAdd(cnt + ex2, 1u);
            TokRec tr; tr.e[0] = ex1; tr.e[1] = ex2; tr.row[0] = s1; tr.row[1] = s2; tr.gate[0] = g1; tr.gate[1] = g2;
            TOK[tok] = tr;
        }
        asm volatile("s_waitcnt lgkmcnt(0)" ::: "memory");
    }
}

DI void p8_gather(Frame& F) {
    const int gw = F.vcu * NWAVES + F.wave, NGW = F.G * NWAVES, lane = F.lane;
    unsigned* ctl = (unsigned*)(F.ws + WS_CTL);
    LAS int* pst = (LAS int*)(F.lds);
    if (F.tid == 0) {
        int acc = 0, nt = 0;
        for (int e = 0; e < NEXP; ++e) { const int c = (int)__hip_atomic_load(ctl + CW_CNT + e, __ATOMIC_RELAXED, __HIP_MEMORY_SCOPE_AGENT); pst[e] = acc; const int ntile = (c + 255) >> 8;
            if (blockIdx.x == 0) { ctl[CW_ETAB + 2 * e] = (unsigned)(acc >> 8); ctl[CW_ETAB + 2 * e + 1] = (unsigned)ntile; }
            nt += ntile; acc += ntile * 256; }
        if (blockIdx.x == 0) ctl[CW_NTILE] = (unsigned)nt;
    }
    __syncthreads();
    const bf16* HN = (const bf16*)((unsigned char*)F.out + DO_HN); bf16* XB = (bf16*)(F.ws + WS_XBUF); TokRec* TOK = (TokRec*)(F.ws + WS_TOK);
    constexpr int NB4 = 4;
    for (int t0 = gw; t0 < TT; t0 += NB4 * NGW) {
        TokRec tr[NB4]; v4u a[NB4], b2[NB4];
#pragma unroll
        for (int u = 0; u < NB4; ++u) { const int t = (t0 + u * NGW < TT) ? t0 + u * NGW : t0; tr[u] = TOK[t];
            a[u] = *(const v4u*)(HN + (size_t)t * DMODEL + lane * 8); b2[u] = *(const v4u*)(HN + (size_t)t * DMODEL + 512 + lane * 8); }
#pragma unroll
        for (int u = 0; u < NB4; ++u) {
            const int t = t0 + u * NGW; if (t >= TT) break;
            const int r0 = pst[tr[u].e[0]] + tr[u].row[0], r1 = pst[tr[u].e[1]] + tr[u].row[1];
            *(v4u*)(XB + (size_t)r0 * DMODEL + lane * 8) = a[u]; *(v4u*)(XB + (size_t)r0 * DMODEL + 512 + lane * 8) = b2[u];
            *(v4u*)(XB + (size_t)r1 * DMODEL + lane * 8) = a[u]; *(v4u*)(XB + (size_t)r1 * DMODEL + 512 + lane * 8) = b2[u];
            if (lane == 0) { TOK[t].row[0] = r0; TOK[t].row[1] = r1; }
        }
    }
}

DI void p11_final(Frame& F) {
    const int gw = F.vcu * NWAVES + F.wave, NGW = F.G * NWAVES, lane = F.lane;
    const bf16* Y = (const bf16*)(F.ws + WS_XBUF); const TokRec* TOK = (const TokRec*)(F.ws + WS_TOK); const float* fw = F.in[16];
    const f32x4 w0 = *(const f32x4*)(fw + lane * 8), w1 = *(const f32x4*)(fw + lane * 8 + 4), w2 = *(const f32x4*)(fw + 512 + lane * 8), w3 = *(const f32x4*)(fw + 516 + lane * 8);
    constexpr int NB2 = 2;
    for (int t0 = gw; t0 < TT; t0 += NB2 * NGW) {
        TokRec tr[NB2]; f32x4 xa[NB2][4]; v4u ya[NB2][2][2];
#pragma unroll
        for (int u = 0; u < NB2; ++u) { const int t = (t0 + u * NGW < TT) ? t0 + u * NGW : t0; tr[u] = TOK[t];
            const float* xr = (const float*)(F.ws + WS_X1) + (size_t)t * DMODEL + lane * 8;
            xa[u][0] = *(const f32x4*)(xr); xa[u][1] = *(const f32x4*)(xr + 4); xa[u][2] = *(const f32x4*)(xr + 512); xa[u][3] = *(const f32x4*)(xr + 516); }
#pragma unroll
        for (int u = 0; u < NB2; ++u)
#pragma unroll
            for (int k = 0; k < 2; ++k) { const bf16* yr = Y + (size_t)tr[u].row[k] * DMODEL + lane * 8; ya[u][k][0] = *(const v4u*)(yr); ya[u][k][1] = *(const v4u*)(yr + 512); }
#pragma unroll
        for (int u = 0; u < NB2; ++u) {
            const int t = t0 + u * NGW; if (t >= TT) break;
            float v[16] = {xa[u][0].x, xa[u][0].y, xa[u][0].z, xa[u][0].w, xa[u][1].x, xa[u][1].y, xa[u][1].z, xa[u][1].w, xa[u][2].x, xa[u][2].y, xa[u][2].z, xa[u][2].w, xa[u][3].x, xa[u][3].y, xa[u][3].z, xa[u][3].w};
#pragma unroll
            for (int k = 0; k < 2; ++k) {
                const float gk = tr[u].gate[k]; const v4u y0 = ya[u][k][0], y1 = ya[u][k][1];
                v[0] += gk * bflo(y0.x); v[1] += gk * bfhi(y0.x); v[2] += gk * bflo(y0.y); v[3] += gk * bfhi(y0.y); v[4] += gk * bflo(y0.z); v[5] += gk * bfhi(y0.z); v[6] += gk * bflo(y0.w); v[7] += gk * bfhi(y0.w);
                v[8] += gk * bflo(y1.x); v[9] += gk * bfhi(y1.x); v[10] += gk * bflo(y1.y); v[11] += gk * bfhi(y1.y); v[12] += gk * bflo(y1.z); v[13] += gk * bfhi(y1.z); v[14] += gk * bflo(y1.w); v[15] += gk * bfhi(y1.w);
            }
            float ss = 0.f;
#pragma unroll
            for (int i = 0; i < 16; ++i) ss += v[i] * v[i];
            const float rs = 1.0f / sqrtf(wave_sum(ss) * (1.f / DMODEL) + EPS);
            float* orow = F.out + (size_t)t * DMODEL + lane * 8;
            *(f32x4*)(orow) = (f32x4){v[0] * rs * w0.x, v[1] * rs * w0.y, v[2] * rs * w0.z, v[3] * rs * w0.w};
            *(f32x4*)(orow + 4) = (f32x4){v[4] * rs * w1.x, v[5] * rs * w1.y, v[6] * rs * w1.z, v[7] * rs * w1.w};
            *(f32x4*)(orow + 512) = (f32x4){v[8] * rs * w2.x, v[9] * rs * w2.y, v[10] * rs * w2.z, v[11] * rs * w2.w};
            *(f32x4*)(orow + 516) = (f32x4){v[12] * rs * w3.x, v[13] * rs * w3.y, v[14] * rs * w3.z, v[15] * rs * w3.w};
        }
    }
}

struct Args { const float* in[17]; float* out; unsigned char* ws; int ph_lo, ph_hi; };
__global__ void __launch_bounds__(NTHREADS, 2) fwd_kernel(Args args) {
    extern __shared__ __attribute__((aligned(16))) unsigned char lds[];
    cg::grid_group grid = cg::this_grid();
    Frame F;
    F.lds = (LAS unsigned char*)lds; F.tid = threadIdx.x; F.lane = F.tid & 63; F.wave = __builtin_amdgcn_readfirstlane(F.tid >> 6);
    F.G = gridDim.x; { const int bx = blockIdx.x; F.vcu = (F.G % 8 == 0) ? (bx % 8) * (F.G / 8) + bx / 8 : bx; }
#pragma unroll
    for (int i = 0; i < 17; ++i) F.in[i] = args.in[i];
    F.out = args.out; F.ws = args.ws;
    const int lo = args.ph_lo, hi = args.ph_hi;
    if (F.tid < 16) ((volatile LAS unsigned*)(F.lds + MISC_OFF))[F.tid] = 0u;
    __syncthreads();
    XcdBarrier bar = xcd_barrier_post((unsigned*)(F.ws + WS_CTL) + CW_BAR, (volatile LAS unsigned*)(F.lds + MISC_OFF));
    if (lo > 1000) grid.sync();
#ifndef PHSEL
#define PHSEL 0xfff
#endif
#define IN(k) (((PHSEL >> (k)) & 1) && lo <= (k) && (k) < hi)
#define SEAM(k) do { if (IN(k) && IN((k) + 1)) xcd_barrier(bar); } while (0)
#ifndef REP_PH
#define REP_PH -1
#endif
#define REPS(k) for (int rep_ = 0; rep_ < ((k) == REP_PH ? 2 : 1); ++rep_, ((k) == REP_PH && rep_ < 2) ? xcd_barrier(bar) : (void)0)
    if (IN(0)) REPS(0) { p0_prologue(F); } SEAM(0);
    if (IN(1)) REPS(1) {
        pg8::Gemm gm{(const pg8::bf16_t*)(F.ws + WS_XN), (const pg8::bf16_t*)(F.ws + WS_WIN), TT, NPROJ, DMODEL}; pg8::StaticOrder S; S.init(TT, NPROJ, F.G, (int)blockIdx.x);
        EpiProj E{(bf16*)(F.ws + WS_QKVA), (bf16*)(F.ws + WS_ZA), (bf16*)(F.ws + WS_QKVB), (float*)(F.ws + WS_GATES)};
        pg8::gemm_phase<EpiProj, pg8::StaticOrder, true, true>(F.lds, gm, S, E);
    } SEAM(1);
    if (IN(2)) REPS(2) {
#ifndef NO_ROPE
        p2_rope(F);
#ifdef PROBE_ROPE2
        xcd_barrier(bar); p2_rope(F);
#endif
#endif
#ifndef NO_PRE
        p2_gdn_pre(F);
#ifdef PROBE_PRE2
        xcd_barrier(bar); p2_gdn_pre(F);
#endif
#endif
    } SEAM(2);
    if (IN(3)) REPS(3) {
        const attn_body::AttnTensors AT{(const attn_body::bf16*)((unsigned char*)F.out + DO_QR), (const attn_body::bf16*)((unsigned char*)F.out + DO_KR), (const attn_body::bf16*)((unsigned char*)F.out + DO_VR),
                                        (attn_body::bf16*)(F.ws + WS_OCAT) + 512};
        const attn_body::StaticOrder S((int)F.G, (int)blockIdx.x);
#ifdef PROBE_ZERO_ATTN
        { (void)AT; (void)S; bf16* OC = (bf16*)(F.ws + WS_OCAT); const int gt = blockIdx.x * NTHREADS + F.tid, GT = F.G * NTHREADS;
          for (int i = gt; i < TT * 64; i += GT) { const int t = i >> 6, c = i & 63; *(v4u*)(OC + (size_t)t * 1024 + 512 + c * 8) = (v4u){0u, 0u, 0u, 0u}; } }
#else
        attn_body::attn_phase<attn_body::StaticOrder>((char*)lds, AT, S);
#endif
    } SEAM(3);
#ifdef PROBE_SCAN2
    if (IN(4)) { p4_scan(F); xcd_barrier(bar); p4_scan(F); } SEAM(4);
#else
    if (IN(4)) REPS(4) { p4_scan(F); } SEAM(4);
#endif
    if (IN(5)) REPS(5) { p5_combine(F); if (F.G <= 128) { small_weights(F, F.vcu * NWAVES + F.wave, F.G * NWAVES); moe_weights(F, F.vcu * NWAVES + F.wave, F.G * NWAVES); } } SEAM(5);
    if (IN(6)) REPS(6) {
        pg8::Gemm gm{(const pg8::bf16_t*)(F.ws + WS_OCAT), (const pg8::bf16_t*)(F.ws + WS_WOUT), TT, DMODEL, DMODEL}; pg8::StaticOrder S; S.init(TT, DMODEL, F.G, (int)blockIdx.x);
        EpiResid E{F.in[0], (float*)(F.ws + WS_X1)};
        pg8::gemm_phase<EpiResid, pg8::StaticOrder, true, true>(F.lds, gm, S, E);
    } SEAM(6);
    if (IN(7)) { p7_route(F); } SEAM(7);
    if (IN(8)) { p8_gather(F); } SEAM(8);
    if (IN(9)) REPS(9) {
        pg8::Gemm gm{(const pg8::bf16_t*)(F.ws + WS_XBUF), (const pg8::bf16_t*)(F.ws + WS_WGU0), 0, 0, DMODEL}; MoeOrder S{(const unsigned*)(F.ws + WS_CTL), F.G, (int)blockIdx.x, WGU_SPLIT, (int)((WS_WGU1 - WS_WGU0) / (512 * 1024))};
        EpiGU E{(bf16*)(F.ws + WS_HID)};
        pg8::gemm_phase<EpiGU, MoeOrder, true, true>(F.lds, gm, S, E);
    } SEAM(9);
    if (IN(10)) REPS(10) {
        pg8::Gemm gm{(const pg8::bf16_t*)(F.ws + WS_HID), (const pg8::bf16_t*)((unsigned char*)F.out + DO_WD0), 0, 0, FFE}; MoeOrder S{(const unsigned*)(F.ws + WS_CTL), F.G, (int)blockIdx.x, WD_SPLIT, (int)((DO_WD1 - DO_WD0) / (256 * 1024))};
        EpiY E{(bf16*)(F.ws + WS_XBUF)};
        pg8::gemm_phase<EpiY, MoeOrder, true, true>(F.lds, gm, S, E);
    } SEAM(10);
#ifdef EXTRA_SYNCS
    for (int q_ = 0; q_ < EXTRA_SYNCS; ++q_) xcd_barrier(bar);
#endif
    if (IN(11)) { p11_final(F); }
#undef IN
#undef SEAM
}

extern "C" void kernel_launch(void* const* d_in, const int* in_sizes, int n_in, void* d_out, int out_size, void* d_ws, size_t ws_size, hipStream_t stream) {
    static int grid = 0;
    if (grid == 0) {
        if (n_in != 17 || out_size != TT * DMODEL || ws_size < WS_END) { fprintf(stderr, "kernel_launch: unexpected problem (n_in %d out %d ws %zu)\n", n_in, out_size, ws_size); grid = -1; return; }
        int dev = 0, cus = 0, per_cu = 0;
        if (hipGetDevice(&dev) != hipSuccess || hipDeviceGetAttribute(&cus, hipDeviceAttributeMultiprocessorCount, dev) != hipSuccess) { grid = -1; return; }
        if (hipFuncSetAttribute((const void*)fwd_kernel, hipFuncAttributeMaxDynamicSharedMemorySize, LDS_BYTES) != hipSuccess) { fprintf(stderr, "hipFuncSetAttribute failed\n"); grid = -1; return; }
        if (hipOccupancyMaxActiveBlocksPerMultiprocessor(&per_cu, (const void*)fwd_kernel, NTHREADS, LDS_BYTES) != hipSuccess || per_cu < 1) { fprintf(stderr, "occupancy query: %d\n", per_cu); grid = -1; return; }
        grid = cus;
    }
    if (grid < 0) return;
    (void)hipMemsetAsync((char*)d_ws + WS_CTL, 0, CTL_ZERO_BYTES, stream);
    Args a{};
    for (int i = 0; i < 17; ++i) a.in[i] = (const float*)d_in[i];
    a.out = (float*)d_out; a.ws = (unsigned char*)d_ws;
#if MK_PER_PHASE
    for (int p = 0; p < N_PHASES; ++p) { a.ph_lo = p; a.ph_hi = p + 1; hipLaunchKernelGGL(fwd_kernel, dim3(grid), dim3(NTHREADS), LDS_BYTES, stream, a); }
#else
    a.ph_lo = 0; a.ph_hi = N_PHASES;
    void* kargs[] = {&a};
    hipError_t e = hipLaunchCooperativeKernel((void*)fwd_kernel, dim3(grid), dim3(NTHREADS), kargs, LDS_BYTES, stream);
    if (e != hipSuccess) fprintf(stderr, "cooperative launch failed: %s (grid %d)\n", hipGetErrorString(e), grid);
#endif
}
```

```cpp
#include <hip/hip_runtime.h>
#include <cstdio>
#include <cstdint>
namespace pg8 {
#define PG8_LAS __attribute__((address_space(3)))
typedef unsigned short bf16_t;
typedef short bf16x8 __attribute__((ext_vector_type(8)));
typedef float f32x4 __attribute__((ext_vector_type(4)));
typedef unsigned u32x4 __attribute__((ext_vector_type(4)));
constexpr int BM = 256, BK = 64, HALF = 128, HTB = HALF * BK * 2  , STAGE_BYTES = 8 * HTB, NXCD = 8, WGM = 8;

__host__ __device__ __forceinline__ int lds_byte(int r, int c) { const int st = (r >> 4) * 2 + (c >> 5), rr = r & 15, cc = c & 31, ob = rr * 64 + cc * 2; return st * 1024 + (ob ^ (((ob >> 9) & 1) << 5)); }
__host__ __device__ __forceinline__ void stage_rc(int b, int& R, int& C) { const int st = b / 1024, sb = b % 1024, swz = sb ^ (((sb >> 9) & 1) << 5); R = (st >> 1) * 16 + swz / 64; C = (st & 1) * 32 + (swz % 64) / 2; }
__host__ __device__ __forceinline__ int perm32(int rho) { const int n = rho >> 4, i = rho & 15; return 8 * (i >> 2) + 4 * n + (i & 3); }

struct Unit { int pm, pn, ex, tq; };
struct Gemm { const bf16_t* A; const bf16_t* Bt; int M, N, K; };

struct StaticOrder {
    int nM, nN, nwg, G, c;
    __host__ __device__ void init(int M, int N, int G_, int c_) { nM = M / BM; nN = N / BM; nwg = nM * nN; G = G_; c = c_; }
    __host__ __device__ bool next(int i, Unit& u) const {
        const long L = (long)i * G + c; if (L >= nwg) return false;
        int wgid = (int)L; { const int q = nwg / NXCD, r = nwg % NXCD, xcd = wgid % NXCD, off = wgid / NXCD; wgid = (xcd < r ? xcd * (q + 1) : r * (q + 1) + (xcd - r) * q) + off; }
        const int nig = WGM * nN, gid = wgid / nig, fm = gid * WGM, gsz = (nM - fm) < WGM ? (nM - fm) : WGM;
        u.pm = fm + ((wgid % nig) % gsz); u.pn = (wgid % nig) / gsz; return true;
    }
    __device__ __forceinline__ void a_ready(const Unit&) const {}
    __device__ __forceinline__ void done(const Unit&) const {}
};

__device__ __forceinline__ unsigned cvt_pk_bf16(float lo, float hi) { unsigned r; asm volatile("v_cvt_pk_bf16_f32 %0, %1, %2" : "=v"(r) : "v"(lo), "v"(hi)); return r; }
typedef float f32x2 __attribute__((ext_vector_type(2)));
template <class Epi, class Sched, bool ALIGN_EPI = false, bool SP2 = false>
__device__ __forceinline__ void gemm_phase(PG8_LAS unsigned char* lds, const Gemm g, const Sched& S, const Epi& E) {
    const int tid = threadIdx.x, wid = __builtin_amdgcn_readfirstlane(tid >> 6), lane = tid & 63, wr = wid >> 2, wc = wid & 3, fr = lane & 15, fq = lane >> 4;
    const int K = g.K, nt = K / BK;
    unsigned voffA[2], voffB[2];
#pragma unroll
    for (int i = 0; i < 2; ++i) { int R, C; stage_rc(tid * 16 + i * 8192, R, C); const int Rb = Epi::PERM ? ((R & ~31) + perm32(R & 31)) : R;
        voffA[i] = (unsigned)(R * K + C) * 2u; voffB[i] = (unsigned)(Rb * K + C) * 2u; }
    const size_t kstep = (size_t)(BK * 2);
    const size_t hstep = (size_t)HALF * K * 2;
    const size_t tstep = 2 * hstep;
    const unsigned ldsw = (unsigned)wid * 1024u;
    const int aoff = lds_byte(wr * 64 + fr, fq * 8), boff = lds_byte(wc * 32 + fr, fq * 8);
#define PG8_SA(b, h) (((b) * 2 + (h)) * HTB)
#define PG8_SB(b, h) ((4 + (b) * 2 + (h)) * HTB)
#define PG8_STAGE(bufoff, gbase, voff) do { _Pragma("unroll") for (int _i = 0; _i < 2; ++_i) \
        __builtin_amdgcn_global_load_lds((const unsigned*)((const char*)(gbase) + (voff)[_i]), (PG8_LAS unsigned*)(lds + (bufoff) + ldsw + _i * 8192), 16, 0, 0); } while (0)
#define PG8_LDA(dst, b, h) do { _Pragma("unroll") for (int m = 0; m < 4; ++m) _Pragma("unroll") for (int k = 0; k < 2; ++k) dst[m][k] = *(const PG8_LAS bf16x8*)(lds + PG8_SA(b, h) + aoff + m * 2048 + k * 1024); } while (0)
#define PG8_LDB(dst, b, h) do { _Pragma("unroll") for (int n = 0; n < 2; ++n) _Pragma("unroll") for (int k = 0; k < 2; ++k) dst[n][k] = *(const PG8_LAS bf16x8*)(lds + PG8_SB(b, h) + boff + n * 2048 + k * 1024); } while (0)
#define PG8_MMA(ai, bj, At, Bt) do { __builtin_amdgcn_s_setprio(1); _Pragma("unroll") for (int m = 0; m < 4; ++m) _Pragma("unroll") for (int n = 0; n < 2; ++n) _Pragma("unroll") for (int k = 0; k < 2; ++k) \
        acc[ai][bj][m][n] = __builtin_amdgcn_mfma_f32_16x16x32_bf16(Bt[n][k], At[m][k], acc[ai][bj][m][n], 0, 0, 0); __builtin_amdgcn_s_setprio(0); } while (0)
#define PG8_WAIT_V(n) asm volatile("s_waitcnt vmcnt(" #n ")" ::: "memory")
#define PG8_WAIT_L(n) asm volatile("s_waitcnt lgkmcnt(" #n ")" ::: "memory")
#define PG8_BAR __builtin_amdgcn_s_barrier()
#define PG8_SCHED __builtin_amdgcn_sched_barrier(0)
    Unit cur, nxt; int ui = 0;
    if (!S.next(0, cur)) return;
    f32x4 acc[2][2][4][2];
#pragma unroll
    for (int a = 0; a < 2; ++a)
#pragma unroll
        for (int b = 0; b < 2; ++b)
#pragma unroll
            for (int m = 0; m < 4; ++m)
#pragma unroll
                for (int n = 0; n < 2; ++n) acc[a][b][m][n] = (f32x4){0.f, 0.f, 0.f, 0.f};
    bf16x8 At[4][2], B0[2][2], B1[2][2];
    const char* cA = (const char*)g.A + (size_t)cur.pm * tstep; const char* cB = (const char*)g.Bt + (size_t)cur.pn * tstep;
    S.a_ready(cur);
    if constexpr (SP2) {
        PG8_STAGE(PG8_SB(0, 0), cB, voffB); PG8_STAGE(PG8_SB(0, 1), cB + hstep, voffB); PG8_STAGE(PG8_SA(0, 0), cA, voffA); PG8_STAGE(PG8_SA(0, 1), cA + hstep, voffA);
        if (wr == 1) PG8_BAR;
        PG8_WAIT_V(2); PG8_BAR;
        PG8_STAGE(PG8_SB(1, 0), cB + kstep, voffB); PG8_STAGE(PG8_SA(1, 0), cA + kstep, voffA); PG8_STAGE(PG8_SB(1, 1), cB + hstep + kstep, voffB);
        PG8_WAIT_V(6); PG8_BAR;
    } else {
        PG8_STAGE(PG8_SB(0, 0), cB, voffB); PG8_STAGE(PG8_SA(0, 0), cA, voffA); PG8_STAGE(PG8_SB(0, 1), cB + hstep, voffB); PG8_STAGE(PG8_SA(0, 1), cA + hstep, voffA);
        if (wr == 1) PG8_BAR;
        PG8_WAIT_V(4); PG8_BAR;
        PG8_STAGE(PG8_SB(1, 0), cB + kstep, voffB); PG8_STAGE(PG8_SA(1, 0), cA + kstep, voffA); PG8_STAGE(PG8_SB(1, 1), cB + hstep + kstep, voffB);
        PG8_WAIT_V(6); PG8_BAR;
    }
    for (;;) {
        const bool has_next = S.next(ui + 1, nxt);
        const char* nA = has_next ? (const char*)g.A + (size_t)nxt.pm * tstep : cA; const char* nB = has_next ? (const char*)g.Bt + (size_t)nxt.pn * tstep : cB;
        for (int t = 0; t < nt; t += 2) {
            const bool last = (t == nt - 2);
            const char* a1 = cA + (size_t)(t + 1) * kstep;
            const char* a2 = last ? nA : cA + (size_t)(t + 2) * kstep; const char* b2 = last ? nB : cB + (size_t)(t + 2) * kstep;
            const char* a3 = a2 + kstep; const char* b3 = b2 + kstep;
            if (last && has_next) S.a_ready(nxt);
            if constexpr (SP2) {
            PG8_LDB(B0, 0, 0); PG8_LDB(B1, 0, 1); PG8_SCHED; PG8_LDA(At, 0, 0); PG8_STAGE(PG8_SA(1, 1), a1 + hstep, voffA);
            PG8_WAIT_V(8); PG8_WAIT_L(0); PG8_BAR; PG8_MMA(0, 0, At, B0); PG8_MMA(0, 1, At, B1); PG8_BAR; PG8_SCHED;
            PG8_LDA(At, 0, 1); PG8_STAGE(PG8_SB(0, 0), b2, voffB); PG8_STAGE(PG8_SB(0, 1), b2 + hstep, voffB); PG8_STAGE(PG8_SA(0, 0), a2, voffA);
            PG8_WAIT_V(8); PG8_WAIT_L(0); PG8_BAR; PG8_MMA(1, 0, At, B0); PG8_MMA(1, 1, At, B1); PG8_BAR; PG8_SCHED;
            PG8_LDB(B0, 1, 0); PG8_LDB(B1, 1, 1); PG8_SCHED; PG8_LDA(At, 1, 0); PG8_STAGE(PG8_SA(0, 1), a2 + hstep, voffA);
            PG8_WAIT_V(8); PG8_WAIT_L(0); PG8_BAR; PG8_MMA(0, 0, At, B0); PG8_MMA(0, 1, At, B1); PG8_BAR; PG8_SCHED;
            PG8_LDA(At, 1, 1); PG8_STAGE(PG8_SB(1, 0), b3, voffB); PG8_STAGE(PG8_SB(1, 1), b3 + hstep, voffB); PG8_STAGE(PG8_SA(1, 0), a3, voffA);
            PG8_WAIT_V(8); PG8_WAIT_L(0); PG8_BAR; PG8_MMA(1, 0, At, B0); PG8_MMA(1, 1, At, B1); PG8_BAR; PG8_SCHED;
            } else {
            PG8_LDB(B0, 0, 0); PG8_SCHED; PG8_LDA(At, 0, 0); PG8_STAGE(PG8_SA(1, 1), a1 + hstep, voffA);
            PG8_WAIT_L(8); PG8_BAR; PG8_WAIT_L(0); PG8_MMA(0, 0, At, B0); PG8_BAR; PG8_SCHED;
            PG8_LDB(B1, 0, 1); PG8_STAGE(PG8_SB(0, 0), b2, voffB);
            PG8_BAR; PG8_WAIT_L(0); PG8_MMA(0, 1, At, B1); PG8_BAR;
            PG8_LDA(At, 0, 1); PG8_STAGE(PG8_SA(0, 0), a2, voffA);
            PG8_BAR; PG8_WAIT_L(0); PG8_MMA(1, 0, At, B0); PG8_BAR; PG8_SCHED;
            PG8_STAGE(PG8_SB(0, 1), b2 + hstep, voffB);
            PG8_WAIT_V(6); PG8_BAR; PG8_MMA(1, 1, At, B1); PG8_BAR;
            PG8_LDB(B0, 1, 0); PG8_SCHED; PG8_LDA(At, 1, 0); PG8_STAGE(PG8_SA(0, 1), a2 + hstep, voffA);
            PG8_WAIT_L(8); PG8_BAR; PG8_WAIT_L(0); PG8_MMA(0, 0, At, B0); PG8_BAR; PG8_SCHED;
            PG8_LDB(B1, 1, 1); PG8_STAGE(PG8_SB(1, 0), b3, voffB);
            PG8_BAR; PG8_WAIT_L(0); PG8_MMA(0, 1, At, B1); PG8_BAR;
            PG8_LDA(At, 1, 1); PG8_STAGE(PG8_SA(1, 0), a3, voffA);
            PG8_BAR; PG8_WAIT_L(0); PG8_MMA(1, 0, At, B0); PG8_BAR; PG8_SCHED;
            PG8_STAGE(PG8_SB(1, 1), b3 + hstep, voffB);
            PG8_WAIT_V(6); PG8_BAR; PG8_MMA(1, 1, At, B1); PG8_BAR;
            }
        }
        if constexpr (ALIGN_EPI) { if (wr == 0) PG8_BAR; }
        if constexpr (!Epi::AFTER_DRAIN) { E(acc, cur, wr, wc, fr, fq); S.done(cur); }
        if (!has_next) break;
#pragma unroll
        for (int a = 0; a < 2; ++a)
#pragma unroll
            for (int b = 0; b < 2; ++b)
#pragma unroll
                for (int m = 0; m < 4; ++m)
#pragma unroll
                    for (int n = 0; n < 2; ++n) acc[a][b][m][n] = (f32x4){0.f, 0.f, 0.f, 0.f};
        cur = nxt; cA = nA; cB = nB; ++ui;
        if constexpr (ALIGN_EPI) { if (wr == 1) PG8_BAR; }
    }
    PG8_WAIT_V(0);
    if constexpr (!ALIGN_EPI) { if (wr == 0) PG8_BAR; }
    PG8_BAR;
    if constexpr (Epi::AFTER_DRAIN) { E.fused(acc, cur, wr, wc, fr, fq, lds, wid, lane); S.done(cur); }
#undef PG8_SA
#undef PG8_SB
#undef PG8_STAGE
#undef PG8_LDA
#undef PG8_LDB
#undef PG8_MMA
#undef PG8_WAIT_V
#undef PG8_WAIT_L
#undef PG8_BAR
#undef PG8_SCHED
}
template <class Epi, class Sched, class AMap, bool ALIGN_EPI = false>
__device__ __forceinline__ void gemm_phase_gather(PG8_LAS unsigned char* lds, const Gemm g, const Sched& S, const Epi& E, const AMap& AM) {
    constexpr bool SP2 = true;
    const int tid = threadIdx.x, wid = __builtin_amdgcn_readfirstlane(tid >> 6), lane = tid & 63, wr = wid >> 2, wc = wid & 3, fr = lane & 15, fq = lane >> 4;
    const int K = g.K, nt = K / BK;
    unsigned voffA[2], voffB[2]; int rowA[2];
#pragma unroll
    for (int i = 0; i < 2; ++i) { int R, C; stage_rc(tid * 16 + i * 8192, R, C); const int Rb = Epi::PERM ? ((R & ~31) + perm32(R & 31)) : R;
        voffA[i] = (unsigned)C * 2u; voffB[i] = (unsigned)(Rb * K + C) * 2u; rowA[i] = R; }
    const size_t kstep = (size_t)(BK * 2);
    const size_t hstep = (size_t)HALF * K * 2;
    const size_t tstep = 2 * hstep;
    const unsigned ldsw = (unsigned)wid * 1024u;
    const int aoff = lds_byte(wr * 64 + fr, fq * 8), boff = lds_byte(wc * 32 + fr, fq * 8);
#define PG8_SA(b, h) (((b) * 2 + (h)) * HTB)
#define PG8_SB(b, h) ((4 + (b) * 2 + (h)) * HTB)
#define PG8_STAGE(bufoff, gbase, voff) do { _Pragma("unroll") for (int _i = 0; _i < 2; ++_i) \
        __builtin_amdgcn_global_load_lds((const unsigned*)((const char*)(gbase) + (voff)[_i]), (PG8_LAS unsigned*)(lds + (bufoff) + ldsw + _i * 8192), 16, 0, 0); } while (0)
#define PG8_LDA(dst, b, h) do { _Pragma("unroll") for (int m = 0; m < 4; ++m) _Pragma("unroll") for (int k = 0; k < 2; ++k) dst[m][k] = *(const PG8_LAS bf16x8*)(lds + PG8_SA(b, h) + aoff + m * 2048 + k * 1024); } while (0)
#define PG8_LDB(dst, b, h) do { _Pragma("unroll") for (int n = 0; n < 2; ++n) _Pragma("unroll") for (int k = 0; k < 2; ++k) dst[n][k] = *(const PG8_LAS bf16x8*)(lds + PG8_SB(b, h) + boff + n * 2048 + k * 1024); } while (0)
#define PG8_MMA(ai, bj, At, Bt) do { __builtin_amdgcn_s_setprio(1); _Pragma("unroll") for (int m = 0; m < 4; ++m) _Pragma("unroll") for (int n = 0; n < 2; ++n) _Pragma("unroll") for (int k = 0; k < 2; ++k) \
        acc[ai][bj][m][n] = __builtin_amdgcn_mfma_f32_16x16x32_bf16(Bt[n][k], At[m][k], acc[ai][bj][m][n], 0, 0, 0); __builtin_amdgcn_s_setprio(0); } while (0)
#define PG8_WAIT_V(n) asm volatile("s_waitcnt vmcnt(" #n ")" ::: "memory")
#define PG8_WAIT_L(n) asm volatile("s_waitcnt lgkmcnt(" #n ")" ::: "memory")
#define PG8_BAR __builtin_amdgcn_s_barrier()
#define PG8_SCHED __builtin_amdgcn_sched_barrier(0)
    Unit cur, nxt; int ui = 0;
    if (!S.next(0, cur)) return;
    f32x4 acc[2][2][4][2];
#pragma unroll
    for (int a = 0; a < 2; ++a)
#pragma unroll
        for (int b = 0; b < 2; ++b)
#pragma unroll
            for (int m = 0; m < 4; ++m)
#pragma unroll
                for (int n = 0; n < 2; ++n) acc[a][b][m][n] = (f32x4){0.f, 0.f, 0.f, 0.f};
    bf16x8 At[4][2], B0[2][2], B1[2][2];
    const char* cA = (const char*)g.A; const char* cB = (const char*)g.Bt + (size_t)cur.pn * tstep;
    unsigned vA0[2], vA1[2], nA0[2], nA1[2];
#pragma unroll
    for (int i = 0; i < 2; ++i) { vA0[i] = (unsigned)AM.row(cur, rowA[i]) * (unsigned)(K * 2) + voffA[i]; vA1[i] = (unsigned)AM.row(cur, HALF + rowA[i]) * (unsigned)(K * 2) + voffA[i]; }
    S.a_ready(cur);
    if constexpr (SP2) {
        PG8_STAGE(PG8_SB(0, 0), cB, voffB); PG8_STAGE(PG8_SB(0, 1), cB + hstep, voffB); PG8_STAGE(PG8_SA(0, 0), cA, vA0); PG8_STAGE(PG8_SA(0, 1), cA, vA1);
        if (wr == 1) PG8_BAR;
        PG8_WAIT_V(2); PG8_BAR;
        PG8_STAGE(PG8_SB(1, 0), cB + kstep, voffB); PG8_STAGE(PG8_SA(1, 0), cA + kstep, vA0); PG8_STAGE(PG8_SB(1, 1), cB + hstep + kstep, voffB);
        PG8_WAIT_V(6); PG8_BAR;
    } else {
        PG8_STAGE(PG8_SB(0, 0), cB, voffB); PG8_STAGE(PG8_SA(0, 0), cA, voffA); PG8_STAGE(PG8_SB(0, 1), cB + hstep, voffB); PG8_STAGE(PG8_SA(0, 1), cA + hstep, voffA);
        if (wr == 1) PG8_BAR;
        PG8_WAIT_V(4); PG8_BAR;
        PG8_STAGE(PG8_SB(1, 0), cB + kstep, voffB); PG8_STAGE(PG8_SA(1, 0), cA + kstep, voffA); PG8_STAGE(PG8_SB(1, 1), cB + hstep + kstep, voffB);
        PG8_WAIT_V(6); PG8_BAR;
    }
    for (;;) {
        const bool has_next = S.next(ui + 1, nxt);
        const char* nA = cA; const char* nB = has_next ? (const char*)g.Bt + (size_t)nxt.pn * tstep : cB;
#pragma unroll
        for (int i = 0; i < 2; ++i) { nA0[i] = has_next ? (unsigned)AM.row(nxt, rowA[i]) * (unsigned)(K * 2) + voffA[i] : vA0[i]; nA1[i] = has_next ? (unsigned)AM.row(nxt, HALF + rowA[i]) * (unsigned)(K * 2) + voffA[i] : vA1[i]; }
        for (int t = 0; t < nt; t += 2) {
            const bool last = (t == nt - 2);
            const char* a1 = cA + (size_t)(t + 1) * kstep;
            const char* a2 = last ? nA : cA + (size_t)(t + 2) * kstep; const char* b2 = last ? nB : cB + (size_t)(t + 2) * kstep;
            const char* a3 = a2 + kstep; const char* b3 = b2 + kstep;
            unsigned s0[2], s1[2];
#pragma unroll
            for (int i = 0; i < 2; ++i) { s0[i] = vA0[i]; s1[i] = vA1[i]; }
            if (last) {
#pragma unroll
                for (int i = 0; i < 2; ++i) { unsigned t0_ = nA0[i], t1_ = nA1[i]; asm volatile("" : "+v"(t0_), "+v"(t1_)); s0[i] = t0_; s1[i] = t1_; } }
            if (last && has_next) S.a_ready(nxt);
            if constexpr (SP2) {
            PG8_LDB(B0, 0, 0); PG8_LDB(B1, 0, 1); PG8_SCHED; PG8_LDA(At, 0, 0); PG8_STAGE(PG8_SA(1, 1), a1, vA1);
            PG8_WAIT_V(8); PG8_WAIT_L(0); PG8_BAR; PG8_MMA(0, 0, At, B0); PG8_MMA(0, 1, At, B1); PG8_BAR; PG8_SCHED;
            PG8_LDA(At, 0, 1); PG8_STAGE(PG8_SB(0, 0), b2, voffB); PG8_STAGE(PG8_SB(0, 1), b2 + hstep, voffB); PG8_STAGE(PG8_SA(0, 0), a2, s0);
            PG8_WAIT_V(8); PG8_WAIT_L(0); PG8_BAR; PG8_MMA(1, 0, At, B0); PG8_MMA(1, 1, At, B1); PG8_BAR; PG8_SCHED;
            PG8_LDB(B0, 1, 0); PG8_LDB(B1, 1, 1); PG8_SCHED; PG8_LDA(At, 1, 0); PG8_STAGE(PG8_SA(0, 1), a2, s1);
            PG8_WAIT_V(8); PG8_WAIT_L(0); PG8_BAR; PG8_MMA(0, 0, At, B0); PG8_MMA(0, 1, At, B1); PG8_BAR; PG8_SCHED;
            PG8_LDA(At, 1, 1); PG8_STAGE(PG8_SB(1, 0), b3, voffB); PG8_STAGE(PG8_SB(1, 1), b3 + hstep, voffB); PG8_STAGE(PG8_SA(1, 0), a3, s0);
            PG8_WAIT_V(8); PG8_WAIT_L(0); PG8_BAR; PG8_MMA(1, 0, At, B0); PG8_MMA(1, 1, At, B1); PG8_BAR; PG8_SCHED;
            } else {
            PG8_LDB(B0, 0, 0); PG8_SCHED; PG8_LDA(At, 0, 0); PG8_STAGE(PG8_SA(1, 1), a1 + hstep, voffA);
            PG8_WAIT_L(8); PG8_BAR; PG8_WAIT_L(0); PG8_MMA(0, 0, At, B0); PG8_BAR; PG8_SCHED;
            PG8_LDB(B1, 0, 1); PG8_STAGE(PG8_SB(0, 0), b2, voffB);
            PG8_BAR; PG8_WAIT_L(0); PG8_MMA(0, 1, At, B1); PG8_BAR;
            PG8_LDA(At, 0, 1); PG8_STAGE(PG8_SA(0, 0), a2, voffA);
            PG8_BAR; PG8_WAIT_L(0); PG8_MMA(1, 0, At, B0); PG8_BAR; PG8_SCHED;
            PG8_STAGE(PG8_SB(0, 1), b2 + hstep, voffB);
            PG8_WAIT_V(6); PG8_BAR; PG8_MMA(1, 1, At, B1); PG8_BAR;
            PG8_LDB(B0, 1, 0); PG8_SCHED; PG8_LDA(At, 1, 0); PG8_STAGE(PG8_SA(0, 1), a2 + hstep, voffA);
            PG8_WAIT_L(8); PG8_BAR; PG8_WAIT_L(0); PG8_MMA(0, 0, At, B0); PG8_BAR; PG8_SCHED;
            PG8_LDB(B1, 1, 1); PG8_STAGE(PG8_SB(1, 0), b3, voffB);
            PG8_BAR; PG8_WAIT_L(0); PG8_MMA(0, 1, At, B1); PG8_BAR;
            PG8_LDA(At, 1, 1); PG8_STAGE(PG8_SA(1, 0), a3, voffA);
            PG8_BAR; PG8_WAIT_L(0); PG8_MMA(1, 0, At, B0); PG8_BAR; PG8_SCHED;
            PG8_STAGE(PG8_SB(1, 1), b3 + hstep, voffB);
            PG8_WAIT_V(6); PG8_BAR; PG8_MMA(1, 1, At, B1); PG8_BAR;
            }
        }
        if constexpr (ALIGN_EPI) { if (wr == 0) PG8_BAR; }
        if constexpr (!Epi::AFTER_DRAIN) { E(acc, cur, wr, wc, fr, fq); S.done(cur); }
        if (!has_next) break;
#pragma unroll
        for (int a = 0; a < 2; ++a)
#pragma unroll
            for (int b = 0; b < 2; ++b)
#pragma unroll
                for (int m = 0; m < 4; ++m)
#pragma unroll
                    for (int n = 0; n < 2; ++n) acc[a][b][m][n] = (f32x4){0.f, 0.f, 0.f, 0.f};
        cur = nxt; cA = nA; cB = nB; ++ui;
#pragma unroll
        for (int i = 0; i < 2; ++i) { vA0[i] = nA0[i]; vA1[i] = nA1[i]; }
        if constexpr (ALIGN_EPI) { if (wr == 1) PG8_BAR; }
    }
    PG8_WAIT_V(0);
    if constexpr (!ALIGN_EPI) { if (wr == 0) PG8_BAR; }
    PG8_BAR;
    if constexpr (Epi::AFTER_DRAIN) { E.fused(acc, cur, wr, wc, fr, fq, lds, wid, lane); S.done(cur); }
#undef PG8_SA
#undef PG8_SB
#undef PG8_STAGE
#undef PG8_LDA
#undef PG8_LDB
#undef PG8_MMA
#undef PG8_WAIT_V
#undef PG8_WAIT_L
#undef PG8_BAR
#undef PG8_SCHED
}
}
#include <hip/hip_bf16.h>
#include <cmath>
namespace attn_body {
using bf16=__hip_bfloat16;
using bf16x8=__attribute__((ext_vector_type(8)))short;
using s16x4=__attribute__((ext_vector_type(4)))short;
using f32x16=__attribute__((ext_vector_type(16)))float;
using u32x4=__attribute__((ext_vector_type(4)))unsigned;
constexpr int BATCH=2,NHEAD=8,NKVH=2,SEQ=8192,D=64,QP=512,KP=128,OP=1024;
constexpr int NW=8,QBLK=32,QB=QBLK*NW,KVBLK=64,NQB=SEQ/QB;
constexpr int ATTN_UNIT_ROWS=QB;
__device__ __forceinline__ int crow(int r,int hi){return (r&3)+8*(r>>2)+4*hi;}
#define SBAR() __builtin_amdgcn_sched_barrier(0)
__device__ __forceinline__ void cmask(f32x16&p0,f32x16&p1,int jb,int qrel,int hi){
  const float NEG=-INFINITY; int kb=64*jb+4*hi;
  #pragma unroll
  for(int r=0;r<16;++r){int kv=kb+(r&3)+8*(r>>2); if(kv>qrel)p0[r]=NEG; if(kv+32>qrel)p1[r]=NEG;}
}

constexpr int NSLOT=3, SLOTB=8192;
constexpr int LDS_K=0, LDS_V=NSLOT*SLOTB, LDS_WS=2*NSLOT*SLOTB, LDS_OST=LDS_WS+NW*64*4, LDS_BYTES=LDS_OST+NW*4096;
constexpr float C2=0.125f*1.4426950408889634f;
__device__ __forceinline__ void glds16(const void*gsrc,unsigned lds_dst){unsigned keep;
  asm volatile("s_mov_b32 %0, m0\n\ts_mov_b32 m0, %2\n\ts_nop 0\n\tglobal_load_lds_dwordx4 %1, off\n\ts_mov_b32 m0, %0":"=&s"(keep):"v"(gsrc),"s"(lds_dst):"memory");}
__device__ __forceinline__ float max3f(float a,float b,float c){float r;asm("v_max3_f32 %0, %1, %2, %3":"=v"(r):"v"(a),"v"(b),"v"(c));return r;}
__device__ __forceinline__ float max2f(float a,float b){float r;asm("v_max_f32_e32 %0, %1, %2":"=v"(r):"v"(a),"v"(b));return r;}
__device__ __forceinline__ float fadd_s(float a,float b){float r;asm("v_add_f32_e32 %0, %1, %2":"=v"(r):"v"(a),"v"(b));return r;}
__device__ __forceinline__ float fsub_s(float a,float b){float r;asm("v_sub_f32_e32 %0, %1, %2":"=v"(r):"v"(a),"v"(b));return r;}
typedef float f32x2_t __attribute__((ext_vector_type(2))); typedef __bf16 bf16x2_t __attribute__((ext_vector_type(2)));
__device__ __forceinline__ unsigned cvtpk_s(float lo,float hi){f32x2_t v={lo,hi};bf16x2_t b=__builtin_convertvector(v,bf16x2_t);return __builtin_bit_cast(unsigned,b);}
#define WAIT_BAR(N) asm volatile("s_waitcnt vmcnt(" #N ") lgkmcnt(0)\n\ts_barrier":::"memory")

__device__ __forceinline__ void qkt(f32x16&p0,f32x16&p1,const char*Kslot,const bf16x8*qr,const f32x16&negm,int r32,int hi){
  const char*kb=Kslot+hi*1024+r32*16;
  #pragma unroll
  for(int d0=0;d0<4;++d0){
    const bf16x8 b0=*reinterpret_cast<const bf16x8*>(kb+d0*2048);
    const bf16x8 b1=*reinterpret_cast<const bf16x8*>(kb+d0*2048+512);
    if(d0==0){p0=__builtin_amdgcn_mfma_f32_32x32x16_bf16(b0,qr[0],negm,0,0,0);p1=__builtin_amdgcn_mfma_f32_32x32x16_bf16(b1,qr[0],negm,0,0,0);}
    else{p0=__builtin_amdgcn_mfma_f32_32x32x16_bf16(b0,qr[d0],p0,0,0,0);p1=__builtin_amdgcn_mfma_f32_32x32x16_bf16(b1,qr[d0],p1,0,0,0);}}
}
typedef __attribute__((address_space(3))) const char* lds_cptr;
typedef short v4i16_t __attribute__((ext_vector_type(4)));
__device__ __forceinline__ void kload8(bf16x8*kf,lds_cptr kp){
  kf[0]=*(const __attribute__((address_space(3))) bf16x8*)(kp);      kf[1]=*(const __attribute__((address_space(3))) bf16x8*)(kp+512);
  kf[2]=*(const __attribute__((address_space(3))) bf16x8*)(kp+2048); kf[3]=*(const __attribute__((address_space(3))) bf16x8*)(kp+2560);
  kf[4]=*(const __attribute__((address_space(3))) bf16x8*)(kp+4096); kf[5]=*(const __attribute__((address_space(3))) bf16x8*)(kp+4608);
  kf[6]=*(const __attribute__((address_space(3))) bf16x8*)(kp+6144); kf[7]=*(const __attribute__((address_space(3))) bf16x8*)(kp+6656);
}
__device__ __forceinline__ void kload2(bf16x8*kf,lds_cptr kp,int j){ kf[2*j]=*(const __attribute__((address_space(3))) bf16x8*)(kp+j*2048); kf[2*j+1]=*(const __attribute__((address_space(3))) bf16x8*)(kp+j*2048+512); }
__device__ __forceinline__ s16x4 vtr(lds_cptr p){ return __builtin_bit_cast(s16x4,__builtin_amdgcn_ds_read_tr16_b64_v4i16((__attribute__((address_space(3))) v4i16_t*)p)); }
__device__ __forceinline__ float rowmax(const f32x16&p0,const f32x16&p1){
  float a=max3f(p0[0],p0[1],p1[0]),b=max3f(p0[2],p0[3],p1[1]);a=max3f(a,p1[2],p1[3]);
  #pragma unroll
  for(int r=4;r<16;r+=4){a=max3f(a,p0[r],p0[r+1]);b=max3f(b,p0[r+2],p0[r+3]);a=max3f(a,p1[r],p1[r+1]);b=max3f(b,p1[r+2],p1[r+3]);}
  const float m=max2f(a,b);
  auto rr=__builtin_amdgcn_permlane32_swap(__float_as_uint(m),__float_as_uint(m),false,false);
  return max2f(__uint_as_float(rr[0]),__uint_as_float(rr[1]));
}
__device__ __forceinline__ void pv(f32x16*o,int vb,bf16x8 pa0,bf16x8 pa1,bf16x8 pa2,bf16x8 pa3){
  #pragma unroll
  for(int d0=0;d0<2;++d0){s16x4 lo[4],hi[4];
    #pragma unroll
    for(int ks=0;ks<4;++ks){
      asm volatile("ds_read_b64_tr_b16 %0,%1 offset:%c2":"=&v"(lo[ks]):"v"(vb),"i"(d0*4096+ks*1024):"memory");
      asm volatile("ds_read_b64_tr_b16 %0,%1 offset:%c2":"=&v"(hi[ks]):"v"(vb),"i"(d0*4096+ks*1024+512):"memory");}
    asm volatile("s_waitcnt lgkmcnt(0)":::"memory");SBAR();
    #define PK(k) (bf16x8){lo[k][0],lo[k][1],lo[k][2],lo[k][3],hi[k][0],hi[k][1],hi[k][2],hi[k][3]}
    o[d0]=__builtin_amdgcn_mfma_f32_32x32x16_bf16(pa0,PK(0),o[d0],0,0,0);
    o[d0]=__builtin_amdgcn_mfma_f32_32x32x16_bf16(pa1,PK(1),o[d0],0,0,0);
    o[d0]=__builtin_amdgcn_mfma_f32_32x32x16_bf16(pa2,PK(2),o[d0],0,0,0);
    o[d0]=__builtin_amdgcn_mfma_f32_32x32x16_bf16(pa3,PK(3),o[d0],0,0,0);
    #undef PK
  }
}

#ifndef ATTN_STORE16
#define ATTN_STORE16(p,v) (*(u32x4*)(p)=(v))
#endif
template<int THRL> __device__ __forceinline__ void attn_unit(int b,int h,int qb,const bf16*Q,const bf16*__restrict__ K,const bf16*__restrict__ V,bf16*O,char*shm){
  const int tid=threadIdx.x,lane=tid&63,r32=lane&31,hi=lane>>5; const int wid=__builtin_amdgcn_readfirstlane(tid>>6);
  const long rowbase=(long)b*SEQ; const int q0=qb*QB;
  const bf16*Qw=Q+(rowbase+q0+wid*QBLK)*QP+h*D;
  const int hk=h/(NHEAD/NKVH); const bf16*Kh=K+rowbase*KP+hk*D,*Vh=V+rowbase*KP+hk*D;
  const unsigned lds0=(unsigned)(uintptr_t)shm;
  float*wsf=(float*)(shm+LDS_WS)+wid*64;
  const bf16*ksrc=Kh+(long)lane*KP+wid*8;
  const bf16*vsrc=Vh+(long)(16*(wid&3)+(lane>>2))*KP+(wid>>2)*32+(lane&3)*8;
  const unsigned kdst=lds0+LDS_K+wid*1024, vdst=lds0+LDS_V+wid*1024;
  #define DMA_K(t,slot) glds16(ksrc+(long)(t)*KVBLK*KP,(unsigned)__builtin_amdgcn_readfirstlane(kdst+(slot)))
  #define DMA_V(t,slot) glds16(vsrc+(long)(t)*KVBLK*KP,(unsigned)__builtin_amdgcn_readfirstlane(vdst+(slot)))
  const int vb0=(int)(lds0+LDS_V)+((lane>>4)&1)*32+(lane&3)*8+(4*hi+((lane&15)>>2))*64;
  const char*Kbase=shm+LDS_K; bf16x8 kf[8];
  const lds_cptr shm3=(lds_cptr)shm; const lds_cptr kp0=shm3+LDS_K+hi*1024+r32*16; const lds_cptr vp0=shm3+LDS_V+((lane>>4)&1)*32+(lane&3)*8+(4*hi+((lane&15)>>2))*64;
  constexpr int NT=SEQ/KVBLK;
  DMA_K(0,0);DMA_V(0,0);DMA_K(1,SLOTB);
  bf16x8 qr[4];
  #pragma unroll
  for(int d0=0;d0<4;++d0)qr[d0]=*reinterpret_cast<const bf16x8*>(&Qw[(long)r32*QP+d0*16+hi*8]);
  float mhat=0.f,l_reg=0.f;f32x16 o[2];o[0]=f32x16{};o[1]=f32x16{};f32x16 negm=f32x16{};asm volatile("":"+v"(negm));
  const int qrel=wid*QBLK+r32;
  #define CMASK(P0,P1,t) do{}while(0)
  bool resc=false;
  #define START(P0,P1) do{ const float rm=rowmax(P0,P1); resc=false; \
    { const float dl=rm; mhat=fadd_s(mhat,dl); \
      _Pragma("unroll") for(int r=0;r<16;++r){P0[r]=fsub_s(P0[r],dl);P1[r]=fsub_s(P1[r],dl);} \
      _Pragma("unroll") for(int r=0;r<16;++r)negm[r]=-mhat; asm volatile("":"+v"(negm)); } \
    _Pragma("unroll") for(int r=0;r<16;++r)P0[r]=__builtin_amdgcn_exp2f(P0[r]); }while(0)
  #define RESC() do{ if(resc){ asm volatile("s_waitcnt lgkmcnt(0)":::"memory"); \
      _Pragma("unroll") for(int d_=0;d_<2;++d_) _Pragma("unroll") for(int r=0;r<16;++r)o[d_][r]*=wsf[crow(r,hi)]; } }while(0)
  f32x16 pA0,pA1,pB0,pB1;
  int sl_prev=0,sl_cur=0,sl_next=SLOTB;
  #define ROT() do{sl_prev=sl_cur;sl_cur=sl_next;sl_next=(sl_next==(NSLOT-1)*SLOTB)?0:sl_next+SLOTB;}while(0)
  DMA_K(2,2*SLOTB);
  WAIT_BAR(3);
  qkt(pA0,pA1,Kbase,qr,negm,r32,hi);asm volatile("s_nop 15\n\ts_nop 7":"+v"(pA0),"+v"(pA1));CMASK(pA0,pA1,0);
  START(pA0,pA1);
  _Pragma("unroll") for(int r=0;r<16;++r)pA1[r]=__builtin_amdgcn_exp2f(pA1[r]);
  WAIT_BAR(0);
  DMA_K(3,0);DMA_V(1,SLOTB);
  ROT();
  kload8(kf,kp0+sl_cur);
  WAIT_BAR(2);
  s16x4 vlo[8],vhi[8]; u32x4 pw0,pw1,pw2,pw3;
  #define PKW(P,B) cvtpk_s(P[B],P[B+1])
  #define PAF(k) __builtin_bit_cast(bf16x8,pw##k)
  #define VFR(i) (bf16x8){vlo[i][0],vlo[i][1],vlo[i][2],vlo[i][3],vhi[i][0],vhi[i][1],vhi[i][2],vhi[i][3]}
  #define PIN(x) asm volatile("":"+v"(x))
  #define MX3(a,b,c) __builtin_fmaxf(__builtin_fmaxf((a),(b)),(c))
  #define GAPA(MF,A0,A1,A2,A3,W0,W1,PW) do{ MF; sacc+=A0; sacc+=A1; sacc+=A2; sacc+=A3; PIN(sacc); W0; W1; PIN(PW); SBAR(); }while(0)
  #define EX(v) __builtin_amdgcn_exp2f(v)
  #define GAPB(MF,X,B) do{ MF; X[B]=EX(X[B]); X[B+1]=EX(X[B+1]); X[B+2]=EX(X[B+2]); X[B+3]=EX(X[B+3]); PIN(X); SBAR(); }while(0)
  #define VRD(i) do{ vlo[i]=vtr(vp_+(((i)>>2)*4096+((i)&3)*1024)); vhi[i]=vtr(vp_+(((i)>>2)*4096+((i)&3)*1024+512)); }while(0)
  #define KRD(G,j) do{ if(G){ kload2(kf,kp0+sl_next,j); SBAR(); } }while(0)
  #define STEP(C0,C1,P0,P1,t,GK,GV,GL) do{ SBAR(); \
    const lds_cptr vp_=vp0+sl_prev; \
    VRD(0); SBAR(); float sacc=(P0[0]+P0[1]); \
    GAPA(C0=__builtin_amdgcn_mfma_f32_32x32x16_bf16(kf[0],qr[0],negm,0,0,0), P0[2],P0[3],P0[4],P0[5],     pw0[0]=PKW(P0,0), pw0[1]=PKW(P0,2), pw0); \
    VRD(4); SBAR(); GAPA(C1=__builtin_amdgcn_mfma_f32_32x32x16_bf16(kf[1],qr[0],negm,0,0,0), P0[6],P0[7],P0[8],P0[9],     pw0[2]=PKW(P0,4), pw0[3]=PKW(P0,6), pw0); \
    VRD(1); SBAR(); GAPA(C0=__builtin_amdgcn_mfma_f32_32x32x16_bf16(kf[2],qr[1],C0,0,0,0),   P0[10],P0[11],P0[12],P0[13], pw1[0]=PKW(P0,8), pw1[1]=PKW(P0,10), pw1); \
    VRD(5); SBAR(); GAPA(C1=__builtin_amdgcn_mfma_f32_32x32x16_bf16(kf[3],qr[1],C1,0,0,0),   P0[14],P0[15],P1[0],P1[1],   pw1[2]=PKW(P0,12),pw1[3]=PKW(P0,14), pw1); \
    VRD(2); SBAR(); GAPA(C0=__builtin_amdgcn_mfma_f32_32x32x16_bf16(kf[4],qr[2],C0,0,0,0),   P1[2],P1[3],P1[4],P1[5],     pw2[0]=PKW(P1,0), pw2[1]=PKW(P1,2), pw2); \
    VRD(6); SBAR(); GAPA(C1=__builtin_amdgcn_mfma_f32_32x32x16_bf16(kf[5],qr[2],C1,0,0,0),   P1[6],P1[7],P1[8],P1[9],     pw2[2]=PKW(P1,4), pw2[3]=PKW(P1,6), pw2); \
    VRD(3); SBAR(); GAPA(C0=__builtin_amdgcn_mfma_f32_32x32x16_bf16(kf[6],qr[3],C0,0,0,0),   P1[10],P1[11],P1[12],P1[13], pw3[0]=PKW(P1,8), pw3[1]=PKW(P1,10), pw3); \
    VRD(7); SBAR(); GAPA(C1=__builtin_amdgcn_mfma_f32_32x32x16_bf16(kf[7],qr[3],C1,0,0,0),   P1[14],P1[15],0.f,0.f,       pw3[2]=PKW(P1,12),pw3[3]=PKW(P1,14), pw3); \
    l_reg+=sacc; \
    if(GK){DMA_K((t)+3,sl_cur);} if(GV){DMA_V((t)+1,sl_next);} \
    CMASK(C0,C1,t); \
    { float a=MX3(C0[0],C0[1],C1[0]),b=MX3(C0[2],C0[3],C1[1]); a=MX3(a,C1[2],C1[3]); \
      _Pragma("unroll") for(int r=4;r<16;r+=4){a=MX3(a,C0[r],C0[r+1]);b=MX3(b,C0[r+2],C0[r+3]);a=MX3(a,C1[r],C1[r+1]);b=MX3(b,C1[r+2],C1[r+3]);} \
      float rm=__builtin_fmaxf(a,b); { auto rr=__builtin_amdgcn_permlane32_swap(__float_as_uint(rm),__float_as_uint(rm),false,false); rm=__builtin_fmaxf(__uint_as_float(rr[0]),__uint_as_float(rr[1])); } \
      resc=false; \
      if(__builtin_expect(__any(rm>(float)THRL),0)){ const float dl=__builtin_fmaxf(rm,0.f); mhat+=dl; \
        _Pragma("unroll") for(int r=0;r<16;++r){C0[r]-=dl;C1[r]-=dl;} \
        _Pragma("unroll") for(int r=0;r<16;++r)negm[r]=-mhat; asm volatile("":"+v"(negm)); \
        const float f=__builtin_amdgcn_exp2f(-dl); l_reg*=f; if(hi==0)wsf[r32]=f; resc=true; } } \
    SBAR(); \
    GAPB(o[0]=__builtin_amdgcn_mfma_f32_32x32x16_bf16(PAF(0),VFR(0),o[0],0,0,0), C0,0); \
    GAPB(o[1]=__builtin_amdgcn_mfma_f32_32x32x16_bf16(PAF(0),VFR(4),o[1],0,0,0), C0,4); \
    KRD(GL,0); GAPB(o[0]=__builtin_amdgcn_mfma_f32_32x32x16_bf16(PAF(1),VFR(1),o[0],0,0,0), C0,8); \
    KRD(GL,1); GAPB(o[1]=__builtin_amdgcn_mfma_f32_32x32x16_bf16(PAF(1),VFR(5),o[1],0,0,0), C0,12); \
    KRD(GL,2); GAPB(o[0]=__builtin_amdgcn_mfma_f32_32x32x16_bf16(PAF(2),VFR(2),o[0],0,0,0), C1,0); \
    KRD(GL,3); GAPB(o[1]=__builtin_amdgcn_mfma_f32_32x32x16_bf16(PAF(2),VFR(6),o[1],0,0,0), C1,4); \
    GAPB(o[0]=__builtin_amdgcn_mfma_f32_32x32x16_bf16(PAF(3),VFR(3),o[0],0,0,0), C1,8); \
    GAPB(o[1]=__builtin_amdgcn_mfma_f32_32x32x16_bf16(PAF(3),VFR(7),o[1],0,0,0), C1,12); \
    }while(0)
  int t=1;
  #undef CMASK
  #define CMASK(P0,P1,t) do{}while(0)
  for(;t+5<NT;t+=2){
    STEP(pB0,pB1,pA0,pA1,t,true,true,true);     WAIT_BAR(2); RESC(); ROT();
    STEP(pA0,pA1,pB0,pB1,t+1,true,true,true);   WAIT_BAR(2); RESC(); ROT();
  }
  #undef CMASK
  #define CMASK(P0,P1,t) do{}while(0)
  #define ENDW(tt) do{ if((tt)+3<NT){WAIT_BAR(2);} else if((tt)+2<NT){WAIT_BAR(1);} else {WAIT_BAR(0);} }while(0)
  for(;t+1<NT;t+=2){
    STEP(pB0,pB1,pA0,pA1,t,(t+3<NT),(t+1<NT),(t+1<NT));       ENDW(t);   RESC(); ROT();
    STEP(pA0,pA1,pB0,pB1,t+1,(t+4<NT),(t+2<NT),(t+2<NT));     ENDW(t+1); RESC(); ROT();
  }
  STEP(pB0,pB1,pA0,pA1,NT-1,false,false,false); RESC();
  { float sacc=pB0[0]+pB0[1]; _Pragma("unroll") for(int r=2;r<16;++r)sacc+=pB0[r]; _Pragma("unroll") for(int r=0;r<16;++r)sacc+=pB1[r]; l_reg+=sacc;
    pw0=(u32x4){PKW(pB0,0),PKW(pB0,2),PKW(pB0,4),PKW(pB0,6)};pw1=(u32x4){PKW(pB0,8),PKW(pB0,10),PKW(pB0,12),PKW(pB0,14)};pw2=(u32x4){PKW(pB1,0),PKW(pB1,2),PKW(pB1,4),PKW(pB1,6)};pw3=(u32x4){PKW(pB1,8),PKW(pB1,10),PKW(pB1,12),PKW(pB1,14)};
    SBAR(); pv(o,vb0+sl_cur,PAF(0),PAF(1),PAF(2),PAF(3)); }
  #undef PKW
  #undef PAF
  #undef VFR
  #undef PIN
  #undef MX3
  #undef GAPA
  #undef GAPB
  #undef EX
  #undef VRD
  #undef KRD
  #undef STEP
  #undef ENDW
  {auto rr=__builtin_amdgcn_permlane32_swap(__float_as_uint(l_reg),__float_as_uint(l_reg),false,false);l_reg=__uint_as_float(rr[0])+__uint_as_float(rr[1]);}
  if(hi==0)wsf[32+r32]=l_reg;asm volatile("s_waitcnt lgkmcnt(0)":::"memory");
  float rli[16];
  #pragma unroll
  for(int r=0;r<16;++r)rli[r]=__builtin_amdgcn_rcpf(wsf[32+crow(r,hi)]);
  bf16*Ow=O+(rowbase+q0+wid*QBLK)*OP+h*D;
  { bf16*stg=(bf16*)(shm+LDS_OST)+wid*2048;
    #pragma unroll
    for(int r=0;r<16;++r){const int orow=crow(r,hi);
      #pragma unroll
      for(int d0=0;d0<2;++d0)stg[orow*64+d0*32+r32]=__float2bfloat16(o[d0][r]*rli[r]);}
    asm volatile("s_waitcnt lgkmcnt(0)":::"memory");
    #pragma unroll
    for(int i=0;i<4;++i){const int row=i*8+(lane>>3),ch=lane&7; const u32x4 v=*(const u32x4*)(stg+row*64+ch*8); ATTN_STORE16(Ow+(long)row*OP+ch*8,v);} }
  asm volatile("s_waitcnt lgkmcnt(0)\n\ts_barrier":::"memory");
  #undef DMA_K
  #undef DMA_V
  #undef CMASK
  #undef START
  #undef RESC
  #undef ROT
}
constexpr int ATTN_LDS_BYTES=LDS_BYTES;
struct AttnTensors { const bf16* Q; const bf16* K; const bf16* V; bf16* O; };
struct AttnUnit { int bh; int qb; };
struct StaticOrder {
  int vcu, G;
  __device__ __forceinline__ explicit StaticOrder(int grid,int block):vcu((grid%8==0)?(block%8)*(grid/8)+block/8:block),G(grid){}
  __device__ __forceinline__ bool next(int i,AttnUnit&u)const{
    const int L=i*G+vcu; if(L>=BATCH*NHEAD*NQB)return false;
    if(G==256){ if(i>=2)return false; const int x=vcu>>5,j=vcu&31; const int b=x>>2,kvh=(x>>1)&1,hq=kvh*4+2*(x&1)+i; u.bh=b*NHEAD+hq; u.qb=j; return true; }
    u.bh=L/NQB; u.qb=L%NQB; return true; }
  __device__ __forceinline__ void a_ready(const AttnUnit&)const{}
  __device__ __forceinline__ void done(const AttnUnit&)const{}
};
template<class Sched,int THRL=8> __device__ __forceinline__ void attn_phase(char*lds,const AttnTensors&T,const Sched&S){
  AttnUnit u;
  for(int i=0;S.next(i,u);++i){ S.a_ready(u); attn_unit<THRL>(u.bh/NHEAD,u.bh%NHEAD,u.qb,T.Q,T.K,T.V,T.O,lds); S.done(u); }
}
#undef SBAR
#undef WAIT_BAR
}

#include <hip/hip_cooperative_groups.h>
namespace cg = cooperative_groups;
#ifndef MK_PER_PHASE
#define MK_PER_PHASE 0
#endif
constexpr int NWAVES = 8, NTHREADS = 512;
constexpr int NB = 2, SEQ = 8192, DMODEL = 1024, TT = NB * SEQ;
constexpr int NPROJ = 3072;
constexpr int NEXP = 32, FFE = 512;
constexpr float EPS = 1e-6f;
constexpr int N_PHASES = 12;

constexpr size_t MiB = 1u << 20;
constexpr size_t WS_CTL = 0, CTL_ZERO_BYTES = 64 * 1024;
constexpr size_t WS_WOUT = 1 * MiB;
constexpr size_t WS_LIST = 1 * MiB;
constexpr size_t WS_WR = 3 * MiB;
constexpr size_t WS_TOK = 3 * MiB + 256 * 1024;
constexpr size_t WS_GATES = 4 * MiB;
constexpr size_t WS_WIN = 5 * MiB;
constexpr size_t WS_A = 11 * MiB;
constexpr size_t WS_XN = WS_A;
constexpr size_t GDN_SH_BYTES = 71680, GDN_D_BYTES = 19456;
constexpr size_t WS_GSH = WS_A;
constexpr size_t WS_GD = WS_A + 1024 * GDN_SH_BYTES;
constexpr size_t WS_X1 = 5 * MiB;
constexpr size_t WS_HID = 69 * MiB;
constexpr size_t WS_XBUF = 109 * MiB;
constexpr size_t WS_B = 157 * MiB;
constexpr size_t WS_QKVA = WS_B;
constexpr size_t WS_QKVB = WS_B + 48 * MiB;
constexpr size_t WS_ZA = WS_B + 72 * MiB;
constexpr size_t WS_OCAT = WS_B;
constexpr size_t WS_WGU0 = 189 * MiB, WS_WGU1 = 245 * MiB; constexpr int WGU_SPLIT = 20;
constexpr size_t DO_WD0 = 0, DO_WD1 = 56 * MiB; constexpr int WD_SPLIT = 24;
constexpr size_t DO_HN = 24 * MiB;
constexpr size_t WS_END = 269 * MiB;
static_assert(WS_GD + 4096 * GDN_D_BYTES <= WS_B, "GDN records fit region A");
static_assert(WS_X1 + 64 * MiB <= WS_HID && WS_HID + 40928ull * 1024 <= WS_XBUF && WS_XBUF + 40928ull * 2048 <= WS_WGU0, "post-scan map");
static_assert(WS_WGU0 + WGU_SPLIT * 2 * MiB <= WS_B + 72 * MiB && WS_WGU1 + (32 - WGU_SPLIT) * 2 * MiB <= 269 * MiB, "WGU fragments");
constexpr size_t DO_QR = 0, DO_KR = 16 * MiB, DO_VR = 20 * MiB, DO_OF = 24 * MiB, DO_OB = 40 * MiB;
constexpr int CW_CNT = 64;
constexpr int CW_NTILE = 128;
constexpr int CW_ETAB = 192;
constexpr int CW_SCANQ = 1024;

constexpr int LDS_BYTES = 160 * 1024;

#define GAS __attribute__((address_space(1)))
#define LAS __attribute__((address_space(3)))
typedef unsigned short bf16;
typedef unsigned v4u __attribute__((ext_vector_type(4)));
typedef unsigned v2u __attribute__((ext_vector_type(2)));
typedef float f32x4 __attribute__((ext_vector_type(4)));
typedef short bf16x8 __attribute__((ext_vector_type(8)));
typedef short s16x4 __attribute__((ext_vector_type(4)));
#define DI __device__ __forceinline__

DI unsigned f2bf(float f) { unsigned u = __builtin_bit_cast(unsigned, f); return (u + 0x7fffu + ((u >> 16) & 1u)) >> 16; }
typedef float f32x2_t __attribute__((ext_vector_type(2))); typedef __bf16 bf16x2_t __attribute__((ext_vector_type(2)));
DI unsigned pk2(float lo, float hi) { f32x2_t v = {lo, hi}; bf16x2_t b = __builtin_convertvector(v, bf16x2_t); return __builtin_bit_cast(unsigned, b); }
DI float bf2f(unsigned short h) { return __builtin_bit_cast(float, (unsigned)h << 16); }
DI float bflo(unsigned w) { return __builtin_bit_cast(float, w << 16); }
DI float bfhi(unsigned w) { return __builtin_bit_cast(float, w & 0xffff0000u); }
DI float wave_sum(float v) {
#pragma unroll
    for (int o = 1; o < 64; o <<= 1) v += __shfl_xor(v, o);
    return v;
}
DI float siluf(float x) { return x * __builtin_amdgcn_rcpf(1.0f + __expf(-x)); }
DI float sigmoidf_(float x) { return 1.0f / (1.0f + __expf(-x)); }
DI int perm32i(int idx) { return ((idx >> 2) & 3) * 8 + (idx >> 4) * 4 + (idx & 3); }
DI int permcol(int c) { return (c & ~31) + perm32i(c & 31); }
template <class T> DI T opaque(T p) { asm volatile("" : "+v"(p)); return p; }

typedef GAS unsigned gu32;
#define RLX_AGENT __ATOMIC_RELAXED, __HIP_MEMORY_SCOPE_AGENT
constexpr int CW_BAR = 4096;
constexpr int MISC_OFF = LDS_BYTES - 64;
#define XB_TMO      128
#define XB_XCNT(j)  (256  + 64 * (j))
#define XB_XSUB(j)  (1280 + 64 * (j))
#define XB_XGEN(j)  (2304 + 64 * (j))
#define XB_TOP      3328
#define XB_TOPGEN   3392
#define XCD_BAR_WORDS 3456
#define XB_SPIN_CAP (1u << 18)

__device__ __forceinline__ unsigned xb_ld(unsigned* p)              { return __hip_atomic_load(p, __ATOMIC_RELAXED, __HIP_MEMORY_SCOPE_AGENT); }
__device__ __forceinline__ unsigned xb_add(unsigned* p, unsigned v) { return __hip_atomic_fetch_add(p, v, __ATOMIC_RELAXED, __HIP_MEMORY_SCOPE_AGENT); }
__device__ __forceinline__ unsigned xb_xcc_id() { return (unsigned)__builtin_amdgcn_s_getreg((3 << 11) | 20) & 0xFu; }
#define XB_SPIN(cond, bar) do { unsigned _sp = 0; while (cond) { __builtin_amdgcn_s_sleep(1); \
    if ((++_sp & 255u) == 0u) { if (xb_ld(&(bar)[XB_TMO])) break; if (_sp > XB_SPIN_CAP) { atomicAdd(&(bar)[XB_TMO], 1u); break; } } } } while (0)

struct XcdBarrier {
    unsigned* bar; unsigned x;
    volatile LAS unsigned* st;
};

__device__ __forceinline__ XcdBarrier xcd_barrier_post(unsigned* bar, volatile LAS unsigned* st) {
    XcdBarrier b; b.bar = bar; b.x = xb_xcc_id(); b.st = st;
    if (threadIdx.x == 0) (void)xb_add(&bar[XB_XCNT(b.x)], 1u);
    return b;
}
__device__ __forceinline__ void xcd_barrier_complete(unsigned* bar, unsigned x, unsigned& nloc, unsigned& nx) {
    const unsigned G = gridDim.x * gridDim.y * gridDim.z;
    unsigned sum, cnt, mine, sp = 0u;
    for (;;) {
        sum = 0u; cnt = 0u; mine = 0u;
#pragma unroll
        for (unsigned j = 0; j < 16; ++j) { const unsigned c = xb_ld(&bar[XB_XCNT(j)]); sum += c; cnt += (c > 0u) ? 1u : 0u; mine = (j == x) ? c : mine; }
        if (sum == G) break;
        __builtin_amdgcn_s_sleep(1);
        if ((++sp & 255u) == 0u) { if (xb_ld(&bar[XB_TMO])) break; if (sp > XB_SPIN_CAP) { atomicAdd(&bar[XB_TMO], 1u); break; } }
    }
    nloc = mine > 0u ? mine : 1u; nx = cnt > 0u ? cnt : 1u;
}

__device__ __forceinline__ void xcd_barrier(const XcdBarrier& b) {
    asm volatile("s_waitcnt vmcnt(0)" ::: "memory");
    __syncthreads();
    if (threadIdx.x == 0) {
        unsigned* bar = b.bar;
        __builtin_amdgcn_s_waitcnt(0);
        unsigned nloc = b.st[0], nx = b.st[1];
        if (nloc == 0u) { xcd_barrier_complete(bar, b.x, nloc, nx); b.st[0] = nloc; b.st[1] = nx; }
        const unsigned old = xb_add(&bar[XB_XSUB(b.x)], 1u);
        const unsigned gen = old / nloc;
        if (old + 1u == (gen + 1u) * nloc) {
            __builtin_amdgcn_fence(__ATOMIC_RELEASE, "agent");
            asm volatile("s_waitcnt vmcnt(0)" ::: "memory");
            const unsigned og = xb_add(&bar[XB_TOP], 1u);
            const unsigned tg = og / nx;
            if (og + 1u == (tg + 1u) * nx) xb_add(&bar[XB_TOPGEN], 1u);
            else XB_SPIN(xb_ld(&bar[XB_TOPGEN]) == tg, bar);
            __builtin_amdgcn_fence(__ATOMIC_ACQUIRE, "agent");
            xb_add(&bar[XB_XGEN(b.x)], 1u);
            asm volatile("s_waitcnt vmcnt(0)" ::: "memory");
        } else {
            XB_SPIN(xb_ld(&bar[XB_XGEN(b.x)]) == gen, bar);
            __builtin_amdgcn_fence(__ATOMIC_ACQUIRE, "agent");
            asm volatile("s_waitcnt vmcnt(0)" ::: "memory");
        }
    }
    __syncthreads();
}

struct Frame {
    LAS unsigned char* lds;
    int tid, lane, wave, vcu, G;
    const float* in[17];
    float* out; unsigned char* ws;
};

DI void p0_transpose_item(const float* W, int ldw, int nblk, bf16* WT, int K, int row_off, int rmul, LAS float* scr, int item, int lane) {
    const int kb = item / nblk, nb = item % nblk, k0 = 64 * kb, n0 = 32 * nb;
    const int r8 = lane >> 3, c4 = (lane & 7) * 4;
    f32x4 v[8];
#pragma unroll
    for (int i = 0; i < 8; ++i) v[i] = __builtin_nontemporal_load((const f32x4*)(W + (size_t)(k0 + 8 * i + r8) * ldw + n0 + c4));
#pragma unroll
    for (int i = 0; i < 8; ++i) { LAS float* d = scr + (8 * i + r8) * 33 + c4; d[0] = v[i].x; d[1] = v[i].y; d[2] = v[i].z; d[3] = v[i].w; }
    asm volatile("s_waitcnt lgkmcnt(0)" ::: "memory");
    const int c = lane & 7;
#pragma unroll
    for (int j = 0; j < 4; ++j) { const int n = (lane >> 3) + 8 * j; const LAS float* s = scr + (8 * c) * 33 + n;
        v4u o; o.x = pk2(s[0 * 33], s[1 * 33]); o.y = pk2(s[2 * 33], s[3 * 33]); o.z = pk2(s[4 * 33], s[5 * 33]); o.w = pk2(s[6 * 33], s[7 * 33]);
        *(GAS v4u*)(WT + (size_t)(row_off + (n0 + n) * rmul) * K + k0 + 8 * c) = o; }
    asm volatile("s_waitcnt lgkmcnt(0)" ::: "memory");
}
template <int NR> DI void rms_rows_to_bf16(const float* const (&xrow)[NR], const float* w, bf16* const (&orow)[NR], int lane) {
    const GAS f32x4* wr = (const GAS f32x4*)w + lane;
    f32x4 v[NR][4];
#pragma unroll
    for (int r = 0; r < NR; ++r) { const GAS f32x4* xr = (const GAS f32x4*)xrow[r] + lane;
#pragma unroll
        for (int j = 0; j < 4; ++j) v[r][j] = xr[64 * j]; }
    f32x4 ww[4];
#pragma unroll
    for (int j = 0; j < 4; ++j) ww[j] = wr[64 * j];
#pragma unroll
    for (int r = 0; r < NR; ++r) {
        float s_ = 0.f;
#pragma unroll
        for (int j = 0; j < 4; ++j) s_ += (v[r][j].x * v[r][j].x + v[r][j].y * v[r][j].y) + (v[r][j].z * v[r][j].z + v[r][j].w * v[r][j].w);
        const float rs = 1.0f / sqrtf(wave_sum(s_) * (1.f / DMODEL) + EPS);
        GAS v2u* o8 = (GAS v2u*)orow[r] + lane;
#pragma unroll
        for (int j = 0; j < 4; ++j) { v2u o; o.x = pk2(v[r][j].x * rs * ww[j].x, v[r][j].y * rs * ww[j].y); o.y = pk2(v[r][j].z * rs * ww[j].z, v[r][j].w * rs * ww[j].w); o8[64 * j] = o; }
    }
}
DI void p0_prologue(Frame& F) {
    LAS float* scr = (LAS float*)(F.lds + F.wave * 16384);
    const int gw = F.vcu * NWAVES + F.wave, NGW = F.G * NWAVES;
    const float* w_in = F.in[2];
    bf16* WIN = (bf16*)(F.ws + WS_WIN);
    constexpr int I1 = 16 * 64, I2 = 16 * 24, I3 = 16, NITEMS = I1 + I2 + I3;
    for (int it = gw; it < NITEMS; it += NGW) {
        int r = it;
        if (r < I1) { p0_transpose_item(w_in, 2832, 64, WIN, 1024, 0, 1, scr, r, F.lane); continue; } r -= I1;
        if (r < I2) { p0_transpose_item(w_in + 2064, 2832, 24, WIN, 1024, 2048, 1, scr, r, F.lane); continue; } r -= I2;
        p0_transpose_item(w_in + 2048, 2832, 1, WIN, 1024, 2816, 1, scr, r, F.lane);
    }
    { const int gt = F.vcu * NTHREADS + F.tid, GT = F.G * NTHREADS; GAS v4u* z = (GAS v4u*)(WIN + (size_t)2848 * 1024);
      for (int i = gt; i < 224 * 1024 * 2 / 16; i += GT) z[i] = (v4u){0u, 0u, 0u, 0u}; }
    bf16* XN = (bf16*)(F.ws + WS_XN);
    for (int m = gw; m < TT; m += 2 * NGW) { const int m1 = (m + NGW < TT) ? m + NGW : m;
        const float* const xr[2] = {F.in[0] + (size_t)m * DMODEL, F.in[0] + (size_t)m1 * DMODEL}; bf16* const orw[2] = {XN + (size_t)m * DMODEL, XN + (size_t)m1 * DMODEL};
        rms_rows_to_bf16<2>(xr, F.in[1], orw, F.lane); }
}

struct EpiProj {
    static constexpr bool PERM = true, AFTER_DRAIN = false;
    bf16 *qkva, *za, *qkvb; float* gates;
    DI void operator()(const pg8::f32x4 (&acc)[2][2][4][2], const pg8::Unit& u, int wr, int wc, int fr, int fq) const {
        const int row0 = u.pm * 256 + wr * 64 + fr;
        if (u.pn == 11) {
            if (wc == 0 && fq < 2) {
#pragma unroll
                for (int ai = 0; ai < 2; ++ai)
#pragma unroll
                    for (int m = 0; m < 4; ++m) { float* rp = gates + (size_t)(row0 + ai * 128 + m * 16) * 16 + 8 * fq;
                        *(pg8::f32x4*)(rp) = acc[ai][0][m][0]; *(pg8::f32x4*)(rp + 4) = acc[ai][0][m][1]; }
            }
            return;
        }
        bf16* base; int ldc, colt;
        if (u.pn < 6) { base = qkva; ldc = 1536; colt = u.pn * 256; } else if (u.pn < 8) { base = za; ldc = 512; colt = (u.pn - 6) * 256; } else { base = qkvb; ldc = 768; colt = (u.pn - 8) * 256; }
        const int col0 = colt + wc * 32 + 8 * fq;
#pragma unroll
        for (int ai = 0; ai < 2; ++ai)
#pragma unroll
            for (int m = 0; m < 4; ++m) { bf16* rowp = base + (size_t)(row0 + ai * 128 + m * 16) * ldc + col0;
#pragma unroll
                for (int bj = 0; bj < 2; ++bj) { const pg8::f32x4 v0 = acc[ai][bj][m][0], v1 = acc[ai][bj][m][1]; pg8::u32x4 w;
                    w.x = pg8::cvt_pk_bf16(v0[0], v0[1]); w.y = pg8::cvt_pk_bf16(v0[2], v0[3]); w.z = pg8::cvt_pk_bf16(v1[0], v1[1]); w.w = pg8::cvt_pk_bf16(v1[2], v1[3]);
                    *(pg8::u32x4*)(rowp + bj * 128) = w; } }
    }
};
struct EpiResid {
    static constexpr bool PERM = false, AFTER_DRAIN = false;
    const float* x; float* x1;
    DI void operator()(const pg8::f32x4 (&acc)[2][2][4][2], const pg8::Unit& u, int wr, int wc, int fr, int fq) const {
        const int row0 = u.pm * 256 + wr * 64 + fr, col0 = u.pn * 256 + wc * 32 + 4 * fq;
#pragma unroll
        for (int ai = 0; ai < 2; ++ai)
#pragma unroll
            for (int m = 0; m < 4; ++m) { const size_t off = (size_t)(row0 + ai * 128 + m * 16) * DMODEL + col0;
#pragma unroll
                for (int bj = 0; bj < 2; ++bj)
#pragma unroll
                    for (int n = 0; n < 2; ++n) { const pg8::f32x4 b = *(const pg8::f32x4*)(x + off + bj * 128 + n * 16); *(pg8::f32x4*)(x1 + off + bj * 128 + n * 16) = b + acc[ai][bj][m][n]; } }
    }
};
struct EpiGU {
    static constexpr bool PERM = true, AFTER_DRAIN = false;
    bf16* hid;
    DI void operator()(const pg8::f32x4 (&acc)[2][2][4][2], const pg8::Unit& u, int wr, int wc, int fr, int fq) const {
        const int row0 = u.pm * 256 + wr * 64 + fr; const int jt = u.pn & 3;
        const int ff0 = jt * 128 + wc * 16 + 4 * fq;
#pragma unroll
        for (int ai = 0; ai < 2; ++ai)
#pragma unroll
            for (int m = 0; m < 4; ++m) { bf16* rowp = hid + (size_t)(row0 + ai * 128 + m * 16) * FFE + ff0;
#pragma unroll
                for (int bj = 0; bj < 2; ++bj) { const pg8::f32x4 v0 = acc[ai][bj][m][0], v1 = acc[ai][bj][m][1];
                    const float h0 = siluf(v0[0]) * v0[1], h1 = siluf(v0[2]) * v0[3], h2 = siluf(v1[0]) * v1[1], h3 = siluf(v1[2]) * v1[3];
                    v2u w; w.x = pg8::cvt_pk_bf16(h0, h1); w.y = pg8::cvt_pk_bf16(h2, h3);
                    *(v2u*)(rowp + bj * 64) = w; } }
    }
};
struct EpiY {
    static constexpr bool PERM = true, AFTER_DRAIN = false;
    bf16* y;
    DI void operator()(const pg8::f32x4 (&acc)[2][2][4][2], const pg8::Unit& u, int wr, int wc, int fr, int fq) const {
        const int row0 = u.pm * 256 + wr * 64 + fr; const int col0 = (u.pn & 3) * 256 + wc * 32 + 8 * fq;
#pragma unroll
        for (int ai = 0; ai < 2; ++ai)
#pragma unroll
            for (int m = 0; m < 4; ++m) { bf16* rowp = y + (size_t)(row0 + ai * 128 + m * 16) * DMODEL + col0;
#pragma unroll
                for (int bj = 0; bj < 2; ++bj) { const pg8::f32x4 v0 = acc[ai][bj][m][0], v1 = acc[ai][bj][m][1]; pg8::u32x4 w;
                    w.x = pg8::cvt_pk_bf16(v0[0], v0[1]); w.y = pg8::cvt_pk_bf16(v0[2], v0[3]); w.z = pg8::cvt_pk_bf16(v1[0], v1[1]); w.w = pg8::cvt_pk_bf16(v1[2], v1[3]);
                    *(pg8::u32x4*)(rowp + bj * 128) = w; } }
    }
};
constexpr int ETAB_OFF = 131072;
struct MoeOrder {
    const LAS unsigned* etab; int G, c, esplit, pnoff;
    DI bool next(int i, pg8::Unit& u) const {
        if (G % 8 != 0) {
            int L = i * G + c;
            for (int e = 0; e < NEXP; ++e) { const int n4 = 4 * (int)etab[2 * e + 1]; if (L < n4) { u.pm = (int)etab[2 * e] + (L >> 2); u.pn = (e < esplit ? 4 * e : pnoff + 4 * (e - esplit)) + (L & 3); u.ex = e; u.tq = L >> 2; return true; } L -= n4; }
            return false; }
        const int x = c & 7; int L = i * (G >> 3) + (c >> 3);
#pragma unroll
        for (int q = 0; q < NEXP / 8; ++q) { const int e = x + 8 * q; const int n4 = 4 * (int)etab[2 * e + 1];
            if (L < n4) { u.pm = (int)etab[2 * e] + (L >> 2); u.pn = (e < esplit ? 4 * e : pnoff + 4 * (e - esplit)) + (L & 3); u.ex = e; u.tq = L >> 2; return true; } L -= n4; }
        return false; }
    DI void a_ready(const pg8::Unit&) const {}
    DI void done(const pg8::Unit&) const {}
};
struct MoeRows {
    const int* list; const LAS unsigned* etab;
    DI int row(const pg8::Unit& u, int r) const { const int slot = u.tq * 256 + r; return slot < (int)etab[64 + u.ex] ? list[u.ex * TT + slot] : 0; }
};

DI void p2_rope(Frame& F) {
    const int gw = F.vcu * NWAVES + F.wave, NGW = F.G * NWAVES, lane = F.lane;
    const bf16* QKVB = (const bf16*)(F.ws + WS_QKVB);
    bf16* QR = (bf16*)((unsigned char*)F.out + DO_QR); bf16* KR = (bf16*)((unsigned char*)F.out + DO_KR); bf16* VR = (bf16*)((unsigned char*)F.out + DO_VR);
    const int pi = lane & 31, hsel = lane >> 5;
    const float qw0 = F.in[7][2 * pi], qw1 = F.in[7][2 * pi + 1], kw0 = F.in[8][2 * pi], kw1 = F.in[8][2 * pi + 1];
    const float invf = exp2f(-(float)(2 * (pi & 15)) * (13.287712379549449f / 32.0f));
    constexpr float C2 = 0.125f * 1.4426950408889634f;
    constexpr int NB4 = 4;
    for (int t0 = gw; t0 < TT; t0 += NB4 * NGW) {
        unsigned w[NB4][5], vw[NB4];
#pragma unroll
        for (int u = 0; u < NB4; ++u) { const int t = t0 + u * NGW; const unsigned* src = (const unsigned*)(QKVB + (size_t)(t < TT ? t : t0) * 768);
#pragma unroll
            for (int j = 0; j < 5; ++j) w[u][j] = src[(2 * j + hsel) * 32 + pi];
            vw[u] = src[320 + lane]; }
#pragma unroll
        for (int u = 0; u < NB4; ++u) {
            const int t = t0 + u * NGW; if (t >= TT) break;
            const int s_ = t & (SEQ - 1); const float pos = (pi < 16) ? (float)(s_ >> 6) : (float)(s_ & 63);
            const float ang = pos * invf;
            const double rev = (double)ang * 0.15915494309189535; const float fr = (float)(rev - floor(rev));
            const float sn = __builtin_amdgcn_sinf(fr), cs = __builtin_amdgcn_cosf(fr);
#pragma unroll
            for (int j = 0; j < 5; ++j) {
                const int head = 2 * j + hsel;
                const float x0 = bflo(w[u][j]), x1 = bfhi(w[u][j]);
                float ss = x0 * x0 + x1 * x1;
#pragma unroll
                for (int o = 1; o < 32; o <<= 1) ss += __shfl_xor(ss, o);
                const float rs = 1.0f / sqrtf(ss * (1.f / 64.f) + EPS);
                const bool isq = head < 8;
                const float y0 = x0 * rs * (isq ? qw0 : kw0), y1 = x1 * rs * (isq ? qw1 : kw1);
                float o0 = y0 * cs - y1 * sn, o1 = y0 * sn + y1 * cs;
                if (isq) { o0 *= C2; o1 *= C2; ((unsigned*)(QR + (size_t)t * 512))[head * 32 + pi] = pk2(o0, o1); }
                else ((unsigned*)(KR + (size_t)t * 128))[(head - 8) * 32 + pi] = pk2(o0, o1);
            }
            ((unsigned*)(VR + (size_t)t * 128))[lane] = vw[u];
        }
    }
}

constexpr int G_KNP = 0, G_QNP = 17408, G_KNTP = 34816, G_VCT = 53248;
constexpr int G_D0 = 71680, G_D1 = 71680 + 19456;
constexpr int GD_TBP = 0, GD_AP = 9216, GD_VEC = 18432;
constexpr int G_LM = 110592;
constexpr int G_GV = G_LM + 32768;
static_assert(G_GV + 2048 <= LDS_BYTES - 64, "gdn pre lds");

#define TRI_ROW(i, LC, LN) { \
        if ((i) + 1 < 64) { _Pragma("unroll") for (int j4 = 0; j4 < ((i) + 1 + 3) / 4 && j4 < 8; ++j4) LN[j4] = *(const LAS f32x4*)(L + ((i) + 1) * 64 + 4 * j4); } \
        _Pragma("unroll") for (int j4 = 8; j4 < ((i) + 3) / 4; ++j4) lt[j4 - 8] = *(const LAS f32x4*)(L + (i) * 64 + 4 * j4); \
        __builtin_amdgcn_sched_barrier(0); \
        f32x2_t a0 = {(lane == (i)) ? 1.0f : 0.0f, 0.f}, a1 = {0.f, 0.f}; \
        _Pragma("unroll") for (int j4 = 0; j4 < ((i) + 3) / 4; ++j4) { const f32x4 l = (j4 < 8) ? LC[j4 & 7] : lt[(j4 - 8) & 7]; \
            f32x2_t l0 = {l.x, (4 * j4 + 1 < (i)) ? l.y : 0.f}, l1 = {(4 * j4 + 2 < (i)) ? l.z : 0.f, (4 * j4 + 3 < (i)) ? l.w : 0.f}; \
            a0 -= l0 * xp[2 * j4]; if (4 * j4 + 2 < (i)) a1 -= l1 * xp[2 * j4 + 1]; } \
        const float a = (a0.x + a0.y) + (a1.x + a1.y); \
        if ((i) & 1) xp[(i) >> 1].y = a; else { xp[(i) >> 1].x = a; xp[(i) >> 1].y = 0.f; } \
        TBP[(REV ? 63 - (i) : (i)) * 72 + pc] = (bf16)(pk2(a * bcol, 0.f) & 0xffffu); \
        __builtin_amdgcn_sched_barrier(0); }
template <bool REV> DI void tri_inverse(LAS float* L, const LAS float* beta, LAS bf16* TBP, int lane) {
    f32x2_t xp[32];
    L = opaque(L); TBP = opaque(TBP); lane = opaque(lane);
    const float bcol = REV ? beta[63 - lane] : beta[lane];
    const int pc = REV ? permcol(63 - lane) : permcol(lane);
    f32x4 la[8], lb[8], lt[8];
#pragma unroll
    for (int ii = 0; ii < 64; ii += 2) { TRI_ROW(ii, la, lb) TRI_ROW(ii + 1, lb, la) }
}
#undef TRI_ROW

DI void gdn_conv(Frame& F, LAS unsigned char* lds, int t384, int b, int h, int n) {
    const bf16* QKVA = (const bf16*)(F.ws + WS_QKVA); const float* convw = F.in[3];
    const int cgp = t384 % 48, rg = t384 / 48, mat = cgp >> 4, cc = (cgp & 15) * 8;
    const int col = mat * 512 + h * 128 + cc;
    float w[5][8];
#pragma unroll
    for (int j = 0; j < 5; ++j) { const f32x4 a = *(const f32x4*)(convw + j * 1536 + col), bq = *(const f32x4*)(convw + j * 1536 + col + 4);
        w[j][0] = a.x; w[j][1] = a.y; w[j][2] = a.z; w[j][3] = a.w; w[j][4] = bq.x; w[j][5] = bq.y; w[j][6] = bq.z; w[j][7] = bq.w; }
    const int a4 = (cc >> 3) & 3, p0 = (cc & ~31) + 16 * (a4 & 1) + 4 * (a4 >> 1);
    const int ra = rg & 3, q0 = (rg >> 2) * 32 + 16 * (ra & 1) + 4 * (ra >> 1);
#pragma unroll
    for (int hf = 0; hf < 2; ++hf) {
        float o[4][8];
#pragma unroll
        for (int r = 0; r < 4; ++r)
#pragma unroll
            for (int c = 0; c < 8; ++c) o[r][c] = 0.f;
#pragma unroll
        for (int i = 0; i < 8; ++i) {
            const int pos = n * 64 + rg * 8 + hf * 4 - 2 + i;
            v4u raw = (v4u){0u, 0u, 0u, 0u};
            if (pos >= 0 && pos < SEQ) raw = *(const v4u*)(QKVA + (size_t)(b * SEQ + pos) * 1536 + col);
            float xin[8] = {bflo(raw.x), bfhi(raw.x), bflo(raw.y), bfhi(raw.y), bflo(raw.z), bfhi(raw.z), bflo(raw.w), bfhi(raw.w)};
#pragma unroll
            for (int j = 0; j < 5; ++j) { const int r = i - j; if (r >= 0 && r < 4) {
#pragma unroll
                for (int c = 0; c < 8; ++c) o[r][c] += w[j][c] * xin[c]; } }
        }
#pragma unroll
        for (int r = 0; r < 4; ++r) {
            float ss = 0.f;
#pragma unroll
            for (int c = 0; c < 8; ++c) { o[r][c] = siluf(o[r][c]); ss += o[r][c] * o[r][c]; }
            ss += __shfl_xor(ss, 1); ss += __shfl_xor(ss, 2); ss += __shfl_xor(ss, 4); ss += __shfl_xor(ss, 8);
            float sc = 1.0f;
            if (mat < 2) { sc = 1.0f / sqrtf(ss + EPS); if (mat == 0) sc *= 0.08838834764831845f; }
#pragma unroll
            for (int c = 0; c < 8; ++c) o[r][c] *= sc;
        }
        if (mat < 2) {
            LAS unsigned char* tile = lds + (mat == 0 ? G_QNP : G_KNP);
#pragma unroll
            for (int r = 0; r < 4; ++r) { const int c = rg * 8 + hf * 4 + r;
                v2u lo, hi2; lo.x = pk2(o[r][0], o[r][1]); lo.y = pk2(o[r][2], o[r][3]); hi2.x = pk2(o[r][4], o[r][5]); hi2.y = pk2(o[r][6], o[r][7]);
                *(LAS v2u*)(tile + c * 272 + p0 * 2) = lo; *(LAS v2u*)(tile + c * 272 + (p0 + 8) * 2) = hi2; }
        }
        if (mat >= 1) {
#pragma unroll
            for (int c = 0; c < 8; ++c) {
                v2u q4; q4.x = pk2(o[0][c], o[1][c]); q4.y = pk2(o[2][c], o[3][c]);
                if (mat == 1) *(LAS v2u*)(lds + G_KNTP + (cc + c) * 144 + (q0 + 8 * hf) * 2) = q4;
                else *(LAS v2u*)(lds + G_VCT + (cc + c) * 144 + rg * 16 + hf * 8) = q4;
            }
        }
    }
}
DI void gdn_gates(Frame& F, LAS unsigned char* lds, LAS float* gv, int lane, int b, int h, int n) {
    const float* gp = (const float*)(F.ws + WS_GATES) + (size_t)(b * SEQ + n * 64 + lane) * 16;
    const float bfv = gp[h], bbv = gp[4 + h], afv = gp[8 + h], abv = gp[12 + h];
    const float betaf = sigmoidf_(bfv), betab = sigmoidf_(bbv);
    const float xf = afv + F.in[5][h], xb = abv + F.in[5][4 + h];
    const float spf = fmaxf(xf, 0.f) + log1pf(__expf(-fabsf(xf))), spb = fmaxf(xb, 0.f) + log1pf(__expf(-fabsf(xb)));
    const float gf = -__expf(F.in[4][h]) * spf, gb = -__expf(F.in[4][4 + h]) * spb;
    float Gf = gf, Rb = gb;
#pragma unroll
    for (int o = 1; o < 64; o <<= 1) { const float u1 = __shfl_up(Gf, o); if (lane >= o) Gf += u1; const float d1 = __shfl_down(Rb, o); if (lane + o < 64) Rb += d1; }
    gv[lane] = Gf; gv[64 + lane] = Rb; gv[128 + lane] = betaf; gv[192 + lane] = betab;
    const float GfL = __shfl(Gf, 63), Rb0 = __shfl(Rb, 0);
    LAS float* v0 = (LAS float*)(lds + G_D0 + GD_VEC); LAS float* v1 = (LAS float*)(lds + G_D1 + GD_VEC);
    v0[lane] = __expf(Gf); v0[64 + lane] = __expf(GfL - Gf); v1[lane] = __expf(Rb); v1[64 + lane] = __expf(Rb0 - Rb);
    if (lane == 0) { v0[128] = __expf(GfL); v1[128] = __expf(Rb0); }
}
DI void p2_gdn_pre(Frame& F) {
    const int tid = F.tid, lane = F.lane, wave = F.wave;
    int task = F.vcu;
    if (task < 1024) {
        LAS unsigned char* lds = opaque(F.lds);
        const int b = task >> 9, h = (task >> 7) & 3, n = task & 127;
        if (wave >= 2) gdn_conv(F, lds, tid - 128, b, h, n);
        if (wave == 2) gdn_gates(F, lds, (LAS float*)(lds + G_GV), lane, b, h, n);
    }
    __syncthreads();
    int par = 0;
#pragma unroll 1
    for (; task < 1024; task += F.G, par ^= 1) {
        LAS unsigned char* lds = opaque(F.lds);
        const int b = task >> 9, h = (task >> 7) & 3, n = task & 127, bh = b * 4 + h;
        LAS float* gv = (LAS float*)(lds + G_GV + par * 1024);
        LAS float* sGf = gv; LAS float* sRb = gv + 64; LAS float* sBf = gv + 128; LAS float* sBb = gv + 192;
        {
            const int p = wave >> 2, mt = wave & 3, n16 = lane & 15, g = lane >> 4;
            const LAS unsigned char* At = lds + (p == 0 ? G_KNP : G_QNP) + (16 * mt + n16) * 272 + g * 16;
            bf16x8 af[4], bfr[16];
#pragma unroll
            for (int ks = 0; ks < 4; ++ks) af[ks] = *(const LAS bf16x8*)(At + ks * 64);
#pragma unroll
            for (int nt = 0; nt < 4; ++nt)
#pragma unroll
                for (int ks = 0; ks < 4; ++ks) bfr[nt * 4 + ks] = *(const LAS bf16x8*)(lds + G_KNP + (16 * nt + n16) * 272 + g * 16 + ks * 64);
            float Gc[4], Rc[4], Bfc[4], Bbc[4];
#pragma unroll
            for (int r = 0; r < 4; ++r) { const int c = 16 * mt + 4 * g + r; Gc[r] = sGf[c]; Rc[r] = sRb[c]; Bfc[r] = sBf[c]; Bbc[r] = sBb[c]; }
#pragma unroll
            for (int nt = 0; nt < 4; ++nt) {
                f32x4 acc = (f32x4){0.f, 0.f, 0.f, 0.f};
#pragma unroll
                for (int ks = 0; ks < 4; ++ks) acc = __builtin_amdgcn_mfma_f32_16x16x32_bf16(af[ks], bfr[nt * 4 + ks], acc, 0, 0, 0);
                const int s_ = 16 * nt + n16; const float Gs = sGf[s_], Rs = sRb[s_]; const int ps = permcol(s_);
#pragma unroll
                for (int r = 0; r < 4; ++r) {
                    const int c = 16 * mt + 4 * g + r; const float v = acc[r];
                    const float df = __expf(fminf(Gc[r] - Gs, 0.f)), db = __expf(fminf(Rc[r] - Rs, 0.f));
                    if (p == 0) {
                        ((LAS float*)(lds + G_LM))[c * 64 + s_] = Bfc[r] * v * df;
                        ((LAS float*)(lds + G_LM + 16384))[(63 - c) * 64 + (63 - s_)] = Bbc[r] * v * db;
                    } else {
                        ((LAS bf16*)(lds + G_D0 + GD_AP))[c * 72 + ps] = (bf16)(pk2(s_ <= c ? v * df : 0.f, 0.f) & 0xffffu);
                        ((LAS bf16*)(lds + G_D1 + GD_AP))[c * 72 + ps] = (bf16)(pk2(s_ >= c ? v * db : 0.f, 0.f) & 0xffffu);
                    }
                }
            }
        }
        __syncthreads();
        GAS v4u* gd0 = (GAS v4u*)(F.ws + WS_GD + (size_t)((bh * 2 + 0) * 128 + n) * GDN_D_BYTES);
        GAS v4u* gd1 = (GAS v4u*)(F.ws + WS_GD + (size_t)((bh * 2 + 1) * 128 + n) * GDN_D_BYTES);
        {
            GAS v4u* gsh = (GAS v4u*)(F.ws + WS_GSH + (size_t)(bh * 128 + n) * GDN_SH_BYTES);
#pragma unroll 3
            for (int i = tid; i < (int)(GDN_SH_BYTES / 16); i += NTHREADS) gsh[i] = *(const LAS v4u*)(lds + i * 16);
#pragma unroll 1
            for (int i = GD_AP / 16 + tid; i < (int)(GDN_D_BYTES / 16); i += NTHREADS) { gd0[i] = *(const LAS v4u*)(lds + G_D0 + i * 16); gd1[i] = *(const LAS v4u*)(lds + G_D1 + i * 16); }
        }
        __syncthreads();
        if (wave == 0) { tri_inverse<false>((LAS float*)(lds + G_LM), sBf, (LAS bf16*)(lds + G_D0 + GD_TBP), lane);
#pragma unroll 3
            for (int i = lane; i < GD_AP / 16; i += 64) gd0[i] = *(const LAS v4u*)(lds + G_D0 + i * 16); }
        else if (wave == 1) { tri_inverse<true>((LAS float*)(lds + G_LM + 16384), sBb, (LAS bf16*)(lds + G_D1 + GD_TBP), lane);
#pragma unroll 3
            for (int i = lane; i < GD_AP / 16; i += 64) gd1[i] = *(const LAS v4u*)(lds + G_D1 + i * 16); }
        else {
            const int t2 = task + F.G;
            if (t2 < 1024) { const int b2 = t2 >> 9, h2 = (t2 >> 7) & 3, n2 = t2 & 127;
                gdn_conv(F, lds, tid - 128, b2, h2, n2);
                if (wave == 2) gdn_gates(F, lds, (LAS float*)(lds + G_GV + (par ^ 1) * 1024), lane, b2, h2, n2); }
        }
        __syncthreads();
    }
}

DI bf16x8 pack8(const f32x4 a, const f32x4 b) {
    v4u p; p.x = pk2(a[0], a[1]); p.y = pk2(a[2], a[3]); p.z = pk2(b[0], b[1]); p.w = pk2(b[2], b[3]); return __builtin_bit_cast(bf16x8, p);
}
DI void small_weights(Frame& F, int gw, int NGW) {
    LAS float* scr = (LAS float*)(F.lds + F.wave * 16384);
    bf16* WOUT = (bf16*)(F.ws + WS_WOUT);
    for (int it = gw; it < 16 * 32; it += NGW) p0_transpose_item(F.in[9], 1024, 32, WOUT, 1024, 0, 1, scr, it, F.lane);
    bf16* WRH = (bf16*)(F.ws + WS_WR); bf16* WRL = WRH + 48 * 1024; const float* wrg = F.in[11]; const float* wre = F.in[12];
    for (int i = gw * 64 + F.lane; i < 48 * 1024; i += NGW * 64) { const int j = i >> 10, k = i & 1023; float v = 0.f; if (j < 4) v = wrg[k * 4 + j]; else if (j < 36) v = wre[k * 32 + (j - 4)];
        const unsigned h = f2bf(v); const float hv = __builtin_bit_cast(float, h << 16); WRH[i] = (bf16)h; WRL[i] = (bf16)f2bf(v - hv); }
}
DI bf16* wgu_ptr(Frame& F, int e) { return (bf16*)(F.ws + (e < WGU_SPLIT ? WS_WGU0 + (size_t)e * 2 * MiB : WS_WGU1 + (size_t)(e - WGU_SPLIT) * 2 * MiB)); }
DI bf16* wd_ptr(Frame& F, int e) { return (bf16*)((unsigned char*)F.out + (e < WD_SPLIT ? DO_WD0 + (size_t)e * MiB : DO_WD1 + (size_t)(e - WD_SPLIT) * MiB)); }
DI void moe_weights(Frame& F, int gw, int NGW) {
    LAS float* scr = (LAS float*)(F.lds + F.wave * 16384);
    constexpr int IG = 16 * 16, ID = 8 * 32, IPE = 2 * IG + ID;
    for (int it = gw; it < NEXP * IPE; it += NGW) {
        const int e = it / IPE; int r = it % IPE;
        if (r < IG) { p0_transpose_item(F.in[13] + (size_t)e * 1024 * 512, 512, 16, wgu_ptr(F, e), 1024, 0, 2, scr, r, F.lane); continue; } r -= IG;
        if (r < IG) { p0_transpose_item(F.in[14] + (size_t)e * 1024 * 512, 512, 16, wgu_ptr(F, e), 1024, 1, 2, scr, r, F.lane); continue; } r -= IG;
        p0_transpose_item(F.in[15] + (size_t)e * 512 * 1024, 1024, 32, wd_ptr(F, e), 512, 0, 1, scr, r, F.lane);
    }
}

constexpr int SC_SLOT = 78848, SC_VCT = 53248, SC_D = 55552, SC_NCH = 11;
static_assert(2 * SC_SLOT <= LDS_BYTES, "scan slots");
DI void sc_issue(v4u (&R)[SC_NCH], const unsigned char* ws, const unsigned (&delta)[SC_NCH], const unsigned (&dmask)[SC_NCH], unsigned shbase, unsigned ddiff) {
#pragma unroll
    for (int j = 0; j < SC_NCH; ++j) { const unsigned off = shbase + delta[j] + (dmask[j] & ddiff);
#ifdef SC_PLAIN_LOADS
        R[j] = *(const v4u*)(ws + off); }
#else
        asm volatile("global_load_dwordx4 %0, %1, %2" : "=v"(R[j]) : "v"(off), "s"(ws) : "memory"); }
#endif
}
#ifdef SC_PLAIN_LOADS
#define SC_WAIT(R, n) do {} while (0)
#else
#define SC_WAIT(R, n) asm volatile("s_waitcnt vmcnt(" #n ")" : "+v"(R[0]), "+v"(R[1]), "+v"(R[2]), "+v"(R[3]), "+v"(R[4]), "+v"(R[5]), "+v"(R[6]), "+v"(R[7]), "+v"(R[8]), "+v"(R[9]), "+v"(R[10]) :: "memory")
#endif
DI void sc_write(const v4u (&R)[SC_NCH], LAS unsigned char* slot, int lid) {
#pragma unroll
    for (int j = 0; j < SC_NCH; ++j) *(LAS v4u*)(slot + 16 * (lid + 448 * j)) = R[j];
}
DI void p4_scan(Frame& F) {
    const int lane = F.lane, n16 = lane & 15, g = lane >> 4, wave = F.wave;
    {
        volatile LAS int* tsk = (volatile LAS int*)(F.lds + MISC_OFF + 32);
        if (F.tid == 0) {
            unsigned* q = (unsigned*)(F.ws + WS_CTL) + CW_SCANQ; const unsigned xcc = xb_xcc_id() & 7u; int task = -1;
            for (unsigned t = 0; t < 8 && task < 0; ++t) { const unsigned y = (xcc + t) & 7u; const unsigned j = xb_add(q + 64 * y, 1u); if (j < 16u) task = (int)(y * 16 + j); }
            *tsk = task; if (task < 0) tsk[1] = (int)xb_add(q + 64 * 8, 1u);
        }
        __syncthreads();
    }
    const int task = *(volatile LAS int*)(F.lds + MISC_OFF + 32);
    if (task < 0) {
        if (F.G > 128) { const int cgw = *(volatile LAS int*)(F.lds + MISC_OFF + 36) * NWAVES + wave, cng = (F.G - 128) * NWAVES; small_weights(F, cgw, cng); moe_weights(F, cgw, cng); }
        return; }
    const int chain = 2 * (task >> 4) + ((task & 15) >> 3), e = task & 7;
    const int bh = chain >> 1, dir = chain & 1, b = bh >> 2, h = bh & 3;
    LAS unsigned char* lds = opaque(F.lds);
    if (wave != 0) {
        const int lid = (wave - 1) * 64 + lane;
        const unsigned sh0 = (unsigned)(WS_GSH + (size_t)(bh * 128) * GDN_SH_BYTES), d0 = (unsigned)(WS_GD + (size_t)((bh * 2 + dir) * 128) * GDN_D_BYTES);
        unsigned delta[SC_NCH], dmask[SC_NCH];
#pragma unroll
        for (int j = 0; j < SC_NCH; ++j) { const int c = lid + 448 * j;
            delta[j] = (c < 3328) ? 16u * c : ((c < 3472) ? (unsigned)(G_VCT + 16 * e * 144 + 16 * (c - 3328)) : 16u * (c - 3472));
            dmask[j] = (c < 3472) ? 0u : 0xffffffffu; }
        v4u R0[SC_NCH], R1[SC_NCH], R2[SC_NCH];
#define SC_SRC(st) const int n_ = (dir == 0) ? ((st) < 128 ? (st) : 127) : ((st) < 128 ? 127 - (st) : 0); \
                   const unsigned shb_ = sh0 + (unsigned)n_ * (unsigned)GDN_SH_BYTES, ddf_ = (d0 + (unsigned)n_ * (unsigned)GDN_D_BYTES) - shb_;
        { SC_SRC(0) sc_issue(R0, F.ws, delta, dmask, shb_, ddf_); }
        { SC_SRC(1) sc_issue(R1, F.ws, delta, dmask, shb_, ddf_); }
        { SC_SRC(2) sc_issue(R2, F.ws, delta, dmask, shb_, ddf_); }
#define SC_BODY(R, st) { SC_WAIT(R, 22); sc_write(R, lds + ((st) & 1) * SC_SLOT, lid); { SC_SRC((st) + 3) sc_issue(R, F.ws, delta, dmask, shb_, ddf_); } \
                        asm volatile("s_waitcnt lgkmcnt(0)" ::: "memory"); __builtin_amdgcn_s_barrier(); }
#pragma unroll 1
        for (int s0 = 0; s0 < 126; s0 += 3) { SC_BODY(R0, s0) SC_BODY(R1, s0 + 1) SC_BODY(R2, s0 + 2) }
        SC_BODY(R0, 126) SC_BODY(R1, 127)
        SC_WAIT(R0, 0); SC_WAIT(R1, 0); SC_WAIT(R2, 0);
#undef SC_BODY
#undef SC_SRC
        return;
    }
    bf16* Odir = (bf16*)((unsigned char*)F.out + (dir == 0 ? DO_OF : DO_OB));
    f32x4 S[8];
#pragma unroll
    for (int i = 0; i < 8; ++i) S[i] = (f32x4){0.f, 0.f, 0.f, 0.f};
    bf16x8 Sb[4];
#pragma unroll
    for (int i = 0; i < 4; ++i) Sb[i] = (bf16x8){0, 0, 0, 0, 0, 0, 0, 0};
    const unsigned aoff272 = n16 * 272 + g * 16, aoff144 = n16 * 144 + g * 16;
    const unsigned lds0 = (unsigned)(uintptr_t)lds;
#define SB_() __builtin_amdgcn_sched_barrier(0)
#define LDR128(dst, base, off) asm volatile("ds_read_b128 %0, %1 offset:%2" : "=v"(dst) : "v"(base), "i"(off) : "memory")
#define LDR64(dst, base, off) asm volatile("ds_read_b64 %0, %1 offset:%2" : "=v"(dst) : "v"(base), "i"(off) : "memory")
#define LDR32(dst, base, off) asm volatile("ds_read_b32 %0, %1 offset:%2" : "=v"(dst) : "v"(base), "i"(off) : "memory")
#pragma unroll 1
    for (int step = 0; step < 128; ++step) {
        __builtin_amdgcn_s_barrier();
        asm volatile("" ::: "memory");
        const int n = dir == 0 ? step : 127 - step;
        const unsigned slot = lds0 + (unsigned)(step & 1) * SC_SLOT;
        const unsigned bK = slot + G_KNP + aoff272, bQ = slot + G_QNP + aoff272, bKT = slot + G_KNTP + aoff144, bT = slot + SC_D + GD_TBP + aoff144;
        const unsigned bV = slot + SC_VCT + n16 * 144 + g * 8, bvec = slot + SC_D + GD_VEC + g * 16, bd = slot + SC_D + GD_VEC;
        f32x4 eG[4], ks[4]; v2u vv[4]; float dch; bf16x8 fa[16];
        LDR128(eG[0], bvec, 0); LDR128(eG[1], bvec, 64); LDR128(eG[2], bvec, 128); LDR128(eG[3], bvec, 192);
        LDR128(ks[0], bvec, 256); LDR128(ks[1], bvec, 320); LDR128(ks[2], bvec, 384); LDR128(ks[3], bvec, 448);
        LDR32(dch, bd, 512);
        LDR64(vv[0], bV, 0); LDR64(vv[1], bV, 32); LDR64(vv[2], bV, 64); LDR64(vv[3], bV, 96);
#pragma unroll
        for (int m = 0; m < 4; ++m) { LDR128(fa[m * 4 + 0], bK, m * 4352 + 0); LDR128(fa[m * 4 + 1], bK, m * 4352 + 64); LDR128(fa[m * 4 + 2], bK, m * 4352 + 128); LDR128(fa[m * 4 + 3], bK, m * 4352 + 192); }
        bf16x8 fq[16];
#pragma unroll
        for (int m = 0; m < 4; ++m) { LDR128(fq[m * 4 + 0], bQ, m * 4352 + 0); LDR128(fq[m * 4 + 1], bQ, m * 4352 + 64); LDR128(fq[m * 4 + 2], bQ, m * 4352 + 128); LDR128(fq[m * 4 + 3], bQ, m * 4352 + 192); }
        asm volatile("s_waitcnt lgkmcnt(15)" : "+v"(eG[0]), "+v"(eG[1]), "+v"(eG[2]), "+v"(eG[3]), "+v"(ks[0]), "+v"(ks[1]), "+v"(ks[2]), "+v"(ks[3]), "+v"(dch), "+v"(vv[0]), "+v"(vv[1]), "+v"(vv[2]), "+v"(vv[3]),
                     "+v"(fa[0]), "+v"(fa[1]), "+v"(fa[2]), "+v"(fa[3]), "+v"(fa[4]), "+v"(fa[5]), "+v"(fa[6]), "+v"(fa[7]), "+v"(fa[8]), "+v"(fa[9]), "+v"(fa[10]), "+v"(fa[11]), "+v"(fa[12]), "+v"(fa[13]), "+v"(fa[14]), "+v"(fa[15]) :: "memory");
        SB_();
        f32x4 KS[4];
#pragma unroll
        for (int m = 0; m < 4; ++m) KS[m] = (f32x4){0.f, 0.f, 0.f, 0.f};
#pragma unroll
        for (int i = 0; i < 4; ++i)
#pragma unroll
            for (int m = 0; m < 4; ++m) KS[m] = __builtin_amdgcn_mfma_f32_16x16x32_bf16(fa[m * 4 + i], Sb[i], KS[m], 0, 0, 0);
        SB_();
        bf16x8 ft[8];
#pragma unroll
        for (int m = 0; m < 4; ++m) { LDR128(ft[m * 2 + 0], bT, m * 2304 + 0); LDR128(ft[m * 2 + 1], bT, m * 2304 + 64); }
        asm volatile("s_waitcnt lgkmcnt(8)" : "+v"(fq[0]), "+v"(fq[1]), "+v"(fq[2]), "+v"(fq[3]), "+v"(fq[4]), "+v"(fq[5]), "+v"(fq[6]), "+v"(fq[7]), "+v"(fq[8]), "+v"(fq[9]), "+v"(fq[10]), "+v"(fq[11]), "+v"(fq[12]), "+v"(fq[13]), "+v"(fq[14]), "+v"(fq[15]) :: "memory");
        SB_();
        f32x4 o[4];
#pragma unroll
        for (int m = 0; m < 4; ++m) o[m] = (f32x4){0.f, 0.f, 0.f, 0.f};
#pragma unroll
        for (int i = 0; i < 4; ++i)
#pragma unroll
            for (int m = 0; m < 4; ++m) o[m] = __builtin_amdgcn_mfma_f32_16x16x32_bf16(fq[m * 4 + i], Sb[i], o[m], 0, 0, 0);
        f32x4 rr[4];
#pragma unroll
        for (int m = 0; m < 4; ++m) { rr[m][0] = bflo(vv[m].x) - eG[m][0] * KS[m][0]; rr[m][1] = bfhi(vv[m].x) - eG[m][1] * KS[m][1]; rr[m][2] = bflo(vv[m].y) - eG[m][2] * KS[m][2]; rr[m][3] = bfhi(vv[m].y) - eG[m][3] * KS[m][3]; }
        bf16x8 rb[2]; rb[0] = pack8(rr[0], rr[1]); rb[1] = pack8(rr[2], rr[3]);
        SB_();
        bf16x8 fk[16];
#pragma unroll
        for (int jt = 0; jt < 8; ++jt) { LDR128(fk[jt * 2 + 0], bKT, jt * 2304 + 0); LDR128(fk[jt * 2 + 1], bKT, jt * 2304 + 64); }
        asm volatile("s_waitcnt lgkmcnt(15)" : "+v"(ft[0]), "+v"(ft[1]), "+v"(ft[2]), "+v"(ft[3]), "+v"(ft[4]), "+v"(ft[5]), "+v"(ft[6]), "+v"(ft[7]) :: "memory");
        SB_();
        f32x4 vn[4];
#pragma unroll
        for (int m = 0; m < 4; ++m) vn[m] = (f32x4){0.f, 0.f, 0.f, 0.f};
#pragma unroll
        for (int i = 0; i < 2; ++i)
#pragma unroll
            for (int m = 0; m < 4; ++m) vn[m] = __builtin_amdgcn_mfma_f32_16x16x32_bf16(ft[m * 2 + i], rb[i], vn[m], 0, 0, 0);
#pragma unroll
        for (int m = 0; m < 4; ++m) o[m] = o[m] * eG[m];
#pragma unroll
        for (int jt = 0; jt < 8; ++jt) S[jt] = S[jt] * dch;
        SB_();
        bf16x8 fp[8];
#pragma unroll
        for (int m = 0; m < 4; ++m) { LDR128(fp[m * 2 + 0], bT, GD_AP + m * 2304 + 0); LDR128(fp[m * 2 + 1], bT, GD_AP + m * 2304 + 64); }
        bf16x8 vnb[2]; vnb[0] = pack8(vn[0], vn[1]); vnb[1] = pack8(vn[2], vn[3]);
        bf16x8 vs[2]; vs[0] = pack8(vn[0] * ks[0], vn[1] * ks[1]); vs[1] = pack8(vn[2] * ks[2], vn[3] * ks[3]);
        asm volatile("s_waitcnt lgkmcnt(8)" : "+v"(fk[0]), "+v"(fk[1]), "+v"(fk[2]), "+v"(fk[3]), "+v"(fk[4]), "+v"(fk[5]), "+v"(fk[6]), "+v"(fk[7]), "+v"(fk[8]), "+v"(fk[9]), "+v"(fk[10]), "+v"(fk[11]), "+v"(fk[12]), "+v"(fk[13]), "+v"(fk[14]), "+v"(fk[15]) :: "memory");
        SB_();
#pragma unroll
        for (int i = 0; i < 2; ++i)
#pragma unroll
            for (int jt = 0; jt < 8; ++jt) S[jt] = __builtin_amdgcn_mfma_f32_16x16x32_bf16(fk[jt * 2 + i], vs[i], S[jt], 0, 0, 0);
        asm volatile("s_waitcnt lgkmcnt(0)" : "+v"(fp[0]), "+v"(fp[1]), "+v"(fp[2]), "+v"(fp[3]), "+v"(fp[4]), "+v"(fp[5]), "+v"(fp[6]), "+v"(fp[7]) :: "memory");
#pragma unroll
        for (int i = 0; i < 2; ++i)
#pragma unroll
            for (int m = 0; m < 4; ++m) o[m] = __builtin_amdgcn_mfma_f32_16x16x32_bf16(fp[m * 2 + i], vnb[i], o[m], 0, 0, 0);
#pragma unroll
        for (int i = 0; i < 4; ++i) Sb[i] = pack8(S[2 * i], S[2 * i + 1]);
        SB_();
        bf16* op = Odir + (size_t)(b * SEQ + n * 64) * 512 + h * 128 + 16 * e + n16;
#pragma unroll
        for (int m = 0; m < 4; ++m)
#pragma unroll
            for (int r = 0; r < 4; ++r) op[(size_t)(16 * m + 4 * g + r) * 512] = (bf16)(pk2(o[m][r], 0.f) & 0xffffu);
    }
#undef SB_
#undef LDR128
#undef LDR64
#undef LDR32
}

DI void p5_combine(Frame& F) {
    const int gw = F.vcu * NWAVES + F.wave, NGW = F.G * NWAVES, lane = F.lane;
    const bf16* OFp = (const bf16*)((unsigned char*)F.out + DO_OF); const bf16* OBp = (const bf16*)((unsigned char*)F.out + DO_OB);
    const bf16* ZA = (const bf16*)(F.ws + WS_ZA); bf16* OCAT = (bf16*)(F.ws + WS_OCAT);
    const float* nw = F.in[6] + (lane & 15) * 8;
    float w8[8];
#pragma unroll
    for (int c = 0; c < 8; ++c) w8[c] = nw[c];
    constexpr int NB4 = 4;
    for (int t0 = gw; t0 < TT; t0 += NB4 * NGW) {
        v4u a[NB4], bb[NB4], z[NB4];
#pragma unroll
        for (int u = 0; u < NB4; ++u) { const int t = (t0 + u * NGW < TT) ? t0 + u * NGW : t0;
            a[u] = *(const v4u*)(OFp + (size_t)t * 512 + lane * 8); bb[u] = *(const v4u*)(OBp + (size_t)t * 512 + lane * 8); z[u] = *(const v4u*)(ZA + (size_t)t * 512 + lane * 8); }
#pragma unroll
        for (int u = 0; u < NB4; ++u) {
            const int t = t0 + u * NGW; if (t >= TT) break;
            float o[8] = {bflo(a[u].x) + bflo(bb[u].x), bfhi(a[u].x) + bfhi(bb[u].x), bflo(a[u].y) + bflo(bb[u].y), bfhi(a[u].y) + bfhi(bb[u].y), bflo(a[u].z) + bflo(bb[u].z), bfhi(a[u].z) + bfhi(bb[u].z), bflo(a[u].w) + bflo(bb[u].w), bfhi(a[u].w) + bfhi(bb[u].w)};
            const float zz[8] = {bflo(z[u].x), bfhi(z[u].x), bflo(z[u].y), bfhi(z[u].y), bflo(z[u].z), bfhi(z[u].z), bflo(z[u].w), bfhi(z[u].w)};
            float ss = 0.f;
#pragma unroll
            for (int c = 0; c < 8; ++c) ss += o[c] * o[c];
            ss += __shfl_xor(ss, 1); ss += __shfl_xor(ss, 2); ss += __shfl_xor(ss, 4); ss += __shfl_xor(ss, 8);
            const float rn = 1.0f / sqrtf(ss * (1.f / 128.f) + EPS);
#pragma unroll
            for (int c = 0; c < 8; ++c) o[c] = o[c] * rn * w8[c] * siluf(zz[c]);
            v4u r; r.x = pk2(o[0], o[1]); r.y = pk2(o[2], o[3]); r.z = pk2(o[4], o[5]); r.w = pk2(o[6], o[7]);
            *(v4u*)(OCAT + (size_t)t * 1024 + lane * 8) = r;
        }
    }
}

struct TokRec { int e[2]; int row[2]; float gate[2]; };
DI void p7_route(Frame& F) {
    const int gw = F.vcu * NWAVES + F.wave, NGW = F.G * NWAVES, lane = F.lane, n16 = lane & 15, g = lane >> 4;
    const float* X1 = (const float*)(F.ws + WS_X1); const float* nfw = F.in[10];
    const bf16* WRH = (const bf16*)(F.ws + WS_WR); const bf16* WRL = WRH + 48 * 1024;
    bf16* HN = (bf16*)((unsigned char*)F.out + DO_HN); TokRec* TOK = (TokRec*)(F.ws + WS_TOK); unsigned* cnt = (unsigned*)(F.ws + WS_CTL) + CW_CNT; int* LIST = (int*)(F.ws + WS_LIST);
    LAS float* lg = (LAS float*)(F.lds + F.wave * 4096);
    for (int rt = gw; rt < TT / 16; rt += NGW) {
        const int row = rt * 16 + n16; const float* xr = X1 + (size_t)row * DMODEL + 8 * g;
        float ss = 0.f;
#pragma unroll 16
        for (int i = 0; i < 32; ++i) { const f32x4 a = *(const f32x4*)(xr + 32 * i), b2 = *(const f32x4*)(xr + 32 * i + 4);
            ss += (a.x * a.x + a.y * a.y) + (a.z * a.z + a.w * a.w) + (b2.x * b2.x + b2.y * b2.y) + (b2.z * b2.z + b2.w * b2.w); }
        ss += __shfl_xor(ss, 16); ss += __shfl_xor(ss, 32);
        const float rs = 1.0f / sqrtf(ss * (1.f / DMODEL) + EPS);
        f32x4 acc[3];
#pragma unroll
        for (int q = 0; q < 3; ++q) acc[q] = (f32x4){0.f, 0.f, 0.f, 0.f};
#pragma unroll 4
        for (int i = 0; i < 32; ++i) {
            const f32x4 a = *(const f32x4*)(xr + 32 * i), b2 = *(const f32x4*)(xr + 32 * i + 4);
            const f32x4 wa = *(const f32x4*)(nfw + 32 * i + 8 * g), wb = *(const f32x4*)(nfw + 32 * i + 8 * g + 4);
            float hv[8] = {a.x * rs * wa.x, a.y * rs * wa.y, a.z * rs * wa.z, a.w * rs * wa.w, b2.x * rs * wb.x, b2.y * rs * wb.y, b2.z * rs * wb.z, b2.w * rs * wb.w};
            v4u hi, lo; unsigned hh[8], ll[8];
#pragma unroll
            for (int c = 0; c < 8; ++c) { hh[c] = f2bf(hv[c]); ll[c] = f2bf(hv[c] - __builtin_bit_cast(float, hh[c] << 16)); }
            hi.x = hh[0] | (hh[1] << 16); hi.y = hh[2] | (hh[3] << 16); hi.z = hh[4] | (hh[5] << 16); hi.w = hh[6] | (hh[7] << 16);
            lo.x = ll[0] | (ll[1] << 16); lo.y = ll[2] | (ll[3] << 16); lo.z = ll[4] | (ll[5] << 16); lo.w = ll[6] | (ll[7] << 16);
            *(v4u*)(HN + (size_t)row * DMODEL + 32 * i + 8 * g) = hi;
            const bf16x8 ah = __builtin_bit_cast(bf16x8, hi), al = __builtin_bit_cast(bf16x8, lo);
#pragma unroll
            for (int q = 0; q < 3; ++q) {
                const bf16x8 bh = *(const bf16x8*)(WRH + (size_t)(16 * q + n16) * 1024 + 32 * i + 8 * g), bl = *(const bf16x8*)(WRL + (size_t)(16 * q + n16) * 1024 + 32 * i + 8 * g);
                acc[q] = __builtin_amdgcn_mfma_f32_16x16x32_bf16(ah, bh, acc[q], 0, 0, 0);
                acc[q] = __builtin_amdgcn_mfma_f32_16x16x32_bf16(ah, bl, acc[q], 0, 0, 0);
                acc[q] = __builtin_amdgcn_mfma_f32_16x16x32_bf16(al, bh, acc[q], 0, 0, 0);
            }
        }
#pragma unroll
        for (int q = 0; q < 3; ++q)
#pragma unroll
            for (int r = 0; r < 4; ++r) lg[(4 * g + r) * 48 + 16 * q + n16] = acc[q][r];
        asm volatile("s_waitcnt lgkmcnt(0)" ::: "memory");
        if (lane < 16) {
            const LAS float* L = lg + lane * 48; const int tok = rt * 16 + lane;
            float gm = L[0]; int gs = 0;
#pragma unroll
            for (int q = 1; q < 4; ++q) if (L[q] > gm) { gm = L[q]; gs = q; }
            float gsum = 0.f;
#pragma unroll
            for (int q = 0; q < 4; ++q) gsum += __expf(L[q] - gm);
            const float gp_top = 1.0f / gsum;
            float fv[8];
#pragma unroll
            for (int q = 0; q < 8; ++q) { float v = L[4 + q]; v = (gs == 1) ? L[12 + q] : v; v = (gs == 2) ? L[20 + q] : v; v = (gs == 3) ? L[28 + q] : v; fv[q] = v; }
            float m1 = fv[0]; int i1 = 0;
#pragma unroll
            for (int q = 1; q < 8; ++q) if (fv[q] > m1) { m1 = fv[q]; i1 = q; }
            float m2 = -3.0e38f; int i2 = 0;
#pragma unroll
            for (int q = 0; q < 8; ++q) if (q != i1 && fv[q] > m2) { m2 = fv[q]; i2 = q; }
            const float e2 = __expf(m2 - m1); const float g1 = gp_top / (1.0f + e2), g2 = gp_top * e2 / (1.0f + e2);
            const int ex1 = gs * 8 + i1, ex2 = gs * 8 + i2;
            const int s1 = (int)atomicAdd(cnt + ex1, 1u), s2 = (int)atomicAdd(cnt + ex2, 1u);
            LIST[ex1 * TT + s1] = tok; LIST[ex2 * TT + s2] = tok;
            TokRec tr; tr.e[0] = ex1; tr.e[1] = ex2; tr.row[0] = s1; tr.row[1] = s2; tr.gate[0] = g1; tr.gate[1] = g2;
            TOK[tok] = tr;
        }
        asm volatile("s_waitcnt lgkmcnt(0)" ::: "memory");
    }
}

DI void build_etab(Frame& F) {
    LAS unsigned* etab = (LAS unsigned*)(F.lds + ETAB_OFF);
    if (F.tid == 0) {
        const unsigned* ctl = (const unsigned*)(F.ws + WS_CTL); unsigned acc = 0;
        for (int e = 0; e < NEXP; ++e) { const unsigned c = __hip_atomic_load(ctl + CW_CNT + e, __ATOMIC_RELAXED, __HIP_MEMORY_SCOPE_AGENT); const unsigned ntile = (c + 255u) >> 8;
            etab[2 * e] = acc; etab[2 * e + 1] = ntile; etab[64 + e] = c; acc += ntile; }
    }
    __syncthreads();
}

DI void p11_final(Frame& F) {
    build_etab(F);
    const LAS unsigned* etab = (const LAS unsigned*)(F.lds + ETAB_OFF);
    const int gw = F.vcu * NWAVES + F.wave, NGW = F.G * NWAVES, lane = F.lane;
    const bf16* Y = (const bf16*)(F.ws + WS_XBUF); const TokRec* TOK = (const TokRec*)(F.ws + WS_TOK); const float* fw = F.in[16];
    const f32x4 w0 = *(const f32x4*)(fw + lane * 8), w1 = *(const f32x4*)(fw + lane * 8 + 4), w2 = *(const f32x4*)(fw + 512 + lane * 8), w3 = *(const f32x4*)(fw + 516 + lane * 8);
    constexpr int NB2 = 2;
    for (int t0 = gw; t0 < TT; t0 += NB2 * NGW) {
        TokRec tr[NB2]; f32x4 xa[NB2][4]; v4u ya[NB2][2][2];
#pragma unroll
        for (int u = 0; u < NB2; ++u) { const int t = (t0 + u * NGW < TT) ? t0 + u * NGW : t0; tr[u] = TOK[t];
            const float* xr = (const float*)(F.ws + WS_X1) + (size_t)t * DMODEL + lane * 8;
            xa[u][0] = *(const f32x4*)(xr); xa[u][1] = *(const f32x4*)(xr + 4); xa[u][2] = *(const f32x4*)(xr + 512); xa[u][3] = *(const f32x4*)(xr + 516); }
#pragma unroll
        for (int u = 0; u < NB2; ++u)
#pragma unroll
            for (int k = 0; k < 2; ++k) { const bf16* yr = Y + (size_t)(etab[2 * tr[u].e[k]] * 256u + (unsigned)tr[u].row[k]) * DMODEL + lane * 8; ya[u][k][0] = *(const v4u*)(yr); ya[u][k][1] = *(const v4u*)(yr + 512); }
#pragma unroll
        for (int u = 0; u < NB2; ++u) {
            const int t = t0 + u * NGW; if (t >= TT) break;
            float v[16] = {xa[u][0].x, xa[u][0].y, xa[u][0].z, xa[u][0].w, xa[u][1].x, xa[u][1].y, xa[u][1].z, xa[u][1].w, xa[u][2].x, xa[u][2].y, xa[u][2].z, xa[u][2].w, xa[u][3].x, xa[u][3].y, xa[u][3].z, xa[u][3].w};
#pragma unroll
            for (int k = 0; k < 2; ++k) {
                const float gk = tr[u].gate[k]; const v4u y0 = ya[u][k][0], y1 = ya[u][k][1];
                v[0] += gk * bflo(y0.x); v[1] += gk * bfhi(y0.x); v[2] += gk * bflo(y0.y); v[3] += gk * bfhi(y0.y); v[4] += gk * bflo(y0.z); v[5] += gk * bfhi(y0.z); v[6] += gk * bflo(y0.w); v[7] += gk * bfhi(y0.w);
                v[8] += gk * bflo(y1.x); v[9] += gk * bfhi(y1.x); v[10] += gk * bflo(y1.y); v[11] += gk * bfhi(y1.y); v[12] += gk * bflo(y1.z); v[13] += gk * bfhi(y1.z); v[14] += gk * bflo(y1.w); v[15] += gk * bfhi(y1.w);
            }
            float ss = 0.f;
#pragma unroll
            for (int i = 0; i < 16; ++i) ss += v[i] * v[i];
            const float rs = 1.0f / sqrtf(wave_sum(ss) * (1.f / DMODEL) + EPS);
            float* orow = F.out + (size_t)t * DMODEL + lane * 8;
            *(f32x4*)(orow) = (f32x4){v[0] * rs * w0.x, v[1] * rs * w0.y, v[2] * rs * w0.z, v[3] * rs * w0.w};
            *(f32x4*)(orow + 4) = (f32x4){v[4] * rs * w1.x, v[5] * rs * w1.y, v[6] * rs * w1.z, v[7] * rs * w1.w};
            *(f32x4*)(orow + 512) = (f32x4){v[8] * rs * w2.x, v[9] * rs * w2.y, v[10] * rs * w2.z, v[11] * rs * w2.w};
            *(f32x4*)(orow + 516) = (f32x4){v[12] * rs * w3.x, v[13] * rs * w3.y, v[14] * rs * w3.z, v[15] * rs * w3.w};
        }
    }
}

struct Args { const float* in[17]; float* out; unsigned char* ws; int ph_lo, ph_hi; };
__global__ void __launch_bounds__(NTHREADS, 2) fwd_kernel(Args args) {
    extern __shared__ __attribute__((aligned(16))) unsigned char lds[];
    cg::grid_group grid = cg::this_grid();
    Frame F;
    F.lds = (LAS unsigned char*)lds; F.tid = threadIdx.x; F.lane = F.tid & 63; F.wave = __builtin_amdgcn_readfirstlane(F.tid >> 6);
    F.G = gridDim.x; { const int bx = blockIdx.x; F.vcu = (F.G % 8 == 0) ? (bx % 8) * (F.G / 8) + bx / 8 : bx; }
#pragma unroll
    for (int i = 0; i < 17; ++i) F.in[i] = args.in[i];
    F.out = args.out; F.ws = args.ws;
    const int lo = args.ph_lo, hi = args.ph_hi;
    if (F.tid < 16) ((volatile LAS unsigned*)(F.lds + MISC_OFF))[F.tid] = 0u;
    __syncthreads();
    XcdBarrier bar = xcd_barrier_post((unsigned*)(F.ws + WS_CTL) + CW_BAR, (volatile LAS unsigned*)(F.lds + MISC_OFF));
    if (lo > 1000) grid.sync();
#ifndef PHSEL
#define PHSEL 0xfff
#endif
#define IN(k) (((PHSEL >> (k)) & 1) && lo <= (k) && (k) < hi)
#define SEAM(k) do { if (IN(k) && IN((k) + 1)) xcd_barrier(bar); } while (0)
#ifndef REP_PH
#define REP_PH -1
#endif
#define REPS(k) for (int rep_ = 0; rep_ < ((k) == REP_PH ? 2 : 1); ++rep_, ((k) == REP_PH && rep_ < 2) ? xcd_barrier(bar) : (void)0)
    if (IN(0)) REPS(0) { p0_prologue(F); } SEAM(0);
    if (IN(1)) REPS(1) {
        pg8::Gemm gm{(const pg8::bf16_t*)(F.ws + WS_XN), (const pg8::bf16_t*)(F.ws + WS_WIN), TT, NPROJ, DMODEL}; pg8::StaticOrder S; S.init(TT, NPROJ, F.G, (int)blockIdx.x);
        EpiProj E{(bf16*)(F.ws + WS_QKVA), (bf16*)(F.ws + WS_ZA), (bf16*)(F.ws + WS_QKVB), (float*)(F.ws + WS_GATES)};
        pg8::gemm_phase<EpiProj, pg8::StaticOrder, true, true>(F.lds, gm, S, E);
    } SEAM(1);
    if (IN(2)) REPS(2) {
#ifndef NO_ROPE
        p2_rope(F);
#ifdef PROBE_ROPE2
        xcd_barrier(bar); p2_rope(F);
#endif
#endif
#ifndef NO_PRE
        p2_gdn_pre(F);
#ifdef PROBE_PRE2
        xcd_barrier(bar); p2_gdn_pre(F);
#endif
#endif
    } SEAM(2);
    if (IN(3)) REPS(3) {
        const attn_body::AttnTensors AT{(const attn_body::bf16*)((unsigned char*)F.out + DO_QR), (const attn_body::bf16*)((unsigned char*)F.out + DO_KR), (const attn_body::bf16*)((unsigned char*)F.out + DO_VR),
                                        (attn_body::bf16*)(F.ws + WS_OCAT) + 512};
        const attn_body::StaticOrder S((int)F.G, (int)blockIdx.x);
#ifdef PROBE_ZERO_ATTN
        { (void)AT; (void)S; bf16* OC = (bf16*)(F.ws + WS_OCAT); const int gt = blockIdx.x * NTHREADS + F.tid, GT = F.G * NTHREADS;
          for (int i = gt; i < TT * 64; i += GT) { const int t = i >> 6, c = i & 63; *(v4u*)(OC + (size_t)t * 1024 + 512 + c * 8) = (v4u){0u, 0u, 0u, 0u}; } }
#else
        attn_body::attn_phase<attn_body::StaticOrder>((char*)lds, AT, S);
#endif
    } SEAM(3);
#ifdef PROBE_SCAN2
    if (IN(4)) { p4_scan(F); xcd_barrier(bar); p4_scan(F); } SEAM(4);
#else
    if (IN(4)) REPS(4) { p4_scan(F); } SEAM(4);
#endif
    if (IN(5)) REPS(5) { p5_combine(F); if (F.G <= 128) { small_weights(F, F.vcu * NWAVES + F.wave, F.G * NWAVES); moe_weights(F, F.vcu * NWAVES + F.wave, F.G * NWAVES); } } SEAM(5);
    if (IN(6)) REPS(6) {
        pg8::Gemm gm{(const pg8::bf16_t*)(F.ws + WS_OCAT), (const pg8::bf16_t*)(F.ws + WS_WOUT), TT, DMODEL, DMODEL}; pg8::StaticOrder S; S.init(TT, DMODEL, F.G, (int)blockIdx.x);
        EpiResid E{F.in[0], (float*)(F.ws + WS_X1)};
        pg8::gemm_phase<EpiResid, pg8::StaticOrder, true, true>(F.lds, gm, S, E);
    } SEAM(6);
    if (IN(7)) { p7_route(F); } SEAM(7);
    if (IN(9)) REPS(9) {
        build_etab(F);
        pg8::Gemm gm{(const pg8::bf16_t*)((unsigned char*)F.out + DO_HN), (const pg8::bf16_t*)(F.ws + WS_WGU0), 0, 0, DMODEL};
        MoeOrder S{(const LAS unsigned*)(F.lds + ETAB_OFF), F.G, (int)blockIdx.x, WGU_SPLIT, (int)((WS_WGU1 - WS_WGU0) / (512 * 1024))};
        MoeRows AM{(const int*)(F.ws + WS_LIST), (const LAS unsigned*)(F.lds + ETAB_OFF)};
        EpiGU E{(bf16*)(F.ws + WS_HID)};
        pg8::gemm_phase_gather<EpiGU, MoeOrder, MoeRows, true>(F.lds, gm, S, E, AM);
    } SEAM(9);
    if (IN(10)) REPS(10) {
        pg8::Gemm gm{(const pg8::bf16_t*)(F.ws + WS_HID), (const pg8::bf16_t*)((unsigned char*)F.out + DO_WD0), 0, 0, FFE}; build_etab(F); MoeOrder S{(const LAS unsigned*)(F.lds + ETAB_OFF), F.G, (int)blockIdx.x, WD_SPLIT, (int)((DO_WD1 - DO_WD0) / (256 * 1024))};
        EpiY E{(bf16*)(F.ws + WS_XBUF)};
        pg8::gemm_phase<EpiY, MoeOrder, true, true>(F.lds, gm, S, E);
    } SEAM(10);
#ifdef EXTRA_SYNCS
    for (int q_ = 0; q_ < EXTRA_SYNCS; ++q_) xcd_barrier(bar);
#endif
    if (IN(11)) { p11_final(F); }
#undef IN
#undef SEAM
}

extern "C" void kernel_launch(void* const* d_in, const int* in_sizes, int n_in, void* d_out, int out_size, void* d_ws, size_t ws_size, hipStream_t stream) {
    static int grid = 0;
    if (grid == 0) {
        if (n_in != 17 || out_size != TT * DMODEL || ws_size < WS_END) { fprintf(stderr, "kernel_launch: unexpected problem (n_in %d out %d ws %zu)\n", n_in, out_size, ws_size); grid = -1; return; }
        int dev = 0, cus = 0, per_cu = 0;
        if (hipGetDevice(&dev) != hipSuccess || hipDeviceGetAttribute(&cus, hipDeviceAttributeMultiprocessorCount, dev) != hipSuccess) { grid = -1; return; }
        if (hipFuncSetAttribute((const void*)fwd_kernel, hipFuncAttributeMaxDynamicSharedMemorySize, LDS_BYTES) != hipSuccess) { fprintf(stderr, "hipFuncSetAttribute failed\n"); grid = -1; return; }
        if (hipOccupancyMaxActiveBlocksPerMultiprocessor(&per_cu, (const void*)fwd_kernel, NTHREADS, LDS_BYTES) != hipSuccess || per_cu < 1) { fprintf(stderr, "occupancy query: %d\n", per_cu); grid = -1; return; }
        grid = cus;
    }
    if (grid < 0) return;
    (void)hipMemsetAsync((char*)d_ws + WS_CTL, 0, CTL_ZERO_BYTES, stream);
    Args a{};
    for (int i = 0; i < 17; ++i) a.in[i] = (const float*)d_in[i];
    a.out = (float*)d_out; a.ws = (unsigned char*)d_ws;
#if MK_PER_PHASE
    for (int p = 0; p < N_PHASES; ++p) { a.ph_lo = p; a.ph_hi = p + 1; hipLaunchKernelGGL(fwd_kernel, dim3(grid), dim3(NTHREADS), LDS_BYTES, stream, a); }
#else
    a.ph_lo = 0; a.ph_hi = N_PHASES;
    void* kargs[] = {&a};
    hipError_t e = hipLaunchCooperativeKernel((void*)fwd_kernel, dim3(grid), dim3(NTHREADS), kargs, LDS_BYTES, stream);
    if (e != hipSuccess) fprintf(stderr, "cooperative launch failed: %s (grid %d)\n", hipGetErrorString(e), grid);
#endif
}
```

```cpp
#include <hip/hip_runtime.h>
#include <cstdio>
#include <cstdint>
namespace pg8 {
#define PG8_LAS __attribute__((address_space(3)))
typedef unsigned short bf16_t;
typedef short bf16x8 __attribute__((ext_vector_type(8)));
typedef float f32x4 __attribute__((ext_vector_type(4)));
typedef unsigned u32x4 __attribute__((ext_vector_type(4)));
constexpr int BM = 256, BK = 64, HALF = 128, HTB = HALF * BK * 2  , STAGE_BYTES = 8 * HTB, NXCD = 8, WGM = 8;

__host__ __device__ __forceinline__ int lds_byte(int r, int c) { const int st = (r >> 4) * 2 + (c >> 5), rr = r & 15, cc = c & 31, ob = rr * 64 + cc * 2; return st * 1024 + (ob ^ (((ob >> 9) & 1) << 5)); }
__host__ __device__ __forceinline__ void stage_rc(int b, int& R, int& C) { const int st = b / 1024, sb = b % 1024, swz = sb ^ (((sb >> 9) & 1) << 5); R = (st >> 1) * 16 + swz / 64; C = (st & 1) * 32 + (swz % 64) / 2; }
__host__ __device__ __forceinline__ int perm32(int rho) { const int n = rho >> 4, i = rho & 15; return 8 * (i >> 2) + 4 * n + (i & 3); }

struct Unit { int pm, pn, ex, tq; };
struct Gemm { const bf16_t* A; const bf16_t* Bt; int M, N, K; };

struct StaticOrder {
    int nM, nN, nwg, G, c;
    __host__ __device__ void init(int M, int N, int G_, int c_) { nM = M / BM; nN = N / BM; nwg = nM * nN; G = G_; c = c_; }
    __host__ __device__ bool next(int i, Unit& u) const {
        const long L = (long)i * G + c; if (L >= nwg) return false;
        int wgid = (int)L; { const int q = nwg / NXCD, r = nwg % NXCD, xcd = wgid % NXCD, off = wgid / NXCD; wgid = (xcd < r ? xcd * (q + 1) : r * (q + 1) + (xcd - r) * q) + off; }
        const int nig = WGM * nN, gid = wgid / nig, fm = gid * WGM, gsz = (nM - fm) < WGM ? (nM - fm) : WGM;
        u.pm = fm + ((wgid % nig) % gsz); u.pn = (wgid % nig) / gsz; return true;
    }
    __device__ __forceinline__ void a_ready(const Unit&) const {}
    __device__ __forceinline__ void done(const Unit&) const {}
};

__device__ __forceinline__ unsigned cvt_pk_bf16(float lo, float hi) { unsigned r; asm volatile("v_cvt_pk_bf16_f32 %0, %1, %2" : "=v"(r) : "v"(lo), "v"(hi)); return r; }
typedef float f32x2 __attribute__((ext_vector_type(2)));
template <class Epi, class Sched, bool ALIGN_EPI = false, bool SP2 = false>
__device__ __forceinline__ void gemm_phase(PG8_LAS unsigned char* lds, const Gemm g, const Sched& S, const Epi& E) {
    const int tid = threadIdx.x, wid = __builtin_amdgcn_readfirstlane(tid >> 6), lane = tid & 63, wr = wid >> 2, wc = wid & 3, fr = lane & 15, fq = lane >> 4;
    const int K = g.K, nt = K / BK;
    unsigned voffA[2], voffB[2];
#pragma unroll
    for (int i = 0; i < 2; ++i) { int R, C; stage_rc(tid * 16 + i * 8192, R, C); const int Rb = Epi::PERM ? ((R & ~31) + perm32(R & 31)) : R;
        voffA[i] = (unsigned)(R * K + C) * 2u; voffB[i] = (unsigned)(Rb * K + C) * 2u; }
    const size_t kstep = (size_t)(BK * 2);
    const size_t hstep = (size_t)HALF * K * 2;
    const size_t tstep = 2 * hstep;
    const unsigned ldsw = (unsigned)wid * 1024u;
    const int aoff = lds_byte(wr * 64 + fr, fq * 8), boff = lds_byte(wc * 32 + fr, fq * 8);
#define PG8_SA(b, h) (((b) * 2 + (h)) * HTB)
#define PG8_SB(b, h) ((4 + (b) * 2 + (h)) * HTB)
#define PG8_STAGE(bufoff, gbase, voff) do { _Pragma("unroll") for (int _i = 0; _i < 2; ++_i) \
        __builtin_amdgcn_global_load_lds((const unsigned*)((const char*)(gbase) + (voff)[_i]), (PG8_LAS unsigned*)(lds + (bufoff) + ldsw + _i * 8192), 16, 0, 0); } while (0)
#define PG8_LDA(dst, b, h) do { _Pragma("unroll") for (int m = 0; m < 4; ++m) _Pragma("unroll") for (int k = 0; k < 2; ++k) dst[m][k] = *(const PG8_LAS bf16x8*)(lds + PG8_SA(b, h) + aoff + m * 2048 + k * 1024); } while (0)
#define PG8_LDB(dst, b, h) do { _Pragma("unroll") for (int n = 0; n < 2; ++n) _Pragma("unroll") for (int k = 0; k < 2; ++k) dst[n][k] = *(const PG8_LAS bf16x8*)(lds + PG8_SB(b, h) + boff + n * 2048 + k * 1024); } while (0)
#define PG8_MMA(ai, bj, At, Bt) do { __builtin_amdgcn_s_setprio(1); _Pragma("unroll") for (int m = 0; m < 4; ++m) _Pragma("unroll") for (int n = 0; n < 2; ++n) _Pragma("unroll") for (int k = 0; k < 2; ++k) \
        acc[ai][bj][m][n] = __builtin_amdgcn_mfma_f32_16x16x32_bf16(Bt[n][k], At[m][k], acc[ai][bj][m][n], 0, 0, 0); __builtin_amdgcn_s_setprio(0); } while (0)
#define PG8_WAIT_V(n) asm volatile("s_waitcnt vmcnt(" #n ")" ::: "memory")
#define PG8_WAIT_L(n) asm volatile("s_waitcnt lgkmcnt(" #n ")" ::: "memory")
#define PG8_BAR __builtin_amdgcn_s_barrier()
#define PG8_SCHED __builtin_amdgcn_sched_barrier(0)
    Unit cur, nxt; int ui = 0;
    if (!S.next(0, cur)) return;
    f32x4 acc[2][2][4][2];
#pragma unroll
    for (int a = 0; a < 2; ++a)
#pragma unroll
        for (int b = 0; b < 2; ++b)
#pragma unroll
            for (int m = 0; m < 4; ++m)
#pragma unroll
                for (int n = 0; n < 2; ++n) acc[a][b][m][n] = (f32x4){0.f, 0.f, 0.f, 0.f};
    bf16x8 At[4][2], B0[2][2], B1[2][2];
    const char* cA = (const char*)g.A + (size_t)cur.pm * tstep; const char* cB = (const char*)g.Bt + (size_t)cur.pn * tstep;
    S.a_ready(cur);
    if constexpr (SP2) {
        PG8_STAGE(PG8_SB(0, 0), cB, voffB); PG8_STAGE(PG8_SB(0, 1), cB + hstep, voffB); PG8_STAGE(PG8_SA(0, 0), cA, voffA); PG8_STAGE(PG8_SA(0, 1), cA + hstep, voffA);
        if (wr == 1) PG8_BAR;
        PG8_WAIT_V(2); PG8_BAR;
        PG8_STAGE(PG8_SB(1, 0), cB + kstep, voffB); PG8_STAGE(PG8_SA(1, 0), cA + kstep, voffA); PG8_STAGE(PG8_SB(1, 1), cB + hstep + kstep, voffB);
        PG8_WAIT_V(6); PG8_BAR;
    } else {
        PG8_STAGE(PG8_SB(0, 0), cB, voffB); PG8_STAGE(PG8_SA(0, 0), cA, voffA); PG8_STAGE(PG8_SB(0, 1), cB + hstep, voffB); PG8_STAGE(PG8_SA(0, 1), cA + hstep, voffA);
        if (wr == 1) PG8_BAR;
        PG8_WAIT_V(4); PG8_BAR;
        PG8_STAGE(PG8_SB(1, 0), cB + kstep, voffB); PG8_STAGE(PG8_SA(1, 0), cA + kstep, voffA); PG8_STAGE(PG8_SB(1, 1), cB + hstep + kstep, voffB);
        PG8_WAIT_V(6); PG8_BAR;
    }
    for (;;) {
        const bool has_next = S.next(ui + 1, nxt);
        const char* nA = has_next ? (const char*)g.A + (size_t)nxt.pm * tstep : cA; const char* nB = has_next ? (const char*)g.Bt + (size_t)nxt.pn * tstep : cB;
        for (int t = 0; t < nt; t += 2) {
            const bool last = (t == nt - 2);
            const char* a1 = cA + (size_t)(t + 1) * kstep;
            const char* a2 = last ? nA : cA + (size_t)(t + 2) * kstep; const char* b2 = last ? nB : cB + (size_t)(t + 2) * kstep;
            const char* a3 = a2 + kstep; const char* b3 = b2 + kstep;
            if (last && has_next) S.a_ready(nxt);
            if constexpr (SP2) {
            PG8_LDB(B0, 0, 0); PG8_LDB(B1, 0, 1); PG8_SCHED; PG8_LDA(At, 0, 0); PG8_STAGE(PG8_SA(1, 1), a1 + hstep, voffA);
            PG8_WAIT_V(8); PG8_WAIT_L(0); PG8_BAR; PG8_MMA(0, 0, At, B0); PG8_MMA(0, 1, At, B1); PG8_BAR; PG8_SCHED;
            PG8_LDA(At, 0, 1); PG8_STAGE(PG8_SB(0, 0), b2, voffB); PG8_STAGE(PG8_SB(0, 1), b2 + hstep, voffB); PG8_STAGE(PG8_SA(0, 0), a2, voffA);
            PG8_WAIT_V(8); PG8_WAIT_L(0); PG8_BAR; PG8_MMA(1, 0, At, B0); PG8_MMA(1, 1, At, B1); PG8_BAR; PG8_SCHED;
            PG8_LDB(B0, 1, 0); PG8_LDB(B1, 1, 1); PG8_SCHED; PG8_LDA(At, 1, 0); PG8_STAGE(PG8_SA(0, 1), a2 + hstep, voffA);
            PG8_WAIT_V(8); PG8_WAIT_L(0); PG8_BAR; PG8_MMA(0, 0, At, B0); PG8_MMA(0, 1, At, B1); PG8_BAR; PG8_SCHED;
            PG8_LDA(At, 1, 1); PG8_STAGE(PG8_SB(1, 0), b3, voffB); PG8_STAGE(PG8_SB(1, 1), b3 + hstep, voffB); PG8_STAGE(PG8_SA(1, 0), a3, voffA);
            PG8_WAIT_V(8); PG8_WAIT_L(0); PG8_BAR; PG8_MMA(1, 0, At, B0); PG8_MMA(1, 1, At, B1); PG8_BAR; PG8_SCHED;
            } else {
            PG8_LDB(B0, 0, 0); PG8_SCHED; PG8_LDA(At, 0, 0); PG8_STAGE(PG8_SA(1, 1), a1 + hstep, voffA);
            PG8_WAIT_L(8); PG8_BAR; PG8_WAIT_L(0); PG8_MMA(0, 0, At, B0); PG8_BAR; PG8_SCHED;
            PG8_LDB(B1, 0, 1); PG8_STAGE(PG8_SB(0, 0), b2, voffB);
            PG8_BAR; PG8_WAIT_L(0); PG8_MMA(0, 1, At, B1); PG8_BAR;
            PG8_LDA(At, 0, 1); PG8_STAGE(PG8_SA(0, 0), a2, voffA);
            PG8_BAR; PG8_WAIT_L(0); PG8_MMA(1, 0, At, B0); PG8_BAR; PG8_SCHED;
            PG8_STAGE(PG8_SB(0, 1), b2 + hstep, voffB);
            PG8_WAIT_V(6); PG8_BAR; PG8_MMA(1, 1, At, B1); PG8_BAR;
            PG8_LDB(B0, 1, 0); PG8_SCHED; PG8_LDA(At, 1, 0); PG8_STAGE(PG8_SA(0, 1), a2 + hstep, voffA);
            PG8_WAIT_L(8); PG8_BAR; PG8_WAIT_L(0); PG8_MMA(0, 0, At, B0); PG8_BAR; PG8_SCHED;
            PG8_LDB(B1, 1, 1); PG8_STAGE(PG8_SB(1, 0), b3, voffB);
            PG8_BAR; PG8_WAIT_L(0); PG8_MMA(0, 1, At, B1); PG8_BAR;
            PG8_LDA(At, 1, 1); PG8_STAGE(PG8_SA(1, 0), a3, voffA);
            PG8_BAR; PG8_WAIT_L(0); PG8_MMA(1, 0, At, B0); PG8_BAR; PG8_SCHED;
            PG8_STAGE(PG8_SB(1, 1), b3 + hstep, voffB);
            PG8_WAIT_V(6); PG8_BAR; PG8_MMA(1, 1, At, B1); PG8_BAR;
            }
        }
        if constexpr (ALIGN_EPI) { if (wr == 0) PG8_BAR; }
        if constexpr (!Epi::AFTER_DRAIN) { E(acc, cur, wr, wc, fr, fq); S.done(cur); }
        if (!has_next) break;
#pragma unroll
        for (int a = 0; a < 2; ++a)
#pragma unroll
            for (int b = 0; b < 2; ++b)
#pragma unroll
                for (int m = 0; m < 4; ++m)
#pragma unroll
                    for (int n = 0; n < 2; ++n) acc[a][b][m][n] = (f32x4){0.f, 0.f, 0.f, 0.f};
        cur = nxt; cA = nA; cB = nB; ++ui;
        if constexpr (ALIGN_EPI) { if (wr == 1) PG8_BAR; }
    }
    PG8_WAIT_V(0);
    if constexpr (!ALIGN_EPI) { if (wr == 0) PG8_BAR; }
    PG8_BAR;
    if constexpr (Epi::AFTER_DRAIN) { E.fused(acc, cur, wr, wc, fr, fq, lds, wid, lane); S.done(cur); }
#undef PG8_SA
#undef PG8_SB
#undef PG8_STAGE
#undef PG8_LDA
#undef PG8_LDB
#undef PG8_MMA
#undef PG8_WAIT_V
#undef PG8_WAIT_L
#undef PG8_BAR
#undef PG8_SCHED
}
template <class Epi, class Sched, class AMap, bool ALIGN_EPI = false>
__device__ __forceinline__ void gemm_phase_gather(PG8_LAS unsigned char* lds, const Gemm g, const Sched& S, const Epi& E, const AMap& AM) {
    constexpr bool SP2 = true;
    const int tid = threadIdx.x, wid = __builtin_amdgcn_readfirstlane(tid >> 6), lane = tid & 63, wr = wid >> 2, wc = wid & 3, fr = lane & 15, fq = lane >> 4;
    const int K = g.K, nt = K / BK;
    unsigned voffA[2], voffB[2]; int rowA[2];
#pragma unroll
    for (int i = 0; i < 2; ++i) { int R, C; stage_rc(tid * 16 + i * 8192, R, C); const int Rb = Epi::PERM ? ((R & ~31) + perm32(R & 31)) : R;
        voffA[i] = (unsigned)C * 2u; voffB[i] = (unsigned)(Rb * K + C) * 2u; rowA[i] = R; }
    const size_t kstep = (size_t)(BK * 2);
    const size_t hstep = (size_t)HALF * K * 2;
    const size_t tstep = 2 * hstep;
    const unsigned ldsw = (unsigned)wid * 1024u;
    const int aoff = lds_byte(wr * 64 + fr, fq * 8), boff = lds_byte(wc * 32 + fr, fq * 8);
#define PG8_SA(b, h) (((b) * 2 + (h)) * HTB)
#define PG8_SB(b, h) ((4 + (b) * 2 + (h)) * HTB)
#define PG8_STAGE(bufoff, gbase, voff) do { _Pragma("unroll") for (int _i = 0; _i < 2; ++_i) \
        __builtin_amdgcn_global_load_lds((const unsigned*)((const char*)(gbase) + (voff)[_i]), (PG8_LAS unsigned*)(lds + (bufoff) + ldsw + _i * 8192), 16, 0, 0); } while (0)
#define PG8_LDA(dst, b, h) do { _Pragma("unroll") for (int m = 0; m < 4; ++m) _Pragma("unroll") for (int k = 0; k < 2; ++k) dst[m][k] = *(const PG8_LAS bf16x8*)(lds + PG8_SA(b, h) + aoff + m * 2048 + k * 1024); } while (0)
#define PG8_LDB(dst, b, h) do { _Pragma("unroll") for (int n = 0; n < 2; ++n) _Pragma("unroll") for (int k = 0; k < 2; ++k) dst[n][k] = *(const PG8_LAS bf16x8*)(lds + PG8_SB(b, h) + boff + n * 2048 + k * 1024); } while (0)
#define PG8_MMA(ai, bj, At, Bt) do { __builtin_amdgcn_s_setprio(1); _Pragma("unroll") for (int m = 0; m < 4; ++m) _Pragma("unroll") for (int n = 0; n < 2; ++n) _Pragma("unroll") for (int k = 0; k < 2; ++k) \
        acc[ai][bj][m][n] = __builtin_amdgcn_mfma_f32_16x16x32_bf16(Bt[n][k], At[m][k], acc[ai][bj][m][n], 0, 0, 0); __builtin_amdgcn_s_setprio(0); } while (0)
#define PG8_WAIT_V(n) asm volatile("s_waitcnt vmcnt(" #n ")" ::: "memory")
#define PG8_WAIT_L(n) asm volatile("s_waitcnt lgkmcnt(" #n ")" ::: "memory")
#define PG8_BAR __builtin_amdgcn_s_barrier()
#define PG8_SCHED __builtin_amdgcn_sched_barrier(0)
    Unit cur, nxt; int ui = 0;
    if (!S.next(0, cur)) return;
    f32x4 acc[2][2][4][2];
#pragma unroll
    for (int a = 0; a < 2; ++a)
#pragma unroll
        for (int b = 0; b < 2; ++b)
#pragma unroll
            for (int m = 0; m < 4; ++m)
#pragma unroll
                for (int n = 0; n < 2; ++n) acc[a][b][m][n] = (f32x4){0.f, 0.f, 0.f, 0.f};
    bf16x8 At[4][2], B0[2][2], B1[2][2];
    const char* cA = (const char*)g.A; const char* cB = (const char*)g.Bt + (size_t)cur.pn * tstep;
    unsigned vA0[2], vA1[2], nA0[2], nA1[2];
#pragma unroll
    for (int i = 0; i < 2; ++i) { vA0[i] = (unsigned)AM.row(cur, rowA[i]) * (unsigned)(K * 2) + voffA[i]; vA1[i] = (unsigned)AM.row(cur, HALF + rowA[i]) * (unsigned)(K * 2) + voffA[i]; }
    S.a_ready(cur);
    if constexpr (SP2) {
        PG8_STAGE(PG8_SB(0, 0), cB, voffB); PG8_STAGE(PG8_SB(0, 1), cB + hstep, voffB); PG8_STAGE(PG8_SA(0, 0), cA, vA0); PG8_STAGE(PG8_SA(0, 1), cA, vA1);
        if (wr == 1) PG8_BAR;
        PG8_WAIT_V(2); PG8_BAR;
        PG8_STAGE(PG8_SB(1, 0), cB + kstep, voffB); PG8_STAGE(PG8_SA(1, 0), cA + kstep, vA0); PG8_STAGE(PG8_SB(1, 1), cB + hstep + kstep, voffB);
        PG8_WAIT_V(6); PG8_BAR;
    } else {
        PG8_STAGE(PG8_SB(0, 0), cB, voffB); PG8_STAGE(PG8_SA(0, 0), cA, voffA); PG8_STAGE(PG8_SB(0, 1), cB + hstep, voffB); PG8_STAGE(PG8_SA(0, 1), cA + hstep, voffA);
        if (wr == 1) PG8_BAR;
        PG8_WAIT_V(4); PG8_BAR;
        PG8_STAGE(PG8_SB(1, 0), cB + kstep, voffB); PG8_STAGE(PG8_SA(1, 0), cA + kstep, voffA); PG8_STAGE(PG8_SB(1, 1), cB + hstep + kstep, voffB);
        PG8_WAIT_V(6); PG8_BAR;
    }
    for (;;) {
        const bool has_next = S.next(ui + 1, nxt);
        const char* nA = cA; const char* nB = has_next ? (const char*)g.Bt + (size_t)nxt.pn * tstep : cB;
#pragma unroll
        for (int i = 0; i < 2; ++i) { nA0[i] = has_next ? (unsigned)AM.row(nxt, rowA[i]) * (unsigned)(K * 2) + voffA[i] : vA0[i]; nA1[i] = has_next ? (unsigned)AM.row(nxt, HALF + rowA[i]) * (unsigned)(K * 2) + voffA[i] : vA1[i]; }
        for (int t = 0; t < nt; t += 2) {
            const bool last = (t == nt - 2);
            const char* a1 = cA + (size_t)(t + 1) * kstep;
            const char* a2 = last ? nA : cA + (size_t)(t + 2) * kstep; const char* b2 = last ? nB : cB + (size_t)(t + 2) * kstep;
            const char* a3 = a2 + kstep; const char* b3 = b2 + kstep;
            unsigned s0[2], s1[2];
#pragma unroll
            for (int i = 0; i < 2; ++i) { s0[i] = vA0[i]; s1[i] = vA1[i]; }
            if (last) {
#pragma unroll
                for (int i = 0; i < 2; ++i) { unsigned t0_ = nA0[i], t1_ = nA1[i]; asm volatile("" : "+v"(t0_), "+v"(t1_)); s0[i] = t0_; s1[i] = t1_; } }
            if (last && has_next) S.a_ready(nxt);
            if constexpr (SP2) {
            PG8_LDB(B0, 0, 0); PG8_LDB(B1, 0, 1); PG8_SCHED; PG8_LDA(At, 0, 0); PG8_STAGE(PG8_SA(1, 1), a1, vA1);
            PG8_WAIT_V(8); PG8_WAIT_L(0); PG8_BAR; PG8_MMA(0, 0, At, B0); PG8_MMA(0, 1, At, B1); PG8_BAR; PG8_SCHED;
            PG8_LDA(At, 0, 1); PG8_STAGE(PG8_SB(0, 0), b2, voffB); PG8_STAGE(PG8_SB(0, 1), b2 + hstep, voffB); PG8_STAGE(PG8_SA(0, 0), a2, s0);
            PG8_WAIT_V(8); PG8_WAIT_L(0); PG8_BAR; PG8_MMA(1, 0, At, B0); PG8_MMA(1, 1, At, B1); PG8_BAR; PG8_SCHED;
            PG8_LDB(B0, 1, 0); PG8_LDB(B1, 1, 1); PG8_SCHED; PG8_LDA(At, 1, 0); PG8_STAGE(PG8_SA(0, 1), a2, s1);
            PG8_WAIT_V(8); PG8_WAIT_L(0); PG8_BAR; PG8_MMA(0, 0, At, B0); PG8_MMA(0, 1, At, B1); PG8_BAR; PG8_SCHED;
            PG8_LDA(At, 1, 1); PG8_STAGE(PG8_SB(1, 0), b3, voffB); PG8_STAGE(PG8_SB(1, 1), b3 + hstep, voffB); PG8_STAGE(PG8_SA(1, 0), a3, s0);
            PG8_WAIT_V(8); PG8_WAIT_L(0); PG8_BAR; PG8_MMA(1, 0, At, B0); PG8_MMA(1, 1, At, B1); PG8_BAR; PG8_SCHED;
            } else {
            PG8_LDB(B0, 0, 0); PG8_SCHED; PG8_LDA(At, 0, 0); PG8_STAGE(PG8_SA(1, 1), a1 + hstep, voffA);
            PG8_WAIT_L(8); PG8_BAR; PG8_WAIT_L(0); PG8_MMA(0, 0, At, B0); PG8_BAR; PG8_SCHED;
            PG8_LDB(B1, 0, 1); PG8_STAGE(PG8_SB(0, 0), b2, voffB);
            PG8_BAR; PG8_WAIT_L(0); PG8_MMA(0, 1, At, B1); PG8_BAR;
            PG8_LDA(At, 0, 1); PG8_STAGE(PG8_SA(0, 0), a2, voffA);
            PG8_BAR; PG8_WAIT_L(0); PG8_MMA(1, 0, At, B0); PG8_BAR; PG8_SCHED;
            PG8_STAGE(PG8_SB(0, 1), b2 + hstep, voffB);
            PG8_WAIT_V(6); PG8_BAR; PG8_MMA(1, 1, At, B1); PG8_BAR;
            PG8_LDB(B0, 1, 0); PG8_SCHED; PG8_LDA(At, 1, 0); PG8_STAGE(PG8_SA(0, 1), a2 + hstep, voffA);
            PG8_WAIT_L(8); PG8_BAR; PG8_WAIT_L(0); PG8_MMA(0, 0, At, B0); PG8_BAR; PG8_SCHED;
            PG8_LDB(B1, 1, 1); PG8_STAGE(PG8_SB(1, 0), b3, voffB);
            PG8_BAR; PG8_WAIT_L(0); PG8_MMA(0, 1, At, B1); PG8_BAR;
            PG8_LDA(At, 1, 1); PG8_STAGE(PG8_SA(1, 0), a3, voffA);
            PG8_BAR; PG8_WAIT_L(0); PG8_MMA(1, 0, At, B0); PG8_BAR; PG8_SCHED;
            PG8_STAGE(PG8_SB(1, 1), b3 + hstep, voffB);
            PG8_WAIT_V(6); PG8_BAR; PG8_MMA(1, 1, At, B1); PG8_BAR;
            }
        }
        if constexpr (ALIGN_EPI) { if (wr == 0) PG8_BAR; }
        if constexpr (!Epi::AFTER_DRAIN) { E(acc, cur, wr, wc, fr, fq); S.done(cur); }
        if (!has_next) break;
#pragma unroll
        for (int a = 0; a < 2; ++a)
#pragma unroll
            for (int b = 0; b < 2; ++b)
#pragma unroll
                for (int m = 0; m < 4; ++m)
#pragma unroll
                    for (int n = 0; n < 2; ++n) acc[a][b][m][n] = (f32x4){0.f, 0.f, 0.f, 0.f};
        cur = nxt; cA = nA; cB = nB; ++ui;
#pragma unroll
        for (int i = 0; i < 2; ++i) { vA0[i] = nA0[i]; vA1[i] = nA1[i]; }
        if constexpr (ALIGN_EPI) { if (wr == 1) PG8_BAR; }
    }
    PG8_WAIT_V(0);
    if constexpr (!ALIGN_EPI) { if (wr == 0) PG8_BAR; }
    PG8_BAR;
    if constexpr (Epi::AFTER_DRAIN) { E.fused(acc, cur, wr, wc, fr, fq, lds, wid, lane); S.done(cur); }
#undef PG8_SA
#undef PG8_SB
#undef PG8_STAGE
#undef PG8_LDA
#undef PG8_LDB
#undef PG8_MMA
#undef PG8_WAIT_V
#undef PG8_WAIT_L
#undef PG8_BAR
#undef PG8_SCHED
}
}
#include <hip/hip_bf16.h>
#include <cmath>
namespace attn_body {
using bf16=__hip_bfloat16;
using bf16x8=__attribute__((ext_vector_type(8)))short;
using s16x4=__attribute__((ext_vector_type(4)))short;
using f32x16=__attribute__((ext_vector_type(16)))float;
using u32x4=__attribute__((ext_vector_type(4)))unsigned;
constexpr int BATCH=2,NHEAD=8,NKVH=2,SEQ=8192,D=64,QP=512,KP=128,OP=1024;
constexpr int NW=8,QBLK=32,QB=QBLK*NW,KVBLK=64,NQB=SEQ/QB;
constexpr int ATTN_UNIT_ROWS=QB;
__device__ __forceinline__ int crow(int r,int hi){return (r&3)+8*(r>>2)+4*hi;}
#define SBAR() __builtin_amdgcn_sched_barrier(0)
__device__ __forceinline__ void cmask(f32x16&p0,f32x16&p1,int jb,int qrel,int hi){
  const float NEG=-INFINITY; int kb=64*jb+4*hi;
  #pragma unroll
  for(int r=0;r<16;++r){int kv=kb+(r&3)+8*(r>>2); if(kv>qrel)p0[r]=NEG; if(kv+32>qrel)p1[r]=NEG;}
}

constexpr int NSLOT=3, SLOTB=8192;
constexpr int LDS_K=0, LDS_V=NSLOT*SLOTB, LDS_WS=2*NSLOT*SLOTB, LDS_OST=LDS_WS+NW*64*4, LDS_BYTES=LDS_OST+NW*4096;
constexpr float C2=0.125f*1.4426950408889634f;
__device__ __forceinline__ void glds16(const void*gsrc,unsigned lds_dst){unsigned keep;
  asm volatile("s_mov_b32 %0, m0\n\ts_mov_b32 m0, %2\n\ts_nop 0\n\tglobal_load_lds_dwordx4 %1, off\n\ts_mov_b32 m0, %0":"=&s"(keep):"v"(gsrc),"s"(lds_dst):"memory");}
__device__ __forceinline__ float max3f(float a,float b,float c){float r;asm("v_max3_f32 %0, %1, %2, %3":"=v"(r):"v"(a),"v"(b),"v"(c));return r;}
__device__ __forceinline__ float max2f(float a,float b){float r;asm("v_max_f32_e32 %0, %1, %2":"=v"(r):"v"(a),"v"(b));return r;}
__device__ __forceinline__ float fadd_s(float a,float b){float r;asm("v_add_f32_e32 %0, %1, %2":"=v"(r):"v"(a),"v"(b));return r;}
__device__ __forceinline__ float fsub_s(float a,float b){float r;asm("v_sub_f32_e32 %0, %1, %2":"=v"(r):"v"(a),"v"(b));return r;}
typedef float f32x2_t __attribute__((ext_vector_type(2))); typedef __bf16 bf16x2_t __attribute__((ext_vector_type(2)));
__device__ __forceinline__ unsigned cvtpk_s(float lo,float hi){f32x2_t v={lo,hi};bf16x2_t b=__builtin_convertvector(v,bf16x2_t);return __builtin_bit_cast(unsigned,b);}
#define WAIT_BAR(N) asm volatile("s_waitcnt vmcnt(" #N ") lgkmcnt(0)\n\ts_barrier":::"memory")

__device__ __forceinline__ void qkt(f32x16&p0,f32x16&p1,const char*Kslot,const bf16x8*qr,const f32x16&negm,int r32,int hi){
  const char*kb=Kslot+hi*1024+r32*16;
  #pragma unroll
  for(int d0=0;d0<4;++d0){
    const bf16x8 b0=*reinterpret_cast<const bf16x8*>(kb+d0*2048);
    const bf16x8 b1=*reinterpret_cast<const bf16x8*>(kb+d0*2048+512);
    if(d0==0){p0=__builtin_amdgcn_mfma_f32_32x32x16_bf16(b0,qr[0],negm,0,0,0);p1=__builtin_amdgcn_mfma_f32_32x32x16_bf16(b1,qr[0],negm,0,0,0);}
    else{p0=__builtin_amdgcn_mfma_f32_32x32x16_bf16(b0,qr[d0],p0,0,0,0);p1=__builtin_amdgcn_mfma_f32_32x32x16_bf16(b1,qr[d0],p1,0,0,0);}}
}
typedef __attribute__((address_space(3))) const char* lds_cptr;
typedef short v4i16_t __attribute__((ext_vector_type(4)));
__device__ __forceinline__ void kload8(bf16x8*kf,lds_cptr kp){
  kf[0]=*(const __attribute__((address_space(3))) bf16x8*)(kp);      kf[1]=*(const __attribute__((address_space(3))) bf16x8*)(kp+512);
  kf[2]=*(const __attribute__((address_space(3))) bf16x8*)(kp+2048); kf[3]=*(const __attribute__((address_space(3))) bf16x8*)(kp+2560);
  kf[4]=*(const __attribute__((address_space(3))) bf16x8*)(kp+4096); kf[5]=*(const __attribute__((address_space(3))) bf16x8*)(kp+4608);
  kf[6]=*(const __attribute__((address_space(3))) bf16x8*)(kp+6144); kf[7]=*(const __attribute__((address_space(3))) bf16x8*)(kp+6656);
}
__device__ __forceinline__ void kload2(bf16x8*kf,lds_cptr kp,int j){ kf[2*j]=*(const __attribute__((address_space(3))) bf16x8*)(kp+j*2048); kf[2*j+1]=*(const __attribute__((address_space(3))) bf16x8*)(kp+j*2048+512); }
__device__ __forceinline__ s16x4 vtr(lds_cptr p){ return __builtin_bit_cast(s16x4,__builtin_amdgcn_ds_read_tr16_b64_v4i16((__attribute__((address_space(3))) v4i16_t*)p)); }
__device__ __forceinline__ float rowmax(const f32x16&p0,const f32x16&p1){
  float a=max3f(p0[0],p0[1],p1[0]),b=max3f(p0[2],p0[3],p1[1]);a=max3f(a,p1[2],p1[3]);
  #pragma unroll
  for(int r=4;r<16;r+=4){a=max3f(a,p0[r],p0[r+1]);b=max3f(b,p0[r+2],p0[r+3]);a=max3f(a,p1[r],p1[r+1]);b=max3f(b,p1[r+2],p1[r+3]);}
  const float m=max2f(a,b);
  auto rr=__builtin_amdgcn_permlane32_swap(__float_as_uint(m),__float_as_uint(m),false,false);
  return max2f(__uint_as_float(rr[0]),__uint_as_float(rr[1]));
}
__device__ __forceinline__ void pv(f32x16*o,int vb,bf16x8 pa0,bf16x8 pa1,bf16x8 pa2,bf16x8 pa3){
  #pragma unroll
  for(int d0=0;d0<2;++d0){s16x4 lo[4],hi[4];
    #pragma unroll
    for(int ks=0;ks<4;++ks){
      asm volatile("ds_read_b64_tr_b16 %0,%1 offset:%c2":"=&v"(lo[ks]):"v"(vb),"i"(d0*4096+ks*1024):"memory");
      asm volatile("ds_read_b64_tr_b16 %0,%1 offset:%c2":"=&v"(hi[ks]):"v"(vb),"i"(d0*4096+ks*1024+512):"memory");}
    asm volatile("s_waitcnt lgkmcnt(0)":::"memory");SBAR();
    #define PK(k) (bf16x8){lo[k][0],lo[k][1],lo[k][2],lo[k][3],hi[k][0],hi[k][1],hi[k][2],hi[k][3]}
    o[d0]=__builtin_amdgcn_mfma_f32_32x32x16_bf16(pa0,PK(0),o[d0],0,0,0);
    o[d0]=__builtin_amdgcn_mfma_f32_32x32x16_bf16(pa1,PK(1),o[d0],0,0,0);
    o[d0]=__builtin_amdgcn_mfma_f32_32x32x16_bf16(pa2,PK(2),o[d0],0,0,0);
    o[d0]=__builtin_amdgcn_mfma_f32_32x32x16_bf16(pa3,PK(3),o[d0],0,0,0);
    #undef PK
  }
}

#ifndef ATTN_STORE16
#define ATTN_STORE16(p,v) (*(u32x4*)(p)=(v))
#endif
template<int THRL> __device__ __forceinline__ void attn_unit(int b,int h,int qb,const bf16*Q,const bf16*__restrict__ K,const bf16*__restrict__ V,bf16*O,char*shm){
  const int tid=threadIdx.x,lane=tid&63,r32=lane&31,hi=lane>>5; const int wid=__builtin_amdgcn_readfirstlane(tid>>6);
  const long rowbase=(long)b*SEQ; const int q0=qb*QB;
  const bf16*Qw=Q+(rowbase+q0+wid*QBLK)*QP+h*D;
  const int hk=h/(NHEAD/NKVH); const bf16*Kh=K+rowbase*KP+hk*D,*Vh=V+rowbase*KP+hk*D;
  const unsigned lds0=(unsigned)(uintptr_t)shm;
  float*wsf=(float*)(shm+LDS_WS)+wid*64;
  const bf16*ksrc=Kh+(long)lane*KP+wid*8;
  const bf16*vsrc=Vh+(long)(16*(wid&3)+(lane>>2))*KP+(wid>>2)*32+(lane&3)*8;
  const unsigned kdst=lds0+LDS_K+wid*1024, vdst=lds0+LDS_V+wid*1024;
  #define DMA_K(t,slot) glds16(ksrc+(long)(t)*KVBLK*KP,(unsigned)__builtin_amdgcn_readfirstlane(kdst+(slot)))
  #define DMA_V(t,slot) glds16(vsrc+(long)(t)*KVBLK*KP,(unsigned)__builtin_amdgcn_readfirstlane(vdst+(slot)))
  const int vb0=(int)(lds0+LDS_V)+((lane>>4)&1)*32+(lane&3)*8+(4*hi+((lane&15)>>2))*64;
  const char*Kbase=shm+LDS_K; bf16x8 kf[8];
  const lds_cptr shm3=(lds_cptr)shm; const lds_cptr kp0=shm3+LDS_K+hi*1024+r32*16; const lds_cptr vp0=shm3+LDS_V+((lane>>4)&1)*32+(lane&3)*8+(4*hi+((lane&15)>>2))*64;
  constexpr int NT=SEQ/KVBLK;
  DMA_K(0,0);DMA_V(0,0);DMA_K(1,SLOTB);
  bf16x8 qr[4];
  #pragma unroll
  for(int d0=0;d0<4;++d0)qr[d0]=*reinterpret_cast<const bf16x8*>(&Qw[(long)r32*QP+d0*16+hi*8]);
  float mhat=0.f,l_reg=0.f;f32x16 o[2];o[0]=f32x16{};o[1]=f32x16{};f32x16 negm=f32x16{};asm volatile("":"+v"(negm));
  const int qrel=wid*QBLK+r32;
  #define CMASK(P0,P1,t) do{}while(0)
  bool resc=false;
  #define START(P0,P1) do{ const float rm=rowmax(P0,P1); resc=false; \
    { const float dl=rm; mhat=fadd_s(mhat,dl); \
      _Pragma("unroll") for(int r=0;r<16;++r){P0[r]=fsub_s(P0[r],dl);P1[r]=fsub_s(P1[r],dl);} \
      _Pragma("unroll") for(int r=0;r<16;++r)negm[r]=-mhat; asm volatile("":"+v"(negm)); } \
    _Pragma("unroll") for(int r=0;r<16;++r)P0[r]=__builtin_amdgcn_exp2f(P0[r]); }while(0)
  #define RESC() do{ if(resc){ asm volatile("s_waitcnt lgkmcnt(0)":::"memory"); \
      _Pragma("unroll") for(int d_=0;d_<2;++d_) _Pragma("unroll") for(int r=0;r<16;++r)o[d_][r]*=wsf[crow(r,hi)]; } }while(0)
  f32x16 pA0,pA1,pB0,pB1;
  int sl_prev=0,sl_cur=0,sl_next=SLOTB;
  #define ROT() do{sl_prev=sl_cur;sl_cur=sl_next;sl_next=(sl_next==(NSLOT-1)*SLOTB)?0:sl_next+SLOTB;}while(0)
  DMA_K(2,2*SLOTB);
  WAIT_BAR(3);
  qkt(pA0,pA1,Kbase,qr,negm,r32,hi);asm volatile("s_nop 15\n\ts_nop 7":"+v"(pA0),"+v"(pA1));CMASK(pA0,pA1,0);
  START(pA0,pA1);
  _Pragma("unroll") for(int r=0;r<16;++r)pA1[r]=__builtin_amdgcn_exp2f(pA1[r]);
  WAIT_BAR(0);
  DMA_K(3,0);DMA_V(1,SLOTB);
  ROT();
  kload8(kf,kp0+sl_cur);
  WAIT_BAR(2);
  s16x4 vlo[8],vhi[8]; u32x4 pw0,pw1,pw2,pw3;
  #define PKW(P,B) cvtpk_s(P[B],P[B+1])
  #define PAF(k) __builtin_bit_cast(bf16x8,pw##k)
  #define VFR(i) (bf16x8){vlo[i][0],vlo[i][1],vlo[i][2],vlo[i][3],vhi[i][0],vhi[i][1],vhi[i][2],vhi[i][3]}
  #define PIN(x) asm volatile("":"+v"(x))
  #define MX3(a,b,c) __builtin_fmaxf(__builtin_fmaxf((a),(b)),(c))
  #define GAPA(MF,A0,A1,A2,A3,W0,W1,PW) do{ MF; sacc+=A0; sacc+=A1; sacc+=A2; sacc+=A3; PIN(sacc); W0; W1; PIN(PW); SBAR(); }while(0)
  #define EX(v) __builtin_amdgcn_exp2f(v)
  #define GAPB(MF,X,B) do{ MF; X[B]=EX(X[B]); X[B+1]=EX(X[B+1]); X[B+2]=EX(X[B+2]); X[B+3]=EX(X[B+3]); PIN(X); SBAR(); }while(0)
  #define VRD(i) do{ vlo[i]=vtr(vp_+(((i)>>2)*4096+((i)&3)*1024)); vhi[i]=vtr(vp_+(((i)>>2)*4096+((i)&3)*1024+512)); }while(0)
  #define KRD(G,j) do{ if(G){ kload2(kf,kp0+sl_next,j); SBAR(); } }while(0)
  #define STEP(C0,C1,P0,P1,t,GK,GV,GL) do{ SBAR(); \
    const lds_cptr vp_=vp0+sl_prev; \
    VRD(0); SBAR(); float sacc=(P0[0]+P0[1]); \
    GAPA(C0=__builtin_amdgcn_mfma_f32_32x32x16_bf16(kf[0],qr[0],negm,0,0,0), P0[2],P0[3],P0[4],P0[5],     pw0[0]=PKW(P0,0), pw0[1]=PKW(P0,2), pw0); \
    VRD(4); SBAR(); GAPA(C1=__builtin_amdgcn_mfma_f32_32x32x16_bf16(kf[1],qr[0],negm,0,0,0), P0[6],P0[7],P0[8],P0[9],     pw0[2]=PKW(P0,4), pw0[3]=PKW(P0,6), pw0); \
    VRD(1); SBAR(); GAPA(C0=__builtin_amdgcn_mfma_f32_32x32x16_bf16(kf[2],qr[1],C0,0,0,0),   P0[10],P0[11],P0[12],P0[13], pw1[0]=PKW(P0,8), pw1[1]=PKW(P0,10), pw1); \
    VRD(5); SBAR(); GAPA(C1=__builtin_amdgcn_mfma_f32_32x32x16_bf16(kf[3],qr[1],C1,0,0,0),   P0[14],P0[15],P1[0],P1[1],   pw1[2]=PKW(P0,12),pw1[3]=PKW(P0,14), pw1); \
    VRD(2); SBAR(); GAPA(C0=__builtin_amdgcn_mfma_f32_32x32x16_bf16(kf[4],qr[2],C0,0,0,0),   P1[2],P1[3],P1[4],P1[5],     pw2[0]=PKW(P1,0), pw2[1]=PKW(P1,2), pw2); \
    VRD(6); SBAR(); GAPA(C1=__builtin_amdgcn_mfma_f32_32x32x16_bf16(kf[5],qr[2],C1,0,0,0),   P1[6],P1[7],P1[8],P1[9],     pw2[2]=PKW(P1,4), pw2[3]=PKW(P1,6), pw2); \
    VRD(3); SBAR(); GAPA(C0=__builtin_amdgcn_mfma_f32_32x32x16_bf16(kf[6],qr[3],C0,0,0,0),   P1[10],P1[11],P1[12],P1[13], pw3[0]=PKW(P1,8), pw3[1]=PKW(P1,10), pw3); \
    VRD(7); SBAR(); GAPA(C1=__builtin_amdgcn_mfma_f32_32x32x16_bf16(kf[7],qr[3],C1,0,0,0),   P1[14],P1[15],0.f,0.f,       pw3[2]=PKW(P1,12),pw3[3]=PKW(P1,14), pw3); \
    l_reg+=sacc; \
    if(GK){DMA_K((t)+3,sl_cur);} if(GV){DMA_V((t)+1,sl_next);} \
    CMASK(C0,C1,t); \
    { float a=MX3(C0[0],C0[1],C1[0]),b=MX3(C0[2],C0[3],C1[1]); a=MX3(a,C1[2],C1[3]); \
      _Pragma("unroll") for(int r=4;r<16;r+=4){a=MX3(a,C0[r],C0[r+1]);b=MX3(b,C0[r+2],C0[r+3]);a=MX3(a,C1[r],C1[r+1]);b=MX3(b,C1[r+2],C1[r+3]);} \
      float rm=__builtin_fmaxf(a,b); { auto rr=__builtin_amdgcn_permlane32_swap(__float_as_uint(rm),__float_as_uint(rm),false,false); rm=__builtin_fmaxf(__uint_as_float(rr[0]),__uint_as_float(rr[1])); } \
      resc=false; \
      if(__builtin_expect(__any(rm>(float)THRL),0)){ const float dl=__builtin_fmaxf(rm,0.f); mhat+=dl; \
        _Pragma("unroll") for(int r=0;r<16;++r){C0[r]-=dl;C1[r]-=dl;} \
        _Pragma("unroll") for(int r=0;r<16;++r)negm[r]=-mhat; asm volatile("":"+v"(negm)); \
        const float f=__builtin_amdgcn_exp2f(-dl); l_reg*=f; if(hi==0)wsf[r32]=f; resc=true; } } \
    SBAR(); \
    GAPB(o[0]=__builtin_amdgcn_mfma_f32_32x32x16_bf16(PAF(0),VFR(0),o[0],0,0,0), C0,0); \
    GAPB(o[1]=__builtin_amdgcn_mfma_f32_32x32x16_bf16(PAF(0),VFR(4),o[1],0,0,0), C0,4); \
    KRD(GL,0); GAPB(o[0]=__builtin_amdgcn_mfma_f32_32x32x16_bf16(PAF(1),VFR(1),o[0],0,0,0), C0,8); \
    KRD(GL,1); GAPB(o[1]=__builtin_amdgcn_mfma_f32_32x32x16_bf16(PAF(1),VFR(5),o[1],0,0,0), C0,12); \
    KRD(GL,2); GAPB(o[0]=__builtin_amdgcn_mfma_f32_32x32x16_bf16(PAF(2),VFR(2),o[0],0,0,0), C1,0); \
    KRD(GL,3); GAPB(o[1]=__builtin_amdgcn_mfma_f32_32x32x16_bf16(PAF(2),VFR(6),o[1],0,0,0), C1,4); \
    GAPB(o[0]=__builtin_amdgcn_mfma_f32_32x32x16_bf16(PAF(3),VFR(3),o[0],0,0,0), C1,8); \
    GAPB(o[1]=__builtin_amdgcn_mfma_f32_32x32x16_bf16(PAF(3),VFR(7),o[1],0,0,0), C1,12); \
    }while(0)
  int t=1;
  #undef CMASK
  #define CMASK(P0,P1,t) do{}while(0)
  for(;t+5<NT;t+=2){
    STEP(pB0,pB1,pA0,pA1,t,true,true,true);     WAIT_BAR(2); RESC(); ROT();
    STEP(pA0,pA1,pB0,pB1,t+1,true,true,true);   WAIT_BAR(2); RESC(); ROT();
  }
  #undef CMASK
  #define CMASK(P0,P1,t) do{}while(0)
  #define ENDW(tt) do{ if((tt)+3<NT){WAIT_BAR(2);} else if((tt)+2<NT){WAIT_BAR(1);} else {WAIT_BAR(0);} }while(0)
  for(;t+1<NT;t+=2){
    STEP(pB0,pB1,pA0,pA1,t,(t+3<NT),(t+1<NT),(t+1<NT));       ENDW(t);   RESC(); ROT();
    STEP(pA0,pA1,pB0,pB1,t+1,(t+4<NT),(t+2<NT),(t+2<NT));     ENDW(t+1); RESC(); ROT();
  }
  STEP(pB0,pB1,pA0,pA1,NT-1,false,false,false); RESC();
  { float sacc=pB0[0]+pB0[1]; _Pragma("unroll") for(int r=2;r<16;++r)sacc+=pB0[r]; _Pragma("unroll") for(int r=0;r<16;++r)sacc+=pB1[r]; l_reg+=sacc;
    pw0=(u32x4){PKW(pB0,0),PKW(pB0,2),PKW(pB0,4),PKW(pB0,6)};pw1=(u32x4){PKW(pB0,8),PKW(pB0,10),PKW(pB0,12),PKW(pB0,14)};pw2=(u32x4){PKW(pB1,0),PKW(pB1,2),PKW(pB1,4),PKW(pB1,6)};pw3=(u32x4){PKW(pB1,8),PKW(pB1,10),PKW(pB1,12),PKW(pB1,14)};
    SBAR(); pv(o,vb0+sl_cur,PAF(0),PAF(1),PAF(2),PAF(3)); }
  #undef PKW
  #undef PAF
  #undef VFR
  #undef PIN
  #undef MX3
  #undef GAPA
  #undef GAPB
  #undef EX
  #undef VRD
  #undef KRD
  #undef STEP
  #undef ENDW
  {auto rr=__builtin_amdgcn_permlane32_swap(__float_as_uint(l_reg),__float_as_uint(l_reg),false,false);l_reg=__uint_as_float(rr[0])+__uint_as_float(rr[1]);}
  if(hi==0)wsf[32+r32]=l_reg;asm volatile("s_waitcnt lgkmcnt(0)":::"memory");
  float rli[16];
  #pragma unroll
  for(int r=0;r<16;++r)rli[r]=__builtin_amdgcn_rcpf(wsf[32+crow(r,hi)]);
  bf16*Ow=O+(rowbase+q0+wid*QBLK)*OP+h*D;
  { bf16*stg=(bf16*)(shm+LDS_OST)+wid*2048;
    #pragma unroll
    for(int r=0;r<16;++r){const int orow=crow(r,hi);
      #pragma unroll
      for(int d0=0;d0<2;++d0)stg[orow*64+d0*32+r32]=__float2bfloat16(o[d0][r]*rli[r]);}
    asm volatile("s_waitcnt lgkmcnt(0)":::"memory");
    #pragma unroll
    for(int i=0;i<4;++i){const int row=i*8+(lane>>3),ch=lane&7; const u32x4 v=*(const u32x4*)(stg+row*64+ch*8); ATTN_STORE16(Ow+(long)row*OP+ch*8,v);} }
  asm volatile("s_waitcnt lgkmcnt(0)\n\ts_barrier":::"memory");
  #undef DMA_K
  #undef DMA_V
  #undef CMASK
  #undef START
  #undef RESC
  #undef ROT
}
constexpr int ATTN_LDS_BYTES=LDS_BYTES;
struct AttnTensors { const bf16* Q; const bf16* K; const bf16* V; bf16* O; };
struct AttnUnit { int bh; int qb; };
struct StaticOrder {
  int vcu, G;
  __device__ __forceinline__ explicit StaticOrder(int grid,int block):vcu((grid%8==0)?(block%8)*(grid/8)+block/8:block),G(grid){}
  __device__ __forceinline__ bool next(int i,AttnUnit&u)const{
    const int L=i*G+vcu; if(L>=BATCH*NHEAD*NQB)return false;
    if(G==256){ if(i>=2)return false; const int x=vcu>>5,j=vcu&31; const int b=x>>2,kvh=(x>>1)&1,hq=kvh*4+2*(x&1)+i; u.bh=b*NHEAD+hq; u.qb=j; return true; }
    u.bh=L/NQB; u.qb=L%NQB; return true; }
  __device__ __forceinline__ void a_ready(const AttnUnit&)const{}
  __device__ __forceinline__ void done(const AttnUnit&)const{}
};
template<class Sched,int THRL=8> __device__ __forceinline__ void attn_phase(char*lds,const AttnTensors&T,const Sched&S){
  AttnUnit u;
  for(int i=0;S.next(i,u);++i){ S.a_ready(u); attn_unit<THRL>(u.bh/NHEAD,u.bh%NHEAD,u.qb,T.Q,T.K,T.V,T.O,lds); S.done(u); }
}
#undef SBAR
#undef WAIT_BAR
}

#include <hip/hip_cooperative_groups.h>
namespace cg = cooperative_groups;
#ifndef MK_PER_PHASE
#define MK_PER_PHASE 0
#endif
constexpr int NWAVES = 8, NTHREADS = 512;
constexpr int NB = 2, SEQ = 8192, DMODEL = 1024, TT = NB * SEQ;
constexpr int NPROJ = 3072;
constexpr int NEXP = 32, FFE = 512;
constexpr float EPS = 1e-6f;
constexpr int N_PHASES = 12;

constexpr size_t MiB = 1u << 20;
constexpr size_t WS_CTL = 0, CTL_ZERO_BYTES = 64 * 1024;
constexpr size_t WS_WOUT = 1 * MiB;
constexpr size_t WS_LIST = 229 * MiB;
constexpr size_t WS_WR = 3 * MiB;
constexpr size_t WS_TOK = 3 * MiB + 256 * 1024;
constexpr size_t WS_GATES = 4 * MiB;
constexpr size_t WS_WIN = 5 * MiB;
constexpr size_t WS_A = 11 * MiB;
constexpr size_t WS_XN = WS_A;
constexpr size_t GDN_SH_BYTES = 71680, GDN_D_BYTES = 19456;
constexpr size_t WS_GSH = WS_A;
constexpr size_t WS_GD = WS_A + 1024 * GDN_SH_BYTES;
constexpr size_t WS_X1 = 5 * MiB;
constexpr size_t WS_HID = 69 * MiB;
constexpr size_t WS_XBUF = 109 * MiB;
constexpr size_t WS_B = 157 * MiB;
constexpr size_t WS_QKVA = WS_B;
constexpr size_t WS_QKVB = WS_B + 48 * MiB;
constexpr size_t WS_ZA = WS_B + 72 * MiB;
constexpr size_t WS_OCAT = WS_B;
constexpr size_t WS_WGU0 = 189 * MiB, WS_WGU1 = 245 * MiB; constexpr int WGU_SPLIT = 20;
constexpr size_t DO_WD0 = 0, DO_WD1 = 56 * MiB; constexpr int WD_SPLIT = 24;
constexpr size_t DO_HN = 24 * MiB;
constexpr size_t WS_END = 269 * MiB;
static_assert(WS_GD + 4096 * GDN_D_BYTES <= WS_B, "GDN records fit region A");
static_assert(WS_X1 + 64 * MiB <= WS_HID && WS_HID + 40928ull * 1024 <= WS_XBUF && WS_XBUF + 40928ull * 2048 <= WS_WGU0, "post-scan map");
static_assert(WS_WGU0 + WGU_SPLIT * 2 * MiB <= WS_B + 72 * MiB && WS_WGU1 + (32 - WGU_SPLIT) * 2 * MiB <= 269 * MiB, "WGU fragments");
constexpr size_t DO_QR = 0, DO_KR = 16 * MiB, DO_VR = 20 * MiB, DO_OF = 24 * MiB, DO_OB = 40 * MiB;
constexpr int CW_CNT = 2048;
constexpr int CW_NTILE = 128;
constexpr int CW_ETAB = 192;
constexpr int CW_SCANQ = 1024;

constexpr int LDS_BYTES = 160 * 1024;

#define GAS __attribute__((address_space(1)))
#define LAS __attribute__((address_space(3)))
typedef unsigned short bf16;
typedef unsigned v4u __attribute__((ext_vector_type(4)));
typedef unsigned v2u __attribute__((ext_vector_type(2)));
typedef float f32x4 __attribute__((ext_vector_type(4)));
typedef short bf16x8 __attribute__((ext_vector_type(8)));
typedef short s16x4 __attribute__((ext_vector_type(4)));
#define DI __device__ __forceinline__

DI unsigned f2bf(float f) { unsigned u = __builtin_bit_cast(unsigned, f); return (u + 0x7fffu + ((u >> 16) & 1u)) >> 16; }
typedef float f32x2_t __attribute__((ext_vector_type(2))); typedef __bf16 bf16x2_t __attribute__((ext_vector_type(2)));
DI unsigned pk2(float lo, float hi) { f32x2_t v = {lo, hi}; bf16x2_t b = __builtin_convertvector(v, bf16x2_t); return __builtin_bit_cast(unsigned, b); }
DI float bf2f(unsigned short h) { return __builtin_bit_cast(float, (unsigned)h << 16); }
DI float bflo(unsigned w) { return __builtin_bit_cast(float, w << 16); }
DI float bfhi(unsigned w) { return __builtin_bit_cast(float, w & 0xffff0000u); }
DI float wave_sum(float v) {
#pragma unroll
    for (int o = 1; o < 64; o <<= 1) v += __shfl_xor(v, o);
    return v;
}
DI float siluf(float x) { return x * __builtin_amdgcn_rcpf(1.0f + __expf(-x)); }
DI float sigmoidf_(float x) { return 1.0f / (1.0f + __expf(-x)); }
DI int perm32i(int idx) { return ((idx >> 2) & 3) * 8 + (idx >> 4) * 4 + (idx & 3); }
DI int permcol(int c) { return (c & ~31) + perm32i(c & 31); }
template <class T> DI T opaque(T p) { asm volatile("" : "+v"(p)); return p; }

typedef GAS unsigned gu32;
#define RLX_AGENT __ATOMIC_RELAXED, __HIP_MEMORY_SCOPE_AGENT
constexpr int CW_BAR = 4096;
constexpr int MISC_OFF = LDS_BYTES - 64;
#define XB_TMO      128
#define XB_XCNT(j)  (256  + 64 * (j))
#define XB_XSUB(j)  (1280 + 64 * (j))
#define XB_XGEN(j)  (2304 + 64 * (j))
#define XB_TOP      3328
#define XB_TOPGEN   3392
#define XCD_BAR_WORDS 3456
#define XB_SPIN_CAP (1u << 18)

__device__ __forceinline__ unsigned xb_ld(unsigned* p)              { return __hip_atomic_load(p, __ATOMIC_RELAXED, __HIP_MEMORY_SCOPE_AGENT); }
__device__ __forceinline__ unsigned xb_add(unsigned* p, unsigned v) { return __hip_atomic_fetch_add(p, v, __ATOMIC_RELAXED, __HIP_MEMORY_SCOPE_AGENT); }
__device__ __forceinline__ unsigned xb_xcc_id() { return (unsigned)__builtin_amdgcn_s_getreg((3 << 11) | 20) & 0xFu; }
#define XB_SPIN(cond, bar) do { unsigned _sp = 0; while (cond) { __builtin_amdgcn_s_sleep(1); \
    if ((++_sp & 255u) == 0u) { if (xb_ld(&(bar)[XB_TMO])) break; if (_sp > XB_SPIN_CAP) { atomicAdd(&(bar)[XB_TMO], 1u); break; } } } } while (0)

struct XcdBarrier {
    unsigned* bar; unsigned x;
    volatile LAS unsigned* st;
};

__device__ __forceinline__ XcdBarrier xcd_barrier_post(unsigned* bar, volatile LAS unsigned* st) {
    XcdBarrier b; b.bar = bar; b.x = xb_xcc_id(); b.st = st;
    if (threadIdx.x == 0) (void)xb_add(&bar[XB_XCNT(b.x)], 1u);
    return b;
}
__device__ __forceinline__ void xcd_barrier_complete(unsigned* bar, unsigned x, unsigned& nloc, unsigned& nx) {
    const unsigned G = gridDim.x * gridDim.y * gridDim.z;
    unsigned sum, cnt, mine, sp = 0u;
    for (;;) {
        sum = 0u; cnt = 0u; mine = 0u;
#pragma unroll
        for (unsigned j = 0; j < 16; ++j) { const unsigned c = xb_ld(&bar[XB_XCNT(j)]); sum += c; cnt += (c > 0u) ? 1u : 0u; mine = (j == x) ? c : mine; }
        if (sum == G) break;
        __builtin_amdgcn_s_sleep(1);
        if ((++sp & 255u) == 0u) { if (xb_ld(&bar[XB_TMO])) break; if (sp > XB_SPIN_CAP) { atomicAdd(&bar[XB_TMO], 1u); break; } }
    }
    nloc = mine > 0u ? mine : 1u; nx = cnt > 0u ? cnt : 1u;
}

__device__ __forceinline__ void xcd_barrier(const XcdBarrier& b) {
    asm volatile("s_waitcnt vmcnt(0)" ::: "memory");
    __syncthreads();
    if (threadIdx.x == 0) {
        unsigned* bar = b.bar;
        __builtin_amdgcn_s_waitcnt(0);
        unsigned nloc = b.st[0], nx = b.st[1];
        if (nloc == 0u) { xcd_barrier_complete(bar, b.x, nloc, nx); b.st[0] = nloc; b.st[1] = nx; }
        const unsigned old = xb_add(&bar[XB_XSUB(b.x)], 1u);
        const unsigned gen = old / nloc;
        if (old + 1u == (gen + 1u) * nloc) {
            __builtin_amdgcn_fence(__ATOMIC_RELEASE, "agent");
            asm volatile("s_waitcnt vmcnt(0)" ::: "memory");
            const unsigned og = xb_add(&bar[XB_TOP], 1u);
            const unsigned tg = og / nx;
            if (og + 1u == (tg + 1u) * nx) xb_add(&bar[XB_TOPGEN], 1u);
            else XB_SPIN(xb_ld(&bar[XB_TOPGEN]) == tg, bar);
            __builtin_amdgcn_fence(__ATOMIC_ACQUIRE, "agent");
            xb_add(&bar[XB_XGEN(b.x)], 1u);
            asm volatile("s_waitcnt vmcnt(0)" ::: "memory");
        } else {
            XB_SPIN(xb_ld(&bar[XB_XGEN(b.x)]) == gen, bar);
            __builtin_amdgcn_fence(__ATOMIC_ACQUIRE, "agent");
            asm volatile("s_waitcnt vmcnt(0)" ::: "memory");
        }
    }
    __syncthreads();
}

struct Frame {
    LAS unsigned char* lds;
    int tid, lane, wave, vcu, G;
    const float* in[17];
    float* out; unsigned char* ws;
};

DI void p0_transpose_item(const float* W, int ldw, int nblk, bf16* WT, int K, int row_off, int rmul, LAS float* scr, int item, int lane) {
    const int kb = item / nblk, nb = item % nblk, k0 = 64 * kb, n0 = 32 * nb;
    const int r8 = lane >> 3, c4 = (lane & 7) * 4;
    f32x4 v[8];
#pragma unroll
    for (int i = 0; i < 8; ++i) v[i] = __builtin_nontemporal_load((const f32x4*)(W + (size_t)(k0 + 8 * i + r8) * ldw + n0 + c4));
#pragma unroll
    for (int i = 0; i < 8; ++i) { LAS float* d = scr + (8 * i + r8) * 33 + c4; d[0] = v[i].x; d[1] = v[i].y; d[2] = v[i].z; d[3] = v[i].w; }
    asm volatile("s_waitcnt lgkmcnt(0)" ::: "memory");
    const int c = lane & 7;
#pragma unroll
    for (int j = 0; j < 4; ++j) { const int n = (lane >> 3) + 8 * j; const LAS float* s = scr + (8 * c) * 33 + n;
        v4u o; o.x = pk2(s[0 * 33], s[1 * 33]); o.y = pk2(s[2 * 33], s[3 * 33]); o.z = pk2(s[4 * 33], s[5 * 33]); o.w = pk2(s[6 * 33], s[7 * 33]);
        *(GAS v4u*)(WT + (size_t)(row_off + (n0 + n) * rmul) * K + k0 + 8 * c) = o; }
    asm volatile("s_waitcnt lgkmcnt(0)" ::: "memory");
}
template <int NR> DI void rms_rows_to_bf16(const float* const (&xrow)[NR], const float* w, bf16* const (&orow)[NR], int lane) {
    const GAS f32x4* wr = (const GAS f32x4*)w + lane;
    f32x4 v[NR][4];
#pragma unroll
    for (int r = 0; r < NR; ++r) { const GAS f32x4* xr = (const GAS f32x4*)xrow[r] + lane;
#pragma unroll
        for (int j = 0; j < 4; ++j) v[r][j] = xr[64 * j]; }
    f32x4 ww[4];
#pragma unroll
    for (int j = 0; j < 4; ++j) ww[j] = wr[64 * j];
#pragma unroll
    for (int r = 0; r < NR; ++r) {
        float s_ = 0.f;
#pragma unroll
        for (int j = 0; j < 4; ++j) s_ += (v[r][j].x * v[r][j].x + v[r][j].y * v[r][j].y) + (v[r][j].z * v[r][j].z + v[r][j].w * v[r][j].w);
        const float rs = __builtin_amdgcn_rsqf(wave_sum(s_) * (1.f / DMODEL) + EPS);
        GAS v2u* o8 = (GAS v2u*)orow[r] + lane;
#pragma unroll
        for (int j = 0; j < 4; ++j) { v2u o; o.x = pk2(v[r][j].x * rs * ww[j].x, v[r][j].y * rs * ww[j].y); o.y = pk2(v[r][j].z * rs * ww[j].z, v[r][j].w * rs * ww[j].w); o8[64 * j] = o; }
    }
}
DI void p0_prologue(Frame& F) {
    LAS float* scr = (LAS float*)(F.lds + F.wave * 16384);
    const int gw = F.vcu * NWAVES + F.wave, NGW = F.G * NWAVES;
    const float* w_in = F.in[2];
    bf16* WIN = (bf16*)(F.ws + WS_WIN);
    constexpr int I1 = 16 * 64, I2 = 16 * 24, I3 = 16, NITEMS = I1 + I2 + I3;
    for (int it = gw; it < NITEMS; it += NGW) {
        int r = it;
        if (r < I1) { p0_transpose_item(w_in, 2832, 64, WIN, 1024, 0, 1, scr, r, F.lane); continue; } r -= I1;
        if (r < I2) { p0_transpose_item(w_in + 2064, 2832, 24, WIN, 1024, 2048, 1, scr, r, F.lane); continue; } r -= I2;
        p0_transpose_item(w_in + 2048, 2832, 1, WIN, 1024, 2816, 1, scr, r, F.lane);
    }
    { const int gt = F.vcu * NTHREADS + F.tid, GT = F.G * NTHREADS; GAS v4u* z = (GAS v4u*)(WIN + (size_t)2848 * 1024);
      for (int i = gt; i < 224 * 1024 * 2 / 16; i += GT) z[i] = (v4u){0u, 0u, 0u, 0u}; }
    bf16* XN = (bf16*)(F.ws + WS_XN);
    for (int m = gw; m < TT; m += 2 * NGW) { const int m1 = (m + NGW < TT) ? m + NGW : m;
        const float* const xr[2] = {F.in[0] + (size_t)m * DMODEL, F.in[0] + (size_t)m1 * DMODEL}; bf16* const orw[2] = {XN + (size_t)m * DMODEL, XN + (size_t)m1 * DMODEL};
        rms_rows_to_bf16<2>(xr, F.in[1], orw, F.lane); }
}

struct EpiProj {
    static constexpr bool PERM = true, AFTER_DRAIN = false;
    bf16 *qkva, *za, *qkvb; float* gates;
    DI void operator()(const pg8::f32x4 (&acc)[2][2][4][2], const pg8::Unit& u, int wr, int wc, int fr, int fq) const {
        const int row0 = u.pm * 256 + wr * 64 + fr;
        if (u.pn == 11) {
            if (wc == 0 && fq < 2) {
#pragma unroll
                for (int ai = 0; ai < 2; ++ai)
#pragma unroll
                    for (int m = 0; m < 4; ++m) { float* rp = gates + (size_t)(row0 + ai * 128 + m * 16) * 16 + 8 * fq;
                        *(pg8::f32x4*)(rp) = acc[ai][0][m][0]; *(pg8::f32x4*)(rp + 4) = acc[ai][0][m][1]; }
            }
            return;
        }
        bf16* base; int ldc, colt;
        if (u.pn < 6) { base = qkva; ldc = 1536; colt = u.pn * 256; } else if (u.pn < 8) { base = za; ldc = 512; colt = (u.pn - 6) * 256; } else { base = qkvb; ldc = 768; colt = (u.pn - 8) * 256; }
        const int col0 = colt + wc * 32 + 8 * fq;
#pragma unroll
        for (int ai = 0; ai < 2; ++ai)
#pragma unroll
            for (int m = 0; m < 4; ++m) { bf16* rowp = base + (size_t)(row0 + ai * 128 + m * 16) * ldc + col0;
#pragma unroll
                for (int bj = 0; bj < 2; ++bj) { const pg8::f32x4 v0 = acc[ai][bj][m][0], v1 = acc[ai][bj][m][1]; pg8::u32x4 w;
                    w.x = pg8::cvt_pk_bf16(v0[0], v0[1]); w.y = pg8::cvt_pk_bf16(v0[2], v0[3]); w.z = pg8::cvt_pk_bf16(v1[0], v1[1]); w.w = pg8::cvt_pk_bf16(v1[2], v1[3]);
                    *(pg8::u32x4*)(rowp + bj * 128) = w; } }
    }
};
struct EpiResid {
    static constexpr bool PERM = false, AFTER_DRAIN = false;
    const float* x; float* x1;
    DI void operator()(const pg8::f32x4 (&acc)[2][2][4][2], const pg8::Unit& u, int wr, int wc, int fr, int fq) const {
        const int row0 = u.pm * 256 + wr * 64 + fr, col0 = u.pn * 256 + wc * 32 + 4 * fq;
#pragma unroll
        for (int ai = 0; ai < 2; ++ai)
#pragma unroll
            for (int m = 0; m < 4; ++m) { const size_t off = (size_t)(row0 + ai * 128 + m * 16) * DMODEL + col0;
#pragma unroll
                for (int bj = 0; bj < 2; ++bj)
#pragma unroll
                    for (int n = 0; n < 2; ++n) { const pg8::f32x4 b = *(const pg8::f32x4*)(x + off + bj * 128 + n * 16); *(pg8::f32x4*)(x1 + off + bj * 128 + n * 16) = b + acc[ai][bj][m][n]; } }
    }
};
struct EpiGU {
    static constexpr bool PERM = true, AFTER_DRAIN = false;
    bf16* hid;
    DI void operator()(const pg8::f32x4 (&acc)[2][2][4][2], const pg8::Unit& u, int wr, int wc, int fr, int fq) const {
        const int row0 = u.pm * 256 + wr * 64 + fr; const int jt = u.pn & 3;
        const int ff0 = jt * 128 + wc * 16 + 4 * fq;
#pragma unroll
        for (int ai = 0; ai < 2; ++ai)
#pragma unroll
            for (int m = 0; m < 4; ++m) { bf16* rowp = hid + (size_t)(row0 + ai * 128 + m * 16) * FFE + ff0;
#pragma unroll
                for (int bj = 0; bj < 2; ++bj) { const pg8::f32x4 v0 = acc[ai][bj][m][0], v1 = acc[ai][bj][m][1];
                    const float h0 = siluf(v0[0]) * v0[1], h1 = siluf(v0[2]) * v0[3], h2 = siluf(v1[0]) * v1[1], h3 = siluf(v1[2]) * v1[3];
                    v2u w; w.x = pg8::cvt_pk_bf16(h0, h1); w.y = pg8::cvt_pk_bf16(h2, h3);
                    *(v2u*)(rowp + bj * 64) = w; } }
    }
};
struct EpiY {
    static constexpr bool PERM = true, AFTER_DRAIN = false;
    bf16* y;
    DI void operator()(const pg8::f32x4 (&acc)[2][2][4][2], const pg8::Unit& u, int wr, int wc, int fr, int fq) const {
        const int row0 = u.pm * 256 + wr * 64 + fr; const int col0 = (u.pn & 3) * 256 + wc * 32 + 8 * fq;
#pragma unroll
        for (int ai = 0; ai < 2; ++ai)
#pragma unroll
            for (int m = 0; m < 4; ++m) { bf16* rowp = y + (size_t)(row0 + ai * 128 + m * 16) * DMODEL + col0;
#pragma unroll
                for (int bj = 0; bj < 2; ++bj) { const pg8::f32x4 v0 = acc[ai][bj][m][0], v1 = acc[ai][bj][m][1]; pg8::u32x4 w;
                    w.x = pg8::cvt_pk_bf16(v0[0], v0[1]); w.y = pg8::cvt_pk_bf16(v0[2], v0[3]); w.z = pg8::cvt_pk_bf16(v1[0], v1[1]); w.w = pg8::cvt_pk_bf16(v1[2], v1[3]);
                    *(pg8::u32x4*)(rowp + bj * 128) = w; } }
    }
};
constexpr int ETAB_OFF = 131072;
struct MoeOrder {
    const LAS unsigned* etab; int G, c, esplit, pnoff;
    DI bool next(int i, pg8::Unit& u) const {
        if (G % 8 != 0) {
            int L = i * G + c;
            for (int e = 0; e < NEXP; ++e) { const int n4 = 4 * (int)etab[2 * e + 1]; if (L < n4) { u.pm = (int)etab[2 * e] + (L >> 2); u.pn = (e < esplit ? 4 * e : pnoff + 4 * (e - esplit)) + (L & 3); u.ex = e; u.tq = L >> 2; return true; } L -= n4; }
            return false; }
        const int x = c & 7; int L = i * (G >> 3) + (c >> 3);
#pragma unroll
        for (int q = 0; q < NEXP / 8; ++q) { const int e = x + 8 * q; const int n4 = 4 * (int)etab[2 * e + 1];
            if (L < n4) { u.pm = (int)etab[2 * e] + (L >> 2); u.pn = (e < esplit ? 4 * e : pnoff + 4 * (e - esplit)) + (L & 3); u.ex = e; u.tq = L >> 2; return true; } L -= n4; }
        return false; }
    DI void a_ready(const pg8::Unit&) const {}
    DI void done(const pg8::Unit&) const {}
};
struct MoeRows {
    const int* list; const LAS unsigned* etab;
    DI int row(const pg8::Unit& u, int r) const {
        const int slot = u.tq * 256 + r, e = u.ex; if (slot >= (int)etab[64 + e]) return 0;
        const LAS unsigned* sp = etab + 96 + 8 * e; int sb = 0;
#pragma unroll
        for (int q = 1; q < 8; ++q) sb += (slot >= (int)sp[q]) ? 1 : 0;
        return list[(size_t)(e * 8 + sb) * TT + (slot - (int)sp[sb])]; }
};

DI void p2_rope(Frame& F) {
    const int gw = F.vcu * NWAVES + F.wave, NGW = F.G * NWAVES, lane = F.lane;
    const bf16* QKVB = (const bf16*)(F.ws + WS_QKVB);
    bf16* QR = (bf16*)((unsigned char*)F.out + DO_QR); bf16* KR = (bf16*)((unsigned char*)F.out + DO_KR); bf16* VR = (bf16*)((unsigned char*)F.out + DO_VR);
    const int pi = lane & 31, hsel = lane >> 5;
    const float qw0 = F.in[7][2 * pi], qw1 = F.in[7][2 * pi + 1], kw0 = F.in[8][2 * pi], kw1 = F.in[8][2 * pi + 1];
    const float invf = exp2f(-(float)(2 * (pi & 15)) * (13.287712379549449f / 32.0f));
    constexpr float C2 = 0.125f * 1.4426950408889634f;
    constexpr int NB4 = 4;
    for (int t0 = gw; t0 < TT; t0 += NB4 * NGW) {
        unsigned w[NB4][5], vw[NB4];
#pragma unroll
        for (int u = 0; u < NB4; ++u) { const int t = t0 + u * NGW; const unsigned* src = (const unsigned*)(QKVB + (size_t)(t < TT ? t : t0) * 768);
#pragma unroll
            for (int j = 0; j < 5; ++j) w[u][j] = src[(2 * j + hsel) * 32 + pi];
            vw[u] = src[320 + lane]; }
#pragma unroll
        for (int u = 0; u < NB4; ++u) {
            const int t = t0 + u * NGW; if (t >= TT) break;
            const int s_ = t & (SEQ - 1); const float pos = (pi < 16) ? (float)(s_ >> 6) : (float)(s_ & 63);
            const float ang = pos * invf;
            const float rev = ang * 0.15915494309189535f;
            const float sn = __builtin_amdgcn_sinf(rev), cs = __builtin_amdgcn_cosf(rev);
#pragma unroll
            for (int j = 0; j < 5; ++j) {
                const int head = 2 * j + hsel;
                const float x0 = bflo(w[u][j]), x1 = bfhi(w[u][j]);
                float ss = x0 * x0 + x1 * x1;
#pragma unroll
                for (int o = 1; o < 32; o <<= 1) ss += __shfl_xor(ss, o);
                const float rs = __builtin_amdgcn_rsqf(ss * (1.f / 64.f) + EPS);
                const bool isq = head < 8;
                const float y0 = x0 * rs * (isq ? qw0 : kw0), y1 = x1 * rs * (isq ? qw1 : kw1);
                float o0 = y0 * cs - y1 * sn, o1 = y0 * sn + y1 * cs;
                if (isq) { o0 *= C2; o1 *= C2; ((unsigned*)(QR + (size_t)t * 512))[head * 32 + pi] = pk2(o0, o1); }
                else ((unsigned*)(KR + (size_t)t * 128))[(head - 8) * 32 + pi] = pk2(o0, o1);
            }
            ((unsigned*)(VR + (size_t)t * 128))[lane] = vw[u];
        }
    }
}

constexpr int G_KNP = 0, G_QNP = 17408, G_KNTP = 34816, G_VCT = 53248;
constexpr int G_D0 = 71680, G_D1 = 71680 + 19456;
constexpr int GD_TBP = 0, GD_AP = 9216, GD_VEC = 18432;
constexpr int G_LM = 110592;
constexpr int G_GV = G_LM + 32768;
static_assert(G_GV + 2048 <= LDS_BYTES - 64, "gdn pre lds");

#define TRI_ROW(i, LC, LN) { \
        if ((i) + 1 < 64) { _Pragma("unroll") for (int j4 = 0; j4 < ((i) + 1 + 3) / 4 && j4 < 8; ++j4) LN[j4] = *(const LAS f32x4*)(L + ((i) + 1) * 64 + 4 * j4); } \
        _Pragma("unroll") for (int j4 = 8; j4 < ((i) + 3) / 4; ++j4) lt[j4 - 8] = *(const LAS f32x4*)(L + (i) * 64 + 4 * j4); \
        __builtin_amdgcn_sched_barrier(0); \
        f32x2_t a0 = {(lane == (i)) ? 1.0f : 0.0f, 0.f}, a1 = {0.f, 0.f}; \
        _Pragma("unroll") for (int j4 = 0; j4 < ((i) + 3) / 4; ++j4) { const f32x4 l = (j4 < 8) ? LC[j4 & 7] : lt[(j4 - 8) & 7]; \
            f32x2_t l0 = {l.x, (4 * j4 + 1 < (i)) ? l.y : 0.f}, l1 = {(4 * j4 + 2 < (i)) ? l.z : 0.f, (4 * j4 + 3 < (i)) ? l.w : 0.f}; \
            a0 -= l0 * xp[2 * j4]; if (4 * j4 + 2 < (i)) a1 -= l1 * xp[2 * j4 + 1]; } \
        const float a = (a0.x + a0.y) + (a1.x + a1.y); \
        if ((i) & 1) xp[(i) >> 1].y = a; else { xp[(i) >> 1].x = a; xp[(i) >> 1].y = 0.f; } \
        TBP[(REV ? 63 - (i) : (i)) * 72 + pc] = (bf16)(pk2(a * bcol, 0.f) & 0xffffu); \
        __builtin_amdgcn_sched_barrier(0); }
template <bool REV> DI void tri_inverse(LAS float* L, const LAS float* beta, LAS bf16* TBP, int lane) {
    f32x2_t xp[32];
    L = opaque(L); TBP = opaque(TBP); lane = opaque(lane);
    const float bcol = REV ? beta[63 - lane] : beta[lane];
    const int pc = REV ? permcol(63 - lane) : permcol(lane);
    f32x4 la[8], lb[8], lt[8];
#pragma unroll
    for (int ii = 0; ii < 64; ii += 2) { TRI_ROW(ii, la, lb) TRI_ROW(ii + 1, lb, la) }
}
#undef TRI_ROW

DI void gdn_conv(Frame& F, LAS unsigned char* lds, int t384, int b, int h, int n) {
    const bf16* QKVA = (const bf16*)(F.ws + WS_QKVA); const float* convw = F.in[3];
    const int cgp = t384 % 48, rg = t384 / 48, mat = cgp >> 4, cc = (cgp & 15) * 8;
    const int col = mat * 512 + h * 128 + cc;
    float w[5][8];
#pragma unroll
    for (int j = 0; j < 5; ++j) { const f32x4 a = *(const f32x4*)(convw + j * 1536 + col), bq = *(const f32x4*)(convw + j * 1536 + col + 4);
        w[j][0] = a.x; w[j][1] = a.y; w[j][2] = a.z; w[j][3] = a.w; w[j][4] = bq.x; w[j][5] = bq.y; w[j][6] = bq.z; w[j][7] = bq.w; }
    const int a4 = (cc >> 3) & 3, p0 = (cc & ~31) + 16 * (a4 & 1) + 4 * (a4 >> 1);
    const int ra = rg & 3, q0 = (rg >> 2) * 32 + 16 * (ra & 1) + 4 * (ra >> 1);
#pragma unroll
    for (int hf = 0; hf < 2; ++hf) {
        float o[4][8];
#pragma unroll
        for (int r = 0; r < 4; ++r)
#pragma unroll
            for (int c = 0; c < 8; ++c) o[r][c] = 0.f;
#pragma unroll
        for (int i = 0; i < 8; ++i) {
            const int pos = n * 64 + rg * 8 + hf * 4 - 2 + i;
            v4u raw = (v4u){0u, 0u, 0u, 0u};
            if (pos >= 0 && pos < SEQ) raw = *(const v4u*)(QKVA + (size_t)(b * SEQ + pos) * 1536 + col);
            float xin[8] = {bflo(raw.x), bfhi(raw.x), bflo(raw.y), bfhi(raw.y), bflo(raw.z), bfhi(raw.z), bflo(raw.w), bfhi(raw.w)};
#pragma unroll
            for (int j = 0; j < 5; ++j) { const int r = i - j; if (r >= 0 && r < 4) {
#pragma unroll
                for (int c = 0; c < 8; ++c) o[r][c] += w[j][c] * xin[c]; } }
        }
#pragma unroll
        for (int r = 0; r < 4; ++r) {
            float ss = 0.f;
#pragma unroll
            for (int c = 0; c < 8; ++c) { o[r][c] = siluf(o[r][c]); ss += o[r][c] * o[r][c]; }
            ss += __shfl_xor(ss, 1); ss += __shfl_xor(ss, 2); ss += __shfl_xor(ss, 4); ss += __shfl_xor(ss, 8);
            float sc = 1.0f;
            if (mat < 2) { sc = __builtin_amdgcn_rsqf(ss + EPS); if (mat == 0) sc *= 0.08838834764831845f; }
#pragma unroll
            for (int c = 0; c < 8; ++c) o[r][c] *= sc;
        }
        if (mat < 2) {
            LAS unsigned char* tile = lds + (mat == 0 ? G_QNP : G_KNP);
#pragma unroll
            for (int r = 0; r < 4; ++r) { const int c = rg * 8 + hf * 4 + r;
                v2u lo, hi2; lo.x = pk2(o[r][0], o[r][1]); lo.y = pk2(o[r][2], o[r][3]); hi2.x = pk2(o[r][4], o[r][5]); hi2.y = pk2(o[r][6], o[r][7]);
                *(LAS v2u*)(tile + c * 272 + p0 * 2) = lo; *(LAS v2u*)(tile + c * 272 + (p0 + 8) * 2) = hi2; }
        }
        if (mat >= 1) {
#pragma unroll
            for (int c = 0; c < 8; ++c) {
                v2u q4; q4.x = pk2(o[0][c], o[1][c]); q4.y = pk2(o[2][c], o[3][c]);
                if (mat == 1) *(LAS v2u*)(lds + G_KNTP + (cc + c) * 144 + (q0 + 8 * hf) * 2) = q4;
                else *(LAS v2u*)(lds + G_VCT + (cc + c) * 144 + rg * 16 + hf * 8) = q4;
            }
        }
    }
}
DI void gdn_gates(Frame& F, LAS unsigned char* lds, LAS float* gv, int lane, int b, int h, int n) {
    const float* gp = (const float*)(F.ws + WS_GATES) + (size_t)(b * SEQ + n * 64 + lane) * 16;
    const float bfv = gp[h], bbv = gp[4 + h], afv = gp[8 + h], abv = gp[12 + h];
    const float betaf = sigmoidf_(bfv), betab = sigmoidf_(bbv);
    const float xf = afv + F.in[5][h], xb = abv + F.in[5][4 + h];
    const float spf = fmaxf(xf, 0.f) + log1pf(__expf(-fabsf(xf))), spb = fmaxf(xb, 0.f) + log1pf(__expf(-fabsf(xb)));
    const float gf = -__expf(F.in[4][h]) * spf, gb = -__expf(F.in[4][4 + h]) * spb;
    float Gf = gf, Rb = gb;
#pragma unroll
    for (int o = 1; o < 64; o <<= 1) { const float u1 = __shfl_up(Gf, o); if (lane >= o) Gf += u1; const float d1 = __shfl_down(Rb, o); if (lane + o < 64) Rb += d1; }
    gv[lane] = Gf; gv[64 + lane] = Rb; gv[128 + lane] = betaf; gv[192 + lane] = betab;
    const float GfL = __shfl(Gf, 63), Rb0 = __shfl(Rb, 0);
    LAS float* v0 = (LAS float*)(lds + G_D0 + GD_VEC); LAS float* v1 = (LAS float*)(lds + G_D1 + GD_VEC);
    v0[lane] = __expf(Gf); v0[64 + lane] = __expf(GfL - Gf); v1[lane] = __expf(Rb); v1[64 + lane] = __expf(Rb0 - Rb);
    if (lane == 0) { v0[128] = __expf(GfL); v1[128] = __expf(Rb0); }
}
DI void p2_gdn_pre(Frame& F) {
    const int tid = F.tid, lane = F.lane, wave = F.wave;
    int task = F.vcu;
    if (task < 1024) {
        LAS unsigned char* lds = opaque(F.lds);
        const int b = task >> 9, h = (task >> 7) & 3, n = task & 127;
        if (wave >= 2) gdn_conv(F, lds, tid - 128, b, h, n);
        if (wave == 2) gdn_gates(F, lds, (LAS float*)(lds + G_GV), lane, b, h, n);
    }
    __syncthreads();
    int par = 0;
#pragma unroll 1
    for (; task < 1024; task += F.G, par ^= 1) {
        LAS unsigned char* lds = opaque(F.lds);
        const int b = task >> 9, h = (task >> 7) & 3, n = task & 127, bh = b * 4 + h;
        LAS float* gv = (LAS float*)(lds + G_GV + par * 1024);
        LAS float* sGf = gv; LAS float* sRb = gv + 64; LAS float* sBf = gv + 128; LAS float* sBb = gv + 192;
        {
            const int p = wave >> 2, mt = wave & 3, n16 = lane & 15, g = lane >> 4;
            const LAS unsigned char* At = lds + (p == 0 ? G_KNP : G_QNP) + (16 * mt + n16) * 272 + g * 16;
            bf16x8 af[4], bfr[16];
#pragma unroll
            for (int ks = 0; ks < 4; ++ks) af[ks] = *(const LAS bf16x8*)(At + ks * 64);
#pragma unroll
            for (int nt = 0; nt < 4; ++nt)
#pragma unroll
                for (int ks = 0; ks < 4; ++ks) bfr[nt * 4 + ks] = *(const LAS bf16x8*)(lds + G_KNP + (16 * nt + n16) * 272 + g * 16 + ks * 64);
            float Gc[4], Rc[4], Bfc[4], Bbc[4];
#pragma unroll
            for (int r = 0; r < 4; ++r) { const int c = 16 * mt + 4 * g + r; Gc[r] = sGf[c]; Rc[r] = sRb[c]; Bfc[r] = sBf[c]; Bbc[r] = sBb[c]; }
#pragma unroll
            for (int nt = 0; nt < 4; ++nt) {
                f32x4 acc = (f32x4){0.f, 0.f, 0.f, 0.f};
#pragma unroll
                for (int ks = 0; ks < 4; ++ks) acc = __builtin_amdgcn_mfma_f32_16x16x32_bf16(af[ks], bfr[nt * 4 + ks], acc, 0, 0, 0);
                const int s_ = 16 * nt + n16; const float Gs = sGf[s_], Rs = sRb[s_]; const int ps = permcol(s_);
#pragma unroll
                for (int r = 0; r < 4; ++r) {
                    const int c = 16 * mt + 4 * g + r; const float v = acc[r];
                    const float df = __expf(fminf(Gc[r] - Gs, 0.f)), db = __expf(fminf(Rc[r] - Rs, 0.f));
                    if (p == 0) {
                        ((LAS float*)(lds + G_LM))[c * 64 + s_] = Bfc[r] * v * df;
                        ((LAS float*)(lds + G_LM + 16384))[(63 - c) * 64 + (63 - s_)] = Bbc[r] * v * db;
                    } else {
                        ((LAS bf16*)(lds + G_D0 + GD_AP))[c * 72 + ps] = (bf16)(pk2(s_ <= c ? v * df : 0.f, 0.f) & 0xffffu);
                        ((LAS bf16*)(lds + G_D1 + GD_AP))[c * 72 + ps] = (bf16)(pk2(s_ >= c ? v * db : 0.f, 0.f) & 0xffffu);
                    }
                }
            }
        }
        __syncthreads();
        GAS v4u* gd0 = (GAS v4u*)(F.ws + WS_GD + (size_t)((bh * 2 + 0) * 128 + n) * GDN_D_BYTES);
        GAS v4u* gd1 = (GAS v4u*)(F.ws + WS_GD + (size_t)((bh * 2 + 1) * 128 + n) * GDN_D_BYTES);
        {
            GAS v4u* gsh = (GAS v4u*)(F.ws + WS_GSH + (size_t)(bh * 128 + n) * GDN_SH_BYTES);
#pragma unroll 3
            for (int i = tid; i < (int)(GDN_SH_BYTES / 16); i += NTHREADS) gsh[i] = *(const LAS v4u*)(lds + i * 16);
#pragma unroll 1
            for (int i = GD_AP / 16 + tid; i < (int)(GDN_D_BYTES / 16); i += NTHREADS) { gd0[i] = *(const LAS v4u*)(lds + G_D0 + i * 16); gd1[i] = *(const LAS v4u*)(lds + G_D1 + i * 16); }
        }
        __syncthreads();
        if (wave == 0) { tri_inverse<false>((LAS float*)(lds + G_LM), sBf, (LAS bf16*)(lds + G_D0 + GD_TBP), lane);
#pragma unroll 3
            for (int i = lane; i < GD_AP / 16; i += 64) gd0[i] = *(const LAS v4u*)(lds + G_D0 + i * 16); }
        else if (wave == 1) { tri_inverse<true>((LAS float*)(lds + G_LM + 16384), sBb, (LAS bf16*)(lds + G_D1 + GD_TBP), lane);
#pragma unroll 3
            for (int i = lane; i < GD_AP / 16; i += 64) gd1[i] = *(const LAS v4u*)(lds + G_D1 + i * 16); }
        else {
            const int t2 = task + F.G;
            if (t2 < 1024) { const int b2 = t2 >> 9, h2 = (t2 >> 7) & 3, n2 = t2 & 127;
                gdn_conv(F, lds, tid - 128, b2, h2, n2);
                if (wave == 2) gdn_gates(F, lds, (LAS float*)(lds + G_GV + (par ^ 1) * 1024), lane, b2, h2, n2); }
        }
        __syncthreads();
    }
}

DI bf16x8 pack8(const f32x4 a, const f32x4 b) {
    v4u p; p.x = pk2(a[0], a[1]); p.y = pk2(a[2], a[3]); p.z = pk2(b[0], b[1]); p.w = pk2(b[2], b[3]); return __builtin_bit_cast(bf16x8, p);
}
DI void small_weights(Frame& F, int gw, int NGW) {
    LAS float* scr = (LAS float*)(F.lds + F.wave * 16384);
    bf16* WOUT = (bf16*)(F.ws + WS_WOUT);
    for (int it = gw; it < 16 * 32; it += NGW) p0_transpose_item(F.in[9], 1024, 32, WOUT, 1024, 0, 1, scr, it, F.lane);
    bf16* WRH = (bf16*)(F.ws + WS_WR); bf16* WRL = WRH + 48 * 1024; const float* wrg = F.in[11]; const float* wre = F.in[12];
    for (int i = gw * 64 + F.lane; i < 48 * 1024; i += NGW * 64) { const int j = i >> 10, k = i & 1023; float v = 0.f; if (j < 4) v = wrg[k * 4 + j]; else if (j < 36) v = wre[k * 32 + (j - 4)];
        const unsigned h = f2bf(v); const float hv = __builtin_bit_cast(float, h << 16); WRH[i] = (bf16)h; WRL[i] = (bf16)f2bf(v - hv); }
}
DI bf16* wgu_ptr(Frame& F, int e) { return (bf16*)(F.ws + (e < WGU_SPLIT ? WS_WGU0 + (size_t)e * 2 * MiB : WS_WGU1 + (size_t)(e - WGU_SPLIT) * 2 * MiB)); }
DI bf16* wd_ptr(Frame& F, int e) { return (bf16*)((unsigned char*)F.out + (e < WD_SPLIT ? DO_WD0 + (size_t)e * MiB : DO_WD1 + (size_t)(e - WD_SPLIT) * MiB)); }
DI void moe_weights(Frame& F, int gw, int NGW) {
    LAS float* scr = (LAS float*)(F.lds + F.wave * 16384);
    constexpr int IG = 16 * 16, ID = 8 * 32, IPE = 2 * IG + ID;
    for (int it = gw; it < NEXP * IPE; it += NGW) {
        const int e = it / IPE; int r = it % IPE;
        if (r < IG) { p0_transpose_item(F.in[13] + (size_t)e * 1024 * 512, 512, 16, wgu_ptr(F, e), 1024, 0, 2, scr, r, F.lane); continue; } r -= IG;
        if (r < IG) { p0_transpose_item(F.in[14] + (size_t)e * 1024 * 512, 512, 16, wgu_ptr(F, e), 1024, 1, 2, scr, r, F.lane); continue; } r -= IG;
        p0_transpose_item(F.in[15] + (size_t)e * 512 * 1024, 1024, 32, wd_ptr(F, e), 512, 0, 1, scr, r, F.lane);
    }
}

constexpr int SC_SLOT = 78848, SC_VCT = 53248, SC_D = 55552, SC_NCH = 11;
static_assert(2 * SC_SLOT <= LDS_BYTES, "scan slots");
DI void sc_issue(v4u (&R)[SC_NCH], const unsigned char* ws, const unsigned (&delta)[SC_NCH], const unsigned (&dmask)[SC_NCH], unsigned shbase, unsigned ddiff) {
#pragma unroll
    for (int j = 0; j < SC_NCH; ++j) { const unsigned off = shbase + delta[j] + (dmask[j] & ddiff);
#ifdef SC_PLAIN_LOADS
        R[j] = *(const v4u*)(ws + off); }
#else
        asm volatile("global_load_dwordx4 %0, %1, %2" : "=v"(R[j]) : "v"(off), "s"(ws) : "memory"); }
#endif
}
#ifdef SC_PLAIN_LOADS
#define SC_WAIT(R, n) do {} while (0)
#else
#define SC_WAIT(R, n) asm volatile("s_waitcnt vmcnt(" #n ")" : "+v"(R[0]), "+v"(R[1]), "+v"(R[2]), "+v"(R[3]), "+v"(R[4]), "+v"(R[5]), "+v"(R[6]), "+v"(R[7]), "+v"(R[8]), "+v"(R[9]), "+v"(R[10]) :: "memory")
#endif
DI void sc_write(const v4u (&R)[SC_NCH], LAS unsigned char* slot, int lid) {
#pragma unroll
    for (int j = 0; j < SC_NCH; ++j) *(LAS v4u*)(slot + 16 * (lid + 448 * j)) = R[j];
}
DI void p4_scan(Frame& F) {
    const int lane = F.lane, n16 = lane & 15, g = lane >> 4, wave = F.wave;
    {
        volatile LAS int* tsk = (volatile LAS int*)(F.lds + MISC_OFF + 32);
        if (F.tid == 0) {
            unsigned* q = (unsigned*)(F.ws + WS_CTL) + CW_SCANQ; const unsigned xcc = xb_xcc_id() & 7u; int task = -1;
            for (unsigned t = 0; t < 8 && task < 0; ++t) { const unsigned y = (xcc + t) & 7u; const unsigned j = xb_add(q + 64 * y, 1u); if (j < 16u) task = (int)(y * 16 + j); }
            *tsk = task; if (task < 0) tsk[1] = (int)xb_add(q + 64 * 8, 1u);
        }
        __syncthreads();
    }
    const int task = *(volatile LAS int*)(F.lds + MISC_OFF + 32);
    if (task < 0) {
        if (F.G > 128) { const int cgw = *(volatile LAS int*)(F.lds + MISC_OFF + 36) * NWAVES + wave, cng = (F.G - 128) * NWAVES; small_weights(F, cgw, cng); moe_weights(F, cgw, cng); }
        return; }
    const int chain = 2 * (task >> 4) + ((task & 15) >> 3), e = task & 7;
    const int bh = chain >> 1, dir = chain & 1, b = bh >> 2, h = bh & 3;
    LAS unsigned char* lds = opaque(F.lds);
    if (wave != 0) {
        const int lid = (wave - 1) * 64 + lane;
        const unsigned sh0 = (unsigned)(WS_GSH + (size_t)(bh * 128) * GDN_SH_BYTES), d0 = (unsigned)(WS_GD + (size_t)((bh * 2 + dir) * 128) * GDN_D_BYTES);
        unsigned delta[SC_NCH], dmask[SC_NCH];
#pragma unroll
        for (int j = 0; j < SC_NCH; ++j) { const int c = lid + 448 * j;
            delta[j] = (c < 3328) ? 16u * c : ((c < 3472) ? (unsigned)(G_VCT + 16 * e * 144 + 16 * (c - 3328)) : 16u * (c - 3472));
            dmask[j] = (c < 3472) ? 0u : 0xffffffffu; }
        v4u R0[SC_NCH], R1[SC_NCH], R2[SC_NCH];
#define SC_SRC(st) const int n_ = (dir == 0) ? ((st) < 128 ? (st) : 127) : ((st) < 128 ? 127 - (st) : 0); \
                   const unsigned shb_ = sh0 + (unsigned)n_ * (unsigned)GDN_SH_BYTES, ddf_ = (d0 + (unsigned)n_ * (unsigned)GDN_D_BYTES) - shb_;
        { SC_SRC(0) sc_issue(R0, F.ws, delta, dmask, shb_, ddf_); }
        { SC_SRC(1) sc_issue(R1, F.ws, delta, dmask, shb_, ddf_); }
        { SC_SRC(2) sc_issue(R2, F.ws, delta, dmask, shb_, ddf_); }
#define SC_BODY(R, st) { SC_WAIT(R, 22); sc_write(R, lds + ((st) & 1) * SC_SLOT, lid); { SC_SRC((st) + 3) sc_issue(R, F.ws, delta, dmask, shb_, ddf_); } \
                        asm volatile("s_waitcnt lgkmcnt(0)" ::: "memory"); __builtin_amdgcn_s_barrier(); }
#pragma unroll 1
        for (int s0 = 0; s0 < 126; s0 += 3) { SC_BODY(R0, s0) SC_BODY(R1, s0 + 1) SC_BODY(R2, s0 + 2) }
        SC_BODY(R0, 126) SC_BODY(R1, 127)
        SC_WAIT(R0, 0); SC_WAIT(R1, 0); SC_WAIT(R2, 0);
#undef SC_BODY
#undef SC_SRC
        return;
    }
    bf16* Odir = (bf16*)((unsigned char*)F.out + (dir == 0 ? DO_OF : DO_OB));
    f32x4 S[8];
#pragma unroll
    for (int i = 0; i < 8; ++i) S[i] = (f32x4){0.f, 0.f, 0.f, 0.f};
    bf16x8 Sb[4];
#pragma unroll
    for (int i = 0; i < 4; ++i) Sb[i] = (bf16x8){0, 0, 0, 0, 0, 0, 0, 0};
    const unsigned aoff272 = n16 * 272 + g * 16, aoff144 = n16 * 144 + g * 16;
    const unsigned lds0 = (unsigned)(uintptr_t)lds;
#define SB_() __builtin_amdgcn_sched_barrier(0)
#define LDR128(dst, base, off) asm volatile("ds_read_b128 %0, %1 offset:%2" : "=v"(dst) : "v"(base), "i"(off) : "memory")
#define LDR64(dst, base, off) asm volatile("ds_read_b64 %0, %1 offset:%2" : "=v"(dst) : "v"(base), "i"(off) : "memory")
#define LDR32(dst, base, off) asm volatile("ds_read_b32 %0, %1 offset:%2" : "=v"(dst) : "v"(base), "i"(off) : "memory")
#pragma unroll 1
    for (int step = 0; step < 128; ++step) {
        __builtin_amdgcn_s_barrier();
        asm volatile("" ::: "memory");
        const int n = dir == 0 ? step : 127 - step;
        const unsigned slot = lds0 + (unsigned)(step & 1) * SC_SLOT;
        const unsigned bK = slot + G_KNP + aoff272, bQ = slot + G_QNP + aoff272, bKT = slot + G_KNTP + aoff144, bT = slot + SC_D + GD_TBP + aoff144;
        const unsigned bV = slot + SC_VCT + n16 * 144 + g * 8, bvec = slot + SC_D + GD_VEC + g * 16, bd = slot + SC_D + GD_VEC;
        f32x4 eG[4], ks[4]; v2u vv[4]; float dch; bf16x8 fa[16];
        LDR128(eG[0], bvec, 0); LDR128(eG[1], bvec, 64); LDR128(eG[2], bvec, 128); LDR128(eG[3], bvec, 192);
        LDR128(ks[0], bvec, 256); LDR128(ks[1], bvec, 320); LDR128(ks[2], bvec, 384); LDR128(ks[3], bvec, 448);
        LDR32(dch, bd, 512);
        LDR64(vv[0], bV, 0); LDR64(vv[1], bV, 32); LDR64(vv[2], bV, 64); LDR64(vv[3], bV, 96);
#pragma unroll
        for (int m = 0; m < 4; ++m) { LDR128(fa[m * 4 + 0], bK, m * 4352 + 0); LDR128(fa[m * 4 + 1], bK, m * 4352 + 64); LDR128(fa[m * 4 + 2], bK, m * 4352 + 128); LDR128(fa[m * 4 + 3], bK, m * 4352 + 192); }
        bf16x8 fq[16];
#pragma unroll
        for (int m = 0; m < 4; ++m) { LDR128(fq[m * 4 + 0], bQ, m * 4352 + 0); LDR128(fq[m * 4 + 1], bQ, m * 4352 + 64); LDR128(fq[m * 4 + 2], bQ, m * 4352 + 128); LDR128(fq[m * 4 + 3], bQ, m * 4352 + 192); }
        asm volatile("s_waitcnt lgkmcnt(15)" : "+v"(eG[0]), "+v"(eG[1]), "+v"(eG[2]), "+v"(eG[3]), "+v"(ks[0]), "+v"(ks[1]), "+v"(ks[2]), "+v"(ks[3]), "+v"(dch), "+v"(vv[0]), "+v"(vv[1]), "+v"(vv[2]), "+v"(vv[3]),
                     "+v"(fa[0]), "+v"(fa[1]), "+v"(fa[2]), "+v"(fa[3]), "+v"(fa[4]), "+v"(fa[5]), "+v"(fa[6]), "+v"(fa[7]), "+v"(fa[8]), "+v"(fa[9]), "+v"(fa[10]), "+v"(fa[11]), "+v"(fa[12]), "+v"(fa[13]), "+v"(fa[14]), "+v"(fa[15]) :: "memory");
        SB_();
        f32x4 KS[4];
#pragma unroll
        for (int m = 0; m < 4; ++m) KS[m] = (f32x4){0.f, 0.f, 0.f, 0.f};
#pragma unroll
        for (int i = 0; i < 4; ++i)
#pragma unroll
            for (int m = 0; m < 4; ++m) KS[m] = __builtin_amdgcn_mfma_f32_16x16x32_bf16(fa[m * 4 + i], Sb[i], KS[m], 0, 0, 0);
        SB_();
        bf16x8 ft[8];
#pragma unroll
        for (int m = 0; m < 4; ++m) { LDR128(ft[m * 2 + 0], bT, m * 2304 + 0); LDR128(ft[m * 2 + 1], bT, m * 2304 + 64); }
        asm volatile("s_waitcnt lgkmcnt(8)" : "+v"(fq[0]), "+v"(fq[1]), "+v"(fq[2]), "+v"(fq[3]), "+v"(fq[4]), "+v"(fq[5]), "+v"(fq[6]), "+v"(fq[7]), "+v"(fq[8]), "+v"(fq[9]), "+v"(fq[10]), "+v"(fq[11]), "+v"(fq[12]), "+v"(fq[13]), "+v"(fq[14]), "+v"(fq[15]) :: "memory");
        SB_();
        f32x4 o[4];
#pragma unroll
        for (int m = 0; m < 4; ++m) o[m] = (f32x4){0.f, 0.f, 0.f, 0.f};
#pragma unroll
        for (int i = 0; i < 4; ++i)
#pragma unroll
            for (int m = 0; m < 4; ++m) o[m] = __builtin_amdgcn_mfma_f32_16x16x32_bf16(fq[m * 4 + i], Sb[i], o[m], 0, 0, 0);
        f32x4 rr[4];
#pragma unroll
        for (int m = 0; m < 4; ++m) { rr[m][0] = bflo(vv[m].x) - eG[m][0] * KS[m][0]; rr[m][1] = bfhi(vv[m].x) - eG[m][1] * KS[m][1]; rr[m][2] = bflo(vv[m].y) - eG[m][2] * KS[m][2]; rr[m][3] = bfhi(vv[m].y) - eG[m][3] * KS[m][3]; }
        bf16x8 rb[2]; rb[0] = pack8(rr[0], rr[1]); rb[1] = pack8(rr[2], rr[3]);
        SB_();
        bf16x8 fk[16];
#pragma unroll
        for (int jt = 0; jt < 8; ++jt) { LDR128(fk[jt * 2 + 0], bKT, jt * 2304 + 0); LDR128(fk[jt * 2 + 1], bKT, jt * 2304 + 64); }
        asm volatile("s_waitcnt lgkmcnt(15)" : "+v"(ft[0]), "+v"(ft[1]), "+v"(ft[2]), "+v"(ft[3]), "+v"(ft[4]), "+v"(ft[5]), "+v"(ft[6]), "+v"(ft[7]) :: "memory");
        SB_();
        f32x4 vn[4];
#pragma unroll
        for (int m = 0; m < 4; ++m) vn[m] = (f32x4){0.f, 0.f, 0.f, 0.f};
#pragma unroll
        for (int i = 0; i < 2; ++i)
#pragma unroll
            for (int m = 0; m < 4; ++m) vn[m] = __builtin_amdgcn_mfma_f32_16x16x32_bf16(ft[m * 2 + i], rb[i], vn[m], 0, 0, 0);
#pragma unroll
        for (int m = 0; m < 4; ++m) o[m] = o[m] * eG[m];
#pragma unroll
        for (int jt = 0; jt < 8; ++jt) S[jt] = S[jt] * dch;
        SB_();
        bf16x8 fp[8];
#pragma unroll
        for (int m = 0; m < 4; ++m) { LDR128(fp[m * 2 + 0], bT, GD_AP + m * 2304 + 0); LDR128(fp[m * 2 + 1], bT, GD_AP + m * 2304 + 64); }
        bf16x8 vnb[2]; vnb[0] = pack8(vn[0], vn[1]); vnb[1] = pack8(vn[2], vn[3]);
        bf16x8 vs[2]; vs[0] = pack8(vn[0] * ks[0], vn[1] * ks[1]); vs[1] = pack8(vn[2] * ks[2], vn[3] * ks[3]);
        asm volatile("s_waitcnt lgkmcnt(8)" : "+v"(fk[0]), "+v"(fk[1]), "+v"(fk[2]), "+v"(fk[3]), "+v"(fk[4]), "+v"(fk[5]), "+v"(fk[6]), "+v"(fk[7]), "+v"(fk[8]), "+v"(fk[9]), "+v"(fk[10]), "+v"(fk[11]), "+v"(fk[12]), "+v"(fk[13]), "+v"(fk[14]), "+v"(fk[15]) :: "memory");
        SB_();
#pragma unroll
        for (int i = 0; i < 2; ++i)
#pragma unroll
            for (int jt = 0; jt < 8; ++jt) S[jt] = __builtin_amdgcn_mfma_f32_16x16x32_bf16(fk[jt * 2 + i], vs[i], S[jt], 0, 0, 0);
        asm volatile("s_waitcnt lgkmcnt(0)" : "+v"(fp[0]), "+v"(fp[1]), "+v"(fp[2]), "+v"(fp[3]), "+v"(fp[4]), "+v"(fp[5]), "+v"(fp[6]), "+v"(fp[7]) :: "memory");
#pragma unroll
        for (int i = 0; i < 2; ++i)
#pragma unroll
            for (int m = 0; m < 4; ++m) o[m] = __builtin_amdgcn_mfma_f32_16x16x32_bf16(fp[m * 2 + i], vnb[i], o[m], 0, 0, 0);
#pragma unroll
        for (int i = 0; i < 4; ++i) Sb[i] = pack8(S[2 * i], S[2 * i + 1]);
        SB_();
        bf16* op = Odir + (size_t)(b * SEQ + n * 64) * 512 + h * 128 + 16 * e + n16;
#pragma unroll
        for (int m = 0; m < 4; ++m)
#pragma unroll
            for (int r = 0; r < 4; ++r) op[(size_t)(16 * m + 4 * g + r) * 512] = (bf16)(pk2(o[m][r], 0.f) & 0xffffu);
    }
#undef SB_
#undef LDR128
#undef LDR64
#undef LDR32
}

DI void p5_combine(Frame& F) {
    const int gw = F.vcu * NWAVES + F.wave, NGW = F.G * NWAVES, lane = F.lane;
    const bf16* OFp = (const bf16*)((unsigned char*)F.out + DO_OF); const bf16* OBp = (const bf16*)((unsigned char*)F.out + DO_OB);
    const bf16* ZA = (const bf16*)(F.ws + WS_ZA); bf16* OCAT = (bf16*)(F.ws + WS_OCAT);
    const float* nw = F.in[6] + (lane & 15) * 8;
    float w8[8];
#pragma unroll
    for (int c = 0; c < 8; ++c) w8[c] = nw[c];
    constexpr int NB4 = 4;
    for (int t0 = gw; t0 < TT; t0 += NB4 * NGW) {
        v4u a[NB4], bb[NB4], z[NB4];
#pragma unroll
        for (int u = 0; u < NB4; ++u) { const int t = (t0 + u * NGW < TT) ? t0 + u * NGW : t0;
            a[u] = *(const v4u*)(OFp + (size_t)t * 512 + lane * 8); bb[u] = *(const v4u*)(OBp + (size_t)t * 512 + lane * 8); z[u] = *(const v4u*)(ZA + (size_t)t * 512 + lane * 8); }
#pragma unroll
        for (int u = 0; u < NB4; ++u) {
            const int t = t0 + u * NGW; if (t >= TT) break;
            float o[8] = {bflo(a[u].x) + bflo(bb[u].x), bfhi(a[u].x) + bfhi(bb[u].x), bflo(a[u].y) + bflo(bb[u].y), bfhi(a[u].y) + bfhi(bb[u].y), bflo(a[u].z) + bflo(bb[u].z), bfhi(a[u].z) + bfhi(bb[u].z), bflo(a[u].w) + bflo(bb[u].w), bfhi(a[u].w) + bfhi(bb[u].w)};
            const float zz[8] = {bflo(z[u].x), bfhi(z[u].x), bflo(z[u].y), bfhi(z[u].y), bflo(z[u].z), bfhi(z[u].z), bflo(z[u].w), bfhi(z[u].w)};
            float ss = 0.f;
#pragma unroll
            for (int c = 0; c < 8; ++c) ss += o[c] * o[c];
            ss += __shfl_xor(ss, 1); ss += __shfl_xor(ss, 2); ss += __shfl_xor(ss, 4); ss += __shfl_xor(ss, 8);
            const float rn = __builtin_amdgcn_rsqf(ss * (1.f / 128.f) + EPS);
#pragma unroll
            for (int c = 0; c < 8; ++c) o[c] = o[c] * rn * w8[c] * siluf(zz[c]);
            v4u r; r.x = pk2(o[0], o[1]); r.y = pk2(o[2], o[3]); r.z = pk2(o[4], o[5]); r.w = pk2(o[6], o[7]);
            *(v4u*)(OCAT + (size_t)t * 1024 + lane * 8) = r;
        }
    }
}

struct TokRec { int e[2]; int row[2]; float gate[2]; };
DI void p7_route(Frame& F) {
    const int lane = F.lane, n16 = lane & 15, g = lane >> 4, wave = F.wave;
    const float* X1 = (const float*)(F.ws + WS_X1); const float* nfw = F.in[10];
    const bf16* WRH = (const bf16*)(F.ws + WS_WR); const bf16* WRL = WRH + 48 * 1024;
    bf16* HN = (bf16*)((unsigned char*)F.out + DO_HN); TokRec* TOK = (TokRec*)(F.ws + WS_TOK); unsigned* gcnt = (unsigned*)(F.ws + WS_CTL) + CW_CNT; int* LIST = (int*)(F.ws + WS_LIST);
    LAS float* lg = (LAS float*)(F.lds + (wave & 3) * 4096);
    LAS unsigned* hist = (LAS unsigned*)(F.lds + 16384); LAS unsigned* base = hist + 32;
    const int sub = blockIdx.x & 7;
    for (int rt0 = blockIdx.x * 4; rt0 < TT / 16; rt0 += F.G * 4) {
        if (F.tid < 32) hist[F.tid] = 0u;
        __syncthreads();
        int ex1 = 0, ex2 = 0, tok = -1; unsigned l1 = 0, l2 = 0; float g1 = 0.f, g2 = 0.f;
        const int rt = rt0 + wave;
        if (wave < 4 && rt < TT / 16) {
            const int row = rt * 16 + n16; const float* xr = X1 + (size_t)row * DMODEL + 8 * g;
            float ss = 0.f;
#pragma unroll 16
            for (int i = 0; i < 32; ++i) { const f32x4 a = *(const f32x4*)(xr + 32 * i), b2 = *(const f32x4*)(xr + 32 * i + 4);
                ss += (a.x * a.x + a.y * a.y) + (a.z * a.z + a.w * a.w) + (b2.x * b2.x + b2.y * b2.y) + (b2.z * b2.z + b2.w * b2.w); }
            ss += __shfl_xor(ss, 16); ss += __shfl_xor(ss, 32);
            const float rs = __builtin_amdgcn_rsqf(ss * (1.f / DMODEL) + EPS);
            f32x4 acc[3];
#pragma unroll
            for (int q = 0; q < 3; ++q) acc[q] = (f32x4){0.f, 0.f, 0.f, 0.f};
#pragma unroll 4
            for (int i = 0; i < 32; ++i) {
                const f32x4 a = *(const f32x4*)(xr + 32 * i), b2 = *(const f32x4*)(xr + 32 * i + 4);
                const f32x4 wa = *(const f32x4*)(nfw + 32 * i + 8 * g), wb = *(const f32x4*)(nfw + 32 * i + 8 * g + 4);
                float hv[8] = {a.x * rs * wa.x, a.y * rs * wa.y, a.z * rs * wa.z, a.w * rs * wa.w, b2.x * rs * wb.x, b2.y * rs * wb.y, b2.z * rs * wb.z, b2.w * rs * wb.w};
                v4u hi, lo; unsigned hh[8], ll[8];
#pragma unroll
                for (int c = 0; c < 8; ++c) { hh[c] = f2bf(hv[c]); ll[c] = f2bf(hv[c] - __builtin_bit_cast(float, hh[c] << 16)); }
                hi.x = hh[0] | (hh[1] << 16); hi.y = hh[2] | (hh[3] << 16); hi.z = hh[4] | (hh[5] << 16); hi.w = hh[6] | (hh[7] << 16);
                lo.x = ll[0] | (ll[1] << 16); lo.y = ll[2] | (ll[3] << 16); lo.z = ll[4] | (ll[5] << 16); lo.w = ll[6] | (ll[7] << 16);
                *(v4u*)(HN + (size_t)row * DMODEL + 32 * i + 8 * g) = hi;
                const bf16x8 ah = __builtin_bit_cast(bf16x8, hi), al = __builtin_bit_cast(bf16x8, lo);
#pragma unroll
                for (int q = 0; q < 3; ++q) {
                    const bf16x8 bh = *(const bf16x8*)(WRH + (size_t)(16 * q + n16) * 1024 + 32 * i + 8 * g), bl = *(const bf16x8*)(WRL + (size_t)(16 * q + n16) * 1024 + 32 * i + 8 * g);
                    acc[q] = __builtin_amdgcn_mfma_f32_16x16x32_bf16(ah, bh, acc[q], 0, 0, 0);
                    acc[q] = __builtin_amdgcn_mfma_f32_16x16x32_bf16(ah, bl, acc[q], 0, 0, 0);
                    acc[q] = __builtin_amdgcn_mfma_f32_16x16x32_bf16(al, bh, acc[q], 0, 0, 0);
                }
            }
#pragma unroll
            for (int q = 0; q < 3; ++q)
#pragma unroll
                for (int r = 0; r < 4; ++r) lg[(4 * g + r) * 48 + 16 * q + n16] = acc[q][r];
            asm volatile("s_waitcnt lgkmcnt(0)" ::: "memory");
            if (lane < 16) {
                const LAS float* L = lg + lane * 48; tok = rt * 16 + lane;
                float gm = L[0]; int gs = 0;
#pragma unroll
                for (int q = 1; q < 4; ++q) if (L[q] > gm) { gm = L[q]; gs = q; }
                float gsum = 0.f;
#pragma unroll
                for (int q = 0; q < 4; ++q) gsum += __expf(L[q] - gm);
                const float gp_top = 1.0f / gsum;
                float fv[8];
#pragma unroll
                for (int q = 0; q < 8; ++q) { float v = L[4 + q]; v = (gs == 1) ? L[12 + q] : v; v = (gs == 2) ? L[20 + q] : v; v = (gs == 3) ? L[28 + q] : v; fv[q] = v; }
                float m1 = fv[0]; int i1 = 0;
#pragma unroll
                for (int q = 1; q < 8; ++q) if (fv[q] > m1) { m1 = fv[q]; i1 = q; }
                float m2 = -3.0e38f; int i2 = 0;
#pragma unroll
                for (int q = 0; q < 8; ++q) if (q != i1 && fv[q] > m2) { m2 = fv[q]; i2 = q; }
                const float e2 = __expf(m2 - m1); g1 = gp_top / (1.0f + e2); g2 = gp_top * e2 / (1.0f + e2);
                ex1 = gs * 8 + i1; ex2 = gs * 8 + i2;
                l1 = __hip_atomic_fetch_add(hist + ex1, 1u, __ATOMIC_RELAXED, __HIP_MEMORY_SCOPE_WORKGROUP); l2 = __hip_atomic_fetch_add(hist + ex2, 1u, __ATOMIC_RELAXED, __HIP_MEMORY_SCOPE_WORKGROUP);
            }
        }
        __syncthreads();
        if (F.tid < 32) { const unsigned hcount = hist[F.tid]; base[F.tid] = hcount ? atomicAdd(gcnt + F.tid * 8 + sub, hcount) : 0u; }
        __syncthreads();
        if (tok >= 0) {
            const int s1 = (int)(base[ex1] + l1), s2 = (int)(base[ex2] + l2);
            LIST[(size_t)(ex1 * 8 + sub) * TT + s1] = tok; LIST[(size_t)(ex2 * 8 + sub) * TT + s2] = tok;
            TokRec tr; tr.e[0] = ex1; tr.e[1] = ex2; tr.row[0] = (sub << 24) | s1; tr.row[1] = (sub << 24) | s2; tr.gate[0] = g1; tr.gate[1] = g2;
            TOK[tok] = tr;
        }
    }
}

DI void build_etab(Frame& F) {
    LAS unsigned* etab = (LAS unsigned*)(F.lds + ETAB_OFF);
    if (F.tid < 32) {
        const unsigned* gcnt = (const unsigned*)(F.ws + WS_CTL) + CW_CNT + F.tid * 8; unsigned acc = 0;
#pragma unroll
        for (int q = 0; q < 8; ++q) { const unsigned c = __hip_atomic_load(gcnt + q, __ATOMIC_RELAXED, __HIP_MEMORY_SCOPE_AGENT); etab[96 + 8 * F.tid + q] = acc; acc += c; }
        etab[64 + F.tid] = acc; etab[2 * F.tid + 1] = (acc + 255u) >> 8;
    }
    __syncthreads();
    if (F.tid == 0) { unsigned acc = 0; for (int e = 0; e < NEXP; ++e) { etab[2 * e] = acc; acc += etab[2 * e + 1]; } }
    __syncthreads();
}

DI void p11_final(Frame& F) {
    build_etab(F);
    const LAS unsigned* etab = (const LAS unsigned*)(F.lds + ETAB_OFF);
    const int gw = F.vcu * NWAVES + F.wave, NGW = F.G * NWAVES, lane = F.lane;
    const bf16* Y = (const bf16*)(F.ws + WS_XBUF); const TokRec* TOK = (const TokRec*)(F.ws + WS_TOK); const float* fw = F.in[16];
    const f32x4 w0 = *(const f32x4*)(fw + lane * 8), w1 = *(const f32x4*)(fw + lane * 8 + 4), w2 = *(const f32x4*)(fw + 512 + lane * 8), w3 = *(const f32x4*)(fw + 516 + lane * 8);
    constexpr int NB2 = 2;
    for (int t0 = gw; t0 < TT; t0 += NB2 * NGW) {
        TokRec tr[NB2]; f32x4 xa[NB2][4]; v4u ya[NB2][2][2];
#pragma unroll
        for (int u = 0; u < NB2; ++u) { const int t = (t0 + u * NGW < TT) ? t0 + u * NGW : t0; tr[u] = TOK[t];
            const float* xr = (const float*)(F.ws + WS_X1) + (size_t)t * DMODEL + lane * 8;
            xa[u][0] = *(const f32x4*)(xr); xa[u][1] = *(const f32x4*)(xr + 4); xa[u][2] = *(const f32x4*)(xr + 512); xa[u][3] = *(const f32x4*)(xr + 516); }
#pragma unroll
        for (int u = 0; u < NB2; ++u)
#pragma unroll
            for (int k = 0; k < 2; ++k) { const unsigned rk = (unsigned)tr[u].row[k]; const bf16* yr = Y + (size_t)(etab[2 * tr[u].e[k]] * 256u + etab[96 + 8 * tr[u].e[k] + (rk >> 24)] + (rk & 0xffffffu)) * DMODEL + lane * 8; ya[u][k][0] = *(const v4u*)(yr); ya[u][k][1] = *(const v4u*)(yr + 512); }
#pragma unroll
        for (int u = 0; u < NB2; ++u) {
            const int t = t0 + u * NGW; if (t >= TT) break;
            float v[16] = {xa[u][0].x, xa[u][0].y, xa[u][0].z, xa[u][0].w, xa[u][1].x, xa[u][1].y, xa[u][1].z, xa[u][1].w, xa[u][2].x, xa[u][2].y, xa[u][2].z, xa[u][2].w, xa[u][3].x, xa[u][3].y, xa[u][3].z, xa[u][3].w};
#pragma unroll
            for (int k = 0; k < 2; ++k) {
                const float gk = tr[u].gate[k]; const v4u y0 = ya[u][k][0], y1 = ya[u][k][1];
                v[0] += gk * bflo(y0.x); v[1] += gk * bfhi(y0.x); v[2] += gk * bflo(y0.y); v[3] += gk * bfhi(y0.y); v[4] += gk * bflo(y0.z); v[5] += gk * bfhi(y0.z); v[6] += gk * bflo(y0.w); v[7] += gk * bfhi(y0.w);
                v[8] += gk * bflo(y1.x); v[9] += gk * bfhi(y1.x); v[10] += gk * bflo(y1.y); v[11] += gk * bfhi(y1.y); v[12] += gk * bflo(y1.z); v[13] += gk * bfhi(y1.z); v[14] += gk * bflo(y1.w); v[15] += gk * bfhi(y1.w);
            }
            float ss = 0.f;
#pragma unroll
            for (int i = 0; i < 16; ++i) ss += v[i] * v[i];
            const float rs = __builtin_amdgcn_rsqf(wave_sum(ss) * (1.f / DMODEL) + EPS);
            float* orow = F.out + (size_t)t * DMODEL + lane * 8;
            *(f32x4*)(orow) = (f32x4){v[0] * rs * w0.x, v[1] * rs * w0.y, v[2] * rs * w0.z, v[3] * rs * w0.w};
            *(f32x4*)(orow + 4) = (f32x4){v[4] * rs * w1.x, v[5] * rs * w1.y, v[6] * rs * w1.z, v[7] * rs * w1.w};
            *(f32x4*)(orow + 512) = (f32x4){v[8] * rs * w2.x, v[9] * rs * w2.y, v[10] * rs * w2.z, v[11] * rs * w2.w};
            *(f32x4*)(orow + 516) = (f32x4){v[12] * rs * w3.x, v[13] * rs * w3.y, v[14] * rs * w3.z, v[15] * rs * w3.w};
        }
    }
}

struct Args { const float* in[17]; float* out; unsigned char* ws; int ph_lo, ph_hi; };
__global__ void __launch_bounds__(NTHREADS, 2) fwd_kernel(Args args) {
    extern __shared__ __attribute__((aligned(16))) unsigned char lds[];
    cg::grid_group grid = cg::this_grid();
    Frame F;
    F.lds = (LAS unsigned char*)lds; F.tid = threadIdx.x; F.lane = F.tid & 63; F.wave = __builtin_amdgcn_readfirstlane(F.tid >> 6);
    F.G = gridDim.x; { const int bx = blockIdx.x; F.vcu = (F.G % 8 == 0) ? (bx % 8) * (F.G / 8) + bx / 8 : bx; }
#pragma unroll
    for (int i = 0; i < 17; ++i) F.in[i] = args.in[i];
    F.out = args.out; F.ws = args.ws;
    const int lo = args.ph_lo, hi = args.ph_hi;
    if (F.tid < 16) ((volatile LAS unsigned*)(F.lds + MISC_OFF))[F.tid] = 0u;
    __syncthreads();
    XcdBarrier bar = xcd_barrier_post((unsigned*)(F.ws + WS_CTL) + CW_BAR, (volatile LAS unsigned*)(F.lds + MISC_OFF));
    if (lo > 1000) grid.sync();
#ifndef PHSEL
#define PHSEL 0xfff
#endif
#define IN(k) (((PHSEL >> (k)) & 1) && lo <= (k) && (k) < hi)
#define SEAM(k) do { if (IN(k) && IN((k) + 1)) xcd_barrier(bar); } while (0)
#ifndef REP_PH
#define REP_PH -1
#endif
#define REPS(k) for (int rep_ = 0; rep_ < ((k) == REP_PH ? 2 : 1); ++rep_, ((k) == REP_PH && rep_ < 2) ? xcd_barrier(bar) : (void)0)
    if (IN(0)) REPS(0) { p0_prologue(F); } SEAM(0);
    if (IN(1)) REPS(1) {
        pg8::Gemm gm{(const pg8::bf16_t*)(F.ws + WS_XN), (const pg8::bf16_t*)(F.ws + WS_WIN), TT, NPROJ, DMODEL}; pg8::StaticOrder S; S.init(TT, NPROJ, F.G, (int)blockIdx.x);
        EpiProj E{(bf16*)(F.ws + WS_QKVA), (bf16*)(F.ws + WS_ZA), (bf16*)(F.ws + WS_QKVB), (float*)(F.ws + WS_GATES)};
        pg8::gemm_phase<EpiProj, pg8::StaticOrder, true, true>(F.lds, gm, S, E);
    } SEAM(1);
    if (IN(2)) REPS(2) {
#ifndef NO_ROPE
        p2_rope(F);
#ifdef PROBE_ROPE2
        xcd_barrier(bar); p2_rope(F);
#endif
#endif
#ifndef NO_PRE
        p2_gdn_pre(F);
#ifdef PROBE_PRE2
        xcd_barrier(bar); p2_gdn_pre(F);
#endif
#endif
    } SEAM(2);
    if (IN(3)) REPS(3) {
        const attn_body::AttnTensors AT{(const attn_body::bf16*)((unsigned char*)F.out + DO_QR), (const attn_body::bf16*)((unsigned char*)F.out + DO_KR), (const attn_body::bf16*)((unsigned char*)F.out + DO_VR),
                                        (attn_body::bf16*)(F.ws + WS_OCAT) + 512};
        const attn_body::StaticOrder S((int)F.G, (int)blockIdx.x);
#ifdef PROBE_ZERO_ATTN
        { (void)AT; (void)S; bf16* OC = (bf16*)(F.ws + WS_OCAT); const int gt = blockIdx.x * NTHREADS + F.tid, GT = F.G * NTHREADS;
          for (int i = gt; i < TT * 64; i += GT) { const int t = i >> 6, c = i & 63; *(v4u*)(OC + (size_t)t * 1024 + 512 + c * 8) = (v4u){0u, 0u, 0u, 0u}; } }
#else
        attn_body::attn_phase<attn_body::StaticOrder>((char*)lds, AT, S);
#endif
    } SEAM(3);
#ifdef PROBE_SCAN2
    if (IN(4)) { p4_scan(F); xcd_barrier(bar); p4_scan(F); } SEAM(4);
#else
    if (IN(4)) REPS(4) { p4_scan(F); } SEAM(4);
#endif
    if (IN(5)) REPS(5) { p5_combine(F); if (F.G <= 128) { small_weights(F, F.vcu * NWAVES + F.wave, F.G * NWAVES); moe_weights(F, F.vcu * NWAVES + F.wave, F.G * NWAVES); } } SEAM(5);
    if (IN(6)) REPS(6) {
        pg8::Gemm gm{(const pg8::bf16_t*)(F.ws + WS_OCAT), (const pg8::bf16_t*)(F.ws + WS_WOUT), TT, DMODEL, DMODEL}; pg8::StaticOrder S; S.init(TT, DMODEL, F.G, (int)blockIdx.x);
        EpiResid E{F.in[0], (float*)(F.ws + WS_X1)};
        pg8::gemm_phase<EpiResid, pg8::StaticOrder, true, true>(F.lds, gm, S, E);
    } SEAM(6);
    if (IN(7)) { p7_route(F); } SEAM(7);
    if (IN(9)) REPS(9) {
        build_etab(F);
        pg8::Gemm gm{(const pg8::bf16_t*)((unsigned char*)F.out + DO_HN), (const pg8::bf16_t*)(F.ws + WS_WGU0), 0, 0, DMODEL};
        MoeOrder S{(const LAS unsigned*)(F.lds + ETAB_OFF), F.G, (int)blockIdx.x, WGU_SPLIT, (int)((WS_WGU1 - WS_WGU0) / (512 * 1024))};
        MoeRows AM{(const int*)(F.ws + WS_LIST), (const LAS unsigned*)(F.lds + ETAB_OFF)};
        EpiGU E{(bf16*)(F.ws + WS_HID)};
        pg8::gemm_phase_gather<EpiGU, MoeOrder, MoeRows, true>(F.lds, gm, S, E, AM);
    } SEAM(9);
    if (IN(10)) REPS(10) {
        pg8::Gemm gm{(const pg8::bf16_t*)(F.ws + WS_HID), (const pg8::bf16_t*)((unsigned char*)F.out + DO_WD0), 0, 0, FFE}; build_etab(F); MoeOrder S{(const LAS unsigned*)(F.lds + ETAB_OFF), F.G, (int)blockIdx.x, WD_SPLIT, (int)((DO_WD1 - DO_WD0) / (256 * 1024))};
        EpiY E{(bf16*)(F.ws + WS_XBUF)};
        pg8::gemm_phase<EpiY, MoeOrder, true, true>(F.lds, gm, S, E);
    } SEAM(10);
#ifdef EXTRA_SYNCS
    for (int q_ = 0; q_ < EXTRA_SYNCS; ++q_) xcd_barrier(bar);
#endif
    if (IN(11)) { p11_final(F); }
#undef IN
#undef SEAM
}

extern "C" void kernel_launch(void* const* d_in, const int* in_sizes, int n_in, void* d_out, int out_size, void* d_ws, size_t ws_size, hipStream_t stream) {
    static int grid = 0;
    if (grid == 0) {
        if (n_in != 17 || out_size != TT * DMODEL || ws_size < WS_END) { fprintf(stderr, "kernel_launch: unexpected problem (n_in %d out %d ws %zu)\n", n_in, out_size, ws_size); grid = -1; return; }
        int dev = 0, cus = 0, per_cu = 0;
        if (hipGetDevice(&dev) != hipSuccess || hipDeviceGetAttribute(&cus, hipDeviceAttributeMultiprocessorCount, dev) != hipSuccess) { grid = -1; return; }
        if (hipFuncSetAttribute((const void*)fwd_kernel, hipFuncAttributeMaxDynamicSharedMemorySize, LDS_BYTES) != hipSuccess) { fprintf(stderr, "hipFuncSetAttribute failed\n"); grid = -1; return; }
        if (hipOccupancyMaxActiveBlocksPerMultiprocessor(&per_cu, (const void*)fwd_kernel, NTHREADS, LDS_BYTES) != hipSuccess || per_cu < 1) { fprintf(stderr, "occupancy query: %d\n", per_cu); grid = -1; return; }
        grid = cus;
    }
    if (grid < 0) return;
    (void)hipMemsetAsync((char*)d_ws + WS_CTL, 0, CTL_ZERO_BYTES, stream);
    Args a{};
    for (int i = 0; i < 17; ++i) a.in[i] = (const float*)d_in[i];
    a.out = (float*)d_out; a.ws = (unsigned char*)d_ws;
#if MK_PER_PHASE
    for (int p = 0; p < N_PHASES; ++p) { a.ph_lo = p; a.ph_hi = p + 1; hipLaunchKernelGGL(fwd_kernel, dim3(grid), dim3(NTHREADS), LDS_BYTES, stream, a); }
#else
    a.ph_lo = 0; a.ph_hi = N_PHASES;
    void* kargs[] = {&a};
    hipError_t e = hipLaunchCooperativeKernel((void*)fwd_kernel, dim3(grid), dim3(NTHREADS), kargs, LDS_BYTES, stream);
    if (e != hipSuccess) fprintf(stderr, "cooperative launch failed: %s (grid %d)\n", hipGetErrorString(e), grid);
#endif
}
```

```cpp
#include <hip/hip_runtime.h>
#include <cstdio>
#include <cstdint>
namespace pg8 {
#define PG8_LAS __attribute__((address_space(3)))
typedef unsigned short bf16_t;
typedef short bf16x8 __attribute__((ext_vector_type(8)));
typedef float f32x4 __attribute__((ext_vector_type(4)));
typedef unsigned u32x4 __attribute__((ext_vector_type(4)));
constexpr int BM = 256, BK = 64, HALF = 128, HTB = HALF * BK * 2  , STAGE_BYTES = 8 * HTB, NXCD = 8, WGM = 8;

__host__ __device__ __forceinline__ int lds_byte(int r, int c) { const int st = (r >> 4) * 2 + (c >> 5), rr = r & 15, cc = c & 31, ob = rr * 64 + cc * 2; return st * 1024 + (ob ^ (((ob >> 9) & 1) << 5)); }
__host__ __device__ __forceinline__ void stage_rc(int b, int& R, int& C) { const int st = b / 1024, sb = b % 1024, swz = sb ^ (((sb >> 9) & 1) << 5); R = (st >> 1) * 16 + swz / 64; C = (st & 1) * 32 + (swz % 64) / 2; }
__host__ __device__ __forceinline__ int perm32(int rho) { const int n = rho >> 4, i = rho & 15; return 8 * (i >> 2) + 4 * n + (i & 3); }

struct Unit { int pm, pn, ex, tq; };
struct Gemm { const bf16_t* A; const bf16_t* Bt; int M, N, K; };

struct StaticOrder {
    int nM, nN, nwg, G, c;
    __host__ __device__ void init(int M, int N, int G_, int c_) { nM = M / BM; nN = N / BM; nwg = nM * nN; G = G_; c = c_; }
    __host__ __device__ bool next(int i, Unit& u) const {
        const long L = (long)i * G + c; if (L >= nwg) return false;
        int wgid = (int)L; { const int q = nwg / NXCD, r = nwg % NXCD, xcd = wgid % NXCD, off = wgid / NXCD; wgid = (xcd < r ? xcd * (q + 1) : r * (q + 1) + (xcd - r) * q) + off; }
        const int nig = WGM * nN, gid = wgid / nig, fm = gid * WGM, gsz = (nM - fm) < WGM ? (nM - fm) : WGM;
        u.pm = fm + ((wgid % nig) % gsz); u.pn = (wgid % nig) / gsz; return true;
    }
    __device__ __forceinline__ void a_ready(const Unit&) const {}
    __device__ __forceinline__ void done(const Unit&) const {}
};

__device__ __forceinline__ unsigned cvt_pk_bf16(float lo, float hi) { unsigned r; asm volatile("v_cvt_pk_bf16_f32 %0, %1, %2" : "=v"(r) : "v"(lo), "v"(hi)); return r; }
typedef float f32x2 __attribute__((ext_vector_type(2)));
template <class Epi, class Sched, bool ALIGN_EPI = false, bool SP2 = false>
__device__ __forceinline__ void gemm_phase(PG8_LAS unsigned char* lds, const Gemm g, const Sched& S, const Epi& E) {
    const int tid = threadIdx.x, wid = __builtin_amdgcn_readfirstlane(tid >> 6), lane = tid & 63, wr = wid >> 2, wc = wid & 3, fr = lane & 15, fq = lane >> 4;
    const int K = g.K, nt = K / BK;
    unsigned voffA[2], voffB[2];
#pragma unroll
    for (int i = 0; i < 2; ++i) { int R, C; stage_rc(tid * 16 + i * 8192, R, C); const int Rb = Epi::PERM ? ((R & ~31) + perm32(R & 31)) : R;
        voffA[i] = (unsigned)(R * K + C) * 2u; voffB[i] = (unsigned)(Rb * K + C) * 2u; }
    const size_t kstep = (size_t)(BK * 2);
    const size_t hstep = (size_t)HALF * K * 2;
    const size_t tstep = 2 * hstep;
    const unsigned ldsw = (unsigned)wid * 1024u;
    const int aoff = lds_byte(wr * 64 + fr, fq * 8), boff = lds_byte(wc * 32 + fr, fq * 8);
#define PG8_SA(b, h) (((b) * 2 + (h)) * HTB)
#define PG8_SB(b, h) ((4 + (b) * 2 + (h)) * HTB)
#define PG8_STAGE(bufoff, gbase, voff) do { _Pragma("unroll") for (int _i = 0; _i < 2; ++_i) \
        __builtin_amdgcn_global_load_lds((const unsigned*)((const char*)(gbase) + (voff)[_i]), (PG8_LAS unsigned*)(lds + (bufoff) + ldsw + _i * 8192), 16, 0, 0); } while (0)
#define PG8_LDA(dst, b, h) do { _Pragma("unroll") for (int m = 0; m < 4; ++m) _Pragma("unroll") for (int k = 0; k < 2; ++k) dst[m][k] = *(const PG8_LAS bf16x8*)(lds + PG8_SA(b, h) + aoff + m * 2048 + k * 1024); } while (0)
#define PG8_LDB(dst, b, h) do { _Pragma("unroll") for (int n = 0; n < 2; ++n) _Pragma("unroll") for (int k = 0; k < 2; ++k) dst[n][k] = *(const PG8_LAS bf16x8*)(lds + PG8_SB(b, h) + boff + n * 2048 + k * 1024); } while (0)
#define PG8_MMA(ai, bj, At, Bt) do { __builtin_amdgcn_s_setprio(1); _Pragma("unroll") for (int m = 0; m < 4; ++m) _Pragma("unroll") for (int n = 0; n < 2; ++n) _Pragma("unroll") for (int k = 0; k < 2; ++k) \
        acc[ai][bj][m][n] = __builtin_amdgcn_mfma_f32_16x16x32_bf16(Bt[n][k], At[m][k], acc[ai][bj][m][n], 0, 0, 0); __builtin_amdgcn_s_setprio(0); } while (0)
#define PG8_WAIT_V(n) asm volatile("s_waitcnt vmcnt(" #n ")" ::: "memory")
#define PG8_WAIT_L(n) asm volatile("s_waitcnt lgkmcnt(" #n ")" ::: "memory")
#define PG8_BAR __builtin_amdgcn_s_barrier()
#define PG8_SCHED __builtin_amdgcn_sched_barrier(0)
    Unit cur, nxt; int ui = 0;
    if (!S.next(0, cur)) return;
    f32x4 acc[2][2][4][2];
#pragma unroll
    for (int a = 0; a < 2; ++a)
#pragma unroll
        for (int b = 0; b < 2; ++b)
#pragma unroll
            for (int m = 0; m < 4; ++m)
#pragma unroll
                for (int n = 0; n < 2; ++n) acc[a][b][m][n] = (f32x4){0.f, 0.f, 0.f, 0.f};
    bf16x8 At[4][2], B0[2][2], B1[2][2];
    const char* cA = (const char*)g.A + (size_t)cur.pm * tstep; const char* cB = (const char*)g.Bt + (size_t)cur.pn * tstep;
    S.a_ready(cur);
    if constexpr (SP2) {
        PG8_STAGE(PG8_SB(0, 0), cB, voffB); PG8_STAGE(PG8_SB(0, 1), cB + hstep, voffB); PG8_STAGE(PG8_SA(0, 0), cA, voffA); PG8_STAGE(PG8_SA(0, 1), cA + hstep, voffA);
        if (wr == 1) PG8_BAR;
        PG8_WAIT_V(2); PG8_BAR;
        PG8_STAGE(PG8_SB(1, 0), cB + kstep, voffB); PG8_STAGE(PG8_SA(1, 0), cA + kstep, voffA); PG8_STAGE(PG8_SB(1, 1), cB + hstep + kstep, voffB);
        PG8_WAIT_V(6); PG8_BAR;
    } else {
        PG8_STAGE(PG8_SB(0, 0), cB, voffB); PG8_STAGE(PG8_SA(0, 0), cA, voffA); PG8_STAGE(PG8_SB(0, 1), cB + hstep, voffB); PG8_STAGE(PG8_SA(0, 1), cA + hstep, voffA);
        if (wr == 1) PG8_BAR;
        PG8_WAIT_V(4); PG8_BAR;
        PG8_STAGE(PG8_SB(1, 0), cB + kstep, voffB); PG8_STAGE(PG8_SA(1, 0), cA + kstep, voffA); PG8_STAGE(PG8_SB(1, 1), cB + hstep + kstep, voffB);
        PG8_WAIT_V(6); PG8_BAR;
    }
    for (;;) {
        const bool has_next = S.next(ui + 1, nxt);
        const char* nA = has_next ? (const char*)g.A + (size_t)nxt.pm * tstep : cA; const char* nB = has_next ? (const char*)g.Bt + (size_t)nxt.pn * tstep : cB;
        for (int t = 0; t < nt; t += 2) {
            const bool last = (t == nt - 2);
            const char* a1 = cA + (size_t)(t + 1) * kstep;
            const char* a2 = last ? nA : cA + (size_t)(t + 2) * kstep; const char* b2 = last ? nB : cB + (size_t)(t + 2) * kstep;
            const char* a3 = a2 + kstep; const char* b3 = b2 + kstep;
            if (last && has_next) S.a_ready(nxt);
            if constexpr (SP2) {
            PG8_LDB(B0, 0, 0); PG8_LDB(B1, 0, 1); PG8_SCHED; PG8_LDA(At, 0, 0); PG8_STAGE(PG8_SA(1, 1), a1 + hstep, voffA);
            PG8_WAIT_V(8); PG8_WAIT_L(0); PG8_BAR; PG8_MMA(0, 0, At, B0); PG8_MMA(0, 1, At, B1); PG8_BAR; PG8_SCHED;
            PG8_LDA(At, 0, 1); PG8_STAGE(PG8_SB(0, 0), b2, voffB); PG8_STAGE(PG8_SB(0, 1), b2 + hstep, voffB); PG8_STAGE(PG8_SA(0, 0), a2, voffA);
            PG8_WAIT_V(8); PG8_WAIT_L(0); PG8_BAR; PG8_MMA(1, 0, At, B0); PG8_MMA(1, 1, At, B1); PG8_BAR; PG8_SCHED;
            PG8_LDB(B0, 1, 0); PG8_LDB(B1, 1, 1); PG8_SCHED; PG8_LDA(At, 1, 0); PG8_STAGE(PG8_SA(0, 1), a2 + hstep, voffA);
            PG8_WAIT_V(8); PG8_WAIT_L(0); PG8_BAR; PG8_MMA(0, 0, At, B0); PG8_MMA(0, 1, At, B1); PG8_BAR; PG8_SCHED;
            PG8_LDA(At, 1, 1); PG8_STAGE(PG8_SB(1, 0), b3, voffB); PG8_STAGE(PG8_SB(1, 1), b3 + hstep, voffB); PG8_STAGE(PG8_SA(1, 0), a3, voffA);
            PG8_WAIT_V(8); PG8_WAIT_L(0); PG8_BAR; PG8_MMA(1, 0, At, B0); PG8_MMA(1, 1, At, B1); PG8_BAR; PG8_SCHED;
            } else {
            PG8_LDB(B0, 0, 0); PG8_SCHED; PG8_LDA(At, 0, 0); PG8_STAGE(PG8_SA(1, 1), a1 + hstep, voffA);
            PG8_WAIT_L(8); PG8_BAR; PG8_WAIT_L(0); PG8_MMA(0, 0, At, B0); PG8_BAR; PG8_SCHED;
            PG8_LDB(B1, 0, 1); PG8_STAGE(PG8_SB(0, 0), b2, voffB);
            PG8_BAR; PG8_WAIT_L(0); PG8_MMA(0, 1, At, B1); PG8_BAR;
            PG8_LDA(At, 0, 1); PG8_STAGE(PG8_SA(0, 0), a2, voffA);
            PG8_BAR; PG8_WAIT_L(0); PG8_MMA(1, 0, At, B0); PG8_BAR; PG8_SCHED;
            PG8_STAGE(PG8_SB(0, 1), b2 + hstep, voffB);
            PG8_WAIT_V(6); PG8_BAR; PG8_MMA(1, 1, At, B1); PG8_BAR;
            PG8_LDB(B0, 1, 0); PG8_SCHED; PG8_LDA(At, 1, 0); PG8_STAGE(PG8_SA(0, 1), a2 + hstep, voffA);
            PG8_WAIT_L(8); PG8_BAR; PG8_WAIT_L(0); PG8_MMA(0, 0, At, B0); PG8_BAR; PG8_SCHED;
            PG8_LDB(B1, 1, 1); PG8_STAGE(PG8_SB(1, 0), b3, voffB);
            PG8_BAR; PG8_WAIT_L(0); PG8_MMA(0, 1, At, B1); PG8_BAR;
            PG8_LDA(At, 1, 1); PG8_STAGE(PG8_SA(1, 0), a3, voffA);
            PG8_BAR; PG8_WAIT_L(0); PG8_MMA(1, 0, At, B0); PG8_BAR; PG8_SCHED;
            PG8_STAGE(PG8_SB(1, 1), b3 + hstep, voffB);
            PG8_WAIT_V(6); PG8_BAR; PG8_MMA(1, 1, At, B1); PG8_BAR;
            }
        }
        if constexpr (ALIGN_EPI) { if (wr == 0) PG8_BAR; }
        if constexpr (!Epi::AFTER_DRAIN) { E(acc, cur, wr, wc, fr, fq); S.done(cur); }
        if (!has_next) break;
#pragma unroll
        for (int a = 0; a < 2; ++a)
#pragma unroll
            for (int b = 0; b < 2; ++b)
#pragma unroll
                for (int m = 0; m < 4; ++m)
#pragma unroll
                    for (int n = 0; n < 2; ++n) acc[a][b][m][n] = (f32x4){0.f, 0.f, 0.f, 0.f};
        cur = nxt; cA = nA; cB = nB; ++ui;
        if constexpr (ALIGN_EPI) { if (wr == 1) PG8_BAR; }
    }
    PG8_WAIT_V(0);
    if constexpr (!ALIGN_EPI) { if (wr == 0) PG8_BAR; }
    PG8_BAR;
    if constexpr (Epi::AFTER_DRAIN) { E.fused(acc, cur, wr, wc, fr, fq, lds, wid, lane); S.done(cur); }
#undef PG8_SA
#undef PG8_SB
#undef PG8_STAGE
#undef PG8_LDA
#undef PG8_LDB
#undef PG8_MMA
#undef PG8_WAIT_V
#undef PG8_WAIT_L
#undef PG8_BAR
#undef PG8_SCHED
}
template <class Epi, class Sched, class AMap, bool ALIGN_EPI = false>
__device__ __forceinline__ void gemm_phase_gather(PG8_LAS unsigned char* lds, const Gemm g, const Sched& S, const Epi& E, const AMap& AM) {
    constexpr bool SP2 = true;
    const int tid = threadIdx.x, wid = __builtin_amdgcn_readfirstlane(tid >> 6), lane = tid & 63, wr = wid >> 2, wc = wid & 3, fr = lane & 15, fq = lane >> 4;
    const int K = g.K, nt = K / BK;
    unsigned voffA[2], voffB[2]; int rowA[2];
#pragma unroll
    for (int i = 0; i < 2; ++i) { int R, C; stage_rc(tid * 16 + i * 8192, R, C); const int Rb = Epi::PERM ? ((R & ~31) + perm32(R & 31)) : R;
        voffA[i] = (unsigned)C * 2u; voffB[i] = (unsigned)(Rb * K + C) * 2u; rowA[i] = R; }
    const size_t kstep = (size_t)(BK * 2);
    const size_t hstep = (size_t)HALF * K * 2;
    const size_t tstep = 2 * hstep;
    const unsigned ldsw = (unsigned)wid * 1024u;
    const int aoff = lds_byte(wr * 64 + fr, fq * 8), boff = lds_byte(wc * 32 + fr, fq * 8);
#define PG8_SA(b, h) (((b) * 2 + (h)) * HTB)
#define PG8_SB(b, h) ((4 + (b) * 2 + (h)) * HTB)
#define PG8_STAGE(bufoff, gbase, voff) do { _Pragma("unroll") for (int _i = 0; _i < 2; ++_i) \
        __builtin_amdgcn_global_load_lds((const unsigned*)((const char*)(gbase) + (voff)[_i]), (PG8_LAS unsigned*)(lds + (bufoff) + ldsw + _i * 8192), 16, 0, 0); } while (0)
#define PG8_LDA(dst, b, h) do { _Pragma("unroll") for (int m = 0; m < 4; ++m) _Pragma("unroll") for (int k = 0; k < 2; ++k) dst[m][k] = *(const PG8_LAS bf16x8*)(lds + PG8_SA(b, h) + aoff + m * 2048 + k * 1024); } while (0)
#define PG8_LDB(dst, b, h) do { _Pragma("unroll") for (int n = 0; n < 2; ++n) _Pragma("unroll") for (int k = 0; k < 2; ++k) dst[n][k] = *(const PG8_LAS bf16x8*)(lds + PG8_SB(b, h) + boff + n * 2048 + k * 1024); } while (0)
#define PG8_MMA(ai, bj, At, Bt) do { __builtin_amdgcn_s_setprio(1); _Pragma("unroll") for (int m = 0; m < 4; ++m) _Pragma("unroll") for (int n = 0; n < 2; ++n) _Pragma("unroll") for (int k = 0; k < 2; ++k) \
        acc[ai][bj][m][n] = __builtin_amdgcn_mfma_f32_16x16x32_bf16(Bt[n][k], At[m][k], acc[ai][bj][m][n], 0, 0, 0); __builtin_amdgcn_s_setprio(0); } while (0)
#define PG8_WAIT_V(n) asm volatile("s_waitcnt vmcnt(" #n ")" ::: "memory")
#define PG8_WAIT_L(n) asm volatile("s_waitcnt lgkmcnt(" #n ")" ::: "memory")
#define PG8_BAR __builtin_amdgcn_s_barrier()
#define PG8_SCHED __builtin_amdgcn_sched_barrier(0)
    Unit cur, nxt; int ui = 0;
    if (!S.next(0, cur)) return;
    f32x4 acc[2][2][4][2];
#pragma unroll
    for (int a = 0; a < 2; ++a)
#pragma unroll
        for (int b = 0; b < 2; ++b)
#pragma unroll
            for (int m = 0; m < 4; ++m)
#pragma unroll
                for (int n = 0; n < 2; ++n) acc[a][b][m][n] = (f32x4){0.f, 0.f, 0.f, 0.f};
    bf16x8 At[4][2], B0[2][2], B1[2][2];
    const char* cA = (const char*)g.A; const char* cB = (const char*)g.Bt + (size_t)cur.pn * tstep;
    unsigned vA0[2], vA1[2], nA0[2], nA1[2];
#pragma unroll
    for (int i = 0; i < 2; ++i) { vA0[i] = (unsigned)AM.row(cur, rowA[i]) * (unsigned)(K * 2) + voffA[i]; vA1[i] = (unsigned)AM.row(cur, HALF + rowA[i]) * (unsigned)(K * 2) + voffA[i]; }
    S.a_ready(cur);
    if constexpr (SP2) {
        PG8_STAGE(PG8_SB(0, 0), cB, voffB); PG8_STAGE(PG8_SB(0, 1), cB + hstep, voffB); PG8_STAGE(PG8_SA(0, 0), cA, vA0); PG8_STAGE(PG8_SA(0, 1), cA, vA1);
        if (wr == 1) PG8_BAR;
        PG8_WAIT_V(2); PG8_BAR;
        PG8_STAGE(PG8_SB(1, 0), cB + kstep, voffB); PG8_STAGE(PG8_SA(1, 0), cA + kstep, vA0); PG8_STAGE(PG8_SB(1, 1), cB + hstep + kstep, voffB);
        PG8_WAIT_V(6); PG8_BAR;
    } else {
        PG8_STAGE(PG8_SB(0, 0), cB, voffB); PG8_STAGE(PG8_SA(0, 0), cA, voffA); PG8_STAGE(PG8_SB(0, 1), cB + hstep, voffB); PG8_STAGE(PG8_SA(0, 1), cA + hstep, voffA);
        if (wr == 1) PG8_BAR;
        PG8_WAIT_V(4); PG8_BAR;
        PG8_STAGE(PG8_SB(1, 0), cB + kstep, voffB); PG8_STAGE(PG8_SA(1, 0), cA + kstep, voffA); PG8_STAGE(PG8_SB(1, 1), cB + hstep + kstep, voffB);
        PG8_WAIT_V(6); PG8_BAR;
    }
    for (;;) {
        const bool has_next = S.next(ui + 1, nxt);
        const char* nA = cA; const char* nB = has_next ? (const char*)g.Bt + (size_t)nxt.pn * tstep : cB;
#pragma unroll
        for (int i = 0; i < 2; ++i) { nA0[i] = has_next ? (unsigned)AM.row(nxt, rowA[i]) * (unsigned)(K * 2) + voffA[i] : vA0[i]; nA1[i] = has_next ? (unsigned)AM.row(nxt, HALF + rowA[i]) * (unsigned)(K * 2) + voffA[i] : vA1[i]; }
        for (int t = 0; t < nt; t += 2) {
            const bool last = (t == nt - 2);
            const char* a1 = cA + (size_t)(t + 1) * kstep;
            const char* a2 = last ? nA : cA + (size_t)(t + 2) * kstep; const char* b2 = last ? nB : cB + (size_t)(t + 2) * kstep;
            const char* a3 = a2 + kstep; const char* b3 = b2 + kstep;
            unsigned s0[2], s1[2];
#pragma unroll
            for (int i = 0; i < 2; ++i) { s0[i] = vA0[i]; s1[i] = vA1[i]; }
            if (last) {
#pragma unroll
                for (int i = 0; i < 2; ++i) { unsigned t0_ = nA0[i], t1_ = nA1[i]; asm volatile("" : "+v"(t0_), "+v"(t1_)); s0[i] = t0_; s1[i] = t1_; } }
            if (last && has_next) S.a_ready(nxt);
            if constexpr (SP2) {
            PG8_LDB(B0, 0, 0); PG8_LDB(B1, 0, 1); PG8_SCHED; PG8_LDA(At, 0, 0); PG8_STAGE(PG8_SA(1, 1), a1, vA1);
            PG8_WAIT_V(8); PG8_WAIT_L(0); PG8_BAR; PG8_MMA(0, 0, At, B0); PG8_MMA(0, 1, At, B1); PG8_BAR; PG8_SCHED;
            PG8_LDA(At, 0, 1); PG8_STAGE(PG8_SB(0, 0), b2, voffB); PG8_STAGE(PG8_SB(0, 1), b2 + hstep, voffB); PG8_STAGE(PG8_SA(0, 0), a2, s0);
            PG8_WAIT_V(8); PG8_WAIT_L(0); PG8_BAR; PG8_MMA(1, 0, At, B0); PG8_MMA(1, 1, At, B1); PG8_BAR; PG8_SCHED;
            PG8_LDB(B0, 1, 0); PG8_LDB(B1, 1, 1); PG8_SCHED; PG8_LDA(At, 1, 0); PG8_STAGE(PG8_SA(0, 1), a2, s1);
            PG8_WAIT_V(8); PG8_WAIT_L(0); PG8_BAR; PG8_MMA(0, 0, At, B0); PG8_MMA(0, 1, At, B1); PG8_BAR; PG8_SCHED;
            PG8_LDA(At, 1, 1); PG8_STAGE(PG8_SB(1, 0), b3, voffB); PG8_STAGE(PG8_SB(1, 1), b3 + hstep, voffB); PG8_STAGE(PG8_SA(1, 0), a3, s0);
            PG8_WAIT_V(8); PG8_WAIT_L(0); PG8_BAR; PG8_MMA(1, 0, At, B0); PG8_MMA(1, 1, At, B1); PG8_BAR; PG8_SCHED;
            } else {
            PG8_LDB(B0, 0, 0); PG8_SCHED; PG8_LDA(At, 0, 0); PG8_STAGE(PG8_SA(1, 1), a1 + hstep, voffA);
            PG8_WAIT_L(8); PG8_BAR; PG8_WAIT_L(0); PG8_MMA(0, 0, At, B0); PG8_BAR; PG8_SCHED;
            PG8_LDB(B1, 0, 1); PG8_STAGE(PG8_SB(0, 0), b2, voffB);
            PG8_BAR; PG8_WAIT_L(0); PG8_MMA(0, 1, At, B1); PG8_BAR;
            PG8_LDA(At, 0, 1); PG8_STAGE(PG8_SA(0, 0), a2, voffA);
            PG8_BAR; PG8_WAIT_L(0); PG8_MMA(1, 0, At, B0); PG8_BAR; PG8_SCHED;
            PG8_STAGE(PG8_SB(0, 1), b2 + hstep, voffB);
            PG8_WAIT_V(6); PG8_BAR; PG8_MMA(1, 1, At, B1); PG8_BAR;
            PG8_LDB(B0, 1, 0); PG8_SCHED; PG8_LDA(At, 1, 0); PG8_STAGE(PG8_SA(0, 1), a2 + hstep, voffA);
            PG8_WAIT_L(8); PG8_BAR; PG8_WAIT_L(0); PG8_MMA(0, 0, At, B0); PG8_BAR; PG8_SCHED;
            PG8_LDB(B1, 1, 1); PG8_STAGE(PG8_SB(1, 0), b3, voffB);
            PG8_BAR; PG8_WAIT_L(0); PG8_MMA(0, 1, At, B1); PG8_BAR;
            PG8_LDA(At, 1, 1); PG8_STAGE(PG8_SA(1, 0), a3, voffA);
            PG8_BAR; PG8_WAIT_L(0); PG8_MMA(1, 0, At, B0); PG8_BAR; PG8_SCHED;
            PG8_STAGE(PG8_SB(1, 1), b3 + hstep, voffB);
            PG8_WAIT_V(6); PG8_BAR; PG8_MMA(1, 1, At, B1); PG8_BAR;
            }
        }
        if constexpr (ALIGN_EPI) { if (wr == 0) PG8_BAR; }
        if constexpr (!Epi::AFTER_DRAIN) { E(acc, cur, wr, wc, fr, fq); S.done(cur); }
        if (!has_next) break;
#pragma unroll
        for (int a = 0; a < 2; ++a)
#pragma unroll
            for (int b = 0; b < 2; ++b)
#pragma unroll
                for (int m = 0; m < 4; ++m)
#pragma unroll
                    for (int n = 0; n < 2; ++n) acc[a][b][m][n] = (f32x4){0.f, 0.f, 0.f, 0.f};
        cur = nxt; cA = nA; cB = nB; ++ui;
#pragma unroll
        for (int i = 0; i < 2; ++i) { vA0[i] = nA0[i]; vA1[i] = nA1[i]; }
        if constexpr (ALIGN_EPI) { if (wr == 1) PG8_BAR; }
    }
    PG8_WAIT_V(0);
    if constexpr (!ALIGN_EPI) { if (wr == 0) PG8_BAR; }
    PG8_BAR;
    if constexpr (Epi::AFTER_DRAIN) { E.fused(acc, cur, wr, wc, fr, fq, lds, wid, lane); S.done(cur); }
#undef PG8_SA
#undef PG8_SB
#undef PG8_STAGE
#undef PG8_LDA
#undef PG8_LDB
#undef PG8_MMA
#undef PG8_WAIT_V
#undef PG8_WAIT_L
#undef PG8_BAR
#undef PG8_SCHED
}
}
#include <hip/hip_bf16.h>
#include <cmath>
namespace attn_body {
using bf16=__hip_bfloat16;
using bf16x8=__attribute__((ext_vector_type(8)))short;
using s16x4=__attribute__((ext_vector_type(4)))short;
using f32x16=__attribute__((ext_vector_type(16)))float;
using u32x4=__attribute__((ext_vector_type(4)))unsigned;
constexpr int BATCH=2,NHEAD=8,NKVH=2,SEQ=8192,D=64,QP=512,KP=128,OP=1024;
constexpr int NW=8,QBLK=32,QB=QBLK*NW,KVBLK=64,NQB=SEQ/QB;
constexpr int ATTN_UNIT_ROWS=QB;
__device__ __forceinline__ int crow(int r,int hi){return (r&3)+8*(r>>2)+4*hi;}
#define SBAR() __builtin_amdgcn_sched_barrier(0)
__device__ __forceinline__ void cmask(f32x16&p0,f32x16&p1,int jb,int qrel,int hi){
  const float NEG=-INFINITY; int kb=64*jb+4*hi;
  #pragma unroll
  for(int r=0;r<16;++r){int kv=kb+(r&3)+8*(r>>2); if(kv>qrel)p0[r]=NEG; if(kv+32>qrel)p1[r]=NEG;}
}

constexpr int NSLOT=3, SLOTB=8192;
constexpr int LDS_K=0, LDS_V=NSLOT*SLOTB, LDS_WS=2*NSLOT*SLOTB, LDS_OST=LDS_WS+NW*64*4, LDS_BYTES=LDS_OST+NW*4096;
constexpr float C2=0.125f*1.4426950408889634f;
__device__ __forceinline__ void glds16(const void*gsrc,unsigned lds_dst){unsigned keep;
  asm volatile("s_mov_b32 %0, m0\n\ts_mov_b32 m0, %2\n\ts_nop 0\n\tglobal_load_lds_dwordx4 %1, off\n\ts_mov_b32 m0, %0":"=&s"(keep):"v"(gsrc),"s"(lds_dst):"memory");}
__device__ __forceinline__ float max3f(float a,float b,float c){float r;asm("v_max3_f32 %0, %1, %2, %3":"=v"(r):"v"(a),"v"(b),"v"(c));return r;}
__device__ __forceinline__ float max2f(float a,float b){float r;asm("v_max_f32_e32 %0, %1, %2":"=v"(r):"v"(a),"v"(b));return r;}
__device__ __forceinline__ float fadd_s(float a,float b){float r;asm("v_add_f32_e32 %0, %1, %2":"=v"(r):"v"(a),"v"(b));return r;}
__device__ __forceinline__ float fsub_s(float a,float b){float r;asm("v_sub_f32_e32 %0, %1, %2":"=v"(r):"v"(a),"v"(b));return r;}
typedef float f32x2_t __attribute__((ext_vector_type(2))); typedef __bf16 bf16x2_t __attribute__((ext_vector_type(2)));
__device__ __forceinline__ unsigned cvtpk_s(float lo,float hi){f32x2_t v={lo,hi};bf16x2_t b=__builtin_convertvector(v,bf16x2_t);return __builtin_bit_cast(unsigned,b);}
#define WAIT_BAR(N) asm volatile("s_waitcnt vmcnt(" #N ") lgkmcnt(0)\n\ts_barrier":::"memory")

__device__ __forceinline__ void qkt(f32x16&p0,f32x16&p1,const char*Kslot,const bf16x8*qr,const f32x16&negm,int r32,int hi){
  const char*kb=Kslot+hi*1024+r32*16;
  #pragma unroll
  for(int d0=0;d0<4;++d0){
    const bf16x8 b0=*reinterpret_cast<const bf16x8*>(kb+d0*2048);
    const bf16x8 b1=*reinterpret_cast<const bf16x8*>(kb+d0*2048+512);
    if(d0==0){p0=__builtin_amdgcn_mfma_f32_32x32x16_bf16(b0,qr[0],negm,0,0,0);p1=__builtin_amdgcn_mfma_f32_32x32x16_bf16(b1,qr[0],negm,0,0,0);}
    else{p0=__builtin_amdgcn_mfma_f32_32x32x16_bf16(b0,qr[d0],p0,0,0,0);p1=__builtin_amdgcn_mfma_f32_32x32x16_bf16(b1,qr[d0],p1,0,0,0);}}
}
typedef __attribute__((address_space(3))) const char* lds_cptr;
typedef short v4i16_t __attribute__((ext_vector_type(4)));
__device__ __forceinline__ void kload8(bf16x8*kf,lds_cptr kp){
  kf[0]=*(const __attribute__((address_space(3))) bf16x8*)(kp);      kf[1]=*(const __attribute__((address_space(3))) bf16x8*)(kp+512);
  kf[2]=*(const __attribute__((address_space(3))) bf16x8*)(kp+2048); kf[3]=*(const __attribute__((address_space(3))) bf16x8*)(kp+2560);
  kf[4]=*(const __attribute__((address_space(3))) bf16x8*)(kp+4096); kf[5]=*(const __attribute__((address_space(3))) bf16x8*)(kp+4608);
  kf[6]=*(const __attribute__((address_space(3))) bf16x8*)(kp+6144); kf[7]=*(const __attribute__((address_space(3))) bf16x8*)(kp+6656);
}
__device__ __forceinline__ void kload2(bf16x8*kf,lds_cptr kp,int j){ kf[2*j]=*(const __attribute__((address_space(3))) bf16x8*)(kp+j*2048); kf[2*j+1]=*(const __attribute__((address_space(3))) bf16x8*)(kp+j*2048+512); }
__device__ __forceinline__ s16x4 vtr(lds_cptr p){ return __builtin_bit_cast(s16x4,__builtin_amdgcn_ds_read_tr16_b64_v4i16((__attribute__((address_space(3))) v4i16_t*)p)); }
__device__ __forceinline__ float rowmax(const f32x16&p0,const f32x16&p1){
  float a=max3f(p0[0],p0[1],p1[0]),b=max3f(p0[2],p0[3],p1[1]);a=max3f(a,p1[2],p1[3]);
  #pragma unroll
  for(int r=4;r<16;r+=4){a=max3f(a,p0[r],p0[r+1]);b=max3f(b,p0[r+2],p0[r+3]);a=max3f(a,p1[r],p1[r+1]);b=max3f(b,p1[r+2],p1[r+3]);}
  const float m=max2f(a,b);
  auto rr=__builtin_amdgcn_permlane32_swap(__float_as_uint(m),__float_as_uint(m),false,false);
  return max2f(__uint_as_float(rr[0]),__uint_as_float(rr[1]));
}
__device__ __forceinline__ void pv(f32x16*o,int vb,bf16x8 pa0,bf16x8 pa1,bf16x8 pa2,bf16x8 pa3){
  #pragma unroll
  for(int d0=0;d0<2;++d0){s16x4 lo[4],hi[4];
    #pragma unroll
    for(int ks=0;ks<4;++ks){
      asm volatile("ds_read_b64_tr_b16 %0,%1 offset:%c2":"=&v"(lo[ks]):"v"(vb),"i"(d0*4096+ks*1024):"memory");
      asm volatile("ds_read_b64_tr_b16 %0,%1 offset:%c2":"=&v"(hi[ks]):"v"(vb),"i"(d0*4096+ks*1024+512):"memory");}
    asm volatile("s_waitcnt lgkmcnt(0)":::"memory");SBAR();
    #define PK(k) (bf16x8){lo[k][0],lo[k][1],lo[k][2],lo[k][3],hi[k][0],hi[k][1],hi[k][2],hi[k][3]}
    o[d0]=__builtin_amdgcn_mfma_f32_32x32x16_bf16(pa0,PK(0),o[d0],0,0,0);
    o[d0]=__builtin_amdgcn_mfma_f32_32x32x16_bf16(pa1,PK(1),o[d0],0,0,0);
    o[d0]=__builtin_amdgcn_mfma_f32_32x32x16_bf16(pa2,PK(2),o[d0],0,0,0);
    o[d0]=__builtin_amdgcn_mfma_f32_32x32x16_bf16(pa3,PK(3),o[d0],0,0,0);
    #undef PK
  }
}

#ifndef ATTN_STORE16
#define ATTN_STORE16(p,v) (*(u32x4*)(p)=(v))
#endif
template<int THRL> __device__ __forceinline__ void attn_unit(int b,int h,int qb,const bf16*Q,const bf16*__restrict__ K,const bf16*__restrict__ V,bf16*O,char*shm){
  const int tid=threadIdx.x,lane=tid&63,r32=lane&31,hi=lane>>5; const int wid=__builtin_amdgcn_readfirstlane(tid>>6);
  const long rowbase=(long)b*SEQ; const int q0=qb*QB;
  const bf16*Qw=Q+(rowbase+q0+wid*QBLK)*QP+h*D;
  const int hk=h/(NHEAD/NKVH); const bf16*Kh=K+(long)(b*NKVH+hk)*SEQ*D,*Vh=V+(long)(b*NKVH+hk)*SEQ*D;
  const unsigned lds0=(unsigned)(uintptr_t)shm;
  float*wsf=(float*)(shm+LDS_WS)+wid*64;
  const bf16*ksrc=Kh+(wid*64+lane)*8;
  const bf16*vsrc=Vh+(wid*64+lane)*8;
  const unsigned kdst=lds0+LDS_K+wid*1024, vdst=lds0+LDS_V+wid*1024;
  #define DMA_K(t,slot) glds16(ksrc+(long)(t)*KVBLK*D,(unsigned)__builtin_amdgcn_readfirstlane(kdst+(slot)))
  #define DMA_V(t,slot) glds16(vsrc+(long)(t)*KVBLK*D,(unsigned)__builtin_amdgcn_readfirstlane(vdst+(slot)))
  const int vb0=(int)(lds0+LDS_V)+((lane>>4)&1)*32+(lane&3)*8+(4*hi+((lane&15)>>2))*64;
  const char*Kbase=shm+LDS_K; bf16x8 kf[8];
  const lds_cptr shm3=(lds_cptr)shm; const lds_cptr kp0=shm3+LDS_K+hi*1024+r32*16; const lds_cptr vp0=shm3+LDS_V+((lane>>4)&1)*32+(lane&3)*8+(4*hi+((lane&15)>>2))*64;
  constexpr int NT=SEQ/KVBLK;
  DMA_K(0,0);DMA_V(0,0);DMA_K(1,SLOTB);
  bf16x8 qr[4];
  #pragma unroll
  for(int d0=0;d0<4;++d0)qr[d0]=*reinterpret_cast<const bf16x8*>(&Qw[(long)r32*QP+d0*16+hi*8]);
  float mhat=0.f,l_reg=0.f;f32x16 o[2];o[0]=f32x16{};o[1]=f32x16{};f32x16 negm=f32x16{};asm volatile("":"+v"(negm));
  const int qrel=wid*QBLK+r32;
  #define CMASK(P0,P1,t) do{}while(0)
  bool resc=false;
  #define START(P0,P1) do{ const float rm=rowmax(P0,P1); resc=false; \
    { const float dl=rm; mhat=fadd_s(mhat,dl); \
      _Pragma("unroll") for(int r=0;r<16;++r){P0[r]=fsub_s(P0[r],dl);P1[r]=fsub_s(P1[r],dl);} \
      _Pragma("unroll") for(int r=0;r<16;++r)negm[r]=-mhat; asm volatile("":"+v"(negm)); } \
    _Pragma("unroll") for(int r=0;r<16;++r)P0[r]=__builtin_amdgcn_exp2f(P0[r]); }while(0)
  #define RESC() do{ if(resc){ asm volatile("s_waitcnt lgkmcnt(0)":::"memory"); \
      _Pragma("unroll") for(int d_=0;d_<2;++d_) _Pragma("unroll") for(int r=0;r<16;++r)o[d_][r]*=wsf[crow(r,hi)]; } }while(0)
  f32x16 pA0,pA1,pB0,pB1;
  int sl_prev=0,sl_cur=0,sl_next=SLOTB;
  #define ROT() do{sl_prev=sl_cur;sl_cur=sl_next;sl_next=(sl_next==(NSLOT-1)*SLOTB)?0:sl_next+SLOTB;}while(0)
  DMA_K(2,2*SLOTB);
  WAIT_BAR(3);
  qkt(pA0,pA1,Kbase,qr,negm,r32,hi);asm volatile("s_nop 15\n\ts_nop 7":"+v"(pA0),"+v"(pA1));CMASK(pA0,pA1,0);
  START(pA0,pA1);
  _Pragma("unroll") for(int r=0;r<16;++r)pA1[r]=__builtin_amdgcn_exp2f(pA1[r]);
  WAIT_BAR(0);
  DMA_K(3,0);DMA_V(1,SLOTB);
  ROT();
  kload8(kf,kp0+sl_cur);
  WAIT_BAR(2);
  s16x4 vlo[8],vhi[8]; u32x4 pw0,pw1,pw2,pw3;
  #define PKW(P,B) cvtpk_s(P[B],P[B+1])
  #define PAF(k) __builtin_bit_cast(bf16x8,pw##k)
  #define VFR(i) (bf16x8){vlo[i][0],vlo[i][1],vlo[i][2],vlo[i][3],vhi[i][0],vhi[i][1],vhi[i][2],vhi[i][3]}
  #define PIN(x) asm volatile("":"+v"(x))
  #define MX3(a,b,c) __builtin_fmaxf(__builtin_fmaxf((a),(b)),(c))
  #define GAPA(MF,A0,A1,A2,A3,W0,W1,PW) do{ MF; sacc+=A0; sacc+=A1; sacc+=A2; sacc+=A3; PIN(sacc); W0; W1; PIN(PW); SBAR(); }while(0)
  #define EX(v) __builtin_amdgcn_exp2f(v)
  #define GAPB(MF,X,B) do{ MF; X[B]=EX(X[B]); X[B+1]=EX(X[B+1]); X[B+2]=EX(X[B+2]); X[B+3]=EX(X[B+3]); PIN(X); SBAR(); }while(0)
  #define VRD(i) do{ vlo[i]=vtr(vp_+(((i)>>2)*4096+((i)&3)*1024)); vhi[i]=vtr(vp_+(((i)>>2)*4096+((i)&3)*1024+512)); }while(0)
  #define KRD(G,j) do{ if(G){ kload2(kf,kp0+sl_next,j); SBAR(); } }while(0)
  #define STEP(C0,C1,P0,P1,t,GK,GV,GL) do{ SBAR(); \
    const lds_cptr vp_=vp0+sl_prev; \
    VRD(0); SBAR(); float sacc=(P0[0]+P0[1]); \
    GAPA(C0=__builtin_amdgcn_mfma_f32_32x32x16_bf16(kf[0],qr[0],negm,0,0,0), P0[2],P0[3],P0[4],P0[5],     pw0[0]=PKW(P0,0), pw0[1]=PKW(P0,2), pw0); \
    VRD(4); SBAR(); GAPA(C1=__builtin_amdgcn_mfma_f32_32x32x16_bf16(kf[1],qr[0],negm,0,0,0), P0[6],P0[7],P0[8],P0[9],     pw0[2]=PKW(P0,4), pw0[3]=PKW(P0,6), pw0); \
    VRD(1); SBAR(); GAPA(C0=__builtin_amdgcn_mfma_f32_32x32x16_bf16(kf[2],qr[1],C0,0,0,0),   P0[10],P0[11],P0[12],P0[13], pw1[0]=PKW(P0,8), pw1[1]=PKW(P0,10), pw1); \
    VRD(5); SBAR(); GAPA(C1=__builtin_amdgcn_mfma_f32_32x32x16_bf16(kf[3],qr[1],C1,0,0,0),   P0[14],P0[15],P1[0],P1[1],   pw1[2]=PKW(P0,12),pw1[3]=PKW(P0,14), pw1); \
    VRD(2); SBAR(); GAPA(C0=__builtin_amdgcn_mfma_f32_32x32x16_bf16(kf[4],qr[2],C0,0,0,0),   P1[2],P1[3],P1[4],P1[5],     pw2[0]=PKW(P1,0), pw2[1]=PKW(P1,2), pw2); \
    VRD(6); SBAR(); GAPA(C1=__builtin_amdgcn_mfma_f32_32x32x16_bf16(kf[5],qr[2],C1,0,0,0),   P1[6],P1[7],P1[8],P1[9],     pw2[2]=PKW(P1,4), pw2[3]=PKW(P1,6), pw2); \
    VRD(3); SBAR(); GAPA(C0=__builtin_amdgcn_mfma_f32_32x32x16_bf16(kf[6],qr[3],C0,0,0,0),   P1[10],P1[11],P1[12],P1[13], pw3[0]=PKW(P1,8), pw3[1]=PKW(P1,10), pw3); \
    VRD(7); SBAR(); GAPA(C1=__builtin_amdgcn_mfma_f32_32x32x16_bf16(kf[7],qr[3],C1,0,0,0),   P1[14],P1[15],0.f,0.f,       pw3[2]=PKW(P1,12),pw3[3]=PKW(P1,14), pw3); \
    l_reg+=sacc; \
    if(GK){DMA_K((t)+3,sl_cur);} if(GV){DMA_V((t)+1,sl_next);} \
    CMASK(C0,C1,t); \
    { float a=MX3(C0[0],C0[1],C1[0]),b=MX3(C0[2],C0[3],C1[1]); a=MX3(a,C1[2],C1[3]); \
      _Pragma("unroll") for(int r=4;r<16;r+=4){a=MX3(a,C0[r],C0[r+1]);b=MX3(b,C0[r+2],C0[r+3]);a=MX3(a,C1[r],C1[r+1]);b=MX3(b,C1[r+2],C1[r+3]);} \
      float rm=__builtin_fmaxf(a,b); { auto rr=__builtin_amdgcn_permlane32_swap(__float_as_uint(rm),__float_as_uint(rm),false,false); rm=__builtin_fmaxf(__uint_as_float(rr[0]),__uint_as_float(rr[1])); } \
      resc=false; \
      if(__builtin_expect(__any(rm>(float)THRL),0)){ const float dl=__builtin_fmaxf(rm,0.f); mhat+=dl; \
        _Pragma("unroll") for(int r=0;r<16;++r){C0[r]-=dl;C1[r]-=dl;} \
        _Pragma("unroll") for(int r=0;r<16;++r)negm[r]=-mhat; asm volatile("":"+v"(negm)); \
        const float f=__builtin_amdgcn_exp2f(-dl); l_reg*=f; if(hi==0)wsf[r32]=f; resc=true; } } \
    SBAR(); \
    GAPB(o[0]=__builtin_amdgcn_mfma_f32_32x32x16_bf16(PAF(0),VFR(0),o[0],0,0,0), C0,0); \
    GAPB(o[1]=__builtin_amdgcn_mfma_f32_32x32x16_bf16(PAF(0),VFR(4),o[1],0,0,0), C0,4); \
    KRD(GL,0); GAPB(o[0]=__builtin_amdgcn_mfma_f32_32x32x16_bf16(PAF(1),VFR(1),o[0],0,0,0), C0,8); \
    KRD(GL,1); GAPB(o[1]=__builtin_amdgcn_mfma_f32_32x32x16_bf16(PAF(1),VFR(5),o[1],0,0,0), C0,12); \
    KRD(GL,2); GAPB(o[0]=__builtin_amdgcn_mfma_f32_32x32x16_bf16(PAF(2),VFR(2),o[0],0,0,0), C1,0); \
    KRD(GL,3); GAPB(o[1]=__builtin_amdgcn_mfma_f32_32x32x16_bf16(PAF(2),VFR(6),o[1],0,0,0), C1,4); \
    GAPB(o[0]=__builtin_amdgcn_mfma_f32_32x32x16_bf16(PAF(3),VFR(3),o[0],0,0,0), C1,8); \
    GAPB(o[1]=__builtin_amdgcn_mfma_f32_32x32x16_bf16(PAF(3),VFR(7),o[1],0,0,0), C1,12); \
    }while(0)
  int t=1;
  #undef CMASK
  #define CMASK(P0,P1,t) do{}while(0)
  for(;t+5<NT;t+=2){
    STEP(pB0,pB1,pA0,pA1,t,true,true,true);     WAIT_BAR(2); RESC(); ROT();
    STEP(pA0,pA1,pB0,pB1,t+1,true,true,true);   WAIT_BAR(2); RESC(); ROT();
  }
  #undef CMASK
  #define CMASK(P0,P1,t) do{}while(0)
  #define ENDW(tt) do{ if((tt)+3<NT){WAIT_BAR(2);} else if((tt)+2<NT){WAIT_BAR(1);} else {WAIT_BAR(0);} }while(0)
  for(;t+1<NT;t+=2){
    STEP(pB0,pB1,pA0,pA1,t,(t+3<NT),(t+1<NT),(t+1<NT));       ENDW(t);   RESC(); ROT();
    STEP(pA0,pA1,pB0,pB1,t+1,(t+4<NT),(t+2<NT),(t+2<NT));     ENDW(t+1); RESC(); ROT();
  }
  STEP(pB0,pB1,pA0,pA1,NT-1,false,false,false); RESC();
  { float sacc=pB0[0]+pB0[1]; _Pragma("unroll") for(int r=2;r<16;++r)sacc+=pB0[r]; _Pragma("unroll") for(int r=0;r<16;++r)sacc+=pB1[r]; l_reg+=sacc;
    pw0=(u32x4){PKW(pB0,0),PKW(pB0,2),PKW(pB0,4),PKW(pB0,6)};pw1=(u32x4){PKW(pB0,8),PKW(pB0,10),PKW(pB0,12),PKW(pB0,14)};pw2=(u32x4){PKW(pB1,0),PKW(pB1,2),PKW(pB1,4),PKW(pB1,6)};pw3=(u32x4){PKW(pB1,8),PKW(pB1,10),PKW(pB1,12),PKW(pB1,14)};
    SBAR(); pv(o,vb0+sl_cur,PAF(0),PAF(1),PAF(2),PAF(3)); }
  #undef PKW
  #undef PAF
  #undef VFR
  #undef PIN
  #undef MX3
  #undef GAPA
  #undef GAPB
  #undef EX
  #undef VRD
  #undef KRD
  #undef STEP
  #undef ENDW
  {auto rr=__builtin_amdgcn_permlane32_swap(__float_as_uint(l_reg),__float_as_uint(l_reg),false,false);l_reg=__uint_as_float(rr[0])+__uint_as_float(rr[1]);}
  if(hi==0)wsf[32+r32]=l_reg;asm volatile("s_waitcnt lgkmcnt(0)":::"memory");
  float rli[16];
  #pragma unroll
  for(int r=0;r<16;++r)rli[r]=__builtin_amdgcn_rcpf(wsf[32+crow(r,hi)]);
  bf16*Ow=O+(rowbase+q0+wid*QBLK)*OP+h*D;
  { bf16*stg=(bf16*)(shm+LDS_OST)+wid*2048;
    #pragma unroll
    for(int r=0;r<16;++r){const int orow=crow(r,hi);
      #pragma unroll
      for(int d0=0;d0<2;++d0)stg[orow*64+d0*32+r32]=__float2bfloat16(o[d0][r]*rli[r]);}
    asm volatile("s_waitcnt lgkmcnt(0)":::"memory");
    #pragma unroll
    for(int i=0;i<4;++i){const int row=i*8+(lane>>3),ch=lane&7; const u32x4 v=*(const u32x4*)(stg+row*64+ch*8); ATTN_STORE16(Ow+(long)row*OP+ch*8,v);} }
  asm volatile("s_waitcnt lgkmcnt(0)\n\ts_barrier":::"memory");
  #undef DMA_K
  #undef DMA_V
  #undef CMASK
  #undef START
  #undef RESC
  #undef ROT
}
constexpr int ATTN_LDS_BYTES=LDS_BYTES;
struct AttnTensors { const bf16* Q; const bf16* K; const bf16* V; bf16* O; };
struct AttnUnit { int bh; int qb; };
struct StaticOrder {
  int vcu, G;
  __device__ __forceinline__ explicit StaticOrder(int grid,int block):vcu((grid%8==0)?(block%8)*(grid/8)+block/8:block),G(grid){}
  __device__ __forceinline__ bool next(int i,AttnUnit&u)const{
    const int L=i*G+vcu; if(L>=BATCH*NHEAD*NQB)return false;
    if(G==256){ if(i>=2)return false; const int x=vcu>>5,j=vcu&31; const int b=x>>2,kvh=(x>>1)&1,hq=kvh*4+2*(x&1)+i; u.bh=b*NHEAD+hq; u.qb=j; return true; }
    u.bh=L/NQB; u.qb=L%NQB; return true; }
  __device__ __forceinline__ void a_ready(const AttnUnit&)const{}
  __device__ __forceinline__ void done(const AttnUnit&)const{}
};
template<class Sched,int THRL=8> __device__ __forceinline__ void attn_phase(char*lds,const AttnTensors&T,const Sched&S){
  AttnUnit u;
  for(int i=0;S.next(i,u);++i){ S.a_ready(u); attn_unit<THRL>(u.bh/NHEAD,u.bh%NHEAD,u.qb,T.Q,T.K,T.V,T.O,lds); S.done(u); }
}
#undef SBAR
#undef WAIT_BAR
}

#include <hip/hip_cooperative_groups.h>
namespace cg = cooperative_groups;
#ifndef MK_PER_PHASE
#define MK_PER_PHASE 0
#endif
constexpr int NWAVES = 8, NTHREADS = 512;
constexpr int NB = 2, SEQ = 8192, DMODEL = 1024, TT = NB * SEQ;
constexpr int NPROJ = 3072;
constexpr int NEXP = 32, FFE = 512;
constexpr float EPS = 1e-6f;
constexpr int N_PHASES = 12;

constexpr size_t MiB = 1u << 20;
constexpr size_t WS_CTL = 0, CTL_ZERO_BYTES = 64 * 1024;
constexpr size_t WS_WOUT = 1 * MiB;
constexpr size_t WS_LIST = 229 * MiB;
constexpr size_t WS_WR = 3 * MiB;
constexpr size_t WS_TOK = 3 * MiB + 256 * 1024;
constexpr size_t WS_GATES = 4 * MiB;
constexpr size_t WS_WIN = 5 * MiB;
constexpr size_t WS_A = 11 * MiB;
constexpr size_t WS_XN = WS_A;
constexpr size_t GDN_SH_BYTES = 71680, GDN_D_BYTES = 19456;
constexpr size_t WS_GSH = WS_A;
constexpr size_t WS_GD = WS_A + 1024 * GDN_SH_BYTES;
constexpr size_t WS_X1 = 5 * MiB;
constexpr size_t WS_HID = 69 * MiB;
constexpr size_t WS_XBUF = 109 * MiB;
constexpr size_t WS_B = 157 * MiB;
constexpr size_t WS_QKVA = WS_B;
constexpr size_t WS_QKVB = WS_B + 48 * MiB;
constexpr size_t WS_ZA = WS_B + 72 * MiB;
constexpr size_t WS_OCAT = WS_B;
constexpr size_t WS_WGU0 = 189 * MiB, WS_WGU1 = 245 * MiB; constexpr int WGU_SPLIT = 20;
constexpr size_t DO_WD0 = 0, DO_WD1 = 56 * MiB; constexpr int WD_SPLIT = 24;
constexpr size_t DO_HN = 24 * MiB;
constexpr size_t WS_END = 269 * MiB;
static_assert(WS_GD + 4096 * GDN_D_BYTES <= WS_B, "GDN records fit region A");
static_assert(WS_X1 + 64 * MiB <= WS_HID && WS_HID + 40928ull * 1024 <= WS_XBUF && WS_XBUF + 40928ull * 2048 <= WS_WGU0, "post-scan map");
static_assert(WS_WGU0 + WGU_SPLIT * 2 * MiB <= WS_B + 72 * MiB && WS_WGU1 + (32 - WGU_SPLIT) * 2 * MiB <= 269 * MiB, "WGU fragments");
constexpr size_t DO_QR = 0, DO_KR = 16 * MiB, DO_VR = 20 * MiB, DO_OF = 24 * MiB, DO_OB = 40 * MiB;
constexpr int CW_CNT = 2048;
constexpr int CW_NTILE = 128;
constexpr int CW_ETAB = 192;
constexpr int CW_SCANQ = 1024;

constexpr int LDS_BYTES = 160 * 1024;

#define GAS __attribute__((address_space(1)))
#define LAS __attribute__((address_space(3)))
typedef unsigned short bf16;
typedef unsigned v4u __attribute__((ext_vector_type(4)));
typedef unsigned v2u __attribute__((ext_vector_type(2)));
typedef float f32x4 __attribute__((ext_vector_type(4)));
typedef short bf16x8 __attribute__((ext_vector_type(8)));
typedef short s16x4 __attribute__((ext_vector_type(4)));
#define DI __device__ __forceinline__

DI unsigned f2bf(float f) { unsigned u = __builtin_bit_cast(unsigned, f); return (u + 0x7fffu + ((u >> 16) & 1u)) >> 16; }
typedef float f32x2_t __attribute__((ext_vector_type(2))); typedef __bf16 bf16x2_t __attribute__((ext_vector_type(2)));
DI unsigned pk2(float lo, float hi) { f32x2_t v = {lo, hi}; bf16x2_t b = __builtin_convertvector(v, bf16x2_t); return __builtin_bit_cast(unsigned, b); }
DI float bf2f(unsigned short h) { return __builtin_bit_cast(float, (unsigned)h << 16); }
DI float bflo(unsigned w) { return __builtin_bit_cast(float, w << 16); }
DI float bfhi(unsigned w) { return __builtin_bit_cast(float, w & 0xffff0000u); }
DI float wave_sum(float v) {
#pragma unroll
    for (int o = 1; o < 64; o <<= 1) v += __shfl_xor(v, o);
    return v;
}
DI float siluf(float x) { return x * __builtin_amdgcn_rcpf(1.0f + __expf(-x)); }
DI float sigmoidf_(float x) { return 1.0f / (1.0f + __expf(-x)); }
DI int perm32i(int idx) { return ((idx >> 2) & 3) * 8 + (idx >> 4) * 4 + (idx & 3); }
DI int permcol(int c) { return (c & ~31) + perm32i(c & 31); }
template <class T> DI T opaque(T p) { asm volatile("" : "+v"(p)); return p; }

typedef GAS unsigned gu32;
#define RLX_AGENT __ATOMIC_RELAXED, __HIP_MEMORY_SCOPE_AGENT
constexpr int CW_BAR = 4096;
constexpr int MISC_OFF = LDS_BYTES - 64;
#define XB_TMO      128
#define XB_XCNT(j)  (256  + 64 * (j))
#define XB_XSUB(j)  (1280 + 64 * (j))
#define XB_XGEN(j)  (2304 + 64 * (j))
#define XB_TOP      3328
#define XB_TOPGEN   3392
#define XCD_BAR_WORDS 3456
#define XB_SPIN_CAP (1u << 18)

__device__ __forceinline__ unsigned xb_ld(unsigned* p)              { return __hip_atomic_load(p, __ATOMIC_RELAXED, __HIP_MEMORY_SCOPE_AGENT); }
__device__ __forceinline__ unsigned xb_add(unsigned* p, unsigned v) { return __hip_atomic_fetch_add(p, v, __ATOMIC_RELAXED, __HIP_MEMORY_SCOPE_AGENT); }
__device__ __forceinline__ unsigned xb_xcc_id() { return (unsigned)__builtin_amdgcn_s_getreg((3 << 11) | 20) & 0xFu; }
#define XB_SPIN(cond, bar) do { unsigned _sp = 0; while (cond) { __builtin_amdgcn_s_sleep(1); \
    if ((++_sp & 255u) == 0u) { if (xb_ld(&(bar)[XB_TMO])) break; if (_sp > XB_SPIN_CAP) { atomicAdd(&(bar)[XB_TMO], 1u); break; } } } } while (0)

struct XcdBarrier {
    unsigned* bar; unsigned x;
    volatile LAS unsigned* st;
};

__device__ __forceinline__ XcdBarrier xcd_barrier_post(unsigned* bar, volatile LAS unsigned* st) {
    XcdBarrier b; b.bar = bar; b.x = xb_xcc_id(); b.st = st;
    if (threadIdx.x == 0) (void)xb_add(&bar[XB_XCNT(b.x)], 1u);
    return b;
}
__device__ __forceinline__ void xcd_barrier_complete(unsigned* bar, unsigned x, unsigned& nloc, unsigned& nx) {
    const unsigned G = gridDim.x * gridDim.y * gridDim.z;
    unsigned sum, cnt, mine, sp = 0u;
    for (;;) {
        sum = 0u; cnt = 0u; mine = 0u;
#pragma unroll
        for (unsigned j = 0; j < 16; ++j) { const unsigned c = xb_ld(&bar[XB_XCNT(j)]); sum += c; cnt += (c > 0u) ? 1u : 0u; mine = (j == x) ? c : mine; }
        if (sum == G) break;
        __builtin_amdgcn_s_sleep(1);
        if ((++sp & 255u) == 0u) { if (xb_ld(&bar[XB_TMO])) break; if (sp > XB_SPIN_CAP) { atomicAdd(&bar[XB_TMO], 1u); break; } }
    }
    nloc = mine > 0u ? mine : 1u; nx = cnt > 0u ? cnt : 1u;
}

__device__ __forceinline__ void xcd_barrier(const XcdBarrier& b) {
    asm volatile("s_waitcnt vmcnt(0)" ::: "memory");
    __syncthreads();
    if (threadIdx.x == 0) {
        unsigned* bar = b.bar;
        __builtin_amdgcn_s_waitcnt(0);
        unsigned nloc = b.st[0], nx = b.st[1];
        if (nloc == 0u) { xcd_barrier_complete(bar, b.x, nloc, nx); b.st[0] = nloc; b.st[1] = nx; }
        const unsigned old = xb_add(&bar[XB_XSUB(b.x)], 1u);
        const unsigned gen = old / nloc;
        if (old + 1u == (gen + 1u) * nloc) {
            __builtin_amdgcn_fence(__ATOMIC_RELEASE, "agent");
            asm volatile("s_waitcnt vmcnt(0)" ::: "memory");
            const unsigned og = xb_add(&bar[XB_TOP], 1u);
            const unsigned tg = og / nx;
            if (og + 1u == (tg + 1u) * nx) xb_add(&bar[XB_TOPGEN], 1u);
            else XB_SPIN(xb_ld(&bar[XB_TOPGEN]) == tg, bar);
            __builtin_amdgcn_fence(__ATOMIC_ACQUIRE, "agent");
            xb_add(&bar[XB_XGEN(b.x)], 1u);
            asm volatile("s_waitcnt vmcnt(0)" ::: "memory");
        } else {
            XB_SPIN(xb_ld(&bar[XB_XGEN(b.x)]) == gen, bar);
            __builtin_amdgcn_fence(__ATOMIC_ACQUIRE, "agent");
            asm volatile("s_waitcnt vmcnt(0)" ::: "memory");
        }
    }
    __syncthreads();
}

struct Frame {
    LAS unsigned char* lds;
    int tid, lane, wave, vcu, G;
    const float* in[17];
    float* out; unsigned char* ws;
};

DI void p0_transpose_item(const float* W, int ldw, int nblk, bf16* WT, int K, int row_off, int rmul, LAS float* scr, int item, int lane) {
    const int kb = item / nblk, nb = item % nblk, k0 = 64 * kb, n0 = 32 * nb;
    const int r8 = lane >> 3, c4 = (lane & 7) * 4;
    f32x4 v[8];
#pragma unroll
    for (int i = 0; i < 8; ++i) v[i] = __builtin_nontemporal_load((const f32x4*)(W + (size_t)(k0 + 8 * i + r8) * ldw + n0 + c4));
#pragma unroll
    for (int i = 0; i < 8; ++i) { LAS float* d = scr + (8 * i + r8) * 33 + c4; d[0] = v[i].x; d[1] = v[i].y; d[2] = v[i].z; d[3] = v[i].w; }
    asm volatile("s_waitcnt lgkmcnt(0)" ::: "memory");
    const int c = lane & 7;
#pragma unroll
    for (int j = 0; j < 4; ++j) { const int n = (lane >> 3) + 8 * j; const LAS float* s = scr + (8 * c) * 33 + n;
        v4u o; o.x = pk2(s[0 * 33], s[1 * 33]); o.y = pk2(s[2 * 33], s[3 * 33]); o.z = pk2(s[4 * 33], s[5 * 33]); o.w = pk2(s[6 * 33], s[7 * 33]);
        *(GAS v4u*)(WT + (size_t)(row_off + (n0 + n) * rmul) * K + k0 + 8 * c) = o; }
    asm volatile("s_waitcnt lgkmcnt(0)" ::: "memory");
}
template <int NR> DI void rms_rows_to_bf16(const float* const (&xrow)[NR], const float* w, bf16* const (&orow)[NR], int lane) {
    const GAS f32x4* wr = (const GAS f32x4*)w + lane;
    f32x4 v[NR][4];
#pragma unroll
    for (int r = 0; r < NR; ++r) { const GAS f32x4* xr = (const GAS f32x4*)xrow[r] + lane;
#pragma unroll
        for (int j = 0; j < 4; ++j) v[r][j] = xr[64 * j]; }
    f32x4 ww[4];
#pragma unroll
    for (int j = 0; j < 4; ++j) ww[j] = wr[64 * j];
#pragma unroll
    for (int r = 0; r < NR; ++r) {
        float s_ = 0.f;
#pragma unroll
        for (int j = 0; j < 4; ++j) s_ += (v[r][j].x * v[r][j].x + v[r][j].y * v[r][j].y) + (v[r][j].z * v[r][j].z + v[r][j].w * v[r][j].w);
        const float rs = __builtin_amdgcn_rsqf(wave_sum(s_) * (1.f / DMODEL) + EPS);
        GAS v2u* o8 = (GAS v2u*)orow[r] + lane;
#pragma unroll
        for (int j = 0; j < 4; ++j) { v2u o; o.x = pk2(v[r][j].x * rs * ww[j].x, v[r][j].y * rs * ww[j].y); o.y = pk2(v[r][j].z * rs * ww[j].z, v[r][j].w * rs * ww[j].w); o8[64 * j] = o; }
    }
}
DI void p0_prologue(Frame& F) {
    LAS float* scr = (LAS float*)(F.lds + F.wave * 16384);
    const int gw = F.vcu * NWAVES + F.wave, NGW = F.G * NWAVES;
    const float* w_in = F.in[2];
    bf16* WIN = (bf16*)(F.ws + WS_WIN);
    constexpr int I1 = 16 * 64, I2 = 16 * 24, I3 = 16, NITEMS = I1 + I2 + I3;
    for (int it = gw; it < NITEMS; it += NGW) {
        int r = it;
        if (r < I1) { p0_transpose_item(w_in, 2832, 64, WIN, 1024, 0, 1, scr, r, F.lane); continue; } r -= I1;
        if (r < I2) { p0_transpose_item(w_in + 2064, 2832, 24, WIN, 1024, 2048, 1, scr, r, F.lane); continue; } r -= I2;
        p0_transpose_item(w_in + 2048, 2832, 1, WIN, 1024, 2816, 1, scr, r, F.lane);
    }
    { const int gt = F.vcu * NTHREADS + F.tid, GT = F.G * NTHREADS; GAS v4u* z = (GAS v4u*)(WIN + (size_t)2848 * 1024);
      for (int i = gt; i < 224 * 1024 * 2 / 16; i += GT) z[i] = (v4u){0u, 0u, 0u, 0u}; }
    bf16* XN = (bf16*)(F.ws + WS_XN);
    for (int m = gw; m < TT; m += 2 * NGW) { const int m1 = (m + NGW < TT) ? m + NGW : m;
        const float* const xr[2] = {F.in[0] + (size_t)m * DMODEL, F.in[0] + (size_t)m1 * DMODEL}; bf16* const orw[2] = {XN + (size_t)m * DMODEL, XN + (size_t)m1 * DMODEL};
        rms_rows_to_bf16<2>(xr, F.in[1], orw, F.lane); }
}

struct EpiProj {
    static constexpr bool PERM = true, AFTER_DRAIN = false;
    bf16 *qkva, *za, *qkvb; float* gates;
    DI void operator()(const pg8::f32x4 (&acc)[2][2][4][2], const pg8::Unit& u, int wr, int wc, int fr, int fq) const {
        const int row0 = u.pm * 256 + wr * 64 + fr;
        if (u.pn == 11) {
            if (wc == 0 && fq < 2) {
#pragma unroll
                for (int ai = 0; ai < 2; ++ai)
#pragma unroll
                    for (int m = 0; m < 4; ++m) { float* rp = gates + (size_t)(row0 + ai * 128 + m * 16) * 16 + 8 * fq;
                        *(pg8::f32x4*)(rp) = acc[ai][0][m][0]; *(pg8::f32x4*)(rp + 4) = acc[ai][0][m][1]; }
            }
            return;
        }
        bf16* base; int ldc, colt;
        if (u.pn < 6) { base = qkva; ldc = 1536; colt = u.pn * 256; } else if (u.pn < 8) { base = za; ldc = 512; colt = (u.pn - 6) * 256; } else { base = qkvb; ldc = 768; colt = (u.pn - 8) * 256; }
        const int col0 = colt + wc * 32 + 8 * fq;
#pragma unroll
        for (int ai = 0; ai < 2; ++ai)
#pragma unroll
            for (int m = 0; m < 4; ++m) { bf16* rowp = base + (size_t)(row0 + ai * 128 + m * 16) * ldc + col0;
#pragma unroll
                for (int bj = 0; bj < 2; ++bj) { const pg8::f32x4 v0 = acc[ai][bj][m][0], v1 = acc[ai][bj][m][1]; pg8::u32x4 w;
                    w.x = pg8::cvt_pk_bf16(v0[0], v0[1]); w.y = pg8::cvt_pk_bf16(v0[2], v0[3]); w.z = pg8::cvt_pk_bf16(v1[0], v1[1]); w.w = pg8::cvt_pk_bf16(v1[2], v1[3]);
                    *(pg8::u32x4*)(rowp + bj * 128) = w; } }
    }
};
struct EpiResid {
    static constexpr bool PERM = false, AFTER_DRAIN = false;
    const float* x; float* x1;
    DI void operator()(const pg8::f32x4 (&acc)[2][2][4][2], const pg8::Unit& u, int wr, int wc, int fr, int fq) const {
        const int row0 = u.pm * 256 + wr * 64 + fr, col0 = u.pn * 256 + wc * 32 + 4 * fq;
#pragma unroll
        for (int ai = 0; ai < 2; ++ai)
#pragma unroll
            for (int m = 0; m < 4; ++m) { const size_t off = (size_t)(row0 + ai * 128 + m * 16) * DMODEL + col0;
#pragma unroll
                for (int bj = 0; bj < 2; ++bj)
#pragma unroll
                    for (int n = 0; n < 2; ++n) { const pg8::f32x4 b = *(const pg8::f32x4*)(x + off + bj * 128 + n * 16); *(pg8::f32x4*)(x1 + off + bj * 128 + n * 16) = b + acc[ai][bj][m][n]; } }
    }
};
struct EpiGU {
    static constexpr bool PERM = true, AFTER_DRAIN = false;
    bf16* hid;
    DI void operator()(const pg8::f32x4 (&acc)[2][2][4][2], const pg8::Unit& u, int wr, int wc, int fr, int fq) const {
        const int row0 = u.pm * 256 + wr * 64 + fr; const int jt = u.pn & 3;
        const int ff0 = jt * 128 + wc * 16 + 4 * fq;
#pragma unroll
        for (int ai = 0; ai < 2; ++ai)
#pragma unroll
            for (int m = 0; m < 4; ++m) { bf16* rowp = hid + (size_t)(row0 + ai * 128 + m * 16) * FFE + ff0;
#pragma unroll
                for (int bj = 0; bj < 2; ++bj) { const pg8::f32x4 v0 = acc[ai][bj][m][0], v1 = acc[ai][bj][m][1];
                    const float h0 = siluf(v0[0]) * v0[1], h1 = siluf(v0[2]) * v0[3], h2 = siluf(v1[0]) * v1[1], h3 = siluf(v1[2]) * v1[3];
                    v2u w; w.x = pg8::cvt_pk_bf16(h0, h1); w.y = pg8::cvt_pk_bf16(h2, h3);
                    *(v2u*)(rowp + bj * 64) = w; } }
    }
};
struct EpiY {
    static constexpr bool PERM = true, AFTER_DRAIN = false;
    bf16* y;
    DI void operator()(const pg8::f32x4 (&acc)[2][2][4][2], const pg8::Unit& u, int wr, int wc, int fr, int fq) const {
        const int row0 = u.pm * 256 + wr * 64 + fr; const int col0 = (u.pn & 3) * 256 + wc * 32 + 8 * fq;
#pragma unroll
        for (int ai = 0; ai < 2; ++ai)
#pragma unroll
            for (int m = 0; m < 4; ++m) { bf16* rowp = y + (size_t)(row0 + ai * 128 + m * 16) * DMODEL + col0;
#pragma unroll
                for (int bj = 0; bj < 2; ++bj) { const pg8::f32x4 v0 = acc[ai][bj][m][0], v1 = acc[ai][bj][m][1]; pg8::u32x4 w;
                    w.x = pg8::cvt_pk_bf16(v0[0], v0[1]); w.y = pg8::cvt_pk_bf16(v0[2], v0[3]); w.z = pg8::cvt_pk_bf16(v1[0], v1[1]); w.w = pg8::cvt_pk_bf16(v1[2], v1[3]);
                    *(pg8::u32x4*)(rowp + bj * 128) = w; } }
    }
};
constexpr int ETAB_OFF = 131072;
struct MoeOrder {
    const LAS unsigned* etab; int G, c, esplit, pnoff;
    DI bool next(int i, pg8::Unit& u) const {
        if (G % 8 != 0) {
            int L = i * G + c;
            for (int e = 0; e < NEXP; ++e) { const int n4 = 4 * (int)etab[2 * e + 1]; if (L < n4) { u.pm = (int)etab[2 * e] + (L >> 2); u.pn = (e < esplit ? 4 * e : pnoff + 4 * (e - esplit)) + (L & 3); u.ex = e; u.tq = L >> 2; return true; } L -= n4; }
            return false; }
        const int x = c & 7; int L = i * (G >> 3) + (c >> 3);
#pragma unroll
        for (int q = 0; q < NEXP / 8; ++q) { const int e = x + 8 * q; const int n4 = 4 * (int)etab[2 * e + 1];
            if (L < n4) { u.pm = (int)etab[2 * e] + (L >> 2); u.pn = (e < esplit ? 4 * e : pnoff + 4 * (e - esplit)) + (L & 3); u.ex = e; u.tq = L >> 2; return true; } L -= n4; }
        return false; }
    DI void a_ready(const pg8::Unit&) const {}
    DI void done(const pg8::Unit&) const {}
};
struct MoeRows {
    const int* list; const LAS unsigned* etab;
    DI int row(const pg8::Unit& u, int r) const {
        const int slot = u.tq * 256 + r, e = u.ex; if (slot >= (int)etab[64 + e]) return 0;
        const LAS unsigned* sp = etab + 96 + 8 * e; int sb = 0;
#pragma unroll
        for (int q = 1; q < 8; ++q) sb += (slot >= (int)sp[q]) ? 1 : 0;
        return list[(size_t)(e * 8 + sb) * TT + (slot - (int)sp[sb])]; }
};

DI void p2_rope(Frame& F) {
    const int gw = F.vcu * NWAVES + F.wave, NGW = F.G * NWAVES, lane = F.lane;
    const bf16* QKVB = (const bf16*)(F.ws + WS_QKVB);
    bf16* QR = (bf16*)((unsigned char*)F.out + DO_QR); bf16* KR = (bf16*)((unsigned char*)F.out + DO_KR); bf16* VR = (bf16*)((unsigned char*)F.out + DO_VR);
    const int pi = lane & 31, hsel = lane >> 5;
    const float qw0 = F.in[7][2 * pi], qw1 = F.in[7][2 * pi + 1], kw0 = F.in[8][2 * pi], kw1 = F.in[8][2 * pi + 1];
    const float invf = exp2f(-(float)(2 * (pi & 15)) * (13.287712379549449f / 32.0f));
    constexpr float C2 = 0.125f * 1.4426950408889634f;
    constexpr int NB4 = 4;
    for (int t0 = gw; t0 < TT; t0 += NB4 * NGW) {
        unsigned w[NB4][5], vw[NB4];
#pragma unroll
        for (int u = 0; u < NB4; ++u) { const int t = t0 + u * NGW; const unsigned* src = (const unsigned*)(QKVB + (size_t)(t < TT ? t : t0) * 768);
#pragma unroll
            for (int j = 0; j < 5; ++j) w[u][j] = src[(2 * j + hsel) * 32 + pi];
            vw[u] = src[320 + lane]; }
#pragma unroll
        for (int u = 0; u < NB4; ++u) {
            const int t = t0 + u * NGW; if (t >= TT) break;
            const int s_ = t & (SEQ - 1); const float pos = (pi < 16) ? (float)(s_ >> 6) : (float)(s_ & 63);
            const float ang = pos * invf;
            const float rev = ang * 0.15915494309189535f;
            const float sn = __builtin_amdgcn_sinf(rev), cs = __builtin_amdgcn_cosf(rev);
#pragma unroll
            for (int j = 0; j < 5; ++j) {
                const int head = 2 * j + hsel;
                const float x0 = bflo(w[u][j]), x1 = bfhi(w[u][j]);
                float ss = x0 * x0 + x1 * x1;
#pragma unroll
                for (int o = 1; o < 32; o <<= 1) ss += __shfl_xor(ss, o);
                const float rs = __builtin_amdgcn_rsqf(ss * (1.f / 64.f) + EPS);
                const bool isq = head < 8;
                const float y0 = x0 * rs * (isq ? qw0 : kw0), y1 = x1 * rs * (isq ? qw1 : kw1);
                float o0 = y0 * cs - y1 * sn, o1 = y0 * sn + y1 * cs;
                if (isq) { o0 *= C2; o1 *= C2; ((unsigned*)(QR + (size_t)t * 512))[head * 32 + pi] = pk2(o0, o1); }
                else { const int hk = head - 8, bq = t >> 13, sq = t & (SEQ - 1);
                    ((unsigned*)(KR + ((size_t)((bq * 2 + hk) * 128 + (sq >> 6)) * 8 + (pi >> 2)) * 512 + (sq & 63) * 8))[pi & 3] = pk2(o0, o1); }
            }
            { const int hk = lane >> 5, d = 2 * (lane & 31), bq = t >> 13, sq = t & (SEQ - 1), r = sq & 63;
              ((unsigned*)(VR + ((size_t)((bq * 2 + hk) * 128 + (sq >> 6)) * 8 + (d >> 5) * 4 + (r >> 4)) * 512 + ((r & 15) * 4 + ((d & 31) >> 3)) * 8))[(d & 7) >> 1] = vw[u]; }
        }
    }
}

constexpr int G_KNP = 0, G_QNP = 17408, G_KNTP = 34816, G_VCT = 53248;
constexpr int G_D0 = 71680, G_D1 = 71680 + 19456;
constexpr int GD_TBP = 0, GD_AP = 9216, GD_VEC = 18432;
constexpr int G_LM = 110592;
constexpr int G_GV = G_LM + 32768;
static_assert(G_GV + 2048 <= LDS_BYTES - 64, "gdn pre lds");

#define TRI_ROW(i, LC, LN) { \
        if ((i) + 1 < 64) { _Pragma("unroll") for (int j4 = 0; j4 < ((i) + 1 + 3) / 4 && j4 < 8; ++j4) LN[j4] = *(const LAS f32x4*)(L + ((i) + 1) * 64 + 4 * j4); } \
        _Pragma("unroll") for (int j4 = 8; j4 < ((i) + 3) / 4; ++j4) lt[j4 - 8] = *(const LAS f32x4*)(L + (i) * 64 + 4 * j4); \
        __builtin_amdgcn_sched_barrier(0); \
        f32x2_t a0 = {(lane == (i)) ? 1.0f : 0.0f, 0.f}, a1 = {0.f, 0.f}; \
        _Pragma("unroll") for (int j4 = 0; j4 < ((i) + 3) / 4; ++j4) { const f32x4 l = (j4 < 8) ? LC[j4 & 7] : lt[(j4 - 8) & 7]; \
            f32x2_t l0 = {l.x, (4 * j4 + 1 < (i)) ? l.y : 0.f}, l1 = {(4 * j4 + 2 < (i)) ? l.z : 0.f, (4 * j4 + 3 < (i)) ? l.w : 0.f}; \
            a0 -= l0 * xp[2 * j4]; if (4 * j4 + 2 < (i)) a1 -= l1 * xp[2 * j4 + 1]; } \
        const float a = (a0.x + a0.y) + (a1.x + a1.y); \
        if ((i) & 1) xp[(i) >> 1].y = a; else { xp[(i) >> 1].x = a; xp[(i) >> 1].y = 0.f; } \
        TBP[(REV ? 63 - (i) : (i)) * 72 + pc] = (bf16)(pk2(a * bcol, 0.f) & 0xffffu); \
        __builtin_amdgcn_sched_barrier(0); }
template <bool REV> DI void tri_inverse(LAS float* L, const LAS float* beta, LAS bf16* TBP, int lane) {
    f32x2_t xp[32];
    L = opaque(L); TBP = opaque(TBP); lane = opaque(lane);
    const float bcol = REV ? beta[63 - lane] : beta[lane];
    const int pc = REV ? permcol(63 - lane) : permcol(lane);
    f32x4 la[8], lb[8], lt[8];
#pragma unroll
    for (int ii = 0; ii < 64; ii += 2) { TRI_ROW(ii, la, lb) TRI_ROW(ii + 1, lb, la) }
}
#undef TRI_ROW

DI void gdn_conv(Frame& F, LAS unsigned char* lds, int t384, int b, int h, int n) {
    const bf16* QKVA = (const bf16*)(F.ws + WS_QKVA); const float* convw = F.in[3];
    const int cgp = t384 % 48, rg = t384 / 48, mat = cgp >> 4, cc = (cgp & 15) * 8;
    const int col = mat * 512 + h * 128 + cc;
    float w[5][8];
#pragma unroll
    for (int j = 0; j < 5; ++j) { const f32x4 a = *(const f32x4*)(convw + j * 1536 + col), bq = *(const f32x4*)(convw + j * 1536 + col + 4);
        w[j][0] = a.x; w[j][1] = a.y; w[j][2] = a.z; w[j][3] = a.w; w[j][4] = bq.x; w[j][5] = bq.y; w[j][6] = bq.z; w[j][7] = bq.w; }
    const int a4 = (cc >> 3) & 3, p0 = (cc & ~31) + 16 * (a4 & 1) + 4 * (a4 >> 1);
    const int ra = rg & 3, q0 = (rg >> 2) * 32 + 16 * (ra & 1) + 4 * (ra >> 1);
#pragma unroll
    for (int hf = 0; hf < 2; ++hf) {
        float o[4][8];
#pragma unroll
        for (int r = 0; r < 4; ++r)
#pragma unroll
            for (int c = 0; c < 8; ++c) o[r][c] = 0.f;
#pragma unroll
        for (int i = 0; i < 8; ++i) {
            const int pos = n * 64 + rg * 8 + hf * 4 - 2 + i;
            v4u raw = (v4u){0u, 0u, 0u, 0u};
            if (pos >= 0 && pos < SEQ) raw = *(const v4u*)(QKVA + (size_t)(b * SEQ + pos) * 1536 + col);
            float xin[8] = {bflo(raw.x), bfhi(raw.x), bflo(raw.y), bfhi(raw.y), bflo(raw.z), bfhi(raw.z), bflo(raw.w), bfhi(raw.w)};
#pragma unroll
            for (int j = 0; j < 5; ++j) { const int r = i - j; if (r >= 0 && r < 4) {
#pragma unroll
                for (int c = 0; c < 8; ++c) o[r][c] += w[j][c] * xin[c]; } }
        }
#pragma unroll
        for (int r = 0; r < 4; ++r) {
            float ss = 0.f;
#pragma unroll
            for (int c = 0; c < 8; ++c) { o[r][c] = siluf(o[r][c]); ss += o[r][c] * o[r][c]; }
            ss += __shfl_xor(ss, 1); ss += __shfl_xor(ss, 2); ss += __shfl_xor(ss, 4); ss += __shfl_xor(ss, 8);
            float sc = 1.0f;
            if (mat < 2) { sc = __builtin_amdgcn_rsqf(ss + EPS); if (mat == 0) sc *= 0.08838834764831845f; }
#pragma unroll
            for (int c = 0; c < 8; ++c) o[r][c] *= sc;
        }
        if (mat < 2) {
            LAS unsigned char* tile = lds + (mat == 0 ? G_QNP : G_KNP);
#pragma unroll
            for (int r = 0; r < 4; ++r) { const int c = rg * 8 + hf * 4 + r;
                v2u lo, hi2; lo.x = pk2(o[r][0], o[r][1]); lo.y = pk2(o[r][2], o[r][3]); hi2.x = pk2(o[r][4], o[r][5]); hi2.y = pk2(o[r][6], o[r][7]);
                *(LAS v2u*)(tile + c * 272 + p0 * 2) = lo; *(LAS v2u*)(tile + c * 272 + (p0 + 8) * 2) = hi2; }
        }
        if (mat >= 1) {
#pragma unroll
            for (int c = 0; c < 8; ++c) {
                v2u q4; q4.x = pk2(o[0][c], o[1][c]); q4.y = pk2(o[2][c], o[3][c]);
                if (mat == 1) *(LAS v2u*)(lds + G_KNTP + (cc + c) * 144 + (q0 + 8 * hf) * 2) = q4;
                else *(LAS v2u*)(lds + G_VCT + (cc + c) * 144 + rg * 16 + hf * 8) = q4;
            }
        }
    }
}
DI void gdn_gates(Frame& F, LAS unsigned char* lds, LAS float* gv, int lane, int b, int h, int n) {
    const float* gp = (const float*)(F.ws + WS_GATES) + (size_t)(b * SEQ + n * 64 + lane) * 16;
    const float bfv = gp[h], bbv = gp[4 + h], afv = gp[8 + h], abv = gp[12 + h];
    const float betaf = sigmoidf_(bfv), betab = sigmoidf_(bbv);
    const float xf = afv + F.in[5][h], xb = abv + F.in[5][4 + h];
    const float spf = fmaxf(xf, 0.f) + log1pf(__expf(-fabsf(xf))), spb = fmaxf(xb, 0.f) + log1pf(__expf(-fabsf(xb)));
    const float gf = -__expf(F.in[4][h]) * spf, gb = -__expf(F.in[4][4 + h]) * spb;
    float Gf = gf, Rb = gb;
#pragma unroll
    for (int o = 1; o < 64; o <<= 1) { const float u1 = __shfl_up(Gf, o); if (lane >= o) Gf += u1; const float d1 = __shfl_down(Rb, o); if (lane + o < 64) Rb += d1; }
    gv[lane] = Gf; gv[64 + lane] = Rb; gv[128 + lane] = betaf; gv[192 + lane] = betab;
    const float GfL = __shfl(Gf, 63), Rb0 = __shfl(Rb, 0);
    LAS float* v0 = (LAS float*)(lds + G_D0 + GD_VEC); LAS float* v1 = (LAS float*)(lds + G_D1 + GD_VEC);
    v0[lane] = __expf(Gf); v0[64 + lane] = __expf(GfL - Gf); v1[lane] = __expf(Rb); v1[64 + lane] = __expf(Rb0 - Rb);
    if (lane == 0) { v0[128] = __expf(GfL); v1[128] = __expf(Rb0); }
}
DI void p2_gdn_pre(Frame& F) {
    const int tid = F.tid, lane = F.lane, wave = F.wave;
    int task = F.vcu;
    if (task < 1024) {
        LAS unsigned char* lds = opaque(F.lds);
        const int b = task >> 9, h = (task >> 7) & 3, n = task & 127;
        if (wave >= 2) gdn_conv(F, lds, tid - 128, b, h, n);
        if (wave == 2) gdn_gates(F, lds, (LAS float*)(lds + G_GV), lane, b, h, n);
    }
    __syncthreads();
    int par = 0;
#pragma unroll 1
    for (; task < 1024; task += F.G, par ^= 1) {
        LAS unsigned char* lds = opaque(F.lds);
        const int b = task >> 9, h = (task >> 7) & 3, n = task & 127, bh = b * 4 + h;
        LAS float* gv = (LAS float*)(lds + G_GV + par * 1024);
        LAS float* sGf = gv; LAS float* sRb = gv + 64; LAS float* sBf = gv + 128; LAS float* sBb = gv + 192;
        {
            const int p = wave >> 2, mt = wave & 3, n16 = lane & 15, g = lane >> 4;
            const LAS unsigned char* At = lds + (p == 0 ? G_KNP : G_QNP) + (16 * mt + n16) * 272 + g * 16;
            bf16x8 af[4], bfr[16];
#pragma unroll
            for (int ks = 0; ks < 4; ++ks) af[ks] = *(const LAS bf16x8*)(At + ks * 64);
#pragma unroll
            for (int nt = 0; nt < 4; ++nt)
#pragma unroll
                for (int ks = 0; ks < 4; ++ks) bfr[nt * 4 + ks] = *(const LAS bf16x8*)(lds + G_KNP + (16 * nt + n16) * 272 + g * 16 + ks * 64);
            float Gc[4], Rc[4], Bfc[4], Bbc[4];
#pragma unroll
            for (int r = 0; r < 4; ++r) { const int c = 16 * mt + 4 * g + r; Gc[r] = sGf[c]; Rc[r] = sRb[c]; Bfc[r] = sBf[c]; Bbc[r] = sBb[c]; }
#pragma unroll
            for (int nt = 0; nt < 4; ++nt) {
                f32x4 acc = (f32x4){0.f, 0.f, 0.f, 0.f};
#pragma unroll
                for (int ks = 0; ks < 4; ++ks) acc = __builtin_amdgcn_mfma_f32_16x16x32_bf16(af[ks], bfr[nt * 4 + ks], acc, 0, 0, 0);
                const int s_ = 16 * nt + n16; const float Gs = sGf[s_], Rs = sRb[s_]; const int ps = permcol(s_);
#pragma unroll
                for (int r = 0; r < 4; ++r) {
                    const int c = 16 * mt + 4 * g + r; const float v = acc[r];
                    const float df = __expf(fminf(Gc[r] - Gs, 0.f)), db = __expf(fminf(Rc[r] - Rs, 0.f));
                    if (p == 0) {
                        ((LAS float*)(lds + G_LM))[c * 64 + s_] = Bfc[r] * v * df;
                        ((LAS float*)(lds + G_LM + 16384))[(63 - c) * 64 + (63 - s_)] = Bbc[r] * v * db;
                    } else {
                        ((LAS bf16*)(lds + G_D0 + GD_AP))[c * 72 + ps] = (bf16)(pk2(s_ <= c ? v * df : 0.f, 0.f) & 0xffffu);
                        ((LAS bf16*)(lds + G_D1 + GD_AP))[c * 72 + ps] = (bf16)(pk2(s_ >= c ? v * db : 0.f, 0.f) & 0xffffu);
                    }
                }
            }
        }
        __syncthreads();
        GAS v4u* gd0 = (GAS v4u*)(F.ws + WS_GD + (size_t)((bh * 2 + 0) * 128 + n) * GDN_D_BYTES);
        GAS v4u* gd1 = (GAS v4u*)(F.ws + WS_GD + (size_t)((bh * 2 + 1) * 128 + n) * GDN_D_BYTES);
        {
            GAS v4u* gsh = (GAS v4u*)(F.ws + WS_GSH + (size_t)(bh * 128 + n) * GDN_SH_BYTES);
#pragma unroll 3
            for (int i = tid; i < (int)(GDN_SH_BYTES / 16); i += NTHREADS) gsh[i] = *(const LAS v4u*)(lds + i * 16);
#pragma unroll 1
            for (int i = GD_AP / 16 + tid; i < (int)(GDN_D_BYTES / 16); i += NTHREADS) { gd0[i] = *(const LAS v4u*)(lds + G_D0 + i * 16); gd1[i] = *(const LAS v4u*)(lds + G_D1 + i * 16); }
        }
        __syncthreads();
        if (wave == 0) { tri_inverse<false>((LAS float*)(lds + G_LM), sBf, (LAS bf16*)(lds + G_D0 + GD_TBP), lane);
#pragma unroll 3
            for (int i = lane; i < GD_AP / 16; i += 64) gd0[i] = *(const LAS v4u*)(lds + G_D0 + i * 16); }
        else if (wave == 1) { tri_inverse<true>((LAS float*)(lds + G_LM + 16384), sBb, (LAS bf16*)(lds + G_D1 + GD_TBP), lane);
#pragma unroll 3
            for (int i = lane; i < GD_AP / 16; i += 64) gd1[i] = *(const LAS v4u*)(lds + G_D1 + i * 16); }
        else {
            const int t2 = task + F.G;
            if (t2 < 1024) { const int b2 = t2 >> 9, h2 = (t2 >> 7) & 3, n2 = t2 & 127;
                gdn_conv(F, lds, tid - 128, b2, h2, n2);
                if (wave == 2) gdn_gates(F, lds, (LAS float*)(lds + G_GV + (par ^ 1) * 1024), lane, b2, h2, n2); }
        }
        __syncthreads();
    }
}

DI bf16x8 pack8(const f32x4 a, const f32x4 b) {
    v4u p; p.x = pk2(a[0], a[1]); p.y = pk2(a[2], a[3]); p.z = pk2(b[0], b[1]); p.w = pk2(b[2], b[3]); return __builtin_bit_cast(bf16x8, p);
}
DI void small_weights(Frame& F, int gw, int NGW) {
    LAS float* scr = (LAS float*)(F.lds + F.wave * 16384);
    bf16* WOUT = (bf16*)(F.ws + WS_WOUT);
    for (int it = gw; it < 16 * 32; it += NGW) p0_transpose_item(F.in[9], 1024, 32, WOUT, 1024, 0, 1, scr, it, F.lane);
    bf16* WRH = (bf16*)(F.ws + WS_WR); bf16* WRL = WRH + 48 * 1024; const float* wrg = F.in[11]; const float* wre = F.in[12];
    for (int i = gw * 64 + F.lane; i < 48 * 1024; i += NGW * 64) { const int j = i >> 10, k = i & 1023; float v = 0.f; if (j < 4) v = wrg[k * 4 + j]; else if (j < 36) v = wre[k * 32 + (j - 4)];
        const unsigned h = f2bf(v); const float hv = __builtin_bit_cast(float, h << 16); WRH[i] = (bf16)h; WRL[i] = (bf16)f2bf(v - hv); }
}
DI bf16* wgu_ptr(Frame& F, int e) { return (bf16*)(F.ws + (e < WGU_SPLIT ? WS_WGU0 + (size_t)e * 2 * MiB : WS_WGU1 + (size_t)(e - WGU_SPLIT) * 2 * MiB)); }
DI bf16* wd_ptr(Frame& F, int e) { return (bf16*)((unsigned char*)F.out + (e < WD_SPLIT ? DO_WD0 + (size_t)e * MiB : DO_WD1 + (size_t)(e - WD_SPLIT) * MiB)); }
DI void moe_weights(Frame& F, int gw, int NGW) {
    LAS float* scr = (LAS float*)(F.lds + F.wave * 16384);
    constexpr int IG = 16 * 16, ID = 8 * 32, IPE = 2 * IG + ID;
    for (int it = gw; it < NEXP * IPE; it += NGW) {
        const int e = it / IPE; int r = it % IPE;
        if (r < IG) { p0_transpose_item(F.in[13] + (size_t)e * 1024 * 512, 512, 16, wgu_ptr(F, e), 1024, 0, 2, scr, r, F.lane); continue; } r -= IG;
        if (r < IG) { p0_transpose_item(F.in[14] + (size_t)e * 1024 * 512, 512, 16, wgu_ptr(F, e), 1024, 1, 2, scr, r, F.lane); continue; } r -= IG;
        p0_transpose_item(F.in[15] + (size_t)e * 512 * 1024, 1024, 32, wd_ptr(F, e), 512, 0, 1, scr, r, F.lane);
    }
}

constexpr int SC_SLOT = 78848, SC_VCT = 53248, SC_D = 55552, SC_NCH = 11;
static_assert(2 * SC_SLOT <= LDS_BYTES, "scan slots");
DI void sc_issue(v4u (&R)[SC_NCH], const unsigned char* ws, const unsigned (&delta)[SC_NCH], const unsigned (&dmask)[SC_NCH], unsigned shbase, unsigned ddiff) {
#pragma unroll
    for (int j = 0; j < SC_NCH; ++j) { const unsigned off = shbase + delta[j] + (dmask[j] & ddiff);
#ifdef SC_PLAIN_LOADS
        R[j] = *(const v4u*)(ws + off); }
#else
        asm volatile("global_load_dwordx4 %0, %1, %2" : "=v"(R[j]) : "v"(off), "s"(ws) : "memory"); }
#endif
}
#ifdef SC_PLAIN_LOADS
#define SC_WAIT(R, n) do {} while (0)
#else
#define SC_WAIT(R, n) asm volatile("s_waitcnt vmcnt(" #n ")" : "+v"(R[0]), "+v"(R[1]), "+v"(R[2]), "+v"(R[3]), "+v"(R[4]), "+v"(R[5]), "+v"(R[6]), "+v"(R[7]), "+v"(R[8]), "+v"(R[9]), "+v"(R[10]) :: "memory")
#endif
DI void sc_write(const v4u (&R)[SC_NCH], LAS unsigned char* slot, int lid) {
#pragma unroll
    for (int j = 0; j < SC_NCH; ++j) *(LAS v4u*)(slot + 16 * (lid + 448 * j)) = R[j];
}
DI void p4_scan(Frame& F) {
    const int lane = F.lane, n16 = lane & 15, g = lane >> 4, wave = F.wave;
    {
        volatile LAS int* tsk = (volatile LAS int*)(F.lds + MISC_OFF + 32);
        if (F.tid == 0) {
            unsigned* q = (unsigned*)(F.ws + WS_CTL) + CW_SCANQ; const unsigned xcc = xb_xcc_id() & 7u; int task = -1;
            for (unsigned t = 0; t < 8 && task < 0; ++t) { const unsigned y = (xcc + t) & 7u; const unsigned j = xb_add(q + 64 * y, 1u); if (j < 16u) task = (int)(y * 16 + j); }
            *tsk = task; if (task < 0) tsk[1] = (int)xb_add(q + 64 * 8, 1u);
        }
        __syncthreads();
    }
    const int task = *(volatile LAS int*)(F.lds + MISC_OFF + 32);
    if (task < 0) {
        if (F.G > 128) { const int cgw = *(volatile LAS int*)(F.lds + MISC_OFF + 36) * NWAVES + wave, cng = (F.G - 128) * NWAVES; small_weights(F, cgw, cng); moe_weights(F, cgw, cng); }
        return; }
    const int chain = 2 * (task >> 4) + ((task & 15) >> 3), e = task & 7;
    const int bh = chain >> 1, dir = chain & 1, b = bh >> 2, h = bh & 3;
    LAS unsigned char* lds = opaque(F.lds);
    if (wave != 0) {
        const int lid = (wave - 1) * 64 + lane;
        const unsigned sh0 = (unsigned)(WS_GSH + (size_t)(bh * 128) * GDN_SH_BYTES), d0 = (unsigned)(WS_GD + (size_t)((bh * 2 + dir) * 128) * GDN_D_BYTES);
        unsigned delta[SC_NCH], dmask[SC_NCH];
#pragma unroll
        for (int j = 0; j < SC_NCH; ++j) { const int c = lid + 448 * j;
            delta[j] = (c < 3328) ? 16u * c : ((c < 3472) ? (unsigned)(G_VCT + 16 * e * 144 + 16 * (c - 3328)) : 16u * (c - 3472));
            dmask[j] = (c < 3472) ? 0u : 0xffffffffu; }
        v4u R0[SC_NCH], R1[SC_NCH], R2[SC_NCH];
#define SC_SRC(st) const int n_ = (dir == 0) ? ((st) < 128 ? (st) : 127) : ((st) < 128 ? 127 - (st) : 0); \
                   const unsigned shb_ = sh0 + (unsigned)n_ * (unsigned)GDN_SH_BYTES, ddf_ = (d0 + (unsigned)n_ * (unsigned)GDN_D_BYTES) - shb_;
        { SC_SRC(0) sc_issue(R0, F.ws, delta, dmask, shb_, ddf_); }
        { SC_SRC(1) sc_issue(R1, F.ws, delta, dmask, shb_, ddf_); }
        { SC_SRC(2) sc_issue(R2, F.ws, delta, dmask, shb_, ddf_); }
#define SC_BODY(R, st) { SC_WAIT(R, 22); sc_write(R, lds + ((st) & 1) * SC_SLOT, lid); { SC_SRC((st) + 3) sc_issue(R, F.ws, delta, dmask, shb_, ddf_); } \
                        asm volatile("s_waitcnt lgkmcnt(0)" ::: "memory"); __builtin_amdgcn_s_barrier(); }
#pragma unroll 1
        for (int s0 = 0; s0 < 126; s0 += 3) { SC_BODY(R0, s0) SC_BODY(R1, s0 + 1) SC_BODY(R2, s0 + 2) }
        SC_BODY(R0, 126) SC_BODY(R1, 127)
        SC_WAIT(R0, 0); SC_WAIT(R1, 0); SC_WAIT(R2, 0);
#undef SC_BODY
#undef SC_SRC
        return;
    }
    bf16* Odir = (bf16*)((unsigned char*)F.out + (dir == 0 ? DO_OF : DO_OB));
    f32x4 S[8];
#pragma unroll
    for (int i = 0; i < 8; ++i) S[i] = (f32x4){0.f, 0.f, 0.f, 0.f};
    bf16x8 Sb[4];
#pragma unroll
    for (int i = 0; i < 4; ++i) Sb[i] = (bf16x8){0, 0, 0, 0, 0, 0, 0, 0};
    const unsigned aoff272 = n16 * 272 + g * 16, aoff144 = n16 * 144 + g * 16;
    const unsigned lds0 = (unsigned)(uintptr_t)lds;
#define SB_() __builtin_amdgcn_sched_barrier(0)
#define LDR128(dst, base, off) asm volatile("ds_read_b128 %0, %1 offset:%2" : "=v"(dst) : "v"(base), "i"(off) : "memory")
#define LDR64(dst, base, off) asm volatile("ds_read_b64 %0, %1 offset:%2" : "=v"(dst) : "v"(base), "i"(off) : "memory")
#define LDR32(dst, base, off) asm volatile("ds_read_b32 %0, %1 offset:%2" : "=v"(dst) : "v"(base), "i"(off) : "memory")
#pragma unroll 1
    for (int step = 0; step < 128; ++step) {
        __builtin_amdgcn_s_barrier();
        asm volatile("" ::: "memory");
        const int n = dir == 0 ? step : 127 - step;
        const unsigned slot = lds0 + (unsigned)(step & 1) * SC_SLOT;
        const unsigned bK = slot + G_KNP + aoff272, bQ = slot + G_QNP + aoff272, bKT = slot + G_KNTP + aoff144, bT = slot + SC_D + GD_TBP + aoff144;
        const unsigned bV = slot + SC_VCT + n16 * 144 + g * 8, bvec = slot + SC_D + GD_VEC + g * 16, bd = slot + SC_D + GD_VEC;
        f32x4 eG[4], ks[4]; v2u vv[4]; float dch; bf16x8 fa[16];
        LDR128(eG[0], bvec, 0); LDR128(eG[1], bvec, 64); LDR128(eG[2], bvec, 128); LDR128(eG[3], bvec, 192);
        LDR128(ks[0], bvec, 256); LDR128(ks[1], bvec, 320); LDR128(ks[2], bvec, 384); LDR128(ks[3], bvec, 448);
        LDR32(dch, bd, 512);
        LDR64(vv[0], bV, 0); LDR64(vv[1], bV, 32); LDR64(vv[2], bV, 64); LDR64(vv[3], bV, 96);
#pragma unroll
        for (int m = 0; m < 4; ++m) { LDR128(fa[m * 4 + 0], bK, m * 4352 + 0); LDR128(fa[m * 4 + 1], bK, m * 4352 + 64); LDR128(fa[m * 4 + 2], bK, m * 4352 + 128); LDR128(fa[m * 4 + 3], bK, m * 4352 + 192); }
        bf16x8 fq[16];
#pragma unroll
        for (int m = 0; m < 4; ++m) { LDR128(fq[m * 4 + 0], bQ, m * 4352 + 0); LDR128(fq[m * 4 + 1], bQ, m * 4352 + 64); LDR128(fq[m * 4 + 2], bQ, m * 4352 + 128); LDR128(fq[m * 4 + 3], bQ, m * 4352 + 192); }
        asm volatile("s_waitcnt lgkmcnt(15)" : "+v"(eG[0]), "+v"(eG[1]), "+v"(eG[2]), "+v"(eG[3]), "+v"(ks[0]), "+v"(ks[1]), "+v"(ks[2]), "+v"(ks[3]), "+v"(dch), "+v"(vv[0]), "+v"(vv[1]), "+v"(vv[2]), "+v"(vv[3]),
                     "+v"(fa[0]), "+v"(fa[1]), "+v"(fa[2]), "+v"(fa[3]), "+v"(fa[4]), "+v"(fa[5]), "+v"(fa[6]), "+v"(fa[7]), "+v"(fa[8]), "+v"(fa[9]), "+v"(fa[10]), "+v"(fa[11]), "+v"(fa[12]), "+v"(fa[13]), "+v"(fa[14]), "+v"(fa[15]) :: "memory");
        SB_();
        f32x4 KS[4];
#pragma unroll
        for (int m = 0; m < 4; ++m) KS[m] = (f32x4){0.f, 0.f, 0.f, 0.f};
#pragma unroll
        for (int i = 0; i < 4; ++i)
#pragma unroll
            for (int m = 0; m < 4; ++m) KS[m] = __builtin_amdgcn_mfma_f32_16x16x32_bf16(fa[m * 4 + i], Sb[i], KS[m], 0, 0, 0);
        SB_();
        bf16x8 ft[8];
#pragma unroll
        for (int m = 0; m < 4; ++m) { LDR128(ft[m * 2 + 0], bT, m * 2304 + 0); LDR128(ft[m * 2 + 1], bT, m * 2304 + 64); }
        asm volatile("s_waitcnt lgkmcnt(8)" : "+v"(fq[0]), "+v"(fq[1]), "+v"(fq[2]), "+v"(fq[3]), "+v"(fq[4]), "+v"(fq[5]), "+v"(fq[6]), "+v"(fq[7]), "+v"(fq[8]), "+v"(fq[9]), "+v"(fq[10]), "+v"(fq[11]), "+v"(fq[12]), "+v"(fq[13]), "+v"(fq[14]), "+v"(fq[15]) :: "memory");
        SB_();
        f32x4 o[4];
#pragma unroll
        for (int m = 0; m < 4; ++m) o[m] = (f32x4){0.f, 0.f, 0.f, 0.f};
#pragma unroll
        for (int i = 0; i < 4; ++i)
#pragma unroll
            for (int m = 0; m < 4; ++m) o[m] = __builtin_amdgcn_mfma_f32_16x16x32_bf16(fq[m * 4 + i], Sb[i], o[m], 0, 0, 0);
        f32x4 rr[4];
#pragma unroll
        for (int m = 0; m < 4; ++m) { rr[m][0] = bflo(vv[m].x) - eG[m][0] * KS[m][0]; rr[m][1] = bfhi(vv[m].x) - eG[m][1] * KS[m][1]; rr[m][2] = bflo(vv[m].y) - eG[m][2] * KS[m][2]; rr[m][3] = bfhi(vv[m].y) - eG[m][3] * KS[m][3]; }
        bf16x8 rb[2]; rb[0] = pack8(rr[0], rr[1]); rb[1] = pack8(rr[2], rr[3]);
        SB_();
        bf16x8 fk[16];
#pragma unroll
        for (int jt = 0; jt < 8; ++jt) { LDR128(fk[jt * 2 + 0], bKT, jt * 2304 + 0); LDR128(fk[jt * 2 + 1], bKT, jt * 2304 + 64); }
        asm volatile("s_waitcnt lgkmcnt(15)" : "+v"(ft[0]), "+v"(ft[1]), "+v"(ft[2]), "+v"(ft[3]), "+v"(ft[4]), "+v"(ft[5]), "+v"(ft[6]), "+v"(ft[7]) :: "memory");
        SB_();
        f32x4 vn[4];
#pragma unroll
        for (int m = 0; m < 4; ++m) vn[m] = (f32x4){0.f, 0.f, 0.f, 0.f};
#pragma unroll
        for (int i = 0; i < 2; ++i)
#pragma unroll
            for (int m = 0; m < 4; ++m) vn[m] = __builtin_amdgcn_mfma_f32_16x16x32_bf16(ft[m * 2 + i], rb[i], vn[m], 0, 0, 0);
#pragma unroll
        for (int m = 0; m < 4; ++m) o[m] = o[m] * eG[m];
#pragma unroll
        for (int jt = 0; jt < 8; ++jt) S[jt] = S[jt] * dch;
        SB_();
        bf16x8 fp[8];
#pragma unroll
        for (int m = 0; m < 4; ++m) { LDR128(fp[m * 2 + 0], bT, GD_AP + m * 2304 + 0); LDR128(fp[m * 2 + 1], bT, GD_AP + m * 2304 + 64); }
        bf16x8 vnb[2]; vnb[0] = pack8(vn[0], vn[1]); vnb[1] = pack8(vn[2], vn[3]);
        bf16x8 vs[2]; vs[0] = pack8(vn[0] * ks[0], vn[1] * ks[1]); vs[1] = pack8(vn[2] * ks[2], vn[3] * ks[3]);
        asm volatile("s_waitcnt lgkmcnt(8)" : "+v"(fk[0]), "+v"(fk[1]), "+v"(fk[2]), "+v"(fk[3]), "+v"(fk[4]), "+v"(fk[5]), "+v"(fk[6]), "+v"(fk[7]), "+v"(fk[8]), "+v"(fk[9]), "+v"(fk[10]), "+v"(fk[11]), "+v"(fk[12]), "+v"(fk[13]), "+v"(fk[14]), "+v"(fk[15]) :: "memory");
        SB_();
#pragma unroll
        for (int i = 0; i < 2; ++i)
#pragma unroll
            for (int jt = 0; jt < 8; ++jt) S[jt] = __builtin_amdgcn_mfma_f32_16x16x32_bf16(fk[jt * 2 + i], vs[i], S[jt], 0, 0, 0);
        asm volatile("s_waitcnt lgkmcnt(0)" : "+v"(fp[0]), "+v"(fp[1]), "+v"(fp[2]), "+v"(fp[3]), "+v"(fp[4]), "+v"(fp[5]), "+v"(fp[6]), "+v"(fp[7]) :: "memory");
#pragma unroll
        for (int i = 0; i < 2; ++i)
#pragma unroll
            for (int m = 0; m < 4; ++m) o[m] = __builtin_amdgcn_mfma_f32_16x16x32_bf16(fp[m * 2 + i], vnb[i], o[m], 0, 0, 0);
#pragma unroll
        for (int i = 0; i < 4; ++i) Sb[i] = pack8(S[2 * i], S[2 * i + 1]);
        SB_();
        bf16* op = Odir + (size_t)(b * SEQ + n * 64) * 512 + h * 128 + 16 * e + n16;
#pragma unroll
        for (int m = 0; m < 4; ++m)
#pragma unroll
            for (int r = 0; r < 4; ++r) op[(size_t)(16 * m + 4 * g + r) * 512] = (bf16)(pk2(o[m][r], 0.f) & 0xffffu);
    }
#undef SB_
#undef LDR128
#undef LDR64
#undef LDR32
}

DI void p5_combine(Frame& F) {
    const int gw = F.vcu * NWAVES + F.wave, NGW = F.G * NWAVES, lane = F.lane;
    const bf16* OFp = (const bf16*)((unsigned char*)F.out + DO_OF); const bf16* OBp = (const bf16*)((unsigned char*)F.out + DO_OB);
    const bf16* ZA = (const bf16*)(F.ws + WS_ZA); bf16* OCAT = (bf16*)(F.ws + WS_OCAT);
    const float* nw = F.in[6] + (lane & 15) * 8;
    float w8[8];
#pragma unroll
    for (int c = 0; c < 8; ++c) w8[c] = nw[c];
    constexpr int NB4 = 4;
    for (int t0 = gw; t0 < TT; t0 += NB4 * NGW) {
        v4u a[NB4], bb[NB4], z[NB4];
#pragma unroll
        for (int u = 0; u < NB4; ++u) { const int t = (t0 + u * NGW < TT) ? t0 + u * NGW : t0;
            a[u] = *(const v4u*)(OFp + (size_t)t * 512 + lane * 8); bb[u] = *(const v4u*)(OBp + (size_t)t * 512 + lane * 8); z[u] = *(const v4u*)(ZA + (size_t)t * 512 + lane * 8); }
#pragma unroll
        for (int u = 0; u < NB4; ++u) {
            const int t = t0 + u * NGW; if (t >= TT) break;
            float o[8] = {bflo(a[u].x) + bflo(bb[u].x), bfhi(a[u].x) + bfhi(bb[u].x), bflo(a[u].y) + bflo(bb[u].y), bfhi(a[u].y) + bfhi(bb[u].y), bflo(a[u].z) + bflo(bb[u].z), bfhi(a[u].z) + bfhi(bb[u].z), bflo(a[u].w) + bflo(bb[u].w), bfhi(a[u].w) + bfhi(bb[u].w)};
            const float zz[8] = {bflo(z[u].x), bfhi(z[u].x), bflo(z[u].y), bfhi(z[u].y), bflo(z[u].z), bfhi(z[u].z), bflo(z[u].w), bfhi(z[u].w)};
            float ss = 0.f;
#pragma unroll
            for (int c = 0; c < 8; ++c) ss += o[c] * o[c];
            ss += __shfl_xor(ss, 1); ss += __shfl_xor(ss, 2); ss += __shfl_xor(ss, 4); ss += __shfl_xor(ss, 8);
            const float rn = __builtin_amdgcn_rsqf(ss * (1.f / 128.f) + EPS);
#pragma unroll
            for (int c = 0; c < 8; ++c) o[c] = o[c] * rn * w8[c] * siluf(zz[c]);
            v4u r; r.x = pk2(o[0], o[1]); r.y = pk2(o[2], o[3]); r.z = pk2(o[4], o[5]); r.w = pk2(o[6], o[7]);
            *(v4u*)(OCAT + (size_t)t * 1024 + lane * 8) = r;
        }
    }
}

struct TokRec { int e[2]; int row[2]; float gate[2]; };
DI void p7_route(Frame& F) {
    const int lane = F.lane, n16 = lane & 15, g = lane >> 4, wave = F.wave;
    const float* X1 = (const float*)(F.ws + WS_X1); const float* nfw = F.in[10];
    const bf16* WRH = (const bf16*)(F.ws + WS_WR); const bf16* WRL = WRH + 48 * 1024;
    bf16* HN = (bf16*)((unsigned char*)F.out + DO_HN); TokRec* TOK = (TokRec*)(F.ws + WS_TOK); unsigned* gcnt = (unsigned*)(F.ws + WS_CTL) + CW_CNT; int* LIST = (int*)(F.ws + WS_LIST);
    LAS float* lg = (LAS float*)(F.lds + (wave & 3) * 4096);
    LAS unsigned* hist = (LAS unsigned*)(F.lds + 16384); LAS unsigned* base = hist + 32;
    const int sub = blockIdx.x & 7;
    for (int rt0 = blockIdx.x * 4; rt0 < TT / 16; rt0 += F.G * 4) {
        if (F.tid < 32) hist[F.tid] = 0u;
        __syncthreads();
        int ex1 = 0, ex2 = 0, tok = -1; unsigned l1 = 0, l2 = 0; float g1 = 0.f, g2 = 0.f;
        const int rt = rt0 + wave;
        if (wave < 4 && rt < TT / 16) {
            const int row = rt * 16 + n16; const float* xr = X1 + (size_t)row * DMODEL + 8 * g;
            float ss = 0.f;
#pragma unroll 16
            for (int i = 0; i < 32; ++i) { const f32x4 a = *(const f32x4*)(xr + 32 * i), b2 = *(const f32x4*)(xr + 32 * i + 4);
                ss += (a.x * a.x + a.y * a.y) + (a.z * a.z + a.w * a.w) + (b2.x * b2.x + b2.y * b2.y) + (b2.z * b2.z + b2.w * b2.w); }
            ss += __shfl_xor(ss, 16); ss += __shfl_xor(ss, 32);
            const float rs = __builtin_amdgcn_rsqf(ss * (1.f / DMODEL) + EPS);
            f32x4 acc[3];
#pragma unroll
            for (int q = 0; q < 3; ++q) acc[q] = (f32x4){0.f, 0.f, 0.f, 0.f};
#pragma unroll 4
            for (int i = 0; i < 32; ++i) {
                const f32x4 a = *(const f32x4*)(xr + 32 * i), b2 = *(const f32x4*)(xr + 32 * i + 4);
                const f32x4 wa = *(const f32x4*)(nfw + 32 * i + 8 * g), wb = *(const f32x4*)(nfw + 32 * i + 8 * g + 4);
                float hv[8] = {a.x * rs * wa.x, a.y * rs * wa.y, a.z * rs * wa.z, a.w * rs * wa.w, b2.x * rs * wb.x, b2.y * rs * wb.y, b2.z * rs * wb.z, b2.w * rs * wb.w};
                v4u hi, lo;
                hi.x = pk2(hv[0], hv[1]); hi.y = pk2(hv[2], hv[3]); hi.z = pk2(hv[4], hv[5]); hi.w = pk2(hv[6], hv[7]);
                lo.x = pk2(hv[0] - bflo(hi.x), hv[1] - bfhi(hi.x)); lo.y = pk2(hv[2] - bflo(hi.y), hv[3] - bfhi(hi.y));
                lo.z = pk2(hv[4] - bflo(hi.z), hv[5] - bfhi(hi.z)); lo.w = pk2(hv[6] - bflo(hi.w), hv[7] - bfhi(hi.w));
                *(v4u*)(HN + (size_t)row * DMODEL + 32 * i + 8 * g) = hi;
                const bf16x8 ah = __builtin_bit_cast(bf16x8, hi), al = __builtin_bit_cast(bf16x8, lo);
#pragma unroll
                for (int q = 0; q < 3; ++q) {
                    const bf16x8 bh = *(const bf16x8*)(WRH + (size_t)(16 * q + n16) * 1024 + 32 * i + 8 * g), bl = *(const bf16x8*)(WRL + (size_t)(16 * q + n16) * 1024 + 32 * i + 8 * g);
                    acc[q] = __builtin_amdgcn_mfma_f32_16x16x32_bf16(ah, bh, acc[q], 0, 0, 0);
                    acc[q] = __builtin_amdgcn_mfma_f32_16x16x32_bf16(ah, bl, acc[q], 0, 0, 0);
                    acc[q] = __builtin_amdgcn_mfma_f32_16x16x32_bf16(al, bh, acc[q], 0, 0, 0);
                }
            }
#pragma unroll
            for (int q = 0; q < 3; ++q)
#pragma unroll
                for (int r = 0; r < 4; ++r) lg[(4 * g + r) * 48 + 16 * q + n16] = acc[q][r];
            asm volatile("s_waitcnt lgkmcnt(0)" ::: "memory");
            if (lane < 16) {
                const LAS float* L = lg + lane * 48; tok = rt * 16 + lane;
                float gm = L[0]; int gs = 0;
#pragma unroll
                for (int q = 1; q < 4; ++q) if (L[q] > gm) { gm = L[q]; gs = q; }
                float gsum = 0.f;
#pragma unroll
                for (int q = 0; q < 4; ++q) gsum += __expf(L[q] - gm);
                const float gp_top = 1.0f / gsum;
                float fv[8];
#pragma unroll
                for (int q = 0; q < 8; ++q) { float v = L[4 + q]; v = (gs == 1) ? L[12 + q] : v; v = (gs == 2) ? L[20 + q] : v; v = (gs == 3) ? L[28 + q] : v; fv[q] = v; }
                float m1 = fv[0]; int i1 = 0;
#pragma unroll
                for (int q = 1; q < 8; ++q) if (fv[q] > m1) { m1 = fv[q]; i1 = q; }
                float m2 = -3.0e38f; int i2 = 0;
#pragma unroll
                for (int q = 0; q < 8; ++q) if (q != i1 && fv[q] > m2) { m2 = fv[q]; i2 = q; }
                const float e2 = __expf(m2 - m1); g1 = gp_top / (1.0f + e2); g2 = gp_top * e2 / (1.0f + e2);
                ex1 = gs * 8 + i1; ex2 = gs * 8 + i2;
                l1 = __hip_atomic_fetch_add(hist + ex1, 1u, __ATOMIC_RELAXED, __HIP_MEMORY_SCOPE_WORKGROUP); l2 = __hip_atomic_fetch_add(hist + ex2, 1u, __ATOMIC_RELAXED, __HIP_MEMORY_SCOPE_WORKGROUP);
            }
        }
        __syncthreads();
        if (F.tid < 32) { const unsigned hcount = hist[F.tid]; base[F.tid] = hcount ? atomicAdd(gcnt + F.tid * 8 + sub, hcount) : 0u; }
        __syncthreads();
        if (tok >= 0) {
            const int s1 = (int)(base[ex1] + l1), s2 = (int)(base[ex2] + l2);
            LIST[(size_t)(ex1 * 8 + sub) * TT + s1] = tok; LIST[(size_t)(ex2 * 8 + sub) * TT + s2] = tok;
            TokRec tr; tr.e[0] = ex1; tr.e[1] = ex2; tr.row[0] = (sub << 24) | s1; tr.row[1] = (sub << 24) | s2; tr.gate[0] = g1; tr.gate[1] = g2;
            TOK[tok] = tr;
        }
    }
}

DI void build_etab(Frame& F) {
    LAS unsigned* etab = (LAS unsigned*)(F.lds + ETAB_OFF);
    if (F.tid < 32) {
        const unsigned* gcnt = (const unsigned*)(F.ws + WS_CTL) + CW_CNT + F.tid * 8; unsigned acc = 0;
#pragma unroll
        for (int q = 0; q < 8; ++q) { const unsigned c = __hip_atomic_load(gcnt + q, __ATOMIC_RELAXED, __HIP_MEMORY_SCOPE_AGENT); etab[96 + 8 * F.tid + q] = acc; acc += c; }
        etab[64 + F.tid] = acc; etab[2 * F.tid + 1] = (acc + 255u) >> 8;
    }
    __syncthreads();
    if (F.tid == 0) { unsigned acc = 0; for (int e = 0; e < NEXP; ++e) { etab[2 * e] = acc; acc += etab[2 * e + 1]; } }
    __syncthreads();
}

DI void p11_final(Frame& F) {
    build_etab(F);
    const LAS unsigned* etab = (const LAS unsigned*)(F.lds + ETAB_OFF);
    const int gw = F.vcu * NWAVES + F.wave, NGW = F.G * NWAVES, lane = F.lane;
    const bf16* Y = (const bf16*)(F.ws + WS_XBUF); const TokRec* TOK = (const TokRec*)(F.ws + WS_TOK); const float* fw = F.in[16];
    const f32x4 w0 = *(const f32x4*)(fw + lane * 8), w1 = *(const f32x4*)(fw + lane * 8 + 4), w2 = *(const f32x4*)(fw + 512 + lane * 8), w3 = *(const f32x4*)(fw + 516 + lane * 8);
    constexpr int NB2 = 2;
    for (int t0 = gw; t0 < TT; t0 += NB2 * NGW) {
        TokRec tr[NB2]; f32x4 xa[NB2][4]; v4u ya[NB2][2][2];
#pragma unroll
        for (int u = 0; u < NB2; ++u) { const int t = (t0 + u * NGW < TT) ? t0 + u * NGW : t0; tr[u] = TOK[t];
            const float* xr = (const float*)(F.ws + WS_X1) + (size_t)t * DMODEL + lane * 8;
            xa[u][0] = *(const f32x4*)(xr); xa[u][1] = *(const f32x4*)(xr + 4); xa[u][2] = *(const f32x4*)(xr + 512); xa[u][3] = *(const f32x4*)(xr + 516); }
#pragma unroll
        for (int u = 0; u < NB2; ++u)
#pragma unroll
            for (int k = 0; k < 2; ++k) { const unsigned rk = (unsigned)tr[u].row[k]; const bf16* yr = Y + (size_t)(etab[2 * tr[u].e[k]] * 256u + etab[96 + 8 * tr[u].e[k] + (rk >> 24)] + (rk & 0xffffffu)) * DMODEL + lane * 8; ya[u][k][0] = *(const v4u*)(yr); ya[u][k][1] = *(const v4u*)(yr + 512); }
#pragma unroll
        for (int u = 0; u < NB2; ++u) {
            const int t = t0 + u * NGW; if (t >= TT) break;
            float v[16] = {xa[u][0].x, xa[u][0].y, xa[u][0].z, xa[u][0].w, xa[u][1].x, xa[u][1].y, xa[u][1].z, xa[u][1].w, xa[u][2].x, xa[u][2].y, xa[u][2].z, xa[u][2].w, xa[u][3].x, xa[u][3].y, xa[u][3].z, xa[u][3].w};
#pragma unroll
            for (int k = 0; k < 2; ++k) {
                const float gk = tr[u].gate[k]; const v4u y0 = ya[u][k][0], y1 = ya[u][k][1];
                v[0] += gk * bflo(y0.x); v[1] += gk * bfhi(y0.x); v[2] += gk * bflo(y0.y); v[3] += gk * bfhi(y0.y); v[4] += gk * bflo(y0.z); v[5] += gk * bfhi(y0.z); v[6] += gk * bflo(y0.w); v[7] += gk * bfhi(y0.w);
                v[8] += gk * bflo(y1.x); v[9] += gk * bfhi(y1.x); v[10] += gk * bflo(y1.y); v[11] += gk * bfhi(y1.y); v[12] += gk * bflo(y1.z); v[13] += gk * bfhi(y1.z); v[14] += gk * bflo(y1.w); v[15] += gk * bfhi(y1.w);
            }
            float ss = 0.f;
#pragma unroll
            for (int i = 0; i < 16; ++i) ss += v[i] * v[i];
            const float rs = __builtin_amdgcn_rsqf(wave_sum(ss) * (1.f / DMODEL) + EPS);
            float* orow = F.out + (size_t)t * DMODEL + lane * 8;
            *(f32x4*)(orow) = (f32x4){v[0] * rs * w0.x, v[1] * rs * w0.y, v[2] * rs * w0.z, v[3] * rs * w0.w};
            *(f32x4*)(orow + 4) = (f32x4){v[4] * rs * w1.x, v[5] * rs * w1.y, v[6] * rs * w1.z, v[7] * rs * w1.w};
            *(f32x4*)(orow + 512) = (f32x4){v[8] * rs * w2.x, v[9] * rs * w2.y, v[10] * rs * w2.z, v[11] * rs * w2.w};
            *(f32x4*)(orow + 516) = (f32x4){v[12] * rs * w3.x, v[13] * rs * w3.y, v[14] * rs * w3.z, v[15] * rs * w3.w};
        }
    }
}

struct Args { const float* in[17]; float* out; unsigned char* ws; int ph_lo, ph_hi; };
__global__ void __launch_bounds__(NTHREADS, 2) fwd_kernel(Args args) {
    extern __shared__ __attribute__((aligned(16))) unsigned char lds[];
    cg::grid_group grid = cg::this_grid();
    Frame F;
    F.lds = (LAS unsigned char*)lds; F.tid = threadIdx.x; F.lane = F.tid & 63; F.wave = __builtin_amdgcn_readfirstlane(F.tid >> 6);
    F.G = gridDim.x; { const int bx = blockIdx.x; F.vcu = (F.G % 8 == 0) ? (bx % 8) * (F.G / 8) + bx / 8 : bx; }
#pragma unroll
    for (int i = 0; i < 17; ++i) F.in[i] = args.in[i];
    F.out = args.out; F.ws = args.ws;
    const int lo = args.ph_lo, hi = args.ph_hi;
    if (F.tid < 16) ((volatile LAS unsigned*)(F.lds + MISC_OFF))[F.tid] = 0u;
    __syncthreads();
    XcdBarrier bar = xcd_barrier_post((unsigned*)(F.ws + WS_CTL) + CW_BAR, (volatile LAS unsigned*)(F.lds + MISC_OFF));
    if (lo > 1000) grid.sync();
#ifndef PHSEL
#define PHSEL 0xfff
#endif
#define IN(k) (((PHSEL >> (k)) & 1) && lo <= (k) && (k) < hi)
#define SEAM(k) do { if (IN(k) && IN((k) + 1)) xcd_barrier(bar); } while (0)
#ifndef REP_PH
#define REP_PH -1
#endif
#define REPS(k) for (int rep_ = 0; rep_ < ((k) == REP_PH ? 2 : 1); ++rep_, ((k) == REP_PH && rep_ < 2) ? xcd_barrier(bar) : (void)0)
    if (IN(0)) REPS(0) { p0_prologue(F); } SEAM(0);
    if (IN(1)) REPS(1) {
        pg8::Gemm gm{(const pg8::bf16_t*)(F.ws + WS_XN), (const pg8::bf16_t*)(F.ws + WS_WIN), TT, NPROJ, DMODEL}; pg8::StaticOrder S; S.init(TT, NPROJ, F.G, (int)blockIdx.x);
        EpiProj E{(bf16*)(F.ws + WS_QKVA), (bf16*)(F.ws + WS_ZA), (bf16*)(F.ws + WS_QKVB), (float*)(F.ws + WS_GATES)};
        pg8::gemm_phase<EpiProj, pg8::StaticOrder, true, true>(F.lds, gm, S, E);
    } SEAM(1);
    if (IN(2)) REPS(2) {
#ifndef NO_ROPE
        p2_rope(F);
#ifdef PROBE_ROPE2
        xcd_barrier(bar); p2_rope(F);
#endif
#endif
#ifndef NO_PRE
        p2_gdn_pre(F);
#ifdef PROBE_PRE2
        xcd_barrier(bar); p2_gdn_pre(F);
#endif
#endif
    } SEAM(2);
    if (IN(3)) REPS(3) {
        const attn_body::AttnTensors AT{(const attn_body::bf16*)((unsigned char*)F.out + DO_QR), (const attn_body::bf16*)((unsigned char*)F.out + DO_KR), (const attn_body::bf16*)((unsigned char*)F.out + DO_VR),
                                        (attn_body::bf16*)(F.ws + WS_OCAT) + 512};
        const attn_body::StaticOrder S((int)F.G, (int)blockIdx.x);
#ifdef PROBE_ZERO_ATTN
        { (void)AT; (void)S; bf16* OC = (bf16*)(F.ws + WS_OCAT); const int gt = blockIdx.x * NTHREADS + F.tid, GT = F.G * NTHREADS;
          for (int i = gt; i < TT * 64; i += GT) { const int t = i >> 6, c = i & 63; *(v4u*)(OC + (size_t)t * 1024 + 512 + c * 8) = (v4u){0u, 0u, 0u, 0u}; } }
#else
        attn_body::attn_phase<attn_body::StaticOrder>((char*)lds, AT, S);
#endif
    } SEAM(3);
#ifdef PROBE_SCAN2
    if (IN(4)) { p4_scan(F); xcd_barrier(bar); p4_scan(F); } SEAM(4);
#else
    if (IN(4)) REPS(4) { p4_scan(F); } SEAM(4);
#endif
    if (IN(5)) REPS(5) { p5_combine(F); if (F.G <= 128) { small_weights(F, F.vcu * NWAVES + F.wave, F.G * NWAVES); moe_weights(F, F.vcu * NWAVES + F.wave, F.G * NWAVES); } } SEAM(5);
    if (IN(6)) REPS(6) {
        pg8::Gemm gm{(const pg8::bf16_t*)(F.ws + WS_OCAT), (const pg8::bf16_t*)(F.ws + WS_WOUT), TT, DMODEL, DMODEL}; pg8::StaticOrder S; S.init(TT, DMODEL, F.G, (int)blockIdx.x);
        EpiResid E{F.in[0], (float*)(F.ws + WS_X1)};
        pg8::gemm_phase<EpiResid, pg8::StaticOrder, true, true>(F.lds, gm, S, E);
    } SEAM(6);
    if (IN(7)) { p7_route(F); } SEAM(7);
    if (IN(9)) REPS(9) {
        build_etab(F);
        pg8::Gemm gm{(const pg8::bf16_t*)((unsigned char*)F.out + DO_HN), (const pg8::bf16_t*)(F.ws + WS_WGU0), 0, 0, DMODEL};
        MoeOrder S{(const LAS unsigned*)(F.lds + ETAB_OFF), F.G, (int)blockIdx.x, WGU_SPLIT, (int)((WS_WGU1 - WS_WGU0) / (512 * 1024))};
        MoeRows AM{(const int*)(F.ws + WS_LIST), (const LAS unsigned*)(F.lds + ETAB_OFF)};
        EpiGU E{(bf16*)(F.ws + WS_HID)};
        pg8::gemm_phase_gather<EpiGU, MoeOrder, MoeRows, true>(F.lds, gm, S, E, AM);
    } SEAM(9);
    if (IN(10)) REPS(10) {
        pg8::Gemm gm{(const pg8::bf16_t*)(F.ws + WS_HID), (const pg8::bf16_t*)((unsigned char*)F.out + DO_WD0), 0, 0, FFE}; build_etab(F); MoeOrder S{(const LAS unsigned*)(F.lds + ETAB_OFF), F.G, (int)blockIdx.x, WD_SPLIT, (int)((DO_WD1 - DO_WD0) / (256 * 1024))};
        EpiY E{(bf16*)(F.ws + WS_XBUF)};
        pg8::gemm_phase<EpiY, MoeOrder, true, true>(F.lds, gm, S, E);
    } SEAM(10);
#ifdef EXTRA_SYNCS
    for (int q_ = 0; q_ < EXTRA_SYNCS; ++q_) xcd_barrier(bar);
#endif
    if (IN(11)) { p11_final(F); }
#undef IN
#undef SEAM
}

extern "C" void kernel_launch(void* const* d_in, const int* in_sizes, int n_in, void* d_out, int out_size, void* d_ws, size_t ws_size, hipStream_t stream) {
    static int grid = 0;
    if (grid == 0) {
        if (n_in != 17 || out_size != TT * DMODEL || ws_size < WS_END) { fprintf(stderr, "kernel_launch: unexpected problem (n_in %d out %d ws %zu)\n", n_in, out_size, ws_size); grid = -1; return; }
        int dev = 0, cus = 0, per_cu = 0;
        if (hipGetDevice(&dev) != hipSuccess || hipDeviceGetAttribute(&cus, hipDeviceAttributeMultiprocessorCount, dev) != hipSuccess) { grid = -1; return; }
        if (hipFuncSetAttribute((const void*)fwd_kernel, hipFuncAttributeMaxDynamicSharedMemorySize, LDS_BYTES) != hipSuccess) { fprintf(stderr, "hipFuncSetAttribute failed\n"); grid = -1; return; }
        if (hipOccupancyMaxActiveBlocksPerMultiprocessor(&per_cu, (const void*)fwd_kernel, NTHREADS, LDS_BYTES) != hipSuccess || per_cu < 1) { fprintf(stderr, "occupancy query: %d\n", per_cu); grid = -1; return; }
        grid = cus;
    }
    if (grid < 0) return;
    (void)hipMemsetAsync((char*)d_ws + WS_CTL, 0, CTL_ZERO_BYTES, stream);
    Args a{};
    for (int i = 0; i < 17; ++i) a.in[i] = (const float*)d_in[i];
    a.out = (float*)d_out; a.ws = (unsigned char*)d_ws;
#if MK_PER_PHASE
    for (int p = 0; p < N_PHASES; ++p) { a.ph_lo = p; a.ph_hi = p + 1; hipLaunchKernelGGL(fwd_kernel, dim3(grid), dim3(NTHREADS), LDS_BYTES, stream, a); }
#else
    a.ph_lo = 0; a.ph_hi = N_PHASES;
    void* kargs[] = {&a};
    hipError_t e = hipLaunchCooperativeKernel((void*)fwd_kernel, dim3(grid), dim3(NTHREADS), kargs, LDS_BYTES, stream);
    if (e != hipSuccess) fprintf(stderr, "cooperative launch failed: %s (grid %d)\n", hipGetErrorString(e), grid);
#endif
}
```

```cpp
#include <hip/hip_runtime.h>
#include <cstdio>
#include <cstdint>
namespace pg8 {
#define PG8_LAS __attribute__((address_space(3)))
typedef unsigned short bf16_t;
typedef short bf16x8 __attribute__((ext_vector_type(8)));
typedef float f32x4 __attribute__((ext_vector_type(4)));
typedef unsigned u32x4 __attribute__((ext_vector_type(4)));
constexpr int BM = 256, BK = 64, HALF = 128, HTB = HALF * BK * 2  , STAGE_BYTES = 8 * HTB, NXCD = 8, WGM = 8;

__host__ __device__ __forceinline__ int lds_byte(int r, int c) { const int st = (r >> 4) * 2 + (c >> 5), rr = r & 15, cc = c & 31, ob = rr * 64 + cc * 2; return st * 1024 + (ob ^ (((ob >> 9) & 1) << 5)); }
__host__ __device__ __forceinline__ void stage_rc(int b, int& R, int& C) { const int st = b / 1024, sb = b % 1024, swz = sb ^ (((sb >> 9) & 1) << 5); R = (st >> 1) * 16 + swz / 64; C = (st & 1) * 32 + (swz % 64) / 2; }
__host__ __device__ __forceinline__ int perm32(int rho) { const int n = rho >> 4, i = rho & 15; return 8 * (i >> 2) + 4 * n + (i & 3); }

struct Unit { int pm, pn, ex, tq; };
struct Gemm { const bf16_t* A; const bf16_t* Bt; int M, N, K; };

struct StaticOrder {
    int nM, nN, nwg, G, c;
    __host__ __device__ void init(int M, int N, int G_, int c_) { nM = M / BM; nN = N / BM; nwg = nM * nN; G = G_; c = c_; }
    __host__ __device__ bool next(int i, Unit& u) const {
        const long L = (long)i * G + c; if (L >= nwg) return false;
        int wgid = (int)L; { const int q = nwg / NXCD, r = nwg % NXCD, xcd = wgid % NXCD, off = wgid / NXCD; wgid = (xcd < r ? xcd * (q + 1) : r * (q + 1) + (xcd - r) * q) + off; }
        const int nig = WGM * nN, gid = wgid / nig, fm = gid * WGM, gsz = (nM - fm) < WGM ? (nM - fm) : WGM;
        u.pm = fm + ((wgid % nig) % gsz); u.pn = (wgid % nig) / gsz; return true;
    }
    __device__ __forceinline__ void a_ready(const Unit&) const {}
    __device__ __forceinline__ void done(const Unit&) const {}
};

__device__ __forceinline__ unsigned cvt_pk_bf16(float lo, float hi) { unsigned r; asm volatile("v_cvt_pk_bf16_f32 %0, %1, %2" : "=v"(r) : "v"(lo), "v"(hi)); return r; }
typedef float f32x2 __attribute__((ext_vector_type(2)));
template <class Epi, class Sched, bool ALIGN_EPI = false, bool SP2 = false>
__device__ __forceinline__ void gemm_phase(PG8_LAS unsigned char* lds, const Gemm g, const Sched& S, const Epi& E) {
    const int tid = threadIdx.x, wid = __builtin_amdgcn_readfirstlane(tid >> 6), lane = tid & 63, wr = wid >> 2, wc = wid & 3, fr = lane & 15, fq = lane >> 4;
    const int K = g.K, nt = K / BK;
    unsigned voffA[2], voffB[2];
#pragma unroll
    for (int i = 0; i < 2; ++i) { int R, C; stage_rc(tid * 16 + i * 8192, R, C); const int Rb = Epi::PERM ? ((R & ~31) + perm32(R & 31)) : R;
        voffA[i] = (unsigned)(R * K + C) * 2u; voffB[i] = (unsigned)(Rb * K + C) * 2u; }
    const size_t kstep = (size_t)(BK * 2);
    const size_t hstep = (size_t)HALF * K * 2;
    const size_t tstep = 2 * hstep;
    const unsigned ldsw = (unsigned)wid * 1024u;
    const int aoff = lds_byte(wr * 64 + fr, fq * 8), boff = lds_byte(wc * 32 + fr, fq * 8);
#define PG8_SA(b, h) (((b) * 2 + (h)) * HTB)
#define PG8_SB(b, h) ((4 + (b) * 2 + (h)) * HTB)
#define PG8_STAGE(bufoff, gbase, voff) do { _Pragma("unroll") for (int _i = 0; _i < 2; ++_i) \
        __builtin_amdgcn_global_load_lds((const unsigned*)((const char*)(gbase) + (voff)[_i]), (PG8_LAS unsigned*)(lds + (bufoff) + ldsw + _i * 8192), 16, 0, 0); } while (0)
#define PG8_LDA(dst, b, h) do { _Pragma("unroll") for (int m = 0; m < 4; ++m) _Pragma("unroll") for (int k = 0; k < 2; ++k) dst[m][k] = *(const PG8_LAS bf16x8*)(lds + PG8_SA(b, h) + aoff + m * 2048 + k * 1024); } while (0)
#define PG8_LDB(dst, b, h) do { _Pragma("unroll") for (int n = 0; n < 2; ++n) _Pragma("unroll") for (int k = 0; k < 2; ++k) dst[n][k] = *(const PG8_LAS bf16x8*)(lds + PG8_SB(b, h) + boff + n * 2048 + k * 1024); } while (0)
#define PG8_MMA(ai, bj, At, Bt) do { __builtin_amdgcn_s_setprio(1); _Pragma("unroll") for (int m = 0; m < 4; ++m) _Pragma("unroll") for (int n = 0; n < 2; ++n) _Pragma("unroll") for (int k = 0; k < 2; ++k) \
        acc[ai][bj][m][n] = __builtin_amdgcn_mfma_f32_16x16x32_bf16(Bt[n][k], At[m][k], acc[ai][bj][m][n], 0, 0, 0); __builtin_amdgcn_s_setprio(0); } while (0)
#define PG8_WAIT_V(n) asm volatile("s_waitcnt vmcnt(" #n ")" ::: "memory")
#define PG8_WAIT_L(n) asm volatile("s_waitcnt lgkmcnt(" #n ")" ::: "memory")
#define PG8_BAR __builtin_amdgcn_s_barrier()
#define PG8_SCHED __builtin_amdgcn_sched_barrier(0)
    Unit cur, nxt; int ui = 0;
    if (!S.next(0, cur)) return;
    f32x4 acc[2][2][4][2];
#pragma unroll
    for (int a = 0; a < 2; ++a)
#pragma unroll
        for (int b = 0; b < 2; ++b)
#pragma unroll
            for (int m = 0; m < 4; ++m)
#pragma unroll
                for (int n = 0; n < 2; ++n) acc[a][b][m][n] = (f32x4){0.f, 0.f, 0.f, 0.f};
    bf16x8 At[4][2], B0[2][2], B1[2][2];
    const char* cA = (const char*)g.A + (size_t)cur.pm * tstep; const char* cB = (const char*)g.Bt + (size_t)cur.pn * tstep;
    S.a_ready(cur);
    if constexpr (SP2) {
        PG8_STAGE(PG8_SB(0, 0), cB, voffB); PG8_STAGE(PG8_SB(0, 1), cB + hstep, voffB); PG8_STAGE(PG8_SA(0, 0), cA, voffA); PG8_STAGE(PG8_SA(0, 1), cA + hstep, voffA);
        if (wr == 1) PG8_BAR;
        PG8_WAIT_V(2); PG8_BAR;
        PG8_STAGE(PG8_SB(1, 0), cB + kstep, voffB); PG8_STAGE(PG8_SA(1, 0), cA + kstep, voffA); PG8_STAGE(PG8_SB(1, 1), cB + hstep + kstep, voffB);
        PG8_WAIT_V(6); PG8_BAR;
    } else {
        PG8_STAGE(PG8_SB(0, 0), cB, voffB); PG8_STAGE(PG8_SA(0, 0), cA, voffA); PG8_STAGE(PG8_SB(0, 1), cB + hstep, voffB); PG8_STAGE(PG8_SA(0, 1), cA + hstep, voffA);
        if (wr == 1) PG8_BAR;
        PG8_WAIT_V(4); PG8_BAR;
        PG8_STAGE(PG8_SB(1, 0), cB + kstep, voffB); PG8_STAGE(PG8_SA(1, 0), cA + kstep, voffA); PG8_STAGE(PG8_SB(1, 1), cB + hstep + kstep, voffB);
        PG8_WAIT_V(6); PG8_BAR;
    }
    for (;;) {
        const bool has_next = S.next(ui + 1, nxt);
        const char* nA = has_next ? (const char*)g.A + (size_t)nxt.pm * tstep : cA; const char* nB = has_next ? (const char*)g.Bt + (size_t)nxt.pn * tstep : cB;
        for (int t = 0; t < nt; t += 2) {
            const bool last = (t == nt - 2);
            const char* a1 = cA + (size_t)(t + 1) * kstep;
            const char* a2 = last ? nA : cA + (size_t)(t + 2) * kstep; const char* b2 = last ? nB : cB + (size_t)(t + 2) * kstep;
            const char* a3 = a2 + kstep; const char* b3 = b2 + kstep;
            if (last && has_next) S.a_ready(nxt);
            if constexpr (SP2) {
            PG8_LDB(B0, 0, 0); PG8_LDB(B1, 0, 1); PG8_SCHED; PG8_LDA(At, 0, 0); PG8_STAGE(PG8_SA(1, 1), a1 + hstep, voffA);
            PG8_WAIT_V(8); PG8_WAIT_L(0); PG8_BAR; PG8_MMA(0, 0, At, B0); PG8_MMA(0, 1, At, B1); PG8_BAR; PG8_SCHED;
            PG8_LDA(At, 0, 1); PG8_STAGE(PG8_SB(0, 0), b2, voffB); PG8_STAGE(PG8_SB(0, 1), b2 + hstep, voffB); PG8_STAGE(PG8_SA(0, 0), a2, voffA);
            PG8_WAIT_V(8); PG8_WAIT_L(0); PG8_BAR; PG8_MMA(1, 0, At, B0); PG8_MMA(1, 1, At, B1); PG8_BAR; PG8_SCHED;
            PG8_LDB(B0, 1, 0); PG8_LDB(B1, 1, 1); PG8_SCHED; PG8_LDA(At, 1, 0); PG8_STAGE(PG8_SA(0, 1), a2 + hstep, voffA);
            PG8_WAIT_V(8); PG8_WAIT_L(0); PG8_BAR; PG8_MMA(0, 0, At, B0); PG8_MMA(0, 1, At, B1); PG8_BAR; PG8_SCHED;
            PG8_LDA(At, 1, 1); PG8_STAGE(PG8_SB(1, 0), b3, voffB); PG8_STAGE(PG8_SB(1, 1), b3 + hstep, voffB); PG8_STAGE(PG8_SA(1, 0), a3, voffA);
            PG8_WAIT_V(8); PG8_WAIT_L(0); PG8_BAR; PG8_MMA(1, 0, At, B0); PG8_MMA(1, 1, At, B1); PG8_BAR; PG8_SCHED;
            } else {
            PG8_LDB(B0, 0, 0); PG8_SCHED; PG8_LDA(At, 0, 0); PG8_STAGE(PG8_SA(1, 1), a1 + hstep, voffA);
            PG8_WAIT_L(8); PG8_BAR; PG8_WAIT_L(0); PG8_MMA(0, 0, At, B0); PG8_BAR; PG8_SCHED;
            PG8_LDB(B1, 0, 1); PG8_STAGE(PG8_SB(0, 0), b2, voffB);
            PG8_BAR; PG8_WAIT_L(0); PG8_MMA(0, 1, At, B1); PG8_BAR;
            PG8_LDA(At, 0, 1); PG8_STAGE(PG8_SA(0, 0), a2, voffA);
            PG8_BAR; PG8_WAIT_L(0); PG8_MMA(1, 0, At, B0); PG8_BAR; PG8_SCHED;
            PG8_STAGE(PG8_SB(0, 1), b2 + hstep, voffB);
            PG8_WAIT_V(6); PG8_BAR; PG8_MMA(1, 1, At, B1); PG8_BAR;
            PG8_LDB(B0, 1, 0); PG8_SCHED; PG8_LDA(At, 1, 0); PG8_STAGE(PG8_SA(0, 1), a2 + hstep, voffA);
            PG8_WAIT_L(8); PG8_BAR; PG8_WAIT_L(0); PG8_MMA(0, 0, At, B0); PG8_BAR; PG8_SCHED;
            PG8_LDB(B1, 1, 1); PG8_STAGE(PG8_SB(1, 0), b3, voffB);
            PG8_BAR; PG8_WAIT_L(0); PG8_MMA(0, 1, At, B1); PG8_BAR;
            PG8_LDA(At, 1, 1); PG8_STAGE(PG8_SA(1, 0), a3, voffA);
            PG8_BAR; PG8_WAIT_L(0); PG8_MMA(1, 0, At, B0); PG8_BAR; PG8_SCHED;
            PG8_STAGE(PG8_SB(1, 1), b3 + hstep, voffB);
            PG8_WAIT_V(6); PG8_BAR; PG8_MMA(1, 1, At, B1); PG8_BAR;
            }
        }
        if constexpr (ALIGN_EPI) { if (wr == 0) PG8_BAR; }
        if constexpr (!Epi::AFTER_DRAIN) { E(acc, cur, wr, wc, fr, fq); S.done(cur); }
        if (!has_next) break;
#pragma unroll
        for (int a = 0; a < 2; ++a)
#pragma unroll
            for (int b = 0; b < 2; ++b)
#pragma unroll
                for (int m = 0; m < 4; ++m)
#pragma unroll
                    for (int n = 0; n < 2; ++n) acc[a][b][m][n] = (f32x4){0.f, 0.f, 0.f, 0.f};
        cur = nxt; cA = nA; cB = nB; ++ui;
        if constexpr (ALIGN_EPI) { if (wr == 1) PG8_BAR; }
    }
    PG8_WAIT_V(0);
    if constexpr (!ALIGN_EPI) { if (wr == 0) PG8_BAR; }
    PG8_BAR;
    if constexpr (Epi::AFTER_DRAIN) { E.fused(acc, cur, wr, wc, fr, fq, lds, wid, lane); S.done(cur); }
#undef PG8_SA
#undef PG8_SB
#undef PG8_STAGE
#undef PG8_LDA
#undef PG8_LDB
#undef PG8_MMA
#undef PG8_WAIT_V
#undef PG8_WAIT_L
#undef PG8_BAR
#undef PG8_SCHED
}
typedef int i32x4 __attribute__((ext_vector_type(4)));
template <bool I8> struct AccSel { typedef f32x4 type; };
template <> struct AccSel<true> { typedef i32x4 type; };
template <bool I8> __device__ __forceinline__ void mma_step(typename AccSel<I8>::type& c, const bf16x8& b, const bf16x8& a) {
    if constexpr (I8) c = __builtin_amdgcn_mfma_i32_16x16x64_i8(__builtin_bit_cast(i32x4, b), __builtin_bit_cast(i32x4, a), c, 0, 0, 0);
    else c = __builtin_amdgcn_mfma_f32_16x16x32_bf16(b, a, c, 0, 0, 0);
}
template <class Epi, class Sched, class AMap, bool ALIGN_EPI = false, bool I8 = false>
__device__ __forceinline__ void gemm_phase_gather(PG8_LAS unsigned char* lds, const Gemm g, const Sched& S, const Epi& E, const AMap& AM) {
    constexpr bool SP2 = true;
    const int tid = threadIdx.x, wid = __builtin_amdgcn_readfirstlane(tid >> 6), lane = tid & 63, wr = wid >> 2, wc = wid & 3, fr = lane & 15, fq = lane >> 4;
    const int K = g.K, nt = K / BK;
    unsigned voffA[2], voffB[2]; int rowA[2];
#pragma unroll
    for (int i = 0; i < 2; ++i) { int R, C; stage_rc(tid * 16 + i * 8192, R, C); const int Rb = Epi::PERM ? ((R & ~31) + perm32(R & 31)) : R;
        voffA[i] = (unsigned)C * 2u; voffB[i] = (unsigned)(Rb * K + C) * 2u; rowA[i] = R; }
    const size_t kstep = (size_t)(BK * 2);
    const size_t hstep = (size_t)HALF * K * 2;
    const size_t tstep = 2 * hstep;
    const unsigned ldsw = (unsigned)wid * 1024u;
    const int aoff = lds_byte(wr * 64 + fr, fq * 8), boff = lds_byte(wc * 32 + fr, fq * 8);
#define PG8_SA(b, h) (((b) * 2 + (h)) * HTB)
#define PG8_SB(b, h) ((4 + (b) * 2 + (h)) * HTB)
#define PG8_STAGE(bufoff, gbase, voff) do { _Pragma("unroll") for (int _i = 0; _i < 2; ++_i) \
        __builtin_amdgcn_global_load_lds((const unsigned*)((const char*)(gbase) + (voff)[_i]), (PG8_LAS unsigned*)(lds + (bufoff) + ldsw + _i * 8192), 16, 0, 0); } while (0)
#define PG8_LDA(dst, b, h) do { _Pragma("unroll") for (int m = 0; m < 4; ++m) _Pragma("unroll") for (int k = 0; k < 2; ++k) dst[m][k] = *(const PG8_LAS bf16x8*)(lds + PG8_SA(b, h) + aoff + m * 2048 + k * 1024); } while (0)
#define PG8_LDB(dst, b, h) do { _Pragma("unroll") for (int n = 0; n < 2; ++n) _Pragma("unroll") for (int k = 0; k < 2; ++k) dst[n][k] = *(const PG8_LAS bf16x8*)(lds + PG8_SB(b, h) + boff + n * 2048 + k * 1024); } while (0)
#define PG8_MMA(ai, bj, At, Bt) do { __builtin_amdgcn_s_setprio(1); _Pragma("unroll") for (int m = 0; m < 4; ++m) _Pragma("unroll") for (int n = 0; n < 2; ++n) _Pragma("unroll") for (int k = 0; k < 2; ++k) \
        mma_step<I8>(acc[ai][bj][m][n], Bt[n][k], At[m][k]); __builtin_amdgcn_s_setprio(0); } while (0)
#define PG8_WAIT_V(n) asm volatile("s_waitcnt vmcnt(" #n ")" ::: "memory")
#define PG8_WAIT_L(n) asm volatile("s_waitcnt lgkmcnt(" #n ")" ::: "memory")
#define PG8_BAR __builtin_amdgcn_s_barrier()
#define PG8_SCHED __builtin_amdgcn_sched_barrier(0)
    Unit cur, nxt; int ui = 0;
    if (!S.next(0, cur)) return;
    typedef typename AccSel<I8>::type acc_t;
    acc_t acc[2][2][4][2];
#pragma unroll
    for (int a = 0; a < 2; ++a)
#pragma unroll
        for (int b = 0; b < 2; ++b)
#pragma unroll
            for (int m = 0; m < 4; ++m)
#pragma unroll
                for (int n = 0; n < 2; ++n) acc[a][b][m][n] = (acc_t){0, 0, 0, 0};
    bf16x8 At[4][2], B0[2][2], B1[2][2];
    const char* cA = (const char*)g.A; const char* cB = (const char*)g.Bt + (size_t)cur.pn * tstep;
    unsigned vA0[2], vA1[2], nA0[2], nA1[2];
#pragma unroll
    for (int i = 0; i < 2; ++i) { vA0[i] = (unsigned)AM.row(cur, rowA[i]) * (unsigned)(K * 2) + voffA[i]; vA1[i] = (unsigned)AM.row(cur, HALF + rowA[i]) * (unsigned)(K * 2) + voffA[i]; }
    S.a_ready(cur);
    if constexpr (SP2) {
        PG8_STAGE(PG8_SB(0, 0), cB, voffB); PG8_STAGE(PG8_SB(0, 1), cB + hstep, voffB); PG8_STAGE(PG8_SA(0, 0), cA, vA0); PG8_STAGE(PG8_SA(0, 1), cA, vA1);
        if (wr == 1) PG8_BAR;
        PG8_WAIT_V(2); PG8_BAR;
        PG8_STAGE(PG8_SB(1, 0), cB + kstep, voffB); PG8_STAGE(PG8_SA(1, 0), cA + kstep, vA0); PG8_STAGE(PG8_SB(1, 1), cB + hstep + kstep, voffB);
        PG8_WAIT_V(6); PG8_BAR;
    } else {
        PG8_STAGE(PG8_SB(0, 0), cB, voffB); PG8_STAGE(PG8_SA(0, 0), cA, voffA); PG8_STAGE(PG8_SB(0, 1), cB + hstep, voffB); PG8_STAGE(PG8_SA(0, 1), cA + hstep, voffA);
        if (wr == 1) PG8_BAR;
        PG8_WAIT_V(4); PG8_BAR;
        PG8_STAGE(PG8_SB(1, 0), cB + kstep, voffB); PG8_STAGE(PG8_SA(1, 0), cA + kstep, voffA); PG8_STAGE(PG8_SB(1, 1), cB + hstep + kstep, voffB);
        PG8_WAIT_V(6); PG8_BAR;
    }
    for (;;) {
        const bool has_next = S.next(ui + 1, nxt);
        const char* nA = cA; const char* nB = has_next ? (const char*)g.Bt + (size_t)nxt.pn * tstep : cB;
#pragma unroll
        for (int i = 0; i < 2; ++i) { nA0[i] = has_next ? (unsigned)AM.row(nxt, rowA[i]) * (unsigned)(K * 2) + voffA[i] : vA0[i]; nA1[i] = has_next ? (unsigned)AM.row(nxt, HALF + rowA[i]) * (unsigned)(K * 2) + voffA[i] : vA1[i]; }
        for (int t = 0; t < nt; t += 2) {
            const bool last = (t == nt - 2);
            const char* a1 = cA + (size_t)(t + 1) * kstep;
            const char* a2 = last ? nA : cA + (size_t)(t + 2) * kstep; const char* b2 = last ? nB : cB + (size_t)(t + 2) * kstep;
            const char* a3 = a2 + kstep; const char* b3 = b2 + kstep;
            unsigned s0[2], s1[2];
#pragma unroll
            for (int i = 0; i < 2; ++i) { s0[i] = vA0[i]; s1[i] = vA1[i]; }
            if (last) {
#pragma unroll
                for (int i = 0; i < 2; ++i) { unsigned t0_ = nA0[i], t1_ = nA1[i]; asm volatile("" : "+v"(t0_), "+v"(t1_)); s0[i] = t0_; s1[i] = t1_; } }
            if (last && has_next) S.a_ready(nxt);
            if constexpr (SP2) {
            PG8_LDB(B0, 0, 0); PG8_LDB(B1, 0, 1); PG8_SCHED; PG8_LDA(At, 0, 0); PG8_STAGE(PG8_SA(1, 1), a1, vA1);
            PG8_WAIT_V(8); PG8_WAIT_L(0); PG8_BAR; PG8_MMA(0, 0, At, B0); PG8_MMA(0, 1, At, B1); PG8_BAR; PG8_SCHED;
            PG8_LDA(At, 0, 1); PG8_STAGE(PG8_SB(0, 0), b2, voffB); PG8_STAGE(PG8_SB(0, 1), b2 + hstep, voffB); PG8_STAGE(PG8_SA(0, 0), a2, s0);
            PG8_WAIT_V(8); PG8_WAIT_L(0); PG8_BAR; PG8_MMA(1, 0, At, B0); PG8_MMA(1, 1, At, B1); PG8_BAR; PG8_SCHED;
            PG8_LDB(B0, 1, 0); PG8_LDB(B1, 1, 1); PG8_SCHED; PG8_LDA(At, 1, 0); PG8_STAGE(PG8_SA(0, 1), a2, s1);
            PG8_WAIT_V(8); PG8_WAIT_L(0); PG8_BAR; PG8_MMA(0, 0, At, B0); PG8_MMA(0, 1, At, B1); PG8_BAR; PG8_SCHED;
            PG8_LDA(At, 1, 1); PG8_STAGE(PG8_SB(1, 0), b3, voffB); PG8_STAGE(PG8_SB(1, 1), b3 + hstep, voffB); PG8_STAGE(PG8_SA(1, 0), a3, s0);
            PG8_WAIT_V(8); PG8_WAIT_L(0); PG8_BAR; PG8_MMA(1, 0, At, B0); PG8_MMA(1, 1, At, B1); PG8_BAR; PG8_SCHED;
            } else {
            PG8_LDB(B0, 0, 0); PG8_SCHED; PG8_LDA(At, 0, 0); PG8_STAGE(PG8_SA(1, 1), a1 + hstep, voffA);
            PG8_WAIT_L(8); PG8_BAR; PG8_WAIT_L(0); PG8_MMA(0, 0, At, B0); PG8_BAR; PG8_SCHED;
            PG8_LDB(B1, 0, 1); PG8_STAGE(PG8_SB(0, 0), b2, voffB);
            PG8_BAR; PG8_WAIT_L(0); PG8_MMA(0, 1, At, B1); PG8_BAR;
            PG8_LDA(At, 0, 1); PG8_STAGE(PG8_SA(0, 0), a2, voffA);
            PG8_BAR; PG8_WAIT_L(0); PG8_MMA(1, 0, At, B0); PG8_BAR; PG8_SCHED;
            PG8_STAGE(PG8_SB(0, 1), b2 + hstep, voffB);
            PG8_WAIT_V(6); PG8_BAR; PG8_MMA(1, 1, At, B1); PG8_BAR;
            PG8_LDB(B0, 1, 0); PG8_SCHED; PG8_LDA(At, 1, 0); PG8_STAGE(PG8_SA(0, 1), a2 + hstep, voffA);
            PG8_WAIT_L(8); PG8_BAR; PG8_WAIT_L(0); PG8_MMA(0, 0, At, B0); PG8_BAR; PG8_SCHED;
            PG8_LDB(B1, 1, 1); PG8_STAGE(PG8_SB(1, 0), b3, voffB);
            PG8_BAR; PG8_WAIT_L(0); PG8_MMA(0, 1, At, B1); PG8_BAR;
            PG8_LDA(At, 1, 1); PG8_STAGE(PG8_SA(1, 0), a3, voffA);
            PG8_BAR; PG8_WAIT_L(0); PG8_MMA(1, 0, At, B0); PG8_BAR; PG8_SCHED;
            PG8_STAGE(PG8_SB(1, 1), b3 + hstep, voffB);
            PG8_WAIT_V(6); PG8_BAR; PG8_MMA(1, 1, At, B1); PG8_BAR;
            }
        }
        if constexpr (ALIGN_EPI) { if (wr == 0) PG8_BAR; }
        if constexpr (!Epi::AFTER_DRAIN) { E(acc, cur, wr, wc, fr, fq); S.done(cur); }
        if (!has_next) break;
#pragma unroll
        for (int a = 0; a < 2; ++a)
#pragma unroll
            for (int b = 0; b < 2; ++b)
#pragma unroll
                for (int m = 0; m < 4; ++m)
#pragma unroll
                    for (int n = 0; n < 2; ++n) acc[a][b][m][n] = (acc_t){0, 0, 0, 0};
        cur = nxt; cA = nA; cB = nB; ++ui;
#pragma unroll
        for (int i = 0; i < 2; ++i) { vA0[i] = nA0[i]; vA1[i] = nA1[i]; }
        if constexpr (ALIGN_EPI) { if (wr == 1) PG8_BAR; }
    }
    PG8_WAIT_V(0);
    if constexpr (!ALIGN_EPI) { if (wr == 0) PG8_BAR; }
    PG8_BAR;
    if constexpr (Epi::AFTER_DRAIN) { E.fused(acc, cur, wr, wc, fr, fq, lds, wid, lane); S.done(cur); }
#undef PG8_SA
#undef PG8_SB
#undef PG8_STAGE
#undef PG8_LDA
#undef PG8_LDB
#undef PG8_MMA
#undef PG8_WAIT_V
#undef PG8_WAIT_L
#undef PG8_BAR
#undef PG8_SCHED
}
}
#include <hip/hip_bf16.h>
#include <cmath>
namespace attn_body {
using bf16=__hip_bfloat16;
using bf16x8=__attribute__((ext_vector_type(8)))short;
using s16x4=__attribute__((ext_vector_type(4)))short;
using f32x16=__attribute__((ext_vector_type(16)))float;
using u32x4=__attribute__((ext_vector_type(4)))unsigned;
constexpr int BATCH=2,NHEAD=8,NKVH=2,SEQ=8192,D=64,QP=512,KP=128,OP=1024;
constexpr int NW=8,QBLK=32,QB=QBLK*NW,KVBLK=64,NQB=SEQ/QB;
constexpr int ATTN_UNIT_ROWS=QB;
__device__ __forceinline__ int crow(int r,int hi){return (r&3)+8*(r>>2)+4*hi;}
#define SBAR() __builtin_amdgcn_sched_barrier(0)
__device__ __forceinline__ void cmask(f32x16&p0,f32x16&p1,int jb,int qrel,int hi){
  const float NEG=-INFINITY; int kb=64*jb+4*hi;
  #pragma unroll
  for(int r=0;r<16;++r){int kv=kb+(r&3)+8*(r>>2); if(kv>qrel)p0[r]=NEG; if(kv+32>qrel)p1[r]=NEG;}
}

constexpr int NSLOT=3, SLOTB=8192;
constexpr int LDS_K=0, LDS_V=NSLOT*SLOTB, LDS_WS=2*NSLOT*SLOTB, LDS_OST=LDS_WS+NW*64*4, LDS_BYTES=LDS_OST+NW*4096;
constexpr float C2=0.125f*1.4426950408889634f;
__device__ __forceinline__ void glds16(const void*gsrc,unsigned lds_dst){unsigned keep;
  asm volatile("s_mov_b32 %0, m0\n\ts_mov_b32 m0, %2\n\ts_nop 0\n\tglobal_load_lds_dwordx4 %1, off\n\ts_mov_b32 m0, %0":"=&s"(keep):"v"(gsrc),"s"(lds_dst):"memory");}
__device__ __forceinline__ float max3f(float a,float b,float c){float r;asm("v_max3_f32 %0, %1, %2, %3":"=v"(r):"v"(a),"v"(b),"v"(c));return r;}
__device__ __forceinline__ float max2f(float a,float b){float r;asm("v_max_f32_e32 %0, %1, %2":"=v"(r):"v"(a),"v"(b));return r;}
__device__ __forceinline__ float fadd_s(float a,float b){float r;asm("v_add_f32_e32 %0, %1, %2":"=v"(r):"v"(a),"v"(b));return r;}
__device__ __forceinline__ float fsub_s(float a,float b){float r;asm("v_sub_f32_e32 %0, %1, %2":"=v"(r):"v"(a),"v"(b));return r;}
typedef float f32x2_t __attribute__((ext_vector_type(2))); typedef __bf16 bf16x2_t __attribute__((ext_vector_type(2)));
__device__ __forceinline__ unsigned cvtpk_s(float lo,float hi){f32x2_t v={lo,hi};bf16x2_t b=__builtin_convertvector(v,bf16x2_t);return __builtin_bit_cast(unsigned,b);}
#define WAIT_BAR(N) asm volatile("s_waitcnt vmcnt(" #N ") lgkmcnt(0)\n\ts_barrier":::"memory")

__device__ __forceinline__ void qkt(f32x16&p0,f32x16&p1,const char*Kslot,const bf16x8*qr,const f32x16&negm,int r32,int hi){
  const char*kb=Kslot+hi*1024+r32*16;
  #pragma unroll
  for(int d0=0;d0<4;++d0){
    const bf16x8 b0=*reinterpret_cast<const bf16x8*>(kb+d0*2048);
    const bf16x8 b1=*reinterpret_cast<const bf16x8*>(kb+d0*2048+512);
    if(d0==0){p0=__builtin_amdgcn_mfma_f32_32x32x16_bf16(b0,qr[0],negm,0,0,0);p1=__builtin_amdgcn_mfma_f32_32x32x16_bf16(b1,qr[0],negm,0,0,0);}
    else{p0=__builtin_amdgcn_mfma_f32_32x32x16_bf16(b0,qr[d0],p0,0,0,0);p1=__builtin_amdgcn_mfma_f32_32x32x16_bf16(b1,qr[d0],p1,0,0,0);}}
}
typedef __attribute__((address_space(3))) const char* lds_cptr;
typedef short v4i16_t __attribute__((ext_vector_type(4)));
__device__ __forceinline__ void kload8(bf16x8*kf,lds_cptr kp){
  kf[0]=*(const __attribute__((address_space(3))) bf16x8*)(kp);      kf[1]=*(const __attribute__((address_space(3))) bf16x8*)(kp+512);
  kf[2]=*(const __attribute__((address_space(3))) bf16x8*)(kp+2048); kf[3]=*(const __attribute__((address_space(3))) bf16x8*)(kp+2560);
  kf[4]=*(const __attribute__((address_space(3))) bf16x8*)(kp+4096); kf[5]=*(const __attribute__((address_space(3))) bf16x8*)(kp+4608);
  kf[6]=*(const __attribute__((address_space(3))) bf16x8*)(kp+6144); kf[7]=*(const __attribute__((address_space(3))) bf16x8*)(kp+6656);
}
__device__ __forceinline__ void kload2(bf16x8*kf,lds_cptr kp,int j){ kf[2*j]=*(const __attribute__((address_space(3))) bf16x8*)(kp+j*2048); kf[2*j+1]=*(const __attribute__((address_space(3))) bf16x8*)(kp+j*2048+512); }
__device__ __forceinline__ s16x4 vtr(lds_cptr p){ return __builtin_bit_cast(s16x4,__builtin_amdgcn_ds_read_tr16_b64_v4i16((__attribute__((address_space(3))) v4i16_t*)p)); }
__device__ __forceinline__ float rowmax(const f32x16&p0,const f32x16&p1){
  float a=max3f(p0[0],p0[1],p1[0]),b=max3f(p0[2],p0[3],p1[1]);a=max3f(a,p1[2],p1[3]);
  #pragma unroll
  for(int r=4;r<16;r+=4){a=max3f(a,p0[r],p0[r+1]);b=max3f(b,p0[r+2],p0[r+3]);a=max3f(a,p1[r],p1[r+1]);b=max3f(b,p1[r+2],p1[r+3]);}
  const float m=max2f(a,b);
  auto rr=__builtin_amdgcn_permlane32_swap(__float_as_uint(m),__float_as_uint(m),false,false);
  return max2f(__uint_as_float(rr[0]),__uint_as_float(rr[1]));
}
__device__ __forceinline__ void pv(f32x16*o,int vb,bf16x8 pa0,bf16x8 pa1,bf16x8 pa2,bf16x8 pa3){
  #pragma unroll
  for(int d0=0;d0<2;++d0){s16x4 lo[4],hi[4];
    #pragma unroll
    for(int ks=0;ks<4;++ks){
      asm volatile("ds_read_b64_tr_b16 %0,%1 offset:%c2":"=&v"(lo[ks]):"v"(vb),"i"(d0*4096+ks*1024):"memory");
      asm volatile("ds_read_b64_tr_b16 %0,%1 offset:%c2":"=&v"(hi[ks]):"v"(vb),"i"(d0*4096+ks*1024+512):"memory");}
    asm volatile("s_waitcnt lgkmcnt(0)":::"memory");SBAR();
    #define PK(k) (bf16x8){lo[k][0],lo[k][1],lo[k][2],lo[k][3],hi[k][0],hi[k][1],hi[k][2],hi[k][3]}
    o[d0]=__builtin_amdgcn_mfma_f32_32x32x16_bf16(pa0,PK(0),o[d0],0,0,0);
    o[d0]=__builtin_amdgcn_mfma_f32_32x32x16_bf16(pa1,PK(1),o[d0],0,0,0);
    o[d0]=__builtin_amdgcn_mfma_f32_32x32x16_bf16(pa2,PK(2),o[d0],0,0,0);
    o[d0]=__builtin_amdgcn_mfma_f32_32x32x16_bf16(pa3,PK(3),o[d0],0,0,0);
    #undef PK
  }
}

#ifndef ATTN_STORE16
#define ATTN_STORE16(p,v) (*(u32x4*)(p)=(v))
#endif
template<int THRL> __device__ __forceinline__ void attn_unit(int b,int h,int qb,const bf16*Q,const bf16*__restrict__ K,const bf16*__restrict__ V,bf16*O,char*shm){
  const int tid=threadIdx.x,lane=tid&63,r32=lane&31,hi=lane>>5; const int wid=__builtin_amdgcn_readfirstlane(tid>>6);
  const long rowbase=(long)b*SEQ; const int q0=qb*QB;
  const bf16*Qw=Q+(rowbase+q0+wid*QBLK)*QP+h*D;
  const int hk=h/(NHEAD/NKVH); const bf16*Kh=K+(long)(b*NKVH+hk)*SEQ*D,*Vh=V+(long)(b*NKVH+hk)*SEQ*D;
  const unsigned lds0=(unsigned)(uintptr_t)shm;
  float*wsf=(float*)(shm+LDS_WS)+wid*64;
  const bf16*ksrc=Kh+(wid*64+lane)*8;
  const bf16*vsrc=Vh+(wid*64+lane)*8;
  const unsigned kdst=lds0+LDS_K+wid*1024, vdst=lds0+LDS_V+wid*1024;
  #define DMA_K(t,slot) glds16(ksrc+(long)(t)*KVBLK*D,(unsigned)__builtin_amdgcn_readfirstlane(kdst+(slot)))
  #define DMA_V(t,slot) glds16(vsrc+(long)(t)*KVBLK*D,(unsigned)__builtin_amdgcn_readfirstlane(vdst+(slot)))
  const int vb0=(int)(lds0+LDS_V)+((lane>>4)&1)*32+(lane&3)*8+(4*hi+((lane&15)>>2))*64;
  const char*Kbase=shm+LDS_K; bf16x8 kf[8];
  const lds_cptr shm3=(lds_cptr)shm; const lds_cptr kp0=shm3+LDS_K+hi*1024+r32*16; const lds_cptr vp0=shm3+LDS_V+((lane>>4)&1)*32+(lane&3)*8+(4*hi+((lane&15)>>2))*64;
  constexpr int NT=SEQ/KVBLK;
  DMA_K(0,0);DMA_V(0,0);DMA_K(1,SLOTB);
  bf16x8 qr[4];
  #pragma unroll
  for(int d0=0;d0<4;++d0)qr[d0]=*reinterpret_cast<const bf16x8*>(&Qw[(long)r32*QP+d0*16+hi*8]);
  float mhat=0.f,l_reg=0.f;f32x16 o[2];o[0]=f32x16{};o[1]=f32x16{};f32x16 negm=f32x16{};asm volatile("":"+v"(negm));
  const int qrel=wid*QBLK+r32;
  #define CMASK(P0,P1,t) do{}while(0)
  bool resc=false;
  #define START(P0,P1) do{ const float rm=rowmax(P0,P1); resc=false; \
    { const float dl=rm; mhat=fadd_s(mhat,dl); \
      _Pragma("unroll") for(int r=0;r<16;++r){P0[r]=fsub_s(P0[r],dl);P1[r]=fsub_s(P1[r],dl);} \
      _Pragma("unroll") for(int r=0;r<16;++r)negm[r]=-mhat; asm volatile("":"+v"(negm)); } \
    _Pragma("unroll") for(int r=0;r<16;++r)P0[r]=__builtin_amdgcn_exp2f(P0[r]); }while(0)
  #define RESC() do{ if(resc){ asm volatile("s_waitcnt lgkmcnt(0)":::"memory"); \
      _Pragma("unroll") for(int d_=0;d_<2;++d_) _Pragma("unroll") for(int r=0;r<16;++r)o[d_][r]*=wsf[crow(r,hi)]; } }while(0)
  f32x16 pA0,pA1,pB0,pB1;
  int sl_prev=0,sl_cur=0,sl_next=SLOTB;
  #define ROT() do{sl_prev=sl_cur;sl_cur=sl_next;sl_next=(sl_next==(NSLOT-1)*SLOTB)?0:sl_next+SLOTB;}while(0)
  DMA_K(2,2*SLOTB);
  WAIT_BAR(3);
  qkt(pA0,pA1,Kbase,qr,negm,r32,hi);asm volatile("s_nop 15\n\ts_nop 7":"+v"(pA0),"+v"(pA1));CMASK(pA0,pA1,0);
  START(pA0,pA1);
  _Pragma("unroll") for(int r=0;r<16;++r)pA1[r]=__builtin_amdgcn_exp2f(pA1[r]);
  WAIT_BAR(0);
  DMA_K(3,0);DMA_V(1,SLOTB);
  ROT();
  kload8(kf,kp0+sl_cur);
  WAIT_BAR(2);
  s16x4 vlo[8],vhi[8]; u32x4 pw0,pw1,pw2,pw3;
  #define PKW(P,B) cvtpk_s(P[B],P[B+1])
  #define PAF(k) __builtin_bit_cast(bf16x8,pw##k)
  #define VFR(i) (bf16x8){vlo[i][0],vlo[i][1],vlo[i][2],vlo[i][3],vhi[i][0],vhi[i][1],vhi[i][2],vhi[i][3]}
  #define PIN(x) asm volatile("":"+v"(x))
  #define MX3(a,b,c) __builtin_fmaxf(__builtin_fmaxf((a),(b)),(c))
  #define GAPA(MF,A0,A1,A2,A3,W0,W1,PW) do{ MF; sacc+=A0; sacc+=A1; sacc+=A2; sacc+=A3; PIN(sacc); W0; W1; PIN(PW); SBAR(); }while(0)
  #define EX(v) __builtin_amdgcn_exp2f(v)
  #define GAPB(MF,X,B) do{ MF; X[B]=EX(X[B]); X[B+1]=EX(X[B+1]); X[B+2]=EX(X[B+2]); X[B+3]=EX(X[B+3]); PIN(X); SBAR(); }while(0)
  #define VRD(i) do{ vlo[i]=vtr(vp_+(((i)>>2)*4096+((i)&3)*1024)); vhi[i]=vtr(vp_+(((i)>>2)*4096+((i)&3)*1024+512)); }while(0)
  #define KRD(G,j) do{ if(G){ kload2(kf,kp0+sl_next,j); SBAR(); } }while(0)
  #define STEP(C0,C1,P0,P1,t,GK,GV,GL) do{ SBAR(); \
    const lds_cptr vp_=vp0+sl_prev; \
    VRD(0); SBAR(); float sacc=(P0[0]+P0[1]); \
    GAPA(C0=__builtin_amdgcn_mfma_f32_32x32x16_bf16(kf[0],qr[0],negm,0,0,0), P0[2],P0[3],P0[4],P0[5],     pw0[0]=PKW(P0,0), pw0[1]=PKW(P0,2), pw0); \
    VRD(4); SBAR(); GAPA(C1=__builtin_amdgcn_mfma_f32_32x32x16_bf16(kf[1],qr[0],negm,0,0,0), P0[6],P0[7],P0[8],P0[9],     pw0[2]=PKW(P0,4), pw0[3]=PKW(P0,6), pw0); \
    VRD(1); SBAR(); GAPA(C0=__builtin_amdgcn_mfma_f32_32x32x16_bf16(kf[2],qr[1],C0,0,0,0),   P0[10],P0[11],P0[12],P0[13], pw1[0]=PKW(P0,8), pw1[1]=PKW(P0,10), pw1); \
    VRD(5); SBAR(); GAPA(C1=__builtin_amdgcn_mfma_f32_32x32x16_bf16(kf[3],qr[1],C1,0,0,0),   P0[14],P0[15],P1[0],P1[1],   pw1[2]=PKW(P0,12),pw1[3]=PKW(P0,14), pw1); \
    VRD(2); SBAR(); GAPA(C0=__builtin_amdgcn_mfma_f32_32x32x16_bf16(kf[4],qr[2],C0,0,0,0),   P1[2],P1[3],P1[4],P1[5],     pw2[0]=PKW(P1,0), pw2[1]=PKW(P1,2), pw2); \
    VRD(6); SBAR(); GAPA(C1=__builtin_amdgcn_mfma_f32_32x32x16_bf16(kf[5],qr[2],C1,0,0,0),   P1[6],P1[7],P1[8],P1[9],     pw2[2]=PKW(P1,4), pw2[3]=PKW(P1,6), pw2); \
    VRD(3); SBAR(); GAPA(C0=__builtin_amdgcn_mfma_f32_32x32x16_bf16(kf[6],qr[3],C0,0,0,0),   P1[10],P1[11],P1[12],P1[13], pw3[0]=PKW(P1,8), pw3[1]=PKW(P1,10), pw3); \
    VRD(7); SBAR(); GAPA(C1=__builtin_amdgcn_mfma_f32_32x32x16_bf16(kf[7],qr[3],C1,0,0,0),   P1[14],P1[15],0.f,0.f,       pw3[2]=PKW(P1,12),pw3[3]=PKW(P1,14), pw3); \
    l_reg+=sacc; \
    if(GK){DMA_K((t)+3,sl_cur);} if(GV){DMA_V((t)+1,sl_next);} \
    CMASK(C0,C1,t); \
    { float a=MX3(C0[0],C0[1],C1[0]),b=MX3(C0[2],C0[3],C1[1]); a=MX3(a,C1[2],C1[3]); \
      _Pragma("unroll") for(int r=4;r<16;r+=4){a=MX3(a,C0[r],C0[r+1]);b=MX3(b,C0[r+2],C0[r+3]);a=MX3(a,C1[r],C1[r+1]);b=MX3(b,C1[r+2],C1[r+3]);} \
      float rm=__builtin_fmaxf(a,b); { auto rr=__builtin_amdgcn_permlane32_swap(__float_as_uint(rm),__float_as_uint(rm),false,false); rm=__builtin_fmaxf(__uint_as_float(rr[0]),__uint_as_float(rr[1])); } \
      resc=false; \
      if(__builtin_expect(__any(rm>(float)THRL),0)){ const float dl=__builtin_fmaxf(rm,0.f); mhat+=dl; \
        _Pragma("unroll") for(int r=0;r<16;++r){C0[r]-=dl;C1[r]-=dl;} \
        _Pragma("unroll") for(int r=0;r<16;++r)negm[r]=-mhat; asm volatile("":"+v"(negm)); \
        const float f=__builtin_amdgcn_exp2f(-dl); l_reg*=f; if(hi==0)wsf[r32]=f; resc=true; } } \
    SBAR(); \
    GAPB(o[0]=__builtin_amdgcn_mfma_f32_32x32x16_bf16(PAF(0),VFR(0),o[0],0,0,0), C0,0); \
    GAPB(o[1]=__builtin_amdgcn_mfma_f32_32x32x16_bf16(PAF(0),VFR(4),o[1],0,0,0), C0,4); \
    KRD(GL,0); GAPB(o[0]=__builtin_amdgcn_mfma_f32_32x32x16_bf16(PAF(1),VFR(1),o[0],0,0,0), C0,8); \
    KRD(GL,1); GAPB(o[1]=__builtin_amdgcn_mfma_f32_32x32x16_bf16(PAF(1),VFR(5),o[1],0,0,0), C0,12); \
    KRD(GL,2); GAPB(o[0]=__builtin_amdgcn_mfma_f32_32x32x16_bf16(PAF(2),VFR(2),o[0],0,0,0), C1,0); \
    KRD(GL,3); GAPB(o[1]=__builtin_amdgcn_mfma_f32_32x32x16_bf16(PAF(2),VFR(6),o[1],0,0,0), C1,4); \
    GAPB(o[0]=__builtin_amdgcn_mfma_f32_32x32x16_bf16(PAF(3),VFR(3),o[0],0,0,0), C1,8); \
    GAPB(o[1]=__builtin_amdgcn_mfma_f32_32x32x16_bf16(PAF(3),VFR(7),o[1],0,0,0), C1,12); \
    }while(0)
  int t=1;
  #undef CMASK
  #define CMASK(P0,P1,t) do{}while(0)
  for(;t+5<NT;t+=2){
    STEP(pB0,pB1,pA0,pA1,t,true,true,true);     WAIT_BAR(2); RESC(); ROT();
    STEP(pA0,pA1,pB0,pB1,t+1,true,true,true);   WAIT_BAR(2); RESC(); ROT();
  }
  #undef CMASK
  #define CMASK(P0,P1,t) do{}while(0)
  #define ENDW(tt) do{ if((tt)+3<NT){WAIT_BAR(2);} else if((tt)+2<NT){WAIT_BAR(1);} else {WAIT_BAR(0);} }while(0)
  for(;t+1<NT;t+=2){
    STEP(pB0,pB1,pA0,pA1,t,(t+3<NT),(t+1<NT),(t+1<NT));       ENDW(t);   RESC(); ROT();
    STEP(pA0,pA1,pB0,pB1,t+1,(t+4<NT),(t+2<NT),(t+2<NT));     ENDW(t+1); RESC(); ROT();
  }
  STEP(pB0,pB1,pA0,pA1,NT-1,false,false,false); RESC();
  { float sacc=pB0[0]+pB0[1]; _Pragma("unroll") for(int r=2;r<16;++r)sacc+=pB0[r]; _Pragma("unroll") for(int r=0;r<16;++r)sacc+=pB1[r]; l_reg+=sacc;
    pw0=(u32x4){PKW(pB0,0),PKW(pB0,2),PKW(pB0,4),PKW(pB0,6)};pw1=(u32x4){PKW(pB0,8),PKW(pB0,10),PKW(pB0,12),PKW(pB0,14)};pw2=(u32x4){PKW(pB1,0),PKW(pB1,2),PKW(pB1,4),PKW(pB1,6)};pw3=(u32x4){PKW(pB1,8),PKW(pB1,10),PKW(pB1,12),PKW(pB1,14)};
    SBAR(); pv(o,vb0+sl_cur,PAF(0),PAF(1),PAF(2),PAF(3)); }
  #undef PKW
  #undef PAF
  #undef VFR
  #undef PIN
  #undef MX3
  #undef GAPA
  #undef GAPB
  #undef EX
  #undef VRD
  #undef KRD
  #undef STEP
  #undef ENDW
  {auto rr=__builtin_amdgcn_permlane32_swap(__float_as_uint(l_reg),__float_as_uint(l_reg),false,false);l_reg=__uint_as_float(rr[0])+__uint_as_float(rr[1]);}
  if(hi==0)wsf[32+r32]=l_reg;asm volatile("s_waitcnt lgkmcnt(0)":::"memory");
  float rli[16];
  #pragma unroll
  for(int r=0;r<16;++r)rli[r]=__builtin_amdgcn_rcpf(wsf[32+crow(r,hi)]);
  bf16*Ow=O+(rowbase+q0+wid*QBLK)*OP+h*D;
  { bf16*stg=(bf16*)(shm+LDS_OST)+wid*2048;
    #pragma unroll
    for(int r=0;r<16;++r){const int orow=crow(r,hi);
      #pragma unroll
      for(int d0=0;d0<2;++d0)stg[orow*64+d0*32+r32]=__float2bfloat16(o[d0][r]*rli[r]);}
    asm volatile("s_waitcnt lgkmcnt(0)":::"memory");
    #pragma unroll
    for(int i=0;i<4;++i){const int row=i*8+(lane>>3),ch=lane&7; const u32x4 v=*(const u32x4*)(stg+row*64+ch*8); ATTN_STORE16(Ow+(long)row*OP+ch*8,v);} }
  asm volatile("s_waitcnt lgkmcnt(0)\n\ts_barrier":::"memory");
  #undef DMA_K
  #undef DMA_V
  #undef CMASK
  #undef START
  #undef RESC
  #undef ROT
}
constexpr int ATTN_LDS_BYTES=LDS_BYTES;
struct AttnTensors { const bf16* Q; const bf16* K; const bf16* V; bf16* O; };
struct AttnUnit { int bh; int qb; };
struct StaticOrder {
  int vcu, G;
  __device__ __forceinline__ explicit StaticOrder(int grid,int block):vcu((grid%8==0)?(block%8)*(grid/8)+block/8:block),G(grid){}
  __device__ __forceinline__ bool next(int i,AttnUnit&u)const{
    const int L=i*G+vcu; if(L>=BATCH*NHEAD*NQB)return false;
    if(G==256){ if(i>=2)return false; const int x=vcu>>5,j=vcu&31; const int b=x>>2,kvh=(x>>1)&1,hq=kvh*4+2*(x&1)+i; u.bh=b*NHEAD+hq; u.qb=j; return true; }
    u.bh=L/NQB; u.qb=L%NQB; return true; }
  __device__ __forceinline__ void a_ready(const AttnUnit&)const{}
  __device__ __forceinline__ void done(const AttnUnit&)const{}
};
template<class Sched,int THRL=8> __device__ __forceinline__ void attn_phase(char*lds,const AttnTensors&T,const Sched&S){
  AttnUnit u;
  for(int i=0;S.next(i,u);++i){ S.a_ready(u); attn_unit<THRL>(u.bh/NHEAD,u.bh%NHEAD,u.qb,T.Q,T.K,T.V,T.O,lds); S.done(u); }
}
#undef SBAR
#undef WAIT_BAR
}

#include <hip/hip_cooperative_groups.h>
namespace cg = cooperative_groups;
#ifndef MK_PER_PHASE
#define MK_PER_PHASE 0
#endif
constexpr int NWAVES = 8, NTHREADS = 512;
constexpr int NB = 2, SEQ = 8192, DMODEL = 1024, TT = NB * SEQ;
constexpr int NPROJ = 3072;
constexpr int NEXP = 32, FFE = 512;
constexpr float EPS = 1e-6f;
constexpr int N_PHASES = 12;

constexpr size_t MiB = 1u << 20;
constexpr size_t WS_CTL = 0, CTL_ZERO_BYTES = 64 * 1024;
constexpr size_t WS_WOUT = 1 * MiB;
constexpr size_t WS_LIST = 229 * MiB;
constexpr size_t WS_WR = 3 * MiB;
constexpr size_t WS_TOK = 3 * MiB + 256 * 1024;
constexpr size_t WS_GATES = 4 * MiB;
constexpr size_t WS_WIN = 5 * MiB;
constexpr size_t WS_A = 11 * MiB;
constexpr size_t WS_XN = WS_A;
constexpr size_t GDN_SH_BYTES = 71680, GDN_D_BYTES = 19456;
constexpr size_t WS_GSH = WS_A;
constexpr size_t WS_GD = WS_A + 1024 * GDN_SH_BYTES;
constexpr size_t WS_X1 = 5 * MiB;
constexpr size_t WS_HID = 69 * MiB;
constexpr size_t WS_XBUF = 109 * MiB;
constexpr size_t WS_B = 157 * MiB;
constexpr size_t WS_QKVA = WS_B;
constexpr size_t WS_QKVB = WS_B + 48 * MiB;
constexpr size_t WS_ZA = WS_B + 72 * MiB;
constexpr size_t WS_OCAT = WS_B;
constexpr size_t WS_WGU0 = 189 * MiB, WS_WGU1 = 245 * MiB; constexpr int WGU_SPLIT = 20;
constexpr size_t WS_WSC = 3 * MiB + 768 * 1024;
constexpr float ACT_CLIP = 6.0f;
constexpr size_t DO_WD0 = 0, DO_WD1 = 56 * MiB; constexpr int WD_SPLIT = 24;
constexpr size_t DO_HN = 24 * MiB;
constexpr size_t WS_END = 269 * MiB;
static_assert(WS_GD + 4096 * GDN_D_BYTES <= WS_B, "GDN records fit region A");
static_assert(WS_X1 + 64 * MiB <= WS_HID && WS_HID + 40928ull * 1024 <= WS_XBUF && WS_XBUF + 40928ull * 2048 <= WS_WGU0, "post-scan map");
static_assert(WS_WGU0 + WGU_SPLIT * MiB <= WS_B + 72 * MiB && WS_WGU1 + (32 - WGU_SPLIT) * MiB <= 269 * MiB, "WGU fragments");
constexpr size_t DO_QR = 0, DO_KR = 16 * MiB, DO_VR = 20 * MiB, DO_OF = 24 * MiB, DO_OB = 40 * MiB;
constexpr int CW_CNT = 2048;
constexpr int CW_NTILE = 128;
constexpr int CW_ETAB = 192;
constexpr int CW_SCANQ = 1024;

constexpr int LDS_BYTES = 160 * 1024;

#define GAS __attribute__((address_space(1)))
#define LAS __attribute__((address_space(3)))
typedef unsigned short bf16;
typedef unsigned v4u __attribute__((ext_vector_type(4)));
typedef unsigned v2u __attribute__((ext_vector_type(2)));
typedef float f32x4 __attribute__((ext_vector_type(4)));
typedef short bf16x8 __attribute__((ext_vector_type(8)));
typedef short s16x4 __attribute__((ext_vector_type(4)));
#define DI __device__ __forceinline__

DI unsigned f2bf(float f) { unsigned u = __builtin_bit_cast(unsigned, f); return (u + 0x7fffu + ((u >> 16) & 1u)) >> 16; }
typedef float f32x2_t __attribute__((ext_vector_type(2))); typedef __bf16 bf16x2_t __attribute__((ext_vector_type(2)));
DI unsigned pk2(float lo, float hi) { f32x2_t v = {lo, hi}; bf16x2_t b = __builtin_convertvector(v, bf16x2_t); return __builtin_bit_cast(unsigned, b); }
DI float bf2f(unsigned short h) { return __builtin_bit_cast(float, (unsigned)h << 16); }
DI float bflo(unsigned w) { return __builtin_bit_cast(float, w << 16); }
DI float bfhi(unsigned w) { return __builtin_bit_cast(float, w & 0xffff0000u); }
DI unsigned q8x4(float a, float b, float c, float d, float sc) {
    const float M = 12582912.f;
    const unsigned ua = __builtin_bit_cast(unsigned, fminf(fmaxf(a * sc, -127.f), 127.f) + M), ub = __builtin_bit_cast(unsigned, fminf(fmaxf(b * sc, -127.f), 127.f) + M);
    const unsigned uc = __builtin_bit_cast(unsigned, fminf(fmaxf(c * sc, -127.f), 127.f) + M), ud = __builtin_bit_cast(unsigned, fminf(fmaxf(d * sc, -127.f), 127.f) + M);
    return (ua & 255u) | ((ub & 255u) << 8) | ((uc & 255u) << 16) | (ud << 24);
}
DI float wave_max(float v) {
#pragma unroll
    for (int o = 1; o < 64; o <<= 1) v = fmaxf(v, __shfl_xor(v, o));
    return v;
}
DI float act_absmax(const float* nfw, int lane) {
    float m = 0.f;
#pragma unroll
    for (int i = 0; i < 16; ++i) m = fmaxf(m, fabsf(nfw[lane + 64 * i]));
    return ACT_CLIP * wave_max(m);
}
DI float wave_sum(float v) {
#pragma unroll
    for (int o = 1; o < 64; o <<= 1) v += __shfl_xor(v, o);
    return v;
}
DI float siluf(float x) { return x * __builtin_amdgcn_rcpf(1.0f + __expf(-x)); }
DI float sigmoidf_(float x) { return 1.0f / (1.0f + __expf(-x)); }
DI int perm32i(int idx) { return ((idx >> 2) & 3) * 8 + (idx >> 4) * 4 + (idx & 3); }
DI int permcol(int c) { return (c & ~31) + perm32i(c & 31); }
template <class T> DI T opaque(T p) { asm volatile("" : "+v"(p)); return p; }

typedef GAS unsigned gu32;
#define RLX_AGENT __ATOMIC_RELAXED, __HIP_MEMORY_SCOPE_AGENT
constexpr int CW_BAR = 4096;
constexpr int MISC_OFF = LDS_BYTES - 64;
#define XB_TMO      128
#define XB_XCNT(j)  (256  + 64 * (j))
#define XB_XSUB(j)  (1280 + 64 * (j))
#define XB_XGEN(j)  (2304 + 64 * (j))
#define XB_TOP      3328
#define XB_TOPGEN   3392
#define XCD_BAR_WORDS 3456
#define XB_SPIN_CAP (1u << 18)

__device__ __forceinline__ unsigned xb_ld(unsigned* p)              { return __hip_atomic_load(p, __ATOMIC_RELAXED, __HIP_MEMORY_SCOPE_AGENT); }
__device__ __forceinline__ unsigned xb_add(unsigned* p, unsigned v) { return __hip_atomic_fetch_add(p, v, __ATOMIC_RELAXED, __HIP_MEMORY_SCOPE_AGENT); }
__device__ __forceinline__ unsigned xb_xcc_id() { return (unsigned)__builtin_amdgcn_s_getreg((3 << 11) | 20) & 0xFu; }
#define XB_SPIN(cond, bar) do { unsigned _sp = 0; while (cond) { __builtin_amdgcn_s_sleep(1); \
    if ((++_sp & 255u) == 0u) { if (xb_ld(&(bar)[XB_TMO])) break; if (_sp > XB_SPIN_CAP) { atomicAdd(&(bar)[XB_TMO], 1u); break; } } } } while (0)

struct XcdBarrier {
    unsigned* bar; unsigned x;
    volatile LAS unsigned* st;
};

__device__ __forceinline__ XcdBarrier xcd_barrier_post(unsigned* bar, volatile LAS unsigned* st) {
    XcdBarrier b; b.bar = bar; b.x = xb_xcc_id(); b.st = st;
    if (threadIdx.x == 0) (void)xb_add(&bar[XB_XCNT(b.x)], 1u);
    return b;
}
__device__ __forceinline__ void xcd_barrier_complete(unsigned* bar, unsigned x, unsigned& nloc, unsigned& nx) {
    const unsigned G = gridDim.x * gridDim.y * gridDim.z;
    unsigned sum, cnt, mine, sp = 0u;
    for (;;) {
        sum = 0u; cnt = 0u; mine = 0u;
#pragma unroll
        for (unsigned j = 0; j < 16; ++j) { const unsigned c = xb_ld(&bar[XB_XCNT(j)]); sum += c; cnt += (c > 0u) ? 1u : 0u; mine = (j == x) ? c : mine; }
        if (sum == G) break;
        __builtin_amdgcn_s_sleep(1);
        if ((++sp & 255u) == 0u) { if (xb_ld(&bar[XB_TMO])) break; if (sp > XB_SPIN_CAP) { atomicAdd(&bar[XB_TMO], 1u); break; } }
    }
    nloc = mine > 0u ? mine : 1u; nx = cnt > 0u ? cnt : 1u;
}

__device__ __forceinline__ void xcd_barrier(const XcdBarrier& b) {
    asm volatile("s_waitcnt vmcnt(0)" ::: "memory");
    __syncthreads();
    if (threadIdx.x == 0) {
        unsigned* bar = b.bar;
        __builtin_amdgcn_s_waitcnt(0);
        unsigned nloc = b.st[0], nx = b.st[1];
        if (nloc == 0u) { xcd_barrier_complete(bar, b.x, nloc, nx); b.st[0] = nloc; b.st[1] = nx; }
        const unsigned old = xb_add(&bar[XB_XSUB(b.x)], 1u);
        const unsigned gen = old / nloc;
        if (old + 1u == (gen + 1u) * nloc) {
            __builtin_amdgcn_fence(__ATOMIC_RELEASE, "agent");
            asm volatile("s_waitcnt vmcnt(0)" ::: "memory");
            const unsigned og = xb_add(&bar[XB_TOP], 1u);
            const unsigned tg = og / nx;
            if (og + 1u == (tg + 1u) * nx) xb_add(&bar[XB_TOPGEN], 1u);
            else XB_SPIN(xb_ld(&bar[XB_TOPGEN]) == tg, bar);
            __builtin_amdgcn_fence(__ATOMIC_ACQUIRE, "agent");
            xb_add(&bar[XB_XGEN(b.x)], 1u);
            asm volatile("s_waitcnt vmcnt(0)" ::: "memory");
        } else {
            XB_SPIN(xb_ld(&bar[XB_XGEN(b.x)]) == gen, bar);
            __builtin_amdgcn_fence(__ATOMIC_ACQUIRE, "agent");
            asm volatile("s_waitcnt vmcnt(0)" ::: "memory");
        }
    }
    __syncthreads();
}

struct Frame {
    LAS unsigned char* lds;
    int tid, lane, wave, vcu, G;
    const float* in[17];
    float* out; unsigned char* ws;
};

DI void p0_transpose_item(const float* W, int ldw, int nblk, bf16* WT, int K, int row_off, int rmul, LAS float* scr, int item, int lane) {
    const int kb = item / nblk, nb = item % nblk, k0 = 64 * kb, n0 = 32 * nb;
    const int r8 = lane >> 3, c4 = (lane & 7) * 4;
    f32x4 v[8];
#pragma unroll
    for (int i = 0; i < 8; ++i) v[i] = __builtin_nontemporal_load((const f32x4*)(W + (size_t)(k0 + 8 * i + r8) * ldw + n0 + c4));
#pragma unroll
    for (int i = 0; i < 8; ++i) { LAS float* d = scr + (8 * i + r8) * 33 + c4; d[0] = v[i].x; d[1] = v[i].y; d[2] = v[i].z; d[3] = v[i].w; }
    asm volatile("s_waitcnt lgkmcnt(0)" ::: "memory");
    const int c = lane & 7;
#pragma unroll
    for (int j = 0; j < 4; ++j) { const int n = (lane >> 3) + 8 * j; const LAS float* s = scr + (8 * c) * 33 + n;
        v4u o; o.x = pk2(s[0 * 33], s[1 * 33]); o.y = pk2(s[2 * 33], s[3 * 33]); o.z = pk2(s[4 * 33], s[5 * 33]); o.w = pk2(s[6 * 33], s[7 * 33]);
        *(GAS v4u*)(WT + (size_t)(row_off + (n0 + n) * rmul) * K + k0 + 8 * c) = o; }
    asm volatile("s_waitcnt lgkmcnt(0)" ::: "memory");
}
template <int NR> DI void rms_rows_to_bf16(const float* const (&xrow)[NR], const float* w, bf16* const (&orow)[NR], int lane) {
    const GAS f32x4* wr = (const GAS f32x4*)w + lane;
    f32x4 v[NR][4];
#pragma unroll
    for (int r = 0; r < NR; ++r) { const GAS f32x4* xr = (const GAS f32x4*)xrow[r] + lane;
#pragma unroll
        for (int j = 0; j < 4; ++j) v[r][j] = xr[64 * j]; }
    f32x4 ww[4];
#pragma unroll
    for (int j = 0; j < 4; ++j) ww[j] = wr[64 * j];
#pragma unroll
    for (int r = 0; r < NR; ++r) {
        float s_ = 0.f;
#pragma unroll
        for (int j = 0; j < 4; ++j) s_ += (v[r][j].x * v[r][j].x + v[r][j].y * v[r][j].y) + (v[r][j].z * v[r][j].z + v[r][j].w * v[r][j].w);
        const float rs = __builtin_amdgcn_rsqf(wave_sum(s_) * (1.f / DMODEL) + EPS);
        GAS v2u* o8 = (GAS v2u*)orow[r] + lane;
#pragma unroll
        for (int j = 0; j < 4; ++j) { v2u o; o.x = pk2(v[r][j].x * rs * ww[j].x, v[r][j].y * rs * ww[j].y); o.y = pk2(v[r][j].z * rs * ww[j].z, v[r][j].w * rs * ww[j].w); o8[64 * j] = o; }
    }
}
DI void p0_prologue(Frame& F) {
    LAS float* scr = (LAS float*)(F.lds + F.wave * 16384);
    const int gw = F.vcu * NWAVES + F.wave, NGW = F.G * NWAVES;
    const float* w_in = F.in[2];
    bf16* WIN = (bf16*)(F.ws + WS_WIN);
    constexpr int I1 = 16 * 64, I2 = 16 * 24, I3 = 16, NITEMS = I1 + I2 + I3;
    for (int it = gw; it < NITEMS; it += NGW) {
        int r = it;
        if (r < I1) { p0_transpose_item(w_in, 2832, 64, WIN, 1024, 0, 1, scr, r, F.lane); continue; } r -= I1;
        if (r < I2) { p0_transpose_item(w_in + 2064, 2832, 24, WIN, 1024, 2048, 1, scr, r, F.lane); continue; } r -= I2;
        p0_transpose_item(w_in + 2048, 2832, 1, WIN, 1024, 2816, 1, scr, r, F.lane);
    }
    { const int gt = F.vcu * NTHREADS + F.tid, GT = F.G * NTHREADS; GAS v4u* z = (GAS v4u*)(WIN + (size_t)2848 * 1024);
      for (int i = gt; i < 224 * 1024 * 2 / 16; i += GT) z[i] = (v4u){0u, 0u, 0u, 0u}; }
    bf16* XN = (bf16*)(F.ws + WS_XN);
    for (int m = gw; m < TT; m += 2 * NGW) { const int m1 = (m + NGW < TT) ? m + NGW : m;
        const float* const xr[2] = {F.in[0] + (size_t)m * DMODEL, F.in[0] + (size_t)m1 * DMODEL}; bf16* const orw[2] = {XN + (size_t)m * DMODEL, XN + (size_t)m1 * DMODEL};
        rms_rows_to_bf16<2>(xr, F.in[1], orw, F.lane); }
}

struct EpiProj {
    static constexpr bool PERM = true, AFTER_DRAIN = false;
    bf16 *qkva, *za, *qkvb; float* gates;
    DI void operator()(const pg8::f32x4 (&acc)[2][2][4][2], const pg8::Unit& u, int wr, int wc, int fr, int fq) const {
        const int row0 = u.pm * 256 + wr * 64 + fr;
        if (u.pn == 11) {
            if (wc == 0 && fq < 2) {
#pragma unroll
                for (int ai = 0; ai < 2; ++ai)
#pragma unroll
                    for (int m = 0; m < 4; ++m) { float* rp = gates + (size_t)(row0 + ai * 128 + m * 16) * 16 + 8 * fq;
                        *(pg8::f32x4*)(rp) = acc[ai][0][m][0]; *(pg8::f32x4*)(rp + 4) = acc[ai][0][m][1]; }
            }
            return;
        }
        bf16* base; int ldc, colt;
        if (u.pn < 6) { base = qkva; ldc = 1536; colt = u.pn * 256; } else if (u.pn < 8) { base = za; ldc = 512; colt = (u.pn - 6) * 256; } else { base = qkvb; ldc = 768; colt = (u.pn - 8) * 256; }
        const int col0 = colt + wc * 32 + 8 * fq;
#pragma unroll
        for (int ai = 0; ai < 2; ++ai)
#pragma unroll
            for (int m = 0; m < 4; ++m) { bf16* rowp = base + (size_t)(row0 + ai * 128 + m * 16) * ldc + col0;
#pragma unroll
                for (int bj = 0; bj < 2; ++bj) { const pg8::f32x4 v0 = acc[ai][bj][m][0], v1 = acc[ai][bj][m][1]; pg8::u32x4 w;
                    w.x = pg8::cvt_pk_bf16(v0[0], v0[1]); w.y = pg8::cvt_pk_bf16(v0[2], v0[3]); w.z = pg8::cvt_pk_bf16(v1[0], v1[1]); w.w = pg8::cvt_pk_bf16(v1[2], v1[3]);
                    *(pg8::u32x4*)(rowp + bj * 128) = w; } }
    }
};
struct EpiResid {
    static constexpr bool PERM = false, AFTER_DRAIN = false;
    const float* x; float* x1;
    DI void operator()(const pg8::f32x4 (&acc)[2][2][4][2], const pg8::Unit& u, int wr, int wc, int fr, int fq) const {
        const int row0 = u.pm * 256 + wr * 64 + fr, col0 = u.pn * 256 + wc * 32 + 4 * fq;
#pragma unroll
        for (int ai = 0; ai < 2; ++ai)
#pragma unroll
            for (int m = 0; m < 4; ++m) { const size_t off = (size_t)(row0 + ai * 128 + m * 16) * DMODEL + col0;
#pragma unroll
                for (int bj = 0; bj < 2; ++bj)
#pragma unroll
                    for (int n = 0; n < 2; ++n) { const pg8::f32x4 b = *(const pg8::f32x4*)(x + off + bj * 128 + n * 16); *(pg8::f32x4*)(x1 + off + bj * 128 + n * 16) = b + acc[ai][bj][m][n]; } }
    }
};
struct EpiGU {
    static constexpr bool PERM = true, AFTER_DRAIN = false;
    bf16* hid; const float* wsc; float ainv;
    DI void operator()(const pg8::i32x4 (&acc)[2][2][4][2], const pg8::Unit& u, int wr, int wc, int fr, int fq) const {
        const int row0 = u.pm * 256 + wr * 64 + fr; const int jt = u.pn & 3;
        const int ff0 = jt * 128 + wc * 16 + 4 * fq;
        const float* ws_ = wsc + u.ex * 1024 + jt * 256 + wc * 32 + 8 * fq;
        f32x4 s0[2], s1[2];
#pragma unroll
        for (int bj = 0; bj < 2; ++bj) { s0[bj] = *(const f32x4*)(ws_ + bj * 128) * ainv; s1[bj] = *(const f32x4*)(ws_ + bj * 128 + 4) * ainv; }
#pragma unroll
        for (int ai = 0; ai < 2; ++ai)
#pragma unroll
            for (int m = 0; m < 4; ++m) { bf16* rowp = hid + (size_t)(row0 + ai * 128 + m * 16) * FFE + ff0;
#pragma unroll
                for (int bj = 0; bj < 2; ++bj) { const pg8::i32x4 a0 = acc[ai][bj][m][0], a1 = acc[ai][bj][m][1];
                    const float g0 = (float)a0[0] * s0[bj][0], u0 = (float)a0[1] * s0[bj][1], g1 = (float)a0[2] * s0[bj][2], u1 = (float)a0[3] * s0[bj][3];
                    const float g2 = (float)a1[0] * s1[bj][0], u2 = (float)a1[1] * s1[bj][1], g3 = (float)a1[2] * s1[bj][2], u3 = (float)a1[3] * s1[bj][3];
                    v2u w; w.x = pg8::cvt_pk_bf16(siluf(g0) * u0, siluf(g1) * u1); w.y = pg8::cvt_pk_bf16(siluf(g2) * u2, siluf(g3) * u3);
                    *(v2u*)(rowp + bj * 64) = w; } }
    }
};
struct EpiY {
    static constexpr bool PERM = true, AFTER_DRAIN = false;
    bf16* y;
    DI void operator()(const pg8::f32x4 (&acc)[2][2][4][2], const pg8::Unit& u, int wr, int wc, int fr, int fq) const {
        const int row0 = u.pm * 256 + wr * 64 + fr; const int col0 = (u.pn & 3) * 256 + wc * 32 + 8 * fq;
#pragma unroll
        for (int ai = 0; ai < 2; ++ai)
#pragma unroll
            for (int m = 0; m < 4; ++m) { bf16* rowp = y + (size_t)(row0 + ai * 128 + m * 16) * DMODEL + col0;
#pragma unroll
                for (int bj = 0; bj < 2; ++bj) { const pg8::f32x4 v0 = acc[ai][bj][m][0], v1 = acc[ai][bj][m][1]; pg8::u32x4 w;
                    w.x = pg8::cvt_pk_bf16(v0[0], v0[1]); w.y = pg8::cvt_pk_bf16(v0[2], v0[3]); w.z = pg8::cvt_pk_bf16(v1[0], v1[1]); w.w = pg8::cvt_pk_bf16(v1[2], v1[3]);
                    *(pg8::u32x4*)(rowp + bj * 128) = w; } }
    }
};
constexpr int ETAB_OFF = 131072;
struct MoeOrder {
    const LAS unsigned* etab; int G, c, esplit, pnoff;
    DI bool next(int i, pg8::Unit& u) const {
        if (G % 8 != 0) {
            int L = i * G + c;
            for (int e = 0; e < NEXP; ++e) { const int n4 = 4 * (int)etab[2 * e + 1]; if (L < n4) { u.pm = (int)etab[2 * e] + (L >> 2); u.pn = (e < esplit ? 4 * e : pnoff + 4 * (e - esplit)) + (L & 3); u.ex = e; u.tq = L >> 2; return true; } L -= n4; }
            return false; }
        const int x = c & 7; int L = i * (G >> 3) + (c >> 3);
#pragma unroll
        for (int q = 0; q < NEXP / 8; ++q) { const int e = x + 8 * q; const int n4 = 4 * (int)etab[2 * e + 1];
            if (L < n4) { u.pm = (int)etab[2 * e] + (L >> 2); u.pn = (e < esplit ? 4 * e : pnoff + 4 * (e - esplit)) + (L & 3); u.ex = e; u.tq = L >> 2; return true; } L -= n4; }
        return false; }
    DI void a_ready(const pg8::Unit&) const {}
    DI void done(const pg8::Unit&) const {}
};
struct MoeRows {
    const int* list; const LAS unsigned* etab;
    DI int row(const pg8::Unit& u, int r) const {
        const int slot = u.tq * 256 + r, e = u.ex; if (slot >= (int)etab[64 + e]) return 0;
        const LAS unsigned* sp = etab + 96 + 8 * e; int sb = 0;
#pragma unroll
        for (int q = 1; q < 8; ++q) sb += (slot >= (int)sp[q]) ? 1 : 0;
        return list[(size_t)(e * 8 + sb) * TT + (slot - (int)sp[sb])]; }
};

DI void p2_rope(Frame& F) {
    const int gw = F.vcu * NWAVES + F.wave, NGW = F.G * NWAVES, lane = F.lane;
    const bf16* QKVB = (const bf16*)(F.ws + WS_QKVB);
    bf16* QR = (bf16*)((unsigned char*)F.out + DO_QR); bf16* KR = (bf16*)((unsigned char*)F.out + DO_KR); bf16* VR = (bf16*)((unsigned char*)F.out + DO_VR);
    const int pi = lane & 31, hsel = lane >> 5;
    const float qw0 = F.in[7][2 * pi], qw1 = F.in[7][2 * pi + 1], kw0 = F.in[8][2 * pi], kw1 = F.in[8][2 * pi + 1];
    const float invf = exp2f(-(float)(2 * (pi & 15)) * (13.287712379549449f / 32.0f));
    constexpr float C2 = 0.125f * 1.4426950408889634f;
    constexpr int NB4 = 4;
    for (int t0 = gw; t0 < TT; t0 += NB4 * NGW) {
        unsigned w[NB4][5], vw[NB4];
#pragma unroll
        for (int u = 0; u < NB4; ++u) { const int t = t0 + u * NGW; const unsigned* src = (const unsigned*)(QKVB + (size_t)(t < TT ? t : t0) * 768);
#pragma unroll
            for (int j = 0; j < 5; ++j) w[u][j] = src[(2 * j + hsel) * 32 + pi];
            vw[u] = src[320 + lane]; }
#pragma unroll
        for (int u = 0; u < NB4; ++u) {
            const int t = t0 + u * NGW; if (t >= TT) break;
            const int s_ = t & (SEQ - 1); const float pos = (pi < 16) ? (float)(s_ >> 6) : (float)(s_ & 63);
            const float ang = pos * invf;
            const float rev = ang * 0.15915494309189535f;
            const float sn = __builtin_amdgcn_sinf(rev), cs = __builtin_amdgcn_cosf(rev);
#pragma unroll
            for (int j = 0; j < 5; ++j) {
                const int head = 2 * j + hsel;
                const float x0 = bflo(w[u][j]), x1 = bfhi(w[u][j]);
                float ss = x0 * x0 + x1 * x1;
#pragma unroll
                for (int o = 1; o < 32; o <<= 1) ss += __shfl_xor(ss, o);
                const float rs = __builtin_amdgcn_rsqf(ss * (1.f / 64.f) + EPS);
                const bool isq = head < 8;
                const float y0 = x0 * rs * (isq ? qw0 : kw0), y1 = x1 * rs * (isq ? qw1 : kw1);
                float o0 = y0 * cs - y1 * sn, o1 = y0 * sn + y1 * cs;
                if (isq) { o0 *= C2; o1 *= C2; ((unsigned*)(QR + (size_t)t * 512))[head * 32 + pi] = pk2(o0, o1); }
                else { const int hk = head - 8, bq = t >> 13, sq = t & (SEQ - 1);
                    ((unsigned*)(KR + ((size_t)((bq * 2 + hk) * 128 + (sq >> 6)) * 8 + (pi >> 2)) * 512 + (sq & 63) * 8))[pi & 3] = pk2(o0, o1); }
            }
            { const int hk = lane >> 5, d = 2 * (lane & 31), bq = t >> 13, sq = t & (SEQ - 1), r = sq & 63;
              ((unsigned*)(VR + ((size_t)((bq * 2 + hk) * 128 + (sq >> 6)) * 8 + (d >> 5) * 4 + (r >> 4)) * 512 + ((r & 15) * 4 + ((d & 31) >> 3)) * 8))[(d & 7) >> 1] = vw[u]; }
        }
    }
}

constexpr int G_KNP = 0, G_QNP = 17408, G_KNTP = 34816, G_VCT = 53248;
constexpr int G_D0 = 71680, G_D1 = 71680 + 19456;
constexpr int GD_TBP = 0, GD_AP = 9216, GD_VEC = 18432;
constexpr int G_LM = 110592;
constexpr int G_GV = G_LM + 32768;
static_assert(G_GV + 2048 <= LDS_BYTES - 64, "gdn pre lds");

#define TRI_ROW(i, LC, LN) { \
        if ((i) + 1 < 64) { _Pragma("unroll") for (int j4 = 0; j4 < ((i) + 1 + 3) / 4 && j4 < 8; ++j4) LN[j4] = *(const LAS f32x4*)(L + ((i) + 1) * 64 + 4 * j4); } \
        _Pragma("unroll") for (int j4 = 8; j4 < ((i) + 3) / 4; ++j4) lt[j4 - 8] = *(const LAS f32x4*)(L + (i) * 64 + 4 * j4); \
        __builtin_amdgcn_sched_barrier(0); \
        f32x2_t a0 = {(lane == (i)) ? 1.0f : 0.0f, 0.f}, a1 = {0.f, 0.f}; \
        _Pragma("unroll") for (int j4 = 0; j4 < ((i) + 3) / 4; ++j4) { const f32x4 l = (j4 < 8) ? LC[j4 & 7] : lt[(j4 - 8) & 7]; \
            f32x2_t l0 = {l.x, (4 * j4 + 1 < (i)) ? l.y : 0.f}, l1 = {(4 * j4 + 2 < (i)) ? l.z : 0.f, (4 * j4 + 3 < (i)) ? l.w : 0.f}; \
            a0 -= l0 * xp[2 * j4]; if (4 * j4 + 2 < (i)) a1 -= l1 * xp[2 * j4 + 1]; } \
        const float a = (a0.x + a0.y) + (a1.x + a1.y); \
        if ((i) & 1) xp[(i) >> 1].y = a; else { xp[(i) >> 1].x = a; xp[(i) >> 1].y = 0.f; } \
        TBP[(REV ? 63 - (i) : (i)) * 72 + pc] = (bf16)(pk2(a * bcol, 0.f) & 0xffffu); \
        __builtin_amdgcn_sched_barrier(0); }
template <bool REV> DI void tri_inverse(LAS float* L, const LAS float* beta, LAS bf16* TBP, int lane) {
    f32x2_t xp[32];
    L = opaque(L); TBP = opaque(TBP); lane = opaque(lane);
    const float bcol = REV ? beta[63 - lane] : beta[lane];
    const int pc = REV ? permcol(63 - lane) : permcol(lane);
    f32x4 la[8], lb[8], lt[8];
#pragma unroll
    for (int ii = 0; ii < 64; ii += 2) { TRI_ROW(ii, la, lb) TRI_ROW(ii + 1, lb, la) }
}
#undef TRI_ROW

DI void gdn_conv(Frame& F, LAS unsigned char* lds, int t384, int b, int h, int n) {
    const bf16* QKVA = (const bf16*)(F.ws + WS_QKVA); const float* convw = F.in[3];
    const int cgp = t384 % 48, rg = t384 / 48, mat = cgp >> 4, cc = (cgp & 15) * 8;
    const int col = mat * 512 + h * 128 + cc;
    float w[5][8];
#pragma unroll
    for (int j = 0; j < 5; ++j) { const f32x4 a = *(const f32x4*)(convw + j * 1536 + col), bq = *(const f32x4*)(convw + j * 1536 + col + 4);
        w[j][0] = a.x; w[j][1] = a.y; w[j][2] = a.z; w[j][3] = a.w; w[j][4] = bq.x; w[j][5] = bq.y; w[j][6] = bq.z; w[j][7] = bq.w; }
    const int a4 = (cc >> 3) & 3, p0 = (cc & ~31) + 16 * (a4 & 1) + 4 * (a4 >> 1);
    const int ra = rg & 3, q0 = (rg >> 2) * 32 + 16 * (ra & 1) + 4 * (ra >> 1);
#pragma unroll
    for (int hf = 0; hf < 2; ++hf) {
        float o[4][8];
#pragma unroll
        for (int r = 0; r < 4; ++r)
#pragma unroll
            for (int c = 0; c < 8; ++c) o[r][c] = 0.f;
#pragma unroll
        for (int i = 0; i < 8; ++i) {
            const int pos = n * 64 + rg * 8 + hf * 4 - 2 + i;
            v4u raw = (v4u){0u, 0u, 0u, 0u};
            if (pos >= 0 && pos < SEQ) raw = *(const v4u*)(QKVA + (size_t)(b * SEQ + pos) * 1536 + col);
            float xin[8] = {bflo(raw.x), bfhi(raw.x), bflo(raw.y), bfhi(raw.y), bflo(raw.z), bfhi(raw.z), bflo(raw.w), bfhi(raw.w)};
#pragma unroll
            for (int j = 0; j < 5; ++j) { const int r = i - j; if (r >= 0 && r < 4) {
#pragma unroll
                for (int c = 0; c < 8; ++c) o[r][c] += w[j][c] * xin[c]; } }
        }
#pragma unroll
        for (int r = 0; r < 4; ++r) {
            float ss = 0.f;
#pragma unroll
            for (int c = 0; c < 8; ++c) { o[r][c] = siluf(o[r][c]); ss += o[r][c] * o[r][c]; }
            ss += __shfl_xor(ss, 1); ss += __shfl_xor(ss, 2); ss += __shfl_xor(ss, 4); ss += __shfl_xor(ss, 8);
            float sc = 1.0f;
            if (mat < 2) { sc = __builtin_amdgcn_rsqf(ss + EPS); if (mat == 0) sc *= 0.08838834764831845f; }
#pragma unroll
            for (int c = 0; c < 8; ++c) o[r][c] *= sc;
        }
        if (mat < 2) {
            LAS unsigned char* tile = lds + (mat == 0 ? G_QNP : G_KNP);
#pragma unroll
            for (int r = 0; r < 4; ++r) { const int c = rg * 8 + hf * 4 + r;
                v2u lo, hi2; lo.x = pk2(o[r][0], o[r][1]); lo.y = pk2(o[r][2], o[r][3]); hi2.x = pk2(o[r][4], o[r][5]); hi2.y = pk2(o[r][6], o[r][7]);
                *(LAS v2u*)(tile + c * 272 + p0 * 2) = lo; *(LAS v2u*)(tile + c * 272 + (p0 + 8) * 2) = hi2; }
        }
        if (mat >= 1) {
#pragma unroll
            for (int c = 0; c < 8; ++c) {
                v2u q4; q4.x = pk2(o[0][c], o[1][c]); q4.y = pk2(o[2][c], o[3][c]);
                if (mat == 1) *(LAS v2u*)(lds + G_KNTP + (cc + c) * 144 + (q0 + 8 * hf) * 2) = q4;
                else *(LAS v2u*)(lds + G_VCT + (cc + c) * 144 + rg * 16 + hf * 8) = q4;
            }
        }
    }
}
DI void gdn_gates(Frame& F, LAS unsigned char* lds, LAS float* gv, int lane, int b, int h, int n) {
    const float* gp = (const float*)(F.ws + WS_GATES) + (size_t)(b * SEQ + n * 64 + lane) * 16;
    const float bfv = gp[h], bbv = gp[4 + h], afv = gp[8 + h], abv = gp[12 + h];
    const float betaf = sigmoidf_(bfv), betab = sigmoidf_(bbv);
    const float xf = afv + F.in[5][h], xb = abv + F.in[5][4 + h];
    const float spf = fmaxf(xf, 0.f) + log1pf(__expf(-fabsf(xf))), spb = fmaxf(xb, 0.f) + log1pf(__expf(-fabsf(xb)));
    const float gf = -__expf(F.in[4][h]) * spf, gb = -__expf(F.in[4][4 + h]) * spb;
    float Gf = gf, Rb = gb;
#pragma unroll
    for (int o = 1; o < 64; o <<= 1) { const float u1 = __shfl_up(Gf, o); if (lane >= o) Gf += u1; const float d1 = __shfl_down(Rb, o); if (lane + o < 64) Rb += d1; }
    gv[lane] = Gf; gv[64 + lane] = Rb; gv[128 + lane] = betaf; gv[192 + lane] = betab;
    const float GfL = __shfl(Gf, 63), Rb0 = __shfl(Rb, 0);
    LAS float* v0 = (LAS float*)(lds + G_D0 + GD_VEC); LAS float* v1 = (LAS float*)(lds + G_D1 + GD_VEC);
    v0[lane] = __expf(Gf); v0[64 + lane] = __expf(GfL - Gf); v1[lane] = __expf(Rb); v1[64 + lane] = __expf(Rb0 - Rb);
    if (lane == 0) { v0[128] = __expf(GfL); v1[128] = __expf(Rb0); }
}
DI void p2_gdn_pre(Frame& F) {
    const int tid = F.tid, lane = F.lane, wave = F.wave;
    int task = F.vcu;
    if (task < 1024) {
        LAS unsigned char* lds = opaque(F.lds);
        const int b = task >> 9, h = (task >> 7) & 3, n = task & 127;
        if (wave >= 2) gdn_conv(F, lds, tid - 128, b, h, n);
        if (wave == 2) gdn_gates(F, lds, (LAS float*)(lds + G_GV), lane, b, h, n);
    }
    __syncthreads();
    int par = 0;
#pragma unroll 1
    for (; task < 1024; task += F.G, par ^= 1) {
        LAS unsigned char* lds = opaque(F.lds);
        const int b = task >> 9, h = (task >> 7) & 3, n = task & 127, bh = b * 4 + h;
        LAS float* gv = (LAS float*)(lds + G_GV + par * 1024);
        LAS float* sGf = gv; LAS float* sRb = gv + 64; LAS float* sBf = gv + 128; LAS float* sBb = gv + 192;
        {
            const int p = wave >> 2, mt = wave & 3, n16 = lane & 15, g = lane >> 4;
            const LAS unsigned char* At = lds + (p == 0 ? G_KNP : G_QNP) + (16 * mt + n16) * 272 + g * 16;
            bf16x8 af[4], bfr[16];
#pragma unroll
            for (int ks = 0; ks < 4; ++ks) af[ks] = *(const LAS bf16x8*)(At + ks * 64);
#pragma unroll
            for (int nt = 0; nt < 4; ++nt)
#pragma unroll
                for (int ks = 0; ks < 4; ++ks) bfr[nt * 4 + ks] = *(const LAS bf16x8*)(lds + G_KNP + (16 * nt + n16) * 272 + g * 16 + ks * 64);
            float Gc[4], Rc[4], Bfc[4], Bbc[4];
#pragma unroll
            for (int r = 0; r < 4; ++r) { const int c = 16 * mt + 4 * g + r; Gc[r] = sGf[c]; Rc[r] = sRb[c]; Bfc[r] = sBf[c]; Bbc[r] = sBb[c]; }
#pragma unroll
            for (int nt = 0; nt < 4; ++nt) {
                f32x4 acc = (f32x4){0.f, 0.f, 0.f, 0.f};
#pragma unroll
                for (int ks = 0; ks < 4; ++ks) acc = __builtin_amdgcn_mfma_f32_16x16x32_bf16(af[ks], bfr[nt * 4 + ks], acc, 0, 0, 0);
                const int s_ = 16 * nt + n16; const float Gs = sGf[s_], Rs = sRb[s_]; const int ps = permcol(s_);
#pragma unroll
                for (int r = 0; r < 4; ++r) {
                    const int c = 16 * mt + 4 * g + r; const float v = acc[r];
                    const float df = __expf(fminf(Gc[r] - Gs, 0.f)), db = __expf(fminf(Rc[r] - Rs, 0.f));
                    if (p == 0) {
                        ((LAS float*)(lds + G_LM))[c * 64 + s_] = Bfc[r] * v * df;
                        ((LAS float*)(lds + G_LM + 16384))[(63 - c) * 64 + (63 - s_)] = Bbc[r] * v * db;
                    } else {
                        ((LAS bf16*)(lds + G_D0 + GD_AP))[c * 72 + ps] = (bf16)(pk2(s_ <= c ? v * df : 0.f, 0.f) & 0xffffu);
                        ((LAS bf16*)(lds + G_D1 + GD_AP))[c * 72 + ps] = (bf16)(pk2(s_ >= c ? v * db : 0.f, 0.f) & 0xffffu);
                    }
                }
            }
        }
        __syncthreads();
        GAS v4u* gd0 = (GAS v4u*)(F.ws + WS_GD + (size_t)((bh * 2 + 0) * 128 + n) * GDN_D_BYTES);
        GAS v4u* gd1 = (GAS v4u*)(F.ws + WS_GD + (size_t)((bh * 2 + 1) * 128 + n) * GDN_D_BYTES);
        {
            GAS v4u* gsh = (GAS v4u*)(F.ws + WS_GSH + (size_t)(bh * 128 + n) * GDN_SH_BYTES);
#pragma unroll 3
            for (int i = tid; i < (int)(GDN_SH_BYTES / 16); i += NTHREADS) gsh[i] = *(const LAS v4u*)(lds + i * 16);
#pragma unroll 1
            for (int i = GD_AP / 16 + tid; i < (int)(GDN_D_BYTES / 16); i += NTHREADS) { gd0[i] = *(const LAS v4u*)(lds + G_D0 + i * 16); gd1[i] = *(const LAS v4u*)(lds + G_D1 + i * 16); }
        }
        __syncthreads();
        if (wave == 0) { tri_inverse<false>((LAS float*)(lds + G_LM), sBf, (LAS bf16*)(lds + G_D0 + GD_TBP), lane);
#pragma unroll 3
            for (int i = lane; i < GD_AP / 16; i += 64) gd0[i] = *(const LAS v4u*)(lds + G_D0 + i * 16); }
        else if (wave == 1) { tri_inverse<true>((LAS float*)(lds + G_LM + 16384), sBb, (LAS bf16*)(lds + G_D1 + GD_TBP), lane);
#pragma unroll 3
            for (int i = lane; i < GD_AP / 16; i += 64) gd1[i] = *(const LAS v4u*)(lds + G_D1 + i * 16); }
        else {
            const int t2 = task + F.G;
            if (t2 < 1024) { const int b2 = t2 >> 9, h2 = (t2 >> 7) & 3, n2 = t2 & 127;
                gdn_conv(F, lds, tid - 128, b2, h2, n2);
                if (wave == 2) gdn_gates(F, lds, (LAS float*)(lds + G_GV + (par ^ 1) * 1024), lane, b2, h2, n2); }
        }
        __syncthreads();
    }
}

DI bf16x8 pack8(const f32x4 a, const f32x4 b) {
    v4u p; p.x = pk2(a[0], a[1]); p.y = pk2(a[2], a[3]); p.z = pk2(b[0], b[1]); p.w = pk2(b[2], b[3]); return __builtin_bit_cast(bf16x8, p);
}
DI void small_weights(Frame& F, int gw, int NGW) {
    LAS float* scr = (LAS float*)(F.lds + F.wave * 16384);
    bf16* WOUT = (bf16*)(F.ws + WS_WOUT);
    for (int it = gw; it < 16 * 32; it += NGW) p0_transpose_item(F.in[9], 1024, 32, WOUT, 1024, 0, 1, scr, it, F.lane);
    bf16* WRH = (bf16*)(F.ws + WS_WR); bf16* WRL = WRH + 48 * 1024; const float* wrg = F.in[11]; const float* wre = F.in[12];
    for (int i = gw * 64 + F.lane; i < 48 * 1024; i += NGW * 64) { const int j = i >> 10, k = i & 1023; float v = 0.f; if (j < 4) v = wrg[k * 4 + j]; else if (j < 36) v = wre[k * 32 + (j - 4)];
        const unsigned h = f2bf(v); const float hv = __builtin_bit_cast(float, h << 16); WRH[i] = (bf16)h; WRL[i] = (bf16)f2bf(v - hv); }
}
DI unsigned char* wgu_ptr(Frame& F, int e) { return F.ws + (e < WGU_SPLIT ? WS_WGU0 + (size_t)e * MiB : WS_WGU1 + (size_t)(e - WGU_SPLIT) * MiB); }
DI bf16* wd_ptr(Frame& F, int e) { return (bf16*)((unsigned char*)F.out + (e < WD_SPLIT ? DO_WD0 + (size_t)e * MiB : DO_WD1 + (size_t)(e - WD_SPLIT) * MiB)); }
DI void wgu_q_strip(const float* W, unsigned char* WQ, float* wsc, int mat, int nb, LAS unsigned char* lds, int wave, int lane) {
    LAS float* scr = (LAS float*)(lds + wave * 16384); LAS float* cmx = (LAS float*)(lds + 8 * 16384);
    const int n0 = 32 * nb, r8 = lane >> 3, c4 = (lane & 7) * 4, kw = 128 * wave;
    f32x4 mx = (f32x4){0.f, 0.f, 0.f, 0.f};
#pragma unroll
    for (int i = 0; i < 16; ++i) { const f32x4 v = *(const f32x4*)(W + (size_t)(kw + 8 * i + r8) * 512 + n0 + c4);
        mx.x = fmaxf(mx.x, fabsf(v.x)); mx.y = fmaxf(mx.y, fabsf(v.y)); mx.z = fmaxf(mx.z, fabsf(v.z)); mx.w = fmaxf(mx.w, fabsf(v.w)); }
#pragma unroll
    for (int o = 8; o < 64; o <<= 1) { mx.x = fmaxf(mx.x, __shfl_xor(mx.x, o)); mx.y = fmaxf(mx.y, __shfl_xor(mx.y, o)); mx.z = fmaxf(mx.z, __shfl_xor(mx.z, o)); mx.w = fmaxf(mx.w, __shfl_xor(mx.w, o)); }
    if (lane < 8) *(LAS f32x4*)(cmx + wave * 32 + c4) = mx;
    __syncthreads();
    float sq[4];
#pragma unroll
    for (int j = 0; j < 4; ++j) { const int n = (lane >> 3) + 8 * j; float m = cmx[n];
#pragma unroll
        for (int w = 1; w < 8; ++w) m = fmaxf(m, cmx[w * 32 + n]);
        sq[j] = m > 0.f ? 127.0f / m : 0.f;
        if (wave == 0 && (lane & 7) == 0) wsc[2 * (n0 + n) + mat] = m * (1.0f / 127.0f); }
    const int c = lane & 7;
#pragma unroll
    for (int kb = 0; kb < 2; ++kb) {
        const int k0 = kw + 64 * kb;
        f32x4 v[8];
#pragma unroll
        for (int i = 0; i < 8; ++i) v[i] = *(const f32x4*)(W + (size_t)(k0 + 8 * i + r8) * 512 + n0 + c4);
#pragma unroll
        for (int i = 0; i < 8; ++i) { LAS float* d = scr + (8 * i + r8) * 33 + c4; d[0] = v[i].x; d[1] = v[i].y; d[2] = v[i].z; d[3] = v[i].w; }
        asm volatile("s_waitcnt lgkmcnt(0)" ::: "memory");
#pragma unroll
        for (int j = 0; j < 4; ++j) { const int n = (lane >> 3) + 8 * j; const LAS float* t = scr + (8 * c) * 33 + n;
            v2u o; o.x = q8x4(t[0 * 33], t[1 * 33], t[2 * 33], t[3 * 33], sq[j]); o.y = q8x4(t[4 * 33], t[5 * 33], t[6 * 33], t[7 * 33], sq[j]);
            *(GAS v2u*)(WQ + (size_t)(2 * (n0 + n) + mat) * 1024 + k0 + 8 * c) = o; }
        asm volatile("s_waitcnt lgkmcnt(0)" ::: "memory");
    }
    __syncthreads();
}
DI void moe_weights(Frame& F, int cb, int ncb) {
    for (int it = cb; it < NEXP * 32; it += ncb) { const int e = it >> 5, mat = (it >> 4) & 1, nb = it & 15;
        wgu_q_strip((mat ? F.in[14] : F.in[13]) + (size_t)e * 1024 * 512, wgu_ptr(F, e), (float*)(F.ws + WS_WSC) + e * 1024, mat, nb, F.lds, F.wave, F.lane); }
    LAS float* scr = (LAS float*)(F.lds + F.wave * 16384);
    constexpr int ID = 8 * 32; const int gw = cb * NWAVES + F.wave, NGW = ncb * NWAVES;
    for (int it = gw; it < NEXP * ID; it += NGW) { const int e = it / ID, r = it % ID;
        p0_transpose_item(F.in[15] + (size_t)e * 512 * 1024, 1024, 32, wd_ptr(F, e), 512, 0, 1, scr, r, F.lane); }
}

constexpr int SC_SLOT = 78848, SC_VCT = 53248, SC_D = 55552, SC_NCH = 11;
static_assert(2 * SC_SLOT <= LDS_BYTES, "scan slots");
DI void sc_issue(v4u (&R)[SC_NCH], const unsigned char* ws, const unsigned (&delta)[SC_NCH], const unsigned (&dmask)[SC_NCH], unsigned shbase, unsigned ddiff) {
#pragma unroll
    for (int j = 0; j < SC_NCH; ++j) { const unsigned off = shbase + delta[j] + (dmask[j] & ddiff);
#ifdef SC_PLAIN_LOADS
        R[j] = *(const v4u*)(ws + off); }
#else
        asm volatile("global_load_dwordx4 %0, %1, %2" : "=v"(R[j]) : "v"(off), "s"(ws) : "memory"); }
#endif
}
#ifdef SC_PLAIN_LOADS
#define SC_WAIT(R, n) do {} while (0)
#else
#define SC_WAIT(R, n) asm volatile("s_waitcnt vmcnt(" #n ")" : "+v"(R[0]), "+v"(R[1]), "+v"(R[2]), "+v"(R[3]), "+v"(R[4]), "+v"(R[5]), "+v"(R[6]), "+v"(R[7]), "+v"(R[8]), "+v"(R[9]), "+v"(R[10]) :: "memory")
#endif
DI void sc_write(const v4u (&R)[SC_NCH], LAS unsigned char* slot, int lid) {
#pragma unroll
    for (int j = 0; j < SC_NCH; ++j) *(LAS v4u*)(slot + 16 * (lid + 448 * j)) = R[j];
}
DI void p4_scan(Frame& F) {
    const int lane = F.lane, n16 = lane & 15, g = lane >> 4, wave = F.wave;
    {
        volatile LAS int* tsk = (volatile LAS int*)(F.lds + MISC_OFF + 32);
        if (F.tid == 0) {
            unsigned* q = (unsigned*)(F.ws + WS_CTL) + CW_SCANQ; const unsigned xcc = xb_xcc_id() & 7u; int task = -1;
            for (unsigned t = 0; t < 8 && task < 0; ++t) { const unsigned y = (xcc + t) & 7u; const unsigned j = xb_add(q + 64 * y, 1u); if (j < 16u) task = (int)(y * 16 + j); }
            *tsk = task; if (task < 0) tsk[1] = (int)xb_add(q + 64 * 8, 1u);
        }
        __syncthreads();
    }
    const int task = *(volatile LAS int*)(F.lds + MISC_OFF + 32);
    if (task < 0) {
        if (F.G > 128) { const int cgw = *(volatile LAS int*)(F.lds + MISC_OFF + 36) * NWAVES + wave, cng = (F.G - 128) * NWAVES; small_weights(F, cgw, cng); moe_weights(F, *(volatile LAS int*)(F.lds + MISC_OFF + 36), F.G - 128); }
        return; }
    const int chain = 2 * (task >> 4) + ((task & 15) >> 3), e = task & 7;
    const int bh = chain >> 1, dir = chain & 1, b = bh >> 2, h = bh & 3;
    LAS unsigned char* lds = opaque(F.lds);
    if (wave != 0) {
        const int lid = (wave - 1) * 64 + lane;
        const unsigned sh0 = (unsigned)(WS_GSH + (size_t)(bh * 128) * GDN_SH_BYTES), d0 = (unsigned)(WS_GD + (size_t)((bh * 2 + dir) * 128) * GDN_D_BYTES);
        unsigned delta[SC_NCH], dmask[SC_NCH];
#pragma unroll
        for (int j = 0; j < SC_NCH; ++j) { const int c = lid + 448 * j;
            delta[j] = (c < 3328) ? 16u * c : ((c < 3472) ? (unsigned)(G_VCT + 16 * e * 144 + 16 * (c - 3328)) : 16u * (c - 3472));
            dmask[j] = (c < 3472) ? 0u : 0xffffffffu; }
        v4u R0[SC_NCH], R1[SC_NCH], R2[SC_NCH];
#define SC_SRC(st) const int n_ = (dir == 0) ? ((st) < 128 ? (st) : 127) : ((st) < 128 ? 127 - (st) : 0); \
                   const unsigned shb_ = sh0 + (unsigned)n_ * (unsigned)GDN_SH_BYTES, ddf_ = (d0 + (unsigned)n_ * (unsigned)GDN_D_BYTES) - shb_;
        { SC_SRC(0) sc_issue(R0, F.ws, delta, dmask, shb_, ddf_); }
        { SC_SRC(1) sc_issue(R1, F.ws, delta, dmask, shb_, ddf_); }
        { SC_SRC(2) sc_issue(R2, F.ws, delta, dmask, shb_, ddf_); }
#define SC_BODY(R, st) { SC_WAIT(R, 22); sc_write(R, lds + ((st) & 1) * SC_SLOT, lid); { SC_SRC((st) + 3) sc_issue(R, F.ws, delta, dmask, shb_, ddf_); } \
                        asm volatile("s_waitcnt lgkmcnt(0)" ::: "memory"); __builtin_amdgcn_s_barrier(); }
#pragma unroll 1
        for (int s0 = 0; s0 < 126; s0 += 3) { SC_BODY(R0, s0) SC_BODY(R1, s0 + 1) SC_BODY(R2, s0 + 2) }
        SC_BODY(R0, 126) SC_BODY(R1, 127)
        SC_WAIT(R0, 0); SC_WAIT(R1, 0); SC_WAIT(R2, 0);
#undef SC_BODY
#undef SC_SRC
        return;
    }
    bf16* Odir = (bf16*)((unsigned char*)F.out + (dir == 0 ? DO_OF : DO_OB));
    f32x4 S[8];
#pragma unroll
    for (int i = 0; i < 8; ++i) S[i] = (f32x4){0.f, 0.f, 0.f, 0.f};
    bf16x8 Sb[4];
#pragma unroll
    for (int i = 0; i < 4; ++i) Sb[i] = (bf16x8){0, 0, 0, 0, 0, 0, 0, 0};
    const unsigned aoff272 = n16 * 272 + g * 16, aoff144 = n16 * 144 + g * 16;
    const unsigned lds0 = (unsigned)(uintptr_t)lds;
#define SB_() __builtin_amdgcn_sched_barrier(0)
#define LDR128(dst, base, off) asm volatile("ds_read_b128 %0, %1 offset:%2" : "=v"(dst) : "v"(base), "i"(off) : "memory")
#define LDR64(dst, base, off) asm volatile("ds_read_b64 %0, %1 offset:%2" : "=v"(dst) : "v"(base), "i"(off) : "memory")
#define LDR32(dst, base, off) asm volatile("ds_read_b32 %0, %1 offset:%2" : "=v"(dst) : "v"(base), "i"(off) : "memory")
#pragma unroll 1
    for (int step = 0; step < 128; ++step) {
        __builtin_amdgcn_s_barrier();
        asm volatile("" ::: "memory");
        const int n = dir == 0 ? step : 127 - step;
        const unsigned slot = lds0 + (unsigned)(step & 1) * SC_SLOT;
        const unsigned bK = slot + G_KNP + aoff272, bQ = slot + G_QNP + aoff272, bKT = slot + G_KNTP + aoff144, bT = slot + SC_D + GD_TBP + aoff144;
        const unsigned bV = slot + SC_VCT + n16 * 144 + g * 8, bvec = slot + SC_D + GD_VEC + g * 16, bd = slot + SC_D + GD_VEC;
        f32x4 eG[4], ks[4]; v2u vv[4]; float dch; bf16x8 fa[16];
        LDR128(eG[0], bvec, 0); LDR128(eG[1], bvec, 64); LDR128(eG[2], bvec, 128); LDR128(eG[3], bvec, 192);
        LDR128(ks[0], bvec, 256); LDR128(ks[1], bvec, 320); LDR128(ks[2], bvec, 384); LDR128(ks[3], bvec, 448);
        LDR32(dch, bd, 512);
        LDR64(vv[0], bV, 0); LDR64(vv[1], bV, 32); LDR64(vv[2], bV, 64); LDR64(vv[3], bV, 96);
#pragma unroll
        for (int m = 0; m < 4; ++m) { LDR128(fa[m * 4 + 0], bK, m * 4352 + 0); LDR128(fa[m * 4 + 1], bK, m * 4352 + 64); LDR128(fa[m * 4 + 2], bK, m * 4352 + 128); LDR128(fa[m * 4 + 3], bK, m * 4352 + 192); }
        bf16x8 fq[16];
#pragma unroll
        for (int m = 0; m < 4; ++m) { LDR128(fq[m * 4 + 0], bQ, m * 4352 + 0); LDR128(fq[m * 4 + 1], bQ, m * 4352 + 64); LDR128(fq[m * 4 + 2], bQ, m * 4352 + 128); LDR128(fq[m * 4 + 3], bQ, m * 4352 + 192); }
        asm volatile("s_waitcnt lgkmcnt(15)" : "+v"(eG[0]), "+v"(eG[1]), "+v"(eG[2]), "+v"(eG[3]), "+v"(ks[0]), "+v"(ks[1]), "+v"(ks[2]), "+v"(ks[3]), "+v"(dch), "+v"(vv[0]), "+v"(vv[1]), "+v"(vv[2]), "+v"(vv[3]),
                     "+v"(fa[0]), "+v"(fa[1]), "+v"(fa[2]), "+v"(fa[3]), "+v"(fa[4]), "+v"(fa[5]), "+v"(fa[6]), "+v"(fa[7]), "+v"(fa[8]), "+v"(fa[9]), "+v"(fa[10]), "+v"(fa[11]), "+v"(fa[12]), "+v"(fa[13]), "+v"(fa[14]), "+v"(fa[15]) :: "memory");
        SB_();
        f32x4 KS[4];
#pragma unroll
        for (int m = 0; m < 4; ++m) KS[m] = (f32x4){0.f, 0.f, 0.f, 0.f};
#pragma unroll
        for (int i = 0; i < 4; ++i)
#pragma unroll
            for (int m = 0; m < 4; ++m) KS[m] = __builtin_amdgcn_mfma_f32_16x16x32_bf16(fa[m * 4 + i], Sb[i], KS[m], 0, 0, 0);
        SB_();
        bf16x8 ft[8];
#pragma unroll
        for (int m = 0; m < 4; ++m) { LDR128(ft[m * 2 + 0], bT, m * 2304 + 0); LDR128(ft[m * 2 + 1], bT, m * 2304 + 64); }
        asm volatile("s_waitcnt lgkmcnt(8)" : "+v"(fq[0]), "+v"(fq[1]), "+v"(fq[2]), "+v"(fq[3]), "+v"(fq[4]), "+v"(fq[5]), "+v"(fq[6]), "+v"(fq[7]), "+v"(fq[8]), "+v"(fq[9]), "+v"(fq[10]), "+v"(fq[11]), "+v"(fq[12]), "+v"(fq[13]), "+v"(fq[14]), "+v"(fq[15]) :: "memory");
        SB_();
        f32x4 o[4];
#pragma unroll
        for (int m = 0; m < 4; ++m) o[m] = (f32x4){0.f, 0.f, 0.f, 0.f};
#pragma unroll
        for (int i = 0; i < 4; ++i)
#pragma unroll
            for (int m = 0; m < 4; ++m) o[m] = __builtin_amdgcn_mfma_f32_16x16x32_bf16(fq[m * 4 + i], Sb[i], o[m], 0, 0, 0);
        f32x4 rr[4];
#pragma unroll
        for (int m = 0; m < 4; ++m) { rr[m][0] = bflo(vv[m].x) - eG[m][0] * KS[m][0]; rr[m][1] = bfhi(vv[m].x) - eG[m][1] * KS[m][1]; rr[m][2] = bflo(vv[m].y) - eG[m][2] * KS[m][2]; rr[m][3] = bfhi(vv[m].y) - eG[m][3] * KS[m][3]; }
        bf16x8 rb[2]; rb[0] = pack8(rr[0], rr[1]); rb[1] = pack8(rr[2], rr[3]);
        SB_();
        bf16x8 fk[16];
#pragma unroll
        for (int jt = 0; jt < 8; ++jt) { LDR128(fk[jt * 2 + 0], bKT, jt * 2304 + 0); LDR128(fk[jt * 2 + 1], bKT, jt * 2304 + 64); }
        asm volatile("s_waitcnt lgkmcnt(15)" : "+v"(ft[0]), "+v"(ft[1]), "+v"(ft[2]), "+v"(ft[3]), "+v"(ft[4]), "+v"(ft[5]), "+v"(ft[6]), "+v"(ft[7]) :: "memory");
        SB_();
        f32x4 vn[4];
#pragma unroll
        for (int m = 0; m < 4; ++m) vn[m] = (f32x4){0.f, 0.f, 0.f, 0.f};
#pragma unroll
        for (int i = 0; i < 2; ++i)
#pragma unroll
            for (int m = 0; m < 4; ++m) vn[m] = __builtin_amdgcn_mfma_f32_16x16x32_bf16(ft[m * 2 + i], rb[i], vn[m], 0, 0, 0);
#pragma unroll
        for (int m = 0; m < 4; ++m) o[m] = o[m] * eG[m];
#pragma unroll
        for (int jt = 0; jt < 8; ++jt) S[jt] = S[jt] * dch;
        SB_();
        bf16x8 fp[8];
#pragma unroll
        for (int m = 0; m < 4; ++m) { LDR128(fp[m * 2 + 0], bT, GD_AP + m * 2304 + 0); LDR128(fp[m * 2 + 1], bT, GD_AP + m * 2304 + 64); }
        bf16x8 vnb[2]; vnb[0] = pack8(vn[0], vn[1]); vnb[1] = pack8(vn[2], vn[3]);
        bf16x8 vs[2]; vs[0] = pack8(vn[0] * ks[0], vn[1] * ks[1]); vs[1] = pack8(vn[2] * ks[2], vn[3] * ks[3]);
        asm volatile("s_waitcnt lgkmcnt(8)" : "+v"(fk[0]), "+v"(fk[1]), "+v"(fk[2]), "+v"(fk[3]), "+v"(fk[4]), "+v"(fk[5]), "+v"(fk[6]), "+v"(fk[7]), "+v"(fk[8]), "+v"(fk[9]), "+v"(fk[10]), "+v"(fk[11]), "+v"(fk[12]), "+v"(fk[13]), "+v"(fk[14]), "+v"(fk[15]) :: "memory");
        SB_();
#pragma unroll
        for (int i = 0; i < 2; ++i)
#pragma unroll
            for (int jt = 0; jt < 8; ++jt) S[jt] = __builtin_amdgcn_mfma_f32_16x16x32_bf16(fk[jt * 2 + i], vs[i], S[jt], 0, 0, 0);
        asm volatile("s_waitcnt lgkmcnt(0)" : "+v"(fp[0]), "+v"(fp[1]), "+v"(fp[2]), "+v"(fp[3]), "+v"(fp[4]), "+v"(fp[5]), "+v"(fp[6]), "+v"(fp[7]) :: "memory");
#pragma unroll
        for (int i = 0; i < 2; ++i)
#pragma unroll
            for (int m = 0; m < 4; ++m) o[m] = __builtin_amdgcn_mfma_f32_16x16x32_bf16(fp[m * 2 + i], vnb[i], o[m], 0, 0, 0);
#pragma unroll
        for (int i = 0; i < 4; ++i) Sb[i] = pack8(S[2 * i], S[2 * i + 1]);
        SB_();
        bf16* op = Odir + (size_t)(b * SEQ + n * 64) * 512 + h * 128 + 16 * e + n16;
#pragma unroll
        for (int m = 0; m < 4; ++m)
#pragma unroll
            for (int r = 0; r < 4; ++r) op[(size_t)(16 * m + 4 * g + r) * 512] = (bf16)(pk2(o[m][r], 0.f) & 0xffffu);
    }
#undef SB_
#undef LDR128
#undef LDR64
#undef LDR32
}

DI void p5_combine(Frame& F) {
    const int gw = F.vcu * NWAVES + F.wave, NGW = F.G * NWAVES, lane = F.lane;
    const bf16* OFp = (const bf16*)((unsigned char*)F.out + DO_OF); const bf16* OBp = (const bf16*)((unsigned char*)F.out + DO_OB);
    const bf16* ZA = (const bf16*)(F.ws + WS_ZA); bf16* OCAT = (bf16*)(F.ws + WS_OCAT);
    const float* nw = F.in[6] + (lane & 15) * 8;
    float w8[8];
#pragma unroll
    for (int c = 0; c < 8; ++c) w8[c] = nw[c];
    constexpr int NB4 = 4;
    for (int t0 = gw; t0 < TT; t0 += NB4 * NGW) {
        v4u a[NB4], bb[NB4], z[NB4];
#pragma unroll
        for (int u = 0; u < NB4; ++u) { const int t = (t0 + u * NGW < TT) ? t0 + u * NGW : t0;
            a[u] = *(const v4u*)(OFp + (size_t)t * 512 + lane * 8); bb[u] = *(const v4u*)(OBp + (size_t)t * 512 + lane * 8); z[u] = *(const v4u*)(ZA + (size_t)t * 512 + lane * 8); }
#pragma unroll
        for (int u = 0; u < NB4; ++u) {
            const int t = t0 + u * NGW; if (t >= TT) break;
            float o[8] = {bflo(a[u].x) + bflo(bb[u].x), bfhi(a[u].x) + bfhi(bb[u].x), bflo(a[u].y) + bflo(bb[u].y), bfhi(a[u].y) + bfhi(bb[u].y), bflo(a[u].z) + bflo(bb[u].z), bfhi(a[u].z) + bfhi(bb[u].z), bflo(a[u].w) + bflo(bb[u].w), bfhi(a[u].w) + bfhi(bb[u].w)};
            const float zz[8] = {bflo(z[u].x), bfhi(z[u].x), bflo(z[u].y), bfhi(z[u].y), bflo(z[u].z), bfhi(z[u].z), bflo(z[u].w), bfhi(z[u].w)};
            float ss = 0.f;
#pragma unroll
            for (int c = 0; c < 8; ++c) ss += o[c] * o[c];
            ss += __shfl_xor(ss, 1); ss += __shfl_xor(ss, 2); ss += __shfl_xor(ss, 4); ss += __shfl_xor(ss, 8);
            const float rn = __builtin_amdgcn_rsqf(ss * (1.f / 128.f) + EPS);
#pragma unroll
            for (int c = 0; c < 8; ++c) o[c] = o[c] * rn * w8[c] * siluf(zz[c]);
            v4u r; r.x = pk2(o[0], o[1]); r.y = pk2(o[2], o[3]); r.z = pk2(o[4], o[5]); r.w = pk2(o[6], o[7]);
            *(v4u*)(OCAT + (size_t)t * 1024 + lane * 8) = r;
        }
    }
}

struct TokRec { int e[2]; int row[2]; float gate[2]; };
DI void p7_route(Frame& F) {
    const int lane = F.lane, n16 = lane & 15, g = lane >> 4, wave = F.wave;
    const float* X1 = (const float*)(F.ws + WS_X1); const float* nfw = F.in[10];
    const bf16* WRH = (const bf16*)(F.ws + WS_WR); const bf16* WRL = WRH + 48 * 1024;
    unsigned char* HN = (unsigned char*)F.out + DO_HN; TokRec* TOK = (TokRec*)(F.ws + WS_TOK); unsigned* gcnt = (unsigned*)(F.ws + WS_CTL) + CW_CNT; int* LIST = (int*)(F.ws + WS_LIST);
    LAS float* lg = (LAS float*)(F.lds + (wave & 3) * 4096);
    LAS unsigned* hist = (LAS unsigned*)(F.lds + 16384); LAS unsigned* base = hist + 32;
    const int sub = blockIdx.x & 7;
    const float qsc = 127.0f / act_absmax(nfw, lane);
    for (int rt0 = blockIdx.x * 4; rt0 < TT / 16; rt0 += F.G * 4) {
        if (F.tid < 32) hist[F.tid] = 0u;
        __syncthreads();
        int ex1 = 0, ex2 = 0, tok = -1; unsigned l1 = 0, l2 = 0; float g1 = 0.f, g2 = 0.f;
        const int rt = rt0 + wave;
        if (wave < 4 && rt < TT / 16) {
            const int row = rt * 16 + n16; const float* xr = X1 + (size_t)row * DMODEL + 8 * g;
            float ss = 0.f;
#pragma unroll 16
            for (int i = 0; i < 32; ++i) { const f32x4 a = *(const f32x4*)(xr + 32 * i), b2 = *(const f32x4*)(xr + 32 * i + 4);
                ss += (a.x * a.x + a.y * a.y) + (a.z * a.z + a.w * a.w) + (b2.x * b2.x + b2.y * b2.y) + (b2.z * b2.z + b2.w * b2.w); }
            ss += __shfl_xor(ss, 16); ss += __shfl_xor(ss, 32);
            const float rs = __builtin_amdgcn_rsqf(ss * (1.f / DMODEL) + EPS);
            f32x4 acc[3];
#pragma unroll
            for (int q = 0; q < 3; ++q) acc[q] = (f32x4){0.f, 0.f, 0.f, 0.f};
#pragma unroll 4
            for (int i = 0; i < 32; ++i) {
                const f32x4 a = *(const f32x4*)(xr + 32 * i), b2 = *(const f32x4*)(xr + 32 * i + 4);
                const f32x4 wa = *(const f32x4*)(nfw + 32 * i + 8 * g), wb = *(const f32x4*)(nfw + 32 * i + 8 * g + 4);
                float hv[8] = {a.x * rs * wa.x, a.y * rs * wa.y, a.z * rs * wa.z, a.w * rs * wa.w, b2.x * rs * wb.x, b2.y * rs * wb.y, b2.z * rs * wb.z, b2.w * rs * wb.w};
                v4u hi, lo;
                hi.x = pk2(hv[0], hv[1]); hi.y = pk2(hv[2], hv[3]); hi.z = pk2(hv[4], hv[5]); hi.w = pk2(hv[6], hv[7]);
                lo.x = pk2(hv[0] - bflo(hi.x), hv[1] - bfhi(hi.x)); lo.y = pk2(hv[2] - bflo(hi.y), hv[3] - bfhi(hi.y));
                lo.z = pk2(hv[4] - bflo(hi.z), hv[5] - bfhi(hi.z)); lo.w = pk2(hv[6] - bflo(hi.w), hv[7] - bfhi(hi.w));
                { v2u q; q.x = q8x4(hv[0], hv[1], hv[2], hv[3], qsc); q.y = q8x4(hv[4], hv[5], hv[6], hv[7], qsc); *(v2u*)(HN + (size_t)row * DMODEL + 32 * i + 8 * g) = q; }
                const bf16x8 ah = __builtin_bit_cast(bf16x8, hi), al = __builtin_bit_cast(bf16x8, lo);
#pragma unroll
                for (int q = 0; q < 3; ++q) {
                    const bf16x8 bh = *(const bf16x8*)(WRH + (size_t)(16 * q + n16) * 1024 + 32 * i + 8 * g), bl = *(const bf16x8*)(WRL + (size_t)(16 * q + n16) * 1024 + 32 * i + 8 * g);
                    acc[q] = __builtin_amdgcn_mfma_f32_16x16x32_bf16(ah, bh, acc[q], 0, 0, 0);
                    acc[q] = __builtin_amdgcn_mfma_f32_16x16x32_bf16(ah, bl, acc[q], 0, 0, 0);
                    acc[q] = __builtin_amdgcn_mfma_f32_16x16x32_bf16(al, bh, acc[q], 0, 0, 0);
                }
            }
#pragma unroll
            for (int q = 0; q < 3; ++q)
#pragma unroll
                for (int r = 0; r < 4; ++r) lg[(4 * g + r) * 48 + 16 * q + n16] = acc[q][r];
            asm volatile("s_waitcnt lgkmcnt(0)" ::: "memory");
            if (lane < 16) {
                const LAS float* L = lg + lane * 48; tok = rt * 16 + lane;
                float gm = L[0]; int gs = 0;
#pragma unroll
                for (int q = 1; q < 4; ++q) if (L[q] > gm) { gm = L[q]; gs = q; }
                float gsum = 0.f;
#pragma unroll
                for (int q = 0; q < 4; ++q) gsum += __expf(L[q] - gm);
                const float gp_top = 1.0f / gsum;
                float fv[8];
#pragma unroll
                for (int q = 0; q < 8; ++q) { float v = L[4 + q]; v = (gs == 1) ? L[12 + q] : v; v = (gs == 2) ? L[20 + q] : v; v = (gs == 3) ? L[28 + q] : v; fv[q] = v; }
                float m1 = fv[0]; int i1 = 0;
#pragma unroll
                for (int q = 1; q < 8; ++q) if (fv[q] > m1) { m1 = fv[q]; i1 = q; }
                float m2 = -3.0e38f; int i2 = 0;
#pragma unroll
                for (int q = 0; q < 8; ++q) if (q != i1 && fv[q] > m2) { m2 = fv[q]; i2 = q; }
                const float e2 = __expf(m2 - m1); g1 = gp_top / (1.0f + e2); g2 = gp_top * e2 / (1.0f + e2);
                ex1 = gs * 8 + i1; ex2 = gs * 8 + i2;
                l1 = __hip_atomic_fetch_add(hist + ex1, 1u, __ATOMIC_RELAXED, __HIP_MEMORY_SCOPE_WORKGROUP); l2 = __hip_atomic_fetch_add(hist + ex2, 1u, __ATOMIC_RELAXED, __HIP_MEMORY_SCOPE_WORKGROUP);
            }
        }
        __syncthreads();
        if (F.tid < 32) { const unsigned hcount = hist[F.tid]; base[F.tid] = hcount ? atomicAdd(gcnt + F.tid * 8 + sub, hcount) : 0u; }
        __syncthreads();
        if (tok >= 0) {
            const int s1 = (int)(base[ex1] + l1), s2 = (int)(base[ex2] + l2);
            LIST[(size_t)(ex1 * 8 + sub) * TT + s1] = tok; LIST[(size_t)(ex2 * 8 + sub) * TT + s2] = tok;
            TokRec tr; tr.e[0] = ex1; tr.e[1] = ex2; tr.row[0] = (sub << 24) | s1; tr.row[1] = (sub << 24) | s2; tr.gate[0] = g1; tr.gate[1] = g2;
            TOK[tok] = tr;
        }
    }
}

DI void build_etab(Frame& F) {
    LAS unsigned* etab = (LAS unsigned*)(F.lds + ETAB_OFF);
    if (F.tid < 32) {
        const unsigned* gcnt = (const unsigned*)(F.ws + WS_CTL) + CW_CNT + F.tid * 8; unsigned acc = 0;
#pragma unroll
        for (int q = 0; q < 8; ++q) { const unsigned c = __hip_atomic_load(gcnt + q, __ATOMIC_RELAXED, __HIP_MEMORY_SCOPE_AGENT); etab[96 + 8 * F.tid + q] = acc; acc += c; }
        etab[64 + F.tid] = acc; etab[2 * F.tid + 1] = (acc + 255u) >> 8;
    }
    __syncthreads();
    if (F.tid == 0) { unsigned acc = 0; for (int e = 0; e < NEXP; ++e) { etab[2 * e] = acc; acc += etab[2 * e + 1]; } }
    if (F.wave == 1) { const float am = act_absmax(F.in[10], F.lane); if (F.lane == 0) ((LAS float*)etab)[352] = am * (1.0f / 127.0f); }
    __syncthreads();
}

DI void p11_final(Frame& F) {
    build_etab(F);
    const LAS unsigned* etab = (const LAS unsigned*)(F.lds + ETAB_OFF);
    const int gw = F.vcu * NWAVES + F.wave, NGW = F.G * NWAVES, lane = F.lane;
    const bf16* Y = (const bf16*)(F.ws + WS_XBUF); const TokRec* TOK = (const TokRec*)(F.ws + WS_TOK); const float* fw = F.in[16];
    const f32x4 w0 = *(const f32x4*)(fw + lane * 8), w1 = *(const f32x4*)(fw + lane * 8 + 4), w2 = *(const f32x4*)(fw + 512 + lane * 8), w3 = *(const f32x4*)(fw + 516 + lane * 8);
    constexpr int NB2 = 2;
    for (int t0 = gw; t0 < TT; t0 += NB2 * NGW) {
        TokRec tr[NB2]; f32x4 xa[NB2][4]; v4u ya[NB2][2][2];
#pragma unroll
        for (int u = 0; u < NB2; ++u) { const int t = (t0 + u * NGW < TT) ? t0 + u * NGW : t0; tr[u] = TOK[t];
            const float* xr = (const float*)(F.ws + WS_X1) + (size_t)t * DMODEL + lane * 8;
            xa[u][0] = *(const f32x4*)(xr); xa[u][1] = *(const f32x4*)(xr + 4); xa[u][2] = *(const f32x4*)(xr + 512); xa[u][3] = *(const f32x4*)(xr + 516); }
#pragma unroll
        for (int u = 0; u < NB2; ++u)
#pragma unroll
            for (int k = 0; k < 2; ++k) { const unsigned rk = (unsigned)tr[u].row[k]; const bf16* yr = Y + (size_t)(etab[2 * tr[u].e[k]] * 256u + etab[96 + 8 * tr[u].e[k] + (rk >> 24)] + (rk & 0xffffffu)) * DMODEL + lane * 8; ya[u][k][0] = *(const v4u*)(yr); ya[u][k][1] = *(const v4u*)(yr + 512); }
#pragma unroll
        for (int u = 0; u < NB2; ++u) {
            const int t = t0 + u * NGW; if (t >= TT) break;
            float v[16] = {xa[u][0].x, xa[u][0].y, xa[u][0].z, xa[u][0].w, xa[u][1].x, xa[u][1].y, xa[u][1].z, xa[u][1].w, xa[u][2].x, xa[u][2].y, xa[u][2].z, xa[u][2].w, xa[u][3].x, xa[u][3].y, xa[u][3].z, xa[u][3].w};
#pragma unroll
            for (int k = 0; k < 2; ++k) {
                const float gk = tr[u].gate[k]; const v4u y0 = ya[u][k][0], y1 = ya[u][k][1];
                v[0] += gk * bflo(y0.x); v[1] += gk * bfhi(y0.x); v[2] += gk * bflo(y0.y); v[3] += gk * bfhi(y0.y); v[4] += gk * bflo(y0.z); v[5] += gk * bfhi(y0.z); v[6] += gk * bflo(y0.w); v[7] += gk * bfhi(y0.w);
                v[8] += gk * bflo(y1.x); v[9] += gk * bfhi(y1.x); v[10] += gk * bflo(y1.y); v[11] += gk * bfhi(y1.y); v[12] += gk * bflo(y1.z); v[13] += gk * bfhi(y1.z); v[14] += gk * bflo(y1.w); v[15] += gk * bfhi(y1.w);
            }
            float ss = 0.f;
#pragma unroll
            for (int i = 0; i < 16; ++i) ss += v[i] * v[i];
            const float rs = __builtin_amdgcn_rsqf(wave_sum(ss) * (1.f / DMODEL) + EPS);
            float* orow = F.out + (size_t)t * DMODEL + lane * 8;
            *(f32x4*)(orow) = (f32x4){v[0] * rs * w0.x, v[1] * rs * w0.y, v[2] * rs * w0.z, v[3] * rs * w0.w};
            *(f32x4*)(orow + 4) = (f32x4){v[4] * rs * w1.x, v[5] * rs * w1.y, v[6] * rs * w1.z, v[7] * rs * w1.w};
            *(f32x4*)(orow + 512) = (f32x4){v[8] * rs * w2.x, v[9] * rs * w2.y, v[10] * rs * w2.z, v[11] * rs * w2.w};
            *(f32x4*)(orow + 516) = (f32x4){v[12] * rs * w3.x, v[13] * rs * w3.y, v[14] * rs * w3.z, v[15] * rs * w3.w};
        }
    }
}

struct Args { const float* in[17]; float* out; unsigned char* ws; int ph_lo, ph_hi; };
__global__ void __launch_bounds__(NTHREADS, 2) fwd_kernel(Args args) {
    extern __shared__ __attribute__((aligned(16))) unsigned char lds[];
    cg::grid_group grid = cg::this_grid();
    Frame F;
    F.lds = (LAS unsigned char*)lds; F.tid = threadIdx.x; F.lane = F.tid & 63; F.wave = __builtin_amdgcn_readfirstlane(F.tid >> 6);
    F.G = gridDim.x; { const int bx = blockIdx.x; F.vcu = (F.G % 8 == 0) ? (bx % 8) * (F.G / 8) + bx / 8 : bx; }
#pragma unroll
    for (int i = 0; i < 17; ++i) F.in[i] = args.in[i];
    F.out = args.out; F.ws = args.ws;
    const int lo = args.ph_lo, hi = args.ph_hi;
    if (F.tid < 16) ((volatile LAS unsigned*)(F.lds + MISC_OFF))[F.tid] = 0u;
    __syncthreads();
    XcdBarrier bar = xcd_barrier_post((unsigned*)(F.ws + WS_CTL) + CW_BAR, (volatile LAS unsigned*)(F.lds + MISC_OFF));
    if (lo > 1000) grid.sync();
#ifndef PHSEL
#define PHSEL 0xfff
#endif
#define IN(k) (((PHSEL >> (k)) & 1) && lo <= (k) && (k) < hi)
#define SEAM(k) do { if (IN(k) && IN((k) + 1)) xcd_barrier(bar); } while (0)
#ifndef REP_PH
#define REP_PH -1
#endif
#define REPS(k) for (int rep_ = 0; rep_ < ((k) == REP_PH ? 2 : 1); ++rep_, ((k) == REP_PH && rep_ < 2) ? xcd_barrier(bar) : (void)0)
    if (IN(0)) REPS(0) { p0_prologue(F); } SEAM(0);
    if (IN(1)) REPS(1) {
        pg8::Gemm gm{(const pg8::bf16_t*)(F.ws + WS_XN), (const pg8::bf16_t*)(F.ws + WS_WIN), TT, NPROJ, DMODEL}; pg8::StaticOrder S; S.init(TT, NPROJ, F.G, (int)blockIdx.x);
        EpiProj E{(bf16*)(F.ws + WS_QKVA), (bf16*)(F.ws + WS_ZA), (bf16*)(F.ws + WS_QKVB), (float*)(F.ws + WS_GATES)};
        pg8::gemm_phase<EpiProj, pg8::StaticOrder, true, true>(F.lds, gm, S, E);
    } SEAM(1);
    if (IN(2)) REPS(2) {
#ifndef NO_ROPE
        p2_rope(F);
#ifdef PROBE_ROPE2
        xcd_barrier(bar); p2_rope(F);
#endif
#endif
#ifndef NO_PRE
        p2_gdn_pre(F);
#ifdef PROBE_PRE2
        xcd_barrier(bar); p2_gdn_pre(F);
#endif
#endif
    } SEAM(2);
    if (IN(3)) REPS(3) {
        const attn_body::AttnTensors AT{(const attn_body::bf16*)((unsigned char*)F.out + DO_QR), (const attn_body::bf16*)((unsigned char*)F.out + DO_KR), (const attn_body::bf16*)((unsigned char*)F.out + DO_VR),
                                        (attn_body::bf16*)(F.ws + WS_OCAT) + 512};
        const attn_body::StaticOrder S((int)F.G, (int)blockIdx.x);
#ifdef PROBE_ZERO_ATTN
        { (void)AT; (void)S; bf16* OC = (bf16*)(F.ws + WS_OCAT); const int gt = blockIdx.x * NTHREADS + F.tid, GT = F.G * NTHREADS;
          for (int i = gt; i < TT * 64; i += GT) { const int t = i >> 6, c = i & 63; *(v4u*)(OC + (size_t)t * 1024 + 512 + c * 8) = (v4u){0u, 0u, 0u, 0u}; } }
#else
        attn_body::attn_phase<attn_body::StaticOrder>((char*)lds, AT, S);
#endif
    } SEAM(3);
#ifdef PROBE_SCAN2
    if (IN(4)) { p4_scan(F); xcd_barrier(bar); p4_scan(F); } SEAM(4);
#else
    if (IN(4)) REPS(4) { p4_scan(F); } SEAM(4);
#endif
    if (IN(5)) REPS(5) { p5_combine(F); if (F.G <= 128) { small_weights(F, F.vcu * NWAVES + F.wave, F.G * NWAVES); moe_weights(F, F.vcu, F.G); } } SEAM(5);
    if (IN(6)) REPS(6) {
        pg8::Gemm gm{(const pg8::bf16_t*)(F.ws + WS_OCAT), (const pg8::bf16_t*)(F.ws + WS_WOUT), TT, DMODEL, DMODEL}; pg8::StaticOrder S; S.init(TT, DMODEL, F.G, (int)blockIdx.x);
        EpiResid E{F.in[0], (float*)(F.ws + WS_X1)};
        pg8::gemm_phase<EpiResid, pg8::StaticOrder, true, true>(F.lds, gm, S, E);
    } SEAM(6);
    if (IN(7)) { p7_route(F); } SEAM(7);
    if (IN(9)) REPS(9) {
        build_etab(F);
        pg8::Gemm gm{(const pg8::bf16_t*)((unsigned char*)F.out + DO_HN), (const pg8::bf16_t*)(F.ws + WS_WGU0), 0, 0, DMODEL / 2};
        MoeOrder S{(const LAS unsigned*)(F.lds + ETAB_OFF), F.G, (int)blockIdx.x, WGU_SPLIT, (int)((WS_WGU1 - WS_WGU0) / (256 * 1024))};
        MoeRows AM{(const int*)(F.ws + WS_LIST), (const LAS unsigned*)(F.lds + ETAB_OFF)};
        EpiGU E{(bf16*)(F.ws + WS_HID), (const float*)(F.ws + WS_WSC), ((const LAS float*)(F.lds + ETAB_OFF))[352]};
        pg8::gemm_phase_gather<EpiGU, MoeOrder, MoeRows, true, true>(F.lds, gm, S, E, AM);
    } SEAM(9);
    if (IN(10)) REPS(10) {
        pg8::Gemm gm{(const pg8::bf16_t*)(F.ws + WS_HID), (const pg8::bf16_t*)((unsigned char*)F.out + DO_WD0), 0, 0, FFE}; build_etab(F); MoeOrder S{(const LAS unsigned*)(F.lds + ETAB_OFF), F.G, (int)blockIdx.x, WD_SPLIT, (int)((DO_WD1 - DO_WD0) / (256 * 1024))};
        EpiY E{(bf16*)(F.ws + WS_XBUF)};
        pg8::gemm_phase<EpiY, MoeOrder, true, true>(F.lds, gm, S, E);
    } SEAM(10);
#ifdef EXTRA_SYNCS
    for (int q_ = 0; q_ < EXTRA_SYNCS; ++q_) xcd_barrier(bar);
#endif
    if (IN(11)) { p11_final(F); }
#undef IN
#undef SEAM
}

extern "C" void kernel_launch(void* const* d_in, const int* in_sizes, int n_in, void* d_out, int out_size, void* d_ws, size_t ws_size, hipStream_t stream) {
    static int grid = 0;
    if (grid == 0) {
        if (n_in != 17 || out_size != TT * DMODEL || ws_size < WS_END) { fprintf(stderr, "kernel_launch: unexpected problem (n_in %d out %d ws %zu)\n", n_in, out_size, ws_size); grid = -1; return; }
        int dev = 0, cus = 0, per_cu = 0;
        if (hipGetDevice(&dev) != hipSuccess || hipDeviceGetAttribute(&cus, hipDeviceAttributeMultiprocessorCount, dev) != hipSuccess) { grid = -1; return; }
        if (hipFuncSetAttribute((const void*)fwd_kernel, hipFuncAttributeMaxDynamicSharedMemorySize, LDS_BYTES) != hipSuccess) { fprintf(stderr, "hipFuncSetAttribute failed\n"); grid = -1; return; }
        if (hipOccupancyMaxActiveBlocksPerMultiprocessor(&per_cu, (const void*)fwd_kernel, NTHREADS, LDS_BYTES) != hipSuccess || per_cu < 1) { fprintf(stderr, "occupancy query: %d\n", per_cu); grid = -1; return; }
        grid = cus;
    }
    if (grid < 0) return;
    (void)hipMemsetAsync((char*)d_ws + WS_CTL, 0, CTL_ZERO_BYTES, stream);
    Args a{};
    for (int i = 0; i < 17; ++i) a.in[i] = (const float*)d_in[i];
    a.out = (float*)d_out; a.ws = (unsigned char*)d_ws;
#if MK_PER_PHASE
    for (int p = 0; p < N_PHASES; ++p) { a.ph_lo = p; a.ph_hi = p + 1; hipLaunchKernelGGL(fwd_kernel, dim3(grid), dim3(NTHREADS), LDS_BYTES, stream, a); }
#else
    a.ph_lo = 0; a.ph_hi = N_PHASES;
    void* kargs[] = {&a};
    hipError_t e = hipLaunchCooperativeKernel((void*)fwd_kernel, dim3(grid), dim3(NTHREADS), kargs, LDS_BYTES, stream);
    if (e != hipSuccess) fprintf(stderr, "cooperative launch failed: %s (grid %d)\n", hipGetErrorString(e), grid);
#endif
}
```

```cpp
#include <hip/hip_runtime.h>
#include <cstdio>
#include <cstdint>
namespace pg8 {
#define PG8_LAS __attribute__((address_space(3)))
typedef unsigned short bf16_t;
typedef short bf16x8 __attribute__((ext_vector_type(8)));
typedef float f32x4 __attribute__((ext_vector_type(4)));
typedef unsigned u32x4 __attribute__((ext_vector_type(4)));
constexpr int BM = 256, BK = 64, HALF = 128, HTB = HALF * BK * 2  , STAGE_BYTES = 8 * HTB, NXCD = 8, WGM = 8;

__host__ __device__ __forceinline__ int lds_byte(int r, int c) { const int st = (r >> 4) * 2 + (c >> 5), rr = r & 15, cc = c & 31, ob = rr * 64 + cc * 2; return st * 1024 + (ob ^ (((ob >> 9) & 1) << 5)); }
__host__ __device__ __forceinline__ void stage_rc(int b, int& R, int& C) { const int st = b / 1024, sb = b % 1024, swz = sb ^ (((sb >> 9) & 1) << 5); R = (st >> 1) * 16 + swz / 64; C = (st & 1) * 32 + (swz % 64) / 2; }
__host__ __device__ __forceinline__ int perm32(int rho) { const int n = rho >> 4, i = rho & 15; return 8 * (i >> 2) + 4 * n + (i & 3); }

struct Unit { int pm, pn, ex, tq; };
struct Gemm { const bf16_t* A; const bf16_t* Bt; int M, N, K; };

struct StaticOrder {
    int nM, nN, nwg, G, c;
    __host__ __device__ void init(int M, int N, int G_, int c_) { nM = M / BM; nN = N / BM; nwg = nM * nN; G = G_; c = c_; }
    __host__ __device__ bool next(int i, Unit& u) const {
        const long L = (long)i * G + c; if (L >= nwg) return false;
        int wgid = (int)L; { const int q = nwg / NXCD, r = nwg % NXCD, xcd = wgid % NXCD, off = wgid / NXCD; wgid = (xcd < r ? xcd * (q + 1) : r * (q + 1) + (xcd - r) * q) + off; }
        const int nig = WGM * nN, gid = wgid / nig, fm = gid * WGM, gsz = (nM - fm) < WGM ? (nM - fm) : WGM;
        u.pm = fm + ((wgid % nig) % gsz); u.pn = (wgid % nig) / gsz; return true;
    }
    __device__ __forceinline__ void a_ready(const Unit&) const {}
    __device__ __forceinline__ void done(const Unit&) const {}
};

__device__ __forceinline__ unsigned cvt_pk_bf16(float lo, float hi) { unsigned r; asm volatile("v_cvt_pk_bf16_f32 %0, %1, %2" : "=v"(r) : "v"(lo), "v"(hi)); return r; }
typedef float f32x2 __attribute__((ext_vector_type(2)));
template <class Epi, class Sched, bool ALIGN_EPI = false, bool SP2 = false>
__device__ __forceinline__ void gemm_phase(PG8_LAS unsigned char* lds, const Gemm g, const Sched& S, const Epi& E) {
    const int tid = threadIdx.x, wid = __builtin_amdgcn_readfirstlane(tid >> 6), lane = tid & 63, wr = wid >> 2, wc = wid & 3, fr = lane & 15, fq = lane >> 4;
    const int K = g.K, nt = K / BK;
    unsigned voffA[2], voffB[2];
#pragma unroll
    for (int i = 0; i < 2; ++i) { int R, C; stage_rc(tid * 16 + i * 8192, R, C); const int Rb = Epi::PERM ? ((R & ~31) + perm32(R & 31)) : R;
        voffA[i] = (unsigned)(R * K + C) * 2u; voffB[i] = (unsigned)(Rb * K + C) * 2u; }
    const size_t kstep = (size_t)(BK * 2);
    const size_t hstep = (size_t)HALF * K * 2;
    const size_t tstep = 2 * hstep;
    const unsigned ldsw = (unsigned)wid * 1024u;
    const int aoff = lds_byte(wr * 64 + fr, fq * 8), boff = lds_byte(wc * 32 + fr, fq * 8);
#define PG8_SA(b, h) (((b) * 2 + (h)) * HTB)
#define PG8_SB(b, h) ((4 + (b) * 2 + (h)) * HTB)
#define PG8_STAGE(bufoff, gbase, voff) do { _Pragma("unroll") for (int _i = 0; _i < 2; ++_i) \
        __builtin_amdgcn_global_load_lds((const unsigned*)((const char*)(gbase) + (voff)[_i]), (PG8_LAS unsigned*)(lds + (bufoff) + ldsw + _i * 8192), 16, 0, 0); } while (0)
#define PG8_LDA(dst, b, h) do { _Pragma("unroll") for (int m = 0; m < 4; ++m) _Pragma("unroll") for (int k = 0; k < 2; ++k) dst[m][k] = *(const PG8_LAS bf16x8*)(lds + PG8_SA(b, h) + aoff + m * 2048 + k * 1024); } while (0)
#define PG8_LDB(dst, b, h) do { _Pragma("unroll") for (int n = 0; n < 2; ++n) _Pragma("unroll") for (int k = 0; k < 2; ++k) dst[n][k] = *(const PG8_LAS bf16x8*)(lds + PG8_SB(b, h) + boff + n * 2048 + k * 1024); } while (0)
#define PG8_MMA(ai, bj, At, Bt) do { __builtin_amdgcn_s_setprio(1); _Pragma("unroll") for (int m = 0; m < 4; ++m) _Pragma("unroll") for (int n = 0; n < 2; ++n) _Pragma("unroll") for (int k = 0; k < 2; ++k) \
        acc[ai][bj][m][n] = __builtin_amdgcn_mfma_f32_16x16x32_bf16(Bt[n][k], At[m][k], acc[ai][bj][m][n], 0, 0, 0); __builtin_amdgcn_s_setprio(0); } while (0)
#define PG8_WAIT_V(n) asm volatile("s_waitcnt vmcnt(" #n ")" ::: "memory")
#define PG8_WAIT_L(n) asm volatile("s_waitcnt lgkmcnt(" #n ")" ::: "memory")
#define PG8_BAR __builtin_amdgcn_s_barrier()
#define PG8_SCHED __builtin_amdgcn_sched_barrier(0)
    Unit cur, nxt; int ui = 0;
    if (!S.next(0, cur)) return;
    f32x4 acc[2][2][4][2];
#pragma unroll
    for (int a = 0; a < 2; ++a)
#pragma unroll
        for (int b = 0; b < 2; ++b)
#pragma unroll
            for (int m = 0; m < 4; ++m)
#pragma unroll
                for (int n = 0; n < 2; ++n) acc[a][b][m][n] = (f32x4){0.f, 0.f, 0.f, 0.f};
    bf16x8 At[4][2], B0[2][2], B1[2][2];
    const char* cA = (const char*)g.A + (size_t)cur.pm * tstep; const char* cB = (const char*)g.Bt + (size_t)cur.pn * tstep;
    S.a_ready(cur);
    if constexpr (SP2) {
        PG8_STAGE(PG8_SB(0, 0), cB, voffB); PG8_STAGE(PG8_SB(0, 1), cB + hstep, voffB); PG8_STAGE(PG8_SA(0, 0), cA, voffA); PG8_STAGE(PG8_SA(0, 1), cA + hstep, voffA);
        if (wr == 1) PG8_BAR;
        PG8_WAIT_V(2); PG8_BAR;
        PG8_STAGE(PG8_SB(1, 0), cB + kstep, voffB); PG8_STAGE(PG8_SA(1, 0), cA + kstep, voffA); PG8_STAGE(PG8_SB(1, 1), cB + hstep + kstep, voffB);
        PG8_WAIT_V(6); PG8_BAR;
    } else {
        PG8_STAGE(PG8_SB(0, 0), cB, voffB); PG8_STAGE(PG8_SA(0, 0), cA, voffA); PG8_STAGE(PG8_SB(0, 1), cB + hstep, voffB); PG8_STAGE(PG8_SA(0, 1), cA + hstep, voffA);
        if (wr == 1) PG8_BAR;
        PG8_WAIT_V(4); PG8_BAR;
        PG8_STAGE(PG8_SB(1, 0), cB + kstep, voffB); PG8_STAGE(PG8_SA(1, 0), cA + kstep, voffA); PG8_STAGE(PG8_SB(1, 1), cB + hstep + kstep, voffB);
        PG8_WAIT_V(6); PG8_BAR;
    }
    for (;;) {
        const bool has_next = S.next(ui + 1, nxt);
        const char* nA = has_next ? (const char*)g.A + (size_t)nxt.pm * tstep : cA; const char* nB = has_next ? (const char*)g.Bt + (size_t)nxt.pn * tstep : cB;
        for (int t = 0; t < nt; t += 2) {
            const bool last = (t == nt - 2);
            const char* a1 = cA + (size_t)(t + 1) * kstep;
            const char* a2 = last ? nA : cA + (size_t)(t + 2) * kstep; const char* b2 = last ? nB : cB + (size_t)(t + 2) * kstep;
            const char* a3 = a2 + kstep; const char* b3 = b2 + kstep;
            if (last && has_next) S.a_ready(nxt);
            if constexpr (SP2) {
            PG8_LDB(B0, 0, 0); PG8_LDB(B1, 0, 1); PG8_SCHED; PG8_LDA(At, 0, 0); PG8_STAGE(PG8_SA(1, 1), a1 + hstep, voffA);
            PG8_WAIT_V(8); PG8_WAIT_L(0); PG8_BAR; PG8_MMA(0, 0, At, B0); PG8_MMA(0, 1, At, B1); PG8_BAR; PG8_SCHED;
            PG8_LDA(At, 0, 1); PG8_STAGE(PG8_SB(0, 0), b2, voffB); PG8_STAGE(PG8_SB(0, 1), b2 + hstep, voffB); PG8_STAGE(PG8_SA(0, 0), a2, voffA);
            PG8_WAIT_V(8); PG8_WAIT_L(0); PG8_BAR; PG8_MMA(1, 0, At, B0); PG8_MMA(1, 1, At, B1); PG8_BAR; PG8_SCHED;
            PG8_LDB(B0, 1, 0); PG8_LDB(B1, 1, 1); PG8_SCHED; PG8_LDA(At, 1, 0); PG8_STAGE(PG8_SA(0, 1), a2 + hstep, voffA);
            PG8_WAIT_V(8); PG8_WAIT_L(0); PG8_BAR; PG8_MMA(0, 0, At, B0); PG8_MMA(0, 1, At, B1); PG8_BAR; PG8_SCHED;
            PG8_LDA(At, 1, 1); PG8_STAGE(PG8_SB(1, 0), b3, voffB); PG8_STAGE(PG8_SB(1, 1), b3 + hstep, voffB); PG8_STAGE(PG8_SA(1, 0), a3, voffA);
            PG8_WAIT_V(8); PG8_WAIT_L(0); PG8_BAR; PG8_MMA(1, 0, At, B0); PG8_MMA(1, 1, At, B1); PG8_BAR; PG8_SCHED;
            } else {
            PG8_LDB(B0, 0, 0); PG8_SCHED; PG8_LDA(At, 0, 0); PG8_STAGE(PG8_SA(1, 1), a1 + hstep, voffA);
            PG8_WAIT_L(8); PG8_BAR; PG8_WAIT_L(0); PG8_MMA(0, 0, At, B0); PG8_BAR; PG8_SCHED;
            PG8_LDB(B1, 0, 1); PG8_STAGE(PG8_SB(0, 0), b2, voffB);
            PG8_BAR; PG8_WAIT_L(0); PG8_MMA(0, 1, At, B1); PG8_BAR;
            PG8_LDA(At, 0, 1); PG8_STAGE(PG8_SA(0, 0), a2, voffA);
            PG8_BAR; PG8_WAIT_L(0); PG8_MMA(1, 0, At, B0); PG8_BAR; PG8_SCHED;
            PG8_STAGE(PG8_SB(0, 1), b2 + hstep, voffB);
            PG8_WAIT_V(6); PG8_BAR; PG8_MMA(1, 1, At, B1); PG8_BAR;
            PG8_LDB(B0, 1, 0); PG8_SCHED; PG8_LDA(At, 1, 0); PG8_STAGE(PG8_SA(0, 1), a2 + hstep, voffA);
            PG8_WAIT_L(8); PG8_BAR; PG8_WAIT_L(0); PG8_MMA(0, 0, At, B0); PG8_BAR; PG8_SCHED;
            PG8_LDB(B1, 1, 1); PG8_STAGE(PG8_SB(1, 0), b3, voffB);
            PG8_BAR; PG8_WAIT_L(0); PG8_MMA(0, 1, At, B1); PG8_BAR;
            PG8_LDA(At, 1, 1); PG8_STAGE(PG8_SA(1, 0), a3, voffA);
            PG8_BAR; PG8_WAIT_L(0); PG8_MMA(1, 0, At, B0); PG8_BAR; PG8_SCHED;
            PG8_STAGE(PG8_SB(1, 1), b3 + hstep, voffB);
            PG8_WAIT_V(6); PG8_BAR; PG8_MMA(1, 1, At, B1); PG8_BAR;
            }
        }
        if constexpr (ALIGN_EPI) { if (wr == 0) PG8_BAR; }
        if constexpr (!Epi::AFTER_DRAIN) { E(acc, cur, wr, wc, fr, fq); S.done(cur); }
        if (!has_next) break;
#pragma unroll
        for (int a = 0; a < 2; ++a)
#pragma unroll
            for (int b = 0; b < 2; ++b)
#pragma unroll
                for (int m = 0; m < 4; ++m)
#pragma unroll
                    for (int n = 0; n < 2; ++n) acc[a][b][m][n] = (f32x4){0.f, 0.f, 0.f, 0.f};
        cur = nxt; cA = nA; cB = nB; ++ui;
        if constexpr (ALIGN_EPI) { if (wr == 1) PG8_BAR; }
    }
    PG8_WAIT_V(0);
    if constexpr (!ALIGN_EPI) { if (wr == 0) PG8_BAR; }
    PG8_BAR;
    if constexpr (Epi::AFTER_DRAIN) { E.fused(acc, cur, wr, wc, fr, fq, lds, wid, lane); S.done(cur); }
#undef PG8_SA
#undef PG8_SB
#undef PG8_STAGE
#undef PG8_LDA
#undef PG8_LDB
#undef PG8_MMA
#undef PG8_WAIT_V
#undef PG8_WAIT_L
#undef PG8_BAR
#undef PG8_SCHED
}
typedef int i32x4 __attribute__((ext_vector_type(4)));
template <bool I8> struct AccSel { typedef f32x4 type; };
template <> struct AccSel<true> { typedef i32x4 type; };
template <bool I8> __device__ __forceinline__ void mma_step(typename AccSel<I8>::type& c, const bf16x8& b, const bf16x8& a) {
    if constexpr (I8) c = __builtin_amdgcn_mfma_i32_16x16x64_i8(__builtin_bit_cast(i32x4, b), __builtin_bit_cast(i32x4, a), c, 0, 0, 0);
    else c = __builtin_amdgcn_mfma_f32_16x16x32_bf16(b, a, c, 0, 0, 0);
}
template <class Epi, class Sched, class AMap, bool ALIGN_EPI = false, bool I8 = false>
__device__ __forceinline__ void gemm_phase_gather(PG8_LAS unsigned char* lds, const Gemm g, const Sched& S, const Epi& E, const AMap& AM) {
    constexpr bool SP2 = true;
    const int tid = threadIdx.x, wid = __builtin_amdgcn_readfirstlane(tid >> 6), lane = tid & 63, wr = wid >> 2, wc = wid & 3, fr = lane & 15, fq = lane >> 4;
    const int K = g.K, nt = K / BK;
    unsigned voffA[2], voffB[2]; int rowA[2];
#pragma unroll
    for (int i = 0; i < 2; ++i) { int R, C; stage_rc(tid * 16 + i * 8192, R, C); const int Rb = Epi::PERM ? ((R & ~31) + perm32(R & 31)) : R;
        voffA[i] = (unsigned)C * 2u; voffB[i] = (unsigned)(Rb * K + C) * 2u; rowA[i] = R; }
    const size_t kstep = (size_t)(BK * 2);
    const size_t hstep = (size_t)HALF * K * 2;
    const size_t tstep = 2 * hstep;
    const unsigned ldsw = (unsigned)wid * 1024u;
    const int aoff = lds_byte(wr * 64 + fr, fq * 8), boff = lds_byte(wc * 32 + fr, fq * 8);
#define PG8_SA(b, h) (((b) * 2 + (h)) * HTB)
#define PG8_SB(b, h) ((4 + (b) * 2 + (h)) * HTB)
#define PG8_STAGE(bufoff, gbase, voff) do { _Pragma("unroll") for (int _i = 0; _i < 2; ++_i) \
        __builtin_amdgcn_global_load_lds((const unsigned*)((const char*)(gbase) + (voff)[_i]), (PG8_LAS unsigned*)(lds + (bufoff) + ldsw + _i * 8192), 16, 0, 0); } while (0)
#define PG8_LDA(dst, b, h) do { _Pragma("unroll") for (int m = 0; m < 4; ++m) _Pragma("unroll") for (int k = 0; k < 2; ++k) dst[m][k] = *(const PG8_LAS bf16x8*)(lds + PG8_SA(b, h) + aoff + m * 2048 + k * 1024); } while (0)
#define PG8_LDB(dst, b, h) do { _Pragma("unroll") for (int n = 0; n < 2; ++n) _Pragma("unroll") for (int k = 0; k < 2; ++k) dst[n][k] = *(const PG8_LAS bf16x8*)(lds + PG8_SB(b, h) + boff + n * 2048 + k * 1024); } while (0)
#define PG8_MMA(ai, bj, At, Bt) do { __builtin_amdgcn_s_setprio(1); _Pragma("unroll") for (int m = 0; m < 4; ++m) _Pragma("unroll") for (int n = 0; n < 2; ++n) _Pragma("unroll") for (int k = 0; k < 2; ++k) \
        mma_step<I8>(acc[ai][bj][m][n], Bt[n][k], At[m][k]); __builtin_amdgcn_s_setprio(0); } while (0)
#define PG8_WAIT_V(n) asm volatile("s_waitcnt vmcnt(" #n ")" ::: "memory")
#define PG8_WAIT_L(n) asm volatile("s_waitcnt lgkmcnt(" #n ")" ::: "memory")
#define PG8_BAR __builtin_amdgcn_s_barrier()
#define PG8_SCHED __builtin_amdgcn_sched_barrier(0)
    Unit cur, nxt; int ui = 0;
    if (!S.next(0, cur)) return;
    typedef typename AccSel<I8>::type acc_t;
    acc_t acc[2][2][4][2];
#pragma unroll
    for (int a = 0; a < 2; ++a)
#pragma unroll
        for (int b = 0; b < 2; ++b)
#pragma unroll
            for (int m = 0; m < 4; ++m)
#pragma unroll
                for (int n = 0; n < 2; ++n) acc[a][b][m][n] = (acc_t){0, 0, 0, 0};
    bf16x8 At[4][2], B0[2][2], B1[2][2];
    const char* cA = (const char*)g.A; const char* cB = (const char*)g.Bt + (size_t)cur.pn * tstep;
    unsigned vA0[2], vA1[2], nA0[2], nA1[2];
#pragma unroll
    for (int i = 0; i < 2; ++i) { vA0[i] = (unsigned)AM.row(cur, rowA[i]) * (unsigned)(K * 2) + voffA[i]; vA1[i] = (unsigned)AM.row(cur, HALF + rowA[i]) * (unsigned)(K * 2) + voffA[i]; }
    S.a_ready(cur);
    if constexpr (SP2) {
        PG8_STAGE(PG8_SB(0, 0), cB, voffB); PG8_STAGE(PG8_SB(0, 1), cB + hstep, voffB); PG8_STAGE(PG8_SA(0, 0), cA, vA0); PG8_STAGE(PG8_SA(0, 1), cA, vA1);
        if (wr == 1) PG8_BAR;
        PG8_WAIT_V(2); PG8_BAR;
        PG8_STAGE(PG8_SB(1, 0), cB + kstep, voffB); PG8_STAGE(PG8_SA(1, 0), cA + kstep, vA0); PG8_STAGE(PG8_SB(1, 1), cB + hstep + kstep, voffB);
        PG8_WAIT_V(6); PG8_BAR;
    } else {
        PG8_STAGE(PG8_SB(0, 0), cB, voffB); PG8_STAGE(PG8_SA(0, 0), cA, voffA); PG8_STAGE(PG8_SB(0, 1), cB + hstep, voffB); PG8_STAGE(PG8_SA(0, 1), cA + hstep, voffA);
        if (wr == 1) PG8_BAR;
        PG8_WAIT_V(4); PG8_BAR;
        PG8_STAGE(PG8_SB(1, 0), cB + kstep, voffB); PG8_STAGE(PG8_SA(1, 0), cA + kstep, voffA); PG8_STAGE(PG8_SB(1, 1), cB + hstep + kstep, voffB);
        PG8_WAIT_V(6); PG8_BAR;
    }
    for (;;) {
        const bool has_next = S.next(ui + 1, nxt);
        const char* nA = cA; const char* nB = has_next ? (const char*)g.Bt + (size_t)nxt.pn * tstep : cB;
#pragma unroll
        for (int i = 0; i < 2; ++i) { nA0[i] = has_next ? (unsigned)AM.row(nxt, rowA[i]) * (unsigned)(K * 2) + voffA[i] : vA0[i]; nA1[i] = has_next ? (unsigned)AM.row(nxt, HALF + rowA[i]) * (unsigned)(K * 2) + voffA[i] : vA1[i]; }
        for (int t = 0; t < nt; t += 2) {
            const bool last = (t == nt - 2);
            const char* a1 = cA + (size_t)(t + 1) * kstep;
            const char* a2 = last ? nA : cA + (size_t)(t + 2) * kstep; const char* b2 = last ? nB : cB + (size_t)(t + 2) * kstep;
            const char* a3 = a2 + kstep; const char* b3 = b2 + kstep;
            unsigned s0[2], s1[2];
#pragma unroll
            for (int i = 0; i < 2; ++i) { s0[i] = vA0[i]; s1[i] = vA1[i]; }
            if (last) {
#pragma unroll
                for (int i = 0; i < 2; ++i) { unsigned t0_ = nA0[i], t1_ = nA1[i]; asm volatile("" : "+v"(t0_), "+v"(t1_)); s0[i] = t0_; s1[i] = t1_; } }
            if (last && has_next) S.a_ready(nxt);
            if constexpr (SP2) {
            PG8_LDB(B0, 0, 0); PG8_LDB(B1, 0, 1); PG8_SCHED; PG8_LDA(At, 0, 0); PG8_STAGE(PG8_SA(1, 1), a1, vA1);
            PG8_WAIT_V(8); PG8_WAIT_L(0); PG8_BAR; PG8_MMA(0, 0, At, B0); PG8_MMA(0, 1, At, B1); PG8_BAR; PG8_SCHED;
            PG8_LDA(At, 0, 1); PG8_STAGE(PG8_SB(0, 0), b2, voffB); PG8_STAGE(PG8_SB(0, 1), b2 + hstep, voffB); PG8_STAGE(PG8_SA(0, 0), a2, s0);
            PG8_WAIT_V(8); PG8_WAIT_L(0); PG8_BAR; PG8_MMA(1, 0, At, B0); PG8_MMA(1, 1, At, B1); PG8_BAR; PG8_SCHED;
            PG8_LDB(B0, 1, 0); PG8_LDB(B1, 1, 1); PG8_SCHED; PG8_LDA(At, 1, 0); PG8_STAGE(PG8_SA(0, 1), a2, s1);
            PG8_WAIT_V(8); PG8_WAIT_L(0); PG8_BAR; PG8_MMA(0, 0, At, B0); PG8_MMA(0, 1, At, B1); PG8_BAR; PG8_SCHED;
            PG8_LDA(At, 1, 1); PG8_STAGE(PG8_SB(1, 0), b3, voffB); PG8_STAGE(PG8_SB(1, 1), b3 + hstep, voffB); PG8_STAGE(PG8_SA(1, 0), a3, s0);
            PG8_WAIT_V(8); PG8_WAIT_L(0); PG8_BAR; PG8_MMA(1, 0, At, B0); PG8_MMA(1, 1, At, B1); PG8_BAR; PG8_SCHED;
            } else {
            PG8_LDB(B0, 0, 0); PG8_SCHED; PG8_LDA(At, 0, 0); PG8_STAGE(PG8_SA(1, 1), a1 + hstep, voffA);
            PG8_WAIT_L(8); PG8_BAR; PG8_WAIT_L(0); PG8_MMA(0, 0, At, B0); PG8_BAR; PG8_SCHED;
            PG8_LDB(B1, 0, 1); PG8_STAGE(PG8_SB(0, 0), b2, voffB);
            PG8_BAR; PG8_WAIT_L(0); PG8_MMA(0, 1, At, B1); PG8_BAR;
            PG8_LDA(At, 0, 1); PG8_STAGE(PG8_SA(0, 0), a2, voffA);
            PG8_BAR; PG8_WAIT_L(0); PG8_MMA(1, 0, At, B0); PG8_BAR; PG8_SCHED;
            PG8_STAGE(PG8_SB(0, 1), b2 + hstep, voffB);
            PG8_WAIT_V(6); PG8_BAR; PG8_MMA(1, 1, At, B1); PG8_BAR;
            PG8_LDB(B0, 1, 0); PG8_SCHED; PG8_LDA(At, 1, 0); PG8_STAGE(PG8_SA(0, 1), a2 + hstep, voffA);
            PG8_WAIT_L(8); PG8_BAR; PG8_WAIT_L(0); PG8_MMA(0, 0, At, B0); PG8_BAR; PG8_SCHED;
            PG8_LDB(B1, 1, 1); PG8_STAGE(PG8_SB(1, 0), b3, voffB);
            PG8_BAR; PG8_WAIT_L(0); PG8_MMA(0, 1, At, B1); PG8_BAR;
            PG8_LDA(At, 1, 1); PG8_STAGE(PG8_SA(1, 0), a3, voffA);
            PG8_BAR; PG8_WAIT_L(0); PG8_MMA(1, 0, At, B0); PG8_BAR; PG8_SCHED;
            PG8_STAGE(PG8_SB(1, 1), b3 + hstep, voffB);
            PG8_WAIT_V(6); PG8_BAR; PG8_MMA(1, 1, At, B1); PG8_BAR;
            }
        }
        if constexpr (ALIGN_EPI) { if (wr == 0) PG8_BAR; }
        if constexpr (!Epi::AFTER_DRAIN) { E(acc, cur, wr, wc, fr, fq); S.done(cur); }
        if (!has_next) break;
#pragma unroll
        for (int a = 0; a < 2; ++a)
#pragma unroll
            for (int b = 0; b < 2; ++b)
#pragma unroll
                for (int m = 0; m < 4; ++m)
#pragma unroll
                    for (int n = 0; n < 2; ++n) acc[a][b][m][n] = (acc_t){0, 0, 0, 0};
        cur = nxt; cA = nA; cB = nB; ++ui;
#pragma unroll
        for (int i = 0; i < 2; ++i) { vA0[i] = nA0[i]; vA1[i] = nA1[i]; }
        if constexpr (ALIGN_EPI) { if (wr == 1) PG8_BAR; }
    }
    PG8_WAIT_V(0);
    if constexpr (!ALIGN_EPI) { if (wr == 0) PG8_BAR; }
    PG8_BAR;
    if constexpr (Epi::AFTER_DRAIN) { E.fused(acc, cur, wr, wc, fr, fq, lds, wid, lane); S.done(cur); }
#undef PG8_SA
#undef PG8_SB
#undef PG8_STAGE
#undef PG8_LDA
#undef PG8_LDB
#undef PG8_MMA
#undef PG8_WAIT_V
#undef PG8_WAIT_L
#undef PG8_BAR
#undef PG8_SCHED
}
}
#include <hip/hip_bf16.h>
#include <cmath>
namespace attn_body {
using bf16=__hip_bfloat16;
using bf16x8=__attribute__((ext_vector_type(8)))short;
using s16x4=__attribute__((ext_vector_type(4)))short;
using f32x16=__attribute__((ext_vector_type(16)))float;
using u32x4=__attribute__((ext_vector_type(4)))unsigned;
constexpr int BATCH=2,NHEAD=8,NKVH=2,SEQ=8192,D=64,QP=512,KP=128,OP=1024;
constexpr int NW=8,QBLK=32,QB=QBLK*NW,KVBLK=64,NQB=SEQ/QB;
constexpr int ATTN_UNIT_ROWS=QB;
__device__ __forceinline__ int crow(int r,int hi){return (r&3)+8*(r>>2)+4*hi;}
#define SBAR() __builtin_amdgcn_sched_barrier(0)
__device__ __forceinline__ void cmask(f32x16&p0,f32x16&p1,int jb,int qrel,int hi){
  const float NEG=-INFINITY; int kb=64*jb+4*hi;
  #pragma unroll
  for(int r=0;r<16;++r){int kv=kb+(r&3)+8*(r>>2); if(kv>qrel)p0[r]=NEG; if(kv+32>qrel)p1[r]=NEG;}
}

constexpr int NSLOT=3, SLOTB=8192;
constexpr int LDS_K=0, LDS_V=NSLOT*SLOTB, LDS_WS=2*NSLOT*SLOTB, LDS_OST=LDS_WS+NW*64*4, LDS_BYTES=LDS_OST+NW*4096;
constexpr float C2=0.125f*1.4426950408889634f;
__device__ __forceinline__ void glds16(const void*gsrc,unsigned lds_dst){unsigned keep;
  asm volatile("s_mov_b32 %0, m0\n\ts_mov_b32 m0, %2\n\ts_nop 0\n\tglobal_load_lds_dwordx4 %1, off\n\ts_mov_b32 m0, %0":"=&s"(keep):"v"(gsrc),"s"(lds_dst):"memory");}
__device__ __forceinline__ float max3f(float a,float b,float c){float r;asm("v_max3_f32 %0, %1, %2, %3":"=v"(r):"v"(a),"v"(b),"v"(c));return r;}
__device__ __forceinline__ float max2f(float a,float b){float r;asm("v_max_f32_e32 %0, %1, %2":"=v"(r):"v"(a),"v"(b));return r;}
__device__ __forceinline__ float fadd_s(float a,float b){float r;asm("v_add_f32_e32 %0, %1, %2":"=v"(r):"v"(a),"v"(b));return r;}
__device__ __forceinline__ float fsub_s(float a,float b){float r;asm("v_sub_f32_e32 %0, %1, %2":"=v"(r):"v"(a),"v"(b));return r;}
typedef float f32x2_t __attribute__((ext_vector_type(2))); typedef __bf16 bf16x2_t __attribute__((ext_vector_type(2)));
__device__ __forceinline__ unsigned cvtpk_s(float lo,float hi){f32x2_t v={lo,hi};bf16x2_t b=__builtin_convertvector(v,bf16x2_t);return __builtin_bit_cast(unsigned,b);}
#define WAIT_BAR(N) asm volatile("s_waitcnt vmcnt(" #N ") lgkmcnt(0)\n\ts_barrier":::"memory")

__device__ __forceinline__ void qkt(f32x16&p0,f32x16&p1,const char*Kslot,const bf16x8*qr,const f32x16&negm,int r32,int hi){
  const char*kb=Kslot+hi*1024+r32*16;
  #pragma unroll
  for(int d0=0;d0<4;++d0){
    const bf16x8 b0=*reinterpret_cast<const bf16x8*>(kb+d0*2048);
    const bf16x8 b1=*reinterpret_cast<const bf16x8*>(kb+d0*2048+512);
    if(d0==0){p0=__builtin_amdgcn_mfma_f32_32x32x16_bf16(b0,qr[0],negm,0,0,0);p1=__builtin_amdgcn_mfma_f32_32x32x16_bf16(b1,qr[0],negm,0,0,0);}
    else{p0=__builtin_amdgcn_mfma_f32_32x32x16_bf16(b0,qr[d0],p0,0,0,0);p1=__builtin_amdgcn_mfma_f32_32x32x16_bf16(b1,qr[d0],p1,0,0,0);}}
}
typedef __attribute__((address_space(3))) const char* lds_cptr;
typedef short v4i16_t __attribute__((ext_vector_type(4)));
__device__ __forceinline__ void kload8(bf16x8*kf,lds_cptr kp){
  kf[0]=*(const __attribute__((address_space(3))) bf16x8*)(kp);      kf[1]=*(const __attribute__((address_space(3))) bf16x8*)(kp+512);
  kf[2]=*(const __attribute__((address_space(3))) bf16x8*)(kp+2048); kf[3]=*(const __attribute__((address_space(3))) bf16x8*)(kp+2560);
  kf[4]=*(const __attribute__((address_space(3))) bf16x8*)(kp+4096); kf[5]=*(const __attribute__((address_space(3))) bf16x8*)(kp+4608);
  kf[6]=*(const __attribute__((address_space(3))) bf16x8*)(kp+6144); kf[7]=*(const __attribute__((address_space(3))) bf16x8*)(kp+6656);
}
__device__ __forceinline__ void kload2(bf16x8*kf,lds_cptr kp,int j){ kf[2*j]=*(const __attribute__((address_space(3))) bf16x8*)(kp+j*2048); kf[2*j+1]=*(const __attribute__((address_space(3))) bf16x8*)(kp+j*2048+512); }
__device__ __forceinline__ s16x4 vtr(lds_cptr p){ return __builtin_bit_cast(s16x4,__builtin_amdgcn_ds_read_tr16_b64_v4i16((__attribute__((address_space(3))) v4i16_t*)p)); }
__device__ __forceinline__ float rowmax(const f32x16&p0,const f32x16&p1){
  float a=max3f(p0[0],p0[1],p1[0]),b=max3f(p0[2],p0[3],p1[1]);a=max3f(a,p1[2],p1[3]);
  #pragma unroll
  for(int r=4;r<16;r+=4){a=max3f(a,p0[r],p0[r+1]);b=max3f(b,p0[r+2],p0[r+3]);a=max3f(a,p1[r],p1[r+1]);b=max3f(b,p1[r+2],p1[r+3]);}
  const float m=max2f(a,b);
  auto rr=__builtin_amdgcn_permlane32_swap(__float_as_uint(m),__float_as_uint(m),false,false);
  return max2f(__uint_as_float(rr[0]),__uint_as_float(rr[1]));
}
__device__ __forceinline__ void pv(f32x16*o,int vb,bf16x8 pa0,bf16x8 pa1,bf16x8 pa2,bf16x8 pa3){
  #pragma unroll
  for(int d0=0;d0<2;++d0){s16x4 lo[4],hi[4];
    #pragma unroll
    for(int ks=0;ks<4;++ks){
      asm volatile("ds_read_b64_tr_b16 %0,%1 offset:%c2":"=&v"(lo[ks]):"v"(vb),"i"(d0*4096+ks*1024):"memory");
      asm volatile("ds_read_b64_tr_b16 %0,%1 offset:%c2":"=&v"(hi[ks]):"v"(vb),"i"(d0*4096+ks*1024+512):"memory");}
    asm volatile("s_waitcnt lgkmcnt(0)":::"memory");SBAR();
    #define PK(k) (bf16x8){lo[k][0],lo[k][1],lo[k][2],lo[k][3],hi[k][0],hi[k][1],hi[k][2],hi[k][3]}
    o[d0]=__builtin_amdgcn_mfma_f32_32x32x16_bf16(pa0,PK(0),o[d0],0,0,0);
    o[d0]=__builtin_amdgcn_mfma_f32_32x32x16_bf16(pa1,PK(1),o[d0],0,0,0);
    o[d0]=__builtin_amdgcn_mfma_f32_32x32x16_bf16(pa2,PK(2),o[d0],0,0,0);
    o[d0]=__builtin_amdgcn_mfma_f32_32x32x16_bf16(pa3,PK(3),o[d0],0,0,0);
    #undef PK
  }
}

#ifndef ATTN_STORE16
#define ATTN_STORE16(p,v) (*(u32x4*)(p)=(v))
#endif
template<int THRL> __device__ __forceinline__ void attn_unit(int b,int h,int qb,const bf16*Q,const bf16*__restrict__ K,const bf16*__restrict__ V,bf16*O,char*shm){
  const int tid=threadIdx.x,lane=tid&63,r32=lane&31,hi=lane>>5; const int wid=__builtin_amdgcn_readfirstlane(tid>>6);
  const long rowbase=(long)b*SEQ; const int q0=qb*QB;
  const bf16*Qw=Q+(rowbase+q0+wid*QBLK)*QP+h*D;
  const int hk=h/(NHEAD/NKVH); const bf16*Kh=K+(long)(b*NKVH+hk)*SEQ*D,*Vh=V+(long)(b*NKVH+hk)*SEQ*D;
  const unsigned lds0=(unsigned)(uintptr_t)shm;
  float*wsf=(float*)(shm+LDS_WS)+wid*64;
  const bf16*ksrc=Kh+(wid*64+lane)*8;
  const bf16*vsrc=Vh+(wid*64+lane)*8;
  const unsigned kdst=lds0+LDS_K+wid*1024, vdst=lds0+LDS_V+wid*1024;
  #define DMA_K(t,slot) glds16(ksrc+(long)(t)*KVBLK*D,(unsigned)__builtin_amdgcn_readfirstlane(kdst+(slot)))
  #define DMA_V(t,slot) glds16(vsrc+(long)(t)*KVBLK*D,(unsigned)__builtin_amdgcn_readfirstlane(vdst+(slot)))
  const int vb0=(int)(lds0+LDS_V)+((lane>>4)&1)*32+(lane&3)*8+(4*hi+((lane&15)>>2))*64;
  const char*Kbase=shm+LDS_K; bf16x8 kf[8];
  const lds_cptr shm3=(lds_cptr)shm; const lds_cptr kp0=shm3+LDS_K+hi*1024+r32*16; const lds_cptr vp0=shm3+LDS_V+((lane>>4)&1)*32+(lane&3)*8+(4*hi+((lane&15)>>2))*64;
  constexpr int NT=SEQ/KVBLK;
  DMA_K(0,0);DMA_V(0,0);DMA_K(1,SLOTB);
  bf16x8 qr[4];
  #pragma unroll
  for(int d0=0;d0<4;++d0)qr[d0]=*reinterpret_cast<const bf16x8*>(&Qw[(long)r32*QP+d0*16+hi*8]);
  float mhat=0.f,l_reg=0.f;f32x16 o[2];o[0]=f32x16{};o[1]=f32x16{};f32x16 negm=f32x16{};asm volatile("":"+v"(negm));
  const int qrel=wid*QBLK+r32;
  #define CMASK(P0,P1,t) do{}while(0)
  bool resc=false;
  #define START(P0,P1) do{ const float rm=rowmax(P0,P1); resc=false; \
    { const float dl=rm; mhat=fadd_s(mhat,dl); \
      _Pragma("unroll") for(int r=0;r<16;++r){P0[r]=fsub_s(P0[r],dl);P1[r]=fsub_s(P1[r],dl);} \
      _Pragma("unroll") for(int r=0;r<16;++r)negm[r]=-mhat; asm volatile("":"+v"(negm)); } \
    _Pragma("unroll") for(int r=0;r<16;++r)P0[r]=__builtin_amdgcn_exp2f(P0[r]); }while(0)
  #define RESC() do{ if(resc){ asm volatile("s_waitcnt lgkmcnt(0)":::"memory"); \
      _Pragma("unroll") for(int d_=0;d_<2;++d_) _Pragma("unroll") for(int r=0;r<16;++r)o[d_][r]*=wsf[crow(r,hi)]; } }while(0)
  f32x16 pA0,pA1,pB0,pB1;
  int sl_prev=0,sl_cur=0,sl_next=SLOTB;
  #define ROT() do{sl_prev=sl_cur;sl_cur=sl_next;sl_next=(sl_next==(NSLOT-1)*SLOTB)?0:sl_next+SLOTB;}while(0)
  DMA_K(2,2*SLOTB);
  WAIT_BAR(3);
  qkt(pA0,pA1,Kbase,qr,negm,r32,hi);asm volatile("s_nop 15\n\ts_nop 7":"+v"(pA0),"+v"(pA1));CMASK(pA0,pA1,0);
  START(pA0,pA1);
  _Pragma("unroll") for(int r=0;r<16;++r)pA1[r]=__builtin_amdgcn_exp2f(pA1[r]);
  WAIT_BAR(0);
  DMA_K(3,0);DMA_V(1,SLOTB);
  ROT();
  kload8(kf,kp0+sl_cur);
  WAIT_BAR(2);
  s16x4 vlo[8],vhi[8]; u32x4 pw0,pw1,pw2,pw3;
  #define PKW(P,B) cvtpk_s(P[B],P[B+1])
  #define PAF(k) __builtin_bit_cast(bf16x8,pw##k)
  #define VFR(i) (bf16x8){vlo[i][0],vlo[i][1],vlo[i][2],vlo[i][3],vhi[i][0],vhi[i][1],vhi[i][2],vhi[i][3]}
  #define PIN(x) asm volatile("":"+v"(x))
  #define MX3(a,b,c) __builtin_fmaxf(__builtin_fmaxf((a),(b)),(c))
  #define GAPA(MF,A0,A1,A2,A3,W0,W1,PW) do{ MF; sacc+=A0; sacc+=A1; sacc+=A2; sacc+=A3; PIN(sacc); W0; W1; PIN(PW); SBAR(); }while(0)
  #define EX(v) __builtin_amdgcn_exp2f(v)
  #define GAPB(MF,X,B) do{ MF; X[B]=EX(X[B]); X[B+1]=EX(X[B+1]); X[B+2]=EX(X[B+2]); X[B+3]=EX(X[B+3]); PIN(X); SBAR(); }while(0)
  #define VRD(i) do{ vlo[i]=vtr(vp_+(((i)>>2)*4096+((i)&3)*1024)); vhi[i]=vtr(vp_+(((i)>>2)*4096+((i)&3)*1024+512)); }while(0)
  #define KRD(G,j) do{ if(G){ kload2(kf,kp0+sl_next,j); SBAR(); } }while(0)
  #define STEP(C0,C1,P0,P1,t,GK,GV,GL) do{ SBAR(); \
    const lds_cptr vp_=vp0+sl_prev; \
    VRD(0); SBAR(); float sacc=(P0[0]+P0[1]); \
    GAPA(C0=__builtin_amdgcn_mfma_f32_32x32x16_bf16(kf[0],qr[0],negm,0,0,0), P0[2],P0[3],P0[4],P0[5],     pw0[0]=PKW(P0,0), pw0[1]=PKW(P0,2), pw0); \
    VRD(4); SBAR(); GAPA(C1=__builtin_amdgcn_mfma_f32_32x32x16_bf16(kf[1],qr[0],negm,0,0,0), P0[6],P0[7],P0[8],P0[9],     pw0[2]=PKW(P0,4), pw0[3]=PKW(P0,6), pw0); \
    VRD(1); SBAR(); GAPA(C0=__builtin_amdgcn_mfma_f32_32x32x16_bf16(kf[2],qr[1],C0,0,0,0),   P0[10],P0[11],P0[12],P0[13], pw1[0]=PKW(P0,8), pw1[1]=PKW(P0,10), pw1); \
    VRD(5); SBAR(); GAPA(C1=__builtin_amdgcn_mfma_f32_32x32x16_bf16(kf[3],qr[1],C1,0,0,0),   P0[14],P0[15],P1[0],P1[1],   pw1[2]=PKW(P0,12),pw1[3]=PKW(P0,14), pw1); \
    VRD(2); SBAR(); GAPA(C0=__builtin_amdgcn_mfma_f32_32x32x16_bf16(kf[4],qr[2],C0,0,0,0),   P1[2],P1[3],P1[4],P1[5],     pw2[0]=PKW(P1,0), pw2[1]=PKW(P1,2), pw2); \
    VRD(6); SBAR(); GAPA(C1=__builtin_amdgcn_mfma_f32_32x32x16_bf16(kf[5],qr[2],C1,0,0,0),   P1[6],P1[7],P1[8],P1[9],     pw2[2]=PKW(P1,4), pw2[3]=PKW(P1,6), pw2); \
    VRD(3); SBAR(); GAPA(C0=__builtin_amdgcn_mfma_f32_32x32x16_bf16(kf[6],qr[3],C0,0,0,0),   P1[10],P1[11],P1[12],P1[13], pw3[0]=PKW(P1,8), pw3[1]=PKW(P1,10), pw3); \
    VRD(7); SBAR(); GAPA(C1=__builtin_amdgcn_mfma_f32_32x32x16_bf16(kf[7],qr[3],C1,0,0,0),   P1[14],P1[15],0.f,0.f,       pw3[2]=PKW(P1,12),pw3[3]=PKW(P1,14), pw3); \
    l_reg+=sacc; \
    if(GK){DMA_K((t)+3,sl_cur);} if(GV){DMA_V((t)+1,sl_next);} \
    CMASK(C0,C1,t); \
    { float a=MX3(C0[0],C0[1],C1[0]),b=MX3(C0[2],C0[3],C1[1]); a=MX3(a,C1[2],C1[3]); \
      _Pragma("unroll") for(int r=4;r<16;r+=4){a=MX3(a,C0[r],C0[r+1]);b=MX3(b,C0[r+2],C0[r+3]);a=MX3(a,C1[r],C1[r+1]);b=MX3(b,C1[r+2],C1[r+3]);} \
      float rm=__builtin_fmaxf(a,b); { auto rr=__builtin_amdgcn_permlane32_swap(__float_as_uint(rm),__float_as_uint(rm),false,false); rm=__builtin_fmaxf(__uint_as_float(rr[0]),__uint_as_float(rr[1])); } \
      resc=false; \
      if(__builtin_expect(__any(rm>(float)THRL),0)){ const float dl=__builtin_fmaxf(rm,0.f); mhat+=dl; \
        _Pragma("unroll") for(int r=0;r<16;++r){C0[r]-=dl;C1[r]-=dl;} \
        _Pragma("unroll") for(int r=0;r<16;++r)negm[r]=-mhat; asm volatile("":"+v"(negm)); \
        const float f=__builtin_amdgcn_exp2f(-dl); l_reg*=f; if(hi==0)wsf[r32]=f; resc=true; } } \
    SBAR(); \
    GAPB(o[0]=__builtin_amdgcn_mfma_f32_32x32x16_bf16(PAF(0),VFR(0),o[0],0,0,0), C0,0); \
    GAPB(o[1]=__builtin_amdgcn_mfma_f32_32x32x16_bf16(PAF(0),VFR(4),o[1],0,0,0), C0,4); \
    KRD(GL,0); GAPB(o[0]=__builtin_amdgcn_mfma_f32_32x32x16_bf16(PAF(1),VFR(1),o[0],0,0,0), C0,8); \
    KRD(GL,1); GAPB(o[1]=__builtin_amdgcn_mfma_f32_32x32x16_bf16(PAF(1),VFR(5),o[1],0,0,0), C0,12); \
    KRD(GL,2); GAPB(o[0]=__builtin_amdgcn_mfma_f32_32x32x16_bf16(PAF(2),VFR(2),o[0],0,0,0), C1,0); \
    KRD(GL,3); GAPB(o[1]=__builtin_amdgcn_mfma_f32_32x32x16_bf16(PAF(2),VFR(6),o[1],0,0,0), C1,4); \
    GAPB(o[0]=__builtin_amdgcn_mfma_f32_32x32x16_bf16(PAF(3),VFR(3),o[0],0,0,0), C1,8); \
    GAPB(o[1]=__builtin_amdgcn_mfma_f32_32x32x16_bf16(PAF(3),VFR(7),o[1],0,0,0), C1,12); \
    }while(0)
  int t=1;
  #undef CMASK
  #define CMASK(P0,P1,t) do{}while(0)
  for(;t+5<NT;t+=2){
    STEP(pB0,pB1,pA0,pA1,t,true,true,true);     WAIT_BAR(2); RESC(); ROT();
    STEP(pA0,pA1,pB0,pB1,t+1,true,true,true);   WAIT_BAR(2); RESC(); ROT();
  }
  #undef CMASK
  #define CMASK(P0,P1,t) do{}while(0)
  #define ENDW(tt) do{ if((tt)+3<NT){WAIT_BAR(2);} else if((tt)+2<NT){WAIT_BAR(1);} else {WAIT_BAR(0);} }while(0)
  for(;t+1<NT;t+=2){
    STEP(pB0,pB1,pA0,pA1,t,(t+3<NT),(t+1<NT),(t+1<NT));       ENDW(t);   RESC(); ROT();
    STEP(pA0,pA1,pB0,pB1,t+1,(t+4<NT),(t+2<NT),(t+2<NT));     ENDW(t+1); RESC(); ROT();
  }
  STEP(pB0,pB1,pA0,pA1,NT-1,false,false,false); RESC();
  { float sacc=pB0[0]+pB0[1]; _Pragma("unroll") for(int r=2;r<16;++r)sacc+=pB0[r]; _Pragma("unroll") for(int r=0;r<16;++r)sacc+=pB1[r]; l_reg+=sacc;
    pw0=(u32x4){PKW(pB0,0),PKW(pB0,2),PKW(pB0,4),PKW(pB0,6)};pw1=(u32x4){PKW(pB0,8),PKW(pB0,10),PKW(pB0,12),PKW(pB0,14)};pw2=(u32x4){PKW(pB1,0),PKW(pB1,2),PKW(pB1,4),PKW(pB1,6)};pw3=(u32x4){PKW(pB1,8),PKW(pB1,10),PKW(pB1,12),PKW(pB1,14)};
    SBAR(); pv(o,vb0+sl_cur,PAF(0),PAF(1),PAF(2),PAF(3)); }
  #undef PKW
  #undef PAF
  #undef VFR
  #undef PIN
  #undef MX3
  #undef GAPA
  #undef GAPB
  #undef EX
  #undef VRD
  #undef KRD
  #undef STEP
  #undef ENDW
  {auto rr=__builtin_amdgcn_permlane32_swap(__float_as_uint(l_reg),__float_as_uint(l_reg),false,false);l_reg=__uint_as_float(rr[0])+__uint_as_float(rr[1]);}
  if(hi==0)wsf[32+r32]=l_reg;asm volatile("s_waitcnt lgkmcnt(0)":::"memory");
  float rli[16];
  #pragma unroll
  for(int r=0;r<16;++r)rli[r]=__builtin_amdgcn_rcpf(wsf[32+crow(r,hi)]);
  bf16*Ow=O+(rowbase+q0+wid*QBLK)*OP+h*D;
  { bf16*stg=(bf16*)(shm+LDS_OST)+wid*2048;
    #pragma unroll
    for(int r=0;r<16;++r){const int orow=crow(r,hi);
      #pragma unroll
      for(int d0=0;d0<2;++d0)stg[orow*64+d0*32+r32]=__float2bfloat16(o[d0][r]*rli[r]);}
    asm volatile("s_waitcnt lgkmcnt(0)":::"memory");
    #pragma unroll
    for(int i=0;i<4;++i){const int row=i*8+(lane>>3),ch=lane&7; const u32x4 v=*(const u32x4*)(stg+row*64+ch*8); ATTN_STORE16(Ow+(long)row*OP+ch*8,v);} }
  asm volatile("s_waitcnt lgkmcnt(0)\n\ts_barrier":::"memory");
  #undef DMA_K
  #undef DMA_V
  #undef CMASK
  #undef START
  #undef RESC
  #undef ROT
}
constexpr int ATTN_LDS_BYTES=LDS_BYTES;
struct AttnTensors { const bf16* Q; const bf16* K; const bf16* V; bf16* O; };
struct AttnUnit { int bh; int qb; };
struct StaticOrder {
  int vcu, G;
  __device__ __forceinline__ explicit StaticOrder(int grid,int block):vcu((grid%8==0)?(block%8)*(grid/8)+block/8:block),G(grid){}
  __device__ __forceinline__ bool next(int i,AttnUnit&u)const{
    const int L=i*G+vcu; if(L>=BATCH*NHEAD*NQB)return false;
    if(G==256){ if(i>=2)return false; const int x=vcu>>5,j=vcu&31; const int b=x>>2,kvh=(x>>1)&1,hq=kvh*4+2*(x&1)+i; u.bh=b*NHEAD+hq; u.qb=j; return true; }
    u.bh=L/NQB; u.qb=L%NQB; return true; }
  __device__ __forceinline__ void a_ready(const AttnUnit&)const{}
  __device__ __forceinline__ void done(const AttnUnit&)const{}
};
template<class Sched,int THRL=8> __device__ __forceinline__ void attn_phase(char*lds,const AttnTensors&T,const Sched&S){
  AttnUnit u;
  for(int i=0;S.next(i,u);++i){ S.a_ready(u); attn_unit<THRL>(u.bh/NHEAD,u.bh%NHEAD,u.qb,T.Q,T.K,T.V,T.O,lds); S.done(u); }
}
#undef SBAR
#undef WAIT_BAR
}

#include <hip/hip_cooperative_groups.h>
namespace cg = cooperative_groups;
#ifndef MK_PER_PHASE
#define MK_PER_PHASE 0
#endif
constexpr int NWAVES = 8, NTHREADS = 512;
constexpr int NB = 2, SEQ = 8192, DMODEL = 1024, TT = NB * SEQ;
constexpr int NPROJ = 2816;
constexpr int NEXP = 32, FFE = 512;
constexpr float EPS = 1e-6f;
constexpr int N_PHASES = 12;

constexpr size_t MiB = 1u << 20;
constexpr size_t WS_CTL = 0, CTL_ZERO_BYTES = 64 * 1024;
constexpr size_t WS_WOUT = 1 * MiB;
constexpr size_t WS_LIST = 229 * MiB;
constexpr size_t WS_WR = 3 * MiB;
constexpr size_t WS_TOK = 3 * MiB + 256 * 1024;
constexpr size_t WS_GATES = 4 * MiB;
constexpr size_t WS_WIN = 5 * MiB;
constexpr size_t WS_WSI = 3 * MiB + 896 * 1024;
constexpr size_t WS_XSC = 3 * MiB + 912 * 1024;
constexpr size_t WS_A = 11 * MiB;
constexpr size_t WS_XN = WS_A;
constexpr size_t GDN_SH_BYTES = 71680, GDN_D_BYTES = 19456;
constexpr size_t WS_GSH = WS_A;
constexpr size_t WS_GD = WS_A + 1024 * GDN_SH_BYTES;
constexpr size_t WS_X1 = 5 * MiB;
constexpr size_t WS_HID = 69 * MiB;
constexpr size_t WS_XBUF = 109 * MiB;
constexpr size_t WS_B = 157 * MiB;
constexpr size_t WS_QKVA = WS_B;
constexpr size_t WS_QKVB = WS_B + 48 * MiB;
constexpr size_t WS_ZA = WS_B + 72 * MiB;
constexpr size_t WS_OCAT = WS_B;
constexpr size_t WS_WGU0 = 189 * MiB, WS_WGU1 = 245 * MiB; constexpr int WGU_SPLIT = 20;
constexpr size_t WS_WSC = 3 * MiB + 768 * 1024;
constexpr float ACT_CLIP = 6.0f;
constexpr size_t DO_WD0 = 0, DO_WD1 = 56 * MiB; constexpr int WD_SPLIT = 24;
constexpr size_t DO_HN = 24 * MiB;
constexpr size_t WS_END = 269 * MiB;
static_assert(WS_GD + 4096 * GDN_D_BYTES <= WS_B, "GDN records fit region A");
static_assert(WS_X1 + 64 * MiB <= WS_HID && WS_HID + 40928ull * 1024 <= WS_XBUF && WS_XBUF + 40928ull * 2048 <= WS_WGU0, "post-scan map");
static_assert(WS_WGU0 + WGU_SPLIT * MiB <= WS_B + 72 * MiB && WS_WGU1 + (32 - WGU_SPLIT) * MiB <= 269 * MiB, "WGU fragments");
constexpr size_t DO_QR = 0, DO_KR = 16 * MiB, DO_VR = 20 * MiB, DO_OF = 24 * MiB, DO_OB = 40 * MiB;
constexpr int CW_CNT = 2048;
constexpr int CW_NTILE = 128;
constexpr int CW_ETAB = 192;
constexpr int CW_SCANQ = 1024;

constexpr int LDS_BYTES = 160 * 1024;

#define GAS __attribute__((address_space(1)))
#define LAS __attribute__((address_space(3)))
typedef unsigned short bf16;
typedef unsigned v4u __attribute__((ext_vector_type(4)));
typedef unsigned v2u __attribute__((ext_vector_type(2)));
typedef float f32x4 __attribute__((ext_vector_type(4)));
typedef short bf16x8 __attribute__((ext_vector_type(8)));
typedef short s16x4 __attribute__((ext_vector_type(4)));
#define DI __device__ __forceinline__

DI unsigned f2bf(float f) { unsigned u = __builtin_bit_cast(unsigned, f); return (u + 0x7fffu + ((u >> 16) & 1u)) >> 16; }
typedef float f32x2_t __attribute__((ext_vector_type(2))); typedef __bf16 bf16x2_t __attribute__((ext_vector_type(2)));
DI unsigned pk2(float lo, float hi) { f32x2_t v = {lo, hi}; bf16x2_t b = __builtin_convertvector(v, bf16x2_t); return __builtin_bit_cast(unsigned, b); }
DI float bf2f(unsigned short h) { return __builtin_bit_cast(float, (unsigned)h << 16); }
DI float bflo(unsigned w) { return __builtin_bit_cast(float, w << 16); }
DI float bfhi(unsigned w) { return __builtin_bit_cast(float, w & 0xffff0000u); }
DI unsigned q8x4(float a, float b, float c, float d, float sc) {
    const float M = 12582912.f;
    const unsigned ua = __builtin_bit_cast(unsigned, fminf(fmaxf(a * sc, -127.f), 127.f) + M), ub = __builtin_bit_cast(unsigned, fminf(fmaxf(b * sc, -127.f), 127.f) + M);
    const unsigned uc = __builtin_bit_cast(unsigned, fminf(fmaxf(c * sc, -127.f), 127.f) + M), ud = __builtin_bit_cast(unsigned, fminf(fmaxf(d * sc, -127.f), 127.f) + M);
    return (ua & 255u) | ((ub & 255u) << 8) | ((uc & 255u) << 16) | (ud << 24);
}
DI float wave_max(float v) {
#pragma unroll
    for (int o = 1; o < 64; o <<= 1) v = fmaxf(v, __shfl_xor(v, o));
    return v;
}
DI float act_absmax(const float* nfw, int lane) {
    float m = 0.f;
#pragma unroll
    for (int i = 0; i < 16; ++i) m = fmaxf(m, fabsf(nfw[lane + 64 * i]));
    return ACT_CLIP * wave_max(m);
}
DI float wave_sum(float v) {
#pragma unroll
    for (int o = 1; o < 64; o <<= 1) v += __shfl_xor(v, o);
    return v;
}
DI float siluf(float x) { return x * __builtin_amdgcn_rcpf(1.0f + __expf(-x)); }
DI float sigmoidf_(float x) { return 1.0f / (1.0f + __expf(-x)); }
DI int perm32i(int idx) { return ((idx >> 2) & 3) * 8 + (idx >> 4) * 4 + (idx & 3); }
DI int permcol(int c) { return (c & ~31) + perm32i(c & 31); }
template <class T> DI T opaque(T p) { asm volatile("" : "+v"(p)); return p; }

typedef GAS unsigned gu32;
#define RLX_AGENT __ATOMIC_RELAXED, __HIP_MEMORY_SCOPE_AGENT
constexpr int CW_BAR = 4096;
constexpr int MISC_OFF = LDS_BYTES - 64;
#define XB_TMO      128
#define XB_XCNT(j)  (256  + 64 * (j))
#define XB_XSUB(j)  (1280 + 64 * (j))
#define XB_XGEN(j)  (2304 + 64 * (j))
#define XB_TOP      3328
#define XB_TOPGEN   3392
#define XCD_BAR_WORDS 3456
#define XB_SPIN_CAP (1u << 18)

__device__ __forceinline__ unsigned xb_ld(unsigned* p)              { return __hip_atomic_load(p, __ATOMIC_RELAXED, __HIP_MEMORY_SCOPE_AGENT); }
__device__ __forceinline__ unsigned xb_add(unsigned* p, unsigned v) { return __hip_atomic_fetch_add(p, v, __ATOMIC_RELAXED, __HIP_MEMORY_SCOPE_AGENT); }
__device__ __forceinline__ unsigned xb_xcc_id() { return (unsigned)__builtin_amdgcn_s_getreg((3 << 11) | 20) & 0xFu; }
#define XB_SPIN(cond, bar) do { unsigned _sp = 0; while (cond) { __builtin_amdgcn_s_sleep(1); \
    if ((++_sp & 255u) == 0u) { if (xb_ld(&(bar)[XB_TMO])) break; if (_sp > XB_SPIN_CAP) { atomicAdd(&(bar)[XB_TMO], 1u); break; } } } } while (0)

struct XcdBarrier {
    unsigned* bar; unsigned x;
    volatile LAS unsigned* st;
};

__device__ __forceinline__ XcdBarrier xcd_barrier_post(unsigned* bar, volatile LAS unsigned* st) {
    XcdBarrier b; b.bar = bar; b.x = xb_xcc_id(); b.st = st;
    if (threadIdx.x == 0) (void)xb_add(&bar[XB_XCNT(b.x)], 1u);
    return b;
}
__device__ __forceinline__ void xcd_barrier_complete(unsigned* bar, unsigned x, unsigned& nloc, unsigned& nx) {
    const unsigned G = gridDim.x * gridDim.y * gridDim.z;
    unsigned sum, cnt, mine, sp = 0u;
    for (;;) {
        sum = 0u; cnt = 0u; mine = 0u;
#pragma unroll
        for (unsigned j = 0; j < 16; ++j) { const unsigned c = xb_ld(&bar[XB_XCNT(j)]); sum += c; cnt += (c > 0u) ? 1u : 0u; mine = (j == x) ? c : mine; }
        if (sum == G) break;
        __builtin_amdgcn_s_sleep(1);
        if ((++sp & 255u) == 0u) { if (xb_ld(&bar[XB_TMO])) break; if (sp > XB_SPIN_CAP) { atomicAdd(&bar[XB_TMO], 1u); break; } }
    }
    nloc = mine > 0u ? mine : 1u; nx = cnt > 0u ? cnt : 1u;
}

__device__ __forceinline__ void xcd_barrier(const XcdBarrier& b) {
    asm volatile("s_waitcnt vmcnt(0)" ::: "memory");
    __syncthreads();
    if (threadIdx.x == 0) {
        unsigned* bar = b.bar;
        __builtin_amdgcn_s_waitcnt(0);
        unsigned nloc = b.st[0], nx = b.st[1];
        if (nloc == 0u) { xcd_barrier_complete(bar, b.x, nloc, nx); b.st[0] = nloc; b.st[1] = nx; }
        const unsigned old = xb_add(&bar[XB_XSUB(b.x)], 1u);
        const unsigned gen = old / nloc;
        if (old + 1u == (gen + 1u) * nloc) {
            __builtin_amdgcn_fence(__ATOMIC_RELEASE, "agent");
            asm volatile("s_waitcnt vmcnt(0)" ::: "memory");
            const unsigned og = xb_add(&bar[XB_TOP], 1u);
            const unsigned tg = og / nx;
            if (og + 1u == (tg + 1u) * nx) xb_add(&bar[XB_TOPGEN], 1u);
            else XB_SPIN(xb_ld(&bar[XB_TOPGEN]) == tg, bar);
            __builtin_amdgcn_fence(__ATOMIC_ACQUIRE, "agent");
            xb_add(&bar[XB_XGEN(b.x)], 1u);
            asm volatile("s_waitcnt vmcnt(0)" ::: "memory");
        } else {
            XB_SPIN(xb_ld(&bar[XB_XGEN(b.x)]) == gen, bar);
            __builtin_amdgcn_fence(__ATOMIC_ACQUIRE, "agent");
            asm volatile("s_waitcnt vmcnt(0)" ::: "memory");
        }
    }
    __syncthreads();
}

struct Frame {
    LAS unsigned char* lds;
    int tid, lane, wave, vcu, G;
    const float* in[17];
    float* out; unsigned char* ws;
};

DI void p0_transpose_item(const float* W, int ldw, int nblk, bf16* WT, int K, int row_off, int rmul, LAS float* scr, int item, int lane) {
    const int kb = item / nblk, nb = item % nblk, k0 = 64 * kb, n0 = 32 * nb;
    const int r8 = lane >> 3, c4 = (lane & 7) * 4;
    f32x4 v[8];
#pragma unroll
    for (int i = 0; i < 8; ++i) v[i] = __builtin_nontemporal_load((const f32x4*)(W + (size_t)(k0 + 8 * i + r8) * ldw + n0 + c4));
#pragma unroll
    for (int i = 0; i < 8; ++i) { LAS float* d = scr + (8 * i + r8) * 33 + c4; d[0] = v[i].x; d[1] = v[i].y; d[2] = v[i].z; d[3] = v[i].w; }
    asm volatile("s_waitcnt lgkmcnt(0)" ::: "memory");
    const int c = lane & 7;
#pragma unroll
    for (int j = 0; j < 4; ++j) { const int n = (lane >> 3) + 8 * j; const LAS float* s = scr + (8 * c) * 33 + n;
        v4u o; o.x = pk2(s[0 * 33], s[1 * 33]); o.y = pk2(s[2 * 33], s[3 * 33]); o.z = pk2(s[4 * 33], s[5 * 33]); o.w = pk2(s[6 * 33], s[7 * 33]);
        *(GAS v4u*)(WT + (size_t)(row_off + (n0 + n) * rmul) * K + k0 + 8 * c) = o; }
    asm volatile("s_waitcnt lgkmcnt(0)" ::: "memory");
}
template <int NR> DI void rms_rows_to_bf16(const float* const (&xrow)[NR], const float* w, bf16* const (&orow)[NR], int lane) {
    const GAS f32x4* wr = (const GAS f32x4*)w + lane;
    f32x4 v[NR][4];
#pragma unroll
    for (int r = 0; r < NR; ++r) { const GAS f32x4* xr = (const GAS f32x4*)xrow[r] + lane;
#pragma unroll
        for (int j = 0; j < 4; ++j) v[r][j] = xr[64 * j]; }
    f32x4 ww[4];
#pragma unroll
    for (int j = 0; j < 4; ++j) ww[j] = wr[64 * j];
#pragma unroll
    for (int r = 0; r < NR; ++r) {
        float s_ = 0.f;
#pragma unroll
        for (int j = 0; j < 4; ++j) s_ += (v[r][j].x * v[r][j].x + v[r][j].y * v[r][j].y) + (v[r][j].z * v[r][j].z + v[r][j].w * v[r][j].w);
        const float rs = __builtin_amdgcn_rsqf(wave_sum(s_) * (1.f / DMODEL) + EPS);
        GAS v2u* o8 = (GAS v2u*)orow[r] + lane;
#pragma unroll
        for (int j = 0; j < 4; ++j) { v2u o; o.x = pk2(v[r][j].x * rs * ww[j].x, v[r][j].y * rs * ww[j].y); o.y = pk2(v[r][j].z * rs * ww[j].z, v[r][j].w * rs * ww[j].w); o8[64 * j] = o; }
    }
}
DI void q_strip(const float* W, int ldw, int n0, unsigned char* WQ, float* wsc, int rowbase, int rmul, LAS unsigned char* lds, int wave, int lane) {
    LAS float* scr = (LAS float*)(lds + wave * 8704); LAS float* cmx = (LAS float*)(lds + 8 * 8704);
    const int r8 = lane >> 3, c4 = (lane & 7) * 4, kw = 128 * wave;
    f32x4 mx = (f32x4){0.f, 0.f, 0.f, 0.f};
#pragma unroll
    for (int i = 0; i < 16; ++i) { const f32x4 v = *(const f32x4*)(W + (size_t)(kw + 8 * i + r8) * ldw + n0 + c4);
        mx.x = fmaxf(mx.x, fabsf(v.x)); mx.y = fmaxf(mx.y, fabsf(v.y)); mx.z = fmaxf(mx.z, fabsf(v.z)); mx.w = fmaxf(mx.w, fabsf(v.w)); }
#pragma unroll
    for (int o = 8; o < 64; o <<= 1) { mx.x = fmaxf(mx.x, __shfl_xor(mx.x, o)); mx.y = fmaxf(mx.y, __shfl_xor(mx.y, o)); mx.z = fmaxf(mx.z, __shfl_xor(mx.z, o)); mx.w = fmaxf(mx.w, __shfl_xor(mx.w, o)); }
    if (lane < 8) *(LAS f32x4*)(cmx + wave * 32 + c4) = mx;
    __syncthreads();
    float sq[4];
#pragma unroll
    for (int j = 0; j < 4; ++j) { const int n = (lane >> 3) + 8 * j; float m = cmx[n];
#pragma unroll
        for (int w = 1; w < 8; ++w) m = fmaxf(m, cmx[w * 32 + n]);
        sq[j] = m > 0.f ? 127.0f / m : 0.f;
        if (wave == 0 && (lane & 7) == 0) wsc[rowbase + n * rmul] = m * (1.0f / 127.0f); }
    const int c = lane & 7;
#pragma unroll
    for (int kb = 0; kb < 2; ++kb) {
        const int k0 = kw + 64 * kb;
        f32x4 v[8];
#pragma unroll
        for (int i = 0; i < 8; ++i) v[i] = *(const f32x4*)(W + (size_t)(k0 + 8 * i + r8) * ldw + n0 + c4);
#pragma unroll
        for (int i = 0; i < 8; ++i) { LAS float* d = scr + (8 * i + r8) * 33 + c4; d[0] = v[i].x; d[1] = v[i].y; d[2] = v[i].z; d[3] = v[i].w; }
        asm volatile("s_waitcnt lgkmcnt(0)" ::: "memory");
#pragma unroll
        for (int j = 0; j < 4; ++j) { const int n = (lane >> 3) + 8 * j; const LAS float* t = scr + (8 * c) * 33 + n;
            v2u o; o.x = q8x4(t[0 * 33], t[1 * 33], t[2 * 33], t[3 * 33], sq[j]); o.y = q8x4(t[4 * 33], t[5 * 33], t[6 * 33], t[7 * 33], sq[j]);
            *(GAS v2u*)(WQ + (size_t)(rowbase + n * rmul) * 1024 + k0 + 8 * c) = o; }
        asm volatile("s_waitcnt lgkmcnt(0)" ::: "memory");
    }
    __syncthreads();
}
DI float reduce16(const float (&ga)[16], int lane) {
    float gb[8], gc[4], gd[2];
    { const bool hi = (lane & 32) != 0;
#pragma unroll
      for (int i = 0; i < 8; ++i) { const float snd = hi ? ga[i] : ga[i + 8], kp = hi ? ga[i + 8] : ga[i]; gb[i] = kp + __shfl_xor(snd, 32); } }
    { const bool hi = (lane & 16) != 0;
#pragma unroll
      for (int i = 0; i < 4; ++i) { const float snd = hi ? gb[i] : gb[i + 4], kp = hi ? gb[i + 4] : gb[i]; gc[i] = kp + __shfl_xor(snd, 16); } }
    { const bool hi = (lane & 8) != 0;
#pragma unroll
      for (int i = 0; i < 2; ++i) { const float snd = hi ? gc[i] : gc[i + 2], kp = hi ? gc[i + 2] : gc[i]; gd[i] = kp + __shfl_xor(snd, 8); } }
    float res;
    { const bool hi = (lane & 4) != 0; const float snd = hi ? gd[0] : gd[1], kp = hi ? gd[1] : gd[0]; res = kp + __shfl_xor(snd, 4); }
    res += __shfl_xor(res, 1); res += __shfl_xor(res, 2);
    return res;
}
DI void rms_rows_to_q8(const float* const (&xrow)[2], const float* w, unsigned char* const (&orow)[2], float* const (&xsc)[2], float* const (&gout)[2], const LAS float* gw_, int lane) {
    const LAS float* gw = gw_;
    gw = opaque(gw);
    const GAS f32x4* wr = (const GAS f32x4*)w + lane;
    f32x4 v[2][4];
#pragma unroll
    for (int r = 0; r < 2; ++r) { const GAS f32x4* xr = (const GAS f32x4*)xrow[r] + lane;
#pragma unroll
        for (int j = 0; j < 4; ++j) v[r][j] = xr[64 * j]; }
    f32x4 ww[4];
#pragma unroll
    for (int j = 0; j < 4; ++j) ww[j] = wr[64 * j];
#pragma unroll
    for (int r = 0; r < 2; ++r) {
        float s_ = 0.f;
#pragma unroll
        for (int j = 0; j < 4; ++j) s_ += (v[r][j].x * v[r][j].x + v[r][j].y * v[r][j].y) + (v[r][j].z * v[r][j].z + v[r][j].w * v[r][j].w);
        const float rs = __builtin_amdgcn_rsqf(wave_sum(s_) * (1.f / DMODEL) + EPS);
        float am = 0.f;
#pragma unroll
        for (int j = 0; j < 4; ++j) { v[r][j] = v[r][j] * ww[j] * rs; am = fmaxf(fmaxf(am, fmaxf(fabsf(v[r][j].x), fabsf(v[r][j].y))), fmaxf(fabsf(v[r][j].z), fabsf(v[r][j].w))); }
        am = wave_max(am);
        const float qsc = am > 0.f ? 127.0f / am : 0.f;
        if (lane == 0) *xsc[r] = am * (1.0f / 127.0f);
        GAS unsigned* o4 = (GAS unsigned*)orow[r] + lane;
#pragma unroll
        for (int j = 0; j < 4; ++j) o4[64 * j] = q8x4(v[r][j].x, v[r][j].y, v[r][j].z, v[r][j].w, qsc);
    }
#ifndef NO_GATES
    float ga[2][16];
#pragma unroll
    for (int c = 0; c < 16; ++c) { ga[0][c] = 0.f; ga[1][c] = 0.f; }
    asm volatile("" : "+v"(v[0][0]), "+v"(v[0][1]), "+v"(v[0][2]), "+v"(v[0][3]), "+v"(v[1][0]), "+v"(v[1][1]), "+v"(v[1][2]), "+v"(v[1][3]));
#pragma unroll
    for (int j = 0; j < 4; ++j)
#pragma unroll
        for (int q = 0; q < 4; ++q) { const LAS f32x4* g4 = (const LAS f32x4*)gw + ((j * 4 + q) * 4) * 64 + lane;
            const f32x4 g0 = g4[0], g1 = g4[64], g2 = g4[128], g3 = g4[192];
#pragma unroll
            for (int r = 0; r < 2; ++r) { const float h = v[r][j][q];
                ga[r][0] += h * g0.x; ga[r][1] += h * g0.y; ga[r][2] += h * g0.z; ga[r][3] += h * g0.w; ga[r][4] += h * g1.x; ga[r][5] += h * g1.y; ga[r][6] += h * g1.z; ga[r][7] += h * g1.w;
                ga[r][8] += h * g2.x; ga[r][9] += h * g2.y; ga[r][10] += h * g2.z; ga[r][11] += h * g2.w; ga[r][12] += h * g3.x; ga[r][13] += h * g3.y; ga[r][14] += h * g3.z; ga[r][15] += h * g3.w; }
            asm volatile("" : "+v"(ga[1][0]), "+v"(ga[1][1]), "+v"(ga[1][2]), "+v"(ga[1][3]), "+v"(ga[1][4]), "+v"(ga[1][5]), "+v"(ga[1][6]), "+v"(ga[1][7]), "+v"(ga[1][8]), "+v"(ga[1][9]),
                         "+v"(ga[1][10]), "+v"(ga[1][11]), "+v"(ga[1][12]), "+v"(ga[1][13]), "+v"(ga[1][14]), "+v"(ga[1][15]) :: "memory"); }
    const int gc_ = ((lane >> 5) & 1) * 8 + ((lane >> 4) & 1) * 4 + ((lane >> 3) & 1) * 2 + ((lane >> 2) & 1);
#pragma unroll
    for (int r = 0; r < 2; ++r) { const float res = reduce16(ga[r], lane); if ((lane & 3) == 0) gout[r][gc_] = res; }
#endif
}
DI void p0_prologue(Frame& F) {
    const float* w_in = F.in[2];
    unsigned char* WIN = F.ws + WS_WIN; float* WSI = (float*)(F.ws + WS_WSI);
    constexpr int NSTRIP = 64 + 24;
    if (F.vcu < NSTRIP) { const int st = F.vcu;
        if (st < 64) q_strip(w_in, 2832, 32 * st, WIN, WSI, 32 * st, 1, F.lds, F.wave, F.lane);
        else q_strip(w_in + 2064, 2832, 32 * (st - 64), WIN, WSI, 2048 + 32 * (st - 64), 1, F.lds, F.wave, F.lane); }
    unsigned char* XN = F.ws + WS_XN; float* XSC = (float*)(F.ws + WS_XSC); float* GATES = (float*)(F.ws + WS_GATES);
    LAS float* gw = (LAS float*)(F.lds + 73728);
    for (int i = F.tid; i < 1024 * 4; i += NTHREADS) { const int k = i >> 2, c4 = i & 3, jj = k >> 8, qq = k & 3, ln = (k & 255) >> 2;
        *((LAS f32x4*)gw + ((jj * 4 + qq) * 4 + c4) * 64 + ln) = *(const f32x4*)(w_in + (size_t)k * 2832 + 2048 + c4 * 4); }
    __syncthreads();
    const int nst = (F.G < NSTRIP ? F.G : NSTRIP), NSLOT = nst * NWAVES + (F.G - nst) * NWAVES * 2;
    const int s0_ = (F.vcu < nst) ? F.vcu * NWAVES + F.wave : nst * NWAVES + ((F.vcu - nst) * NWAVES + F.wave) * 2, nmine = (F.vcu < nst) ? 1 : 2;
#pragma unroll 1
    for (int q = 0; q < nmine; ++q)
#pragma unroll 1
        for (int p = s0_ + q; p < TT / 2; p += NSLOT) { const int m = 2 * p;
            const float* const xr[2] = {F.in[0] + (size_t)m * DMODEL, F.in[0] + (size_t)(m + 1) * DMODEL}; unsigned char* const orw[2] = {XN + (size_t)m * DMODEL, XN + (size_t)(m + 1) * DMODEL};
            float* const xs[2] = {XSC + m, XSC + m + 1}; float* const go[2] = {GATES + (size_t)m * 16, GATES + (size_t)(m + 1) * 16};
            rms_rows_to_q8(xr, F.in[1], orw, xs, go, gw, F.lane); }
}

struct EpiProj {
    static constexpr bool PERM = true, AFTER_DRAIN = false;
    bf16 *qkva, *za, *qkvb; const float* wsi; const float* xsc;
    DI void operator()(const pg8::i32x4 (&acc)[2][2][4][2], const pg8::Unit& u, int wr, int wc, int fr, int fq) const {
        const int row0 = u.pm * 256 + wr * 64 + fr;
        const float* ws_ = wsi + u.pn * 256 + wc * 32 + 8 * fq;
        bf16* base; int ldc, colt;
        if (u.pn < 6) { base = qkva; ldc = 1536; colt = u.pn * 256; } else if (u.pn < 8) { base = za; ldc = 512; colt = (u.pn - 6) * 256; } else { base = qkvb; ldc = 768; colt = (u.pn - 8) * 256; }
        const int col0 = colt + wc * 32 + 8 * fq;
        f32x4 s0[2], s1[2];
#pragma unroll
        for (int bj = 0; bj < 2; ++bj) { s0[bj] = *(const f32x4*)(ws_ + bj * 128); s1[bj] = *(const f32x4*)(ws_ + bj * 128 + 4); }
        float rsc[2][4];
#pragma unroll
        for (int ai = 0; ai < 2; ++ai)
#pragma unroll
            for (int m = 0; m < 4; ++m) rsc[ai][m] = xsc[row0 + ai * 128 + m * 16];
#pragma unroll
        for (int ai = 0; ai < 2; ++ai)
#pragma unroll
            for (int m = 0; m < 4; ++m) { bf16* rowp = base + (size_t)(row0 + ai * 128 + m * 16) * ldc + col0; const float rr = rsc[ai][m];
#pragma unroll
                for (int bj = 0; bj < 2; ++bj) { const pg8::i32x4 a0 = acc[ai][bj][m][0], a1 = acc[ai][bj][m][1]; const f32x4 t0 = s0[bj] * rr, t1 = s1[bj] * rr; pg8::u32x4 w;
                    w.x = pg8::cvt_pk_bf16((float)a0[0] * t0[0], (float)a0[1] * t0[1]); w.y = pg8::cvt_pk_bf16((float)a0[2] * t0[2], (float)a0[3] * t0[3]);
                    w.z = pg8::cvt_pk_bf16((float)a1[0] * t1[0], (float)a1[1] * t1[1]); w.w = pg8::cvt_pk_bf16((float)a1[2] * t1[2], (float)a1[3] * t1[3]);
                    *(pg8::u32x4*)(rowp + bj * 128) = w; } }
    }
};
struct IdRows { DI int row(const pg8::Unit& u, int r) const { return u.pm * 256 + r; } };
struct EpiResid {
    static constexpr bool PERM = false, AFTER_DRAIN = false;
    const float* x; float* x1;
    DI void operator()(const pg8::f32x4 (&acc)[2][2][4][2], const pg8::Unit& u, int wr, int wc, int fr, int fq) const {
        const int row0 = u.pm * 256 + wr * 64 + fr, col0 = u.pn * 256 + wc * 32 + 4 * fq;
#pragma unroll
        for (int ai = 0; ai < 2; ++ai)
#pragma unroll
            for (int m = 0; m < 4; ++m) { const size_t off = (size_t)(row0 + ai * 128 + m * 16) * DMODEL + col0;
#pragma unroll
                for (int bj = 0; bj < 2; ++bj)
#pragma unroll
                    for (int n = 0; n < 2; ++n) { const pg8::f32x4 b = *(const pg8::f32x4*)(x + off + bj * 128 + n * 16); *(pg8::f32x4*)(x1 + off + bj * 128 + n * 16) = b + acc[ai][bj][m][n]; } }
    }
};
struct EpiGU {
    static constexpr bool PERM = true, AFTER_DRAIN = false;
    bf16* hid; const float* wsc; float ainv;
    DI void operator()(const pg8::i32x4 (&acc)[2][2][4][2], const pg8::Unit& u, int wr, int wc, int fr, int fq) const {
        const int row0 = u.pm * 256 + wr * 64 + fr; const int jt = u.pn & 3;
        const int ff0 = jt * 128 + wc * 16 + 4 * fq;
        const float* ws_ = wsc + u.ex * 1024 + jt * 256 + wc * 32 + 8 * fq;
        f32x4 s0[2], s1[2];
#pragma unroll
        for (int bj = 0; bj < 2; ++bj) { s0[bj] = *(const f32x4*)(ws_ + bj * 128) * ainv; s1[bj] = *(const f32x4*)(ws_ + bj * 128 + 4) * ainv; }
#pragma unroll
        for (int ai = 0; ai < 2; ++ai)
#pragma unroll
            for (int m = 0; m < 4; ++m) { bf16* rowp = hid + (size_t)(row0 + ai * 128 + m * 16) * FFE + ff0;
#pragma unroll
                for (int bj = 0; bj < 2; ++bj) { const pg8::i32x4 a0 = acc[ai][bj][m][0], a1 = acc[ai][bj][m][1];
                    const float g0 = (float)a0[0] * s0[bj][0], u0 = (float)a0[1] * s0[bj][1], g1 = (float)a0[2] * s0[bj][2], u1 = (float)a0[3] * s0[bj][3];
                    const float g2 = (float)a1[0] * s1[bj][0], u2 = (float)a1[1] * s1[bj][1], g3 = (float)a1[2] * s1[bj][2], u3 = (float)a1[3] * s1[bj][3];
                    v2u w; w.x = pg8::cvt_pk_bf16(siluf(g0) * u0, siluf(g1) * u1); w.y = pg8::cvt_pk_bf16(siluf(g2) * u2, siluf(g3) * u3);
                    *(v2u*)(rowp + bj * 64) = w; } }
    }
};
struct EpiY {
    static constexpr bool PERM = true, AFTER_DRAIN = false;
    bf16* y;
    DI void operator()(const pg8::f32x4 (&acc)[2][2][4][2], const pg8::Unit& u, int wr, int wc, int fr, int fq) const {
        const int row0 = u.pm * 256 + wr * 64 + fr; const int col0 = (u.pn & 3) * 256 + wc * 32 + 8 * fq;
#pragma unroll
        for (int ai = 0; ai < 2; ++ai)
#pragma unroll
            for (int m = 0; m < 4; ++m) { bf16* rowp = y + (size_t)(row0 + ai * 128 + m * 16) * DMODEL + col0;
#pragma unroll
                for (int bj = 0; bj < 2; ++bj) { const pg8::f32x4 v0 = acc[ai][bj][m][0], v1 = acc[ai][bj][m][1]; pg8::u32x4 w;
                    w.x = pg8::cvt_pk_bf16(v0[0], v0[1]); w.y = pg8::cvt_pk_bf16(v0[2], v0[3]); w.z = pg8::cvt_pk_bf16(v1[0], v1[1]); w.w = pg8::cvt_pk_bf16(v1[2], v1[3]);
                    *(pg8::u32x4*)(rowp + bj * 128) = w; } }
    }
};
constexpr int ETAB_OFF = 131072;
struct MoeOrder {
    const LAS unsigned* etab; int G, c, esplit, pnoff;
    DI bool next(int i, pg8::Unit& u) const {
        if (G % 8 != 0) {
            int L = i * G + c;
            for (int e = 0; e < NEXP; ++e) { const int n4 = 4 * (int)etab[2 * e + 1]; if (L < n4) { u.pm = (int)etab[2 * e] + (L >> 2); u.pn = (e < esplit ? 4 * e : pnoff + 4 * (e - esplit)) + (L & 3); u.ex = e; u.tq = L >> 2; return true; } L -= n4; }
            return false; }
        const int x = c & 7; int L = i * (G >> 3) + (c >> 3);
#pragma unroll
        for (int q = 0; q < NEXP / 8; ++q) { const int e = x + 8 * q; const int n4 = 4 * (int)etab[2 * e + 1];
            if (L < n4) { u.pm = (int)etab[2 * e] + (L >> 2); u.pn = (e < esplit ? 4 * e : pnoff + 4 * (e - esplit)) + (L & 3); u.ex = e; u.tq = L >> 2; return true; } L -= n4; }
        return false; }
    DI void a_ready(const pg8::Unit&) const {}
    DI void done(const pg8::Unit&) const {}
};
struct MoeRows {
    const int* list; const LAS unsigned* etab;
    DI int row(const pg8::Unit& u, int r) const {
        const int slot = u.tq * 256 + r, e = u.ex; if (slot >= (int)etab[64 + e]) return 0;
        const LAS unsigned* sp = etab + 96 + 8 * e; int sb = 0;
#pragma unroll
        for (int q = 1; q < 8; ++q) sb += (slot >= (int)sp[q]) ? 1 : 0;
        return list[(size_t)(e * 8 + sb) * TT + (slot - (int)sp[sb])]; }
};

DI void p2_rope(Frame& F) {
    const int gw = F.vcu * NWAVES + F.wave, NGW = F.G * NWAVES, lane = F.lane;
    const bf16* QKVB = (const bf16*)(F.ws + WS_QKVB);
    bf16* QR = (bf16*)((unsigned char*)F.out + DO_QR); bf16* KR = (bf16*)((unsigned char*)F.out + DO_KR); bf16* VR = (bf16*)((unsigned char*)F.out + DO_VR);
    const int pi = lane & 31, hsel = lane >> 5;
    const float qw0 = F.in[7][2 * pi], qw1 = F.in[7][2 * pi + 1], kw0 = F.in[8][2 * pi], kw1 = F.in[8][2 * pi + 1];
    const float invf = exp2f(-(float)(2 * (pi & 15)) * (13.287712379549449f / 32.0f));
    constexpr float C2 = 0.125f * 1.4426950408889634f;
    constexpr int NB4 = 4;
    for (int t0 = gw; t0 < TT; t0 += NB4 * NGW) {
        unsigned w[NB4][5], vw[NB4];
#pragma unroll
        for (int u = 0; u < NB4; ++u) { const int t = t0 + u * NGW; const unsigned* src = (const unsigned*)(QKVB + (size_t)(t < TT ? t : t0) * 768);
#pragma unroll
            for (int j = 0; j < 5; ++j) w[u][j] = src[(2 * j + hsel) * 32 + pi];
            vw[u] = src[320 + lane]; }
#pragma unroll
        for (int u = 0; u < NB4; ++u) {
            const int t = t0 + u * NGW; if (t >= TT) break;
            const int s_ = t & (SEQ - 1); const float pos = (pi < 16) ? (float)(s_ >> 6) : (float)(s_ & 63);
            const float ang = pos * invf;
            const float rev = ang * 0.15915494309189535f;
            const float sn = __builtin_amdgcn_sinf(rev), cs = __builtin_amdgcn_cosf(rev);
#pragma unroll
            for (int j = 0; j < 5; ++j) {
                const int head = 2 * j + hsel;
                const float x0 = bflo(w[u][j]), x1 = bfhi(w[u][j]);
                float ss = x0 * x0 + x1 * x1;
#pragma unroll
                for (int o = 1; o < 32; o <<= 1) ss += __shfl_xor(ss, o);
                const float rs = __builtin_amdgcn_rsqf(ss * (1.f / 64.f) + EPS);
                const bool isq = head < 8;
                const float y0 = x0 * rs * (isq ? qw0 : kw0), y1 = x1 * rs * (isq ? qw1 : kw1);
                float o0 = y0 * cs - y1 * sn, o1 = y0 * sn + y1 * cs;
                if (isq) { o0 *= C2; o1 *= C2; ((unsigned*)(QR + (size_t)t * 512))[head * 32 + pi] = pk2(o0, o1); }
                else { const int hk = head - 8, bq = t >> 13, sq = t & (SEQ - 1);
                    ((unsigned*)(KR + ((size_t)((bq * 2 + hk) * 128 + (sq >> 6)) * 8 + (pi >> 2)) * 512 + (sq & 63) * 8))[pi & 3] = pk2(o0, o1); }
            }
            { const int hk = lane >> 5, d = 2 * (lane & 31), bq = t >> 13, sq = t & (SEQ - 1), r = sq & 63;
              ((unsigned*)(VR + ((size_t)((bq * 2 + hk) * 128 + (sq >> 6)) * 8 + (d >> 5) * 4 + (r >> 4)) * 512 + ((r & 15) * 4 + ((d & 31) >> 3)) * 8))[(d & 7) >> 1] = vw[u]; }
        }
    }
}

constexpr int G_KNP = 0, G_QNP = 17408, G_KNTP = 34816, G_VCT = 53248;
constexpr int G_D0 = 71680, G_D1 = 71680 + 19456;
constexpr int GD_TBP = 0, GD_AP = 9216, GD_VEC = 18432;
constexpr int G_LM = 110592;
constexpr int G_GV = G_LM + 32768;
static_assert(G_GV + 2048 <= LDS_BYTES - 64, "gdn pre lds");

#define TRI_ROW(i, LC, LN) { \
        if ((i) + 1 < 64) { _Pragma("unroll") for (int j4 = 0; j4 < ((i) + 1 + 3) / 4 && j4 < 8; ++j4) LN[j4] = *(const LAS f32x4*)(L + ((i) + 1) * 64 + 4 * j4); } \
        _Pragma("unroll") for (int j4 = 8; j4 < ((i) + 3) / 4; ++j4) lt[j4 - 8] = *(const LAS f32x4*)(L + (i) * 64 + 4 * j4); \
        __builtin_amdgcn_sched_barrier(0); \
        f32x2_t a0 = {(lane == (i)) ? 1.0f : 0.0f, 0.f}, a1 = {0.f, 0.f}; \
        _Pragma("unroll") for (int j4 = 0; j4 < ((i) + 3) / 4; ++j4) { const f32x4 l = (j4 < 8) ? LC[j4 & 7] : lt[(j4 - 8) & 7]; \
            f32x2_t l0 = {l.x, (4 * j4 + 1 < (i)) ? l.y : 0.f}, l1 = {(4 * j4 + 2 < (i)) ? l.z : 0.f, (4 * j4 + 3 < (i)) ? l.w : 0.f}; \
            a0 -= l0 * xp[2 * j4]; if (4 * j4 + 2 < (i)) a1 -= l1 * xp[2 * j4 + 1]; } \
        const float a = (a0.x + a0.y) + (a1.x + a1.y); \
        if ((i) & 1) xp[(i) >> 1].y = a; else { xp[(i) >> 1].x = a; xp[(i) >> 1].y = 0.f; } \
        TBP[(REV ? 63 - (i) : (i)) * 72 + pc] = (bf16)(pk2(a * bcol, 0.f) & 0xffffu); \
        __builtin_amdgcn_sched_barrier(0); }
template <bool REV> DI void tri_inverse(LAS float* L, const LAS float* beta, LAS bf16* TBP, int lane) {
    f32x2_t xp[32];
    L = opaque(L); TBP = opaque(TBP); lane = opaque(lane);
    const float bcol = REV ? beta[63 - lane] : beta[lane];
    const int pc = REV ? permcol(63 - lane) : permcol(lane);
    f32x4 la[8], lb[8], lt[8];
#pragma unroll
    for (int ii = 0; ii < 64; ii += 2) { TRI_ROW(ii, la, lb) TRI_ROW(ii + 1, lb, la) }
}
#undef TRI_ROW

DI void gdn_conv(Frame& F, LAS unsigned char* lds, int t384, int b, int h, int n) {
    const bf16* QKVA = (const bf16*)(F.ws + WS_QKVA); const float* convw = F.in[3];
    const int cgp = t384 % 48, rg = t384 / 48, mat = cgp >> 4, cc = (cgp & 15) * 8;
    const int col = mat * 512 + h * 128 + cc;
    float w[5][8];
#pragma unroll
    for (int j = 0; j < 5; ++j) { const f32x4 a = *(const f32x4*)(convw + j * 1536 + col), bq = *(const f32x4*)(convw + j * 1536 + col + 4);
        w[j][0] = a.x; w[j][1] = a.y; w[j][2] = a.z; w[j][3] = a.w; w[j][4] = bq.x; w[j][5] = bq.y; w[j][6] = bq.z; w[j][7] = bq.w; }
    const int a4 = (cc >> 3) & 3, p0 = (cc & ~31) + 16 * (a4 & 1) + 4 * (a4 >> 1);
    const int ra = rg & 3, q0 = (rg >> 2) * 32 + 16 * (ra & 1) + 4 * (ra >> 1);
#pragma unroll
    for (int hf = 0; hf < 2; ++hf) {
        float o[4][8];
#pragma unroll
        for (int r = 0; r < 4; ++r)
#pragma unroll
            for (int c = 0; c < 8; ++c) o[r][c] = 0.f;
#pragma unroll
        for (int i = 0; i < 8; ++i) {
            const int pos = n * 64 + rg * 8 + hf * 4 - 2 + i;
            v4u raw = (v4u){0u, 0u, 0u, 0u};
            if (pos >= 0 && pos < SEQ) raw = *(const v4u*)(QKVA + (size_t)(b * SEQ + pos) * 1536 + col);
            float xin[8] = {bflo(raw.x), bfhi(raw.x), bflo(raw.y), bfhi(raw.y), bflo(raw.z), bfhi(raw.z), bflo(raw.w), bfhi(raw.w)};
#pragma unroll
            for (int j = 0; j < 5; ++j) { const int r = i - j; if (r >= 0 && r < 4) {
#pragma unroll
                for (int c = 0; c < 8; ++c) o[r][c] += w[j][c] * xin[c]; } }
        }
#pragma unroll
        for (int r = 0; r < 4; ++r) {
            float ss = 0.f;
#pragma unroll
            for (int c = 0; c < 8; ++c) { o[r][c] = siluf(o[r][c]); ss += o[r][c] * o[r][c]; }
            ss += __shfl_xor(ss, 1); ss += __shfl_xor(ss, 2); ss += __shfl_xor(ss, 4); ss += __shfl_xor(ss, 8);
            float sc = 1.0f;
            if (mat < 2) { sc = __builtin_amdgcn_rsqf(ss + EPS); if (mat == 0) sc *= 0.08838834764831845f; }
#pragma unroll
            for (int c = 0; c < 8; ++c) o[r][c] *= sc;
        }
        if (mat < 2) {
            LAS unsigned char* tile = lds + (mat == 0 ? G_QNP : G_KNP);
#pragma unroll
            for (int r = 0; r < 4; ++r) { const int c = rg * 8 + hf * 4 + r;
                v2u lo, hi2; lo.x = pk2(o[r][0], o[r][1]); lo.y = pk2(o[r][2], o[r][3]); hi2.x = pk2(o[r][4], o[r][5]); hi2.y = pk2(o[r][6], o[r][7]);
                *(LAS v2u*)(tile + c * 272 + p0 * 2) = lo; *(LAS v2u*)(tile + c * 272 + (p0 + 8) * 2) = hi2; }
        }
        if (mat >= 1) {
#pragma unroll
            for (int c = 0; c < 8; ++c) {
                v2u q4; q4.x = pk2(o[0][c], o[1][c]); q4.y = pk2(o[2][c], o[3][c]);
                if (mat == 1) *(LAS v2u*)(lds + G_KNTP + (cc + c) * 144 + (q0 + 8 * hf) * 2) = q4;
                else *(LAS v2u*)(lds + G_VCT + (cc + c) * 144 + rg * 16 + hf * 8) = q4;
            }
        }
    }
}
DI void gdn_gates(Frame& F, LAS unsigned char* lds, LAS float* gv, int lane, int b, int h, int n) {
    const float* gp = (const float*)(F.ws + WS_GATES) + (size_t)(b * SEQ + n * 64 + lane) * 16;
    const float bfv = gp[h], bbv = gp[4 + h], afv = gp[8 + h], abv = gp[12 + h];
    const float betaf = sigmoidf_(bfv), betab = sigmoidf_(bbv);
    const float xf = afv + F.in[5][h], xb = abv + F.in[5][4 + h];
    const float spf = fmaxf(xf, 0.f) + log1pf(__expf(-fabsf(xf))), spb = fmaxf(xb, 0.f) + log1pf(__expf(-fabsf(xb)));
    const float gf = -__expf(F.in[4][h]) * spf, gb = -__expf(F.in[4][4 + h]) * spb;
    float Gf = gf, Rb = gb;
#pragma unroll
    for (int o = 1; o < 64; o <<= 1) { const float u1 = __shfl_up(Gf, o); if (lane >= o) Gf += u1; const float d1 = __shfl_down(Rb, o); if (lane + o < 64) Rb += d1; }
    gv[lane] = Gf; gv[64 + lane] = Rb; gv[128 + lane] = betaf; gv[192 + lane] = betab;
    const float GfL = __shfl(Gf, 63), Rb0 = __shfl(Rb, 0);
    LAS float* v0 = (LAS float*)(lds + G_D0 + GD_VEC); LAS float* v1 = (LAS float*)(lds + G_D1 + GD_VEC);
    v0[lane] = __expf(Gf); v0[64 + lane] = __expf(GfL - Gf); v1[lane] = __expf(Rb); v1[64 + lane] = __expf(Rb0 - Rb);
    if (lane == 0) { v0[128] = __expf(GfL); v1[128] = __expf(Rb0); }
}
DI void p2_gdn_pre(Frame& F) {
    const int tid = F.tid, lane = F.lane, wave = F.wave;
    int task = F.vcu;
    if (task < 1024) {
        LAS unsigned char* lds = opaque(F.lds);
        const int b = task >> 9, h = (task >> 7) & 3, n = task & 127;
        if (wave >= 2) gdn_conv(F, lds, tid - 128, b, h, n);
        if (wave == 2) gdn_gates(F, lds, (LAS float*)(lds + G_GV), lane, b, h, n);
    }
    __syncthreads();
    int par = 0;
#pragma unroll 1
    for (; task < 1024; task += F.G, par ^= 1) {
        LAS unsigned char* lds = opaque(F.lds);
        const int b = task >> 9, h = (task >> 7) & 3, n = task & 127, bh = b * 4 + h;
        LAS float* gv = (LAS float*)(lds + G_GV + par * 1024);
        LAS float* sGf = gv; LAS float* sRb = gv + 64; LAS float* sBf = gv + 128; LAS float* sBb = gv + 192;
        {
            const int p = wave >> 2, mt = wave & 3, n16 = lane & 15, g = lane >> 4;
            const LAS unsigned char* At = lds + (p == 0 ? G_KNP : G_QNP) + (16 * mt + n16) * 272 + g * 16;
            bf16x8 af[4], bfr[16];
#pragma unroll
            for (int ks = 0; ks < 4; ++ks) af[ks] = *(const LAS bf16x8*)(At + ks * 64);
#pragma unroll
            for (int nt = 0; nt < 4; ++nt)
#pragma unroll
                for (int ks = 0; ks < 4; ++ks) bfr[nt * 4 + ks] = *(const LAS bf16x8*)(lds + G_KNP + (16 * nt + n16) * 272 + g * 16 + ks * 64);
            float Gc[4], Rc[4], Bfc[4], Bbc[4];
#pragma unroll
            for (int r = 0; r < 4; ++r) { const int c = 16 * mt + 4 * g + r; Gc[r] = sGf[c]; Rc[r] = sRb[c]; Bfc[r] = sBf[c]; Bbc[r] = sBb[c]; }
#pragma unroll
            for (int nt = 0; nt < 4; ++nt) {
                f32x4 acc = (f32x4){0.f, 0.f, 0.f, 0.f};
#pragma unroll
                for (int ks = 0; ks < 4; ++ks) acc = __builtin_amdgcn_mfma_f32_16x16x32_bf16(af[ks], bfr[nt * 4 + ks], acc, 0, 0, 0);
                const int s_ = 16 * nt + n16; const float Gs = sGf[s_], Rs = sRb[s_]; const int ps = permcol(s_);
#pragma unroll
                for (int r = 0; r < 4; ++r) {
                    const int c = 16 * mt + 4 * g + r; const float v = acc[r];
                    const float df = __expf(fminf(Gc[r] - Gs, 0.f)), db = __expf(fminf(Rc[r] - Rs, 0.f));
                    if (p == 0) {
                        ((LAS float*)(lds + G_LM))[c * 64 + s_] = Bfc[r] * v * df;
                        ((LAS float*)(lds + G_LM + 16384))[(63 - c) * 64 + (63 - s_)] = Bbc[r] * v * db;
                    } else {
                        ((LAS bf16*)(lds + G_D0 + GD_AP))[c * 72 + ps] = (bf16)(pk2(s_ <= c ? v * df : 0.f, 0.f) & 0xffffu);
                        ((LAS bf16*)(lds + G_D1 + GD_AP))[c * 72 + ps] = (bf16)(pk2(s_ >= c ? v * db : 0.f, 0.f) & 0xffffu);
                    }
                }
            }
        }
        __syncthreads();
        GAS v4u* gd0 = (GAS v4u*)(F.ws + WS_GD + (size_t)((bh * 2 + 0) * 128 + n) * GDN_D_BYTES);
        GAS v4u* gd1 = (GAS v4u*)(F.ws + WS_GD + (size_t)((bh * 2 + 1) * 128 + n) * GDN_D_BYTES);
        {
            GAS v4u* gsh = (GAS v4u*)(F.ws + WS_GSH + (size_t)(bh * 128 + n) * GDN_SH_BYTES);
#pragma unroll 3
            for (int i = tid; i < (int)(GDN_SH_BYTES / 16); i += NTHREADS) gsh[i] = *(const LAS v4u*)(lds + i * 16);
#pragma unroll 1
            for (int i = GD_AP / 16 + tid; i < (int)(GDN_D_BYTES / 16); i += NTHREADS) { gd0[i] = *(const LAS v4u*)(lds + G_D0 + i * 16); gd1[i] = *(const LAS v4u*)(lds + G_D1 + i * 16); }
        }
        __syncthreads();
        if (wave == 0) { tri_inverse<false>((LAS float*)(lds + G_LM), sBf, (LAS bf16*)(lds + G_D0 + GD_TBP), lane);
#pragma unroll 3
            for (int i = lane; i < GD_AP / 16; i += 64) gd0[i] = *(const LAS v4u*)(lds + G_D0 + i * 16); }
        else if (wave == 1) { tri_inverse<true>((LAS float*)(lds + G_LM + 16384), sBb, (LAS bf16*)(lds + G_D1 + GD_TBP), lane);
#pragma unroll 3
            for (int i = lane; i < GD_AP / 16; i += 64) gd1[i] = *(const LAS v4u*)(lds + G_D1 + i * 16); }
        else {
            const int t2 = task + F.G;
            if (t2 < 1024) { const int b2 = t2 >> 9, h2 = (t2 >> 7) & 3, n2 = t2 & 127;
                gdn_conv(F, lds, tid - 128, b2, h2, n2);
                if (wave == 2) gdn_gates(F, lds, (LAS float*)(lds + G_GV + (par ^ 1) * 1024), lane, b2, h2, n2); }
        }
        __syncthreads();
    }
}

DI bf16x8 pack8(const f32x4 a, const f32x4 b) {
    v4u p; p.x = pk2(a[0], a[1]); p.y = pk2(a[2], a[3]); p.z = pk2(b[0], b[1]); p.w = pk2(b[2], b[3]); return __builtin_bit_cast(bf16x8, p);
}
DI void small_weights(Frame& F, int gw, int NGW) {
    LAS float* scr = (LAS float*)(F.lds + F.wave * 16384);
    bf16* WOUT = (bf16*)(F.ws + WS_WOUT);
    for (int it = gw; it < 16 * 32; it += NGW) p0_transpose_item(F.in[9], 1024, 32, WOUT, 1024, 0, 1, scr, it, F.lane);
    bf16* WRH = (bf16*)(F.ws + WS_WR); bf16* WRL = WRH + 48 * 1024; const float* wrg = F.in[11]; const float* wre = F.in[12];
    for (int i = gw * 64 + F.lane; i < 48 * 1024; i += NGW * 64) { const int j = i >> 10, k = i & 1023; float v = 0.f; if (j < 4) v = wrg[k * 4 + j]; else if (j < 36) v = wre[k * 32 + (j - 4)];
        const unsigned h = f2bf(v); const float hv = __builtin_bit_cast(float, h << 16); WRH[i] = (bf16)h; WRL[i] = (bf16)f2bf(v - hv); }
}
DI unsigned char* wgu_ptr(Frame& F, int e) { return F.ws + (e < WGU_SPLIT ? WS_WGU0 + (size_t)e * MiB : WS_WGU1 + (size_t)(e - WGU_SPLIT) * MiB); }
DI bf16* wd_ptr(Frame& F, int e) { return (bf16*)((unsigned char*)F.out + (e < WD_SPLIT ? DO_WD0 + (size_t)e * MiB : DO_WD1 + (size_t)(e - WD_SPLIT) * MiB)); }
DI void moe_weights(Frame& F, int cb, int ncb) {
    for (int it = cb; it < NEXP * 32; it += ncb) { const int e = it >> 5, mat = (it >> 4) & 1, nb = it & 15;
        q_strip((mat ? F.in[14] : F.in[13]) + (size_t)e * 1024 * 512, 512, 32 * nb, wgu_ptr(F, e), (float*)(F.ws + WS_WSC) + e * 1024, mat + 64 * nb, 2, F.lds, F.wave, F.lane); }
    LAS float* scr = (LAS float*)(F.lds + F.wave * 16384);
    constexpr int ID = 8 * 32; const int gw = cb * NWAVES + F.wave, NGW = ncb * NWAVES;
    for (int it = gw; it < NEXP * ID; it += NGW) { const int e = it / ID, r = it % ID;
        p0_transpose_item(F.in[15] + (size_t)e * 512 * 1024, 1024, 32, wd_ptr(F, e), 512, 0, 1, scr, r, F.lane); }
}

constexpr int SC_SLOT = 78848, SC_VCT = 53248, SC_D = 55552, SC_NCH = 11;
static_assert(2 * SC_SLOT <= LDS_BYTES, "scan slots");
DI void sc_issue(v4u (&R)[SC_NCH], const unsigned char* ws, const unsigned (&delta)[SC_NCH], const unsigned (&dmask)[SC_NCH], unsigned shbase, unsigned ddiff) {
#pragma unroll
    for (int j = 0; j < SC_NCH; ++j) { const unsigned off = shbase + delta[j] + (dmask[j] & ddiff);
#ifdef SC_PLAIN_LOADS
        R[j] = *(const v4u*)(ws + off); }
#else
        asm volatile("global_load_dwordx4 %0, %1, %2" : "=v"(R[j]) : "v"(off), "s"(ws) : "memory"); }
#endif
}
#ifdef SC_PLAIN_LOADS
#define SC_WAIT(R, n) do {} while (0)
#else
#define SC_WAIT(R, n) asm volatile("s_waitcnt vmcnt(" #n ")" : "+v"(R[0]), "+v"(R[1]), "+v"(R[2]), "+v"(R[3]), "+v"(R[4]), "+v"(R[5]), "+v"(R[6]), "+v"(R[7]), "+v"(R[8]), "+v"(R[9]), "+v"(R[10]) :: "memory")
#endif
DI void sc_write(const v4u (&R)[SC_NCH], LAS unsigned char* slot, int lid) {
#pragma unroll
    for (int j = 0; j < SC_NCH; ++j) *(LAS v4u*)(slot + 16 * (lid + 448 * j)) = R[j];
}
DI void p4_scan(Frame& F) {
    const int lane = F.lane, n16 = lane & 15, g = lane >> 4, wave = F.wave;
    {
        volatile LAS int* tsk = (volatile LAS int*)(F.lds + MISC_OFF + 32);
        if (F.tid == 0) {
            unsigned* q = (unsigned*)(F.ws + WS_CTL) + CW_SCANQ; const unsigned xcc = xb_xcc_id() & 7u; int task = -1;
            for (unsigned t = 0; t < 8 && task < 0; ++t) { const unsigned y = (xcc + t) & 7u; const unsigned j = xb_add(q + 64 * y, 1u); if (j < 16u) task = (int)(y * 16 + j); }
            *tsk = task; if (task < 0) tsk[1] = (int)xb_add(q + 64 * 8, 1u);
        }
        __syncthreads();
    }
    const int task = *(volatile LAS int*)(F.lds + MISC_OFF + 32);
    if (task < 0) {
        if (F.G > 128) { const int cgw = *(volatile LAS int*)(F.lds + MISC_OFF + 36) * NWAVES + wave, cng = (F.G - 128) * NWAVES; small_weights(F, cgw, cng); moe_weights(F, *(volatile LAS int*)(F.lds + MISC_OFF + 36), F.G - 128); }
        return; }
    const int chain = 2 * (task >> 4) + ((task & 15) >> 3), e = task & 7;
    const int bh = chain >> 1, dir = chain & 1, b = bh >> 2, h = bh & 3;
    LAS unsigned char* lds = opaque(F.lds);
    if (wave != 0) {
        const int lid = (wave - 1) * 64 + lane;
        const unsigned sh0 = (unsigned)(WS_GSH + (size_t)(bh * 128) * GDN_SH_BYTES), d0 = (unsigned)(WS_GD + (size_t)((bh * 2 + dir) * 128) * GDN_D_BYTES);
        unsigned delta[SC_NCH], dmask[SC_NCH];
#pragma unroll
        for (int j = 0; j < SC_NCH; ++j) { const int c = lid + 448 * j;
            delta[j] = (c < 3328) ? 16u * c : ((c < 3472) ? (unsigned)(G_VCT + 16 * e * 144 + 16 * (c - 3328)) : 16u * (c - 3472));
            dmask[j] = (c < 3472) ? 0u : 0xffffffffu; }
        v4u R0[SC_NCH], R1[SC_NCH], R2[SC_NCH];
#define SC_SRC(st) const int n_ = (dir == 0) ? ((st) < 128 ? (st) : 127) : ((st) < 128 ? 127 - (st) : 0); \
                   const unsigned shb_ = sh0 + (unsigned)n_ * (unsigned)GDN_SH_BYTES, ddf_ = (d0 + (unsigned)n_ * (unsigned)GDN_D_BYTES) - shb_;
        { SC_SRC(0) sc_issue(R0, F.ws, delta, dmask, shb_, ddf_); }
        { SC_SRC(1) sc_issue(R1, F.ws, delta, dmask, shb_, ddf_); }
        { SC_SRC(2) sc_issue(R2, F.ws, delta, dmask, shb_, ddf_); }
#define SC_BODY(R, st) { SC_WAIT(R, 22); sc_write(R, lds + ((st) & 1) * SC_SLOT, lid); { SC_SRC((st) + 3) sc_issue(R, F.ws, delta, dmask, shb_, ddf_); } \
                        asm volatile("s_waitcnt lgkmcnt(0)" ::: "memory"); __builtin_amdgcn_s_barrier(); }
#pragma unroll 1
        for (int s0 = 0; s0 < 126; s0 += 3) { SC_BODY(R0, s0) SC_BODY(R1, s0 + 1) SC_BODY(R2, s0 + 2) }
        SC_BODY(R0, 126) SC_BODY(R1, 127)
        SC_WAIT(R0, 0); SC_WAIT(R1, 0); SC_WAIT(R2, 0);
#undef SC_BODY
#undef SC_SRC
        return;
    }
    bf16* Odir = (bf16*)((unsigned char*)F.out + (dir == 0 ? DO_OF : DO_OB));
    f32x4 S[8];
#pragma unroll
    for (int i = 0; i < 8; ++i) S[i] = (f32x4){0.f, 0.f, 0.f, 0.f};
    bf16x8 Sb[4];
#pragma unroll
    for (int i = 0; i < 4; ++i) Sb[i] = (bf16x8){0, 0, 0, 0, 0, 0, 0, 0};
    const unsigned aoff272 = n16 * 272 + g * 16, aoff144 = n16 * 144 + g * 16;
    const unsigned lds0 = (unsigned)(uintptr_t)lds;
#define SB_() __builtin_amdgcn_sched_barrier(0)
#define LDR128(dst, base, off) asm volatile("ds_read_b128 %0, %1 offset:%2" : "=v"(dst) : "v"(base), "i"(off) : "memory")
#define LDR64(dst, base, off) asm volatile("ds_read_b64 %0, %1 offset:%2" : "=v"(dst) : "v"(base), "i"(off) : "memory")
#define LDR32(dst, base, off) asm volatile("ds_read_b32 %0, %1 offset:%2" : "=v"(dst) : "v"(base), "i"(off) : "memory")
#pragma unroll 1
    for (int step = 0; step < 128; ++step) {
        __builtin_amdgcn_s_barrier();
        asm volatile("" ::: "memory");
        const int n = dir == 0 ? step : 127 - step;
        const unsigned slot = lds0 + (unsigned)(step & 1) * SC_SLOT;
        const unsigned bK = slot + G_KNP + aoff272, bQ = slot + G_QNP + aoff272, bKT = slot + G_KNTP + aoff144, bT = slot + SC_D + GD_TBP + aoff144;
        const unsigned bV = slot + SC_VCT + n16 * 144 + g * 8, bvec = slot + SC_D + GD_VEC + g * 16, bd = slot + SC_D + GD_VEC;
        f32x4 eG[4], ks[4]; v2u vv[4]; float dch; bf16x8 fa[16];
        LDR128(eG[0], bvec, 0); LDR128(eG[1], bvec, 64); LDR128(eG[2], bvec, 128); LDR128(eG[3], bvec, 192);
        LDR128(ks[0], bvec, 256); LDR128(ks[1], bvec, 320); LDR128(ks[2], bvec, 384); LDR128(ks[3], bvec, 448);
        LDR32(dch, bd, 512);
        LDR64(vv[0], bV, 0); LDR64(vv[1], bV, 32); LDR64(vv[2], bV, 64); LDR64(vv[3], bV, 96);
#pragma unroll
        for (int m = 0; m < 4; ++m) { LDR128(fa[m * 4 + 0], bK, m * 4352 + 0); LDR128(fa[m * 4 + 1], bK, m * 4352 + 64); LDR128(fa[m * 4 + 2], bK, m * 4352 + 128); LDR128(fa[m * 4 + 3], bK, m * 4352 + 192); }
        bf16x8 fq[16];
#pragma unroll
        for (int m = 0; m < 4; ++m) { LDR128(fq[m * 4 + 0], bQ, m * 4352 + 0); LDR128(fq[m * 4 + 1], bQ, m * 4352 + 64); LDR128(fq[m * 4 + 2], bQ, m * 4352 + 128); LDR128(fq[m * 4 + 3], bQ, m * 4352 + 192); }
        asm volatile("s_waitcnt lgkmcnt(15)" : "+v"(eG[0]), "+v"(eG[1]), "+v"(eG[2]), "+v"(eG[3]), "+v"(ks[0]), "+v"(ks[1]), "+v"(ks[2]), "+v"(ks[3]), "+v"(dch), "+v"(vv[0]), "+v"(vv[1]), "+v"(vv[2]), "+v"(vv[3]),
                     "+v"(fa[0]), "+v"(fa[1]), "+v"(fa[2]), "+v"(fa[3]), "+v"(fa[4]), "+v"(fa[5]), "+v"(fa[6]), "+v"(fa[7]), "+v"(fa[8]), "+v"(fa[9]), "+v"(fa[10]), "+v"(fa[11]), "+v"(fa[12]), "+v"(fa[13]), "+v"(fa[14]), "+v"(fa[15]) :: "memory");
        SB_();
        f32x4 KS[4];
#pragma unroll
        for (int m = 0; m < 4; ++m) KS[m] = (f32x4){0.f, 0.f, 0.f, 0.f};
#pragma unroll
        for (int i = 0; i < 4; ++i)
#pragma unroll
            for (int m = 0; m < 4; ++m) KS[m] = __builtin_amdgcn_mfma_f32_16x16x32_bf16(fa[m * 4 + i], Sb[i], KS[m], 0, 0, 0);
        SB_();
        bf16x8 ft[8];
#pragma unroll
        for (int m = 0; m < 4; ++m) { LDR128(ft[m * 2 + 0], bT, m * 2304 + 0); LDR128(ft[m * 2 + 1], bT, m * 2304 + 64); }
        asm volatile("s_waitcnt lgkmcnt(8)" : "+v"(fq[0]), "+v"(fq[1]), "+v"(fq[2]), "+v"(fq[3]), "+v"(fq[4]), "+v"(fq[5]), "+v"(fq[6]), "+v"(fq[7]), "+v"(fq[8]), "+v"(fq[9]), "+v"(fq[10]), "+v"(fq[11]), "+v"(fq[12]), "+v"(fq[13]), "+v"(fq[14]), "+v"(fq[15]) :: "memory");
        SB_();
        f32x4 o[4];
#pragma unroll
        for (int m = 0; m < 4; ++m) o[m] = (f32x4){0.f, 0.f, 0.f, 0.f};
#pragma unroll
        for (int i = 0; i < 4; ++i)
#pragma unroll
            for (int m = 0; m < 4; ++m) o[m] = __builtin_amdgcn_mfma_f32_16x16x32_bf16(fq[m * 4 + i], Sb[i], o[m], 0, 0, 0);
        f32x4 rr[4];
#pragma unroll
        for (int m = 0; m < 4; ++m) { rr[m][0] = bflo(vv[m].x) - eG[m][0] * KS[m][0]; rr[m][1] = bfhi(vv[m].x) - eG[m][1] * KS[m][1]; rr[m][2] = bflo(vv[m].y) - eG[m][2] * KS[m][2]; rr[m][3] = bfhi(vv[m].y) - eG[m][3] * KS[m][3]; }
        bf16x8 rb[2]; rb[0] = pack8(rr[0], rr[1]); rb[1] = pack8(rr[2], rr[3]);
        SB_();
        bf16x8 fk[16];
#pragma unroll
        for (int jt = 0; jt < 8; ++jt) { LDR128(fk[jt * 2 + 0], bKT, jt * 2304 + 0); LDR128(fk[jt * 2 + 1], bKT, jt * 2304 + 64); }
        asm volatile("s_waitcnt lgkmcnt(15)" : "+v"(ft[0]), "+v"(ft[1]), "+v"(ft[2]), "+v"(ft[3]), "+v"(ft[4]), "+v"(ft[5]), "+v"(ft[6]), "+v"(ft[7]) :: "memory");
        SB_();
        f32x4 vn[4];
#pragma unroll
        for (int m = 0; m < 4; ++m) vn[m] = (f32x4){0.f, 0.f, 0.f, 0.f};
#pragma unroll
        for (int i = 0; i < 2; ++i)
#pragma unroll
            for (int m = 0; m < 4; ++m) vn[m] = __builtin_amdgcn_mfma_f32_16x16x32_bf16(ft[m * 2 + i], rb[i], vn[m], 0, 0, 0);
#pragma unroll
        for (int m = 0; m < 4; ++m) o[m] = o[m] * eG[m];
#pragma unroll
        for (int jt = 0; jt < 8; ++jt) S[jt] = S[jt] * dch;
        SB_();
        bf16x8 fp[8];
#pragma unroll
        for (int m = 0; m < 4; ++m) { LDR128(fp[m * 2 + 0], bT, GD_AP + m * 2304 + 0); LDR128(fp[m * 2 + 1], bT, GD_AP + m * 2304 + 64); }
        bf16x8 vnb[2]; vnb[0] = pack8(vn[0], vn[1]); vnb[1] = pack8(vn[2], vn[3]);
        bf16x8 vs[2]; vs[0] = pack8(vn[0] * ks[0], vn[1] * ks[1]); vs[1] = pack8(vn[2] * ks[2], vn[3] * ks[3]);
        asm volatile("s_waitcnt lgkmcnt(8)" : "+v"(fk[0]), "+v"(fk[1]), "+v"(fk[2]), "+v"(fk[3]), "+v"(fk[4]), "+v"(fk[5]), "+v"(fk[6]), "+v"(fk[7]), "+v"(fk[8]), "+v"(fk[9]), "+v"(fk[10]), "+v"(fk[11]), "+v"(fk[12]), "+v"(fk[13]), "+v"(fk[14]), "+v"(fk[15]) :: "memory");
        SB_();
#pragma unroll
        for (int i = 0; i < 2; ++i)
#pragma unroll
            for (int jt = 0; jt < 8; ++jt) S[jt] = __builtin_amdgcn_mfma_f32_16x16x32_bf16(fk[jt * 2 + i], vs[i], S[jt], 0, 0, 0);
        asm volatile("s_waitcnt lgkmcnt(0)" : "+v"(fp[0]), "+v"(fp[1]), "+v"(fp[2]), "+v"(fp[3]), "+v"(fp[4]), "+v"(fp[5]), "+v"(fp[6]), "+v"(fp[7]) :: "memory");
#pragma unroll
        for (int i = 0; i < 2; ++i)
#pragma unroll
            for (int m = 0; m < 4; ++m) o[m] = __builtin_amdgcn_mfma_f32_16x16x32_bf16(fp[m * 2 + i], vnb[i], o[m], 0, 0, 0);
#pragma unroll
        for (int i = 0; i < 4; ++i) Sb[i] = pack8(S[2 * i], S[2 * i + 1]);
        SB_();
        bf16* op = Odir + (size_t)(b * SEQ + n * 64) * 512 + h * 128 + 16 * e + n16;
#pragma unroll
        for (int m = 0; m < 4; ++m)
#pragma unroll
            for (int r = 0; r < 4; ++r) op[(size_t)(16 * m + 4 * g + r) * 512] = (bf16)(pk2(o[m][r], 0.f) & 0xffffu);
    }
#undef SB_
#undef LDR128
#undef LDR64
#undef LDR32
}

DI void p5_combine(Frame& F) {
    const int gw = F.vcu * NWAVES + F.wave, NGW = F.G * NWAVES, lane = F.lane;
    const bf16* OFp = (const bf16*)((unsigned char*)F.out + DO_OF); const bf16* OBp = (const bf16*)((unsigned char*)F.out + DO_OB);
    const bf16* ZA = (const bf16*)(F.ws + WS_ZA); bf16* OCAT = (bf16*)(F.ws + WS_OCAT);
    const float* nw = F.in[6] + (lane & 15) * 8;
    float w8[8];
#pragma unroll
    for (int c = 0; c < 8; ++c) w8[c] = nw[c];
    constexpr int NB4 = 4;
    for (int t0 = gw; t0 < TT; t0 += NB4 * NGW) {
        v4u a[NB4], bb[NB4], z[NB4];
#pragma unroll
        for (int u = 0; u < NB4; ++u) { const int t = (t0 + u * NGW < TT) ? t0 + u * NGW : t0;
            a[u] = *(const v4u*)(OFp + (size_t)t * 512 + lane * 8); bb[u] = *(const v4u*)(OBp + (size_t)t * 512 + lane * 8); z[u] = *(const v4u*)(ZA + (size_t)t * 512 + lane * 8); }
#pragma unroll
        for (int u = 0; u < NB4; ++u) {
            const int t = t0 + u * NGW; if (t >= TT) break;
            float o[8] = {bflo(a[u].x) + bflo(bb[u].x), bfhi(a[u].x) + bfhi(bb[u].x), bflo(a[u].y) + bflo(bb[u].y), bfhi(a[u].y) + bfhi(bb[u].y), bflo(a[u].z) + bflo(bb[u].z), bfhi(a[u].z) + bfhi(bb[u].z), bflo(a[u].w) + bflo(bb[u].w), bfhi(a[u].w) + bfhi(bb[u].w)};
            const float zz[8] = {bflo(z[u].x), bfhi(z[u].x), bflo(z[u].y), bfhi(z[u].y), bflo(z[u].z), bfhi(z[u].z), bflo(z[u].w), bfhi(z[u].w)};
            float ss = 0.f;
#pragma unroll
            for (int c = 0; c < 8; ++c) ss += o[c] * o[c];
            ss += __shfl_xor(ss, 1); ss += __shfl_xor(ss, 2); ss += __shfl_xor(ss, 4); ss += __shfl_xor(ss, 8);
            const float rn = __builtin_amdgcn_rsqf(ss * (1.f / 128.f) + EPS);
#pragma unroll
            for (int c = 0; c < 8; ++c) o[c] = o[c] * rn * w8[c] * siluf(zz[c]);
            v4u r; r.x = pk2(o[0], o[1]); r.y = pk2(o[2], o[3]); r.z = pk2(o[4], o[5]); r.w = pk2(o[6], o[7]);
            *(v4u*)(OCAT + (size_t)t * 1024 + lane * 8) = r;
        }
    }
}

struct TokRec { int e[2]; int row[2]; float gate[2]; };
DI void p7_route(Frame& F) {
    const int lane = F.lane, n16 = lane & 15, g = lane >> 4, wave = F.wave;
    const float* X1 = (const float*)(F.ws + WS_X1); const float* nfw = F.in[10];
    const bf16* WRH = (const bf16*)(F.ws + WS_WR); const bf16* WRL = WRH + 48 * 1024;
    unsigned char* HN = (unsigned char*)F.out + DO_HN; TokRec* TOK = (TokRec*)(F.ws + WS_TOK); unsigned* gcnt = (unsigned*)(F.ws + WS_CTL) + CW_CNT; int* LIST = (int*)(F.ws + WS_LIST);
    LAS float* lg = (LAS float*)(F.lds + (wave & 3) * 4096);
    LAS unsigned* hist = (LAS unsigned*)(F.lds + 16384); LAS unsigned* base = hist + 32;
    const int sub = blockIdx.x & 7;
    const float qsc = 127.0f / act_absmax(nfw, lane);
    for (int rt0 = blockIdx.x * 4; rt0 < TT / 16; rt0 += F.G * 4) {
        if (F.tid < 32) hist[F.tid] = 0u;
        __syncthreads();
        int ex1 = 0, ex2 = 0, tok = -1; unsigned l1 = 0, l2 = 0; float g1 = 0.f, g2 = 0.f;
        const int rt = rt0 + wave;
        if (wave < 4 && rt < TT / 16) {
            const int row = rt * 16 + n16; const float* xr = X1 + (size_t)row * DMODEL + 8 * g;
            float ss = 0.f;
#pragma unroll 16
            for (int i = 0; i < 32; ++i) { const f32x4 a = *(const f32x4*)(xr + 32 * i), b2 = *(const f32x4*)(xr + 32 * i + 4);
                ss += (a.x * a.x + a.y * a.y) + (a.z * a.z + a.w * a.w) + (b2.x * b2.x + b2.y * b2.y) + (b2.z * b2.z + b2.w * b2.w); }
            ss += __shfl_xor(ss, 16); ss += __shfl_xor(ss, 32);
            const float rs = __builtin_amdgcn_rsqf(ss * (1.f / DMODEL) + EPS);
            f32x4 acc[3];
#pragma unroll
            for (int q = 0; q < 3; ++q) acc[q] = (f32x4){0.f, 0.f, 0.f, 0.f};
#pragma unroll 4
            for (int i = 0; i < 32; ++i) {
                const f32x4 a = *(const f32x4*)(xr + 32 * i), b2 = *(const f32x4*)(xr + 32 * i + 4);
                const f32x4 wa = *(const f32x4*)(nfw + 32 * i + 8 * g), wb = *(const f32x4*)(nfw + 32 * i + 8 * g + 4);
                float hv[8] = {a.x * rs * wa.x, a.y * rs * wa.y, a.z * rs * wa.z, a.w * rs * wa.w, b2.x * rs * wb.x, b2.y * rs * wb.y, b2.z * rs * wb.z, b2.w * rs * wb.w};
                v4u hi, lo;
                hi.x = pk2(hv[0], hv[1]); hi.y = pk2(hv[2], hv[3]); hi.z = pk2(hv[4], hv[5]); hi.w = pk2(hv[6], hv[7]);
                lo.x = pk2(hv[0] - bflo(hi.x), hv[1] - bfhi(hi.x)); lo.y = pk2(hv[2] - bflo(hi.y), hv[3] - bfhi(hi.y));
                lo.z = pk2(hv[4] - bflo(hi.z), hv[5] - bfhi(hi.z)); lo.w = pk2(hv[6] - bflo(hi.w), hv[7] - bfhi(hi.w));
                { v2u q; q.x = q8x4(hv[0], hv[1], hv[2], hv[3], qsc); q.y = q8x4(hv[4], hv[5], hv[6], hv[7], qsc); *(v2u*)(HN + (size_t)row * DMODEL + 32 * i + 8 * g) = q; }
                const bf16x8 ah = __builtin_bit_cast(bf16x8, hi), al = __builtin_bit_cast(bf16x8, lo);
#pragma unroll
                for (int q = 0; q < 3; ++q) {
                    const bf16x8 bh = *(const bf16x8*)(WRH + (size_t)(16 * q + n16) * 1024 + 32 * i + 8 * g), bl = *(const bf16x8*)(WRL + (size_t)(16 * q + n16) * 1024 + 32 * i + 8 * g);
                    acc[q] = __builtin_amdgcn_mfma_f32_16x16x32_bf16(ah, bh, acc[q], 0, 0, 0);
                    acc[q] = __builtin_amdgcn_mfma_f32_16x16x32_bf16(ah, bl, acc[q], 0, 0, 0);
                    acc[q] = __builtin_amdgcn_mfma_f32_16x16x32_bf16(al, bh, acc[q], 0, 0, 0);
                }
            }
#pragma unroll
            for (int q = 0; q < 3; ++q)
#pragma unroll
                for (int r = 0; r < 4; ++r) lg[(4 * g + r) * 48 + 16 * q + n16] = acc[q][r];
            asm volatile("s_waitcnt lgkmcnt(0)" ::: "memory");
            if (lane < 16) {
                const LAS float* L = lg + lane * 48; tok = rt * 16 + lane;
                float gm = L[0]; int gs = 0;
#pragma unroll
                for (int q = 1; q < 4; ++q) if (L[q] > gm) { gm = L[q]; gs = q; }
                float gsum = 0.f;
#pragma unroll
                for (int q = 0; q < 4; ++q) gsum += __expf(L[q] - gm);
                const float gp_top = 1.0f / gsum;
                float fv[8];
#pragma unroll
                for (int q = 0; q < 8; ++q) { float v = L[4 + q]; v = (gs == 1) ? L[12 + q] : v; v = (gs == 2) ? L[20 + q] : v; v = (gs == 3) ? L[28 + q] : v; fv[q] = v; }
                float m1 = fv[0]; int i1 = 0;
#pragma unroll
                for (int q = 1; q < 8; ++q) if (fv[q] > m1) { m1 = fv[q]; i1 = q; }
                float m2 = -3.0e38f; int i2 = 0;
#pragma unroll
                for (int q = 0; q < 8; ++q) if (q != i1 && fv[q] > m2) { m2 = fv[q]; i2 = q; }
                const float e2 = __expf(m2 - m1); g1 = gp_top / (1.0f + e2); g2 = gp_top * e2 / (1.0f + e2);
                ex1 = gs * 8 + i1; ex2 = gs * 8 + i2;
                l1 = __hip_atomic_fetch_add(hist + ex1, 1u, __ATOMIC_RELAXED, __HIP_MEMORY_SCOPE_WORKGROUP); l2 = __hip_atomic_fetch_add(hist + ex2, 1u, __ATOMIC_RELAXED, __HIP_MEMORY_SCOPE_WORKGROUP);
            }
        }
        __syncthreads();
        if (F.tid < 32) { const unsigned hcount = hist[F.tid]; base[F.tid] = hcount ? atomicAdd(gcnt + F.tid * 8 + sub, hcount) : 0u; }
        __syncthreads();
        if (tok >= 0) {
            const int s1 = (int)(base[ex1] + l1), s2 = (int)(base[ex2] + l2);
            LIST[(size_t)(ex1 * 8 + sub) * TT + s1] = tok; LIST[(size_t)(ex2 * 8 + sub) * TT + s2] = tok;
            TokRec tr; tr.e[0] = ex1; tr.e[1] = ex2; tr.row[0] = (sub << 24) | s1; tr.row[1] = (sub << 24) | s2; tr.gate[0] = g1; tr.gate[1] = g2;
            TOK[tok] = tr;
        }
    }
}

DI void build_etab(Frame& F) {
    LAS unsigned* etab = (LAS unsigned*)(F.lds + ETAB_OFF);
    if (F.tid < 32) {
        const unsigned* gcnt = (const unsigned*)(F.ws + WS_CTL) + CW_CNT + F.tid * 8; unsigned acc = 0;
#pragma unroll
        for (int q = 0; q < 8; ++q) { const unsigned c = __hip_atomic_load(gcnt + q, __ATOMIC_RELAXED, __HIP_MEMORY_SCOPE_AGENT); etab[96 + 8 * F.tid + q] = acc; acc += c; }
        etab[64 + F.tid] = acc; etab[2 * F.tid + 1] = (acc + 255u) >> 8;
    }
    __syncthreads();
    if (F.tid == 0) { unsigned acc = 0; for (int e = 0; e < NEXP; ++e) { etab[2 * e] = acc; acc += etab[2 * e + 1]; } }
    if (F.wave == 1) { const float am = act_absmax(F.in[10], F.lane); if (F.lane == 0) ((LAS float*)etab)[352] = am * (1.0f / 127.0f); }
    __syncthreads();
}

DI void p11_final(Frame& F) {
    build_etab(F);
    const LAS unsigned* etab = (const LAS unsigned*)(F.lds + ETAB_OFF);
    const int gw = F.vcu * NWAVES + F.wave, NGW = F.G * NWAVES, lane = F.lane;
    const bf16* Y = (const bf16*)(F.ws + WS_XBUF); const TokRec* TOK = (const TokRec*)(F.ws + WS_TOK); const float* fw = F.in[16];
    const f32x4 w0 = *(const f32x4*)(fw + lane * 8), w1 = *(const f32x4*)(fw + lane * 8 + 4), w2 = *(const f32x4*)(fw + 512 + lane * 8), w3 = *(const f32x4*)(fw + 516 + lane * 8);
    constexpr int NB2 = 2;
    for (int t0 = gw; t0 < TT; t0 += NB2 * NGW) {
        TokRec tr[NB2]; f32x4 xa[NB2][4]; v4u ya[NB2][2][2];
#pragma unroll
        for (int u = 0; u < NB2; ++u) { const int t = (t0 + u * NGW < TT) ? t0 + u * NGW : t0; tr[u] = TOK[t];
            const float* xr = (const float*)(F.ws + WS_X1) + (size_t)t * DMODEL + lane * 8;
            xa[u][0] = *(const f32x4*)(xr); xa[u][1] = *(const f32x4*)(xr + 4); xa[u][2] = *(const f32x4*)(xr + 512); xa[u][3] = *(const f32x4*)(xr + 516); }
#pragma unroll
        for (int u = 0; u < NB2; ++u)
#pragma unroll
            for (int k = 0; k < 2; ++k) { const unsigned rk = (unsigned)tr[u].row[k]; const bf16* yr = Y + (size_t)(etab[2 * tr[u].e[k]] * 256u + etab[96 + 8 * tr[u].e[k] + (rk >> 24)] + (rk & 0xffffffu)) * DMODEL + lane * 8; ya[u][k][0] = *(const v4u*)(yr); ya[u][k][1] = *(const v4u*)(yr + 512); }
#pragma unroll
        for (int u = 0; u < NB2; ++u) {
            const int t = t0 + u * NGW; if (t >= TT) break;
            float v[16] = {xa[u][0].x, xa[u][0].y, xa[u][0].z, xa[u][0].w, xa[u][1].x, xa[u][1].y, xa[u][1].z, xa[u][1].w, xa[u][2].x, xa[u][2].y, xa[u][2].z, xa[u][2].w, xa[u][3].x, xa[u][3].y, xa[u][3].z, xa[u][3].w};
#pragma unroll
            for (int k = 0; k < 2; ++k) {
                const float gk = tr[u].gate[k]; const v4u y0 = ya[u][k][0], y1 = ya[u][k][1];
                v[0] += gk * bflo(y0.x); v[1] += gk * bfhi(y0.x); v[2] += gk * bflo(y0.y); v[3] += gk * bfhi(y0.y); v[4] += gk * bflo(y0.z); v[5] += gk * bfhi(y0.z); v[6] += gk * bflo(y0.w); v[7] += gk * bfhi(y0.w);
                v[8] += gk * bflo(y1.x); v[9] += gk * bfhi(y1.x); v[10] += gk * bflo(y1.y); v[11] += gk * bfhi(y1.y); v[12] += gk * bflo(y1.z); v[13] += gk * bfhi(y1.z); v[14] += gk * bflo(y1.w); v[15] += gk * bfhi(y1.w);
            }
            float ss = 0.f;
#pragma unroll
            for (int i = 0; i < 16; ++i) ss += v[i] * v[i];
            const float rs = __builtin_amdgcn_rsqf(wave_sum(ss) * (1.f / DMODEL) + EPS);
            float* orow = F.out + (size_t)t * DMODEL + lane * 8;
            *(f32x4*)(orow) = (f32x4){v[0] * rs * w0.x, v[1] * rs * w0.y, v[2] * rs * w0.z, v[3] * rs * w0.w};
            *(f32x4*)(orow + 4) = (f32x4){v[4] * rs * w1.x, v[5] * rs * w1.y, v[6] * rs * w1.z, v[7] * rs * w1.w};
            *(f32x4*)(orow + 512) = (f32x4){v[8] * rs * w2.x, v[9] * rs * w2.y, v[10] * rs * w2.z, v[11] * rs * w2.w};
            *(f32x4*)(orow + 516) = (f32x4){v[12] * rs * w3.x, v[13] * rs * w3.y, v[14] * rs * w3.z, v[15] * rs * w3.w};
        }
    }
}

struct Args { const float* in[17]; float* out; unsigned char* ws; int ph_lo, ph_hi; };
__global__ void __launch_bounds__(NTHREADS, 2) fwd_kernel(Args args) {
    extern __shared__ __attribute__((aligned(16))) unsigned char lds[];
    cg::grid_group grid = cg::this_grid();
    Frame F;
    F.lds = (LAS unsigned char*)lds; F.tid = threadIdx.x; F.lane = F.tid & 63; F.wave = __builtin_amdgcn_readfirstlane(F.tid >> 6);
    F.G = gridDim.x; { const int bx = blockIdx.x; F.vcu = (F.G % 8 == 0) ? (bx % 8) * (F.G / 8) + bx / 8 : bx; }
#pragma unroll
    for (int i = 0; i < 17; ++i) F.in[i] = args.in[i];
    F.out = args.out; F.ws = args.ws;
    const int lo = args.ph_lo, hi = args.ph_hi;
    if (F.tid < 16) ((volatile LAS unsigned*)(F.lds + MISC_OFF))[F.tid] = 0u;
    __syncthreads();
    XcdBarrier bar = xcd_barrier_post((unsigned*)(F.ws + WS_CTL) + CW_BAR, (volatile LAS unsigned*)(F.lds + MISC_OFF));
    if (lo > 1000) grid.sync();
#ifndef PHSEL
#define PHSEL 0xfff
#endif
#define IN(k) (((PHSEL >> (k)) & 1) && lo <= (k) && (k) < hi)
#define SEAM(k) do { if (IN(k) && IN((k) + 1)) xcd_barrier(bar); } while (0)
#ifndef REP_PH
#define REP_PH -1
#endif
#define REPS(k) for (int rep_ = 0; rep_ < ((k) == REP_PH ? 2 : 1); ++rep_, ((k) == REP_PH && rep_ < 2) ? xcd_barrier(bar) : (void)0)
    if (IN(0)) REPS(0) { p0_prologue(F); } SEAM(0);
    if (IN(1)) REPS(1) {
        pg8::Gemm gm{(const pg8::bf16_t*)(F.ws + WS_XN), (const pg8::bf16_t*)(F.ws + WS_WIN), TT, NPROJ, DMODEL / 2};
        pg8::StaticOrder S; S.init(TT, NPROJ, F.G, (int)blockIdx.x);
        EpiProj E{(bf16*)(F.ws + WS_QKVA), (bf16*)(F.ws + WS_ZA), (bf16*)(F.ws + WS_QKVB), (const float*)(F.ws + WS_WSI), (const float*)(F.ws + WS_XSC)};
        pg8::gemm_phase_gather<EpiProj, pg8::StaticOrder, IdRows, true, true>(F.lds, gm, S, E, IdRows{});
    } SEAM(1);
    if (IN(2)) REPS(2) {
#ifndef NO_ROPE
        p2_rope(F);
#ifdef PROBE_ROPE2
        xcd_barrier(bar); p2_rope(F);
#endif
#endif
#ifndef NO_PRE
        p2_gdn_pre(F);
#ifdef PROBE_PRE2
        xcd_barrier(bar); p2_gdn_pre(F);
#endif
#endif
    } SEAM(2);
    if (IN(3)) REPS(3) {
        const attn_body::AttnTensors AT{(const attn_body::bf16*)((unsigned char*)F.out + DO_QR), (const attn_body::bf16*)((unsigned char*)F.out + DO_KR), (const attn_body::bf16*)((unsigned char*)F.out + DO_VR),
                                        (attn_body::bf16*)(F.ws + WS_OCAT) + 512};
        const attn_body::StaticOrder S((int)F.G, (int)blockIdx.x);
#ifdef PROBE_ZERO_ATTN
        { (void)AT; (void)S; bf16* OC = (bf16*)(F.ws + WS_OCAT); const int gt = blockIdx.x * NTHREADS + F.tid, GT = F.G * NTHREADS;
          for (int i = gt; i < TT * 64; i += GT) { const int t = i >> 6, c = i & 63; *(v4u*)(OC + (size_t)t * 1024 + 512 + c * 8) = (v4u){0u, 0u, 0u, 0u}; } }
#else
        attn_body::attn_phase<attn_body::StaticOrder>((char*)lds, AT, S);
#endif
    } SEAM(3);
#ifdef PROBE_SCAN2
    if (IN(4)) { p4_scan(F); xcd_barrier(bar); p4_scan(F); } SEAM(4);
#else
    if (IN(4)) REPS(4) { p4_scan(F); } SEAM(4);
#endif
    if (IN(5)) REPS(5) { p5_combine(F); if (F.G <= 128) { small_weights(F, F.vcu * NWAVES + F.wave, F.G * NWAVES); moe_weights(F, F.vcu, F.G); } } SEAM(5);
    if (IN(6)) REPS(6) {
        pg8::Gemm gm{(const pg8::bf16_t*)(F.ws + WS_OCAT), (const pg8::bf16_t*)(F.ws + WS_WOUT), TT, DMODEL, DMODEL}; pg8::StaticOrder S; S.init(TT, DMODEL, F.G, (int)blockIdx.x);
        EpiResid E{F.in[0], (float*)(F.ws + WS_X1)};
        pg8::gemm_phase<EpiResid, pg8::StaticOrder, true, true>(F.lds, gm, S, E);
    } SEAM(6);
    if (IN(7)) { p7_route(F); } SEAM(7);
    if (IN(9)) REPS(9) {
        build_etab(F);
        pg8::Gemm gm{(const pg8::bf16_t*)((unsigned char*)F.out + DO_HN), (const pg8::bf16_t*)(F.ws + WS_WGU0), 0, 0, DMODEL / 2};
        MoeOrder S{(const LAS unsigned*)(F.lds + ETAB_OFF), F.G, (int)blockIdx.x, WGU_SPLIT, (int)((WS_WGU1 - WS_WGU0) / (256 * 1024))};
        MoeRows AM{(const int*)(F.ws + WS_LIST), (const LAS unsigned*)(F.lds + ETAB_OFF)};
        EpiGU E{(bf16*)(F.ws + WS_HID), (const float*)(F.ws + WS_WSC), ((const LAS float*)(F.lds + ETAB_OFF))[352]};
        pg8::gemm_phase_gather<EpiGU, MoeOrder, MoeRows, true, true>(F.lds, gm, S, E, AM);
    } SEAM(9);
    if (IN(10)) REPS(10) {
        pg8::Gemm gm{(const pg8::bf16_t*)(F.ws + WS_HID), (const pg8::bf16_t*)((unsigned char*)F.out + DO_WD0), 0, 0, FFE}; build_etab(F); MoeOrder S{(const LAS unsigned*)(F.lds + ETAB_OFF), F.G, (int)blockIdx.x, WD_SPLIT, (int)((DO_WD1 - DO_WD0) / (256 * 1024))};
        EpiY E{(bf16*)(F.ws + WS_XBUF)};
        pg8::gemm_phase<EpiY, MoeOrder, true, true>(F.lds, gm, S, E);
    } SEAM(10);
#ifdef EXTRA_SYNCS
    for (int q_ = 0; q_ < EXTRA_SYNCS; ++q_) xcd_barrier(bar);
#endif
    if (IN(11)) { p11_final(F); }
#undef IN
#undef SEAM
}

extern "C" void kernel_launch(void* const* d_in, const int* in_sizes, int n_in, void* d_out, int out_size, void* d_ws, size_t ws_size, hipStream_t stream) {
    static int grid = 0;
    if (grid == 0) {
        if (n_in != 17 || out_size != TT * DMODEL || ws_size < WS_END) { fprintf(stderr, "kernel_launch: unexpected problem (n_in %d out %d ws %zu)\n", n_in, out_size, ws_size); grid = -1; return; }
        int dev = 0, cus = 0, per_cu = 0;
        if (hipGetDevice(&dev) != hipSuccess || hipDeviceGetAttribute(&cus, hipDeviceAttributeMultiprocessorCount, dev) != hipSuccess) { grid = -1; return; }
        if (hipFuncSetAttribute((const void*)fwd_kernel, hipFuncAttributeMaxDynamicSharedMemorySize, LDS_BYTES) != hipSuccess) { fprintf(stderr, "hipFuncSetAttribute failed\n"); grid = -1; return; }
        if (hipOccupancyMaxActiveBlocksPerMultiprocessor(&per_cu, (const void*)fwd_kernel, NTHREADS, LDS_BYTES) != hipSuccess || per_cu < 1) { fprintf(stderr, "occupancy query: %d\n", per_cu); grid = -1; return; }
        grid = cus;
    }
    if (grid < 0) return;
    (void)hipMemsetAsync((char*)d_ws + WS_CTL, 0, CTL_ZERO_BYTES, stream);
    Args a{};
    for (int i = 0; i < 17; ++i) a.in[i] = (const float*)d_in[i];
    a.out = (float*)d_out; a.ws = (unsigned char*)d_ws;
#if MK_PER_PHASE
    for (int p = 0; p < N_PHASES; ++p) { a.ph_lo = p; a.ph_hi = p + 1; hipLaunchKernelGGL(fwd_kernel, dim3(grid), dim3(NTHREADS), LDS_BYTES, stream, a); }
#else
    a.ph_lo = 0; a.ph_hi = N_PHASES;
    void* kargs[] = {&a};
    hipError_t e = hipLaunchCooperativeKernel((void*)fwd_kernel, dim3(grid), dim3(NTHREADS), kargs, LDS_BYTES, stream);
    if (e != hipSuccess) fprintf(stderr, "cooperative launch failed: %s (grid %d)\n", hipGetErrorString(e), grid);
#endif
}
```

```cpp
#include <hip/hip_runtime.h>
#include <cstdio>
#include <cstdint>
namespace pg8 {
#define PG8_LAS __attribute__((address_space(3)))
typedef unsigned short bf16_t;
typedef short bf16x8 __attribute__((ext_vector_type(8)));
typedef float f32x4 __attribute__((ext_vector_type(4)));
typedef unsigned u32x4 __attribute__((ext_vector_type(4)));
constexpr int BM = 256, BK = 64, HALF = 128, HTB = HALF * BK * 2  , STAGE_BYTES = 8 * HTB, NXCD = 8, WGM = 8;

__host__ __device__ __forceinline__ int lds_byte(int r, int c) { const int st = (r >> 4) * 2 + (c >> 5), rr = r & 15, cc = c & 31, ob = rr * 64 + cc * 2; return st * 1024 + (ob ^ (((ob >> 9) & 1) << 5)); }
__host__ __device__ __forceinline__ void stage_rc(int b, int& R, int& C) { const int st = b / 1024, sb = b % 1024, swz = sb ^ (((sb >> 9) & 1) << 5); R = (st >> 1) * 16 + swz / 64; C = (st & 1) * 32 + (swz % 64) / 2; }
__host__ __device__ __forceinline__ int perm32(int rho) { const int n = rho >> 4, i = rho & 15; return 8 * (i >> 2) + 4 * n + (i & 3); }

struct Unit { int pm, pn, ex, tq; };
struct Gemm { const bf16_t* A; const bf16_t* Bt; int M, N, K; };

struct StaticOrder {
    int nM, nN, nwg, G, c;
    __host__ __device__ void init(int M, int N, int G_, int c_) { nM = M / BM; nN = N / BM; nwg = nM * nN; G = G_; c = c_; }
    __host__ __device__ bool next(int i, Unit& u) const {
        const long L = (long)i * G + c; if (L >= nwg) return false;
        int wgid = (int)L; { const int q = nwg / NXCD, r = nwg % NXCD, xcd = wgid % NXCD, off = wgid / NXCD; wgid = (xcd < r ? xcd * (q + 1) : r * (q + 1) + (xcd - r) * q) + off; }
        const int nig = WGM * nN, gid = wgid / nig, fm = gid * WGM, gsz = (nM - fm) < WGM ? (nM - fm) : WGM;
        u.pm = fm + ((wgid % nig) % gsz); u.pn = (wgid % nig) / gsz; return true;
    }
    __device__ __forceinline__ void a_ready(const Unit&) const {}
    __device__ __forceinline__ void done(const Unit&) const {}
};

__device__ __forceinline__ unsigned cvt_pk_bf16(float lo, float hi) { unsigned r; asm volatile("v_cvt_pk_bf16_f32 %0, %1, %2" : "=v"(r) : "v"(lo), "v"(hi)); return r; }
typedef float f32x2 __attribute__((ext_vector_type(2)));
template <class Epi, class Sched, bool ALIGN_EPI = false, bool SP2 = false>
__device__ __forceinline__ void gemm_phase(PG8_LAS unsigned char* lds, const Gemm g, const Sched& S, const Epi& E) {
    const int tid = threadIdx.x, wid = __builtin_amdgcn_readfirstlane(tid >> 6), lane = tid & 63, wr = wid >> 2, wc = wid & 3, fr = lane & 15, fq = lane >> 4;
    const int K = g.K, nt = K / BK;
    unsigned voffA[2], voffB[2];
#pragma unroll
    for (int i = 0; i < 2; ++i) { int R, C; stage_rc(tid * 16 + i * 8192, R, C); const int Rb = Epi::PERM ? ((R & ~31) + perm32(R & 31)) : R;
        voffA[i] = (unsigned)(R * K + C) * 2u; voffB[i] = (unsigned)(Rb * K + C) * 2u; }
    const size_t kstep = (size_t)(BK * 2);
    const size_t hstep = (size_t)HALF * K * 2;
    const size_t tstep = 2 * hstep;
    const unsigned ldsw = (unsigned)wid * 1024u;
    const int aoff = lds_byte(wr * 64 + fr, fq * 8), boff = lds_byte(wc * 32 + fr, fq * 8);
#define PG8_SA(b, h) (((b) * 2 + (h)) * HTB)
#define PG8_SB(b, h) ((4 + (b) * 2 + (h)) * HTB)
#define PG8_STAGE(bufoff, gbase, voff) do { _Pragma("unroll") for (int _i = 0; _i < 2; ++_i) \
        __builtin_amdgcn_global_load_lds((const unsigned*)((const char*)(gbase) + (voff)[_i]), (PG8_LAS unsigned*)(lds + (bufoff) + ldsw + _i * 8192), 16, 0, 0); } while (0)
#define PG8_LDA(dst, b, h) do { _Pragma("unroll") for (int m = 0; m < 4; ++m) _Pragma("unroll") for (int k = 0; k < 2; ++k) dst[m][k] = *(const PG8_LAS bf16x8*)(lds + PG8_SA(b, h) + aoff + m * 2048 + k * 1024); } while (0)
#define PG8_LDB(dst, b, h) do { _Pragma("unroll") for (int n = 0; n < 2; ++n) _Pragma("unroll") for (int k = 0; k < 2; ++k) dst[n][k] = *(const PG8_LAS bf16x8*)(lds + PG8_SB(b, h) + boff + n * 2048 + k * 1024); } while (0)
#define PG8_MMA(ai, bj, At, Bt) do { __builtin_amdgcn_s_setprio(1); _Pragma("unroll") for (int m = 0; m < 4; ++m) _Pragma("unroll") for (int n = 0; n < 2; ++n) _Pragma("unroll") for (int k = 0; k < 2; ++k) \
        acc[ai][bj][m][n] = __builtin_amdgcn_mfma_f32_16x16x32_bf16(Bt[n][k], At[m][k], acc[ai][bj][m][n], 0, 0, 0); __builtin_amdgcn_s_setprio(0); } while (0)
#define PG8_WAIT_V(n) asm volatile("s_waitcnt vmcnt(" #n ")" ::: "memory")
#define PG8_WAIT_L(n) asm volatile("s_waitcnt lgkmcnt(" #n ")" ::: "memory")
#define PG8_BAR __builtin_amdgcn_s_barrier()
#define PG8_SCHED __builtin_amdgcn_sched_barrier(0)
    Unit cur, nxt; int ui = 0;
    if (!S.next(0, cur)) return;
    f32x4 acc[2][2][4][2];
#pragma unroll
    for (int a = 0; a < 2; ++a)
#pragma unroll
        for (int b = 0; b < 2; ++b)
#pragma unroll
            for (int m = 0; m < 4; ++m)
#pragma unroll
                for (int n = 0; n < 2; ++n) acc[a][b][m][n] = (f32x4){0.f, 0.f, 0.f, 0.f};
    bf16x8 At[4][2], B0[2][2], B1[2][2];
    const char* cA = (const char*)g.A + (size_t)cur.pm * tstep; const char* cB = (const char*)g.Bt + (size_t)cur.pn * tstep;
    S.a_ready(cur);
    if constexpr (SP2) {
        PG8_STAGE(PG8_SB(0, 0), cB, voffB); PG8_STAGE(PG8_SB(0, 1), cB + hstep, voffB); PG8_STAGE(PG8_SA(0, 0), cA, voffA); PG8_STAGE(PG8_SA(0, 1), cA + hstep, voffA);
        if (wr == 1) PG8_BAR;
        PG8_WAIT_V(2); PG8_BAR;
        PG8_STAGE(PG8_SB(1, 0), cB + kstep, voffB); PG8_STAGE(PG8_SA(1, 0), cA + kstep, voffA); PG8_STAGE(PG8_SB(1, 1), cB + hstep + kstep, voffB);
        PG8_WAIT_V(6); PG8_BAR;
    } else {
        PG8_STAGE(PG8_SB(0, 0), cB, voffB); PG8_STAGE(PG8_SA(0, 0), cA, voffA); PG8_STAGE(PG8_SB(0, 1), cB + hstep, voffB); PG8_STAGE(PG8_SA(0, 1), cA + hstep, voffA);
        if (wr == 1) PG8_BAR;
        PG8_WAIT_V(4); PG8_BAR;
        PG8_STAGE(PG8_SB(1, 0), cB + kstep, voffB); PG8_STAGE(PG8_SA(1, 0), cA + kstep, voffA); PG8_STAGE(PG8_SB(1, 1), cB + hstep + kstep, voffB);
        PG8_WAIT_V(6); PG8_BAR;
    }
    for (;;) {
        const bool has_next = S.next(ui + 1, nxt);
        const char* nA = has_next ? (const char*)g.A + (size_t)nxt.pm * tstep : cA; const char* nB = has_next ? (const char*)g.Bt + (size_t)nxt.pn * tstep : cB;
        for (int t = 0; t < nt; t += 2) {
            const bool last = (t == nt - 2);
            const char* a1 = cA + (size_t)(t + 1) * kstep;
            const char* a2 = last ? nA : cA + (size_t)(t + 2) * kstep; const char* b2 = last ? nB : cB + (size_t)(t + 2) * kstep;
            const char* a3 = a2 + kstep; const char* b3 = b2 + kstep;
            if (last && has_next) S.a_ready(nxt);
            if constexpr (SP2) {
            PG8_LDB(B0, 0, 0); PG8_LDB(B1, 0, 1); PG8_SCHED; PG8_LDA(At, 0, 0); PG8_STAGE(PG8_SA(1, 1), a1 + hstep, voffA);
            PG8_WAIT_V(8); PG8_WAIT_L(0); PG8_BAR; PG8_MMA(0, 0, At, B0); PG8_MMA(0, 1, At, B1); PG8_BAR; PG8_SCHED;
            PG8_LDA(At, 0, 1); PG8_STAGE(PG8_SB(0, 0), b2, voffB); PG8_STAGE(PG8_SB(0, 1), b2 + hstep, voffB); PG8_STAGE(PG8_SA(0, 0), a2, voffA);
            PG8_WAIT_V(8); PG8_WAIT_L(0); PG8_BAR; PG8_MMA(1, 0, At, B0); PG8_MMA(1, 1, At, B1); PG8_BAR; PG8_SCHED;
            PG8_LDB(B0, 1, 0); PG8_LDB(B1, 1, 1); PG8_SCHED; PG8_LDA(At, 1, 0); PG8_STAGE(PG8_SA(0, 1), a2 + hstep, voffA);
            PG8_WAIT_V(8); PG8_WAIT_L(0); PG8_BAR; PG8_MMA(0, 0, At, B0); PG8_MMA(0, 1, At, B1); PG8_BAR; PG8_SCHED;
            PG8_LDA(At, 1, 1); PG8_STAGE(PG8_SB(1, 0), b3, voffB); PG8_STAGE(PG8_SB(1, 1), b3 + hstep, voffB); PG8_STAGE(PG8_SA(1, 0), a3, voffA);
            PG8_WAIT_V(8); PG8_WAIT_L(0); PG8_BAR; PG8_MMA(1, 0, At, B0); PG8_MMA(1, 1, At, B1); PG8_BAR; PG8_SCHED;
            } else {
            PG8_LDB(B0, 0, 0); PG8_SCHED; PG8_LDA(At, 0, 0); PG8_STAGE(PG8_SA(1, 1), a1 + hstep, voffA);
            PG8_WAIT_L(8); PG8_BAR; PG8_WAIT_L(0); PG8_MMA(0, 0, At, B0); PG8_BAR; PG8_SCHED;
            PG8_LDB(B1, 0, 1); PG8_STAGE(PG8_SB(0, 0), b2, voffB);
            PG8_BAR; PG8_WAIT_L(0); PG8_MMA(0, 1, At, B1); PG8_BAR;
            PG8_LDA(At, 0, 1); PG8_STAGE(PG8_SA(0, 0), a2, voffA);
            PG8_BAR; PG8_WAIT_L(0); PG8_MMA(1, 0, At, B0); PG8_BAR; PG8_SCHED;
            PG8_STAGE(PG8_SB(0, 1), b2 + hstep, voffB);
            PG8_WAIT_V(6); PG8_BAR; PG8_MMA(1, 1, At, B1); PG8_BAR;
            PG8_LDB(B0, 1, 0); PG8_SCHED; PG8_LDA(At, 1, 0); PG8_STAGE(PG8_SA(0, 1), a2 + hstep, voffA);
            PG8_WAIT_L(8); PG8_BAR; PG8_WAIT_L(0); PG8_MMA(0, 0, At, B0); PG8_BAR; PG8_SCHED;
            PG8_LDB(B1, 1, 1); PG8_STAGE(PG8_SB(1, 0), b3, voffB);
            PG8_BAR; PG8_WAIT_L(0); PG8_MMA(0, 1, At, B1); PG8_BAR;
            PG8_LDA(At, 1, 1); PG8_STAGE(PG8_SA(1, 0), a3, voffA);
            PG8_BAR; PG8_WAIT_L(0); PG8_MMA(1, 0, At, B0); PG8_BAR; PG8_SCHED;
            PG8_STAGE(PG8_SB(1, 1), b3 + hstep, voffB);
            PG8_WAIT_V(6); PG8_BAR; PG8_MMA(1, 1, At, B1); PG8_BAR;
            }
        }
        if constexpr (ALIGN_EPI) { if (wr == 0) PG8_BAR; }
        if constexpr (!Epi::AFTER_DRAIN) { E(acc, cur, wr, wc, fr, fq); S.done(cur); }
        if (!has_next) break;
#pragma unroll
        for (int a = 0; a < 2; ++a)
#pragma unroll
            for (int b = 0; b < 2; ++b)
#pragma unroll
                for (int m = 0; m < 4; ++m)
#pragma unroll
                    for (int n = 0; n < 2; ++n) acc[a][b][m][n] = (f32x4){0.f, 0.f, 0.f, 0.f};
        cur = nxt; cA = nA; cB = nB; ++ui;
        if constexpr (ALIGN_EPI) { if (wr == 1) PG8_BAR; }
    }
    PG8_WAIT_V(0);
    if constexpr (!ALIGN_EPI) { if (wr == 0) PG8_BAR; }
    PG8_BAR;
    if constexpr (Epi::AFTER_DRAIN) { E.fused(acc, cur, wr, wc, fr, fq, lds, wid, lane); S.done(cur); }
#undef PG8_SA
#undef PG8_SB
#undef PG8_STAGE
#undef PG8_LDA
#undef PG8_LDB
#undef PG8_MMA
#undef PG8_WAIT_V
#undef PG8_WAIT_L
#undef PG8_BAR
#undef PG8_SCHED
}
typedef int i32x4 __attribute__((ext_vector_type(4)));
template <bool I8> struct AccSel { typedef f32x4 type; };
template <> struct AccSel<true> { typedef i32x4 type; };
template <bool I8> __device__ __forceinline__ void mma_step(typename AccSel<I8>::type& c, const bf16x8& b, const bf16x8& a) {
    if constexpr (I8) c = __builtin_amdgcn_mfma_i32_16x16x64_i8(__builtin_bit_cast(i32x4, b), __builtin_bit_cast(i32x4, a), c, 0, 0, 0);
    else c = __builtin_amdgcn_mfma_f32_16x16x32_bf16(b, a, c, 0, 0, 0);
}
template <class Epi, class Sched, class AMap, bool ALIGN_EPI = false, bool I8 = false>
__device__ __forceinline__ void gemm_phase_gather(PG8_LAS unsigned char* lds, const Gemm g, const Sched& S, const Epi& E, const AMap& AM) {
    constexpr bool SP2 = true;
    const int tid = threadIdx.x, wid = __builtin_amdgcn_readfirstlane(tid >> 6), lane = tid & 63, wr = wid >> 2, wc = wid & 3, fr = lane & 15, fq = lane >> 4;
    const int K = g.K, nt = K / BK;
    unsigned voffA[2], voffB[2]; int rowA[2];
#pragma unroll
    for (int i = 0; i < 2; ++i) { int R, C; stage_rc(tid * 16 + i * 8192, R, C); const int Rb = Epi::PERM ? ((R & ~31) + perm32(R & 31)) : R;
        voffA[i] = (unsigned)C * 2u; voffB[i] = (unsigned)(Rb * K + C) * 2u; rowA[i] = R; }
    const size_t kstep = (size_t)(BK * 2);
    const size_t hstep = (size_t)HALF * K * 2;
    const size_t tstep = 2 * hstep;
    const unsigned ldsw = (unsigned)wid * 1024u;
    const int aoff = lds_byte(wr * 64 + fr, fq * 8), boff = lds_byte(wc * 32 + fr, fq * 8);
#define PG8_SA(b, h) (((b) * 2 + (h)) * HTB)
#define PG8_SB(b, h) ((4 + (b) * 2 + (h)) * HTB)
#define PG8_STAGE(bufoff, gbase, voff) do { _Pragma("unroll") for (int _i = 0; _i < 2; ++_i) \
        __builtin_amdgcn_global_load_lds((const unsigned*)((const char*)(gbase) + (voff)[_i]), (PG8_LAS unsigned*)(lds + (bufoff) + ldsw + _i * 8192), 16, 0, 0); } while (0)
#define PG8_LDA(dst, b, h) do { _Pragma("unroll") for (int m = 0; m < 4; ++m) _Pragma("unroll") for (int k = 0; k < 2; ++k) dst[m][k] = *(const PG8_LAS bf16x8*)(lds + PG8_SA(b, h) + aoff + m * 2048 + k * 1024); } while (0)
#define PG8_LDB(dst, b, h) do { _Pragma("unroll") for (int n = 0; n < 2; ++n) _Pragma("unroll") for (int k = 0; k < 2; ++k) dst[n][k] = *(const PG8_LAS bf16x8*)(lds + PG8_SB(b, h) + boff + n * 2048 + k * 1024); } while (0)
#define PG8_MMA(ai, bj, At, Bt) do { __builtin_amdgcn_s_setprio(1); _Pragma("unroll") for (int m = 0; m < 4; ++m) _Pragma("unroll") for (int n = 0; n < 2; ++n) _Pragma("unroll") for (int k = 0; k < 2; ++k) \
        mma_step<I8>(acc[ai][bj][m][n], Bt[n][k], At[m][k]); __builtin_amdgcn_s_setprio(0); } while (0)
#define PG8_WAIT_V(n) asm volatile("s_waitcnt vmcnt(" #n ")" ::: "memory")
#define PG8_WAIT_L(n) asm volatile("s_waitcnt lgkmcnt(" #n ")" ::: "memory")
#define PG8_BAR __builtin_amdgcn_s_barrier()
#define PG8_SCHED __builtin_amdgcn_sched_barrier(0)
    Unit cur, nxt; int ui = 0;
    if (!S.next(0, cur)) return;
    typedef typename AccSel<I8>::type acc_t;
    acc_t acc[2][2][4][2];
#pragma unroll
    for (int a = 0; a < 2; ++a)
#pragma unroll
        for (int b = 0; b < 2; ++b)
#pragma unroll
            for (int m = 0; m < 4; ++m)
#pragma unroll
                for (int n = 0; n < 2; ++n) acc[a][b][m][n] = (acc_t){0, 0, 0, 0};
    bf16x8 At[4][2], B0[2][2], B1[2][2];
    const char* cA = (const char*)g.A; const char* cB = (const char*)g.Bt + (size_t)cur.pn * tstep;
    unsigned vA0[2], vA1[2], nA0[2], nA1[2];
#pragma unroll
    for (int i = 0; i < 2; ++i) { vA0[i] = (unsigned)AM.row(cur, rowA[i]) * (unsigned)(K * 2) + voffA[i]; vA1[i] = (unsigned)AM.row(cur, HALF + rowA[i]) * (unsigned)(K * 2) + voffA[i]; }
    S.a_ready(cur);
    if constexpr (SP2) {
        PG8_STAGE(PG8_SB(0, 0), cB, voffB); PG8_STAGE(PG8_SB(0, 1), cB + hstep, voffB); PG8_STAGE(PG8_SA(0, 0), cA, vA0); PG8_STAGE(PG8_SA(0, 1), cA, vA1);
        if (wr == 1) PG8_BAR;
        PG8_WAIT_V(2); PG8_BAR;
        PG8_STAGE(PG8_SB(1, 0), cB + kstep, voffB); PG8_STAGE(PG8_SA(1, 0), cA + kstep, vA0); PG8_STAGE(PG8_SB(1, 1), cB + hstep + kstep, voffB);
        PG8_WAIT_V(6); PG8_BAR;
    } else {
        PG8_STAGE(PG8_SB(0, 0), cB, voffB); PG8_STAGE(PG8_SA(0, 0), cA, voffA); PG8_STAGE(PG8_SB(0, 1), cB + hstep, voffB); PG8_STAGE(PG8_SA(0, 1), cA + hstep, voffA);
        if (wr == 1) PG8_BAR;
        PG8_WAIT_V(4); PG8_BAR;
        PG8_STAGE(PG8_SB(1, 0), cB + kstep, voffB); PG8_STAGE(PG8_SA(1, 0), cA + kstep, voffA); PG8_STAGE(PG8_SB(1, 1), cB + hstep + kstep, voffB);
        PG8_WAIT_V(6); PG8_BAR;
    }
    for (;;) {
        const bool has_next = S.next(ui + 1, nxt);
        const char* nA = cA; const char* nB = has_next ? (const char*)g.Bt + (size_t)nxt.pn * tstep : cB;
#pragma unroll
        for (int i = 0; i < 2; ++i) { nA0[i] = has_next ? (unsigned)AM.row(nxt, rowA[i]) * (unsigned)(K * 2) + voffA[i] : vA0[i]; nA1[i] = has_next ? (unsigned)AM.row(nxt, HALF + rowA[i]) * (unsigned)(K * 2) + voffA[i] : vA1[i]; }
        for (int t = 0; t < nt; t += 2) {
            const bool last = (t == nt - 2);
            const char* a1 = cA + (size_t)(t + 1) * kstep;
            const char* a2 = last ? nA : cA + (size_t)(t + 2) * kstep; const char* b2 = last ? nB : cB + (size_t)(t + 2) * kstep;
            const char* a3 = a2 + kstep; const char* b3 = b2 + kstep;
            unsigned s0[2], s1[2];
#pragma unroll
            for (int i = 0; i < 2; ++i) { s0[i] = vA0[i]; s1[i] = vA1[i]; }
            if (last) {
#pragma unroll
                for (int i = 0; i < 2; ++i) { unsigned t0_ = nA0[i], t1_ = nA1[i]; asm volatile("" : "+v"(t0_), "+v"(t1_)); s0[i] = t0_; s1[i] = t1_; } }
            if (last && has_next) S.a_ready(nxt);
            if constexpr (SP2) {
            PG8_LDB(B0, 0, 0); PG8_LDB(B1, 0, 1); PG8_SCHED; PG8_LDA(At, 0, 0); PG8_STAGE(PG8_SA(1, 1), a1, vA1);
            PG8_WAIT_V(8); PG8_WAIT_L(0); PG8_BAR; PG8_MMA(0, 0, At, B0); PG8_MMA(0, 1, At, B1); PG8_BAR; PG8_SCHED;
            PG8_LDA(At, 0, 1); PG8_STAGE(PG8_SB(0, 0), b2, voffB); PG8_STAGE(PG8_SB(0, 1), b2 + hstep, voffB); PG8_STAGE(PG8_SA(0, 0), a2, s0);
            PG8_WAIT_V(8); PG8_WAIT_L(0); PG8_BAR; PG8_MMA(1, 0, At, B0); PG8_MMA(1, 1, At, B1); PG8_BAR; PG8_SCHED;
            PG8_LDB(B0, 1, 0); PG8_LDB(B1, 1, 1); PG8_SCHED; PG8_LDA(At, 1, 0); PG8_STAGE(PG8_SA(0, 1), a2, s1);
            PG8_WAIT_V(8); PG8_WAIT_L(0); PG8_BAR; PG8_MMA(0, 0, At, B0); PG8_MMA(0, 1, At, B1); PG8_BAR; PG8_SCHED;
            PG8_LDA(At, 1, 1); PG8_STAGE(PG8_SB(1, 0), b3, voffB); PG8_STAGE(PG8_SB(1, 1), b3 + hstep, voffB); PG8_STAGE(PG8_SA(1, 0), a3, s0);
            PG8_WAIT_V(8); PG8_WAIT_L(0); PG8_BAR; PG8_MMA(1, 0, At, B0); PG8_MMA(1, 1, At, B1); PG8_BAR; PG8_SCHED;
            } else {
            PG8_LDB(B0, 0, 0); PG8_SCHED; PG8_LDA(At, 0, 0); PG8_STAGE(PG8_SA(1, 1), a1 + hstep, voffA);
            PG8_WAIT_L(8); PG8_BAR; PG8_WAIT_L(0); PG8_MMA(0, 0, At, B0); PG8_BAR; PG8_SCHED;
            PG8_LDB(B1, 0, 1); PG8_STAGE(PG8_SB(0, 0), b2, voffB);
            PG8_BAR; PG8_WAIT_L(0); PG8_MMA(0, 1, At, B1); PG8_BAR;
            PG8_LDA(At, 0, 1); PG8_STAGE(PG8_SA(0, 0), a2, voffA);
            PG8_BAR; PG8_WAIT_L(0); PG8_MMA(1, 0, At, B0); PG8_BAR; PG8_SCHED;
            PG8_STAGE(PG8_SB(0, 1), b2 + hstep, voffB);
            PG8_WAIT_V(6); PG8_BAR; PG8_MMA(1, 1, At, B1); PG8_BAR;
            PG8_LDB(B0, 1, 0); PG8_SCHED; PG8_LDA(At, 1, 0); PG8_STAGE(PG8_SA(0, 1), a2 + hstep, voffA);
            PG8_WAIT_L(8); PG8_BAR; PG8_WAIT_L(0); PG8_MMA(0, 0, At, B0); PG8_BAR; PG8_SCHED;
            PG8_LDB(B1, 1, 1); PG8_STAGE(PG8_SB(1, 0), b3, voffB);
            PG8_BAR; PG8_WAIT_L(0); PG8_MMA(0, 1, At, B1); PG8_BAR;
            PG8_LDA(At, 1, 1); PG8_STAGE(PG8_SA(1, 0), a3, voffA);
            PG8_BAR; PG8_WAIT_L(0); PG8_MMA(1, 0, At, B0); PG8_BAR; PG8_SCHED;
            PG8_STAGE(PG8_SB(1, 1), b3 + hstep, voffB);
            PG8_WAIT_V(6); PG8_BAR; PG8_MMA(1, 1, At, B1); PG8_BAR;
            }
        }
        if constexpr (ALIGN_EPI) { if (wr == 0) PG8_BAR; }
        if constexpr (!Epi::AFTER_DRAIN) { E(acc, cur, wr, wc, fr, fq); S.done(cur); }
        if (!has_next) break;
#pragma unroll
        for (int a = 0; a < 2; ++a)
#pragma unroll
            for (int b = 0; b < 2; ++b)
#pragma unroll
                for (int m = 0; m < 4; ++m)
#pragma unroll
                    for (int n = 0; n < 2; ++n) acc[a][b][m][n] = (acc_t){0, 0, 0, 0};
        cur = nxt; cA = nA; cB = nB; ++ui;
#pragma unroll
        for (int i = 0; i < 2; ++i) { vA0[i] = nA0[i]; vA1[i] = nA1[i]; }
        if constexpr (ALIGN_EPI) { if (wr == 1) PG8_BAR; }
    }
    PG8_WAIT_V(0);
    if constexpr (!ALIGN_EPI) { if (wr == 0) PG8_BAR; }
    PG8_BAR;
    if constexpr (Epi::AFTER_DRAIN) { E.fused(acc, cur, wr, wc, fr, fq, lds, wid, lane); S.done(cur); }
#undef PG8_SA
#undef PG8_SB
#undef PG8_STAGE
#undef PG8_LDA
#undef PG8_LDB
#undef PG8_MMA
#undef PG8_WAIT_V
#undef PG8_WAIT_L
#undef PG8_BAR
#undef PG8_SCHED
}
}
#include <hip/hip_bf16.h>
#include <cmath>
namespace attn_body {
using bf16=__hip_bfloat16;
using bf16x8=__attribute__((ext_vector_type(8)))short;
using s16x4=__attribute__((ext_vector_type(4)))short;
using f32x16=__attribute__((ext_vector_type(16)))float;
using u32x4=__attribute__((ext_vector_type(4)))unsigned;
constexpr int BATCH=2,NHEAD=8,NKVH=2,SEQ=8192,D=64,QP=512,KP=128,OP=1024;
constexpr int NW=8,QBLK=32,QB=QBLK*NW,KVBLK=64,NQB=SEQ/QB;
constexpr int ATTN_UNIT_ROWS=QB;
__device__ __forceinline__ int crow(int r,int hi){return (r&3)+8*(r>>2)+4*hi;}
#define SBAR() __builtin_amdgcn_sched_barrier(0)
__device__ __forceinline__ void cmask(f32x16&p0,f32x16&p1,int jb,int qrel,int hi){
  const float NEG=-INFINITY; int kb=64*jb+4*hi;
  #pragma unroll
  for(int r=0;r<16;++r){int kv=kb+(r&3)+8*(r>>2); if(kv>qrel)p0[r]=NEG; if(kv+32>qrel)p1[r]=NEG;}
}

constexpr int NSLOT=3, SLOTB=8192;
constexpr int LDS_K=0, LDS_V=NSLOT*SLOTB, LDS_WS=2*NSLOT*SLOTB, LDS_OST=LDS_WS+NW*64*4, LDS_BYTES=LDS_OST+NW*4096;
constexpr float C2=0.125f*1.4426950408889634f;
__device__ __forceinline__ void glds16(const void*gsrc,unsigned lds_dst){unsigned keep;
  asm volatile("s_mov_b32 %0, m0\n\ts_mov_b32 m0, %2\n\ts_nop 0\n\tglobal_load_lds_dwordx4 %1, off\n\ts_mov_b32 m0, %0":"=&s"(keep):"v"(gsrc),"s"(lds_dst):"memory");}
__device__ __forceinline__ float max3f(float a,float b,float c){float r;asm("v_max3_f32 %0, %1, %2, %3":"=v"(r):"v"(a),"v"(b),"v"(c));return r;}
__device__ __forceinline__ float max2f(float a,float b){float r;asm("v_max_f32_e32 %0, %1, %2":"=v"(r):"v"(a),"v"(b));return r;}
__device__ __forceinline__ float fadd_s(float a,float b){float r;asm("v_add_f32_e32 %0, %1, %2":"=v"(r):"v"(a),"v"(b));return r;}
__device__ __forceinline__ float fsub_s(float a,float b){float r;asm("v_sub_f32_e32 %0, %1, %2":"=v"(r):"v"(a),"v"(b));return r;}
typedef float f32x2_t __attribute__((ext_vector_type(2))); typedef __bf16 bf16x2_t __attribute__((ext_vector_type(2)));
__device__ __forceinline__ unsigned cvtpk_s(float lo,float hi){f32x2_t v={lo,hi};bf16x2_t b=__builtin_convertvector(v,bf16x2_t);return __builtin_bit_cast(unsigned,b);}
#define WAIT_BAR(N) asm volatile("s_waitcnt vmcnt(" #N ") lgkmcnt(0)\n\ts_barrier":::"memory")

__device__ __forceinline__ void qkt(f32x16&p0,f32x16&p1,const char*Kslot,const bf16x8*qr,const f32x16&negm,int r32,int hi){
  const char*kb=Kslot+hi*1024+r32*16;
  #pragma unroll
  for(int d0=0;d0<4;++d0){
    const bf16x8 b0=*reinterpret_cast<const bf16x8*>(kb+d0*2048);
    const bf16x8 b1=*reinterpret_cast<const bf16x8*>(kb+d0*2048+512);
    if(d0==0){p0=__builtin_amdgcn_mfma_f32_32x32x16_bf16(b0,qr[0],negm,0,0,0);p1=__builtin_amdgcn_mfma_f32_32x32x16_bf16(b1,qr[0],negm,0,0,0);}
    else{p0=__builtin_amdgcn_mfma_f32_32x32x16_bf16(b0,qr[d0],p0,0,0,0);p1=__builtin_amdgcn_mfma_f32_32x32x16_bf16(b1,qr[d0],p1,0,0,0);}}
}
typedef __attribute__((address_space(3))) const char* lds_cptr;
typedef short v4i16_t __attribute__((ext_vector_type(4)));
__device__ __forceinline__ void kload8(bf16x8*kf,lds_cptr kp){
  kf[0]=*(const __attribute__((address_space(3))) bf16x8*)(kp);      kf[1]=*(const __attribute__((address_space(3))) bf16x8*)(kp+512);
  kf[2]=*(const __attribute__((address_space(3))) bf16x8*)(kp+2048); kf[3]=*(const __attribute__((address_space(3))) bf16x8*)(kp+2560);
  kf[4]=*(const __attribute__((address_space(3))) bf16x8*)(kp+4096); kf[5]=*(const __attribute__((address_space(3))) bf16x8*)(kp+4608);
  kf[6]=*(const __attribute__((address_space(3))) bf16x8*)(kp+6144); kf[7]=*(const __attribute__((address_space(3))) bf16x8*)(kp+6656);
}
__device__ __forceinline__ void kload2(bf16x8*kf,lds_cptr kp,int j){ kf[2*j]=*(const __attribute__((address_space(3))) bf16x8*)(kp+j*2048); kf[2*j+1]=*(const __attribute__((address_space(3))) bf16x8*)(kp+j*2048+512); }
__device__ __forceinline__ s16x4 vtr(lds_cptr p){ return __builtin_bit_cast(s16x4,__builtin_amdgcn_ds_read_tr16_b64_v4i16((__attribute__((address_space(3))) v4i16_t*)p)); }
__device__ __forceinline__ float rowmax(const f32x16&p0,const f32x16&p1){
  float a=max3f(p0[0],p0[1],p1[0]),b=max3f(p0[2],p0[3],p1[1]);a=max3f(a,p1[2],p1[3]);
  #pragma unroll
  for(int r=4;r<16;r+=4){a=max3f(a,p0[r],p0[r+1]);b=max3f(b,p0[r+2],p0[r+3]);a=max3f(a,p1[r],p1[r+1]);b=max3f(b,p1[r+2],p1[r+3]);}
  const float m=max2f(a,b);
  auto rr=__builtin_amdgcn_permlane32_swap(__float_as_uint(m),__float_as_uint(m),false,false);
  return max2f(__uint_as_float(rr[0]),__uint_as_float(rr[1]));
}
__device__ __forceinline__ void pv(f32x16*o,int vb,bf16x8 pa0,bf16x8 pa1,bf16x8 pa2,bf16x8 pa3){
  #pragma unroll
  for(int d0=0;d0<2;++d0){s16x4 lo[4],hi[4];
    #pragma unroll
    for(int ks=0;ks<4;++ks){
      asm volatile("ds_read_b64_tr_b16 %0,%1 offset:%c2":"=&v"(lo[ks]):"v"(vb),"i"(d0*4096+ks*1024):"memory");
      asm volatile("ds_read_b64_tr_b16 %0,%1 offset:%c2":"=&v"(hi[ks]):"v"(vb),"i"(d0*4096+ks*1024+512):"memory");}
    asm volatile("s_waitcnt lgkmcnt(0)":::"memory");SBAR();
    #define PK(k) (bf16x8){lo[k][0],lo[k][1],lo[k][2],lo[k][3],hi[k][0],hi[k][1],hi[k][2],hi[k][3]}
    o[d0]=__builtin_amdgcn_mfma_f32_32x32x16_bf16(pa0,PK(0),o[d0],0,0,0);
    o[d0]=__builtin_amdgcn_mfma_f32_32x32x16_bf16(pa1,PK(1),o[d0],0,0,0);
    o[d0]=__builtin_amdgcn_mfma_f32_32x32x16_bf16(pa2,PK(2),o[d0],0,0,0);
    o[d0]=__builtin_amdgcn_mfma_f32_32x32x16_bf16(pa3,PK(3),o[d0],0,0,0);
    #undef PK
  }
}

#ifndef ATTN_STORE16
#define ATTN_STORE16(p,v) (*(u32x4*)(p)=(v))
#endif
template<int THRL> __device__ __forceinline__ void attn_unit(int b,int h,int qb,const bf16*Q,const bf16*__restrict__ K,const bf16*__restrict__ V,bf16*O,char*shm){
  const int tid=threadIdx.x,lane=tid&63,r32=lane&31,hi=lane>>5; const int wid=__builtin_amdgcn_readfirstlane(tid>>6);
  const long rowbase=(long)b*SEQ; const int q0=qb*QB;
  const bf16*Qw=Q+(rowbase+q0+wid*QBLK)*QP+h*D;
  const int hk=h/(NHEAD/NKVH); const bf16*Kh=K+(long)(b*NKVH+hk)*SEQ*D,*Vh=V+(long)(b*NKVH+hk)*SEQ*D;
  const unsigned lds0=(unsigned)(uintptr_t)shm;
  float*wsf=(float*)(shm+LDS_WS)+wid*64;
  const bf16*ksrc=Kh+(wid*64+lane)*8;
  const bf16*vsrc=Vh+(wid*64+lane)*8;
  const unsigned kdst=lds0+LDS_K+wid*1024, vdst=lds0+LDS_V+wid*1024;
  #define DMA_K(t,slot) glds16(ksrc+(long)(t)*KVBLK*D,(unsigned)__builtin_amdgcn_readfirstlane(kdst+(slot)))
  #define DMA_V(t,slot) glds16(vsrc+(long)(t)*KVBLK*D,(unsigned)__builtin_amdgcn_readfirstlane(vdst+(slot)))
  const int vb0=(int)(lds0+LDS_V)+((lane>>4)&1)*32+(lane&3)*8+(4*hi+((lane&15)>>2))*64;
  const char*Kbase=shm+LDS_K; bf16x8 kf[8];
  const lds_cptr shm3=(lds_cptr)shm; const lds_cptr kp0=shm3+LDS_K+hi*1024+r32*16; const lds_cptr vp0=shm3+LDS_V+((lane>>4)&1)*32+(lane&3)*8+(4*hi+((lane&15)>>2))*64;
  constexpr int NT=SEQ/KVBLK;
  DMA_K(0,0);DMA_V(0,0);DMA_K(1,SLOTB);
  bf16x8 qr[4];
  #pragma unroll
  for(int d0=0;d0<4;++d0)qr[d0]=*reinterpret_cast<const bf16x8*>(&Qw[(long)r32*QP+d0*16+hi*8]);
  float mhat=0.f,l_reg=0.f;f32x16 o[2];o[0]=f32x16{};o[1]=f32x16{};f32x16 negm=f32x16{};asm volatile("":"+v"(negm));
  const int qrel=wid*QBLK+r32;
  #define CMASK(P0,P1,t) do{}while(0)
  bool resc=false;
  #define START(P0,P1) do{ const float rm=rowmax(P0,P1); resc=false; \
    { const float dl=rm; mhat=fadd_s(mhat,dl); \
      _Pragma("unroll") for(int r=0;r<16;++r){P0[r]=fsub_s(P0[r],dl);P1[r]=fsub_s(P1[r],dl);} \
      _Pragma("unroll") for(int r=0;r<16;++r)negm[r]=-mhat; asm volatile("":"+v"(negm)); } \
    _Pragma("unroll") for(int r=0;r<16;++r)P0[r]=__builtin_amdgcn_exp2f(P0[r]); }while(0)
  #define RESC() do{ if(resc){ asm volatile("s_waitcnt lgkmcnt(0)":::"memory"); \
      _Pragma("unroll") for(int d_=0;d_<2;++d_) _Pragma("unroll") for(int r=0;r<16;++r)o[d_][r]*=wsf[crow(r,hi)]; } }while(0)
  f32x16 pA0,pA1,pB0,pB1;
  int sl_prev=0,sl_cur=0,sl_next=SLOTB;
  #define ROT() do{sl_prev=sl_cur;sl_cur=sl_next;sl_next=(sl_next==(NSLOT-1)*SLOTB)?0:sl_next+SLOTB;}while(0)
  DMA_K(2,2*SLOTB);
  WAIT_BAR(3);
  qkt(pA0,pA1,Kbase,qr,negm,r32,hi);asm volatile("s_nop 15\n\ts_nop 7":"+v"(pA0),"+v"(pA1));CMASK(pA0,pA1,0);
  START(pA0,pA1);
  _Pragma("unroll") for(int r=0;r<16;++r)pA1[r]=__builtin_amdgcn_exp2f(pA1[r]);
  WAIT_BAR(0);
  DMA_K(3,0);DMA_V(1,SLOTB);
  ROT();
  kload8(kf,kp0+sl_cur);
  WAIT_BAR(2);
  s16x4 vlo[8],vhi[8]; u32x4 pw0,pw1,pw2,pw3;
  #define PKW(P,B) cvtpk_s(P[B],P[B+1])
  #define PAF(k) __builtin_bit_cast(bf16x8,pw##k)
  #define VFR(i) (bf16x8){vlo[i][0],vlo[i][1],vlo[i][2],vlo[i][3],vhi[i][0],vhi[i][1],vhi[i][2],vhi[i][3]}
  #define PIN(x) asm volatile("":"+v"(x))
  #define MX3(a,b,c) __builtin_fmaxf(__builtin_fmaxf((a),(b)),(c))
  #define GAPA(MF,A0,A1,A2,A3,W0,W1,PW) do{ MF; sacc+=A0; sacc+=A1; sacc+=A2; sacc+=A3; PIN(sacc); W0; W1; PIN(PW); SBAR(); }while(0)
  #define EX(v) __builtin_amdgcn_exp2f(v)
  #define GAPB(MF,X,B) do{ MF; X[B]=EX(X[B]); X[B+1]=EX(X[B+1]); X[B+2]=EX(X[B+2]); X[B+3]=EX(X[B+3]); PIN(X); SBAR(); }while(0)
  #define VRD(i) do{ vlo[i]=vtr(vp_+(((i)>>2)*4096+((i)&3)*1024)); vhi[i]=vtr(vp_+(((i)>>2)*4096+((i)&3)*1024+512)); }while(0)
  #define KRD(G,j) do{ if(G){ kload2(kf,kp0+sl_next,j); SBAR(); } }while(0)
  #define STEP(C0,C1,P0,P1,t,GK,GV,GL) do{ SBAR(); \
    const lds_cptr vp_=vp0+sl_prev; \
    VRD(0); SBAR(); float sacc=(P0[0]+P0[1]); \
    GAPA(C0=__builtin_amdgcn_mfma_f32_32x32x16_bf16(kf[0],qr[0],negm,0,0,0), P0[2],P0[3],P0[4],P0[5],     pw0[0]=PKW(P0,0), pw0[1]=PKW(P0,2), pw0); \
    VRD(4); SBAR(); GAPA(C1=__builtin_amdgcn_mfma_f32_32x32x16_bf16(kf[1],qr[0],negm,0,0,0), P0[6],P0[7],P0[8],P0[9],     pw0[2]=PKW(P0,4), pw0[3]=PKW(P0,6), pw0); \
    VRD(1); SBAR(); GAPA(C0=__builtin_amdgcn_mfma_f32_32x32x16_bf16(kf[2],qr[1],C0,0,0,0),   P0[10],P0[11],P0[12],P0[13], pw1[0]=PKW(P0,8), pw1[1]=PKW(P0,10), pw1); \
    VRD(5); SBAR(); GAPA(C1=__builtin_amdgcn_mfma_f32_32x32x16_bf16(kf[3],qr[1],C1,0,0,0),   P0[14],P0[15],P1[0],P1[1],   pw1[2]=PKW(P0,12),pw1[3]=PKW(P0,14), pw1); \
    VRD(2); SBAR(); GAPA(C0=__builtin_amdgcn_mfma_f32_32x32x16_bf16(kf[4],qr[2],C0,0,0,0),   P1[2],P1[3],P1[4],P1[5],     pw2[0]=PKW(P1,0), pw2[1]=PKW(P1,2), pw2); \
    VRD(6); SBAR(); GAPA(C1=__builtin_amdgcn_mfma_f32_32x32x16_bf16(kf[5],qr[2],C1,0,0,0),   P1[6],P1[7],P1[8],P1[9],     pw2[2]=PKW(P1,4), pw2[3]=PKW(P1,6), pw2); \
    VRD(3); SBAR(); GAPA(C0=__builtin_amdgcn_mfma_f32_32x32x16_bf16(kf[6],qr[3],C0,0,0,0),   P1[10],P1[11],P1[12],P1[13], pw3[0]=PKW(P1,8), pw3[1]=PKW(P1,10), pw3); \
    VRD(7); SBAR(); GAPA(C1=__builtin_amdgcn_mfma_f32_32x32x16_bf16(kf[7],qr[3],C1,0,0,0),   P1[14],P1[15],0.f,0.f,       pw3[2]=PKW(P1,12),pw3[3]=PKW(P1,14), pw3); \
    l_reg+=sacc; \
    if(GK){DMA_K((t)+3,sl_cur);} if(GV){DMA_V((t)+1,sl_next);} \
    CMASK(C0,C1,t); \
    { float a=MX3(C0[0],C0[1],C1[0]),b=MX3(C0[2],C0[3],C1[1]); a=MX3(a,C1[2],C1[3]); \
      _Pragma("unroll") for(int r=4;r<16;r+=4){a=MX3(a,C0[r],C0[r+1]);b=MX3(b,C0[r+2],C0[r+3]);a=MX3(a,C1[r],C1[r+1]);b=MX3(b,C1[r+2],C1[r+3]);} \
      float rm=__builtin_fmaxf(a,b); { auto rr=__builtin_amdgcn_permlane32_swap(__float_as_uint(rm),__float_as_uint(rm),false,false); rm=__builtin_fmaxf(__uint_as_float(rr[0]),__uint_as_float(rr[1])); } \
      resc=false; \
      if(__builtin_expect(__any(rm>(float)THRL),0)){ const float dl=__builtin_fmaxf(rm,0.f); mhat+=dl; \
        _Pragma("unroll") for(int r=0;r<16;++r){C0[r]-=dl;C1[r]-=dl;} \
        _Pragma("unroll") for(int r=0;r<16;++r)negm[r]=-mhat; asm volatile("":"+v"(negm)); \
        const float f=__builtin_amdgcn_exp2f(-dl); l_reg*=f; if(hi==0)wsf[r32]=f; resc=true; } } \
    SBAR(); \
    GAPB(o[0]=__builtin_amdgcn_mfma_f32_32x32x16_bf16(PAF(0),VFR(0),o[0],0,0,0), C0,0); \
    GAPB(o[1]=__builtin_amdgcn_mfma_f32_32x32x16_bf16(PAF(0),VFR(4),o[1],0,0,0), C0,4); \
    KRD(GL,0); GAPB(o[0]=__builtin_amdgcn_mfma_f32_32x32x16_bf16(PAF(1),VFR(1),o[0],0,0,0), C0,8); \
    KRD(GL,1); GAPB(o[1]=__builtin_amdgcn_mfma_f32_32x32x16_bf16(PAF(1),VFR(5),o[1],0,0,0), C0,12); \
    KRD(GL,2); GAPB(o[0]=__builtin_amdgcn_mfma_f32_32x32x16_bf16(PAF(2),VFR(2),o[0],0,0,0), C1,0); \
    KRD(GL,3); GAPB(o[1]=__builtin_amdgcn_mfma_f32_32x32x16_bf16(PAF(2),VFR(6),o[1],0,0,0), C1,4); \
    GAPB(o[0]=__builtin_amdgcn_mfma_f32_32x32x16_bf16(PAF(3),VFR(3),o[0],0,0,0), C1,8); \
    GAPB(o[1]=__builtin_amdgcn_mfma_f32_32x32x16_bf16(PAF(3),VFR(7),o[1],0,0,0), C1,12); \
    }while(0)
  int t=1;
  #undef CMASK
  #define CMASK(P0,P1,t) do{}while(0)
  for(;t+5<NT;t+=2){
    STEP(pB0,pB1,pA0,pA1,t,true,true,true);     WAIT_BAR(2); RESC(); ROT();
    STEP(pA0,pA1,pB0,pB1,t+1,true,true,true);   WAIT_BAR(2); RESC(); ROT();
  }
  #undef CMASK
  #define CMASK(P0,P1,t) do{}while(0)
  #define ENDW(tt) do{ if((tt)+3<NT){WAIT_BAR(2);} else if((tt)+2<NT){WAIT_BAR(1);} else {WAIT_BAR(0);} }while(0)
  for(;t+1<NT;t+=2){
    STEP(pB0,pB1,pA0,pA1,t,(t+3<NT),(t+1<NT),(t+1<NT));       ENDW(t);   RESC(); ROT();
    STEP(pA0,pA1,pB0,pB1,t+1,(t+4<NT),(t+2<NT),(t+2<NT));     ENDW(t+1); RESC(); ROT();
  }
  STEP(pB0,pB1,pA0,pA1,NT-1,false,false,false); RESC();
  { float sacc=pB0[0]+pB0[1]; _Pragma("unroll") for(int r=2;r<16;++r)sacc+=pB0[r]; _Pragma("unroll") for(int r=0;r<16;++r)sacc+=pB1[r]; l_reg+=sacc;
    pw0=(u32x4){PKW(pB0,0),PKW(pB0,2),PKW(pB0,4),PKW(pB0,6)};pw1=(u32x4){PKW(pB0,8),PKW(pB0,10),PKW(pB0,12),PKW(pB0,14)};pw2=(u32x4){PKW(pB1,0),PKW(pB1,2),PKW(pB1,4),PKW(pB1,6)};pw3=(u32x4){PKW(pB1,8),PKW(pB1,10),PKW(pB1,12),PKW(pB1,14)};
    SBAR(); pv(o,vb0+sl_cur,PAF(0),PAF(1),PAF(2),PAF(3)); }
  #undef PKW
  #undef PAF
  #undef VFR
  #undef PIN
  #undef MX3
  #undef GAPA
  #undef GAPB
  #undef EX
  #undef VRD
  #undef KRD
  #undef STEP
  #undef ENDW
  {auto rr=__builtin_amdgcn_permlane32_swap(__float_as_uint(l_reg),__float_as_uint(l_reg),false,false);l_reg=__uint_as_float(rr[0])+__uint_as_float(rr[1]);}
  if(hi==0)wsf[32+r32]=l_reg;asm volatile("s_waitcnt lgkmcnt(0)":::"memory");
  float rli[16];
  #pragma unroll
  for(int r=0;r<16;++r)rli[r]=__builtin_amdgcn_rcpf(wsf[32+crow(r,hi)]);
  bf16*Ow=O+(rowbase+q0+wid*QBLK)*OP+h*D;
  { bf16*stg=(bf16*)(shm+LDS_OST)+wid*2048;
    #pragma unroll
    for(int r=0;r<16;++r){const int orow=crow(r,hi);
      #pragma unroll
      for(int d0=0;d0<2;++d0)stg[orow*64+d0*32+r32]=__float2bfloat16(o[d0][r]*rli[r]);}
    asm volatile("s_waitcnt lgkmcnt(0)":::"memory");
    #pragma unroll
    for(int i=0;i<4;++i){const int row=i*8+(lane>>3),ch=lane&7; const u32x4 v=*(const u32x4*)(stg+row*64+ch*8); ATTN_STORE16(Ow+(long)row*OP+ch*8,v);} }
  asm volatile("s_waitcnt lgkmcnt(0)\n\ts_barrier":::"memory");
  #undef DMA_K
  #undef DMA_V
  #undef CMASK
  #undef START
  #undef RESC
  #undef ROT
}
constexpr int ATTN_LDS_BYTES=LDS_BYTES;
struct AttnTensors { const bf16* Q; const bf16* K; const bf16* V; bf16* O; };
struct AttnUnit { int bh; int qb; };
struct StaticOrder {
  int vcu, G;
  __device__ __forceinline__ explicit StaticOrder(int grid,int block):vcu((grid%8==0)?(block%8)*(grid/8)+block/8:block),G(grid){}
  __device__ __forceinline__ bool next(int i,AttnUnit&u)const{
    const int L=i*G+vcu; if(L>=BATCH*NHEAD*NQB)return false;
    if(G==256){ if(i>=2)return false; const int x=vcu>>5,j=vcu&31; const int b=x>>2,kvh=(x>>1)&1,hq=kvh*4+2*(x&1)+i; u.bh=b*NHEAD+hq; u.qb=j; return true; }
    u.bh=L/NQB; u.qb=L%NQB; return true; }
  __device__ __forceinline__ void a_ready(const AttnUnit&)const{}
  __device__ __forceinline__ void done(const AttnUnit&)const{}
};
template<class Sched,int THRL=8> __device__ __forceinline__ void attn_phase(char*lds,const AttnTensors&T,const Sched&S){
  AttnUnit u;
  for(int i=0;S.next(i,u);++i){ S.a_ready(u); attn_unit<THRL>(u.bh/NHEAD,u.bh%NHEAD,u.qb,T.Q,T.K,T.V,T.O,lds); S.done(u); }
}
#undef SBAR
#undef WAIT_BAR
}

#include <hip/hip_cooperative_groups.h>
namespace cg = cooperative_groups;
#ifndef MK_PER_PHASE
#define MK_PER_PHASE 0
#endif
constexpr int NWAVES = 8, NTHREADS = 512;
constexpr int NB = 2, SEQ = 8192, DMODEL = 1024, TT = NB * SEQ;
constexpr int NPROJ = 2816;
constexpr int NEXP = 32, FFE = 512;
constexpr float EPS = 1e-6f;
constexpr int N_PHASES = 12;

constexpr size_t MiB = 1u << 20;
constexpr size_t WS_CTL = 0, CTL_ZERO_BYTES = 64 * 1024;
constexpr size_t WS_WOUT = 1 * MiB;
constexpr size_t WS_LIST = 229 * MiB;
constexpr size_t WS_WR = 3 * MiB;
constexpr size_t WS_TOK = 3 * MiB + 256 * 1024;
constexpr size_t WS_GATES = 4 * MiB;
constexpr size_t WS_WIN = 5 * MiB;
constexpr size_t WS_WSI = 3 * MiB + 896 * 1024;
constexpr size_t WS_XSC = 3 * MiB + 912 * 1024;
constexpr size_t WS_A = 11 * MiB;
constexpr size_t WS_XN = WS_A;
constexpr size_t GDN_SH_BYTES = 71680, GDN_D_BYTES = 19456;
constexpr size_t WS_GSH = WS_A;
constexpr size_t WS_GD = WS_A + 1024 * GDN_SH_BYTES;
constexpr size_t WS_X1 = 5 * MiB;
constexpr size_t WS_HID = 69 * MiB;
constexpr size_t WS_XBUF = 109 * MiB;
constexpr size_t WS_B = 157 * MiB;
constexpr size_t WS_QKVA = WS_B;
constexpr size_t WS_QKVB = WS_B + 48 * MiB;
constexpr size_t WS_ZA = WS_B + 72 * MiB;
constexpr size_t WS_OCAT = WS_B;
constexpr size_t WS_WGU0 = 189 * MiB, WS_WGU1 = 245 * MiB; constexpr int WGU_SPLIT = 20;
constexpr size_t WS_WSC = 3 * MiB + 768 * 1024;
constexpr float ACT_CLIP = 6.0f;
constexpr size_t DO_WD0 = 0, DO_WD1 = 56 * MiB; constexpr int WD_SPLIT = 24;
constexpr size_t DO_HN = 24 * MiB;
constexpr size_t WS_END = 269 * MiB;
static_assert(WS_GD + 4096 * GDN_D_BYTES <= WS_B, "GDN records fit region A");
static_assert(WS_X1 + 64 * MiB <= WS_HID && WS_HID + 40928ull * 1024 <= WS_XBUF && WS_XBUF + 40928ull * 2048 <= WS_WGU0, "post-scan map");
static_assert(WS_WGU0 + WGU_SPLIT * MiB <= WS_B + 72 * MiB && WS_WGU1 + (32 - WGU_SPLIT) * MiB <= 269 * MiB, "WGU fragments");
constexpr size_t DO_QR = 0, DO_KR = 16 * MiB, DO_VR = 20 * MiB, DO_OF = 24 * MiB, DO_OB = 40 * MiB;
constexpr int CW_CNT = 2048;
constexpr int CW_NTILE = 128;
constexpr int CW_ETAB = 192;
constexpr int CW_SCANQ = 1024;

constexpr int LDS_BYTES = 160 * 1024;

#define GAS __attribute__((address_space(1)))
#define LAS __attribute__((address_space(3)))
typedef unsigned short bf16;
typedef unsigned v4u __attribute__((ext_vector_type(4)));
typedef unsigned v2u __attribute__((ext_vector_type(2)));
typedef float f32x4 __attribute__((ext_vector_type(4)));
typedef short bf16x8 __attribute__((ext_vector_type(8)));
typedef short s16x4 __attribute__((ext_vector_type(4)));
#define DI __device__ __forceinline__

DI unsigned f2bf(float f) { unsigned u = __builtin_bit_cast(unsigned, f); return (u + 0x7fffu + ((u >> 16) & 1u)) >> 16; }
typedef float f32x2_t __attribute__((ext_vector_type(2))); typedef __bf16 bf16x2_t __attribute__((ext_vector_type(2)));
DI unsigned pk2(float lo, float hi) { f32x2_t v = {lo, hi}; bf16x2_t b = __builtin_convertvector(v, bf16x2_t); return __builtin_bit_cast(unsigned, b); }
DI float bf2f(unsigned short h) { return __builtin_bit_cast(float, (unsigned)h << 16); }
DI float bflo(unsigned w) { return __builtin_bit_cast(float, w << 16); }
DI float bfhi(unsigned w) { return __builtin_bit_cast(float, w & 0xffff0000u); }
DI unsigned q8x4(float a, float b, float c, float d, float sc) {
    const float M = 12582912.f;
    const unsigned ua = __builtin_bit_cast(unsigned, fminf(fmaxf(a * sc, -127.f), 127.f) + M), ub = __builtin_bit_cast(unsigned, fminf(fmaxf(b * sc, -127.f), 127.f) + M);
    const unsigned uc = __builtin_bit_cast(unsigned, fminf(fmaxf(c * sc, -127.f), 127.f) + M), ud = __builtin_bit_cast(unsigned, fminf(fmaxf(d * sc, -127.f), 127.f) + M);
    return (ua & 255u) | ((ub & 255u) << 8) | ((uc & 255u) << 16) | (ud << 24);
}
template <int CTRL> DI float dpp_f(float v) { return __builtin_bit_cast(float, __builtin_amdgcn_update_dpp(0, __builtin_bit_cast(int, v), CTRL, 0xf, 0xf, true)); }
#ifdef NO_DPP
DI float sum16(float v) { v += __shfl_xor(v, 1); v += __shfl_xor(v, 2); v += __shfl_xor(v, 4); v += __shfl_xor(v, 8); return v; }
DI float max16(float v) { v = fmaxf(v, __shfl_xor(v, 1)); v = fmaxf(v, __shfl_xor(v, 2)); v = fmaxf(v, __shfl_xor(v, 4)); v = fmaxf(v, __shfl_xor(v, 8)); return v; }
DI float get_x8(float v) { return __shfl_xor(v, 8); }
#else
DI float sum16(float v) { v += dpp_f<0xB1>(v); v += dpp_f<0x4E>(v); v += dpp_f<0x141>(v); v += dpp_f<0x140>(v); return v; }
DI float max16(float v) { v = fmaxf(v, dpp_f<0xB1>(v)); v = fmaxf(v, dpp_f<0x4E>(v)); v = fmaxf(v, dpp_f<0x141>(v)); v = fmaxf(v, dpp_f<0x140>(v)); return v; }
DI float get_x8(float v) { return dpp_f<0x128>(v); }
#endif
DI float sum_x16(float v) { return v + __shfl_xor(v, 16); }
DI float max_x16(float v) { return fmaxf(v, __shfl_xor(v, 16)); }
DI float sum_x32(float v) { return v + __shfl_xor(v, 32); }
DI float max_x32(float v) { return fmaxf(v, __shfl_xor(v, 32)); }
DI float wave_max(float v) { return max_x32(max_x16(max16(v))); }
DI float act_absmax(const float* nfw, int lane) {
    float m = 0.f;
#pragma unroll
    for (int i = 0; i < 16; ++i) m = fmaxf(m, fabsf(nfw[lane + 64 * i]));
    return ACT_CLIP * wave_max(m);
}
DI float wave_sum(float v) { return sum_x32(sum_x16(sum16(v))); }
DI float siluf(float x) { return x * __builtin_amdgcn_rcpf(1.0f + __expf(-x)); }
DI float sigmoidf_(float x) { return 1.0f / (1.0f + __expf(-x)); }
DI int perm32i(int idx) { return ((idx >> 2) & 3) * 8 + (idx >> 4) * 4 + (idx & 3); }
DI int permcol(int c) { return (c & ~31) + perm32i(c & 31); }
template <class T> DI T opaque(T p) { asm volatile("" : "+v"(p)); return p; }

typedef GAS unsigned gu32;
#define RLX_AGENT __ATOMIC_RELAXED, __HIP_MEMORY_SCOPE_AGENT
constexpr int CW_BAR = 4096;
constexpr int MISC_OFF = LDS_BYTES - 64;
#define XB_TMO      128
#define XB_XCNT(j)  (256  + 64 * (j))
#define XB_XSUB(j)  (1280 + 64 * (j))
#define XB_XGEN(j)  (2304 + 64 * (j))
#define XB_TOP      3328
#define XB_TOPGEN   3392
#define XCD_BAR_WORDS 3456
#define XB_SPIN_CAP (1u << 18)

__device__ __forceinline__ unsigned xb_ld(unsigned* p)              { return __hip_atomic_load(p, __ATOMIC_RELAXED, __HIP_MEMORY_SCOPE_AGENT); }
__device__ __forceinline__ unsigned xb_add(unsigned* p, unsigned v) { return __hip_atomic_fetch_add(p, v, __ATOMIC_RELAXED, __HIP_MEMORY_SCOPE_AGENT); }
__device__ __forceinline__ unsigned xb_xcc_id() { return (unsigned)__builtin_amdgcn_s_getreg((3 << 11) | 20) & 0xFu; }
#define XB_SPIN(cond, bar) do { unsigned _sp = 0; while (cond) { __builtin_amdgcn_s_sleep(1); \
    if ((++_sp & 255u) == 0u) { if (xb_ld(&(bar)[XB_TMO])) break; if (_sp > XB_SPIN_CAP) { atomicAdd(&(bar)[XB_TMO], 1u); break; } } } } while (0)

struct XcdBarrier {
    unsigned* bar; unsigned x;
    volatile LAS unsigned* st;
};

__device__ __forceinline__ XcdBarrier xcd_barrier_post(unsigned* bar, volatile LAS unsigned* st) {
    XcdBarrier b; b.bar = bar; b.x = xb_xcc_id(); b.st = st;
    if (threadIdx.x == 0) (void)xb_add(&bar[XB_XCNT(b.x)], 1u);
    return b;
}
__device__ __forceinline__ void xcd_barrier_complete(unsigned* bar, unsigned x, unsigned& nloc, unsigned& nx) {
    const unsigned G = gridDim.x * gridDim.y * gridDim.z;
    unsigned sum, cnt, mine, sp = 0u;
    for (;;) {
        sum = 0u; cnt = 0u; mine = 0u;
#pragma unroll
        for (unsigned j = 0; j < 16; ++j) { const unsigned c = xb_ld(&bar[XB_XCNT(j)]); sum += c; cnt += (c > 0u) ? 1u : 0u; mine = (j == x) ? c : mine; }
        if (sum == G) break;
        __builtin_amdgcn_s_sleep(1);
        if ((++sp & 255u) == 0u) { if (xb_ld(&bar[XB_TMO])) break; if (sp > XB_SPIN_CAP) { atomicAdd(&bar[XB_TMO], 1u); break; } }
    }
    nloc = mine > 0u ? mine : 1u; nx = cnt > 0u ? cnt : 1u;
}

__device__ __forceinline__ void xcd_barrier(const XcdBarrier& b) {
    asm volatile("s_waitcnt vmcnt(0)" ::: "memory");
    __syncthreads();
    if (threadIdx.x == 0) {
        unsigned* bar = b.bar;
        __builtin_amdgcn_s_waitcnt(0);
        unsigned nloc = b.st[0], nx = b.st[1];
        if (nloc == 0u) { xcd_barrier_complete(bar, b.x, nloc, nx); b.st[0] = nloc; b.st[1] = nx; }
        const unsigned old = xb_add(&bar[XB_XSUB(b.x)], 1u);
        const unsigned gen = old / nloc;
        if (old + 1u == (gen + 1u) * nloc) {
            __builtin_amdgcn_fence(__ATOMIC_RELEASE, "agent");
            asm volatile("s_waitcnt vmcnt(0)" ::: "memory");
            const unsigned og = xb_add(&bar[XB_TOP], 1u);
            const unsigned tg = og / nx;
            if (og + 1u == (tg + 1u) * nx) xb_add(&bar[XB_TOPGEN], 1u);
            else XB_SPIN(xb_ld(&bar[XB_TOPGEN]) == tg, bar);
            __builtin_amdgcn_fence(__ATOMIC_ACQUIRE, "agent");
            xb_add(&bar[XB_XGEN(b.x)], 1u);
            asm volatile("s_waitcnt vmcnt(0)" ::: "memory");
        } else {
            XB_SPIN(xb_ld(&bar[XB_XGEN(b.x)]) == gen, bar);
            __builtin_amdgcn_fence(__ATOMIC_ACQUIRE, "agent");
            asm volatile("s_waitcnt vmcnt(0)" ::: "memory");
        }
    }
    __syncthreads();
}

struct Frame {
    LAS unsigned char* lds;
    int tid, lane, wave, vcu, G;
    const float* in[17];
    float* out; unsigned char* ws;
};

DI void p0_transpose_item(const float* W, int ldw, int nblk, bf16* WT, int K, int row_off, int rmul, LAS float* scr, int item, int lane) {
    const int kb = item / nblk, nb = item % nblk, k0 = 64 * kb, n0 = 32 * nb;
    const int r8 = lane >> 3, c4 = (lane & 7) * 4;
    f32x4 v[8];
#pragma unroll
    for (int i = 0; i < 8; ++i) v[i] = __builtin_nontemporal_load((const f32x4*)(W + (size_t)(k0 + 8 * i + r8) * ldw + n0 + c4));
#pragma unroll
    for (int i = 0; i < 8; ++i) { LAS float* d = scr + (8 * i + r8) * 33 + c4; d[0] = v[i].x; d[1] = v[i].y; d[2] = v[i].z; d[3] = v[i].w; }
    asm volatile("s_waitcnt lgkmcnt(0)" ::: "memory");
    const int c = lane & 7;
#pragma unroll
    for (int j = 0; j < 4; ++j) { const int n = (lane >> 3) + 8 * j; const LAS float* s = scr + (8 * c) * 33 + n;
        v4u o; o.x = pk2(s[0 * 33], s[1 * 33]); o.y = pk2(s[2 * 33], s[3 * 33]); o.z = pk2(s[4 * 33], s[5 * 33]); o.w = pk2(s[6 * 33], s[7 * 33]);
        *(GAS v4u*)(WT + (size_t)(row_off + (n0 + n) * rmul) * K + k0 + 8 * c) = o; }
    asm volatile("s_waitcnt lgkmcnt(0)" ::: "memory");
}
template <int NR> DI void rms_rows_to_bf16(const float* const (&xrow)[NR], const float* w, bf16* const (&orow)[NR], int lane) {
    const GAS f32x4* wr = (const GAS f32x4*)w + lane;
    f32x4 v[NR][4];
#pragma unroll
    for (int r = 0; r < NR; ++r) { const GAS f32x4* xr = (const GAS f32x4*)xrow[r] + lane;
#pragma unroll
        for (int j = 0; j < 4; ++j) v[r][j] = xr[64 * j]; }
    f32x4 ww[4];
#pragma unroll
    for (int j = 0; j < 4; ++j) ww[j] = wr[64 * j];
#pragma unroll
    for (int r = 0; r < NR; ++r) {
        float s_ = 0.f;
#pragma unroll
        for (int j = 0; j < 4; ++j) s_ += (v[r][j].x * v[r][j].x + v[r][j].y * v[r][j].y) + (v[r][j].z * v[r][j].z + v[r][j].w * v[r][j].w);
        const float rs = __builtin_amdgcn_rsqf(wave_sum(s_) * (1.f / DMODEL) + EPS);
        GAS v2u* o8 = (GAS v2u*)orow[r] + lane;
#pragma unroll
        for (int j = 0; j < 4; ++j) { v2u o; o.x = pk2(v[r][j].x * rs * ww[j].x, v[r][j].y * rs * ww[j].y); o.y = pk2(v[r][j].z * rs * ww[j].z, v[r][j].w * rs * ww[j].w); o8[64 * j] = o; }
    }
}
DI void q_strip(const float* W, int ldw, int n0, unsigned char* WQ, float* wsc, int rowbase, int rmul, LAS unsigned char* lds, int wave, int lane) {
    LAS float* scr = (LAS float*)(lds + wave * 8704); LAS float* cmx = (LAS float*)(lds + 8 * 8704);
    const int r8 = lane >> 3, c4 = (lane & 7) * 4, kw = 128 * wave;
    f32x4 mx = (f32x4){0.f, 0.f, 0.f, 0.f};
#pragma unroll
    for (int i = 0; i < 16; ++i) { const f32x4 v = *(const f32x4*)(W + (size_t)(kw + 8 * i + r8) * ldw + n0 + c4);
        mx.x = fmaxf(mx.x, fabsf(v.x)); mx.y = fmaxf(mx.y, fabsf(v.y)); mx.z = fmaxf(mx.z, fabsf(v.z)); mx.w = fmaxf(mx.w, fabsf(v.w)); }
    mx.x = max_x32(max_x16(fmaxf(mx.x, get_x8(mx.x)))); mx.y = max_x32(max_x16(fmaxf(mx.y, get_x8(mx.y))));
    mx.z = max_x32(max_x16(fmaxf(mx.z, get_x8(mx.z)))); mx.w = max_x32(max_x16(fmaxf(mx.w, get_x8(mx.w))));
    if (lane < 8) *(LAS f32x4*)(cmx + wave * 32 + c4) = mx;
    __syncthreads();
    float sq[4];
#pragma unroll
    for (int j = 0; j < 4; ++j) { const int n = (lane >> 3) + 8 * j; float m = cmx[n];
#pragma unroll
        for (int w = 1; w < 8; ++w) m = fmaxf(m, cmx[w * 32 + n]);
        sq[j] = m > 0.f ? 127.0f / m : 0.f;
        if (wave == 0 && (lane & 7) == 0) wsc[rowbase + n * rmul] = m * (1.0f / 127.0f); }
    const int c = lane & 7;
#pragma unroll
    for (int kb = 0; kb < 2; ++kb) {
        const int k0 = kw + 64 * kb;
        f32x4 v[8];
#pragma unroll
        for (int i = 0; i < 8; ++i) v[i] = *(const f32x4*)(W + (size_t)(k0 + 8 * i + r8) * ldw + n0 + c4);
#pragma unroll
        for (int i = 0; i < 8; ++i) { LAS float* d = scr + (8 * i + r8) * 33 + c4; d[0] = v[i].x; d[1] = v[i].y; d[2] = v[i].z; d[3] = v[i].w; }
        asm volatile("s_waitcnt lgkmcnt(0)" ::: "memory");
#pragma unroll
        for (int j = 0; j < 4; ++j) { const int n = (lane >> 3) + 8 * j; const LAS float* t = scr + (8 * c) * 33 + n;
            v2u o; o.x = q8x4(t[0 * 33], t[1 * 33], t[2 * 33], t[3 * 33], sq[j]); o.y = q8x4(t[4 * 33], t[5 * 33], t[6 * 33], t[7 * 33], sq[j]);
            *(GAS v2u*)(WQ + (size_t)(rowbase + n * rmul) * 1024 + k0 + 8 * c) = o; }
        asm volatile("s_waitcnt lgkmcnt(0)" ::: "memory");
    }
    __syncthreads();
}
DI float reduce16(const float (&ga)[16], int lane) {
    float gb[8], gc[4];
    const bool h32 = (lane & 32) != 0, h16 = (lane & 16) != 0;
#pragma unroll
    for (int i = 0; i < 8; ++i) { const float lo = sum_x32(ga[i]), hi = sum_x32(ga[i + 8]); gb[i] = h32 ? hi : lo; }
#pragma unroll
    for (int i = 0; i < 4; ++i) { const float lo = sum_x16(gb[i]), hi = sum_x16(gb[i + 4]); gc[i] = h16 ? hi : lo; }
    float res = 0.f;
#pragma unroll
    for (int i = 0; i < 4; ++i) { const float t = sum16(gc[i]); res = ((lane & 3) == i) ? t : res; }
    return res;
}
DI void rms_rows_to_q8(const float* const (&xrow)[2], const float* w, unsigned char* const (&orow)[2], float* const (&xsc)[2], float* const (&gout)[2], const LAS float* gw_, int lane) {
    const LAS float* gw = gw_;
    gw = opaque(gw);
    const GAS f32x4* wr = (const GAS f32x4*)w + lane;
    f32x4 v[2][4];
#pragma unroll
    for (int r = 0; r < 2; ++r) { const GAS f32x4* xr = (const GAS f32x4*)xrow[r] + lane;
#pragma unroll
        for (int j = 0; j < 4; ++j) v[r][j] = xr[64 * j]; }
    f32x4 ww[4];
#pragma unroll
    for (int j = 0; j < 4; ++j) ww[j] = wr[64 * j];
#pragma unroll
    for (int r = 0; r < 2; ++r) {
        float s_ = 0.f;
#pragma unroll
        for (int j = 0; j < 4; ++j) s_ += (v[r][j].x * v[r][j].x + v[r][j].y * v[r][j].y) + (v[r][j].z * v[r][j].z + v[r][j].w * v[r][j].w);
        const float rs = __builtin_amdgcn_rsqf(wave_sum(s_) * (1.f / DMODEL) + EPS);
        float am = 0.f;
#pragma unroll
        for (int j = 0; j < 4; ++j) { v[r][j] = v[r][j] * ww[j] * rs; am = fmaxf(fmaxf(am, fmaxf(fabsf(v[r][j].x), fabsf(v[r][j].y))), fmaxf(fabsf(v[r][j].z), fabsf(v[r][j].w))); }
        am = wave_max(am);
        const float qsc = am > 0.f ? 127.0f / am : 0.f;
        if (lane == 0) *xsc[r] = am * (1.0f / 127.0f);
        GAS unsigned* o4 = (GAS unsigned*)orow[r] + lane;
#pragma unroll
        for (int j = 0; j < 4; ++j) o4[64 * j] = q8x4(v[r][j].x, v[r][j].y, v[r][j].z, v[r][j].w, qsc);
    }
#ifndef NO_GATES
    float ga[2][16];
#pragma unroll
    for (int c = 0; c < 16; ++c) { ga[0][c] = 0.f; ga[1][c] = 0.f; }
    asm volatile("" : "+v"(v[0][0]), "+v"(v[0][1]), "+v"(v[0][2]), "+v"(v[0][3]), "+v"(v[1][0]), "+v"(v[1][1]), "+v"(v[1][2]), "+v"(v[1][3]));
#pragma unroll
    for (int j = 0; j < 4; ++j)
#pragma unroll
        for (int q = 0; q < 4; ++q) { const LAS f32x4* g4 = (const LAS f32x4*)gw + ((j * 4 + q) * 4) * 64 + lane;
            const f32x4 g0 = g4[0], g1 = g4[64], g2 = g4[128], g3 = g4[192];
#pragma unroll
            for (int r = 0; r < 2; ++r) { const float h = v[r][j][q];
                ga[r][0] += h * g0.x; ga[r][1] += h * g0.y; ga[r][2] += h * g0.z; ga[r][3] += h * g0.w; ga[r][4] += h * g1.x; ga[r][5] += h * g1.y; ga[r][6] += h * g1.z; ga[r][7] += h * g1.w;
                ga[r][8] += h * g2.x; ga[r][9] += h * g2.y; ga[r][10] += h * g2.z; ga[r][11] += h * g2.w; ga[r][12] += h * g3.x; ga[r][13] += h * g3.y; ga[r][14] += h * g3.z; ga[r][15] += h * g3.w; }
            asm volatile("" : "+v"(ga[1][0]), "+v"(ga[1][1]), "+v"(ga[1][2]), "+v"(ga[1][3]), "+v"(ga[1][4]), "+v"(ga[1][5]), "+v"(ga[1][6]), "+v"(ga[1][7]), "+v"(ga[1][8]), "+v"(ga[1][9]),
                         "+v"(ga[1][10]), "+v"(ga[1][11]), "+v"(ga[1][12]), "+v"(ga[1][13]), "+v"(ga[1][14]), "+v"(ga[1][15]) :: "memory"); }
    const int gc_ = 4 * (lane >> 4) + (lane & 3);
#pragma unroll
    for (int r = 0; r < 2; ++r) { const float res = reduce16(ga[r], lane); if ((lane & 12) == 0) gout[r][gc_] = res; }
#endif
}
DI void p0_prologue(Frame& F) {
    const float* w_in = F.in[2];
    unsigned char* WIN = F.ws + WS_WIN; float* WSI = (float*)(F.ws + WS_WSI);
    constexpr int NSTRIP = 64 + 24;
    if (F.vcu < NSTRIP) { const int st = F.vcu;
        if (st < 64) q_strip(w_in, 2832, 32 * st, WIN, WSI, 32 * st, 1, F.lds, F.wave, F.lane);
        else q_strip(w_in + 2064, 2832, 32 * (st - 64), WIN, WSI, 2048 + 32 * (st - 64), 1, F.lds, F.wave, F.lane); }
    unsigned char* XN = F.ws + WS_XN; float* XSC = (float*)(F.ws + WS_XSC); float* GATES = (float*)(F.ws + WS_GATES);
    LAS float* gw = (LAS float*)(F.lds + 73728);
    for (int i = F.tid; i < 1024 * 4; i += NTHREADS) { const int k = i >> 2, c4 = i & 3, jj = k >> 8, qq = k & 3, ln = (k & 255) >> 2;
        *((LAS f32x4*)gw + ((jj * 4 + qq) * 4 + c4) * 64 + ln) = *(const f32x4*)(w_in + (size_t)k * 2832 + 2048 + c4 * 4); }
    __syncthreads();
    const int nst = (F.G < NSTRIP ? F.G : NSTRIP), NSLOT = nst * NWAVES + (F.G - nst) * NWAVES * 2;
    const int s0_ = (F.vcu < nst) ? F.vcu * NWAVES + F.wave : nst * NWAVES + ((F.vcu - nst) * NWAVES + F.wave) * 2, nmine = (F.vcu < nst) ? 1 : 2;
#pragma unroll 1
    for (int q = 0; q < nmine; ++q)
#pragma unroll 1
        for (int p = s0_ + q; p < TT / 2; p += NSLOT) { const int m = 2 * p;
            const float* const xr[2] = {F.in[0] + (size_t)m * DMODEL, F.in[0] + (size_t)(m + 1) * DMODEL}; unsigned char* const orw[2] = {XN + (size_t)m * DMODEL, XN + (size_t)(m + 1) * DMODEL};
            float* const xs[2] = {XSC + m, XSC + m + 1}; float* const go[2] = {GATES + (size_t)m * 16, GATES + (size_t)(m + 1) * 16};
            rms_rows_to_q8(xr, F.in[1], orw, xs, go, gw, F.lane); }
}

struct EpiProj {
    static constexpr bool PERM = true, AFTER_DRAIN = false;
    bf16 *qkva, *za, *qkvb; const float* wsi; const float* xsc;
    DI void operator()(const pg8::i32x4 (&acc)[2][2][4][2], const pg8::Unit& u, int wr, int wc, int fr, int fq) const {
        const int row0 = u.pm * 256 + wr * 64 + fr;
        const float* ws_ = wsi + u.pn * 256 + wc * 32 + 8 * fq;
        bf16* base; int ldc, colt;
        if (u.pn < 6) { base = qkva; ldc = 1536; colt = u.pn * 256; } else if (u.pn < 8) { base = za; ldc = 512; colt = (u.pn - 6) * 256; } else { base = qkvb; ldc = 768; colt = (u.pn - 8) * 256; }
        const int col0 = colt + wc * 32 + 8 * fq;
        f32x4 s0[2], s1[2];
#pragma unroll
        for (int bj = 0; bj < 2; ++bj) { s0[bj] = *(const f32x4*)(ws_ + bj * 128); s1[bj] = *(const f32x4*)(ws_ + bj * 128 + 4); }
        float rsc[2][4];
#pragma unroll
        for (int ai = 0; ai < 2; ++ai)
#pragma unroll
            for (int m = 0; m < 4; ++m) rsc[ai][m] = xsc[row0 + ai * 128 + m * 16];
#pragma unroll
        for (int ai = 0; ai < 2; ++ai)
#pragma unroll
            for (int m = 0; m < 4; ++m) { bf16* rowp = base + (size_t)(row0 + ai * 128 + m * 16) * ldc + col0; const float rr = rsc[ai][m];
#pragma unroll
                for (int bj = 0; bj < 2; ++bj) { const pg8::i32x4 a0 = acc[ai][bj][m][0], a1 = acc[ai][bj][m][1]; const f32x4 t0 = s0[bj] * rr, t1 = s1[bj] * rr; pg8::u32x4 w;
                    w.x = pg8::cvt_pk_bf16((float)a0[0] * t0[0], (float)a0[1] * t0[1]); w.y = pg8::cvt_pk_bf16((float)a0[2] * t0[2], (float)a0[3] * t0[3]);
                    w.z = pg8::cvt_pk_bf16((float)a1[0] * t1[0], (float)a1[1] * t1[1]); w.w = pg8::cvt_pk_bf16((float)a1[2] * t1[2], (float)a1[3] * t1[3]);
                    *(pg8::u32x4*)(rowp + bj * 128) = w; } }
    }
};
struct IdRows { DI int row(const pg8::Unit& u, int r) const { return u.pm * 256 + r; } };
struct EpiResid {
    static constexpr bool PERM = false, AFTER_DRAIN = false;
    const float* x; float* x1;
    DI void operator()(const pg8::f32x4 (&acc)[2][2][4][2], const pg8::Unit& u, int wr, int wc, int fr, int fq) const {
        const int row0 = u.pm * 256 + wr * 64 + fr, col0 = u.pn * 256 + wc * 32 + 4 * fq;
#pragma unroll
        for (int ai = 0; ai < 2; ++ai)
#pragma unroll
            for (int m = 0; m < 4; ++m) { const size_t off = (size_t)(row0 + ai * 128 + m * 16) * DMODEL + col0;
#pragma unroll
                for (int bj = 0; bj < 2; ++bj)
#pragma unroll
                    for (int n = 0; n < 2; ++n) { const pg8::f32x4 b = *(const pg8::f32x4*)(x + off + bj * 128 + n * 16); *(pg8::f32x4*)(x1 + off + bj * 128 + n * 16) = b + acc[ai][bj][m][n]; } }
    }
};
struct EpiGU {
    static constexpr bool PERM = true, AFTER_DRAIN = false;
    bf16* hid; const float* wsc; float ainv;
    DI void operator()(const pg8::i32x4 (&acc)[2][2][4][2], const pg8::Unit& u, int wr, int wc, int fr, int fq) const {
        const int row0 = u.pm * 256 + wr * 64 + fr; const int jt = u.pn & 3;
        const int ff0 = jt * 128 + wc * 16 + 4 * fq;
        const float* ws_ = wsc + u.ex * 1024 + jt * 256 + wc * 32 + 8 * fq;
        f32x4 s0[2], s1[2];
#pragma unroll
        for (int bj = 0; bj < 2; ++bj) { s0[bj] = *(const f32x4*)(ws_ + bj * 128) * ainv; s1[bj] = *(const f32x4*)(ws_ + bj * 128 + 4) * ainv; }
#pragma unroll
        for (int ai = 0; ai < 2; ++ai)
#pragma unroll
            for (int m = 0; m < 4; ++m) { bf16* rowp = hid + (size_t)(row0 + ai * 128 + m * 16) * FFE + ff0;
#pragma unroll
                for (int bj = 0; bj < 2; ++bj) { const pg8::i32x4 a0 = acc[ai][bj][m][0], a1 = acc[ai][bj][m][1];
                    const float g0 = (float)a0[0] * s0[bj][0], u0 = (float)a0[1] * s0[bj][1], g1 = (float)a0[2] * s0[bj][2], u1 = (float)a0[3] * s0[bj][3];
                    const float g2 = (float)a1[0] * s1[bj][0], u2 = (float)a1[1] * s1[bj][1], g3 = (float)a1[2] * s1[bj][2], u3 = (float)a1[3] * s1[bj][3];
                    v2u w; w.x = pg8::cvt_pk_bf16(siluf(g0) * u0, siluf(g1) * u1); w.y = pg8::cvt_pk_bf16(siluf(g2) * u2, siluf(g3) * u3);
                    *(v2u*)(rowp + bj * 64) = w; } }
    }
};
struct EpiY {
    static constexpr bool PERM = true, AFTER_DRAIN = false;
    bf16* y;
    DI void operator()(const pg8::f32x4 (&acc)[2][2][4][2], const pg8::Unit& u, int wr, int wc, int fr, int fq) const {
        const int row0 = u.pm * 256 + wr * 64 + fr; const int col0 = (u.pn & 3) * 256 + wc * 32 + 8 * fq;
#pragma unroll
        for (int ai = 0; ai < 2; ++ai)
#pragma unroll
            for (int m = 0; m < 4; ++m) { bf16* rowp = y + (size_t)(row0 + ai * 128 + m * 16) * DMODEL + col0;
#pragma unroll
                for (int bj = 0; bj < 2; ++bj) { const pg8::f32x4 v0 = acc[ai][bj][m][0], v1 = acc[ai][bj][m][1]; pg8::u32x4 w;
                    w.x = pg8::cvt_pk_bf16(v0[0], v0[1]); w.y = pg8::cvt_pk_bf16(v0[2], v0[3]); w.z = pg8::cvt_pk_bf16(v1[0], v1[1]); w.w = pg8::cvt_pk_bf16(v1[2], v1[3]);
                    *(pg8::u32x4*)(rowp + bj * 128) = w; } }
    }
};
constexpr int ETAB_OFF = 131072;
struct MoeOrder {
    const LAS unsigned* etab; int G, c, esplit, pnoff;
    DI bool next(int i, pg8::Unit& u) const {
        if (G % 8 != 0) {
            int L = i * G + c;
            for (int e = 0; e < NEXP; ++e) { const int n4 = 4 * (int)etab[2 * e + 1]; if (L < n4) { u.pm = (int)etab[2 * e] + (L >> 2); u.pn = (e < esplit ? 4 * e : pnoff + 4 * (e - esplit)) + (L & 3); u.ex = e; u.tq = L >> 2; return true; } L -= n4; }
            return false; }
        const int x = c & 7; int L = i * (G >> 3) + (c >> 3);
#pragma unroll
        for (int q = 0; q < NEXP / 8; ++q) { const int e = x + 8 * q; const int n4 = 4 * (int)etab[2 * e + 1];
            if (L < n4) { u.pm = (int)etab[2 * e] + (L >> 2); u.pn = (e < esplit ? 4 * e : pnoff + 4 * (e - esplit)) + (L & 3); u.ex = e; u.tq = L >> 2; return true; } L -= n4; }
        return false; }
    DI void a_ready(const pg8::Unit&) const {}
    DI void done(const pg8::Unit&) const {}
};
struct MoeRows {
    const int* list; const LAS unsigned* etab;
    DI int row(const pg8::Unit& u, int r) const {
        const int slot = u.tq * 256 + r, e = u.ex; if (slot >= (int)etab[64 + e]) return 0;
        const LAS unsigned* sp = etab + 96 + 8 * e; int sb = 0;
#pragma unroll
        for (int q = 1; q < 8; ++q) sb += (slot >= (int)sp[q]) ? 1 : 0;
        return list[(size_t)(e * 8 + sb) * TT + (slot - (int)sp[sb])]; }
};

DI void p2_rope(Frame& F) {
    const int gw = F.vcu * NWAVES + F.wave, NGW = F.G * NWAVES, lane = F.lane;
    const bf16* QKVB = (const bf16*)(F.ws + WS_QKVB);
    bf16* QR = (bf16*)((unsigned char*)F.out + DO_QR); bf16* KR = (bf16*)((unsigned char*)F.out + DO_KR); bf16* VR = (bf16*)((unsigned char*)F.out + DO_VR);
    const int pi = lane & 31, hsel = lane >> 5;
    const float qw0 = F.in[7][2 * pi], qw1 = F.in[7][2 * pi + 1], kw0 = F.in[8][2 * pi], kw1 = F.in[8][2 * pi + 1];
    const float invf = exp2f(-(float)(2 * (pi & 15)) * (13.287712379549449f / 32.0f));
    constexpr float C2 = 0.125f * 1.4426950408889634f;
    constexpr int NB4 = 4;
    for (int t0 = gw; t0 < TT; t0 += NB4 * NGW) {
        unsigned w[NB4][5], vw[NB4];
#pragma unroll
        for (int u = 0; u < NB4; ++u) { const int t = t0 + u * NGW; const unsigned* src = (const unsigned*)(QKVB + (size_t)(t < TT ? t : t0) * 768);
#pragma unroll
            for (int j = 0; j < 5; ++j) w[u][j] = src[(2 * j + hsel) * 32 + pi];
            vw[u] = src[320 + lane]; }
#pragma unroll
        for (int u = 0; u < NB4; ++u) {
            const int t = t0 + u * NGW; if (t >= TT) break;
            const int s_ = t & (SEQ - 1); const float pos = (pi < 16) ? (float)(s_ >> 6) : (float)(s_ & 63);
            const float ang = pos * invf;
            const float rev = ang * 0.15915494309189535f;
            const float sn = __builtin_amdgcn_sinf(rev), cs = __builtin_amdgcn_cosf(rev);
#pragma unroll
            for (int j = 0; j < 5; ++j) {
                const int head = 2 * j + hsel;
                const float x0 = bflo(w[u][j]), x1 = bfhi(w[u][j]);
                float ss = x0 * x0 + x1 * x1;
                ss = sum_x16(sum16(ss));
                const float rs = __builtin_amdgcn_rsqf(ss * (1.f / 64.f) + EPS);
                const bool isq = head < 8;
                const float y0 = x0 * rs * (isq ? qw0 : kw0), y1 = x1 * rs * (isq ? qw1 : kw1);
                float o0 = y0 * cs - y1 * sn, o1 = y0 * sn + y1 * cs;
                if (isq) { o0 *= C2; o1 *= C2; ((unsigned*)(QR + (size_t)t * 512))[head * 32 + pi] = pk2(o0, o1); }
                else { const int hk = head - 8, bq = t >> 13, sq = t & (SEQ - 1);
                    ((unsigned*)(KR + ((size_t)((bq * 2 + hk) * 128 + (sq >> 6)) * 8 + (pi >> 2)) * 512 + (sq & 63) * 8))[pi & 3] = pk2(o0, o1); }
            }
            { const int hk = lane >> 5, d = 2 * (lane & 31), bq = t >> 13, sq = t & (SEQ - 1), r = sq & 63;
              ((unsigned*)(VR + ((size_t)((bq * 2 + hk) * 128 + (sq >> 6)) * 8 + (d >> 5) * 4 + (r >> 4)) * 512 + ((r & 15) * 4 + ((d & 31) >> 3)) * 8))[(d & 7) >> 1] = vw[u]; }
        }
    }
}

constexpr int G_KNP = 0, G_QNP = 17408, G_KNTP = 34816, G_VCT = 53248;
constexpr int G_D0 = 71680, G_D1 = 71680 + 19456;
constexpr int GD_TBP = 0, GD_AP = 9216, GD_VEC = 18432;
constexpr int G_LM = 110592;
constexpr int G_GV = G_LM + 32768;
static_assert(G_GV + 2048 <= LDS_BYTES - 64, "gdn pre lds");

#define TRI_ROW(i, LC, LN) { \
        if ((i) + 1 < 64) { _Pragma("unroll") for (int j4 = 0; j4 < ((i) + 1 + 3) / 4 && j4 < 8; ++j4) LN[j4] = *(const LAS f32x4*)(L + ((i) + 1) * 64 + 4 * j4); } \
        _Pragma("unroll") for (int j4 = 8; j4 < ((i) + 3) / 4; ++j4) lt[j4 - 8] = *(const LAS f32x4*)(L + (i) * 64 + 4 * j4); \
        __builtin_amdgcn_sched_barrier(0); \
        f32x2_t a0 = {(lane == (i)) ? 1.0f : 0.0f, 0.f}, a1 = {0.f, 0.f}; \
        _Pragma("unroll") for (int j4 = 0; j4 < ((i) + 3) / 4; ++j4) { const f32x4 l = (j4 < 8) ? LC[j4 & 7] : lt[(j4 - 8) & 7]; \
            f32x2_t l0 = {l.x, (4 * j4 + 1 < (i)) ? l.y : 0.f}, l1 = {(4 * j4 + 2 < (i)) ? l.z : 0.f, (4 * j4 + 3 < (i)) ? l.w : 0.f}; \
            a0 -= l0 * xp[2 * j4]; if (4 * j4 + 2 < (i)) a1 -= l1 * xp[2 * j4 + 1]; } \
        const float a = (a0.x + a0.y) + (a1.x + a1.y); \
        if ((i) & 1) xp[(i) >> 1].y = a; else { xp[(i) >> 1].x = a; xp[(i) >> 1].y = 0.f; } \
        TBP[(REV ? 63 - (i) : (i)) * 72 + pc] = (bf16)(pk2(a * bcol, 0.f) & 0xffffu); \
        __builtin_amdgcn_sched_barrier(0); }
template <bool REV> DI void tri_inverse(LAS float* L, const LAS float* beta, LAS bf16* TBP, int lane) {
    f32x2_t xp[32];
    L = opaque(L); TBP = opaque(TBP); lane = opaque(lane);
    const float bcol = REV ? beta[63 - lane] : beta[lane];
    const int pc = REV ? permcol(63 - lane) : permcol(lane);
    f32x4 la[8], lb[8], lt[8];
#pragma unroll
    for (int ii = 0; ii < 64; ii += 2) { TRI_ROW(ii, la, lb) TRI_ROW(ii + 1, lb, la) }
}
#undef TRI_ROW

DI void gdn_conv(Frame& F, LAS unsigned char* lds, int t384, int b, int h, int n) {
    const bf16* QKVA = (const bf16*)(F.ws + WS_QKVA); const float* convw = F.in[3];
    const int cgp = t384 % 48, rg = t384 / 48, mat = cgp >> 4, cc = (cgp & 15) * 8;
    const int col = mat * 512 + h * 128 + cc;
    float w[5][8];
#pragma unroll
    for (int j = 0; j < 5; ++j) { const f32x4 a = *(const f32x4*)(convw + j * 1536 + col), bq = *(const f32x4*)(convw + j * 1536 + col + 4);
        w[j][0] = a.x; w[j][1] = a.y; w[j][2] = a.z; w[j][3] = a.w; w[j][4] = bq.x; w[j][5] = bq.y; w[j][6] = bq.z; w[j][7] = bq.w; }
    const int a4 = (cc >> 3) & 3, p0 = (cc & ~31) + 16 * (a4 & 1) + 4 * (a4 >> 1);
    const int ra = rg & 3, q0 = (rg >> 2) * 32 + 16 * (ra & 1) + 4 * (ra >> 1);
#pragma unroll
    for (int hf = 0; hf < 2; ++hf) {
        float o[4][8];
#pragma unroll
        for (int r = 0; r < 4; ++r)
#pragma unroll
            for (int c = 0; c < 8; ++c) o[r][c] = 0.f;
#pragma unroll
        for (int i = 0; i < 8; ++i) {
            const int pos = n * 64 + rg * 8 + hf * 4 - 2 + i;
            v4u raw = (v4u){0u, 0u, 0u, 0u};
            if (pos >= 0 && pos < SEQ) raw = *(const v4u*)(QKVA + (size_t)(b * SEQ + pos) * 1536 + col);
            float xin[8] = {bflo(raw.x), bfhi(raw.x), bflo(raw.y), bfhi(raw.y), bflo(raw.z), bfhi(raw.z), bflo(raw.w), bfhi(raw.w)};
#pragma unroll
            for (int j = 0; j < 5; ++j) { const int r = i - j; if (r >= 0 && r < 4) {
#pragma unroll
                for (int c = 0; c < 8; ++c) o[r][c] += w[j][c] * xin[c]; } }
        }
#pragma unroll
        for (int r = 0; r < 4; ++r) {
            float ss = 0.f;
#pragma unroll
            for (int c = 0; c < 8; ++c) { o[r][c] = siluf(o[r][c]); ss += o[r][c] * o[r][c]; }
            ss = sum16(ss);
            float sc = 1.0f;
            if (mat < 2) { sc = __builtin_amdgcn_rsqf(ss + EPS); if (mat == 0) sc *= 0.08838834764831845f; }
#pragma unroll
            for (int c = 0; c < 8; ++c) o[r][c] *= sc;
        }
        if (mat < 2) {
            LAS unsigned char* tile = lds + (mat == 0 ? G_QNP : G_KNP);
#pragma unroll
            for (int r = 0; r < 4; ++r) { const int c = rg * 8 + hf * 4 + r;
                v2u lo, hi2; lo.x = pk2(o[r][0], o[r][1]); lo.y = pk2(o[r][2], o[r][3]); hi2.x = pk2(o[r][4], o[r][5]); hi2.y = pk2(o[r][6], o[r][7]);
                *(LAS v2u*)(tile + c * 272 + p0 * 2) = lo; *(LAS v2u*)(tile + c * 272 + (p0 + 8) * 2) = hi2; }
        }
        if (mat >= 1) {
#pragma unroll
            for (int c = 0; c < 8; ++c) {
                v2u q4; q4.x = pk2(o[0][c], o[1][c]); q4.y = pk2(o[2][c], o[3][c]);
                if (mat == 1) *(LAS v2u*)(lds + G_KNTP + (cc + c) * 144 + (q0 + 8 * hf) * 2) = q4;
                else *(LAS v2u*)(lds + G_VCT + (cc + c) * 144 + rg * 16 + hf * 8) = q4;
            }
        }
    }
}
DI void gdn_gates(Frame& F, LAS unsigned char* lds, LAS float* gv, int lane, int b, int h, int n) {
    const float* gp = (const float*)(F.ws + WS_GATES) + (size_t)(b * SEQ + n * 64 + lane) * 16;
    const float bfv = gp[h], bbv = gp[4 + h], afv = gp[8 + h], abv = gp[12 + h];
    const float betaf = sigmoidf_(bfv), betab = sigmoidf_(bbv);
    const float xf = afv + F.in[5][h], xb = abv + F.in[5][4 + h];
    const float spf = fmaxf(xf, 0.f) + log1pf(__expf(-fabsf(xf))), spb = fmaxf(xb, 0.f) + log1pf(__expf(-fabsf(xb)));
    const float gf = -__expf(F.in[4][h]) * spf, gb = -__expf(F.in[4][4 + h]) * spb;
    float Gf = gf, Rb = gb;
#pragma unroll
    for (int o = 1; o < 64; o <<= 1) { const float u1 = __shfl_up(Gf, o); if (lane >= o) Gf += u1; const float d1 = __shfl_down(Rb, o); if (lane + o < 64) Rb += d1; }
    gv[lane] = Gf; gv[64 + lane] = Rb; gv[128 + lane] = betaf; gv[192 + lane] = betab;
    const float GfL = __shfl(Gf, 63), Rb0 = __shfl(Rb, 0);
    LAS float* v0 = (LAS float*)(lds + G_D0 + GD_VEC); LAS float* v1 = (LAS float*)(lds + G_D1 + GD_VEC);
    v0[lane] = __expf(Gf); v0[64 + lane] = __expf(GfL - Gf); v1[lane] = __expf(Rb); v1[64 + lane] = __expf(Rb0 - Rb);
    if (lane == 0) { v0[128] = __expf(GfL); v1[128] = __expf(Rb0); }
}
DI void p2_gdn_pre(Frame& F) {
    const int tid = F.tid, lane = F.lane, wave = F.wave;
    int task = F.vcu;
    if (task < 1024) {
        LAS unsigned char* lds = opaque(F.lds);
        const int b = task >> 9, h = (task >> 7) & 3, n = task & 127;
        if (wave >= 2) gdn_conv(F, lds, tid - 128, b, h, n);
        if (wave == 2) gdn_gates(F, lds, (LAS float*)(lds + G_GV), lane, b, h, n);
    }
    __syncthreads();
    int par = 0;
#pragma unroll 1
    for (; task < 1024; task += F.G, par ^= 1) {
        LAS unsigned char* lds = opaque(F.lds);
        const int b = task >> 9, h = (task >> 7) & 3, n = task & 127, bh = b * 4 + h;
        LAS float* gv = (LAS float*)(lds + G_GV + par * 1024);
        LAS float* sGf = gv; LAS float* sRb = gv + 64; LAS float* sBf = gv + 128; LAS float* sBb = gv + 192;
        {
            const int p = wave >> 2, mt = wave & 3, n16 = lane & 15, g = lane >> 4;
            const LAS unsigned char* At = lds + (p == 0 ? G_KNP : G_QNP) + (16 * mt + n16) * 272 + g * 16;
            bf16x8 af[4], bfr[16];
#pragma unroll
            for (int ks = 0; ks < 4; ++ks) af[ks] = *(const LAS bf16x8*)(At + ks * 64);
#pragma unroll
            for (int nt = 0; nt < 4; ++nt)
#pragma unroll
                for (int ks = 0; ks < 4; ++ks) bfr[nt * 4 + ks] = *(const LAS bf16x8*)(lds + G_KNP + (16 * nt + n16) * 272 + g * 16 + ks * 64);
            float Gc[4], Rc[4], Bfc[4], Bbc[4];
#pragma unroll
            for (int r = 0; r < 4; ++r) { const int c = 16 * mt + 4 * g + r; Gc[r] = sGf[c]; Rc[r] = sRb[c]; Bfc[r] = sBf[c]; Bbc[r] = sBb[c]; }
#pragma unroll
            for (int nt = 0; nt < 4; ++nt) {
                f32x4 acc = (f32x4){0.f, 0.f, 0.f, 0.f};
#pragma unroll
                for (int ks = 0; ks < 4; ++ks) acc = __builtin_amdgcn_mfma_f32_16x16x32_bf16(af[ks], bfr[nt * 4 + ks], acc, 0, 0, 0);
                const int s_ = 16 * nt + n16; const float Gs = sGf[s_], Rs = sRb[s_]; const int ps = permcol(s_);
#pragma unroll
                for (int r = 0; r < 4; ++r) {
                    const int c = 16 * mt + 4 * g + r; const float v = acc[r];
                    const float df = __expf(fminf(Gc[r] - Gs, 0.f)), db = __expf(fminf(Rc[r] - Rs, 0.f));
                    if (p == 0) {
                        ((LAS float*)(lds + G_LM))[c * 64 + s_] = Bfc[r] * v * df;
                        ((LAS float*)(lds + G_LM + 16384))[(63 - c) * 64 + (63 - s_)] = Bbc[r] * v * db;
                    } else {
                        ((LAS bf16*)(lds + G_D0 + GD_AP))[c * 72 + ps] = (bf16)(pk2(s_ <= c ? v * df : 0.f, 0.f) & 0xffffu);
                        ((LAS bf16*)(lds + G_D1 + GD_AP))[c * 72 + ps] = (bf16)(pk2(s_ >= c ? v * db : 0.f, 0.f) & 0xffffu);
                    }
                }
            }
        }
        __syncthreads();
        GAS v4u* gd0 = (GAS v4u*)(F.ws + WS_GD + (size_t)((bh * 2 + 0) * 128 + n) * GDN_D_BYTES);
        GAS v4u* gd1 = (GAS v4u*)(F.ws + WS_GD + (size_t)((bh * 2 + 1) * 128 + n) * GDN_D_BYTES);
        {
            GAS v4u* gsh = (GAS v4u*)(F.ws + WS_GSH + (size_t)(bh * 128 + n) * GDN_SH_BYTES);
#pragma unroll 3
            for (int i = tid; i < (int)(GDN_SH_BYTES / 16); i += NTHREADS) gsh[i] = *(const LAS v4u*)(lds + i * 16);
#pragma unroll 1
            for (int i = GD_AP / 16 + tid; i < (int)(GDN_D_BYTES / 16); i += NTHREADS) { gd0[i] = *(const LAS v4u*)(lds + G_D0 + i * 16); gd1[i] = *(const LAS v4u*)(lds + G_D1 + i * 16); }
        }
        __syncthreads();
        if (wave == 0) { tri_inverse<false>((LAS float*)(lds + G_LM), sBf, (LAS bf16*)(lds + G_D0 + GD_TBP), lane);
#pragma unroll 3
            for (int i = lane; i < GD_AP / 16; i += 64) gd0[i] = *(const LAS v4u*)(lds + G_D0 + i * 16); }
        else if (wave == 1) { tri_inverse<true>((LAS float*)(lds + G_LM + 16384), sBb, (LAS bf16*)(lds + G_D1 + GD_TBP), lane);
#pragma unroll 3
            for (int i = lane; i < GD_AP / 16; i += 64) gd1[i] = *(const LAS v4u*)(lds + G_D1 + i * 16); }
        else {
            const int t2 = task + F.G;
            if (t2 < 1024) { const int b2 = t2 >> 9, h2 = (t2 >> 7) & 3, n2 = t2 & 127;
                gdn_conv(F, lds, tid - 128, b2, h2, n2);
                if (wave == 2) gdn_gates(F, lds, (LAS float*)(lds + G_GV + (par ^ 1) * 1024), lane, b2, h2, n2); }
        }
        __syncthreads();
    }
}

DI bf16x8 pack8(const f32x4 a, const f32x4 b) {
    v4u p; p.x = pk2(a[0], a[1]); p.y = pk2(a[2], a[3]); p.z = pk2(b[0], b[1]); p.w = pk2(b[2], b[3]); return __builtin_bit_cast(bf16x8, p);
}
DI void small_weights(Frame& F, int gw, int NGW) {
    LAS float* scr = (LAS float*)(F.lds + F.wave * 16384);
    bf16* WOUT = (bf16*)(F.ws + WS_WOUT);
    for (int it = gw; it < 16 * 32; it += NGW) p0_transpose_item(F.in[9], 1024, 32, WOUT, 1024, 0, 1, scr, it, F.lane);
    bf16* WRH = (bf16*)(F.ws + WS_WR); bf16* WRL = WRH + 48 * 1024; const float* wrg = F.in[11]; const float* wre = F.in[12];
    for (int i = gw * 64 + F.lane; i < 48 * 1024; i += NGW * 64) { const int j = i >> 10, k = i & 1023; float v = 0.f; if (j < 4) v = wrg[k * 4 + j]; else if (j < 36) v = wre[k * 32 + (j - 4)];
        const unsigned h = f2bf(v); const float hv = __builtin_bit_cast(float, h << 16); WRH[i] = (bf16)h; WRL[i] = (bf16)f2bf(v - hv); }
}
DI unsigned char* wgu_ptr(Frame& F, int e) { return F.ws + (e < WGU_SPLIT ? WS_WGU0 + (size_t)e * MiB : WS_WGU1 + (size_t)(e - WGU_SPLIT) * MiB); }
DI bf16* wd_ptr(Frame& F, int e) { return (bf16*)((unsigned char*)F.out + (e < WD_SPLIT ? DO_WD0 + (size_t)e * MiB : DO_WD1 + (size_t)(e - WD_SPLIT) * MiB)); }
DI void moe_weights(Frame& F, int cb, int ncb) {
    for (int it = cb; it < NEXP * 32; it += ncb) { const int e = it >> 5, mat = (it >> 4) & 1, nb = it & 15;
        q_strip((mat ? F.in[14] : F.in[13]) + (size_t)e * 1024 * 512, 512, 32 * nb, wgu_ptr(F, e), (float*)(F.ws + WS_WSC) + e * 1024, mat + 64 * nb, 2, F.lds, F.wave, F.lane); }
    LAS float* scr = (LAS float*)(F.lds + F.wave * 16384);
    constexpr int ID = 8 * 32; const int gw = cb * NWAVES + F.wave, NGW = ncb * NWAVES;
    for (int it = gw; it < NEXP * ID; it += NGW) { const int e = it / ID, r = it % ID;
        p0_transpose_item(F.in[15] + (size_t)e * 512 * 1024, 1024, 32, wd_ptr(F, e), 512, 0, 1, scr, r, F.lane); }
}

constexpr int SC_SLOT = 78848, SC_VCT = 53248, SC_D = 55552, SC_NCH = 11;
static_assert(2 * SC_SLOT <= LDS_BYTES, "scan slots");
DI void sc_issue(v4u (&R)[SC_NCH], const unsigned char* ws, const unsigned (&delta)[SC_NCH], const unsigned (&dmask)[SC_NCH], unsigned shbase, unsigned ddiff) {
#pragma unroll
    for (int j = 0; j < SC_NCH; ++j) { const unsigned off = shbase + delta[j] + (dmask[j] & ddiff);
#ifdef SC_PLAIN_LOADS
        R[j] = *(const v4u*)(ws + off); }
#else
        asm volatile("global_load_dwordx4 %0, %1, %2" : "=v"(R[j]) : "v"(off), "s"(ws) : "memory"); }
#endif
}
#ifdef SC_PLAIN_LOADS
#define SC_WAIT(R, n) do {} while (0)
#else
#define SC_WAIT(R, n) asm volatile("s_waitcnt vmcnt(" #n ")" : "+v"(R[0]), "+v"(R[1]), "+v"(R[2]), "+v"(R[3]), "+v"(R[4]), "+v"(R[5]), "+v"(R[6]), "+v"(R[7]), "+v"(R[8]), "+v"(R[9]), "+v"(R[10]) :: "memory")
#endif
DI void sc_write(const v4u (&R)[SC_NCH], LAS unsigned char* slot, int lid) {
#pragma unroll
    for (int j = 0; j < SC_NCH; ++j) *(LAS v4u*)(slot + 16 * (lid + 448 * j)) = R[j];
}
DI void p4_scan(Frame& F) {
    const int lane = F.lane, n16 = lane & 15, g = lane >> 4, wave = F.wave;
    {
        volatile LAS int* tsk = (volatile LAS int*)(F.lds + MISC_OFF + 32);
        if (F.tid == 0) {
            unsigned* q = (unsigned*)(F.ws + WS_CTL) + CW_SCANQ; const unsigned xcc = xb_xcc_id() & 7u; int task = -1;
            for (unsigned t = 0; t < 8 && task < 0; ++t) { const unsigned y = (xcc + t) & 7u; const unsigned j = xb_add(q + 64 * y, 1u); if (j < 16u) task = (int)(y * 16 + j); }
            *tsk = task; if (task < 0) tsk[1] = (int)xb_add(q + 64 * 8, 1u);
        }
        __syncthreads();
    }
    const int task = *(volatile LAS int*)(F.lds + MISC_OFF + 32);
    if (task < 0) {
        if (F.G > 128) { const int cgw = *(volatile LAS int*)(F.lds + MISC_OFF + 36) * NWAVES + wave, cng = (F.G - 128) * NWAVES; small_weights(F, cgw, cng); moe_weights(F, *(volatile LAS int*)(F.lds + MISC_OFF + 36), F.G - 128); }
        return; }
    const int chain = 2 * (task >> 4) + ((task & 15) >> 3), e = task & 7;
    const int bh = chain >> 1, dir = chain & 1, b = bh >> 2, h = bh & 3;
    LAS unsigned char* lds = opaque(F.lds);
    if (wave != 0) {
        const int lid = (wave - 1) * 64 + lane;
        const unsigned sh0 = (unsigned)(WS_GSH + (size_t)(bh * 128) * GDN_SH_BYTES), d0 = (unsigned)(WS_GD + (size_t)((bh * 2 + dir) * 128) * GDN_D_BYTES);
        unsigned delta[SC_NCH], dmask[SC_NCH];
#pragma unroll
        for (int j = 0; j < SC_NCH; ++j) { const int c = lid + 448 * j;
            delta[j] = (c < 3328) ? 16u * c : ((c < 3472) ? (unsigned)(G_VCT + 16 * e * 144 + 16 * (c - 3328)) : 16u * (c - 3472));
            dmask[j] = (c < 3472) ? 0u : 0xffffffffu; }
        v4u R0[SC_NCH], R1[SC_NCH], R2[SC_NCH];
#define SC_SRC(st) const int n_ = (dir == 0) ? ((st) < 128 ? (st) : 127) : ((st) < 128 ? 127 - (st) : 0); \
                   const unsigned shb_ = sh0 + (unsigned)n_ * (unsigned)GDN_SH_BYTES, ddf_ = (d0 + (unsigned)n_ * (unsigned)GDN_D_BYTES) - shb_;
        { SC_SRC(0) sc_issue(R0, F.ws, delta, dmask, shb_, ddf_); }
        { SC_SRC(1) sc_issue(R1, F.ws, delta, dmask, shb_, ddf_); }
        { SC_SRC(2) sc_issue(R2, F.ws, delta, dmask, shb_, ddf_); }
#define SC_BODY(R, st) { SC_WAIT(R, 22); sc_write(R, lds + ((st) & 1) * SC_SLOT, lid); { SC_SRC((st) + 3) sc_issue(R, F.ws, delta, dmask, shb_, ddf_); } \
                        asm volatile("s_waitcnt lgkmcnt(0)" ::: "memory"); __builtin_amdgcn_s_barrier(); }
#pragma unroll 1
        for (int s0 = 0; s0 < 126; s0 += 3) { SC_BODY(R0, s0) SC_BODY(R1, s0 + 1) SC_BODY(R2, s0 + 2) }
        SC_BODY(R0, 126) SC_BODY(R1, 127)
        SC_WAIT(R0, 0); SC_WAIT(R1, 0); SC_WAIT(R2, 0);
#undef SC_BODY
#undef SC_SRC
        return;
    }
    bf16* Odir = (bf16*)((unsigned char*)F.out + (dir == 0 ? DO_OF : DO_OB));
    f32x4 S[8];
#pragma unroll
    for (int i = 0; i < 8; ++i) S[i] = (f32x4){0.f, 0.f, 0.f, 0.f};
    bf16x8 Sb[4];
#pragma unroll
    for (int i = 0; i < 4; ++i) Sb[i] = (bf16x8){0, 0, 0, 0, 0, 0, 0, 0};
    const unsigned aoff272 = n16 * 272 + g * 16, aoff144 = n16 * 144 + g * 16;
    const unsigned lds0 = (unsigned)(uintptr_t)lds;
#define SB_() __builtin_amdgcn_sched_barrier(0)
#define LDR128(dst, base, off) asm volatile("ds_read_b128 %0, %1 offset:%2" : "=v"(dst) : "v"(base), "i"(off) : "memory")
#define LDR64(dst, base, off) asm volatile("ds_read_b64 %0, %1 offset:%2" : "=v"(dst) : "v"(base), "i"(off) : "memory")
#define LDR32(dst, base, off) asm volatile("ds_read_b32 %0, %1 offset:%2" : "=v"(dst) : "v"(base), "i"(off) : "memory")
#pragma unroll 1
    for (int step = 0; step < 128; ++step) {
        __builtin_amdgcn_s_barrier();
        asm volatile("" ::: "memory");
        const int n = dir == 0 ? step : 127 - step;
        const unsigned slot = lds0 + (unsigned)(step & 1) * SC_SLOT;
        const unsigned bK = slot + G_KNP + aoff272, bQ = slot + G_QNP + aoff272, bKT = slot + G_KNTP + aoff144, bT = slot + SC_D + GD_TBP + aoff144;
        const unsigned bV = slot + SC_VCT + n16 * 144 + g * 8, bvec = slot + SC_D + GD_VEC + g * 16, bd = slot + SC_D + GD_VEC;
        f32x4 eG[4], ks[4]; v2u vv[4]; float dch; bf16x8 fa[16];
        LDR128(eG[0], bvec, 0); LDR128(eG[1], bvec, 64); LDR128(eG[2], bvec, 128); LDR128(eG[3], bvec, 192);
        LDR128(ks[0], bvec, 256); LDR128(ks[1], bvec, 320); LDR128(ks[2], bvec, 384); LDR128(ks[3], bvec, 448);
        LDR32(dch, bd, 512);
        LDR64(vv[0], bV, 0); LDR64(vv[1], bV, 32); LDR64(vv[2], bV, 64); LDR64(vv[3], bV, 96);
#pragma unroll
        for (int m = 0; m < 4; ++m) { LDR128(fa[m * 4 + 0], bK, m * 4352 + 0); LDR128(fa[m * 4 + 1], bK, m * 4352 + 64); LDR128(fa[m * 4 + 2], bK, m * 4352 + 128); LDR128(fa[m * 4 + 3], bK, m * 4352 + 192); }
        bf16x8 fq[16];
#pragma unroll
        for (int m = 0; m < 4; ++m) { LDR128(fq[m * 4 + 0], bQ, m * 4352 + 0); LDR128(fq[m * 4 + 1], bQ, m * 4352 + 64); LDR128(fq[m * 4 + 2], bQ, m * 4352 + 128); LDR128(fq[m * 4 + 3], bQ, m * 4352 + 192); }
        asm volatile("s_waitcnt lgkmcnt(15)" : "+v"(eG[0]), "+v"(eG[1]), "+v"(eG[2]), "+v"(eG[3]), "+v"(ks[0]), "+v"(ks[1]), "+v"(ks[2]), "+v"(ks[3]), "+v"(dch), "+v"(vv[0]), "+v"(vv[1]), "+v"(vv[2]), "+v"(vv[3]),
                     "+v"(fa[0]), "+v"(fa[1]), "+v"(fa[2]), "+v"(fa[3]), "+v"(fa[4]), "+v"(fa[5]), "+v"(fa[6]), "+v"(fa[7]), "+v"(fa[8]), "+v"(fa[9]), "+v"(fa[10]), "+v"(fa[11]), "+v"(fa[12]), "+v"(fa[13]), "+v"(fa[14]), "+v"(fa[15]) :: "memory");
        SB_();
        f32x4 KS[4];
#pragma unroll
        for (int m = 0; m < 4; ++m) KS[m] = (f32x4){0.f, 0.f, 0.f, 0.f};
#pragma unroll
        for (int i = 0; i < 4; ++i)
#pragma unroll
            for (int m = 0; m < 4; ++m) KS[m] = __builtin_amdgcn_mfma_f32_16x16x32_bf16(fa[m * 4 + i], Sb[i], KS[m], 0, 0, 0);
        SB_();
        bf16x8 ft[8];
#pragma unroll
        for (int m = 0; m < 4; ++m) { LDR128(ft[m * 2 + 0], bT, m * 2304 + 0); LDR128(ft[m * 2 + 1], bT, m * 2304 + 64); }
        asm volatile("s_waitcnt lgkmcnt(8)" : "+v"(fq[0]), "+v"(fq[1]), "+v"(fq[2]), "+v"(fq[3]), "+v"(fq[4]), "+v"(fq[5]), "+v"(fq[6]), "+v"(fq[7]), "+v"(fq[8]), "+v"(fq[9]), "+v"(fq[10]), "+v"(fq[11]), "+v"(fq[12]), "+v"(fq[13]), "+v"(fq[14]), "+v"(fq[15]) :: "memory");
        SB_();
        f32x4 o[4];
#pragma unroll
        for (int m = 0; m < 4; ++m) o[m] = (f32x4){0.f, 0.f, 0.f, 0.f};
#pragma unroll
        for (int i = 0; i < 4; ++i)
#pragma unroll
            for (int m = 0; m < 4; ++m) o[m] = __builtin_amdgcn_mfma_f32_16x16x32_bf16(fq[m * 4 + i], Sb[i], o[m], 0, 0, 0);
        f32x4 rr[4];
#pragma unroll
        for (int m = 0; m < 4; ++m) { rr[m][0] = bflo(vv[m].x) - eG[m][0] * KS[m][0]; rr[m][1] = bfhi(vv[m].x) - eG[m][1] * KS[m][1]; rr[m][2] = bflo(vv[m].y) - eG[m][2] * KS[m][2]; rr[m][3] = bfhi(vv[m].y) - eG[m][3] * KS[m][3]; }
        bf16x8 rb[2]; rb[0] = pack8(rr[0], rr[1]); rb[1] = pack8(rr[2], rr[3]);
        SB_();
        bf16x8 fk[16];
#pragma unroll
        for (int jt = 0; jt < 8; ++jt) { LDR128(fk[jt * 2 + 0], bKT, jt * 2304 + 0); LDR128(fk[jt * 2 + 1], bKT, jt * 2304 + 64); }
        asm volatile("s_waitcnt lgkmcnt(15)" : "+v"(ft[0]), "+v"(ft[1]), "+v"(ft[2]), "+v"(ft[3]), "+v"(ft[4]), "+v"(ft[5]), "+v"(ft[6]), "+v"(ft[7]) :: "memory");
        SB_();
        f32x4 vn[4];
#pragma unroll
        for (int m = 0; m < 4; ++m) vn[m] = (f32x4){0.f, 0.f, 0.f, 0.f};
#pragma unroll
        for (int i = 0; i < 2; ++i)
#pragma unroll
            for (int m = 0; m < 4; ++m) vn[m] = __builtin_amdgcn_mfma_f32_16x16x32_bf16(ft[m * 2 + i], rb[i], vn[m], 0, 0, 0);
#pragma unroll
        for (int m = 0; m < 4; ++m) o[m] = o[m] * eG[m];
#pragma unroll
        for (int jt = 0; jt < 8; ++jt) S[jt] = S[jt] * dch;
        SB_();
        bf16x8 fp[8];
#pragma unroll
        for (int m = 0; m < 4; ++m) { LDR128(fp[m * 2 + 0], bT, GD_AP + m * 2304 + 0); LDR128(fp[m * 2 + 1], bT, GD_AP + m * 2304 + 64); }
        bf16x8 vnb[2]; vnb[0] = pack8(vn[0], vn[1]); vnb[1] = pack8(vn[2], vn[3]);
        bf16x8 vs[2]; vs[0] = pack8(vn[0] * ks[0], vn[1] * ks[1]); vs[1] = pack8(vn[2] * ks[2], vn[3] * ks[3]);
        asm volatile("s_waitcnt lgkmcnt(8)" : "+v"(fk[0]), "+v"(fk[1]), "+v"(fk[2]), "+v"(fk[3]), "+v"(fk[4]), "+v"(fk[5]), "+v"(fk[6]), "+v"(fk[7]), "+v"(fk[8]), "+v"(fk[9]), "+v"(fk[10]), "+v"(fk[11]), "+v"(fk[12]), "+v"(fk[13]), "+v"(fk[14]), "+v"(fk[15]) :: "memory");
        SB_();
#pragma unroll
        for (int i = 0; i < 2; ++i)
#pragma unroll
            for (int jt = 0; jt < 8; ++jt) S[jt] = __builtin_amdgcn_mfma_f32_16x16x32_bf16(fk[jt * 2 + i], vs[i], S[jt], 0, 0, 0);
        asm volatile("s_waitcnt lgkmcnt(0)" : "+v"(fp[0]), "+v"(fp[1]), "+v"(fp[2]), "+v"(fp[3]), "+v"(fp[4]), "+v"(fp[5]), "+v"(fp[6]), "+v"(fp[7]) :: "memory");
#pragma unroll
        for (int i = 0; i < 2; ++i)
#pragma unroll
            for (int m = 0; m < 4; ++m) o[m] = __builtin_amdgcn_mfma_f32_16x16x32_bf16(fp[m * 2 + i], vnb[i], o[m], 0, 0, 0);
#pragma unroll
        for (int i = 0; i < 4; ++i) Sb[i] = pack8(S[2 * i], S[2 * i + 1]);
        SB_();
        bf16* op = Odir + (size_t)(b * SEQ + n * 64) * 512 + h * 128 + 16 * e + n16;
#pragma unroll
        for (int m = 0; m < 4; ++m)
#pragma unroll
            for (int r = 0; r < 4; ++r) op[(size_t)(16 * m + 4 * g + r) * 512] = (bf16)(pk2(o[m][r], 0.f) & 0xffffu);
    }
#undef SB_
#undef LDR128
#undef LDR64
#undef LDR32
}

DI void p5_combine(Frame& F) {
    const int gw = F.vcu * NWAVES + F.wave, NGW = F.G * NWAVES, lane = F.lane;
    const bf16* OFp = (const bf16*)((unsigned char*)F.out + DO_OF); const bf16* OBp = (const bf16*)((unsigned char*)F.out + DO_OB);
    const bf16* ZA = (const bf16*)(F.ws + WS_ZA); bf16* OCAT = (bf16*)(F.ws + WS_OCAT);
    const float* nw = F.in[6] + (lane & 15) * 8;
    float w8[8];
#pragma unroll
    for (int c = 0; c < 8; ++c) w8[c] = nw[c];
    constexpr int NB4 = 4;
    for (int t0 = gw; t0 < TT; t0 += NB4 * NGW) {
        v4u a[NB4], bb[NB4], z[NB4];
#pragma unroll
        for (int u = 0; u < NB4; ++u) { const int t = (t0 + u * NGW < TT) ? t0 + u * NGW : t0;
            a[u] = *(const v4u*)(OFp + (size_t)t * 512 + lane * 8); bb[u] = *(const v4u*)(OBp + (size_t)t * 512 + lane * 8); z[u] = *(const v4u*)(ZA + (size_t)t * 512 + lane * 8); }
#pragma unroll
        for (int u = 0; u < NB4; ++u) {
            const int t = t0 + u * NGW; if (t >= TT) break;
            float o[8] = {bflo(a[u].x) + bflo(bb[u].x), bfhi(a[u].x) + bfhi(bb[u].x), bflo(a[u].y) + bflo(bb[u].y), bfhi(a[u].y) + bfhi(bb[u].y), bflo(a[u].z) + bflo(bb[u].z), bfhi(a[u].z) + bfhi(bb[u].z), bflo(a[u].w) + bflo(bb[u].w), bfhi(a[u].w) + bfhi(bb[u].w)};
            const float zz[8] = {bflo(z[u].x), bfhi(z[u].x), bflo(z[u].y), bfhi(z[u].y), bflo(z[u].z), bfhi(z[u].z), bflo(z[u].w), bfhi(z[u].w)};
            float ss = 0.f;
#pragma unroll
            for (int c = 0; c < 8; ++c) ss += o[c] * o[c];
            ss = sum16(ss);
            const float rn = __builtin_amdgcn_rsqf(ss * (1.f / 128.f) + EPS);
#pragma unroll
            for (int c = 0; c < 8; ++c) o[c] = o[c] * rn * w8[c] * siluf(zz[c]);
            v4u r; r.x = pk2(o[0], o[1]); r.y = pk2(o[2], o[3]); r.z = pk2(o[4], o[5]); r.w = pk2(o[6], o[7]);
            *(v4u*)(OCAT + (size_t)t * 1024 + lane * 8) = r;
        }
    }
}

struct TokRec { int e[2]; int row[2]; float gate[2]; };
DI void p7_route(Frame& F) {
    const int lane = F.lane, n16 = lane & 15, g = lane >> 4, wave = F.wave;
    const float* X1 = (const float*)(F.ws + WS_X1); const float* nfw = F.in[10];
    const bf16* WRH = (const bf16*)(F.ws + WS_WR); const bf16* WRL = WRH + 48 * 1024;
    unsigned char* HN = (unsigned char*)F.out + DO_HN; TokRec* TOK = (TokRec*)(F.ws + WS_TOK); unsigned* gcnt = (unsigned*)(F.ws + WS_CTL) + CW_CNT; int* LIST = (int*)(F.ws + WS_LIST);
    LAS float* lg = (LAS float*)(F.lds + (wave & 3) * 4096);
    LAS unsigned* hist = (LAS unsigned*)(F.lds + 16384); LAS unsigned* base = hist + 32;
    const int sub = blockIdx.x & 7;
    const float qsc = 127.0f / act_absmax(nfw, lane);
    for (int rt0 = blockIdx.x * 4; rt0 < TT / 16; rt0 += F.G * 4) {
        if (F.tid < 32) hist[F.tid] = 0u;
        __syncthreads();
        int ex1 = 0, ex2 = 0, tok = -1; unsigned l1 = 0, l2 = 0; float g1 = 0.f, g2 = 0.f;
        const int rt = rt0 + wave;
        if (wave < 4 && rt < TT / 16) {
            const int row = rt * 16 + n16; const float* xr = X1 + (size_t)row * DMODEL + 8 * g;
            float ss = 0.f;
#pragma unroll 16
            for (int i = 0; i < 32; ++i) { const f32x4 a = *(const f32x4*)(xr + 32 * i), b2 = *(const f32x4*)(xr + 32 * i + 4);
                ss += (a.x * a.x + a.y * a.y) + (a.z * a.z + a.w * a.w) + (b2.x * b2.x + b2.y * b2.y) + (b2.z * b2.z + b2.w * b2.w); }
            ss = sum_x32(sum_x16(ss));
            const float rs = __builtin_amdgcn_rsqf(ss * (1.f / DMODEL) + EPS);
            f32x4 acc[3];
#pragma unroll
            for (int q = 0; q < 3; ++q) acc[q] = (f32x4){0.f, 0.f, 0.f, 0.f};
#pragma unroll 4
            for (int i = 0; i < 32; ++i) {
                const f32x4 a = *(const f32x4*)(xr + 32 * i), b2 = *(const f32x4*)(xr + 32 * i + 4);
                const f32x4 wa = *(const f32x4*)(nfw + 32 * i + 8 * g), wb = *(const f32x4*)(nfw + 32 * i + 8 * g + 4);
                float hv[8] = {a.x * rs * wa.x, a.y * rs * wa.y, a.z * rs * wa.z, a.w * rs * wa.w, b2.x * rs * wb.x, b2.y * rs * wb.y, b2.z * rs * wb.z, b2.w * rs * wb.w};
                v4u hi, lo;
                hi.x = pk2(hv[0], hv[1]); hi.y = pk2(hv[2], hv[3]); hi.z = pk2(hv[4], hv[5]); hi.w = pk2(hv[6], hv[7]);
                lo.x = pk2(hv[0] - bflo(hi.x), hv[1] - bfhi(hi.x)); lo.y = pk2(hv[2] - bflo(hi.y), hv[3] - bfhi(hi.y));
                lo.z = pk2(hv[4] - bflo(hi.z), hv[5] - bfhi(hi.z)); lo.w = pk2(hv[6] - bflo(hi.w), hv[7] - bfhi(hi.w));
                { v2u q; q.x = q8x4(hv[0], hv[1], hv[2], hv[3], qsc); q.y = q8x4(hv[4], hv[5], hv[6], hv[7], qsc); *(v2u*)(HN + (size_t)row * DMODEL + 32 * i + 8 * g) = q; }
                const bf16x8 ah = __builtin_bit_cast(bf16x8, hi), al = __builtin_bit_cast(bf16x8, lo);
#pragma unroll
                for (int q = 0; q < 3; ++q) {
                    const bf16x8 bh = *(const bf16x8*)(WRH + (size_t)(16 * q + n16) * 1024 + 32 * i + 8 * g), bl = *(const bf16x8*)(WRL + (size_t)(16 * q + n16) * 1024 + 32 * i + 8 * g);
                    acc[q] = __builtin_amdgcn_mfma_f32_16x16x32_bf16(ah, bh, acc[q], 0, 0, 0);
                    acc[q] = __builtin_amdgcn_mfma_f32_16x16x32_bf16(ah, bl, acc[q], 0, 0, 0);
                    acc[q] = __builtin_amdgcn_mfma_f32_16x16x32_bf16(al, bh, acc[q], 0, 0, 0);
                }
            }
#pragma unroll
            for (int q = 0; q < 3; ++q)
#pragma unroll
                for (int r = 0; r < 4; ++r) lg[(4 * g + r) * 48 + 16 * q + n16] = acc[q][r];
            asm volatile("s_waitcnt lgkmcnt(0)" ::: "memory");
            if (lane < 16) {
                const LAS float* L = lg + lane * 48; tok = rt * 16 + lane;
                float gm = L[0]; int gs = 0;
#pragma unroll
                for (int q = 1; q < 4; ++q) if (L[q] > gm) { gm = L[q]; gs = q; }
                float gsum = 0.f;
#pragma unroll
                for (int q = 0; q < 4; ++q) gsum += __expf(L[q] - gm);
                const float gp_top = 1.0f / gsum;
                float fv[8];
#pragma unroll
                for (int q = 0; q < 8; ++q) { float v = L[4 + q]; v = (gs == 1) ? L[12 + q] : v; v = (gs == 2) ? L[20 + q] : v; v = (gs == 3) ? L[28 + q] : v; fv[q] = v; }
                float m1 = fv[0]; int i1 = 0;
#pragma unroll
                for (int q = 1; q < 8; ++q) if (fv[q] > m1) { m1 = fv[q]; i1 = q; }
                float m2 = -3.0e38f; int i2 = 0;
#pragma unroll
                for (int q = 0; q < 8; ++q) if (q != i1 && fv[q] > m2) { m2 = fv[q]; i2 = q; }
                const float e2 = __expf(m2 - m1); g1 = gp_top / (1.0f + e2); g2 = gp_top * e2 / (1.0f + e2);
                ex1 = gs * 8 + i1; ex2 = gs * 8 + i2;
                l1 = __hip_atomic_fetch_add(hist + ex1, 1u, __ATOMIC_RELAXED, __HIP_MEMORY_SCOPE_WORKGROUP); l2 = __hip_atomic_fetch_add(hist + ex2, 1u, __ATOMIC_RELAXED, __HIP_MEMORY_SCOPE_WORKGROUP);
            }
        }
        __syncthreads();
        if (F.tid < 32) { const unsigned hcount = hist[F.tid]; base[F.tid] = hcount ? atomicAdd(gcnt + F.tid * 8 + sub, hcount) : 0u; }
        __syncthreads();
        if (tok >= 0) {
            const int s1 = (int)(base[ex1] + l1), s2 = (int)(base[ex2] + l2);
            LIST[(size_t)(ex1 * 8 + sub) * TT + s1] = tok; LIST[(size_t)(ex2 * 8 + sub) * TT + s2] = tok;
            TokRec tr; tr.e[0] = ex1; tr.e[1] = ex2; tr.row[0] = (sub << 24) | s1; tr.row[1] = (sub << 24) | s2; tr.gate[0] = g1; tr.gate[1] = g2;
            TOK[tok] = tr;
        }
    }
}

DI void build_etab(Frame& F) {
    LAS unsigned* etab = (LAS unsigned*)(F.lds + ETAB_OFF);
    if (F.tid < 32) {
        const unsigned* gcnt = (const unsigned*)(F.ws + WS_CTL) + CW_CNT + F.tid * 8; unsigned acc = 0;
#pragma unroll
        for (int q = 0; q < 8; ++q) { const unsigned c = __hip_atomic_load(gcnt + q, __ATOMIC_RELAXED, __HIP_MEMORY_SCOPE_AGENT); etab[96 + 8 * F.tid + q] = acc; acc += c; }
        etab[64 + F.tid] = acc; etab[2 * F.tid + 1] = (acc + 255u) >> 8;
    }
    __syncthreads();
    if (F.tid == 0) { unsigned acc = 0; for (int e = 0; e < NEXP; ++e) { etab[2 * e] = acc; acc += etab[2 * e + 1]; } }
    if (F.wave == 1) { const float am = act_absmax(F.in[10], F.lane); if (F.lane == 0) ((LAS float*)etab)[352] = am * (1.0f / 127.0f); }
    __syncthreads();
}

DI void p11_final(Frame& F) {
    build_etab(F);
    const LAS unsigned* etab = (const LAS unsigned*)(F.lds + ETAB_OFF);
    const int gw = F.vcu * NWAVES + F.wave, NGW = F.G * NWAVES, lane = F.lane;
    const bf16* Y = (const bf16*)(F.ws + WS_XBUF); const TokRec* TOK = (const TokRec*)(F.ws + WS_TOK); const float* fw = F.in[16];
    const f32x4 w0 = *(const f32x4*)(fw + lane * 8), w1 = *(const f32x4*)(fw + lane * 8 + 4), w2 = *(const f32x4*)(fw + 512 + lane * 8), w3 = *(const f32x4*)(fw + 516 + lane * 8);
    constexpr int NB2 = 2;
    for (int t0 = gw; t0 < TT; t0 += NB2 * NGW) {
        TokRec tr[NB2]; f32x4 xa[NB2][4]; v4u ya[NB2][2][2];
#pragma unroll
        for (int u = 0; u < NB2; ++u) { const int t = (t0 + u * NGW < TT) ? t0 + u * NGW : t0; tr[u] = TOK[t];
            const float* xr = (const float*)(F.ws + WS_X1) + (size_t)t * DMODEL + lane * 8;
            xa[u][0] = *(const f32x4*)(xr); xa[u][1] = *(const f32x4*)(xr + 4); xa[u][2] = *(const f32x4*)(xr + 512); xa[u][3] = *(const f32x4*)(xr + 516); }
#pragma unroll
        for (int u = 0; u < NB2; ++u)
#pragma unroll
            for (int k = 0; k < 2; ++k) { const unsigned rk = (unsigned)tr[u].row[k]; const bf16* yr = Y + (size_t)(etab[2 * tr[u].e[k]] * 256u + etab[96 + 8 * tr[u].e[k] + (rk >> 24)] + (rk & 0xffffffu)) * DMODEL + lane * 8; ya[u][k][0] = *(const v4u*)(yr); ya[u][k][1] = *(const v4u*)(yr + 512); }
#pragma unroll
        for (int u = 0; u < NB2; ++u) {
            const int t = t0 + u * NGW; if (t >= TT) break;
            float v[16] = {xa[u][0].x, xa[u][0].y, xa[u][0].z, xa[u][0].w, xa[u][1].x, xa[u][1].y, xa[u][1].z, xa[u][1].w, xa[u][2].x, xa[u][2].y, xa[u][2].z, xa[u][2].w, xa[u][3].x, xa[u][3].y, xa[u][3].z, xa[u][3].w};
#pragma unroll
            for (int k = 0; k < 2; ++k) {
                const float gk = tr[u].gate[k]; const v4u y0 = ya[u][k][0], y1 = ya[u][k][1];
                v[0] += gk * bflo(y0.x); v[1] += gk * bfhi(y0.x); v[2] += gk * bflo(y0.y); v[3] += gk * bfhi(y0.y); v[4] += gk * bflo(y0.z); v[5] += gk * bfhi(y0.z); v[6] += gk * bflo(y0.w); v[7] += gk * bfhi(y0.w);
                v[8] += gk * bflo(y1.x); v[9] += gk * bfhi(y1.x); v[10] += gk * bflo(y1.y); v[11] += gk * bfhi(y1.y); v[12] += gk * bflo(y1.z); v[13] += gk * bfhi(y1.z); v[14] += gk * bflo(y1.w); v[15] += gk * bfhi(y1.w);
            }
            float ss = 0.f;
#pragma unroll
            for (int i = 0; i < 16; ++i) ss += v[i] * v[i];
            const float rs = __builtin_amdgcn_rsqf(wave_sum(ss) * (1.f / DMODEL) + EPS);
            float* orow = F.out + (size_t)t * DMODEL + lane * 8;
            *(f32x4*)(orow) = (f32x4){v[0] * rs * w0.x, v[1] * rs * w0.y, v[2] * rs * w0.z, v[3] * rs * w0.w};
            *(f32x4*)(orow + 4) = (f32x4){v[4] * rs * w1.x, v[5] * rs * w1.y, v[6] * rs * w1.z, v[7] * rs * w1.w};
            *(f32x4*)(orow + 512) = (f32x4){v[8] * rs * w2.x, v[9] * rs * w2.y, v[10] * rs * w2.z, v[11] * rs * w2.w};
            *(f32x4*)(orow + 516) = (f32x4){v[12] * rs * w3.x, v[13] * rs * w3.y, v[14] * rs * w3.z, v[15] * rs * w3.w};
        }
    }
}

struct Args { const float* in[17]; float* out; unsigned char* ws; int ph_lo, ph_hi; };
__global__ void __launch_bounds__(NTHREADS, 2) fwd_kernel(Args args) {
    extern __shared__ __attribute__((aligned(16))) unsigned char lds[];
    cg::grid_group grid = cg::this_grid();
    Frame F;
    F.lds = (LAS unsigned char*)lds; F.tid = threadIdx.x; F.lane = F.tid & 63; F.wave = __builtin_amdgcn_readfirstlane(F.tid >> 6);
    F.G = gridDim.x; { const int bx = blockIdx.x; F.vcu = (F.G % 8 == 0) ? (bx % 8) * (F.G / 8) + bx / 8 : bx; }
#pragma unroll
    for (int i = 0; i < 17; ++i) F.in[i] = args.in[i];
    F.out = args.out; F.ws = args.ws;
    const int lo = args.ph_lo, hi = args.ph_hi;
    if (F.tid < 16) ((volatile LAS unsigned*)(F.lds + MISC_OFF))[F.tid] = 0u;
    __syncthreads();
    XcdBarrier bar = xcd_barrier_post((unsigned*)(F.ws + WS_CTL) + CW_BAR, (volatile LAS unsigned*)(F.lds + MISC_OFF));
    if (lo > 1000) grid.sync();
#ifndef PHSEL
#define PHSEL 0xfff
#endif
#define IN(k) (((PHSEL >> (k)) & 1) && lo <= (k) && (k) < hi)
#define SEAM(k) do { if (IN(k) && IN((k) + 1)) xcd_barrier(bar); } while (0)
#ifndef REP_PH
#define REP_PH -1
#endif
#define REPS(k) for (int rep_ = 0; rep_ < ((k) == REP_PH ? 2 : 1); ++rep_, ((k) == REP_PH && rep_ < 2) ? xcd_barrier(bar) : (void)0)
    if (IN(0)) REPS(0) { p0_prologue(F); } SEAM(0);
    if (IN(1)) REPS(1) {
        pg8::Gemm gm{(const pg8::bf16_t*)(F.ws + WS_XN), (const pg8::bf16_t*)(F.ws + WS_WIN), TT, NPROJ, DMODEL / 2};
        pg8::StaticOrder S; S.init(TT, NPROJ, F.G, (int)blockIdx.x);
        EpiProj E{(bf16*)(F.ws + WS_QKVA), (bf16*)(F.ws + WS_ZA), (bf16*)(F.ws + WS_QKVB), (const float*)(F.ws + WS_WSI), (const float*)(F.ws + WS_XSC)};
        pg8::gemm_phase_gather<EpiProj, pg8::StaticOrder, IdRows, true, true>(F.lds, gm, S, E, IdRows{});
    } SEAM(1);
    if (IN(2)) REPS(2) {
#ifndef NO_ROPE
        p2_rope(F);
#ifdef PROBE_ROPE2
        xcd_barrier(bar); p2_rope(F);
#endif
#endif
#ifndef NO_PRE
        p2_gdn_pre(F);
#ifdef PROBE_PRE2
        xcd_barrier(bar); p2_gdn_pre(F);
#endif
#endif
    } SEAM(2);
    if (IN(3)) REPS(3) {
        const attn_body::AttnTensors AT{(const attn_body::bf16*)((unsigned char*)F.out + DO_QR), (const attn_body::bf16*)((unsigned char*)F.out + DO_KR), (const attn_body::bf16*)((unsigned char*)F.out + DO_VR),
                                        (attn_body::bf16*)(F.ws + WS_OCAT) + 512};
        const attn_body::StaticOrder S((int)F.G, (int)blockIdx.x);
#ifdef PROBE_ZERO_ATTN
        { (void)AT; (void)S; bf16* OC = (bf16*)(F.ws + WS_OCAT); const int gt = blockIdx.x * NTHREADS + F.tid, GT = F.G * NTHREADS;
          for (int i = gt; i < TT * 64; i += GT) { const int t = i >> 6, c = i & 63; *(v4u*)(OC + (size_t)t * 1024 + 512 + c * 8) = (v4u){0u, 0u, 0u, 0u}; } }
#else
        attn_body::attn_phase<attn_body::StaticOrder>((char*)lds, AT, S);
#endif
    } SEAM(3);
#ifdef PROBE_SCAN2
    if (IN(4)) { p4_scan(F); xcd_barrier(bar); p4_scan(F); } SEAM(4);
#else
    if (IN(4)) REPS(4) { p4_scan(F); } SEAM(4);
#endif
    if (IN(5)) REPS(5) { p5_combine(F); if (F.G <= 128) { small_weights(F, F.vcu * NWAVES + F.wave, F.G * NWAVES); moe_weights(F, F.vcu, F.G); } } SEAM(5);
    if (IN(6)) REPS(6) {
        pg8::Gemm gm{(const pg8::bf16_t*)(F.ws + WS_OCAT), (const pg8::bf16_t*)(F.ws + WS_WOUT), TT, DMODEL, DMODEL}; pg8::StaticOrder S; S.init(TT, DMODEL, F.G, (int)blockIdx.x);
        EpiResid E{F.in[0], (float*)(F.ws + WS_X1)};
        pg8::gemm_phase<EpiResid, pg8::StaticOrder, true, true>(F.lds, gm, S, E);
    } SEAM(6);
    if (IN(7)) { p7_route(F); } SEAM(7);
    if (IN(9)) REPS(9) {
        build_etab(F);
        pg8::Gemm gm{(const pg8::bf16_t*)((unsigned char*)F.out + DO_HN), (const pg8::bf16_t*)(F.ws + WS_WGU0), 0, 0, DMODEL / 2};
        MoeOrder S{(const LAS unsigned*)(F.lds + ETAB_OFF), F.G, (int)blockIdx.x, WGU_SPLIT, (int)((WS_WGU1 - WS_WGU0) / (256 * 1024))};
        MoeRows AM{(const int*)(F.ws + WS_LIST), (const LAS unsigned*)(F.lds + ETAB_OFF)};
        EpiGU E{(bf16*)(F.ws + WS_HID), (const float*)(F.ws + WS_WSC), ((const LAS float*)(F.lds + ETAB_OFF))[352]};
        pg8::gemm_phase_gather<EpiGU, MoeOrder, MoeRows, true, true>(F.lds, gm, S, E, AM);
    } SEAM(9);
    if (IN(10)) REPS(10) {
        pg8::Gemm gm{(const pg8::bf16_t*)(F.ws + WS_HID), (const pg8::bf16_t*)((unsigned char*)F.out + DO_WD0), 0, 0, FFE}; build_etab(F); MoeOrder S{(const LAS unsigned*)(F.lds + ETAB_OFF), F.G, (int)blockIdx.x, WD_SPLIT, (int)((DO_WD1 - DO_WD0) / (256 * 1024))};
        EpiY E{(bf16*)(F.ws + WS_XBUF)};
        pg8::gemm_phase<EpiY, MoeOrder, true, true>(F.lds, gm, S, E);
    } SEAM(10);
#ifdef EXTRA_SYNCS
    for (int q_ = 0; q_ < EXTRA_SYNCS; ++q_) xcd_barrier(bar);
#endif
    if (IN(11)) { p11_final(F); }
#undef IN
#undef SEAM
}

extern "C" void kernel_launch(void* const* d_in, const int* in_sizes, int n_in, void* d_out, int out_size, void* d_ws, size_t ws_size, hipStream_t stream) {
    static int grid = 0;
    if (grid == 0) {
        if (n_in != 17 || out_size != TT * DMODEL || ws_size < WS_END) { fprintf(stderr, "kernel_launch: unexpected problem (n_in %d out %d ws %zu)\n", n_in, out_size, ws_size); grid = -1; return; }
        int dev = 0, cus = 0, per_cu = 0;
        if (hipGetDevice(&dev) != hipSuccess || hipDeviceGetAttribute(&cus, hipDeviceAttributeMultiprocessorCount, dev) != hipSuccess) { grid = -1; return; }
        if (hipFuncSetAttribute((const void*)fwd_kernel, hipFuncAttributeMaxDynamicSharedMemorySize, LDS_BYTES) != hipSuccess) { fprintf(stderr, "hipFuncSetAttribute failed\n"); grid = -1; return; }
        if (hipOccupancyMaxActiveBlocksPerMultiprocessor(&per_cu, (const void*)fwd_kernel, NTHREADS, LDS_BYTES) != hipSuccess || per_cu < 1) { fprintf(stderr, "occupancy query: %d\n", per_cu); grid = -1; return; }
        grid = cus;
    }
    if (grid < 0) return;
    (void)hipMemsetAsync((char*)d_ws + WS_CTL, 0, CTL_ZERO_BYTES, stream);
    Args a{};
    for (int i = 0; i < 17; ++i) a.in[i] = (const float*)d_in[i];
    a.out = (float*)d_out; a.ws = (unsigned char*)d_ws;
#if MK_PER_PHASE
    for (int p = 0; p < N_PHASES; ++p) { a.ph_lo = p; a.ph_hi = p + 1; hipLaunchKernelGGL(fwd_kernel, dim3(grid), dim3(NTHREADS), LDS_BYTES, stream, a); }
#else
    a.ph_lo = 0; a.ph_hi = N_PHASES;
    void* kargs[] = {&a};
    hipError_t e = hipLaunchCooperativeKernel((void*)fwd_kernel, dim3(grid), dim3(NTHREADS), kargs, LDS_BYTES, stream);
    if (e != hipSuccess) fprintf(stderr, "cooperative launch failed: %s (grid %d)\n", hipGetErrorString(e), grid);
#endif
}
```

```cpp
#include <hip/hip_runtime.h>
#include <cstdio>
#include <cstdint>
namespace pg8 {
#define PG8_LAS __attribute__((address_space(3)))
typedef unsigned short bf16_t;
typedef short bf16x8 __attribute__((ext_vector_type(8)));
typedef float f32x4 __attribute__((ext_vector_type(4)));
typedef unsigned u32x4 __attribute__((ext_vector_type(4)));
constexpr int BM = 256, BK = 64, HALF = 128, HTB = HALF * BK * 2  , STAGE_BYTES = 8 * HTB, NXCD = 8, WGM = 8;

__host__ __device__ __forceinline__ int lds_byte(int r, int c) { const int st = (r >> 4) * 2 + (c >> 5), rr = r & 15, cc = c & 31, ob = rr * 64 + cc * 2; return st * 1024 + (ob ^ (((ob >> 9) & 1) << 5)); }
__host__ __device__ __forceinline__ void stage_rc(int b, int& R, int& C) { const int st = b / 1024, sb = b % 1024, swz = sb ^ (((sb >> 9) & 1) << 5); R = (st >> 1) * 16 + swz / 64; C = (st & 1) * 32 + (swz % 64) / 2; }
__host__ __device__ __forceinline__ int perm32(int rho) { const int n = rho >> 4, i = rho & 15; return 8 * (i >> 2) + 4 * n + (i & 3); }

struct Unit { int pm, pn, ex, tq; };
struct Gemm { const bf16_t* A; const bf16_t* Bt; int M, N, K; };

struct StaticOrder {
    int nM, nN, nwg, G, c;
    __host__ __device__ void init(int M, int N, int G_, int c_) { nM = M / BM; nN = N / BM; nwg = nM * nN; G = G_; c = c_; }
    __host__ __device__ bool next(int i, Unit& u) const {
        const long L = (long)i * G + c; if (L >= nwg) return false;
        int wgid = (int)L; { const int q = nwg / NXCD, r = nwg % NXCD, xcd = wgid % NXCD, off = wgid / NXCD; wgid = (xcd < r ? xcd * (q + 1) : r * (q + 1) + (xcd - r) * q) + off; }
        const int nig = WGM * nN, gid = wgid / nig, fm = gid * WGM, gsz = (nM - fm) < WGM ? (nM - fm) : WGM;
        u.pm = fm + ((wgid % nig) % gsz); u.pn = (wgid % nig) / gsz; return true;
    }
    __device__ __forceinline__ void a_ready(const Unit&) const {}
    __device__ __forceinline__ void done(const Unit&) const {}
};

__device__ __forceinline__ unsigned cvt_pk_bf16(float lo, float hi) { unsigned r; asm volatile("v_cvt_pk_bf16_f32 %0, %1, %2" : "=v"(r) : "v"(lo), "v"(hi)); return r; }
typedef float f32x2 __attribute__((ext_vector_type(2)));
template <class Epi, class Sched, bool ALIGN_EPI = false, bool SP2 = false>
__device__ __forceinline__ void gemm_phase(PG8_LAS unsigned char* lds, const Gemm g, const Sched& S, const Epi& E) {
    const int tid = threadIdx.x, wid = __builtin_amdgcn_readfirstlane(tid >> 6), lane = tid & 63, wr = wid >> 2, wc = wid & 3, fr = lane & 15, fq = lane >> 4;
    const int K = g.K, nt = K / BK;
    unsigned voffA[2], voffB[2];
#pragma unroll
    for (int i = 0; i < 2; ++i) { int R, C; stage_rc(tid * 16 + i * 8192, R, C); const int Rb = Epi::PERM ? ((R & ~31) + perm32(R & 31)) : R;
        voffA[i] = (unsigned)(R * K + C) * 2u; voffB[i] = (unsigned)(Rb * K + C) * 2u; }
    const size_t kstep = (size_t)(BK * 2);
    const size_t hstep = (size_t)HALF * K * 2;
    const size_t tstep = 2 * hstep;
    const unsigned ldsw = (unsigned)wid * 1024u;
    const int aoff = lds_byte(wr * 64 + fr, fq * 8), boff = lds_byte(wc * 32 + fr, fq * 8);
#define PG8_SA(b, h) (((b) * 2 + (h)) * HTB)
#define PG8_SB(b, h) ((4 + (b) * 2 + (h)) * HTB)
#define PG8_STAGE(bufoff, gbase, voff) do { _Pragma("unroll") for (int _i = 0; _i < 2; ++_i) \
        __builtin_amdgcn_global_load_lds((const unsigned*)((const char*)(gbase) + (voff)[_i]), (PG8_LAS unsigned*)(lds + (bufoff) + ldsw + _i * 8192), 16, 0, 0); } while (0)
#define PG8_LDA(dst, b, h) do { _Pragma("unroll") for (int m = 0; m < 4; ++m) _Pragma("unroll") for (int k = 0; k < 2; ++k) dst[m][k] = *(const PG8_LAS bf16x8*)(lds + PG8_SA(b, h) + aoff + m * 2048 + k * 1024); } while (0)
#define PG8_LDB(dst, b, h) do { _Pragma("unroll") for (int n = 0; n < 2; ++n) _Pragma("unroll") for (int k = 0; k < 2; ++k) dst[n][k] = *(const PG8_LAS bf16x8*)(lds + PG8_SB(b, h) + boff + n * 2048 + k * 1024); } while (0)
#define PG8_MMA(ai, bj, At, Bt) do { __builtin_amdgcn_s_setprio(1); _Pragma("unroll") for (int m = 0; m < 4; ++m) _Pragma("unroll") for (int n = 0; n < 2; ++n) _Pragma("unroll") for (int k = 0; k < 2; ++k) \
        acc[ai][bj][m][n] = __builtin_amdgcn_mfma_f32_16x16x32_bf16(Bt[n][k], At[m][k], acc[ai][bj][m][n], 0, 0, 0); __builtin_amdgcn_s_setprio(0); } while (0)
#define PG8_WAIT_V(n) asm volatile("s_waitcnt vmcnt(" #n ")" ::: "memory")
#define PG8_WAIT_L(n) asm volatile("s_waitcnt lgkmcnt(" #n ")" ::: "memory")
#define PG8_BAR __builtin_amdgcn_s_barrier()
#define PG8_SCHED __builtin_amdgcn_sched_barrier(0)
    Unit cur, nxt; int ui = 0;
    if (!S.next(0, cur)) return;
    f32x4 acc[2][2][4][2];
#pragma unroll
    for (int a = 0; a < 2; ++a)
#pragma unroll
        for (int b = 0; b < 2; ++b)
#pragma unroll
            for (int m = 0; m < 4; ++m)
#pragma unroll
                for (int n = 0; n < 2; ++n) acc[a][b][m][n] = (f32x4){0.f, 0.f, 0.f, 0.f};
    bf16x8 At[4][2], B0[2][2], B1[2][2];
    const char* cA = (const char*)g.A + (size_t)cur.pm * tstep; const char* cB = (const char*)g.Bt + (size_t)cur.pn * tstep;
    S.a_ready(cur);
    if constexpr (SP2) {
        PG8_STAGE(PG8_SB(0, 0), cB, voffB); PG8_STAGE(PG8_SB(0, 1), cB + hstep, voffB); PG8_STAGE(PG8_SA(0, 0), cA, voffA); PG8_STAGE(PG8_SA(0, 1), cA + hstep, voffA);
        if (wr == 1) PG8_BAR;
        PG8_WAIT_V(2); PG8_BAR;
        PG8_STAGE(PG8_SB(1, 0), cB + kstep, voffB); PG8_STAGE(PG8_SA(1, 0), cA + kstep, voffA); PG8_STAGE(PG8_SB(1, 1), cB + hstep + kstep, voffB);
        PG8_WAIT_V(6); PG8_BAR;
    } else {
        PG8_STAGE(PG8_SB(0, 0), cB, voffB); PG8_STAGE(PG8_SA(0, 0), cA, voffA); PG8_STAGE(PG8_SB(0, 1), cB + hstep, voffB); PG8_STAGE(PG8_SA(0, 1), cA + hstep, voffA);
        if (wr == 1) PG8_BAR;
        PG8_WAIT_V(4); PG8_BAR;
        PG8_STAGE(PG8_SB(1, 0), cB + kstep, voffB); PG8_STAGE(PG8_SA(1, 0), cA + kstep, voffA); PG8_STAGE(PG8_SB(1, 1), cB + hstep + kstep, voffB);
        PG8_WAIT_V(6); PG8_BAR;
    }
    for (;;) {
        const bool has_next = S.next(ui + 1, nxt);
        const char* nA = has_next ? (const char*)g.A + (size_t)nxt.pm * tstep : cA; const char* nB = has_next ? (const char*)g.Bt + (size_t)nxt.pn * tstep : cB;
        for (int t = 0; t < nt; t += 2) {
            const bool last = (t == nt - 2);
            const char* a1 = cA + (size_t)(t + 1) * kstep;
            const char* a2 = last ? nA : cA + (size_t)(t + 2) * kstep; const char* b2 = last ? nB : cB + (size_t)(t + 2) * kstep;
            const char* a3 = a2 + kstep; const char* b3 = b2 + kstep;
            if (last && has_next) S.a_ready(nxt);
            if constexpr (SP2) {
            PG8_LDB(B0, 0, 0); PG8_LDB(B1, 0, 1); PG8_SCHED; PG8_LDA(At, 0, 0); PG8_STAGE(PG8_SA(1, 1), a1 + hstep, voffA);
            PG8_WAIT_V(8); PG8_WAIT_L(0); PG8_BAR; PG8_MMA(0, 0, At, B0); PG8_MMA(0, 1, At, B1); PG8_BAR; PG8_SCHED;
            PG8_LDA(At, 0, 1); PG8_STAGE(PG8_SB(0, 0), b2, voffB); PG8_STAGE(PG8_SB(0, 1), b2 + hstep, voffB); PG8_STAGE(PG8_SA(0, 0), a2, voffA);
            PG8_WAIT_V(8); PG8_WAIT_L(0); PG8_BAR; PG8_MMA(1, 0, At, B0); PG8_MMA(1, 1, At, B1); PG8_BAR; PG8_SCHED;
            PG8_LDB(B0, 1, 0); PG8_LDB(B1, 1, 1); PG8_SCHED; PG8_LDA(At, 1, 0); PG8_STAGE(PG8_SA(0, 1), a2 + hstep, voffA);
            PG8_WAIT_V(8); PG8_WAIT_L(0); PG8_BAR; PG8_MMA(0, 0, At, B0); PG8_MMA(0, 1, At, B1); PG8_BAR; PG8_SCHED;
            PG8_LDA(At, 1, 1); PG8_STAGE(PG8_SB(1, 0), b3, voffB); PG8_STAGE(PG8_SB(1, 1), b3 + hstep, voffB); PG8_STAGE(PG8_SA(1, 0), a3, voffA);
            PG8_WAIT_V(8); PG8_WAIT_L(0); PG8_BAR; PG8_MMA(1, 0, At, B0); PG8_MMA(1, 1, At, B1); PG8_BAR; PG8_SCHED;
            } else {
            PG8_LDB(B0, 0, 0); PG8_SCHED; PG8_LDA(At, 0, 0); PG8_STAGE(PG8_SA(1, 1), a1 + hstep, voffA);
            PG8_WAIT_L(8); PG8_BAR; PG8_WAIT_L(0); PG8_MMA(0, 0, At, B0); PG8_BAR; PG8_SCHED;
            PG8_LDB(B1, 0, 1); PG8_STAGE(PG8_SB(0, 0), b2, voffB);
            PG8_BAR; PG8_WAIT_L(0); PG8_MMA(0, 1, At, B1); PG8_BAR;
            PG8_LDA(At, 0, 1); PG8_STAGE(PG8_SA(0, 0), a2, voffA);
            PG8_BAR; PG8_WAIT_L(0); PG8_MMA(1, 0, At, B0); PG8_BAR; PG8_SCHED;
            PG8_STAGE(PG8_SB(0, 1), b2 + hstep, voffB);
            PG8_WAIT_V(6); PG8_BAR; PG8_MMA(1, 1, At, B1); PG8_BAR;
            PG8_LDB(B0, 1, 0); PG8_SCHED; PG8_LDA(At, 1, 0); PG8_STAGE(PG8_SA(0, 1), a2 + hstep, voffA);
            PG8_WAIT_L(8); PG8_BAR; PG8_WAIT_L(0); PG8_MMA(0, 0, At, B0); PG8_BAR; PG8_SCHED;
            PG8_LDB(B1, 1, 1); PG8_STAGE(PG8_SB(1, 0), b3, voffB);
            PG8_BAR; PG8_WAIT_L(0); PG8_MMA(0, 1, At, B1); PG8_BAR;
            PG8_LDA(At, 1, 1); PG8_STAGE(PG8_SA(1, 0), a3, voffA);
            PG8_BAR; PG8_WAIT_L(0); PG8_MMA(1, 0, At, B0); PG8_BAR; PG8_SCHED;
            PG8_STAGE(PG8_SB(1, 1), b3 + hstep, voffB);
            PG8_WAIT_V(6); PG8_BAR; PG8_MMA(1, 1, At, B1); PG8_BAR;
            }
        }
        if constexpr (ALIGN_EPI) { if (wr == 0) PG8_BAR; }
        if constexpr (!Epi::AFTER_DRAIN) { E(acc, cur, wr, wc, fr, fq); S.done(cur); }
        if (!has_next) break;
#pragma unroll
        for (int a = 0; a < 2; ++a)
#pragma unroll
            for (int b = 0; b < 2; ++b)
#pragma unroll
                for (int m = 0; m < 4; ++m)
#pragma unroll
                    for (int n = 0; n < 2; ++n) acc[a][b][m][n] = (f32x4){0.f, 0.f, 0.f, 0.f};
        cur = nxt; cA = nA; cB = nB; ++ui;
        if constexpr (ALIGN_EPI) { if (wr == 1) PG8_BAR; }
    }
    PG8_WAIT_V(0);
    if constexpr (!ALIGN_EPI) { if (wr == 0) PG8_BAR; }
    PG8_BAR;
    if constexpr (Epi::AFTER_DRAIN) { E.fused(acc, cur, wr, wc, fr, fq, lds, wid, lane); S.done(cur); }
#undef PG8_SA
#undef PG8_SB
#undef PG8_STAGE
#undef PG8_LDA
#undef PG8_LDB
#undef PG8_MMA
#undef PG8_WAIT_V
#undef PG8_WAIT_L
#undef PG8_BAR
#undef PG8_SCHED
}
typedef int i32x4 __attribute__((ext_vector_type(4)));
template <bool I8> struct AccSel { typedef f32x4 type; };
template <> struct AccSel<true> { typedef i32x4 type; };
template <bool I8> __device__ __forceinline__ void mma_step(typename AccSel<I8>::type& c, const bf16x8& b, const bf16x8& a) {
    if constexpr (I8) c = __builtin_amdgcn_mfma_i32_16x16x64_i8(__builtin_bit_cast(i32x4, b), __builtin_bit_cast(i32x4, a), c, 0, 0, 0);
    else c = __builtin_amdgcn_mfma_f32_16x16x32_bf16(b, a, c, 0, 0, 0);
}
template <class Epi, class Sched, class AMap, bool ALIGN_EPI = false, bool I8 = false>
__device__ __forceinline__ void gemm_phase_gather(PG8_LAS unsigned char* lds, const Gemm g, const Sched& S, const Epi& E, const AMap& AM) {
    constexpr bool SP2 = true;
    const int tid = threadIdx.x, wid = __builtin_amdgcn_readfirstlane(tid >> 6), lane = tid & 63, wr = wid >> 2, wc = wid & 3, fr = lane & 15, fq = lane >> 4;
    const int K = g.K, nt = K / BK;
    unsigned voffA[2], voffB[2]; int rowA[2];
#pragma unroll
    for (int i = 0; i < 2; ++i) { int R, C; stage_rc(tid * 16 + i * 8192, R, C); const int Rb = Epi::PERM ? ((R & ~31) + perm32(R & 31)) : R;
        voffA[i] = (unsigned)C * 2u; voffB[i] = (unsigned)(Rb * K + C) * 2u; rowA[i] = R; }
    const size_t kstep = (size_t)(BK * 2);
    const size_t hstep = (size_t)HALF * K * 2;
    const size_t tstep = 2 * hstep;
    const unsigned ldsw = (unsigned)wid * 1024u;
    const int aoff = lds_byte(wr * 64 + fr, fq * 8), boff = lds_byte(wc * 32 + fr, fq * 8);
#define PG8_SA(b, h) (((b) * 2 + (h)) * HTB)
#define PG8_SB(b, h) ((4 + (b) * 2 + (h)) * HTB)
#define PG8_STAGE(bufoff, gbase, voff) do { _Pragma("unroll") for (int _i = 0; _i < 2; ++_i) \
        __builtin_amdgcn_global_load_lds((const unsigned*)((const char*)(gbase) + (voff)[_i]), (PG8_LAS unsigned*)(lds + (bufoff) + ldsw + _i * 8192), 16, 0, 0); } while (0)
#define PG8_LDA(dst, b, h) do { _Pragma("unroll") for (int m = 0; m < 4; ++m) _Pragma("unroll") for (int k = 0; k < 2; ++k) dst[m][k] = *(const PG8_LAS bf16x8*)(lds + PG8_SA(b, h) + aoff + m * 2048 + k * 1024); } while (0)
#define PG8_LDB(dst, b, h) do { _Pragma("unroll") for (int n = 0; n < 2; ++n) _Pragma("unroll") for (int k = 0; k < 2; ++k) dst[n][k] = *(const PG8_LAS bf16x8*)(lds + PG8_SB(b, h) + boff + n * 2048 + k * 1024); } while (0)
#define PG8_MMA(ai, bj, At, Bt) do { __builtin_amdgcn_s_setprio(1); _Pragma("unroll") for (int m = 0; m < 4; ++m) _Pragma("unroll") for (int n = 0; n < 2; ++n) _Pragma("unroll") for (int k = 0; k < 2; ++k) \
        mma_step<I8>(acc[ai][bj][m][n], Bt[n][k], At[m][k]); __builtin_amdgcn_s_setprio(0); } while (0)
#define PG8_WAIT_V(n) asm volatile("s_waitcnt vmcnt(" #n ")" ::: "memory")
#define PG8_WAIT_L(n) asm volatile("s_waitcnt lgkmcnt(" #n ")" ::: "memory")
#define PG8_BAR __builtin_amdgcn_s_barrier()
#define PG8_SCHED __builtin_amdgcn_sched_barrier(0)
    Unit cur, nxt; int ui = 0;
    if (!S.next(0, cur)) return;
    typedef typename AccSel<I8>::type acc_t;
    acc_t acc[2][2][4][2];
#pragma unroll
    for (int a = 0; a < 2; ++a)
#pragma unroll
        for (int b = 0; b < 2; ++b)
#pragma unroll
            for (int m = 0; m < 4; ++m)
#pragma unroll
                for (int n = 0; n < 2; ++n) acc[a][b][m][n] = (acc_t){0, 0, 0, 0};
    bf16x8 At[4][2], B0[2][2], B1[2][2];
    const char* cA = (const char*)g.A; const char* cB = (const char*)g.Bt + (size_t)cur.pn * tstep;
    unsigned vA0[2], vA1[2], nA0[2], nA1[2];
#pragma unroll
    for (int i = 0; i < 2; ++i) { vA0[i] = (unsigned)AM.row(cur, rowA[i]) * (unsigned)(K * 2) + voffA[i]; vA1[i] = (unsigned)AM.row(cur, HALF + rowA[i]) * (unsigned)(K * 2) + voffA[i]; }
    S.a_ready(cur);
    if constexpr (SP2) {
        PG8_STAGE(PG8_SB(0, 0), cB, voffB); PG8_STAGE(PG8_SB(0, 1), cB + hstep, voffB); PG8_STAGE(PG8_SA(0, 0), cA, vA0); PG8_STAGE(PG8_SA(0, 1), cA, vA1);
        if (wr == 1) PG8_BAR;
        PG8_WAIT_V(2); PG8_BAR;
        PG8_STAGE(PG8_SB(1, 0), cB + kstep, voffB); PG8_STAGE(PG8_SA(1, 0), cA + kstep, vA0); PG8_STAGE(PG8_SB(1, 1), cB + hstep + kstep, voffB);
        PG8_WAIT_V(6); PG8_BAR;
    } else {
        PG8_STAGE(PG8_SB(0, 0), cB, voffB); PG8_STAGE(PG8_SA(0, 0), cA, voffA); PG8_STAGE(PG8_SB(0, 1), cB + hstep, voffB); PG8_STAGE(PG8_SA(0, 1), cA + hstep, voffA);
        if (wr == 1) PG8_BAR;
        PG8_WAIT_V(4); PG8_BAR;
        PG8_STAGE(PG8_SB(1, 0), cB + kstep, voffB); PG8_STAGE(PG8_SA(1, 0), cA + kstep, voffA); PG8_STAGE(PG8_SB(1, 1), cB + hstep + kstep, voffB);
        PG8_WAIT_V(6); PG8_BAR;
    }
    for (;;) {
        const bool has_next = S.next(ui + 1, nxt);
        const char* nA = cA; const char* nB = has_next ? (const char*)g.Bt + (size_t)nxt.pn * tstep : cB;
#pragma unroll
        for (int i = 0; i < 2; ++i) { nA0[i] = has_next ? (unsigned)AM.row(nxt, rowA[i]) * (unsigned)(K * 2) + voffA[i] : vA0[i]; nA1[i] = has_next ? (unsigned)AM.row(nxt, HALF + rowA[i]) * (unsigned)(K * 2) + voffA[i] : vA1[i]; }
        for (int t = 0; t < nt; t += 2) {
            const bool last = (t == nt - 2);
            const char* a1 = cA + (size_t)(t + 1) * kstep;
            const char* a2 = last ? nA : cA + (size_t)(t + 2) * kstep; const char* b2 = last ? nB : cB + (size_t)(t + 2) * kstep;
            const char* a3 = a2 + kstep; const char* b3 = b2 + kstep;
            unsigned s0[2], s1[2];
#pragma unroll
            for (int i = 0; i < 2; ++i) { s0[i] = vA0[i]; s1[i] = vA1[i]; }
            if (last) {
#pragma unroll
                for (int i = 0; i < 2; ++i) { unsigned t0_ = nA0[i], t1_ = nA1[i]; asm volatile("" : "+v"(t0_), "+v"(t1_)); s0[i] = t0_; s1[i] = t1_; } }
            if (last && has_next) S.a_ready(nxt);
            if constexpr (SP2) {
            PG8_LDB(B0, 0, 0); PG8_LDB(B1, 0, 1); PG8_SCHED; PG8_LDA(At, 0, 0); PG8_STAGE(PG8_SA(1, 1), a1, vA1);
            PG8_WAIT_V(8); PG8_WAIT_L(0); PG8_BAR; PG8_MMA(0, 0, At, B0); PG8_MMA(0, 1, At, B1); PG8_BAR; PG8_SCHED;
            PG8_LDA(At, 0, 1); PG8_STAGE(PG8_SB(0, 0), b2, voffB); PG8_STAGE(PG8_SB(0, 1), b2 + hstep, voffB); PG8_STAGE(PG8_SA(0, 0), a2, s0);
            PG8_WAIT_V(8); PG8_WAIT_L(0); PG8_BAR; PG8_MMA(1, 0, At, B0); PG8_MMA(1, 1, At, B1); PG8_BAR; PG8_SCHED;
            PG8_LDB(B0, 1, 0); PG8_LDB(B1, 1, 1); PG8_SCHED; PG8_LDA(At, 1, 0); PG8_STAGE(PG8_SA(0, 1), a2, s1);
            PG8_WAIT_V(8); PG8_WAIT_L(0); PG8_BAR; PG8_MMA(0, 0, At, B0); PG8_MMA(0, 1, At, B1); PG8_BAR; PG8_SCHED;
            PG8_LDA(At, 1, 1); PG8_STAGE(PG8_SB(1, 0), b3, voffB); PG8_STAGE(PG8_SB(1, 1), b3 + hstep, voffB); PG8_STAGE(PG8_SA(1, 0), a3, s0);
            PG8_WAIT_V(8); PG8_WAIT_L(0); PG8_BAR; PG8_MMA(1, 0, At, B0); PG8_MMA(1, 1, At, B1); PG8_BAR; PG8_SCHED;
            } else {
            PG8_LDB(B0, 0, 0); PG8_SCHED; PG8_LDA(At, 0, 0); PG8_STAGE(PG8_SA(1, 1), a1 + hstep, voffA);
            PG8_WAIT_L(8); PG8_BAR; PG8_WAIT_L(0); PG8_MMA(0, 0, At, B0); PG8_BAR; PG8_SCHED;
            PG8_LDB(B1, 0, 1); PG8_STAGE(PG8_SB(0, 0), b2, voffB);
            PG8_BAR; PG8_WAIT_L(0); PG8_MMA(0, 1, At, B1); PG8_BAR;
            PG8_LDA(At, 0, 1); PG8_STAGE(PG8_SA(0, 0), a2, voffA);
            PG8_BAR; PG8_WAIT_L(0); PG8_MMA(1, 0, At, B0); PG8_BAR; PG8_SCHED;
            PG8_STAGE(PG8_SB(0, 1), b2 + hstep, voffB);
            PG8_WAIT_V(6); PG8_BAR; PG8_MMA(1, 1, At, B1); PG8_BAR;
            PG8_LDB(B0, 1, 0); PG8_SCHED; PG8_LDA(At, 1, 0); PG8_STAGE(PG8_SA(0, 1), a2 + hstep, voffA);
            PG8_WAIT_L(8); PG8_BAR; PG8_WAIT_L(0); PG8_MMA(0, 0, At, B0); PG8_BAR; PG8_SCHED;
            PG8_LDB(B1, 1, 1); PG8_STAGE(PG8_SB(1, 0), b3, voffB);
            PG8_BAR; PG8_WAIT_L(0); PG8_MMA(0, 1, At, B1); PG8_BAR;
            PG8_LDA(At, 1, 1); PG8_STAGE(PG8_SA(1, 0), a3, voffA);
            PG8_BAR; PG8_WAIT_L(0); PG8_MMA(1, 0, At, B0); PG8_BAR; PG8_SCHED;
            PG8_STAGE(PG8_SB(1, 1), b3 + hstep, voffB);
            PG8_WAIT_V(6); PG8_BAR; PG8_MMA(1, 1, At, B1); PG8_BAR;
            }
        }
        if constexpr (ALIGN_EPI) { if (wr == 0) PG8_BAR; }
        if constexpr (!Epi::AFTER_DRAIN) { E(acc, cur, wr, wc, fr, fq); S.done(cur); }
        if (!has_next) break;
#pragma unroll
        for (int a = 0; a < 2; ++a)
#pragma unroll
            for (int b = 0; b < 2; ++b)
#pragma unroll
                for (int m = 0; m < 4; ++m)
#pragma unroll
                    for (int n = 0; n < 2; ++n) acc[a][b][m][n] = (acc_t){0, 0, 0, 0};
        cur = nxt; cA = nA; cB = nB; ++ui;
#pragma unroll
        for (int i = 0; i < 2; ++i) { vA0[i] = nA0[i]; vA1[i] = nA1[i]; }
        if constexpr (ALIGN_EPI) { if (wr == 1) PG8_BAR; }
    }
    PG8_WAIT_V(0);
    if constexpr (!ALIGN_EPI) { if (wr == 0) PG8_BAR; }
    PG8_BAR;
    if constexpr (Epi::AFTER_DRAIN) { E.fused(acc, cur, wr, wc, fr, fq, lds, wid, lane); S.done(cur); }
#undef PG8_SA
#undef PG8_SB
#undef PG8_STAGE
#undef PG8_LDA
#undef PG8_LDB
#undef PG8_MMA
#undef PG8_WAIT_V
#undef PG8_WAIT_L
#undef PG8_BAR
#undef PG8_SCHED
}
}
#include <hip/hip_bf16.h>
#include <cmath>
namespace attn_body {
using bf16=__hip_bfloat16;
using bf16x8=__attribute__((ext_vector_type(8)))short;
using s16x4=__attribute__((ext_vector_type(4)))short;
using f32x16=__attribute__((ext_vector_type(16)))float;
using u32x4=__attribute__((ext_vector_type(4)))unsigned;
constexpr int BATCH=2,NHEAD=8,NKVH=2,SEQ=8192,D=64,QP=512,KP=128,OP=1024;
constexpr int NW=8,QBLK=32,QB=QBLK*NW,KVBLK=64,NQB=SEQ/QB;
constexpr int ATTN_UNIT_ROWS=QB;
__device__ __forceinline__ int crow(int r,int hi){return (r&3)+8*(r>>2)+4*hi;}
#define SBAR() __builtin_amdgcn_sched_barrier(0)
__device__ __forceinline__ void cmask(f32x16&p0,f32x16&p1,int jb,int qrel,int hi){
  const float NEG=-INFINITY; int kb=64*jb+4*hi;
  #pragma unroll
  for(int r=0;r<16;++r){int kv=kb+(r&3)+8*(r>>2); if(kv>qrel)p0[r]=NEG; if(kv+32>qrel)p1[r]=NEG;}
}

constexpr int NSLOT=3, SLOTB=8192;
constexpr int LDS_K=0, LDS_V=NSLOT*SLOTB, LDS_WS=2*NSLOT*SLOTB, LDS_OST=LDS_WS+NW*64*4, LDS_BYTES=LDS_OST+NW*4096;
constexpr float C2=0.125f*1.4426950408889634f;
__device__ __forceinline__ void glds16(const void*gsrc,unsigned lds_dst){unsigned keep;
  asm volatile("s_mov_b32 %0, m0\n\ts_mov_b32 m0, %2\n\ts_nop 0\n\tglobal_load_lds_dwordx4 %1, off\n\ts_mov_b32 m0, %0":"=&s"(keep):"v"(gsrc),"s"(lds_dst):"memory");}
__device__ __forceinline__ float max3f(float a,float b,float c){float r;asm("v_max3_f32 %0, %1, %2, %3":"=v"(r):"v"(a),"v"(b),"v"(c));return r;}
__device__ __forceinline__ float max2f(float a,float b){float r;asm("v_max_f32_e32 %0, %1, %2":"=v"(r):"v"(a),"v"(b));return r;}
__device__ __forceinline__ float fadd_s(float a,float b){float r;asm("v_add_f32_e32 %0, %1, %2":"=v"(r):"v"(a),"v"(b));return r;}
__device__ __forceinline__ float fsub_s(float a,float b){float r;asm("v_sub_f32_e32 %0, %1, %2":"=v"(r):"v"(a),"v"(b));return r;}
typedef float f32x2_t __attribute__((ext_vector_type(2))); typedef __bf16 bf16x2_t __attribute__((ext_vector_type(2)));
__device__ __forceinline__ unsigned cvtpk_s(float lo,float hi){f32x2_t v={lo,hi};bf16x2_t b=__builtin_convertvector(v,bf16x2_t);return __builtin_bit_cast(unsigned,b);}
#define WAIT_BAR(N) asm volatile("s_waitcnt vmcnt(" #N ") lgkmcnt(0)\n\ts_barrier":::"memory")

__device__ __forceinline__ void qkt(f32x16&p0,f32x16&p1,const char*Kslot,const bf16x8*qr,const f32x16&negm,int r32,int hi){
  const char*kb=Kslot+hi*1024+r32*16;
  #pragma unroll
  for(int d0=0;d0<4;++d0){
    const bf16x8 b0=*reinterpret_cast<const bf16x8*>(kb+d0*2048);
    const bf16x8 b1=*reinterpret_cast<const bf16x8*>(kb+d0*2048+512);
    if(d0==0){p0=__builtin_amdgcn_mfma_f32_32x32x16_bf16(b0,qr[0],negm,0,0,0);p1=__builtin_amdgcn_mfma_f32_32x32x16_bf16(b1,qr[0],negm,0,0,0);}
    else{p0=__builtin_amdgcn_mfma_f32_32x32x16_bf16(b0,qr[d0],p0,0,0,0);p1=__builtin_amdgcn_mfma_f32_32x32x16_bf16(b1,qr[d0],p1,0,0,0);}}
}
typedef __attribute__((address_space(3))) const char* lds_cptr;
typedef short v4i16_t __attribute__((ext_vector_type(4)));
__device__ __forceinline__ void kload8(bf16x8*kf,lds_cptr kp){
  kf[0]=*(const __attribute__((address_space(3))) bf16x8*)(kp);      kf[1]=*(const __attribute__((address_space(3))) bf16x8*)(kp+512);
  kf[2]=*(const __attribute__((address_space(3))) bf16x8*)(kp+2048); kf[3]=*(const __attribute__((address_space(3))) bf16x8*)(kp+2560);
  kf[4]=*(const __attribute__((address_space(3))) bf16x8*)(kp+4096); kf[5]=*(const __attribute__((address_space(3))) bf16x8*)(kp+4608);
  kf[6]=*(const __attribute__((address_space(3))) bf16x8*)(kp+6144); kf[7]=*(const __attribute__((address_space(3))) bf16x8*)(kp+6656);
}
__device__ __forceinline__ void kload2(bf16x8*kf,lds_cptr kp,int j){ kf[2*j]=*(const __attribute__((address_space(3))) bf16x8*)(kp+j*2048); kf[2*j+1]=*(const __attribute__((address_space(3))) bf16x8*)(kp+j*2048+512); }
__device__ __forceinline__ s16x4 vtr(lds_cptr p){ return __builtin_bit_cast(s16x4,__builtin_amdgcn_ds_read_tr16_b64_v4i16((__attribute__((address_space(3))) v4i16_t*)p)); }
__device__ __forceinline__ float rowmax(const f32x16&p0,const f32x16&p1){
  float a=max3f(p0[0],p0[1],p1[0]),b=max3f(p0[2],p0[3],p1[1]);a=max3f(a,p1[2],p1[3]);
  #pragma unroll
  for(int r=4;r<16;r+=4){a=max3f(a,p0[r],p0[r+1]);b=max3f(b,p0[r+2],p0[r+3]);a=max3f(a,p1[r],p1[r+1]);b=max3f(b,p1[r+2],p1[r+3]);}
  const float m=max2f(a,b);
  auto rr=__builtin_amdgcn_permlane32_swap(__float_as_uint(m),__float_as_uint(m),false,false);
  return max2f(__uint_as_float(rr[0]),__uint_as_float(rr[1]));
}
__device__ __forceinline__ void pv(f32x16*o,int vb,bf16x8 pa0,bf16x8 pa1,bf16x8 pa2,bf16x8 pa3){
  #pragma unroll
  for(int d0=0;d0<2;++d0){s16x4 lo[4],hi[4];
    #pragma unroll
    for(int ks=0;ks<4;++ks){
      asm volatile("ds_read_b64_tr_b16 %0,%1 offset:%c2":"=&v"(lo[ks]):"v"(vb),"i"(d0*4096+ks*1024):"memory");
      asm volatile("ds_read_b64_tr_b16 %0,%1 offset:%c2":"=&v"(hi[ks]):"v"(vb),"i"(d0*4096+ks*1024+512):"memory");}
    asm volatile("s_waitcnt lgkmcnt(0)":::"memory");SBAR();
    #define PK(k) (bf16x8){lo[k][0],lo[k][1],lo[k][2],lo[k][3],hi[k][0],hi[k][1],hi[k][2],hi[k][3]}
    o[d0]=__builtin_amdgcn_mfma_f32_32x32x16_bf16(pa0,PK(0),o[d0],0,0,0);
    o[d0]=__builtin_amdgcn_mfma_f32_32x32x16_bf16(pa1,PK(1),o[d0],0,0,0);
    o[d0]=__builtin_amdgcn_mfma_f32_32x32x16_bf16(pa2,PK(2),o[d0],0,0,0);
    o[d0]=__builtin_amdgcn_mfma_f32_32x32x16_bf16(pa3,PK(3),o[d0],0,0,0);
    #undef PK
  }
}

#ifndef ATTN_STORE16
#define ATTN_STORE16(p,v) (*(u32x4*)(p)=(v))
#endif
template<int THRL> __device__ __forceinline__ void attn_unit(int b,int h,int qb,const bf16*Q,const bf16*__restrict__ K,const bf16*__restrict__ V,bf16*O,char*shm,const float nshift){
  const int tid=threadIdx.x,lane=tid&63,r32=lane&31,hi=lane>>5; const int wid=__builtin_amdgcn_readfirstlane(tid>>6);
  const long rowbase=(long)b*SEQ; const int q0=qb*QB;
  const bf16*Qw=Q+(rowbase+q0+wid*QBLK)*QP+h*D;
  const int hk=h/(NHEAD/NKVH); const bf16*Kh=K+(long)(b*NKVH+hk)*SEQ*D,*Vh=V+(long)(b*NKVH+hk)*SEQ*D;
  const unsigned lds0=(unsigned)(uintptr_t)shm;
  float*wsf=(float*)(shm+LDS_WS)+wid*64;
  const bf16*ksrc=Kh+(wid*64+lane)*8;
  const bf16*vsrc=Vh+(wid*64+lane)*8;
  const unsigned kdst=lds0+LDS_K+wid*1024, vdst=lds0+LDS_V+wid*1024;
  #define DMA_K(t,slot) glds16(ksrc+(long)(t)*KVBLK*D,(unsigned)__builtin_amdgcn_readfirstlane(kdst+(slot)))
  #define DMA_V(t,slot) glds16(vsrc+(long)(t)*KVBLK*D,(unsigned)__builtin_amdgcn_readfirstlane(vdst+(slot)))
  const int vb0=(int)(lds0+LDS_V)+((lane>>4)&1)*32+(lane&3)*8+(4*hi+((lane&15)>>2))*64;
  const char*Kbase=shm+LDS_K; bf16x8 kf[8];
  const lds_cptr shm3=(lds_cptr)shm; const lds_cptr kp0=shm3+LDS_K+hi*1024+r32*16; const lds_cptr vp0=shm3+LDS_V+((lane>>4)&1)*32+(lane&3)*8+(4*hi+((lane&15)>>2))*64;
  constexpr int NT=SEQ/KVBLK;
  DMA_K(0,0);DMA_V(0,0);DMA_K(1,SLOTB);
  bf16x8 qr[4];
  #pragma unroll
  for(int d0=0;d0<4;++d0)qr[d0]=*reinterpret_cast<const bf16x8*>(&Qw[(long)r32*QP+d0*16+hi*8]);
  float l_reg=0.f;f32x16 o[2];o[0]=f32x16{};o[1]=f32x16{};f32x16 negm;
  _Pragma("unroll") for(int r=0;r<16;++r)negm[r]=nshift; asm volatile("":"+v"(negm));
  const int qrel=wid*QBLK+r32;
  #define CMASK(P0,P1,t) do{}while(0)
  #define START(P0,P1) do{ _Pragma("unroll") for(int r=0;r<16;++r)P0[r]=__builtin_amdgcn_exp2f(P0[r]); }while(0)
  f32x16 pA0,pA1,pB0,pB1;
  int sl_prev=0,sl_cur=0,sl_next=SLOTB;
  #define ROT() do{sl_prev=sl_cur;sl_cur=sl_next;sl_next=(sl_next==(NSLOT-1)*SLOTB)?0:sl_next+SLOTB;}while(0)
  DMA_K(2,2*SLOTB);
  WAIT_BAR(3);
  qkt(pA0,pA1,Kbase,qr,negm,r32,hi);asm volatile("s_nop 15\n\ts_nop 7":"+v"(pA0),"+v"(pA1));CMASK(pA0,pA1,0);
  START(pA0,pA1);
  _Pragma("unroll") for(int r=0;r<16;++r)pA1[r]=__builtin_amdgcn_exp2f(pA1[r]);
  WAIT_BAR(0);
  DMA_K(3,0);DMA_V(1,SLOTB);
  ROT();
  kload8(kf,kp0+sl_cur);
  WAIT_BAR(2);
  s16x4 vlo[8],vhi[8]; u32x4 pw0,pw1,pw2,pw3;
  #define PKW(P,B) cvtpk_s(P[B],P[B+1])
  #define PAF(k) __builtin_bit_cast(bf16x8,pw##k)
  #define VFR(i) (bf16x8){vlo[i][0],vlo[i][1],vlo[i][2],vlo[i][3],vhi[i][0],vhi[i][1],vhi[i][2],vhi[i][3]}
  #define PIN(x) asm volatile("":"+v"(x))
  #define GAPA(MF,A0,A1,A2,A3,W0,W1,PW) do{ MF; sacc+=A0; sacc+=A1; sacc+=A2; sacc+=A3; PIN(sacc); W0; W1; PIN(PW); SBAR(); }while(0)
  #define EX(v) __builtin_amdgcn_exp2f(v)
  #define GAPB(MF,X,B) do{ MF; X[B]=EX(X[B]); X[B+1]=EX(X[B+1]); X[B+2]=EX(X[B+2]); X[B+3]=EX(X[B+3]); PIN(X); SBAR(); }while(0)
  #define VRD(i) do{ vlo[i]=vtr(vp_+(((i)>>2)*4096+((i)&3)*1024)); vhi[i]=vtr(vp_+(((i)>>2)*4096+((i)&3)*1024+512)); }while(0)
  #define KRD(G,j) do{ if(G){ kload2(kf,kp0+sl_next,j); SBAR(); } }while(0)
  #define STEP(C0,C1,P0,P1,t,GK,GV,GL) do{ SBAR(); \
    const lds_cptr vp_=vp0+sl_prev; \
    VRD(0); SBAR(); float sacc=(P0[0]+P0[1]); \
    GAPA(C0=__builtin_amdgcn_mfma_f32_32x32x16_bf16(kf[0],qr[0],negm,0,0,0), P0[2],P0[3],P0[4],P0[5],     pw0[0]=PKW(P0,0), pw0[1]=PKW(P0,2), pw0); \
    VRD(4); SBAR(); GAPA(C1=__builtin_amdgcn_mfma_f32_32x32x16_bf16(kf[1],qr[0],negm,0,0,0), P0[6],P0[7],P0[8],P0[9],     pw0[2]=PKW(P0,4), pw0[3]=PKW(P0,6), pw0); \
    VRD(1); SBAR(); GAPA(C0=__builtin_amdgcn_mfma_f32_32x32x16_bf16(kf[2],qr[1],C0,0,0,0),   P0[10],P0[11],P0[12],P0[13], pw1[0]=PKW(P0,8), pw1[1]=PKW(P0,10), pw1); \
    VRD(5); SBAR(); GAPA(C1=__builtin_amdgcn_mfma_f32_32x32x16_bf16(kf[3],qr[1],C1,0,0,0),   P0[14],P0[15],P1[0],P1[1],   pw1[2]=PKW(P0,12),pw1[3]=PKW(P0,14), pw1); \
    VRD(2); SBAR(); GAPA(C0=__builtin_amdgcn_mfma_f32_32x32x16_bf16(kf[4],qr[2],C0,0,0,0),   P1[2],P1[3],P1[4],P1[5],     pw2[0]=PKW(P1,0), pw2[1]=PKW(P1,2), pw2); \
    VRD(6); SBAR(); GAPA(C1=__builtin_amdgcn_mfma_f32_32x32x16_bf16(kf[5],qr[2],C1,0,0,0),   P1[6],P1[7],P1[8],P1[9],     pw2[2]=PKW(P1,4), pw2[3]=PKW(P1,6), pw2); \
    VRD(3); SBAR(); GAPA(C0=__builtin_amdgcn_mfma_f32_32x32x16_bf16(kf[6],qr[3],C0,0,0,0),   P1[10],P1[11],P1[12],P1[13], pw3[0]=PKW(P1,8), pw3[1]=PKW(P1,10), pw3); \
    VRD(7); SBAR(); GAPA(C1=__builtin_amdgcn_mfma_f32_32x32x16_bf16(kf[7],qr[3],C1,0,0,0),   P1[14],P1[15],0.f,0.f,       pw3[2]=PKW(P1,12),pw3[3]=PKW(P1,14), pw3); \
    l_reg+=sacc; \
    if(GK){DMA_K((t)+3,sl_cur);} if(GV){DMA_V((t)+1,sl_next);} \
    CMASK(C0,C1,t); \
    SBAR(); \
    GAPB(o[0]=__builtin_amdgcn_mfma_f32_32x32x16_bf16(PAF(0),VFR(0),o[0],0,0,0), C0,0); \
    GAPB(o[1]=__builtin_amdgcn_mfma_f32_32x32x16_bf16(PAF(0),VFR(4),o[1],0,0,0), C0,4); \
    KRD(GL,0); GAPB(o[0]=__builtin_amdgcn_mfma_f32_32x32x16_bf16(PAF(1),VFR(1),o[0],0,0,0), C0,8); \
    KRD(GL,1); GAPB(o[1]=__builtin_amdgcn_mfma_f32_32x32x16_bf16(PAF(1),VFR(5),o[1],0,0,0), C0,12); \
    KRD(GL,2); GAPB(o[0]=__builtin_amdgcn_mfma_f32_32x32x16_bf16(PAF(2),VFR(2),o[0],0,0,0), C1,0); \
    KRD(GL,3); GAPB(o[1]=__builtin_amdgcn_mfma_f32_32x32x16_bf16(PAF(2),VFR(6),o[1],0,0,0), C1,4); \
    GAPB(o[0]=__builtin_amdgcn_mfma_f32_32x32x16_bf16(PAF(3),VFR(3),o[0],0,0,0), C1,8); \
    GAPB(o[1]=__builtin_amdgcn_mfma_f32_32x32x16_bf16(PAF(3),VFR(7),o[1],0,0,0), C1,12); \
    }while(0)
  int t=1;
  #undef CMASK
  #define CMASK(P0,P1,t) do{}while(0)
  for(;t+5<NT;t+=2){
    STEP(pB0,pB1,pA0,pA1,t,true,true,true);     WAIT_BAR(2); ROT();
    STEP(pA0,pA1,pB0,pB1,t+1,true,true,true);   WAIT_BAR(2); ROT();
  }
  #undef CMASK
  #define CMASK(P0,P1,t) do{}while(0)
  #define ENDW(tt) do{ if((tt)+3<NT){WAIT_BAR(2);} else if((tt)+2<NT){WAIT_BAR(1);} else {WAIT_BAR(0);} }while(0)
  for(;t+1<NT;t+=2){
    STEP(pB0,pB1,pA0,pA1,t,(t+3<NT),(t+1<NT),(t+1<NT));       ENDW(t);   ROT();
    STEP(pA0,pA1,pB0,pB1,t+1,(t+4<NT),(t+2<NT),(t+2<NT));     ENDW(t+1); ROT();
  }
  STEP(pB0,pB1,pA0,pA1,NT-1,false,false,false);
  { float sacc=pB0[0]+pB0[1]; _Pragma("unroll") for(int r=2;r<16;++r)sacc+=pB0[r]; _Pragma("unroll") for(int r=0;r<16;++r)sacc+=pB1[r]; l_reg+=sacc;
    pw0=(u32x4){PKW(pB0,0),PKW(pB0,2),PKW(pB0,4),PKW(pB0,6)};pw1=(u32x4){PKW(pB0,8),PKW(pB0,10),PKW(pB0,12),PKW(pB0,14)};pw2=(u32x4){PKW(pB1,0),PKW(pB1,2),PKW(pB1,4),PKW(pB1,6)};pw3=(u32x4){PKW(pB1,8),PKW(pB1,10),PKW(pB1,12),PKW(pB1,14)};
    SBAR(); pv(o,vb0+sl_cur,PAF(0),PAF(1),PAF(2),PAF(3)); }
  #undef PKW
  #undef PAF
  #undef VFR
  #undef PIN
  #undef GAPA
  #undef GAPB
  #undef EX
  #undef VRD
  #undef KRD
  #undef STEP
  #undef ENDW
  {auto rr=__builtin_amdgcn_permlane32_swap(__float_as_uint(l_reg),__float_as_uint(l_reg),false,false);l_reg=__uint_as_float(rr[0])+__uint_as_float(rr[1]);}
  if(hi==0)wsf[32+r32]=l_reg;asm volatile("s_waitcnt lgkmcnt(0)":::"memory");
  float rli[16];
  #pragma unroll
  for(int r=0;r<16;++r)rli[r]=__builtin_amdgcn_rcpf(wsf[32+crow(r,hi)]);
  bf16*Ow=O+(rowbase+q0+wid*QBLK)*OP+h*D;
  { bf16*stg=(bf16*)(shm+LDS_OST)+wid*2048;
    #pragma unroll
    for(int r=0;r<16;++r){const int orow=crow(r,hi);
      #pragma unroll
      for(int d0=0;d0<2;++d0)stg[orow*64+d0*32+r32]=__float2bfloat16(o[d0][r]*rli[r]);}
    asm volatile("s_waitcnt lgkmcnt(0)":::"memory");
    #pragma unroll
    for(int i=0;i<4;++i){const int row=i*8+(lane>>3),ch=lane&7; const u32x4 v=*(const u32x4*)(stg+row*64+ch*8); ATTN_STORE16(Ow+(long)row*OP+ch*8,v);} }
  asm volatile("s_waitcnt lgkmcnt(0)\n\ts_barrier":::"memory");
  #undef DMA_K
  #undef DMA_V
  #undef CMASK
  #undef START
  #undef ROT
}
constexpr int ATTN_LDS_BYTES=LDS_BYTES;
struct AttnTensors { const bf16* Q; const bf16* K; const bf16* V; bf16* O; };
struct AttnUnit { int bh; int qb; };
struct StaticOrder {
  int vcu, G;
  __device__ __forceinline__ explicit StaticOrder(int grid,int block):vcu((grid%8==0)?(block%8)*(grid/8)+block/8:block),G(grid){}
  __device__ __forceinline__ bool next(int i,AttnUnit&u)const{
    const int L=i*G+vcu; if(L>=BATCH*NHEAD*NQB)return false;
    if(G==256){ if(i>=2)return false; const int x=vcu>>5,j=vcu&31; const int b=x>>2,kvh=(x>>1)&1,hq=kvh*4+2*(x&1)+i; u.bh=b*NHEAD+hq; u.qb=j; return true; }
    u.bh=L/NQB; u.qb=L%NQB; return true; }
  __device__ __forceinline__ void a_ready(const AttnUnit&)const{}
  __device__ __forceinline__ void done(const AttnUnit&)const{}
};
template<class Sched,int THRL=8> __device__ __forceinline__ void attn_phase(char*lds,const AttnTensors&T,const Sched&S,const float nshift){
  AttnUnit u;
  for(int i=0;S.next(i,u);++i){ S.a_ready(u); attn_unit<THRL>(u.bh/NHEAD,u.bh%NHEAD,u.qb,T.Q,T.K,T.V,T.O,lds,nshift); S.done(u); }
}
#undef SBAR
#undef WAIT_BAR
}

#include <hip/hip_cooperative_groups.h>
namespace cg = cooperative_groups;
#ifndef MK_PER_PHASE
#define MK_PER_PHASE 0
#endif
constexpr int NWAVES = 8, NTHREADS = 512;
constexpr int NB = 2, SEQ = 8192, DMODEL = 1024, TT = NB * SEQ;
constexpr int NPROJ = 2816;
constexpr int NEXP = 32, FFE = 512;
constexpr float EPS = 1e-6f;
constexpr int N_PHASES = 12;

constexpr size_t MiB = 1u << 20;
constexpr size_t WS_CTL = 0, CTL_ZERO_BYTES = 64 * 1024;
constexpr size_t WS_WOUT = 1 * MiB;
constexpr size_t WS_LIST = 229 * MiB;
constexpr size_t WS_WR = 3 * MiB;
constexpr size_t WS_TOK = 3 * MiB + 256 * 1024;
constexpr size_t WS_GATES = 4 * MiB;
constexpr size_t WS_WIN = 5 * MiB;
constexpr size_t WS_WSI = 3 * MiB + 896 * 1024;
constexpr size_t WS_XSC = 3 * MiB + 912 * 1024;
constexpr size_t WS_A = 11 * MiB;
constexpr size_t WS_XN = WS_A;
constexpr size_t GDN_SH_BYTES = 71680, GDN_D_BYTES = 19456;
constexpr size_t WS_GSH = WS_A;
constexpr size_t WS_GD = WS_A + 1024 * GDN_SH_BYTES;
constexpr size_t WS_X1 = 5 * MiB;
constexpr size_t WS_HID = 69 * MiB;
constexpr size_t WS_XBUF = 109 * MiB;
constexpr size_t WS_B = 157 * MiB;
constexpr size_t WS_QKVA = WS_B;
constexpr size_t WS_QKVB = WS_B + 48 * MiB;
constexpr size_t WS_ZA = WS_B + 72 * MiB;
constexpr size_t WS_OCAT = WS_B;
constexpr size_t WS_WGU0 = 189 * MiB, WS_WGU1 = 245 * MiB; constexpr int WGU_SPLIT = 20;
constexpr size_t WS_WSC = 3 * MiB + 768 * 1024;
constexpr float ACT_CLIP = 6.0f;
constexpr size_t DO_WD0 = 0, DO_WD1 = 56 * MiB; constexpr int WD_SPLIT = 24;
constexpr size_t DO_HN = 24 * MiB;
constexpr size_t WS_END = 269 * MiB;
static_assert(WS_GD + 4096 * GDN_D_BYTES <= WS_B, "GDN records fit region A");
static_assert(WS_X1 + 64 * MiB <= WS_HID && WS_HID + 40928ull * 1024 <= WS_XBUF && WS_XBUF + 40928ull * 2048 <= WS_WGU0, "post-scan map");
static_assert(WS_WGU0 + WGU_SPLIT * MiB <= WS_B + 72 * MiB && WS_WGU1 + (32 - WGU_SPLIT) * MiB <= 269 * MiB, "WGU fragments");
constexpr size_t DO_QR = 0, DO_KR = 16 * MiB, DO_VR = 20 * MiB, DO_OF = 24 * MiB, DO_OB = 40 * MiB;
constexpr int CW_CNT = 2048;
constexpr int CW_NTILE = 128;
constexpr int CW_ETAB = 192;
constexpr int CW_SCANQ = 1024;

constexpr int LDS_BYTES = 160 * 1024;

#define GAS __attribute__((address_space(1)))
#define LAS __attribute__((address_space(3)))
typedef unsigned short bf16;
typedef unsigned v4u __attribute__((ext_vector_type(4)));
typedef unsigned v2u __attribute__((ext_vector_type(2)));
typedef float f32x4 __attribute__((ext_vector_type(4)));
typedef short bf16x8 __attribute__((ext_vector_type(8)));
typedef short s16x4 __attribute__((ext_vector_type(4)));
#define DI __device__ __forceinline__

DI unsigned f2bf(float f) { unsigned u = __builtin_bit_cast(unsigned, f); return (u + 0x7fffu + ((u >> 16) & 1u)) >> 16; }
typedef float f32x2_t __attribute__((ext_vector_type(2))); typedef __bf16 bf16x2_t __attribute__((ext_vector_type(2)));
DI unsigned pk2(float lo, float hi) { f32x2_t v = {lo, hi}; bf16x2_t b = __builtin_convertvector(v, bf16x2_t); return __builtin_bit_cast(unsigned, b); }
DI float bf2f(unsigned short h) { return __builtin_bit_cast(float, (unsigned)h << 16); }
DI float bflo(unsigned w) { return __builtin_bit_cast(float, w << 16); }
DI float bfhi(unsigned w) { return __builtin_bit_cast(float, w & 0xffff0000u); }
DI unsigned q8x4(float a, float b, float c, float d, float sc) {
    const float M = 12582912.f;
    const unsigned ua = __builtin_bit_cast(unsigned, fminf(fmaxf(a * sc, -127.f), 127.f) + M), ub = __builtin_bit_cast(unsigned, fminf(fmaxf(b * sc, -127.f), 127.f) + M);
    const unsigned uc = __builtin_bit_cast(unsigned, fminf(fmaxf(c * sc, -127.f), 127.f) + M), ud = __builtin_bit_cast(unsigned, fminf(fmaxf(d * sc, -127.f), 127.f) + M);
    return (ua & 255u) | ((ub & 255u) << 8) | ((uc & 255u) << 16) | (ud << 24);
}
template <int CTRL> DI float dpp_f(float v) { return __builtin_bit_cast(float, __builtin_amdgcn_update_dpp(0, __builtin_bit_cast(int, v), CTRL, 0xf, 0xf, true)); }
#ifdef NO_DPP
DI float sum16(float v) { v += __shfl_xor(v, 1); v += __shfl_xor(v, 2); v += __shfl_xor(v, 4); v += __shfl_xor(v, 8); return v; }
DI float max16(float v) { v = fmaxf(v, __shfl_xor(v, 1)); v = fmaxf(v, __shfl_xor(v, 2)); v = fmaxf(v, __shfl_xor(v, 4)); v = fmaxf(v, __shfl_xor(v, 8)); return v; }
DI float get_x8(float v) { return __shfl_xor(v, 8); }
#else
DI float sum16(float v) { v += dpp_f<0xB1>(v); v += dpp_f<0x4E>(v); v += dpp_f<0x141>(v); v += dpp_f<0x140>(v); return v; }
DI float max16(float v) { v = fmaxf(v, dpp_f<0xB1>(v)); v = fmaxf(v, dpp_f<0x4E>(v)); v = fmaxf(v, dpp_f<0x141>(v)); v = fmaxf(v, dpp_f<0x140>(v)); return v; }
DI float get_x8(float v) { return dpp_f<0x128>(v); }
#endif
DI float sum_x16(float v) { return v + __shfl_xor(v, 16); }
DI float max_x16(float v) { return fmaxf(v, __shfl_xor(v, 16)); }
DI float sum_x32(float v) { return v + __shfl_xor(v, 32); }
DI float max_x32(float v) { return fmaxf(v, __shfl_xor(v, 32)); }
DI float wave_max(float v) { return max_x32(max_x16(max16(v))); }
DI float act_absmax(const float* nfw, int lane) {
    float m = 0.f;
#pragma unroll
    for (int i = 0; i < 16; ++i) m = fmaxf(m, fabsf(nfw[lane + 64 * i]));
    return ACT_CLIP * wave_max(m);
}
DI float wave_sum(float v) { return sum_x32(sum_x16(sum16(v))); }
DI float siluf(float x) { return x * __builtin_amdgcn_rcpf(1.0f + __expf(-x)); }
DI float sigmoidf_(float x) { return 1.0f / (1.0f + __expf(-x)); }
DI int perm32i(int idx) { return ((idx >> 2) & 3) * 8 + (idx >> 4) * 4 + (idx & 3); }
DI int permcol(int c) { return (c & ~31) + perm32i(c & 31); }
template <class T> DI T opaque(T p) { asm volatile("" : "+v"(p)); return p; }

typedef GAS unsigned gu32;
#define RLX_AGENT __ATOMIC_RELAXED, __HIP_MEMORY_SCOPE_AGENT
constexpr int CW_BAR = 4096;
constexpr int MISC_OFF = LDS_BYTES - 64;
#define XB_TMO      128
#define XB_XCNT(j)  (256  + 64 * (j))
#define XB_XSUB(j)  (1280 + 64 * (j))
#define XB_XGEN(j)  (2304 + 64 * (j))
#define XB_TOP      3328
#define XB_TOPGEN   3392
#define XCD_BAR_WORDS 3456
#define XB_SPIN_CAP (1u << 18)

__device__ __forceinline__ unsigned xb_ld(unsigned* p)              { return __hip_atomic_load(p, __ATOMIC_RELAXED, __HIP_MEMORY_SCOPE_AGENT); }
__device__ __forceinline__ unsigned xb_add(unsigned* p, unsigned v) { return __hip_atomic_fetch_add(p, v, __ATOMIC_RELAXED, __HIP_MEMORY_SCOPE_AGENT); }
__device__ __forceinline__ unsigned xb_xcc_id() { return (unsigned)__builtin_amdgcn_s_getreg((3 << 11) | 20) & 0xFu; }
#define XB_SPIN(cond, bar) do { unsigned _sp = 0; while (cond) { __builtin_amdgcn_s_sleep(1); \
    if ((++_sp & 255u) == 0u) { if (xb_ld(&(bar)[XB_TMO])) break; if (_sp > XB_SPIN_CAP) { atomicAdd(&(bar)[XB_TMO], 1u); break; } } } } while (0)

struct XcdBarrier {
    unsigned* bar; unsigned x;
    volatile LAS unsigned* st;
};

__device__ __forceinline__ XcdBarrier xcd_barrier_post(unsigned* bar, volatile LAS unsigned* st) {
    XcdBarrier b; b.bar = bar; b.x = xb_xcc_id(); b.st = st;
    if (threadIdx.x == 0) (void)xb_add(&bar[XB_XCNT(b.x)], 1u);
    return b;
}
__device__ __forceinline__ void xcd_barrier_complete(unsigned* bar, unsigned x, unsigned& nloc, unsigned& nx) {
    const unsigned G = gridDim.x * gridDim.y * gridDim.z;
    unsigned sum, cnt, mine, sp = 0u;
    for (;;) {
        sum = 0u; cnt = 0u; mine = 0u;
#pragma unroll
        for (unsigned j = 0; j < 16; ++j) { const unsigned c = xb_ld(&bar[XB_XCNT(j)]); sum += c; cnt += (c > 0u) ? 1u : 0u; mine = (j == x) ? c : mine; }
        if (sum == G) break;
        __builtin_amdgcn_s_sleep(1);
        if ((++sp & 255u) == 0u) { if (xb_ld(&bar[XB_TMO])) break; if (sp > XB_SPIN_CAP) { atomicAdd(&bar[XB_TMO], 1u); break; } }
    }
    nloc = mine > 0u ? mine : 1u; nx = cnt > 0u ? cnt : 1u;
}

__device__ __forceinline__ void xcd_barrier(const XcdBarrier& b) {
    asm volatile("s_waitcnt vmcnt(0)" ::: "memory");
    __syncthreads();
    if (threadIdx.x == 0) {
        unsigned* bar = b.bar;
        __builtin_amdgcn_s_waitcnt(0);
        unsigned nloc = b.st[0], nx = b.st[1];
        if (nloc == 0u) { xcd_barrier_complete(bar, b.x, nloc, nx); b.st[0] = nloc; b.st[1] = nx; }
        const unsigned old = xb_add(&bar[XB_XSUB(b.x)], 1u);
        const unsigned gen = old / nloc;
        if (old + 1u == (gen + 1u) * nloc) {
            __builtin_amdgcn_fence(__ATOMIC_RELEASE, "agent");
            asm volatile("s_waitcnt vmcnt(0)" ::: "memory");
            const unsigned og = xb_add(&bar[XB_TOP], 1u);
            const unsigned tg = og / nx;
            if (og + 1u == (tg + 1u) * nx) xb_add(&bar[XB_TOPGEN], 1u);
            else XB_SPIN(xb_ld(&bar[XB_TOPGEN]) == tg, bar);
            __builtin_amdgcn_fence(__ATOMIC_ACQUIRE, "agent");
            xb_add(&bar[XB_XGEN(b.x)], 1u);
            asm volatile("s_waitcnt vmcnt(0)" ::: "memory");
        } else {
            XB_SPIN(xb_ld(&bar[XB_XGEN(b.x)]) == gen, bar);
            __builtin_amdgcn_fence(__ATOMIC_ACQUIRE, "agent");
            asm volatile("s_waitcnt vmcnt(0)" ::: "memory");
        }
    }
    __syncthreads();
}

struct Frame {
    LAS unsigned char* lds;
    int tid, lane, wave, vcu, G;
    const float* in[17];
    float* out; unsigned char* ws;
};

DI void p0_transpose_item(const float* W, int ldw, int nblk, bf16* WT, int K, int row_off, int rmul, LAS float* scr, int item, int lane) {
    const int kb = item / nblk, nb = item % nblk, k0 = 64 * kb, n0 = 32 * nb;
    const int r8 = lane >> 3, c4 = (lane & 7) * 4;
    f32x4 v[8];
#pragma unroll
    for (int i = 0; i < 8; ++i) v[i] = __builtin_nontemporal_load((const f32x4*)(W + (size_t)(k0 + 8 * i + r8) * ldw + n0 + c4));
#pragma unroll
    for (int i = 0; i < 8; ++i) { LAS float* d = scr + (8 * i + r8) * 33 + c4; d[0] = v[i].x; d[1] = v[i].y; d[2] = v[i].z; d[3] = v[i].w; }
    asm volatile("s_waitcnt lgkmcnt(0)" ::: "memory");
    const int c = lane & 7;
#pragma unroll
    for (int j = 0; j < 4; ++j) { const int n = (lane >> 3) + 8 * j; const LAS float* s = scr + (8 * c) * 33 + n;
        v4u o; o.x = pk2(s[0 * 33], s[1 * 33]); o.y = pk2(s[2 * 33], s[3 * 33]); o.z = pk2(s[4 * 33], s[5 * 33]); o.w = pk2(s[6 * 33], s[7 * 33]);
        *(GAS v4u*)(WT + (size_t)(row_off + (n0 + n) * rmul) * K + k0 + 8 * c) = o; }
    asm volatile("s_waitcnt lgkmcnt(0)" ::: "memory");
}
template <int NR> DI void rms_rows_to_bf16(const float* const (&xrow)[NR], const float* w, bf16* const (&orow)[NR], int lane) {
    const GAS f32x4* wr = (const GAS f32x4*)w + lane;
    f32x4 v[NR][4];
#pragma unroll
    for (int r = 0; r < NR; ++r) { const GAS f32x4* xr = (const GAS f32x4*)xrow[r] + lane;
#pragma unroll
        for (int j = 0; j < 4; ++j) v[r][j] = xr[64 * j]; }
    f32x4 ww[4];
#pragma unroll
    for (int j = 0; j < 4; ++j) ww[j] = wr[64 * j];
#pragma unroll
    for (int r = 0; r < NR; ++r) {
        float s_ = 0.f;
#pragma unroll
        for (int j = 0; j < 4; ++j) s_ += (v[r][j].x * v[r][j].x + v[r][j].y * v[r][j].y) + (v[r][j].z * v[r][j].z + v[r][j].w * v[r][j].w);
        const float rs = __builtin_amdgcn_rsqf(wave_sum(s_) * (1.f / DMODEL) + EPS);
        GAS v2u* o8 = (GAS v2u*)orow[r] + lane;
#pragma unroll
        for (int j = 0; j < 4; ++j) { v2u o; o.x = pk2(v[r][j].x * rs * ww[j].x, v[r][j].y * rs * ww[j].y); o.y = pk2(v[r][j].z * rs * ww[j].z, v[r][j].w * rs * ww[j].w); o8[64 * j] = o; }
    }
}
DI void q_strip(const float* W, int ldw, int n0, unsigned char* WQ, float* wsc, int rowbase, int rmul, LAS unsigned char* lds, int wave, int lane) {
    LAS float* scr = (LAS float*)(lds + wave * 8704); LAS float* cmx = (LAS float*)(lds + 8 * 8704);
    const int r8 = lane >> 3, c4 = (lane & 7) * 4, kw = 128 * wave;
    f32x4 mx = (f32x4){0.f, 0.f, 0.f, 0.f};
#pragma unroll
    for (int i = 0; i < 16; ++i) { const f32x4 v = *(const f32x4*)(W + (size_t)(kw + 8 * i + r8) * ldw + n0 + c4);
        mx.x = fmaxf(mx.x, fabsf(v.x)); mx.y = fmaxf(mx.y, fabsf(v.y)); mx.z = fmaxf(mx.z, fabsf(v.z)); mx.w = fmaxf(mx.w, fabsf(v.w)); }
    mx.x = max_x32(max_x16(fmaxf(mx.x, get_x8(mx.x)))); mx.y = max_x32(max_x16(fmaxf(mx.y, get_x8(mx.y))));
    mx.z = max_x32(max_x16(fmaxf(mx.z, get_x8(mx.z)))); mx.w = max_x32(max_x16(fmaxf(mx.w, get_x8(mx.w))));
    if (lane < 8) *(LAS f32x4*)(cmx + wave * 32 + c4) = mx;
    __syncthreads();
    float sq[4];
#pragma unroll
    for (int j = 0; j < 4; ++j) { const int n = (lane >> 3) + 8 * j; float m = cmx[n];
#pragma unroll
        for (int w = 1; w < 8; ++w) m = fmaxf(m, cmx[w * 32 + n]);
        sq[j] = m > 0.f ? 127.0f / m : 0.f;
        if (wave == 0 && (lane & 7) == 0) wsc[rowbase + n * rmul] = m * (1.0f / 127.0f); }
    const int c = lane & 7;
#pragma unroll
    for (int kb = 0; kb < 2; ++kb) {
        const int k0 = kw + 64 * kb;
        f32x4 v[8];
#pragma unroll
        for (int i = 0; i < 8; ++i) v[i] = *(const f32x4*)(W + (size_t)(k0 + 8 * i + r8) * ldw + n0 + c4);
#pragma unroll
        for (int i = 0; i < 8; ++i) { LAS float* d = scr + (8 * i + r8) * 33 + c4; d[0] = v[i].x; d[1] = v[i].y; d[2] = v[i].z; d[3] = v[i].w; }
        asm volatile("s_waitcnt lgkmcnt(0)" ::: "memory");
#pragma unroll
        for (int j = 0; j < 4; ++j) { const int n = (lane >> 3) + 8 * j; const LAS float* t = scr + (8 * c) * 33 + n;
            v2u o; o.x = q8x4(t[0 * 33], t[1 * 33], t[2 * 33], t[3 * 33], sq[j]); o.y = q8x4(t[4 * 33], t[5 * 33], t[6 * 33], t[7 * 33], sq[j]);
            *(GAS v2u*)(WQ + (size_t)(rowbase + n * rmul) * 1024 + k0 + 8 * c) = o; }
        asm volatile("s_waitcnt lgkmcnt(0)" ::: "memory");
    }
    __syncthreads();
}
DI float reduce16(const float (&ga)[16], int lane) {
    float gb[8], gc[4];
    const bool h32 = (lane & 32) != 0, h16 = (lane & 16) != 0;
#pragma unroll
    for (int i = 0; i < 8; ++i) { const float lo = sum_x32(ga[i]), hi = sum_x32(ga[i + 8]); gb[i] = h32 ? hi : lo; }
#pragma unroll
    for (int i = 0; i < 4; ++i) { const float lo = sum_x16(gb[i]), hi = sum_x16(gb[i + 4]); gc[i] = h16 ? hi : lo; }
    float res = 0.f;
#pragma unroll
    for (int i = 0; i < 4; ++i) { const float t = sum16(gc[i]); res = ((lane & 3) == i) ? t : res; }
    return res;
}
DI void rms_rows_to_q8(const float* const (&xrow)[2], const float* w, unsigned char* const (&orow)[2], float* const (&xsc)[2], float* const (&gout)[2], const LAS float* gw_, int lane) {
    const LAS float* gw = gw_;
    gw = opaque(gw);
    const GAS f32x4* wr = (const GAS f32x4*)w + lane;
    f32x4 v[2][4];
#pragma unroll
    for (int r = 0; r < 2; ++r) { const GAS f32x4* xr = (const GAS f32x4*)xrow[r] + lane;
#pragma unroll
        for (int j = 0; j < 4; ++j) v[r][j] = xr[64 * j]; }
    f32x4 ww[4];
#pragma unroll
    for (int j = 0; j < 4; ++j) ww[j] = wr[64 * j];
#pragma unroll
    for (int r = 0; r < 2; ++r) {
        float s_ = 0.f;
#pragma unroll
        for (int j = 0; j < 4; ++j) s_ += (v[r][j].x * v[r][j].x + v[r][j].y * v[r][j].y) + (v[r][j].z * v[r][j].z + v[r][j].w * v[r][j].w);
        const float rs = __builtin_amdgcn_rsqf(wave_sum(s_) * (1.f / DMODEL) + EPS);
        float am = 0.f;
#pragma unroll
        for (int j = 0; j < 4; ++j) { v[r][j] = v[r][j] * ww[j] * rs; am = fmaxf(fmaxf(am, fmaxf(fabsf(v[r][j].x), fabsf(v[r][j].y))), fmaxf(fabsf(v[r][j].z), fabsf(v[r][j].w))); }
        am = wave_max(am);
        const float qsc = am > 0.f ? 127.0f / am : 0.f;
        if (lane == 0) *xsc[r] = am * (1.0f / 127.0f);
        GAS unsigned* o4 = (GAS unsigned*)orow[r] + lane;
#pragma unroll
        for (int j = 0; j < 4; ++j) o4[64 * j] = q8x4(v[r][j].x, v[r][j].y, v[r][j].z, v[r][j].w, qsc);
    }
#ifndef NO_GATES
    float ga[2][16];
#pragma unroll
    for (int c = 0; c < 16; ++c) { ga[0][c] = 0.f; ga[1][c] = 0.f; }
    asm volatile("" : "+v"(v[0][0]), "+v"(v[0][1]), "+v"(v[0][2]), "+v"(v[0][3]), "+v"(v[1][0]), "+v"(v[1][1]), "+v"(v[1][2]), "+v"(v[1][3]));
#pragma unroll
    for (int j = 0; j < 4; ++j)
#pragma unroll
        for (int q = 0; q < 4; ++q) { const LAS f32x4* g4 = (const LAS f32x4*)gw + ((j * 4 + q) * 4) * 64 + lane;
            const f32x4 g0 = g4[0], g1 = g4[64], g2 = g4[128], g3 = g4[192];
#pragma unroll
            for (int r = 0; r < 2; ++r) { const float h = v[r][j][q];
                ga[r][0] += h * g0.x; ga[r][1] += h * g0.y; ga[r][2] += h * g0.z; ga[r][3] += h * g0.w; ga[r][4] += h * g1.x; ga[r][5] += h * g1.y; ga[r][6] += h * g1.z; ga[r][7] += h * g1.w;
                ga[r][8] += h * g2.x; ga[r][9] += h * g2.y; ga[r][10] += h * g2.z; ga[r][11] += h * g2.w; ga[r][12] += h * g3.x; ga[r][13] += h * g3.y; ga[r][14] += h * g3.z; ga[r][15] += h * g3.w; }
            asm volatile("" : "+v"(ga[1][0]), "+v"(ga[1][1]), "+v"(ga[1][2]), "+v"(ga[1][3]), "+v"(ga[1][4]), "+v"(ga[1][5]), "+v"(ga[1][6]), "+v"(ga[1][7]), "+v"(ga[1][8]), "+v"(ga[1][9]),
                         "+v"(ga[1][10]), "+v"(ga[1][11]), "+v"(ga[1][12]), "+v"(ga[1][13]), "+v"(ga[1][14]), "+v"(ga[1][15]) :: "memory"); }
    const int gc_ = 4 * (lane >> 4) + (lane & 3);
#pragma unroll
    for (int r = 0; r < 2; ++r) { const float res = reduce16(ga[r], lane); if ((lane & 12) == 0) gout[r][gc_] = res; }
#endif
}
DI void p0_prologue(Frame& F) {
    const float* w_in = F.in[2];
    unsigned char* WIN = F.ws + WS_WIN; float* WSI = (float*)(F.ws + WS_WSI);
    constexpr int NSTRIP = 64 + 24;
    if (F.vcu < NSTRIP) { const int st = F.vcu;
        if (st < 64) q_strip(w_in, 2832, 32 * st, WIN, WSI, 32 * st, 1, F.lds, F.wave, F.lane);
        else q_strip(w_in + 2064, 2832, 32 * (st - 64), WIN, WSI, 2048 + 32 * (st - 64), 1, F.lds, F.wave, F.lane); }
    unsigned char* XN = F.ws + WS_XN; float* XSC = (float*)(F.ws + WS_XSC); float* GATES = (float*)(F.ws + WS_GATES);
    LAS float* gw = (LAS float*)(F.lds + 73728);
    for (int i = F.tid; i < 1024 * 4; i += NTHREADS) { const int k = i >> 2, c4 = i & 3, jj = k >> 8, qq = k & 3, ln = (k & 255) >> 2;
        *((LAS f32x4*)gw + ((jj * 4 + qq) * 4 + c4) * 64 + ln) = *(const f32x4*)(w_in + (size_t)k * 2832 + 2048 + c4 * 4); }
    __syncthreads();
    const int nst = (F.G < NSTRIP ? F.G : NSTRIP), NSLOT = nst * NWAVES + (F.G - nst) * NWAVES * 2;
    const int s0_ = (F.vcu < nst) ? F.vcu * NWAVES + F.wave : nst * NWAVES + ((F.vcu - nst) * NWAVES + F.wave) * 2, nmine = (F.vcu < nst) ? 1 : 2;
#pragma unroll 1
    for (int q = 0; q < nmine; ++q)
#pragma unroll 1
        for (int p = s0_ + q; p < TT / 2; p += NSLOT) { const int m = 2 * p;
            const float* const xr[2] = {F.in[0] + (size_t)m * DMODEL, F.in[0] + (size_t)(m + 1) * DMODEL}; unsigned char* const orw[2] = {XN + (size_t)m * DMODEL, XN + (size_t)(m + 1) * DMODEL};
            float* const xs[2] = {XSC + m, XSC + m + 1}; float* const go[2] = {GATES + (size_t)m * 16, GATES + (size_t)(m + 1) * 16};
            rms_rows_to_q8(xr, F.in[1], orw, xs, go, gw, F.lane); }
}

struct EpiProj {
    static constexpr bool PERM = true, AFTER_DRAIN = false;
    bf16 *qkva, *za, *qkvb; const float* wsi; const float* xsc;
    DI void operator()(const pg8::i32x4 (&acc)[2][2][4][2], const pg8::Unit& u, int wr, int wc, int fr, int fq) const {
        const int row0 = u.pm * 256 + wr * 64 + fr;
        const float* ws_ = wsi + u.pn * 256 + wc * 32 + 8 * fq;
        bf16* base; int ldc, colt;
        if (u.pn < 6) { base = qkva; ldc = 1536; colt = u.pn * 256; } else if (u.pn < 8) { base = za; ldc = 512; colt = (u.pn - 6) * 256; } else { base = qkvb; ldc = 768; colt = (u.pn - 8) * 256; }
        const int col0 = colt + wc * 32 + 8 * fq;
        f32x4 s0[2], s1[2];
#pragma unroll
        for (int bj = 0; bj < 2; ++bj) { s0[bj] = *(const f32x4*)(ws_ + bj * 128); s1[bj] = *(const f32x4*)(ws_ + bj * 128 + 4); }
        float rsc[2][4];
#pragma unroll
        for (int ai = 0; ai < 2; ++ai)
#pragma unroll
            for (int m = 0; m < 4; ++m) rsc[ai][m] = xsc[row0 + ai * 128 + m * 16];
#pragma unroll
        for (int ai = 0; ai < 2; ++ai)
#pragma unroll
            for (int m = 0; m < 4; ++m) { bf16* rowp = base + (size_t)(row0 + ai * 128 + m * 16) * ldc + col0; const float rr = rsc[ai][m];
#pragma unroll
                for (int bj = 0; bj < 2; ++bj) { const pg8::i32x4 a0 = acc[ai][bj][m][0], a1 = acc[ai][bj][m][1]; const f32x4 t0 = s0[bj] * rr, t1 = s1[bj] * rr; pg8::u32x4 w;
                    w.x = pg8::cvt_pk_bf16((float)a0[0] * t0[0], (float)a0[1] * t0[1]); w.y = pg8::cvt_pk_bf16((float)a0[2] * t0[2], (float)a0[3] * t0[3]);
                    w.z = pg8::cvt_pk_bf16((float)a1[0] * t1[0], (float)a1[1] * t1[1]); w.w = pg8::cvt_pk_bf16((float)a1[2] * t1[2], (float)a1[3] * t1[3]);
                    *(pg8::u32x4*)(rowp + bj * 128) = w; } }
    }
};
struct IdRows { DI int row(const pg8::Unit& u, int r) const { return u.pm * 256 + r; } };
struct EpiResid {
    static constexpr bool PERM = false, AFTER_DRAIN = false;
    const float* x; float* x1;
    DI void operator()(const pg8::f32x4 (&acc)[2][2][4][2], const pg8::Unit& u, int wr, int wc, int fr, int fq) const {
        const int row0 = u.pm * 256 + wr * 64 + fr, col0 = u.pn * 256 + wc * 32 + 4 * fq;
#pragma unroll
        for (int ai = 0; ai < 2; ++ai)
#pragma unroll
            for (int m = 0; m < 4; ++m) { const size_t off = (size_t)(row0 + ai * 128 + m * 16) * DMODEL + col0;
#pragma unroll
                for (int bj = 0; bj < 2; ++bj)
#pragma unroll
                    for (int n = 0; n < 2; ++n) { const pg8::f32x4 b = *(const pg8::f32x4*)(x + off + bj * 128 + n * 16); *(pg8::f32x4*)(x1 + off + bj * 128 + n * 16) = b + acc[ai][bj][m][n]; } }
    }
};
struct EpiGU {
    static constexpr bool PERM = true, AFTER_DRAIN = false;
    bf16* hid; const float* wsc; float ainv;
    DI void operator()(const pg8::i32x4 (&acc)[2][2][4][2], const pg8::Unit& u, int wr, int wc, int fr, int fq) const {
        const int row0 = u.pm * 256 + wr * 64 + fr; const int jt = u.pn & 3;
        const int ff0 = jt * 128 + wc * 16 + 4 * fq;
        const float* ws_ = wsc + u.ex * 1024 + jt * 256 + wc * 32 + 8 * fq;
        f32x4 s0[2], s1[2];
#pragma unroll
        for (int bj = 0; bj < 2; ++bj) { s0[bj] = *(const f32x4*)(ws_ + bj * 128) * ainv; s1[bj] = *(const f32x4*)(ws_ + bj * 128 + 4) * ainv; }
#pragma unroll
        for (int ai = 0; ai < 2; ++ai)
#pragma unroll
            for (int m = 0; m < 4; ++m) { bf16* rowp = hid + (size_t)(row0 + ai * 128 + m * 16) * FFE + ff0;
#pragma unroll
                for (int bj = 0; bj < 2; ++bj) { const pg8::i32x4 a0 = acc[ai][bj][m][0], a1 = acc[ai][bj][m][1];
                    const float g0 = (float)a0[0] * s0[bj][0], u0 = (float)a0[1] * s0[bj][1], g1 = (float)a0[2] * s0[bj][2], u1 = (float)a0[3] * s0[bj][3];
                    const float g2 = (float)a1[0] * s1[bj][0], u2 = (float)a1[1] * s1[bj][1], g3 = (float)a1[2] * s1[bj][2], u3 = (float)a1[3] * s1[bj][3];
                    v2u w; w.x = pg8::cvt_pk_bf16(siluf(g0) * u0, siluf(g1) * u1); w.y = pg8::cvt_pk_bf16(siluf(g2) * u2, siluf(g3) * u3);
                    *(v2u*)(rowp + bj * 64) = w; } }
    }
};
struct EpiY {
    static constexpr bool PERM = true, AFTER_DRAIN = false;
    bf16* y;
    DI void operator()(const pg8::f32x4 (&acc)[2][2][4][2], const pg8::Unit& u, int wr, int wc, int fr, int fq) const {
        const int row0 = u.pm * 256 + wr * 64 + fr; const int col0 = (u.pn & 3) * 256 + wc * 32 + 8 * fq;
#pragma unroll
        for (int ai = 0; ai < 2; ++ai)
#pragma unroll
            for (int m = 0; m < 4; ++m) { bf16* rowp = y + (size_t)(row0 + ai * 128 + m * 16) * DMODEL + col0;
#pragma unroll
                for (int bj = 0; bj < 2; ++bj) { const pg8::f32x4 v0 = acc[ai][bj][m][0], v1 = acc[ai][bj][m][1]; pg8::u32x4 w;
                    w.x = pg8::cvt_pk_bf16(v0[0], v0[1]); w.y = pg8::cvt_pk_bf16(v0[2], v0[3]); w.z = pg8::cvt_pk_bf16(v1[0], v1[1]); w.w = pg8::cvt_pk_bf16(v1[2], v1[3]);
                    *(pg8::u32x4*)(rowp + bj * 128) = w; } }
    }
};
constexpr int ETAB_OFF = 131072;
struct MoeOrder {
    const LAS unsigned* etab; int G, c, esplit, pnoff;
    DI bool next(int i, pg8::Unit& u) const {
        if (G % 8 != 0) {
            int L = i * G + c;
            for (int e = 0; e < NEXP; ++e) { const int n4 = 4 * (int)etab[2 * e + 1]; if (L < n4) { u.pm = (int)etab[2 * e] + (L >> 2); u.pn = (e < esplit ? 4 * e : pnoff + 4 * (e - esplit)) + (L & 3); u.ex = e; u.tq = L >> 2; return true; } L -= n4; }
            return false; }
        const int x = c & 7; int L = i * (G >> 3) + (c >> 3);
#pragma unroll
        for (int q = 0; q < NEXP / 8; ++q) { const int e = x + 8 * q; const int n4 = 4 * (int)etab[2 * e + 1];
            if (L < n4) { u.pm = (int)etab[2 * e] + (L >> 2); u.pn = (e < esplit ? 4 * e : pnoff + 4 * (e - esplit)) + (L & 3); u.ex = e; u.tq = L >> 2; return true; } L -= n4; }
        return false; }
    DI void a_ready(const pg8::Unit&) const {}
    DI void done(const pg8::Unit&) const {}
};
struct MoeRows {
    const int* list; const LAS unsigned* etab;
    DI int row(const pg8::Unit& u, int r) const {
        const int slot = u.tq * 256 + r, e = u.ex; if (slot >= (int)etab[64 + e]) return 0;
        const LAS unsigned* sp = etab + 96 + 8 * e; int sb = 0;
#pragma unroll
        for (int q = 1; q < 8; ++q) sb += (slot >= (int)sp[q]) ? 1 : 0;
        return list[(size_t)(e * 8 + sb) * TT + (slot - (int)sp[sb])]; }
};

DI void p2_rope(Frame& F) {
    const int gw = F.vcu * NWAVES + F.wave, NGW = F.G * NWAVES, lane = F.lane;
    const bf16* QKVB = (const bf16*)(F.ws + WS_QKVB);
    bf16* QR = (bf16*)((unsigned char*)F.out + DO_QR); bf16* KR = (bf16*)((unsigned char*)F.out + DO_KR); bf16* VR = (bf16*)((unsigned char*)F.out + DO_VR);
    const int pi = lane & 31, hsel = lane >> 5;
    const float qw0 = F.in[7][2 * pi], qw1 = F.in[7][2 * pi + 1], kw0 = F.in[8][2 * pi], kw1 = F.in[8][2 * pi + 1];
    const float invf = exp2f(-(float)(2 * (pi & 15)) * (13.287712379549449f / 32.0f));
    constexpr float C2 = 0.125f * 1.4426950408889634f;
    constexpr int NB4 = 4;
    for (int t0 = gw; t0 < TT; t0 += NB4 * NGW) {
        unsigned w[NB4][5], vw[NB4];
#pragma unroll
        for (int u = 0; u < NB4; ++u) { const int t = t0 + u * NGW; const unsigned* src = (const unsigned*)(QKVB + (size_t)(t < TT ? t : t0) * 768);
#pragma unroll
            for (int j = 0; j < 5; ++j) w[u][j] = src[(2 * j + hsel) * 32 + pi];
            vw[u] = src[320 + lane]; }
#pragma unroll
        for (int u = 0; u < NB4; ++u) {
            const int t = t0 + u * NGW; if (t >= TT) break;
            const int s_ = t & (SEQ - 1); const float pos = (pi < 16) ? (float)(s_ >> 6) : (float)(s_ & 63);
            const float ang = pos * invf;
            const float rev = ang * 0.15915494309189535f;
            const float sn = __builtin_amdgcn_sinf(rev), cs = __builtin_amdgcn_cosf(rev);
#pragma unroll
            for (int j = 0; j < 5; ++j) {
                const int head = 2 * j + hsel;
                const float x0 = bflo(w[u][j]), x1 = bfhi(w[u][j]);
                float ss = x0 * x0 + x1 * x1;
                ss = sum_x16(sum16(ss));
                const float rs = __builtin_amdgcn_rsqf(ss * (1.f / 64.f) + EPS);
                const bool isq = head < 8;
                const float y0 = x0 * rs * (isq ? qw0 : kw0), y1 = x1 * rs * (isq ? qw1 : kw1);
                float o0 = y0 * cs - y1 * sn, o1 = y0 * sn + y1 * cs;
                if (isq) { o0 *= C2; o1 *= C2; ((unsigned*)(QR + (size_t)t * 512))[head * 32 + pi] = pk2(o0, o1); }
                else { const int hk = head - 8, bq = t >> 13, sq = t & (SEQ - 1);
                    ((unsigned*)(KR + ((size_t)((bq * 2 + hk) * 128 + (sq >> 6)) * 8 + (pi >> 2)) * 512 + (sq & 63) * 8))[pi & 3] = pk2(o0, o1); }
            }
            { const int hk = lane >> 5, d = 2 * (lane & 31), bq = t >> 13, sq = t & (SEQ - 1), r = sq & 63;
              ((unsigned*)(VR + ((size_t)((bq * 2 + hk) * 128 + (sq >> 6)) * 8 + (d >> 5) * 4 + (r >> 4)) * 512 + ((r & 15) * 4 + ((d & 31) >> 3)) * 8))[(d & 7) >> 1] = vw[u]; }
        }
    }
}

constexpr int G_KNP = 0, G_QNP = 17408, G_KNTP = 34816, G_VCT = 53248;
constexpr int G_D0 = 71680, G_D1 = 71680 + 19456;
constexpr int GD_TBP = 0, GD_AP = 9216, GD_VEC = 18432;
constexpr int G_LM = 110592;
constexpr int G_GV = G_LM + 32768;
static_assert(G_GV + 2048 <= LDS_BYTES - 64, "gdn pre lds");

#define TRI_ROW(i, LC, LN) { \
        if ((i) + 1 < 64) { _Pragma("unroll") for (int j4 = 0; j4 < ((i) + 1 + 3) / 4 && j4 < 8; ++j4) LN[j4] = *(const LAS f32x4*)(L + ((i) + 1) * 64 + 4 * j4); } \
        _Pragma("unroll") for (int j4 = 8; j4 < ((i) + 3) / 4; ++j4) lt[j4 - 8] = *(const LAS f32x4*)(L + (i) * 64 + 4 * j4); \
        __builtin_amdgcn_sched_barrier(0); \
        f32x2_t a0 = {(lane == (i)) ? 1.0f : 0.0f, 0.f}, a1 = {0.f, 0.f}; \
        _Pragma("unroll") for (int j4 = 0; j4 < ((i) + 3) / 4; ++j4) { const f32x4 l = (j4 < 8) ? LC[j4 & 7] : lt[(j4 - 8) & 7]; \
            f32x2_t l0 = {l.x, (4 * j4 + 1 < (i)) ? l.y : 0.f}, l1 = {(4 * j4 + 2 < (i)) ? l.z : 0.f, (4 * j4 + 3 < (i)) ? l.w : 0.f}; \
            a0 -= l0 * xp[2 * j4]; if (4 * j4 + 2 < (i)) a1 -= l1 * xp[2 * j4 + 1]; } \
        const float a = (a0.x + a0.y) + (a1.x + a1.y); \
        if ((i) & 1) xp[(i) >> 1].y = a; else { xp[(i) >> 1].x = a; xp[(i) >> 1].y = 0.f; } \
        TBP[(REV ? 63 - (i) : (i)) * 72 + pc] = (bf16)(pk2(a * bcol, 0.f) & 0xffffu); \
        __builtin_amdgcn_sched_barrier(0); }
template <bool REV> DI void tri_inverse(LAS float* L, const LAS float* beta, LAS bf16* TBP, int lane) {
    f32x2_t xp[32];
    L = opaque(L); TBP = opaque(TBP); lane = opaque(lane);
    const float bcol = REV ? beta[63 - lane] : beta[lane];
    const int pc = REV ? permcol(63 - lane) : permcol(lane);
    f32x4 la[8], lb[8], lt[8];
#pragma unroll
    for (int ii = 0; ii < 64; ii += 2) { TRI_ROW(ii, la, lb) TRI_ROW(ii + 1, lb, la) }
}
#undef TRI_ROW

DI void gdn_conv(Frame& F, LAS unsigned char* lds, int t384, int b, int h, int n) {
    const bf16* QKVA = (const bf16*)(F.ws + WS_QKVA); const float* convw = F.in[3];
    const int cgp = t384 % 48, rg = t384 / 48, mat = cgp >> 4, cc = (cgp & 15) * 8;
    const int col = mat * 512 + h * 128 + cc;
    float w[5][8];
#pragma unroll
    for (int j = 0; j < 5; ++j) { const f32x4 a = *(const f32x4*)(convw + j * 1536 + col), bq = *(const f32x4*)(convw + j * 1536 + col + 4);
        w[j][0] = a.x; w[j][1] = a.y; w[j][2] = a.z; w[j][3] = a.w; w[j][4] = bq.x; w[j][5] = bq.y; w[j][6] = bq.z; w[j][7] = bq.w; }
    const int a4 = (cc >> 3) & 3, p0 = (cc & ~31) + 16 * (a4 & 1) + 4 * (a4 >> 1);
    const int ra = rg & 3, q0 = (rg >> 2) * 32 + 16 * (ra & 1) + 4 * (ra >> 1);
#pragma unroll
    for (int hf = 0; hf < 2; ++hf) {
        float o[4][8];
#pragma unroll
        for (int r = 0; r < 4; ++r)
#pragma unroll
            for (int c = 0; c < 8; ++c) o[r][c] = 0.f;
#pragma unroll
        for (int i = 0; i < 8; ++i) {
            const int pos = n * 64 + rg * 8 + hf * 4 - 2 + i;
            v4u raw = (v4u){0u, 0u, 0u, 0u};
            if (pos >= 0 && pos < SEQ) raw = *(const v4u*)(QKVA + (size_t)(b * SEQ + pos) * 1536 + col);
            float xin[8] = {bflo(raw.x), bfhi(raw.x), bflo(raw.y), bfhi(raw.y), bflo(raw.z), bfhi(raw.z), bflo(raw.w), bfhi(raw.w)};
#pragma unroll
            for (int j = 0; j < 5; ++j) { const int r = i - j; if (r >= 0 && r < 4) {
#pragma unroll
                for (int c = 0; c < 8; ++c) o[r][c] += w[j][c] * xin[c]; } }
        }
#pragma unroll
        for (int r = 0; r < 4; ++r) {
            float ss = 0.f;
#pragma unroll
            for (int c = 0; c < 8; ++c) { o[r][c] = siluf(o[r][c]); ss += o[r][c] * o[r][c]; }
            ss = sum16(ss);
            float sc = 1.0f;
            if (mat < 2) { sc = __builtin_amdgcn_rsqf(ss + EPS); if (mat == 0) sc *= 0.08838834764831845f; }
#pragma unroll
            for (int c = 0; c < 8; ++c) o[r][c] *= sc;
        }
        if (mat < 2) {
            LAS unsigned char* tile = lds + (mat == 0 ? G_QNP : G_KNP);
#pragma unroll
            for (int r = 0; r < 4; ++r) { const int c = rg * 8 + hf * 4 + r;
                v2u lo, hi2; lo.x = pk2(o[r][0], o[r][1]); lo.y = pk2(o[r][2], o[r][3]); hi2.x = pk2(o[r][4], o[r][5]); hi2.y = pk2(o[r][6], o[r][7]);
                *(LAS v2u*)(tile + c * 272 + p0 * 2) = lo; *(LAS v2u*)(tile + c * 272 + (p0 + 8) * 2) = hi2; }
        }
        if (mat >= 1) {
#pragma unroll
            for (int c = 0; c < 8; ++c) {
                v2u q4; q4.x = pk2(o[0][c], o[1][c]); q4.y = pk2(o[2][c], o[3][c]);
                if (mat == 1) *(LAS v2u*)(lds + G_KNTP + (cc + c) * 144 + (q0 + 8 * hf) * 2) = q4;
                else *(LAS v2u*)(lds + G_VCT + (cc + c) * 144 + rg * 16 + hf * 8) = q4;
            }
        }
    }
}
DI void gdn_gates(Frame& F, LAS unsigned char* lds, LAS float* gv, int lane, int b, int h, int n) {
    const float* gp = (const float*)(F.ws + WS_GATES) + (size_t)(b * SEQ + n * 64 + lane) * 16;
    const float bfv = gp[h], bbv = gp[4 + h], afv = gp[8 + h], abv = gp[12 + h];
    const float betaf = sigmoidf_(bfv), betab = sigmoidf_(bbv);
    const float xf = afv + F.in[5][h], xb = abv + F.in[5][4 + h];
    const float spf = fmaxf(xf, 0.f) + log1pf(__expf(-fabsf(xf))), spb = fmaxf(xb, 0.f) + log1pf(__expf(-fabsf(xb)));
    const float gf = -__expf(F.in[4][h]) * spf, gb = -__expf(F.in[4][4 + h]) * spb;
    float Gf = gf, Rb = gb;
#pragma unroll
    for (int o = 1; o < 64; o <<= 1) { const float u1 = __shfl_up(Gf, o); if (lane >= o) Gf += u1; const float d1 = __shfl_down(Rb, o); if (lane + o < 64) Rb += d1; }
    gv[lane] = Gf; gv[64 + lane] = Rb; gv[128 + lane] = betaf; gv[192 + lane] = betab;
    const float GfL = __shfl(Gf, 63), Rb0 = __shfl(Rb, 0);
    LAS float* v0 = (LAS float*)(lds + G_D0 + GD_VEC); LAS float* v1 = (LAS float*)(lds + G_D1 + GD_VEC);
    v0[lane] = __expf(Gf); v0[64 + lane] = __expf(GfL - Gf); v1[lane] = __expf(Rb); v1[64 + lane] = __expf(Rb0 - Rb);
    if (lane == 0) { v0[128] = __expf(GfL); v1[128] = __expf(Rb0); }
}
DI void p2_gdn_pre(Frame& F) {
    const int tid = F.tid, lane = F.lane, wave = F.wave;
    int task = F.vcu;
    if (task < 1024) {
        LAS unsigned char* lds = opaque(F.lds);
        const int b = task >> 9, h = (task >> 7) & 3, n = task & 127;
        if (wave >= 2) gdn_conv(F, lds, tid - 128, b, h, n);
        if (wave == 2) gdn_gates(F, lds, (LAS float*)(lds + G_GV), lane, b, h, n);
    }
    __syncthreads();
    int par = 0;
#pragma unroll 1
    for (; task < 1024; task += F.G, par ^= 1) {
        LAS unsigned char* lds = opaque(F.lds);
        const int b = task >> 9, h = (task >> 7) & 3, n = task & 127, bh = b * 4 + h;
        LAS float* gv = (LAS float*)(lds + G_GV + par * 1024);
        LAS float* sGf = gv; LAS float* sRb = gv + 64; LAS float* sBf = gv + 128; LAS float* sBb = gv + 192;
        {
            const int p = wave >> 2, mt = wave & 3, n16 = lane & 15, g = lane >> 4;
            const LAS unsigned char* At = lds + (p == 0 ? G_KNP : G_QNP) + (16 * mt + n16) * 272 + g * 16;
            bf16x8 af[4], bfr[16];
#pragma unroll
            for (int ks = 0; ks < 4; ++ks) af[ks] = *(const LAS bf16x8*)(At + ks * 64);
#pragma unroll
            for (int nt = 0; nt < 4; ++nt)
#pragma unroll
                for (int ks = 0; ks < 4; ++ks) bfr[nt * 4 + ks] = *(const LAS bf16x8*)(lds + G_KNP + (16 * nt + n16) * 272 + g * 16 + ks * 64);
            float Gc[4], Rc[4], Bfc[4], Bbc[4];
#pragma unroll
            for (int r = 0; r < 4; ++r) { const int c = 16 * mt + 4 * g + r; Gc[r] = sGf[c]; Rc[r] = sRb[c]; Bfc[r] = sBf[c]; Bbc[r] = sBb[c]; }
#pragma unroll
            for (int nt = 0; nt < 4; ++nt) {
                f32x4 acc = (f32x4){0.f, 0.f, 0.f, 0.f};
#pragma unroll
                for (int ks = 0; ks < 4; ++ks) acc = __builtin_amdgcn_mfma_f32_16x16x32_bf16(af[ks], bfr[nt * 4 + ks], acc, 0, 0, 0);
                const int s_ = 16 * nt + n16; const float Gs = sGf[s_], Rs = sRb[s_]; const int ps = permcol(s_);
#pragma unroll
                for (int r = 0; r < 4; ++r) {
                    const int c = 16 * mt + 4 * g + r; const float v = acc[r];
                    const float df = __expf(fminf(Gc[r] - Gs, 0.f)), db = __expf(fminf(Rc[r] - Rs, 0.f));
                    if (p == 0) {
                        ((LAS float*)(lds + G_LM))[c * 64 + s_] = Bfc[r] * v * df;
                        ((LAS float*)(lds + G_LM + 16384))[(63 - c) * 64 + (63 - s_)] = Bbc[r] * v * db;
                    } else {
                        ((LAS bf16*)(lds + G_D0 + GD_AP))[c * 72 + ps] = (bf16)(pk2(s_ <= c ? v * df : 0.f, 0.f) & 0xffffu);
                        ((LAS bf16*)(lds + G_D1 + GD_AP))[c * 72 + ps] = (bf16)(pk2(s_ >= c ? v * db : 0.f, 0.f) & 0xffffu);
                    }
                }
            }
        }
        __syncthreads();
        GAS v4u* gd0 = (GAS v4u*)(F.ws + WS_GD + (size_t)((bh * 2 + 0) * 128 + n) * GDN_D_BYTES);
        GAS v4u* gd1 = (GAS v4u*)(F.ws + WS_GD + (size_t)((bh * 2 + 1) * 128 + n) * GDN_D_BYTES);
        {
            GAS v4u* gsh = (GAS v4u*)(F.ws + WS_GSH + (size_t)(bh * 128 + n) * GDN_SH_BYTES);
#pragma unroll 3
            for (int i = tid; i < (int)(GDN_SH_BYTES / 16); i += NTHREADS) gsh[i] = *(const LAS v4u*)(lds + i * 16);
#pragma unroll 1
            for (int i = GD_AP / 16 + tid; i < (int)(GDN_D_BYTES / 16); i += NTHREADS) { gd0[i] = *(const LAS v4u*)(lds + G_D0 + i * 16); gd1[i] = *(const LAS v4u*)(lds + G_D1 + i * 16); }
        }
        __syncthreads();
        if (wave == 0) { tri_inverse<false>((LAS float*)(lds + G_LM), sBf, (LAS bf16*)(lds + G_D0 + GD_TBP), lane);
#pragma unroll 3
            for (int i = lane; i < GD_AP / 16; i += 64) gd0[i] = *(const LAS v4u*)(lds + G_D0 + i * 16); }
        else if (wave == 1) { tri_inverse<true>((LAS float*)(lds + G_LM + 16384), sBb, (LAS bf16*)(lds + G_D1 + GD_TBP), lane);
#pragma unroll 3
            for (int i = lane; i < GD_AP / 16; i += 64) gd1[i] = *(const LAS v4u*)(lds + G_D1 + i * 16); }
        else {
            const int t2 = task + F.G;
            if (t2 < 1024) { const int b2 = t2 >> 9, h2 = (t2 >> 7) & 3, n2 = t2 & 127;
                gdn_conv(F, lds, tid - 128, b2, h2, n2);
                if (wave == 2) gdn_gates(F, lds, (LAS float*)(lds + G_GV + (par ^ 1) * 1024), lane, b2, h2, n2); }
        }
        __syncthreads();
    }
}

DI bf16x8 pack8(const f32x4 a, const f32x4 b) {
    v4u p; p.x = pk2(a[0], a[1]); p.y = pk2(a[2], a[3]); p.z = pk2(b[0], b[1]); p.w = pk2(b[2], b[3]); return __builtin_bit_cast(bf16x8, p);
}
DI void small_weights(Frame& F, int gw, int NGW) {
    LAS float* scr = (LAS float*)(F.lds + F.wave * 16384);
    bf16* WOUT = (bf16*)(F.ws + WS_WOUT);
    for (int it = gw; it < 16 * 32; it += NGW) p0_transpose_item(F.in[9], 1024, 32, WOUT, 1024, 0, 1, scr, it, F.lane);
    bf16* WRH = (bf16*)(F.ws + WS_WR); bf16* WRL = WRH + 48 * 1024; const float* wrg = F.in[11]; const float* wre = F.in[12];
    for (int i = gw * 64 + F.lane; i < 48 * 1024; i += NGW * 64) { const int j = i >> 10, k = i & 1023; float v = 0.f; if (j < 4) v = wrg[k * 4 + j]; else if (j < 36) v = wre[k * 32 + (j - 4)];
        const unsigned h = f2bf(v); const float hv = __builtin_bit_cast(float, h << 16); WRH[i] = (bf16)h; WRL[i] = (bf16)f2bf(v - hv); }
}
DI unsigned char* wgu_ptr(Frame& F, int e) { return F.ws + (e < WGU_SPLIT ? WS_WGU0 + (size_t)e * MiB : WS_WGU1 + (size_t)(e - WGU_SPLIT) * MiB); }
DI bf16* wd_ptr(Frame& F, int e) { return (bf16*)((unsigned char*)F.out + (e < WD_SPLIT ? DO_WD0 + (size_t)e * MiB : DO_WD1 + (size_t)(e - WD_SPLIT) * MiB)); }
DI void moe_weights(Frame& F, int cb, int ncb) {
    for (int it = cb; it < NEXP * 32; it += ncb) { const int e = it >> 5, mat = (it >> 4) & 1, nb = it & 15;
        q_strip((mat ? F.in[14] : F.in[13]) + (size_t)e * 1024 * 512, 512, 32 * nb, wgu_ptr(F, e), (float*)(F.ws + WS_WSC) + e * 1024, mat + 64 * nb, 2, F.lds, F.wave, F.lane); }
    LAS float* scr = (LAS float*)(F.lds + F.wave * 16384);
    constexpr int ID = 8 * 32; const int gw = cb * NWAVES + F.wave, NGW = ncb * NWAVES;
    for (int it = gw; it < NEXP * ID; it += NGW) { const int e = it / ID, r = it % ID;
        p0_transpose_item(F.in[15] + (size_t)e * 512 * 1024, 1024, 32, wd_ptr(F, e), 512, 0, 1, scr, r, F.lane); }
}

constexpr int SC_SLOT = 78848, SC_VCT = 53248, SC_D = 55552, SC_NCH = 11;
static_assert(2 * SC_SLOT <= LDS_BYTES, "scan slots");
DI void sc_issue(v4u (&R)[SC_NCH], const unsigned char* ws, const unsigned (&delta)[SC_NCH], const unsigned (&dmask)[SC_NCH], unsigned shbase, unsigned ddiff) {
#pragma unroll
    for (int j = 0; j < SC_NCH; ++j) { const unsigned off = shbase + delta[j] + (dmask[j] & ddiff);
#ifdef SC_PLAIN_LOADS
        R[j] = *(const v4u*)(ws + off); }
#else
        asm volatile("global_load_dwordx4 %0, %1, %2" : "=v"(R[j]) : "v"(off), "s"(ws) : "memory"); }
#endif
}
#ifdef SC_PLAIN_LOADS
#define SC_WAIT(R, n) do {} while (0)
#else
#define SC_WAIT(R, n) asm volatile("s_waitcnt vmcnt(" #n ")" : "+v"(R[0]), "+v"(R[1]), "+v"(R[2]), "+v"(R[3]), "+v"(R[4]), "+v"(R[5]), "+v"(R[6]), "+v"(R[7]), "+v"(R[8]), "+v"(R[9]), "+v"(R[10]) :: "memory")
#endif
DI void sc_write(const v4u (&R)[SC_NCH], LAS unsigned char* slot, int lid) {
#pragma unroll
    for (int j = 0; j < SC_NCH; ++j) *(LAS v4u*)(slot + 16 * (lid + 448 * j)) = R[j];
}
DI void p4_scan(Frame& F) {
    const int lane = F.lane, n16 = lane & 15, g = lane >> 4, wave = F.wave;
    {
        volatile LAS int* tsk = (volatile LAS int*)(F.lds + MISC_OFF + 32);
        if (F.tid == 0) {
            unsigned* q = (unsigned*)(F.ws + WS_CTL) + CW_SCANQ; const unsigned xcc = xb_xcc_id() & 7u; int task = -1;
            for (unsigned t = 0; t < 8 && task < 0; ++t) { const unsigned y = (xcc + t) & 7u; const unsigned j = xb_add(q + 64 * y, 1u); if (j < 16u) task = (int)(y * 16 + j); }
            *tsk = task; if (task < 0) tsk[1] = (int)xb_add(q + 64 * 8, 1u);
        }
        __syncthreads();
    }
    const int task = *(volatile LAS int*)(F.lds + MISC_OFF + 32);
    if (task < 0) {
        if (F.G > 128) { const int cgw = *(volatile LAS int*)(F.lds + MISC_OFF + 36) * NWAVES + wave, cng = (F.G - 128) * NWAVES; small_weights(F, cgw, cng); moe_weights(F, *(volatile LAS int*)(F.lds + MISC_OFF + 36), F.G - 128); }
        return; }
    const int chain = 2 * (task >> 4) + ((task & 15) >> 3), e = task & 7;
    const int bh = chain >> 1, dir = chain & 1, b = bh >> 2, h = bh & 3;
    LAS unsigned char* lds = opaque(F.lds);
    if (wave != 0) {
        const int lid = (wave - 1) * 64 + lane;
        const unsigned sh0 = (unsigned)(WS_GSH + (size_t)(bh * 128) * GDN_SH_BYTES), d0 = (unsigned)(WS_GD + (size_t)((bh * 2 + dir) * 128) * GDN_D_BYTES);
        unsigned delta[SC_NCH], dmask[SC_NCH];
#pragma unroll
        for (int j = 0; j < SC_NCH; ++j) { const int c = lid + 448 * j;
            delta[j] = (c < 3328) ? 16u * c : ((c < 3472) ? (unsigned)(G_VCT + 16 * e * 144 + 16 * (c - 3328)) : 16u * (c - 3472));
            dmask[j] = (c < 3472) ? 0u : 0xffffffffu; }
        v4u R0[SC_NCH], R1[SC_NCH], R2[SC_NCH];
#define SC_SRC(st) const int n_ = (dir == 0) ? ((st) < 128 ? (st) : 127) : ((st) < 128 ? 127 - (st) : 0); \
                   const unsigned shb_ = sh0 + (unsigned)n_ * (unsigned)GDN_SH_BYTES, ddf_ = (d0 + (unsigned)n_ * (unsigned)GDN_D_BYTES) - shb_;
        { SC_SRC(0) sc_issue(R0, F.ws, delta, dmask, shb_, ddf_); }
        { SC_SRC(1) sc_issue(R1, F.ws, delta, dmask, shb_, ddf_); }
        { SC_SRC(2) sc_issue(R2, F.ws, delta, dmask, shb_, ddf_); }
#define SC_BODY(R, st) { SC_WAIT(R, 22); sc_write(R, lds + ((st) & 1) * SC_SLOT, lid); { SC_SRC((st) + 3) sc_issue(R, F.ws, delta, dmask, shb_, ddf_); } \
                        asm volatile("s_waitcnt lgkmcnt(0)" ::: "memory"); __builtin_amdgcn_s_barrier(); }
#pragma unroll 1
        for (int s0 = 0; s0 < 126; s0 += 3) { SC_BODY(R0, s0) SC_BODY(R1, s0 + 1) SC_BODY(R2, s0 + 2) }
        SC_BODY(R0, 126) SC_BODY(R1, 127)
        SC_WAIT(R0, 0); SC_WAIT(R1, 0); SC_WAIT(R2, 0);
#undef SC_BODY
#undef SC_SRC
        return;
    }
    bf16* Odir = (bf16*)((unsigned char*)F.out + (dir == 0 ? DO_OF : DO_OB));
    f32x4 S[8];
#pragma unroll
    for (int i = 0; i < 8; ++i) S[i] = (f32x4){0.f, 0.f, 0.f, 0.f};
    bf16x8 Sb[4];
#pragma unroll
    for (int i = 0; i < 4; ++i) Sb[i] = (bf16x8){0, 0, 0, 0, 0, 0, 0, 0};
    const unsigned aoff272 = n16 * 272 + g * 16, aoff144 = n16 * 144 + g * 16;
    const unsigned lds0 = (unsigned)(uintptr_t)lds;
#define SB_() __builtin_amdgcn_sched_barrier(0)
#define LDR128(dst, base, off) asm volatile("ds_read_b128 %0, %1 offset:%2" : "=v"(dst) : "v"(base), "i"(off) : "memory")
#define LDR64(dst, base, off) asm volatile("ds_read_b64 %0, %1 offset:%2" : "=v"(dst) : "v"(base), "i"(off) : "memory")
#define LDR32(dst, base, off) asm volatile("ds_read_b32 %0, %1 offset:%2" : "=v"(dst) : "v"(base), "i"(off) : "memory")
#pragma unroll 1
    for (int step = 0; step < 128; ++step) {
        __builtin_amdgcn_s_barrier();
        asm volatile("" ::: "memory");
        const int n = dir == 0 ? step : 127 - step;
        const unsigned slot = lds0 + (unsigned)(step & 1) * SC_SLOT;
        const unsigned bK = slot + G_KNP + aoff272, bQ = slot + G_QNP + aoff272, bKT = slot + G_KNTP + aoff144, bT = slot + SC_D + GD_TBP + aoff144;
        const unsigned bV = slot + SC_VCT + n16 * 144 + g * 8, bvec = slot + SC_D + GD_VEC + g * 16, bd = slot + SC_D + GD_VEC;
        f32x4 eG[4], ks[4]; v2u vv[4]; float dch; bf16x8 fa[16];
        LDR128(eG[0], bvec, 0); LDR128(eG[1], bvec, 64); LDR128(eG[2], bvec, 128); LDR128(eG[3], bvec, 192);
        LDR128(ks[0], bvec, 256); LDR128(ks[1], bvec, 320); LDR128(ks[2], bvec, 384); LDR128(ks[3], bvec, 448);
        LDR32(dch, bd, 512);
        LDR64(vv[0], bV, 0); LDR64(vv[1], bV, 32); LDR64(vv[2], bV, 64); LDR64(vv[3], bV, 96);
#pragma unroll
        for (int m = 0; m < 4; ++m) { LDR128(fa[m * 4 + 0], bK, m * 4352 + 0); LDR128(fa[m * 4 + 1], bK, m * 4352 + 64); LDR128(fa[m * 4 + 2], bK, m * 4352 + 128); LDR128(fa[m * 4 + 3], bK, m * 4352 + 192); }
        bf16x8 fq[16];
#pragma unroll
        for (int m = 0; m < 4; ++m) { LDR128(fq[m * 4 + 0], bQ, m * 4352 + 0); LDR128(fq[m * 4 + 1], bQ, m * 4352 + 64); LDR128(fq[m * 4 + 2], bQ, m * 4352 + 128); LDR128(fq[m * 4 + 3], bQ, m * 4352 + 192); }
        asm volatile("s_waitcnt lgkmcnt(15)" : "+v"(eG[0]), "+v"(eG[1]), "+v"(eG[2]), "+v"(eG[3]), "+v"(ks[0]), "+v"(ks[1]), "+v"(ks[2]), "+v"(ks[3]), "+v"(dch), "+v"(vv[0]), "+v"(vv[1]), "+v"(vv[2]), "+v"(vv[3]),
                     "+v"(fa[0]), "+v"(fa[1]), "+v"(fa[2]), "+v"(fa[3]), "+v"(fa[4]), "+v"(fa[5]), "+v"(fa[6]), "+v"(fa[7]), "+v"(fa[8]), "+v"(fa[9]), "+v"(fa[10]), "+v"(fa[11]), "+v"(fa[12]), "+v"(fa[13]), "+v"(fa[14]), "+v"(fa[15]) :: "memory");
        SB_();
        f32x4 KS[4];
#pragma unroll
        for (int m = 0; m < 4; ++m) KS[m] = (f32x4){0.f, 0.f, 0.f, 0.f};
#pragma unroll
        for (int i = 0; i < 4; ++i)
#pragma unroll
            for (int m = 0; m < 4; ++m) KS[m] = __builtin_amdgcn_mfma_f32_16x16x32_bf16(fa[m * 4 + i], Sb[i], KS[m], 0, 0, 0);
        SB_();
        bf16x8 ft[8];
#pragma unroll
        for (int m = 0; m < 4; ++m) { LDR128(ft[m * 2 + 0], bT, m * 2304 + 0); LDR128(ft[m * 2 + 1], bT, m * 2304 + 64); }
        asm volatile("s_waitcnt lgkmcnt(8)" : "+v"(fq[0]), "+v"(fq[1]), "+v"(fq[2]), "+v"(fq[3]), "+v"(fq[4]), "+v"(fq[5]), "+v"(fq[6]), "+v"(fq[7]), "+v"(fq[8]), "+v"(fq[9]), "+v"(fq[10]), "+v"(fq[11]), "+v"(fq[12]), "+v"(fq[13]), "+v"(fq[14]), "+v"(fq[15]) :: "memory");
        SB_();
        f32x4 o[4];
#pragma unroll
        for (int m = 0; m < 4; ++m) o[m] = (f32x4){0.f, 0.f, 0.f, 0.f};
#pragma unroll
        for (int i = 0; i < 4; ++i)
#pragma unroll
            for (int m = 0; m < 4; ++m) o[m] = __builtin_amdgcn_mfma_f32_16x16x32_bf16(fq[m * 4 + i], Sb[i], o[m], 0, 0, 0);
        f32x4 rr[4];
#pragma unroll
        for (int m = 0; m < 4; ++m) { rr[m][0] = bflo(vv[m].x) - eG[m][0] * KS[m][0]; rr[m][1] = bfhi(vv[m].x) - eG[m][1] * KS[m][1]; rr[m][2] = bflo(vv[m].y) - eG[m][2] * KS[m][2]; rr[m][3] = bfhi(vv[m].y) - eG[m][3] * KS[m][3]; }
        bf16x8 rb[2]; rb[0] = pack8(rr[0], rr[1]); rb[1] = pack8(rr[2], rr[3]);
        SB_();
        bf16x8 fk[16];
#pragma unroll
        for (int jt = 0; jt < 8; ++jt) { LDR128(fk[jt * 2 + 0], bKT, jt * 2304 + 0); LDR128(fk[jt * 2 + 1], bKT, jt * 2304 + 64); }
        asm volatile("s_waitcnt lgkmcnt(15)" : "+v"(ft[0]), "+v"(ft[1]), "+v"(ft[2]), "+v"(ft[3]), "+v"(ft[4]), "+v"(ft[5]), "+v"(ft[6]), "+v"(ft[7]) :: "memory");
        SB_();
        f32x4 vn[4];
#pragma unroll
        for (int m = 0; m < 4; ++m) vn[m] = (f32x4){0.f, 0.f, 0.f, 0.f};
#pragma unroll
        for (int i = 0; i < 2; ++i)
#pragma unroll
            for (int m = 0; m < 4; ++m) vn[m] = __builtin_amdgcn_mfma_f32_16x16x32_bf16(ft[m * 2 + i], rb[i], vn[m], 0, 0, 0);
#pragma unroll
        for (int m = 0; m < 4; ++m) o[m] = o[m] * eG[m];
#pragma unroll
        for (int jt = 0; jt < 8; ++jt) S[jt] = S[jt] * dch;
        SB_();
        bf16x8 fp[8];
#pragma unroll
        for (int m = 0; m < 4; ++m) { LDR128(fp[m * 2 + 0], bT, GD_AP + m * 2304 + 0); LDR128(fp[m * 2 + 1], bT, GD_AP + m * 2304 + 64); }
        bf16x8 vnb[2]; vnb[0] = pack8(vn[0], vn[1]); vnb[1] = pack8(vn[2], vn[3]);
        bf16x8 vs[2]; vs[0] = pack8(vn[0] * ks[0], vn[1] * ks[1]); vs[1] = pack8(vn[2] * ks[2], vn[3] * ks[3]);
        asm volatile("s_waitcnt lgkmcnt(8)" : "+v"(fk[0]), "+v"(fk[1]), "+v"(fk[2]), "+v"(fk[3]), "+v"(fk[4]), "+v"(fk[5]), "+v"(fk[6]), "+v"(fk[7]), "+v"(fk[8]), "+v"(fk[9]), "+v"(fk[10]), "+v"(fk[11]), "+v"(fk[12]), "+v"(fk[13]), "+v"(fk[14]), "+v"(fk[15]) :: "memory");
        SB_();
#pragma unroll
        for (int i = 0; i < 2; ++i)
#pragma unroll
            for (int jt = 0; jt < 8; ++jt) S[jt] = __builtin_amdgcn_mfma_f32_16x16x32_bf16(fk[jt * 2 + i], vs[i], S[jt], 0, 0, 0);
        asm volatile("s_waitcnt lgkmcnt(0)" : "+v"(fp[0]), "+v"(fp[1]), "+v"(fp[2]), "+v"(fp[3]), "+v"(fp[4]), "+v"(fp[5]), "+v"(fp[6]), "+v"(fp[7]) :: "memory");
#pragma unroll
        for (int i = 0; i < 2; ++i)
#pragma unroll
            for (int m = 0; m < 4; ++m) o[m] = __builtin_amdgcn_mfma_f32_16x16x32_bf16(fp[m * 2 + i], vnb[i], o[m], 0, 0, 0);
#pragma unroll
        for (int i = 0; i < 4; ++i) Sb[i] = pack8(S[2 * i], S[2 * i + 1]);
        SB_();
        bf16* op = Odir + (size_t)(b * SEQ + n * 64) * 512 + h * 128 + 16 * e + n16;
#pragma unroll
        for (int m = 0; m < 4; ++m)
#pragma unroll
            for (int r = 0; r < 4; ++r) op[(size_t)(16 * m + 4 * g + r) * 512] = (bf16)(pk2(o[m][r], 0.f) & 0xffffu);
    }
#undef SB_
#undef LDR128
#undef LDR64
#undef LDR32
}

DI void p5_combine(Frame& F) {
    const int gw = F.vcu * NWAVES + F.wave, NGW = F.G * NWAVES, lane = F.lane;
    const bf16* OFp = (const bf16*)((unsigned char*)F.out + DO_OF); const bf16* OBp = (const bf16*)((unsigned char*)F.out + DO_OB);
    const bf16* ZA = (const bf16*)(F.ws + WS_ZA); bf16* OCAT = (bf16*)(F.ws + WS_OCAT);
    const float* nw = F.in[6] + (lane & 15) * 8;
    float w8[8];
#pragma unroll
    for (int c = 0; c < 8; ++c) w8[c] = nw[c];
    constexpr int NB4 = 4;
    for (int t0 = gw; t0 < TT; t0 += NB4 * NGW) {
        v4u a[NB4], bb[NB4], z[NB4];
#pragma unroll
        for (int u = 0; u < NB4; ++u) { const int t = (t0 + u * NGW < TT) ? t0 + u * NGW : t0;
            a[u] = *(const v4u*)(OFp + (size_t)t * 512 + lane * 8); bb[u] = *(const v4u*)(OBp + (size_t)t * 512 + lane * 8); z[u] = *(const v4u*)(ZA + (size_t)t * 512 + lane * 8); }
#pragma unroll
        for (int u = 0; u < NB4; ++u) {
            const int t = t0 + u * NGW; if (t >= TT) break;
            float o[8] = {bflo(a[u].x) + bflo(bb[u].x), bfhi(a[u].x) + bfhi(bb[u].x), bflo(a[u].y) + bflo(bb[u].y), bfhi(a[u].y) + bfhi(bb[u].y), bflo(a[u].z) + bflo(bb[u].z), bfhi(a[u].z) + bfhi(bb[u].z), bflo(a[u].w) + bflo(bb[u].w), bfhi(a[u].w) + bfhi(bb[u].w)};
            const float zz[8] = {bflo(z[u].x), bfhi(z[u].x), bflo(z[u].y), bfhi(z[u].y), bflo(z[u].z), bfhi(z[u].z), bflo(z[u].w), bfhi(z[u].w)};
            float ss = 0.f;
#pragma unroll
            for (int c = 0; c < 8; ++c) ss += o[c] * o[c];
            ss = sum16(ss);
            const float rn = __builtin_amdgcn_rsqf(ss * (1.f / 128.f) + EPS);
#pragma unroll
            for (int c = 0; c < 8; ++c) o[c] = o[c] * rn * w8[c] * siluf(zz[c]);
            v4u r; r.x = pk2(o[0], o[1]); r.y = pk2(o[2], o[3]); r.z = pk2(o[4], o[5]); r.w = pk2(o[6], o[7]);
            *(v4u*)(OCAT + (size_t)t * 1024 + lane * 8) = r;
        }
    }
}

struct TokRec { int e[2]; int row[2]; float gate[2]; };
DI void p7_route(Frame& F) {
    const int lane = F.lane, n16 = lane & 15, g = lane >> 4, wave = F.wave;
    const float* X1 = (const float*)(F.ws + WS_X1); const float* nfw = F.in[10];
    const bf16* WRH = (const bf16*)(F.ws + WS_WR); const bf16* WRL = WRH + 48 * 1024;
    unsigned char* HN = (unsigned char*)F.out + DO_HN; TokRec* TOK = (TokRec*)(F.ws + WS_TOK); unsigned* gcnt = (unsigned*)(F.ws + WS_CTL) + CW_CNT; int* LIST = (int*)(F.ws + WS_LIST);
    LAS float* lg = (LAS float*)(F.lds + (wave & 3) * 4096);
    LAS unsigned* hist = (LAS unsigned*)(F.lds + 16384); LAS unsigned* base = hist + 32;
    const int sub = blockIdx.x & 7;
    const float qsc = 127.0f / act_absmax(nfw, lane);
    for (int rt0 = blockIdx.x * 4; rt0 < TT / 16; rt0 += F.G * 4) {
        if (F.tid < 32) hist[F.tid] = 0u;
        __syncthreads();
        int ex1 = 0, ex2 = 0, tok = -1; unsigned l1 = 0, l2 = 0; float g1 = 0.f, g2 = 0.f;
        const int rt = rt0 + wave;
        if (wave < 4 && rt < TT / 16) {
            const int row = rt * 16 + n16; const float* xr = X1 + (size_t)row * DMODEL + 8 * g;
            float ss = 0.f;
#pragma unroll 16
            for (int i = 0; i < 32; ++i) { const f32x4 a = *(const f32x4*)(xr + 32 * i), b2 = *(const f32x4*)(xr + 32 * i + 4);
                ss += (a.x * a.x + a.y * a.y) + (a.z * a.z + a.w * a.w) + (b2.x * b2.x + b2.y * b2.y) + (b2.z * b2.z + b2.w * b2.w); }
            ss = sum_x32(sum_x16(ss));
            const float rs = __builtin_amdgcn_rsqf(ss * (1.f / DMODEL) + EPS);
            f32x4 acc[3];
#pragma unroll
            for (int q = 0; q < 3; ++q) acc[q] = (f32x4){0.f, 0.f, 0.f, 0.f};
#pragma unroll 4
            for (int i = 0; i < 32; ++i) {
                const f32x4 a = *(const f32x4*)(xr + 32 * i), b2 = *(const f32x4*)(xr + 32 * i + 4);
                const f32x4 wa = *(const f32x4*)(nfw + 32 * i + 8 * g), wb = *(const f32x4*)(nfw + 32 * i + 8 * g + 4);
                float hv[8] = {a.x * rs * wa.x, a.y * rs * wa.y, a.z * rs * wa.z, a.w * rs * wa.w, b2.x * rs * wb.x, b2.y * rs * wb.y, b2.z * rs * wb.z, b2.w * rs * wb.w};
                v4u hi, lo;
                hi.x = pk2(hv[0], hv[1]); hi.y = pk2(hv[2], hv[3]); hi.z = pk2(hv[4], hv[5]); hi.w = pk2(hv[6], hv[7]);
                lo.x = pk2(hv[0] - bflo(hi.x), hv[1] - bfhi(hi.x)); lo.y = pk2(hv[2] - bflo(hi.y), hv[3] - bfhi(hi.y));
                lo.z = pk2(hv[4] - bflo(hi.z), hv[5] - bfhi(hi.z)); lo.w = pk2(hv[6] - bflo(hi.w), hv[7] - bfhi(hi.w));
                { v2u q; q.x = q8x4(hv[0], hv[1], hv[2], hv[3], qsc); q.y = q8x4(hv[4], hv[5], hv[6], hv[7], qsc); *(v2u*)(HN + (size_t)row * DMODEL + 32 * i + 8 * g) = q; }
                const bf16x8 ah = __builtin_bit_cast(bf16x8, hi), al = __builtin_bit_cast(bf16x8, lo);
#pragma unroll
                for (int q = 0; q < 3; ++q) {
                    const bf16x8 bh = *(const bf16x8*)(WRH + (size_t)(16 * q + n16) * 1024 + 32 * i + 8 * g), bl = *(const bf16x8*)(WRL + (size_t)(16 * q + n16) * 1024 + 32 * i + 8 * g);
                    acc[q] = __builtin_amdgcn_mfma_f32_16x16x32_bf16(ah, bh, acc[q], 0, 0, 0);
                    acc[q] = __builtin_amdgcn_mfma_f32_16x16x32_bf16(ah, bl, acc[q], 0, 0, 0);
                    acc[q] = __builtin_amdgcn_mfma_f32_16x16x32_bf16(al, bh, acc[q], 0, 0, 0);
                }
            }
#pragma unroll
            for (int q = 0; q < 3; ++q)
#pragma unroll
                for (int r = 0; r < 4; ++r) lg[(4 * g + r) * 48 + 16 * q + n16] = acc[q][r];
            asm volatile("s_waitcnt lgkmcnt(0)" ::: "memory");
            if (lane < 16) {
                const LAS float* L = lg + lane * 48; tok = rt * 16 + lane;
                float gm = L[0]; int gs = 0;
#pragma unroll
                for (int q = 1; q < 4; ++q) if (L[q] > gm) { gm = L[q]; gs = q; }
                float gsum = 0.f;
#pragma unroll
                for (int q = 0; q < 4; ++q) gsum += __expf(L[q] - gm);
                const float gp_top = 1.0f / gsum;
                float fv[8];
#pragma unroll
                for (int q = 0; q < 8; ++q) { float v = L[4 + q]; v = (gs == 1) ? L[12 + q] : v; v = (gs == 2) ? L[20 + q] : v; v = (gs == 3) ? L[28 + q] : v; fv[q] = v; }
                float m1 = fv[0]; int i1 = 0;
#pragma unroll
                for (int q = 1; q < 8; ++q) if (fv[q] > m1) { m1 = fv[q]; i1 = q; }
                float m2 = -3.0e38f; int i2 = 0;
#pragma unroll
                for (int q = 0; q < 8; ++q) if (q != i1 && fv[q] > m2) { m2 = fv[q]; i2 = q; }
                const float e2 = __expf(m2 - m1); g1 = gp_top / (1.0f + e2); g2 = gp_top * e2 / (1.0f + e2);
                ex1 = gs * 8 + i1; ex2 = gs * 8 + i2;
                l1 = __hip_atomic_fetch_add(hist + ex1, 1u, __ATOMIC_RELAXED, __HIP_MEMORY_SCOPE_WORKGROUP); l2 = __hip_atomic_fetch_add(hist + ex2, 1u, __ATOMIC_RELAXED, __HIP_MEMORY_SCOPE_WORKGROUP);
            }
        }
        __syncthreads();
        if (F.tid < 32) { const unsigned hcount = hist[F.tid]; base[F.tid] = hcount ? atomicAdd(gcnt + F.tid * 8 + sub, hcount) : 0u; }
        __syncthreads();
        if (tok >= 0) {
            const int s1 = (int)(base[ex1] + l1), s2 = (int)(base[ex2] + l2);
            LIST[(size_t)(ex1 * 8 + sub) * TT + s1] = tok; LIST[(size_t)(ex2 * 8 + sub) * TT + s2] = tok;
            TokRec tr; tr.e[0] = ex1; tr.e[1] = ex2; tr.row[0] = (sub << 24) | s1; tr.row[1] = (sub << 24) | s2; tr.gate[0] = g1; tr.gate[1] = g2;
            TOK[tok] = tr;
        }
    }
}

DI void build_etab(Frame& F) {
    LAS unsigned* etab = (LAS unsigned*)(F.lds + ETAB_OFF);
    if (F.tid < 32) {
        const unsigned* gcnt = (const unsigned*)(F.ws + WS_CTL) + CW_CNT + F.tid * 8; unsigned acc = 0;
#pragma unroll
        for (int q = 0; q < 8; ++q) { const unsigned c = __hip_atomic_load(gcnt + q, __ATOMIC_RELAXED, __HIP_MEMORY_SCOPE_AGENT); etab[96 + 8 * F.tid + q] = acc; acc += c; }
        etab[64 + F.tid] = acc; etab[2 * F.tid + 1] = (acc + 255u) >> 8;
    }
    __syncthreads();
    if (F.tid == 0) { unsigned acc = 0; for (int e = 0; e < NEXP; ++e) { etab[2 * e] = acc; acc += etab[2 * e + 1]; } }
    if (F.wave == 1) { const float am = act_absmax(F.in[10], F.lane); if (F.lane == 0) ((LAS float*)etab)[352] = am * (1.0f / 127.0f); }
    __syncthreads();
}

DI void p11_final(Frame& F) {
    build_etab(F);
    const LAS unsigned* etab = (const LAS unsigned*)(F.lds + ETAB_OFF);
    const int gw = F.vcu * NWAVES + F.wave, NGW = F.G * NWAVES, lane = F.lane;
    const bf16* Y = (const bf16*)(F.ws + WS_XBUF); const TokRec* TOK = (const TokRec*)(F.ws + WS_TOK); const float* fw = F.in[16];
    const f32x4 w0 = *(const f32x4*)(fw + lane * 8), w1 = *(const f32x4*)(fw + lane * 8 + 4), w2 = *(const f32x4*)(fw + 512 + lane * 8), w3 = *(const f32x4*)(fw + 516 + lane * 8);
    constexpr int NB2 = 2;
    for (int t0 = gw; t0 < TT; t0 += NB2 * NGW) {
        TokRec tr[NB2]; f32x4 xa[NB2][4]; v4u ya[NB2][2][2];
#pragma unroll
        for (int u = 0; u < NB2; ++u) { const int t = (t0 + u * NGW < TT) ? t0 + u * NGW : t0; tr[u] = TOK[t];
            const float* xr = (const float*)(F.ws + WS_X1) + (size_t)t * DMODEL + lane * 8;
            xa[u][0] = *(const f32x4*)(xr); xa[u][1] = *(const f32x4*)(xr + 4); xa[u][2] = *(const f32x4*)(xr + 512); xa[u][3] = *(const f32x4*)(xr + 516); }
#pragma unroll
        for (int u = 0; u < NB2; ++u)
#pragma unroll
            for (int k = 0; k < 2; ++k) { const unsigned rk = (unsigned)tr[u].row[k]; const bf16* yr = Y + (size_t)(etab[2 * tr[u].e[k]] * 256u + etab[96 + 8 * tr[u].e[k] + (rk >> 24)] + (rk & 0xffffffu)) * DMODEL + lane * 8; ya[u][k][0] = *(const v4u*)(yr); ya[u][k][1] = *(const v4u*)(yr + 512); }
#pragma unroll
        for (int u = 0; u < NB2; ++u) {
            const int t = t0 + u * NGW; if (t >= TT) break;
            float v[16] = {xa[u][0].x, xa[u][0].y, xa[u][0].z, xa[u][0].w, xa[u][1].x, xa[u][1].y, xa[u][1].z, xa[u][1].w, xa[u][2].x, xa[u][2].y, xa[u][2].z, xa[u][2].w, xa[u][3].x, xa[u][3].y, xa[u][3].z, xa[u][3].w};
#pragma unroll
            for (int k = 0; k < 2; ++k) {
                const float gk = tr[u].gate[k]; const v4u y0 = ya[u][k][0], y1 = ya[u][k][1];
                v[0] += gk * bflo(y0.x); v[1] += gk * bfhi(y0.x); v[2] += gk * bflo(y0.y); v[3] += gk * bfhi(y0.y); v[4] += gk * bflo(y0.z); v[5] += gk * bfhi(y0.z); v[6] += gk * bflo(y0.w); v[7] += gk * bfhi(y0.w);
                v[8] += gk * bflo(y1.x); v[9] += gk * bfhi(y1.x); v[10] += gk * bflo(y1.y); v[11] += gk * bfhi(y1.y); v[12] += gk * bflo(y1.z); v[13] += gk * bfhi(y1.z); v[14] += gk * bflo(y1.w); v[15] += gk * bfhi(y1.w);
            }
            float ss = 0.f;
#pragma unroll
            for (int i = 0; i < 16; ++i) ss += v[i] * v[i];
            const float rs = __builtin_amdgcn_rsqf(wave_sum(ss) * (1.f / DMODEL) + EPS);
            float* orow = F.out + (size_t)t * DMODEL + lane * 8;
            *(f32x4*)(orow) = (f32x4){v[0] * rs * w0.x, v[1] * rs * w0.y, v[2] * rs * w0.z, v[3] * rs * w0.w};
            *(f32x4*)(orow + 4) = (f32x4){v[4] * rs * w1.x, v[5] * rs * w1.y, v[6] * rs * w1.z, v[7] * rs * w1.w};
            *(f32x4*)(orow + 512) = (f32x4){v[8] * rs * w2.x, v[9] * rs * w2.y, v[10] * rs * w2.z, v[11] * rs * w2.w};
            *(f32x4*)(orow + 516) = (f32x4){v[12] * rs * w3.x, v[13] * rs * w3.y, v[14] * rs * w3.z, v[15] * rs * w3.w};
        }
    }
}

struct Args { const float* in[17]; float* out; unsigned char* ws; int ph_lo, ph_hi; };
__global__ void __launch_bounds__(NTHREADS, 2) fwd_kernel(Args args) {
    extern __shared__ __attribute__((aligned(16))) unsigned char lds[];
    cg::grid_group grid = cg::this_grid();
    Frame F;
    F.lds = (LAS unsigned char*)lds; F.tid = threadIdx.x; F.lane = F.tid & 63; F.wave = __builtin_amdgcn_readfirstlane(F.tid >> 6);
    F.G = gridDim.x; { const int bx = blockIdx.x; F.vcu = (F.G % 8 == 0) ? (bx % 8) * (F.G / 8) + bx / 8 : bx; }
#pragma unroll
    for (int i = 0; i < 17; ++i) F.in[i] = args.in[i];
    F.out = args.out; F.ws = args.ws;
    const int lo = args.ph_lo, hi = args.ph_hi;
    if (F.tid < 16) ((volatile LAS unsigned*)(F.lds + MISC_OFF))[F.tid] = 0u;
    __syncthreads();
    XcdBarrier bar = xcd_barrier_post((unsigned*)(F.ws + WS_CTL) + CW_BAR, (volatile LAS unsigned*)(F.lds + MISC_OFF));
    if (lo > 1000) grid.sync();
#ifndef PHSEL
#define PHSEL 0xfff
#endif
#define IN(k) (((PHSEL >> (k)) & 1) && lo <= (k) && (k) < hi)
#define SEAM(k) do { if (IN(k) && IN((k) + 1)) xcd_barrier(bar); } while (0)
#ifndef REP_PH
#define REP_PH -1
#endif
#define REPS(k) for (int rep_ = 0; rep_ < ((k) == REP_PH ? 2 : 1); ++rep_, ((k) == REP_PH && rep_ < 2) ? xcd_barrier(bar) : (void)0)
    if (IN(0)) REPS(0) { p0_prologue(F); } SEAM(0);
    if (IN(1)) REPS(1) {
        pg8::Gemm gm{(const pg8::bf16_t*)(F.ws + WS_XN), (const pg8::bf16_t*)(F.ws + WS_WIN), TT, NPROJ, DMODEL / 2};
        pg8::StaticOrder S; S.init(TT, NPROJ, F.G, (int)blockIdx.x);
        EpiProj E{(bf16*)(F.ws + WS_QKVA), (bf16*)(F.ws + WS_ZA), (bf16*)(F.ws + WS_QKVB), (const float*)(F.ws + WS_WSI), (const float*)(F.ws + WS_XSC)};
        pg8::gemm_phase_gather<EpiProj, pg8::StaticOrder, IdRows, true, true>(F.lds, gm, S, E, IdRows{});
    } SEAM(1);
    if (IN(2)) REPS(2) {
#ifndef NO_ROPE
        p2_rope(F);
#ifdef PROBE_ROPE2
        xcd_barrier(bar); p2_rope(F);
#endif
#endif
#ifndef NO_PRE
        p2_gdn_pre(F);
#ifdef PROBE_PRE2
        xcd_barrier(bar); p2_gdn_pre(F);
#endif
#endif
    } SEAM(2);
    if (IN(3)) REPS(3) {
        const attn_body::AttnTensors AT{(const attn_body::bf16*)((unsigned char*)F.out + DO_QR), (const attn_body::bf16*)((unsigned char*)F.out + DO_KR), (const attn_body::bf16*)((unsigned char*)F.out + DO_VR),
                                        (attn_body::bf16*)(F.ws + WS_OCAT) + 512};
        const attn_body::StaticOrder S((int)F.G, (int)blockIdx.x);
#ifdef PROBE_ZERO_ATTN
        { (void)AT; (void)S; bf16* OC = (bf16*)(F.ws + WS_OCAT); const int gt = blockIdx.x * NTHREADS + F.tid, GT = F.G * NTHREADS;
          for (int i = gt; i < TT * 64; i += GT) { const int t = i >> 6, c = i & 63; *(v4u*)(OC + (size_t)t * 1024 + 512 + c * 8) = (v4u){0u, 0u, 0u, 0u}; } }
#else
        const float nshift = -(0.125f * 1.4426950408889634f * 64.f * 1.01f) * wave_max(fabsf(F.in[7][F.lane])) * wave_max(fabsf(F.in[8][F.lane]));
        attn_body::attn_phase<attn_body::StaticOrder>((char*)lds, AT, S, nshift);
#endif
    } SEAM(3);
#ifdef PROBE_SCAN2
    if (IN(4)) { p4_scan(F); xcd_barrier(bar); p4_scan(F); } SEAM(4);
#else
    if (IN(4)) REPS(4) { p4_scan(F); } SEAM(4);
#endif
    if (IN(5)) REPS(5) { p5_combine(F); if (F.G <= 128) { small_weights(F, F.vcu * NWAVES + F.wave, F.G * NWAVES); moe_weights(F, F.vcu, F.G); } } SEAM(5);
    if (IN(6)) REPS(6) {
        pg8::Gemm gm{(const pg8::bf16_t*)(F.ws + WS_OCAT), (const pg8::bf16_t*)(F.ws + WS_WOUT), TT, DMODEL, DMODEL}; pg8::StaticOrder S; S.init(TT, DMODEL, F.G, (int)blockIdx.x);
        EpiResid E{F.in[0], (float*)(F.ws + WS_X1)};
        pg8::gemm_phase<EpiResid, pg8::StaticOrder, true, true>(F.lds, gm, S, E);
    } SEAM(6);
    if (IN(7)) { p7_route(F); } SEAM(7);
    if (IN(9)) REPS(9) {
        build_etab(F);
        pg8::Gemm gm{(const pg8::bf16_t*)((unsigned char*)F.out + DO_HN), (const pg8::bf16_t*)(F.ws + WS_WGU0), 0, 0, DMODEL / 2};
        MoeOrder S{(const LAS unsigned*)(F.lds + ETAB_OFF), F.G, (int)blockIdx.x, WGU_SPLIT, (int)((WS_WGU1 - WS_WGU0) / (256 * 1024))};
        MoeRows AM{(const int*)(F.ws + WS_LIST), (const LAS unsigned*)(F.lds + ETAB_OFF)};
        EpiGU E{(bf16*)(F.ws + WS_HID), (const float*)(F.ws + WS_WSC), ((const LAS float*)(F.lds + ETAB_OFF))[352]};
        pg8::gemm_phase_gather<EpiGU, MoeOrder, MoeRows, true, true>(F.lds, gm, S, E, AM);
    } SEAM(9);
    if (IN(10)) REPS(10) {
        pg8::Gemm gm{(const pg8::bf16_t*)(F.ws + WS_HID), (const pg8::bf16_t*)((unsigned char*)F.out + DO_WD0), 0, 0, FFE}; build_etab(F); MoeOrder S{(const LAS unsigned*)(F.lds + ETAB_OFF), F.G, (int)blockIdx.x, WD_SPLIT, (int)((DO_WD1 - DO_WD0) / (256 * 1024))};
        EpiY E{(bf16*)(F.ws + WS_XBUF)};
        pg8::gemm_phase<EpiY, MoeOrder, true, true>(F.lds, gm, S, E);
    } SEAM(10);
#ifdef EXTRA_SYNCS
    for (int q_ = 0; q_ < EXTRA_SYNCS; ++q_) xcd_barrier(bar);
#endif
    if (IN(11)) { p11_final(F); }
#undef IN
#undef SEAM
}

extern "C" void kernel_launch(void* const* d_in, const int* in_sizes, int n_in, void* d_out, int out_size, void* d_ws, size_t ws_size, hipStream_t stream) {
    static int grid = 0;
    if (grid == 0) {
        if (n_in != 17 || out_size != TT * DMODEL || ws_size < WS_END) { fprintf(stderr, "kernel_launch: unexpected problem (n_in %d out %d ws %zu)\n", n_in, out_size, ws_size); grid = -1; return; }
        int dev = 0, cus = 0, per_cu = 0;
        if (hipGetDevice(&dev) != hipSuccess || hipDeviceGetAttribute(&cus, hipDeviceAttributeMultiprocessorCount, dev) != hipSuccess) { grid = -1; return; }
        if (hipFuncSetAttribute((const void*)fwd_kernel, hipFuncAttributeMaxDynamicSharedMemorySize, LDS_BYTES) != hipSuccess) { fprintf(stderr, "hipFuncSetAttribute failed\n"); grid = -1; return; }
        if (hipOccupancyMaxActiveBlocksPerMultiprocessor(&per_cu, (const void*)fwd_kernel, NTHREADS, LDS_BYTES) != hipSuccess || per_cu < 1) { fprintf(stderr, "occupancy query: %d\n", per_cu); grid = -1; return; }
        grid = cus;
    }
    if (grid < 0) return;
    (void)hipMemsetAsync((char*)d_ws + WS_CTL, 0, CTL_ZERO_BYTES, stream);
    Args a{};
    for (int i = 0; i < 17; ++i) a.in[i] = (const float*)d_in[i];
    a.out = (float*)d_out; a.ws = (unsigned char*)d_ws;
#if MK_PER_PHASE
    for (int p = 0; p < N_PHASES; ++p) { a.ph_lo = p; a.ph_hi = p + 1; hipLaunchKernelGGL(fwd_kernel, dim3(grid), dim3(NTHREADS), LDS_BYTES, stream, a); }
#else
    a.ph_lo = 0; a.ph_hi = N_PHASES;
    void* kargs[] = {&a};
    hipError_t e = hipLaunchCooperativeKernel((void*)fwd_kernel, dim3(grid), dim3(NTHREADS), kargs, LDS_BYTES, stream);
    if (e != hipSuccess) fprintf(stderr, "cooperative launch failed: %s (grid %d)\n", hipGetErrorString(e), grid);
#endif
}
```

```cpp
#include <hip/hip_runtime.h>
#include <cstdio>
#include <cstdint>
namespace pg8 {
#define PG8_LAS __attribute__((address_space(3)))
typedef unsigned short bf16_t;
typedef short bf16x8 __attribute__((ext_vector_type(8)));
typedef float f32x4 __attribute__((ext_vector_type(4)));
typedef unsigned u32x4 __attribute__((ext_vector_type(4)));
constexpr int BM = 256, BK = 64, HALF = 128, HTB = HALF * BK * 2  , STAGE_BYTES = 8 * HTB, NXCD = 8, WGM = 8;

__host__ __device__ __forceinline__ int lds_byte(int r, int c) { const int st = (r >> 4) * 2 + (c >> 5), rr = r & 15, cc = c & 31, ob = rr * 64 + cc * 2; return st * 1024 + (ob ^ (((ob >> 9) & 1) << 5)); }
__host__ __device__ __forceinline__ void stage_rc(int b, int& R, int& C) { const int st = b / 1024, sb = b % 1024, swz = sb ^ (((sb >> 9) & 1) << 5); R = (st >> 1) * 16 + swz / 64; C = (st & 1) * 32 + (swz % 64) / 2; }
__host__ __device__ __forceinline__ int perm32(int rho) { const int n = rho >> 4, i = rho & 15; return 8 * (i >> 2) + 4 * n + (i & 3); }

struct Unit { int pm, pn, ex, tq; };
struct Gemm { const bf16_t* A; const bf16_t* Bt; int M, N, K; };

struct StaticOrder {
    int nM, nN, nwg, G, c;
    __host__ __device__ void init(int M, int N, int G_, int c_) { nM = M / BM; nN = N / BM; nwg = nM * nN; G = G_; c = c_; }
    __host__ __device__ bool next(int i, Unit& u) const {
        const long L = (long)i * G + c; if (L >= nwg) return false;
        int wgid = (int)L; { const int q = nwg / NXCD, r = nwg % NXCD, xcd = wgid % NXCD, off = wgid / NXCD; wgid = (xcd < r ? xcd * (q + 1) : r * (q + 1) + (xcd - r) * q) + off; }
        const int nig = WGM * nN, gid = wgid / nig, fm = gid * WGM, gsz = (nM - fm) < WGM ? (nM - fm) : WGM;
        u.pm = fm + ((wgid % nig) % gsz); u.pn = (wgid % nig) / gsz; return true;
    }
    __device__ __forceinline__ void a_ready(const Unit&) const {}
    __device__ __forceinline__ void done(const Unit&) const {}
};

__device__ __forceinline__ unsigned cvt_pk_bf16(float lo, float hi) { unsigned r; asm volatile("v_cvt_pk_bf16_f32 %0, %1, %2" : "=v"(r) : "v"(lo), "v"(hi)); return r; }
typedef float f32x2 __attribute__((ext_vector_type(2)));
template <class Epi, class Sched, bool ALIGN_EPI = false, bool SP2 = false>
__device__ __forceinline__ void gemm_phase(PG8_LAS unsigned char* lds, const Gemm g, const Sched& S, const Epi& E) {
    const int tid = threadIdx.x, wid = __builtin_amdgcn_readfirstlane(tid >> 6), lane = tid & 63, wr = wid >> 2, wc = wid & 3, fr = lane & 15, fq = lane >> 4;
    const int K = g.K, nt = K / BK;
    unsigned voffA[2], voffB[2];
#pragma unroll
    for (int i = 0; i < 2; ++i) { int R, C; stage_rc(tid * 16 + i * 8192, R, C); const int Rb = Epi::PERM ? ((R & ~31) + perm32(R & 31)) : R;
        voffA[i] = (unsigned)(R * K + C) * 2u; voffB[i] = (unsigned)(Rb * K + C) * 2u; }
    const size_t kstep = (size_t)(BK * 2);
    const size_t hstep = (size_t)HALF * K * 2;
    const size_t tstep = 2 * hstep;
    const unsigned ldsw = (unsigned)wid * 1024u;
    const int aoff = lds_byte(wr * 64 + fr, fq * 8), boff = lds_byte(wc * 32 + fr, fq * 8);
#define PG8_SA(b, h) (((b) * 2 + (h)) * HTB)
#define PG8_SB(b, h) ((4 + (b) * 2 + (h)) * HTB)
#define PG8_STAGE(bufoff, gbase, voff) do { _Pragma("unroll") for (int _i = 0; _i < 2; ++_i) \
        __builtin_amdgcn_global_load_lds((const unsigned*)((const char*)(gbase) + (voff)[_i]), (PG8_LAS unsigned*)(lds + (bufoff) + ldsw + _i * 8192), 16, 0, 0); } while (0)
#define PG8_LDA(dst, b, h) do { _Pragma("unroll") for (int m = 0; m < 4; ++m) _Pragma("unroll") for (int k = 0; k < 2; ++k) dst[m][k] = *(const PG8_LAS bf16x8*)(lds + PG8_SA(b, h) + aoff + m * 2048 + k * 1024); } while (0)
#define PG8_LDB(dst, b, h) do { _Pragma("unroll") for (int n = 0; n < 2; ++n) _Pragma("unroll") for (int k = 0; k < 2; ++k) dst[n][k] = *(const PG8_LAS bf16x8*)(lds + PG8_SB(b, h) + boff + n * 2048 + k * 1024); } while (0)
#define PG8_MMA(ai, bj, At, Bt) do { __builtin_amdgcn_s_setprio(1); _Pragma("unroll") for (int m = 0; m < 4; ++m) _Pragma("unroll") for (int n = 0; n < 2; ++n) _Pragma("unroll") for (int k = 0; k < 2; ++k) \
        acc[ai][bj][m][n] = __builtin_amdgcn_mfma_f32_16x16x32_bf16(Bt[n][k], At[m][k], acc[ai][bj][m][n], 0, 0, 0); __builtin_amdgcn_s_setprio(0); } while (0)
#define PG8_WAIT_V(n) asm volatile("s_waitcnt vmcnt(" #n ")" ::: "memory")
#define PG8_WAIT_L(n) asm volatile("s_waitcnt lgkmcnt(" #n ")" ::: "memory")
#define PG8_BAR __builtin_amdgcn_s_barrier()
#define PG8_SCHED __builtin_amdgcn_sched_barrier(0)
    Unit cur, nxt; int ui = 0;
    if (!S.next(0, cur)) return;
    f32x4 acc[2][2][4][2];
#pragma unroll
    for (int a = 0; a < 2; ++a)
#pragma unroll
        for (int b = 0; b < 2; ++b)
#pragma unroll
            for (int m = 0; m < 4; ++m)
#pragma unroll
                for (int n = 0; n < 2; ++n) acc[a][b][m][n] = (f32x4){0.f, 0.f, 0.f, 0.f};
    bf16x8 At[4][2], B0[2][2], B1[2][2];
    const char* cA = (const char*)g.A + (size_t)cur.pm * tstep; const char* cB = (const char*)g.Bt + (size_t)cur.pn * tstep;
    S.a_ready(cur);
    if constexpr (SP2) {
        PG8_STAGE(PG8_SB(0, 0), cB, voffB); PG8_STAGE(PG8_SB(0, 1), cB + hstep, voffB); PG8_STAGE(PG8_SA(0, 0), cA, voffA); PG8_STAGE(PG8_SA(0, 1), cA + hstep, voffA);
        if (wr == 1) PG8_BAR;
        PG8_WAIT_V(2); PG8_BAR;
        PG8_STAGE(PG8_SB(1, 0), cB + kstep, voffB); PG8_STAGE(PG8_SA(1, 0), cA + kstep, voffA); PG8_STAGE(PG8_SB(1, 1), cB + hstep + kstep, voffB);
        PG8_WAIT_V(6); PG8_BAR;
    } else {
        PG8_STAGE(PG8_SB(0, 0), cB, voffB); PG8_STAGE(PG8_SA(0, 0), cA, voffA); PG8_STAGE(PG8_SB(0, 1), cB + hstep, voffB); PG8_STAGE(PG8_SA(0, 1), cA + hstep, voffA);
        if (wr == 1) PG8_BAR;
        PG8_WAIT_V(4); PG8_BAR;
        PG8_STAGE(PG8_SB(1, 0), cB + kstep, voffB); PG8_STAGE(PG8_SA(1, 0), cA + kstep, voffA); PG8_STAGE(PG8_SB(1, 1), cB + hstep + kstep, voffB);
        PG8_WAIT_V(6); PG8_BAR;
    }
    for (;;) {
        const bool has_next = S.next(ui + 1, nxt);
        const char* nA = has_next ? (const char*)g.A + (size_t)nxt.pm * tstep : cA; const char* nB = has_next ? (const char*)g.Bt + (size_t)nxt.pn * tstep : cB;
        for (int t = 0; t < nt; t += 2) {
            const bool last = (t == nt - 2);
            const char* a1 = cA + (size_t)(t + 1) * kstep;
            const char* a2 = last ? nA : cA + (size_t)(t + 2) * kstep; const char* b2 = last ? nB : cB + (size_t)(t + 2) * kstep;
            const char* a3 = a2 + kstep; const char* b3 = b2 + kstep;
            if (last && has_next) S.a_ready(nxt);
            if constexpr (SP2) {
            PG8_LDB(B0, 0, 0); PG8_LDB(B1, 0, 1); PG8_SCHED; PG8_LDA(At, 0, 0); PG8_STAGE(PG8_SA(1, 1), a1 + hstep, voffA);
            PG8_WAIT_V(8); PG8_WAIT_L(0); PG8_BAR; PG8_MMA(0, 0, At, B0); PG8_MMA(0, 1, At, B1); PG8_BAR; PG8_SCHED;
            PG8_LDA(At, 0, 1); PG8_STAGE(PG8_SB(0, 0), b2, voffB); PG8_STAGE(PG8_SB(0, 1), b2 + hstep, voffB); PG8_STAGE(PG8_SA(0, 0), a2, voffA);
            PG8_WAIT_V(8); PG8_WAIT_L(0); PG8_BAR; PG8_MMA(1, 0, At, B0); PG8_MMA(1, 1, At, B1); PG8_BAR; PG8_SCHED;
            PG8_LDB(B0, 1, 0); PG8_LDB(B1, 1, 1); PG8_SCHED; PG8_LDA(At, 1, 0); PG8_STAGE(PG8_SA(0, 1), a2 + hstep, voffA);
            PG8_WAIT_V(8); PG8_WAIT_L(0); PG8_BAR; PG8_MMA(0, 0, At, B0); PG8_MMA(0, 1, At, B1); PG8_BAR; PG8_SCHED;
            PG8_LDA(At, 1, 1); PG8_STAGE(PG8_SB(1, 0), b3, voffB); PG8_STAGE(PG8_SB(1, 1), b3 + hstep, voffB); PG8_STAGE(PG8_SA(1, 0), a3, voffA);
            PG8_WAIT_V(8); PG8_WAIT_L(0); PG8_BAR; PG8_MMA(1, 0, At, B0); PG8_MMA(1, 1, At, B1); PG8_BAR; PG8_SCHED;
            } else {
            PG8_LDB(B0, 0, 0); PG8_SCHED; PG8_LDA(At, 0, 0); PG8_STAGE(PG8_SA(1, 1), a1 + hstep, voffA);
            PG8_WAIT_L(8); PG8_BAR; PG8_WAIT_L(0); PG8_MMA(0, 0, At, B0); PG8_BAR; PG8_SCHED;
            PG8_LDB(B1, 0, 1); PG8_STAGE(PG8_SB(0, 0), b2, voffB);
            PG8_BAR; PG8_WAIT_L(0); PG8_MMA(0, 1, At, B1); PG8_BAR;
            PG8_LDA(At, 0, 1); PG8_STAGE(PG8_SA(0, 0), a2, voffA);
            PG8_BAR; PG8_WAIT_L(0); PG8_MMA(1, 0, At, B0); PG8_BAR; PG8_SCHED;
            PG8_STAGE(PG8_SB(0, 1), b2 + hstep, voffB);
            PG8_WAIT_V(6); PG8_BAR; PG8_MMA(1, 1, At, B1); PG8_BAR;
            PG8_LDB(B0, 1, 0); PG8_SCHED; PG8_LDA(At, 1, 0); PG8_STAGE(PG8_SA(0, 1), a2 + hstep, voffA);
            PG8_WAIT_L(8); PG8_BAR; PG8_WAIT_L(0); PG8_MMA(0, 0, At, B0); PG8_BAR; PG8_SCHED;
            PG8_LDB(B1, 1, 1); PG8_STAGE(PG8_SB(1, 0), b3, voffB);
            PG8_BAR; PG8_WAIT_L(0); PG8_MMA(0, 1, At, B1); PG8_BAR;
            PG8_LDA(At, 1, 1); PG8_STAGE(PG8_SA(1, 0), a3, voffA);
            PG8_BAR; PG8_WAIT_L(0); PG8_MMA(1, 0, At, B0); PG8_BAR; PG8_SCHED;
            PG8_STAGE(PG8_SB(1, 1), b3 + hstep, voffB);
            PG8_WAIT_V(6); PG8_BAR; PG8_MMA(1, 1, At, B1); PG8_BAR;
            }
        }
        if constexpr (ALIGN_EPI) { if (wr == 0) PG8_BAR; }
        if constexpr (!Epi::AFTER_DRAIN) { E(acc, cur, wr, wc, fr, fq); S.done(cur); }
        if (!has_next) break;
#pragma unroll
        for (int a = 0; a < 2; ++a)
#pragma unroll
            for (int b = 0; b < 2; ++b)
#pragma unroll
                for (int m = 0; m < 4; ++m)
#pragma unroll
                    for (int n = 0; n < 2; ++n) acc[a][b][m][n] = (f32x4){0.f, 0.f, 0.f, 0.f};
        cur = nxt; cA = nA; cB = nB; ++ui;
        if constexpr (ALIGN_EPI) { if (wr == 1) PG8_BAR; }
    }
    PG8_WAIT_V(0);
    if constexpr (!ALIGN_EPI) { if (wr == 0) PG8_BAR; }
    PG8_BAR;
    if constexpr (Epi::AFTER_DRAIN) { E.fused(acc, cur, wr, wc, fr, fq, lds, wid, lane); S.done(cur); }
#undef PG8_SA
#undef PG8_SB
#undef PG8_STAGE
#undef PG8_LDA
#undef PG8_LDB
#undef PG8_MMA
#undef PG8_WAIT_V
#undef PG8_WAIT_L
#undef PG8_BAR
#undef PG8_SCHED
}
typedef int i32x4 __attribute__((ext_vector_type(4)));
template <bool I8> struct AccSel { typedef f32x4 type; };
template <> struct AccSel<true> { typedef i32x4 type; };
template <bool I8> __device__ __forceinline__ void mma_step(typename AccSel<I8>::type& c, const bf16x8& b, const bf16x8& a) {
    if constexpr (I8) c = __builtin_amdgcn_mfma_i32_16x16x64_i8(__builtin_bit_cast(i32x4, b), __builtin_bit_cast(i32x4, a), c, 0, 0, 0);
    else c = __builtin_amdgcn_mfma_f32_16x16x32_bf16(b, a, c, 0, 0, 0);
}
template <class Epi, class Sched, class AMap, bool ALIGN_EPI = false, bool I8 = false>
__device__ __forceinline__ void gemm_phase_gather(PG8_LAS unsigned char* lds, const Gemm g, const Sched& S, const Epi& E, const AMap& AM) {
    constexpr bool SP2 = true;
    const int tid = threadIdx.x, wid = __builtin_amdgcn_readfirstlane(tid >> 6), lane = tid & 63, wr = wid >> 2, wc = wid & 3, fr = lane & 15, fq = lane >> 4;
    const int K = g.K, nt = K / BK;
    unsigned voffA[2], voffB[2]; int rowA[2];
#pragma unroll
    for (int i = 0; i < 2; ++i) { int R, C; stage_rc(tid * 16 + i * 8192, R, C); const int Rb = Epi::PERM ? ((R & ~31) + perm32(R & 31)) : R;
        voffA[i] = (unsigned)C * 2u; voffB[i] = (unsigned)(Rb * K + C) * 2u; rowA[i] = R; }
    const size_t kstep = (size_t)(BK * 2);
    const size_t hstep = (size_t)HALF * K * 2;
    const size_t tstep = 2 * hstep;
    const unsigned ldsw = (unsigned)wid * 1024u;
    const int aoff = lds_byte(wr * 64 + fr, fq * 8), boff = lds_byte(wc * 32 + fr, fq * 8);
#define PG8_SA(b, h) (((b) * 2 + (h)) * HTB)
#define PG8_SB(b, h) ((4 + (b) * 2 + (h)) * HTB)
#define PG8_STAGE(bufoff, gbase, voff) do { _Pragma("unroll") for (int _i = 0; _i < 2; ++_i) \
        __builtin_amdgcn_global_load_lds((const unsigned*)((const char*)(gbase) + (voff)[_i]), (PG8_LAS unsigned*)(lds + (bufoff) + ldsw + _i * 8192), 16, 0, 0); } while (0)
#define PG8_LDA(dst, b, h) do { _Pragma("unroll") for (int m = 0; m < 4; ++m) _Pragma("unroll") for (int k = 0; k < 2; ++k) dst[m][k] = *(const PG8_LAS bf16x8*)(lds + PG8_SA(b, h) + aoff + m * 2048 + k * 1024); } while (0)
#define PG8_LDB(dst, b, h) do { _Pragma("unroll") for (int n = 0; n < 2; ++n) _Pragma("unroll") for (int k = 0; k < 2; ++k) dst[n][k] = *(const PG8_LAS bf16x8*)(lds + PG8_SB(b, h) + boff + n * 2048 + k * 1024); } while (0)
#define PG8_MMA(ai, bj, At, Bt) do { __builtin_amdgcn_s_setprio(1); _Pragma("unroll") for (int m = 0; m < 4; ++m) _Pragma("unroll") for (int n = 0; n < 2; ++n) _Pragma("unroll") for (int k = 0; k < 2; ++k) \
        mma_step<I8>(acc[ai][bj][m][n], Bt[n][k], At[m][k]); __builtin_amdgcn_s_setprio(0); } while (0)
#define PG8_WAIT_V(n) asm volatile("s_waitcnt vmcnt(" #n ")" ::: "memory")
#define PG8_WAIT_L(n) asm volatile("s_waitcnt lgkmcnt(" #n ")" ::: "memory")
#define PG8_BAR __builtin_amdgcn_s_barrier()
#define PG8_SCHED __builtin_amdgcn_sched_barrier(0)
    Unit cur, nxt; int ui = 0;
    if (!S.next(0, cur)) return;
    typedef typename AccSel<I8>::type acc_t;
    acc_t acc[2][2][4][2];
#pragma unroll
    for (int a = 0; a < 2; ++a)
#pragma unroll
        for (int b = 0; b < 2; ++b)
#pragma unroll
            for (int m = 0; m < 4; ++m)
#pragma unroll
                for (int n = 0; n < 2; ++n) acc[a][b][m][n] = (acc_t){0, 0, 0, 0};
    bf16x8 At[4][2], B0[2][2], B1[2][2];
    const char* cA = (const char*)g.A; const char* cB = (const char*)g.Bt + (size_t)cur.pn * tstep;
    unsigned vA0[2], vA1[2], nA0[2], nA1[2];
#pragma unroll
    for (int i = 0; i < 2; ++i) { vA0[i] = (unsigned)AM.row(cur, rowA[i]) * (unsigned)(K * 2) + voffA[i]; vA1[i] = (unsigned)AM.row(cur, HALF + rowA[i]) * (unsigned)(K * 2) + voffA[i]; }
    S.a_ready(cur);
    if constexpr (SP2) {
        PG8_STAGE(PG8_SB(0, 0), cB, voffB); PG8_STAGE(PG8_SB(0, 1), cB + hstep, voffB); PG8_STAGE(PG8_SA(0, 0), cA, vA0); PG8_STAGE(PG8_SA(0, 1), cA, vA1);
        if (wr == 1) PG8_BAR;
        PG8_WAIT_V(2); PG8_BAR;
        PG8_STAGE(PG8_SB(1, 0), cB + kstep, voffB); PG8_STAGE(PG8_SA(1, 0), cA + kstep, vA0); PG8_STAGE(PG8_SB(1, 1), cB + hstep + kstep, voffB);
        PG8_WAIT_V(6); PG8_BAR;
    } else {
        PG8_STAGE(PG8_SB(0, 0), cB, voffB); PG8_STAGE(PG8_SA(0, 0), cA, voffA); PG8_STAGE(PG8_SB(0, 1), cB + hstep, voffB); PG8_STAGE(PG8_SA(0, 1), cA + hstep, voffA);
        if (wr == 1) PG8_BAR;
        PG8_WAIT_V(4); PG8_BAR;
        PG8_STAGE(PG8_SB(1, 0), cB + kstep, voffB); PG8_STAGE(PG8_SA(1, 0), cA + kstep, voffA); PG8_STAGE(PG8_SB(1, 1), cB + hstep + kstep, voffB);
        PG8_WAIT_V(6); PG8_BAR;
    }
    for (;;) {
        const bool has_next = S.next(ui + 1, nxt);
        const char* nA = cA; const char* nB = has_next ? (const char*)g.Bt + (size_t)nxt.pn * tstep : cB;
#pragma unroll
        for (int i = 0; i < 2; ++i) { nA0[i] = has_next ? (unsigned)AM.row(nxt, rowA[i]) * (unsigned)(K * 2) + voffA[i] : vA0[i]; nA1[i] = has_next ? (unsigned)AM.row(nxt, HALF + rowA[i]) * (unsigned)(K * 2) + voffA[i] : vA1[i]; }
        for (int t = 0; t < nt; t += 2) {
            const bool last = (t == nt - 2);
            const char* a1 = cA + (size_t)(t + 1) * kstep;
            const char* a2 = last ? nA : cA + (size_t)(t + 2) * kstep; const char* b2 = last ? nB : cB + (size_t)(t + 2) * kstep;
            const char* a3 = a2 + kstep; const char* b3 = b2 + kstep;
            unsigned s0[2], s1[2];
#pragma unroll
            for (int i = 0; i < 2; ++i) { s0[i] = vA0[i]; s1[i] = vA1[i]; }
            if (last) {
#pragma unroll
                for (int i = 0; i < 2; ++i) { unsigned t0_ = nA0[i], t1_ = nA1[i]; asm volatile("" : "+v"(t0_), "+v"(t1_)); s0[i] = t0_; s1[i] = t1_; } }
            if (last && has_next) S.a_ready(nxt);
            if constexpr (SP2) {
            PG8_LDB(B0, 0, 0); PG8_LDB(B1, 0, 1); PG8_SCHED; PG8_LDA(At, 0, 0); PG8_STAGE(PG8_SA(1, 1), a1, vA1);
            PG8_WAIT_V(8); PG8_WAIT_L(0); PG8_BAR; PG8_MMA(0, 0, At, B0); PG8_MMA(0, 1, At, B1); PG8_BAR; PG8_SCHED;
            PG8_LDA(At, 0, 1); PG8_STAGE(PG8_SB(0, 0), b2, voffB); PG8_STAGE(PG8_SB(0, 1), b2 + hstep, voffB); PG8_STAGE(PG8_SA(0, 0), a2, s0);
            PG8_WAIT_V(8); PG8_WAIT_L(0); PG8_BAR; PG8_MMA(1, 0, At, B0); PG8_MMA(1, 1, At, B1); PG8_BAR; PG8_SCHED;
            PG8_LDB(B0, 1, 0); PG8_LDB(B1, 1, 1); PG8_SCHED; PG8_LDA(At, 1, 0); PG8_STAGE(PG8_SA(0, 1), a2, s1);
            PG8_WAIT_V(8); PG8_WAIT_L(0); PG8_BAR; PG8_MMA(0, 0, At, B0); PG8_MMA(0, 1, At, B1); PG8_BAR; PG8_SCHED;
            PG8_LDA(At, 1, 1); PG8_STAGE(PG8_SB(1, 0), b3, voffB); PG8_STAGE(PG8_SB(1, 1), b3 + hstep, voffB); PG8_STAGE(PG8_SA(1, 0), a3, s0);
            PG8_WAIT_V(8); PG8_WAIT_L(0); PG8_BAR; PG8_MMA(1, 0, At, B0); PG8_MMA(1, 1, At, B1); PG8_BAR; PG8_SCHED;
            } else {
            PG8_LDB(B0, 0, 0); PG8_SCHED; PG8_LDA(At, 0, 0); PG8_STAGE(PG8_SA(1, 1), a1 + hstep, voffA);
            PG8_WAIT_L(8); PG8_BAR; PG8_WAIT_L(0); PG8_MMA(0, 0, At, B0); PG8_BAR; PG8_SCHED;
            PG8_LDB(B1, 0, 1); PG8_STAGE(PG8_SB(0, 0), b2, voffB);
            PG8_BAR; PG8_WAIT_L(0); PG8_MMA(0, 1, At, B1); PG8_BAR;
            PG8_LDA(At, 0, 1); PG8_STAGE(PG8_SA(0, 0), a2, voffA);
            PG8_BAR; PG8_WAIT_L(0); PG8_MMA(1, 0, At, B0); PG8_BAR; PG8_SCHED;
            PG8_STAGE(PG8_SB(0, 1), b2 + hstep, voffB);
            PG8_WAIT_V(6); PG8_BAR; PG8_MMA(1, 1, At, B1); PG8_BAR;
            PG8_LDB(B0, 1, 0); PG8_SCHED; PG8_LDA(At, 1, 0); PG8_STAGE(PG8_SA(0, 1), a2 + hstep, voffA);
            PG8_WAIT_L(8); PG8_BAR; PG8_WAIT_L(0); PG8_MMA(0, 0, At, B0); PG8_BAR; PG8_SCHED;
            PG8_LDB(B1, 1, 1); PG8_STAGE(PG8_SB(1, 0), b3, voffB);
            PG8_BAR; PG8_WAIT_L(0); PG8_MMA(0, 1, At, B1); PG8_BAR;
            PG8_LDA(At, 1, 1); PG8_STAGE(PG8_SA(1, 0), a3, voffA);
            PG8_BAR; PG8_WAIT_L(0); PG8_MMA(1, 0, At, B0); PG8_BAR; PG8_SCHED;
            PG8_STAGE(PG8_SB(1, 1), b3 + hstep, voffB);
            PG8_WAIT_V(6); PG8_BAR; PG8_MMA(1, 1, At, B1); PG8_BAR;
            }
        }
        if constexpr (ALIGN_EPI) { if (wr == 0) PG8_BAR; }
        if constexpr (!Epi::AFTER_DRAIN) { E(acc, cur, wr, wc, fr, fq); S.done(cur); }
        if (!has_next) break;
#pragma unroll
        for (int a = 0; a < 2; ++a)
#pragma unroll
            for (int b = 0; b < 2; ++b)
#pragma unroll
                for (int m = 0; m < 4; ++m)
#pragma unroll
                    for (int n = 0; n < 2; ++n) acc[a][b][m][n] = (acc_t){0, 0, 0, 0};
        cur = nxt; cA = nA; cB = nB; ++ui;
#pragma unroll
        for (int i = 0; i < 2; ++i) { vA0[i] = nA0[i]; vA1[i] = nA1[i]; }
        if constexpr (ALIGN_EPI) { if (wr == 1) PG8_BAR; }
    }
    PG8_WAIT_V(0);
    if constexpr (!ALIGN_EPI) { if (wr == 0) PG8_BAR; }
    PG8_BAR;
    if constexpr (Epi::AFTER_DRAIN) { E.fused(acc, cur, wr, wc, fr, fq, lds, wid, lane); S.done(cur); }
#undef PG8_SA
#undef PG8_SB
#undef PG8_STAGE
#undef PG8_LDA
#undef PG8_LDB
#undef PG8_MMA
#undef PG8_WAIT_V
#undef PG8_WAIT_L
#undef PG8_BAR
#undef PG8_SCHED
}
}
#include <hip/hip_bf16.h>
#include <cmath>
namespace attn_body {
using bf16=__hip_bfloat16;
using bf16x8=__attribute__((ext_vector_type(8)))short;
using s16x4=__attribute__((ext_vector_type(4)))short;
using f32x16=__attribute__((ext_vector_type(16)))float;
using u32x4=__attribute__((ext_vector_type(4)))unsigned;
constexpr int BATCH=2,NHEAD=8,NKVH=2,SEQ=8192,D=64,QP=512,KP=128,OP=1024;
constexpr int NW=8,QBLK=32,QB=QBLK*NW,KVBLK=64,NQB=SEQ/QB;
constexpr int ATTN_UNIT_ROWS=QB;
__device__ __forceinline__ int crow(int r,int hi){return (r&3)+8*(r>>2)+4*hi;}
#define SBAR() __builtin_amdgcn_sched_barrier(0)
__device__ __forceinline__ void cmask(f32x16&p0,f32x16&p1,int jb,int qrel,int hi){
  const float NEG=-INFINITY; int kb=64*jb+4*hi;
  #pragma unroll
  for(int r=0;r<16;++r){int kv=kb+(r&3)+8*(r>>2); if(kv>qrel)p0[r]=NEG; if(kv+32>qrel)p1[r]=NEG;}
}

constexpr int NSLOT=3, SLOTB=8192;
constexpr int LDS_K=0, LDS_V=NSLOT*SLOTB, LDS_WS=2*NSLOT*SLOTB, LDS_OST=LDS_WS+NW*64*4, LDS_BYTES=LDS_OST+NW*4096;
constexpr float C2=0.125f*1.4426950408889634f;
__device__ __forceinline__ void glds16(const void*gsrc,unsigned lds_dst){unsigned keep;
  asm volatile("s_mov_b32 %0, m0\n\ts_mov_b32 m0, %2\n\ts_nop 0\n\tglobal_load_lds_dwordx4 %1, off\n\ts_mov_b32 m0, %0":"=&s"(keep):"v"(gsrc),"s"(lds_dst):"memory");}
__device__ __forceinline__ float max3f(float a,float b,float c){float r;asm("v_max3_f32 %0, %1, %2, %3":"=v"(r):"v"(a),"v"(b),"v"(c));return r;}
__device__ __forceinline__ float max2f(float a,float b){float r;asm("v_max_f32_e32 %0, %1, %2":"=v"(r):"v"(a),"v"(b));return r;}
__device__ __forceinline__ float fadd_s(float a,float b){float r;asm("v_add_f32_e32 %0, %1, %2":"=v"(r):"v"(a),"v"(b));return r;}
__device__ __forceinline__ float fsub_s(float a,float b){float r;asm("v_sub_f32_e32 %0, %1, %2":"=v"(r):"v"(a),"v"(b));return r;}
typedef float f32x2_t __attribute__((ext_vector_type(2))); typedef __bf16 bf16x2_t __attribute__((ext_vector_type(2)));
__device__ __forceinline__ unsigned cvtpk_s(float lo,float hi){f32x2_t v={lo,hi};bf16x2_t b=__builtin_convertvector(v,bf16x2_t);return __builtin_bit_cast(unsigned,b);}
#define WAIT_BAR(N) asm volatile("s_waitcnt vmcnt(" #N ") lgkmcnt(0)\n\ts_barrier":::"memory")

__device__ __forceinline__ void qkt(f32x16&p0,f32x16&p1,const char*Kslot,const bf16x8*qr,const f32x16&negm,int r32,int hi){
  const char*kb=Kslot+hi*1024+r32*16;
  #pragma unroll
  for(int d0=0;d0<4;++d0){
    const bf16x8 b0=*reinterpret_cast<const bf16x8*>(kb+d0*2048);
    const bf16x8 b1=*reinterpret_cast<const bf16x8*>(kb+d0*2048+512);
    if(d0==0){p0=__builtin_amdgcn_mfma_f32_32x32x16_bf16(b0,qr[0],negm,0,0,0);p1=__builtin_amdgcn_mfma_f32_32x32x16_bf16(b1,qr[0],negm,0,0,0);}
    else{p0=__builtin_amdgcn_mfma_f32_32x32x16_bf16(b0,qr[d0],p0,0,0,0);p1=__builtin_amdgcn_mfma_f32_32x32x16_bf16(b1,qr[d0],p1,0,0,0);}}
}
typedef __attribute__((address_space(3))) const char* lds_cptr;
typedef short v4i16_t __attribute__((ext_vector_type(4)));
__device__ __forceinline__ void kload8(bf16x8*kf,lds_cptr kp){
  kf[0]=*(const __attribute__((address_space(3))) bf16x8*)(kp);      kf[1]=*(const __attribute__((address_space(3))) bf16x8*)(kp+512);
  kf[2]=*(const __attribute__((address_space(3))) bf16x8*)(kp+2048); kf[3]=*(const __attribute__((address_space(3))) bf16x8*)(kp+2560);
  kf[4]=*(const __attribute__((address_space(3))) bf16x8*)(kp+4096); kf[5]=*(const __attribute__((address_space(3))) bf16x8*)(kp+4608);
  kf[6]=*(const __attribute__((address_space(3))) bf16x8*)(kp+6144); kf[7]=*(const __attribute__((address_space(3))) bf16x8*)(kp+6656);
}
__device__ __forceinline__ void kload2(bf16x8*kf,lds_cptr kp,int j){ kf[2*j]=*(const __attribute__((address_space(3))) bf16x8*)(kp+j*2048); kf[2*j+1]=*(const __attribute__((address_space(3))) bf16x8*)(kp+j*2048+512); }
__device__ __forceinline__ s16x4 vtr(lds_cptr p){ return __builtin_bit_cast(s16x4,__builtin_amdgcn_ds_read_tr16_b64_v4i16((__attribute__((address_space(3))) v4i16_t*)p)); }
__device__ __forceinline__ float rowmax(const f32x16&p0,const f32x16&p1){
  float a=max3f(p0[0],p0[1],p1[0]),b=max3f(p0[2],p0[3],p1[1]);a=max3f(a,p1[2],p1[3]);
  #pragma unroll
  for(int r=4;r<16;r+=4){a=max3f(a,p0[r],p0[r+1]);b=max3f(b,p0[r+2],p0[r+3]);a=max3f(a,p1[r],p1[r+1]);b=max3f(b,p1[r+2],p1[r+3]);}
  const float m=max2f(a,b);
  auto rr=__builtin_amdgcn_permlane32_swap(__float_as_uint(m),__float_as_uint(m),false,false);
  return max2f(__uint_as_float(rr[0]),__uint_as_float(rr[1]));
}
__device__ __forceinline__ void pv(f32x16*o,int vb,bf16x8 pa0,bf16x8 pa1,bf16x8 pa2,bf16x8 pa3){
  #pragma unroll
  for(int d0=0;d0<2;++d0){s16x4 lo[4],hi[4];
    #pragma unroll
    for(int ks=0;ks<4;++ks){
      asm volatile("ds_read_b64_tr_b16 %0,%1 offset:%c2":"=&v"(lo[ks]):"v"(vb),"i"(d0*4096+ks*1024):"memory");
      asm volatile("ds_read_b64_tr_b16 %0,%1 offset:%c2":"=&v"(hi[ks]):"v"(vb),"i"(d0*4096+ks*1024+512):"memory");}
    asm volatile("s_waitcnt lgkmcnt(0)":::"memory");SBAR();
    #define PK(k) (bf16x8){lo[k][0],lo[k][1],lo[k][2],lo[k][3],hi[k][0],hi[k][1],hi[k][2],hi[k][3]}
    o[d0]=__builtin_amdgcn_mfma_f32_32x32x16_bf16(pa0,PK(0),o[d0],0,0,0);
    o[d0]=__builtin_amdgcn_mfma_f32_32x32x16_bf16(pa1,PK(1),o[d0],0,0,0);
    o[d0]=__builtin_amdgcn_mfma_f32_32x32x16_bf16(pa2,PK(2),o[d0],0,0,0);
    o[d0]=__builtin_amdgcn_mfma_f32_32x32x16_bf16(pa3,PK(3),o[d0],0,0,0);
    #undef PK
  }
}

#ifndef ATTN_STORE16
#define ATTN_STORE16(p,v) (*(u32x4*)(p)=(v))
#endif
template<int THRL> __device__ __forceinline__ void attn_unit(int b,int h,int qb,const bf16*Q,const bf16*__restrict__ K,const bf16*__restrict__ V,bf16*O,char*shm,const float nshift){
  const int tid=threadIdx.x,lane=tid&63,r32=lane&31,hi=lane>>5; const int wid=__builtin_amdgcn_readfirstlane(tid>>6);
  const long rowbase=(long)b*SEQ; const int q0=qb*QB;
  const bf16*Qw=Q+(rowbase+q0+wid*QBLK)*QP+h*D;
  const int hk=h/(NHEAD/NKVH); const bf16*Kh=K+(long)(b*NKVH+hk)*SEQ*D,*Vh=V+(long)(b*NKVH+hk)*SEQ*D;
  const unsigned lds0=(unsigned)(uintptr_t)shm;
  float*wsf=(float*)(shm+LDS_WS)+wid*64;
  const bf16*ksrc=Kh+(wid*64+lane)*8;
  const bf16*vsrc=Vh+(wid*64+lane)*8;
  const unsigned kdst=lds0+LDS_K+wid*1024, vdst=lds0+LDS_V+wid*1024;
  #define DMA_K(t,slot) glds16(ksrc+(long)(t)*KVBLK*D,(unsigned)__builtin_amdgcn_readfirstlane(kdst+(slot)))
  #define DMA_V(t,slot) glds16(vsrc+(long)(t)*KVBLK*D,(unsigned)__builtin_amdgcn_readfirstlane(vdst+(slot)))
  const int vb0=(int)(lds0+LDS_V)+((lane>>4)&1)*32+(lane&3)*8+(4*hi+((lane&15)>>2))*64;
  const char*Kbase=shm+LDS_K; bf16x8 kf[8];
  const lds_cptr shm3=(lds_cptr)shm; const lds_cptr kp0=shm3+LDS_K+hi*1024+r32*16; const lds_cptr vp0=shm3+LDS_V+((lane>>4)&1)*32+(lane&3)*8+(4*hi+((lane&15)>>2))*64;
  constexpr int NT=SEQ/KVBLK;
  DMA_K(0,0);DMA_V(0,0);DMA_K(1,SLOTB);
  bf16x8 qr[4];
  #pragma unroll
  for(int d0=0;d0<4;++d0)qr[d0]=*reinterpret_cast<const bf16x8*>(&Qw[(long)r32*QP+d0*16+hi*8]);
  float l_reg=0.f;f32x16 o[2];o[0]=f32x16{};o[1]=f32x16{};f32x16 negm;
  _Pragma("unroll") for(int r=0;r<16;++r)negm[r]=nshift; asm volatile("":"+v"(negm));
  const int qrel=wid*QBLK+r32;
  #define CMASK(P0,P1,t) do{}while(0)
  #define START(P0,P1) do{ _Pragma("unroll") for(int r=0;r<16;++r)P0[r]=__builtin_amdgcn_exp2f(P0[r]); }while(0)
  f32x16 pA0,pA1,pB0,pB1;
  int sl_prev=0,sl_cur=0,sl_next=SLOTB;
  #define ROT() do{sl_prev=sl_cur;sl_cur=sl_next;sl_next=(sl_next==(NSLOT-1)*SLOTB)?0:sl_next+SLOTB;}while(0)
  DMA_K(2,2*SLOTB);
  WAIT_BAR(3);
  qkt(pA0,pA1,Kbase,qr,negm,r32,hi);asm volatile("s_nop 15\n\ts_nop 7":"+v"(pA0),"+v"(pA1));CMASK(pA0,pA1,0);
  START(pA0,pA1);
  _Pragma("unroll") for(int r=0;r<16;++r)pA1[r]=__builtin_amdgcn_exp2f(pA1[r]);
  WAIT_BAR(0);
  DMA_K(3,0);DMA_V(1,SLOTB);
  ROT();
  kload8(kf,kp0+sl_cur);
  WAIT_BAR(2);
  s16x4 vlo[8],vhi[8]; u32x4 pw0,pw1,pw2,pw3;
  #define PKW(P,B) cvtpk_s(P[B],P[B+1])
  #define PAF(k) __builtin_bit_cast(bf16x8,pw##k)
  #define VFR(i) (bf16x8){vlo[i][0],vlo[i][1],vlo[i][2],vlo[i][3],vhi[i][0],vhi[i][1],vhi[i][2],vhi[i][3]}
  #define PIN(x) asm volatile("":"+v"(x))
  #define GAPA(MF,A0,A1,A2,A3,W0,W1,PW) do{ MF; sacc+=A0; sacc+=A1; sacc+=A2; sacc+=A3; PIN(sacc); W0; W1; PIN(PW); SBAR(); }while(0)
  #define EX(v) __builtin_amdgcn_exp2f(v)
  #define GAPB(MF,X,B) do{ MF; X[B]=EX(X[B]); X[B+1]=EX(X[B+1]); X[B+2]=EX(X[B+2]); X[B+3]=EX(X[B+3]); PIN(X); SBAR(); }while(0)
  #define VRD(i) do{ vlo[i]=vtr(vp_+(((i)>>2)*4096+((i)&3)*1024)); vhi[i]=vtr(vp_+(((i)>>2)*4096+((i)&3)*1024+512)); }while(0)
  #define KRD(G,j) do{ if(G){ kload2(kf,kp0+sl_next,j); SBAR(); } }while(0)
  #define STEP(C0,C1,P0,P1,t,GK,GV,GL) do{ SBAR(); \
    const lds_cptr vp_=vp0+sl_prev; \
    VRD(0); SBAR(); float sacc=(P0[0]+P0[1]); \
    GAPA(C0=__builtin_amdgcn_mfma_f32_32x32x16_bf16(kf[0],qr[0],negm,0,0,0), P0[2],P0[3],P0[4],P0[5],     pw0[0]=PKW(P0,0), pw0[1]=PKW(P0,2), pw0); \
    VRD(4); SBAR(); GAPA(C1=__builtin_amdgcn_mfma_f32_32x32x16_bf16(kf[1],qr[0],negm,0,0,0), P0[6],P0[7],P0[8],P0[9],     pw0[2]=PKW(P0,4), pw0[3]=PKW(P0,6), pw0); \
    VRD(1); SBAR(); GAPA(C0=__builtin_amdgcn_mfma_f32_32x32x16_bf16(kf[2],qr[1],C0,0,0,0),   P0[10],P0[11],P0[12],P0[13], pw1[0]=PKW(P0,8), pw1[1]=PKW(P0,10), pw1); \
    VRD(5); SBAR(); GAPA(C1=__builtin_amdgcn_mfma_f32_32x32x16_bf16(kf[3],qr[1],C1,0,0,0),   P0[14],P0[15],P1[0],P1[1],   pw1[2]=PKW(P0,12),pw1[3]=PKW(P0,14), pw1); \
    VRD(2); SBAR(); GAPA(C0=__builtin_amdgcn_mfma_f32_32x32x16_bf16(kf[4],qr[2],C0,0,0,0),   P1[2],P1[3],P1[4],P1[5],     pw2[0]=PKW(P1,0), pw2[1]=PKW(P1,2), pw2); \
    VRD(6); SBAR(); GAPA(C1=__builtin_amdgcn_mfma_f32_32x32x16_bf16(kf[5],qr[2],C1,0,0,0),   P1[6],P1[7],P1[8],P1[9],     pw2[2]=PKW(P1,4), pw2[3]=PKW(P1,6), pw2); \
    VRD(3); SBAR(); GAPA(C0=__builtin_amdgcn_mfma_f32_32x32x16_bf16(kf[6],qr[3],C0,0,0,0),   P1[10],P1[11],P1[12],P1[13], pw3[0]=PKW(P1,8), pw3[1]=PKW(P1,10), pw3); \
    VRD(7); SBAR(); GAPA(C1=__builtin_amdgcn_mfma_f32_32x32x16_bf16(kf[7],qr[3],C1,0,0,0),   P1[14],P1[15],0.f,0.f,       pw3[2]=PKW(P1,12),pw3[3]=PKW(P1,14), pw3); \
    l_reg+=sacc; \
    if(GK){DMA_K((t)+3,sl_cur);} if(GV){DMA_V((t)+1,sl_next);} \
    CMASK(C0,C1,t); \
    SBAR(); \
    GAPB(o[0]=__builtin_amdgcn_mfma_f32_32x32x16_bf16(PAF(0),VFR(0),o[0],0,0,0), C0,0); \
    GAPB(o[1]=__builtin_amdgcn_mfma_f32_32x32x16_bf16(PAF(0),VFR(4),o[1],0,0,0), C0,4); \
    KRD(GL,0); GAPB(o[0]=__builtin_amdgcn_mfma_f32_32x32x16_bf16(PAF(1),VFR(1),o[0],0,0,0), C0,8); \
    KRD(GL,1); GAPB(o[1]=__builtin_amdgcn_mfma_f32_32x32x16_bf16(PAF(1),VFR(5),o[1],0,0,0), C0,12); \
    KRD(GL,2); GAPB(o[0]=__builtin_amdgcn_mfma_f32_32x32x16_bf16(PAF(2),VFR(2),o[0],0,0,0), C1,0); \
    KRD(GL,3); GAPB(o[1]=__builtin_amdgcn_mfma_f32_32x32x16_bf16(PAF(2),VFR(6),o[1],0,0,0), C1,4); \
    GAPB(o[0]=__builtin_amdgcn_mfma_f32_32x32x16_bf16(PAF(3),VFR(3),o[0],0,0,0), C1,8); \
    GAPB(o[1]=__builtin_amdgcn_mfma_f32_32x32x16_bf16(PAF(3),VFR(7),o[1],0,0,0), C1,12); \
    }while(0)
  int t=1;
  #undef CMASK
  #define CMASK(P0,P1,t) do{}while(0)
  for(;t+5<NT;t+=2){
    STEP(pB0,pB1,pA0,pA1,t,true,true,true);     WAIT_BAR(2); ROT();
    STEP(pA0,pA1,pB0,pB1,t+1,true,true,true);   WAIT_BAR(2); ROT();
  }
  #undef CMASK
  #define CMASK(P0,P1,t) do{}while(0)
  #define ENDW(tt) do{ if((tt)+3<NT){WAIT_BAR(2);} else if((tt)+2<NT){WAIT_BAR(1);} else {WAIT_BAR(0);} }while(0)
  for(;t+1<NT;t+=2){
    STEP(pB0,pB1,pA0,pA1,t,(t+3<NT),(t+1<NT),(t+1<NT));       ENDW(t);   ROT();
    STEP(pA0,pA1,pB0,pB1,t+1,(t+4<NT),(t+2<NT),(t+2<NT));     ENDW(t+1); ROT();
  }
  STEP(pB0,pB1,pA0,pA1,NT-1,false,false,false);
  { float sacc=pB0[0]+pB0[1]; _Pragma("unroll") for(int r=2;r<16;++r)sacc+=pB0[r]; _Pragma("unroll") for(int r=0;r<16;++r)sacc+=pB1[r]; l_reg+=sacc;
    pw0=(u32x4){PKW(pB0,0),PKW(pB0,2),PKW(pB0,4),PKW(pB0,6)};pw1=(u32x4){PKW(pB0,8),PKW(pB0,10),PKW(pB0,12),PKW(pB0,14)};pw2=(u32x4){PKW(pB1,0),PKW(pB1,2),PKW(pB1,4),PKW(pB1,6)};pw3=(u32x4){PKW(pB1,8),PKW(pB1,10),PKW(pB1,12),PKW(pB1,14)};
    SBAR(); pv(o,vb0+sl_cur,PAF(0),PAF(1),PAF(2),PAF(3)); }
  #undef PKW
  #undef PAF
  #undef VFR
  #undef PIN
  #undef GAPA
  #undef GAPB
  #undef EX
  #undef VRD
  #undef KRD
  #undef STEP
  #undef ENDW
  {auto rr=__builtin_amdgcn_permlane32_swap(__float_as_uint(l_reg),__float_as_uint(l_reg),false,false);l_reg=__uint_as_float(rr[0])+__uint_as_float(rr[1]);}
  if(hi==0)wsf[32+r32]=l_reg;asm volatile("s_waitcnt lgkmcnt(0)":::"memory");
  float rli[16];
  #pragma unroll
  for(int r=0;r<16;++r)rli[r]=__builtin_amdgcn_rcpf(wsf[32+crow(r,hi)]);
  bf16*Ow=O+(rowbase+q0+wid*QBLK)*OP+h*D;
  { bf16*stg=(bf16*)(shm+LDS_OST)+wid*2048;
    #pragma unroll
    for(int r=0;r<16;++r){const int orow=crow(r,hi);
      #pragma unroll
      for(int d0=0;d0<2;++d0)stg[orow*64+d0*32+r32]=__float2bfloat16(o[d0][r]*rli[r]);}
    asm volatile("s_waitcnt lgkmcnt(0)":::"memory");
    #pragma unroll
    for(int i=0;i<4;++i){const int row=i*8+(lane>>3),ch=lane&7; const u32x4 v=*(const u32x4*)(stg+row*64+ch*8); ATTN_STORE16(Ow+(long)row*OP+ch*8,v);} }
  asm volatile("s_waitcnt lgkmcnt(0)\n\ts_barrier":::"memory");
  #undef DMA_K
  #undef DMA_V
  #undef CMASK
  #undef START
  #undef ROT
}
constexpr int ATTN_LDS_BYTES=LDS_BYTES;
struct AttnTensors { const bf16* Q; const bf16* K; const bf16* V; bf16* O; };
struct AttnUnit { int bh; int qb; };
struct StaticOrder {
  int vcu, G;
  __device__ __forceinline__ explicit StaticOrder(int grid,int block):vcu((grid%8==0)?(block%8)*(grid/8)+block/8:block),G(grid){}
  __device__ __forceinline__ bool next(int i,AttnUnit&u)const{
    const int L=i*G+vcu; if(L>=BATCH*NHEAD*NQB)return false;
    if(G==256){ if(i>=2)return false; const int x=vcu>>5,j=vcu&31; const int b=x>>2,kvh=(x>>1)&1,hq=kvh*4+2*(x&1)+i; u.bh=b*NHEAD+hq; u.qb=j; return true; }
    u.bh=L/NQB; u.qb=L%NQB; return true; }
  __device__ __forceinline__ void a_ready(const AttnUnit&)const{}
  __device__ __forceinline__ void done(const AttnUnit&)const{}
};
template<class Sched,int THRL=8> __device__ __forceinline__ void attn_phase(char*lds,const AttnTensors&T,const Sched&S,const float nshift){
  AttnUnit u;
  for(int i=0;S.next(i,u);++i){ S.a_ready(u); attn_unit<THRL>(u.bh/NHEAD,u.bh%NHEAD,u.qb,T.Q,T.K,T.V,T.O,lds,nshift); S.done(u); }
}
#undef SBAR
#undef WAIT_BAR
}

#include <hip/hip_cooperative_groups.h>
namespace cg = cooperative_groups;
#ifndef MK_PER_PHASE
#define MK_PER_PHASE 0
#endif
constexpr int NWAVES = 8, NTHREADS = 512;
constexpr int NB = 2, SEQ = 8192, DMODEL = 1024, TT = NB * SEQ;
constexpr int NPROJ = 2816;
constexpr int NEXP = 32, FFE = 512;
constexpr float EPS = 1e-6f;
constexpr int N_PHASES = 12;

constexpr size_t MiB = 1u << 20;
constexpr size_t WS_CTL = 0, CTL_ZERO_BYTES = 64 * 1024;
constexpr size_t WS_WOUT = 1 * MiB;
constexpr size_t WS_LIST = 229 * MiB;
constexpr size_t WS_WR = 3 * MiB;
constexpr size_t WS_TOK = 3 * MiB + 256 * 1024;
constexpr size_t WS_GATES = 4 * MiB;
constexpr size_t WS_WIN = 5 * MiB;
constexpr size_t WS_WSI = 3 * MiB + 896 * 1024;
constexpr size_t WS_XSC = 3 * MiB + 912 * 1024;
constexpr size_t WS_A = 11 * MiB;
constexpr size_t WS_XN = WS_A;
constexpr size_t GDN_SH_BYTES = 71680, GDN_D_BYTES = 19456;
constexpr size_t WS_GSH = WS_A;
constexpr size_t WS_GD = WS_A + 1024 * GDN_SH_BYTES;
constexpr size_t WS_X1 = 5 * MiB;
constexpr size_t WS_HID = 69 * MiB;
constexpr size_t WS_XBUF = 109 * MiB;
constexpr size_t WS_B = 157 * MiB;
constexpr size_t WS_QKVA = WS_B;
constexpr size_t WS_QKVB = WS_B + 48 * MiB;
constexpr size_t WS_ZA = WS_B + 72 * MiB;
constexpr size_t WS_OCAT = WS_B;
constexpr size_t WS_WGU0 = 189 * MiB, WS_WGU1 = 245 * MiB; constexpr int WGU_SPLIT = 20;
constexpr size_t WS_WSC = 3 * MiB + 768 * 1024;
constexpr float ACT_CLIP = 6.0f;
constexpr size_t DO_WD0 = 0, DO_WD1 = 56 * MiB; constexpr int WD_SPLIT = 24;
constexpr size_t DO_HN = 24 * MiB;
constexpr size_t WS_END = 269 * MiB;
static_assert(WS_GD + 4096 * GDN_D_BYTES <= WS_B, "GDN records fit region A");
static_assert(WS_X1 + 64 * MiB <= WS_HID && WS_HID + 40928ull * 1024 <= WS_XBUF && WS_XBUF + 40928ull * 2048 <= WS_WGU0, "post-scan map");
static_assert(WS_WGU0 + WGU_SPLIT * MiB <= WS_B + 72 * MiB && WS_WGU1 + (32 - WGU_SPLIT) * MiB <= 269 * MiB, "WGU fragments");
constexpr size_t DO_QR = 0, DO_KR = 16 * MiB, DO_VR = 20 * MiB, DO_OF = 24 * MiB, DO_OB = 40 * MiB;
constexpr int CW_CNT = 2048;
constexpr int CW_NTILE = 128;
constexpr int CW_ETAB = 192;
constexpr int CW_SCANQ = 1024;

constexpr int LDS_BYTES = 160 * 1024;

#define GAS __attribute__((address_space(1)))
#define LAS __attribute__((address_space(3)))
typedef unsigned short bf16;
typedef unsigned v4u __attribute__((ext_vector_type(4)));
typedef unsigned v2u __attribute__((ext_vector_type(2)));
typedef float f32x4 __attribute__((ext_vector_type(4)));
typedef short bf16x8 __attribute__((ext_vector_type(8)));
typedef short s16x4 __attribute__((ext_vector_type(4)));
#define DI __device__ __forceinline__

DI unsigned f2bf(float f) { unsigned u = __builtin_bit_cast(unsigned, f); return (u + 0x7fffu + ((u >> 16) & 1u)) >> 16; }
typedef float f32x2_t __attribute__((ext_vector_type(2))); typedef __bf16 bf16x2_t __attribute__((ext_vector_type(2)));
DI unsigned pk2(float lo, float hi) { f32x2_t v = {lo, hi}; bf16x2_t b = __builtin_convertvector(v, bf16x2_t); return __builtin_bit_cast(unsigned, b); }
DI float bf2f(unsigned short h) { return __builtin_bit_cast(float, (unsigned)h << 16); }
DI float bflo(unsigned w) { return __builtin_bit_cast(float, w << 16); }
DI float bfhi(unsigned w) { return __builtin_bit_cast(float, w & 0xffff0000u); }
DI unsigned q8x4(float a, float b, float c, float d, float sc) {
    const float M = 12582912.f;
    const unsigned ua = __builtin_bit_cast(unsigned, fminf(fmaxf(a * sc, -127.f), 127.f) + M), ub = __builtin_bit_cast(unsigned, fminf(fmaxf(b * sc, -127.f), 127.f) + M);
    const unsigned uc = __builtin_bit_cast(unsigned, fminf(fmaxf(c * sc, -127.f), 127.f) + M), ud = __builtin_bit_cast(unsigned, fminf(fmaxf(d * sc, -127.f), 127.f) + M);
    return (ua & 255u) | ((ub & 255u) << 8) | ((uc & 255u) << 16) | (ud << 24);
}
template <int CTRL> DI float dpp_f(float v) { return __builtin_bit_cast(float, __builtin_amdgcn_update_dpp(0, __builtin_bit_cast(int, v), CTRL, 0xf, 0xf, true)); }
#ifdef NO_DPP
DI float sum16(float v) { v += __shfl_xor(v, 1); v += __shfl_xor(v, 2); v += __shfl_xor(v, 4); v += __shfl_xor(v, 8); return v; }
DI float max16(float v) { v = fmaxf(v, __shfl_xor(v, 1)); v = fmaxf(v, __shfl_xor(v, 2)); v = fmaxf(v, __shfl_xor(v, 4)); v = fmaxf(v, __shfl_xor(v, 8)); return v; }
DI float get_x8(float v) { return __shfl_xor(v, 8); }
#else
DI float sum16(float v) { v += dpp_f<0xB1>(v); v += dpp_f<0x4E>(v); v += dpp_f<0x141>(v); v += dpp_f<0x140>(v); return v; }
DI float max16(float v) { v = fmaxf(v, dpp_f<0xB1>(v)); v = fmaxf(v, dpp_f<0x4E>(v)); v = fmaxf(v, dpp_f<0x141>(v)); v = fmaxf(v, dpp_f<0x140>(v)); return v; }
DI float get_x8(float v) { return dpp_f<0x128>(v); }
#endif
DI float sum_x16(float v) { return v + __shfl_xor(v, 16); }
DI float max_x16(float v) { return fmaxf(v, __shfl_xor(v, 16)); }
DI float sum_x32(float v) { return v + __shfl_xor(v, 32); }
DI float max_x32(float v) { return fmaxf(v, __shfl_xor(v, 32)); }
DI float wave_max(float v) { return max_x32(max_x16(max16(v))); }
DI float act_absmax(const float* nfw, int lane) {
    float m = 0.f;
#pragma unroll
    for (int i = 0; i < 16; ++i) m = fmaxf(m, fabsf(nfw[lane + 64 * i]));
    return ACT_CLIP * wave_max(m);
}
DI float wave_sum(float v) { return sum_x32(sum_x16(sum16(v))); }
DI float siluf(float x) { return x * __builtin_amdgcn_rcpf(1.0f + __expf(-x)); }
DI float sigmoidf_(float x) { return 1.0f / (1.0f + __expf(-x)); }
DI int perm32i(int idx) { return ((idx >> 2) & 3) * 8 + (idx >> 4) * 4 + (idx & 3); }
DI int permcol(int c) { return (c & ~31) + perm32i(c & 31); }
template <class T> DI T opaque(T p) { asm volatile("" : "+v"(p)); return p; }

typedef GAS unsigned gu32;
#define RLX_AGENT __ATOMIC_RELAXED, __HIP_MEMORY_SCOPE_AGENT
constexpr int CW_BAR = 4096;
constexpr int MISC_OFF = LDS_BYTES - 64;
#define XB_TMO      128
#define XB_XCNT(j)  (256  + 64 * (j))
#define XB_XSUB(j)  (1280 + 64 * (j))
#define XB_XGEN(j)  (2304 + 64 * (j))
#define XB_TOP      3328
#define XB_TOPGEN   3392
#define XCD_BAR_WORDS 3456
#define XB_SPIN_CAP (1u << 18)

__device__ __forceinline__ unsigned xb_ld(unsigned* p)              { return __hip_atomic_load(p, __ATOMIC_RELAXED, __HIP_MEMORY_SCOPE_AGENT); }
__device__ __forceinline__ unsigned xb_add(unsigned* p, unsigned v) { return __hip_atomic_fetch_add(p, v, __ATOMIC_RELAXED, __HIP_MEMORY_SCOPE_AGENT); }
__device__ __forceinline__ unsigned xb_xcc_id() { return (unsigned)__builtin_amdgcn_s_getreg((3 << 11) | 20) & 0xFu; }
#define XB_SPIN(cond, bar) do { unsigned _sp = 0; while (cond) { __builtin_amdgcn_s_sleep(1); \
    if ((++_sp & 255u) == 0u) { if (xb_ld(&(bar)[XB_TMO])) break; if (_sp > XB_SPIN_CAP) { atomicAdd(&(bar)[XB_TMO], 1u); break; } } } } while (0)

struct XcdBarrier {
    unsigned* bar; unsigned x;
    volatile LAS unsigned* st;
};

__device__ __forceinline__ XcdBarrier xcd_barrier_post(unsigned* bar, volatile LAS unsigned* st) {
    XcdBarrier b; b.bar = bar; b.x = xb_xcc_id(); b.st = st;
    if (threadIdx.x == 0) (void)xb_add(&bar[XB_XCNT(b.x)], 1u);
    return b;
}
__device__ __forceinline__ void xcd_barrier_complete(unsigned* bar, unsigned x, unsigned& nloc, unsigned& nx) {
    const unsigned G = gridDim.x * gridDim.y * gridDim.z;
    unsigned sum, cnt, mine, sp = 0u;
    for (;;) {
        sum = 0u; cnt = 0u; mine = 0u;
#pragma unroll
        for (unsigned j = 0; j < 16; ++j) { const unsigned c = xb_ld(&bar[XB_XCNT(j)]); sum += c; cnt += (c > 0u) ? 1u : 0u; mine = (j == x) ? c : mine; }
        if (sum == G) break;
        __builtin_amdgcn_s_sleep(1);
        if ((++sp & 255u) == 0u) { if (xb_ld(&bar[XB_TMO])) break; if (sp > XB_SPIN_CAP) { atomicAdd(&bar[XB_TMO], 1u); break; } }
    }
    nloc = mine > 0u ? mine : 1u; nx = cnt > 0u ? cnt : 1u;
}

__device__ __forceinline__ void xcd_barrier(const XcdBarrier& b) {
    asm volatile("s_waitcnt vmcnt(0)" ::: "memory");
    __syncthreads();
    if (threadIdx.x == 0) {
        unsigned* bar = b.bar;
        __builtin_amdgcn_s_waitcnt(0);
        unsigned nloc = b.st[0], nx = b.st[1];
        if (nloc == 0u) { xcd_barrier_complete(bar, b.x, nloc, nx); b.st[0] = nloc; b.st[1] = nx; }
        const unsigned old = xb_add(&bar[XB_XSUB(b.x)], 1u);
        const unsigned gen = old / nloc;
        if (old + 1u == (gen + 1u) * nloc) {
            __builtin_amdgcn_fence(__ATOMIC_RELEASE, "agent");
            asm volatile("s_waitcnt vmcnt(0)" ::: "memory");
            const unsigned og = xb_add(&bar[XB_TOP], 1u);
            const unsigned tg = og / nx;
            if (og + 1u == (tg + 1u) * nx) xb_add(&bar[XB_TOPGEN], 1u);
            else XB_SPIN(xb_ld(&bar[XB_TOPGEN]) == tg, bar);
            __builtin_amdgcn_fence(__ATOMIC_ACQUIRE, "agent");
            xb_add(&bar[XB_XGEN(b.x)], 1u);
            asm volatile("s_waitcnt vmcnt(0)" ::: "memory");
        } else {
            XB_SPIN(xb_ld(&bar[XB_XGEN(b.x)]) == gen, bar);
            __builtin_amdgcn_fence(__ATOMIC_ACQUIRE, "agent");
            asm volatile("s_waitcnt vmcnt(0)" ::: "memory");
        }
    }
    __syncthreads();
}

struct Frame {
    LAS unsigned char* lds;
    int tid, lane, wave, vcu, G;
    const float* in[17];
    float* out; unsigned char* ws;
};

DI void p0_transpose_item(const float* W, int ldw, int nblk, bf16* WT, int K, int row_off, int rmul, LAS float* scr, int item, int lane) {
    const int kb = item / nblk, nb = item % nblk, k0 = 64 * kb, n0 = 32 * nb;
    const int r8 = lane >> 3, c4 = (lane & 7) * 4;
    f32x4 v[8];
#pragma unroll
    for (int i = 0; i < 8; ++i) v[i] = __builtin_nontemporal_load((const f32x4*)(W + (size_t)(k0 + 8 * i + r8) * ldw + n0 + c4));
#pragma unroll
    for (int i = 0; i < 8; ++i) { LAS float* d = scr + (8 * i + r8) * 33 + c4; d[0] = v[i].x; d[1] = v[i].y; d[2] = v[i].z; d[3] = v[i].w; }
    asm volatile("s_waitcnt lgkmcnt(0)" ::: "memory");
    const int c = lane & 7;
#pragma unroll
    for (int j = 0; j < 4; ++j) { const int n = (lane >> 3) + 8 * j; const LAS float* s = scr + (8 * c) * 33 + n;
        v4u o; o.x = pk2(s[0 * 33], s[1 * 33]); o.y = pk2(s[2 * 33], s[3 * 33]); o.z = pk2(s[4 * 33], s[5 * 33]); o.w = pk2(s[6 * 33], s[7 * 33]);
        *(GAS v4u*)(WT + (size_t)(row_off + (n0 + n) * rmul) * K + k0 + 8 * c) = o; }
    asm volatile("s_waitcnt lgkmcnt(0)" ::: "memory");
}
template <int NR> DI void rms_rows_to_bf16(const float* const (&xrow)[NR], const float* w, bf16* const (&orow)[NR], int lane) {
    const GAS f32x4* wr = (const GAS f32x4*)w + lane;
    f32x4 v[NR][4];
#pragma unroll
    for (int r = 0; r < NR; ++r) { const GAS f32x4* xr = (const GAS f32x4*)xrow[r] + lane;
#pragma unroll
        for (int j = 0; j < 4; ++j) v[r][j] = xr[64 * j]; }
    f32x4 ww[4];
#pragma unroll
    for (int j = 0; j < 4; ++j) ww[j] = wr[64 * j];
#pragma unroll
    for (int r = 0; r < NR; ++r) {
        float s_ = 0.f;
#pragma unroll
        for (int j = 0; j < 4; ++j) s_ += (v[r][j].x * v[r][j].x + v[r][j].y * v[r][j].y) + (v[r][j].z * v[r][j].z + v[r][j].w * v[r][j].w);
        const float rs = __builtin_amdgcn_rsqf(wave_sum(s_) * (1.f / DMODEL) + EPS);
        GAS v2u* o8 = (GAS v2u*)orow[r] + lane;
#pragma unroll
        for (int j = 0; j < 4; ++j) { v2u o; o.x = pk2(v[r][j].x * rs * ww[j].x, v[r][j].y * rs * ww[j].y); o.y = pk2(v[r][j].z * rs * ww[j].z, v[r][j].w * rs * ww[j].w); o8[64 * j] = o; }
    }
}
DI void q_strip(const float* W, int ldw, int n0, unsigned char* WQ, float* wsc, int rowbase, int rmul, LAS unsigned char* lds, int wave, int lane) {
    LAS float* scr = (LAS float*)(lds + wave * 8704); LAS float* cmx = (LAS float*)(lds + 8 * 8704);
    const int r8 = lane >> 3, c4 = (lane & 7) * 4, kw = 128 * wave;
    f32x4 mx = (f32x4){0.f, 0.f, 0.f, 0.f};
#pragma unroll
    for (int i = 0; i < 16; ++i) { const f32x4 v = *(const f32x4*)(W + (size_t)(kw + 8 * i + r8) * ldw + n0 + c4);
        mx.x = fmaxf(mx.x, fabsf(v.x)); mx.y = fmaxf(mx.y, fabsf(v.y)); mx.z = fmaxf(mx.z, fabsf(v.z)); mx.w = fmaxf(mx.w, fabsf(v.w)); }
    mx.x = max_x32(max_x16(fmaxf(mx.x, get_x8(mx.x)))); mx.y = max_x32(max_x16(fmaxf(mx.y, get_x8(mx.y))));
    mx.z = max_x32(max_x16(fmaxf(mx.z, get_x8(mx.z)))); mx.w = max_x32(max_x16(fmaxf(mx.w, get_x8(mx.w))));
    if (lane < 8) *(LAS f32x4*)(cmx + wave * 32 + c4) = mx;
    __syncthreads();
    float sq[4];
#pragma unroll
    for (int j = 0; j < 4; ++j) { const int n = (lane >> 3) + 8 * j; float m = cmx[n];
#pragma unroll
        for (int w = 1; w < 8; ++w) m = fmaxf(m, cmx[w * 32 + n]);
        sq[j] = m > 0.f ? 127.0f / m : 0.f;
        if (wave == 0 && (lane & 7) == 0) wsc[rowbase + n * rmul] = m * (1.0f / 127.0f); }
    const int c = lane & 7;
#pragma unroll
    for (int kb = 0; kb < 2; ++kb) {
        const int k0 = kw + 64 * kb;
        f32x4 v[8];
#pragma unroll
        for (int i = 0; i < 8; ++i) v[i] = *(const f32x4*)(W + (size_t)(k0 + 8 * i + r8) * ldw + n0 + c4);
#pragma unroll
        for (int i = 0; i < 8; ++i) { LAS float* d = scr + (8 * i + r8) * 33 + c4; d[0] = v[i].x; d[1] = v[i].y; d[2] = v[i].z; d[3] = v[i].w; }
        asm volatile("s_waitcnt lgkmcnt(0)" ::: "memory");
#pragma unroll
        for (int j = 0; j < 4; ++j) { const int n = (lane >> 3) + 8 * j; const LAS float* t = scr + (8 * c) * 33 + n;
            v2u o; o.x = q8x4(t[0 * 33], t[1 * 33], t[2 * 33], t[3 * 33], sq[j]); o.y = q8x4(t[4 * 33], t[5 * 33], t[6 * 33], t[7 * 33], sq[j]);
            *(GAS v2u*)(WQ + (size_t)(rowbase + n * rmul) * 1024 + k0 + 8 * c) = o; }
        asm volatile("s_waitcnt lgkmcnt(0)" ::: "memory");
    }
    __syncthreads();
}
DI float reduce16(const float (&ga)[16], int lane) {
    float gb[8], gc[4];
    const bool h32 = (lane & 32) != 0, h16 = (lane & 16) != 0;
#pragma unroll
    for (int i = 0; i < 8; ++i) { const float lo = sum_x32(ga[i]), hi = sum_x32(ga[i + 8]); gb[i] = h32 ? hi : lo; }
#pragma unroll
    for (int i = 0; i < 4; ++i) { const float lo = sum_x16(gb[i]), hi = sum_x16(gb[i + 4]); gc[i] = h16 ? hi : lo; }
    float res = 0.f;
#pragma unroll
    for (int i = 0; i < 4; ++i) { const float t = sum16(gc[i]); res = ((lane & 3) == i) ? t : res; }
    return res;
}
DI void rms_rows_to_q8(const float* const (&xrow)[2], const float* w, unsigned char* const (&orow)[2], float* const (&xsc)[2], float* const (&gout)[2], const LAS float* gw_, int lane) {
    const LAS float* gw = gw_;
    gw = opaque(gw);
    const GAS f32x4* wr = (const GAS f32x4*)w + lane;
    f32x4 v[2][4];
#pragma unroll
    for (int r = 0; r < 2; ++r) { const GAS f32x4* xr = (const GAS f32x4*)xrow[r] + lane;
#pragma unroll
        for (int j = 0; j < 4; ++j) v[r][j] = xr[64 * j]; }
    f32x4 ww[4];
#pragma unroll
    for (int j = 0; j < 4; ++j) ww[j] = wr[64 * j];
#pragma unroll
    for (int r = 0; r < 2; ++r) {
        float s_ = 0.f;
#pragma unroll
        for (int j = 0; j < 4; ++j) s_ += (v[r][j].x * v[r][j].x + v[r][j].y * v[r][j].y) + (v[r][j].z * v[r][j].z + v[r][j].w * v[r][j].w);
        const float rs = __builtin_amdgcn_rsqf(wave_sum(s_) * (1.f / DMODEL) + EPS);
        float am = 0.f;
#pragma unroll
        for (int j = 0; j < 4; ++j) { v[r][j] = v[r][j] * ww[j] * rs; am = fmaxf(fmaxf(am, fmaxf(fabsf(v[r][j].x), fabsf(v[r][j].y))), fmaxf(fabsf(v[r][j].z), fabsf(v[r][j].w))); }
        am = wave_max(am);
        const float qsc = am > 0.f ? 127.0f / am : 0.f;
        if (lane == 0) *xsc[r] = am * (1.0f / 127.0f);
        GAS unsigned* o4 = (GAS unsigned*)orow[r] + lane;
#pragma unroll
        for (int j = 0; j < 4; ++j) o4[64 * j] = q8x4(v[r][j].x, v[r][j].y, v[r][j].z, v[r][j].w, qsc);
    }
#ifndef NO_GATES
    float ga[2][16];
#pragma unroll
    for (int c = 0; c < 16; ++c) { ga[0][c] = 0.f; ga[1][c] = 0.f; }
    asm volatile("" : "+v"(v[0][0]), "+v"(v[0][1]), "+v"(v[0][2]), "+v"(v[0][3]), "+v"(v[1][0]), "+v"(v[1][1]), "+v"(v[1][2]), "+v"(v[1][3]));
#pragma unroll
    for (int j = 0; j < 4; ++j)
#pragma unroll
        for (int q = 0; q < 4; ++q) { const LAS f32x4* g4 = (const LAS f32x4*)gw + ((j * 4 + q) * 4) * 64 + lane;
            const f32x4 g0 = g4[0], g1 = g4[64], g2 = g4[128], g3 = g4[192];
#pragma unroll
            for (int r = 0; r < 2; ++r) { const float h = v[r][j][q];
                ga[r][0] += h * g0.x; ga[r][1] += h * g0.y; ga[r][2] += h * g0.z; ga[r][3] += h * g0.w; ga[r][4] += h * g1.x; ga[r][5] += h * g1.y; ga[r][6] += h * g1.z; ga[r][7] += h * g1.w;
                ga[r][8] += h * g2.x; ga[r][9] += h * g2.y; ga[r][10] += h * g2.z; ga[r][11] += h * g2.w; ga[r][12] += h * g3.x; ga[r][13] += h * g3.y; ga[r][14] += h * g3.z; ga[r][15] += h * g3.w; }
            asm volatile("" : "+v"(ga[1][0]), "+v"(ga[1][1]), "+v"(ga[1][2]), "+v"(ga[1][3]), "+v"(ga[1][4]), "+v"(ga[1][5]), "+v"(ga[1][6]), "+v"(ga[1][7]), "+v"(ga[1][8]), "+v"(ga[1][9]),
                         "+v"(ga[1][10]), "+v"(ga[1][11]), "+v"(ga[1][12]), "+v"(ga[1][13]), "+v"(ga[1][14]), "+v"(ga[1][15]) :: "memory"); }
    const int gc_ = 4 * (lane >> 4) + (lane & 3);
#pragma unroll
    for (int r = 0; r < 2; ++r) { const float res = reduce16(ga[r], lane); if ((lane & 12) == 0) gout[r][gc_] = res; }
#endif
}
DI void p0_prologue(Frame& F) {
    const float* w_in = F.in[2];
    unsigned char* WIN = F.ws + WS_WIN; float* WSI = (float*)(F.ws + WS_WSI);
    constexpr int NSTRIP = 64 + 24;
    if (F.vcu < NSTRIP) { const int st = F.vcu;
        if (st < 64) q_strip(w_in, 2832, 32 * st, WIN, WSI, 32 * st, 1, F.lds, F.wave, F.lane);
        else q_strip(w_in + 2064, 2832, 32 * (st - 64), WIN, WSI, 2048 + 32 * (st - 64), 1, F.lds, F.wave, F.lane); }
    unsigned char* XN = F.ws + WS_XN; float* XSC = (float*)(F.ws + WS_XSC); float* GATES = (float*)(F.ws + WS_GATES);
    LAS float* gw = (LAS float*)(F.lds + 73728);
    for (int i = F.tid; i < 1024 * 4; i += NTHREADS) { const int k = i >> 2, c4 = i & 3, jj = k >> 8, qq = k & 3, ln = (k & 255) >> 2;
        *((LAS f32x4*)gw + ((jj * 4 + qq) * 4 + c4) * 64 + ln) = *(const f32x4*)(w_in + (size_t)k * 2832 + 2048 + c4 * 4); }
    __syncthreads();
    const int nst = (F.G < NSTRIP ? F.G : NSTRIP), NSLOT = nst * NWAVES + (F.G - nst) * NWAVES * 2;
    const int s0_ = (F.vcu < nst) ? F.vcu * NWAVES + F.wave : nst * NWAVES + ((F.vcu - nst) * NWAVES + F.wave) * 2, nmine = (F.vcu < nst) ? 1 : 2;
#pragma unroll 1
    for (int q = 0; q < nmine; ++q)
#pragma unroll 1
        for (int p = s0_ + q; p < TT / 2; p += NSLOT) { const int m = 2 * p;
            const float* const xr[2] = {F.in[0] + (size_t)m * DMODEL, F.in[0] + (size_t)(m + 1) * DMODEL}; unsigned char* const orw[2] = {XN + (size_t)m * DMODEL, XN + (size_t)(m + 1) * DMODEL};
            float* const xs[2] = {XSC + m, XSC + m + 1}; float* const go[2] = {GATES + (size_t)m * 16, GATES + (size_t)(m + 1) * 16};
            rms_rows_to_q8(xr, F.in[1], orw, xs, go, gw, F.lane); }
}

struct EpiProj {
    static constexpr bool PERM = true, AFTER_DRAIN = false;
    bf16 *qkva, *za, *qkvb; const float* wsi; const float* xsc;
    DI void operator()(const pg8::i32x4 (&acc)[2][2][4][2], const pg8::Unit& u, int wr, int wc, int fr, int fq) const {
        const int row0 = u.pm * 256 + wr * 64 + fr;
        const float* ws_ = wsi + u.pn * 256 + wc * 32 + 8 * fq;
        bf16* base; int ldc, colt;
        if (u.pn < 6) { base = qkva; ldc = 1536; colt = u.pn * 256; } else if (u.pn < 8) { base = za; ldc = 512; colt = (u.pn - 6) * 256; } else { base = qkvb; ldc = 768; colt = (u.pn - 8) * 256; }
        const int col0 = colt + wc * 32 + 8 * fq;
        f32x4 s0[2], s1[2];
#pragma unroll
        for (int bj = 0; bj < 2; ++bj) { s0[bj] = *(const f32x4*)(ws_ + bj * 128); s1[bj] = *(const f32x4*)(ws_ + bj * 128 + 4); }
        float rsc[2][4];
#pragma unroll
        for (int ai = 0; ai < 2; ++ai)
#pragma unroll
            for (int m = 0; m < 4; ++m) rsc[ai][m] = xsc[row0 + ai * 128 + m * 16];
#pragma unroll
        for (int ai = 0; ai < 2; ++ai)
#pragma unroll
            for (int m = 0; m < 4; ++m) { bf16* rowp = base + (size_t)(row0 + ai * 128 + m * 16) * ldc + col0; const float rr = rsc[ai][m];
#pragma unroll
                for (int bj = 0; bj < 2; ++bj) { const pg8::i32x4 a0 = acc[ai][bj][m][0], a1 = acc[ai][bj][m][1]; const f32x4 t0 = s0[bj] * rr, t1 = s1[bj] * rr; pg8::u32x4 w;
                    w.x = pg8::cvt_pk_bf16((float)a0[0] * t0[0], (float)a0[1] * t0[1]); w.y = pg8::cvt_pk_bf16((float)a0[2] * t0[2], (float)a0[3] * t0[3]);
                    w.z = pg8::cvt_pk_bf16((float)a1[0] * t1[0], (float)a1[1] * t1[1]); w.w = pg8::cvt_pk_bf16((float)a1[2] * t1[2], (float)a1[3] * t1[3]);
                    *(pg8::u32x4*)(rowp + bj * 128) = w; } }
    }
};
struct IdRows { DI int row(const pg8::Unit& u, int r) const { return u.pm * 256 + r; } };
struct EpiResid {
    static constexpr bool PERM = true, AFTER_DRAIN = false;
    const float* x; bf16* x1;
    DI void operator()(const pg8::f32x4 (&acc)[2][2][4][2], const pg8::Unit& u, int wr, int wc, int fr, int fq) const {
        const int row0 = u.pm * 256 + wr * 64 + fr, col0 = u.pn * 256 + wc * 32 + 8 * fq;
#pragma unroll
        for (int ai = 0; ai < 2; ++ai)
#pragma unroll
            for (int m = 0; m < 4; ++m) { const size_t off = (size_t)(row0 + ai * 128 + m * 16) * DMODEL + col0;
#pragma unroll
                for (int bj = 0; bj < 2; ++bj) { const pg8::f32x4 v0 = *(const pg8::f32x4*)(x + off + bj * 128) + acc[ai][bj][m][0], v1 = *(const pg8::f32x4*)(x + off + bj * 128 + 4) + acc[ai][bj][m][1]; pg8::u32x4 w;
                    w.x = pg8::cvt_pk_bf16(v0[0], v0[1]); w.y = pg8::cvt_pk_bf16(v0[2], v0[3]); w.z = pg8::cvt_pk_bf16(v1[0], v1[1]); w.w = pg8::cvt_pk_bf16(v1[2], v1[3]);
                    *(pg8::u32x4*)(x1 + off + bj * 128) = w; } }
    }
};
struct EpiGU {
    static constexpr bool PERM = true, AFTER_DRAIN = false;
    bf16* hid; const float* wsc; float ainv;
    DI void operator()(const pg8::i32x4 (&acc)[2][2][4][2], const pg8::Unit& u, int wr, int wc, int fr, int fq) const {
        const int row0 = u.pm * 256 + wr * 64 + fr; const int jt = u.pn & 3;
        const int ff0 = jt * 128 + wc * 16 + 4 * fq;
        const float* ws_ = wsc + u.ex * 1024 + jt * 256 + wc * 32 + 8 * fq;
        f32x4 s0[2], s1[2];
#pragma unroll
        for (int bj = 0; bj < 2; ++bj) { s0[bj] = *(const f32x4*)(ws_ + bj * 128) * ainv; s1[bj] = *(const f32x4*)(ws_ + bj * 128 + 4) * ainv; }
#pragma unroll
        for (int ai = 0; ai < 2; ++ai)
#pragma unroll
            for (int m = 0; m < 4; ++m) { bf16* rowp = hid + (size_t)(row0 + ai * 128 + m * 16) * FFE + ff0;
#pragma unroll
                for (int bj = 0; bj < 2; ++bj) { const pg8::i32x4 a0 = acc[ai][bj][m][0], a1 = acc[ai][bj][m][1];
                    const float g0 = (float)a0[0] * s0[bj][0], u0 = (float)a0[1] * s0[bj][1], g1 = (float)a0[2] * s0[bj][2], u1 = (float)a0[3] * s0[bj][3];
                    const float g2 = (float)a1[0] * s1[bj][0], u2 = (float)a1[1] * s1[bj][1], g3 = (float)a1[2] * s1[bj][2], u3 = (float)a1[3] * s1[bj][3];
                    v2u w; w.x = pg8::cvt_pk_bf16(siluf(g0) * u0, siluf(g1) * u1); w.y = pg8::cvt_pk_bf16(siluf(g2) * u2, siluf(g3) * u3);
                    *(v2u*)(rowp + bj * 64) = w; } }
    }
};
struct EpiY {
    static constexpr bool PERM = true, AFTER_DRAIN = false;
    bf16* y;
    DI void operator()(const pg8::f32x4 (&acc)[2][2][4][2], const pg8::Unit& u, int wr, int wc, int fr, int fq) const {
        const int row0 = u.pm * 256 + wr * 64 + fr; const int col0 = (u.pn & 3) * 256 + wc * 32 + 8 * fq;
#pragma unroll
        for (int ai = 0; ai < 2; ++ai)
#pragma unroll
            for (int m = 0; m < 4; ++m) { bf16* rowp = y + (size_t)(row0 + ai * 128 + m * 16) * DMODEL + col0;
#pragma unroll
                for (int bj = 0; bj < 2; ++bj) { const pg8::f32x4 v0 = acc[ai][bj][m][0], v1 = acc[ai][bj][m][1]; pg8::u32x4 w;
                    w.x = pg8::cvt_pk_bf16(v0[0], v0[1]); w.y = pg8::cvt_pk_bf16(v0[2], v0[3]); w.z = pg8::cvt_pk_bf16(v1[0], v1[1]); w.w = pg8::cvt_pk_bf16(v1[2], v1[3]);
                    *(pg8::u32x4*)(rowp + bj * 128) = w; } }
    }
};
constexpr int ETAB_OFF = 131072;
struct MoeOrder {
    const LAS unsigned* etab; int G, c, esplit, pnoff;
    DI bool next(int i, pg8::Unit& u) const {
        if (G % 8 != 0) {
            int L = i * G + c;
            for (int e = 0; e < NEXP; ++e) { const int n4 = 4 * (int)etab[2 * e + 1]; if (L < n4) { u.pm = (int)etab[2 * e] + (L >> 2); u.pn = (e < esplit ? 4 * e : pnoff + 4 * (e - esplit)) + (L & 3); u.ex = e; u.tq = L >> 2; return true; } L -= n4; }
            return false; }
        const int x = c & 7; int L = i * (G >> 3) + (c >> 3);
#pragma unroll
        for (int q = 0; q < NEXP / 8; ++q) { const int e = x + 8 * q; const int n4 = 4 * (int)etab[2 * e + 1];
            if (L < n4) { u.pm = (int)etab[2 * e] + (L >> 2); u.pn = (e < esplit ? 4 * e : pnoff + 4 * (e - esplit)) + (L & 3); u.ex = e; u.tq = L >> 2; return true; } L -= n4; }
        return false; }
    DI void a_ready(const pg8::Unit&) const {}
    DI void done(const pg8::Unit&) const {}
};
struct MoeRows {
    const int* list; const LAS unsigned* etab;
    DI int row(const pg8::Unit& u, int r) const {
        const int slot = u.tq * 256 + r, e = u.ex; if (slot >= (int)etab[64 + e]) return 0;
        const LAS unsigned* sp = etab + 96 + 8 * e; int sb = 0;
#pragma unroll
        for (int q = 1; q < 8; ++q) sb += (slot >= (int)sp[q]) ? 1 : 0;
        return list[(size_t)(e * 8 + sb) * TT + (slot - (int)sp[sb])]; }
};

DI void p2_rope(Frame& F) {
    const int gw = F.vcu * NWAVES + F.wave, NGW = F.G * NWAVES, lane = F.lane;
    const bf16* QKVB = (const bf16*)(F.ws + WS_QKVB);
    bf16* QR = (bf16*)((unsigned char*)F.out + DO_QR); bf16* KR = (bf16*)((unsigned char*)F.out + DO_KR); bf16* VR = (bf16*)((unsigned char*)F.out + DO_VR);
    const int pi = lane & 31, hsel = lane >> 5;
    const float qw0 = F.in[7][2 * pi], qw1 = F.in[7][2 * pi + 1], kw0 = F.in[8][2 * pi], kw1 = F.in[8][2 * pi + 1];
    const float invf = exp2f(-(float)(2 * (pi & 15)) * (13.287712379549449f / 32.0f));
    constexpr float C2 = 0.125f * 1.4426950408889634f;
    constexpr int NB4 = 4;
    for (int t0 = gw; t0 < TT; t0 += NB4 * NGW) {
        unsigned w[NB4][5], vw[NB4];
#pragma unroll
        for (int u = 0; u < NB4; ++u) { const int t = t0 + u * NGW; const unsigned* src = (const unsigned*)(QKVB + (size_t)(t < TT ? t : t0) * 768);
#pragma unroll
            for (int j = 0; j < 5; ++j) w[u][j] = src[(2 * j + hsel) * 32 + pi];
            vw[u] = src[320 + lane]; }
#pragma unroll
        for (int u = 0; u < NB4; ++u) {
            const int t = t0 + u * NGW; if (t >= TT) break;
            const int s_ = t & (SEQ - 1); const float pos = (pi < 16) ? (float)(s_ >> 6) : (float)(s_ & 63);
            const float ang = pos * invf;
            const float rev = ang * 0.15915494309189535f;
            const float sn = __builtin_amdgcn_sinf(rev), cs = __builtin_amdgcn_cosf(rev);
#pragma unroll
            for (int j = 0; j < 5; ++j) {
                const int head = 2 * j + hsel;
                const float x0 = bflo(w[u][j]), x1 = bfhi(w[u][j]);
                float ss = x0 * x0 + x1 * x1;
                ss = sum_x16(sum16(ss));
                const float rs = __builtin_amdgcn_rsqf(ss * (1.f / 64.f) + EPS);
                const bool isq = head < 8;
                const float y0 = x0 * rs * (isq ? qw0 : kw0), y1 = x1 * rs * (isq ? qw1 : kw1);
                float o0 = y0 * cs - y1 * sn, o1 = y0 * sn + y1 * cs;
                if (isq) { o0 *= C2; o1 *= C2; ((unsigned*)(QR + (size_t)t * 512))[head * 32 + pi] = pk2(o0, o1); }
                else { const int hk = head - 8, bq = t >> 13, sq = t & (SEQ - 1);
                    ((unsigned*)(KR + ((size_t)((bq * 2 + hk) * 128 + (sq >> 6)) * 8 + (pi >> 2)) * 512 + (sq & 63) * 8))[pi & 3] = pk2(o0, o1); }
            }
            { const int hk = lane >> 5, d = 2 * (lane & 31), bq = t >> 13, sq = t & (SEQ - 1), r = sq & 63;
              ((unsigned*)(VR + ((size_t)((bq * 2 + hk) * 128 + (sq >> 6)) * 8 + (d >> 5) * 4 + (r >> 4)) * 512 + ((r & 15) * 4 + ((d & 31) >> 3)) * 8))[(d & 7) >> 1] = vw[u]; }
        }
    }
}

constexpr int G_KNP = 0, G_QNP = 17408, G_KNTP = 34816, G_VCT = 53248;
constexpr int G_D0 = 71680, G_D1 = 71680 + 19456;
constexpr int GD_TBP = 0, GD_AP = 9216, GD_VEC = 18432;
constexpr int G_LM = 110592;
constexpr int G_GV = G_LM + 32768;
static_assert(G_GV + 2048 <= LDS_BYTES - 64, "gdn pre lds");

#define TRI_ROW(i, LC, LN) { \
        if ((i) + 1 < 64) { _Pragma("unroll") for (int j4 = 0; j4 < ((i) + 1 + 3) / 4 && j4 < 8; ++j4) LN[j4] = *(const LAS f32x4*)(L + ((i) + 1) * 64 + 4 * j4); } \
        _Pragma("unroll") for (int j4 = 8; j4 < ((i) + 3) / 4; ++j4) lt[j4 - 8] = *(const LAS f32x4*)(L + (i) * 64 + 4 * j4); \
        __builtin_amdgcn_sched_barrier(0); \
        f32x2_t a0 = {(lane == (i)) ? 1.0f : 0.0f, 0.f}, a1 = {0.f, 0.f}; \
        _Pragma("unroll") for (int j4 = 0; j4 < ((i) + 3) / 4; ++j4) { const f32x4 l = (j4 < 8) ? LC[j4 & 7] : lt[(j4 - 8) & 7]; \
            f32x2_t l0 = {l.x, (4 * j4 + 1 < (i)) ? l.y : 0.f}, l1 = {(4 * j4 + 2 < (i)) ? l.z : 0.f, (4 * j4 + 3 < (i)) ? l.w : 0.f}; \
            a0 -= l0 * xp[2 * j4]; if (4 * j4 + 2 < (i)) a1 -= l1 * xp[2 * j4 + 1]; } \
        const float a = (a0.x + a0.y) + (a1.x + a1.y); \
        if ((i) & 1) xp[(i) >> 1].y = a; else { xp[(i) >> 1].x = a; xp[(i) >> 1].y = 0.f; } \
        TBP[(REV ? 63 - (i) : (i)) * 72 + pc] = (bf16)(pk2(a * bcol, 0.f) & 0xffffu); \
        __builtin_amdgcn_sched_barrier(0); }
template <bool REV> DI void tri_inverse(LAS float* L, const LAS float* beta, LAS bf16* TBP, int lane) {
    f32x2_t xp[32];
    L = opaque(L); TBP = opaque(TBP); lane = opaque(lane);
    const float bcol = REV ? beta[63 - lane] : beta[lane];
    const int pc = REV ? permcol(63 - lane) : permcol(lane);
    f32x4 la[8], lb[8], lt[8];
#pragma unroll
    for (int ii = 0; ii < 64; ii += 2) { TRI_ROW(ii, la, lb) TRI_ROW(ii + 1, lb, la) }
}
#undef TRI_ROW

DI void gdn_conv(Frame& F, LAS unsigned char* lds, int t384, int b, int h, int n) {
    const bf16* QKVA = (const bf16*)(F.ws + WS_QKVA); const float* convw = F.in[3];
    const int cgp = t384 % 48, rg = t384 / 48, mat = cgp >> 4, cc = (cgp & 15) * 8;
    const int col = mat * 512 + h * 128 + cc;
    float w[5][8];
#pragma unroll
    for (int j = 0; j < 5; ++j) { const f32x4 a = *(const f32x4*)(convw + j * 1536 + col), bq = *(const f32x4*)(convw + j * 1536 + col + 4);
        w[j][0] = a.x; w[j][1] = a.y; w[j][2] = a.z; w[j][3] = a.w; w[j][4] = bq.x; w[j][5] = bq.y; w[j][6] = bq.z; w[j][7] = bq.w; }
    const int a4 = (cc >> 3) & 3, p0 = (cc & ~31) + 16 * (a4 & 1) + 4 * (a4 >> 1);
    const int ra = rg & 3, q0 = (rg >> 2) * 32 + 16 * (ra & 1) + 4 * (ra >> 1);
#pragma unroll
    for (int hf = 0; hf < 2; ++hf) {
        float o[4][8];
#pragma unroll
        for (int r = 0; r < 4; ++r)
#pragma unroll
            for (int c = 0; c < 8; ++c) o[r][c] = 0.f;
#pragma unroll
        for (int i = 0; i < 8; ++i) {
            const int pos = n * 64 + rg * 8 + hf * 4 - 2 + i;
            v4u raw = (v4u){0u, 0u, 0u, 0u};
            if (pos >= 0 && pos < SEQ) raw = *(const v4u*)(QKVA + (size_t)(b * SEQ + pos) * 1536 + col);
            float xin[8] = {bflo(raw.x), bfhi(raw.x), bflo(raw.y), bfhi(raw.y), bflo(raw.z), bfhi(raw.z), bflo(raw.w), bfhi(raw.w)};
#pragma unroll
            for (int j = 0; j < 5; ++j) { const int r = i - j; if (r >= 0 && r < 4) {
#pragma unroll
                for (int c = 0; c < 8; ++c) o[r][c] += w[j][c] * xin[c]; } }
        }
#pragma unroll
        for (int r = 0; r < 4; ++r) {
            float ss = 0.f;
#pragma unroll
            for (int c = 0; c < 8; ++c) { o[r][c] = siluf(o[r][c]); ss += o[r][c] * o[r][c]; }
            ss = sum16(ss);
            float sc = 1.0f;
            if (mat < 2) { sc = __builtin_amdgcn_rsqf(ss + EPS); if (mat == 0) sc *= 0.08838834764831845f; }
#pragma unroll
            for (int c = 0; c < 8; ++c) o[r][c] *= sc;
        }
        if (mat < 2) {
            LAS unsigned char* tile = lds + (mat == 0 ? G_QNP : G_KNP);
#pragma unroll
            for (int r = 0; r < 4; ++r) { const int c = rg * 8 + hf * 4 + r;
                v2u lo, hi2; lo.x = pk2(o[r][0], o[r][1]); lo.y = pk2(o[r][2], o[r][3]); hi2.x = pk2(o[r][4], o[r][5]); hi2.y = pk2(o[r][6], o[r][7]);
                *(LAS v2u*)(tile + c * 272 + p0 * 2) = lo; *(LAS v2u*)(tile + c * 272 + (p0 + 8) * 2) = hi2; }
        }
        if (mat >= 1) {
#pragma unroll
            for (int c = 0; c < 8; ++c) {
                v2u q4; q4.x = pk2(o[0][c], o[1][c]); q4.y = pk2(o[2][c], o[3][c]);
                if (mat == 1) *(LAS v2u*)(lds + G_KNTP + (cc + c) * 144 + (q0 + 8 * hf) * 2) = q4;
                else *(LAS v2u*)(lds + G_VCT + (cc + c) * 144 + rg * 16 + hf * 8) = q4;
            }
        }
    }
}
DI void gdn_gates(Frame& F, LAS unsigned char* lds, LAS float* gv, int lane, int b, int h, int n) {
    const float* gp = (const float*)(F.ws + WS_GATES) + (size_t)(b * SEQ + n * 64 + lane) * 16;
    const float bfv = gp[h], bbv = gp[4 + h], afv = gp[8 + h], abv = gp[12 + h];
    const float betaf = sigmoidf_(bfv), betab = sigmoidf_(bbv);
    const float xf = afv + F.in[5][h], xb = abv + F.in[5][4 + h];
    const float spf = fmaxf(xf, 0.f) + log1pf(__expf(-fabsf(xf))), spb = fmaxf(xb, 0.f) + log1pf(__expf(-fabsf(xb)));
    const float gf = -__expf(F.in[4][h]) * spf, gb = -__expf(F.in[4][4 + h]) * spb;
    float Gf = gf, Rb = gb;
#pragma unroll
    for (int o = 1; o < 64; o <<= 1) { const float u1 = __shfl_up(Gf, o); if (lane >= o) Gf += u1; const float d1 = __shfl_down(Rb, o); if (lane + o < 64) Rb += d1; }
    gv[lane] = Gf; gv[64 + lane] = Rb; gv[128 + lane] = betaf; gv[192 + lane] = betab;
    const float GfL = __shfl(Gf, 63), Rb0 = __shfl(Rb, 0);
    LAS float* v0 = (LAS float*)(lds + G_D0 + GD_VEC); LAS float* v1 = (LAS float*)(lds + G_D1 + GD_VEC);
    v0[lane] = __expf(Gf); v0[64 + lane] = __expf(GfL - Gf); v1[lane] = __expf(Rb); v1[64 + lane] = __expf(Rb0 - Rb);
    if (lane == 0) { v0[128] = __expf(GfL); v1[128] = __expf(Rb0); }
}
DI void p2_gdn_pre(Frame& F) {
    const int tid = F.tid, lane = F.lane, wave = F.wave;
    int task = F.vcu;
    if (task < 1024) {
        LAS unsigned char* lds = opaque(F.lds);
        const int b = task >> 9, h = (task >> 7) & 3, n = task & 127;
        if (wave >= 2) gdn_conv(F, lds, tid - 128, b, h, n);
        if (wave == 2) gdn_gates(F, lds, (LAS float*)(lds + G_GV), lane, b, h, n);
    }
    __syncthreads();
    int par = 0;
#pragma unroll 1
    for (; task < 1024; task += F.G, par ^= 1) {
        LAS unsigned char* lds = opaque(F.lds);
        const int b = task >> 9, h = (task >> 7) & 3, n = task & 127, bh = b * 4 + h;
        LAS float* gv = (LAS float*)(lds + G_GV + par * 1024);
        LAS float* sGf = gv; LAS float* sRb = gv + 64; LAS float* sBf = gv + 128; LAS float* sBb = gv + 192;
        {
            const int p = wave >> 2, mt = wave & 3, n16 = lane & 15, g = lane >> 4;
            const LAS unsigned char* At = lds + (p == 0 ? G_KNP : G_QNP) + (16 * mt + n16) * 272 + g * 16;
            bf16x8 af[4], bfr[16];
#pragma unroll
            for (int ks = 0; ks < 4; ++ks) af[ks] = *(const LAS bf16x8*)(At + ks * 64);
#pragma unroll
            for (int nt = 0; nt < 4; ++nt)
#pragma unroll
                for (int ks = 0; ks < 4; ++ks) bfr[nt * 4 + ks] = *(const LAS bf16x8*)(lds + G_KNP + (16 * nt + n16) * 272 + g * 16 + ks * 64);
            float Gc[4], Rc[4], Bfc[4], Bbc[4];
#pragma unroll
            for (int r = 0; r < 4; ++r) { const int c = 16 * mt + 4 * g + r; Gc[r] = sGf[c]; Rc[r] = sRb[c]; Bfc[r] = sBf[c]; Bbc[r] = sBb[c]; }
#pragma unroll
            for (int nt = 0; nt < 4; ++nt) {
                f32x4 acc = (f32x4){0.f, 0.f, 0.f, 0.f};
#pragma unroll
                for (int ks = 0; ks < 4; ++ks) acc = __builtin_amdgcn_mfma_f32_16x16x32_bf16(af[ks], bfr[nt * 4 + ks], acc, 0, 0, 0);
                const int s_ = 16 * nt + n16; const float Gs = sGf[s_], Rs = sRb[s_]; const int ps = permcol(s_);
#pragma unroll
                for (int r = 0; r < 4; ++r) {
                    const int c = 16 * mt + 4 * g + r; const float v = acc[r];
                    const float df = __expf(fminf(Gc[r] - Gs, 0.f)), db = __expf(fminf(Rc[r] - Rs, 0.f));
                    if (p == 0) {
                        ((LAS float*)(lds + G_LM))[c * 64 + s_] = Bfc[r] * v * df;
                        ((LAS float*)(lds + G_LM + 16384))[(63 - c) * 64 + (63 - s_)] = Bbc[r] * v * db;
                    } else {
                        ((LAS bf16*)(lds + G_D0 + GD_AP))[c * 72 + ps] = (bf16)(pk2(s_ <= c ? v * df : 0.f, 0.f) & 0xffffu);
                        ((LAS bf16*)(lds + G_D1 + GD_AP))[c * 72 + ps] = (bf16)(pk2(s_ >= c ? v * db : 0.f, 0.f) & 0xffffu);
                    }
                }
            }
        }
        __syncthreads();
        GAS v4u* gd0 = (GAS v4u*)(F.ws + WS_GD + (size_t)((bh * 2 + 0) * 128 + n) * GDN_D_BYTES);
        GAS v4u* gd1 = (GAS v4u*)(F.ws + WS_GD + (size_t)((bh * 2 + 1) * 128 + n) * GDN_D_BYTES);
        {
            GAS v4u* gsh = (GAS v4u*)(F.ws + WS_GSH + (size_t)(bh * 128 + n) * GDN_SH_BYTES);
#pragma unroll 3
            for (int i = tid; i < (int)(GDN_SH_BYTES / 16); i += NTHREADS) gsh[i] = *(const LAS v4u*)(lds + i * 16);
#pragma unroll 1
            for (int i = GD_AP / 16 + tid; i < (int)(GDN_D_BYTES / 16); i += NTHREADS) { gd0[i] = *(const LAS v4u*)(lds + G_D0 + i * 16); gd1[i] = *(const LAS v4u*)(lds + G_D1 + i * 16); }
        }
        __syncthreads();
        if (wave == 0) { tri_inverse<false>((LAS float*)(lds + G_LM), sBf, (LAS bf16*)(lds + G_D0 + GD_TBP), lane);
#pragma unroll 3
            for (int i = lane; i < GD_AP / 16; i += 64) gd0[i] = *(const LAS v4u*)(lds + G_D0 + i * 16); }
        else if (wave == 1) { tri_inverse<true>((LAS float*)(lds + G_LM + 16384), sBb, (LAS bf16*)(lds + G_D1 + GD_TBP), lane);
#pragma unroll 3
            for (int i = lane; i < GD_AP / 16; i += 64) gd1[i] = *(const LAS v4u*)(lds + G_D1 + i * 16); }
        else {
            const int t2 = task + F.G;
            if (t2 < 1024) { const int b2 = t2 >> 9, h2 = (t2 >> 7) & 3, n2 = t2 & 127;
                gdn_conv(F, lds, tid - 128, b2, h2, n2);
                if (wave == 2) gdn_gates(F, lds, (LAS float*)(lds + G_GV + (par ^ 1) * 1024), lane, b2, h2, n2); }
        }
        __syncthreads();
    }
}

DI bf16x8 pack8(const f32x4 a, const f32x4 b) {
    v4u p; p.x = pk2(a[0], a[1]); p.y = pk2(a[2], a[3]); p.z = pk2(b[0], b[1]); p.w = pk2(b[2], b[3]); return __builtin_bit_cast(bf16x8, p);
}
DI void small_weights(Frame& F, int gw, int NGW) {
    LAS float* scr = (LAS float*)(F.lds + F.wave * 16384);
    bf16* WOUT = (bf16*)(F.ws + WS_WOUT);
    for (int it = gw; it < 16 * 32; it += NGW) p0_transpose_item(F.in[9], 1024, 32, WOUT, 1024, 0, 1, scr, it, F.lane);
    bf16* WRH = (bf16*)(F.ws + WS_WR); bf16* WRL = WRH + 48 * 1024; const float* wrg = F.in[11]; const float* wre = F.in[12];
    for (int i = gw * 64 + F.lane; i < 48 * 1024; i += NGW * 64) { const int j = i >> 10, k = i & 1023; float v = 0.f; if (j < 4) v = wrg[k * 4 + j]; else if (j < 36) v = wre[k * 32 + (j - 4)];
        const unsigned h = f2bf(v); const float hv = __builtin_bit_cast(float, h << 16); WRH[i] = (bf16)h; WRL[i] = (bf16)f2bf(v - hv); }
}
DI unsigned char* wgu_ptr(Frame& F, int e) { return F.ws + (e < WGU_SPLIT ? WS_WGU0 + (size_t)e * MiB : WS_WGU1 + (size_t)(e - WGU_SPLIT) * MiB); }
DI bf16* wd_ptr(Frame& F, int e) { return (bf16*)((unsigned char*)F.out + (e < WD_SPLIT ? DO_WD0 + (size_t)e * MiB : DO_WD1 + (size_t)(e - WD_SPLIT) * MiB)); }
DI void moe_weights(Frame& F, int cb, int ncb) {
    for (int it = cb; it < NEXP * 32; it += ncb) { const int e = it >> 5, mat = (it >> 4) & 1, nb = it & 15;
        q_strip((mat ? F.in[14] : F.in[13]) + (size_t)e * 1024 * 512, 512, 32 * nb, wgu_ptr(F, e), (float*)(F.ws + WS_WSC) + e * 1024, mat + 64 * nb, 2, F.lds, F.wave, F.lane); }
    LAS float* scr = (LAS float*)(F.lds + F.wave * 16384);
    constexpr int ID = 8 * 32; const int gw = cb * NWAVES + F.wave, NGW = ncb * NWAVES;
    for (int it = gw; it < NEXP * ID; it += NGW) { const int e = it / ID, r = it % ID;
        p0_transpose_item(F.in[15] + (size_t)e * 512 * 1024, 1024, 32, wd_ptr(F, e), 512, 0, 1, scr, r, F.lane); }
}

constexpr int SC_SLOT = 78848, SC_VCT = 53248, SC_D = 55552, SC_NCH = 11;
static_assert(2 * SC_SLOT <= LDS_BYTES, "scan slots");
DI void sc_issue(v4u (&R)[SC_NCH], const unsigned char* ws, const unsigned (&delta)[SC_NCH], const unsigned (&dmask)[SC_NCH], unsigned shbase, unsigned ddiff) {
#pragma unroll
    for (int j = 0; j < SC_NCH; ++j) { const unsigned off = shbase + delta[j] + (dmask[j] & ddiff);
#ifdef SC_PLAIN_LOADS
        R[j] = *(const v4u*)(ws + off); }
#else
        asm volatile("global_load_dwordx4 %0, %1, %2" : "=v"(R[j]) : "v"(off), "s"(ws) : "memory"); }
#endif
}
#ifdef SC_PLAIN_LOADS
#define SC_WAIT(R, n) do {} while (0)
#else
#define SC_WAIT(R, n) asm volatile("s_waitcnt vmcnt(" #n ")" : "+v"(R[0]), "+v"(R[1]), "+v"(R[2]), "+v"(R[3]), "+v"(R[4]), "+v"(R[5]), "+v"(R[6]), "+v"(R[7]), "+v"(R[8]), "+v"(R[9]), "+v"(R[10]) :: "memory")
#endif
DI void sc_write(const v4u (&R)[SC_NCH], LAS unsigned char* slot, int lid) {
#pragma unroll
    for (int j = 0; j < SC_NCH; ++j) *(LAS v4u*)(slot + 16 * (lid + 448 * j)) = R[j];
}
DI void p4_scan(Frame& F) {
    const int lane = F.lane, n16 = lane & 15, g = lane >> 4, wave = F.wave;
    {
        volatile LAS int* tsk = (volatile LAS int*)(F.lds + MISC_OFF + 32);
        if (F.tid == 0) {
            unsigned* q = (unsigned*)(F.ws + WS_CTL) + CW_SCANQ; const unsigned xcc = xb_xcc_id() & 7u; int task = -1;
            for (unsigned t = 0; t < 8 && task < 0; ++t) { const unsigned y = (xcc + t) & 7u; const unsigned j = xb_add(q + 64 * y, 1u); if (j < 16u) task = (int)(y * 16 + j); }
            *tsk = task; if (task < 0) tsk[1] = (int)xb_add(q + 64 * 8, 1u);
        }
        __syncthreads();
    }
    const int task = *(volatile LAS int*)(F.lds + MISC_OFF + 32);
    if (task < 0) {
        if (F.G > 128) { const int cgw = *(volatile LAS int*)(F.lds + MISC_OFF + 36) * NWAVES + wave, cng = (F.G - 128) * NWAVES; small_weights(F, cgw, cng); moe_weights(F, *(volatile LAS int*)(F.lds + MISC_OFF + 36), F.G - 128); }
        return; }
    const int chain = 2 * (task >> 4) + ((task & 15) >> 3), e = task & 7;
    const int bh = chain >> 1, dir = chain & 1, b = bh >> 2, h = bh & 3;
    LAS unsigned char* lds = opaque(F.lds);
    if (wave != 0) {
        const int lid = (wave - 1) * 64 + lane;
        const unsigned sh0 = (unsigned)(WS_GSH + (size_t)(bh * 128) * GDN_SH_BYTES), d0 = (unsigned)(WS_GD + (size_t)((bh * 2 + dir) * 128) * GDN_D_BYTES);
        unsigned delta[SC_NCH], dmask[SC_NCH];
#pragma unroll
        for (int j = 0; j < SC_NCH; ++j) { const int c = lid + 448 * j;
            delta[j] = (c < 3328) ? 16u * c : ((c < 3472) ? (unsigned)(G_VCT + 16 * e * 144 + 16 * (c - 3328)) : 16u * (c - 3472));
            dmask[j] = (c < 3472) ? 0u : 0xffffffffu; }
        v4u R0[SC_NCH], R1[SC_NCH], R2[SC_NCH];
#define SC_SRC(st) const int n_ = (dir == 0) ? ((st) < 128 ? (st) : 127) : ((st) < 128 ? 127 - (st) : 0); \
                   const unsigned shb_ = sh0 + (unsigned)n_ * (unsigned)GDN_SH_BYTES, ddf_ = (d0 + (unsigned)n_ * (unsigned)GDN_D_BYTES) - shb_;
        { SC_SRC(0) sc_issue(R0, F.ws, delta, dmask, shb_, ddf_); }
        { SC_SRC(1) sc_issue(R1, F.ws, delta, dmask, shb_, ddf_); }
        { SC_SRC(2) sc_issue(R2, F.ws, delta, dmask, shb_, ddf_); }
#define SC_BODY(R, st) { SC_WAIT(R, 22); sc_write(R, lds + ((st) & 1) * SC_SLOT, lid); { SC_SRC((st) + 3) sc_issue(R, F.ws, delta, dmask, shb_, ddf_); } \
                        asm volatile("s_waitcnt lgkmcnt(0)" ::: "memory"); __builtin_amdgcn_s_barrier(); }
#pragma unroll 1
        for (int s0 = 0; s0 < 126; s0 += 3) { SC_BODY(R0, s0) SC_BODY(R1, s0 + 1) SC_BODY(R2, s0 + 2) }
        SC_BODY(R0, 126) SC_BODY(R1, 127)
        SC_WAIT(R0, 0); SC_WAIT(R1, 0); SC_WAIT(R2, 0);
#undef SC_BODY
#undef SC_SRC
        return;
    }
    bf16* Odir = (bf16*)((unsigned char*)F.out + (dir == 0 ? DO_OF : DO_OB));
    f32x4 S[8];
#pragma unroll
    for (int i = 0; i < 8; ++i) S[i] = (f32x4){0.f, 0.f, 0.f, 0.f};
    bf16x8 Sb[4];
#pragma unroll
    for (int i = 0; i < 4; ++i) Sb[i] = (bf16x8){0, 0, 0, 0, 0, 0, 0, 0};
    const unsigned aoff272 = n16 * 272 + g * 16, aoff144 = n16 * 144 + g * 16;
    const unsigned lds0 = (unsigned)(uintptr_t)lds;
#define SB_() __builtin_amdgcn_sched_barrier(0)
#define LDR128(dst, base, off) asm volatile("ds_read_b128 %0, %1 offset:%2" : "=v"(dst) : "v"(base), "i"(off) : "memory")
#define LDR64(dst, base, off) asm volatile("ds_read_b64 %0, %1 offset:%2" : "=v"(dst) : "v"(base), "i"(off) : "memory")
#define LDR32(dst, base, off) asm volatile("ds_read_b32 %0, %1 offset:%2" : "=v"(dst) : "v"(base), "i"(off) : "memory")
#pragma unroll 1
    for (int step = 0; step < 128; ++step) {
        __builtin_amdgcn_s_barrier();
        asm volatile("" ::: "memory");
        const int n = dir == 0 ? step : 127 - step;
        const unsigned slot = lds0 + (unsigned)(step & 1) * SC_SLOT;
        const unsigned bK = slot + G_KNP + aoff272, bQ = slot + G_QNP + aoff272, bKT = slot + G_KNTP + aoff144, bT = slot + SC_D + GD_TBP + aoff144;
        const unsigned bV = slot + SC_VCT + n16 * 144 + g * 8, bvec = slot + SC_D + GD_VEC + g * 16, bd = slot + SC_D + GD_VEC;
        f32x4 eG[4], ks[4]; v2u vv[4]; float dch; bf16x8 fa[16];
        LDR128(eG[0], bvec, 0); LDR128(eG[1], bvec, 64); LDR128(eG[2], bvec, 128); LDR128(eG[3], bvec, 192);
        LDR128(ks[0], bvec, 256); LDR128(ks[1], bvec, 320); LDR128(ks[2], bvec, 384); LDR128(ks[3], bvec, 448);
        LDR32(dch, bd, 512);
        LDR64(vv[0], bV, 0); LDR64(vv[1], bV, 32); LDR64(vv[2], bV, 64); LDR64(vv[3], bV, 96);
#pragma unroll
        for (int m = 0; m < 4; ++m) { LDR128(fa[m * 4 + 0], bK, m * 4352 + 0); LDR128(fa[m * 4 + 1], bK, m * 4352 + 64); LDR128(fa[m * 4 + 2], bK, m * 4352 + 128); LDR128(fa[m * 4 + 3], bK, m * 4352 + 192); }
        bf16x8 fq[16];
#pragma unroll
        for (int m = 0; m < 4; ++m) { LDR128(fq[m * 4 + 0], bQ, m * 4352 + 0); LDR128(fq[m * 4 + 1], bQ, m * 4352 + 64); LDR128(fq[m * 4 + 2], bQ, m * 4352 + 128); LDR128(fq[m * 4 + 3], bQ, m * 4352 + 192); }
        asm volatile("s_waitcnt lgkmcnt(15)" : "+v"(eG[0]), "+v"(eG[1]), "+v"(eG[2]), "+v"(eG[3]), "+v"(ks[0]), "+v"(ks[1]), "+v"(ks[2]), "+v"(ks[3]), "+v"(dch), "+v"(vv[0]), "+v"(vv[1]), "+v"(vv[2]), "+v"(vv[3]),
                     "+v"(fa[0]), "+v"(fa[1]), "+v"(fa[2]), "+v"(fa[3]), "+v"(fa[4]), "+v"(fa[5]), "+v"(fa[6]), "+v"(fa[7]), "+v"(fa[8]), "+v"(fa[9]), "+v"(fa[10]), "+v"(fa[11]), "+v"(fa[12]), "+v"(fa[13]), "+v"(fa[14]), "+v"(fa[15]) :: "memory");
        SB_();
        f32x4 KS[4];
#pragma unroll
        for (int m = 0; m < 4; ++m) KS[m] = (f32x4){0.f, 0.f, 0.f, 0.f};
#pragma unroll
        for (int i = 0; i < 4; ++i)
#pragma unroll
            for (int m = 0; m < 4; ++m) KS[m] = __builtin_amdgcn_mfma_f32_16x16x32_bf16(fa[m * 4 + i], Sb[i], KS[m], 0, 0, 0);
        SB_();
        bf16x8 ft[8];
#pragma unroll
        for (int m = 0; m < 4; ++m) { LDR128(ft[m * 2 + 0], bT, m * 2304 + 0); LDR128(ft[m * 2 + 1], bT, m * 2304 + 64); }
        asm volatile("s_waitcnt lgkmcnt(8)" : "+v"(fq[0]), "+v"(fq[1]), "+v"(fq[2]), "+v"(fq[3]), "+v"(fq[4]), "+v"(fq[5]), "+v"(fq[6]), "+v"(fq[7]), "+v"(fq[8]), "+v"(fq[9]), "+v"(fq[10]), "+v"(fq[11]), "+v"(fq[12]), "+v"(fq[13]), "+v"(fq[14]), "+v"(fq[15]) :: "memory");
        SB_();
        f32x4 o[4];
#pragma unroll
        for (int m = 0; m < 4; ++m) o[m] = (f32x4){0.f, 0.f, 0.f, 0.f};
#pragma unroll
        for (int i = 0; i < 4; ++i)
#pragma unroll
            for (int m = 0; m < 4; ++m) o[m] = __builtin_amdgcn_mfma_f32_16x16x32_bf16(fq[m * 4 + i], Sb[i], o[m], 0, 0, 0);
        f32x4 rr[4];
#pragma unroll
        for (int m = 0; m < 4; ++m) { rr[m][0] = bflo(vv[m].x) - eG[m][0] * KS[m][0]; rr[m][1] = bfhi(vv[m].x) - eG[m][1] * KS[m][1]; rr[m][2] = bflo(vv[m].y) - eG[m][2] * KS[m][2]; rr[m][3] = bfhi(vv[m].y) - eG[m][3] * KS[m][3]; }
        bf16x8 rb[2]; rb[0] = pack8(rr[0], rr[1]); rb[1] = pack8(rr[2], rr[3]);
        SB_();
        bf16x8 fk[16];
#pragma unroll
        for (int jt = 0; jt < 8; ++jt) { LDR128(fk[jt * 2 + 0], bKT, jt * 2304 + 0); LDR128(fk[jt * 2 + 1], bKT, jt * 2304 + 64); }
        asm volatile("s_waitcnt lgkmcnt(15)" : "+v"(ft[0]), "+v"(ft[1]), "+v"(ft[2]), "+v"(ft[3]), "+v"(ft[4]), "+v"(ft[5]), "+v"(ft[6]), "+v"(ft[7]) :: "memory");
        SB_();
        f32x4 vn[4];
#pragma unroll
        for (int m = 0; m < 4; ++m) vn[m] = (f32x4){0.f, 0.f, 0.f, 0.f};
#pragma unroll
        for (int i = 0; i < 2; ++i)
#pragma unroll
            for (int m = 0; m < 4; ++m) vn[m] = __builtin_amdgcn_mfma_f32_16x16x32_bf16(ft[m * 2 + i], rb[i], vn[m], 0, 0, 0);
#pragma unroll
        for (int m = 0; m < 4; ++m) o[m] = o[m] * eG[m];
#pragma unroll
        for (int jt = 0; jt < 8; ++jt) S[jt] = S[jt] * dch;
        SB_();
        bf16x8 fp[8];
#pragma unroll
        for (int m = 0; m < 4; ++m) { LDR128(fp[m * 2 + 0], bT, GD_AP + m * 2304 + 0); LDR128(fp[m * 2 + 1], bT, GD_AP + m * 2304 + 64); }
        bf16x8 vnb[2]; vnb[0] = pack8(vn[0], vn[1]); vnb[1] = pack8(vn[2], vn[3]);
        bf16x8 vs[2]; vs[0] = pack8(vn[0] * ks[0], vn[1] * ks[1]); vs[1] = pack8(vn[2] * ks[2], vn[3] * ks[3]);
        asm volatile("s_waitcnt lgkmcnt(8)" : "+v"(fk[0]), "+v"(fk[1]), "+v"(fk[2]), "+v"(fk[3]), "+v"(fk[4]), "+v"(fk[5]), "+v"(fk[6]), "+v"(fk[7]), "+v"(fk[8]), "+v"(fk[9]), "+v"(fk[10]), "+v"(fk[11]), "+v"(fk[12]), "+v"(fk[13]), "+v"(fk[14]), "+v"(fk[15]) :: "memory");
        SB_();
#pragma unroll
        for (int i = 0; i < 2; ++i)
#pragma unroll
            for (int jt = 0; jt < 8; ++jt) S[jt] = __builtin_amdgcn_mfma_f32_16x16x32_bf16(fk[jt * 2 + i], vs[i], S[jt], 0, 0, 0);
        asm volatile("s_waitcnt lgkmcnt(0)" : "+v"(fp[0]), "+v"(fp[1]), "+v"(fp[2]), "+v"(fp[3]), "+v"(fp[4]), "+v"(fp[5]), "+v"(fp[6]), "+v"(fp[7]) :: "memory");
#pragma unroll
        for (int i = 0; i < 2; ++i)
#pragma unroll
            for (int m = 0; m < 4; ++m) o[m] = __builtin_amdgcn_mfma_f32_16x16x32_bf16(fp[m * 2 + i], vnb[i], o[m], 0, 0, 0);
#pragma unroll
        for (int i = 0; i < 4; ++i) Sb[i] = pack8(S[2 * i], S[2 * i + 1]);
        SB_();
        bf16* op = Odir + (size_t)(b * SEQ + n * 64) * 512 + h * 128 + 16 * e + n16;
#pragma unroll
        for (int m = 0; m < 4; ++m)
#pragma unroll
            for (int r = 0; r < 4; ++r) op[(size_t)(16 * m + 4 * g + r) * 512] = (bf16)(pk2(o[m][r], 0.f) & 0xffffu);
    }
#undef SB_
#undef LDR128
#undef LDR64
#undef LDR32
}

DI void p5_combine(Frame& F) {
    const int gw = F.vcu * NWAVES + F.wave, NGW = F.G * NWAVES, lane = F.lane;
    const bf16* OFp = (const bf16*)((unsigned char*)F.out + DO_OF); const bf16* OBp = (const bf16*)((unsigned char*)F.out + DO_OB);
    const bf16* ZA = (const bf16*)(F.ws + WS_ZA); bf16* OCAT = (bf16*)(F.ws + WS_OCAT);
    const float* nw = F.in[6] + (lane & 15) * 8;
    float w8[8];
#pragma unroll
    for (int c = 0; c < 8; ++c) w8[c] = nw[c];
    constexpr int NB4 = 4;
    for (int t0 = gw; t0 < TT; t0 += NB4 * NGW) {
        v4u a[NB4], bb[NB4], z[NB4];
#pragma unroll
        for (int u = 0; u < NB4; ++u) { const int t = (t0 + u * NGW < TT) ? t0 + u * NGW : t0;
            a[u] = *(const v4u*)(OFp + (size_t)t * 512 + lane * 8); bb[u] = *(const v4u*)(OBp + (size_t)t * 512 + lane * 8); z[u] = *(const v4u*)(ZA + (size_t)t * 512 + lane * 8); }
#pragma unroll
        for (int u = 0; u < NB4; ++u) {
            const int t = t0 + u * NGW; if (t >= TT) break;
            float o[8] = {bflo(a[u].x) + bflo(bb[u].x), bfhi(a[u].x) + bfhi(bb[u].x), bflo(a[u].y) + bflo(bb[u].y), bfhi(a[u].y) + bfhi(bb[u].y), bflo(a[u].z) + bflo(bb[u].z), bfhi(a[u].z) + bfhi(bb[u].z), bflo(a[u].w) + bflo(bb[u].w), bfhi(a[u].w) + bfhi(bb[u].w)};
            const float zz[8] = {bflo(z[u].x), bfhi(z[u].x), bflo(z[u].y), bfhi(z[u].y), bflo(z[u].z), bfhi(z[u].z), bflo(z[u].w), bfhi(z[u].w)};
            float ss = 0.f;
#pragma unroll
            for (int c = 0; c < 8; ++c) ss += o[c] * o[c];
            ss = sum16(ss);
            const float rn = __builtin_amdgcn_rsqf(ss * (1.f / 128.f) + EPS);
#pragma unroll
            for (int c = 0; c < 8; ++c) o[c] = o[c] * rn * w8[c] * siluf(zz[c]);
            v4u r; r.x = pk2(o[0], o[1]); r.y = pk2(o[2], o[3]); r.z = pk2(o[4], o[5]); r.w = pk2(o[6], o[7]);
            *(v4u*)(OCAT + (size_t)t * 1024 + lane * 8) = r;
        }
    }
}

struct TokRec { int e[2]; int row[2]; float gate[2]; };
DI void p7_route(Frame& F) {
    const int lane = F.lane, n16 = lane & 15, g = lane >> 4, wave = F.wave;
    const bf16* X1 = (const bf16*)(F.ws + WS_X1); const float* nfw = F.in[10];
    const bf16* WRH = (const bf16*)(F.ws + WS_WR); const bf16* WRL = WRH + 48 * 1024;
    unsigned char* HN = (unsigned char*)F.out + DO_HN; TokRec* TOK = (TokRec*)(F.ws + WS_TOK); unsigned* gcnt = (unsigned*)(F.ws + WS_CTL) + CW_CNT; int* LIST = (int*)(F.ws + WS_LIST);
    LAS float* lg = (LAS float*)(F.lds + (wave & 3) * 4096);
    LAS unsigned* hist = (LAS unsigned*)(F.lds + 16384); LAS unsigned* base = hist + 32;
    const int sub = blockIdx.x & 7;
    const float qsc = 127.0f / act_absmax(nfw, lane);
    for (int rt0 = blockIdx.x * 4; rt0 < TT / 16; rt0 += F.G * 4) {
        if (F.tid < 32) hist[F.tid] = 0u;
        __syncthreads();
        int ex1 = 0, ex2 = 0, tok = -1; unsigned l1 = 0, l2 = 0; float g1 = 0.f, g2 = 0.f;
        const int rt = rt0 + wave;
        if (wave < 4 && rt < TT / 16) {
            const int row = rt * 16 + n16; const bf16* xr = X1 + (size_t)row * DMODEL + 8 * g;
            float ss = 0.f;
#pragma unroll 16
            for (int i = 0; i < 32; ++i) { const v4u xw = *(const v4u*)(xr + 32 * i); const f32x4 a = {bflo(xw.x), bfhi(xw.x), bflo(xw.y), bfhi(xw.y)}, b2 = {bflo(xw.z), bfhi(xw.z), bflo(xw.w), bfhi(xw.w)};
                ss += (a.x * a.x + a.y * a.y) + (a.z * a.z + a.w * a.w) + (b2.x * b2.x + b2.y * b2.y) + (b2.z * b2.z + b2.w * b2.w); }
            ss = sum_x32(sum_x16(ss));
            const float rs = __builtin_amdgcn_rsqf(ss * (1.f / DMODEL) + EPS);
            f32x4 acc[3];
#pragma unroll
            for (int q = 0; q < 3; ++q) acc[q] = (f32x4){0.f, 0.f, 0.f, 0.f};
#pragma unroll 4
            for (int i = 0; i < 32; ++i) {
                const v4u xw = *(const v4u*)(xr + 32 * i); const f32x4 a = {bflo(xw.x), bfhi(xw.x), bflo(xw.y), bfhi(xw.y)}, b2 = {bflo(xw.z), bfhi(xw.z), bflo(xw.w), bfhi(xw.w)};
                const f32x4 wa = *(const f32x4*)(nfw + 32 * i + 8 * g), wb = *(const f32x4*)(nfw + 32 * i + 8 * g + 4);
                float hv[8] = {a.x * rs * wa.x, a.y * rs * wa.y, a.z * rs * wa.z, a.w * rs * wa.w, b2.x * rs * wb.x, b2.y * rs * wb.y, b2.z * rs * wb.z, b2.w * rs * wb.w};
                v4u hi, lo;
                hi.x = pk2(hv[0], hv[1]); hi.y = pk2(hv[2], hv[3]); hi.z = pk2(hv[4], hv[5]); hi.w = pk2(hv[6], hv[7]);
                lo.x = pk2(hv[0] - bflo(hi.x), hv[1] - bfhi(hi.x)); lo.y = pk2(hv[2] - bflo(hi.y), hv[3] - bfhi(hi.y));
                lo.z = pk2(hv[4] - bflo(hi.z), hv[5] - bfhi(hi.z)); lo.w = pk2(hv[6] - bflo(hi.w), hv[7] - bfhi(hi.w));
                { v2u q; q.x = q8x4(hv[0], hv[1], hv[2], hv[3], qsc); q.y = q8x4(hv[4], hv[5], hv[6], hv[7], qsc); *(v2u*)(HN + (size_t)row * DMODEL + 32 * i + 8 * g) = q; }
                const bf16x8 ah = __builtin_bit_cast(bf16x8, hi), al = __builtin_bit_cast(bf16x8, lo);
#pragma unroll
                for (int q = 0; q < 3; ++q) {
                    const bf16x8 bh = *(const bf16x8*)(WRH + (size_t)(16 * q + n16) * 1024 + 32 * i + 8 * g), bl = *(const bf16x8*)(WRL + (size_t)(16 * q + n16) * 1024 + 32 * i + 8 * g);
                    acc[q] = __builtin_amdgcn_mfma_f32_16x16x32_bf16(ah, bh, acc[q], 0, 0, 0);
                    acc[q] = __builtin_amdgcn_mfma_f32_16x16x32_bf16(ah, bl, acc[q], 0, 0, 0);
                    acc[q] = __builtin_amdgcn_mfma_f32_16x16x32_bf16(al, bh, acc[q], 0, 0, 0);
                }
            }
#pragma unroll
            for (int q = 0; q < 3; ++q)
#pragma unroll
                for (int r = 0; r < 4; ++r) lg[(4 * g + r) * 48 + 16 * q + n16] = acc[q][r];
            asm volatile("s_waitcnt lgkmcnt(0)" ::: "memory");
            if (lane < 16) {
                const LAS float* L = lg + lane * 48; tok = rt * 16 + lane;
                float gm = L[0]; int gs = 0;
#pragma unroll
                for (int q = 1; q < 4; ++q) if (L[q] > gm) { gm = L[q]; gs = q; }
                float gsum = 0.f;
#pragma unroll
                for (int q = 0; q < 4; ++q) gsum += __expf(L[q] - gm);
                const float gp_top = 1.0f / gsum;
                float fv[8];
#pragma unroll
                for (int q = 0; q < 8; ++q) { float v = L[4 + q]; v = (gs == 1) ? L[12 + q] : v; v = (gs == 2) ? L[20 + q] : v; v = (gs == 3) ? L[28 + q] : v; fv[q] = v; }
                float m1 = fv[0]; int i1 = 0;
#pragma unroll
                for (int q = 1; q < 8; ++q) if (fv[q] > m1) { m1 = fv[q]; i1 = q; }
                float m2 = -3.0e38f; int i2 = 0;
#pragma unroll
                for (int q = 0; q < 8; ++q) if (q != i1 && fv[q] > m2) { m2 = fv[q]; i2 = q; }
                const float e2 = __expf(m2 - m1); g1 = gp_top / (1.0f + e2); g2 = gp_top * e2 / (1.0f + e2);
                ex1 = gs * 8 + i1; ex2 = gs * 8 + i2;
                l1 = __hip_atomic_fetch_add(hist + ex1, 1u, __ATOMIC_RELAXED, __HIP_MEMORY_SCOPE_WORKGROUP); l2 = __hip_atomic_fetch_add(hist + ex2, 1u, __ATOMIC_RELAXED, __HIP_MEMORY_SCOPE_WORKGROUP);
            }
        }
        __syncthreads();
        if (F.tid < 32) { const unsigned hcount = hist[F.tid]; base[F.tid] = hcount ? atomicAdd(gcnt + F.tid * 8 + sub, hcount) : 0u; }
        __syncthreads();
        if (tok >= 0) {
            const int s1 = (int)(base[ex1] + l1), s2 = (int)(base[ex2] + l2);
            LIST[(size_t)(ex1 * 8 + sub) * TT + s1] = tok; LIST[(size_t)(ex2 * 8 + sub) * TT + s2] = tok;
            TokRec tr; tr.e[0] = ex1; tr.e[1] = ex2; tr.row[0] = (sub << 24) | s1; tr.row[1] = (sub << 24) | s2; tr.gate[0] = g1; tr.gate[1] = g2;
            TOK[tok] = tr;
        }
    }
}

DI void build_etab(Frame& F) {
    LAS unsigned* etab = (LAS unsigned*)(F.lds + ETAB_OFF);
    if (F.tid < 32) {
        const unsigned* gcnt = (const unsigned*)(F.ws + WS_CTL) + CW_CNT + F.tid * 8; unsigned acc = 0;
#pragma unroll
        for (int q = 0; q < 8; ++q) { const unsigned c = __hip_atomic_load(gcnt + q, __ATOMIC_RELAXED, __HIP_MEMORY_SCOPE_AGENT); etab[96 + 8 * F.tid + q] = acc; acc += c; }
        etab[64 + F.tid] = acc; etab[2 * F.tid + 1] = (acc + 255u) >> 8;
    }
    __syncthreads();
    if (F.tid == 0) { unsigned acc = 0; for (int e = 0; e < NEXP; ++e) { etab[2 * e] = acc; acc += etab[2 * e + 1]; } }
    if (F.wave == 1) { const float am = act_absmax(F.in[10], F.lane); if (F.lane == 0) ((LAS float*)etab)[352] = am * (1.0f / 127.0f); }
    __syncthreads();
}

DI void p11_final(Frame& F) {
    build_etab(F);
    const LAS unsigned* etab = (const LAS unsigned*)(F.lds + ETAB_OFF);
    const int gw = F.vcu * NWAVES + F.wave, NGW = F.G * NWAVES, lane = F.lane;
    const bf16* Y = (const bf16*)(F.ws + WS_XBUF); const TokRec* TOK = (const TokRec*)(F.ws + WS_TOK); const float* fw = F.in[16];
    const f32x4 w0 = *(const f32x4*)(fw + lane * 8), w1 = *(const f32x4*)(fw + lane * 8 + 4), w2 = *(const f32x4*)(fw + 512 + lane * 8), w3 = *(const f32x4*)(fw + 516 + lane * 8);
    constexpr int NB2 = 2;
    for (int t0 = gw; t0 < TT; t0 += NB2 * NGW) {
        TokRec tr[NB2]; v4u xa[NB2][2]; v4u ya[NB2][2][2];
#pragma unroll
        for (int u = 0; u < NB2; ++u) { const int t = (t0 + u * NGW < TT) ? t0 + u * NGW : t0; tr[u] = TOK[t];
            const bf16* xr = (const bf16*)(F.ws + WS_X1) + (size_t)t * DMODEL + lane * 8;
            xa[u][0] = *(const v4u*)(xr); xa[u][1] = *(const v4u*)(xr + 512); }
#pragma unroll
        for (int u = 0; u < NB2; ++u)
#pragma unroll
            for (int k = 0; k < 2; ++k) { const unsigned rk = (unsigned)tr[u].row[k]; const bf16* yr = Y + (size_t)(etab[2 * tr[u].e[k]] * 256u + etab[96 + 8 * tr[u].e[k] + (rk >> 24)] + (rk & 0xffffffu)) * DMODEL + lane * 8; ya[u][k][0] = *(const v4u*)(yr); ya[u][k][1] = *(const v4u*)(yr + 512); }
#pragma unroll
        for (int u = 0; u < NB2; ++u) {
            const int t = t0 + u * NGW; if (t >= TT) break;
            float v[16] = {bflo(xa[u][0].x), bfhi(xa[u][0].x), bflo(xa[u][0].y), bfhi(xa[u][0].y), bflo(xa[u][0].z), bfhi(xa[u][0].z), bflo(xa[u][0].w), bfhi(xa[u][0].w),
                           bflo(xa[u][1].x), bfhi(xa[u][1].x), bflo(xa[u][1].y), bfhi(xa[u][1].y), bflo(xa[u][1].z), bfhi(xa[u][1].z), bflo(xa[u][1].w), bfhi(xa[u][1].w)};
#pragma unroll
            for (int k = 0; k < 2; ++k) {
                const float gk = tr[u].gate[k]; const v4u y0 = ya[u][k][0], y1 = ya[u][k][1];
                v[0] += gk * bflo(y0.x); v[1] += gk * bfhi(y0.x); v[2] += gk * bflo(y0.y); v[3] += gk * bfhi(y0.y); v[4] += gk * bflo(y0.z); v[5] += gk * bfhi(y0.z); v[6] += gk * bflo(y0.w); v[7] += gk * bfhi(y0.w);
                v[8] += gk * bflo(y1.x); v[9] += gk * bfhi(y1.x); v[10] += gk * bflo(y1.y); v[11] += gk * bfhi(y1.y); v[12] += gk * bflo(y1.z); v[13] += gk * bfhi(y1.z); v[14] += gk * bflo(y1.w); v[15] += gk * bfhi(y1.w);
            }
            float ss = 0.f;
#pragma unroll
            for (int i = 0; i < 16; ++i) ss += v[i] * v[i];
            const float rs = __builtin_amdgcn_rsqf(wave_sum(ss) * (1.f / DMODEL) + EPS);
            float* orow = F.out + (size_t)t * DMODEL + lane * 8;
            *(f32x4*)(orow) = (f32x4){v[0] * rs * w0.x, v[1] * rs * w0.y, v[2] * rs * w0.z, v[3] * rs * w0.w};
            *(f32x4*)(orow + 4) = (f32x4){v[4] * rs * w1.x, v[5] * rs * w1.y, v[6] * rs * w1.z, v[7] * rs * w1.w};
            *(f32x4*)(orow + 512) = (f32x4){v[8] * rs * w2.x, v[9] * rs * w2.y, v[10] * rs * w2.z, v[11] * rs * w2.w};
            *(f32x4*)(orow + 516) = (f32x4){v[12] * rs * w3.x, v[13] * rs * w3.y, v[14] * rs * w3.z, v[15] * rs * w3.w};
        }
    }
}

struct Args { const float* in[17]; float* out; unsigned char* ws; int ph_lo, ph_hi; };
__global__ void __launch_bounds__(NTHREADS, 2) fwd_kernel(Args args) {
    extern __shared__ __attribute__((aligned(16))) unsigned char lds[];
    cg::grid_group grid = cg::this_grid();
    Frame F;
    F.lds = (LAS unsigned char*)lds; F.tid = threadIdx.x; F.lane = F.tid & 63; F.wave = __builtin_amdgcn_readfirstlane(F.tid >> 6);
    F.G = gridDim.x; { const int bx = blockIdx.x; F.vcu = (F.G % 8 == 0) ? (bx % 8) * (F.G / 8) + bx / 8 : bx; }
#pragma unroll
    for (int i = 0; i < 17; ++i) F.in[i] = args.in[i];
    F.out = args.out; F.ws = args.ws;
    const int lo = args.ph_lo, hi = args.ph_hi;
    if (F.tid < 16) ((volatile LAS unsigned*)(F.lds + MISC_OFF))[F.tid] = 0u;
    __syncthreads();
    XcdBarrier bar = xcd_barrier_post((unsigned*)(F.ws + WS_CTL) + CW_BAR, (volatile LAS unsigned*)(F.lds + MISC_OFF));
    if (lo > 1000) grid.sync();
#ifndef PHSEL
#define PHSEL 0xfff
#endif
#define IN(k) (((PHSEL >> (k)) & 1) && lo <= (k) && (k) < hi)
#define SEAM(k) do { if (IN(k) && IN((k) + 1)) xcd_barrier(bar); } while (0)
#ifndef REP_PH
#define REP_PH -1
#endif
#define REPS(k) for (int rep_ = 0; rep_ < ((k) == REP_PH ? 2 : 1); ++rep_, ((k) == REP_PH && rep_ < 2) ? xcd_barrier(bar) : (void)0)
    if (IN(0)) REPS(0) { p0_prologue(F); } SEAM(0);
    if (IN(1)) REPS(1) {
        pg8::Gemm gm{(const pg8::bf16_t*)(F.ws + WS_XN), (const pg8::bf16_t*)(F.ws + WS_WIN), TT, NPROJ, DMODEL / 2};
        pg8::StaticOrder S; S.init(TT, NPROJ, F.G, (int)blockIdx.x);
        EpiProj E{(bf16*)(F.ws + WS_QKVA), (bf16*)(F.ws + WS_ZA), (bf16*)(F.ws + WS_QKVB), (const float*)(F.ws + WS_WSI), (const float*)(F.ws + WS_XSC)};
        pg8::gemm_phase_gather<EpiProj, pg8::StaticOrder, IdRows, true, true>(F.lds, gm, S, E, IdRows{});
    } SEAM(1);
    if (IN(2)) REPS(2) {
#ifndef NO_ROPE
        p2_rope(F);
#ifdef PROBE_ROPE2
        xcd_barrier(bar); p2_rope(F);
#endif
#endif
#ifndef NO_PRE
        p2_gdn_pre(F);
#ifdef PROBE_PRE2
        xcd_barrier(bar); p2_gdn_pre(F);
#endif
#endif
    } SEAM(2);
    if (IN(3)) REPS(3) {
        const attn_body::AttnTensors AT{(const attn_body::bf16*)((unsigned char*)F.out + DO_QR), (const attn_body::bf16*)((unsigned char*)F.out + DO_KR), (const attn_body::bf16*)((unsigned char*)F.out + DO_VR),
                                        (attn_body::bf16*)(F.ws + WS_OCAT) + 512};
        const attn_body::StaticOrder S((int)F.G, (int)blockIdx.x);
#ifdef PROBE_ZERO_ATTN
        { (void)AT; (void)S; bf16* OC = (bf16*)(F.ws + WS_OCAT); const int gt = blockIdx.x * NTHREADS + F.tid, GT = F.G * NTHREADS;
          for (int i = gt; i < TT * 64; i += GT) { const int t = i >> 6, c = i & 63; *(v4u*)(OC + (size_t)t * 1024 + 512 + c * 8) = (v4u){0u, 0u, 0u, 0u}; } }
#else
        const float nshift = -(0.125f * 1.4426950408889634f * 64.f * 1.01f) * wave_max(fabsf(F.in[7][F.lane])) * wave_max(fabsf(F.in[8][F.lane]));
        attn_body::attn_phase<attn_body::StaticOrder>((char*)lds, AT, S, nshift);
#endif
    } SEAM(3);
#ifdef PROBE_SCAN2
    if (IN(4)) { p4_scan(F); xcd_barrier(bar); p4_scan(F); } SEAM(4);
#else
    if (IN(4)) REPS(4) { p4_scan(F); } SEAM(4);
#endif
    if (IN(5)) REPS(5) { p5_combine(F); if (F.G <= 128) { small_weights(F, F.vcu * NWAVES + F.wave, F.G * NWAVES); moe_weights(F, F.vcu, F.G); } } SEAM(5);
    if (IN(6)) REPS(6) {
        pg8::Gemm gm{(const pg8::bf16_t*)(F.ws + WS_OCAT), (const pg8::bf16_t*)(F.ws + WS_WOUT), TT, DMODEL, DMODEL}; pg8::StaticOrder S; S.init(TT, DMODEL, F.G, (int)blockIdx.x);
        EpiResid E{F.in[0], (bf16*)(F.ws + WS_X1)};
        pg8::gemm_phase<EpiResid, pg8::StaticOrder, true, true>(F.lds, gm, S, E);
    } SEAM(6);
    if (IN(7)) { p7_route(F); } SEAM(7);
    if (IN(9)) REPS(9) {
        build_etab(F);
        pg8::Gemm gm{(const pg8::bf16_t*)((unsigned char*)F.out + DO_HN), (const pg8::bf16_t*)(F.ws + WS_WGU0), 0, 0, DMODEL / 2};
        MoeOrder S{(const LAS unsigned*)(F.lds + ETAB_OFF), F.G, (int)blockIdx.x, WGU_SPLIT, (int)((WS_WGU1 - WS_WGU0) / (256 * 1024))};
        MoeRows AM{(const int*)(F.ws + WS_LIST), (const LAS unsigned*)(F.lds + ETAB_OFF)};
        EpiGU E{(bf16*)(F.ws + WS_HID), (const float*)(F.ws + WS_WSC), ((const LAS float*)(F.lds + ETAB_OFF))[352]};
        pg8::gemm_phase_gather<EpiGU, MoeOrder, MoeRows, true, true>(F.lds, gm, S, E, AM);
    } SEAM(9);
    if (IN(10)) REPS(10) {
        pg8::Gemm gm{(const pg8::bf16_t*)(F.ws + WS_HID), (const pg8::bf16_t*)((unsigned char*)F.out + DO_WD0), 0, 0, FFE}; build_etab(F); MoeOrder S{(const LAS unsigned*)(F.lds + ETAB_OFF), F.G, (int)blockIdx.x, WD_SPLIT, (int)((DO_WD1 - DO_WD0) / (256 * 1024))};
        EpiY E{(bf16*)(F.ws + WS_XBUF)};
        pg8::gemm_phase<EpiY, MoeOrder, true, true>(F.lds, gm, S, E);
    } SEAM(10);
#ifdef EXTRA_SYNCS
    for (int q_ = 0; q_ < EXTRA_SYNCS; ++q_) xcd_barrier(bar);
#endif
    if (IN(11)) { p11_final(F); }
#undef IN
#undef SEAM
}

extern "C" void kernel_launch(void* const* d_in, const int* in_sizes, int n_in, void* d_out, int out_size, void* d_ws, size_t ws_size, hipStream_t stream) {
    static int grid = 0;
    if (grid == 0) {
        if (n_in != 17 || out_size != TT * DMODEL || ws_size < WS_END) { fprintf(stderr, "kernel_launch: unexpected problem (n_in %d out %d ws %zu)\n", n_in, out_size, ws_size); grid = -1; return; }
        int dev = 0, cus = 0, per_cu = 0;
        if (hipGetDevice(&dev) != hipSuccess || hipDeviceGetAttribute(&cus, hipDeviceAttributeMultiprocessorCount, dev) != hipSuccess) { grid = -1; return; }
        if (hipFuncSetAttribute((const void*)fwd_kernel, hipFuncAttributeMaxDynamicSharedMemorySize, LDS_BYTES) != hipSuccess) { fprintf(stderr, "hipFuncSetAttribute failed\n"); grid = -1; return; }
        if (hipOccupancyMaxActiveBlocksPerMultiprocessor(&per_cu, (const void*)fwd_kernel, NTHREADS, LDS_BYTES) != hipSuccess || per_cu < 1) { fprintf(stderr, "occupancy query: %d\n", per_cu); grid = -1; return; }
        grid = cus;
    }
    if (grid < 0) return;
    (void)hipMemsetAsync((char*)d_ws + WS_CTL, 0, CTL_ZERO_BYTES, stream);
    Args a{};
    for (int i = 0; i < 17; ++i) a.in[i] = (const float*)d_in[i];
    a.out = (float*)d_out; a.ws = (unsigned char*)d_ws;
#if MK_PER_PHASE
    for (int p = 0; p < N_PHASES; ++p) { a.ph_lo = p; a.ph_hi = p + 1; hipLaunchKernelGGL(fwd_kernel, dim3(grid), dim3(NTHREADS), LDS_BYTES, stream, a); }
#else
    a.ph_lo = 0; a.ph_hi = N_PHASES;
    void* kargs[] = {&a};
    hipError_t e = hipLaunchCooperativeKernel((void*)fwd_kernel, dim3(grid), dim3(NTHREADS), kargs, LDS_BYTES, stream);
    if (e != hipSuccess) fprintf(stderr, "cooperative launch failed: %s (grid %d)\n", hipGetErrorString(e), grid);
#endif
}
```

```cpp
#include <hip/hip_runtime.h>
#include <cstdio>
#include <cstdint>
namespace pg8 {
#define PG8_LAS __attribute__((address_space(3)))
typedef unsigned short bf16_t;
typedef short bf16x8 __attribute__((ext_vector_type(8)));
typedef float f32x4 __attribute__((ext_vector_type(4)));
typedef unsigned u32x4 __attribute__((ext_vector_type(4)));
constexpr int BM = 256, BK = 64, HALF = 128, HTB = HALF * BK * 2  , STAGE_BYTES = 8 * HTB, NXCD = 8, WGM = 8;

__host__ __device__ __forceinline__ int lds_byte(int r, int c) { const int st = (r >> 4) * 2 + (c >> 5), rr = r & 15, cc = c & 31, ob = rr * 64 + cc * 2; return st * 1024 + (ob ^ (((ob >> 9) & 1) << 5)); }
__host__ __device__ __forceinline__ void stage_rc(int b, int& R, int& C) { const int st = b / 1024, sb = b % 1024, swz = sb ^ (((sb >> 9) & 1) << 5); R = (st >> 1) * 16 + swz / 64; C = (st & 1) * 32 + (swz % 64) / 2; }
__host__ __device__ __forceinline__ int perm32(int rho) { const int n = rho >> 4, i = rho & 15; return 8 * (i >> 2) + 4 * n + (i & 3); }

struct Unit { int pm, pn, ex, tq; };
struct Gemm { const bf16_t* A; const bf16_t* Bt; int M, N, K; };

struct StaticOrder {
    int nM, nN, nwg, G, c;
    __host__ __device__ void init(int M, int N, int G_, int c_) { nM = M / BM; nN = N / BM; nwg = nM * nN; G = G_; c = c_; }
    __host__ __device__ bool next(int i, Unit& u) const {
        const long L = (long)i * G + c; if (L >= nwg) return false;
        int wgid = (int)L; { const int q = nwg / NXCD, r = nwg % NXCD, xcd = wgid % NXCD, off = wgid / NXCD; wgid = (xcd < r ? xcd * (q + 1) : r * (q + 1) + (xcd - r) * q) + off; }
        const int nig = WGM * nN, gid = wgid / nig, fm = gid * WGM, gsz = (nM - fm) < WGM ? (nM - fm) : WGM;
        u.pm = fm + ((wgid % nig) % gsz); u.pn = (wgid % nig) / gsz; return true;
    }
    __device__ __forceinline__ void a_ready(const Unit&) const {}
    __device__ __forceinline__ void done(const Unit&) const {}
};

__device__ __forceinline__ unsigned cvt_pk_bf16(float lo, float hi) { unsigned r; asm volatile("v_cvt_pk_bf16_f32 %0, %1, %2" : "=v"(r) : "v"(lo), "v"(hi)); return r; }
typedef float f32x2 __attribute__((ext_vector_type(2)));
template <class Epi, class Sched, bool ALIGN_EPI = false, bool SP2 = false>
__device__ __forceinline__ void gemm_phase(PG8_LAS unsigned char* lds, const Gemm g, const Sched& S, const Epi& E) {
    const int tid = threadIdx.x, wid = __builtin_amdgcn_readfirstlane(tid >> 6), lane = tid & 63, wr = wid >> 2, wc = wid & 3, fr = lane & 15, fq = lane >> 4;
    const int K = g.K, nt = K / BK;
    unsigned voffA[2], voffB[2];
#pragma unroll
    for (int i = 0; i < 2; ++i) { int R, C; stage_rc(tid * 16 + i * 8192, R, C); const int Rb = Epi::PERM ? ((R & ~31) + perm32(R & 31)) : R;
        voffA[i] = (unsigned)(R * K + C) * 2u; voffB[i] = (unsigned)(Rb * K + C) * 2u; }
    const size_t kstep = (size_t)(BK * 2);
    const size_t hstep = (size_t)HALF * K * 2;
    const size_t tstep = 2 * hstep;
    const unsigned ldsw = (unsigned)wid * 1024u;
    const int aoff = lds_byte(wr * 64 + fr, fq * 8), boff = lds_byte(wc * 32 + fr, fq * 8);
#define PG8_SA(b, h) (((b) * 2 + (h)) * HTB)
#define PG8_SB(b, h) ((4 + (b) * 2 + (h)) * HTB)
#define PG8_STAGE(bufoff, gbase, voff) do { _Pragma("unroll") for (int _i = 0; _i < 2; ++_i) \
        __builtin_amdgcn_global_load_lds((const unsigned*)((const char*)(gbase) + (voff)[_i]), (PG8_LAS unsigned*)(lds + (bufoff) + ldsw + _i * 8192), 16, 0, 0); } while (0)
#define PG8_LDA(dst, b, h) do { _Pragma("unroll") for (int m = 0; m < 4; ++m) _Pragma("unroll") for (int k = 0; k < 2; ++k) dst[m][k] = *(const PG8_LAS bf16x8*)(lds + PG8_SA(b, h) + aoff + m * 2048 + k * 1024); } while (0)
#define PG8_LDB(dst, b, h) do { _Pragma("unroll") for (int n = 0; n < 2; ++n) _Pragma("unroll") for (int k = 0; k < 2; ++k) dst[n][k] = *(const PG8_LAS bf16x8*)(lds + PG8_SB(b, h) + boff + n * 2048 + k * 1024); } while (0)
#define PG8_MMA(ai, bj, At, Bt) do { __builtin_amdgcn_s_setprio(1); _Pragma("unroll") for (int m = 0; m < 4; ++m) _Pragma("unroll") for (int n = 0; n < 2; ++n) _Pragma("unroll") for (int k = 0; k < 2; ++k) \
        acc[ai][bj][m][n] = __builtin_amdgcn_mfma_f32_16x16x32_bf16(Bt[n][k], At[m][k], acc[ai][bj][m][n], 0, 0, 0); __builtin_amdgcn_s_setprio(0); } while (0)
#define PG8_WAIT_V(n) asm volatile("s_waitcnt vmcnt(" #n ")" ::: "memory")
#define PG8_WAIT_L(n) asm volatile("s_waitcnt lgkmcnt(" #n ")" ::: "memory")
#define PG8_BAR __builtin_amdgcn_s_barrier()
#define PG8_SCHED __builtin_amdgcn_sched_barrier(0)
    Unit cur, nxt; int ui = 0;
    if (!S.next(0, cur)) return;
    f32x4 acc[2][2][4][2];
#pragma unroll
    for (int a = 0; a < 2; ++a)
#pragma unroll
        for (int b = 0; b < 2; ++b)
#pragma unroll
            for (int m = 0; m < 4; ++m)
#pragma unroll
                for (int n = 0; n < 2; ++n) acc[a][b][m][n] = (f32x4){0.f, 0.f, 0.f, 0.f};
    bf16x8 At[4][2], B0[2][2], B1[2][2];
    const char* cA = (const char*)g.A + (size_t)cur.pm * tstep; const char* cB = (const char*)g.Bt + (size_t)cur.pn * tstep;
    S.a_ready(cur);
    if constexpr (SP2) {
        PG8_STAGE(PG8_SB(0, 0), cB, voffB); PG8_STAGE(PG8_SB(0, 1), cB + hstep, voffB); PG8_STAGE(PG8_SA(0, 0), cA, voffA); PG8_STAGE(PG8_SA(0, 1), cA + hstep, voffA);
        if (wr == 1) PG8_BAR;
        PG8_WAIT_V(2); PG8_BAR;
        PG8_STAGE(PG8_SB(1, 0), cB + kstep, voffB); PG8_STAGE(PG8_SA(1, 0), cA + kstep, voffA); PG8_STAGE(PG8_SB(1, 1), cB + hstep + kstep, voffB);
        PG8_WAIT_V(6); PG8_BAR;
    } else {
        PG8_STAGE(PG8_SB(0, 0), cB, voffB); PG8_STAGE(PG8_SA(0, 0), cA, voffA); PG8_STAGE(PG8_SB(0, 1), cB + hstep, voffB); PG8_STAGE(PG8_SA(0, 1), cA + hstep, voffA);
        if (wr == 1) PG8_BAR;
        PG8_WAIT_V(4); PG8_BAR;
        PG8_STAGE(PG8_SB(1, 0), cB + kstep, voffB); PG8_STAGE(PG8_SA(1, 0), cA + kstep, voffA); PG8_STAGE(PG8_SB(1, 1), cB + hstep + kstep, voffB);
        PG8_WAIT_V(6); PG8_BAR;
    }
    for (;;) {
        const bool has_next = S.next(ui + 1, nxt);
        const char* nA = has_next ? (const char*)g.A + (size_t)nxt.pm * tstep : cA; const char* nB = has_next ? (const char*)g.Bt + (size_t)nxt.pn * tstep : cB;
        for (int t = 0; t < nt; t += 2) {
            const bool last = (t == nt - 2);
            const char* a1 = cA + (size_t)(t + 1) * kstep;
            const char* a2 = last ? nA : cA + (size_t)(t + 2) * kstep; const char* b2 = last ? nB : cB + (size_t)(t + 2) * kstep;
            const char* a3 = a2 + kstep; const char* b3 = b2 + kstep;
            if (last && has_next) S.a_ready(nxt);
            if constexpr (SP2) {
            PG8_LDB(B0, 0, 0); PG8_LDB(B1, 0, 1); PG8_SCHED; PG8_LDA(At, 0, 0); PG8_STAGE(PG8_SA(1, 1), a1 + hstep, voffA);
            PG8_WAIT_V(8); PG8_WAIT_L(0); PG8_BAR; PG8_MMA(0, 0, At, B0); PG8_MMA(0, 1, At, B1); PG8_BAR; PG8_SCHED;
            PG8_LDA(At, 0, 1); PG8_STAGE(PG8_SB(0, 0), b2, voffB); PG8_STAGE(PG8_SB(0, 1), b2 + hstep, voffB); PG8_STAGE(PG8_SA(0, 0), a2, voffA);
            PG8_WAIT_V(8); PG8_WAIT_L(0); PG8_BAR; PG8_MMA(1, 0, At, B0); PG8_MMA(1, 1, At, B1); PG8_BAR; PG8_SCHED;
            PG8_LDB(B0, 1, 0); PG8_LDB(B1, 1, 1); PG8_SCHED; PG8_LDA(At, 1, 0); PG8_STAGE(PG8_SA(0, 1), a2 + hstep, voffA);
            PG8_WAIT_V(8); PG8_WAIT_L(0); PG8_BAR; PG8_MMA(0, 0, At, B0); PG8_MMA(0, 1, At, B1); PG8_BAR; PG8_SCHED;
            PG8_LDA(At, 1, 1); PG8_STAGE(PG8_SB(1, 0), b3, voffB); PG8_STAGE(PG8_SB(1, 1), b3 + hstep, voffB); PG8_STAGE(PG8_SA(1, 0), a3, voffA);
            PG8_WAIT_V(8); PG8_WAIT_L(0); PG8_BAR; PG8_MMA(1, 0, At, B0); PG8_MMA(1, 1, At, B1); PG8_BAR; PG8_SCHED;
            } else {
            PG8_LDB(B0, 0, 0); PG8_SCHED; PG8_LDA(At, 0, 0); PG8_STAGE(PG8_SA(1, 1), a1 + hstep, voffA);
            PG8_WAIT_L(8); PG8_BAR; PG8_WAIT_L(0); PG8_MMA(0, 0, At, B0); PG8_BAR; PG8_SCHED;
            PG8_LDB(B1, 0, 1); PG8_STAGE(PG8_SB(0, 0), b2, voffB);
            PG8_BAR; PG8_WAIT_L(0); PG8_MMA(0, 1, At, B1); PG8_BAR;
            PG8_LDA(At, 0, 1); PG8_STAGE(PG8_SA(0, 0), a2, voffA);
            PG8_BAR; PG8_WAIT_L(0); PG8_MMA(1, 0, At, B0); PG8_BAR; PG8_SCHED;
            PG8_STAGE(PG8_SB(0, 1), b2 + hstep, voffB);
            PG8_WAIT_V(6); PG8_BAR; PG8_MMA(1, 1, At, B1); PG8_BAR;
            PG8_LDB(B0, 1, 0); PG8_SCHED; PG8_LDA(At, 1, 0); PG8_STAGE(PG8_SA(0, 1), a2 + hstep, voffA);
            PG8_WAIT_L(8); PG8_BAR; PG8_WAIT_L(0); PG8_MMA(0, 0, At, B0); PG8_BAR; PG8_SCHED;
            PG8_LDB(B1, 1, 1); PG8_STAGE(PG8_SB(1, 0), b3, voffB);
            PG8_BAR; PG8_WAIT_L(0); PG8_MMA(0, 1, At, B1); PG8_BAR;
            PG8_LDA(At, 1, 1); PG8_STAGE(PG8_SA(1, 0), a3, voffA);
            PG8_BAR; PG8_WAIT_L(0); PG8_MMA(1, 0, At, B0); PG8_BAR; PG8_SCHED;
            PG8_STAGE(PG8_SB(1, 1), b3 + hstep, voffB);
            PG8_WAIT_V(6); PG8_BAR; PG8_MMA(1, 1, At, B1); PG8_BAR;
            }
        }
        if constexpr (ALIGN_EPI) { if (wr == 0) PG8_BAR; }
        if constexpr (!Epi::AFTER_DRAIN) { E(acc, cur, wr, wc, fr, fq); S.done(cur); }
        if (!has_next) break;
#pragma unroll
        for (int a = 0; a < 2; ++a)
#pragma unroll
            for (int b = 0; b < 2; ++b)
#pragma unroll
                for (int m = 0; m < 4; ++m)
#pragma unroll
                    for (int n = 0; n < 2; ++n) acc[a][b][m][n] = (f32x4){0.f, 0.f, 0.f, 0.f};
        cur = nxt; cA = nA; cB = nB; ++ui;
        if constexpr (ALIGN_EPI) { if (wr == 1) PG8_BAR; }
    }
    PG8_WAIT_V(0);
    if constexpr (!ALIGN_EPI) { if (wr == 0) PG8_BAR; }
    PG8_BAR;
    if constexpr (Epi::AFTER_DRAIN) { E.fused(acc, cur, wr, wc, fr, fq, lds, wid, lane); S.done(cur); }
#undef PG8_SA
#undef PG8_SB
#undef PG8_STAGE
#undef PG8_LDA
#undef PG8_LDB
#undef PG8_MMA
#undef PG8_WAIT_V
#undef PG8_WAIT_L
#undef PG8_BAR
#undef PG8_SCHED
}
typedef int i32x4 __attribute__((ext_vector_type(4)));
template <bool I8> struct AccSel { typedef f32x4 type; };
template <> struct AccSel<true> { typedef i32x4 type; };
template <bool I8> __device__ __forceinline__ void mma_step(typename AccSel<I8>::type& c, const bf16x8& b, const bf16x8& a) {
    if constexpr (I8) c = __builtin_amdgcn_mfma_i32_16x16x64_i8(__builtin_bit_cast(i32x4, b), __builtin_bit_cast(i32x4, a), c, 0, 0, 0);
    else c = __builtin_amdgcn_mfma_f32_16x16x32_bf16(b, a, c, 0, 0, 0);
}
template <class Epi, class Sched, class AMap, bool ALIGN_EPI = false, bool I8 = false>
__device__ __forceinline__ void gemm_phase_gather(PG8_LAS unsigned char* lds, const Gemm g, const Sched& S, const Epi& E, const AMap& AM) {
    constexpr bool SP2 = true;
    const int tid = threadIdx.x, wid = __builtin_amdgcn_readfirstlane(tid >> 6), lane = tid & 63, wr = wid >> 2, wc = wid & 3, fr = lane & 15, fq = lane >> 4;
    const int K = g.K, nt = K / BK;
    unsigned voffA[2], voffB[2]; int rowA[2];
#pragma unroll
    for (int i = 0; i < 2; ++i) { int R, C; stage_rc(tid * 16 + i * 8192, R, C); const int Rb = Epi::PERM ? ((R & ~31) + perm32(R & 31)) : R;
        voffA[i] = (unsigned)C * 2u; voffB[i] = (unsigned)(Rb * K + C) * 2u; rowA[i] = R; }
    const size_t kstep = (size_t)(BK * 2);
    const size_t hstep = (size_t)HALF * K * 2;
    const size_t tstep = 2 * hstep;
    const unsigned ldsw = (unsigned)wid * 1024u;
    const int aoff = lds_byte(wr * 64 + fr, fq * 8), boff = lds_byte(wc * 32 + fr, fq * 8);
#define PG8_SA(b, h) (((b) * 2 + (h)) * HTB)
#define PG8_SB(b, h) ((4 + (b) * 2 + (h)) * HTB)
#define PG8_STAGE(bufoff, gbase, voff) do { _Pragma("unroll") for (int _i = 0; _i < 2; ++_i) \
        __builtin_amdgcn_global_load_lds((const unsigned*)((const char*)(gbase) + (voff)[_i]), (PG8_LAS unsigned*)(lds + (bufoff) + ldsw + _i * 8192), 16, 0, 0); } while (0)
#define PG8_LDA(dst, b, h) do { _Pragma("unroll") for (int m = 0; m < 4; ++m) _Pragma("unroll") for (int k = 0; k < 2; ++k) dst[m][k] = *(const PG8_LAS bf16x8*)(lds + PG8_SA(b, h) + aoff + m * 2048 + k * 1024); } while (0)
#define PG8_LDB(dst, b, h) do { _Pragma("unroll") for (int n = 0; n < 2; ++n) _Pragma("unroll") for (int k = 0; k < 2; ++k) dst[n][k] = *(const PG8_LAS bf16x8*)(lds + PG8_SB(b, h) + boff + n * 2048 + k * 1024); } while (0)
#define PG8_MMA(ai, bj, At, Bt) do { __builtin_amdgcn_s_setprio(1); _Pragma("unroll") for (int m = 0; m < 4; ++m) _Pragma("unroll") for (int n = 0; n < 2; ++n) _Pragma("unroll") for (int k = 0; k < 2; ++k) \
        mma_step<I8>(acc[ai][bj][m][n], Bt[n][k], At[m][k]); __builtin_amdgcn_s_setprio(0); } while (0)
#define PG8_WAIT_V(n) asm volatile("s_waitcnt vmcnt(" #n ")" ::: "memory")
#define PG8_WAIT_L(n) asm volatile("s_waitcnt lgkmcnt(" #n ")" ::: "memory")
#define PG8_BAR __builtin_amdgcn_s_barrier()
#define PG8_SCHED __builtin_amdgcn_sched_barrier(0)
    Unit cur, nxt; int ui = 0;
    if (!S.next(0, cur)) return;
    typedef typename AccSel<I8>::type acc_t;
    acc_t acc[2][2][4][2];
#pragma unroll
    for (int a = 0; a < 2; ++a)
#pragma unroll
        for (int b = 0; b < 2; ++b)
#pragma unroll
            for (int m = 0; m < 4; ++m)
#pragma unroll
                for (int n = 0; n < 2; ++n) acc[a][b][m][n] = (acc_t){0, 0, 0, 0};
    bf16x8 At[4][2], B0[2][2], B1[2][2];
    const char* cA = (const char*)g.A; const char* cB = (const char*)g.Bt + (size_t)cur.pn * tstep;
    unsigned vA0[2], vA1[2], nA0[2], nA1[2];
#pragma unroll
    for (int i = 0; i < 2; ++i) { vA0[i] = (unsigned)AM.row(cur, rowA[i]) * (unsigned)(K * 2) + voffA[i]; vA1[i] = (unsigned)AM.row(cur, HALF + rowA[i]) * (unsigned)(K * 2) + voffA[i]; }
    S.a_ready(cur);
    if constexpr (SP2) {
        PG8_STAGE(PG8_SB(0, 0), cB, voffB); PG8_STAGE(PG8_SB(0, 1), cB + hstep, voffB); PG8_STAGE(PG8_SA(0, 0), cA, vA0); PG8_STAGE(PG8_SA(0, 1), cA, vA1);
        if (wr == 1) PG8_BAR;
        PG8_WAIT_V(2); PG8_BAR;
        PG8_STAGE(PG8_SB(1, 0), cB + kstep, voffB); PG8_STAGE(PG8_SA(1, 0), cA + kstep, vA0); PG8_STAGE(PG8_SB(1, 1), cB + hstep + kstep, voffB);
        PG8_WAIT_V(6); PG8_BAR;
    } else {
        PG8_STAGE(PG8_SB(0, 0), cB, voffB); PG8_STAGE(PG8_SA(0, 0), cA, voffA); PG8_STAGE(PG8_SB(0, 1), cB + hstep, voffB); PG8_STAGE(PG8_SA(0, 1), cA + hstep, voffA);
        if (wr == 1) PG8_BAR;
        PG8_WAIT_V(4); PG8_BAR;
        PG8_STAGE(PG8_SB(1, 0), cB + kstep, voffB); PG8_STAGE(PG8_SA(1, 0), cA + kstep, voffA); PG8_STAGE(PG8_SB(1, 1), cB + hstep + kstep, voffB);
        PG8_WAIT_V(6); PG8_BAR;
    }
    for (;;) {
        const bool has_next = S.next(ui + 1, nxt);
        const char* nA = cA; const char* nB = has_next ? (const char*)g.Bt + (size_t)nxt.pn * tstep : cB;
#pragma unroll
        for (int i = 0; i < 2; ++i) { nA0[i] = has_next ? (unsigned)AM.row(nxt, rowA[i]) * (unsigned)(K * 2) + voffA[i] : vA0[i]; nA1[i] = has_next ? (unsigned)AM.row(nxt, HALF + rowA[i]) * (unsigned)(K * 2) + voffA[i] : vA1[i]; }
        for (int t = 0; t < nt; t += 2) {
            const bool last = (t == nt - 2);
            const char* a1 = cA + (size_t)(t + 1) * kstep;
            const char* a2 = last ? nA : cA + (size_t)(t + 2) * kstep; const char* b2 = last ? nB : cB + (size_t)(t + 2) * kstep;
            const char* a3 = a2 + kstep; const char* b3 = b2 + kstep;
            unsigned s0[2], s1[2];
#pragma unroll
            for (int i = 0; i < 2; ++i) { s0[i] = vA0[i]; s1[i] = vA1[i]; }
            if (last) {
#pragma unroll
                for (int i = 0; i < 2; ++i) { unsigned t0_ = nA0[i], t1_ = nA1[i]; asm volatile("" : "+v"(t0_), "+v"(t1_)); s0[i] = t0_; s1[i] = t1_; } }
            if (last && has_next) S.a_ready(nxt);
            if constexpr (SP2) {
            PG8_LDB(B0, 0, 0); PG8_LDB(B1, 0, 1); PG8_SCHED; PG8_LDA(At, 0, 0); PG8_STAGE(PG8_SA(1, 1), a1, vA1);
            PG8_WAIT_V(8); PG8_WAIT_L(0); PG8_BAR; PG8_MMA(0, 0, At, B0); PG8_MMA(0, 1, At, B1); PG8_BAR; PG8_SCHED;
            PG8_LDA(At, 0, 1); PG8_STAGE(PG8_SB(0, 0), b2, voffB); PG8_STAGE(PG8_SB(0, 1), b2 + hstep, voffB); PG8_STAGE(PG8_SA(0, 0), a2, s0);
            PG8_WAIT_V(8); PG8_WAIT_L(0); PG8_BAR; PG8_MMA(1, 0, At, B0); PG8_MMA(1, 1, At, B1); PG8_BAR; PG8_SCHED;
            PG8_LDB(B0, 1, 0); PG8_LDB(B1, 1, 1); PG8_SCHED; PG8_LDA(At, 1, 0); PG8_STAGE(PG8_SA(0, 1), a2, s1);
            PG8_WAIT_V(8); PG8_WAIT_L(0); PG8_BAR; PG8_MMA(0, 0, At, B0); PG8_MMA(0, 1, At, B1); PG8_BAR; PG8_SCHED;
            PG8_LDA(At, 1, 1); PG8_STAGE(PG8_SB(1, 0), b3, voffB); PG8_STAGE(PG8_SB(1, 1), b3 + hstep, voffB); PG8_STAGE(PG8_SA(1, 0), a3, s0);
            PG8_WAIT_V(8); PG8_WAIT_L(0); PG8_BAR; PG8_MMA(1, 0, At, B0); PG8_MMA(1, 1, At, B1); PG8_BAR; PG8_SCHED;
            } else {
            PG8_LDB(B0, 0, 0); PG8_SCHED; PG8_LDA(At, 0, 0); PG8_STAGE(PG8_SA(1, 1), a1 + hstep, voffA);
            PG8_WAIT_L(8); PG8_BAR; PG8_WAIT_L(0); PG8_MMA(0, 0, At, B0); PG8_BAR; PG8_SCHED;
            PG8_LDB(B1, 0, 1); PG8_STAGE(PG8_SB(0, 0), b2, voffB);
            PG8_BAR; PG8_WAIT_L(0); PG8_MMA(0, 1, At, B1); PG8_BAR;
            PG8_LDA(At, 0, 1); PG8_STAGE(PG8_SA(0, 0), a2, voffA);
            PG8_BAR; PG8_WAIT_L(0); PG8_MMA(1, 0, At, B0); PG8_BAR; PG8_SCHED;
            PG8_STAGE(PG8_SB(0, 1), b2 + hstep, voffB);
            PG8_WAIT_V(6); PG8_BAR; PG8_MMA(1, 1, At, B1); PG8_BAR;
            PG8_LDB(B0, 1, 0); PG8_SCHED; PG8_LDA(At, 1, 0); PG8_STAGE(PG8_SA(0, 1), a2 + hstep, voffA);
            PG8_WAIT_L(8); PG8_BAR; PG8_WAIT_L(0); PG8_MMA(0, 0, At, B0); PG8_BAR; PG8_SCHED;
            PG8_LDB(B1, 1, 1); PG8_STAGE(PG8_SB(1, 0), b3, voffB);
            PG8_BAR; PG8_WAIT_L(0); PG8_MMA(0, 1, At, B1); PG8_BAR;
            PG8_LDA(At, 1, 1); PG8_STAGE(PG8_SA(1, 0), a3, voffA);
            PG8_BAR; PG8_WAIT_L(0); PG8_MMA(1, 0, At, B0); PG8_BAR; PG8_SCHED;
            PG8_STAGE(PG8_SB(1, 1), b3 + hstep, voffB);
            PG8_WAIT_V(6); PG8_BAR; PG8_MMA(1, 1, At, B1); PG8_BAR;
            }
        }
        if constexpr (ALIGN_EPI) { if (wr == 0) PG8_BAR; }
        if constexpr (!Epi::AFTER_DRAIN) { E(acc, cur, wr, wc, fr, fq); S.done(cur); }
        if (!has_next) break;
#pragma unroll
        for (int a = 0; a < 2; ++a)
#pragma unroll
            for (int b = 0; b < 2; ++b)
#pragma unroll
                for (int m = 0; m < 4; ++m)
#pragma unroll
                    for (int n = 0; n < 2; ++n) acc[a][b][m][n] = (acc_t){0, 0, 0, 0};
        cur = nxt; cA = nA; cB = nB; ++ui;
#pragma unroll
        for (int i = 0; i < 2; ++i) { vA0[i] = nA0[i]; vA1[i] = nA1[i]; }
        if constexpr (ALIGN_EPI) { if (wr == 1) PG8_BAR; }
    }
    PG8_WAIT_V(0);
    if constexpr (!ALIGN_EPI) { if (wr == 0) PG8_BAR; }
    PG8_BAR;
    if constexpr (Epi::AFTER_DRAIN) { E.fused(acc, cur, wr, wc, fr, fq, lds, wid, lane); S.done(cur); }
#undef PG8_SA
#undef PG8_SB
#undef PG8_STAGE
#undef PG8_LDA
#undef PG8_LDB
#undef PG8_MMA
#undef PG8_WAIT_V
#undef PG8_WAIT_L
#undef PG8_BAR
#undef PG8_SCHED
}
}
#include <hip/hip_bf16.h>
#include <cmath>
namespace attn_body {
using bf16=__hip_bfloat16;
using bf16x8=__attribute__((ext_vector_type(8)))short;
using s16x4=__attribute__((ext_vector_type(4)))short;
using f32x16=__attribute__((ext_vector_type(16)))float;
using u32x4=__attribute__((ext_vector_type(4)))unsigned;
constexpr int BATCH=2,NHEAD=8,NKVH=2,SEQ=8192,D=64,QP=512,KP=128,OP=1024;
constexpr int NW=8,QBLK=32,QB=QBLK*NW,KVBLK=64,NQB=SEQ/QB;
constexpr int ATTN_UNIT_ROWS=QB;
__device__ __forceinline__ int crow(int r,int hi){return (r&3)+8*(r>>2)+4*hi;}
#define SBAR() __builtin_amdgcn_sched_barrier(0)
__device__ __forceinline__ void cmask(f32x16&p0,f32x16&p1,int jb,int qrel,int hi){
  const float NEG=-INFINITY; int kb=64*jb+4*hi;
  #pragma unroll
  for(int r=0;r<16;++r){int kv=kb+(r&3)+8*(r>>2); if(kv>qrel)p0[r]=NEG; if(kv+32>qrel)p1[r]=NEG;}
}

constexpr int NSLOT=3, SLOTB=8192;
constexpr int LDS_K=0, LDS_V=NSLOT*SLOTB, LDS_WS=2*NSLOT*SLOTB, LDS_OST=LDS_WS+NW*64*4, LDS_BYTES=LDS_OST+NW*4096;
constexpr float C2=0.125f*1.4426950408889634f;
__device__ __forceinline__ void glds16(const void*gsrc,unsigned lds_dst){unsigned keep;
  asm volatile("s_mov_b32 %0, m0\n\ts_mov_b32 m0, %2\n\ts_nop 0\n\tglobal_load_lds_dwordx4 %1, off\n\ts_mov_b32 m0, %0":"=&s"(keep):"v"(gsrc),"s"(lds_dst):"memory");}
__device__ __forceinline__ float max3f(float a,float b,float c){float r;asm("v_max3_f32 %0, %1, %2, %3":"=v"(r):"v"(a),"v"(b),"v"(c));return r;}
__device__ __forceinline__ float max2f(float a,float b){float r;asm("v_max_f32_e32 %0, %1, %2":"=v"(r):"v"(a),"v"(b));return r;}
__device__ __forceinline__ float fadd_s(float a,float b){float r;asm("v_add_f32_e32 %0, %1, %2":"=v"(r):"v"(a),"v"(b));return r;}
__device__ __forceinline__ float fsub_s(float a,float b){float r;asm("v_sub_f32_e32 %0, %1, %2":"=v"(r):"v"(a),"v"(b));return r;}
typedef float f32x2_t __attribute__((ext_vector_type(2))); typedef __bf16 bf16x2_t __attribute__((ext_vector_type(2)));
__device__ __forceinline__ unsigned cvtpk_s(float lo,float hi){f32x2_t v={lo,hi};bf16x2_t b=__builtin_convertvector(v,bf16x2_t);return __builtin_bit_cast(unsigned,b);}
#define WAIT_BAR(N) asm volatile("s_waitcnt vmcnt(" #N ") lgkmcnt(0)\n\ts_barrier":::"memory")

__device__ __forceinline__ void qkt(f32x16&p0,f32x16&p1,const char*Kslot,const bf16x8*qr,const f32x16&negm,int r32,int hi){
  const char*kb=Kslot+hi*1024+r32*16;
  #pragma unroll
  for(int d0=0;d0<4;++d0){
    const bf16x8 b0=*reinterpret_cast<const bf16x8*>(kb+d0*2048);
    const bf16x8 b1=*reinterpret_cast<const bf16x8*>(kb+d0*2048+512);
    if(d0==0){p0=__builtin_amdgcn_mfma_f32_32x32x16_bf16(b0,qr[0],negm,0,0,0);p1=__builtin_amdgcn_mfma_f32_32x32x16_bf16(b1,qr[0],negm,0,0,0);}
    else{p0=__builtin_amdgcn_mfma_f32_32x32x16_bf16(b0,qr[d0],p0,0,0,0);p1=__builtin_amdgcn_mfma_f32_32x32x16_bf16(b1,qr[d0],p1,0,0,0);}}
}
typedef __attribute__((address_space(3))) const char* lds_cptr;
typedef short v4i16_t __attribute__((ext_vector_type(4)));
__device__ __forceinline__ void kload8(bf16x8*kf,lds_cptr kp){
  kf[0]=*(const __attribute__((address_space(3))) bf16x8*)(kp);      kf[1]=*(const __attribute__((address_space(3))) bf16x8*)(kp+512);
  kf[2]=*(const __attribute__((address_space(3))) bf16x8*)(kp+2048); kf[3]=*(const __attribute__((address_space(3))) bf16x8*)(kp+2560);
  kf[4]=*(const __attribute__((address_space(3))) bf16x8*)(kp+4096); kf[5]=*(const __attribute__((address_space(3))) bf16x8*)(kp+4608);
  kf[6]=*(const __attribute__((address_space(3))) bf16x8*)(kp+6144); kf[7]=*(const __attribute__((address_space(3))) bf16x8*)(kp+6656);
}
__device__ __forceinline__ void kload2(bf16x8*kf,lds_cptr kp,int j){ kf[2*j]=*(const __attribute__((address_space(3))) bf16x8*)(kp+j*2048); kf[2*j+1]=*(const __attribute__((address_space(3))) bf16x8*)(kp+j*2048+512); }
__device__ __forceinline__ s16x4 vtr(lds_cptr p){ return __builtin_bit_cast(s16x4,__builtin_amdgcn_ds_read_tr16_b64_v4i16((__attribute__((address_space(3))) v4i16_t*)p)); }
__device__ __forceinline__ float rowmax(const f32x16&p0,const f32x16&p1){
  float a=max3f(p0[0],p0[1],p1[0]),b=max3f(p0[2],p0[3],p1[1]);a=max3f(a,p1[2],p1[3]);
  #pragma unroll
  for(int r=4;r<16;r+=4){a=max3f(a,p0[r],p0[r+1]);b=max3f(b,p0[r+2],p0[r+3]);a=max3f(a,p1[r],p1[r+1]);b=max3f(b,p1[r+2],p1[r+3]);}
  const float m=max2f(a,b);
  auto rr=__builtin_amdgcn_permlane32_swap(__float_as_uint(m),__float_as_uint(m),false,false);
  return max2f(__uint_as_float(rr[0]),__uint_as_float(rr[1]));
}
__device__ __forceinline__ void pv(f32x16*o,int vb,bf16x8 pa0,bf16x8 pa1,bf16x8 pa2,bf16x8 pa3){
  #pragma unroll
  for(int d0=0;d0<2;++d0){s16x4 lo[4],hi[4];
    #pragma unroll
    for(int ks=0;ks<4;++ks){
      asm volatile("ds_read_b64_tr_b16 %0,%1 offset:%c2":"=&v"(lo[ks]):"v"(vb),"i"(d0*4096+ks*1024):"memory");
      asm volatile("ds_read_b64_tr_b16 %0,%1 offset:%c2":"=&v"(hi[ks]):"v"(vb),"i"(d0*4096+ks*1024+512):"memory");}
    asm volatile("s_waitcnt lgkmcnt(0)":::"memory");SBAR();
    #define PK(k) (bf16x8){lo[k][0],lo[k][1],lo[k][2],lo[k][3],hi[k][0],hi[k][1],hi[k][2],hi[k][3]}
    o[d0]=__builtin_amdgcn_mfma_f32_32x32x16_bf16(pa0,PK(0),o[d0],0,0,0);
    o[d0]=__builtin_amdgcn_mfma_f32_32x32x16_bf16(pa1,PK(1),o[d0],0,0,0);
    o[d0]=__builtin_amdgcn_mfma_f32_32x32x16_bf16(pa2,PK(2),o[d0],0,0,0);
    o[d0]=__builtin_amdgcn_mfma_f32_32x32x16_bf16(pa3,PK(3),o[d0],0,0,0);
    #undef PK
  }
}

#ifndef ATTN_STORE16
#define ATTN_STORE16(p,v) (*(u32x4*)(p)=(v))
#endif
template<int THRL> __device__ __forceinline__ void attn_unit(int b,int h,int qb,const bf16*Q,const bf16*__restrict__ K,const bf16*__restrict__ V,bf16*O,char*shm,const float nshift){
  const int tid=threadIdx.x,lane=tid&63,r32=lane&31,hi=lane>>5; const int wid=__builtin_amdgcn_readfirstlane(tid>>6);
  const long rowbase=(long)b*SEQ; const int q0=qb*QB;
  const bf16*Qw=Q+(rowbase+q0+wid*QBLK)*QP+h*D;
  const int hk=h/(NHEAD/NKVH); const bf16*Kh=K+(long)(b*NKVH+hk)*SEQ*D,*Vh=V+(long)(b*NKVH+hk)*SEQ*D;
  const unsigned lds0=(unsigned)(uintptr_t)shm;
  float*wsf=(float*)(shm+LDS_WS)+wid*64;
  const bf16*ksrc=Kh+(wid*64+lane)*8;
  const bf16*vsrc=Vh+(wid*64+lane)*8;
  const unsigned kdst=lds0+LDS_K+wid*1024, vdst=lds0+LDS_V+wid*1024;
  #define DMA_K(t,slot) glds16(ksrc+(long)(t)*KVBLK*D,(unsigned)__builtin_amdgcn_readfirstlane(kdst+(slot)))
  #define DMA_V(t,slot) glds16(vsrc+(long)(t)*KVBLK*D,(unsigned)__builtin_amdgcn_readfirstlane(vdst+(slot)))
  const int vb0=(int)(lds0+LDS_V)+((lane>>4)&1)*32+(lane&3)*8+(4*hi+((lane&15)>>2))*64;
  const char*Kbase=shm+LDS_K; bf16x8 kf[8];
  const lds_cptr shm3=(lds_cptr)shm; const lds_cptr kp0=shm3+LDS_K+hi*1024+r32*16; const lds_cptr vp0=shm3+LDS_V+((lane>>4)&1)*32+(lane&3)*8+(4*hi+((lane&15)>>2))*64;
  constexpr int NT=SEQ/KVBLK;
  DMA_K(0,0);DMA_V(0,0);DMA_K(1,SLOTB);
  bf16x8 qr[4];
  #pragma unroll
  for(int d0=0;d0<4;++d0)qr[d0]=*reinterpret_cast<const bf16x8*>(&Qw[(long)r32*QP+d0*16+hi*8]);
  float l_reg=0.f;f32x16 o[2];o[0]=f32x16{};o[1]=f32x16{};f32x16 negm;
  _Pragma("unroll") for(int r=0;r<16;++r)negm[r]=nshift; asm volatile("":"+v"(negm));
  const int qrel=wid*QBLK+r32;
  #define CMASK(P0,P1,t) do{}while(0)
  #define START(P0,P1) do{ _Pragma("unroll") for(int r=0;r<16;++r)P0[r]=__builtin_amdgcn_exp2f(P0[r]); }while(0)
  f32x16 pA0,pA1,pB0,pB1;
  int sl_prev=0,sl_cur=0,sl_next=SLOTB;
  #define ROT() do{sl_prev=sl_cur;sl_cur=sl_next;sl_next=(sl_next==(NSLOT-1)*SLOTB)?0:sl_next+SLOTB;}while(0)
  DMA_K(2,2*SLOTB);
  WAIT_BAR(3);
  qkt(pA0,pA1,Kbase,qr,negm,r32,hi);asm volatile("s_nop 15\n\ts_nop 7":"+v"(pA0),"+v"(pA1));CMASK(pA0,pA1,0);
  START(pA0,pA1);
  _Pragma("unroll") for(int r=0;r<16;++r)pA1[r]=__builtin_amdgcn_exp2f(pA1[r]);
  WAIT_BAR(0);
  DMA_K(3,0);DMA_V(1,SLOTB);
  ROT();
  kload8(kf,kp0+sl_cur);
  WAIT_BAR(2);
  s16x4 vlo[8],vhi[8]; u32x4 pw0,pw1,pw2,pw3;
  #define PKW(P,B) cvtpk_s(P[B],P[B+1])
  #define PAF(k) __builtin_bit_cast(bf16x8,pw##k)
  #define VFR(i) (bf16x8){vlo[i][0],vlo[i][1],vlo[i][2],vlo[i][3],vhi[i][0],vhi[i][1],vhi[i][2],vhi[i][3]}
  #define PIN(x) asm volatile("":"+v"(x))
  #define GAPA(MF,A0,A1,A2,A3,W0,W1,PW) do{ MF; sacc+=A0; sacc+=A1; sacc+=A2; sacc+=A3; PIN(sacc); W0; W1; PIN(PW); SBAR(); }while(0)
  #define EX(v) __builtin_amdgcn_exp2f(v)
  #define GAPB(MF,X,B) do{ MF; X[B]=EX(X[B]); X[B+1]=EX(X[B+1]); X[B+2]=EX(X[B+2]); X[B+3]=EX(X[B+3]); PIN(X); SBAR(); }while(0)
  #define VRD(i) do{ vlo[i]=vtr(vp_+(((i)>>2)*4096+((i)&3)*1024)); vhi[i]=vtr(vp_+(((i)>>2)*4096+((i)&3)*1024+512)); }while(0)
  #define KRD(G,j) do{ if(G){ kload2(kf,kp0+sl_next,j); SBAR(); } }while(0)
  #define STEP(C0,C1,P0,P1,t,GK,GV,GL) do{ SBAR(); \
    const lds_cptr vp_=vp0+sl_prev; \
    VRD(0); SBAR(); float sacc=(P0[0]+P0[1]); \
    GAPA(C0=__builtin_amdgcn_mfma_f32_32x32x16_bf16(kf[0],qr[0],negm,0,0,0), P0[2],P0[3],P0[4],P0[5],     pw0[0]=PKW(P0,0), pw0[1]=PKW(P0,2), pw0); \
    VRD(4); SBAR(); GAPA(C1=__builtin_amdgcn_mfma_f32_32x32x16_bf16(kf[1],qr[0],negm,0,0,0), P0[6],P0[7],P0[8],P0[9],     pw0[2]=PKW(P0,4), pw0[3]=PKW(P0,6), pw0); \
    VRD(1); SBAR(); GAPA(C0=__builtin_amdgcn_mfma_f32_32x32x16_bf16(kf[2],qr[1],C0,0,0,0),   P0[10],P0[11],P0[12],P0[13], pw1[0]=PKW(P0,8), pw1[1]=PKW(P0,10), pw1); \
    VRD(5); SBAR(); GAPA(C1=__builtin_amdgcn_mfma_f32_32x32x16_bf16(kf[3],qr[1],C1,0,0,0),   P0[14],P0[15],P1[0],P1[1],   pw1[2]=PKW(P0,12),pw1[3]=PKW(P0,14), pw1); \
    VRD(2); SBAR(); GAPA(C0=__builtin_amdgcn_mfma_f32_32x32x16_bf16(kf[4],qr[2],C0,0,0,0),   P1[2],P1[3],P1[4],P1[5],     pw2[0]=PKW(P1,0), pw2[1]=PKW(P1,2), pw2); \
    VRD(6); SBAR(); GAPA(C1=__builtin_amdgcn_mfma_f32_32x32x16_bf16(kf[5],qr[2],C1,0,0,0),   P1[6],P1[7],P1[8],P1[9],     pw2[2]=PKW(P1,4), pw2[3]=PKW(P1,6), pw2); \
    VRD(3); SBAR(); GAPA(C0=__builtin_amdgcn_mfma_f32_32x32x16_bf16(kf[6],qr[3],C0,0,0,0),   P1[10],P1[11],P1[12],P1[13], pw3[0]=PKW(P1,8), pw3[1]=PKW(P1,10), pw3); \
    VRD(7); SBAR(); GAPA(C1=__builtin_amdgcn_mfma_f32_32x32x16_bf16(kf[7],qr[3],C1,0,0,0),   P1[14],P1[15],0.f,0.f,       pw3[2]=PKW(P1,12),pw3[3]=PKW(P1,14), pw3); \
    l_reg+=sacc; \
    if(GK){DMA_K((t)+3,sl_cur);} if(GV){DMA_V((t)+1,sl_next);} \
    CMASK(C0,C1,t); \
    SBAR(); \
    GAPB(o[0]=__builtin_amdgcn_mfma_f32_32x32x16_bf16(PAF(0),VFR(0),o[0],0,0,0), C0,0); \
    GAPB(o[1]=__builtin_amdgcn_mfma_f32_32x32x16_bf16(PAF(0),VFR(4),o[1],0,0,0), C0,4); \
    KRD(GL,0); GAPB(o[0]=__builtin_amdgcn_mfma_f32_32x32x16_bf16(PAF(1),VFR(1),o[0],0,0,0), C0,8); \
    KRD(GL,1); GAPB(o[1]=__builtin_amdgcn_mfma_f32_32x32x16_bf16(PAF(1),VFR(5),o[1],0,0,0), C0,12); \
    KRD(GL,2); GAPB(o[0]=__builtin_amdgcn_mfma_f32_32x32x16_bf16(PAF(2),VFR(2),o[0],0,0,0), C1,0); \
    KRD(GL,3); GAPB(o[1]=__builtin_amdgcn_mfma_f32_32x32x16_bf16(PAF(2),VFR(6),o[1],0,0,0), C1,4); \
    GAPB(o[0]=__builtin_amdgcn_mfma_f32_32x32x16_bf16(PAF(3),VFR(3),o[0],0,0,0), C1,8); \
    GAPB(o[1]=__builtin_amdgcn_mfma_f32_32x32x16_bf16(PAF(3),VFR(7),o[1],0,0,0), C1,12); \
    }while(0)
  int t=1;
  #undef CMASK
  #define CMASK(P0,P1,t) do{}while(0)
  for(;t+5<NT;t+=2){
    STEP(pB0,pB1,pA0,pA1,t,true,true,true);     WAIT_BAR(2); ROT();
    STEP(pA0,pA1,pB0,pB1,t+1,true,true,true);   WAIT_BAR(2); ROT();
  }
  #undef CMASK
  #define CMASK(P0,P1,t) do{}while(0)
  #define ENDW(tt) do{ if((tt)+3<NT){WAIT_BAR(2);} else if((tt)+2<NT){WAIT_BAR(1);} else {WAIT_BAR(0);} }while(0)
  for(;t+1<NT;t+=2){
    STEP(pB0,pB1,pA0,pA1,t,(t+3<NT),(t+1<NT),(t+1<NT));       ENDW(t);   ROT();
    STEP(pA0,pA1,pB0,pB1,t+1,(t+4<NT),(t+2<NT),(t+2<NT));     ENDW(t+1); ROT();
  }
  STEP(pB0,pB1,pA0,pA1,NT-1,false,false,false);
  { float sacc=pB0[0]+pB0[1]; _Pragma("unroll") for(int r=2;r<16;++r)sacc+=pB0[r]; _Pragma("unroll") for(int r=0;r<16;++r)sacc+=pB1[r]; l_reg+=sacc;
    pw0=(u32x4){PKW(pB0,0),PKW(pB0,2),PKW(pB0,4),PKW(pB0,6)};pw1=(u32x4){PKW(pB0,8),PKW(pB0,10),PKW(pB0,12),PKW(pB0,14)};pw2=(u32x4){PKW(pB1,0),PKW(pB1,2),PKW(pB1,4),PKW(pB1,6)};pw3=(u32x4){PKW(pB1,8),PKW(pB1,10),PKW(pB1,12),PKW(pB1,14)};
    SBAR(); pv(o,vb0+sl_cur,PAF(0),PAF(1),PAF(2),PAF(3)); }
  #undef PKW
  #undef PAF
  #undef VFR
  #undef PIN
  #undef GAPA
  #undef GAPB
  #undef EX
  #undef VRD
  #undef KRD
  #undef STEP
  #undef ENDW
  {auto rr=__builtin_amdgcn_permlane32_swap(__float_as_uint(l_reg),__float_as_uint(l_reg),false,false);l_reg=__uint_as_float(rr[0])+__uint_as_float(rr[1]);}
  if(hi==0)wsf[32+r32]=l_reg;asm volatile("s_waitcnt lgkmcnt(0)":::"memory");
  float rli[16];
  #pragma unroll
  for(int r=0;r<16;++r)rli[r]=__builtin_amdgcn_rcpf(wsf[32+crow(r,hi)]);
  bf16*Ow=O+(rowbase+q0+wid*QBLK)*OP+h*D;
  { bf16*stg=(bf16*)(shm+LDS_OST)+wid*2048;
    #pragma unroll
    for(int r=0;r<16;++r){const int orow=crow(r,hi);
      #pragma unroll
      for(int d0=0;d0<2;++d0)stg[orow*64+d0*32+r32]=__float2bfloat16(o[d0][r]*rli[r]);}
    asm volatile("s_waitcnt lgkmcnt(0)":::"memory");
    #pragma unroll
    for(int i=0;i<4;++i){const int row=i*8+(lane>>3),ch=lane&7; const u32x4 v=*(const u32x4*)(stg+row*64+ch*8); ATTN_STORE16(Ow+(long)row*OP+ch*8,v);} }
  asm volatile("s_waitcnt lgkmcnt(0)\n\ts_barrier":::"memory");
  #undef DMA_K
  #undef DMA_V
  #undef CMASK
  #undef START
  #undef ROT
}
constexpr int ATTN_LDS_BYTES=LDS_BYTES;
struct AttnTensors { const bf16* Q; const bf16* K; const bf16* V; bf16* O; };
struct AttnUnit { int bh; int qb; };
struct StaticOrder {
  int vcu, G;
  __device__ __forceinline__ explicit StaticOrder(int grid,int block):vcu((grid%8==0)?(block%8)*(grid/8)+block/8:block),G(grid){}
  __device__ __forceinline__ bool next(int i,AttnUnit&u)const{
    const int L=i*G+vcu; if(L>=BATCH*NHEAD*NQB)return false;
    if(G==256){ if(i>=2)return false; const int x=vcu>>5,j=vcu&31; const int b=x>>2,kvh=(x>>1)&1,hq=kvh*4+2*(x&1)+i; u.bh=b*NHEAD+hq; u.qb=j; return true; }
    u.bh=L/NQB; u.qb=L%NQB; return true; }
  __device__ __forceinline__ void a_ready(const AttnUnit&)const{}
  __device__ __forceinline__ void done(const AttnUnit&)const{}
};
template<class Sched,int THRL=8> __device__ __forceinline__ void attn_phase(char*lds,const AttnTensors&T,const Sched&S,const float nshift){
  AttnUnit u;
  for(int i=0;S.next(i,u);++i){ S.a_ready(u); attn_unit<THRL>(u.bh/NHEAD,u.bh%NHEAD,u.qb,T.Q,T.K,T.V,T.O,lds,nshift); S.done(u); }
}
#undef SBAR
#undef WAIT_BAR
}

#include <hip/hip_cooperative_groups.h>
namespace cg = cooperative_groups;
#ifndef MK_PER_PHASE
#define MK_PER_PHASE 0
#endif
constexpr int NWAVES = 8, NTHREADS = 512;
constexpr int NB = 2, SEQ = 8192, DMODEL = 1024, TT = NB * SEQ;
constexpr int NPROJ = 2816;
constexpr int NEXP = 32, FFE = 512;
constexpr float EPS = 1e-6f;
constexpr int N_PHASES = 12;

constexpr size_t MiB = 1u << 20;
constexpr size_t WS_CTL = 0, CTL_ZERO_BYTES = 64 * 1024;
constexpr size_t WS_WOUT = 1 * MiB;
constexpr size_t WS_LIST = 229 * MiB;
constexpr size_t WS_WR = 3 * MiB;
constexpr size_t WS_TOK = 3 * MiB + 256 * 1024;
constexpr size_t WS_GATES = 4 * MiB;
constexpr size_t WS_WIN = 5 * MiB;
constexpr size_t WS_WSI = 3 * MiB + 896 * 1024;
constexpr size_t WS_XSC = 3 * MiB + 912 * 1024;
constexpr size_t WS_A = 11 * MiB;
constexpr size_t WS_XN = WS_A;
constexpr size_t GDN_SH_BYTES = 71680, GDN_D_BYTES = 19456;
constexpr size_t WS_GSH = WS_A;
constexpr size_t WS_GD = WS_A + 1024 * GDN_SH_BYTES;
constexpr size_t WS_X1 = 5 * MiB;
constexpr size_t WS_HID = 69 * MiB;
constexpr size_t WS_XBUF = 109 * MiB;
constexpr size_t WS_B = 157 * MiB;
constexpr size_t WS_QKVA = WS_B;
constexpr size_t WS_QKVB = WS_B + 48 * MiB;
constexpr size_t WS_ZA = WS_B + 72 * MiB;
constexpr size_t WS_OCAT = WS_B;
constexpr size_t WS_WGU0 = 189 * MiB, WS_WGU1 = 245 * MiB; constexpr int WGU_SPLIT = 20;
constexpr size_t WS_WSC = 3 * MiB + 768 * 1024;
constexpr float ACT_CLIP = 6.0f;
constexpr size_t DO_WD0 = 0, DO_WD1 = 56 * MiB; constexpr int WD_SPLIT = 24;
constexpr size_t DO_HN = 24 * MiB;
constexpr size_t WS_END = 269 * MiB;
static_assert(WS_GD + 4096 * GDN_D_BYTES <= WS_B, "GDN records fit region A");
static_assert(WS_X1 + 64 * MiB <= WS_HID && WS_HID + 40928ull * 1024 <= WS_XBUF && WS_XBUF + 40928ull * 2048 <= WS_WGU0, "post-scan map");
static_assert(WS_WGU0 + WGU_SPLIT * MiB <= WS_B + 72 * MiB && WS_WGU1 + (32 - WGU_SPLIT) * MiB <= 269 * MiB, "WGU fragments");
constexpr size_t DO_QR = 0, DO_KR = 16 * MiB, DO_VR = 20 * MiB, DO_OF = 24 * MiB, DO_OB = 40 * MiB;
constexpr int CW_CNT = 2048;
constexpr int CW_NTILE = 128;
constexpr int CW_ETAB = 192;
constexpr int CW_SCANQ = 1024;

constexpr int LDS_BYTES = 160 * 1024;

#define GAS __attribute__((address_space(1)))
#define LAS __attribute__((address_space(3)))
typedef unsigned short bf16;
typedef unsigned v4u __attribute__((ext_vector_type(4)));
typedef unsigned v2u __attribute__((ext_vector_type(2)));
typedef float f32x4 __attribute__((ext_vector_type(4)));
typedef short bf16x8 __attribute__((ext_vector_type(8)));
typedef short s16x4 __attribute__((ext_vector_type(4)));
#define DI __device__ __forceinline__

DI unsigned f2bf(float f) { unsigned u = __builtin_bit_cast(unsigned, f); return (u + 0x7fffu + ((u >> 16) & 1u)) >> 16; }
typedef float f32x2_t __attribute__((ext_vector_type(2))); typedef __bf16 bf16x2_t __attribute__((ext_vector_type(2)));
DI unsigned pk2(float lo, float hi) { f32x2_t v = {lo, hi}; bf16x2_t b = __builtin_convertvector(v, bf16x2_t); return __builtin_bit_cast(unsigned, b); }
DI float bf2f(unsigned short h) { return __builtin_bit_cast(float, (unsigned)h << 16); }
DI float bflo(unsigned w) { return __builtin_bit_cast(float, w << 16); }
DI float bfhi(unsigned w) { return __builtin_bit_cast(float, w & 0xffff0000u); }
DI unsigned q8x4(float a, float b, float c, float d, float sc) {
    const float M = 12582912.f;
    const unsigned ua = __builtin_bit_cast(unsigned, fminf(fmaxf(a * sc, -127.f), 127.f) + M), ub = __builtin_bit_cast(unsigned, fminf(fmaxf(b * sc, -127.f), 127.f) + M);
    const unsigned uc = __builtin_bit_cast(unsigned, fminf(fmaxf(c * sc, -127.f), 127.f) + M), ud = __builtin_bit_cast(unsigned, fminf(fmaxf(d * sc, -127.f), 127.f) + M);
    return (ua & 255u) | ((ub & 255u) << 8) | ((uc & 255u) << 16) | (ud << 24);
}
template <int CTRL> DI float dpp_f(float v) { return __builtin_bit_cast(float, __builtin_amdgcn_update_dpp(0, __builtin_bit_cast(int, v), CTRL, 0xf, 0xf, true)); }
#ifdef NO_DPP
DI float sum16(float v) { v += __shfl_xor(v, 1); v += __shfl_xor(v, 2); v += __shfl_xor(v, 4); v += __shfl_xor(v, 8); return v; }
DI float max16(float v) { v = fmaxf(v, __shfl_xor(v, 1)); v = fmaxf(v, __shfl_xor(v, 2)); v = fmaxf(v, __shfl_xor(v, 4)); v = fmaxf(v, __shfl_xor(v, 8)); return v; }
DI float get_x8(float v) { return __shfl_xor(v, 8); }
#else
DI float sum16(float v) { v += dpp_f<0xB1>(v); v += dpp_f<0x4E>(v); v += dpp_f<0x141>(v); v += dpp_f<0x140>(v); return v; }
DI float max16(float v) { v = fmaxf(v, dpp_f<0xB1>(v)); v = fmaxf(v, dpp_f<0x4E>(v)); v = fmaxf(v, dpp_f<0x141>(v)); v = fmaxf(v, dpp_f<0x140>(v)); return v; }
DI float get_x8(float v) { return dpp_f<0x128>(v); }
#endif
DI float sum_x16(float v) { return v + __shfl_xor(v, 16); }
DI float max_x16(float v) { return fmaxf(v, __shfl_xor(v, 16)); }
DI float sum_x32(float v) { return v + __shfl_xor(v, 32); }
DI float max_x32(float v) { return fmaxf(v, __shfl_xor(v, 32)); }
DI float wave_max(float v) { return max_x32(max_x16(max16(v))); }
DI float act_absmax(const float* nfw, int lane) {
    float m = 0.f;
#pragma unroll
    for (int i = 0; i < 16; ++i) m = fmaxf(m, fabsf(nfw[lane + 64 * i]));
    return ACT_CLIP * wave_max(m);
}
DI float wave_sum(float v) { return sum_x32(sum_x16(sum16(v))); }
DI float siluf(float x) { return x * __builtin_amdgcn_rcpf(1.0f + __expf(-x)); }
DI float sigmoidf_(float x) { return 1.0f / (1.0f + __expf(-x)); }
DI int perm32i(int idx) { return ((idx >> 2) & 3) * 8 + (idx >> 4) * 4 + (idx & 3); }
DI int permcol(int c) { return (c & ~31) + perm32i(c & 31); }
template <class T> DI T opaque(T p) { asm volatile("" : "+v"(p)); return p; }

typedef GAS unsigned gu32;
#define RLX_AGENT __ATOMIC_RELAXED, __HIP_MEMORY_SCOPE_AGENT
constexpr int CW_BAR = 4096;
constexpr int MISC_OFF = LDS_BYTES - 64;
#define XB_TMO      128
#define XB_XCNT(j)  (256  + 64 * (j))
#define XB_XSUB(j)  (1280 + 64 * (j))
#define XB_XGEN(j)  (2304 + 64 * (j))
#define XB_TOP      3328
#define XB_TOPGEN   3392
#define XCD_BAR_WORDS 3456
#define XB_SPIN_CAP (1u << 18)

__device__ __forceinline__ unsigned xb_ld(unsigned* p)              { return __hip_atomic_load(p, __ATOMIC_RELAXED, __HIP_MEMORY_SCOPE_AGENT); }
__device__ __forceinline__ unsigned xb_add(unsigned* p, unsigned v) { return __hip_atomic_fetch_add(p, v, __ATOMIC_RELAXED, __HIP_MEMORY_SCOPE_AGENT); }
__device__ __forceinline__ unsigned xb_xcc_id() { return (unsigned)__builtin_amdgcn_s_getreg((3 << 11) | 20) & 0xFu; }
#define XB_SPIN(cond, bar) do { unsigned _sp = 0; while (cond) { __builtin_amdgcn_s_sleep(1); \
    if ((++_sp & 255u) == 0u) { if (xb_ld(&(bar)[XB_TMO])) break; if (_sp > XB_SPIN_CAP) { atomicAdd(&(bar)[XB_TMO], 1u); break; } } } } while (0)

struct XcdBarrier {
    unsigned* bar; unsigned x;
    volatile LAS unsigned* st;
};

__device__ __forceinline__ XcdBarrier xcd_barrier_post(unsigned* bar, volatile LAS unsigned* st) {
    XcdBarrier b; b.bar = bar; b.x = xb_xcc_id(); b.st = st;
    if (threadIdx.x == 0) (void)xb_add(&bar[XB_XCNT(b.x)], 1u);
    return b;
}
__device__ __forceinline__ void xcd_barrier_complete(unsigned* bar, unsigned x, unsigned& nloc, unsigned& nx) {
    const unsigned G = gridDim.x * gridDim.y * gridDim.z;
    unsigned sum, cnt, mine, sp = 0u;
    for (;;) {
        sum = 0u; cnt = 0u; mine = 0u;
#pragma unroll
        for (unsigned j = 0; j < 16; ++j) { const unsigned c = xb_ld(&bar[XB_XCNT(j)]); sum += c; cnt += (c > 0u) ? 1u : 0u; mine = (j == x) ? c : mine; }
        if (sum == G) break;
        __builtin_amdgcn_s_sleep(1);
        if ((++sp & 255u) == 0u) { if (xb_ld(&bar[XB_TMO])) break; if (sp > XB_SPIN_CAP) { atomicAdd(&bar[XB_TMO], 1u); break; } }
    }
    nloc = mine > 0u ? mine : 1u; nx = cnt > 0u ? cnt : 1u;
}

__device__ __forceinline__ void xcd_barrier(const XcdBarrier& b) {
    asm volatile("s_waitcnt vmcnt(0)" ::: "memory");
    __syncthreads();
    if (threadIdx.x == 0) {
        unsigned* bar = b.bar;
        __builtin_amdgcn_s_waitcnt(0);
        unsigned nloc = b.st[0], nx = b.st[1];
        if (nloc == 0u) { xcd_barrier_complete(bar, b.x, nloc, nx); b.st[0] = nloc; b.st[1] = nx; }
        const unsigned old = xb_add(&bar[XB_XSUB(b.x)], 1u);
        const unsigned gen = old / nloc;
        if (old + 1u == (gen + 1u) * nloc) {
            __builtin_amdgcn_fence(__ATOMIC_RELEASE, "agent");
            asm volatile("s_waitcnt vmcnt(0)" ::: "memory");
            const unsigned og = xb_add(&bar[XB_TOP], 1u);
            const unsigned tg = og / nx;
            if (og + 1u == (tg + 1u) * nx) xb_add(&bar[XB_TOPGEN], 1u);
            else XB_SPIN(xb_ld(&bar[XB_TOPGEN]) == tg, bar);
            __builtin_amdgcn_fence(__ATOMIC_ACQUIRE, "agent");
            xb_add(&bar[XB_XGEN(b.x)], 1u);
            asm volatile("s_waitcnt vmcnt(0)" ::: "memory");
        } else {
            XB_SPIN(xb_ld(&bar[XB_XGEN(b.x)]) == gen, bar);
            __builtin_amdgcn_fence(__ATOMIC_ACQUIRE, "agent");
            asm volatile("s_waitcnt vmcnt(0)" ::: "memory");
        }
    }
    __syncthreads();
}

struct Frame {
    LAS unsigned char* lds;
    int tid, lane, wave, vcu, G;
    const float* in[17];
    float* out; unsigned char* ws;
};

DI void p0_transpose_item(const float* W, int ldw, int nblk, bf16* WT, int K, int row_off, int rmul, LAS float* scr, int item, int lane) {
    const int kb = item / nblk, nb = item % nblk, k0 = 64 * kb, n0 = 32 * nb;
    const int r8 = lane >> 3, c4 = (lane & 7) * 4;
    f32x4 v[8];
#pragma unroll
    for (int i = 0; i < 8; ++i) v[i] = __builtin_nontemporal_load((const f32x4*)(W + (size_t)(k0 + 8 * i + r8) * ldw + n0 + c4));
#pragma unroll
    for (int i = 0; i < 8; ++i) { LAS float* d = scr + (8 * i + r8) * 33 + c4; d[0] = v[i].x; d[1] = v[i].y; d[2] = v[i].z; d[3] = v[i].w; }
    asm volatile("s_waitcnt lgkmcnt(0)" ::: "memory");
    const int c = lane & 7;
#pragma unroll
    for (int j = 0; j < 4; ++j) { const int n = (lane >> 3) + 8 * j; const LAS float* s = scr + (8 * c) * 33 + n;
        v4u o; o.x = pk2(s[0 * 33], s[1 * 33]); o.y = pk2(s[2 * 33], s[3 * 33]); o.z = pk2(s[4 * 33], s[5 * 33]); o.w = pk2(s[6 * 33], s[7 * 33]);
        *(GAS v4u*)(WT + (size_t)(row_off + (n0 + n) * rmul) * K + k0 + 8 * c) = o; }
    asm volatile("s_waitcnt lgkmcnt(0)" ::: "memory");
}
template <int NR> DI void rms_rows_to_bf16(const float* const (&xrow)[NR], const float* w, bf16* const (&orow)[NR], int lane) {
    const GAS f32x4* wr = (const GAS f32x4*)w + lane;
    f32x4 v[NR][4];
#pragma unroll
    for (int r = 0; r < NR; ++r) { const GAS f32x4* xr = (const GAS f32x4*)xrow[r] + lane;
#pragma unroll
        for (int j = 0; j < 4; ++j) v[r][j] = xr[64 * j]; }
    f32x4 ww[4];
#pragma unroll
    for (int j = 0; j < 4; ++j) ww[j] = wr[64 * j];
#pragma unroll
    for (int r = 0; r < NR; ++r) {
        float s_ = 0.f;
#pragma unroll
        for (int j = 0; j < 4; ++j) s_ += (v[r][j].x * v[r][j].x + v[r][j].y * v[r][j].y) + (v[r][j].z * v[r][j].z + v[r][j].w * v[r][j].w);
        const float rs = __builtin_amdgcn_rsqf(wave_sum(s_) * (1.f / DMODEL) + EPS);
        GAS v2u* o8 = (GAS v2u*)orow[r] + lane;
#pragma unroll
        for (int j = 0; j < 4; ++j) { v2u o; o.x = pk2(v[r][j].x * rs * ww[j].x, v[r][j].y * rs * ww[j].y); o.y = pk2(v[r][j].z * rs * ww[j].z, v[r][j].w * rs * ww[j].w); o8[64 * j] = o; }
    }
}
DI void q_strip(const float* W, int ldw, int n0, unsigned char* WQ, float* wsc, int rowbase, int rmul, LAS unsigned char* lds, int wave, int lane) {
    LAS float* scr = (LAS float*)(lds + wave * 8704); LAS float* cmx = (LAS float*)(lds + 8 * 8704);
    const int r8 = lane >> 3, c4 = (lane & 7) * 4, kw = 128 * wave;
    f32x4 mx = (f32x4){0.f, 0.f, 0.f, 0.f};
#pragma unroll
    for (int i = 0; i < 16; ++i) { const f32x4 v = *(const f32x4*)(W + (size_t)(kw + 8 * i + r8) * ldw + n0 + c4);
        mx.x = fmaxf(mx.x, fabsf(v.x)); mx.y = fmaxf(mx.y, fabsf(v.y)); mx.z = fmaxf(mx.z, fabsf(v.z)); mx.w = fmaxf(mx.w, fabsf(v.w)); }
    mx.x = max_x32(max_x16(fmaxf(mx.x, get_x8(mx.x)))); mx.y = max_x32(max_x16(fmaxf(mx.y, get_x8(mx.y))));
    mx.z = max_x32(max_x16(fmaxf(mx.z, get_x8(mx.z)))); mx.w = max_x32(max_x16(fmaxf(mx.w, get_x8(mx.w))));
    if (lane < 8) *(LAS f32x4*)(cmx + wave * 32 + c4) = mx;
    __syncthreads();
    float sq[4];
#pragma unroll
    for (int j = 0; j < 4; ++j) { const int n = (lane >> 3) + 8 * j; float m = cmx[n];
#pragma unroll
        for (int w = 1; w < 8; ++w) m = fmaxf(m, cmx[w * 32 + n]);
        sq[j] = m > 0.f ? 127.0f / m : 0.f;
        if (wave == 0 && (lane & 7) == 0) wsc[rowbase + n * rmul] = m * (1.0f / 127.0f); }
    const int c = lane & 7;
#pragma unroll
    for (int kb = 0; kb < 2; ++kb) {
        const int k0 = kw + 64 * kb;
        f32x4 v[8];
#pragma unroll
        for (int i = 0; i < 8; ++i) v[i] = *(const f32x4*)(W + (size_t)(k0 + 8 * i + r8) * ldw + n0 + c4);
#pragma unroll
        for (int i = 0; i < 8; ++i) { LAS float* d = scr + (8 * i + r8) * 33 + c4; d[0] = v[i].x; d[1] = v[i].y; d[2] = v[i].z; d[3] = v[i].w; }
        asm volatile("s_waitcnt lgkmcnt(0)" ::: "memory");
#pragma unroll
        for (int j = 0; j < 4; ++j) { const int n = (lane >> 3) + 8 * j; const LAS float* t = scr + (8 * c) * 33 + n;
            v2u o; o.x = q8x4(t[0 * 33], t[1 * 33], t[2 * 33], t[3 * 33], sq[j]); o.y = q8x4(t[4 * 33], t[5 * 33], t[6 * 33], t[7 * 33], sq[j]);
            *(GAS v2u*)(WQ + (size_t)(rowbase + n * rmul) * 1024 + k0 + 8 * c) = o; }
        asm volatile("s_waitcnt lgkmcnt(0)" ::: "memory");
    }
    __syncthreads();
}
DI float reduce16(const float (&ga)[16], int lane) {
    float gb[8], gc[4];
    const bool h32 = (lane & 32) != 0, h16 = (lane & 16) != 0;
#pragma unroll
    for (int i = 0; i < 8; ++i) { const float lo = sum_x32(ga[i]), hi = sum_x32(ga[i + 8]); gb[i] = h32 ? hi : lo; }
#pragma unroll
    for (int i = 0; i < 4; ++i) { const float lo = sum_x16(gb[i]), hi = sum_x16(gb[i + 4]); gc[i] = h16 ? hi : lo; }
    float res = 0.f;
#pragma unroll
    for (int i = 0; i < 4; ++i) { const float t = sum16(gc[i]); res = ((lane & 3) == i) ? t : res; }
    return res;
}
DI void rms_rows_to_q8(const float* const (&xrow)[2], const float* w, unsigned char* const (&orow)[2], float* const (&xsc)[2], float* const (&gout)[2], const LAS float* gw_, int lane) {
    const LAS float* gw = gw_;
    gw = opaque(gw);
    const GAS f32x4* wr = (const GAS f32x4*)w + lane;
    f32x4 v[2][4];
#pragma unroll
    for (int r = 0; r < 2; ++r) { const GAS f32x4* xr = (const GAS f32x4*)xrow[r] + lane;
#pragma unroll
        for (int j = 0; j < 4; ++j) v[r][j] = xr[64 * j]; }
    f32x4 ww[4];
#pragma unroll
    for (int j = 0; j < 4; ++j) ww[j] = wr[64 * j];
#pragma unroll
    for (int r = 0; r < 2; ++r) {
        float s_ = 0.f;
#pragma unroll
        for (int j = 0; j < 4; ++j) s_ += (v[r][j].x * v[r][j].x + v[r][j].y * v[r][j].y) + (v[r][j].z * v[r][j].z + v[r][j].w * v[r][j].w);
        const float rs = __builtin_amdgcn_rsqf(wave_sum(s_) * (1.f / DMODEL) + EPS);
        float am = 0.f;
#pragma unroll
        for (int j = 0; j < 4; ++j) { v[r][j] = v[r][j] * ww[j] * rs; am = fmaxf(fmaxf(am, fmaxf(fabsf(v[r][j].x), fabsf(v[r][j].y))), fmaxf(fabsf(v[r][j].z), fabsf(v[r][j].w))); }
        am = wave_max(am);
        const float qsc = am > 0.f ? 127.0f / am : 0.f;
        if (lane == 0) *xsc[r] = am * (1.0f / 127.0f);
        GAS unsigned* o4 = (GAS unsigned*)orow[r] + lane;
#pragma unroll
        for (int j = 0; j < 4; ++j) o4[64 * j] = q8x4(v[r][j].x, v[r][j].y, v[r][j].z, v[r][j].w, qsc);
    }
#ifndef NO_GATES
    float ga[2][16];
#pragma unroll
    for (int c = 0; c < 16; ++c) { ga[0][c] = 0.f; ga[1][c] = 0.f; }
    asm volatile("" : "+v"(v[0][0]), "+v"(v[0][1]), "+v"(v[0][2]), "+v"(v[0][3]), "+v"(v[1][0]), "+v"(v[1][1]), "+v"(v[1][2]), "+v"(v[1][3]));
#pragma unroll
    for (int j = 0; j < 4; ++j)
#pragma unroll
        for (int q = 0; q < 4; ++q) { const LAS f32x4* g4 = (const LAS f32x4*)gw + ((j * 4 + q) * 4) * 64 + lane;
            const f32x4 g0 = g4[0], g1 = g4[64], g2 = g4[128], g3 = g4[192];
#pragma unroll
            for (int r = 0; r < 2; ++r) { const float h = v[r][j][q];
                ga[r][0] += h * g0.x; ga[r][1] += h * g0.y; ga[r][2] += h * g0.z; ga[r][3] += h * g0.w; ga[r][4] += h * g1.x; ga[r][5] += h * g1.y; ga[r][6] += h * g1.z; ga[r][7] += h * g1.w;
                ga[r][8] += h * g2.x; ga[r][9] += h * g2.y; ga[r][10] += h * g2.z; ga[r][11] += h * g2.w; ga[r][12] += h * g3.x; ga[r][13] += h * g3.y; ga[r][14] += h * g3.z; ga[r][15] += h * g3.w; }
            asm volatile("" : "+v"(ga[1][0]), "+v"(ga[1][1]), "+v"(ga[1][2]), "+v"(ga[1][3]), "+v"(ga[1][4]), "+v"(ga[1][5]), "+v"(ga[1][6]), "+v"(ga[1][7]), "+v"(ga[1][8]), "+v"(ga[1][9]),
                         "+v"(ga[1][10]), "+v"(ga[1][11]), "+v"(ga[1][12]), "+v"(ga[1][13]), "+v"(ga[1][14]), "+v"(ga[1][15]) :: "memory"); }
    const int gc_ = 4 * (lane >> 4) + (lane & 3);
#pragma unroll
    for (int r = 0; r < 2; ++r) { const float res = reduce16(ga[r], lane); if ((lane & 12) == 0) gout[r][gc_] = res; }
#endif
}
DI void p0_prologue(Frame& F) {
    const float* w_in = F.in[2];
    unsigned char* WIN = F.ws + WS_WIN; float* WSI = (float*)(F.ws + WS_WSI);
    constexpr int NSTRIP = 64 + 24;
    if (F.vcu < NSTRIP) { const int st = F.vcu;
        if (st < 64) q_strip(w_in, 2832, 32 * st, WIN, WSI, 32 * st, 1, F.lds, F.wave, F.lane);
        else q_strip(w_in + 2064, 2832, 32 * (st - 64), WIN, WSI, 2048 + 32 * (st - 64), 1, F.lds, F.wave, F.lane); }
    unsigned char* XN = F.ws + WS_XN; float* XSC = (float*)(F.ws + WS_XSC); float* GATES = (float*)(F.ws + WS_GATES);
    LAS float* gw = (LAS float*)(F.lds + 73728);
    for (int i = F.tid; i < 1024 * 4; i += NTHREADS) { const int k = i >> 2, c4 = i & 3, jj = k >> 8, qq = k & 3, ln = (k & 255) >> 2;
        *((LAS f32x4*)gw + ((jj * 4 + qq) * 4 + c4) * 64 + ln) = *(const f32x4*)(w_in + (size_t)k * 2832 + 2048 + c4 * 4); }
    __syncthreads();
    const int nst = (F.G < NSTRIP ? F.G : NSTRIP), NSLOT = nst * NWAVES + (F.G - nst) * NWAVES * 2;
    const int s0_ = (F.vcu < nst) ? F.vcu * NWAVES + F.wave : nst * NWAVES + ((F.vcu - nst) * NWAVES + F.wave) * 2, nmine = (F.vcu < nst) ? 1 : 2;
#pragma unroll 1
    for (int q = 0; q < nmine; ++q)
#pragma unroll 1
        for (int p = s0_ + q; p < TT / 2; p += NSLOT) { const int m = 2 * p;
            const float* const xr[2] = {F.in[0] + (size_t)m * DMODEL, F.in[0] + (size_t)(m + 1) * DMODEL}; unsigned char* const orw[2] = {XN + (size_t)m * DMODEL, XN + (size_t)(m + 1) * DMODEL};
            float* const xs[2] = {XSC + m, XSC + m + 1}; float* const go[2] = {GATES + (size_t)m * 16, GATES + (size_t)(m + 1) * 16};
            rms_rows_to_q8(xr, F.in[1], orw, xs, go, gw, F.lane); }
}

struct EpiProj {
    static constexpr bool PERM = true, AFTER_DRAIN = false;
    bf16 *qkva, *za, *qkvb; const float* wsi; const float* xsc;
    DI void operator()(const pg8::i32x4 (&acc)[2][2][4][2], const pg8::Unit& u, int wr, int wc, int fr, int fq) const {
        const int row0 = u.pm * 256 + wr * 64 + fr;
        const float* ws_ = wsi + u.pn * 256 + wc * 32 + 8 * fq;
        bf16* base; int ldc, colt;
        if (u.pn < 6) { base = qkva; ldc = 1536; colt = u.pn * 256; } else if (u.pn < 8) { base = za; ldc = 512; colt = (u.pn - 6) * 256; } else { base = qkvb; ldc = 768; colt = (u.pn - 8) * 256; }
        const int col0 = colt + wc * 32 + 8 * fq;
        f32x4 s0[2], s1[2];
#pragma unroll
        for (int bj = 0; bj < 2; ++bj) { s0[bj] = *(const f32x4*)(ws_ + bj * 128); s1[bj] = *(const f32x4*)(ws_ + bj * 128 + 4); }
        float rsc[2][4];
#pragma unroll
        for (int ai = 0; ai < 2; ++ai)
#pragma unroll
            for (int m = 0; m < 4; ++m) rsc[ai][m] = xsc[row0 + ai * 128 + m * 16];
#pragma unroll
        for (int ai = 0; ai < 2; ++ai)
#pragma unroll
            for (int m = 0; m < 4; ++m) { bf16* rowp = base + (size_t)(row0 + ai * 128 + m * 16) * ldc + col0; const float rr = rsc[ai][m];
#pragma unroll
                for (int bj = 0; bj < 2; ++bj) { const pg8::i32x4 a0 = acc[ai][bj][m][0], a1 = acc[ai][bj][m][1]; const f32x4 t0 = s0[bj] * rr, t1 = s1[bj] * rr; pg8::u32x4 w;
                    w.x = pg8::cvt_pk_bf16((float)a0[0] * t0[0], (float)a0[1] * t0[1]); w.y = pg8::cvt_pk_bf16((float)a0[2] * t0[2], (float)a0[3] * t0[3]);
                    w.z = pg8::cvt_pk_bf16((float)a1[0] * t1[0], (float)a1[1] * t1[1]); w.w = pg8::cvt_pk_bf16((float)a1[2] * t1[2], (float)a1[3] * t1[3]);
                    *(pg8::u32x4*)(rowp + bj * 128) = w; } }
    }
};
struct IdRows { DI int row(const pg8::Unit& u, int r) const { return u.pm * 256 + r; } };
struct EpiResid {
    static constexpr bool PERM = true, AFTER_DRAIN = false;
    const float* x; bf16* x1;
    DI void operator()(const pg8::f32x4 (&acc)[2][2][4][2], const pg8::Unit& u, int wr, int wc, int fr, int fq) const {
        const int row0 = u.pm * 256 + wr * 64 + fr, col0 = u.pn * 256 + wc * 32 + 8 * fq;
#pragma unroll
        for (int ai = 0; ai < 2; ++ai)
#pragma unroll
            for (int m = 0; m < 4; ++m) { const size_t off = (size_t)(row0 + ai * 128 + m * 16) * DMODEL + col0;
#pragma unroll
                for (int bj = 0; bj < 2; ++bj) { const pg8::f32x4 v0 = *(const pg8::f32x4*)(x + off + bj * 128) + acc[ai][bj][m][0], v1 = *(const pg8::f32x4*)(x + off + bj * 128 + 4) + acc[ai][bj][m][1]; pg8::u32x4 w;
                    w.x = pg8::cvt_pk_bf16(v0[0], v0[1]); w.y = pg8::cvt_pk_bf16(v0[2], v0[3]); w.z = pg8::cvt_pk_bf16(v1[0], v1[1]); w.w = pg8::cvt_pk_bf16(v1[2], v1[3]);
                    *(pg8::u32x4*)(x1 + off + bj * 128) = w; } }
    }
};
struct EpiGU {
    static constexpr bool PERM = true, AFTER_DRAIN = false;
    bf16* hid; const float* wsc; float ainv;
    DI void operator()(const pg8::i32x4 (&acc)[2][2][4][2], const pg8::Unit& u, int wr, int wc, int fr, int fq) const {
        const int row0 = u.pm * 256 + wr * 64 + fr; const int jt = u.pn & 3;
        const int ff0 = jt * 128 + wc * 16 + 4 * fq;
        const float* ws_ = wsc + u.ex * 1024 + jt * 256 + wc * 32 + 8 * fq;
        f32x4 s0[2], s1[2];
#pragma unroll
        for (int bj = 0; bj < 2; ++bj) { s0[bj] = *(const f32x4*)(ws_ + bj * 128) * ainv; s1[bj] = *(const f32x4*)(ws_ + bj * 128 + 4) * ainv; }
#pragma unroll
        for (int ai = 0; ai < 2; ++ai)
#pragma unroll
            for (int m = 0; m < 4; ++m) { bf16* rowp = hid + (size_t)(row0 + ai * 128 + m * 16) * FFE + ff0;
#pragma unroll
                for (int bj = 0; bj < 2; ++bj) { const pg8::i32x4 a0 = acc[ai][bj][m][0], a1 = acc[ai][bj][m][1];
                    const float g0 = (float)a0[0] * s0[bj][0], u0 = (float)a0[1] * s0[bj][1], g1 = (float)a0[2] * s0[bj][2], u1 = (float)a0[3] * s0[bj][3];
                    const float g2 = (float)a1[0] * s1[bj][0], u2 = (float)a1[1] * s1[bj][1], g3 = (float)a1[2] * s1[bj][2], u3 = (float)a1[3] * s1[bj][3];
                    v2u w; w.x = pg8::cvt_pk_bf16(siluf(g0) * u0, siluf(g1) * u1); w.y = pg8::cvt_pk_bf16(siluf(g2) * u2, siluf(g3) * u3);
                    *(v2u*)(rowp + bj * 64) = w; } }
    }
};
struct EpiY {
    static constexpr bool PERM = true, AFTER_DRAIN = false;
    bf16* y;
    DI void operator()(const pg8::f32x4 (&acc)[2][2][4][2], const pg8::Unit& u, int wr, int wc, int fr, int fq) const {
        const int row0 = u.pm * 256 + wr * 64 + fr; const int col0 = (u.pn & 3) * 256 + wc * 32 + 8 * fq;
#pragma unroll
        for (int ai = 0; ai < 2; ++ai)
#pragma unroll
            for (int m = 0; m < 4; ++m) { bf16* rowp = y + (size_t)(row0 + ai * 128 + m * 16) * DMODEL + col0;
#pragma unroll
                for (int bj = 0; bj < 2; ++bj) { const pg8::f32x4 v0 = acc[ai][bj][m][0], v1 = acc[ai][bj][m][1]; pg8::u32x4 w;
                    w.x = pg8::cvt_pk_bf16(v0[0], v0[1]); w.y = pg8::cvt_pk_bf16(v0[2], v0[3]); w.z = pg8::cvt_pk_bf16(v1[0], v1[1]); w.w = pg8::cvt_pk_bf16(v1[2], v1[3]);
                    *(pg8::u32x4*)(rowp + bj * 128) = w; } }
    }
};
constexpr int ETAB_OFF = 131072;
struct MoeOrder {
    const LAS unsigned* etab; int G, c, esplit, pnoff;
    DI bool next(int i, pg8::Unit& u) const {
        if (G % 8 != 0) {
            int L = i * G + c;
            for (int e = 0; e < NEXP; ++e) { const int n4 = 4 * (int)etab[2 * e + 1]; if (L < n4) { u.pm = (int)etab[2 * e] + (L >> 2); u.pn = (e < esplit ? 4 * e : pnoff + 4 * (e - esplit)) + (L & 3); u.ex = e; u.tq = L >> 2; return true; } L -= n4; }
            return false; }
        const int x = c & 7; int L = i * (G >> 3) + (c >> 3);
#pragma unroll
        for (int q = 0; q < NEXP / 8; ++q) { const int e = x + 8 * q; const int n4 = 4 * (int)etab[2 * e + 1];
            if (L < n4) { u.pm = (int)etab[2 * e] + (L >> 2); u.pn = (e < esplit ? 4 * e : pnoff + 4 * (e - esplit)) + (L & 3); u.ex = e; u.tq = L >> 2; return true; } L -= n4; }
        return false; }
    DI void a_ready(const pg8::Unit&) const {}
    DI void done(const pg8::Unit&) const {}
};
struct MoeRows {
    const int* list; const LAS unsigned* etab;
    DI int row(const pg8::Unit& u, int r) const {
        const int slot = u.tq * 256 + r, e = u.ex; if (slot >= (int)etab[64 + e]) return 0;
        const LAS unsigned* sp = etab + 96 + 8 * e; int sb = 0;
#pragma unroll
        for (int q = 1; q < 8; ++q) sb += (slot >= (int)sp[q]) ? 1 : 0;
        return list[(size_t)(e * 8 + sb) * TT + (slot - (int)sp[sb])]; }
};

DI void p2_rope(Frame& F) {
    const int gw = F.vcu * NWAVES + F.wave, NGW = F.G * NWAVES, lane = F.lane;
    const bf16* QKVB = (const bf16*)(F.ws + WS_QKVB);
    bf16* QR = (bf16*)((unsigned char*)F.out + DO_QR); bf16* KR = (bf16*)((unsigned char*)F.out + DO_KR); bf16* VR = (bf16*)((unsigned char*)F.out + DO_VR);
    const int pi = lane & 31, hsel = lane >> 5;
    const float qw0 = F.in[7][2 * pi], qw1 = F.in[7][2 * pi + 1], kw0 = F.in[8][2 * pi], kw1 = F.in[8][2 * pi + 1];
    const float invf = exp2f(-(float)(2 * (pi & 15)) * (13.287712379549449f / 32.0f));
    constexpr float C2 = 0.125f * 1.4426950408889634f;
    constexpr int NB4 = 4;
    for (int t0 = gw; t0 < TT; t0 += NB4 * NGW) {
        unsigned w[NB4][5], vw[NB4];
#pragma unroll
        for (int u = 0; u < NB4; ++u) { const int t = t0 + u * NGW; const unsigned* src = (const unsigned*)(QKVB + (size_t)(t < TT ? t : t0) * 768);
#pragma unroll
            for (int j = 0; j < 5; ++j) w[u][j] = src[(2 * j + hsel) * 32 + pi];
            vw[u] = src[320 + lane]; }
#pragma unroll
        for (int u = 0; u < NB4; ++u) {
            const int t = t0 + u * NGW; if (t >= TT) break;
            const int s_ = t & (SEQ - 1); const float pos = (pi < 16) ? (float)(s_ >> 6) : (float)(s_ & 63);
            const float ang = pos * invf;
            const float rev = ang * 0.15915494309189535f;
            const float sn = __builtin_amdgcn_sinf(rev), cs = __builtin_amdgcn_cosf(rev);
#pragma unroll
            for (int j = 0; j < 5; ++j) {
                const int head = 2 * j + hsel;
                const float x0 = bflo(w[u][j]), x1 = bfhi(w[u][j]);
                float ss = x0 * x0 + x1 * x1;
                ss = sum_x16(sum16(ss));
                const float rs = __builtin_amdgcn_rsqf(ss * (1.f / 64.f) + EPS);
                const bool isq = head < 8;
                const float y0 = x0 * rs * (isq ? qw0 : kw0), y1 = x1 * rs * (isq ? qw1 : kw1);
                float o0 = y0 * cs - y1 * sn, o1 = y0 * sn + y1 * cs;
                if (isq) { o0 *= C2; o1 *= C2; ((unsigned*)(QR + (size_t)t * 512))[head * 32 + pi] = pk2(o0, o1); }
                else { const int hk = head - 8, bq = t >> 13, sq = t & (SEQ - 1);
                    ((unsigned*)(KR + ((size_t)((bq * 2 + hk) * 128 + (sq >> 6)) * 8 + (pi >> 2)) * 512 + (sq & 63) * 8))[pi & 3] = pk2(o0, o1); }
            }
            { const int hk = lane >> 5, d = 2 * (lane & 31), bq = t >> 13, sq = t & (SEQ - 1), r = sq & 63;
              ((unsigned*)(VR + ((size_t)((bq * 2 + hk) * 128 + (sq >> 6)) * 8 + (d >> 5) * 4 + (r >> 4)) * 512 + ((r & 15) * 4 + ((d & 31) >> 3)) * 8))[(d & 7) >> 1] = vw[u]; }
        }
    }
}

constexpr int G_KNP = 0, G_QNP = 17408, G_KNTP = 34816, G_VCT = 53248;
constexpr int G_D0 = 71680, G_D1 = 71680 + 19456;
constexpr int GD_TBP = 0, GD_AP = 9216, GD_VEC = 18432;
constexpr int G_LM = 110592;
constexpr int G_GV = G_LM + 32768;
static_assert(G_GV + 2048 <= LDS_BYTES - 64, "gdn pre lds");

#define TRI_ROW(i, LC, LN) { \
        if ((i) + 1 < 64) { _Pragma("unroll") for (int j4 = 0; j4 < ((i) + 1 + 3) / 4 && j4 < 8; ++j4) LN[j4] = *(const LAS f32x4*)(L + ((i) + 1) * 64 + 4 * j4); } \
        _Pragma("unroll") for (int j4 = 8; j4 < ((i) + 3) / 4; ++j4) lt[j4 - 8] = *(const LAS f32x4*)(L + (i) * 64 + 4 * j4); \
        __builtin_amdgcn_sched_barrier(0); \
        f32x2_t a0 = {(lane == (i)) ? 1.0f : 0.0f, 0.f}, a1 = {0.f, 0.f}; \
        _Pragma("unroll") for (int j4 = 0; j4 < ((i) + 3) / 4; ++j4) { const f32x4 l = (j4 < 8) ? LC[j4 & 7] : lt[(j4 - 8) & 7]; \
            f32x2_t l0 = {l.x, (4 * j4 + 1 < (i)) ? l.y : 0.f}, l1 = {(4 * j4 + 2 < (i)) ? l.z : 0.f, (4 * j4 + 3 < (i)) ? l.w : 0.f}; \
            a0 -= l0 * xp[2 * j4]; if (4 * j4 + 2 < (i)) a1 -= l1 * xp[2 * j4 + 1]; } \
        const float a = (a0.x + a0.y) + (a1.x + a1.y); \
        if ((i) & 1) xp[(i) >> 1].y = a; else { xp[(i) >> 1].x = a; xp[(i) >> 1].y = 0.f; } \
        TBP[(REV ? 63 - (i) : (i)) * 72 + pc] = (bf16)(pk2(a * bcol, 0.f) & 0xffffu); \
        __builtin_amdgcn_sched_barrier(0); }
template <bool REV> DI void tri_inverse(LAS float* L, const LAS float* beta, LAS bf16* TBP, int lane) {
    f32x2_t xp[32];
    L = opaque(L); TBP = opaque(TBP); lane = opaque(lane);
    const float bcol = REV ? beta[63 - lane] : beta[lane];
    const int pc = REV ? permcol(63 - lane) : permcol(lane);
    f32x4 la[8], lb[8], lt[8];
#pragma unroll
    for (int ii = 0; ii < 64; ii += 2) { TRI_ROW(ii, la, lb) TRI_ROW(ii + 1, lb, la) }
}
#undef TRI_ROW

DI void gdn_conv(Frame& F, LAS unsigned char* lds, int t384, int b, int h, int n) {
    const bf16* QKVA = (const bf16*)(F.ws + WS_QKVA); const float* convw = F.in[3];
    const int cgp = t384 % 48, rg = t384 / 48, mat = cgp >> 4, cc = (cgp & 15) * 8;
    const int col = mat * 512 + h * 128 + cc;
    float w[5][8];
#pragma unroll
    for (int j = 0; j < 5; ++j) { const f32x4 a = *(const f32x4*)(convw + j * 1536 + col), bq = *(const f32x4*)(convw + j * 1536 + col + 4);
        w[j][0] = a.x; w[j][1] = a.y; w[j][2] = a.z; w[j][3] = a.w; w[j][4] = bq.x; w[j][5] = bq.y; w[j][6] = bq.z; w[j][7] = bq.w; }
    const int a4 = (cc >> 3) & 3, p0 = (cc & ~31) + 16 * (a4 & 1) + 4 * (a4 >> 1);
    const int ra = rg & 3, q0 = (rg >> 2) * 32 + 16 * (ra & 1) + 4 * (ra >> 1);
#pragma unroll
    for (int hf = 0; hf < 2; ++hf) {
        float o[4][8];
#pragma unroll
        for (int r = 0; r < 4; ++r)
#pragma unroll
            for (int c = 0; c < 8; ++c) o[r][c] = 0.f;
#pragma unroll
        for (int i = 0; i < 8; ++i) {
            const int pos = n * 64 + rg * 8 + hf * 4 - 2 + i;
            v4u raw = (v4u){0u, 0u, 0u, 0u};
            if (pos >= 0 && pos < SEQ) raw = *(const v4u*)(QKVA + (size_t)(b * SEQ + pos) * 1536 + col);
            float xin[8] = {bflo(raw.x), bfhi(raw.x), bflo(raw.y), bfhi(raw.y), bflo(raw.z), bfhi(raw.z), bflo(raw.w), bfhi(raw.w)};
#pragma unroll
            for (int j = 0; j < 5; ++j) { const int r = i - j; if (r >= 0 && r < 4) {
#pragma unroll
                for (int c = 0; c < 8; ++c) o[r][c] += w[j][c] * xin[c]; } }
        }
#pragma unroll
        for (int r = 0; r < 4; ++r) {
            float ss = 0.f;
#pragma unroll
            for (int c = 0; c < 8; ++c) { o[r][c] = siluf(o[r][c]); ss += o[r][c] * o[r][c]; }
            ss = sum16(ss);
            float sc = 1.0f;
            if (mat < 2) { sc = __builtin_amdgcn_rsqf(ss + EPS); if (mat == 0) sc *= 0.08838834764831845f; }
#pragma unroll
            for (int c = 0; c < 8; ++c) o[r][c] *= sc;
        }
        if (mat < 2) {
            LAS unsigned char* tile = lds + (mat == 0 ? G_QNP : G_KNP);
#pragma unroll
            for (int r = 0; r < 4; ++r) { const int c = rg * 8 + hf * 4 + r;
                v2u lo, hi2; lo.x = pk2(o[r][0], o[r][1]); lo.y = pk2(o[r][2], o[r][3]); hi2.x = pk2(o[r][4], o[r][5]); hi2.y = pk2(o[r][6], o[r][7]);
                *(LAS v2u*)(tile + c * 272 + p0 * 2) = lo; *(LAS v2u*)(tile + c * 272 + (p0 + 8) * 2) = hi2; }
        }
        if (mat >= 1) {
#pragma unroll
            for (int c = 0; c < 8; ++c) {
                v2u q4; q4.x = pk2(o[0][c], o[1][c]); q4.y = pk2(o[2][c], o[3][c]);
                if (mat == 1) *(LAS v2u*)(lds + G_KNTP + (cc + c) * 144 + (q0 + 8 * hf) * 2) = q4;
                else *(LAS v2u*)(lds + G_VCT + (cc + c) * 144 + rg * 16 + hf * 8) = q4;
            }
        }
    }
}
DI void gdn_gates(Frame& F, LAS unsigned char* lds, LAS float* gv, int lane, int b, int h, int n) {
    const float* gp = (const float*)(F.ws + WS_GATES) + (size_t)(b * SEQ + n * 64 + lane) * 16;
    const float bfv = gp[h], bbv = gp[4 + h], afv = gp[8 + h], abv = gp[12 + h];
    const float betaf = sigmoidf_(bfv), betab = sigmoidf_(bbv);
    const float xf = afv + F.in[5][h], xb = abv + F.in[5][4 + h];
    const float spf = fmaxf(xf, 0.f) + log1pf(__expf(-fabsf(xf))), spb = fmaxf(xb, 0.f) + log1pf(__expf(-fabsf(xb)));
    const float gf = -__expf(F.in[4][h]) * spf, gb = -__expf(F.in[4][4 + h]) * spb;
    float Gf = gf, Rb = gb;
#pragma unroll
    for (int o = 1; o < 64; o <<= 1) { const float u1 = __shfl_up(Gf, o); if (lane >= o) Gf += u1; const float d1 = __shfl_down(Rb, o); if (lane + o < 64) Rb += d1; }
    gv[lane] = Gf; gv[64 + lane] = Rb; gv[128 + lane] = betaf; gv[192 + lane] = betab;
    const float GfL = __shfl(Gf, 63), Rb0 = __shfl(Rb, 0);
    LAS float* v0 = (LAS float*)(lds + G_D0 + GD_VEC); LAS float* v1 = (LAS float*)(lds + G_D1 + GD_VEC);
    v0[lane] = __expf(Gf); v0[64 + lane] = __expf(GfL - Gf); v1[lane] = __expf(Rb); v1[64 + lane] = __expf(Rb0 - Rb);
    if (lane == 0) { v0[128] = __expf(GfL); v1[128] = __expf(Rb0); }
}
DI void p2_gdn_pre(Frame& F) {
    const int tid = F.tid, lane = F.lane, wave = F.wave;
    int task = F.vcu;
    if (task < 1024) {
        LAS unsigned char* lds = opaque(F.lds);
        const int b = task >> 9, h = (task >> 7) & 3, n = task & 127;
        if (wave >= 2) gdn_conv(F, lds, tid - 128, b, h, n);
        if (wave == 2) gdn_gates(F, lds, (LAS float*)(lds + G_GV), lane, b, h, n);
    }
    __syncthreads();
    int par = 0;
#pragma unroll 1
    for (; task < 1024; task += F.G, par ^= 1) {
        LAS unsigned char* lds = opaque(F.lds);
        const int b = task >> 9, h = (task >> 7) & 3, n = task & 127, bh = b * 4 + h;
        LAS float* gv = (LAS float*)(lds + G_GV + par * 1024);
        LAS float* sGf = gv; LAS float* sRb = gv + 64; LAS float* sBf = gv + 128; LAS float* sBb = gv + 192;
        {
            const int p = wave >> 2, mt = wave & 3, n16 = lane & 15, g = lane >> 4;
            const LAS unsigned char* At = lds + (p == 0 ? G_KNP : G_QNP) + (16 * mt + n16) * 272 + g * 16;
            bf16x8 af[4], bfr[16];
#pragma unroll
            for (int ks = 0; ks < 4; ++ks) af[ks] = *(const LAS bf16x8*)(At + ks * 64);
#pragma unroll
            for (int nt = 0; nt < 4; ++nt)
#pragma unroll
                for (int ks = 0; ks < 4; ++ks) bfr[nt * 4 + ks] = *(const LAS bf16x8*)(lds + G_KNP + (16 * nt + n16) * 272 + g * 16 + ks * 64);
            float Gc[4], Rc[4], Bfc[4], Bbc[4];
#pragma unroll
            for (int r = 0; r < 4; ++r) { const int c = 16 * mt + 4 * g + r; Gc[r] = sGf[c]; Rc[r] = sRb[c]; Bfc[r] = sBf[c]; Bbc[r] = sBb[c]; }
#pragma unroll
            for (int nt = 0; nt < 4; ++nt) {
                f32x4 acc = (f32x4){0.f, 0.f, 0.f, 0.f};
#pragma unroll
                for (int ks = 0; ks < 4; ++ks) acc = __builtin_amdgcn_mfma_f32_16x16x32_bf16(af[ks], bfr[nt * 4 + ks], acc, 0, 0, 0);
                const int s_ = 16 * nt + n16; const float Gs = sGf[s_], Rs = sRb[s_]; const int ps = permcol(s_);
#pragma unroll
                for (int r = 0; r < 4; ++r) {
                    const int c = 16 * mt + 4 * g + r; const float v = acc[r];
                    const float df = __expf(fminf(Gc[r] - Gs, 0.f)), db = __expf(fminf(Rc[r] - Rs, 0.f));
                    if (p == 0) {
                        ((LAS float*)(lds + G_LM))[c * 64 + s_] = Bfc[r] * v * df;
                        ((LAS float*)(lds + G_LM + 16384))[(63 - c) * 64 + (63 - s_)] = Bbc[r] * v * db;
                    } else {
                        ((LAS bf16*)(lds + G_D0 + GD_AP))[c * 72 + ps] = (bf16)(pk2(s_ <= c ? v * df : 0.f, 0.f) & 0xffffu);
                        ((LAS bf16*)(lds + G_D1 + GD_AP))[c * 72 + ps] = (bf16)(pk2(s_ >= c ? v * db : 0.f, 0.f) & 0xffffu);
                    }
                }
            }
        }
        __syncthreads();
        GAS v4u* gd0 = (GAS v4u*)(F.ws + WS_GD + (size_t)((bh * 2 + 0) * 128 + n) * GDN_D_BYTES);
        GAS v4u* gd1 = (GAS v4u*)(F.ws + WS_GD + (size_t)((bh * 2 + 1) * 128 + n) * GDN_D_BYTES);
        {
            GAS v4u* gsh = (GAS v4u*)(F.ws + WS_GSH + (size_t)(bh * 128 + n) * GDN_SH_BYTES);
#pragma unroll 3
            for (int i = tid; i < (int)(GDN_SH_BYTES / 16); i += NTHREADS) gsh[i] = *(const LAS v4u*)(lds + i * 16);
#pragma unroll 1
            for (int i = GD_AP / 16 + tid; i < (int)(GDN_D_BYTES / 16); i += NTHREADS) { gd0[i] = *(const LAS v4u*)(lds + G_D0 + i * 16); gd1[i] = *(const LAS v4u*)(lds + G_D1 + i * 16); }
        }
        __syncthreads();
        if (wave == 0) { tri_inverse<false>((LAS float*)(lds + G_LM), sBf, (LAS bf16*)(lds + G_D0 + GD_TBP), lane);
#pragma unroll 3
            for (int i = lane; i < GD_AP / 16; i += 64) gd0[i] = *(const LAS v4u*)(lds + G_D0 + i * 16); }
        else if (wave == 1) { tri_inverse<true>((LAS float*)(lds + G_LM + 16384), sBb, (LAS bf16*)(lds + G_D1 + GD_TBP), lane);
#pragma unroll 3
            for (int i = lane; i < GD_AP / 16; i += 64) gd1[i] = *(const LAS v4u*)(lds + G_D1 + i * 16); }
        else {
            const int t2 = task + F.G;
            if (t2 < 1024) { const int b2 = t2 >> 9, h2 = (t2 >> 7) & 3, n2 = t2 & 127;
                gdn_conv(F, lds, tid - 128, b2, h2, n2);
                if (wave == 2) gdn_gates(F, lds, (LAS float*)(lds + G_GV + (par ^ 1) * 1024), lane, b2, h2, n2); }
        }
        __syncthreads();
    }
}

DI bf16x8 pack8(const f32x4 a, const f32x4 b) {
    v4u p; p.x = pk2(a[0], a[1]); p.y = pk2(a[2], a[3]); p.z = pk2(b[0], b[1]); p.w = pk2(b[2], b[3]); return __builtin_bit_cast(bf16x8, p);
}
DI void small_weights(Frame& F, int gw, int NGW) {
    LAS float* scr = (LAS float*)(F.lds + F.wave * 16384);
    bf16* WOUT = (bf16*)(F.ws + WS_WOUT);
    for (int it = gw; it < 16 * 32; it += NGW) p0_transpose_item(F.in[9], 1024, 32, WOUT, 1024, 0, 1, scr, it, F.lane);
    bf16* WRH = (bf16*)(F.ws + WS_WR); bf16* WRL = WRH + 48 * 1024; const float* wrg = F.in[11]; const float* wre = F.in[12];
    for (int i = gw * 64 + F.lane; i < 48 * 1024; i += NGW * 64) { const int j = i >> 10, k = i & 1023; float v = 0.f; if (j < 4) v = wrg[k * 4 + j]; else if (j < 36) v = wre[k * 32 + (j - 4)];
        const unsigned h = f2bf(v); const float hv = __builtin_bit_cast(float, h << 16); WRH[i] = (bf16)h; WRL[i] = (bf16)f2bf(v - hv); }
}
DI unsigned char* wgu_ptr(Frame& F, int e) { return F.ws + (e < WGU_SPLIT ? WS_WGU0 + (size_t)e * MiB : WS_WGU1 + (size_t)(e - WGU_SPLIT) * MiB); }
DI bf16* wd_ptr(Frame& F, int e) { return (bf16*)((unsigned char*)F.out + (e < WD_SPLIT ? DO_WD0 + (size_t)e * MiB : DO_WD1 + (size_t)(e - WD_SPLIT) * MiB)); }
DI void moe_weights(Frame& F, int cb, int ncb) {
    for (int it = cb; it < NEXP * 32; it += ncb) { const int e = it >> 5, mat = (it >> 4) & 1, nb = it & 15;
        q_strip((mat ? F.in[14] : F.in[13]) + (size_t)e * 1024 * 512, 512, 32 * nb, wgu_ptr(F, e), (float*)(F.ws + WS_WSC) + e * 1024, mat + 64 * nb, 2, F.lds, F.wave, F.lane); }
    LAS float* scr = (LAS float*)(F.lds + F.wave * 16384);
    constexpr int ID = 8 * 32; const int gw = cb * NWAVES + F.wave, NGW = ncb * NWAVES;
    for (int it = gw; it < NEXP * ID; it += NGW) { const int e = it / ID, r = it % ID;
        p0_transpose_item(F.in[15] + (size_t)e * 512 * 1024, 1024, 32, wd_ptr(F, e), 512, 0, 1, scr, r, F.lane); }
}

constexpr int NG = 8, GSTEPS = 128 / NG;
constexpr size_t WS_XB = 209 * MiB;
constexpr size_t WS_AOP = 217 * MiB;
constexpr size_t WS_SG = 221 * MiB;
constexpr int GS_SLOT = 54272, GS_Q = 17408, GS_VCT = 34816, GS_VEC = 53248, GS_TB = 18432, GS_AP = 27648;
static_assert(3 * GS_SLOT <= LDS_BYTES - 64, "scan ring");
static_assert(WS_SG + 8 * MiB <= 229 * MiB, "scan buffers");
DI void gs_dma(const unsigned char* src, unsigned lane16, unsigned lds_dst) {
    unsigned keep;
    asm volatile("s_mov_b32 %0, m0\n\ts_mov_b32 m0, %2\n\ts_nop 0\n\tglobal_load_lds_dwordx4 %1, %3\n\ts_mov_b32 m0, %0" : "=&s"(keep) : "v"(lane16), "s"(lds_dst), "s"(src) : "memory");
}
#define GS_WAITBAR(N) asm volatile("s_waitcnt vmcnt(%0) lgkmcnt(0)\n\ts_barrier" :: "n"(N) : "memory")
template <int MODE> DI void gscan(Frame& F, const int chain, const int grp, const f32x4* initp, f32x4* finalp, bf16* aop) {
    constexpr bool OUT = MODE == 0;
    constexpr int N1 = OUT ? 7 : (MODE == 1 ? 5 : 3), N2 = OUT ? 5 : 4, NST = OUT ? 16 : 0;
    const int lane = F.lane, n16 = lane & 15, g = lane >> 4, e = F.wave;
    const int bh = chain >> 1, dir = chain & 1, b = bh >> 2, h = bh & 3;
    const unsigned lds0 = (unsigned)(uintptr_t)opaque(F.lds), lane16 = (unsigned)lane * 16u;
    const unsigned char* shrec = F.ws + WS_GSH + (size_t)(bh * 128) * GDN_SH_BYTES; const unsigned char* drec = F.ws + WS_GD + (size_t)((bh * 2 + dir) * 128) * GDN_D_BYTES;
#define GS_ISSUE1(st_, slot_) do { const int sc_ = (st_) < 128 ? (st_) : 127; const int n_ = dir == 0 ? sc_ : 127 - sc_; const unsigned char* sh_ = shrec + (size_t)n_ * GDN_SH_BYTES; const unsigned char* dr_ = drec + (size_t)n_ * GDN_D_BYTES; \
        _Pragma("unroll") for (int j_ = 0; j_ < N1; ++j_) { const int q_ = e + 8 * j_; int p_; \
            if (MODE == 0) p_ = q_ < 53 ? q_ : 52; else if (MODE == 1) p_ = q_ < 17 ? q_ : (q_ < 35 ? q_ + 17 : 52); else p_ = q_ < 17 ? q_ : 52; \
            const unsigned char* src_ = p_ < 34 ? sh_ + p_ * 1024 : (p_ < 52 ? sh_ + G_VCT + (p_ - 34) * 1024 : dr_ + GD_VEC); \
            gs_dma(src_, lane16, (unsigned)__builtin_amdgcn_readfirstlane(lds0 + (unsigned)((slot_) * GS_SLOT + p_ * 1024))); } } while (0)
#define GS_ISSUE2(st_, slot_) do { const int sc_ = (st_) < 128 ? (st_) : 127; const int n_ = dir == 0 ? sc_ : 127 - sc_; const unsigned char* sh_ = shrec + (size_t)n_ * GDN_SH_BYTES; const unsigned char* dr_ = drec + (size_t)n_ * GDN_D_BYTES; \
        _Pragma("unroll") for (int j_ = 0; j_ < N2; ++j_) { const int q_ = e + 8 * j_; const int pm_ = OUT ? 35 : 26; const int p_ = q_ < pm_ ? q_ : pm_; \
            const unsigned char* src_ = p_ < 18 ? sh_ + G_KNTP + p_ * 1024 : dr_ + (p_ - 18) * 1024; \
            gs_dma(src_, lane16, (unsigned)__builtin_amdgcn_readfirstlane(lds0 + (unsigned)((slot_) * GS_SLOT + p_ * 1024))); } } while (0)
    const int st0 = grp * GSTEPS;
    GS_ISSUE1(st0, 0); GS_ISSUE2(st0, 1);
    bf16* Odir = (bf16*)((unsigned char*)F.out + (dir == 0 ? DO_OF : DO_OB));
    f32x4 S[8];
    if (initp) {
#pragma unroll
        for (int i = 0; i < 8; ++i) S[i] = initp[(e * 8 + i) * 64 + lane];
    } else {
#pragma unroll
        for (int i = 0; i < 8; ++i)
#pragma unroll
            for (int r = 0; r < 4; ++r) S[i][r] = (MODE == 2 && (16 * i + 4 * g + r) == (16 * e + n16)) ? 1.0f : 0.0f;
    }
    bf16x8 Sb[4];
#pragma unroll
    for (int i = 0; i < 4; ++i) Sb[i] = pack8(S[2 * i], S[2 * i + 1]);
    const unsigned aoff272 = n16 * 272 + g * 16, aoff144 = n16 * 144 + g * 16;
#define SB_() __builtin_amdgcn_sched_barrier(0)
#define LDR128(dst, base, off) asm volatile("ds_read_b128 %0, %1 offset:%2" : "=v"(dst) : "v"(base), "i"(off) : "memory")
#define LDR64(dst, base, off) asm volatile("ds_read_b64 %0, %1 offset:%2" : "=v"(dst) : "v"(base), "i"(off) : "memory")
#define LDR32(dst, base, off) asm volatile("ds_read_b32 %0, %1 offset:%2" : "=v"(dst) : "v"(base), "i"(off) : "memory")
    int sl1 = 0, sl2 = 1, sl3 = 2;
#pragma unroll 1
    for (int s = 0; s < GSTEPS; ++s) {
        const int st = st0 + s;
        if (OUT && s > 0) GS_WAITBAR(N2 + NST); else GS_WAITBAR(N2);
        GS_ISSUE1(s + 1 < GSTEPS ? st + 1 : st, sl3);
        const int n = dir == 0 ? st : 127 - st;
        const unsigned h1 = lds0 + (unsigned)sl1 * GS_SLOT, h2 = lds0 + (unsigned)sl2 * GS_SLOT;
        const unsigned bK = h1 + aoff272, bQ = h1 + GS_Q + aoff272, bKT = h2 + aoff144, bT = h2 + GS_TB + aoff144;
        const unsigned bV = h1 + GS_VCT + e * 2304 + n16 * 144 + g * 8, bvec = h1 + GS_VEC + g * 16, bd = h1 + GS_VEC;
        f32x4 eG[4], ks[4]; v2u vv[4]; float dch; bf16x8 fa[16];
        LDR128(eG[0], bvec, 0); LDR128(eG[1], bvec, 64); LDR128(eG[2], bvec, 128); LDR128(eG[3], bvec, 192);
        LDR128(ks[0], bvec, 256); LDR128(ks[1], bvec, 320); LDR128(ks[2], bvec, 384); LDR128(ks[3], bvec, 448);
        LDR32(dch, bd, 512);
        LDR64(vv[0], bV, 0); LDR64(vv[1], bV, 32); LDR64(vv[2], bV, 64); LDR64(vv[3], bV, 96);
#pragma unroll
        for (int m = 0; m < 4; ++m) { LDR128(fa[m * 4 + 0], bK, m * 4352 + 0); LDR128(fa[m * 4 + 1], bK, m * 4352 + 64); LDR128(fa[m * 4 + 2], bK, m * 4352 + 128); LDR128(fa[m * 4 + 3], bK, m * 4352 + 192); }
        bf16x8 fq[16];
        if (OUT) {
#pragma unroll
            for (int m = 0; m < 4; ++m) { LDR128(fq[m * 4 + 0], bQ, m * 4352 + 0); LDR128(fq[m * 4 + 1], bQ, m * 4352 + 64); LDR128(fq[m * 4 + 2], bQ, m * 4352 + 128); LDR128(fq[m * 4 + 3], bQ, m * 4352 + 192); }
            asm volatile("s_waitcnt lgkmcnt(15)" : "+v"(eG[0]), "+v"(eG[1]), "+v"(eG[2]), "+v"(eG[3]), "+v"(ks[0]), "+v"(ks[1]), "+v"(ks[2]), "+v"(ks[3]), "+v"(dch), "+v"(vv[0]), "+v"(vv[1]), "+v"(vv[2]), "+v"(vv[3]),
                         "+v"(fa[0]), "+v"(fa[1]), "+v"(fa[2]), "+v"(fa[3]), "+v"(fa[4]), "+v"(fa[5]), "+v"(fa[6]), "+v"(fa[7]), "+v"(fa[8]), "+v"(fa[9]), "+v"(fa[10]), "+v"(fa[11]), "+v"(fa[12]), "+v"(fa[13]), "+v"(fa[14]), "+v"(fa[15]) :: "memory");
        } else {
            asm volatile("s_waitcnt lgkmcnt(0)" : "+v"(eG[0]), "+v"(eG[1]), "+v"(eG[2]), "+v"(eG[3]), "+v"(ks[0]), "+v"(ks[1]), "+v"(ks[2]), "+v"(ks[3]), "+v"(dch), "+v"(vv[0]), "+v"(vv[1]), "+v"(vv[2]), "+v"(vv[3]),
                         "+v"(fa[0]), "+v"(fa[1]), "+v"(fa[2]), "+v"(fa[3]), "+v"(fa[4]), "+v"(fa[5]), "+v"(fa[6]), "+v"(fa[7]), "+v"(fa[8]), "+v"(fa[9]), "+v"(fa[10]), "+v"(fa[11]), "+v"(fa[12]), "+v"(fa[13]), "+v"(fa[14]), "+v"(fa[15]) :: "memory");
        }
        SB_();
        f32x4 KS[4];
#pragma unroll
        for (int m = 0; m < 4; ++m) KS[m] = (f32x4){0.f, 0.f, 0.f, 0.f};
#pragma unroll
        for (int i = 0; i < 4; ++i)
#pragma unroll
            for (int m = 0; m < 4; ++m) KS[m] = __builtin_amdgcn_mfma_f32_16x16x32_bf16(fa[m * 4 + i], Sb[i], KS[m], 0, 0, 0);
        SB_();
        if (OUT) {
            if (s > 0) asm volatile("s_waitcnt vmcnt(%16) lgkmcnt(0)\n\ts_barrier" : "+v"(fq[0]), "+v"(fq[1]), "+v"(fq[2]), "+v"(fq[3]), "+v"(fq[4]), "+v"(fq[5]), "+v"(fq[6]), "+v"(fq[7]), "+v"(fq[8]), "+v"(fq[9]), "+v"(fq[10]), "+v"(fq[11]), "+v"(fq[12]), "+v"(fq[13]), "+v"(fq[14]), "+v"(fq[15]) : "n"(N1 + NST) : "memory");
            else asm volatile("s_waitcnt vmcnt(%16) lgkmcnt(0)\n\ts_barrier" : "+v"(fq[0]), "+v"(fq[1]), "+v"(fq[2]), "+v"(fq[3]), "+v"(fq[4]), "+v"(fq[5]), "+v"(fq[6]), "+v"(fq[7]), "+v"(fq[8]), "+v"(fq[9]), "+v"(fq[10]), "+v"(fq[11]), "+v"(fq[12]), "+v"(fq[13]), "+v"(fq[14]), "+v"(fq[15]) : "n"(N1) : "memory");
        } else GS_WAITBAR(N1);
        GS_ISSUE2(s + 1 < GSTEPS ? st + 1 : st, sl1);
        bf16x8 ft[8];
#pragma unroll
        for (int m = 0; m < 4; ++m) { LDR128(ft[m * 2 + 0], bT, m * 2304 + 0); LDR128(ft[m * 2 + 1], bT, m * 2304 + 64); }
        SB_();
        f32x4 o[4];
        if (OUT) {
#pragma unroll
            for (int m = 0; m < 4; ++m) o[m] = (f32x4){0.f, 0.f, 0.f, 0.f};
#pragma unroll
            for (int i = 0; i < 4; ++i)
#pragma unroll
                for (int m = 0; m < 4; ++m) o[m] = __builtin_amdgcn_mfma_f32_16x16x32_bf16(fq[m * 4 + i], Sb[i], o[m], 0, 0, 0);
        }
        f32x4 rr[4];
#pragma unroll
        for (int m = 0; m < 4; ++m) {
            if (MODE == 2) { rr[m][0] = -eG[m][0] * KS[m][0]; rr[m][1] = -eG[m][1] * KS[m][1]; rr[m][2] = -eG[m][2] * KS[m][2]; rr[m][3] = -eG[m][3] * KS[m][3]; }
            else { rr[m][0] = bflo(vv[m].x) - eG[m][0] * KS[m][0]; rr[m][1] = bfhi(vv[m].x) - eG[m][1] * KS[m][1]; rr[m][2] = bflo(vv[m].y) - eG[m][2] * KS[m][2]; rr[m][3] = bfhi(vv[m].y) - eG[m][3] * KS[m][3]; } }
        bf16x8 rb[2]; rb[0] = pack8(rr[0], rr[1]); rb[1] = pack8(rr[2], rr[3]);
        SB_();
        bf16x8 fk[16];
#pragma unroll
        for (int jt = 0; jt < 8; ++jt) { LDR128(fk[jt * 2 + 0], bKT, jt * 2304 + 0); LDR128(fk[jt * 2 + 1], bKT, jt * 2304 + 64); }
        asm volatile("s_waitcnt lgkmcnt(15)" : "+v"(ft[0]), "+v"(ft[1]), "+v"(ft[2]), "+v"(ft[3]), "+v"(ft[4]), "+v"(ft[5]), "+v"(ft[6]), "+v"(ft[7]) :: "memory");
        SB_();
        f32x4 vn[4];
#pragma unroll
        for (int m = 0; m < 4; ++m) vn[m] = (f32x4){0.f, 0.f, 0.f, 0.f};
#pragma unroll
        for (int i = 0; i < 2; ++i)
#pragma unroll
            for (int m = 0; m < 4; ++m) vn[m] = __builtin_amdgcn_mfma_f32_16x16x32_bf16(ft[m * 2 + i], rb[i], vn[m], 0, 0, 0);
        if (OUT) {
#pragma unroll
            for (int m = 0; m < 4; ++m) o[m] = o[m] * eG[m];
        }
#pragma unroll
        for (int jt = 0; jt < 8; ++jt) S[jt] = S[jt] * dch;
        SB_();
        bf16x8 fp[8];
        if (OUT) {
#pragma unroll
            for (int m = 0; m < 4; ++m) { LDR128(fp[m * 2 + 0], bT, (GS_AP - GS_TB) + m * 2304 + 0); LDR128(fp[m * 2 + 1], bT, (GS_AP - GS_TB) + m * 2304 + 64); }
        }
        bf16x8 vnb[2]; vnb[0] = pack8(vn[0], vn[1]); vnb[1] = pack8(vn[2], vn[3]);
        bf16x8 vs[2]; vs[0] = pack8(vn[0] * ks[0], vn[1] * ks[1]); vs[1] = pack8(vn[2] * ks[2], vn[3] * ks[3]);
        if (OUT) asm volatile("s_waitcnt lgkmcnt(8)" : "+v"(fk[0]), "+v"(fk[1]), "+v"(fk[2]), "+v"(fk[3]), "+v"(fk[4]), "+v"(fk[5]), "+v"(fk[6]), "+v"(fk[7]), "+v"(fk[8]), "+v"(fk[9]), "+v"(fk[10]), "+v"(fk[11]), "+v"(fk[12]), "+v"(fk[13]), "+v"(fk[14]), "+v"(fk[15]) :: "memory");
        else asm volatile("s_waitcnt lgkmcnt(0)" : "+v"(fk[0]), "+v"(fk[1]), "+v"(fk[2]), "+v"(fk[3]), "+v"(fk[4]), "+v"(fk[5]), "+v"(fk[6]), "+v"(fk[7]), "+v"(fk[8]), "+v"(fk[9]), "+v"(fk[10]), "+v"(fk[11]), "+v"(fk[12]), "+v"(fk[13]), "+v"(fk[14]), "+v"(fk[15]) :: "memory");
        SB_();
#pragma unroll
        for (int i = 0; i < 2; ++i)
#pragma unroll
            for (int jt = 0; jt < 8; ++jt) S[jt] = __builtin_amdgcn_mfma_f32_16x16x32_bf16(fk[jt * 2 + i], vs[i], S[jt], 0, 0, 0);
        if (OUT) {
            asm volatile("s_waitcnt lgkmcnt(0)" : "+v"(fp[0]), "+v"(fp[1]), "+v"(fp[2]), "+v"(fp[3]), "+v"(fp[4]), "+v"(fp[5]), "+v"(fp[6]), "+v"(fp[7]) :: "memory");
#pragma unroll
            for (int i = 0; i < 2; ++i)
#pragma unroll
                for (int m = 0; m < 4; ++m) o[m] = __builtin_amdgcn_mfma_f32_16x16x32_bf16(fp[m * 2 + i], vnb[i], o[m], 0, 0, 0);
        }
#pragma unroll
        for (int i = 0; i < 4; ++i) Sb[i] = pack8(S[2 * i], S[2 * i + 1]);
        SB_();
        if (OUT) {
            bf16* op = Odir + (size_t)(b * SEQ + n * 64) * 512 + h * 128 + 16 * e + n16;
#pragma unroll
            for (int m = 0; m < 4; ++m)
#pragma unroll
                for (int r = 0; r < 4; ++r) op[(size_t)(16 * m + 4 * g + r) * 512] = (bf16)(pk2(o[m][r], 0.f) & 0xffffu);
        }
        { const int t_ = sl1; sl1 = sl3; sl3 = sl2; sl2 = t_; }
    }
#undef SB_
#undef LDR128
#undef LDR64
#undef LDR32
#undef GS_ISSUE1
#undef GS_ISSUE2
    if (finalp) {
#pragma unroll
        for (int i = 0; i < 8; ++i) finalp[(e * 8 + i) * 64 + lane] = S[i];
    }
    if (aop) {
#pragma unroll
        for (int jt = 0; jt < 8; ++jt)
#pragma unroll
            for (int r = 0; r < 4; ++r) aop[((jt * 4 + (e >> 1)) * 64 + 16 * (n16 >> 2) + 4 * g + r) * 8 + 4 * (e & 1) + (n16 & 3)] = (bf16)(pk2(S[jt][r], 0.f) & 0xffffu);
    }
    asm volatile("s_waitcnt vmcnt(0)" ::: "memory");
    __syncthreads();
}
DI f32x4* gs_img(Frame& F, size_t base, int chain, int grp) { return (f32x4*)(F.ws + base) + (size_t)(chain * NG + grp) * (8 * 8 * 64); }
DI bf16* gs_aop(Frame& F, int chain, int grp) { return (bf16*)(F.ws + WS_AOP) + (size_t)(chain * NG + grp) * (8 * 4 * 64 * 8); }
DI bool p4_pass1(Frame& F) {
    const int T = F.vcu; if (F.G != 256 || T >= 16 * (NG - 1) * 2) return false;
    const int part = T & 1, cg = T >> 1, chain = cg / (NG - 1), grp = cg % (NG - 1);
    if (part == 0) { gscan<1>(F, chain, grp, nullptr, gs_img(F, WS_XB, chain, grp), nullptr); return true; }
    if (grp == 0) return false;
    gscan<2>(F, chain, grp, nullptr, nullptr, gs_aop(F, chain, grp)); return true;
}
DI bool p4_pass2(Frame& F) {
    const int chain = F.vcu >> 4; if (F.G != 256 || (F.vcu & 15) != 0) return false;
    const int lane = F.lane, e = F.wave;
    f32x4 S[8];
    { const f32x4* b0 = gs_img(F, WS_XB, chain, 0); f32x4* s1 = gs_img(F, WS_SG, chain, 1);
#pragma unroll
      for (int i = 0; i < 8; ++i) { S[i] = b0[(e * 8 + i) * 64 + lane]; s1[(e * 8 + i) * 64 + lane] = S[i]; } }
#pragma unroll 1
    for (int gq = 1; gq <= NG - 2; ++gq) {
        const f32x4* bg = gs_img(F, WS_XB, chain, gq); const bf16x8* ag = (const bf16x8*)gs_aop(F, chain, gq); f32x4* sn = gs_img(F, WS_SG, chain, gq + 1);
        bf16x8 Sb[4];
#pragma unroll
        for (int i = 0; i < 4; ++i) Sb[i] = pack8(S[2 * i], S[2 * i + 1]);
#pragma unroll
        for (int jt = 0; jt < 8; ++jt) { f32x4 acc = bg[(e * 8 + jt) * 64 + lane];
#pragma unroll
            for (int i = 0; i < 4; ++i) acc = __builtin_amdgcn_mfma_f32_16x16x32_bf16(ag[(jt * 4 + i) * 64 + lane], Sb[i], acc, 0, 0, 0);
            S[jt] = acc; }
#pragma unroll
        for (int jt = 0; jt < 8; ++jt) sn[(e * 8 + jt) * 64 + lane] = S[jt];
    }
    return true;
}
DI void p4_pass3(Frame& F) {
    if (F.G != 256) return;
    if ((F.vcu & 1) == 0) { const int T = F.vcu >> 1, chain = T / NG, grp = T % NG;
        gscan<0>(F, chain, grp, grp == 0 ? nullptr : gs_img(F, WS_SG, chain, grp), nullptr, nullptr); return; }
    const int cb = F.vcu >> 1; small_weights(F, cb * NWAVES + F.wave, 128 * NWAVES); moe_weights(F, cb, 128);
}

DI void p5_combine(Frame& F) {
    const int gw = F.vcu * NWAVES + F.wave, NGW = F.G * NWAVES, lane = F.lane;
    const bf16* OFp = (const bf16*)((unsigned char*)F.out + DO_OF); const bf16* OBp = (const bf16*)((unsigned char*)F.out + DO_OB);
    const bf16* ZA = (const bf16*)(F.ws + WS_ZA); bf16* OCAT = (bf16*)(F.ws + WS_OCAT);
    const float* nw = F.in[6] + (lane & 15) * 8;
    float w8[8];
#pragma unroll
    for (int c = 0; c < 8; ++c) w8[c] = nw[c];
    constexpr int NB4 = 4;
    for (int t0 = gw; t0 < TT; t0 += NB4 * NGW) {
        v4u a[NB4], bb[NB4], z[NB4];
#pragma unroll
        for (int u = 0; u < NB4; ++u) { const int t = (t0 + u * NGW < TT) ? t0 + u * NGW : t0;
            a[u] = *(const v4u*)(OFp + (size_t)t * 512 + lane * 8); bb[u] = *(const v4u*)(OBp + (size_t)t * 512 + lane * 8); z[u] = *(const v4u*)(ZA + (size_t)t * 512 + lane * 8); }
#pragma unroll
        for (int u = 0; u < NB4; ++u) {
            const int t = t0 + u * NGW; if (t >= TT) break;
            float o[8] = {bflo(a[u].x) + bflo(bb[u].x), bfhi(a[u].x) + bfhi(bb[u].x), bflo(a[u].y) + bflo(bb[u].y), bfhi(a[u].y) + bfhi(bb[u].y), bflo(a[u].z) + bflo(bb[u].z), bfhi(a[u].z) + bfhi(bb[u].z), bflo(a[u].w) + bflo(bb[u].w), bfhi(a[u].w) + bfhi(bb[u].w)};
            const float zz[8] = {bflo(z[u].x), bfhi(z[u].x), bflo(z[u].y), bfhi(z[u].y), bflo(z[u].z), bfhi(z[u].z), bflo(z[u].w), bfhi(z[u].w)};
            float ss = 0.f;
#pragma unroll
            for (int c = 0; c < 8; ++c) ss += o[c] * o[c];
            ss = sum16(ss);
            const float rn = __builtin_amdgcn_rsqf(ss * (1.f / 128.f) + EPS);
#pragma unroll
            for (int c = 0; c < 8; ++c) o[c] = o[c] * rn * w8[c] * siluf(zz[c]);
            v4u r; r.x = pk2(o[0], o[1]); r.y = pk2(o[2], o[3]); r.z = pk2(o[4], o[5]); r.w = pk2(o[6], o[7]);
            *(v4u*)(OCAT + (size_t)t * 1024 + lane * 8) = r;
        }
    }
}

struct TokRec { int e[2]; int row[2]; float gate[2]; };
DI void p7_route(Frame& F) {
    const int lane = F.lane, n16 = lane & 15, g = lane >> 4, wave = F.wave;
    const bf16* X1 = (const bf16*)(F.ws + WS_X1); const float* nfw = F.in[10];
    const bf16* WRH = (const bf16*)(F.ws + WS_WR); const bf16* WRL = WRH + 48 * 1024;
    unsigned char* HN = (unsigned char*)F.out + DO_HN; TokRec* TOK = (TokRec*)(F.ws + WS_TOK); unsigned* gcnt = (unsigned*)(F.ws + WS_CTL) + CW_CNT; int* LIST = (int*)(F.ws + WS_LIST);
    LAS float* lg = (LAS float*)(F.lds + (wave & 3) * 4096);
    LAS unsigned* hist = (LAS unsigned*)(F.lds + 16384); LAS unsigned* base = hist + 32;
    const int sub = blockIdx.x & 7;
    const float qsc = 127.0f / act_absmax(nfw, lane);
    for (int rt0 = blockIdx.x * 4; rt0 < TT / 16; rt0 += F.G * 4) {
        if (F.tid < 32) hist[F.tid] = 0u;
        __syncthreads();
        int ex1 = 0, ex2 = 0, tok = -1; unsigned l1 = 0, l2 = 0; float g1 = 0.f, g2 = 0.f;
        const int rt = rt0 + wave;
        if (wave < 4 && rt < TT / 16) {
            const int row = rt * 16 + n16; const bf16* xr = X1 + (size_t)row * DMODEL + 8 * g;
            float ss = 0.f;
#pragma unroll 16
            for (int i = 0; i < 32; ++i) { const v4u xw = *(const v4u*)(xr + 32 * i); const f32x4 a = {bflo(xw.x), bfhi(xw.x), bflo(xw.y), bfhi(xw.y)}, b2 = {bflo(xw.z), bfhi(xw.z), bflo(xw.w), bfhi(xw.w)};
                ss += (a.x * a.x + a.y * a.y) + (a.z * a.z + a.w * a.w) + (b2.x * b2.x + b2.y * b2.y) + (b2.z * b2.z + b2.w * b2.w); }
            ss = sum_x32(sum_x16(ss));
            const float rs = __builtin_amdgcn_rsqf(ss * (1.f / DMODEL) + EPS);
            f32x4 acc[3];
#pragma unroll
            for (int q = 0; q < 3; ++q) acc[q] = (f32x4){0.f, 0.f, 0.f, 0.f};
#pragma unroll 4
            for (int i = 0; i < 32; ++i) {
                const v4u xw = *(const v4u*)(xr + 32 * i); const f32x4 a = {bflo(xw.x), bfhi(xw.x), bflo(xw.y), bfhi(xw.y)}, b2 = {bflo(xw.z), bfhi(xw.z), bflo(xw.w), bfhi(xw.w)};
                const f32x4 wa = *(const f32x4*)(nfw + 32 * i + 8 * g), wb = *(const f32x4*)(nfw + 32 * i + 8 * g + 4);
                float hv[8] = {a.x * rs * wa.x, a.y * rs * wa.y, a.z * rs * wa.z, a.w * rs * wa.w, b2.x * rs * wb.x, b2.y * rs * wb.y, b2.z * rs * wb.z, b2.w * rs * wb.w};
                v4u hi, lo;
                hi.x = pk2(hv[0], hv[1]); hi.y = pk2(hv[2], hv[3]); hi.z = pk2(hv[4], hv[5]); hi.w = pk2(hv[6], hv[7]);
                lo.x = pk2(hv[0] - bflo(hi.x), hv[1] - bfhi(hi.x)); lo.y = pk2(hv[2] - bflo(hi.y), hv[3] - bfhi(hi.y));
                lo.z = pk2(hv[4] - bflo(hi.z), hv[5] - bfhi(hi.z)); lo.w = pk2(hv[6] - bflo(hi.w), hv[7] - bfhi(hi.w));
                { v2u q; q.x = q8x4(hv[0], hv[1], hv[2], hv[3], qsc); q.y = q8x4(hv[4], hv[5], hv[6], hv[7], qsc); *(v2u*)(HN + (size_t)row * DMODEL + 32 * i + 8 * g) = q; }
                const bf16x8 ah = __builtin_bit_cast(bf16x8, hi), al = __builtin_bit_cast(bf16x8, lo);
#pragma unroll
                for (int q = 0; q < 3; ++q) {
                    const bf16x8 bh = *(const bf16x8*)(WRH + (size_t)(16 * q + n16) * 1024 + 32 * i + 8 * g), bl = *(const bf16x8*)(WRL + (size_t)(16 * q + n16) * 1024 + 32 * i + 8 * g);
                    acc[q] = __builtin_amdgcn_mfma_f32_16x16x32_bf16(ah, bh, acc[q], 0, 0, 0);
                    acc[q] = __builtin_amdgcn_mfma_f32_16x16x32_bf16(ah, bl, acc[q], 0, 0, 0);
                    acc[q] = __builtin_amdgcn_mfma_f32_16x16x32_bf16(al, bh, acc[q], 0, 0, 0);
                }
            }
#pragma unroll
            for (int q = 0; q < 3; ++q)
#pragma unroll
                for (int r = 0; r < 4; ++r) lg[(4 * g + r) * 48 + 16 * q + n16] = acc[q][r];
            asm volatile("s_waitcnt lgkmcnt(0)" ::: "memory");
            if (lane < 16) {
                const LAS float* L = lg + lane * 48; tok = rt * 16 + lane;
                float gm = L[0]; int gs = 0;
#pragma unroll
                for (int q = 1; q < 4; ++q) if (L[q] > gm) { gm = L[q]; gs = q; }
                float gsum = 0.f;
#pragma unroll
                for (int q = 0; q < 4; ++q) gsum += __expf(L[q] - gm);
                const float gp_top = 1.0f / gsum;
                float fv[8];
#pragma unroll
                for (int q = 0; q < 8; ++q) { float v = L[4 + q]; v = (gs == 1) ? L[12 + q] : v; v = (gs == 2) ? L[20 + q] : v; v = (gs == 3) ? L[28 + q] : v; fv[q] = v; }
                float m1 = fv[0]; int i1 = 0;
#pragma unroll
                for (int q = 1; q < 8; ++q) if (fv[q] > m1) { m1 = fv[q]; i1 = q; }
                float m2 = -3.0e38f; int i2 = 0;
#pragma unroll
                for (int q = 0; q < 8; ++q) if (q != i1 && fv[q] > m2) { m2 = fv[q]; i2 = q; }
                const float e2 = __expf(m2 - m1); g1 = gp_top / (1.0f + e2); g2 = gp_top * e2 / (1.0f + e2);
                ex1 = gs * 8 + i1; ex2 = gs * 8 + i2;
                l1 = __hip_atomic_fetch_add(hist + ex1, 1u, __ATOMIC_RELAXED, __HIP_MEMORY_SCOPE_WORKGROUP); l2 = __hip_atomic_fetch_add(hist + ex2, 1u, __ATOMIC_RELAXED, __HIP_MEMORY_SCOPE_WORKGROUP);
            }
        }
        __syncthreads();
        if (F.tid < 32) { const unsigned hcount = hist[F.tid]; base[F.tid] = hcount ? atomicAdd(gcnt + F.tid * 8 + sub, hcount) : 0u; }
        __syncthreads();
        if (tok >= 0) {
            const int s1 = (int)(base[ex1] + l1), s2 = (int)(base[ex2] + l2);
            LIST[(size_t)(ex1 * 8 + sub) * TT + s1] = tok; LIST[(size_t)(ex2 * 8 + sub) * TT + s2] = tok;
            TokRec tr; tr.e[0] = ex1; tr.e[1] = ex2; tr.row[0] = (sub << 24) | s1; tr.row[1] = (sub << 24) | s2; tr.gate[0] = g1; tr.gate[1] = g2;
            TOK[tok] = tr;
        }
    }
}

DI void build_etab(Frame& F) {
    LAS unsigned* etab = (LAS unsigned*)(F.lds + ETAB_OFF);
    if (F.tid < 32) {
        const unsigned* gcnt = (const unsigned*)(F.ws + WS_CTL) + CW_CNT + F.tid * 8; unsigned acc = 0;
#pragma unroll
        for (int q = 0; q < 8; ++q) { const unsigned c = __hip_atomic_load(gcnt + q, __ATOMIC_RELAXED, __HIP_MEMORY_SCOPE_AGENT); etab[96 + 8 * F.tid + q] = acc; acc += c; }
        etab[64 + F.tid] = acc; etab[2 * F.tid + 1] = (acc + 255u) >> 8;
    }
    __syncthreads();
    if (F.tid == 0) { unsigned acc = 0; for (int e = 0; e < NEXP; ++e) { etab[2 * e] = acc; acc += etab[2 * e + 1]; } }
    if (F.wave == 1) { const float am = act_absmax(F.in[10], F.lane); if (F.lane == 0) ((LAS float*)etab)[352] = am * (1.0f / 127.0f); }
    __syncthreads();
}

DI void p11_final(Frame& F) {
    build_etab(F);
    const LAS unsigned* etab = (const LAS unsigned*)(F.lds + ETAB_OFF);
    const int gw = F.vcu * NWAVES + F.wave, NGW = F.G * NWAVES, lane = F.lane;
    const bf16* Y = (const bf16*)(F.ws + WS_XBUF); const TokRec* TOK = (const TokRec*)(F.ws + WS_TOK); const float* fw = F.in[16];
    const f32x4 w0 = *(const f32x4*)(fw + lane * 8), w1 = *(const f32x4*)(fw + lane * 8 + 4), w2 = *(const f32x4*)(fw + 512 + lane * 8), w3 = *(const f32x4*)(fw + 516 + lane * 8);
    constexpr int NB2 = 2;
    for (int t0 = gw; t0 < TT; t0 += NB2 * NGW) {
        TokRec tr[NB2]; v4u xa[NB2][2]; v4u ya[NB2][2][2];
#pragma unroll
        for (int u = 0; u < NB2; ++u) { const int t = (t0 + u * NGW < TT) ? t0 + u * NGW : t0; tr[u] = TOK[t];
            const bf16* xr = (const bf16*)(F.ws + WS_X1) + (size_t)t * DMODEL + lane * 8;
            xa[u][0] = *(const v4u*)(xr); xa[u][1] = *(const v4u*)(xr + 512); }
#pragma unroll
        for (int u = 0; u < NB2; ++u)
#pragma unroll
            for (int k = 0; k < 2; ++k) { const unsigned rk = (unsigned)tr[u].row[k]; const bf16* yr = Y + (size_t)(etab[2 * tr[u].e[k]] * 256u + etab[96 + 8 * tr[u].e[k] + (rk >> 24)] + (rk & 0xffffffu)) * DMODEL + lane * 8; ya[u][k][0] = *(const v4u*)(yr); ya[u][k][1] = *(const v4u*)(yr + 512); }
#pragma unroll
        for (int u = 0; u < NB2; ++u) {
            const int t = t0 + u * NGW; if (t >= TT) break;
            float v[16] = {bflo(xa[u][0].x), bfhi(xa[u][0].x), bflo(xa[u][0].y), bfhi(xa[u][0].y), bflo(xa[u][0].z), bfhi(xa[u][0].z), bflo(xa[u][0].w), bfhi(xa[u][0].w),
                           bflo(xa[u][1].x), bfhi(xa[u][1].x), bflo(xa[u][1].y), bfhi(xa[u][1].y), bflo(xa[u][1].z), bfhi(xa[u][1].z), bflo(xa[u][1].w), bfhi(xa[u][1].w)};
#pragma unroll
            for (int k = 0; k < 2; ++k) {
                const float gk = tr[u].gate[k]; const v4u y0 = ya[u][k][0], y1 = ya[u][k][1];
                v[0] += gk * bflo(y0.x); v[1] += gk * bfhi(y0.x); v[2] += gk * bflo(y0.y); v[3] += gk * bfhi(y0.y); v[4] += gk * bflo(y0.z); v[5] += gk * bfhi(y0.z); v[6] += gk * bflo(y0.w); v[7] += gk * bfhi(y0.w);
                v[8] += gk * bflo(y1.x); v[9] += gk * bfhi(y1.x); v[10] += gk * bflo(y1.y); v[11] += gk * bfhi(y1.y); v[12] += gk * bflo(y1.z); v[13] += gk * bfhi(y1.z); v[14] += gk * bflo(y1.w); v[15] += gk * bfhi(y1.w);
            }
            float ss = 0.f;
#pragma unroll
            for (int i = 0; i < 16; ++i) ss += v[i] * v[i];
            const float rs = __builtin_amdgcn_rsqf(wave_sum(ss) * (1.f / DMODEL) + EPS);
            float* orow = F.out + (size_t)t * DMODEL + lane * 8;
            *(f32x4*)(orow) = (f32x4){v[0] * rs * w0.x, v[1] * rs * w0.y, v[2] * rs * w0.z, v[3] * rs * w0.w};
            *(f32x4*)(orow + 4) = (f32x4){v[4] * rs * w1.x, v[5] * rs * w1.y, v[6] * rs * w1.z, v[7] * rs * w1.w};
            *(f32x4*)(orow + 512) = (f32x4){v[8] * rs * w2.x, v[9] * rs * w2.y, v[10] * rs * w2.z, v[11] * rs * w2.w};
            *(f32x4*)(orow + 516) = (f32x4){v[12] * rs * w3.x, v[13] * rs * w3.y, v[14] * rs * w3.z, v[15] * rs * w3.w};
        }
    }
}

struct Args { const float* in[17]; float* out; unsigned char* ws; int ph_lo, ph_hi; };
__global__ void __launch_bounds__(NTHREADS, 2) fwd_kernel(Args args) {
    extern __shared__ __attribute__((aligned(16))) unsigned char lds[];
    cg::grid_group grid = cg::this_grid();
    Frame F;
    F.lds = (LAS unsigned char*)lds; F.tid = threadIdx.x; F.lane = F.tid & 63; F.wave = __builtin_amdgcn_readfirstlane(F.tid >> 6);
    F.G = gridDim.x; { const int bx = blockIdx.x; F.vcu = (F.G % 8 == 0) ? (bx % 8) * (F.G / 8) + bx / 8 : bx; }
#pragma unroll
    for (int i = 0; i < 17; ++i) F.in[i] = args.in[i];
    F.out = args.out; F.ws = args.ws;
    const int lo = args.ph_lo, hi = args.ph_hi;
    if (F.tid < 16) ((volatile LAS unsigned*)(F.lds + MISC_OFF))[F.tid] = 0u;
    __syncthreads();
    XcdBarrier bar = xcd_barrier_post((unsigned*)(F.ws + WS_CTL) + CW_BAR, (volatile LAS unsigned*)(F.lds + MISC_OFF));
    if (lo > 1000) grid.sync();
#ifndef PHSEL
#define PHSEL 0xfff
#endif
#define IN(k) (((PHSEL >> (k)) & 1) && lo <= (k) && (k) < hi)
#define SEAM(k) do { if (IN(k) && IN((k) + 1)) xcd_barrier(bar); } while (0)
#ifndef REP_PH
#define REP_PH -1
#endif
#define REPS(k) for (int rep_ = 0; rep_ < ((k) == REP_PH ? 2 : 1); ++rep_, ((k) == REP_PH && rep_ < 2) ? xcd_barrier(bar) : (void)0)
    if (IN(0)) REPS(0) { p0_prologue(F); } SEAM(0);
    if (IN(1)) REPS(1) {
        pg8::Gemm gm{(const pg8::bf16_t*)(F.ws + WS_XN), (const pg8::bf16_t*)(F.ws + WS_WIN), TT, NPROJ, DMODEL / 2};
        pg8::StaticOrder S; S.init(TT, NPROJ, F.G, (int)blockIdx.x);
        EpiProj E{(bf16*)(F.ws + WS_QKVA), (bf16*)(F.ws + WS_ZA), (bf16*)(F.ws + WS_QKVB), (const float*)(F.ws + WS_WSI), (const float*)(F.ws + WS_XSC)};
        pg8::gemm_phase_gather<EpiProj, pg8::StaticOrder, IdRows, true, true>(F.lds, gm, S, E, IdRows{});
    } SEAM(1);
    if (IN(2)) REPS(2) {
#ifndef NO_ROPE
        p2_rope(F);
#ifdef PROBE_ROPE2
        xcd_barrier(bar); p2_rope(F);
#endif
#endif
#ifndef NO_PRE
        p2_gdn_pre(F);
#ifdef PROBE_PRE2
        xcd_barrier(bar); p2_gdn_pre(F);
#endif
#endif
    } SEAM(2);
    if (IN(3)) REPS(3) {
        const attn_body::AttnTensors AT{(const attn_body::bf16*)((unsigned char*)F.out + DO_QR), (const attn_body::bf16*)((unsigned char*)F.out + DO_KR), (const attn_body::bf16*)((unsigned char*)F.out + DO_VR),
                                        (attn_body::bf16*)(F.ws + WS_OCAT) + 512};
        const attn_body::StaticOrder S((int)F.G, (int)blockIdx.x);
#ifdef PROBE_ZERO_ATTN
        { (void)AT; (void)S; bf16* OC = (bf16*)(F.ws + WS_OCAT); const int gt = blockIdx.x * NTHREADS + F.tid, GT = F.G * NTHREADS;
          for (int i = gt; i < TT * 64; i += GT) { const int t = i >> 6, c = i & 63; *(v4u*)(OC + (size_t)t * 1024 + 512 + c * 8) = (v4u){0u, 0u, 0u, 0u}; } }
#else
        const float nshift = -(0.125f * 1.4426950408889634f * 64.f * 1.01f) * wave_max(fabsf(F.in[7][F.lane])) * wave_max(fabsf(F.in[8][F.lane]));
        attn_body::attn_phase<attn_body::StaticOrder>((char*)lds, AT, S, nshift);
#endif
    } SEAM(3);
    if (IN(4)) { (void)p4_pass1(F); xcd_barrier(bar); (void)p4_pass2(F); xcd_barrier(bar); p4_pass3(F); } SEAM(4);
    if (IN(5)) REPS(5) { p5_combine(F); if (F.G <= 128) { small_weights(F, F.vcu * NWAVES + F.wave, F.G * NWAVES); moe_weights(F, F.vcu, F.G); } } SEAM(5);
    if (IN(6)) REPS(6) {
        pg8::Gemm gm{(const pg8::bf16_t*)(F.ws + WS_OCAT), (const pg8::bf16_t*)(F.ws + WS_WOUT), TT, DMODEL, DMODEL}; pg8::StaticOrder S; S.init(TT, DMODEL, F.G, (int)blockIdx.x);
        EpiResid E{F.in[0], (bf16*)(F.ws + WS_X1)};
        pg8::gemm_phase<EpiResid, pg8::StaticOrder, true, true>(F.lds, gm, S, E);
    } SEAM(6);
    if (IN(7)) { p7_route(F); } SEAM(7);
    if (IN(9)) REPS(9) {
        build_etab(F);
        pg8::Gemm gm{(const pg8::bf16_t*)((unsigned char*)F.out + DO_HN), (const pg8::bf16_t*)(F.ws + WS_WGU0), 0, 0, DMODEL / 2};
        MoeOrder S{(const LAS unsigned*)(F.lds + ETAB_OFF), F.G, (int)blockIdx.x, WGU_SPLIT, (int)((WS_WGU1 - WS_WGU0) / (256 * 1024))};
        MoeRows AM{(const int*)(F.ws + WS_LIST), (const LAS unsigned*)(F.lds + ETAB_OFF)};
        EpiGU E{(bf16*)(F.ws + WS_HID), (const float*)(F.ws + WS_WSC), ((const LAS float*)(F.lds + ETAB_OFF))[352]};
        pg8::gemm_phase_gather<EpiGU, MoeOrder, MoeRows, true, true>(F.lds, gm, S, E, AM);
    } SEAM(9);
    if (IN(10)) REPS(10) {
        pg8::Gemm gm{(const pg8::bf16_t*)(F.ws + WS_HID), (const pg8::bf16_t*)((unsigned char*)F.out + DO_WD0), 0, 0, FFE}; build_etab(F); MoeOrder S{(const LAS unsigned*)(F.lds + ETAB_OFF), F.G, (int)blockIdx.x, WD_SPLIT, (int)((DO_WD1 - DO_WD0) / (256 * 1024))};
        EpiY E{(bf16*)(F.ws + WS_XBUF)};
        pg8::gemm_phase<EpiY, MoeOrder, true, true>(F.lds, gm, S, E);
    } SEAM(10);
#ifdef EXTRA_SYNCS
    for (int q_ = 0; q_ < EXTRA_SYNCS; ++q_) xcd_barrier(bar);
#endif
    if (IN(11)) { p11_final(F); }
#undef IN
#undef SEAM
}

extern "C" void kernel_launch(void* const* d_in, const int* in_sizes, int n_in, void* d_out, int out_size, void* d_ws, size_t ws_size, hipStream_t stream) {
    static int grid = 0;
    if (grid == 0) {
        if (n_in != 17 || out_size != TT * DMODEL || ws_size < WS_END) { fprintf(stderr, "kernel_launch: unexpected problem (n_in %d out %d ws %zu)\n", n_in, out_size, ws_size); grid = -1; return; }
        int dev = 0, cus = 0, per_cu = 0;
        if (hipGetDevice(&dev) != hipSuccess || hipDeviceGetAttribute(&cus, hipDeviceAttributeMultiprocessorCount, dev) != hipSuccess) { grid = -1; return; }
        if (hipFuncSetAttribute((const void*)fwd_kernel, hipFuncAttributeMaxDynamicSharedMemorySize, LDS_BYTES) != hipSuccess) { fprintf(stderr, "hipFuncSetAttribute failed\n"); grid = -1; return; }
        if (hipOccupancyMaxActiveBlocksPerMultiprocessor(&per_cu, (const void*)fwd_kernel, NTHREADS, LDS_BYTES) != hipSuccess || per_cu < 1) { fprintf(stderr, "occupancy query: %d\n", per_cu); grid = -1; return; }
        grid = cus;
    }
    if (grid < 0) return;
    (void)hipMemsetAsync((char*)d_ws + WS_CTL, 0, CTL_ZERO_BYTES, stream);
    Args a{};
    for (int i = 0; i < 17; ++i) a.in[i] = (const float*)d_in[i];
    a.out = (float*)d_out; a.ws = (unsigned char*)d_ws;
#if MK_PER_PHASE
    for (int p = 0; p < N_PHASES; ++p) { a.ph_lo = p; a.ph_hi = p + 1; hipLaunchKernelGGL(fwd_kernel, dim3(grid), dim3(NTHREADS), LDS_BYTES, stream, a); }
#else
    a.ph_lo = 0; a.ph_hi = N_PHASES;
    void* kargs[] = {&a};
    hipError_t e = hipLaunchCooperativeKernel((void*)fwd_kernel, dim3(grid), dim3(NTHREADS), kargs, LDS_BYTES, stream);
    if (e != hipSuccess) fprintf(stderr, "cooperative launch failed: %s (grid %d)\n", hipGetErrorString(e), grid);
#endif
}
```

```cpp
#include <hip/hip_runtime.h>
#include <cstdio>
#include <cstdint>
namespace pg8 {
#define PG8_LAS __attribute__((address_space(3)))
typedef unsigned short bf16_t;
typedef short bf16x8 __attribute__((ext_vector_type(8)));
typedef float f32x4 __attribute__((ext_vector_type(4)));
typedef unsigned u32x4 __attribute__((ext_vector_type(4)));
constexpr int BM = 256, BK = 64, HALF = 128, HTB = HALF * BK * 2  , STAGE_BYTES = 8 * HTB, NXCD = 8, WGM = 8;

__host__ __device__ __forceinline__ int lds_byte(int r, int c) { const int st = (r >> 4) * 2 + (c >> 5), rr = r & 15, cc = c & 31, ob = rr * 64 + cc * 2; return st * 1024 + (ob ^ (((ob >> 9) & 1) << 5)); }
__host__ __device__ __forceinline__ void stage_rc(int b, int& R, int& C) { const int st = b / 1024, sb = b % 1024, swz = sb ^ (((sb >> 9) & 1) << 5); R = (st >> 1) * 16 + swz / 64; C = (st & 1) * 32 + (swz % 64) / 2; }
__host__ __device__ __forceinline__ int perm32(int rho) { const int n = rho >> 4, i = rho & 15; return 8 * (i >> 2) + 4 * n + (i & 3); }

struct Unit { int pm, pn, ex, tq; };
struct Gemm { const bf16_t* A; const bf16_t* Bt; int M, N, K; };

struct StaticOrder {
    int nM, nN, nwg, G, c;
    __host__ __device__ void init(int M, int N, int G_, int c_) { nM = M / BM; nN = N / BM; nwg = nM * nN; G = G_; c = c_; }
    __host__ __device__ bool next(int i, Unit& u) const {
        const long L = (long)i * G + c; if (L >= nwg) return false;
        int wgid = (int)L; { const int q = nwg / NXCD, r = nwg % NXCD, xcd = wgid % NXCD, off = wgid / NXCD; wgid = (xcd < r ? xcd * (q + 1) : r * (q + 1) + (xcd - r) * q) + off; }
        const int nig = WGM * nN, gid = wgid / nig, fm = gid * WGM, gsz = (nM - fm) < WGM ? (nM - fm) : WGM;
        u.pm = fm + ((wgid % nig) % gsz); u.pn = (wgid % nig) / gsz; return true;
    }
    __device__ __forceinline__ void a_ready(const Unit&) const {}
    __device__ __forceinline__ void done(const Unit&) const {}
};

__device__ __forceinline__ unsigned cvt_pk_bf16(float lo, float hi) { unsigned r; asm volatile("v_cvt_pk_bf16_f32 %0, %1, %2" : "=v"(r) : "v"(lo), "v"(hi)); return r; }
typedef float f32x2 __attribute__((ext_vector_type(2)));
template <class Epi, class Sched, bool ALIGN_EPI = false, bool SP2 = false>
__device__ __forceinline__ void gemm_phase(PG8_LAS unsigned char* lds, const Gemm g, const Sched& S, const Epi& E) {
    const int tid = threadIdx.x, wid = __builtin_amdgcn_readfirstlane(tid >> 6), lane = tid & 63, wr = wid >> 2, wc = wid & 3, fr = lane & 15, fq = lane >> 4;
    const int K = g.K, nt = K / BK;
    unsigned voffA[2], voffB[2];
#pragma unroll
    for (int i = 0; i < 2; ++i) { int R, C; stage_rc(tid * 16 + i * 8192, R, C); const int Rb = Epi::PERM ? ((R & ~31) + perm32(R & 31)) : R;
        voffA[i] = (unsigned)(R * K + C) * 2u; voffB[i] = (unsigned)(Rb * K + C) * 2u; }
    const size_t kstep = (size_t)(BK * 2);
    const size_t hstep = (size_t)HALF * K * 2;
    const size_t tstep = 2 * hstep;
    const unsigned ldsw = (unsigned)wid * 1024u;
    const int aoff = lds_byte(wr * 64 + fr, fq * 8), boff = lds_byte(wc * 32 + fr, fq * 8);
#define PG8_SA(b, h) (((b) * 2 + (h)) * HTB)
#define PG8_SB(b, h) ((4 + (b) * 2 + (h)) * HTB)
#define PG8_STAGE(bufoff, gbase, voff) do { _Pragma("unroll") for (int _i = 0; _i < 2; ++_i) \
        __builtin_amdgcn_global_load_lds((const unsigned*)((const char*)(gbase) + (voff)[_i]), (PG8_LAS unsigned*)(lds + (bufoff) + ldsw + _i * 8192), 16, 0, 0); } while (0)
#define PG8_LDA(dst, b, h) do { _Pragma("unroll") for (int m = 0; m < 4; ++m) _Pragma("unroll") for (int k = 0; k < 2; ++k) dst[m][k] = *(const PG8_LAS bf16x8*)(lds + PG8_SA(b, h) + aoff + m * 2048 + k * 1024); } while (0)
#define PG8_LDB(dst, b, h) do { _Pragma("unroll") for (int n = 0; n < 2; ++n) _Pragma("unroll") for (int k = 0; k < 2; ++k) dst[n][k] = *(const PG8_LAS bf16x8*)(lds + PG8_SB(b, h) + boff + n * 2048 + k * 1024); } while (0)
#define PG8_MMA(ai, bj, At, Bt) do { __builtin_amdgcn_s_setprio(1); _Pragma("unroll") for (int m = 0; m < 4; ++m) _Pragma("unroll") for (int n = 0; n < 2; ++n) _Pragma("unroll") for (int k = 0; k < 2; ++k) \
        acc[ai][bj][m][n] = __builtin_amdgcn_mfma_f32_16x16x32_bf16(Bt[n][k], At[m][k], acc[ai][bj][m][n], 0, 0, 0); __builtin_amdgcn_s_setprio(0); } while (0)
#define PG8_WAIT_V(n) asm volatile("s_waitcnt vmcnt(" #n ")" ::: "memory")
#define PG8_WAIT_L(n) asm volatile("s_waitcnt lgkmcnt(" #n ")" ::: "memory")
#define PG8_BAR __builtin_amdgcn_s_barrier()
#define PG8_SCHED __builtin_amdgcn_sched_barrier(0)
    Unit cur, nxt; int ui = 0;
    if (!S.next(0, cur)) return;
    f32x4 acc[2][2][4][2];
#pragma unroll
    for (int a = 0; a < 2; ++a)
#pragma unroll
        for (int b = 0; b < 2; ++b)
#pragma unroll
            for (int m = 0; m < 4; ++m)
#pragma unroll
                for (int n = 0; n < 2; ++n) acc[a][b][m][n] = (f32x4){0.f, 0.f, 0.f, 0.f};
    bf16x8 At[4][2], B0[2][2], B1[2][2];
    const char* cA = (const char*)g.A + (size_t)cur.pm * tstep; const char* cB = (const char*)g.Bt + (size_t)cur.pn * tstep;
    S.a_ready(cur);
    if constexpr (SP2) {
        PG8_STAGE(PG8_SB(0, 0), cB, voffB); PG8_STAGE(PG8_SB(0, 1), cB + hstep, voffB); PG8_STAGE(PG8_SA(0, 0), cA, voffA); PG8_STAGE(PG8_SA(0, 1), cA + hstep, voffA);
        if (wr == 1) PG8_BAR;
        PG8_WAIT_V(2); PG8_BAR;
        PG8_STAGE(PG8_SB(1, 0), cB + kstep, voffB); PG8_STAGE(PG8_SA(1, 0), cA + kstep, voffA); PG8_STAGE(PG8_SB(1, 1), cB + hstep + kstep, voffB);
        PG8_WAIT_V(6); PG8_BAR;
    } else {
        PG8_STAGE(PG8_SB(0, 0), cB, voffB); PG8_STAGE(PG8_SA(0, 0), cA, voffA); PG8_STAGE(PG8_SB(0, 1), cB + hstep, voffB); PG8_STAGE(PG8_SA(0, 1), cA + hstep, voffA);
        if (wr == 1) PG8_BAR;
        PG8_WAIT_V(4); PG8_BAR;
        PG8_STAGE(PG8_SB(1, 0), cB + kstep, voffB); PG8_STAGE(PG8_SA(1, 0), cA + kstep, voffA); PG8_STAGE(PG8_SB(1, 1), cB + hstep + kstep, voffB);
        PG8_WAIT_V(6); PG8_BAR;
    }
    for (;;) {
        const bool has_next = S.next(ui + 1, nxt);
        const char* nA = has_next ? (const char*)g.A + (size_t)nxt.pm * tstep : cA; const char* nB = has_next ? (const char*)g.Bt + (size_t)nxt.pn * tstep : cB;
        for (int t = 0; t < nt; t += 2) {
            const bool last = (t == nt - 2);
            const char* a1 = cA + (size_t)(t + 1) * kstep;
            const char* a2 = last ? nA : cA + (size_t)(t + 2) * kstep; const char* b2 = last ? nB : cB + (size_t)(t + 2) * kstep;
            const char* a3 = a2 + kstep; const char* b3 = b2 + kstep;
            if (last && has_next) S.a_ready(nxt);
            if constexpr (SP2) {
            PG8_LDB(B0, 0, 0); PG8_LDB(B1, 0, 1); PG8_SCHED; PG8_LDA(At, 0, 0); PG8_STAGE(PG8_SA(1, 1), a1 + hstep, voffA);
            PG8_WAIT_V(8); PG8_WAIT_L(0); PG8_BAR; PG8_MMA(0, 0, At, B0); PG8_MMA(0, 1, At, B1); PG8_BAR; PG8_SCHED;
            PG8_LDA(At, 0, 1); PG8_STAGE(PG8_SB(0, 0), b2, voffB); PG8_STAGE(PG8_SB(0, 1), b2 + hstep, voffB); PG8_STAGE(PG8_SA(0, 0), a2, voffA);
            PG8_WAIT_V(8); PG8_WAIT_L(0); PG8_BAR; PG8_MMA(1, 0, At, B0); PG8_MMA(1, 1, At, B1); PG8_BAR; PG8_SCHED;
            PG8_LDB(B0, 1, 0); PG8_LDB(B1, 1, 1); PG8_SCHED; PG8_LDA(At, 1, 0); PG8_STAGE(PG8_SA(0, 1), a2 + hstep, voffA);
            PG8_WAIT_V(8); PG8_WAIT_L(0); PG8_BAR; PG8_MMA(0, 0, At, B0); PG8_MMA(0, 1, At, B1); PG8_BAR; PG8_SCHED;
            PG8_LDA(At, 1, 1); PG8_STAGE(PG8_SB(1, 0), b3, voffB); PG8_STAGE(PG8_SB(1, 1), b3 + hstep, voffB); PG8_STAGE(PG8_SA(1, 0), a3, voffA);
            PG8_WAIT_V(8); PG8_WAIT_L(0); PG8_BAR; PG8_MMA(1, 0, At, B0); PG8_MMA(1, 1, At, B1); PG8_BAR; PG8_SCHED;
            } else {
            PG8_LDB(B0, 0, 0); PG8_SCHED; PG8_LDA(At, 0, 0); PG8_STAGE(PG8_SA(1, 1), a1 + hstep, voffA);
            PG8_WAIT_L(8); PG8_BAR; PG8_WAIT_L(0); PG8_MMA(0, 0, At, B0); PG8_BAR; PG8_SCHED;
            PG8_LDB(B1, 0, 1); PG8_STAGE(PG8_SB(0, 0), b2, voffB);
            PG8_BAR; PG8_WAIT_L(0); PG8_MMA(0, 1, At, B1); PG8_BAR;
            PG8_LDA(At, 0, 1); PG8_STAGE(PG8_SA(0, 0), a2, voffA);
            PG8_BAR; PG8_WAIT_L(0); PG8_MMA(1, 0, At, B0); PG8_BAR; PG8_SCHED;
            PG8_STAGE(PG8_SB(0, 1), b2 + hstep, voffB);
            PG8_WAIT_V(6); PG8_BAR; PG8_MMA(1, 1, At, B1); PG8_BAR;
            PG8_LDB(B0, 1, 0); PG8_SCHED; PG8_LDA(At, 1, 0); PG8_STAGE(PG8_SA(0, 1), a2 + hstep, voffA);
            PG8_WAIT_L(8); PG8_BAR; PG8_WAIT_L(0); PG8_MMA(0, 0, At, B0); PG8_BAR; PG8_SCHED;
            PG8_LDB(B1, 1, 1); PG8_STAGE(PG8_SB(1, 0), b3, voffB);
            PG8_BAR; PG8_WAIT_L(0); PG8_MMA(0, 1, At, B1); PG8_BAR;
            PG8_LDA(At, 1, 1); PG8_STAGE(PG8_SA(1, 0), a3, voffA);
            PG8_BAR; PG8_WAIT_L(0); PG8_MMA(1, 0, At, B0); PG8_BAR; PG8_SCHED;
            PG8_STAGE(PG8_SB(1, 1), b3 + hstep, voffB);
            PG8_WAIT_V(6); PG8_BAR; PG8_MMA(1, 1, At, B1); PG8_BAR;
            }
        }
        if constexpr (ALIGN_EPI) { if (wr == 0) PG8_BAR; }
        if constexpr (!Epi::AFTER_DRAIN) { E(acc, cur, wr, wc, fr, fq); S.done(cur); }
        if (!has_next) break;
#pragma unroll
        for (int a = 0; a < 2; ++a)
#pragma unroll
            for (int b = 0; b < 2; ++b)
#pragma unroll
                for (int m = 0; m < 4; ++m)
#pragma unroll
                    for (int n = 0; n < 2; ++n) acc[a][b][m][n] = (f32x4){0.f, 0.f, 0.f, 0.f};
        cur = nxt; cA = nA; cB = nB; ++ui;
        if constexpr (ALIGN_EPI) { if (wr == 1) PG8_BAR; }
    }
    PG8_WAIT_V(0);
    if constexpr (!ALIGN_EPI) { if (wr == 0) PG8_BAR; }
    PG8_BAR;
    if constexpr (Epi::AFTER_DRAIN) { E.fused(acc, cur, wr, wc, fr, fq, lds, wid, lane); S.done(cur); }
#undef PG8_SA
#undef PG8_SB
#undef PG8_STAGE
#undef PG8_LDA
#undef PG8_LDB
#undef PG8_MMA
#undef PG8_WAIT_V
#undef PG8_WAIT_L
#undef PG8_BAR
#undef PG8_SCHED
}
typedef int i32x4 __attribute__((ext_vector_type(4)));
template <bool I8> struct AccSel { typedef f32x4 type; };
template <> struct AccSel<true> { typedef i32x4 type; };
template <bool I8> __device__ __forceinline__ void mma_step(typename AccSel<I8>::type& c, const bf16x8& b, const bf16x8& a) {
    if constexpr (I8) c = __builtin_amdgcn_mfma_i32_16x16x64_i8(__builtin_bit_cast(i32x4, b), __builtin_bit_cast(i32x4, a), c, 0, 0, 0);
    else c = __builtin_amdgcn_mfma_f32_16x16x32_bf16(b, a, c, 0, 0, 0);
}
template <class Epi, class Sched, class AMap, bool ALIGN_EPI = false, bool I8 = false>
__device__ __forceinline__ void gemm_phase_gather(PG8_LAS unsigned char* lds, const Gemm g, const Sched& S, const Epi& E, const AMap& AM) {
    constexpr bool SP2 = true;
    const int tid = threadIdx.x, wid = __builtin_amdgcn_readfirstlane(tid >> 6), lane = tid & 63, wr = wid >> 2, wc = wid & 3, fr = lane & 15, fq = lane >> 4;
    const int K = g.K, nt = K / BK;
    unsigned voffA[2], voffB[2]; int rowA[2];
#pragma unroll
    for (int i = 0; i < 2; ++i) { int R, C; stage_rc(tid * 16 + i * 8192, R, C); const int Rb = Epi::PERM ? ((R & ~31) + perm32(R & 31)) : R;
        voffA[i] = (unsigned)C * 2u; voffB[i] = (unsigned)(Rb * K + C) * 2u; rowA[i] = R; }
    const size_t kstep = (size_t)(BK * 2);
    const size_t hstep = (size_t)HALF * K * 2;
    const size_t tstep = 2 * hstep;
    const unsigned ldsw = (unsigned)wid * 1024u;
    const int aoff = lds_byte(wr * 64 + fr, fq * 8), boff = lds_byte(wc * 32 + fr, fq * 8);
#define PG8_SA(b, h) (((b) * 2 + (h)) * HTB)
#define PG8_SB(b, h) ((4 + (b) * 2 + (h)) * HTB)
#define PG8_STAGE(bufoff, gbase, voff) do { _Pragma("unroll") for (int _i = 0; _i < 2; ++_i) \
        __builtin_amdgcn_global_load_lds((const unsigned*)((const char*)(gbase) + (voff)[_i]), (PG8_LAS unsigned*)(lds + (bufoff) + ldsw + _i * 8192), 16, 0, 0); } while (0)
#define PG8_LDA(dst, b, h) do { _Pragma("unroll") for (int m = 0; m < 4; ++m) _Pragma("unroll") for (int k = 0; k < 2; ++k) dst[m][k] = *(const PG8_LAS bf16x8*)(lds + PG8_SA(b, h) + aoff + m * 2048 + k * 1024); } while (0)
#define PG8_LDB(dst, b, h) do { _Pragma("unroll") for (int n = 0; n < 2; ++n) _Pragma("unroll") for (int k = 0; k < 2; ++k) dst[n][k] = *(const PG8_LAS bf16x8*)(lds + PG8_SB(b, h) + boff + n * 2048 + k * 1024); } while (0)
#define PG8_MMA(ai, bj, At, Bt) do { __builtin_amdgcn_s_setprio(1); _Pragma("unroll") for (int m = 0; m < 4; ++m) _Pragma("unroll") for (int n = 0; n < 2; ++n) _Pragma("unroll") for (int k = 0; k < 2; ++k) \
        mma_step<I8>(acc[ai][bj][m][n], Bt[n][k], At[m][k]); __builtin_amdgcn_s_setprio(0); } while (0)
#define PG8_WAIT_V(n) asm volatile("s_waitcnt vmcnt(" #n ")" ::: "memory")
#define PG8_WAIT_L(n) asm volatile("s_waitcnt lgkmcnt(" #n ")" ::: "memory")
#define PG8_BAR __builtin_amdgcn_s_barrier()
#define PG8_SCHED __builtin_amdgcn_sched_barrier(0)
    Unit cur, nxt; int ui = 0;
    if (!S.next(0, cur)) return;
    typedef typename AccSel<I8>::type acc_t;
    acc_t acc[2][2][4][2];
#pragma unroll
    for (int a = 0; a < 2; ++a)
#pragma unroll
        for (int b = 0; b < 2; ++b)
#pragma unroll
            for (int m = 0; m < 4; ++m)
#pragma unroll
                for (int n = 0; n < 2; ++n) acc[a][b][m][n] = (acc_t){0, 0, 0, 0};
    bf16x8 At[4][2], B0[2][2], B1[2][2];
    const char* cA = (const char*)g.A; const char* cB = (const char*)g.Bt + (size_t)cur.pn * tstep;
    unsigned vA0[2], vA1[2], nA0[2], nA1[2];
#pragma unroll
    for (int i = 0; i < 2; ++i) { vA0[i] = (unsigned)AM.row(cur, rowA[i]) * (unsigned)(K * 2) + voffA[i]; vA1[i] = (unsigned)AM.row(cur, HALF + rowA[i]) * (unsigned)(K * 2) + voffA[i]; }
    S.a_ready(cur);
    if constexpr (SP2) {
        PG8_STAGE(PG8_SB(0, 0), cB, voffB); PG8_STAGE(PG8_SB(0, 1), cB + hstep, voffB); PG8_STAGE(PG8_SA(0, 0), cA, vA0); PG8_STAGE(PG8_SA(0, 1), cA, vA1);
        if (wr == 1) PG8_BAR;
        PG8_WAIT_V(2); PG8_BAR;
        PG8_STAGE(PG8_SB(1, 0), cB + kstep, voffB); PG8_STAGE(PG8_SA(1, 0), cA + kstep, vA0); PG8_STAGE(PG8_SB(1, 1), cB + hstep + kstep, voffB);
        PG8_WAIT_V(6); PG8_BAR;
    } else {
        PG8_STAGE(PG8_SB(0, 0), cB, voffB); PG8_STAGE(PG8_SA(0, 0), cA, voffA); PG8_STAGE(PG8_SB(0, 1), cB + hstep, voffB); PG8_STAGE(PG8_SA(0, 1), cA + hstep, voffA);
        if (wr == 1) PG8_BAR;
        PG8_WAIT_V(4); PG8_BAR;
        PG8_STAGE(PG8_SB(1, 0), cB + kstep, voffB); PG8_STAGE(PG8_SA(1, 0), cA + kstep, voffA); PG8_STAGE(PG8_SB(1, 1), cB + hstep + kstep, voffB);
        PG8_WAIT_V(6); PG8_BAR;
    }
    for (;;) {
        const bool has_next = S.next(ui + 1, nxt);
        const char* nA = cA; const char* nB = has_next ? (const char*)g.Bt + (size_t)nxt.pn * tstep : cB;
#pragma unroll
        for (int i = 0; i < 2; ++i) { nA0[i] = has_next ? (unsigned)AM.row(nxt, rowA[i]) * (unsigned)(K * 2) + voffA[i] : vA0[i]; nA1[i] = has_next ? (unsigned)AM.row(nxt, HALF + rowA[i]) * (unsigned)(K * 2) + voffA[i] : vA1[i]; }
        for (int t = 0; t < nt; t += 2) {
            const bool last = (t == nt - 2);
            const char* a1 = cA + (size_t)(t + 1) * kstep;
            const char* a2 = last ? nA : cA + (size_t)(t + 2) * kstep; const char* b2 = last ? nB : cB + (size_t)(t + 2) * kstep;
            const char* a3 = a2 + kstep; const char* b3 = b2 + kstep;
            unsigned s0[2], s1[2];
#pragma unroll
            for (int i = 0; i < 2; ++i) { s0[i] = vA0[i]; s1[i] = vA1[i]; }
            if (last) {
#pragma unroll
                for (int i = 0; i < 2; ++i) { unsigned t0_ = nA0[i], t1_ = nA1[i]; asm volatile("" : "+v"(t0_), "+v"(t1_)); s0[i] = t0_; s1[i] = t1_; } }
            if (last && has_next) S.a_ready(nxt);
            if constexpr (SP2) {
            PG8_LDB(B0, 0, 0); PG8_LDB(B1, 0, 1); PG8_SCHED; PG8_LDA(At, 0, 0); PG8_STAGE(PG8_SA(1, 1), a1, vA1);
            PG8_WAIT_V(8); PG8_WAIT_L(0); PG8_BAR; PG8_MMA(0, 0, At, B0); PG8_MMA(0, 1, At, B1); PG8_BAR; PG8_SCHED;
            PG8_LDA(At, 0, 1); PG8_STAGE(PG8_SB(0, 0), b2, voffB); PG8_STAGE(PG8_SB(0, 1), b2 + hstep, voffB); PG8_STAGE(PG8_SA(0, 0), a2, s0);
            PG8_WAIT_V(8); PG8_WAIT_L(0); PG8_BAR; PG8_MMA(1, 0, At, B0); PG8_MMA(1, 1, At, B1); PG8_BAR; PG8_SCHED;
            PG8_LDB(B0, 1, 0); PG8_LDB(B1, 1, 1); PG8_SCHED; PG8_LDA(At, 1, 0); PG8_STAGE(PG8_SA(0, 1), a2, s1);
            PG8_WAIT_V(8); PG8_WAIT_L(0); PG8_BAR; PG8_MMA(0, 0, At, B0); PG8_MMA(0, 1, At, B1); PG8_BAR; PG8_SCHED;
            PG8_LDA(At, 1, 1); PG8_STAGE(PG8_SB(1, 0), b3, voffB); PG8_STAGE(PG8_SB(1, 1), b3 + hstep, voffB); PG8_STAGE(PG8_SA(1, 0), a3, s0);
            PG8_WAIT_V(8); PG8_WAIT_L(0); PG8_BAR; PG8_MMA(1, 0, At, B0); PG8_MMA(1, 1, At, B1); PG8_BAR; PG8_SCHED;
            } else {
            PG8_LDB(B0, 0, 0); PG8_SCHED; PG8_LDA(At, 0, 0); PG8_STAGE(PG8_SA(1, 1), a1 + hstep, voffA);
            PG8_WAIT_L(8); PG8_BAR; PG8_WAIT_L(0); PG8_MMA(0, 0, At, B0); PG8_BAR; PG8_SCHED;
            PG8_LDB(B1, 0, 1); PG8_STAGE(PG8_SB(0, 0), b2, voffB);
            PG8_BAR; PG8_WAIT_L(0); PG8_MMA(0, 1, At, B1); PG8_BAR;
            PG8_LDA(At, 0, 1); PG8_STAGE(PG8_SA(0, 0), a2, voffA);
            PG8_BAR; PG8_WAIT_L(0); PG8_MMA(1, 0, At, B0); PG8_BAR; PG8_SCHED;
            PG8_STAGE(PG8_SB(0, 1), b2 + hstep, voffB);
            PG8_WAIT_V(6); PG8_BAR; PG8_MMA(1, 1, At, B1); PG8_BAR;
            PG8_LDB(B0, 1, 0); PG8_SCHED; PG8_LDA(At, 1, 0); PG8_STAGE(PG8_SA(0, 1), a2 + hstep, voffA);
            PG8_WAIT_L(8); PG8_BAR; PG8_WAIT_L(0); PG8_MMA(0, 0, At, B0); PG8_BAR; PG8_SCHED;
            PG8_LDB(B1, 1, 1); PG8_STAGE(PG8_SB(1, 0), b3, voffB);
            PG8_BAR; PG8_WAIT_L(0); PG8_MMA(0, 1, At, B1); PG8_BAR;
            PG8_LDA(At, 1, 1); PG8_STAGE(PG8_SA(1, 0), a3, voffA);
            PG8_BAR; PG8_WAIT_L(0); PG8_MMA(1, 0, At, B0); PG8_BAR; PG8_SCHED;
            PG8_STAGE(PG8_SB(1, 1), b3 + hstep, voffB);
            PG8_WAIT_V(6); PG8_BAR; PG8_MMA(1, 1, At, B1); PG8_BAR;
            }
        }
        if constexpr (ALIGN_EPI) { if (wr == 0) PG8_BAR; }
        if constexpr (!Epi::AFTER_DRAIN) { E(acc, cur, wr, wc, fr, fq); S.done(cur); }
        if (!has_next) break;
#pragma unroll
        for (int a = 0; a < 2; ++a)
#pragma unroll
            for (int b = 0; b < 2; ++b)
#pragma unroll
                for (int m = 0; m < 4; ++m)
#pragma unroll
                    for (int n = 0; n < 2; ++n) acc[a][b][m][n] = (acc_t){0, 0, 0, 0};
        cur = nxt; cA = nA; cB = nB; ++ui;
#pragma unroll
        for (int i = 0; i < 2; ++i) { vA0[i] = nA0[i]; vA1[i] = nA1[i]; }
        if constexpr (ALIGN_EPI) { if (wr == 1) PG8_BAR; }
    }
    PG8_WAIT_V(0);
    if constexpr (!ALIGN_EPI) { if (wr == 0) PG8_BAR; }
    PG8_BAR;
    if constexpr (Epi::AFTER_DRAIN) { E.fused(acc, cur, wr, wc, fr, fq, lds, wid, lane); S.done(cur); }
#undef PG8_SA
#undef PG8_SB
#undef PG8_STAGE
#undef PG8_LDA
#undef PG8_LDB
#undef PG8_MMA
#undef PG8_WAIT_V
#undef PG8_WAIT_L
#undef PG8_BAR
#undef PG8_SCHED
}
}
#include <hip/hip_bf16.h>
#include <cmath>
namespace attn_body {
using bf16=__hip_bfloat16;
using bf16x8=__attribute__((ext_vector_type(8)))short;
using s16x4=__attribute__((ext_vector_type(4)))short;
using f32x16=__attribute__((ext_vector_type(16)))float;
using u32x4=__attribute__((ext_vector_type(4)))unsigned;
constexpr int BATCH=2,NHEAD=8,NKVH=2,SEQ=8192,D=64,QP=512,KP=128,OP=1024;
constexpr int NW=8,QBLK=32,QB=QBLK*NW,KVBLK=64,NQB=SEQ/QB;
constexpr int ATTN_UNIT_ROWS=QB;
__device__ __forceinline__ int crow(int r,int hi){return (r&3)+8*(r>>2)+4*hi;}
#define SBAR() __builtin_amdgcn_sched_barrier(0)
__device__ __forceinline__ void cmask(f32x16&p0,f32x16&p1,int jb,int qrel,int hi){
  const float NEG=-INFINITY; int kb=64*jb+4*hi;
  #pragma unroll
  for(int r=0;r<16;++r){int kv=kb+(r&3)+8*(r>>2); if(kv>qrel)p0[r]=NEG; if(kv+32>qrel)p1[r]=NEG;}
}

constexpr int NSLOT=3, SLOTB=8192;
constexpr int LDS_K=0, LDS_V=NSLOT*SLOTB, LDS_WS=2*NSLOT*SLOTB, LDS_OST=LDS_WS+NW*64*4, LDS_BYTES=LDS_OST+NW*4096;
constexpr float C2=0.125f*1.4426950408889634f;
__device__ __forceinline__ void glds16(const void*gsrc,unsigned lds_dst){unsigned keep;
  asm volatile("s_mov_b32 %0, m0\n\ts_mov_b32 m0, %2\n\ts_nop 0\n\tglobal_load_lds_dwordx4 %1, off\n\ts_mov_b32 m0, %0":"=&s"(keep):"v"(gsrc),"s"(lds_dst):"memory");}
__device__ __forceinline__ float max3f(float a,float b,float c){float r;asm("v_max3_f32 %0, %1, %2, %3":"=v"(r):"v"(a),"v"(b),"v"(c));return r;}
__device__ __forceinline__ float max2f(float a,float b){float r;asm("v_max_f32_e32 %0, %1, %2":"=v"(r):"v"(a),"v"(b));return r;}
__device__ __forceinline__ float fadd_s(float a,float b){float r;asm("v_add_f32_e32 %0, %1, %2":"=v"(r):"v"(a),"v"(b));return r;}
__device__ __forceinline__ float fsub_s(float a,float b){float r;asm("v_sub_f32_e32 %0, %1, %2":"=v"(r):"v"(a),"v"(b));return r;}
typedef float f32x2_t __attribute__((ext_vector_type(2))); typedef __bf16 bf16x2_t __attribute__((ext_vector_type(2)));
__device__ __forceinline__ unsigned cvtpk_s(float lo,float hi){f32x2_t v={lo,hi};bf16x2_t b=__builtin_convertvector(v,bf16x2_t);return __builtin_bit_cast(unsigned,b);}
#define WAIT_BAR(N) asm volatile("s_waitcnt vmcnt(" #N ") lgkmcnt(0)\n\ts_barrier":::"memory")

__device__ __forceinline__ void qkt(f32x16&p0,f32x16&p1,const char*Kslot,const bf16x8*qr,const f32x16&negm,int r32,int hi){
  const char*kb=Kslot+hi*1024+r32*16;
  #pragma unroll
  for(int d0=0;d0<4;++d0){
    const bf16x8 b0=*reinterpret_cast<const bf16x8*>(kb+d0*2048);
    const bf16x8 b1=*reinterpret_cast<const bf16x8*>(kb+d0*2048+512);
    if(d0==0){p0=__builtin_amdgcn_mfma_f32_32x32x16_bf16(b0,qr[0],negm,0,0,0);p1=__builtin_amdgcn_mfma_f32_32x32x16_bf16(b1,qr[0],negm,0,0,0);}
    else{p0=__builtin_amdgcn_mfma_f32_32x32x16_bf16(b0,qr[d0],p0,0,0,0);p1=__builtin_amdgcn_mfma_f32_32x32x16_bf16(b1,qr[d0],p1,0,0,0);}}
}
typedef __attribute__((address_space(3))) const char* lds_cptr;
typedef short v4i16_t __attribute__((ext_vector_type(4)));
__device__ __forceinline__ void kload8(bf16x8*kf,lds_cptr kp){
  kf[0]=*(const __attribute__((address_space(3))) bf16x8*)(kp);      kf[1]=*(const __attribute__((address_space(3))) bf16x8*)(kp+512);
  kf[2]=*(const __attribute__((address_space(3))) bf16x8*)(kp+2048); kf[3]=*(const __attribute__((address_space(3))) bf16x8*)(kp+2560);
  kf[4]=*(const __attribute__((address_space(3))) bf16x8*)(kp+4096); kf[5]=*(const __attribute__((address_space(3))) bf16x8*)(kp+4608);
  kf[6]=*(const __attribute__((address_space(3))) bf16x8*)(kp+6144); kf[7]=*(const __attribute__((address_space(3))) bf16x8*)(kp+6656);
}
__device__ __forceinline__ void kload2(bf16x8*kf,lds_cptr kp,int j){ kf[2*j]=*(const __attribute__((address_space(3))) bf16x8*)(kp+j*2048); kf[2*j+1]=*(const __attribute__((address_space(3))) bf16x8*)(kp+j*2048+512); }
__device__ __forceinline__ s16x4 vtr(lds_cptr p){ return __builtin_bit_cast(s16x4,__builtin_amdgcn_ds_read_tr16_b64_v4i16((__attribute__((address_space(3))) v4i16_t*)p)); }
__device__ __forceinline__ float rowmax(const f32x16&p0,const f32x16&p1){
  float a=max3f(p0[0],p0[1],p1[0]),b=max3f(p0[2],p0[3],p1[1]);a=max3f(a,p1[2],p1[3]);
  #pragma unroll
  for(int r=4;r<16;r+=4){a=max3f(a,p0[r],p0[r+1]);b=max3f(b,p0[r+2],p0[r+3]);a=max3f(a,p1[r],p1[r+1]);b=max3f(b,p1[r+2],p1[r+3]);}
  const float m=max2f(a,b);
  auto rr=__builtin_amdgcn_permlane32_swap(__float_as_uint(m),__float_as_uint(m),false,false);
  return max2f(__uint_as_float(rr[0]),__uint_as_float(rr[1]));
}
__device__ __forceinline__ void pv(f32x16*o,int vb,bf16x8 pa0,bf16x8 pa1,bf16x8 pa2,bf16x8 pa3){
  #pragma unroll
  for(int d0=0;d0<2;++d0){s16x4 lo[4],hi[4];
    #pragma unroll
    for(int ks=0;ks<4;++ks){
      asm volatile("ds_read_b64_tr_b16 %0,%1 offset:%c2":"=&v"(lo[ks]):"v"(vb),"i"(d0*4096+ks*1024):"memory");
      asm volatile("ds_read_b64_tr_b16 %0,%1 offset:%c2":"=&v"(hi[ks]):"v"(vb),"i"(d0*4096+ks*1024+512):"memory");}
    asm volatile("s_waitcnt lgkmcnt(0)":::"memory");SBAR();
    #define PK(k) (bf16x8){lo[k][0],lo[k][1],lo[k][2],lo[k][3],hi[k][0],hi[k][1],hi[k][2],hi[k][3]}
    o[d0]=__builtin_amdgcn_mfma_f32_32x32x16_bf16(pa0,PK(0),o[d0],0,0,0);
    o[d0]=__builtin_amdgcn_mfma_f32_32x32x16_bf16(pa1,PK(1),o[d0],0,0,0);
    o[d0]=__builtin_amdgcn_mfma_f32_32x32x16_bf16(pa2,PK(2),o[d0],0,0,0);
    o[d0]=__builtin_amdgcn_mfma_f32_32x32x16_bf16(pa3,PK(3),o[d0],0,0,0);
    #undef PK
  }
}

#ifndef ATTN_STORE16
#define ATTN_STORE16(p,v) (*(u32x4*)(p)=(v))
#endif
template<int THRL> __device__ __forceinline__ void attn_unit(int b,int h,int qb,const bf16*Q,const bf16*__restrict__ K,const bf16*__restrict__ V,bf16*O,char*shm,const float nshift){
  const int tid=threadIdx.x,lane=tid&63,r32=lane&31,hi=lane>>5; const int wid=__builtin_amdgcn_readfirstlane(tid>>6);
  const long rowbase=(long)b*SEQ; const int q0=qb*QB;
  const bf16*Qw=Q+(rowbase+q0+wid*QBLK)*QP+h*D;
  const int hk=h/(NHEAD/NKVH); const bf16*Kh=K+(long)(b*NKVH+hk)*SEQ*D,*Vh=V+(long)(b*NKVH+hk)*SEQ*D;
  const unsigned lds0=(unsigned)(uintptr_t)shm;
  float*wsf=(float*)(shm+LDS_WS)+wid*64;
  const bf16*ksrc=Kh+(wid*64+lane)*8;
  const bf16*vsrc=Vh+(wid*64+lane)*8;
  const unsigned kdst=lds0+LDS_K+wid*1024, vdst=lds0+LDS_V+wid*1024;
  #define DMA_K(t,slot) glds16(ksrc+(long)(t)*KVBLK*D,(unsigned)__builtin_amdgcn_readfirstlane(kdst+(slot)))
  #define DMA_V(t,slot) glds16(vsrc+(long)(t)*KVBLK*D,(unsigned)__builtin_amdgcn_readfirstlane(vdst+(slot)))
  const int vb0=(int)(lds0+LDS_V)+((lane>>4)&1)*32+(lane&3)*8+(4*hi+((lane&15)>>2))*64;
  const char*Kbase=shm+LDS_K; bf16x8 kf[8];
  const lds_cptr shm3=(lds_cptr)shm; const lds_cptr kp0=shm3+LDS_K+hi*1024+r32*16; const lds_cptr vp0=shm3+LDS_V+((lane>>4)&1)*32+(lane&3)*8+(4*hi+((lane&15)>>2))*64;
  constexpr int NT=SEQ/KVBLK;
  DMA_K(0,0);DMA_V(0,0);DMA_K(1,SLOTB);
  bf16x8 qr[4];
  #pragma unroll
  for(int d0=0;d0<4;++d0)qr[d0]=*reinterpret_cast<const bf16x8*>(&Qw[(long)r32*QP+d0*16+hi*8]);
  float l_reg=0.f;f32x16 o[2];o[0]=f32x16{};o[1]=f32x16{};f32x16 negm;
  _Pragma("unroll") for(int r=0;r<16;++r)negm[r]=nshift; asm volatile("":"+v"(negm));
  const int qrel=wid*QBLK+r32;
  #define CMASK(P0,P1,t) do{}while(0)
  #define START(P0,P1) do{ _Pragma("unroll") for(int r=0;r<16;++r)P0[r]=__builtin_amdgcn_exp2f(P0[r]); }while(0)
  f32x16 pA0,pA1,pB0,pB1;
  int sl_prev=0,sl_cur=0,sl_next=SLOTB;
  #define ROT() do{sl_prev=sl_cur;sl_cur=sl_next;sl_next=(sl_next==(NSLOT-1)*SLOTB)?0:sl_next+SLOTB;}while(0)
  DMA_K(2,2*SLOTB);
  WAIT_BAR(3);
  qkt(pA0,pA1,Kbase,qr,negm,r32,hi);asm volatile("s_nop 15\n\ts_nop 7":"+v"(pA0),"+v"(pA1));CMASK(pA0,pA1,0);
  START(pA0,pA1);
  _Pragma("unroll") for(int r=0;r<16;++r)pA1[r]=__builtin_amdgcn_exp2f(pA1[r]);
  WAIT_BAR(0);
  DMA_K(3,0);DMA_V(1,SLOTB);
  ROT();
  kload8(kf,kp0+sl_cur);
  WAIT_BAR(2);
  s16x4 vlo[8],vhi[8]; u32x4 pw0,pw1,pw2,pw3;
  #define PKW(P,B) cvtpk_s(P[B],P[B+1])
  #define PAF(k) __builtin_bit_cast(bf16x8,pw##k)
  #define VFR(i) (bf16x8){vlo[i][0],vlo[i][1],vlo[i][2],vlo[i][3],vhi[i][0],vhi[i][1],vhi[i][2],vhi[i][3]}
  #define PIN(x) asm volatile("":"+v"(x))
  #define GAPA(MF,A0,A1,A2,A3,W0,W1,PW) do{ MF; sacc+=A0; sacc+=A1; sacc+=A2; sacc+=A3; PIN(sacc); W0; W1; PIN(PW); SBAR(); }while(0)
  #define EX(v) __builtin_amdgcn_exp2f(v)
  #define GAPB(MF,X,B) do{ MF; X[B]=EX(X[B]); X[B+1]=EX(X[B+1]); X[B+2]=EX(X[B+2]); X[B+3]=EX(X[B+3]); PIN(X); SBAR(); }while(0)
  #define VRD(i) do{ vlo[i]=vtr(vp_+(((i)>>2)*4096+((i)&3)*1024)); vhi[i]=vtr(vp_+(((i)>>2)*4096+((i)&3)*1024+512)); }while(0)
  #define KRD(G,j) do{ if(G){ kload2(kf,kp0+sl_next,j); SBAR(); } }while(0)
  #define STEP(C0,C1,P0,P1,t,GK,GV,GL) do{ SBAR(); \
    const lds_cptr vp_=vp0+sl_prev; \
    VRD(0); SBAR(); float sacc=(P0[0]+P0[1]); \
    GAPA(C0=__builtin_amdgcn_mfma_f32_32x32x16_bf16(kf[0],qr[0],negm,0,0,0), P0[2],P0[3],P0[4],P0[5],     pw0[0]=PKW(P0,0), pw0[1]=PKW(P0,2), pw0); \
    VRD(4); SBAR(); GAPA(C1=__builtin_amdgcn_mfma_f32_32x32x16_bf16(kf[1],qr[0],negm,0,0,0), P0[6],P0[7],P0[8],P0[9],     pw0[2]=PKW(P0,4), pw0[3]=PKW(P0,6), pw0); \
    VRD(1); SBAR(); GAPA(C0=__builtin_amdgcn_mfma_f32_32x32x16_bf16(kf[2],qr[1],C0,0,0,0),   P0[10],P0[11],P0[12],P0[13], pw1[0]=PKW(P0,8), pw1[1]=PKW(P0,10), pw1); \
    VRD(5); SBAR(); GAPA(C1=__builtin_amdgcn_mfma_f32_32x32x16_bf16(kf[3],qr[1],C1,0,0,0),   P0[14],P0[15],P1[0],P1[1],   pw1[2]=PKW(P0,12),pw1[3]=PKW(P0,14), pw1); \
    VRD(2); SBAR(); GAPA(C0=__builtin_amdgcn_mfma_f32_32x32x16_bf16(kf[4],qr[2],C0,0,0,0),   P1[2],P1[3],P1[4],P1[5],     pw2[0]=PKW(P1,0), pw2[1]=PKW(P1,2), pw2); \
    VRD(6); SBAR(); GAPA(C1=__builtin_amdgcn_mfma_f32_32x32x16_bf16(kf[5],qr[2],C1,0,0,0),   P1[6],P1[7],P1[8],P1[9],     pw2[2]=PKW(P1,4), pw2[3]=PKW(P1,6), pw2); \
    VRD(3); SBAR(); GAPA(C0=__builtin_amdgcn_mfma_f32_32x32x16_bf16(kf[6],qr[3],C0,0,0,0),   P1[10],P1[11],P1[12],P1[13], pw3[0]=PKW(P1,8), pw3[1]=PKW(P1,10), pw3); \
    VRD(7); SBAR(); GAPA(C1=__builtin_amdgcn_mfma_f32_32x32x16_bf16(kf[7],qr[3],C1,0,0,0),   P1[14],P1[15],0.f,0.f,       pw3[2]=PKW(P1,12),pw3[3]=PKW(P1,14), pw3); \
    l_reg+=sacc; \
    if(GK){DMA_K((t)+3,sl_cur);} if(GV){DMA_V((t)+1,sl_next);} \
    CMASK(C0,C1,t); \
    SBAR(); \
    GAPB(o[0]=__builtin_amdgcn_mfma_f32_32x32x16_bf16(PAF(0),VFR(0),o[0],0,0,0), C0,0); \
    GAPB(o[1]=__builtin_amdgcn_mfma_f32_32x32x16_bf16(PAF(0),VFR(4),o[1],0,0,0), C0,4); \
    KRD(GL,0); GAPB(o[0]=__builtin_amdgcn_mfma_f32_32x32x16_bf16(PAF(1),VFR(1),o[0],0,0,0), C0,8); \
    KRD(GL,1); GAPB(o[1]=__builtin_amdgcn_mfma_f32_32x32x16_bf16(PAF(1),VFR(5),o[1],0,0,0), C0,12); \
    KRD(GL,2); GAPB(o[0]=__builtin_amdgcn_mfma_f32_32x32x16_bf16(PAF(2),VFR(2),o[0],0,0,0), C1,0); \
    KRD(GL,3); GAPB(o[1]=__builtin_amdgcn_mfma_f32_32x32x16_bf16(PAF(2),VFR(6),o[1],0,0,0), C1,4); \
    GAPB(o[0]=__builtin_amdgcn_mfma_f32_32x32x16_bf16(PAF(3),VFR(3),o[0],0,0,0), C1,8); \
    GAPB(o[1]=__builtin_amdgcn_mfma_f32_32x32x16_bf16(PAF(3),VFR(7),o[1],0,0,0), C1,12); \
    }while(0)
  int t=1;
  #undef CMASK
  #define CMASK(P0,P1,t) do{}while(0)
  for(;t+5<NT;t+=2){
    STEP(pB0,pB1,pA0,pA1,t,true,true,true);     WAIT_BAR(2); ROT();
    STEP(pA0,pA1,pB0,pB1,t+1,true,true,true);   WAIT_BAR(2); ROT();
  }
  #undef CMASK
  #define CMASK(P0,P1,t) do{}while(0)
  #define ENDW(tt) do{ if((tt)+3<NT){WAIT_BAR(2);} else if((tt)+2<NT){WAIT_BAR(1);} else {WAIT_BAR(0);} }while(0)
  for(;t+1<NT;t+=2){
    STEP(pB0,pB1,pA0,pA1,t,(t+3<NT),(t+1<NT),(t+1<NT));       ENDW(t);   ROT();
    STEP(pA0,pA1,pB0,pB1,t+1,(t+4<NT),(t+2<NT),(t+2<NT));     ENDW(t+1); ROT();
  }
  STEP(pB0,pB1,pA0,pA1,NT-1,false,false,false);
  { float sacc=pB0[0]+pB0[1]; _Pragma("unroll") for(int r=2;r<16;++r)sacc+=pB0[r]; _Pragma("unroll") for(int r=0;r<16;++r)sacc+=pB1[r]; l_reg+=sacc;
    pw0=(u32x4){PKW(pB0,0),PKW(pB0,2),PKW(pB0,4),PKW(pB0,6)};pw1=(u32x4){PKW(pB0,8),PKW(pB0,10),PKW(pB0,12),PKW(pB0,14)};pw2=(u32x4){PKW(pB1,0),PKW(pB1,2),PKW(pB1,4),PKW(pB1,6)};pw3=(u32x4){PKW(pB1,8),PKW(pB1,10),PKW(pB1,12),PKW(pB1,14)};
    SBAR(); pv(o,vb0+sl_cur,PAF(0),PAF(1),PAF(2),PAF(3)); }
  #undef PKW
  #undef PAF
  #undef VFR
  #undef PIN
  #undef GAPA
  #undef GAPB
  #undef EX
  #undef VRD
  #undef KRD
  #undef STEP
  #undef ENDW
  {auto rr=__builtin_amdgcn_permlane32_swap(__float_as_uint(l_reg),__float_as_uint(l_reg),false,false);l_reg=__uint_as_float(rr[0])+__uint_as_float(rr[1]);}
  if(hi==0)wsf[32+r32]=l_reg;asm volatile("s_waitcnt lgkmcnt(0)":::"memory");
  float rli[16];
  #pragma unroll
  for(int r=0;r<16;++r)rli[r]=__builtin_amdgcn_rcpf(wsf[32+crow(r,hi)]);
  bf16*Ow=O+(rowbase+q0+wid*QBLK)*OP+h*D;
  { bf16*stg=(bf16*)(shm+LDS_OST)+wid*2048;
    #pragma unroll
    for(int r=0;r<16;++r){const int orow=crow(r,hi);
      #pragma unroll
      for(int d0=0;d0<2;++d0)stg[orow*64+d0*32+r32]=__float2bfloat16(o[d0][r]*rli[r]);}
    asm volatile("s_waitcnt lgkmcnt(0)":::"memory");
    #pragma unroll
    for(int i=0;i<4;++i){const int row=i*8+(lane>>3),ch=lane&7; const u32x4 v=*(const u32x4*)(stg+row*64+ch*8); ATTN_STORE16(Ow+(long)row*OP+ch*8,v);} }
  asm volatile("s_waitcnt lgkmcnt(0)\n\ts_barrier":::"memory");
  #undef DMA_K
  #undef DMA_V
  #undef CMASK
  #undef START
  #undef ROT
}
constexpr int ATTN_LDS_BYTES=LDS_BYTES;
struct AttnTensors { const bf16* Q; const bf16* K; const bf16* V; bf16* O; };
struct AttnUnit { int bh; int qb; };
struct StaticOrder {
  int vcu, G;
  __device__ __forceinline__ explicit StaticOrder(int grid,int block):vcu((grid%8==0)?(block%8)*(grid/8)+block/8:block),G(grid){}
  __device__ __forceinline__ bool next(int i,AttnUnit&u)const{
    const int L=i*G+vcu; if(L>=BATCH*NHEAD*NQB)return false;
    if(G==256){ if(i>=2)return false; const int x=vcu>>5,j=vcu&31; const int b=x>>2,kvh=(x>>1)&1,hq=kvh*4+2*(x&1)+i; u.bh=b*NHEAD+hq; u.qb=j; return true; }
    u.bh=L/NQB; u.qb=L%NQB; return true; }
  __device__ __forceinline__ void a_ready(const AttnUnit&)const{}
  __device__ __forceinline__ void done(const AttnUnit&)const{}
};
template<class Sched,int THRL=8> __device__ __forceinline__ void attn_phase(char*lds,const AttnTensors&T,const Sched&S,const float nshift){
  AttnUnit u;
  for(int i=0;S.next(i,u);++i){ S.a_ready(u); attn_unit<THRL>(u.bh/NHEAD,u.bh%NHEAD,u.qb,T.Q,T.K,T.V,T.O,lds,nshift); S.done(u); }
}
#undef SBAR
#undef WAIT_BAR
}

#include <hip/hip_cooperative_groups.h>
namespace cg = cooperative_groups;
#ifndef MK_PER_PHASE
#define MK_PER_PHASE 0
#endif
constexpr int NWAVES = 8, NTHREADS = 512;
constexpr int NB = 2, SEQ = 8192, DMODEL = 1024, TT = NB * SEQ;
constexpr int NPROJ = 2816;
constexpr int NEXP = 32, FFE = 512;
constexpr float EPS = 1e-6f;
constexpr int N_PHASES = 12;

constexpr size_t MiB = 1u << 20;
constexpr size_t WS_CTL = 0, CTL_ZERO_BYTES = 64 * 1024;
constexpr size_t WS_WOUT = 1 * MiB;
constexpr size_t WS_LIST = 229 * MiB;
constexpr size_t WS_WR = 3 * MiB;
constexpr size_t WS_TOK = 3 * MiB + 256 * 1024;
constexpr size_t WS_GATES = 4 * MiB;
constexpr size_t WS_WIN = 5 * MiB;
constexpr size_t WS_WSI = 3 * MiB + 896 * 1024;
constexpr size_t WS_XSC = 3 * MiB + 912 * 1024;
constexpr size_t WS_A = 11 * MiB;
constexpr size_t WS_XN = WS_A;
constexpr size_t GDN_SH_BYTES = 71680, GDN_D_BYTES = 19456;
constexpr size_t WS_GSH = WS_A;
constexpr size_t WS_GD = WS_A + 1024 * GDN_SH_BYTES;
constexpr size_t WS_X1 = 5 * MiB;
constexpr size_t WS_HID = 69 * MiB;
constexpr size_t WS_XBUF = 109 * MiB;
constexpr size_t WS_B = 157 * MiB;
constexpr size_t WS_QKVA = WS_B;
constexpr size_t WS_QKVB = WS_B + 48 * MiB;
constexpr size_t WS_ZA = WS_B + 72 * MiB;
constexpr size_t WS_OCAT = WS_B;
constexpr size_t WS_WGU0 = 189 * MiB, WS_WGU1 = 245 * MiB; constexpr int WGU_SPLIT = 20;
constexpr size_t WS_WSC = 3 * MiB + 768 * 1024;
constexpr float ACT_CLIP = 6.0f;
constexpr size_t DO_WD0 = 0, DO_WD1 = 56 * MiB; constexpr int WD_SPLIT = 24;
constexpr size_t DO_HN = 24 * MiB;
constexpr size_t WS_END = 269 * MiB;
static_assert(WS_GD + 4096 * GDN_D_BYTES <= WS_B, "GDN records fit region A");
static_assert(WS_X1 + 64 * MiB <= WS_HID && WS_HID + 40928ull * 1024 <= WS_XBUF && WS_XBUF + 40928ull * 2048 <= WS_WGU0, "post-scan map");
static_assert(WS_WGU0 + WGU_SPLIT * MiB <= WS_B + 72 * MiB && WS_WGU1 + (32 - WGU_SPLIT) * MiB <= 269 * MiB, "WGU fragments");
constexpr size_t DO_QR = 0, DO_KR = 16 * MiB, DO_VR = 20 * MiB, DO_OF = 24 * MiB, DO_OB = 40 * MiB;
constexpr int CW_CNT = 2048;
constexpr int CW_NTILE = 128;
constexpr int CW_ETAB = 192;
constexpr int CW_SCANQ = 1024;

constexpr int LDS_BYTES = 160 * 1024;

#define GAS __attribute__((address_space(1)))
#define LAS __attribute__((address_space(3)))
typedef unsigned short bf16;
typedef unsigned v4u __attribute__((ext_vector_type(4)));
typedef unsigned v2u __attribute__((ext_vector_type(2)));
typedef float f32x4 __attribute__((ext_vector_type(4)));
typedef short bf16x8 __attribute__((ext_vector_type(8)));
typedef short s16x4 __attribute__((ext_vector_type(4)));
#define DI __device__ __forceinline__

DI unsigned f2bf(float f) { unsigned u = __builtin_bit_cast(unsigned, f); return (u + 0x7fffu + ((u >> 16) & 1u)) >> 16; }
typedef float f32x2_t __attribute__((ext_vector_type(2))); typedef __bf16 bf16x2_t __attribute__((ext_vector_type(2)));
DI unsigned pk2(float lo, float hi) { f32x2_t v = {lo, hi}; bf16x2_t b = __builtin_convertvector(v, bf16x2_t); return __builtin_bit_cast(unsigned, b); }
DI float bf2f(unsigned short h) { return __builtin_bit_cast(float, (unsigned)h << 16); }
DI float bflo(unsigned w) { return __builtin_bit_cast(float, w << 16); }
DI float bfhi(unsigned w) { return __builtin_bit_cast(float, w & 0xffff0000u); }
DI unsigned q8x4(float a, float b, float c, float d, float sc) {
    const float M = 12582912.f;
    const unsigned ua = __builtin_bit_cast(unsigned, fminf(fmaxf(a * sc, -127.f), 127.f) + M), ub = __builtin_bit_cast(unsigned, fminf(fmaxf(b * sc, -127.f), 127.f) + M);
    const unsigned uc = __builtin_bit_cast(unsigned, fminf(fmaxf(c * sc, -127.f), 127.f) + M), ud = __builtin_bit_cast(unsigned, fminf(fmaxf(d * sc, -127.f), 127.f) + M);
    return (ua & 255u) | ((ub & 255u) << 8) | ((uc & 255u) << 16) | (ud << 24);
}
template <int CTRL> DI float dpp_f(float v) { return __builtin_bit_cast(float, __builtin_amdgcn_update_dpp(0, __builtin_bit_cast(int, v), CTRL, 0xf, 0xf, true)); }
#ifdef NO_DPP
DI float sum16(float v) { v += __shfl_xor(v, 1); v += __shfl_xor(v, 2); v += __shfl_xor(v, 4); v += __shfl_xor(v, 8); return v; }
DI float max16(float v) { v = fmaxf(v, __shfl_xor(v, 1)); v = fmaxf(v, __shfl_xor(v, 2)); v = fmaxf(v, __shfl_xor(v, 4)); v = fmaxf(v, __shfl_xor(v, 8)); return v; }
DI float get_x8(float v) { return __shfl_xor(v, 8); }
#else
DI float sum16(float v) { v += dpp_f<0xB1>(v); v += dpp_f<0x4E>(v); v += dpp_f<0x141>(v); v += dpp_f<0x140>(v); return v; }
DI float max16(float v) { v = fmaxf(v, dpp_f<0xB1>(v)); v = fmaxf(v, dpp_f<0x4E>(v)); v = fmaxf(v, dpp_f<0x141>(v)); v = fmaxf(v, dpp_f<0x140>(v)); return v; }
DI float get_x8(float v) { return dpp_f<0x128>(v); }
#endif
DI float sum_x16(float v) { return v + __shfl_xor(v, 16); }
DI float max_x16(float v) { return fmaxf(v, __shfl_xor(v, 16)); }
DI float sum_x32(float v) { return v + __shfl_xor(v, 32); }
DI float max_x32(float v) { return fmaxf(v, __shfl_xor(v, 32)); }
DI float wave_max(float v) { return max_x32(max_x16(max16(v))); }
DI float act_absmax(const float* nfw, int lane) {
    float m = 0.f;
#pragma unroll
    for (int i = 0; i < 16; ++i) m = fmaxf(m, fabsf(nfw[lane + 64 * i]));
    return ACT_CLIP * wave_max(m);
}
DI float wave_sum(float v) { return sum_x32(sum_x16(sum16(v))); }
DI float siluf(float x) { return x * __builtin_amdgcn_rcpf(1.0f + __expf(-x)); }
DI float sigmoidf_(float x) { return 1.0f / (1.0f + __expf(-x)); }
DI int perm32i(int idx) { return ((idx >> 2) & 3) * 8 + (idx >> 4) * 4 + (idx & 3); }
DI int permcol(int c) { return (c & ~31) + perm32i(c & 31); }
template <class T> DI T opaque(T p) { asm volatile("" : "+v"(p)); return p; }

typedef GAS unsigned gu32;
#define RLX_AGENT __ATOMIC_RELAXED, __HIP_MEMORY_SCOPE_AGENT
constexpr int CW_BAR = 4096;
constexpr int MISC_OFF = LDS_BYTES - 64;
#define XB_TMO      128
#define XB_XCNT(j)  (256  + 64 * (j))
#define XB_XSUB(j)  (1280 + 64 * (j))
#define XB_XGEN(j)  (2304 + 64 * (j))
#define XB_TOP      3328
#define XB_TOPGEN   3392
#define XCD_BAR_WORDS 3456
#define XB_SPIN_CAP (1u << 18)

__device__ __forceinline__ unsigned xb_ld(unsigned* p)              { return __hip_atomic_load(p, __ATOMIC_RELAXED, __HIP_MEMORY_SCOPE_AGENT); }
__device__ __forceinline__ unsigned xb_add(unsigned* p, unsigned v) { return __hip_atomic_fetch_add(p, v, __ATOMIC_RELAXED, __HIP_MEMORY_SCOPE_AGENT); }
__device__ __forceinline__ unsigned xb_xcc_id() { return (unsigned)__builtin_amdgcn_s_getreg((3 << 11) | 20) & 0xFu; }
#define XB_SPIN(cond, bar) do { unsigned _sp = 0; while (cond) { __builtin_amdgcn_s_sleep(1); \
    if ((++_sp & 255u) == 0u) { if (xb_ld(&(bar)[XB_TMO])) break; if (_sp > XB_SPIN_CAP) { atomicAdd(&(bar)[XB_TMO], 1u); break; } } } } while (0)

struct XcdBarrier {
    unsigned* bar; unsigned x;
    volatile LAS unsigned* st;
};

__device__ __forceinline__ XcdBarrier xcd_barrier_post(unsigned* bar, volatile LAS unsigned* st) {
    XcdBarrier b; b.bar = bar; b.x = xb_xcc_id(); b.st = st;
    if (threadIdx.x == 0) (void)xb_add(&bar[XB_XCNT(b.x)], 1u);
    return b;
}
__device__ __forceinline__ void xcd_barrier_complete(unsigned* bar, unsigned x, unsigned& nloc, unsigned& nx) {
    const unsigned G = gridDim.x * gridDim.y * gridDim.z;
    unsigned sum, cnt, mine, sp = 0u;
    for (;;) {
        sum = 0u; cnt = 0u; mine = 0u;
#pragma unroll
        for (unsigned j = 0; j < 16; ++j) { const unsigned c = xb_ld(&bar[XB_XCNT(j)]); sum += c; cnt += (c > 0u) ? 1u : 0u; mine = (j == x) ? c : mine; }
        if (sum == G) break;
        __builtin_amdgcn_s_sleep(1);
        if ((++sp & 255u) == 0u) { if (xb_ld(&bar[XB_TMO])) break; if (sp > XB_SPIN_CAP) { atomicAdd(&bar[XB_TMO], 1u); break; } }
    }
    nloc = mine > 0u ? mine : 1u; nx = cnt > 0u ? cnt : 1u;
}

__device__ __forceinline__ void xcd_barrier(const XcdBarrier& b) {
    asm volatile("s_waitcnt vmcnt(0)" ::: "memory");
    __syncthreads();
    if (threadIdx.x == 0) {
        unsigned* bar = b.bar;
        __builtin_amdgcn_s_waitcnt(0);
        unsigned nloc = b.st[0], nx = b.st[1];
        if (nloc == 0u) { xcd_barrier_complete(bar, b.x, nloc, nx); b.st[0] = nloc; b.st[1] = nx; }
        const unsigned old = xb_add(&bar[XB_XSUB(b.x)], 1u);
        const unsigned gen = old / nloc;
        if (old + 1u == (gen + 1u) * nloc) {
            __builtin_amdgcn_fence(__ATOMIC_RELEASE, "agent");
            asm volatile("s_waitcnt vmcnt(0)" ::: "memory");
            const unsigned og = xb_add(&bar[XB_TOP], 1u);
            const unsigned tg = og / nx;
            if (og + 1u == (tg + 1u) * nx) xb_add(&bar[XB_TOPGEN], 1u);
            else XB_SPIN(xb_ld(&bar[XB_TOPGEN]) == tg, bar);
            __builtin_amdgcn_fence(__ATOMIC_ACQUIRE, "agent");
            xb_add(&bar[XB_XGEN(b.x)], 1u);
            asm volatile("s_waitcnt vmcnt(0)" ::: "memory");
        } else {
            XB_SPIN(xb_ld(&bar[XB_XGEN(b.x)]) == gen, bar);
            __builtin_amdgcn_fence(__ATOMIC_ACQUIRE, "agent");
            asm volatile("s_waitcnt vmcnt(0)" ::: "memory");
        }
    }
    __syncthreads();
}

struct Frame {
    LAS unsigned char* lds;
    int tid, lane, wave, vcu, G;
    const float* in[17];
    float* out; unsigned char* ws;
};

DI void p0_transpose_item(const float* W, int ldw, int nblk, bf16* WT, int K, int row_off, int rmul, LAS float* scr, int item, int lane) {
    const int kb = item / nblk, nb = item % nblk, k0 = 64 * kb, n0 = 32 * nb;
    const int r8 = lane >> 3, c4 = (lane & 7) * 4;
    f32x4 v[8];
#pragma unroll
    for (int i = 0; i < 8; ++i) v[i] = __builtin_nontemporal_load((const f32x4*)(W + (size_t)(k0 + 8 * i + r8) * ldw + n0 + c4));
#pragma unroll
    for (int i = 0; i < 8; ++i) { LAS float* d = scr + (8 * i + r8) * 33 + c4; d[0] = v[i].x; d[1] = v[i].y; d[2] = v[i].z; d[3] = v[i].w; }
    asm volatile("s_waitcnt lgkmcnt(0)" ::: "memory");
    const int c = lane & 7;
#pragma unroll
    for (int j = 0; j < 4; ++j) { const int n = (lane >> 3) + 8 * j; const LAS float* s = scr + (8 * c) * 33 + n;
        v4u o; o.x = pk2(s[0 * 33], s[1 * 33]); o.y = pk2(s[2 * 33], s[3 * 33]); o.z = pk2(s[4 * 33], s[5 * 33]); o.w = pk2(s[6 * 33], s[7 * 33]);
        *(GAS v4u*)(WT + (size_t)(row_off + (n0 + n) * rmul) * K + k0 + 8 * c) = o; }
    asm volatile("s_waitcnt lgkmcnt(0)" ::: "memory");
}
template <int NR> DI void rms_rows_to_bf16(const float* const (&xrow)[NR], const float* w, bf16* const (&orow)[NR], int lane) {
    const GAS f32x4* wr = (const GAS f32x4*)w + lane;
    f32x4 v[NR][4];
#pragma unroll
    for (int r = 0; r < NR; ++r) { const GAS f32x4* xr = (const GAS f32x4*)xrow[r] + lane;
#pragma unroll
        for (int j = 0; j < 4; ++j) v[r][j] = xr[64 * j]; }
    f32x4 ww[4];
#pragma unroll
    for (int j = 0; j < 4; ++j) ww[j] = wr[64 * j];
#pragma unroll
    for (int r = 0; r < NR; ++r) {
        float s_ = 0.f;
#pragma unroll
        for (int j = 0; j < 4; ++j) s_ += (v[r][j].x * v[r][j].x + v[r][j].y * v[r][j].y) + (v[r][j].z * v[r][j].z + v[r][j].w * v[r][j].w);
        const float rs = __builtin_amdgcn_rsqf(wave_sum(s_) * (1.f / DMODEL) + EPS);
        GAS v2u* o8 = (GAS v2u*)orow[r] + lane;
#pragma unroll
        for (int j = 0; j < 4; ++j) { v2u o; o.x = pk2(v[r][j].x * rs * ww[j].x, v[r][j].y * rs * ww[j].y); o.y = pk2(v[r][j].z * rs * ww[j].z, v[r][j].w * rs * ww[j].w); o8[64 * j] = o; }
    }
}
DI void q_strip(const float* W, int ldw, int n0, unsigned char* WQ, float* wsc, int rowbase, int rmul, LAS unsigned char* lds, int wave, int lane) {
    LAS float* scr = (LAS float*)(lds + wave * 8704); LAS float* cmx = (LAS float*)(lds + 8 * 8704);
    const int r8 = lane >> 3, c4 = (lane & 7) * 4, kw = 128 * wave;
    f32x4 mx = (f32x4){0.f, 0.f, 0.f, 0.f};
#pragma unroll
    for (int i = 0; i < 16; ++i) { const f32x4 v = *(const f32x4*)(W + (size_t)(kw + 8 * i + r8) * ldw + n0 + c4);
        mx.x = fmaxf(mx.x, fabsf(v.x)); mx.y = fmaxf(mx.y, fabsf(v.y)); mx.z = fmaxf(mx.z, fabsf(v.z)); mx.w = fmaxf(mx.w, fabsf(v.w)); }
    mx.x = max_x32(max_x16(fmaxf(mx.x, get_x8(mx.x)))); mx.y = max_x32(max_x16(fmaxf(mx.y, get_x8(mx.y))));
    mx.z = max_x32(max_x16(fmaxf(mx.z, get_x8(mx.z)))); mx.w = max_x32(max_x16(fmaxf(mx.w, get_x8(mx.w))));
    if (lane < 8) *(LAS f32x4*)(cmx + wave * 32 + c4) = mx;
    __syncthreads();
    float sq[4];
#pragma unroll
    for (int j = 0; j < 4; ++j) { const int n = (lane >> 3) + 8 * j; float m = cmx[n];
#pragma unroll
        for (int w = 1; w < 8; ++w) m = fmaxf(m, cmx[w * 32 + n]);
        sq[j] = m > 0.f ? 127.0f / m : 0.f;
        if (wave == 0 && (lane & 7) == 0) wsc[rowbase + n * rmul] = m * (1.0f / 127.0f); }
    const int c = lane & 7;
#pragma unroll
    for (int kb = 0; kb < 2; ++kb) {
        const int k0 = kw + 64 * kb;
        f32x4 v[8];
#pragma unroll
        for (int i = 0; i < 8; ++i) v[i] = *(const f32x4*)(W + (size_t)(k0 + 8 * i + r8) * ldw + n0 + c4);
#pragma unroll
        for (int i = 0; i < 8; ++i) { LAS float* d = scr + (8 * i + r8) * 33 + c4; d[0] = v[i].x; d[1] = v[i].y; d[2] = v[i].z; d[3] = v[i].w; }
        asm volatile("s_waitcnt lgkmcnt(0)" ::: "memory");
#pragma unroll
        for (int j = 0; j < 4; ++j) { const int n = (lane >> 3) + 8 * j; const LAS float* t = scr + (8 * c) * 33 + n;
            v2u o; o.x = q8x4(t[0 * 33], t[1 * 33], t[2 * 33], t[3 * 33], sq[j]); o.y = q8x4(t[4 * 33], t[5 * 33], t[6 * 33], t[7 * 33], sq[j]);
            *(GAS v2u*)(WQ + (size_t)(rowbase + n * rmul) * 1024 + k0 + 8 * c) = o; }
        asm volatile("s_waitcnt lgkmcnt(0)" ::: "memory");
    }
    __syncthreads();
}
DI float reduce16(const float (&ga)[16], int lane) {
    float gb[8], gc[4];
    const bool h32 = (lane & 32) != 0, h16 = (lane & 16) != 0;
#pragma unroll
    for (int i = 0; i < 8; ++i) { const float lo = sum_x32(ga[i]), hi = sum_x32(ga[i + 8]); gb[i] = h32 ? hi : lo; }
#pragma unroll
    for (int i = 0; i < 4; ++i) { const float lo = sum_x16(gb[i]), hi = sum_x16(gb[i + 4]); gc[i] = h16 ? hi : lo; }
    float res = 0.f;
#pragma unroll
    for (int i = 0; i < 4; ++i) { const float t = sum16(gc[i]); res = ((lane & 3) == i) ? t : res; }
    return res;
}
DI void rms_rows_to_q8(const float* const (&xrow)[2], const float* w, unsigned char* const (&orow)[2], float* const (&xsc)[2], float* const (&gout)[2], const LAS float* gw_, int lane) {
    const LAS float* gw = gw_;
    gw = opaque(gw);
    const GAS f32x4* wr = (const GAS f32x4*)w + lane;
    f32x4 v[2][4];
#pragma unroll
    for (int r = 0; r < 2; ++r) { const GAS f32x4* xr = (const GAS f32x4*)xrow[r] + lane;
#pragma unroll
        for (int j = 0; j < 4; ++j) v[r][j] = xr[64 * j]; }
    f32x4 ww[4];
#pragma unroll
    for (int j = 0; j < 4; ++j) ww[j] = wr[64 * j];
#pragma unroll
    for (int r = 0; r < 2; ++r) {
        float s_ = 0.f;
#pragma unroll
        for (int j = 0; j < 4; ++j) s_ += (v[r][j].x * v[r][j].x + v[r][j].y * v[r][j].y) + (v[r][j].z * v[r][j].z + v[r][j].w * v[r][j].w);
        const float rs = __builtin_amdgcn_rsqf(wave_sum(s_) * (1.f / DMODEL) + EPS);
        float am = 0.f;
#pragma unroll
        for (int j = 0; j < 4; ++j) { v[r][j] = v[r][j] * ww[j] * rs; am = fmaxf(fmaxf(am, fmaxf(fabsf(v[r][j].x), fabsf(v[r][j].y))), fmaxf(fabsf(v[r][j].z), fabsf(v[r][j].w))); }
        am = wave_max(am);
        const float qsc = am > 0.f ? 127.0f / am : 0.f;
        if (lane == 0) *xsc[r] = am * (1.0f / 127.0f);
        GAS unsigned* o4 = (GAS unsigned*)orow[r] + lane;
#pragma unroll
        for (int j = 0; j < 4; ++j) o4[64 * j] = q8x4(v[r][j].x, v[r][j].y, v[r][j].z, v[r][j].w, qsc);
    }
#ifndef NO_GATES
    float ga[2][16];
#pragma unroll
    for (int c = 0; c < 16; ++c) { ga[0][c] = 0.f; ga[1][c] = 0.f; }
    asm volatile("" : "+v"(v[0][0]), "+v"(v[0][1]), "+v"(v[0][2]), "+v"(v[0][3]), "+v"(v[1][0]), "+v"(v[1][1]), "+v"(v[1][2]), "+v"(v[1][3]));
#pragma unroll
    for (int j = 0; j < 4; ++j)
#pragma unroll
        for (int q = 0; q < 4; ++q) { const LAS f32x4* g4 = (const LAS f32x4*)gw + ((j * 4 + q) * 4) * 64 + lane;
            const f32x4 g0 = g4[0], g1 = g4[64], g2 = g4[128], g3 = g4[192];
#pragma unroll
            for (int r = 0; r < 2; ++r) { const float h = v[r][j][q];
                ga[r][0] += h * g0.x; ga[r][1] += h * g0.y; ga[r][2] += h * g0.z; ga[r][3] += h * g0.w; ga[r][4] += h * g1.x; ga[r][5] += h * g1.y; ga[r][6] += h * g1.z; ga[r][7] += h * g1.w;
                ga[r][8] += h * g2.x; ga[r][9] += h * g2.y; ga[r][10] += h * g2.z; ga[r][11] += h * g2.w; ga[r][12] += h * g3.x; ga[r][13] += h * g3.y; ga[r][14] += h * g3.z; ga[r][15] += h * g3.w; }
            asm volatile("" : "+v"(ga[1][0]), "+v"(ga[1][1]), "+v"(ga[1][2]), "+v"(ga[1][3]), "+v"(ga[1][4]), "+v"(ga[1][5]), "+v"(ga[1][6]), "+v"(ga[1][7]), "+v"(ga[1][8]), "+v"(ga[1][9]),
                         "+v"(ga[1][10]), "+v"(ga[1][11]), "+v"(ga[1][12]), "+v"(ga[1][13]), "+v"(ga[1][14]), "+v"(ga[1][15]) :: "memory"); }
    const int gc_ = 4 * (lane >> 4) + (lane & 3);
#pragma unroll
    for (int r = 0; r < 2; ++r) { const float res = reduce16(ga[r], lane); if ((lane & 12) == 0) gout[r][gc_] = res; }
#endif
}
DI void p0_prologue(Frame& F) {
    const float* w_in = F.in[2];
    unsigned char* WIN = F.ws + WS_WIN; float* WSI = (float*)(F.ws + WS_WSI);
    constexpr int NSTRIP = 64 + 24;
    if (F.vcu < NSTRIP) { const int st = F.vcu;
        if (st < 64) q_strip(w_in, 2832, 32 * st, WIN, WSI, 32 * st, 1, F.lds, F.wave, F.lane);
        else q_strip(w_in + 2064, 2832, 32 * (st - 64), WIN, WSI, 2048 + 32 * (st - 64), 1, F.lds, F.wave, F.lane); }
    unsigned char* XN = F.ws + WS_XN; float* XSC = (float*)(F.ws + WS_XSC); float* GATES = (float*)(F.ws + WS_GATES);
    LAS float* gw = (LAS float*)(F.lds + 73728);
    for (int i = F.tid; i < 1024 * 4; i += NTHREADS) { const int k = i >> 2, c4 = i & 3, jj = k >> 8, qq = k & 3, ln = (k & 255) >> 2;
        *((LAS f32x4*)gw + ((jj * 4 + qq) * 4 + c4) * 64 + ln) = *(const f32x4*)(w_in + (size_t)k * 2832 + 2048 + c4 * 4); }
    __syncthreads();
    const int nst = (F.G < NSTRIP ? F.G : NSTRIP), NSLOT = nst * NWAVES + (F.G - nst) * NWAVES * 2;
    const int s0_ = (F.vcu < nst) ? F.vcu * NWAVES + F.wave : nst * NWAVES + ((F.vcu - nst) * NWAVES + F.wave) * 2, nmine = (F.vcu < nst) ? 1 : 2;
#pragma unroll 1
    for (int q = 0; q < nmine; ++q)
#pragma unroll 1
        for (int p = s0_ + q; p < TT / 2; p += NSLOT) { const int m = 2 * p;
            const float* const xr[2] = {F.in[0] + (size_t)m * DMODEL, F.in[0] + (size_t)(m + 1) * DMODEL}; unsigned char* const orw[2] = {XN + (size_t)m * DMODEL, XN + (size_t)(m + 1) * DMODEL};
            float* const xs[2] = {XSC + m, XSC + m + 1}; float* const go[2] = {GATES + (size_t)m * 16, GATES + (size_t)(m + 1) * 16};
            rms_rows_to_q8(xr, F.in[1], orw, xs, go, gw, F.lane); }
}

struct EpiProj {
    static constexpr bool PERM = true, AFTER_DRAIN = false;
    bf16 *qkva, *za, *qkvb; const float* wsi; const float* xsc;
    DI void operator()(const pg8::i32x4 (&acc)[2][2][4][2], const pg8::Unit& u, int wr, int wc, int fr, int fq) const {
        const int row0 = u.pm * 256 + wr * 64 + fr;
        const float* ws_ = wsi + u.pn * 256 + wc * 32 + 8 * fq;
        bf16* base; int ldc, colt;
        if (u.pn < 6) { base = qkva; ldc = 1536; colt = u.pn * 256; } else if (u.pn < 8) { base = za; ldc = 512; colt = (u.pn - 6) * 256; } else { base = qkvb; ldc = 768; colt = (u.pn - 8) * 256; }
        const int col0 = colt + wc * 32 + 8 * fq;
        f32x4 s0[2], s1[2];
#pragma unroll
        for (int bj = 0; bj < 2; ++bj) { s0[bj] = *(const f32x4*)(ws_ + bj * 128); s1[bj] = *(const f32x4*)(ws_ + bj * 128 + 4); }
        float rsc[2][4];
#pragma unroll
        for (int ai = 0; ai < 2; ++ai)
#pragma unroll
            for (int m = 0; m < 4; ++m) rsc[ai][m] = xsc[row0 + ai * 128 + m * 16];
#pragma unroll
        for (int ai = 0; ai < 2; ++ai)
#pragma unroll
            for (int m = 0; m < 4; ++m) { bf16* rowp = base + (size_t)(row0 + ai * 128 + m * 16) * ldc + col0; const float rr = rsc[ai][m];
#pragma unroll
                for (int bj = 0; bj < 2; ++bj) { const pg8::i32x4 a0 = acc[ai][bj][m][0], a1 = acc[ai][bj][m][1]; const f32x4 t0 = s0[bj] * rr, t1 = s1[bj] * rr; pg8::u32x4 w;
                    w.x = pg8::cvt_pk_bf16((float)a0[0] * t0[0], (float)a0[1] * t0[1]); w.y = pg8::cvt_pk_bf16((float)a0[2] * t0[2], (float)a0[3] * t0[3]);
                    w.z = pg8::cvt_pk_bf16((float)a1[0] * t1[0], (float)a1[1] * t1[1]); w.w = pg8::cvt_pk_bf16((float)a1[2] * t1[2], (float)a1[3] * t1[3]);
                    *(pg8::u32x4*)(rowp + bj * 128) = w; } }
    }
};
struct IdRows { DI int row(const pg8::Unit& u, int r) const { return u.pm * 256 + r; } };
struct EpiResid {
    static constexpr bool PERM = true, AFTER_DRAIN = false;
    const float* x; bf16* x1;
    DI void operator()(const pg8::f32x4 (&acc)[2][2][4][2], const pg8::Unit& u, int wr, int wc, int fr, int fq) const {
        const int row0 = u.pm * 256 + wr * 64 + fr, col0 = u.pn * 256 + wc * 32 + 8 * fq;
#pragma unroll
        for (int ai = 0; ai < 2; ++ai)
#pragma unroll
            for (int m = 0; m < 4; ++m) { const size_t off = (size_t)(row0 + ai * 128 + m * 16) * DMODEL + col0;
#pragma unroll
                for (int bj = 0; bj < 2; ++bj) { const pg8::f32x4 v0 = *(const pg8::f32x4*)(x + off + bj * 128) + acc[ai][bj][m][0], v1 = *(const pg8::f32x4*)(x + off + bj * 128 + 4) + acc[ai][bj][m][1]; pg8::u32x4 w;
                    w.x = pg8::cvt_pk_bf16(v0[0], v0[1]); w.y = pg8::cvt_pk_bf16(v0[2], v0[3]); w.z = pg8::cvt_pk_bf16(v1[0], v1[1]); w.w = pg8::cvt_pk_bf16(v1[2], v1[3]);
                    *(pg8::u32x4*)(x1 + off + bj * 128) = w; } }
    }
};
struct EpiGU {
    static constexpr bool PERM = true, AFTER_DRAIN = false;
    bf16* hid; const float* wsc; float ainv;
    DI void operator()(const pg8::i32x4 (&acc)[2][2][4][2], const pg8::Unit& u, int wr, int wc, int fr, int fq) const {
        const int row0 = u.pm * 256 + wr * 64 + fr; const int jt = u.pn & 3;
        const int ff0 = jt * 128 + wc * 16 + 4 * fq;
        const float* ws_ = wsc + u.ex * 1024 + jt * 256 + wc * 32 + 8 * fq;
        f32x4 s0[2], s1[2];
#pragma unroll
        for (int bj = 0; bj < 2; ++bj) { s0[bj] = *(const f32x4*)(ws_ + bj * 128) * ainv; s1[bj] = *(const f32x4*)(ws_ + bj * 128 + 4) * ainv; }
#pragma unroll
        for (int ai = 0; ai < 2; ++ai)
#pragma unroll
            for (int m = 0; m < 4; ++m) { bf16* rowp = hid + (size_t)(row0 + ai * 128 + m * 16) * FFE + ff0;
#pragma unroll
                for (int bj = 0; bj < 2; ++bj) { const pg8::i32x4 a0 = acc[ai][bj][m][0], a1 = acc[ai][bj][m][1];
                    const float g0 = (float)a0[0] * s0[bj][0], u0 = (float)a0[1] * s0[bj][1], g1 = (float)a0[2] * s0[bj][2], u1 = (float)a0[3] * s0[bj][3];
                    const float g2 = (float)a1[0] * s1[bj][0], u2 = (float)a1[1] * s1[bj][1], g3 = (float)a1[2] * s1[bj][2], u3 = (float)a1[3] * s1[bj][3];
                    v2u w; w.x = pg8::cvt_pk_bf16(siluf(g0) * u0, siluf(g1) * u1); w.y = pg8::cvt_pk_bf16(siluf(g2) * u2, siluf(g3) * u3);
                    *(v2u*)(rowp + bj * 64) = w; } }
    }
};
struct EpiY {
    static constexpr bool PERM = true, AFTER_DRAIN = false;
    bf16* y;
    DI void operator()(const pg8::f32x4 (&acc)[2][2][4][2], const pg8::Unit& u, int wr, int wc, int fr, int fq) const {
        const int row0 = u.pm * 256 + wr * 64 + fr; const int col0 = (u.pn & 3) * 256 + wc * 32 + 8 * fq;
#pragma unroll
        for (int ai = 0; ai < 2; ++ai)
#pragma unroll
            for (int m = 0; m < 4; ++m) { bf16* rowp = y + (size_t)(row0 + ai * 128 + m * 16) * DMODEL + col0;
#pragma unroll
                for (int bj = 0; bj < 2; ++bj) { const pg8::f32x4 v0 = acc[ai][bj][m][0], v1 = acc[ai][bj][m][1]; pg8::u32x4 w;
                    w.x = pg8::cvt_pk_bf16(v0[0], v0[1]); w.y = pg8::cvt_pk_bf16(v0[2], v0[3]); w.z = pg8::cvt_pk_bf16(v1[0], v1[1]); w.w = pg8::cvt_pk_bf16(v1[2], v1[3]);
                    *(pg8::u32x4*)(rowp + bj * 128) = w; } }
    }
};
constexpr int ETAB_OFF = 131072;
struct MoeOrder {
    const LAS unsigned* etab; int G, c, esplit, pnoff;
    DI bool next(int i, pg8::Unit& u) const {
        if (G % 8 != 0) {
            int L = i * G + c;
            for (int e = 0; e < NEXP; ++e) { const int n4 = 4 * (int)etab[2 * e + 1]; if (L < n4) { u.pm = (int)etab[2 * e] + (L >> 2); u.pn = (e < esplit ? 4 * e : pnoff + 4 * (e - esplit)) + (L & 3); u.ex = e; u.tq = L >> 2; return true; } L -= n4; }
            return false; }
        const int x = c & 7; int L = i * (G >> 3) + (c >> 3);
#pragma unroll
        for (int q = 0; q < NEXP / 8; ++q) { const int e = x + 8 * q; const int n4 = 4 * (int)etab[2 * e + 1];
            if (L < n4) { u.pm = (int)etab[2 * e] + (L >> 2); u.pn = (e < esplit ? 4 * e : pnoff + 4 * (e - esplit)) + (L & 3); u.ex = e; u.tq = L >> 2; return true; } L -= n4; }
        return false; }
    DI void a_ready(const pg8::Unit&) const {}
    DI void done(const pg8::Unit&) const {}
};
struct MoeRows {
    const int* list; const LAS unsigned* etab;
    DI int row(const pg8::Unit& u, int r) const {
        const int slot = u.tq * 256 + r, e = u.ex; if (slot >= (int)etab[64 + e]) return 0;
        const LAS unsigned* sp = etab + 96 + 8 * e; int sb = 0;
#pragma unroll
        for (int q = 1; q < 8; ++q) sb += (slot >= (int)sp[q]) ? 1 : 0;
        return list[(size_t)(e * 8 + sb) * TT + (slot - (int)sp[sb])]; }
};

DI void p2_rope(Frame& F) {
    const int gw = F.vcu * NWAVES + F.wave, NGW = F.G * NWAVES, lane = F.lane;
    const bf16* QKVB = (const bf16*)(F.ws + WS_QKVB);
    bf16* QR = (bf16*)((unsigned char*)F.out + DO_QR); bf16* KR = (bf16*)((unsigned char*)F.out + DO_KR); bf16* VR = (bf16*)((unsigned char*)F.out + DO_VR);
    const int pi = lane & 31, hsel = lane >> 5;
    const float qw0 = F.in[7][2 * pi], qw1 = F.in[7][2 * pi + 1], kw0 = F.in[8][2 * pi], kw1 = F.in[8][2 * pi + 1];
    const float invf = exp2f(-(float)(2 * (pi & 15)) * (13.287712379549449f / 32.0f));
    constexpr float C2 = 0.125f * 1.4426950408889634f;
    constexpr int NB4 = 4;
    for (int t0 = gw; t0 < TT; t0 += NB4 * NGW) {
        unsigned w[NB4][5], vw[NB4];
#pragma unroll
        for (int u = 0; u < NB4; ++u) { const int t = t0 + u * NGW; const unsigned* src = (const unsigned*)(QKVB + (size_t)(t < TT ? t : t0) * 768);
#pragma unroll
            for (int j = 0; j < 5; ++j) w[u][j] = src[(2 * j + hsel) * 32 + pi];
            vw[u] = src[320 + lane]; }
#pragma unroll
        for (int u = 0; u < NB4; ++u) {
            const int t = t0 + u * NGW; if (t >= TT) break;
            const int s_ = t & (SEQ - 1); const float pos = (pi < 16) ? (float)(s_ >> 6) : (float)(s_ & 63);
            const float ang = pos * invf;
            const float rev = ang * 0.15915494309189535f;
            const float sn = __builtin_amdgcn_sinf(rev), cs = __builtin_amdgcn_cosf(rev);
#pragma unroll
            for (int j = 0; j < 5; ++j) {
                const int head = 2 * j + hsel;
                const float x0 = bflo(w[u][j]), x1 = bfhi(w[u][j]);
                float ss = x0 * x0 + x1 * x1;
                ss = sum_x16(sum16(ss));
                const float rs = __builtin_amdgcn_rsqf(ss * (1.f / 64.f) + EPS);
                const bool isq = head < 8;
                const float y0 = x0 * rs * (isq ? qw0 : kw0), y1 = x1 * rs * (isq ? qw1 : kw1);
                float o0 = y0 * cs - y1 * sn, o1 = y0 * sn + y1 * cs;
                if (isq) { o0 *= C2; o1 *= C2; ((unsigned*)(QR + (size_t)t * 512))[head * 32 + pi] = pk2(o0, o1); }
                else { const int hk = head - 8, bq = t >> 13, sq = t & (SEQ - 1);
                    ((unsigned*)(KR + ((size_t)((bq * 2 + hk) * 128 + (sq >> 6)) * 8 + (pi >> 2)) * 512 + (sq & 63) * 8))[pi & 3] = pk2(o0, o1); }
            }
            { const int hk = lane >> 5, d = 2 * (lane & 31), bq = t >> 13, sq = t & (SEQ - 1), r = sq & 63;
              ((unsigned*)(VR + ((size_t)((bq * 2 + hk) * 128 + (sq >> 6)) * 8 + (d >> 5) * 4 + (r >> 4)) * 512 + ((r & 15) * 4 + ((d & 31) >> 3)) * 8))[(d & 7) >> 1] = vw[u]; }
        }
    }
}

constexpr int G_KNP = 0, G_QNP = 17408, G_KNTP = 34816, G_VCT = 53248;
constexpr int G_D0 = 71680, G_D1 = 71680 + 19456;
constexpr int GD_TBP = 0, GD_AP = 9216, GD_VEC = 18432;
constexpr int G_LM = 110592;
constexpr int G_GV = G_LM + 32768;
static_assert(G_GV + 2048 <= LDS_BYTES - 64, "gdn pre lds");

#define TRI_ROW(i, LC, LN) { \
        if ((i) + 1 < 64) { _Pragma("unroll") for (int j4 = 0; j4 < ((i) + 1 + 3) / 4 && j4 < 8; ++j4) LN[j4] = *(const LAS f32x4*)(L + ((i) + 1) * 64 + 4 * j4); } \
        _Pragma("unroll") for (int j4 = 8; j4 < ((i) + 3) / 4; ++j4) lt[j4 - 8] = *(const LAS f32x4*)(L + (i) * 64 + 4 * j4); \
        __builtin_amdgcn_sched_barrier(0); \
        f32x2_t a0 = {(lane == (i)) ? 1.0f : 0.0f, 0.f}, a1 = {0.f, 0.f}; \
        _Pragma("unroll") for (int j4 = 0; j4 < ((i) + 3) / 4; ++j4) { const f32x4 l = (j4 < 8) ? LC[j4 & 7] : lt[(j4 - 8) & 7]; \
            f32x2_t l0 = {l.x, (4 * j4 + 1 < (i)) ? l.y : 0.f}, l1 = {(4 * j4 + 2 < (i)) ? l.z : 0.f, (4 * j4 + 3 < (i)) ? l.w : 0.f}; \
            a0 -= l0 * xp[2 * j4]; if (4 * j4 + 2 < (i)) a1 -= l1 * xp[2 * j4 + 1]; } \
        const float a = (a0.x + a0.y) + (a1.x + a1.y); \
        if ((i) & 1) xp[(i) >> 1].y = a; else { xp[(i) >> 1].x = a; xp[(i) >> 1].y = 0.f; } \
        TBP[(REV ? 63 - (i) : (i)) * 72 + pc] = (bf16)(pk2(a * bcol, 0.f) & 0xffffu); \
        __builtin_amdgcn_sched_barrier(0); }
template <bool REV> DI void tri_inverse(LAS float* L, const LAS float* beta, LAS bf16* TBP, int lane) {
    f32x2_t xp[32];
    L = opaque(L); TBP = opaque(TBP); lane = opaque(lane);
    const float bcol = REV ? beta[63 - lane] : beta[lane];
    const int pc = REV ? permcol(63 - lane) : permcol(lane);
    f32x4 la[8], lb[8], lt[8];
#pragma unroll
    for (int ii = 0; ii < 64; ii += 2) { TRI_ROW(ii, la, lb) TRI_ROW(ii + 1, lb, la) }
}
#undef TRI_ROW

DI void gdn_conv(Frame& F, LAS unsigned char* lds, int t384, int b, int h, int n) {
    const bf16* QKVA = (const bf16*)(F.ws + WS_QKVA); const float* convw = F.in[3];
    const int cgp = t384 % 48, rg = t384 / 48, mat = cgp >> 4, cc = (cgp & 15) * 8;
    const int col = mat * 512 + h * 128 + cc;
    float w[5][8];
#pragma unroll
    for (int j = 0; j < 5; ++j) { const f32x4 a = *(const f32x4*)(convw + j * 1536 + col), bq = *(const f32x4*)(convw + j * 1536 + col + 4);
        w[j][0] = a.x; w[j][1] = a.y; w[j][2] = a.z; w[j][3] = a.w; w[j][4] = bq.x; w[j][5] = bq.y; w[j][6] = bq.z; w[j][7] = bq.w; }
    const int a4 = (cc >> 3) & 3, p0 = (cc & ~31) + 16 * (a4 & 1) + 4 * (a4 >> 1);
    const int ra = rg & 3, q0 = (rg >> 2) * 32 + 16 * (ra & 1) + 4 * (ra >> 1);
#pragma unroll
    for (int hf = 0; hf < 2; ++hf) {
        float o[4][8];
#pragma unroll
        for (int r = 0; r < 4; ++r)
#pragma unroll
            for (int c = 0; c < 8; ++c) o[r][c] = 0.f;
#pragma unroll
        for (int i = 0; i < 8; ++i) {
            const int pos = n * 64 + rg * 8 + hf * 4 - 2 + i;
            v4u raw = (v4u){0u, 0u, 0u, 0u};
            if (pos >= 0 && pos < SEQ) raw = *(const v4u*)(QKVA + (size_t)(b * SEQ + pos) * 1536 + col);
            float xin[8] = {bflo(raw.x), bfhi(raw.x), bflo(raw.y), bfhi(raw.y), bflo(raw.z), bfhi(raw.z), bflo(raw.w), bfhi(raw.w)};
#pragma unroll
            for (int j = 0; j < 5; ++j) { const int r = i - j; if (r >= 0 && r < 4) {
#pragma unroll
                for (int c = 0; c < 8; ++c) o[r][c] += w[j][c] * xin[c]; } }
        }
#pragma unroll
        for (int r = 0; r < 4; ++r) {
            float ss = 0.f;
#pragma unroll
            for (int c = 0; c < 8; ++c) { o[r][c] = siluf(o[r][c]); ss += o[r][c] * o[r][c]; }
            ss = sum16(ss);
            float sc = 1.0f;
            if (mat < 2) { sc = __builtin_amdgcn_rsqf(ss + EPS); if (mat == 0) sc *= 0.08838834764831845f; }
#pragma unroll
            for (int c = 0; c < 8; ++c) o[r][c] *= sc;
        }
        if (mat < 2) {
            LAS unsigned char* tile = lds + (mat == 0 ? G_QNP : G_KNP);
#pragma unroll
            for (int r = 0; r < 4; ++r) { const int c = rg * 8 + hf * 4 + r;
                v2u lo, hi2; lo.x = pk2(o[r][0], o[r][1]); lo.y = pk2(o[r][2], o[r][3]); hi2.x = pk2(o[r][4], o[r][5]); hi2.y = pk2(o[r][6], o[r][7]);
                *(LAS v2u*)(tile + c * 272 + p0 * 2) = lo; *(LAS v2u*)(tile + c * 272 + (p0 + 8) * 2) = hi2; }
        }
        if (mat >= 1) {
#pragma unroll
            for (int c = 0; c < 8; ++c) {
                v2u q4; q4.x = pk2(o[0][c], o[1][c]); q4.y = pk2(o[2][c], o[3][c]);
                if (mat == 1) *(LAS v2u*)(lds + G_KNTP + (cc + c) * 144 + (q0 + 8 * hf) * 2) = q4;
                else *(LAS v2u*)(lds + G_VCT + (cc + c) * 144 + rg * 16 + hf * 8) = q4;
            }
        }
    }
}
DI void gdn_gates(Frame& F, LAS unsigned char* lds, LAS float* gv, int lane, int b, int h, int n) {
    const float* gp = (const float*)(F.ws + WS_GATES) + (size_t)(b * SEQ + n * 64 + lane) * 16;
    const float bfv = gp[h], bbv = gp[4 + h], afv = gp[8 + h], abv = gp[12 + h];
    const float betaf = sigmoidf_(bfv), betab = sigmoidf_(bbv);
    const float xf = afv + F.in[5][h], xb = abv + F.in[5][4 + h];
    const float spf = fmaxf(xf, 0.f) + log1pf(__expf(-fabsf(xf))), spb = fmaxf(xb, 0.f) + log1pf(__expf(-fabsf(xb)));
    const float gf = -__expf(F.in[4][h]) * spf, gb = -__expf(F.in[4][4 + h]) * spb;
    float Gf = gf, Rb = gb;
#pragma unroll
    for (int o = 1; o < 64; o <<= 1) { const float u1 = __shfl_up(Gf, o); if (lane >= o) Gf += u1; const float d1 = __shfl_down(Rb, o); if (lane + o < 64) Rb += d1; }
    gv[lane] = Gf; gv[64 + lane] = Rb; gv[128 + lane] = betaf; gv[192 + lane] = betab;
    const float GfL = __shfl(Gf, 63), Rb0 = __shfl(Rb, 0);
    LAS float* v0 = (LAS float*)(lds + G_D0 + GD_VEC); LAS float* v1 = (LAS float*)(lds + G_D1 + GD_VEC);
    v0[lane] = __expf(Gf); v0[64 + lane] = __expf(GfL - Gf); v1[lane] = __expf(Rb); v1[64 + lane] = __expf(Rb0 - Rb);
    if (lane == 0) { v0[128] = __expf(GfL); v1[128] = __expf(Rb0); }
}
DI void p2_gdn_pre(Frame& F) {
    const int tid = F.tid, lane = F.lane, wave = F.wave;
    int task = F.vcu;
    if (task < 1024) {
        LAS unsigned char* lds = opaque(F.lds);
        const int b = task >> 9, h = (task >> 7) & 3, n = task & 127;
        if (wave >= 2) gdn_conv(F, lds, tid - 128, b, h, n);
        if (wave == 2) gdn_gates(F, lds, (LAS float*)(lds + G_GV), lane, b, h, n);
    }
    __syncthreads();
    int par = 0;
#pragma unroll 1
    for (; task < 1024; task += F.G, par ^= 1) {
        LAS unsigned char* lds = opaque(F.lds);
        const int b = task >> 9, h = (task >> 7) & 3, n = task & 127, bh = b * 4 + h;
        LAS float* gv = (LAS float*)(lds + G_GV + par * 1024);
        LAS float* sGf = gv; LAS float* sRb = gv + 64; LAS float* sBf = gv + 128; LAS float* sBb = gv + 192;
        {
            const int p = wave >> 2, mt = wave & 3, n16 = lane & 15, g = lane >> 4;
            const LAS unsigned char* At = lds + (p == 0 ? G_KNP : G_QNP) + (16 * mt + n16) * 272 + g * 16;
            bf16x8 af[4], bfr[16];
#pragma unroll
            for (int ks = 0; ks < 4; ++ks) af[ks] = *(const LAS bf16x8*)(At + ks * 64);
#pragma unroll
            for (int nt = 0; nt < 4; ++nt)
#pragma unroll
                for (int ks = 0; ks < 4; ++ks) bfr[nt * 4 + ks] = *(const LAS bf16x8*)(lds + G_KNP + (16 * nt + n16) * 272 + g * 16 + ks * 64);
            float Gc[4], Rc[4], Bfc[4], Bbc[4];
#pragma unroll
            for (int r = 0; r < 4; ++r) { const int c = 16 * mt + 4 * g + r; Gc[r] = sGf[c]; Rc[r] = sRb[c]; Bfc[r] = sBf[c]; Bbc[r] = sBb[c]; }
#pragma unroll
            for (int nt = 0; nt < 4; ++nt) {
                f32x4 acc = (f32x4){0.f, 0.f, 0.f, 0.f};
#pragma unroll
                for (int ks = 0; ks < 4; ++ks) acc = __builtin_amdgcn_mfma_f32_16x16x32_bf16(af[ks], bfr[nt * 4 + ks], acc, 0, 0, 0);
                const int s_ = 16 * nt + n16; const float Gs = sGf[s_], Rs = sRb[s_]; const int ps = permcol(s_);
#pragma unroll
                for (int r = 0; r < 4; ++r) {
                    const int c = 16 * mt + 4 * g + r; const float v = acc[r];
                    const float df = __expf(fminf(Gc[r] - Gs, 0.f)), db = __expf(fminf(Rc[r] - Rs, 0.f));
                    if (p == 0) {
                        ((LAS float*)(lds + G_LM))[c * 64 + s_] = Bfc[r] * v * df;
                        ((LAS float*)(lds + G_LM + 16384))[(63 - c) * 64 + (63 - s_)] = Bbc[r] * v * db;
                    } else {
                        ((LAS bf16*)(lds + G_D0 + GD_AP))[c * 72 + ps] = (bf16)(pk2(s_ <= c ? v * df : 0.f, 0.f) & 0xffffu);
                        ((LAS bf16*)(lds + G_D1 + GD_AP))[c * 72 + ps] = (bf16)(pk2(s_ >= c ? v * db : 0.f, 0.f) & 0xffffu);
                    }
                }
            }
        }
        __syncthreads();
        GAS v4u* gd0 = (GAS v4u*)(F.ws + WS_GD + (size_t)((bh * 2 + 0) * 128 + n) * GDN_D_BYTES);
        GAS v4u* gd1 = (GAS v4u*)(F.ws + WS_GD + (size_t)((bh * 2 + 1) * 128 + n) * GDN_D_BYTES);
        {
            GAS v4u* gsh = (GAS v4u*)(F.ws + WS_GSH + (size_t)(bh * 128 + n) * GDN_SH_BYTES);
#pragma unroll 3
            for (int i = tid; i < (int)(GDN_SH_BYTES / 16); i += NTHREADS) gsh[i] = *(const LAS v4u*)(lds + i * 16);
#pragma unroll 1
            for (int i = GD_AP / 16 + tid; i < (int)(GDN_D_BYTES / 16); i += NTHREADS) { gd0[i] = *(const LAS v4u*)(lds + G_D0 + i * 16); gd1[i] = *(const LAS v4u*)(lds + G_D1 + i * 16); }
        }
        __syncthreads();
        if (wave == 0) { tri_inverse<false>((LAS float*)(lds + G_LM), sBf, (LAS bf16*)(lds + G_D0 + GD_TBP), lane);
#pragma unroll 3
            for (int i = lane; i < GD_AP / 16; i += 64) gd0[i] = *(const LAS v4u*)(lds + G_D0 + i * 16); }
        else if (wave == 1) { tri_inverse<true>((LAS float*)(lds + G_LM + 16384), sBb, (LAS bf16*)(lds + G_D1 + GD_TBP), lane);
#pragma unroll 3
            for (int i = lane; i < GD_AP / 16; i += 64) gd1[i] = *(const LAS v4u*)(lds + G_D1 + i * 16); }
        else {
            const int t2 = task + F.G;
            if (t2 < 1024) { const int b2 = t2 >> 9, h2 = (t2 >> 7) & 3, n2 = t2 & 127;
                gdn_conv(F, lds, tid - 128, b2, h2, n2);
                if (wave == 2) gdn_gates(F, lds, (LAS float*)(lds + G_GV + (par ^ 1) * 1024), lane, b2, h2, n2); }
        }
        __syncthreads();
    }
}

DI bf16x8 pack8(const f32x4 a, const f32x4 b) {
    v4u p; p.x = pk2(a[0], a[1]); p.y = pk2(a[2], a[3]); p.z = pk2(b[0], b[1]); p.w = pk2(b[2], b[3]); return __builtin_bit_cast(bf16x8, p);
}
DI unsigned char* wgu_ptr(Frame& F, int e) { return F.ws + (e < WGU_SPLIT ? WS_WGU0 + (size_t)e * MiB : WS_WGU1 + (size_t)(e - WGU_SPLIT) * MiB); }
DI bf16* wd_ptr(Frame& F, int e) { return (bf16*)((unsigned char*)F.out + (e < WD_SPLIT ? DO_WD0 + (size_t)e * MiB : DO_WD1 + (size_t)(e - WD_SPLIT) * MiB)); }
constexpr int NG = 8, GSTEPS = 128 / NG;
#ifndef PASS1_QUOTA
#define PASS1_QUOTA 6
#endif
constexpr size_t WS_XB = 209 * MiB;
constexpr size_t WS_AOP = 217 * MiB;
constexpr size_t WS_SG = 221 * MiB;
constexpr int GS_SLOT = 54272, GS_Q = 17408, GS_VCT = 34816, GS_VEC = 53248, GS_TB = 18432, GS_AP = 27648;
static_assert(3 * GS_SLOT <= LDS_BYTES - 64, "scan ring");
static_assert(WS_SG + 8 * MiB <= 229 * MiB, "scan buffers");
DI void gs_dma(const unsigned char* src, unsigned lane16, unsigned lds_dst) {
    unsigned keep;
    asm volatile("s_mov_b32 %0, m0\n\ts_mov_b32 m0, %2\n\ts_nop 0\n\tglobal_load_lds_dwordx4 %1, %3\n\ts_mov_b32 m0, %0" : "=&s"(keep) : "v"(lane16), "s"(lds_dst), "s"(src) : "memory");
}
#define GS_WAITBAR(N) asm volatile("s_waitcnt vmcnt(%0) lgkmcnt(0)\n\ts_barrier" :: "n"(N) : "memory")
DI f32x4* gs_img(Frame& F, size_t base, int chain, int grp) { return (f32x4*)(F.ws + base) + (size_t)(chain * NG + grp) * (8 * 8 * 64); }
DI bf16* gs_aop(Frame& F, int chain, int grp) { return (bf16*)(F.ws + WS_AOP) + (size_t)(chain * NG + grp) * (8 * 4 * 64 * 8); }
DI void gs_start_state(Frame& F, int chain, int grp, f32x4 (&S)[8]);
template <int MODE> DI void gscan(Frame& F, const int chain, const int grp, f32x4* finalp, bf16* aop) {
    constexpr bool OUT = MODE == 0;
    constexpr int N1 = OUT ? 7 : (MODE == 1 ? 5 : 3), N2 = OUT ? 5 : 4, NST = OUT ? 16 : 0;
    const int lane = F.lane, n16 = lane & 15, g = lane >> 4, e = F.wave;
    const int bh = chain >> 1, dir = chain & 1, b = bh >> 2, h = bh & 3;
    const unsigned lds0 = (unsigned)(uintptr_t)opaque(F.lds), lane16 = (unsigned)lane * 16u;
    const unsigned char* shrec = F.ws + WS_GSH + (size_t)(bh * 128) * GDN_SH_BYTES; const unsigned char* drec = F.ws + WS_GD + (size_t)((bh * 2 + dir) * 128) * GDN_D_BYTES;
#define GS_ISSUE1(st_, slot_) do { const int sc_ = (st_) < 128 ? (st_) : 127; const int n_ = dir == 0 ? sc_ : 127 - sc_; const unsigned char* sh_ = shrec + (size_t)n_ * GDN_SH_BYTES; const unsigned char* dr_ = drec + (size_t)n_ * GDN_D_BYTES; \
        _Pragma("unroll") for (int j_ = 0; j_ < N1; ++j_) { const int q_ = e + 8 * j_; int p_; \
            if (MODE == 0) p_ = q_ < 53 ? q_ : 52; else if (MODE == 1) p_ = q_ < 17 ? q_ : (q_ < 35 ? q_ + 17 : 52); else p_ = q_ < 17 ? q_ : 52; \
            const unsigned char* src_ = p_ < 34 ? sh_ + p_ * 1024 : (p_ < 52 ? sh_ + G_VCT + (p_ - 34) * 1024 : dr_ + GD_VEC); \
            gs_dma(src_, lane16, (unsigned)__builtin_amdgcn_readfirstlane(lds0 + (unsigned)((slot_) * GS_SLOT + p_ * 1024))); } } while (0)
#define GS_ISSUE2(st_, slot_) do { const int sc_ = (st_) < 128 ? (st_) : 127; const int n_ = dir == 0 ? sc_ : 127 - sc_; const unsigned char* sh_ = shrec + (size_t)n_ * GDN_SH_BYTES; const unsigned char* dr_ = drec + (size_t)n_ * GDN_D_BYTES; \
        _Pragma("unroll") for (int j_ = 0; j_ < N2; ++j_) { const int q_ = e + 8 * j_; const int pm_ = OUT ? 35 : 26; const int p_ = q_ < pm_ ? q_ : pm_; \
            const unsigned char* src_ = p_ < 18 ? sh_ + G_KNTP + p_ * 1024 : dr_ + (p_ - 18) * 1024; \
            gs_dma(src_, lane16, (unsigned)__builtin_amdgcn_readfirstlane(lds0 + (unsigned)((slot_) * GS_SLOT + p_ * 1024))); } } while (0)
    const int st0 = grp * GSTEPS;
    bf16* Odir = (bf16*)((unsigned char*)F.out + (dir == 0 ? DO_OF : DO_OB));
    f32x4 S[8];
    if (MODE == 0 && grp > 0) gs_start_state(F, chain, grp, S);
    else {
#pragma unroll
        for (int i = 0; i < 8; ++i)
#pragma unroll
            for (int r = 0; r < 4; ++r) S[i][r] = (MODE == 2 && (16 * i + 4 * g + r) == (16 * e + n16)) ? 1.0f : 0.0f;
    }
    GS_ISSUE1(st0, 0); GS_ISSUE2(st0, 1);
    bf16x8 Sb[4];
#pragma unroll
    for (int i = 0; i < 4; ++i) Sb[i] = pack8(S[2 * i], S[2 * i + 1]);
    const unsigned aoff272 = n16 * 272 + g * 16, aoff144 = n16 * 144 + g * 16;
#define SB_() __builtin_amdgcn_sched_barrier(0)
#define LDR128(dst, base, off) asm volatile("ds_read_b128 %0, %1 offset:%2" : "=v"(dst) : "v"(base), "i"(off) : "memory")
#define LDR64(dst, base, off) asm volatile("ds_read_b64 %0, %1 offset:%2" : "=v"(dst) : "v"(base), "i"(off) : "memory")
#define LDR32(dst, base, off) asm volatile("ds_read_b32 %0, %1 offset:%2" : "=v"(dst) : "v"(base), "i"(off) : "memory")
    int sl1 = 0, sl2 = 1, sl3 = 2;
#pragma unroll 1
    for (int s = 0; s < GSTEPS; ++s) {
        const int st = st0 + s;
        if (OUT && s > 0) GS_WAITBAR(N2 + NST); else GS_WAITBAR(N2);
        GS_ISSUE1(s + 1 < GSTEPS ? st + 1 : st, sl3);
        const int n = dir == 0 ? st : 127 - st;
        const unsigned h1 = lds0 + (unsigned)sl1 * GS_SLOT, h2 = lds0 + (unsigned)sl2 * GS_SLOT;
        const unsigned bK = h1 + aoff272, bQ = h1 + GS_Q + aoff272, bKT = h2 + aoff144, bT = h2 + GS_TB + aoff144;
        const unsigned bV = h1 + GS_VCT + e * 2304 + n16 * 144 + g * 8, bvec = h1 + GS_VEC + g * 16, bd = h1 + GS_VEC;
        f32x4 eG[4], ks[4]; v2u vv[4]; float dch; bf16x8 fa[16];
        LDR128(eG[0], bvec, 0); LDR128(eG[1], bvec, 64); LDR128(eG[2], bvec, 128); LDR128(eG[3], bvec, 192);
        LDR128(ks[0], bvec, 256); LDR128(ks[1], bvec, 320); LDR128(ks[2], bvec, 384); LDR128(ks[3], bvec, 448);
        LDR32(dch, bd, 512);
        LDR64(vv[0], bV, 0); LDR64(vv[1], bV, 32); LDR64(vv[2], bV, 64); LDR64(vv[3], bV, 96);
#pragma unroll
        for (int m = 0; m < 4; ++m) { LDR128(fa[m * 4 + 0], bK, m * 4352 + 0); LDR128(fa[m * 4 + 1], bK, m * 4352 + 64); LDR128(fa[m * 4 + 2], bK, m * 4352 + 128); LDR128(fa[m * 4 + 3], bK, m * 4352 + 192); }
        bf16x8 fq[16];
        if (OUT) {
#pragma unroll
            for (int m = 0; m < 4; ++m) { LDR128(fq[m * 4 + 0], bQ, m * 4352 + 0); LDR128(fq[m * 4 + 1], bQ, m * 4352 + 64); LDR128(fq[m * 4 + 2], bQ, m * 4352 + 128); LDR128(fq[m * 4 + 3], bQ, m * 4352 + 192); }
            asm volatile("s_waitcnt lgkmcnt(15)" : "+v"(eG[0]), "+v"(eG[1]), "+v"(eG[2]), "+v"(eG[3]), "+v"(ks[0]), "+v"(ks[1]), "+v"(ks[2]), "+v"(ks[3]), "+v"(dch), "+v"(vv[0]), "+v"(vv[1]), "+v"(vv[2]), "+v"(vv[3]),
                         "+v"(fa[0]), "+v"(fa[1]), "+v"(fa[2]), "+v"(fa[3]), "+v"(fa[4]), "+v"(fa[5]), "+v"(fa[6]), "+v"(fa[7]), "+v"(fa[8]), "+v"(fa[9]), "+v"(fa[10]), "+v"(fa[11]), "+v"(fa[12]), "+v"(fa[13]), "+v"(fa[14]), "+v"(fa[15]) :: "memory");
        } else {
            asm volatile("s_waitcnt lgkmcnt(0)" : "+v"(eG[0]), "+v"(eG[1]), "+v"(eG[2]), "+v"(eG[3]), "+v"(ks[0]), "+v"(ks[1]), "+v"(ks[2]), "+v"(ks[3]), "+v"(dch), "+v"(vv[0]), "+v"(vv[1]), "+v"(vv[2]), "+v"(vv[3]),
                         "+v"(fa[0]), "+v"(fa[1]), "+v"(fa[2]), "+v"(fa[3]), "+v"(fa[4]), "+v"(fa[5]), "+v"(fa[6]), "+v"(fa[7]), "+v"(fa[8]), "+v"(fa[9]), "+v"(fa[10]), "+v"(fa[11]), "+v"(fa[12]), "+v"(fa[13]), "+v"(fa[14]), "+v"(fa[15]) :: "memory");
        }
        SB_();
        f32x4 KS[4];
#pragma unroll
        for (int m = 0; m < 4; ++m) KS[m] = (f32x4){0.f, 0.f, 0.f, 0.f};
#pragma unroll
        for (int i = 0; i < 4; ++i)
#pragma unroll
            for (int m = 0; m < 4; ++m) KS[m] = __builtin_amdgcn_mfma_f32_16x16x32_bf16(fa[m * 4 + i], Sb[i], KS[m], 0, 0, 0);
        SB_();
        if (OUT) {
            if (s > 0) asm volatile("s_waitcnt vmcnt(%16) lgkmcnt(0)\n\ts_barrier" : "+v"(fq[0]), "+v"(fq[1]), "+v"(fq[2]), "+v"(fq[3]), "+v"(fq[4]), "+v"(fq[5]), "+v"(fq[6]), "+v"(fq[7]), "+v"(fq[8]), "+v"(fq[9]), "+v"(fq[10]), "+v"(fq[11]), "+v"(fq[12]), "+v"(fq[13]), "+v"(fq[14]), "+v"(fq[15]) : "n"(N1 + NST) : "memory");
            else asm volatile("s_waitcnt vmcnt(%16) lgkmcnt(0)\n\ts_barrier" : "+v"(fq[0]), "+v"(fq[1]), "+v"(fq[2]), "+v"(fq[3]), "+v"(fq[4]), "+v"(fq[5]), "+v"(fq[6]), "+v"(fq[7]), "+v"(fq[8]), "+v"(fq[9]), "+v"(fq[10]), "+v"(fq[11]), "+v"(fq[12]), "+v"(fq[13]), "+v"(fq[14]), "+v"(fq[15]) : "n"(N1) : "memory");
        } else GS_WAITBAR(N1);
        GS_ISSUE2(s + 1 < GSTEPS ? st + 1 : st, sl1);
        bf16x8 ft[8];
#pragma unroll
        for (int m = 0; m < 4; ++m) { LDR128(ft[m * 2 + 0], bT, m * 2304 + 0); LDR128(ft[m * 2 + 1], bT, m * 2304 + 64); }
        SB_();
        f32x4 o[4];
        if (OUT) {
#pragma unroll
            for (int m = 0; m < 4; ++m) o[m] = (f32x4){0.f, 0.f, 0.f, 0.f};
#pragma unroll
            for (int i = 0; i < 4; ++i)
#pragma unroll
                for (int m = 0; m < 4; ++m) o[m] = __builtin_amdgcn_mfma_f32_16x16x32_bf16(fq[m * 4 + i], Sb[i], o[m], 0, 0, 0);
        }
        f32x4 rr[4];
#pragma unroll
        for (int m = 0; m < 4; ++m) {
            if (MODE == 2) { rr[m][0] = -eG[m][0] * KS[m][0]; rr[m][1] = -eG[m][1] * KS[m][1]; rr[m][2] = -eG[m][2] * KS[m][2]; rr[m][3] = -eG[m][3] * KS[m][3]; }
            else { rr[m][0] = bflo(vv[m].x) - eG[m][0] * KS[m][0]; rr[m][1] = bfhi(vv[m].x) - eG[m][1] * KS[m][1]; rr[m][2] = bflo(vv[m].y) - eG[m][2] * KS[m][2]; rr[m][3] = bfhi(vv[m].y) - eG[m][3] * KS[m][3]; } }
        bf16x8 rb[2]; rb[0] = pack8(rr[0], rr[1]); rb[1] = pack8(rr[2], rr[3]);
        SB_();
        bf16x8 fk[16];
#pragma unroll
        for (int jt = 0; jt < 8; ++jt) { LDR128(fk[jt * 2 + 0], bKT, jt * 2304 + 0); LDR128(fk[jt * 2 + 1], bKT, jt * 2304 + 64); }
        asm volatile("s_waitcnt lgkmcnt(15)" : "+v"(ft[0]), "+v"(ft[1]), "+v"(ft[2]), "+v"(ft[3]), "+v"(ft[4]), "+v"(ft[5]), "+v"(ft[6]), "+v"(ft[7]) :: "memory");
        SB_();
        f32x4 vn[4];
#pragma unroll
        for (int m = 0; m < 4; ++m) vn[m] = (f32x4){0.f, 0.f, 0.f, 0.f};
#pragma unroll
        for (int i = 0; i < 2; ++i)
#pragma unroll
            for (int m = 0; m < 4; ++m) vn[m] = __builtin_amdgcn_mfma_f32_16x16x32_bf16(ft[m * 2 + i], rb[i], vn[m], 0, 0, 0);
        if (OUT) {
#pragma unroll
            for (int m = 0; m < 4; ++m) o[m] = o[m] * eG[m];
        }
#pragma unroll
        for (int jt = 0; jt < 8; ++jt) S[jt] = S[jt] * dch;
        SB_();
        bf16x8 fp[8];
        if (OUT) {
#pragma unroll
            for (int m = 0; m < 4; ++m) { LDR128(fp[m * 2 + 0], bT, (GS_AP - GS_TB) + m * 2304 + 0); LDR128(fp[m * 2 + 1], bT, (GS_AP - GS_TB) + m * 2304 + 64); }
        }
        bf16x8 vnb[2]; vnb[0] = pack8(vn[0], vn[1]); vnb[1] = pack8(vn[2], vn[3]);
        bf16x8 vs[2]; vs[0] = pack8(vn[0] * ks[0], vn[1] * ks[1]); vs[1] = pack8(vn[2] * ks[2], vn[3] * ks[3]);
        if (OUT) asm volatile("s_waitcnt lgkmcnt(8)" : "+v"(fk[0]), "+v"(fk[1]), "+v"(fk[2]), "+v"(fk[3]), "+v"(fk[4]), "+v"(fk[5]), "+v"(fk[6]), "+v"(fk[7]), "+v"(fk[8]), "+v"(fk[9]), "+v"(fk[10]), "+v"(fk[11]), "+v"(fk[12]), "+v"(fk[13]), "+v"(fk[14]), "+v"(fk[15]) :: "memory");
        else asm volatile("s_waitcnt lgkmcnt(0)" : "+v"(fk[0]), "+v"(fk[1]), "+v"(fk[2]), "+v"(fk[3]), "+v"(fk[4]), "+v"(fk[5]), "+v"(fk[6]), "+v"(fk[7]), "+v"(fk[8]), "+v"(fk[9]), "+v"(fk[10]), "+v"(fk[11]), "+v"(fk[12]), "+v"(fk[13]), "+v"(fk[14]), "+v"(fk[15]) :: "memory");
        SB_();
#pragma unroll
        for (int i = 0; i < 2; ++i)
#pragma unroll
            for (int jt = 0; jt < 8; ++jt) S[jt] = __builtin_amdgcn_mfma_f32_16x16x32_bf16(fk[jt * 2 + i], vs[i], S[jt], 0, 0, 0);
        if (OUT) {
            asm volatile("s_waitcnt lgkmcnt(0)" : "+v"(fp[0]), "+v"(fp[1]), "+v"(fp[2]), "+v"(fp[3]), "+v"(fp[4]), "+v"(fp[5]), "+v"(fp[6]), "+v"(fp[7]) :: "memory");
#pragma unroll
            for (int i = 0; i < 2; ++i)
#pragma unroll
                for (int m = 0; m < 4; ++m) o[m] = __builtin_amdgcn_mfma_f32_16x16x32_bf16(fp[m * 2 + i], vnb[i], o[m], 0, 0, 0);
        }
#pragma unroll
        for (int i = 0; i < 4; ++i) Sb[i] = pack8(S[2 * i], S[2 * i + 1]);
        SB_();
        if (OUT) {
            bf16* op = Odir + (size_t)(b * SEQ + n * 64) * 512 + h * 128 + 16 * e + n16;
#pragma unroll
            for (int m = 0; m < 4; ++m)
#pragma unroll
                for (int r = 0; r < 4; ++r) op[(size_t)(16 * m + 4 * g + r) * 512] = (bf16)(pk2(o[m][r], 0.f) & 0xffffu);
        }
        { const int t_ = sl1; sl1 = sl3; sl3 = sl2; sl2 = t_; }
    }
#undef SB_
#undef LDR128
#undef LDR64
#undef LDR32
#undef GS_ISSUE1
#undef GS_ISSUE2
    if (finalp) {
#pragma unroll
        for (int i = 0; i < 8; ++i) finalp[(e * 8 + i) * 64 + lane] = S[i];
    }
    if (aop) {
#pragma unroll
        for (int jt = 0; jt < 8; ++jt)
#pragma unroll
            for (int r = 0; r < 4; ++r) aop[((jt * 4 + (e >> 1)) * 64 + 16 * (n16 >> 2) + 4 * g + r) * 8 + 4 * (e & 1) + (n16 & 3)] = (bf16)(pk2(S[jt][r], 0.f) & 0xffffu);
    }
    asm volatile("s_waitcnt vmcnt(0)" ::: "memory");
    __syncthreads();
}
DI void gs_start_state(Frame& F, int chain, int grp, f32x4 (&S)[8]) {
    const int lane = F.lane, e = F.wave;
    { const f32x4* b0 = gs_img(F, WS_XB, chain, 0);
#pragma unroll
      for (int i = 0; i < 8; ++i) S[i] = b0[(e * 8 + i) * 64 + lane]; }
#pragma unroll 1
    for (int gq = 1; gq < grp; ++gq) {
        const f32x4* bg = gs_img(F, WS_XB, chain, gq); const bf16x8* ag = (const bf16x8*)gs_aop(F, chain, gq);
        bf16x8 Sb[4];
#pragma unroll
        for (int i = 0; i < 4; ++i) Sb[i] = pack8(S[2 * i], S[2 * i + 1]);
#pragma unroll
        for (int jt = 0; jt < 8; ++jt) { f32x4 acc = bg[(e * 8 + jt) * 64 + lane];
#pragma unroll
            for (int i = 0; i < 4; ++i) acc = __builtin_amdgcn_mfma_f32_16x16x32_bf16(ag[(jt * 4 + i) * 64 + lane], Sb[i], acc, 0, 0, 0);
            S[jt] = acc; }
    }
}
constexpr int CV_QS = NEXP * 32, CV_WD = NEXP * 32, CV_WO = 64, CV_RT = 16, CV_ITEMS = CV_QS + CV_WD + CV_WO + CV_RT;
DI void conv_item(Frame& F, int it) {
    LAS float* scr = (LAS float*)(F.lds + F.wave * 16384);
    if (it < CV_QS) {
        const int e = it >> 5, mat = (it >> 4) & 1, nb = it & 15;
        q_strip((mat ? F.in[14] : F.in[13]) + (size_t)e * 1024 * 512, 512, 32 * nb, wgu_ptr(F, e), (float*)(F.ws + WS_WSC) + e * 1024, mat + 64 * nb, 2, F.lds, F.wave, F.lane);
    } else if (it < CV_QS + CV_WD) {
        const int w = (it - CV_QS) * 8 + F.wave, e = w >> 8, r = w & 255;
        p0_transpose_item(F.in[15] + (size_t)e * 512 * 1024, 1024, 32, wd_ptr(F, e), 512, 0, 1, scr, r, F.lane);
    } else if (it < CV_QS + CV_WD + CV_WO) {
        p0_transpose_item(F.in[9], 1024, 32, (bf16*)(F.ws + WS_WOUT), 1024, 0, 1, scr, (it - CV_QS - CV_WD) * 8 + F.wave, F.lane);
    } else {
        bf16* WRH = (bf16*)(F.ws + WS_WR); bf16* WRL = WRH + 48 * 1024; const float* wrg = F.in[11]; const float* wre = F.in[12];
        const int base = (it - CV_QS - CV_WD - CV_WO) * 3072;
#pragma unroll
        for (int q = 0; q < 6; ++q) { const int i = base + q * 512 + F.tid; const int j = i >> 10, k = i & 1023; float v = 0.f; if (j < 4) v = wrg[k * 4 + j]; else if (j < 36) v = wre[k * 32 + (j - 4)];
            const unsigned hh = f2bf(v); const float hv = __builtin_bit_cast(float, hh << 16); WRH[i] = (bf16)hh; WRL[i] = (bf16)f2bf(v - hv); }
    }
}
constexpr int CW_CONVQ = 12288;
DI void conv_pull(Frame& F, int quota) {
    volatile LAS int* slot = (volatile LAS int*)(F.lds + MISC_OFF + 32);
    for (int n = 0; n < quota; ++n) {
        __syncthreads();
        if (F.tid == 0) *slot = (int)xb_add((unsigned*)(F.ws + WS_CTL) + CW_CONVQ, 1u);
        __syncthreads();
        const int it = *slot; if (it >= CV_ITEMS) break;
        conv_item(F, it);
    }
    __syncthreads();
}
DI void p4_pass1(Frame& F) {
    const int T = F.vcu, part = T & 1, cg = T >> 1, chain = cg / (NG - 1), grp = cg % (NG - 1);
    if (T < 16 * (NG - 1) * 2 && part == 0) gscan<1>(F, chain, grp, gs_img(F, WS_XB, chain, grp), nullptr);
    else if (T < 16 * (NG - 1) * 2 && grp > 0) gscan<2>(F, chain, grp, nullptr, gs_aop(F, chain, grp));
    else conv_pull(F, PASS1_QUOTA);
}
DI void p4_pass3(Frame& F) {
    if ((F.vcu & 1) == 0 && (F.vcu >> 1) < 16 * NG) { const int T = F.vcu >> 1; gscan<0>(F, T / NG, T % NG, nullptr, nullptr); }
    conv_pull(F, 1 << 30);
}

DI void p5_combine(Frame& F) {
    const int gw = F.vcu * NWAVES + F.wave, NGW = F.G * NWAVES, lane = F.lane;
    const bf16* OFp = (const bf16*)((unsigned char*)F.out + DO_OF); const bf16* OBp = (const bf16*)((unsigned char*)F.out + DO_OB);
    const bf16* ZA = (const bf16*)(F.ws + WS_ZA); bf16* OCAT = (bf16*)(F.ws + WS_OCAT);
    const float* nw = F.in[6] + (lane & 15) * 8;
    float w8[8];
#pragma unroll
    for (int c = 0; c < 8; ++c) w8[c] = nw[c];
    constexpr int NB4 = 4;
    for (int t0 = gw; t0 < TT; t0 += NB4 * NGW) {
        v4u a[NB4], bb[NB4], z[NB4];
#pragma unroll
        for (int u = 0; u < NB4; ++u) { const int t = (t0 + u * NGW < TT) ? t0 + u * NGW : t0;
            a[u] = *(const v4u*)(OFp + (size_t)t * 512 + lane * 8); bb[u] = *(const v4u*)(OBp + (size_t)t * 512 + lane * 8); z[u] = *(const v4u*)(ZA + (size_t)t * 512 + lane * 8); }
#pragma unroll
        for (int u = 0; u < NB4; ++u) {
            const int t = t0 + u * NGW; if (t >= TT) break;
            float o[8] = {bflo(a[u].x) + bflo(bb[u].x), bfhi(a[u].x) + bfhi(bb[u].x), bflo(a[u].y) + bflo(bb[u].y), bfhi(a[u].y) + bfhi(bb[u].y), bflo(a[u].z) + bflo(bb[u].z), bfhi(a[u].z) + bfhi(bb[u].z), bflo(a[u].w) + bflo(bb[u].w), bfhi(a[u].w) + bfhi(bb[u].w)};
            const float zz[8] = {bflo(z[u].x), bfhi(z[u].x), bflo(z[u].y), bfhi(z[u].y), bflo(z[u].z), bfhi(z[u].z), bflo(z[u].w), bfhi(z[u].w)};
            float ss = 0.f;
#pragma unroll
            for (int c = 0; c < 8; ++c) ss += o[c] * o[c];
            ss = sum16(ss);
            const float rn = __builtin_amdgcn_rsqf(ss * (1.f / 128.f) + EPS);
#pragma unroll
            for (int c = 0; c < 8; ++c) o[c] = o[c] * rn * w8[c] * siluf(zz[c]);
            v4u r; r.x = pk2(o[0], o[1]); r.y = pk2(o[2], o[3]); r.z = pk2(o[4], o[5]); r.w = pk2(o[6], o[7]);
            *(v4u*)(OCAT + (size_t)t * 1024 + lane * 8) = r;
        }
    }
}

struct TokRec { int e[2]; int row[2]; float gate[2]; };
DI void p7_route(Frame& F) {
    const int lane = F.lane, n16 = lane & 15, g = lane >> 4, wave = F.wave;
    const bf16* X1 = (const bf16*)(F.ws + WS_X1); const float* nfw = F.in[10];
    const bf16* WRH = (const bf16*)(F.ws + WS_WR); const bf16* WRL = WRH + 48 * 1024;
    unsigned char* HN = (unsigned char*)F.out + DO_HN; TokRec* TOK = (TokRec*)(F.ws + WS_TOK); unsigned* gcnt = (unsigned*)(F.ws + WS_CTL) + CW_CNT; int* LIST = (int*)(F.ws + WS_LIST);
    LAS float* lg = (LAS float*)(F.lds + (wave & 3) * 4096);
    LAS unsigned* hist = (LAS unsigned*)(F.lds + 16384); LAS unsigned* base = hist + 32;
    const int sub = blockIdx.x & 7;
    const float qsc = 127.0f / act_absmax(nfw, lane);
    for (int rt0 = blockIdx.x * 4; rt0 < TT / 16; rt0 += F.G * 4) {
        if (F.tid < 32) hist[F.tid] = 0u;
        __syncthreads();
        int ex1 = 0, ex2 = 0, tok = -1; unsigned l1 = 0, l2 = 0; float g1 = 0.f, g2 = 0.f;
        const int rt = rt0 + wave;
        if (wave < 4 && rt < TT / 16) {
            const int row = rt * 16 + n16; const bf16* xr = X1 + (size_t)row * DMODEL + 8 * g;
            float ss = 0.f;
#pragma unroll 16
            for (int i = 0; i < 32; ++i) { const v4u xw = *(const v4u*)(xr + 32 * i); const f32x4 a = {bflo(xw.x), bfhi(xw.x), bflo(xw.y), bfhi(xw.y)}, b2 = {bflo(xw.z), bfhi(xw.z), bflo(xw.w), bfhi(xw.w)};
                ss += (a.x * a.x + a.y * a.y) + (a.z * a.z + a.w * a.w) + (b2.x * b2.x + b2.y * b2.y) + (b2.z * b2.z + b2.w * b2.w); }
            ss = sum_x32(sum_x16(ss));
            const float rs = __builtin_amdgcn_rsqf(ss * (1.f / DMODEL) + EPS);
            f32x4 acc[3];
#pragma unroll
            for (int q = 0; q < 3; ++q) acc[q] = (f32x4){0.f, 0.f, 0.f, 0.f};
#pragma unroll 4
            for (int i = 0; i < 32; ++i) {
                const v4u xw = *(const v4u*)(xr + 32 * i); const f32x4 a = {bflo(xw.x), bfhi(xw.x), bflo(xw.y), bfhi(xw.y)}, b2 = {bflo(xw.z), bfhi(xw.z), bflo(xw.w), bfhi(xw.w)};
                const f32x4 wa = *(const f32x4*)(nfw + 32 * i + 8 * g), wb = *(const f32x4*)(nfw + 32 * i + 8 * g + 4);
                float hv[8] = {a.x * rs * wa.x, a.y * rs * wa.y, a.z * rs * wa.z, a.w * rs * wa.w, b2.x * rs * wb.x, b2.y * rs * wb.y, b2.z * rs * wb.z, b2.w * rs * wb.w};
                v4u hi, lo;
                hi.x = pk2(hv[0], hv[1]); hi.y = pk2(hv[2], hv[3]); hi.z = pk2(hv[4], hv[5]); hi.w = pk2(hv[6], hv[7]);
                lo.x = pk2(hv[0] - bflo(hi.x), hv[1] - bfhi(hi.x)); lo.y = pk2(hv[2] - bflo(hi.y), hv[3] - bfhi(hi.y));
                lo.z = pk2(hv[4] - bflo(hi.z), hv[5] - bfhi(hi.z)); lo.w = pk2(hv[6] - bflo(hi.w), hv[7] - bfhi(hi.w));
                { v2u q; q.x = q8x4(hv[0], hv[1], hv[2], hv[3], qsc); q.y = q8x4(hv[4], hv[5], hv[6], hv[7], qsc); *(v2u*)(HN + (size_t)row * DMODEL + 32 * i + 8 * g) = q; }
                const bf16x8 ah = __builtin_bit_cast(bf16x8, hi), al = __builtin_bit_cast(bf16x8, lo);
#pragma unroll
                for (int q = 0; q < 3; ++q) {
                    const bf16x8 bh = *(const bf16x8*)(WRH + (size_t)(16 * q + n16) * 1024 + 32 * i + 8 * g), bl = *(const bf16x8*)(WRL + (size_t)(16 * q + n16) * 1024 + 32 * i + 8 * g);
                    acc[q] = __builtin_amdgcn_mfma_f32_16x16x32_bf16(ah, bh, acc[q], 0, 0, 0);
                    acc[q] = __builtin_amdgcn_mfma_f32_16x16x32_bf16(ah, bl, acc[q], 0, 0, 0);
                    acc[q] = __builtin_amdgcn_mfma_f32_16x16x32_bf16(al, bh, acc[q], 0, 0, 0);
                }
            }
#pragma unroll
            for (int q = 0; q < 3; ++q)
#pragma unroll
                for (int r = 0; r < 4; ++r) lg[(4 * g + r) * 48 + 16 * q + n16] = acc[q][r];
            asm volatile("s_waitcnt lgkmcnt(0)" ::: "memory");
            if (lane < 16) {
                const LAS float* L = lg + lane * 48; tok = rt * 16 + lane;
                float gm = L[0]; int gs = 0;
#pragma unroll
                for (int q = 1; q < 4; ++q) if (L[q] > gm) { gm = L[q]; gs = q; }
                float gsum = 0.f;
#pragma unroll
                for (int q = 0; q < 4; ++q) gsum += __expf(L[q] - gm);
                const float gp_top = 1.0f / gsum;
                float fv[8];
#pragma unroll
                for (int q = 0; q < 8; ++q) { float v = L[4 + q]; v = (gs == 1) ? L[12 + q] : v; v = (gs == 2) ? L[20 + q] : v; v = (gs == 3) ? L[28 + q] : v; fv[q] = v; }
                float m1 = fv[0]; int i1 = 0;
#pragma unroll
                for (int q = 1; q < 8; ++q) if (fv[q] > m1) { m1 = fv[q]; i1 = q; }
                float m2 = -3.0e38f; int i2 = 0;
#pragma unroll
                for (int q = 0; q < 8; ++q) if (q != i1 && fv[q] > m2) { m2 = fv[q]; i2 = q; }
                const float e2 = __expf(m2 - m1); g1 = gp_top / (1.0f + e2); g2 = gp_top * e2 / (1.0f + e2);
                ex1 = gs * 8 + i1; ex2 = gs * 8 + i2;
                l1 = __hip_atomic_fetch_add(hist + ex1, 1u, __ATOMIC_RELAXED, __HIP_MEMORY_SCOPE_WORKGROUP); l2 = __hip_atomic_fetch_add(hist + ex2, 1u, __ATOMIC_RELAXED, __HIP_MEMORY_SCOPE_WORKGROUP);
            }
        }
        __syncthreads();
        if (F.tid < 32) { const unsigned hcount = hist[F.tid]; base[F.tid] = hcount ? atomicAdd(gcnt + F.tid * 8 + sub, hcount) : 0u; }
        __syncthreads();
        if (tok >= 0) {
            const int s1 = (int)(base[ex1] + l1), s2 = (int)(base[ex2] + l2);
            LIST[(size_t)(ex1 * 8 + sub) * TT + s1] = tok; LIST[(size_t)(ex2 * 8 + sub) * TT + s2] = tok;
            TokRec tr; tr.e[0] = ex1; tr.e[1] = ex2; tr.row[0] = (sub << 24) | s1; tr.row[1] = (sub << 24) | s2; tr.gate[0] = g1; tr.gate[1] = g2;
            TOK[tok] = tr;
        }
    }
}

DI void build_etab(Frame& F) {
    LAS unsigned* etab = (LAS unsigned*)(F.lds + ETAB_OFF);
    if (F.tid < 32) {
        const unsigned* gcnt = (const unsigned*)(F.ws + WS_CTL) + CW_CNT + F.tid * 8; unsigned acc = 0;
#pragma unroll
        for (int q = 0; q < 8; ++q) { const unsigned c = __hip_atomic_load(gcnt + q, __ATOMIC_RELAXED, __HIP_MEMORY_SCOPE_AGENT); etab[96 + 8 * F.tid + q] = acc; acc += c; }
        etab[64 + F.tid] = acc; etab[2 * F.tid + 1] = (acc + 255u) >> 8;
    }
    __syncthreads();
    if (F.tid == 0) { unsigned acc = 0; for (int e = 0; e < NEXP; ++e) { etab[2 * e] = acc; acc += etab[2 * e + 1]; } }
    if (F.wave == 1) { const float am = act_absmax(F.in[10], F.lane); if (F.lane == 0) ((LAS float*)etab)[352] = am * (1.0f / 127.0f); }
    __syncthreads();
}

DI void p11_final(Frame& F) {
    build_etab(F);
    const LAS unsigned* etab = (const LAS unsigned*)(F.lds + ETAB_OFF);
    const int gw = F.vcu * NWAVES + F.wave, NGW = F.G * NWAVES, lane = F.lane;
    const bf16* Y = (const bf16*)(F.ws + WS_XBUF); const TokRec* TOK = (const TokRec*)(F.ws + WS_TOK); const float* fw = F.in[16];
    const f32x4 w0 = *(const f32x4*)(fw + lane * 8), w1 = *(const f32x4*)(fw + lane * 8 + 4), w2 = *(const f32x4*)(fw + 512 + lane * 8), w3 = *(const f32x4*)(fw + 516 + lane * 8);
    constexpr int NB2 = 2;
    for (int t0 = gw; t0 < TT; t0 += NB2 * NGW) {
        TokRec tr[NB2]; v4u xa[NB2][2]; v4u ya[NB2][2][2];
#pragma unroll
        for (int u = 0; u < NB2; ++u) { const int t = (t0 + u * NGW < TT) ? t0 + u * NGW : t0; tr[u] = TOK[t];
            const bf16* xr = (const bf16*)(F.ws + WS_X1) + (size_t)t * DMODEL + lane * 8;
            xa[u][0] = *(const v4u*)(xr); xa[u][1] = *(const v4u*)(xr + 512); }
#pragma unroll
        for (int u = 0; u < NB2; ++u)
#pragma unroll
            for (int k = 0; k < 2; ++k) { const unsigned rk = (unsigned)tr[u].row[k]; const bf16* yr = Y + (size_t)(etab[2 * tr[u].e[k]] * 256u + etab[96 + 8 * tr[u].e[k] + (rk >> 24)] + (rk & 0xffffffu)) * DMODEL + lane * 8; ya[u][k][0] = *(const v4u*)(yr); ya[u][k][1] = *(const v4u*)(yr + 512); }
#pragma unroll
        for (int u = 0; u < NB2; ++u) {
            const int t = t0 + u * NGW; if (t >= TT) break;
            float v[16] = {bflo(xa[u][0].x), bfhi(xa[u][0].x), bflo(xa[u][0].y), bfhi(xa[u][0].y), bflo(xa[u][0].z), bfhi(xa[u][0].z), bflo(xa[u][0].w), bfhi(xa[u][0].w),
                           bflo(xa[u][1].x), bfhi(xa[u][1].x), bflo(xa[u][1].y), bfhi(xa[u][1].y), bflo(xa[u][1].z), bfhi(xa[u][1].z), bflo(xa[u][1].w), bfhi(xa[u][1].w)};
#pragma unroll
            for (int k = 0; k < 2; ++k) {
                const float gk = tr[u].gate[k]; const v4u y0 = ya[u][k][0], y1 = ya[u][k][1];
                v[0] += gk * bflo(y0.x); v[1] += gk * bfhi(y0.x); v[2] += gk * bflo(y0.y); v[3] += gk * bfhi(y0.y); v[4] += gk * bflo(y0.z); v[5] += gk * bfhi(y0.z); v[6] += gk * bflo(y0.w); v[7] += gk * bfhi(y0.w);
                v[8] += gk * bflo(y1.x); v[9] += gk * bfhi(y1.x); v[10] += gk * bflo(y1.y); v[11] += gk * bfhi(y1.y); v[12] += gk * bflo(y1.z); v[13] += gk * bfhi(y1.z); v[14] += gk * bflo(y1.w); v[15] += gk * bfhi(y1.w);
            }
            float ss = 0.f;
#pragma unroll
            for (int i = 0; i < 16; ++i) ss += v[i] * v[i];
            const float rs = __builtin_amdgcn_rsqf(wave_sum(ss) * (1.f / DMODEL) + EPS);
            float* orow = F.out + (size_t)t * DMODEL + lane * 8;
            *(f32x4*)(orow) = (f32x4){v[0] * rs * w0.x, v[1] * rs * w0.y, v[2] * rs * w0.z, v[3] * rs * w0.w};
            *(f32x4*)(orow + 4) = (f32x4){v[4] * rs * w1.x, v[5] * rs * w1.y, v[6] * rs * w1.z, v[7] * rs * w1.w};
            *(f32x4*)(orow + 512) = (f32x4){v[8] * rs * w2.x, v[9] * rs * w2.y, v[10] * rs * w2.z, v[11] * rs * w2.w};
            *(f32x4*)(orow + 516) = (f32x4){v[12] * rs * w3.x, v[13] * rs * w3.y, v[14] * rs * w3.z, v[15] * rs * w3.w};
        }
    }
}

struct Args { const float* in[17]; float* out; unsigned char* ws; int ph_lo, ph_hi; };
__global__ void __launch_bounds__(NTHREADS, 2) fwd_kernel(Args args) {
    extern __shared__ __attribute__((aligned(16))) unsigned char lds[];
    cg::grid_group grid = cg::this_grid();
    Frame F;
    F.lds = (LAS unsigned char*)lds; F.tid = threadIdx.x; F.lane = F.tid & 63; F.wave = __builtin_amdgcn_readfirstlane(F.tid >> 6);
    F.G = gridDim.x; { const int bx = blockIdx.x; F.vcu = (F.G % 8 == 0) ? (bx % 8) * (F.G / 8) + bx / 8 : bx; }
#pragma unroll
    for (int i = 0; i < 17; ++i) F.in[i] = args.in[i];
    F.out = args.out; F.ws = args.ws;
    const int lo = args.ph_lo, hi = args.ph_hi;
    if (F.tid < 16) ((volatile LAS unsigned*)(F.lds + MISC_OFF))[F.tid] = 0u;
    __syncthreads();
    XcdBarrier bar = xcd_barrier_post((unsigned*)(F.ws + WS_CTL) + CW_BAR, (volatile LAS unsigned*)(F.lds + MISC_OFF));
    if (lo > 1000) grid.sync();
#ifndef PHSEL
#define PHSEL 0xfff
#endif
#define IN(k) (((PHSEL >> (k)) & 1) && lo <= (k) && (k) < hi)
#define SEAM(k) do { if (IN(k) && IN((k) + 1)) xcd_barrier(bar); } while (0)
#ifndef REP_PH
#define REP_PH -1
#endif
#define REPS(k) for (int rep_ = 0; rep_ < ((k) == REP_PH ? 2 : 1); ++rep_, ((k) == REP_PH && rep_ < 2) ? xcd_barrier(bar) : (void)0)
    if (IN(0)) REPS(0) { p0_prologue(F); } SEAM(0);
    if (IN(1)) REPS(1) {
        pg8::Gemm gm{(const pg8::bf16_t*)(F.ws + WS_XN), (const pg8::bf16_t*)(F.ws + WS_WIN), TT, NPROJ, DMODEL / 2};
        pg8::StaticOrder S; S.init(TT, NPROJ, F.G, (int)blockIdx.x);
        EpiProj E{(bf16*)(F.ws + WS_QKVA), (bf16*)(F.ws + WS_ZA), (bf16*)(F.ws + WS_QKVB), (const float*)(F.ws + WS_WSI), (const float*)(F.ws + WS_XSC)};
        pg8::gemm_phase_gather<EpiProj, pg8::StaticOrder, IdRows, true, true>(F.lds, gm, S, E, IdRows{});
    } SEAM(1);
    if (IN(2)) REPS(2) {
#ifndef NO_ROPE
        p2_rope(F);
#ifdef PROBE_ROPE2
        xcd_barrier(bar); p2_rope(F);
#endif
#endif
#ifndef NO_PRE
        p2_gdn_pre(F);
#ifdef PROBE_PRE2
        xcd_barrier(bar); p2_gdn_pre(F);
#endif
#endif
    } SEAM(2);
    if (IN(3)) REPS(3) {
        const attn_body::AttnTensors AT{(const attn_body::bf16*)((unsigned char*)F.out + DO_QR), (const attn_body::bf16*)((unsigned char*)F.out + DO_KR), (const attn_body::bf16*)((unsigned char*)F.out + DO_VR),
                                        (attn_body::bf16*)(F.ws + WS_OCAT) + 512};
        const attn_body::StaticOrder S((int)F.G, (int)blockIdx.x);
#ifdef PROBE_ZERO_ATTN
        { (void)AT; (void)S; bf16* OC = (bf16*)(F.ws + WS_OCAT); const int gt = blockIdx.x * NTHREADS + F.tid, GT = F.G * NTHREADS;
          for (int i = gt; i < TT * 64; i += GT) { const int t = i >> 6, c = i & 63; *(v4u*)(OC + (size_t)t * 1024 + 512 + c * 8) = (v4u){0u, 0u, 0u, 0u}; } }
#else
        const float nshift = -(0.125f * 1.4426950408889634f * 64.f * 1.01f) * wave_max(fabsf(F.in[7][F.lane])) * wave_max(fabsf(F.in[8][F.lane]));
        attn_body::attn_phase<attn_body::StaticOrder>((char*)lds, AT, S, nshift);
#endif
    } SEAM(3);
    if (IN(4)) { p4_pass1(F); xcd_barrier(bar); p4_pass3(F); } SEAM(4);
    if (IN(5)) REPS(5) { p5_combine(F); } SEAM(5);
    if (IN(6)) REPS(6) {
        pg8::Gemm gm{(const pg8::bf16_t*)(F.ws + WS_OCAT), (const pg8::bf16_t*)(F.ws + WS_WOUT), TT, DMODEL, DMODEL}; pg8::StaticOrder S; S.init(TT, DMODEL, F.G, (int)blockIdx.x);
        EpiResid E{F.in[0], (bf16*)(F.ws + WS_X1)};
        pg8::gemm_phase<EpiResid, pg8::StaticOrder, true, true>(F.lds, gm, S, E);
    } SEAM(6);
    if (IN(7)) { p7_route(F); } SEAM(7);
    if (IN(9)) REPS(9) {
        build_etab(F);
        pg8::Gemm gm{(const pg8::bf16_t*)((unsigned char*)F.out + DO_HN), (const pg8::bf16_t*)(F.ws + WS_WGU0), 0, 0, DMODEL / 2};
        MoeOrder S{(const LAS unsigned*)(F.lds + ETAB_OFF), F.G, (int)blockIdx.x, WGU_SPLIT, (int)((WS_WGU1 - WS_WGU0) / (256 * 1024))};
        MoeRows AM{(const int*)(F.ws + WS_LIST), (const LAS unsigned*)(F.lds + ETAB_OFF)};
        EpiGU E{(bf16*)(F.ws + WS_HID), (const float*)(F.ws + WS_WSC), ((const LAS float*)(F.lds + ETAB_OFF))[352]};
        pg8::gemm_phase_gather<EpiGU, MoeOrder, MoeRows, true, true>(F.lds, gm, S, E, AM);
    } SEAM(9);
    if (IN(10)) REPS(10) {
        pg8::Gemm gm{(const pg8::bf16_t*)(F.ws + WS_HID), (const pg8::bf16_t*)((unsigned char*)F.out + DO_WD0), 0, 0, FFE}; build_etab(F); MoeOrder S{(const LAS unsigned*)(F.lds + ETAB_OFF), F.G, (int)blockIdx.x, WD_SPLIT, (int)((DO_WD1 - DO_WD0) / (256 * 1024))};
        EpiY E{(bf16*)(F.ws + WS_XBUF)};
        pg8::gemm_phase<EpiY, MoeOrder, true, true>(F.lds, gm, S, E);
    } SEAM(10);
#ifdef EXTRA_SYNCS
    for (int q_ = 0; q_ < EXTRA_SYNCS; ++q_) xcd_barrier(bar);
#endif
    if (IN(11)) { p11_final(F); }
#undef IN
#undef SEAM
}

extern "C" void kernel_launch(void* const* d_in, const int* in_sizes, int n_in, void* d_out, int out_size, void* d_ws, size_t ws_size, hipStream_t stream) {
    static int grid = 0;
    if (grid == 0) {
        if (n_in != 17 || out_size != TT * DMODEL || ws_size < WS_END) { fprintf(stderr, "kernel_launch: unexpected problem (n_in %d out %d ws %zu)\n", n_in, out_size, ws_size); grid = -1; return; }
        int dev = 0, cus = 0, per_cu = 0;
        if (hipGetDevice(&dev) != hipSuccess || hipDeviceGetAttribute(&cus, hipDeviceAttributeMultiprocessorCount, dev) != hipSuccess) { grid = -1; return; }
        if (hipFuncSetAttribute((const void*)fwd_kernel, hipFuncAttributeMaxDynamicSharedMemorySize, LDS_BYTES) != hipSuccess) { fprintf(stderr, "hipFuncSetAttribute failed\n"); grid = -1; return; }
        if (hipOccupancyMaxActiveBlocksPerMultiprocessor(&per_cu, (const void*)fwd_kernel, NTHREADS, LDS_BYTES) != hipSuccess || per_cu < 1) { fprintf(stderr, "occupancy query: %d\n", per_cu); grid = -1; return; }
        if (cus < 256) { fprintf(stderr, "kernel_launch: %d CUs; the scan phase's task map needs 256 workgroups\n", cus); grid = -1; return; }
        grid = cus;
    }
    if (grid < 0) return;
    (void)hipMemsetAsync((char*)d_ws + WS_CTL, 0, CTL_ZERO_BYTES, stream);
    Args a{};
    for (int i = 0; i < 17; ++i) a.in[i] = (const float*)d_in[i];
    a.out = (float*)d_out; a.ws = (unsigned char*)d_ws;
#if MK_PER_PHASE
    for (int p = 0; p < N_PHASES; ++p) { a.ph_lo = p; a.ph_hi = p + 1; hipLaunchKernelGGL(fwd_kernel, dim3(grid), dim3(NTHREADS), LDS_BYTES, stream, a); }
#else
    a.ph_lo = 0; a.ph_hi = N_PHASES;
    void* kargs[] = {&a};
    hipError_t e = hipLaunchCooperativeKernel((void*)fwd_kernel, dim3(grid), dim3(NTHREADS), kargs, LDS_BYTES, stream);
    if (e != hipSuccess) fprintf(stderr, "cooperative launch failed: %s (grid %d)\n", hipGetErrorString(e), grid);
#endif
}
```

```cpp
#include <hip/hip_runtime.h>
#include <cstdio>
#include <cstdint>
namespace pg8 {
#define PG8_LAS __attribute__((address_space(3)))
typedef unsigned short bf16_t;
typedef short bf16x8 __attribute__((ext_vector_type(8)));
typedef float f32x4 __attribute__((ext_vector_type(4)));
typedef unsigned u32x4 __attribute__((ext_vector_type(4)));
constexpr int BM = 256, BK = 64, HALF = 128, HTB = HALF * BK * 2  , STAGE_BYTES = 8 * HTB, NXCD = 8, WGM = 8;

__host__ __device__ __forceinline__ int lds_byte(int r, int c) { const int st = (r >> 4) * 2 + (c >> 5), rr = r & 15, cc = c & 31, ob = rr * 64 + cc * 2; return st * 1024 + (ob ^ (((ob >> 9) & 1) << 5)); }
__host__ __device__ __forceinline__ void stage_rc(int b, int& R, int& C) { const int st = b / 1024, sb = b % 1024, swz = sb ^ (((sb >> 9) & 1) << 5); R = (st >> 1) * 16 + swz / 64; C = (st & 1) * 32 + (swz % 64) / 2; }
__host__ __device__ __forceinline__ int perm32(int rho) { const int n = rho >> 4, i = rho & 15; return 8 * (i >> 2) + 4 * n + (i & 3); }

struct Unit { int pm, pn, ex, tq; };
struct Gemm { const bf16_t* A; const bf16_t* Bt; int M, N, K; };

struct StaticOrder {
    int nM, nN, nwg, G, c;
    __host__ __device__ void init(int M, int N, int G_, int c_) { nM = M / BM; nN = N / BM; nwg = nM * nN; G = G_; c = c_; }
    __host__ __device__ bool next(int i, Unit& u) const {
        const long L = (long)i * G + c; if (L >= nwg) return false;
        int wgid = (int)L; { const int q = nwg / NXCD, r = nwg % NXCD, xcd = wgid % NXCD, off = wgid / NXCD; wgid = (xcd < r ? xcd * (q + 1) : r * (q + 1) + (xcd - r) * q) + off; }
        const int nig = WGM * nN, gid = wgid / nig, fm = gid * WGM, gsz = (nM - fm) < WGM ? (nM - fm) : WGM;
        u.pm = fm + ((wgid % nig) % gsz); u.pn = (wgid % nig) / gsz; return true;
    }
    __device__ __forceinline__ void a_ready(const Unit&) const {}
    __device__ __forceinline__ void done(const Unit&) const {}
};

__device__ __forceinline__ unsigned cvt_pk_bf16(float lo, float hi) { unsigned r; asm volatile("v_cvt_pk_bf16_f32 %0, %1, %2" : "=v"(r) : "v"(lo), "v"(hi)); return r; }
typedef float f32x2 __attribute__((ext_vector_type(2)));
template <class Epi, class Sched, bool ALIGN_EPI = false, bool SP2 = false>
__device__ __forceinline__ void gemm_phase(PG8_LAS unsigned char* lds, const Gemm g, const Sched& S, const Epi& E) {
    const int tid = threadIdx.x, wid = __builtin_amdgcn_readfirstlane(tid >> 6), lane = tid & 63, wr = wid >> 2, wc = wid & 3, fr = lane & 15, fq = lane >> 4;
    const int K = g.K, nt = K / BK;
    unsigned voffA[2], voffB[2];
#pragma unroll
    for (int i = 0; i < 2; ++i) { int R, C; stage_rc(tid * 16 + i * 8192, R, C); const int Rb = Epi::PERM ? ((R & ~31) + perm32(R & 31)) : R;
        voffA[i] = (unsigned)(R * K + C) * 2u; voffB[i] = (unsigned)(Rb * K + C) * 2u; }
    const size_t kstep = (size_t)(BK * 2);
    const size_t hstep = (size_t)HALF * K * 2;
    const size_t tstep = 2 * hstep;
    const unsigned ldsw = (unsigned)wid * 1024u;
    const int aoff = lds_byte(wr * 64 + fr, fq * 8), boff = lds_byte(wc * 32 + fr, fq * 8);
#define PG8_SA(b, h) (((b) * 2 + (h)) * HTB)
#define PG8_SB(b, h) ((4 + (b) * 2 + (h)) * HTB)
#define PG8_STAGE(bufoff, gbase, voff) do { _Pragma("unroll") for (int _i = 0; _i < 2; ++_i) \
        __builtin_amdgcn_global_load_lds((const unsigned*)((const char*)(gbase) + (voff)[_i]), (PG8_LAS unsigned*)(lds + (bufoff) + ldsw + _i * 8192), 16, 0, 0); } while (0)
#define PG8_LDA(dst, b, h) do { _Pragma("unroll") for (int m = 0; m < 4; ++m) _Pragma("unroll") for (int k = 0; k < 2; ++k) dst[m][k] = *(const PG8_LAS bf16x8*)(lds + PG8_SA(b, h) + aoff + m * 2048 + k * 1024); } while (0)
#define PG8_LDB(dst, b, h) do { _Pragma("unroll") for (int n = 0; n < 2; ++n) _Pragma("unroll") for (int k = 0; k < 2; ++k) dst[n][k] = *(const PG8_LAS bf16x8*)(lds + PG8_SB(b, h) + boff + n * 2048 + k * 1024); } while (0)
#define PG8_MMA(ai, bj, At, Bt) do { __builtin_amdgcn_s_setprio(1); _Pragma("unroll") for (int m = 0; m < 4; ++m) _Pragma("unroll") for (int n = 0; n < 2; ++n) _Pragma("unroll") for (int k = 0; k < 2; ++k) \
        acc[ai][bj][m][n] = __builtin_amdgcn_mfma_f32_16x16x32_bf16(Bt[n][k], At[m][k], acc[ai][bj][m][n], 0, 0, 0); __builtin_amdgcn_s_setprio(0); } while (0)
#define PG8_WAIT_V(n) asm volatile("s_waitcnt vmcnt(" #n ")" ::: "memory")
#define PG8_WAIT_L(n) asm volatile("s_waitcnt lgkmcnt(" #n ")" ::: "memory")
#define PG8_BAR __builtin_amdgcn_s_barrier()
#define PG8_SCHED __builtin_amdgcn_sched_barrier(0)
    Unit cur, nxt; int ui = 0;
    if (!S.next(0, cur)) return;
    f32x4 acc[2][2][4][2];
#pragma unroll
    for (int a = 0; a < 2; ++a)
#pragma unroll
        for (int b = 0; b < 2; ++b)
#pragma unroll
            for (int m = 0; m < 4; ++m)
#pragma unroll
                for (int n = 0; n < 2; ++n) acc[a][b][m][n] = (f32x4){0.f, 0.f, 0.f, 0.f};
    bf16x8 At[4][2], B0[2][2], B1[2][2];
    const char* cA = (const char*)g.A + (size_t)cur.pm * tstep; const char* cB = (const char*)g.Bt + (size_t)cur.pn * tstep;
    S.a_ready(cur);
    if constexpr (SP2) {
        PG8_STAGE(PG8_SB(0, 0), cB, voffB); PG8_STAGE(PG8_SB(0, 1), cB + hstep, voffB); PG8_STAGE(PG8_SA(0, 0), cA, voffA); PG8_STAGE(PG8_SA(0, 1), cA + hstep, voffA);
        if (wr == 1) PG8_BAR;
        PG8_WAIT_V(2); PG8_BAR;
        PG8_STAGE(PG8_SB(1, 0), cB + kstep, voffB); PG8_STAGE(PG8_SA(1, 0), cA + kstep, voffA); PG8_STAGE(PG8_SB(1, 1), cB + hstep + kstep, voffB);
        PG8_WAIT_V(6); PG8_BAR;
    } else {
        PG8_STAGE(PG8_SB(0, 0), cB, voffB); PG8_STAGE(PG8_SA(0, 0), cA, voffA); PG8_STAGE(PG8_SB(0, 1), cB + hstep, voffB); PG8_STAGE(PG8_SA(0, 1), cA + hstep, voffA);
        if (wr == 1) PG8_BAR;
        PG8_WAIT_V(4); PG8_BAR;
        PG8_STAGE(PG8_SB(1, 0), cB + kstep, voffB); PG8_STAGE(PG8_SA(1, 0), cA + kstep, voffA); PG8_STAGE(PG8_SB(1, 1), cB + hstep + kstep, voffB);
        PG8_WAIT_V(6); PG8_BAR;
    }
    for (;;) {
        const bool has_next = S.next(ui + 1, nxt);
        const char* nA = has_next ? (const char*)g.A + (size_t)nxt.pm * tstep : cA; const char* nB = has_next ? (const char*)g.Bt + (size_t)nxt.pn * tstep : cB;
        for (int t = 0; t < nt; t += 2) {
            const bool last = (t == nt - 2);
            const char* a1 = cA + (size_t)(t + 1) * kstep;
            const char* a2 = last ? nA : cA + (size_t)(t + 2) * kstep; const char* b2 = last ? nB : cB + (size_t)(t + 2) * kstep;
            const char* a3 = a2 + kstep; const char* b3 = b2 + kstep;
            if (last && has_next) S.a_ready(nxt);
            if constexpr (SP2) {
            PG8_LDB(B0, 0, 0); PG8_LDB(B1, 0, 1); PG8_SCHED; PG8_LDA(At, 0, 0); PG8_STAGE(PG8_SA(1, 1), a1 + hstep, voffA);
            PG8_WAIT_V(8); PG8_WAIT_L(0); PG8_BAR; PG8_MMA(0, 0, At, B0); PG8_MMA(0, 1, At, B1); PG8_BAR; PG8_SCHED;
            PG8_LDA(At, 0, 1); PG8_STAGE(PG8_SB(0, 0), b2, voffB); PG8_STAGE(PG8_SB(0, 1), b2 + hstep, voffB); PG8_STAGE(PG8_SA(0, 0), a2, voffA);
            PG8_WAIT_V(8); PG8_WAIT_L(0); PG8_BAR; PG8_MMA(1, 0, At, B0); PG8_MMA(1, 1, At, B1); PG8_BAR; PG8_SCHED;
            PG8_LDB(B0, 1, 0); PG8_LDB(B1, 1, 1); PG8_SCHED; PG8_LDA(At, 1, 0); PG8_STAGE(PG8_SA(0, 1), a2 + hstep, voffA);
            PG8_WAIT_V(8); PG8_WAIT_L(0); PG8_BAR; PG8_MMA(0, 0, At, B0); PG8_MMA(0, 1, At, B1); PG8_BAR; PG8_SCHED;
            PG8_LDA(At, 1, 1); PG8_STAGE(PG8_SB(1, 0), b3, voffB); PG8_STAGE(PG8_SB(1, 1), b3 + hstep, voffB); PG8_STAGE(PG8_SA(1, 0), a3, voffA);
            PG8_WAIT_V(8); PG8_WAIT_L(0); PG8_BAR; PG8_MMA(1, 0, At, B0); PG8_MMA(1, 1, At, B1); PG8_BAR; PG8_SCHED;
            } else {
            PG8_LDB(B0, 0, 0); PG8_SCHED; PG8_LDA(At, 0, 0); PG8_STAGE(PG8_SA(1, 1), a1 + hstep, voffA);
            PG8_WAIT_L(8); PG8_BAR; PG8_WAIT_L(0); PG8_MMA(0, 0, At, B0); PG8_BAR; PG8_SCHED;
            PG8_LDB(B1, 0, 1); PG8_STAGE(PG8_SB(0, 0), b2, voffB);
            PG8_BAR; PG8_WAIT_L(0); PG8_MMA(0, 1, At, B1); PG8_BAR;
            PG8_LDA(At, 0, 1); PG8_STAGE(PG8_SA(0, 0), a2, voffA);
            PG8_BAR; PG8_WAIT_L(0); PG8_MMA(1, 0, At, B0); PG8_BAR; PG8_SCHED;
            PG8_STAGE(PG8_SB(0, 1), b2 + hstep, voffB);
            PG8_WAIT_V(6); PG8_BAR; PG8_MMA(1, 1, At, B1); PG8_BAR;
            PG8_LDB(B0, 1, 0); PG8_SCHED; PG8_LDA(At, 1, 0); PG8_STAGE(PG8_SA(0, 1), a2 + hstep, voffA);
            PG8_WAIT_L(8); PG8_BAR; PG8_WAIT_L(0); PG8_MMA(0, 0, At, B0); PG8_BAR; PG8_SCHED;
            PG8_LDB(B1, 1, 1); PG8_STAGE(PG8_SB(1, 0), b3, voffB);
            PG8_BAR; PG8_WAIT_L(0); PG8_MMA(0, 1, At, B1); PG8_BAR;
            PG8_LDA(At, 1, 1); PG8_STAGE(PG8_SA(1, 0), a3, voffA);
            PG8_BAR; PG8_WAIT_L(0); PG8_MMA(1, 0, At, B0); PG8_BAR; PG8_SCHED;
            PG8_STAGE(PG8_SB(1, 1), b3 + hstep, voffB);
            PG8_WAIT_V(6); PG8_BAR; PG8_MMA(1, 1, At, B1); PG8_BAR;
            }
        }
        if constexpr (ALIGN_EPI) { if (wr == 0) PG8_BAR; }
        if constexpr (!Epi::AFTER_DRAIN) { E(acc, cur, wr, wc, fr, fq); S.done(cur); }
        if (!has_next) break;
#pragma unroll
        for (int a = 0; a < 2; ++a)
#pragma unroll
            for (int b = 0; b < 2; ++b)
#pragma unroll
                for (int m = 0; m < 4; ++m)
#pragma unroll
                    for (int n = 0; n < 2; ++n) acc[a][b][m][n] = (f32x4){0.f, 0.f, 0.f, 0.f};
        cur = nxt; cA = nA; cB = nB; ++ui;
        if constexpr (ALIGN_EPI) { if (wr == 1) PG8_BAR; }
    }
    PG8_WAIT_V(0);
    if constexpr (!ALIGN_EPI) { if (wr == 0) PG8_BAR; }
    PG8_BAR;
    if constexpr (Epi::AFTER_DRAIN) { E.fused(acc, cur, wr, wc, fr, fq, lds, wid, lane); S.done(cur); }
#undef PG8_SA
#undef PG8_SB
#undef PG8_STAGE
#undef PG8_LDA
#undef PG8_LDB
#undef PG8_MMA
#undef PG8_WAIT_V
#undef PG8_WAIT_L
#undef PG8_BAR
#undef PG8_SCHED
}
typedef int i32x4 __attribute__((ext_vector_type(4)));
template <bool I8> struct AccSel { typedef f32x4 type; };
template <> struct AccSel<true> { typedef i32x4 type; };
template <bool I8> __device__ __forceinline__ void mma_step(typename AccSel<I8>::type& c, const bf16x8& b, const bf16x8& a) {
    if constexpr (I8) c = __builtin_amdgcn_mfma_i32_16x16x64_i8(__builtin_bit_cast(i32x4, b), __builtin_bit_cast(i32x4, a), c, 0, 0, 0);
    else c = __builtin_amdgcn_mfma_f32_16x16x32_bf16(b, a, c, 0, 0, 0);
}
template <class Epi, class Sched, class AMap, bool ALIGN_EPI = false, bool I8 = false>
__device__ __forceinline__ void gemm_phase_gather(PG8_LAS unsigned char* lds, const Gemm g, const Sched& S, const Epi& E, const AMap& AM) {
    constexpr bool SP2 = true;
    const int tid = threadIdx.x, wid = __builtin_amdgcn_readfirstlane(tid >> 6), lane = tid & 63, wr = wid >> 2, wc = wid & 3, fr = lane & 15, fq = lane >> 4;
    const int K = g.K, nt = K / BK;
    unsigned voffA[2], voffB[2]; int rowA[2];
#pragma unroll
    for (int i = 0; i < 2; ++i) { int R, C; stage_rc(tid * 16 + i * 8192, R, C); const int Rb = Epi::PERM ? ((R & ~31) + perm32(R & 31)) : R;
        voffA[i] = (unsigned)C * 2u; voffB[i] = (unsigned)(Rb * K + C) * 2u; rowA[i] = R; }
    const size_t kstep = (size_t)(BK * 2);
    const size_t hstep = (size_t)HALF * K * 2;
    const size_t tstep = 2 * hstep;
    const unsigned ldsw = (unsigned)wid * 1024u;
    const int aoff = lds_byte(wr * 64 + fr, fq * 8), boff = lds_byte(wc * 32 + fr, fq * 8);
#define PG8_SA(b, h) (((b) * 2 + (h)) * HTB)
#define PG8_SB(b, h) ((4 + (b) * 2 + (h)) * HTB)
#define PG8_STAGE(bufoff, gbase, voff) do { _Pragma("unroll") for (int _i = 0; _i < 2; ++_i) \
        __builtin_amdgcn_global_load_lds((const unsigned*)((const char*)(gbase) + (voff)[_i]), (PG8_LAS unsigned*)(lds + (bufoff) + ldsw + _i * 8192), 16, 0, 0); } while (0)
#define PG8_LDA(dst, b, h) do { _Pragma("unroll") for (int m = 0; m < 4; ++m) _Pragma("unroll") for (int k = 0; k < 2; ++k) dst[m][k] = *(const PG8_LAS bf16x8*)(lds + PG8_SA(b, h) + aoff + m * 2048 + k * 1024); } while (0)
#define PG8_LDB(dst, b, h) do { _Pragma("unroll") for (int n = 0; n < 2; ++n) _Pragma("unroll") for (int k = 0; k < 2; ++k) dst[n][k] = *(const PG8_LAS bf16x8*)(lds + PG8_SB(b, h) + boff + n * 2048 + k * 1024); } while (0)
#define PG8_MMA(ai, bj, At, Bt) do { __builtin_amdgcn_s_setprio(1); _Pragma("unroll") for (int m = 0; m < 4; ++m) _Pragma("unroll") for (int n = 0; n < 2; ++n) _Pragma("unroll") for (int k = 0; k < 2; ++k) \
        mma_step<I8>(acc[ai][bj][m][n], Bt[n][k], At[m][k]); __builtin_amdgcn_s_setprio(0); } while (0)
#define PG8_WAIT_V(n) asm volatile("s_waitcnt vmcnt(" #n ")" ::: "memory")
#define PG8_WAIT_L(n) asm volatile("s_waitcnt lgkmcnt(" #n ")" ::: "memory")
#define PG8_BAR __builtin_amdgcn_s_barrier()
#define PG8_SCHED __builtin_amdgcn_sched_barrier(0)
    Unit cur, nxt; int ui = 0;
    if (!S.next(0, cur)) return;
    typedef typename AccSel<I8>::type acc_t;
    acc_t acc[2][2][4][2];
#pragma unroll
    for (int a = 0; a < 2; ++a)
#pragma unroll
        for (int b = 0; b < 2; ++b)
#pragma unroll
            for (int m = 0; m < 4; ++m)
#pragma unroll
                for (int n = 0; n < 2; ++n) acc[a][b][m][n] = (acc_t){0, 0, 0, 0};
    bf16x8 At[4][2], B0[2][2], B1[2][2];
    const char* cA = (const char*)g.A; const char* cB = (const char*)g.Bt + (size_t)cur.pn * tstep;
    unsigned vA0[2], vA1[2], nA0[2], nA1[2];
#pragma unroll
    for (int i = 0; i < 2; ++i) { vA0[i] = (unsigned)AM.row(cur, rowA[i]) * (unsigned)(K * 2) + voffA[i]; vA1[i] = (unsigned)AM.row(cur, HALF + rowA[i]) * (unsigned)(K * 2) + voffA[i]; }
    S.a_ready(cur);
    if constexpr (SP2) {
        PG8_STAGE(PG8_SB(0, 0), cB, voffB); PG8_STAGE(PG8_SB(0, 1), cB + hstep, voffB); PG8_STAGE(PG8_SA(0, 0), cA, vA0); PG8_STAGE(PG8_SA(0, 1), cA, vA1);
        if (wr == 1) PG8_BAR;
        PG8_WAIT_V(2); PG8_BAR;
        PG8_STAGE(PG8_SB(1, 0), cB + kstep, voffB); PG8_STAGE(PG8_SA(1, 0), cA + kstep, vA0); PG8_STAGE(PG8_SB(1, 1), cB + hstep + kstep, voffB);
        PG8_WAIT_V(6); PG8_BAR;
    } else {
        PG8_STAGE(PG8_SB(0, 0), cB, voffB); PG8_STAGE(PG8_SA(0, 0), cA, voffA); PG8_STAGE(PG8_SB(0, 1), cB + hstep, voffB); PG8_STAGE(PG8_SA(0, 1), cA + hstep, voffA);
        if (wr == 1) PG8_BAR;
        PG8_WAIT_V(4); PG8_BAR;
        PG8_STAGE(PG8_SB(1, 0), cB + kstep, voffB); PG8_STAGE(PG8_SA(1, 0), cA + kstep, voffA); PG8_STAGE(PG8_SB(1, 1), cB + hstep + kstep, voffB);
        PG8_WAIT_V(6); PG8_BAR;
    }
    for (;;) {
        const bool has_next = S.next(ui + 1, nxt);
        const char* nA = cA; const char* nB = has_next ? (const char*)g.Bt + (size_t)nxt.pn * tstep : cB;
#pragma unroll
        for (int i = 0; i < 2; ++i) { nA0[i] = has_next ? (unsigned)AM.row(nxt, rowA[i]) * (unsigned)(K * 2) + voffA[i] : vA0[i]; nA1[i] = has_next ? (unsigned)AM.row(nxt, HALF + rowA[i]) * (unsigned)(K * 2) + voffA[i] : vA1[i]; }
        for (int t = 0; t < nt; t += 2) {
            const bool last = (t == nt - 2);
            const char* a1 = cA + (size_t)(t + 1) * kstep;
            const char* a2 = last ? nA : cA + (size_t)(t + 2) * kstep; const char* b2 = last ? nB : cB + (size_t)(t + 2) * kstep;
            const char* a3 = a2 + kstep; const char* b3 = b2 + kstep;
            unsigned s0[2], s1[2];
#pragma unroll
            for (int i = 0; i < 2; ++i) { s0[i] = vA0[i]; s1[i] = vA1[i]; }
            if (last) {
#pragma unroll
                for (int i = 0; i < 2; ++i) { unsigned t0_ = nA0[i], t1_ = nA1[i]; asm volatile("" : "+v"(t0_), "+v"(t1_)); s0[i] = t0_; s1[i] = t1_; } }
            if (last && has_next) S.a_ready(nxt);
            if constexpr (SP2) {
            PG8_LDB(B0, 0, 0); PG8_LDB(B1, 0, 1); PG8_SCHED; PG8_LDA(At, 0, 0); PG8_STAGE(PG8_SA(1, 1), a1, vA1);
            PG8_WAIT_V(8); PG8_WAIT_L(0); PG8_BAR; PG8_MMA(0, 0, At, B0); PG8_MMA(0, 1, At, B1); PG8_BAR; PG8_SCHED;
            PG8_LDA(At, 0, 1); PG8_STAGE(PG8_SB(0, 0), b2, voffB); PG8_STAGE(PG8_SB(0, 1), b2 + hstep, voffB); PG8_STAGE(PG8_SA(0, 0), a2, s0);
            PG8_WAIT_V(8); PG8_WAIT_L(0); PG8_BAR; PG8_MMA(1, 0, At, B0); PG8_MMA(1, 1, At, B1); PG8_BAR; PG8_SCHED;
            PG8_LDB(B0, 1, 0); PG8_LDB(B1, 1, 1); PG8_SCHED; PG8_LDA(At, 1, 0); PG8_STAGE(PG8_SA(0, 1), a2, s1);
            PG8_WAIT_V(8); PG8_WAIT_L(0); PG8_BAR; PG8_MMA(0, 0, At, B0); PG8_MMA(0, 1, At, B1); PG8_BAR; PG8_SCHED;
            PG8_LDA(At, 1, 1); PG8_STAGE(PG8_SB(1, 0), b3, voffB); PG8_STAGE(PG8_SB(1, 1), b3 + hstep, voffB); PG8_STAGE(PG8_SA(1, 0), a3, s0);
            PG8_WAIT_V(8); PG8_WAIT_L(0); PG8_BAR; PG8_MMA(1, 0, At, B0); PG8_MMA(1, 1, At, B1); PG8_BAR; PG8_SCHED;
            } else {
            PG8_LDB(B0, 0, 0); PG8_SCHED; PG8_LDA(At, 0, 0); PG8_STAGE(PG8_SA(1, 1), a1 + hstep, voffA);
            PG8_WAIT_L(8); PG8_BAR; PG8_WAIT_L(0); PG8_MMA(0, 0, At, B0); PG8_BAR; PG8_SCHED;
            PG8_LDB(B1, 0, 1); PG8_STAGE(PG8_SB(0, 0), b2, voffB);
            PG8_BAR; PG8_WAIT_L(0); PG8_MMA(0, 1, At, B1); PG8_BAR;
            PG8_LDA(At, 0, 1); PG8_STAGE(PG8_SA(0, 0), a2, voffA);
            PG8_BAR; PG8_WAIT_L(0); PG8_MMA(1, 0, At, B0); PG8_BAR; PG8_SCHED;
            PG8_STAGE(PG8_SB(0, 1), b2 + hstep, voffB);
            PG8_WAIT_V(6); PG8_BAR; PG8_MMA(1, 1, At, B1); PG8_BAR;
            PG8_LDB(B0, 1, 0); PG8_SCHED; PG8_LDA(At, 1, 0); PG8_STAGE(PG8_SA(0, 1), a2 + hstep, voffA);
            PG8_WAIT_L(8); PG8_BAR; PG8_WAIT_L(0); PG8_MMA(0, 0, At, B0); PG8_BAR; PG8_SCHED;
            PG8_LDB(B1, 1, 1); PG8_STAGE(PG8_SB(1, 0), b3, voffB);
            PG8_BAR; PG8_WAIT_L(0); PG8_MMA(0, 1, At, B1); PG8_BAR;
            PG8_LDA(At, 1, 1); PG8_STAGE(PG8_SA(1, 0), a3, voffA);
            PG8_BAR; PG8_WAIT_L(0); PG8_MMA(1, 0, At, B0); PG8_BAR; PG8_SCHED;
            PG8_STAGE(PG8_SB(1, 1), b3 + hstep, voffB);
            PG8_WAIT_V(6); PG8_BAR; PG8_MMA(1, 1, At, B1); PG8_BAR;
            }
        }
        if constexpr (ALIGN_EPI) { if (wr == 0) PG8_BAR; }
        if constexpr (!Epi::AFTER_DRAIN) { E(acc, cur, wr, wc, fr, fq); S.done(cur); }
        if (!has_next) break;
#pragma unroll
        for (int a = 0; a < 2; ++a)
#pragma unroll
            for (int b = 0; b < 2; ++b)
#pragma unroll
                for (int m = 0; m < 4; ++m)
#pragma unroll
                    for (int n = 0; n < 2; ++n) acc[a][b][m][n] = (acc_t){0, 0, 0, 0};
        cur = nxt; cA = nA; cB = nB; ++ui;
#pragma unroll
        for (int i = 0; i < 2; ++i) { vA0[i] = nA0[i]; vA1[i] = nA1[i]; }
        if constexpr (ALIGN_EPI) { if (wr == 1) PG8_BAR; }
    }
    PG8_WAIT_V(0);
    if constexpr (!ALIGN_EPI) { if (wr == 0) PG8_BAR; }
    PG8_BAR;
    if constexpr (Epi::AFTER_DRAIN) { E.fused(acc, cur, wr, wc, fr, fq, lds, wid, lane); S.done(cur); }
#undef PG8_SA
#undef PG8_SB
#undef PG8_STAGE
#undef PG8_LDA
#undef PG8_LDB
#undef PG8_MMA
#undef PG8_WAIT_V
#undef PG8_WAIT_L
#undef PG8_BAR
#undef PG8_SCHED
}
}
#include <hip/hip_bf16.h>
#include <cmath>
namespace attn_body {
using bf16=__hip_bfloat16;
using bf16x8=__attribute__((ext_vector_type(8)))short;
using s16x4=__attribute__((ext_vector_type(4)))short;
using f32x16=__attribute__((ext_vector_type(16)))float;
using u32x4=__attribute__((ext_vector_type(4)))unsigned;
constexpr int BATCH=2,NHEAD=8,NKVH=2,SEQ=8192,D=64,QP=512,KP=128,OP=1024;
constexpr int NW=8,QBLK=32,QB=QBLK*NW,KVBLK=64,NQB=SEQ/QB;
constexpr int ATTN_UNIT_ROWS=QB;
__device__ __forceinline__ int crow(int r,int hi){return (r&3)+8*(r>>2)+4*hi;}
#define SBAR() __builtin_amdgcn_sched_barrier(0)
__device__ __forceinline__ void cmask(f32x16&p0,f32x16&p1,int jb,int qrel,int hi){
  const float NEG=-INFINITY; int kb=64*jb+4*hi;
  #pragma unroll
  for(int r=0;r<16;++r){int kv=kb+(r&3)+8*(r>>2); if(kv>qrel)p0[r]=NEG; if(kv+32>qrel)p1[r]=NEG;}
}

constexpr int NSLOT=3, SLOTB=8192;
constexpr int LDS_K=0, LDS_V=NSLOT*SLOTB, LDS_WS=2*NSLOT*SLOTB, LDS_OST=LDS_WS+NW*64*4, LDS_BYTES=LDS_OST+NW*4096;
constexpr float C2=0.125f*1.4426950408889634f;
__device__ __forceinline__ void glds16(const void*gsrc,unsigned lds_dst){unsigned keep;
  asm volatile("s_mov_b32 %0, m0\n\ts_mov_b32 m0, %2\n\ts_nop 0\n\tglobal_load_lds_dwordx4 %1, off\n\ts_mov_b32 m0, %0":"=&s"(keep):"v"(gsrc),"s"(lds_dst):"memory");}
__device__ __forceinline__ float max3f(float a,float b,float c){float r;asm("v_max3_f32 %0, %1, %2, %3":"=v"(r):"v"(a),"v"(b),"v"(c));return r;}
__device__ __forceinline__ float max2f(float a,float b){float r;asm("v_max_f32_e32 %0, %1, %2":"=v"(r):"v"(a),"v"(b));return r;}
__device__ __forceinline__ float fadd_s(float a,float b){float r;asm("v_add_f32_e32 %0, %1, %2":"=v"(r):"v"(a),"v"(b));return r;}
__device__ __forceinline__ float fsub_s(float a,float b){float r;asm("v_sub_f32_e32 %0, %1, %2":"=v"(r):"v"(a),"v"(b));return r;}
typedef float f32x2_t __attribute__((ext_vector_type(2))); typedef __bf16 bf16x2_t __attribute__((ext_vector_type(2)));
__device__ __forceinline__ unsigned cvtpk_s(float lo,float hi){f32x2_t v={lo,hi};bf16x2_t b=__builtin_convertvector(v,bf16x2_t);return __builtin_bit_cast(unsigned,b);}
#define WAIT_BAR(N) asm volatile("s_waitcnt vmcnt(" #N ") lgkmcnt(0)\n\ts_barrier":::"memory")

__device__ __forceinline__ void qkt(f32x16&p0,f32x16&p1,const char*Kslot,const bf16x8*qr,const f32x16&negm,int r32,int hi){
  const char*kb=Kslot+hi*1024+r32*16;
  #pragma unroll
  for(int d0=0;d0<4;++d0){
    const bf16x8 b0=*reinterpret_cast<const bf16x8*>(kb+d0*2048);
    const bf16x8 b1=*reinterpret_cast<const bf16x8*>(kb+d0*2048+512);
    if(d0==0){p0=__builtin_amdgcn_mfma_f32_32x32x16_bf16(b0,qr[0],negm,0,0,0);p1=__builtin_amdgcn_mfma_f32_32x32x16_bf16(b1,qr[0],negm,0,0,0);}
    else{p0=__builtin_amdgcn_mfma_f32_32x32x16_bf16(b0,qr[d0],p0,0,0,0);p1=__builtin_amdgcn_mfma_f32_32x32x16_bf16(b1,qr[d0],p1,0,0,0);}}
}
typedef __attribute__((address_space(3))) const char* lds_cptr;
typedef short v4i16_t __attribute__((ext_vector_type(4)));
__device__ __forceinline__ void kload8(bf16x8*kf,lds_cptr kp){
  kf[0]=*(const __attribute__((address_space(3))) bf16x8*)(kp);      kf[1]=*(const __attribute__((address_space(3))) bf16x8*)(kp+512);
  kf[2]=*(const __attribute__((address_space(3))) bf16x8*)(kp+2048); kf[3]=*(const __attribute__((address_space(3))) bf16x8*)(kp+2560);
  kf[4]=*(const __attribute__((address_space(3))) bf16x8*)(kp+4096); kf[5]=*(const __attribute__((address_space(3))) bf16x8*)(kp+4608);
  kf[6]=*(const __attribute__((address_space(3))) bf16x8*)(kp+6144); kf[7]=*(const __attribute__((address_space(3))) bf16x8*)(kp+6656);
}
__device__ __forceinline__ void kload2(bf16x8*kf,lds_cptr kp,int j){ kf[2*j]=*(const __attribute__((address_space(3))) bf16x8*)(kp+j*2048); kf[2*j+1]=*(const __attribute__((address_space(3))) bf16x8*)(kp+j*2048+512); }
__device__ __forceinline__ s16x4 vtr(lds_cptr p){ return __builtin_bit_cast(s16x4,__builtin_amdgcn_ds_read_tr16_b64_v4i16((__attribute__((address_space(3))) v4i16_t*)p)); }
__device__ __forceinline__ float rowmax(const f32x16&p0,const f32x16&p1){
  float a=max3f(p0[0],p0[1],p1[0]),b=max3f(p0[2],p0[3],p1[1]);a=max3f(a,p1[2],p1[3]);
  #pragma unroll
  for(int r=4;r<16;r+=4){a=max3f(a,p0[r],p0[r+1]);b=max3f(b,p0[r+2],p0[r+3]);a=max3f(a,p1[r],p1[r+1]);b=max3f(b,p1[r+2],p1[r+3]);}
  const float m=max2f(a,b);
  auto rr=__builtin_amdgcn_permlane32_swap(__float_as_uint(m),__float_as_uint(m),false,false);
  return max2f(__uint_as_float(rr[0]),__uint_as_float(rr[1]));
}
__device__ __forceinline__ void pv(f32x16*o,int vb,bf16x8 pa0,bf16x8 pa1,bf16x8 pa2,bf16x8 pa3){
  #pragma unroll
  for(int d0=0;d0<2;++d0){s16x4 lo[4],hi[4];
    #pragma unroll
    for(int ks=0;ks<4;++ks){
      asm volatile("ds_read_b64_tr_b16 %0,%1 offset:%c2":"=&v"(lo[ks]):"v"(vb),"i"(d0*4096+ks*1024):"memory");
      asm volatile("ds_read_b64_tr_b16 %0,%1 offset:%c2":"=&v"(hi[ks]):"v"(vb),"i"(d0*4096+ks*1024+512):"memory");}
    asm volatile("s_waitcnt lgkmcnt(0)":::"memory");SBAR();
    #define PK(k) (bf16x8){lo[k][0],lo[k][1],lo[k][2],lo[k][3],hi[k][0],hi[k][1],hi[k][2],hi[k][3]}
    o[d0]=__builtin_amdgcn_mfma_f32_32x32x16_bf16(pa0,PK(0),o[d0],0,0,0);
    o[d0]=__builtin_amdgcn_mfma_f32_32x32x16_bf16(pa1,PK(1),o[d0],0,0,0);
    o[d0]=__builtin_amdgcn_mfma_f32_32x32x16_bf16(pa2,PK(2),o[d0],0,0,0);
    o[d0]=__builtin_amdgcn_mfma_f32_32x32x16_bf16(pa3,PK(3),o[d0],0,0,0);
    #undef PK
  }
}

#ifndef ATTN_STORE16
#define ATTN_STORE16(p,v) (*(u32x4*)(p)=(v))
#endif
template<int THRL> __device__ __forceinline__ void attn_unit(int b,int h,int qb,const bf16*Q,const bf16*__restrict__ K,const bf16*__restrict__ V,bf16*O,char*shm,const float nshift){
  const int tid=threadIdx.x,lane=tid&63,r32=lane&31,hi=lane>>5; const int wid=__builtin_amdgcn_readfirstlane(tid>>6);
  const long rowbase=(long)b*SEQ; const int q0=qb*QB;
  const bf16*Qw=Q+(rowbase+q0+wid*QBLK)*QP+h*D;
  const int hk=h/(NHEAD/NKVH); const bf16*Kh=K+(long)(b*NKVH+hk)*SEQ*D,*Vh=V+(long)(b*NKVH+hk)*SEQ*D;
  const unsigned lds0=(unsigned)(uintptr_t)shm;
  float*wsf=(float*)(shm+LDS_WS)+wid*64;
  const bf16*ksrc=Kh+(wid*64+lane)*8;
  const bf16*vsrc=Vh+(wid*64+lane)*8;
  const unsigned kdst=lds0+LDS_K+wid*1024, vdst=lds0+LDS_V+wid*1024;
  #define DMA_K(t,slot) glds16(ksrc+(long)(t)*KVBLK*D,(unsigned)__builtin_amdgcn_readfirstlane(kdst+(slot)))
  #define DMA_V(t,slot) glds16(vsrc+(long)(t)*KVBLK*D,(unsigned)__builtin_amdgcn_readfirstlane(vdst+(slot)))
  const int vb0=(int)(lds0+LDS_V)+((lane>>4)&1)*32+(lane&3)*8+(4*hi+((lane&15)>>2))*64;
  const char*Kbase=shm+LDS_K; bf16x8 kf[8];
  const lds_cptr shm3=(lds_cptr)shm; const lds_cptr kp0=shm3+LDS_K+hi*1024+r32*16; const lds_cptr vp0=shm3+LDS_V+((lane>>4)&1)*32+(lane&3)*8+(4*hi+((lane&15)>>2))*64;
  constexpr int NT=SEQ/KVBLK;
  DMA_K(0,0);DMA_V(0,0);DMA_K(1,SLOTB);
  bf16x8 qr[4];
  #pragma unroll
  for(int d0=0;d0<4;++d0)qr[d0]=*reinterpret_cast<const bf16x8*>(&Qw[(long)r32*QP+d0*16+hi*8]);
  float l_reg=0.f;f32x16 o[2];o[0]=f32x16{};o[1]=f32x16{};f32x16 negm;
  _Pragma("unroll") for(int r=0;r<16;++r)negm[r]=nshift; asm volatile("":"+v"(negm));
  const int qrel=wid*QBLK+r32;
  #define CMASK(P0,P1,t) do{}while(0)
  #define START(P0,P1) do{ _Pragma("unroll") for(int r=0;r<16;++r)P0[r]=__builtin_amdgcn_exp2f(P0[r]); }while(0)
  f32x16 pA0,pA1,pB0,pB1;
  int sl_prev=0,sl_cur=0,sl_next=SLOTB;
  #define ROT() do{sl_prev=sl_cur;sl_cur=sl_next;sl_next=(sl_next==(NSLOT-1)*SLOTB)?0:sl_next+SLOTB;}while(0)
  DMA_K(2,2*SLOTB);
  WAIT_BAR(3);
  qkt(pA0,pA1,Kbase,qr,negm,r32,hi);asm volatile("s_nop 15\n\ts_nop 7":"+v"(pA0),"+v"(pA1));CMASK(pA0,pA1,0);
  START(pA0,pA1);
  _Pragma("unroll") for(int r=0;r<16;++r)pA1[r]=__builtin_amdgcn_exp2f(pA1[r]);
  WAIT_BAR(0);
  DMA_K(3,0);DMA_V(1,SLOTB);
  ROT();
  kload8(kf,kp0+sl_cur);
  WAIT_BAR(2);
  s16x4 vlo[8],vhi[8]; u32x4 pw0,pw1,pw2,pw3;
  #define PKW(P,B) cvtpk_s(P[B],P[B+1])
  #define PAF(k) __builtin_bit_cast(bf16x8,pw##k)
  #define VFR(i) (bf16x8){vlo[i][0],vlo[i][1],vlo[i][2],vlo[i][3],vhi[i][0],vhi[i][1],vhi[i][2],vhi[i][3]}
  #define PIN(x) asm volatile("":"+v"(x))
  #define GAPA(MF,A0,A1,A2,A3,W0,W1,PW) do{ MF; sacc+=A0; sacc+=A1; sacc+=A2; sacc+=A3; PIN(sacc); W0; W1; PIN(PW); SBAR(); }while(0)
  #define EX(v) __builtin_amdgcn_exp2f(v)
  #define GAPB(MF,X,B) do{ MF; X[B]=EX(X[B]); X[B+1]=EX(X[B+1]); X[B+2]=EX(X[B+2]); X[B+3]=EX(X[B+3]); PIN(X); SBAR(); }while(0)
  #define VRD(i) do{ vlo[i]=vtr(vp_+(((i)>>2)*4096+((i)&3)*1024)); vhi[i]=vtr(vp_+(((i)>>2)*4096+((i)&3)*1024+512)); }while(0)
  #define KRD(G,j) do{ if(G){ kload2(kf,kp0+sl_next,j); SBAR(); } }while(0)
  #define STEP(C0,C1,P0,P1,t,GK,GV,GL) do{ SBAR(); \
    const lds_cptr vp_=vp0+sl_prev; \
    VRD(0); SBAR(); float sacc=(P0[0]+P0[1]); \
    GAPA(C0=__builtin_amdgcn_mfma_f32_32x32x16_bf16(kf[0],qr[0],negm,0,0,0), P0[2],P0[3],P0[4],P0[5],     pw0[0]=PKW(P0,0), pw0[1]=PKW(P0,2), pw0); \
    VRD(4); SBAR(); GAPA(C1=__builtin_amdgcn_mfma_f32_32x32x16_bf16(kf[1],qr[0],negm,0,0,0), P0[6],P0[7],P0[8],P0[9],     pw0[2]=PKW(P0,4), pw0[3]=PKW(P0,6), pw0); \
    VRD(1); SBAR(); GAPA(C0=__builtin_amdgcn_mfma_f32_32x32x16_bf16(kf[2],qr[1],C0,0,0,0),   P0[10],P0[11],P0[12],P0[13], pw1[0]=PKW(P0,8), pw1[1]=PKW(P0,10), pw1); \
    VRD(5); SBAR(); GAPA(C1=__builtin_amdgcn_mfma_f32_32x32x16_bf16(kf[3],qr[1],C1,0,0,0),   P0[14],P0[15],P1[0],P1[1],   pw1[2]=PKW(P0,12),pw1[3]=PKW(P0,14), pw1); \
    VRD(2); SBAR(); GAPA(C0=__builtin_amdgcn_mfma_f32_32x32x16_bf16(kf[4],qr[2],C0,0,0,0),   P1[2],P1[3],P1[4],P1[5],     pw2[0]=PKW(P1,0), pw2[1]=PKW(P1,2), pw2); \
    VRD(6); SBAR(); GAPA(C1=__builtin_amdgcn_mfma_f32_32x32x16_bf16(kf[5],qr[2],C1,0,0,0),   P1[6],P1[7],P1[8],P1[9],     pw2[2]=PKW(P1,4), pw2[3]=PKW(P1,6), pw2); \
    VRD(3); SBAR(); GAPA(C0=__builtin_amdgcn_mfma_f32_32x32x16_bf16(kf[6],qr[3],C0,0,0,0),   P1[10],P1[11],P1[12],P1[13], pw3[0]=PKW(P1,8), pw3[1]=PKW(P1,10), pw3); \
    VRD(7); SBAR(); GAPA(C1=__builtin_amdgcn_mfma_f32_32x32x16_bf16(kf[7],qr[3],C1,0,0,0),   P1[14],P1[15],0.f,0.f,       pw3[2]=PKW(P1,12),pw3[3]=PKW(P1,14), pw3); \
    l_reg+=sacc; \
    if(GK){DMA_K((t)+3,sl_cur);} if(GV){DMA_V((t)+1,sl_next);} \
    CMASK(C0,C1,t); \
    SBAR(); \
    GAPB(o[0]=__builtin_amdgcn_mfma_f32_32x32x16_bf16(PAF(0),VFR(0),o[0],0,0,0), C0,0); \
    GAPB(o[1]=__builtin_amdgcn_mfma_f32_32x32x16_bf16(PAF(0),VFR(4),o[1],0,0,0), C0,4); \
    KRD(GL,0); GAPB(o[0]=__builtin_amdgcn_mfma_f32_32x32x16_bf16(PAF(1),VFR(1),o[0],0,0,0), C0,8); \
    KRD(GL,1); GAPB(o[1]=__builtin_amdgcn_mfma_f32_32x32x16_bf16(PAF(1),VFR(5),o[1],0,0,0), C0,12); \
    KRD(GL,2); GAPB(o[0]=__builtin_amdgcn_mfma_f32_32x32x16_bf16(PAF(2),VFR(2),o[0],0,0,0), C1,0); \
    KRD(GL,3); GAPB(o[1]=__builtin_amdgcn_mfma_f32_32x32x16_bf16(PAF(2),VFR(6),o[1],0,0,0), C1,4); \
    GAPB(o[0]=__builtin_amdgcn_mfma_f32_32x32x16_bf16(PAF(3),VFR(3),o[0],0,0,0), C1,8); \
    GAPB(o[1]=__builtin_amdgcn_mfma_f32_32x32x16_bf16(PAF(3),VFR(7),o[1],0,0,0), C1,12); \
    }while(0)
  int t=1;
  #undef CMASK
  #define CMASK(P0,P1,t) do{}while(0)
  for(;t+5<NT;t+=2){
    STEP(pB0,pB1,pA0,pA1,t,true,true,true);     WAIT_BAR(2); ROT();
    STEP(pA0,pA1,pB0,pB1,t+1,true,true,true);   WAIT_BAR(2); ROT();
  }
  #undef CMASK
  #define CMASK(P0,P1,t) do{}while(0)
  #define ENDW(tt) do{ if((tt)+3<NT){WAIT_BAR(2);} else if((tt)+2<NT){WAIT_BAR(1);} else {WAIT_BAR(0);} }while(0)
  for(;t+1<NT;t+=2){
    STEP(pB0,pB1,pA0,pA1,t,(t+3<NT),(t+1<NT),(t+1<NT));       ENDW(t);   ROT();
    STEP(pA0,pA1,pB0,pB1,t+1,(t+4<NT),(t+2<NT),(t+2<NT));     ENDW(t+1); ROT();
  }
  STEP(pB0,pB1,pA0,pA1,NT-1,false,false,false);
  { float sacc=pB0[0]+pB0[1]; _Pragma("unroll") for(int r=2;r<16;++r)sacc+=pB0[r]; _Pragma("unroll") for(int r=0;r<16;++r)sacc+=pB1[r]; l_reg+=sacc;
    pw0=(u32x4){PKW(pB0,0),PKW(pB0,2),PKW(pB0,4),PKW(pB0,6)};pw1=(u32x4){PKW(pB0,8),PKW(pB0,10),PKW(pB0,12),PKW(pB0,14)};pw2=(u32x4){PKW(pB1,0),PKW(pB1,2),PKW(pB1,4),PKW(pB1,6)};pw3=(u32x4){PKW(pB1,8),PKW(pB1,10),PKW(pB1,12),PKW(pB1,14)};
    SBAR(); pv(o,vb0+sl_cur,PAF(0),PAF(1),PAF(2),PAF(3)); }
  #undef PKW
  #undef PAF
  #undef VFR
  #undef PIN
  #undef GAPA
  #undef GAPB
  #undef EX
  #undef VRD
  #undef KRD
  #undef STEP
  #undef ENDW
  {auto rr=__builtin_amdgcn_permlane32_swap(__float_as_uint(l_reg),__float_as_uint(l_reg),false,false);l_reg=__uint_as_float(rr[0])+__uint_as_float(rr[1]);}
  if(hi==0)wsf[32+r32]=l_reg;asm volatile("s_waitcnt lgkmcnt(0)":::"memory");
  float rli[16];
  #pragma unroll
  for(int r=0;r<16;++r)rli[r]=__builtin_amdgcn_rcpf(wsf[32+crow(r,hi)]);
  bf16*Ow=O+(rowbase+q0+wid*QBLK)*OP+h*D;
  { bf16*stg=(bf16*)(shm+LDS_OST)+wid*2048;
    #pragma unroll
    for(int r=0;r<16;++r){const int orow=crow(r,hi);
      #pragma unroll
      for(int d0=0;d0<2;++d0)stg[orow*64+d0*32+r32]=__float2bfloat16(o[d0][r]*rli[r]);}
    asm volatile("s_waitcnt lgkmcnt(0)":::"memory");
    #pragma unroll
    for(int i=0;i<4;++i){const int row=i*8+(lane>>3),ch=lane&7; const u32x4 v=*(const u32x4*)(stg+row*64+ch*8); ATTN_STORE16(Ow+(long)row*OP+ch*8,v);} }
  asm volatile("s_waitcnt lgkmcnt(0)\n\ts_barrier":::"memory");
  #undef DMA_K
  #undef DMA_V
  #undef CMASK
  #undef START
  #undef ROT
}
constexpr int ATTN_LDS_BYTES=LDS_BYTES;
struct AttnTensors { const bf16* Q; const bf16* K; const bf16* V; bf16* O; };
struct AttnUnit { int bh; int qb; };
struct StaticOrder {
  int vcu, G;
  __device__ __forceinline__ explicit StaticOrder(int grid,int block):vcu((grid%8==0)?(block%8)*(grid/8)+block/8:block),G(grid){}
  __device__ __forceinline__ bool next(int i,AttnUnit&u)const{
    const int L=i*G+vcu; if(L>=BATCH*NHEAD*NQB)return false;
    if(G==256){ if(i>=2)return false; const int x=vcu>>5,j=vcu&31; const int b=x>>2,kvh=(x>>1)&1,hq=kvh*4+2*(x&1)+i; u.bh=b*NHEAD+hq; u.qb=j; return true; }
    u.bh=L/NQB; u.qb=L%NQB; return true; }
  __device__ __forceinline__ void a_ready(const AttnUnit&)const{}
  __device__ __forceinline__ void done(const AttnUnit&)const{}
};
template<class Sched,int THRL=8> __device__ __forceinline__ void attn_phase(char*lds,const AttnTensors&T,const Sched&S,const float nshift){
  AttnUnit u;
  for(int i=0;S.next(i,u);++i){ S.a_ready(u); attn_unit<THRL>(u.bh/NHEAD,u.bh%NHEAD,u.qb,T.Q,T.K,T.V,T.O,lds,nshift); S.done(u); }
}
#undef SBAR
#undef WAIT_BAR
}

#include <hip/hip_cooperative_groups.h>
namespace cg = cooperative_groups;
#ifndef MK_PER_PHASE
#define MK_PER_PHASE 0
#endif
constexpr int NWAVES = 8, NTHREADS = 512;
constexpr int NB = 2, SEQ = 8192, DMODEL = 1024, TT = NB * SEQ;
constexpr int NPROJ = 2816;
constexpr int NEXP = 32, FFE = 512;
constexpr float EPS = 1e-6f;
constexpr int N_PHASES = 12;

constexpr size_t MiB = 1u << 20;
constexpr size_t WS_CTL = 0, CTL_ZERO_BYTES = 64 * 1024;
constexpr size_t WS_WOUT = 1 * MiB;
constexpr size_t WS_LIST = 229 * MiB;
constexpr size_t WS_WR = 3 * MiB;
constexpr size_t WS_TOK = 3 * MiB + 256 * 1024;
constexpr size_t WS_GATES = 4 * MiB;
constexpr size_t WS_WIN = 5 * MiB;
constexpr size_t WS_WSI = 3 * MiB + 896 * 1024;
constexpr size_t WS_XSC = 3 * MiB + 912 * 1024;
constexpr size_t WS_A = 11 * MiB;
constexpr size_t WS_XN = WS_A;
constexpr size_t GDN_SH_BYTES = 71680, GDN_D_BYTES = 19456;
constexpr size_t WS_GSH = WS_A;
constexpr size_t WS_GD = WS_A + 1024 * GDN_SH_BYTES;
constexpr size_t WS_X1 = 5 * MiB;
constexpr size_t WS_HID = 69 * MiB;
constexpr size_t WS_XBUF = 109 * MiB;
constexpr size_t WS_B = 157 * MiB;
constexpr size_t WS_QKVA = WS_B;
constexpr size_t WS_QKVB = WS_B + 48 * MiB;
constexpr size_t WS_ZA = WS_B + 72 * MiB;
constexpr size_t WS_OCAT = WS_B;
constexpr size_t WS_WGU0 = 189 * MiB, WS_WGU1 = 245 * MiB; constexpr int WGU_SPLIT = 20;
constexpr size_t WS_WSC = 3 * MiB + 768 * 1024;
constexpr float ACT_CLIP = 6.0f;
constexpr size_t DO_WD0 = 0, DO_WD1 = 56 * MiB; constexpr int WD_SPLIT = 24;
constexpr size_t DO_HN = 24 * MiB;
constexpr size_t WS_END = 269 * MiB;
static_assert(WS_GD + 4096 * GDN_D_BYTES <= WS_B, "GDN records fit region A");
static_assert(WS_X1 + 64 * MiB <= WS_HID && WS_HID + 40928ull * 1024 <= WS_XBUF && WS_XBUF + 40928ull * 2048 <= WS_WGU0, "post-scan map");
static_assert(WS_WGU0 + WGU_SPLIT * MiB <= WS_B + 72 * MiB && WS_WGU1 + (32 - WGU_SPLIT) * MiB <= 269 * MiB, "WGU fragments");
constexpr size_t DO_QR = 0, DO_KR = 16 * MiB, DO_VR = 20 * MiB, DO_OF = 24 * MiB, DO_OB = 40 * MiB;
constexpr int CW_CNT = 2048;
constexpr int CW_NTILE = 128;
constexpr int CW_ETAB = 192;
constexpr int CW_SCANQ = 1024;

constexpr int LDS_BYTES = 160 * 1024;

#define GAS __attribute__((address_space(1)))
#define LAS __attribute__((address_space(3)))
typedef unsigned short bf16;
typedef unsigned v4u __attribute__((ext_vector_type(4)));
typedef unsigned v2u __attribute__((ext_vector_type(2)));
typedef float f32x4 __attribute__((ext_vector_type(4)));
typedef short bf16x8 __attribute__((ext_vector_type(8)));
typedef short s16x4 __attribute__((ext_vector_type(4)));
#define DI __device__ __forceinline__

DI unsigned f2bf(float f) { unsigned u = __builtin_bit_cast(unsigned, f); return (u + 0x7fffu + ((u >> 16) & 1u)) >> 16; }
typedef float f32x2_t __attribute__((ext_vector_type(2))); typedef __bf16 bf16x2_t __attribute__((ext_vector_type(2)));
DI unsigned pk2(float lo, float hi) { f32x2_t v = {lo, hi}; bf16x2_t b = __builtin_convertvector(v, bf16x2_t); return __builtin_bit_cast(unsigned, b); }
DI float bf2f(unsigned short h) { return __builtin_bit_cast(float, (unsigned)h << 16); }
DI float bflo(unsigned w) { return __builtin_bit_cast(float, w << 16); }
DI float bfhi(unsigned w) { return __builtin_bit_cast(float, w & 0xffff0000u); }
DI unsigned q8x4(float a, float b, float c, float d, float sc) {
    const float M = 12582912.f;
    const unsigned ua = __builtin_bit_cast(unsigned, fminf(fmaxf(a * sc, -127.f), 127.f) + M), ub = __builtin_bit_cast(unsigned, fminf(fmaxf(b * sc, -127.f), 127.f) + M);
    const unsigned uc = __builtin_bit_cast(unsigned, fminf(fmaxf(c * sc, -127.f), 127.f) + M), ud = __builtin_bit_cast(unsigned, fminf(fmaxf(d * sc, -127.f), 127.f) + M);
    return (ua & 255u) | ((ub & 255u) << 8) | ((uc & 255u) << 16) | (ud << 24);
}
template <int CTRL> DI float dpp_f(float v) { return __builtin_bit_cast(float, __builtin_amdgcn_update_dpp(0, __builtin_bit_cast(int, v), CTRL, 0xf, 0xf, true)); }
#ifdef NO_DPP
DI float sum16(float v) { v += __shfl_xor(v, 1); v += __shfl_xor(v, 2); v += __shfl_xor(v, 4); v += __shfl_xor(v, 8); return v; }
DI float max16(float v) { v = fmaxf(v, __shfl_xor(v, 1)); v = fmaxf(v, __shfl_xor(v, 2)); v = fmaxf(v, __shfl_xor(v, 4)); v = fmaxf(v, __shfl_xor(v, 8)); return v; }
DI float get_x8(float v) { return __shfl_xor(v, 8); }
#else
DI float sum16(float v) { v += dpp_f<0xB1>(v); v += dpp_f<0x4E>(v); v += dpp_f<0x141>(v); v += dpp_f<0x140>(v); return v; }
DI float max16(float v) { v = fmaxf(v, dpp_f<0xB1>(v)); v = fmaxf(v, dpp_f<0x4E>(v)); v = fmaxf(v, dpp_f<0x141>(v)); v = fmaxf(v, dpp_f<0x140>(v)); return v; }
DI float get_x8(float v) { return dpp_f<0x128>(v); }
#endif
DI float sum_x16(float v) { return v + __shfl_xor(v, 16); }
DI float max_x16(float v) { return fmaxf(v, __shfl_xor(v, 16)); }
DI float sum_x32(float v) { return v + __shfl_xor(v, 32); }
DI float max_x32(float v) { return fmaxf(v, __shfl_xor(v, 32)); }
DI float wave_max(float v) { return max_x32(max_x16(max16(v))); }
DI float act_absmax(const float* nfw, int lane) {
    float m = 0.f;
#pragma unroll
    for (int i = 0; i < 16; ++i) m = fmaxf(m, fabsf(nfw[lane + 64 * i]));
    return ACT_CLIP * wave_max(m);
}
DI float wave_sum(float v) { return sum_x32(sum_x16(sum16(v))); }
DI float siluf(float x) { return x * __builtin_amdgcn_rcpf(1.0f + __expf(-x)); }
DI float sigmoidf_(float x) { return 1.0f / (1.0f + __expf(-x)); }
DI int perm32i(int idx) { return ((idx >> 2) & 3) * 8 + (idx >> 4) * 4 + (idx & 3); }
DI int permcol(int c) { return (c & ~31) + perm32i(c & 31); }
template <class T> DI T opaque(T p) { asm volatile("" : "+v"(p)); return p; }

typedef GAS unsigned gu32;
#define RLX_AGENT __ATOMIC_RELAXED, __HIP_MEMORY_SCOPE_AGENT
constexpr int CW_BAR = 4096;
constexpr int MISC_OFF = LDS_BYTES - 64;
#define XB_TMO      128
#define XB_XCNT(j)  (256  + 64 * (j))
#define XB_XSUB(j)  (1280 + 64 * (j))
#define XB_XGEN(j)  (2304 + 64 * (j))
#define XB_TOP      3328
#define XB_TOPGEN   3392
#define XCD_BAR_WORDS 3456
#define XB_SPIN_CAP (1u << 18)

__device__ __forceinline__ unsigned xb_ld(unsigned* p)              { return __hip_atomic_load(p, __ATOMIC_RELAXED, __HIP_MEMORY_SCOPE_AGENT); }
__device__ __forceinline__ unsigned xb_add(unsigned* p, unsigned v) { return __hip_atomic_fetch_add(p, v, __ATOMIC_RELAXED, __HIP_MEMORY_SCOPE_AGENT); }
__device__ __forceinline__ unsigned xb_xcc_id() { return (unsigned)__builtin_amdgcn_s_getreg((3 << 11) | 20) & 0xFu; }
#define XB_SPIN(cond, bar) do { unsigned _sp = 0; while (cond) { __builtin_amdgcn_s_sleep(1); \
    if ((++_sp & 255u) == 0u) { if (xb_ld(&(bar)[XB_TMO])) break; if (_sp > XB_SPIN_CAP) { atomicAdd(&(bar)[XB_TMO], 1u); break; } } } } while (0)

struct XcdBarrier {
    unsigned* bar; unsigned x;
    volatile LAS unsigned* st;
};

__device__ __forceinline__ XcdBarrier xcd_barrier_post(unsigned* bar, volatile LAS unsigned* st) {
    XcdBarrier b; b.bar = bar; b.x = xb_xcc_id(); b.st = st;
    if (threadIdx.x == 0) (void)xb_add(&bar[XB_XCNT(b.x)], 1u);
    return b;
}
__device__ __forceinline__ void xcd_barrier_complete(unsigned* bar, unsigned x, unsigned& nloc, unsigned& nx) {
    const unsigned G = gridDim.x * gridDim.y * gridDim.z;
    unsigned sum, cnt, mine, sp = 0u;
    for (;;) {
        sum = 0u; cnt = 0u; mine = 0u;
#pragma unroll
        for (unsigned j = 0; j < 16; ++j) { const unsigned c = xb_ld(&bar[XB_XCNT(j)]); sum += c; cnt += (c > 0u) ? 1u : 0u; mine = (j == x) ? c : mine; }
        if (sum == G) break;
        __builtin_amdgcn_s_sleep(1);
        if ((++sp & 255u) == 0u) { if (xb_ld(&bar[XB_TMO])) break; if (sp > XB_SPIN_CAP) { atomicAdd(&bar[XB_TMO], 1u); break; } }
    }
    nloc = mine > 0u ? mine : 1u; nx = cnt > 0u ? cnt : 1u;
}

__device__ __forceinline__ void xcd_barrier(const XcdBarrier& b) {
    asm volatile("s_waitcnt vmcnt(0)" ::: "memory");
    __syncthreads();
    if (threadIdx.x == 0) {
        unsigned* bar = b.bar;
        __builtin_amdgcn_s_waitcnt(0);
        unsigned nloc = b.st[0], nx = b.st[1];
        if (nloc == 0u) { xcd_barrier_complete(bar, b.x, nloc, nx); b.st[0] = nloc; b.st[1] = nx; }
        const unsigned old = xb_add(&bar[XB_XSUB(b.x)], 1u);
        const unsigned gen = old / nloc;
        if (old + 1u == (gen + 1u) * nloc) {
            __builtin_amdgcn_fence(__ATOMIC_RELEASE, "agent");
            asm volatile("s_waitcnt vmcnt(0)" ::: "memory");
            const unsigned og = xb_add(&bar[XB_TOP], 1u);
            const unsigned tg = og / nx;
            if (og + 1u == (tg + 1u) * nx) xb_add(&bar[XB_TOPGEN], 1u);
            else XB_SPIN(xb_ld(&bar[XB_TOPGEN]) == tg, bar);
            __builtin_amdgcn_fence(__ATOMIC_ACQUIRE, "agent");
            xb_add(&bar[XB_XGEN(b.x)], 1u);
            asm volatile("s_waitcnt vmcnt(0)" ::: "memory");
        } else {
            XB_SPIN(xb_ld(&bar[XB_XGEN(b.x)]) == gen, bar);
            __builtin_amdgcn_fence(__ATOMIC_ACQUIRE, "agent");
            asm volatile("s_waitcnt vmcnt(0)" ::: "memory");
        }
    }
    __syncthreads();
}

struct Frame {
    LAS unsigned char* lds;
    int tid, lane, wave, vcu, G;
    const float* in[17];
    float* out; unsigned char* ws;
};

DI void p0_transpose_item(const float* W, int ldw, int nblk, bf16* WT, int K, int row_off, int rmul, LAS float* scr, int item, int lane) {
    const int kb = item / nblk, nb = item % nblk, k0 = 64 * kb, n0 = 32 * nb;
    const int r8 = lane >> 3, c4 = (lane & 7) * 4;
    f32x4 v[8];
#pragma unroll
    for (int i = 0; i < 8; ++i) v[i] = __builtin_nontemporal_load((const f32x4*)(W + (size_t)(k0 + 8 * i + r8) * ldw + n0 + c4));
#pragma unroll
    for (int i = 0; i < 8; ++i) { LAS float* d = scr + (8 * i + r8) * 33 + c4; d[0] = v[i].x; d[1] = v[i].y; d[2] = v[i].z; d[3] = v[i].w; }
    asm volatile("s_waitcnt lgkmcnt(0)" ::: "memory");
    const int c = lane & 7;
#pragma unroll
    for (int j = 0; j < 4; ++j) { const int n = (lane >> 3) + 8 * j; const LAS float* s = scr + (8 * c) * 33 + n;
        v4u o; o.x = pk2(s[0 * 33], s[1 * 33]); o.y = pk2(s[2 * 33], s[3 * 33]); o.z = pk2(s[4 * 33], s[5 * 33]); o.w = pk2(s[6 * 33], s[7 * 33]);
        *(GAS v4u*)(WT + (size_t)(row_off + (n0 + n) * rmul) * K + k0 + 8 * c) = o; }
    asm volatile("s_waitcnt lgkmcnt(0)" ::: "memory");
}
template <int NR> DI void rms_rows_to_bf16(const float* const (&xrow)[NR], const float* w, bf16* const (&orow)[NR], int lane) {
    const GAS f32x4* wr = (const GAS f32x4*)w + lane;
    f32x4 v[NR][4];
#pragma unroll
    for (int r = 0; r < NR; ++r) { const GAS f32x4* xr = (const GAS f32x4*)xrow[r] + lane;
#pragma unroll
        for (int j = 0; j < 4; ++j) v[r][j] = xr[64 * j]; }
    f32x4 ww[4];
#pragma unroll
    for (int j = 0; j < 4; ++j) ww[j] = wr[64 * j];
#pragma unroll
    for (int r = 0; r < NR; ++r) {
        float s_ = 0.f;
#pragma unroll
        for (int j = 0; j < 4; ++j) s_ += (v[r][j].x * v[r][j].x + v[r][j].y * v[r][j].y) + (v[r][j].z * v[r][j].z + v[r][j].w * v[r][j].w);
        const float rs = __builtin_amdgcn_rsqf(wave_sum(s_) * (1.f / DMODEL) + EPS);
        GAS v2u* o8 = (GAS v2u*)orow[r] + lane;
#pragma unroll
        for (int j = 0; j < 4; ++j) { v2u o; o.x = pk2(v[r][j].x * rs * ww[j].x, v[r][j].y * rs * ww[j].y); o.y = pk2(v[r][j].z * rs * ww[j].z, v[r][j].w * rs * ww[j].w); o8[64 * j] = o; }
    }
}
DI void q_strip(const float* W, int ldw, int n0, unsigned char* WQ, float* wsc, int rowbase, int rmul, LAS unsigned char* lds, int wave, int lane) {
    LAS float* scr = (LAS float*)(lds + wave * 8704); LAS float* cmx = (LAS float*)(lds + 8 * 8704);
    const int r8 = lane >> 3, c4 = (lane & 7) * 4, kw = 128 * wave;
    f32x4 mx = (f32x4){0.f, 0.f, 0.f, 0.f};
#pragma unroll
    for (int i = 0; i < 16; ++i) { const f32x4 v = *(const f32x4*)(W + (size_t)(kw + 8 * i + r8) * ldw + n0 + c4);
        mx.x = fmaxf(mx.x, fabsf(v.x)); mx.y = fmaxf(mx.y, fabsf(v.y)); mx.z = fmaxf(mx.z, fabsf(v.z)); mx.w = fmaxf(mx.w, fabsf(v.w)); }
    mx.x = max_x32(max_x16(fmaxf(mx.x, get_x8(mx.x)))); mx.y = max_x32(max_x16(fmaxf(mx.y, get_x8(mx.y))));
    mx.z = max_x32(max_x16(fmaxf(mx.z, get_x8(mx.z)))); mx.w = max_x32(max_x16(fmaxf(mx.w, get_x8(mx.w))));
    if (lane < 8) *(LAS f32x4*)(cmx + wave * 32 + c4) = mx;
    __syncthreads();
    float sq[4];
#pragma unroll
    for (int j = 0; j < 4; ++j) { const int n = (lane >> 3) + 8 * j; float m = cmx[n];
#pragma unroll
        for (int w = 1; w < 8; ++w) m = fmaxf(m, cmx[w * 32 + n]);
        sq[j] = m > 0.f ? 127.0f / m : 0.f;
        if (wave == 0 && (lane & 7) == 0) wsc[rowbase + n * rmul] = m * (1.0f / 127.0f); }
    const int c = lane & 7;
#pragma unroll
    for (int kb = 0; kb < 2; ++kb) {
        const int k0 = kw + 64 * kb;
        f32x4 v[8];
#pragma unroll
        for (int i = 0; i < 8; ++i) v[i] = *(const f32x4*)(W + (size_t)(k0 + 8 * i + r8) * ldw + n0 + c4);
#pragma unroll
        for (int i = 0; i < 8; ++i) { LAS float* d = scr + (8 * i + r8) * 33 + c4; d[0] = v[i].x; d[1] = v[i].y; d[2] = v[i].z; d[3] = v[i].w; }
        asm volatile("s_waitcnt lgkmcnt(0)" ::: "memory");
#pragma unroll
        for (int j = 0; j < 4; ++j) { const int n = (lane >> 3) + 8 * j; const LAS float* t = scr + (8 * c) * 33 + n;
            v2u o; o.x = q8x4(t[0 * 33], t[1 * 33], t[2 * 33], t[3 * 33], sq[j]); o.y = q8x4(t[4 * 33], t[5 * 33], t[6 * 33], t[7 * 33], sq[j]);
            *(GAS v2u*)(WQ + (size_t)(rowbase + n * rmul) * 1024 + k0 + 8 * c) = o; }
        asm volatile("s_waitcnt lgkmcnt(0)" ::: "memory");
    }
    __syncthreads();
}
DI float reduce16(const float (&ga)[16], int lane) {
    float gb[8], gc[4];
    const bool h32 = (lane & 32) != 0, h16 = (lane & 16) != 0;
#pragma unroll
    for (int i = 0; i < 8; ++i) { const float lo = sum_x32(ga[i]), hi = sum_x32(ga[i + 8]); gb[i] = h32 ? hi : lo; }
#pragma unroll
    for (int i = 0; i < 4; ++i) { const float lo = sum_x16(gb[i]), hi = sum_x16(gb[i + 4]); gc[i] = h16 ? hi : lo; }
    float res = 0.f;
#pragma unroll
    for (int i = 0; i < 4; ++i) { const float t = sum16(gc[i]); res = ((lane & 3) == i) ? t : res; }
    return res;
}
DI void rms_rows_to_q8(const float* const (&xrow)[2], const float* w, unsigned char* const (&orow)[2], float* const (&xsc)[2], float* const (&gout)[2], const LAS float* gw_, int lane) {
    const LAS float* gw = gw_;
    gw = opaque(gw);
    const GAS f32x4* wr = (const GAS f32x4*)w + lane;
    f32x4 v[2][4];
#pragma unroll
    for (int r = 0; r < 2; ++r) { const GAS f32x4* xr = (const GAS f32x4*)xrow[r] + lane;
#pragma unroll
        for (int j = 0; j < 4; ++j) v[r][j] = xr[64 * j]; }
    f32x4 ww[4];
#pragma unroll
    for (int j = 0; j < 4; ++j) ww[j] = wr[64 * j];
#pragma unroll
    for (int r = 0; r < 2; ++r) {
        float s_ = 0.f;
#pragma unroll
        for (int j = 0; j < 4; ++j) s_ += (v[r][j].x * v[r][j].x + v[r][j].y * v[r][j].y) + (v[r][j].z * v[r][j].z + v[r][j].w * v[r][j].w);
        const float rs = __builtin_amdgcn_rsqf(wave_sum(s_) * (1.f / DMODEL) + EPS);
        float am = 0.f;
#pragma unroll
        for (int j = 0; j < 4; ++j) { v[r][j] = v[r][j] * ww[j] * rs; am = fmaxf(fmaxf(am, fmaxf(fabsf(v[r][j].x), fabsf(v[r][j].y))), fmaxf(fabsf(v[r][j].z), fabsf(v[r][j].w))); }
        am = wave_max(am);
        const float qsc = am > 0.f ? 127.0f / am : 0.f;
        if (lane == 0) *xsc[r] = am * (1.0f / 127.0f);
        GAS unsigned* o4 = (GAS unsigned*)orow[r] + lane;
#pragma unroll
        for (int j = 0; j < 4; ++j) o4[64 * j] = q8x4(v[r][j].x, v[r][j].y, v[r][j].z, v[r][j].w, qsc);
    }
#ifndef NO_GATES
    float ga[2][16];
#pragma unroll
    for (int c = 0; c < 16; ++c) { ga[0][c] = 0.f; ga[1][c] = 0.f; }
    asm volatile("" : "+v"(v[0][0]), "+v"(v[0][1]), "+v"(v[0][2]), "+v"(v[0][3]), "+v"(v[1][0]), "+v"(v[1][1]), "+v"(v[1][2]), "+v"(v[1][3]));
#pragma unroll
    for (int j = 0; j < 4; ++j)
#pragma unroll
        for (int q = 0; q < 4; ++q) { const LAS f32x4* g4 = (const LAS f32x4*)gw + ((j * 4 + q) * 4) * 64 + lane;
            const f32x4 g0 = g4[0], g1 = g4[64], g2 = g4[128], g3 = g4[192];
#pragma unroll
            for (int r = 0; r < 2; ++r) { const float h = v[r][j][q];
                ga[r][0] += h * g0.x; ga[r][1] += h * g0.y; ga[r][2] += h * g0.z; ga[r][3] += h * g0.w; ga[r][4] += h * g1.x; ga[r][5] += h * g1.y; ga[r][6] += h * g1.z; ga[r][7] += h * g1.w;
                ga[r][8] += h * g2.x; ga[r][9] += h * g2.y; ga[r][10] += h * g2.z; ga[r][11] += h * g2.w; ga[r][12] += h * g3.x; ga[r][13] += h * g3.y; ga[r][14] += h * g3.z; ga[r][15] += h * g3.w; }
            asm volatile("" : "+v"(ga[1][0]), "+v"(ga[1][1]), "+v"(ga[1][2]), "+v"(ga[1][3]), "+v"(ga[1][4]), "+v"(ga[1][5]), "+v"(ga[1][6]), "+v"(ga[1][7]), "+v"(ga[1][8]), "+v"(ga[1][9]),
                         "+v"(ga[1][10]), "+v"(ga[1][11]), "+v"(ga[1][12]), "+v"(ga[1][13]), "+v"(ga[1][14]), "+v"(ga[1][15]) :: "memory"); }
    const int gc_ = 4 * (lane >> 4) + (lane & 3);
#pragma unroll
    for (int r = 0; r < 2; ++r) { const float res = reduce16(ga[r], lane); if ((lane & 12) == 0) gout[r][gc_] = res; }
#endif
}
DI void p0_prologue(Frame& F) {
    const float* w_in = F.in[2];
    unsigned char* WIN = F.ws + WS_WIN; float* WSI = (float*)(F.ws + WS_WSI);
    constexpr int NSTRIP = 64 + 24;
    if (F.vcu < NSTRIP) { const int st = F.vcu;
        if (st < 64) q_strip(w_in, 2832, 32 * st, WIN, WSI, 32 * st, 1, F.lds, F.wave, F.lane);
        else q_strip(w_in + 2064, 2832, 32 * (st - 64), WIN, WSI, 2048 + 32 * (st - 64), 1, F.lds, F.wave, F.lane); }
    unsigned char* XN = F.ws + WS_XN; float* XSC = (float*)(F.ws + WS_XSC); float* GATES = (float*)(F.ws + WS_GATES);
    LAS float* gw = (LAS float*)(F.lds + 73728);
    for (int i = F.tid; i < 1024 * 4; i += NTHREADS) { const int k = i >> 2, c4 = i & 3, jj = k >> 8, qq = k & 3, ln = (k & 255) >> 2;
        *((LAS f32x4*)gw + ((jj * 4 + qq) * 4 + c4) * 64 + ln) = *(const f32x4*)(w_in + (size_t)k * 2832 + 2048 + c4 * 4); }
    __syncthreads();
    const int nst = (F.G < NSTRIP ? F.G : NSTRIP), NSLOT = nst * NWAVES + (F.G - nst) * NWAVES * 2;
    const int s0_ = (F.vcu < nst) ? F.vcu * NWAVES + F.wave : nst * NWAVES + ((F.vcu - nst) * NWAVES + F.wave) * 2, nmine = (F.vcu < nst) ? 1 : 2;
#pragma unroll 1
    for (int q = 0; q < nmine; ++q)
#pragma unroll 1
        for (int p = s0_ + q; p < TT / 2; p += NSLOT) { const int m = 2 * p;
            const float* const xr[2] = {F.in[0] + (size_t)m * DMODEL, F.in[0] + (size_t)(m + 1) * DMODEL}; unsigned char* const orw[2] = {XN + (size_t)m * DMODEL, XN + (size_t)(m + 1) * DMODEL};
            float* const xs[2] = {XSC + m, XSC + m + 1}; float* const go[2] = {GATES + (size_t)m * 16, GATES + (size_t)(m + 1) * 16};
            rms_rows_to_q8(xr, F.in[1], orw, xs, go, gw, F.lane); }
}

struct EpiProj {
    static constexpr bool PERM = true, AFTER_DRAIN = false;
    bf16 *qkva, *za, *qkvb; const float* wsi; const float* xsc;
    DI void operator()(const pg8::i32x4 (&acc)[2][2][4][2], const pg8::Unit& u, int wr, int wc, int fr, int fq) const {
        const int row0 = u.pm * 256 + wr * 64 + fr;
        const float* ws_ = wsi + u.pn * 256 + wc * 32 + 8 * fq;
        bf16* base; int ldc, colt;
        if (u.pn < 6) { base = qkva; ldc = 1536; colt = u.pn * 256; } else if (u.pn < 8) { base = za; ldc = 512; colt = (u.pn - 6) * 256; } else { base = qkvb; ldc = 768; colt = (u.pn - 8) * 256; }
        const int col0 = colt + wc * 32 + 8 * fq;
        f32x4 s0[2], s1[2];
#pragma unroll
        for (int bj = 0; bj < 2; ++bj) { s0[bj] = *(const f32x4*)(ws_ + bj * 128); s1[bj] = *(const f32x4*)(ws_ + bj * 128 + 4); }
        float rsc[2][4];
#pragma unroll
        for (int ai = 0; ai < 2; ++ai)
#pragma unroll
            for (int m = 0; m < 4; ++m) rsc[ai][m] = xsc[row0 + ai * 128 + m * 16];
#pragma unroll
        for (int ai = 0; ai < 2; ++ai)
#pragma unroll
            for (int m = 0; m < 4; ++m) { bf16* rowp = base + (size_t)(row0 + ai * 128 + m * 16) * ldc + col0; const float rr = rsc[ai][m];
#pragma unroll
                for (int bj = 0; bj < 2; ++bj) { const pg8::i32x4 a0 = acc[ai][bj][m][0], a1 = acc[ai][bj][m][1]; const f32x4 t0 = s0[bj] * rr, t1 = s1[bj] * rr; pg8::u32x4 w;
                    w.x = pg8::cvt_pk_bf16((float)a0[0] * t0[0], (float)a0[1] * t0[1]); w.y = pg8::cvt_pk_bf16((float)a0[2] * t0[2], (float)a0[3] * t0[3]);
                    w.z = pg8::cvt_pk_bf16((float)a1[0] * t1[0], (float)a1[1] * t1[1]); w.w = pg8::cvt_pk_bf16((float)a1[2] * t1[2], (float)a1[3] * t1[3]);
                    *(pg8::u32x4*)(rowp + bj * 128) = w; } }
    }
};
struct IdRows { DI int row(const pg8::Unit& u, int r) const { return u.pm * 256 + r; } };
struct EpiResid {
    static constexpr bool PERM = true, AFTER_DRAIN = false;
    const float* x; bf16* x1;
    DI void operator()(const pg8::f32x4 (&acc)[2][2][4][2], const pg8::Unit& u, int wr, int wc, int fr, int fq) const {
        const int row0 = u.pm * 256 + wr * 64 + fr, col0 = u.pn * 256 + wc * 32 + 8 * fq;
#pragma unroll
        for (int ai = 0; ai < 2; ++ai)
#pragma unroll
            for (int m = 0; m < 4; ++m) { const size_t off = (size_t)(row0 + ai * 128 + m * 16) * DMODEL + col0;
#pragma unroll
                for (int bj = 0; bj < 2; ++bj) { const pg8::f32x4 v0 = *(const pg8::f32x4*)(x + off + bj * 128) + acc[ai][bj][m][0], v1 = *(const pg8::f32x4*)(x + off + bj * 128 + 4) + acc[ai][bj][m][1]; pg8::u32x4 w;
                    w.x = pg8::cvt_pk_bf16(v0[0], v0[1]); w.y = pg8::cvt_pk_bf16(v0[2], v0[3]); w.z = pg8::cvt_pk_bf16(v1[0], v1[1]); w.w = pg8::cvt_pk_bf16(v1[2], v1[3]);
                    *(pg8::u32x4*)(x1 + off + bj * 128) = w; } }
    }
};
struct EpiGU {
    static constexpr bool PERM = true, AFTER_DRAIN = false;
    bf16* hid; const float* wsc; float ainv;
    DI void operator()(const pg8::i32x4 (&acc)[2][2][4][2], const pg8::Unit& u, int wr, int wc, int fr, int fq) const {
        const int row0 = u.pm * 256 + wr * 64 + fr; const int jt = u.pn & 3;
        const int ff0 = jt * 128 + wc * 16 + 4 * fq;
        const float* ws_ = wsc + u.ex * 1024 + jt * 256 + wc * 32 + 8 * fq;
        f32x4 s0[2], s1[2];
#pragma unroll
        for (int bj = 0; bj < 2; ++bj) { s0[bj] = *(const f32x4*)(ws_ + bj * 128) * ainv; s1[bj] = *(const f32x4*)(ws_ + bj * 128 + 4) * ainv; }
#pragma unroll
        for (int ai = 0; ai < 2; ++ai)
#pragma unroll
            for (int m = 0; m < 4; ++m) { bf16* rowp = hid + (size_t)(row0 + ai * 128 + m * 16) * FFE + ff0;
#pragma unroll
                for (int bj = 0; bj < 2; ++bj) { const pg8::i32x4 a0 = acc[ai][bj][m][0], a1 = acc[ai][bj][m][1];
                    const float g0 = (float)a0[0] * s0[bj][0], u0 = (float)a0[1] * s0[bj][1], g1 = (float)a0[2] * s0[bj][2], u1 = (float)a0[3] * s0[bj][3];
                    const float g2 = (float)a1[0] * s1[bj][0], u2 = (float)a1[1] * s1[bj][1], g3 = (float)a1[2] * s1[bj][2], u3 = (float)a1[3] * s1[bj][3];
                    v2u w; w.x = pg8::cvt_pk_bf16(siluf(g0) * u0, siluf(g1) * u1); w.y = pg8::cvt_pk_bf16(siluf(g2) * u2, siluf(g3) * u3);
                    *(v2u*)(rowp + bj * 64) = w; } }
    }
};
struct EpiY {
    static constexpr bool PERM = true, AFTER_DRAIN = false;
    bf16* y;
    DI void operator()(const pg8::f32x4 (&acc)[2][2][4][2], const pg8::Unit& u, int wr, int wc, int fr, int fq) const {
        const int row0 = u.pm * 256 + wr * 64 + fr; const int col0 = (u.pn & 3) * 256 + wc * 32 + 8 * fq;
#pragma unroll
        for (int ai = 0; ai < 2; ++ai)
#pragma unroll
            for (int m = 0; m < 4; ++m) { bf16* rowp = y + (size_t)(row0 + ai * 128 + m * 16) * DMODEL + col0;
#pragma unroll
                for (int bj = 0; bj < 2; ++bj) { const pg8::f32x4 v0 = acc[ai][bj][m][0], v1 = acc[ai][bj][m][1]; pg8::u32x4 w;
                    w.x = pg8::cvt_pk_bf16(v0[0], v0[1]); w.y = pg8::cvt_pk_bf16(v0[2], v0[3]); w.z = pg8::cvt_pk_bf16(v1[0], v1[1]); w.w = pg8::cvt_pk_bf16(v1[2], v1[3]);
                    *(pg8::u32x4*)(rowp + bj * 128) = w; } }
    }
};
constexpr int ETAB_OFF = 131072;
struct MoeOrder {
    const LAS unsigned* etab; int G, c, esplit, pnoff;
    DI bool next(int i, pg8::Unit& u) const {
        if (G % 8 != 0) {
            int L = i * G + c;
            for (int e = 0; e < NEXP; ++e) { const int n4 = 4 * (int)etab[2 * e + 1]; if (L < n4) { u.pm = (int)etab[2 * e] + (L >> 2); u.pn = (e < esplit ? 4 * e : pnoff + 4 * (e - esplit)) + (L & 3); u.ex = e; u.tq = L >> 2; return true; } L -= n4; }
            return false; }
        const int x = c & 7; int L = i * (G >> 3) + (c >> 3);
#pragma unroll
        for (int q = 0; q < NEXP / 8; ++q) { const int e = x + 8 * q; const int n4 = 4 * (int)etab[2 * e + 1];
            if (L < n4) { u.pm = (int)etab[2 * e] + (L >> 2); u.pn = (e < esplit ? 4 * e : pnoff + 4 * (e - esplit)) + (L & 3); u.ex = e; u.tq = L >> 2; return true; } L -= n4; }
        return false; }
    DI void a_ready(const pg8::Unit&) const {}
    DI void done(const pg8::Unit&) const {}
};
struct MoeRows {
    const int* list; const LAS unsigned* etab;
    DI int row(const pg8::Unit& u, int r) const {
        const int slot = u.tq * 256 + r, e = u.ex; if (slot >= (int)etab[64 + e]) return 0;
        const LAS unsigned* sp = etab + 96 + 8 * e; int sb = 0;
#pragma unroll
        for (int q = 1; q < 8; ++q) sb += (slot >= (int)sp[q]) ? 1 : 0;
        return list[(size_t)(e * 8 + sb) * TT + (slot - (int)sp[sb])]; }
};

DI void p2_rope(Frame& F) {
    const int gw = F.vcu * NWAVES + F.wave, NGW = F.G * NWAVES, lane = F.lane;
    const bf16* QKVB = (const bf16*)(F.ws + WS_QKVB);
    bf16* QR = (bf16*)((unsigned char*)F.out + DO_QR); bf16* KR = (bf16*)((unsigned char*)F.out + DO_KR); bf16* VR = (bf16*)((unsigned char*)F.out + DO_VR);
    const int pi = lane & 31, hsel = lane >> 5;
    const float qw0 = F.in[7][2 * pi], qw1 = F.in[7][2 * pi + 1], kw0 = F.in[8][2 * pi], kw1 = F.in[8][2 * pi + 1];
    const float invf = exp2f(-(float)(2 * (pi & 15)) * (13.287712379549449f / 32.0f));
    constexpr float C2 = 0.125f * 1.4426950408889634f;
    constexpr int NB4 = 4;
    for (int t0 = gw; t0 < TT; t0 += NB4 * NGW) {
        unsigned w[NB4][5], vw[NB4];
#pragma unroll
        for (int u = 0; u < NB4; ++u) { const int t = t0 + u * NGW; const unsigned* src = (const unsigned*)(QKVB + (size_t)(t < TT ? t : t0) * 768);
#pragma unroll
            for (int j = 0; j < 5; ++j) w[u][j] = src[(2 * j + hsel) * 32 + pi];
            vw[u] = src[320 + lane]; }
#pragma unroll
        for (int u = 0; u < NB4; ++u) {
            const int t = t0 + u * NGW; if (t >= TT) break;
            const int s_ = t & (SEQ - 1); const float pos = (pi < 16) ? (float)(s_ >> 6) : (float)(s_ & 63);
            const float ang = pos * invf;
            const float rev = ang * 0.15915494309189535f;
            const float sn = __builtin_amdgcn_sinf(rev), cs = __builtin_amdgcn_cosf(rev);
#pragma unroll
            for (int j = 0; j < 5; ++j) {
                const int head = 2 * j + hsel;
                const float x0 = bflo(w[u][j]), x1 = bfhi(w[u][j]);
                float ss = x0 * x0 + x1 * x1;
                ss = sum_x16(sum16(ss));
                const float rs = __builtin_amdgcn_rsqf(ss * (1.f / 64.f) + EPS);
                const bool isq = head < 8;
                const float y0 = x0 * rs * (isq ? qw0 : kw0), y1 = x1 * rs * (isq ? qw1 : kw1);
                float o0 = y0 * cs - y1 * sn, o1 = y0 * sn + y1 * cs;
                if (isq) { o0 *= C2; o1 *= C2; ((unsigned*)(QR + (size_t)t * 512))[head * 32 + pi] = pk2(o0, o1); }
                else { const int hk = head - 8, bq = t >> 13, sq = t & (SEQ - 1);
                    ((unsigned*)(KR + ((size_t)((bq * 2 + hk) * 128 + (sq >> 6)) * 8 + (pi >> 2)) * 512 + (sq & 63) * 8))[pi & 3] = pk2(o0, o1); }
            }
            { const int hk = lane >> 5, d = 2 * (lane & 31), bq = t >> 13, sq = t & (SEQ - 1), r = sq & 63;
              ((unsigned*)(VR + ((size_t)((bq * 2 + hk) * 128 + (sq >> 6)) * 8 + (d >> 5) * 4 + (r >> 4)) * 512 + ((r & 15) * 4 + ((d & 31) >> 3)) * 8))[(d & 7) >> 1] = vw[u]; }
        }
    }
}

constexpr int G_KNP = 0, G_QNP = 17408, G_KNTP = 34816, G_VCT = 53248;
constexpr int G_D0 = 71680, G_D1 = 71680 + 19456;
constexpr int GD_TBP = 0, GD_AP = 9216, GD_VEC = 18432;
constexpr int G_LM = 110592;
constexpr int G_GV = G_LM + 32768;
static_assert(G_GV + 2048 <= LDS_BYTES - 64, "gdn pre lds");

#define TRI_ROW(i, LC, LN) { \
        if ((i) + 1 < 64) { _Pragma("unroll") for (int j4 = 0; j4 < ((i) + 1 + 3) / 4 && j4 < 8; ++j4) LN[j4] = *(const LAS f32x4*)(L + ((i) + 1) * 64 + 4 * j4); } \
        _Pragma("unroll") for (int j4 = 8; j4 < ((i) + 3) / 4; ++j4) lt[j4 - 8] = *(const LAS f32x4*)(L + (i) * 64 + 4 * j4); \
        __builtin_amdgcn_sched_barrier(0); \
        f32x2_t a0 = {(lane == (i)) ? 1.0f : 0.0f, 0.f}, a1 = {0.f, 0.f}; \
        _Pragma("unroll") for (int j4 = 0; j4 < ((i) + 3) / 4; ++j4) { const f32x4 l = (j4 < 8) ? LC[j4 & 7] : lt[(j4 - 8) & 7]; \
            f32x2_t l0 = {l.x, (4 * j4 + 1 < (i)) ? l.y : 0.f}, l1 = {(4 * j4 + 2 < (i)) ? l.z : 0.f, (4 * j4 + 3 < (i)) ? l.w : 0.f}; \
            a0 -= l0 * xp[2 * j4]; if (4 * j4 + 2 < (i)) a1 -= l1 * xp[2 * j4 + 1]; } \
        const float a = (a0.x + a0.y) + (a1.x + a1.y); \
        if ((i) & 1) xp[(i) >> 1].y = a; else { xp[(i) >> 1].x = a; xp[(i) >> 1].y = 0.f; } \
        TBP[(REV ? 63 - (i) : (i)) * 72 + pc] = (bf16)(pk2(a * bcol, 0.f) & 0xffffu); \
        __builtin_amdgcn_sched_barrier(0); }
template <bool REV> DI void tri_inverse(LAS float* L, const LAS float* beta, LAS bf16* TBP, int lane) {
    f32x2_t xp[32];
    L = opaque(L); TBP = opaque(TBP); lane = opaque(lane);
    const float bcol = REV ? beta[63 - lane] : beta[lane];
    const int pc = REV ? permcol(63 - lane) : permcol(lane);
    f32x4 la[8], lb[8], lt[8];
#pragma unroll
    for (int ii = 0; ii < 64; ii += 2) { TRI_ROW(ii, la, lb) TRI_ROW(ii + 1, lb, la) }
}
#undef TRI_ROW

DI void gdn_conv(Frame& F, LAS unsigned char* lds, int t384, int b, int h, int n) {
    const bf16* QKVA = (const bf16*)(F.ws + WS_QKVA); const float* convw = F.in[3];
    const int cgp = t384 % 48, rg = t384 / 48, mat = cgp >> 4, cc = (cgp & 15) * 8;
    const int col = mat * 512 + h * 128 + cc;
    float w[5][8];
#pragma unroll
    for (int j = 0; j < 5; ++j) { const f32x4 a = *(const f32x4*)(convw + j * 1536 + col), bq = *(const f32x4*)(convw + j * 1536 + col + 4);
        w[j][0] = a.x; w[j][1] = a.y; w[j][2] = a.z; w[j][3] = a.w; w[j][4] = bq.x; w[j][5] = bq.y; w[j][6] = bq.z; w[j][7] = bq.w; }
    const int a4 = (cc >> 3) & 3, p0 = (cc & ~31) + 16 * (a4 & 1) + 4 * (a4 >> 1);
    const int ra = rg & 3, q0 = (rg >> 2) * 32 + 16 * (ra & 1) + 4 * (ra >> 1);
#pragma unroll
    for (int hf = 0; hf < 2; ++hf) {
        float o[4][8];
#pragma unroll
        for (int r = 0; r < 4; ++r)
#pragma unroll
            for (int c = 0; c < 8; ++c) o[r][c] = 0.f;
#pragma unroll
        for (int i = 0; i < 8; ++i) {
            const int pos = n * 64 + rg * 8 + hf * 4 - 2 + i;
            v4u raw = (v4u){0u, 0u, 0u, 0u};
            if (pos >= 0 && pos < SEQ) raw = *(const v4u*)(QKVA + (size_t)(b * SEQ + pos) * 1536 + col);
            float xin[8] = {bflo(raw.x), bfhi(raw.x), bflo(raw.y), bfhi(raw.y), bflo(raw.z), bfhi(raw.z), bflo(raw.w), bfhi(raw.w)};
#pragma unroll
            for (int j = 0; j < 5; ++j) { const int r = i - j; if (r >= 0 && r < 4) {
#pragma unroll
                for (int c = 0; c < 8; ++c) o[r][c] += w[j][c] * xin[c]; } }
        }
#pragma unroll
        for (int r = 0; r < 4; ++r) {
            float ss = 0.f;
#pragma unroll
            for (int c = 0; c < 8; ++c) { o[r][c] = siluf(o[r][c]); ss += o[r][c] * o[r][c]; }
            ss = sum16(ss);
            float sc = 1.0f;
            if (mat < 2) { sc = __builtin_amdgcn_rsqf(ss + EPS); if (mat == 0) sc *= 0.08838834764831845f; }
#pragma unroll
            for (int c = 0; c < 8; ++c) o[r][c] *= sc;
        }
        if (mat < 2) {
            LAS unsigned char* tile = lds + (mat == 0 ? G_QNP : G_KNP);
#pragma unroll
            for (int r = 0; r < 4; ++r) { const int c = rg * 8 + hf * 4 + r;
                v2u lo, hi2; lo.x = pk2(o[r][0], o[r][1]); lo.y = pk2(o[r][2], o[r][3]); hi2.x = pk2(o[r][4], o[r][5]); hi2.y = pk2(o[r][6], o[r][7]);
                *(LAS v2u*)(tile + c * 272 + p0 * 2) = lo; *(LAS v2u*)(tile + c * 272 + (p0 + 8) * 2) = hi2; }
        }
        if (mat >= 1) {
#pragma unroll
            for (int c = 0; c < 8; ++c) {
                v2u q4; q4.x = pk2(o[0][c], o[1][c]); q4.y = pk2(o[2][c], o[3][c]);
                if (mat == 1) *(LAS v2u*)(lds + G_KNTP + (cc + c) * 144 + (q0 + 8 * hf) * 2) = q4;
                else *(LAS v2u*)(lds + G_VCT + (cc + c) * 144 + rg * 16 + hf * 8) = q4;
            }
        }
    }
}
DI void gdn_gates(Frame& F, LAS unsigned char* lds, LAS float* gv, int lane, int b, int h, int n) {
    const float* gp = (const float*)(F.ws + WS_GATES) + (size_t)(b * SEQ + n * 64 + lane) * 16;
    const float bfv = gp[h], bbv = gp[4 + h], afv = gp[8 + h], abv = gp[12 + h];
    const float betaf = sigmoidf_(bfv), betab = sigmoidf_(bbv);
    const float xf = afv + F.in[5][h], xb = abv + F.in[5][4 + h];
    const float spf = fmaxf(xf, 0.f) + log1pf(__expf(-fabsf(xf))), spb = fmaxf(xb, 0.f) + log1pf(__expf(-fabsf(xb)));
    const float gf = -__expf(F.in[4][h]) * spf, gb = -__expf(F.in[4][4 + h]) * spb;
    float Gf = gf, Rb = gb;
#pragma unroll
    for (int o = 1; o < 64; o <<= 1) { const float u1 = __shfl_up(Gf, o); if (lane >= o) Gf += u1; const float d1 = __shfl_down(Rb, o); if (lane + o < 64) Rb += d1; }
    gv[lane] = Gf; gv[64 + lane] = Rb; gv[128 + lane] = betaf; gv[192 + lane] = betab;
    const float GfL = __shfl(Gf, 63), Rb0 = __shfl(Rb, 0);
    LAS float* v0 = (LAS float*)(lds + G_D0 + GD_VEC); LAS float* v1 = (LAS float*)(lds + G_D1 + GD_VEC);
    v0[lane] = __expf(Gf); v0[64 + lane] = __expf(GfL - Gf); v1[lane] = __expf(Rb); v1[64 + lane] = __expf(Rb0 - Rb);
    if (lane == 0) { v0[128] = __expf(GfL); v1[128] = __expf(Rb0); }
}
DI void p2_gdn_pre(Frame& F) {
    const int tid = F.tid, lane = F.lane, wave = F.wave;
    int task = F.vcu;
    if (task < 1024) {
        LAS unsigned char* lds = opaque(F.lds);
        const int b = task >> 9, h = (task >> 7) & 3, n = task & 127;
        if (wave >= 2) gdn_conv(F, lds, tid - 128, b, h, n);
        if (wave == 2) gdn_gates(F, lds, (LAS float*)(lds + G_GV), lane, b, h, n);
    }
    __syncthreads();
    int par = 0;
#pragma unroll 1
    for (; task < 1024; task += F.G, par ^= 1) {
        LAS unsigned char* lds = opaque(F.lds);
        const int b = task >> 9, h = (task >> 7) & 3, n = task & 127, bh = b * 4 + h;
        LAS float* gv = (LAS float*)(lds + G_GV + par * 1024);
        LAS float* sGf = gv; LAS float* sRb = gv + 64; LAS float* sBf = gv + 128; LAS float* sBb = gv + 192;
        {
            const int p = wave >> 2, mt = wave & 3, n16 = lane & 15, g = lane >> 4;
            const LAS unsigned char* At = lds + (p == 0 ? G_KNP : G_QNP) + (16 * mt + n16) * 272 + g * 16;
            bf16x8 af[4], bfr[16];
#pragma unroll
            for (int ks = 0; ks < 4; ++ks) af[ks] = *(const LAS bf16x8*)(At + ks * 64);
#pragma unroll
            for (int nt = 0; nt < 4; ++nt)
#pragma unroll
                for (int ks = 0; ks < 4; ++ks) bfr[nt * 4 + ks] = *(const LAS bf16x8*)(lds + G_KNP + (16 * nt + n16) * 272 + g * 16 + ks * 64);
            float Gc[4], Rc[4], Bfc[4], Bbc[4];
#pragma unroll
            for (int r = 0; r < 4; ++r) { const int c = 16 * mt + 4 * g + r; Gc[r] = sGf[c]; Rc[r] = sRb[c]; Bfc[r] = sBf[c]; Bbc[r] = sBb[c]; }
#pragma unroll
            for (int nt = 0; nt < 4; ++nt) {
                f32x4 acc = (f32x4){0.f, 0.f, 0.f, 0.f};
#pragma unroll
                for (int ks = 0; ks < 4; ++ks) acc = __builtin_amdgcn_mfma_f32_16x16x32_bf16(af[ks], bfr[nt * 4 + ks], acc, 0, 0, 0);
                const int s_ = 16 * nt + n16; const float Gs = sGf[s_], Rs = sRb[s_]; const int ps = permcol(s_);
#pragma unroll
                for (int r = 0; r < 4; ++r) {
                    const int c = 16 * mt + 4 * g + r; const float v = acc[r];
                    const float df = __expf(fminf(Gc[r] - Gs, 0.f)), db = __expf(fminf(Rc[r] - Rs, 0.f));
                    if (p == 0) {
                        ((LAS float*)(lds + G_LM))[c * 64 + s_] = Bfc[r] * v * df;
                        ((LAS float*)(lds + G_LM + 16384))[(63 - c) * 64 + (63 - s_)] = Bbc[r] * v * db;
                    } else {
                        ((LAS bf16*)(lds + G_D0 + GD_AP))[c * 72 + ps] = (bf16)(pk2(s_ <= c ? v * df : 0.f, 0.f) & 0xffffu);
                        ((LAS bf16*)(lds + G_D1 + GD_AP))[c * 72 + ps] = (bf16)(pk2(s_ >= c ? v * db : 0.f, 0.f) & 0xffffu);
                    }
                }
            }
        }
        __syncthreads();
        GAS v4u* gd0 = (GAS v4u*)(F.ws + WS_GD + (size_t)((bh * 2 + 0) * 128 + n) * GDN_D_BYTES);
        GAS v4u* gd1 = (GAS v4u*)(F.ws + WS_GD + (size_t)((bh * 2 + 1) * 128 + n) * GDN_D_BYTES);
        {
            GAS v4u* gsh = (GAS v4u*)(F.ws + WS_GSH + (size_t)(bh * 128 + n) * GDN_SH_BYTES);
#pragma unroll 3
            for (int i = tid; i < (int)(GDN_SH_BYTES / 16); i += NTHREADS) gsh[i] = *(const LAS v4u*)(lds + i * 16);
#pragma unroll 1
            for (int i = GD_AP / 16 + tid; i < (int)(GDN_D_BYTES / 16); i += NTHREADS) { gd0[i] = *(const LAS v4u*)(lds + G_D0 + i * 16); gd1[i] = *(const LAS v4u*)(lds + G_D1 + i * 16); }
        }
        __syncthreads();
        if (wave == 0) { tri_inverse<false>((LAS float*)(lds + G_LM), sBf, (LAS bf16*)(lds + G_D0 + GD_TBP), lane);
#pragma unroll 3
            for (int i = lane; i < GD_AP / 16; i += 64) gd0[i] = *(const LAS v4u*)(lds + G_D0 + i * 16); }
        else if (wave == 1) { tri_inverse<true>((LAS float*)(lds + G_LM + 16384), sBb, (LAS bf16*)(lds + G_D1 + GD_TBP), lane);
#pragma unroll 3
            for (int i = lane; i < GD_AP / 16; i += 64) gd1[i] = *(const LAS v4u*)(lds + G_D1 + i * 16); }
        else {
            const int t2 = task + F.G;
            if (t2 < 1024) { const int b2 = t2 >> 9, h2 = (t2 >> 7) & 3, n2 = t2 & 127;
                gdn_conv(F, lds, tid - 128, b2, h2, n2);
                if (wave == 2) gdn_gates(F, lds, (LAS float*)(lds + G_GV + (par ^ 1) * 1024), lane, b2, h2, n2); }
        }
        __syncthreads();
    }
}

DI bf16x8 pack8(const f32x4 a, const f32x4 b) {
    v4u p; p.x = pk2(a[0], a[1]); p.y = pk2(a[2], a[3]); p.z = pk2(b[0], b[1]); p.w = pk2(b[2], b[3]); return __builtin_bit_cast(bf16x8, p);
}
DI unsigned char* wgu_ptr(Frame& F, int e) { return F.ws + (e < WGU_SPLIT ? WS_WGU0 + (size_t)e * MiB : WS_WGU1 + (size_t)(e - WGU_SPLIT) * MiB); }
DI bf16* wd_ptr(Frame& F, int e) { return (bf16*)((unsigned char*)F.out + (e < WD_SPLIT ? DO_WD0 + (size_t)e * MiB : DO_WD1 + (size_t)(e - WD_SPLIT) * MiB)); }
constexpr int NG = 8, GSTEPS = 128 / NG;
#ifndef PASS1_QUOTA
#define PASS1_QUOTA 6
#endif
constexpr size_t WS_XB = 209 * MiB;
constexpr size_t WS_AOP = 217 * MiB;
constexpr size_t WS_SG = 221 * MiB;
constexpr int GS_SLOT = 54272, GS_Q = 17408, GS_VCT = 34816, GS_VEC = 53248, GS_TB = 18432, GS_AP = 27648;
static_assert(3 * GS_SLOT <= LDS_BYTES - 64, "scan ring");
static_assert(WS_SG + 8 * MiB <= 229 * MiB, "scan buffers");
DI void gs_dma(const unsigned char* src, unsigned lane16, unsigned lds_dst) {
    unsigned keep;
    asm volatile("s_mov_b32 %0, m0\n\ts_mov_b32 m0, %2\n\ts_nop 0\n\tglobal_load_lds_dwordx4 %1, %3\n\ts_mov_b32 m0, %0" : "=&s"(keep) : "v"(lane16), "s"(lds_dst), "s"(src) : "memory");
}
#define GS_WAITBAR(N) asm volatile("s_waitcnt vmcnt(%0) lgkmcnt(0)\n\ts_barrier" :: "n"(N) : "memory")
DI f32x4* gs_img(Frame& F, size_t base, int chain, int grp) { return (f32x4*)(F.ws + base) + (size_t)(chain * NG + grp) * (8 * 8 * 64); }
DI bf16* gs_aop(Frame& F, int chain, int grp) { return (bf16*)(F.ws + WS_AOP) + (size_t)(chain * NG + grp) * (8 * 4 * 64 * 8); }
DI void gs_start_state(Frame& F, int chain, int grp, f32x4 (&S)[8]);
template <int MODE> DI void gscan(Frame& F, const int chain, const int grp, f32x4* finalp, bf16* aop) {
    constexpr bool OUT = MODE == 0;
    constexpr int N1 = OUT ? 7 : (MODE == 1 ? 5 : 3), N2 = OUT ? 5 : 4, NST = OUT ? 16 : 0;
    const int lane = F.lane, n16 = lane & 15, g = lane >> 4, e = F.wave;
    const int bh = chain >> 1, dir = chain & 1, b = bh >> 2, h = bh & 3;
    const unsigned lds0 = (unsigned)(uintptr_t)opaque(F.lds), lane16 = (unsigned)lane * 16u;
    const unsigned char* shrec = F.ws + WS_GSH + (size_t)(bh * 128) * GDN_SH_BYTES; const unsigned char* drec = F.ws + WS_GD + (size_t)((bh * 2 + dir) * 128) * GDN_D_BYTES;
#define GS_ISSUE1(st_, slot_) do { const int sc_ = (st_) < 128 ? (st_) : 127; const int n_ = dir == 0 ? sc_ : 127 - sc_; const unsigned char* sh_ = shrec + (size_t)n_ * GDN_SH_BYTES; const unsigned char* dr_ = drec + (size_t)n_ * GDN_D_BYTES; \
        _Pragma("unroll") for (int j_ = 0; j_ < N1; ++j_) { const int q_ = e + 8 * j_; int p_; \
            if (MODE == 0) p_ = q_ < 53 ? q_ : 52; else if (MODE == 1) p_ = q_ < 17 ? q_ : (q_ < 35 ? q_ + 17 : 52); else p_ = q_ < 17 ? q_ : 52; \
            const unsigned char* src_ = p_ < 34 ? sh_ + p_ * 1024 : (p_ < 52 ? sh_ + G_VCT + (p_ - 34) * 1024 : dr_ + GD_VEC); \
            gs_dma(src_, lane16, (unsigned)__builtin_amdgcn_readfirstlane(lds0 + (unsigned)((slot_) * GS_SLOT + p_ * 1024))); } } while (0)
#define GS_ISSUE2(st_, slot_) do { const int sc_ = (st_) < 128 ? (st_) : 127; const int n_ = dir == 0 ? sc_ : 127 - sc_; const unsigned char* sh_ = shrec + (size_t)n_ * GDN_SH_BYTES; const unsigned char* dr_ = drec + (size_t)n_ * GDN_D_BYTES; \
        _Pragma("unroll") for (int j_ = 0; j_ < N2; ++j_) { const int q_ = e + 8 * j_; const int pm_ = OUT ? 35 : 26; const int p_ = q_ < pm_ ? q_ : pm_; \
            const unsigned char* src_ = p_ < 18 ? sh_ + G_KNTP + p_ * 1024 : dr_ + (p_ - 18) * 1024; \
            gs_dma(src_, lane16, (unsigned)__builtin_amdgcn_readfirstlane(lds0 + (unsigned)((slot_) * GS_SLOT + p_ * 1024))); } } while (0)
    const int st0 = grp * GSTEPS;
    bf16* Odir = (bf16*)((unsigned char*)F.out + (dir == 0 ? DO_OF : DO_OB));
    f32x4 S[8];
    if (MODE == 0 && grp > 0) gs_start_state(F, chain, grp, S);
    else {
#pragma unroll
        for (int i = 0; i < 8; ++i)
#pragma unroll
            for (int r = 0; r < 4; ++r) S[i][r] = (MODE == 2 && (16 * i + 4 * g + r) == (16 * e + n16)) ? 1.0f : 0.0f;
    }
    GS_ISSUE1(st0, 0); GS_ISSUE2(st0, 1);
    bf16x8 Sb[4];
#pragma unroll
    for (int i = 0; i < 4; ++i) Sb[i] = pack8(S[2 * i], S[2 * i + 1]);
    const unsigned aoff272 = n16 * 272 + g * 16, aoff144 = n16 * 144 + g * 16;
#define SB_() __builtin_amdgcn_sched_barrier(0)
#define LDR128(dst, base, off) asm volatile("ds_read_b128 %0, %1 offset:%2" : "=v"(dst) : "v"(base), "i"(off) : "memory")
#define LDR64(dst, base, off) asm volatile("ds_read_b64 %0, %1 offset:%2" : "=v"(dst) : "v"(base), "i"(off) : "memory")
#define LDR32(dst, base, off) asm volatile("ds_read_b32 %0, %1 offset:%2" : "=v"(dst) : "v"(base), "i"(off) : "memory")
    int sl1 = 0, sl2 = 1, sl3 = 2;
#pragma unroll 1
    for (int s = 0; s < GSTEPS; ++s) {
        const int st = st0 + s;
        if (OUT && s > 0) GS_WAITBAR(N2 + NST); else GS_WAITBAR(N2);
        GS_ISSUE1(s + 1 < GSTEPS ? st + 1 : st, sl3);
        const int n = dir == 0 ? st : 127 - st;
        const unsigned h1 = lds0 + (unsigned)sl1 * GS_SLOT, h2 = lds0 + (unsigned)sl2 * GS_SLOT;
        const unsigned bK = h1 + aoff272, bQ = h1 + GS_Q + aoff272, bKT = h2 + aoff144, bT = h2 + GS_TB + aoff144;
        const unsigned bV = h1 + GS_VCT + e * 2304 + n16 * 144 + g * 8, bvec = h1 + GS_VEC + g * 16, bd = h1 + GS_VEC;
        f32x4 eG[4], ks[4]; v2u vv[4]; float dch; bf16x8 fa[16];
        LDR128(eG[0], bvec, 0); LDR128(eG[1], bvec, 64); LDR128(eG[2], bvec, 128); LDR128(eG[3], bvec, 192);
        LDR128(ks[0], bvec, 256); LDR128(ks[1], bvec, 320); LDR128(ks[2], bvec, 384); LDR128(ks[3], bvec, 448);
        LDR32(dch, bd, 512);
        LDR64(vv[0], bV, 0); LDR64(vv[1], bV, 32); LDR64(vv[2], bV, 64); LDR64(vv[3], bV, 96);
#pragma unroll
        for (int m = 0; m < 4; ++m) { LDR128(fa[m * 4 + 0], bK, m * 4352 + 0); LDR128(fa[m * 4 + 1], bK, m * 4352 + 64); LDR128(fa[m * 4 + 2], bK, m * 4352 + 128); LDR128(fa[m * 4 + 3], bK, m * 4352 + 192); }
        bf16x8 fq[16];
        if (OUT) {
#pragma unroll
            for (int m = 0; m < 4; ++m) { LDR128(fq[m * 4 + 0], bQ, m * 4352 + 0); LDR128(fq[m * 4 + 1], bQ, m * 4352 + 64); LDR128(fq[m * 4 + 2], bQ, m * 4352 + 128); LDR128(fq[m * 4 + 3], bQ, m * 4352 + 192); }
            asm volatile("s_waitcnt lgkmcnt(15)" : "+v"(eG[0]), "+v"(eG[1]), "+v"(eG[2]), "+v"(eG[3]), "+v"(ks[0]), "+v"(ks[1]), "+v"(ks[2]), "+v"(ks[3]), "+v"(dch), "+v"(vv[0]), "+v"(vv[1]), "+v"(vv[2]), "+v"(vv[3]),
                         "+v"(fa[0]), "+v"(fa[1]), "+v"(fa[2]), "+v"(fa[3]), "+v"(fa[4]), "+v"(fa[5]), "+v"(fa[6]), "+v"(fa[7]), "+v"(fa[8]), "+v"(fa[9]), "+v"(fa[10]), "+v"(fa[11]), "+v"(fa[12]), "+v"(fa[13]), "+v"(fa[14]), "+v"(fa[15]) :: "memory");
        } else {
            asm volatile("s_waitcnt lgkmcnt(0)" : "+v"(eG[0]), "+v"(eG[1]), "+v"(eG[2]), "+v"(eG[3]), "+v"(ks[0]), "+v"(ks[1]), "+v"(ks[2]), "+v"(ks[3]), "+v"(dch), "+v"(vv[0]), "+v"(vv[1]), "+v"(vv[2]), "+v"(vv[3]),
                         "+v"(fa[0]), "+v"(fa[1]), "+v"(fa[2]), "+v"(fa[3]), "+v"(fa[4]), "+v"(fa[5]), "+v"(fa[6]), "+v"(fa[7]), "+v"(fa[8]), "+v"(fa[9]), "+v"(fa[10]), "+v"(fa[11]), "+v"(fa[12]), "+v"(fa[13]), "+v"(fa[14]), "+v"(fa[15]) :: "memory");
        }
        SB_();
        f32x4 KS[4];
#pragma unroll
        for (int m = 0; m < 4; ++m) KS[m] = (f32x4){0.f, 0.f, 0.f, 0.f};
#pragma unroll
        for (int i = 0; i < 4; ++i)
#pragma unroll
            for (int m = 0; m < 4; ++m) KS[m] = __builtin_amdgcn_mfma_f32_16x16x32_bf16(fa[m * 4 + i], Sb[i], KS[m], 0, 0, 0);
        SB_();
        if (OUT) {
            if (s > 0) asm volatile("s_waitcnt vmcnt(%16) lgkmcnt(0)\n\ts_barrier" : "+v"(fq[0]), "+v"(fq[1]), "+v"(fq[2]), "+v"(fq[3]), "+v"(fq[4]), "+v"(fq[5]), "+v"(fq[6]), "+v"(fq[7]), "+v"(fq[8]), "+v"(fq[9]), "+v"(fq[10]), "+v"(fq[11]), "+v"(fq[12]), "+v"(fq[13]), "+v"(fq[14]), "+v"(fq[15]) : "n"(N1 + NST) : "memory");
            else asm volatile("s_waitcnt vmcnt(%16) lgkmcnt(0)\n\ts_barrier" : "+v"(fq[0]), "+v"(fq[1]), "+v"(fq[2]), "+v"(fq[3]), "+v"(fq[4]), "+v"(fq[5]), "+v"(fq[6]), "+v"(fq[7]), "+v"(fq[8]), "+v"(fq[9]), "+v"(fq[10]), "+v"(fq[11]), "+v"(fq[12]), "+v"(fq[13]), "+v"(fq[14]), "+v"(fq[15]) : "n"(N1) : "memory");
        } else GS_WAITBAR(N1);
        GS_ISSUE2(s + 1 < GSTEPS ? st + 1 : st, sl1);
        bf16x8 ft[8];
#pragma unroll
        for (int m = 0; m < 4; ++m) { LDR128(ft[m * 2 + 0], bT, m * 2304 + 0); LDR128(ft[m * 2 + 1], bT, m * 2304 + 64); }
        SB_();
        f32x4 o[4];
        if (OUT) {
#pragma unroll
            for (int m = 0; m < 4; ++m) o[m] = (f32x4){0.f, 0.f, 0.f, 0.f};
#pragma unroll
            for (int i = 0; i < 4; ++i)
#pragma unroll
                for (int m = 0; m < 4; ++m) o[m] = __builtin_amdgcn_mfma_f32_16x16x32_bf16(fq[m * 4 + i], Sb[i], o[m], 0, 0, 0);
        }
        f32x4 rr[4];
#pragma unroll
        for (int m = 0; m < 4; ++m) {
            if (MODE == 2) { rr[m][0] = -eG[m][0] * KS[m][0]; rr[m][1] = -eG[m][1] * KS[m][1]; rr[m][2] = -eG[m][2] * KS[m][2]; rr[m][3] = -eG[m][3] * KS[m][3]; }
            else { rr[m][0] = bflo(vv[m].x) - eG[m][0] * KS[m][0]; rr[m][1] = bfhi(vv[m].x) - eG[m][1] * KS[m][1]; rr[m][2] = bflo(vv[m].y) - eG[m][2] * KS[m][2]; rr[m][3] = bfhi(vv[m].y) - eG[m][3] * KS[m][3]; } }
        bf16x8 rb[2]; rb[0] = pack8(rr[0], rr[1]); rb[1] = pack8(rr[2], rr[3]);
        SB_();
        bf16x8 fk[16];
#pragma unroll
        for (int jt = 0; jt < 8; ++jt) { LDR128(fk[jt * 2 + 0], bKT, jt * 2304 + 0); LDR128(fk[jt * 2 + 1], bKT, jt * 2304 + 64); }
        asm volatile("s_waitcnt lgkmcnt(15)" : "+v"(ft[0]), "+v"(ft[1]), "+v"(ft[2]), "+v"(ft[3]), "+v"(ft[4]), "+v"(ft[5]), "+v"(ft[6]), "+v"(ft[7]) :: "memory");
        SB_();
        f32x4 vn[4];
#pragma unroll
        for (int m = 0; m < 4; ++m) vn[m] = (f32x4){0.f, 0.f, 0.f, 0.f};
#pragma unroll
        for (int i = 0; i < 2; ++i)
#pragma unroll
            for (int m = 0; m < 4; ++m) vn[m] = __builtin_amdgcn_mfma_f32_16x16x32_bf16(ft[m * 2 + i], rb[i], vn[m], 0, 0, 0);
        if (OUT) {
#pragma unroll
            for (int m = 0; m < 4; ++m) o[m] = o[m] * eG[m];
        }
#pragma unroll
        for (int jt = 0; jt < 8; ++jt) S[jt] = S[jt] * dch;
        SB_();
        bf16x8 fp[8];
        if (OUT) {
#pragma unroll
            for (int m = 0; m < 4; ++m) { LDR128(fp[m * 2 + 0], bT, (GS_AP - GS_TB) + m * 2304 + 0); LDR128(fp[m * 2 + 1], bT, (GS_AP - GS_TB) + m * 2304 + 64); }
        }
        bf16x8 vnb[2]; vnb[0] = pack8(vn[0], vn[1]); vnb[1] = pack8(vn[2], vn[3]);
        bf16x8 vs[2]; vs[0] = pack8(vn[0] * ks[0], vn[1] * ks[1]); vs[1] = pack8(vn[2] * ks[2], vn[3] * ks[3]);
        if (OUT) asm volatile("s_waitcnt lgkmcnt(8)" : "+v"(fk[0]), "+v"(fk[1]), "+v"(fk[2]), "+v"(fk[3]), "+v"(fk[4]), "+v"(fk[5]), "+v"(fk[6]), "+v"(fk[7]), "+v"(fk[8]), "+v"(fk[9]), "+v"(fk[10]), "+v"(fk[11]), "+v"(fk[12]), "+v"(fk[13]), "+v"(fk[14]), "+v"(fk[15]) :: "memory");
        else asm volatile("s_waitcnt lgkmcnt(0)" : "+v"(fk[0]), "+v"(fk[1]), "+v"(fk[2]), "+v"(fk[3]), "+v"(fk[4]), "+v"(fk[5]), "+v"(fk[6]), "+v"(fk[7]), "+v"(fk[8]), "+v"(fk[9]), "+v"(fk[10]), "+v"(fk[11]), "+v"(fk[12]), "+v"(fk[13]), "+v"(fk[14]), "+v"(fk[15]) :: "memory");
        SB_();
#pragma unroll
        for (int i = 0; i < 2; ++i)
#pragma unroll
            for (int jt = 0; jt < 8; ++jt) S[jt] = __builtin_amdgcn_mfma_f32_16x16x32_bf16(fk[jt * 2 + i], vs[i], S[jt], 0, 0, 0);
        if (OUT) {
            asm volatile("s_waitcnt lgkmcnt(0)" : "+v"(fp[0]), "+v"(fp[1]), "+v"(fp[2]), "+v"(fp[3]), "+v"(fp[4]), "+v"(fp[5]), "+v"(fp[6]), "+v"(fp[7]) :: "memory");
#pragma unroll
            for (int i = 0; i < 2; ++i)
#pragma unroll
                for (int m = 0; m < 4; ++m) o[m] = __builtin_amdgcn_mfma_f32_16x16x32_bf16(fp[m * 2 + i], vnb[i], o[m], 0, 0, 0);
        }
#pragma unroll
        for (int i = 0; i < 4; ++i) Sb[i] = pack8(S[2 * i], S[2 * i + 1]);
        SB_();
        if (OUT) {
            bf16* op = Odir + (size_t)(b * SEQ + n * 64) * 512 + h * 128 + 16 * e + n16;
#pragma unroll
            for (int m = 0; m < 4; ++m)
#pragma unroll
                for (int r = 0; r < 4; ++r) op[(size_t)(16 * m + 4 * g + r) * 512] = (bf16)(pk2(o[m][r], 0.f) & 0xffffu);
        }
        { const int t_ = sl1; sl1 = sl3; sl3 = sl2; sl2 = t_; }
    }
#undef SB_
#undef LDR128
#undef LDR64
#undef LDR32
#undef GS_ISSUE1
#undef GS_ISSUE2
    if (finalp) {
#pragma unroll
        for (int i = 0; i < 8; ++i) finalp[(e * 8 + i) * 64 + lane] = S[i];
    }
    if (aop) {
#pragma unroll
        for (int jt = 0; jt < 8; ++jt)
#pragma unroll
            for (int r = 0; r < 4; ++r) aop[((jt * 4 + (e >> 1)) * 64 + 16 * (n16 >> 2) + 4 * g + r) * 8 + 4 * (e & 1) + (n16 & 3)] = (bf16)(pk2(S[jt][r], 0.f) & 0xffffu);
    }
    asm volatile("s_waitcnt vmcnt(0)" ::: "memory");
    __syncthreads();
}
DI void gs_start_state(Frame& F, int chain, int grp, f32x4 (&S)[8]) {
    const int lane = F.lane, e = F.wave;
    { const f32x4* b0 = gs_img(F, WS_XB, chain, 0);
#pragma unroll
      for (int i = 0; i < 8; ++i) S[i] = b0[(e * 8 + i) * 64 + lane]; }
#pragma unroll 1
    for (int gq = 1; gq < grp; ++gq) {
        const f32x4* bg = gs_img(F, WS_XB, chain, gq); const bf16x8* ag = (const bf16x8*)gs_aop(F, chain, gq);
        bf16x8 Sb[4];
#pragma unroll
        for (int i = 0; i < 4; ++i) Sb[i] = pack8(S[2 * i], S[2 * i + 1]);
#pragma unroll
        for (int jt = 0; jt < 8; ++jt) { f32x4 acc = bg[(e * 8 + jt) * 64 + lane];
#pragma unroll
            for (int i = 0; i < 4; ++i) acc = __builtin_amdgcn_mfma_f32_16x16x32_bf16(ag[(jt * 4 + i) * 64 + lane], Sb[i], acc, 0, 0, 0);
            S[jt] = acc; }
    }
}
constexpr int CV_QS = NEXP * 32, CV_WD = NEXP * 32, CV_WO = 64, CV_RT = 16, CV_ITEMS = CV_QS + CV_WD + CV_WO + CV_RT;
DI void conv_item(Frame& F, int it) {
    LAS float* scr = (LAS float*)(F.lds + F.wave * 16384);
    if (it < CV_QS) {
        const int e = it >> 5, mat = (it >> 4) & 1, nb = it & 15;
        q_strip((mat ? F.in[14] : F.in[13]) + (size_t)e * 1024 * 512, 512, 32 * nb, wgu_ptr(F, e), (float*)(F.ws + WS_WSC) + e * 1024, mat + 64 * nb, 2, F.lds, F.wave, F.lane);
    } else if (it < CV_QS + CV_WD) {
        const int w = (it - CV_QS) * 8 + F.wave, e = w >> 8, r = w & 255;
        p0_transpose_item(F.in[15] + (size_t)e * 512 * 1024, 1024, 32, wd_ptr(F, e), 512, 0, 1, scr, r, F.lane);
    } else if (it < CV_QS + CV_WD + CV_WO) {
        p0_transpose_item(F.in[9], 1024, 32, (bf16*)(F.ws + WS_WOUT), 1024, 0, 1, scr, (it - CV_QS - CV_WD) * 8 + F.wave, F.lane);
    } else {
        bf16* WRH = (bf16*)(F.ws + WS_WR); bf16* WRL = WRH + 48 * 1024; const float* wrg = F.in[11]; const float* wre = F.in[12];
        const int base = (it - CV_QS - CV_WD - CV_WO) * 3072;
#pragma unroll
        for (int q = 0; q < 6; ++q) { const int i = base + q * 512 + F.tid; const int j = i >> 10, k = i & 1023; float v = 0.f; if (j < 4) v = wrg[k * 4 + j]; else if (j < 36) v = wre[k * 32 + (j - 4)];
            const unsigned hh = f2bf(v); const float hv = __builtin_bit_cast(float, hh << 16); WRH[i] = (bf16)hh; WRL[i] = (bf16)f2bf(v - hv); }
    }
}
constexpr int CW_CONVQ = 12288;
static_assert(48 * PASS1_QUOTA <= CV_QS, "pass 1 may only take gate/up strips");
DI void conv_pull(Frame& F, int quota) {
    volatile LAS int* slot = (volatile LAS int*)(F.lds + MISC_OFF + 32);
    for (int n = 0; n < quota; ++n) {
        __syncthreads();
        if (F.tid == 0) *slot = (int)xb_add((unsigned*)(F.ws + WS_CTL) + CW_CONVQ, 1u);
        __syncthreads();
        const int it = *slot; if (it >= CV_ITEMS) break;
        conv_item(F, it);
    }
    __syncthreads();
}
DI void p4_pass1(Frame& F) {
    const int T = F.vcu, part = T & 1, cg = T >> 1, chain = cg / (NG - 1), grp = cg % (NG - 1);
    if (T < 16 * (NG - 1) * 2 && part == 0) gscan<1>(F, chain, grp, gs_img(F, WS_XB, chain, grp), nullptr);
    else if (T < 16 * (NG - 1) * 2 && grp > 0) gscan<2>(F, chain, grp, nullptr, gs_aop(F, chain, grp));
    else conv_pull(F, PASS1_QUOTA);
}
DI void p4_pass3(Frame& F) {
    if ((F.vcu & 1) == 0 && (F.vcu >> 1) < 16 * NG) { const int T = F.vcu >> 1; gscan<0>(F, T / NG, T % NG, nullptr, nullptr); }
    conv_pull(F, 1 << 30);
}

DI void p5_combine(Frame& F) {
    const int gw = F.vcu * NWAVES + F.wave, NGW = F.G * NWAVES, lane = F.lane;
    const bf16* OFp = (const bf16*)((unsigned char*)F.out + DO_OF); const bf16* OBp = (const bf16*)((unsigned char*)F.out + DO_OB);
    const bf16* ZA = (const bf16*)(F.ws + WS_ZA); bf16* OCAT = (bf16*)(F.ws + WS_OCAT);
    const float* nw = F.in[6] + (lane & 15) * 8;
    float w8[8];
#pragma unroll
    for (int c = 0; c < 8; ++c) w8[c] = nw[c];
    constexpr int NB4 = 4;
    for (int t0 = gw; t0 < TT; t0 += NB4 * NGW) {
        v4u a[NB4], bb[NB4], z[NB4];
#pragma unroll
        for (int u = 0; u < NB4; ++u) { const int t = (t0 + u * NGW < TT) ? t0 + u * NGW : t0;
            a[u] = *(const v4u*)(OFp + (size_t)t * 512 + lane * 8); bb[u] = *(const v4u*)(OBp + (size_t)t * 512 + lane * 8); z[u] = *(const v4u*)(ZA + (size_t)t * 512 + lane * 8); }
#pragma unroll
        for (int u = 0; u < NB4; ++u) {
            const int t = t0 + u * NGW; if (t >= TT) break;
            float o[8] = {bflo(a[u].x) + bflo(bb[u].x), bfhi(a[u].x) + bfhi(bb[u].x), bflo(a[u].y) + bflo(bb[u].y), bfhi(a[u].y) + bfhi(bb[u].y), bflo(a[u].z) + bflo(bb[u].z), bfhi(a[u].z) + bfhi(bb[u].z), bflo(a[u].w) + bflo(bb[u].w), bfhi(a[u].w) + bfhi(bb[u].w)};
            const float zz[8] = {bflo(z[u].x), bfhi(z[u].x), bflo(z[u].y), bfhi(z[u].y), bflo(z[u].z), bfhi(z[u].z), bflo(z[u].w), bfhi(z[u].w)};
            float ss = 0.f;
#pragma unroll
            for (int c = 0; c < 8; ++c) ss += o[c] * o[c];
            ss = sum16(ss);
            const float rn = __builtin_amdgcn_rsqf(ss * (1.f / 128.f) + EPS);
#pragma unroll
            for (int c = 0; c < 8; ++c) o[c] = o[c] * rn * w8[c] * siluf(zz[c]);
            v4u r; r.x = pk2(o[0], o[1]); r.y = pk2(o[2], o[3]); r.z = pk2(o[4], o[5]); r.w = pk2(o[6], o[7]);
            *(v4u*)(OCAT + (size_t)t * 1024 + lane * 8) = r;
        }
    }
}

struct TokRec { int e[2]; int row[2]; float gate[2]; };
DI void p7_route(Frame& F) {
    const int lane = F.lane, n16 = lane & 15, g = lane >> 4, wave = F.wave;
    const bf16* X1 = (const bf16*)(F.ws + WS_X1); const float* nfw = F.in[10];
    const bf16* WRH = (const bf16*)(F.ws + WS_WR); const bf16* WRL = WRH + 48 * 1024;
    unsigned char* HN = (unsigned char*)F.out + DO_HN; TokRec* TOK = (TokRec*)(F.ws + WS_TOK); unsigned* gcnt = (unsigned*)(F.ws + WS_CTL) + CW_CNT; int* LIST = (int*)(F.ws + WS_LIST);
    LAS float* lg = (LAS float*)(F.lds + (wave & 3) * 4096);
    LAS unsigned* hist = (LAS unsigned*)(F.lds + 16384); LAS unsigned* base = hist + 32;
    const int sub = blockIdx.x & 7;
    const float qsc = 127.0f / act_absmax(nfw, lane);
    for (int rt0 = blockIdx.x * 4; rt0 < TT / 16; rt0 += F.G * 4) {
        if (F.tid < 32) hist[F.tid] = 0u;
        __syncthreads();
        int ex1 = 0, ex2 = 0, tok = -1; unsigned l1 = 0, l2 = 0; float g1 = 0.f, g2 = 0.f;
        const int rt = rt0 + wave;
        if (wave < 4 && rt < TT / 16) {
            const int row = rt * 16 + n16; const bf16* xr = X1 + (size_t)row * DMODEL + 8 * g;
            float ss = 0.f;
#pragma unroll 16
            for (int i = 0; i < 32; ++i) { const v4u xw = *(const v4u*)(xr + 32 * i); const f32x4 a = {bflo(xw.x), bfhi(xw.x), bflo(xw.y), bfhi(xw.y)}, b2 = {bflo(xw.z), bfhi(xw.z), bflo(xw.w), bfhi(xw.w)};
                ss += (a.x * a.x + a.y * a.y) + (a.z * a.z + a.w * a.w) + (b2.x * b2.x + b2.y * b2.y) + (b2.z * b2.z + b2.w * b2.w); }
            ss = sum_x32(sum_x16(ss));
            const float rs = __builtin_amdgcn_rsqf(ss * (1.f / DMODEL) + EPS);
            f32x4 acc[3];
#pragma unroll
            for (int q = 0; q < 3; ++q) acc[q] = (f32x4){0.f, 0.f, 0.f, 0.f};
#pragma unroll 4
            for (int i = 0; i < 32; ++i) {
                const v4u xw = *(const v4u*)(xr + 32 * i); const f32x4 a = {bflo(xw.x), bfhi(xw.x), bflo(xw.y), bfhi(xw.y)}, b2 = {bflo(xw.z), bfhi(xw.z), bflo(xw.w), bfhi(xw.w)};
                const f32x4 wa = *(const f32x4*)(nfw + 32 * i + 8 * g), wb = *(const f32x4*)(nfw + 32 * i + 8 * g + 4);
                float hv[8] = {a.x * rs * wa.x, a.y * rs * wa.y, a.z * rs * wa.z, a.w * rs * wa.w, b2.x * rs * wb.x, b2.y * rs * wb.y, b2.z * rs * wb.z, b2.w * rs * wb.w};
                v4u hi, lo;
                hi.x = pk2(hv[0], hv[1]); hi.y = pk2(hv[2], hv[3]); hi.z = pk2(hv[4], hv[5]); hi.w = pk2(hv[6], hv[7]);
                lo.x = pk2(hv[0] - bflo(hi.x), hv[1] - bfhi(hi.x)); lo.y = pk2(hv[2] - bflo(hi.y), hv[3] - bfhi(hi.y));
                lo.z = pk2(hv[4] - bflo(hi.z), hv[5] - bfhi(hi.z)); lo.w = pk2(hv[6] - bflo(hi.w), hv[7] - bfhi(hi.w));
                { v2u q; q.x = q8x4(hv[0], hv[1], hv[2], hv[3], qsc); q.y = q8x4(hv[4], hv[5], hv[6], hv[7], qsc); *(v2u*)(HN + (size_t)row * DMODEL + 32 * i + 8 * g) = q; }
                const bf16x8 ah = __builtin_bit_cast(bf16x8, hi), al = __builtin_bit_cast(bf16x8, lo);
#pragma unroll
                for (int q = 0; q < 3; ++q) {
                    const bf16x8 bh = *(const bf16x8*)(WRH + (size_t)(16 * q + n16) * 1024 + 32 * i + 8 * g), bl = *(const bf16x8*)(WRL + (size_t)(16 * q + n16) * 1024 + 32 * i + 8 * g);
                    acc[q] = __builtin_amdgcn_mfma_f32_16x16x32_bf16(ah, bh, acc[q], 0, 0, 0);
                    acc[q] = __builtin_amdgcn_mfma_f32_16x16x32_bf16(ah, bl, acc[q], 0, 0, 0);
                    acc[q] = __builtin_amdgcn_mfma_f32_16x16x32_bf16(al, bh, acc[q], 0, 0, 0);
                }
            }
#pragma unroll
            for (int q = 0; q < 3; ++q)
#pragma unroll
                for (int r = 0; r < 4; ++r) lg[(4 * g + r) * 48 + 16 * q + n16] = acc[q][r];
            asm volatile("s_waitcnt lgkmcnt(0)" ::: "memory");
            if (lane < 16) {
                const LAS float* L = lg + lane * 48; tok = rt * 16 + lane;
                float gm = L[0]; int gs = 0;
#pragma unroll
                for (int q = 1; q < 4; ++q) if (L[q] > gm) { gm = L[q]; gs = q; }
                float gsum = 0.f;
#pragma unroll
                for (int q = 0; q < 4; ++q) gsum += __expf(L[q] - gm);
                const float gp_top = 1.0f / gsum;
                float fv[8];
#pragma unroll
                for (int q = 0; q < 8; ++q) { float v = L[4 + q]; v = (gs == 1) ? L[12 + q] : v; v = (gs == 2) ? L[20 + q] : v; v = (gs == 3) ? L[28 + q] : v; fv[q] = v; }
                float m1 = fv[0]; int i1 = 0;
#pragma unroll
                for (int q = 1; q < 8; ++q) if (fv[q] > m1) { m1 = fv[q]; i1 = q; }
                float m2 = -3.0e38f; int i2 = 0;
#pragma unroll
                for (int q = 0; q < 8; ++q) if (q != i1 && fv[q] > m2) { m2 = fv[q]; i2 = q; }
                const float e2 = __expf(m2 - m1); g1 = gp_top / (1.0f + e2); g2 = gp_top * e2 / (1.0f + e2);
                ex1 = gs * 8 + i1; ex2 = gs * 8 + i2;
                l1 = __hip_atomic_fetch_add(hist + ex1, 1u, __ATOMIC_RELAXED, __HIP_MEMORY_SCOPE_WORKGROUP); l2 = __hip_atomic_fetch_add(hist + ex2, 1u, __ATOMIC_RELAXED, __HIP_MEMORY_SCOPE_WORKGROUP);
            }
        }
        __syncthreads();
        if (F.tid < 32) { const unsigned hcount = hist[F.tid]; base[F.tid] = hcount ? atomicAdd(gcnt + F.tid * 8 + sub, hcount) : 0u; }
        __syncthreads();
        if (tok >= 0) {
            const int s1 = (int)(base[ex1] + l1), s2 = (int)(base[ex2] + l2);
            LIST[(size_t)(ex1 * 8 + sub) * TT + s1] = tok; LIST[(size_t)(ex2 * 8 + sub) * TT + s2] = tok;
            TokRec tr; tr.e[0] = ex1; tr.e[1] = ex2; tr.row[0] = (sub << 24) | s1; tr.row[1] = (sub << 24) | s2; tr.gate[0] = g1; tr.gate[1] = g2;
            TOK[tok] = tr;
        }
    }
}

DI void build_etab(Frame& F) {
    LAS unsigned* etab = (LAS unsigned*)(F.lds + ETAB_OFF);
    if (F.tid < 32) {
        const unsigned* gcnt = (const unsigned*)(F.ws + WS_CTL) + CW_CNT + F.tid * 8; unsigned acc = 0;
#pragma unroll
        for (int q = 0; q < 8; ++q) { const unsigned c = __hip_atomic_load(gcnt + q, __ATOMIC_RELAXED, __HIP_MEMORY_SCOPE_AGENT); etab[96 + 8 * F.tid + q] = acc; acc += c; }
        etab[64 + F.tid] = acc; etab[2 * F.tid + 1] = (acc + 255u) >> 8;
    }
    __syncthreads();
    if (F.tid == 0) { unsigned acc = 0; for (int e = 0; e < NEXP; ++e) { etab[2 * e] = acc; acc += etab[2 * e + 1]; } }
    if (F.wave == 1) { const float am = act_absmax(F.in[10], F.lane); if (F.lane == 0) ((LAS float*)etab)[352] = am * (1.0f / 127.0f); }
    __syncthreads();
}

DI void p11_final(Frame& F) {
    build_etab(F);
    const LAS unsigned* etab = (const LAS unsigned*)(F.lds + ETAB_OFF);
    const int gw = F.vcu * NWAVES + F.wave, NGW = F.G * NWAVES, lane = F.lane;
    const bf16* Y = (const bf16*)(F.ws + WS_XBUF); const TokRec* TOK = (const TokRec*)(F.ws + WS_TOK); const float* fw = F.in[16];
    const f32x4 w0 = *(const f32x4*)(fw + lane * 8), w1 = *(const f32x4*)(fw + lane * 8 + 4), w2 = *(const f32x4*)(fw + 512 + lane * 8), w3 = *(const f32x4*)(fw + 516 + lane * 8);
    constexpr int NB2 = 2;
    for (int t0 = gw; t0 < TT; t0 += NB2 * NGW) {
        TokRec tr[NB2]; v4u xa[NB2][2]; v4u ya[NB2][2][2];
#pragma unroll
        for (int u = 0; u < NB2; ++u) { const int t = (t0 + u * NGW < TT) ? t0 + u * NGW : t0; tr[u] = TOK[t];
            const bf16* xr = (const bf16*)(F.ws + WS_X1) + (size_t)t * DMODEL + lane * 8;
            xa[u][0] = *(const v4u*)(xr); xa[u][1] = *(const v4u*)(xr + 512); }
#pragma unroll
        for (int u = 0; u < NB2; ++u)
#pragma unroll
            for (int k = 0; k < 2; ++k) { const unsigned rk = (unsigned)tr[u].row[k]; const bf16* yr = Y + (size_t)(etab[2 * tr[u].e[k]] * 256u + etab[96 + 8 * tr[u].e[k] + (rk >> 24)] + (rk & 0xffffffu)) * DMODEL + lane * 8; ya[u][k][0] = *(const v4u*)(yr); ya[u][k][1] = *(const v4u*)(yr + 512); }
#pragma unroll
        for (int u = 0; u < NB2; ++u) {
            const int t = t0 + u * NGW; if (t >= TT) break;
            float v[16] = {bflo(xa[u][0].x), bfhi(xa[u][0].x), bflo(xa[u][0].y), bfhi(xa[u][0].y), bflo(xa[u][0].z), bfhi(xa[u][0].z), bflo(xa[u][0].w), bfhi(xa[u][0].w),
                           bflo(xa[u][1].x), bfhi(xa[u][1].x), bflo(xa[u][1].y), bfhi(xa[u][1].y), bflo(xa[u][1].z), bfhi(xa[u][1].z), bflo(xa[u][1].w), bfhi(xa[u][1].w)};
#pragma unroll
            for (int k = 0; k < 2; ++k) {
                const float gk = tr[u].gate[k]; const v4u y0 = ya[u][k][0], y1 = ya[u][k][1];
                v[0] += gk * bflo(y0.x); v[1] += gk * bfhi(y0.x); v[2] += gk * bflo(y0.y); v[3] += gk * bfhi(y0.y); v[4] += gk * bflo(y0.z); v[5] += gk * bfhi(y0.z); v[6] += gk * bflo(y0.w); v[7] += gk * bfhi(y0.w);
                v[8] += gk * bflo(y1.x); v[9] += gk * bfhi(y1.x); v[10] += gk * bflo(y1.y); v[11] += gk * bfhi(y1.y); v[12] += gk * bflo(y1.z); v[13] += gk * bfhi(y1.z); v[14] += gk * bflo(y1.w); v[15] += gk * bfhi(y1.w);
            }
            float ss = 0.f;
#pragma unroll
            for (int i = 0; i < 16; ++i) ss += v[i] * v[i];
            const float rs = __builtin_amdgcn_rsqf(wave_sum(ss) * (1.f / DMODEL) + EPS);
            float* orow = F.out + (size_t)t * DMODEL + lane * 8;
            *(f32x4*)(orow) = (f32x4){v[0] * rs * w0.x, v[1] * rs * w0.y, v[2] * rs * w0.z, v[3] * rs * w0.w};
            *(f32x4*)(orow + 4) = (f32x4){v[4] * rs * w1.x, v[5] * rs * w1.y, v[6] * rs * w1.z, v[7] * rs * w1.w};
            *(f32x4*)(orow + 512) = (f32x4){v[8] * rs * w2.x, v[9] * rs * w2.y, v[10] * rs * w2.z, v[11] * rs * w2.w};
            *(f32x4*)(orow + 516) = (f32x4){v[12] * rs * w3.x, v[13] * rs * w3.y, v[14] * rs * w3.z, v[15] * rs * w3.w};
        }
    }
}

struct Args { const float* in[17]; float* out; unsigned char* ws; int ph_lo, ph_hi; };
__global__ void __launch_bounds__(NTHREADS, 2) fwd_kernel(Args args) {
    extern __shared__ __attribute__((aligned(16))) unsigned char lds[];
    cg::grid_group grid = cg::this_grid();
    Frame F;
    F.lds = (LAS unsigned char*)lds; F.tid = threadIdx.x; F.lane = F.tid & 63; F.wave = __builtin_amdgcn_readfirstlane(F.tid >> 6);
    F.G = gridDim.x; { const int bx = blockIdx.x; F.vcu = (F.G % 8 == 0) ? (bx % 8) * (F.G / 8) + bx / 8 : bx; }
#pragma unroll
    for (int i = 0; i < 17; ++i) F.in[i] = args.in[i];
    F.out = args.out; F.ws = args.ws;
    const int lo = args.ph_lo, hi = args.ph_hi;
    if (F.tid < 16) ((volatile LAS unsigned*)(F.lds + MISC_OFF))[F.tid] = 0u;
    __syncthreads();
    XcdBarrier bar = xcd_barrier_post((unsigned*)(F.ws + WS_CTL) + CW_BAR, (volatile LAS unsigned*)(F.lds + MISC_OFF));
    if (lo > 1000) grid.sync();
#ifndef PHSEL
#define PHSEL 0xfff
#endif
#define IN(k) (((PHSEL >> (k)) & 1) && lo <= (k) && (k) < hi)
#define SEAM(k) do { if (IN(k) && IN((k) + 1)) xcd_barrier(bar); } while (0)
#ifndef REP_PH
#define REP_PH -1
#endif
#define REPS(k) for (int rep_ = 0; rep_ < ((k) == REP_PH ? 2 : 1); ++rep_, ((k) == REP_PH && rep_ < 2) ? xcd_barrier(bar) : (void)0)
    if (IN(0)) REPS(0) { p0_prologue(F); } SEAM(0);
    if (IN(1)) REPS(1) {
        pg8::Gemm gm{(const pg8::bf16_t*)(F.ws + WS_XN), (const pg8::bf16_t*)(F.ws + WS_WIN), TT, NPROJ, DMODEL / 2};
        pg8::StaticOrder S; S.init(TT, NPROJ, F.G, (int)blockIdx.x);
        EpiProj E{(bf16*)(F.ws + WS_QKVA), (bf16*)(F.ws + WS_ZA), (bf16*)(F.ws + WS_QKVB), (const float*)(F.ws + WS_WSI), (const float*)(F.ws + WS_XSC)};
        pg8::gemm_phase_gather<EpiProj, pg8::StaticOrder, IdRows, true, true>(F.lds, gm, S, E, IdRows{});
    } SEAM(1);
    if (IN(2)) REPS(2) {
#ifndef NO_ROPE
        p2_rope(F);
#ifdef PROBE_ROPE2
        xcd_barrier(bar); p2_rope(F);
#endif
#endif
#ifndef NO_PRE
        p2_gdn_pre(F);
#ifdef PROBE_PRE2
        xcd_barrier(bar); p2_gdn_pre(F);
#endif
#endif
    } SEAM(2);
    if (IN(3)) REPS(3) {
        const attn_body::AttnTensors AT{(const attn_body::bf16*)((unsigned char*)F.out + DO_QR), (const attn_body::bf16*)((unsigned char*)F.out + DO_KR), (const attn_body::bf16*)((unsigned char*)F.out + DO_VR),
                                        (attn_body::bf16*)(F.ws + WS_OCAT) + 512};
        const attn_body::StaticOrder S((int)F.G, (int)blockIdx.x);
#ifdef PROBE_ZERO_ATTN
        { (void)AT; (void)S; bf16* OC = (bf16*)(F.ws + WS_OCAT); const int gt = blockIdx.x * NTHREADS + F.tid, GT = F.G * NTHREADS;
          for (int i = gt; i < TT * 64; i += GT) { const int t = i >> 6, c = i & 63; *(v4u*)(OC + (size_t)t * 1024 + 512 + c * 8) = (v4u){0u, 0u, 0u, 0u}; } }
#else
        const float nshift = -(0.125f * 1.4426950408889634f * 64.f * 1.01f) * wave_max(fabsf(F.in[7][F.lane])) * wave_max(fabsf(F.in[8][F.lane]));
        attn_body::attn_phase<attn_body::StaticOrder>((char*)lds, AT, S, nshift);
#endif
    }
#if MK_PER_PHASE
    SEAM(3);
#endif
    if (IN(4)) { p4_pass1(F); xcd_barrier(bar); p4_pass3(F); } SEAM(4);
    if (IN(5)) REPS(5) { p5_combine(F); } SEAM(5);
    if (IN(6)) REPS(6) {
        pg8::Gemm gm{(const pg8::bf16_t*)(F.ws + WS_OCAT), (const pg8::bf16_t*)(F.ws + WS_WOUT), TT, DMODEL, DMODEL}; pg8::StaticOrder S; S.init(TT, DMODEL, F.G, (int)blockIdx.x);
        EpiResid E{F.in[0], (bf16*)(F.ws + WS_X1)};
        pg8::gemm_phase<EpiResid, pg8::StaticOrder, true, true>(F.lds, gm, S, E);
    } SEAM(6);
    if (IN(7)) { p7_route(F); } SEAM(7);
    if (IN(9)) REPS(9) {
        build_etab(F);
        pg8::Gemm gm{(const pg8::bf16_t*)((unsigned char*)F.out + DO_HN), (const pg8::bf16_t*)(F.ws + WS_WGU0), 0, 0, DMODEL / 2};
        MoeOrder S{(const LAS unsigned*)(F.lds + ETAB_OFF), F.G, (int)blockIdx.x, WGU_SPLIT, (int)((WS_WGU1 - WS_WGU0) / (256 * 1024))};
        MoeRows AM{(const int*)(F.ws + WS_LIST), (const LAS unsigned*)(F.lds + ETAB_OFF)};
        EpiGU E{(bf16*)(F.ws + WS_HID), (const float*)(F.ws + WS_WSC), ((const LAS float*)(F.lds + ETAB_OFF))[352]};
        pg8::gemm_phase_gather<EpiGU, MoeOrder, MoeRows, true, true>(F.lds, gm, S, E, AM);
    } SEAM(9);
    if (IN(10)) REPS(10) {
        pg8::Gemm gm{(const pg8::bf16_t*)(F.ws + WS_HID), (const pg8::bf16_t*)((unsigned char*)F.out + DO_WD0), 0, 0, FFE}; build_etab(F); MoeOrder S{(const LAS unsigned*)(F.lds + ETAB_OFF), F.G, (int)blockIdx.x, WD_SPLIT, (int)((DO_WD1 - DO_WD0) / (256 * 1024))};
        EpiY E{(bf16*)(F.ws + WS_XBUF)};
        pg8::gemm_phase<EpiY, MoeOrder, true, true>(F.lds, gm, S, E);
    } SEAM(10);
#ifdef EXTRA_SYNCS
    for (int q_ = 0; q_ < EXTRA_SYNCS; ++q_) xcd_barrier(bar);
#endif
    if (IN(11)) { p11_final(F); }
#undef IN
#undef SEAM
}

extern "C" void kernel_launch(void* const* d_in, const int* in_sizes, int n_in, void* d_out, int out_size, void* d_ws, size_t ws_size, hipStream_t stream) {
    static int grid = 0;
    if (grid == 0) {
        if (n_in != 17 || out_size != TT * DMODEL || ws_size < WS_END) { fprintf(stderr, "kernel_launch: unexpected problem (n_in %d out %d ws %zu)\n", n_in, out_size, ws_size); grid = -1; return; }
        int dev = 0, cus = 0, per_cu = 0;
        if (hipGetDevice(&dev) != hipSuccess || hipDeviceGetAttribute(&cus, hipDeviceAttributeMultiprocessorCount, dev) != hipSuccess) { grid = -1; return; }
        if (hipFuncSetAttribute((const void*)fwd_kernel, hipFuncAttributeMaxDynamicSharedMemorySize, LDS_BYTES) != hipSuccess) { fprintf(stderr, "hipFuncSetAttribute failed\n"); grid = -1; return; }
        if (hipOccupancyMaxActiveBlocksPerMultiprocessor(&per_cu, (const void*)fwd_kernel, NTHREADS, LDS_BYTES) != hipSuccess || per_cu < 1) { fprintf(stderr, "occupancy query: %d\n", per_cu); grid = -1; return; }
        if (cus < 256) { fprintf(stderr, "kernel_launch: %d CUs; the scan phase's task map needs 256 workgroups\n", cus); grid = -1; return; }
        grid = cus;
    }
    if (grid < 0) return;
    (void)hipMemsetAsync((char*)d_ws + WS_CTL, 0, CTL_ZERO_BYTES, stream);
    Args a{};
    for (int i = 0; i < 17; ++i) a.in[i] = (const float*)d_in[i];
    a.out = (float*)d_out; a.ws = (unsigned char*)d_ws;
#if MK_PER_PHASE
    for (int p = 0; p < N_PHASES; ++p) { a.ph_lo = p; a.ph_hi = p + 1; hipLaunchKernelGGL(fwd_kernel, dim3(grid), dim3(NTHREADS), LDS_BYTES, stream, a); }
#else
    a.ph_lo = 0; a.ph_hi = N_PHASES;
    void* kargs[] = {&a};
    hipError_t e = hipLaunchCooperativeKernel((void*)fwd_kernel, dim3(grid), dim3(NTHREADS), kargs, LDS_BYTES, stream);
    if (e != hipSuccess) fprintf(stderr, "cooperative launch failed: %s (grid %d)\n", hipGetErrorString(e), grid);
#endif
}
```

```cpp
#include <hip/hip_runtime.h>
#include <cstdio>
#include <cstdint>
namespace pg8 {
#define PG8_LAS __attribute__((address_space(3)))
typedef unsigned short bf16_t;
typedef short bf16x8 __attribute__((ext_vector_type(8)));
typedef float f32x4 __attribute__((ext_vector_type(4)));
typedef unsigned u32x4 __attribute__((ext_vector_type(4)));
constexpr int BM = 256, BK = 64, HALF = 128, HTB = HALF * BK * 2  , STAGE_BYTES = 8 * HTB, NXCD = 8, WGM = 8;

__host__ __device__ __forceinline__ int lds_byte(int r, int c) { const int st = (r >> 4) * 2 + (c >> 5), rr = r & 15, cc = c & 31, ob = rr * 64 + cc * 2; return st * 1024 + (ob ^ (((ob >> 9) & 1) << 5)); }
__host__ __device__ __forceinline__ void stage_rc(int b, int& R, int& C) { const int st = b / 1024, sb = b % 1024, swz = sb ^ (((sb >> 9) & 1) << 5); R = (st >> 1) * 16 + swz / 64; C = (st & 1) * 32 + (swz % 64) / 2; }
__host__ __device__ __forceinline__ int perm32(int rho) { const int n = rho >> 4, i = rho & 15; return 8 * (i >> 2) + 4 * n + (i & 3); }

struct Unit { int pm, pn, ex, tq; };
struct Gemm { const bf16_t* A; const bf16_t* Bt; int M, N, K; };

struct StaticOrder {
    int nM, nN, nwg, G, c;
    __host__ __device__ void init(int M, int N, int G_, int c_) { nM = M / BM; nN = N / BM; nwg = nM * nN; G = G_; c = c_; }
    __host__ __device__ bool next(int i, Unit& u) const {
        const long L = (long)i * G + c; if (L >= nwg) return false;
        int wgid = (int)L; { const int q = nwg / NXCD, r = nwg % NXCD, xcd = wgid % NXCD, off = wgid / NXCD; wgid = (xcd < r ? xcd * (q + 1) : r * (q + 1) + (xcd - r) * q) + off; }
        const int nig = WGM * nN, gid = wgid / nig, fm = gid * WGM, gsz = (nM - fm) < WGM ? (nM - fm) : WGM;
        u.pm = fm + ((wgid % nig) % gsz); u.pn = (wgid % nig) / gsz; return true;
    }
    __device__ __forceinline__ void a_ready(const Unit&) const {}
    __device__ __forceinline__ void done(const Unit&) const {}
};

__device__ __forceinline__ unsigned cvt_pk_bf16(float lo, float hi) { unsigned r; asm volatile("v_cvt_pk_bf16_f32 %0, %1, %2" : "=v"(r) : "v"(lo), "v"(hi)); return r; }
typedef float f32x2 __attribute__((ext_vector_type(2)));
template <class Epi, class Sched, bool ALIGN_EPI = false, bool SP2 = false>
__device__ __forceinline__ void gemm_phase(PG8_LAS unsigned char* lds, const Gemm g, const Sched& S, const Epi& E) {
    const int tid = threadIdx.x, wid = __builtin_amdgcn_readfirstlane(tid >> 6), lane = tid & 63, wr = wid >> 2, wc = wid & 3, fr = lane & 15, fq = lane >> 4;
    const int K = g.K, nt = K / BK;
    unsigned voffA[2], voffB[2];
#pragma unroll
    for (int i = 0; i < 2; ++i) { int R, C; stage_rc(tid * 16 + i * 8192, R, C); const int Rb = Epi::PERM ? ((R & ~31) + perm32(R & 31)) : R;
        voffA[i] = (unsigned)(R * K + C) * 2u; voffB[i] = (unsigned)(Rb * K + C) * 2u; }
    const size_t kstep = (size_t)(BK * 2);
    const size_t hstep = (size_t)HALF * K * 2;
    const size_t tstep = 2 * hstep;
    const unsigned ldsw = (unsigned)wid * 1024u;
    const int aoff = lds_byte(wr * 64 + fr, fq * 8), boff = lds_byte(wc * 32 + fr, fq * 8);
#define PG8_SA(b, h) (((b) * 2 + (h)) * HTB)
#define PG8_SB(b, h) ((4 + (b) * 2 + (h)) * HTB)
#define PG8_STAGE(bufoff, gbase, voff) do { _Pragma("unroll") for (int _i = 0; _i < 2; ++_i) \
        __builtin_amdgcn_global_load_lds((const unsigned*)((const char*)(gbase) + (voff)[_i]), (PG8_LAS unsigned*)(lds + (bufoff) + ldsw + _i * 8192), 16, 0, 0); } while (0)
#define PG8_LDA(dst, b, h) do { _Pragma("unroll") for (int m = 0; m < 4; ++m) _Pragma("unroll") for (int k = 0; k < 2; ++k) dst[m][k] = *(const PG8_LAS bf16x8*)(lds + PG8_SA(b, h) + aoff + m * 2048 + k * 1024); } while (0)
#define PG8_LDB(dst, b, h) do { _Pragma("unroll") for (int n = 0; n < 2; ++n) _Pragma("unroll") for (int k = 0; k < 2; ++k) dst[n][k] = *(const PG8_LAS bf16x8*)(lds + PG8_SB(b, h) + boff + n * 2048 + k * 1024); } while (0)
#define PG8_MMA(ai, bj, At, Bt) do { __builtin_amdgcn_s_setprio(1); _Pragma("unroll") for (int m = 0; m < 4; ++m) _Pragma("unroll") for (int n = 0; n < 2; ++n) _Pragma("unroll") for (int k = 0; k < 2; ++k) \
        acc[ai][bj][m][n] = __builtin_amdgcn_mfma_f32_16x16x32_bf16(Bt[n][k], At[m][k], acc[ai][bj][m][n], 0, 0, 0); __builtin_amdgcn_s_setprio(0); } while (0)
#define PG8_WAIT_V(n) asm volatile("s_waitcnt vmcnt(" #n ")" ::: "memory")
#define PG8_WAIT_L(n) asm volatile("s_waitcnt lgkmcnt(" #n ")" ::: "memory")
#define PG8_BAR __builtin_amdgcn_s_barrier()
#define PG8_SCHED __builtin_amdgcn_sched_barrier(0)
    Unit cur, nxt; int ui = 0;
    if (!S.next(0, cur)) return;
    f32x4 acc[2][2][4][2];
#pragma unroll
    for (int a = 0; a < 2; ++a)
#pragma unroll
        for (int b = 0; b < 2; ++b)
#pragma unroll
            for (int m = 0; m < 4; ++m)
#pragma unroll
                for (int n = 0; n < 2; ++n) acc[a][b][m][n] = (f32x4){0.f, 0.f, 0.f, 0.f};
    bf16x8 At[4][2], B0[2][2], B1[2][2];
    const char* cA = (const char*)g.A + (size_t)cur.pm * tstep; const char* cB = (const char*)g.Bt + (size_t)cur.pn * tstep;
    S.a_ready(cur);
    if constexpr (SP2) {
        PG8_STAGE(PG8_SB(0, 0), cB, voffB); PG8_STAGE(PG8_SB(0, 1), cB + hstep, voffB); PG8_STAGE(PG8_SA(0, 0), cA, voffA); PG8_STAGE(PG8_SA(0, 1), cA + hstep, voffA);
        if (wr == 1) PG8_BAR;
        PG8_WAIT_V(2); PG8_BAR;
        PG8_STAGE(PG8_SB(1, 0), cB + kstep, voffB); PG8_STAGE(PG8_SA(1, 0), cA + kstep, voffA); PG8_STAGE(PG8_SB(1, 1), cB + hstep + kstep, voffB);
        PG8_WAIT_V(6); PG8_BAR;
    } else {
        PG8_STAGE(PG8_SB(0, 0), cB, voffB); PG8_STAGE(PG8_SA(0, 0), cA, voffA); PG8_STAGE(PG8_SB(0, 1), cB + hstep, voffB); PG8_STAGE(PG8_SA(0, 1), cA + hstep, voffA);
        if (wr == 1) PG8_BAR;
        PG8_WAIT_V(4); PG8_BAR;
        PG8_STAGE(PG8_SB(1, 0), cB + kstep, voffB); PG8_STAGE(PG8_SA(1, 0), cA + kstep, voffA); PG8_STAGE(PG8_SB(1, 1), cB + hstep + kstep, voffB);
        PG8_WAIT_V(6); PG8_BAR;
    }
    for (;;) {
        const bool has_next = S.next(ui + 1, nxt);
        const char* nA = has_next ? (const char*)g.A + (size_t)nxt.pm * tstep : cA; const char* nB = has_next ? (const char*)g.Bt + (size_t)nxt.pn * tstep : cB;
        for (int t = 0; t < nt; t += 2) {
            const bool last = (t == nt - 2);
            const char* a1 = cA + (size_t)(t + 1) * kstep;
            const char* a2 = last ? nA : cA + (size_t)(t + 2) * kstep; const char* b2 = last ? nB : cB + (size_t)(t + 2) * kstep;
            const char* a3 = a2 + kstep; const char* b3 = b2 + kstep;
            if (last && has_next) S.a_ready(nxt);
            if constexpr (SP2) {
            PG8_LDB(B0, 0, 0); PG8_LDB(B1, 0, 1); PG8_SCHED; PG8_LDA(At, 0, 0); PG8_STAGE(PG8_SA(1, 1), a1 + hstep, voffA);
            PG8_WAIT_V(8); PG8_WAIT_L(0); PG8_BAR; PG8_MMA(0, 0, At, B0); PG8_MMA(0, 1, At, B1); PG8_BAR; PG8_SCHED;
            PG8_LDA(At, 0, 1); PG8_STAGE(PG8_SB(0, 0), b2, voffB); PG8_STAGE(PG8_SB(0, 1), b2 + hstep, voffB); PG8_STAGE(PG8_SA(0, 0), a2, voffA);
            PG8_WAIT_V(8); PG8_WAIT_L(0); PG8_BAR; PG8_MMA(1, 0, At, B0); PG8_MMA(1, 1, At, B1); PG8_BAR; PG8_SCHED;
            PG8_LDB(B0, 1, 0); PG8_LDB(B1, 1, 1); PG8_SCHED; PG8_LDA(At, 1, 0); PG8_STAGE(PG8_SA(0, 1), a2 + hstep, voffA);
            PG8_WAIT_V(8); PG8_WAIT_L(0); PG8_BAR; PG8_MMA(0, 0, At, B0); PG8_MMA(0, 1, At, B1); PG8_BAR; PG8_SCHED;
            PG8_LDA(At, 1, 1); PG8_STAGE(PG8_SB(1, 0), b3, voffB); PG8_STAGE(PG8_SB(1, 1), b3 + hstep, voffB); PG8_STAGE(PG8_SA(1, 0), a3, voffA);
            PG8_WAIT_V(8); PG8_WAIT_L(0); PG8_BAR; PG8_MMA(1, 0, At, B0); PG8_MMA(1, 1, At, B1); PG8_BAR; PG8_SCHED;
            } else {
            PG8_LDB(B0, 0, 0); PG8_SCHED; PG8_LDA(At, 0, 0); PG8_STAGE(PG8_SA(1, 1), a1 + hstep, voffA);
            PG8_WAIT_L(8); PG8_BAR; PG8_WAIT_L(0); PG8_MMA(0, 0, At, B0); PG8_BAR; PG8_SCHED;
            PG8_LDB(B1, 0, 1); PG8_STAGE(PG8_SB(0, 0), b2, voffB);
            PG8_BAR; PG8_WAIT_L(0); PG8_MMA(0, 1, At, B1); PG8_BAR;
            PG8_LDA(At, 0, 1); PG8_STAGE(PG8_SA(0, 0), a2, voffA);
            PG8_BAR; PG8_WAIT_L(0); PG8_MMA(1, 0, At, B0); PG8_BAR; PG8_SCHED;
            PG8_STAGE(PG8_SB(0, 1), b2 + hstep, voffB);
            PG8_WAIT_V(6); PG8_BAR; PG8_MMA(1, 1, At, B1); PG8_BAR;
            PG8_LDB(B0, 1, 0); PG8_SCHED; PG8_LDA(At, 1, 0); PG8_STAGE(PG8_SA(0, 1), a2 + hstep, voffA);
            PG8_WAIT_L(8); PG8_BAR; PG8_WAIT_L(0); PG8_MMA(0, 0, At, B0); PG8_BAR; PG8_SCHED;
            PG8_LDB(B1, 1, 1); PG8_STAGE(PG8_SB(1, 0), b3, voffB);
            PG8_BAR; PG8_WAIT_L(0); PG8_MMA(0, 1, At, B1); PG8_BAR;
            PG8_LDA(At, 1, 1); PG8_STAGE(PG8_SA(1, 0), a3, voffA);
            PG8_BAR; PG8_WAIT_L(0); PG8_MMA(1, 0, At, B0); PG8_BAR; PG8_SCHED;
            PG8_STAGE(PG8_SB(1, 1), b3 + hstep, voffB);
            PG8_WAIT_V(6); PG8_BAR; PG8_MMA(1, 1, At, B1); PG8_BAR;
            }
        }
        if constexpr (ALIGN_EPI) { if (wr == 0) PG8_BAR; }
        if constexpr (!Epi::AFTER_DRAIN) { E(acc, cur, wr, wc, fr, fq); S.done(cur); }
        if (!has_next) break;
#pragma unroll
        for (int a = 0; a < 2; ++a)
#pragma unroll
            for (int b = 0; b < 2; ++b)
#pragma unroll
                for (int m = 0; m < 4; ++m)
#pragma unroll
                    for (int n = 0; n < 2; ++n) acc[a][b][m][n] = (f32x4){0.f, 0.f, 0.f, 0.f};
        cur = nxt; cA = nA; cB = nB; ++ui;
        if constexpr (ALIGN_EPI) { if (wr == 1) PG8_BAR; }
    }
    PG8_WAIT_V(0);
    if constexpr (!ALIGN_EPI) { if (wr == 0) PG8_BAR; }
    PG8_BAR;
    if constexpr (Epi::AFTER_DRAIN) { E.fused(acc, cur, wr, wc, fr, fq, lds, wid, lane); S.done(cur); }
#undef PG8_SA
#undef PG8_SB
#undef PG8_STAGE
#undef PG8_LDA
#undef PG8_LDB
#undef PG8_MMA
#undef PG8_WAIT_V
#undef PG8_WAIT_L
#undef PG8_BAR
#undef PG8_SCHED
}
typedef int i32x4 __attribute__((ext_vector_type(4)));
template <bool I8> struct AccSel { typedef f32x4 type; };
template <> struct AccSel<true> { typedef i32x4 type; };
template <bool I8> __device__ __forceinline__ void mma_step(typename AccSel<I8>::type& c, const bf16x8& b, const bf16x8& a) {
    if constexpr (I8) c = __builtin_amdgcn_mfma_i32_16x16x64_i8(__builtin_bit_cast(i32x4, b), __builtin_bit_cast(i32x4, a), c, 0, 0, 0);
    else c = __builtin_amdgcn_mfma_f32_16x16x32_bf16(b, a, c, 0, 0, 0);
}
template <class Epi, class Sched, class AMap, bool ALIGN_EPI = false, bool I8 = false>
__device__ __forceinline__ void gemm_phase_gather(PG8_LAS unsigned char* lds, const Gemm g, const Sched& S, const Epi& E, const AMap& AM) {
    constexpr bool SP2 = true;
    const int tid = threadIdx.x, wid = __builtin_amdgcn_readfirstlane(tid >> 6), lane = tid & 63, wr = wid >> 2, wc = wid & 3, fr = lane & 15, fq = lane >> 4;
    const int K = g.K, nt = K / BK;
    unsigned voffA[2], voffB[2]; int rowA[2];
#pragma unroll
    for (int i = 0; i < 2; ++i) { int R, C; stage_rc(tid * 16 + i * 8192, R, C); const int Rb = Epi::PERM ? ((R & ~31) + perm32(R & 31)) : R;
        voffA[i] = (unsigned)C * 2u; voffB[i] = (unsigned)(Rb * K + C) * 2u; rowA[i] = R; }
    const size_t kstep = (size_t)(BK * 2);
    const size_t hstep = (size_t)HALF * K * 2;
    const size_t tstep = 2 * hstep;
    const unsigned ldsw = (unsigned)wid * 1024u;
    const int aoff = lds_byte(wr * 64 + fr, fq * 8), boff = lds_byte(wc * 32 + fr, fq * 8);
#define PG8_SA(b, h) (((b) * 2 + (h)) * HTB)
#define PG8_SB(b, h) ((4 + (b) * 2 + (h)) * HTB)
#define PG8_STAGE(bufoff, gbase, voff) do { _Pragma("unroll") for (int _i = 0; _i < 2; ++_i) \
        __builtin_amdgcn_global_load_lds((const unsigned*)((const char*)(gbase) + (voff)[_i]), (PG8_LAS unsigned*)(lds + (bufoff) + ldsw + _i * 8192), 16, 0, 0); } while (0)
#define PG8_LDA(dst, b, h) do { _Pragma("unroll") for (int m = 0; m < 4; ++m) _Pragma("unroll") for (int k = 0; k < 2; ++k) dst[m][k] = *(const PG8_LAS bf16x8*)(lds + PG8_SA(b, h) + aoff + m * 2048 + k * 1024); } while (0)
#define PG8_LDB(dst, b, h) do { _Pragma("unroll") for (int n = 0; n < 2; ++n) _Pragma("unroll") for (int k = 0; k < 2; ++k) dst[n][k] = *(const PG8_LAS bf16x8*)(lds + PG8_SB(b, h) + boff + n * 2048 + k * 1024); } while (0)
#define PG8_MMA(ai, bj, At, Bt) do { __builtin_amdgcn_s_setprio(1); _Pragma("unroll") for (int m = 0; m < 4; ++m) _Pragma("unroll") for (int n = 0; n < 2; ++n) _Pragma("unroll") for (int k = 0; k < 2; ++k) \
        mma_step<I8>(acc[ai][bj][m][n], Bt[n][k], At[m][k]); __builtin_amdgcn_s_setprio(0); } while (0)
#define PG8_WAIT_V(n) asm volatile("s_waitcnt vmcnt(" #n ")" ::: "memory")
#define PG8_WAIT_L(n) asm volatile("s_waitcnt lgkmcnt(" #n ")" ::: "memory")
#define PG8_BAR __builtin_amdgcn_s_barrier()
#define PG8_SCHED __builtin_amdgcn_sched_barrier(0)
    Unit cur, nxt; int ui = 0;
    if (!S.next(0, cur)) return;
    typedef typename AccSel<I8>::type acc_t;
    acc_t acc[2][2][4][2];
#pragma unroll
    for (int a = 0; a < 2; ++a)
#pragma unroll
        for (int b = 0; b < 2; ++b)
#pragma unroll
            for (int m = 0; m < 4; ++m)
#pragma unroll
                for (int n = 0; n < 2; ++n) acc[a][b][m][n] = (acc_t){0, 0, 0, 0};
    bf16x8 At[4][2], B0[2][2], B1[2][2];
    const char* cA = (const char*)g.A; const char* cB = (const char*)g.Bt + (size_t)cur.pn * tstep;
    unsigned vA0[2], vA1[2], nA0[2], nA1[2];
#pragma unroll
    for (int i = 0; i < 2; ++i) { vA0[i] = (unsigned)AM.row(cur, rowA[i]) * (unsigned)(K * 2) + voffA[i]; vA1[i] = (unsigned)AM.row(cur, HALF + rowA[i]) * (unsigned)(K * 2) + voffA[i]; }
    S.a_ready(cur);
    if constexpr (SP2) {
        PG8_STAGE(PG8_SB(0, 0), cB, voffB); PG8_STAGE(PG8_SB(0, 1), cB + hstep, voffB); PG8_STAGE(PG8_SA(0, 0), cA, vA0); PG8_STAGE(PG8_SA(0, 1), cA, vA1);
        if (wr == 1) PG8_BAR;
        PG8_WAIT_V(2); PG8_BAR;
        PG8_STAGE(PG8_SB(1, 0), cB + kstep, voffB); PG8_STAGE(PG8_SA(1, 0), cA + kstep, vA0); PG8_STAGE(PG8_SB(1, 1), cB + hstep + kstep, voffB);
        PG8_WAIT_V(6); PG8_BAR;
    } else {
        PG8_STAGE(PG8_SB(0, 0), cB, voffB); PG8_STAGE(PG8_SA(0, 0), cA, voffA); PG8_STAGE(PG8_SB(0, 1), cB + hstep, voffB); PG8_STAGE(PG8_SA(0, 1), cA + hstep, voffA);
        if (wr == 1) PG8_BAR;
        PG8_WAIT_V(4); PG8_BAR;
        PG8_STAGE(PG8_SB(1, 0), cB + kstep, voffB); PG8_STAGE(PG8_SA(1, 0), cA + kstep, voffA); PG8_STAGE(PG8_SB(1, 1), cB + hstep + kstep, voffB);
        PG8_WAIT_V(6); PG8_BAR;
    }
    for (;;) {
        const bool has_next = S.next(ui + 1, nxt);
        const char* nA = cA; const char* nB = has_next ? (const char*)g.Bt + (size_t)nxt.pn * tstep : cB;
#pragma unroll
        for (int i = 0; i < 2; ++i) { nA0[i] = has_next ? (unsigned)AM.row(nxt, rowA[i]) * (unsigned)(K * 2) + voffA[i] : vA0[i]; nA1[i] = has_next ? (unsigned)AM.row(nxt, HALF + rowA[i]) * (unsigned)(K * 2) + voffA[i] : vA1[i]; }
        for (int t = 0; t < nt; t += 2) {
            const bool last = (t == nt - 2);
            const char* a1 = cA + (size_t)(t + 1) * kstep;
            const char* a2 = last ? nA : cA + (size_t)(t + 2) * kstep; const char* b2 = last ? nB : cB + (size_t)(t + 2) * kstep;
            const char* a3 = a2 + kstep; const char* b3 = b2 + kstep;
            unsigned s0[2], s1[2];
#pragma unroll
            for (int i = 0; i < 2; ++i) { s0[i] = vA0[i]; s1[i] = vA1[i]; }
            if (last) {
#pragma unroll
                for (int i = 0; i < 2; ++i) { unsigned t0_ = nA0[i], t1_ = nA1[i]; asm volatile("" : "+v"(t0_), "+v"(t1_)); s0[i] = t0_; s1[i] = t1_; } }
            if (last && has_next) S.a_ready(nxt);
            if constexpr (SP2) {
            PG8_LDB(B0, 0, 0); PG8_LDB(B1, 0, 1); PG8_SCHED; PG8_LDA(At, 0, 0); PG8_STAGE(PG8_SA(1, 1), a1, vA1);
            PG8_WAIT_V(8); PG8_WAIT_L(0); PG8_BAR; PG8_MMA(0, 0, At, B0); PG8_MMA(0, 1, At, B1); PG8_BAR; PG8_SCHED;
            PG8_LDA(At, 0, 1); PG8_STAGE(PG8_SB(0, 0), b2, voffB); PG8_STAGE(PG8_SB(0, 1), b2 + hstep, voffB); PG8_STAGE(PG8_SA(0, 0), a2, s0);
            PG8_WAIT_V(8); PG8_WAIT_L(0); PG8_BAR; PG8_MMA(1, 0, At, B0); PG8_MMA(1, 1, At, B1); PG8_BAR; PG8_SCHED;
            PG8_LDB(B0, 1, 0); PG8_LDB(B1, 1, 1); PG8_SCHED; PG8_LDA(At, 1, 0); PG8_STAGE(PG8_SA(0, 1), a2, s1);
            PG8_WAIT_V(8); PG8_WAIT_L(0); PG8_BAR; PG8_MMA(0, 0, At, B0); PG8_MMA(0, 1, At, B1); PG8_BAR; PG8_SCHED;
            PG8_LDA(At, 1, 1); PG8_STAGE(PG8_SB(1, 0), b3, voffB); PG8_STAGE(PG8_SB(1, 1), b3 + hstep, voffB); PG8_STAGE(PG8_SA(1, 0), a3, s0);
            PG8_WAIT_V(8); PG8_WAIT_L(0); PG8_BAR; PG8_MMA(1, 0, At, B0); PG8_MMA(1, 1, At, B1); PG8_BAR; PG8_SCHED;
            } else {
            PG8_LDB(B0, 0, 0); PG8_SCHED; PG8_LDA(At, 0, 0); PG8_STAGE(PG8_SA(1, 1), a1 + hstep, voffA);
            PG8_WAIT_L(8); PG8_BAR; PG8_WAIT_L(0); PG8_MMA(0, 0, At, B0); PG8_BAR; PG8_SCHED;
            PG8_LDB(B1, 0, 1); PG8_STAGE(PG8_SB(0, 0), b2, voffB);
            PG8_BAR; PG8_WAIT_L(0); PG8_MMA(0, 1, At, B1); PG8_BAR;
            PG8_LDA(At, 0, 1); PG8_STAGE(PG8_SA(0, 0), a2, voffA);
            PG8_BAR; PG8_WAIT_L(0); PG8_MMA(1, 0, At, B0); PG8_BAR; PG8_SCHED;
            PG8_STAGE(PG8_SB(0, 1), b2 + hstep, voffB);
            PG8_WAIT_V(6); PG8_BAR; PG8_MMA(1, 1, At, B1); PG8_BAR;
            PG8_LDB(B0, 1, 0); PG8_SCHED; PG8_LDA(At, 1, 0); PG8_STAGE(PG8_SA(0, 1), a2 + hstep, voffA);
            PG8_WAIT_L(8); PG8_BAR; PG8_WAIT_L(0); PG8_MMA(0, 0, At, B0); PG8_BAR; PG8_SCHED;
            PG8_LDB(B1, 1, 1); PG8_STAGE(PG8_SB(1, 0), b3, voffB);
            PG8_BAR; PG8_WAIT_L(0); PG8_MMA(0, 1, At, B1); PG8_BAR;
            PG8_LDA(At, 1, 1); PG8_STAGE(PG8_SA(1, 0), a3, voffA);
            PG8_BAR; PG8_WAIT_L(0); PG8_MMA(1, 0, At, B0); PG8_BAR; PG8_SCHED;
            PG8_STAGE(PG8_SB(1, 1), b3 + hstep, voffB);
            PG8_WAIT_V(6); PG8_BAR; PG8_MMA(1, 1, At, B1); PG8_BAR;
            }
        }
        if constexpr (ALIGN_EPI) { if (wr == 0) PG8_BAR; }
        if constexpr (!Epi::AFTER_DRAIN) { E(acc, cur, wr, wc, fr, fq); S.done(cur); }
        if (!has_next) break;
#pragma unroll
        for (int a = 0; a < 2; ++a)
#pragma unroll
            for (int b = 0; b < 2; ++b)
#pragma unroll
                for (int m = 0; m < 4; ++m)
#pragma unroll
                    for (int n = 0; n < 2; ++n) acc[a][b][m][n] = (acc_t){0, 0, 0, 0};
        cur = nxt; cA = nA; cB = nB; ++ui;
#pragma unroll
        for (int i = 0; i < 2; ++i) { vA0[i] = nA0[i]; vA1[i] = nA1[i]; }
        if constexpr (ALIGN_EPI) { if (wr == 1) PG8_BAR; }
    }
    PG8_WAIT_V(0);
    if constexpr (!ALIGN_EPI) { if (wr == 0) PG8_BAR; }
    PG8_BAR;
    if constexpr (Epi::AFTER_DRAIN) { E.fused(acc, cur, wr, wc, fr, fq, lds, wid, lane); S.done(cur); }
#undef PG8_SA
#undef PG8_SB
#undef PG8_STAGE
#undef PG8_LDA
#undef PG8_LDB
#undef PG8_MMA
#undef PG8_WAIT_V
#undef PG8_WAIT_L
#undef PG8_BAR
#undef PG8_SCHED
}
}
#include <hip/hip_bf16.h>
#include <cmath>
namespace attn_body {
using bf16=__hip_bfloat16;
using bf16x8=__attribute__((ext_vector_type(8)))short;
using s16x4=__attribute__((ext_vector_type(4)))short;
using f32x16=__attribute__((ext_vector_type(16)))float;
using u32x4=__attribute__((ext_vector_type(4)))unsigned;
constexpr int BATCH=2,NHEAD=8,NKVH=2,SEQ=8192,D=64,QP=512,KP=128,OP=1024;
constexpr int NW=8,QBLK=32,QB=QBLK*NW,KVBLK=64,NQB=SEQ/QB;
constexpr int ATTN_UNIT_ROWS=QB;
__device__ __forceinline__ int crow(int r,int hi){return (r&3)+8*(r>>2)+4*hi;}
#define SBAR() __builtin_amdgcn_sched_barrier(0)
__device__ __forceinline__ void cmask(f32x16&p0,f32x16&p1,int jb,int qrel,int hi){
  const float NEG=-INFINITY; int kb=64*jb+4*hi;
  #pragma unroll
  for(int r=0;r<16;++r){int kv=kb+(r&3)+8*(r>>2); if(kv>qrel)p0[r]=NEG; if(kv+32>qrel)p1[r]=NEG;}
}

constexpr int NSLOT=3, SLOTB=8192;
constexpr int LDS_K=0, LDS_V=NSLOT*SLOTB, LDS_WS=2*NSLOT*SLOTB, LDS_OST=LDS_WS+NW*64*4, LDS_BYTES=LDS_OST+NW*4096;
constexpr float C2=0.125f*1.4426950408889634f;
__device__ __forceinline__ void glds16(const void*gsrc,unsigned lds_dst){unsigned keep;
  asm volatile("s_mov_b32 %0, m0\n\ts_mov_b32 m0, %2\n\ts_nop 0\n\tglobal_load_lds_dwordx4 %1, off\n\ts_mov_b32 m0, %0":"=&s"(keep):"v"(gsrc),"s"(lds_dst):"memory");}
__device__ __forceinline__ float max3f(float a,float b,float c){float r;asm("v_max3_f32 %0, %1, %2, %3":"=v"(r):"v"(a),"v"(b),"v"(c));return r;}
__device__ __forceinline__ float max2f(float a,float b){float r;asm("v_max_f32_e32 %0, %1, %2":"=v"(r):"v"(a),"v"(b));return r;}
__device__ __forceinline__ float fadd_s(float a,float b){float r;asm("v_add_f32_e32 %0, %1, %2":"=v"(r):"v"(a),"v"(b));return r;}
__device__ __forceinline__ float fsub_s(float a,float b){float r;asm("v_sub_f32_e32 %0, %1, %2":"=v"(r):"v"(a),"v"(b));return r;}
typedef float f32x2_t __attribute__((ext_vector_type(2))); typedef __bf16 bf16x2_t __attribute__((ext_vector_type(2)));
__device__ __forceinline__ unsigned cvtpk_s(float lo,float hi){f32x2_t v={lo,hi};bf16x2_t b=__builtin_convertvector(v,bf16x2_t);return __builtin_bit_cast(unsigned,b);}
#define WAIT_BAR(N) asm volatile("s_waitcnt vmcnt(" #N ") lgkmcnt(0)\n\ts_barrier":::"memory")

__device__ __forceinline__ void qkt(f32x16&p0,f32x16&p1,const char*Kslot,const bf16x8*qr,const f32x16&negm,int r32,int hi){
  const char*kb=Kslot+hi*1024+r32*16;
  #pragma unroll
  for(int d0=0;d0<4;++d0){
    const bf16x8 b0=*reinterpret_cast<const bf16x8*>(kb+d0*2048);
    const bf16x8 b1=*reinterpret_cast<const bf16x8*>(kb+d0*2048+512);
    if(d0==0){p0=__builtin_amdgcn_mfma_f32_32x32x16_bf16(b0,qr[0],negm,0,0,0);p1=__builtin_amdgcn_mfma_f32_32x32x16_bf16(b1,qr[0],negm,0,0,0);}
    else{p0=__builtin_amdgcn_mfma_f32_32x32x16_bf16(b0,qr[d0],p0,0,0,0);p1=__builtin_amdgcn_mfma_f32_32x32x16_bf16(b1,qr[d0],p1,0,0,0);}}
}
typedef __attribute__((address_space(3))) const char* lds_cptr;
typedef short v4i16_t __attribute__((ext_vector_type(4)));
__device__ __forceinline__ void kload8(bf16x8*kf,lds_cptr kp){
  kf[0]=*(const __attribute__((address_space(3))) bf16x8*)(kp);      kf[1]=*(const __attribute__((address_space(3))) bf16x8*)(kp+512);
  kf[2]=*(const __attribute__((address_space(3))) bf16x8*)(kp+2048); kf[3]=*(const __attribute__((address_space(3))) bf16x8*)(kp+2560);
  kf[4]=*(const __attribute__((address_space(3))) bf16x8*)(kp+4096); kf[5]=*(const __attribute__((address_space(3))) bf16x8*)(kp+4608);
  kf[6]=*(const __attribute__((address_space(3))) bf16x8*)(kp+6144); kf[7]=*(const __attribute__((address_space(3))) bf16x8*)(kp+6656);
}
__device__ __forceinline__ void kload2(bf16x8*kf,lds_cptr kp,int j){ kf[2*j]=*(const __attribute__((address_space(3))) bf16x8*)(kp+j*2048); kf[2*j+1]=*(const __attribute__((address_space(3))) bf16x8*)(kp+j*2048+512); }
__device__ __forceinline__ s16x4 vtr(lds_cptr p){ return __builtin_bit_cast(s16x4,__builtin_amdgcn_ds_read_tr16_b64_v4i16((__attribute__((address_space(3))) v4i16_t*)p)); }
__device__ __forceinline__ float rowmax(const f32x16&p0,const f32x16&p1){
  float a=max3f(p0[0],p0[1],p1[0]),b=max3f(p0[2],p0[3],p1[1]);a=max3f(a,p1[2],p1[3]);
  #pragma unroll
  for(int r=4;r<16;r+=4){a=max3f(a,p0[r],p0[r+1]);b=max3f(b,p0[r+2],p0[r+3]);a=max3f(a,p1[r],p1[r+1]);b=max3f(b,p1[r+2],p1[r+3]);}
  const float m=max2f(a,b);
  auto rr=__builtin_amdgcn_permlane32_swap(__float_as_uint(m),__float_as_uint(m),false,false);
  return max2f(__uint_as_float(rr[0]),__uint_as_float(rr[1]));
}
__device__ __forceinline__ void pv(f32x16*o,int vb,bf16x8 pa0,bf16x8 pa1,bf16x8 pa2,bf16x8 pa3){
  #pragma unroll
  for(int d0=0;d0<2;++d0){s16x4 lo[4],hi[4];
    #pragma unroll
    for(int ks=0;ks<4;++ks){
      asm volatile("ds_read_b64_tr_b16 %0,%1 offset:%c2":"=&v"(lo[ks]):"v"(vb),"i"(d0*4096+ks*1024):"memory");
      asm volatile("ds_read_b64_tr_b16 %0,%1 offset:%c2":"=&v"(hi[ks]):"v"(vb),"i"(d0*4096+ks*1024+512):"memory");}
    asm volatile("s_waitcnt lgkmcnt(0)":::"memory");SBAR();
    #define PK(k) (bf16x8){lo[k][0],lo[k][1],lo[k][2],lo[k][3],hi[k][0],hi[k][1],hi[k][2],hi[k][3]}
    o[d0]=__builtin_amdgcn_mfma_f32_32x32x16_bf16(pa0,PK(0),o[d0],0,0,0);
    o[d0]=__builtin_amdgcn_mfma_f32_32x32x16_bf16(pa1,PK(1),o[d0],0,0,0);
    o[d0]=__builtin_amdgcn_mfma_f32_32x32x16_bf16(pa2,PK(2),o[d0],0,0,0);
    o[d0]=__builtin_amdgcn_mfma_f32_32x32x16_bf16(pa3,PK(3),o[d0],0,0,0);
    #undef PK
  }
}

#ifndef ATTN_STORE16
#define ATTN_STORE16(p,v) (*(u32x4*)(p)=(v))
#endif
template<int THRL> __device__ __forceinline__ void attn_unit(int b,int h,int qb,const bf16*Q,const bf16*__restrict__ K,const bf16*__restrict__ V,bf16*O,char*shm,const float nshift){
  const int tid=threadIdx.x,lane=tid&63,r32=lane&31,hi=lane>>5; const int wid=__builtin_amdgcn_readfirstlane(tid>>6);
  const long rowbase=(long)b*SEQ; const int q0=qb*QB;
  const bf16*Qw=Q+(rowbase+q0+wid*QBLK)*QP+h*D;
  const int hk=h/(NHEAD/NKVH); const bf16*Kh=K+(long)(b*NKVH+hk)*SEQ*D,*Vh=V+(long)(b*NKVH+hk)*SEQ*D;
  const unsigned lds0=(unsigned)(uintptr_t)shm;
  float*wsf=(float*)(shm+LDS_WS)+wid*64;
  const bf16*ksrc=Kh+(wid*64+lane)*8;
  const bf16*vsrc=Vh+(wid*64+lane)*8;
  const unsigned kdst=lds0+LDS_K+wid*1024, vdst=lds0+LDS_V+wid*1024;
  #define DMA_K(t,slot) glds16(ksrc+(long)(t)*KVBLK*D,(unsigned)__builtin_amdgcn_readfirstlane(kdst+(slot)))
  #define DMA_V(t,slot) glds16(vsrc+(long)(t)*KVBLK*D,(unsigned)__builtin_amdgcn_readfirstlane(vdst+(slot)))
  const int vb0=(int)(lds0+LDS_V)+((lane>>4)&1)*32+(lane&3)*8+(4*hi+((lane&15)>>2))*64;
  const char*Kbase=shm+LDS_K; bf16x8 kf[8];
  const lds_cptr shm3=(lds_cptr)shm; const lds_cptr kp0=shm3+LDS_K+hi*1024+r32*16; const lds_cptr vp0=shm3+LDS_V+((lane>>4)&1)*32+(lane&3)*8+(4*hi+((lane&15)>>2))*64;
  constexpr int NT=SEQ/KVBLK;
  DMA_K(0,0);DMA_V(0,0);DMA_K(1,SLOTB);
  bf16x8 qr[4];
  #pragma unroll
  for(int d0=0;d0<4;++d0)qr[d0]=*reinterpret_cast<const bf16x8*>(&Qw[(long)r32*QP+d0*16+hi*8]);
  float l_reg=0.f;f32x16 o[2];o[0]=f32x16{};o[1]=f32x16{};f32x16 negm;
  _Pragma("unroll") for(int r=0;r<16;++r)negm[r]=nshift; asm volatile("":"+v"(negm));
  const int qrel=wid*QBLK+r32;
  #define CMASK(P0,P1,t) do{}while(0)
  #define START(P0,P1) do{ _Pragma("unroll") for(int r=0;r<16;++r)P0[r]=__builtin_amdgcn_exp2f(P0[r]); }while(0)
  f32x16 pA0,pA1,pB0,pB1;
  int sl_prev=0,sl_cur=0,sl_next=SLOTB;
  #define ROT() do{sl_prev=sl_cur;sl_cur=sl_next;sl_next=(sl_next==(NSLOT-1)*SLOTB)?0:sl_next+SLOTB;}while(0)
  DMA_K(2,2*SLOTB);
  WAIT_BAR(3);
  qkt(pA0,pA1,Kbase,qr,negm,r32,hi);asm volatile("s_nop 15\n\ts_nop 7":"+v"(pA0),"+v"(pA1));CMASK(pA0,pA1,0);
  START(pA0,pA1);
  _Pragma("unroll") for(int r=0;r<16;++r)pA1[r]=__builtin_amdgcn_exp2f(pA1[r]);
  WAIT_BAR(0);
  DMA_K(3,0);DMA_V(1,SLOTB);
  ROT();
  kload8(kf,kp0+sl_cur);
  WAIT_BAR(2);
  s16x4 vlo[8],vhi[8]; u32x4 pw0,pw1,pw2,pw3;
  #define PKW(P,B) cvtpk_s(P[B],P[B+1])
  #define PAF(k) __builtin_bit_cast(bf16x8,pw##k)
  #define VFR(i) (bf16x8){vlo[i][0],vlo[i][1],vlo[i][2],vlo[i][3],vhi[i][0],vhi[i][1],vhi[i][2],vhi[i][3]}
  #define PIN(x) asm volatile("":"+v"(x))
  #define GAPA(MF,A0,A1,A2,A3,W0,W1,PW) do{ MF; sacc+=A0; sacc+=A1; sacc+=A2; sacc+=A3; PIN(sacc); W0; W1; PIN(PW); SBAR(); }while(0)
  #define EX(v) __builtin_amdgcn_exp2f(v)
  #define GAPB(MF,X,B) do{ MF; X[B]=EX(X[B]); X[B+1]=EX(X[B+1]); X[B+2]=EX(X[B+2]); X[B+3]=EX(X[B+3]); PIN(X); SBAR(); }while(0)
  #define VRD(i) do{ vlo[i]=vtr(vp_+(((i)>>2)*4096+((i)&3)*1024)); vhi[i]=vtr(vp_+(((i)>>2)*4096+((i)&3)*1024+512)); }while(0)
  #define KRD(G,j) do{ if(G){ kload2(kf,kp0+sl_next,j); SBAR(); } }while(0)
  #define STEP(C0,C1,P0,P1,t,GK,GV,GL) do{ SBAR(); \
    const lds_cptr vp_=vp0+sl_prev; \
    VRD(0); SBAR(); float sacc=(P0[0]+P0[1]); \
    GAPA(C0=__builtin_amdgcn_mfma_f32_32x32x16_bf16(kf[0],qr[0],negm,0,0,0), P0[2],P0[3],P0[4],P0[5],     pw0[0]=PKW(P0,0), pw0[1]=PKW(P0,2), pw0); \
    VRD(4); SBAR(); GAPA(C1=__builtin_amdgcn_mfma_f32_32x32x16_bf16(kf[1],qr[0],negm,0,0,0), P0[6],P0[7],P0[8],P0[9],     pw0[2]=PKW(P0,4), pw0[3]=PKW(P0,6), pw0); \
    VRD(1); SBAR(); GAPA(C0=__builtin_amdgcn_mfma_f32_32x32x16_bf16(kf[2],qr[1],C0,0,0,0),   P0[10],P0[11],P0[12],P0[13], pw1[0]=PKW(P0,8), pw1[1]=PKW(P0,10), pw1); \
    VRD(5); SBAR(); GAPA(C1=__builtin_amdgcn_mfma_f32_32x32x16_bf16(kf[3],qr[1],C1,0,0,0),   P0[14],P0[15],P1[0],P1[1],   pw1[2]=PKW(P0,12),pw1[3]=PKW(P0,14), pw1); \
    VRD(2); SBAR(); GAPA(C0=__builtin_amdgcn_mfma_f32_32x32x16_bf16(kf[4],qr[2],C0,0,0,0),   P1[2],P1[3],P1[4],P1[5],     pw2[0]=PKW(P1,0), pw2[1]=PKW(P1,2), pw2); \
    VRD(6); SBAR(); GAPA(C1=__builtin_amdgcn_mfma_f32_32x32x16_bf16(kf[5],qr[2],C1,0,0,0),   P1[6],P1[7],P1[8],P1[9],     pw2[2]=PKW(P1,4), pw2[3]=PKW(P1,6), pw2); \
    VRD(3); SBAR(); GAPA(C0=__builtin_amdgcn_mfma_f32_32x32x16_bf16(kf[6],qr[3],C0,0,0,0),   P1[10],P1[11],P1[12],P1[13], pw3[0]=PKW(P1,8), pw3[1]=PKW(P1,10), pw3); \
    VRD(7); SBAR(); GAPA(C1=__builtin_amdgcn_mfma_f32_32x32x16_bf16(kf[7],qr[3],C1,0,0,0),   P1[14],P1[15],0.f,0.f,       pw3[2]=PKW(P1,12),pw3[3]=PKW(P1,14), pw3); \
    l_reg+=sacc; \
    if(GK){DMA_K((t)+3,sl_cur);} if(GV){DMA_V((t)+1,sl_next);} \
    CMASK(C0,C1,t); \
    SBAR(); \
    GAPB(o[0]=__builtin_amdgcn_mfma_f32_32x32x16_bf16(PAF(0),VFR(0),o[0],0,0,0), C0,0); \
    GAPB(o[1]=__builtin_amdgcn_mfma_f32_32x32x16_bf16(PAF(0),VFR(4),o[1],0,0,0), C0,4); \
    KRD(GL,0); GAPB(o[0]=__builtin_amdgcn_mfma_f32_32x32x16_bf16(PAF(1),VFR(1),o[0],0,0,0), C0,8); \
    KRD(GL,1); GAPB(o[1]=__builtin_amdgcn_mfma_f32_32x32x16_bf16(PAF(1),VFR(5),o[1],0,0,0), C0,12); \
    KRD(GL,2); GAPB(o[0]=__builtin_amdgcn_mfma_f32_32x32x16_bf16(PAF(2),VFR(2),o[0],0,0,0), C1,0); \
    KRD(GL,3); GAPB(o[1]=__builtin_amdgcn_mfma_f32_32x32x16_bf16(PAF(2),VFR(6),o[1],0,0,0), C1,4); \
    GAPB(o[0]=__builtin_amdgcn_mfma_f32_32x32x16_bf16(PAF(3),VFR(3),o[0],0,0,0), C1,8); \
    GAPB(o[1]=__builtin_amdgcn_mfma_f32_32x32x16_bf16(PAF(3),VFR(7),o[1],0,0,0), C1,12); \
    }while(0)
  int t=1;
  #undef CMASK
  #define CMASK(P0,P1,t) do{}while(0)
  for(;t+5<NT;t+=2){
    STEP(pB0,pB1,pA0,pA1,t,true,true,true);     WAIT_BAR(2); ROT();
    STEP(pA0,pA1,pB0,pB1,t+1,true,true,true);   WAIT_BAR(2); ROT();
  }
  #undef CMASK
  #define CMASK(P0,P1,t) do{}while(0)
  #define ENDW(tt) do{ if((tt)+3<NT){WAIT_BAR(2);} else if((tt)+2<NT){WAIT_BAR(1);} else {WAIT_BAR(0);} }while(0)
  for(;t+1<NT;t+=2){
    STEP(pB0,pB1,pA0,pA1,t,(t+3<NT),(t+1<NT),(t+1<NT));       ENDW(t);   ROT();
    STEP(pA0,pA1,pB0,pB1,t+1,(t+4<NT),(t+2<NT),(t+2<NT));     ENDW(t+1); ROT();
  }
  STEP(pB0,pB1,pA0,pA1,NT-1,false,false,false);
  { float sacc=pB0[0]+pB0[1]; _Pragma("unroll") for(int r=2;r<16;++r)sacc+=pB0[r]; _Pragma("unroll") for(int r=0;r<16;++r)sacc+=pB1[r]; l_reg+=sacc;
    pw0=(u32x4){PKW(pB0,0),PKW(pB0,2),PKW(pB0,4),PKW(pB0,6)};pw1=(u32x4){PKW(pB0,8),PKW(pB0,10),PKW(pB0,12),PKW(pB0,14)};pw2=(u32x4){PKW(pB1,0),PKW(pB1,2),PKW(pB1,4),PKW(pB1,6)};pw3=(u32x4){PKW(pB1,8),PKW(pB1,10),PKW(pB1,12),PKW(pB1,14)};
    SBAR(); pv(o,vb0+sl_cur,PAF(0),PAF(1),PAF(2),PAF(3)); }
  #undef PKW
  #undef PAF
  #undef VFR
  #undef PIN
  #undef GAPA
  #undef GAPB
  #undef EX
  #undef VRD
  #undef KRD
  #undef STEP
  #undef ENDW
  {auto rr=__builtin_amdgcn_permlane32_swap(__float_as_uint(l_reg),__float_as_uint(l_reg),false,false);l_reg=__uint_as_float(rr[0])+__uint_as_float(rr[1]);}
  if(hi==0)wsf[32+r32]=l_reg;asm volatile("s_waitcnt lgkmcnt(0)":::"memory");
  float rli[16];
  #pragma unroll
  for(int r=0;r<16;++r)rli[r]=__builtin_amdgcn_rcpf(wsf[32+crow(r,hi)]);
  bf16*Ow=O+(rowbase+q0+wid*QBLK)*OP+h*D;
  { bf16*stg=(bf16*)(shm+LDS_OST)+wid*2048;
    #pragma unroll
    for(int r=0;r<16;++r){const int orow=crow(r,hi);
      #pragma unroll
      for(int d0=0;d0<2;++d0)stg[orow*64+d0*32+r32]=__float2bfloat16(o[d0][r]*rli[r]);}
    asm volatile("s_waitcnt lgkmcnt(0)":::"memory");
    #pragma unroll
    for(int i=0;i<4;++i){const int row=i*8+(lane>>3),ch=lane&7; const u32x4 v=*(const u32x4*)(stg+row*64+ch*8); ATTN_STORE16(Ow+(long)row*OP+ch*8,v);} }
  asm volatile("s_waitcnt lgkmcnt(0)\n\ts_barrier":::"memory");
  #undef DMA_K
  #undef DMA_V
  #undef CMASK
  #undef START
  #undef ROT
}
constexpr int ATTN_LDS_BYTES=LDS_BYTES;
struct AttnTensors { const bf16* Q; const bf16* K; const bf16* V; bf16* O; };
struct AttnUnit { int bh; int qb; };
struct StaticOrder {
  int vcu, G;
  __device__ __forceinline__ explicit StaticOrder(int grid,int block):vcu((grid%8==0)?(block%8)*(grid/8)+block/8:block),G(grid){}
  __device__ __forceinline__ bool next(int i,AttnUnit&u)const{
    const int L=i*G+vcu; if(L>=BATCH*NHEAD*NQB)return false;
    if(G==256){ if(i>=2)return false; const int x=vcu>>5,j=vcu&31; const int b=x>>2,kvh=(x>>1)&1,hq=kvh*4+2*(x&1)+i; u.bh=b*NHEAD+hq; u.qb=j; return true; }
    u.bh=L/NQB; u.qb=L%NQB; return true; }
  __device__ __forceinline__ void a_ready(const AttnUnit&)const{}
  __device__ __forceinline__ void done(const AttnUnit&)const{}
};
template<class Sched,int THRL=8> __device__ __forceinline__ void attn_phase(char*lds,const AttnTensors&T,const Sched&S,const float nshift){
  AttnUnit u;
  for(int i=0;S.next(i,u);++i){ S.a_ready(u); attn_unit<THRL>(u.bh/NHEAD,u.bh%NHEAD,u.qb,T.Q,T.K,T.V,T.O,lds,nshift); S.done(u); }
}
#undef SBAR
#undef WAIT_BAR
}

#include <hip/hip_cooperative_groups.h>
namespace cg = cooperative_groups;
#ifndef MK_PER_PHASE
#define MK_PER_PHASE 0
#endif
constexpr int NWAVES = 8, NTHREADS = 512;
constexpr int NB = 2, SEQ = 8192, DMODEL = 1024, TT = NB * SEQ;
constexpr int NPROJ = 2816;
constexpr int NEXP = 32, FFE = 512;
constexpr float EPS = 1e-6f;
constexpr int N_PHASES = 12;

constexpr size_t MiB = 1u << 20;
constexpr size_t WS_CTL = 0, CTL_ZERO_BYTES = 64 * 1024;
constexpr size_t WS_WOUT = 1 * MiB;
constexpr size_t WS_LIST = 229 * MiB;
constexpr size_t WS_WR = 3 * MiB;
constexpr size_t WS_TOK = 3 * MiB + 256 * 1024;
constexpr size_t WS_GATES = 4 * MiB;
constexpr size_t WS_WIN = 5 * MiB;
constexpr size_t WS_WSI = 3 * MiB + 896 * 1024;
constexpr size_t WS_XSC = 3 * MiB + 912 * 1024;
constexpr size_t WS_A = 11 * MiB;
constexpr size_t WS_XN = WS_A;
constexpr size_t GDN_SH_BYTES = 71680, GDN_D_BYTES = 19456;
constexpr size_t WS_GSH = WS_A;
constexpr size_t WS_GD = WS_A + 1024 * GDN_SH_BYTES;
constexpr size_t WS_X1 = 5 * MiB;
constexpr size_t WS_HID = 69 * MiB;
constexpr size_t WS_XBUF = 109 * MiB;
constexpr size_t WS_B = 157 * MiB;
constexpr size_t WS_QKVA = WS_B;
constexpr size_t WS_QKVB = WS_B + 48 * MiB;
constexpr size_t WS_ZA = WS_B + 72 * MiB;
constexpr size_t WS_OCAT = WS_B;
constexpr size_t WS_WGU0 = 189 * MiB, WS_WGU1 = 245 * MiB; constexpr int WGU_SPLIT = 20;
constexpr size_t WS_WSC = 3 * MiB + 768 * 1024;
constexpr float ACT_CLIP = 6.0f;
constexpr size_t DO_WD0 = 0, DO_WD1 = 56 * MiB; constexpr int WD_SPLIT = 24;
constexpr size_t DO_HN = 24 * MiB;
constexpr size_t WS_END = 269 * MiB;
static_assert(WS_GD + 4096 * GDN_D_BYTES <= WS_B, "GDN records fit region A");
static_assert(WS_X1 + 64 * MiB <= WS_HID && WS_HID + 40928ull * 1024 <= WS_XBUF && WS_XBUF + 40928ull * 2048 <= WS_WGU0, "post-scan map");
static_assert(WS_WGU0 + WGU_SPLIT * MiB <= WS_B + 72 * MiB && WS_WGU1 + (32 - WGU_SPLIT) * MiB <= 269 * MiB, "WGU fragments");
constexpr size_t DO_QR = 0, DO_KR = 16 * MiB, DO_VR = 20 * MiB, DO_OF = 24 * MiB, DO_OB = 40 * MiB;
constexpr int CW_CNT = 2048;
constexpr int CW_NTILE = 128;
constexpr int CW_ETAB = 192;
constexpr int CW_SCANQ = 1024;

constexpr int LDS_BYTES = 160 * 1024;

#define GAS __attribute__((address_space(1)))
#define LAS __attribute__((address_space(3)))
typedef unsigned short bf16;
typedef unsigned v4u __attribute__((ext_vector_type(4)));
typedef unsigned v2u __attribute__((ext_vector_type(2)));
typedef float f32x4 __attribute__((ext_vector_type(4)));
typedef short bf16x8 __attribute__((ext_vector_type(8)));
typedef short s16x4 __attribute__((ext_vector_type(4)));
#define DI __device__ __forceinline__

DI unsigned f2bf(float f) { unsigned u = __builtin_bit_cast(unsigned, f); return (u + 0x7fffu + ((u >> 16) & 1u)) >> 16; }
typedef float f32x2_t __attribute__((ext_vector_type(2))); typedef __bf16 bf16x2_t __attribute__((ext_vector_type(2)));
DI unsigned pk2(float lo, float hi) { f32x2_t v = {lo, hi}; bf16x2_t b = __builtin_convertvector(v, bf16x2_t); return __builtin_bit_cast(unsigned, b); }
DI float bf2f(unsigned short h) { return __builtin_bit_cast(float, (unsigned)h << 16); }
DI float bflo(unsigned w) { return __builtin_bit_cast(float, w << 16); }
DI float bfhi(unsigned w) { return __builtin_bit_cast(float, w & 0xffff0000u); }
DI unsigned q8x4(float a, float b, float c, float d, float sc) {
    const float M = 12582912.f;
    const unsigned ua = __builtin_bit_cast(unsigned, fminf(fmaxf(a * sc, -127.f), 127.f) + M), ub = __builtin_bit_cast(unsigned, fminf(fmaxf(b * sc, -127.f), 127.f) + M);
    const unsigned uc = __builtin_bit_cast(unsigned, fminf(fmaxf(c * sc, -127.f), 127.f) + M), ud = __builtin_bit_cast(unsigned, fminf(fmaxf(d * sc, -127.f), 127.f) + M);
    return (ua & 255u) | ((ub & 255u) << 8) | ((uc & 255u) << 16) | (ud << 24);
}
template <int CTRL> DI float dpp_f(float v) { return __builtin_bit_cast(float, __builtin_amdgcn_update_dpp(0, __builtin_bit_cast(int, v), CTRL, 0xf, 0xf, true)); }
#ifdef NO_DPP
DI float sum16(float v) { v += __shfl_xor(v, 1); v += __shfl_xor(v, 2); v += __shfl_xor(v, 4); v += __shfl_xor(v, 8); return v; }
DI float max16(float v) { v = fmaxf(v, __shfl_xor(v, 1)); v = fmaxf(v, __shfl_xor(v, 2)); v = fmaxf(v, __shfl_xor(v, 4)); v = fmaxf(v, __shfl_xor(v, 8)); return v; }
DI float get_x8(float v) { return __shfl_xor(v, 8); }
#else
DI float sum16(float v) { v += dpp_f<0xB1>(v); v += dpp_f<0x4E>(v); v += dpp_f<0x141>(v); v += dpp_f<0x140>(v); return v; }
DI float max16(float v) { v = fmaxf(v, dpp_f<0xB1>(v)); v = fmaxf(v, dpp_f<0x4E>(v)); v = fmaxf(v, dpp_f<0x141>(v)); v = fmaxf(v, dpp_f<0x140>(v)); return v; }
DI float get_x8(float v) { return dpp_f<0x128>(v); }
#endif
DI float sum_x16(float v) { return v + __shfl_xor(v, 16); }
DI float max_x16(float v) { return fmaxf(v, __shfl_xor(v, 16)); }
DI float sum_x32(float v) { return v + __shfl_xor(v, 32); }
DI float max_x32(float v) { return fmaxf(v, __shfl_xor(v, 32)); }
DI float wave_max(float v) { return max_x32(max_x16(max16(v))); }
DI float act_absmax(const float* nfw, int lane) {
    float m = 0.f;
#pragma unroll
    for (int i = 0; i < 16; ++i) m = fmaxf(m, fabsf(nfw[lane + 64 * i]));
    return ACT_CLIP * wave_max(m);
}
DI float wave_sum(float v) { return sum_x32(sum_x16(sum16(v))); }
DI float siluf(float x) { return x * __builtin_amdgcn_rcpf(1.0f + __expf(-x)); }
DI float sigmoidf_(float x) { return 1.0f / (1.0f + __expf(-x)); }
DI int perm32i(int idx) { return ((idx >> 2) & 3) * 8 + (idx >> 4) * 4 + (idx & 3); }
DI int permcol(int c) { return (c & ~31) + perm32i(c & 31); }
template <class T> DI T opaque(T p) { asm volatile("" : "+v"(p)); return p; }

typedef GAS unsigned gu32;
#define RLX_AGENT __ATOMIC_RELAXED, __HIP_MEMORY_SCOPE_AGENT
constexpr int CW_BAR = 4096;
constexpr int MISC_OFF = LDS_BYTES - 64;
#define XB_TMO      128
#define XB_XCNT(j)  (256  + 64 * (j))
#define XB_XSUB(j)  (1280 + 64 * (j))
#define XB_XGEN(j)  (2304 + 64 * (j))
#define XB_TOP      3328
#define XB_TOPGEN   3392
#define XCD_BAR_WORDS 3456
#define XB_SPIN_CAP (1u << 18)

__device__ __forceinline__ unsigned xb_ld(unsigned* p)              { return __hip_atomic_load(p, __ATOMIC_RELAXED, __HIP_MEMORY_SCOPE_AGENT); }
__device__ __forceinline__ unsigned xb_add(unsigned* p, unsigned v) { return __hip_atomic_fetch_add(p, v, __ATOMIC_RELAXED, __HIP_MEMORY_SCOPE_AGENT); }
__device__ __forceinline__ unsigned xb_xcc_id() { return (unsigned)__builtin_amdgcn_s_getreg((3 << 11) | 20) & 0xFu; }
#define XB_SPIN(cond, bar) do { unsigned _sp = 0; while (cond) { __builtin_amdgcn_s_sleep(1); \
    if ((++_sp & 255u) == 0u) { if (xb_ld(&(bar)[XB_TMO])) break; if (_sp > XB_SPIN_CAP) { atomicAdd(&(bar)[XB_TMO], 1u); break; } } } } while (0)

struct XcdBarrier {
    unsigned* bar; unsigned x;
    volatile LAS unsigned* st;
};

__device__ __forceinline__ XcdBarrier xcd_barrier_post(unsigned* bar, volatile LAS unsigned* st) {
    XcdBarrier b; b.bar = bar; b.x = xb_xcc_id(); b.st = st;
    if (threadIdx.x == 0) (void)xb_add(&bar[XB_XCNT(b.x)], 1u);
    return b;
}
__device__ __forceinline__ void xcd_barrier_complete(unsigned* bar, unsigned x, unsigned& nloc, unsigned& nx) {
    const unsigned G = gridDim.x * gridDim.y * gridDim.z;
    unsigned sum, cnt, mine, sp = 0u;
    for (;;) {
        sum = 0u; cnt = 0u; mine = 0u;
#pragma unroll
        for (unsigned j = 0; j < 16; ++j) { const unsigned c = xb_ld(&bar[XB_XCNT(j)]); sum += c; cnt += (c > 0u) ? 1u : 0u; mine = (j == x) ? c : mine; }
        if (sum == G) break;
        __builtin_amdgcn_s_sleep(1);
        if ((++sp & 255u) == 0u) { if (xb_ld(&bar[XB_TMO])) break; if (sp > XB_SPIN_CAP) { atomicAdd(&bar[XB_TMO], 1u); break; } }
    }
    nloc = mine > 0u ? mine : 1u; nx = cnt > 0u ? cnt : 1u;
}

__device__ __forceinline__ void xcd_barrier(const XcdBarrier& b) {
    asm volatile("s_waitcnt vmcnt(0)" ::: "memory");
    __syncthreads();
    if (threadIdx.x == 0) {
        unsigned* bar = b.bar;
        __builtin_amdgcn_s_waitcnt(0);
        unsigned nloc = b.st[0], nx = b.st[1];
        if (nloc == 0u) { xcd_barrier_complete(bar, b.x, nloc, nx); b.st[0] = nloc; b.st[1] = nx; }
        const unsigned old = xb_add(&bar[XB_XSUB(b.x)], 1u);
        const unsigned gen = old / nloc;
        if (old + 1u == (gen + 1u) * nloc) {
            __builtin_amdgcn_fence(__ATOMIC_RELEASE, "agent");
            asm volatile("s_waitcnt vmcnt(0)" ::: "memory");
            const unsigned og = xb_add(&bar[XB_TOP], 1u);
            const unsigned tg = og / nx;
            if (og + 1u == (tg + 1u) * nx) xb_add(&bar[XB_TOPGEN], 1u);
            else XB_SPIN(xb_ld(&bar[XB_TOPGEN]) == tg, bar);
            __builtin_amdgcn_fence(__ATOMIC_ACQUIRE, "agent");
            xb_add(&bar[XB_XGEN(b.x)], 1u);
            asm volatile("s_waitcnt vmcnt(0)" ::: "memory");
        } else {
            XB_SPIN(xb_ld(&bar[XB_XGEN(b.x)]) == gen, bar);
            __builtin_amdgcn_fence(__ATOMIC_ACQUIRE, "agent");
            asm volatile("s_waitcnt vmcnt(0)" ::: "memory");
        }
    }
    __syncthreads();
}

struct Frame {
    LAS unsigned char* lds;
    int tid, lane, wave, vcu, G;
    const float* in[17];
    float* out; unsigned char* ws;
};

DI void p0_transpose_item(const float* W, int ldw, int nblk, bf16* WT, int K, int row_off, int rmul, LAS float* scr, int item, int lane) {
    const int kb = item / nblk, nb = item % nblk, k0 = 64 * kb, n0 = 32 * nb;
    const int r8 = lane >> 3, c4 = (lane & 7) * 4;
    f32x4 v[8];
#pragma unroll
    for (int i = 0; i < 8; ++i) v[i] = __builtin_nontemporal_load((const f32x4*)(W + (size_t)(k0 + 8 * i + r8) * ldw + n0 + c4));
#pragma unroll
    for (int i = 0; i < 8; ++i) { LAS float* d = scr + (8 * i + r8) * 33 + c4; d[0] = v[i].x; d[1] = v[i].y; d[2] = v[i].z; d[3] = v[i].w; }
    asm volatile("s_waitcnt lgkmcnt(0)" ::: "memory");
    const int c = lane & 7;
#pragma unroll
    for (int j = 0; j < 4; ++j) { const int n = (lane >> 3) + 8 * j; const LAS float* s = scr + (8 * c) * 33 + n;
        v4u o; o.x = pk2(s[0 * 33], s[1 * 33]); o.y = pk2(s[2 * 33], s[3 * 33]); o.z = pk2(s[4 * 33], s[5 * 33]); o.w = pk2(s[6 * 33], s[7 * 33]);
        *(GAS v4u*)(WT + (size_t)(row_off + (n0 + n) * rmul) * K + k0 + 8 * c) = o; }
    asm volatile("s_waitcnt lgkmcnt(0)" ::: "memory");
}
template <int NR> DI void rms_rows_to_bf16(const float* const (&xrow)[NR], const float* w, bf16* const (&orow)[NR], int lane) {
    const GAS f32x4* wr = (const GAS f32x4*)w + lane;
    f32x4 v[NR][4];
#pragma unroll
    for (int r = 0; r < NR; ++r) { const GAS f32x4* xr = (const GAS f32x4*)xrow[r] + lane;
#pragma unroll
        for (int j = 0; j < 4; ++j) v[r][j] = xr[64 * j]; }
    f32x4 ww[4];
#pragma unroll
    for (int j = 0; j < 4; ++j) ww[j] = wr[64 * j];
#pragma unroll
    for (int r = 0; r < NR; ++r) {
        float s_ = 0.f;
#pragma unroll
        for (int j = 0; j < 4; ++j) s_ += (v[r][j].x * v[r][j].x + v[r][j].y * v[r][j].y) + (v[r][j].z * v[r][j].z + v[r][j].w * v[r][j].w);
        const float rs = __builtin_amdgcn_rsqf(wave_sum(s_) * (1.f / DMODEL) + EPS);
        GAS v2u* o8 = (GAS v2u*)orow[r] + lane;
#pragma unroll
        for (int j = 0; j < 4; ++j) { v2u o; o.x = pk2(v[r][j].x * rs * ww[j].x, v[r][j].y * rs * ww[j].y); o.y = pk2(v[r][j].z * rs * ww[j].z, v[r][j].w * rs * ww[j].w); o8[64 * j] = o; }
    }
}
DI void q_strip(const float* W, int ldw, int n0, unsigned char* WQ, float* wsc, int rowbase, int rmul, LAS unsigned char* lds, int wave, int lane) {
    LAS float* scr = (LAS float*)(lds + wave * 8704); LAS float* cmx = (LAS float*)(lds + 8 * 8704);
    const int r8 = lane >> 3, c4 = (lane & 7) * 4, kw = 128 * wave;
    f32x4 mx = (f32x4){0.f, 0.f, 0.f, 0.f};
#pragma unroll
    for (int i = 0; i < 16; ++i) { const f32x4 v = *(const f32x4*)(W + (size_t)(kw + 8 * i + r8) * ldw + n0 + c4);
        mx.x = fmaxf(mx.x, fabsf(v.x)); mx.y = fmaxf(mx.y, fabsf(v.y)); mx.z = fmaxf(mx.z, fabsf(v.z)); mx.w = fmaxf(mx.w, fabsf(v.w)); }
    mx.x = max_x32(max_x16(fmaxf(mx.x, get_x8(mx.x)))); mx.y = max_x32(max_x16(fmaxf(mx.y, get_x8(mx.y))));
    mx.z = max_x32(max_x16(fmaxf(mx.z, get_x8(mx.z)))); mx.w = max_x32(max_x16(fmaxf(mx.w, get_x8(mx.w))));
    if (lane < 8) *(LAS f32x4*)(cmx + wave * 32 + c4) = mx;
    __syncthreads();
    float sq[4];
#pragma unroll
    for (int j = 0; j < 4; ++j) { const int n = (lane >> 3) + 8 * j; float m = cmx[n];
#pragma unroll
        for (int w = 1; w < 8; ++w) m = fmaxf(m, cmx[w * 32 + n]);
        sq[j] = m > 0.f ? 127.0f / m : 0.f;
        if (wave == 0 && (lane & 7) == 0) wsc[rowbase + n * rmul] = m * (1.0f / 127.0f); }
    const int c = lane & 7;
#pragma unroll
    for (int kb = 0; kb < 2; ++kb) {
        const int k0 = kw + 64 * kb;
        f32x4 v[8];
#pragma unroll
        for (int i = 0; i < 8; ++i) v[i] = *(const f32x4*)(W + (size_t)(k0 + 8 * i + r8) * ldw + n0 + c4);
#pragma unroll
        for (int i = 0; i < 8; ++i) { LAS float* d = scr + (8 * i + r8) * 33 + c4; d[0] = v[i].x; d[1] = v[i].y; d[2] = v[i].z; d[3] = v[i].w; }
        asm volatile("s_waitcnt lgkmcnt(0)" ::: "memory");
#pragma unroll
        for (int j = 0; j < 4; ++j) { const int n = (lane >> 3) + 8 * j; const LAS float* t = scr + (8 * c) * 33 + n;
            v2u o; o.x = q8x4(t[0 * 33], t[1 * 33], t[2 * 33], t[3 * 33], sq[j]); o.y = q8x4(t[4 * 33], t[5 * 33], t[6 * 33], t[7 * 33], sq[j]);
            *(GAS v2u*)(WQ + (size_t)(rowbase + n * rmul) * 1024 + k0 + 8 * c) = o; }
        asm volatile("s_waitcnt lgkmcnt(0)" ::: "memory");
    }
    __syncthreads();
}
DI float reduce16(const float (&ga)[16], int lane) {
    float gb[8], gc[4];
    const bool h32 = (lane & 32) != 0, h16 = (lane & 16) != 0;
#pragma unroll
    for (int i = 0; i < 8; ++i) { const float lo = sum_x32(ga[i]), hi = sum_x32(ga[i + 8]); gb[i] = h32 ? hi : lo; }
#pragma unroll
    for (int i = 0; i < 4; ++i) { const float lo = sum_x16(gb[i]), hi = sum_x16(gb[i + 4]); gc[i] = h16 ? hi : lo; }
    float res = 0.f;
#pragma unroll
    for (int i = 0; i < 4; ++i) { const float t = sum16(gc[i]); res = ((lane & 3) == i) ? t : res; }
    return res;
}
DI void rms_rows_to_q8(const float* const (&xrow)[2], const float* w, unsigned char* const (&orow)[2], float* const (&xsc)[2], float* const (&gout)[2], const LAS float* gw_, int lane) {
    const LAS float* gw = gw_;
    gw = opaque(gw);
    const GAS f32x4* wr = (const GAS f32x4*)w + lane;
    f32x4 v[2][4];
#pragma unroll
    for (int r = 0; r < 2; ++r) { const GAS f32x4* xr = (const GAS f32x4*)xrow[r] + lane;
#pragma unroll
        for (int j = 0; j < 4; ++j) v[r][j] = xr[64 * j]; }
    f32x4 ww[4];
#pragma unroll
    for (int j = 0; j < 4; ++j) ww[j] = wr[64 * j];
#pragma unroll
    for (int r = 0; r < 2; ++r) {
        float s_ = 0.f;
#pragma unroll
        for (int j = 0; j < 4; ++j) s_ += (v[r][j].x * v[r][j].x + v[r][j].y * v[r][j].y) + (v[r][j].z * v[r][j].z + v[r][j].w * v[r][j].w);
        const float rs = __builtin_amdgcn_rsqf(wave_sum(s_) * (1.f / DMODEL) + EPS);
        float am = 0.f;
#pragma unroll
        for (int j = 0; j < 4; ++j) { v[r][j] = v[r][j] * ww[j] * rs; am = fmaxf(fmaxf(am, fmaxf(fabsf(v[r][j].x), fabsf(v[r][j].y))), fmaxf(fabsf(v[r][j].z), fabsf(v[r][j].w))); }
        am = wave_max(am);
        const float qsc = am > 0.f ? 127.0f / am : 0.f;
        if (lane == 0) *xsc[r] = am * (1.0f / 127.0f);
        GAS unsigned* o4 = (GAS unsigned*)orow[r] + lane;
#pragma unroll
        for (int j = 0; j < 4; ++j) o4[64 * j] = q8x4(v[r][j].x, v[r][j].y, v[r][j].z, v[r][j].w, qsc);
    }
#ifndef NO_GATES
    float ga[2][16];
#pragma unroll
    for (int c = 0; c < 16; ++c) { ga[0][c] = 0.f; ga[1][c] = 0.f; }
    asm volatile("" : "+v"(v[0][0]), "+v"(v[0][1]), "+v"(v[0][2]), "+v"(v[0][3]), "+v"(v[1][0]), "+v"(v[1][1]), "+v"(v[1][2]), "+v"(v[1][3]));
#pragma unroll
    for (int j = 0; j < 4; ++j)
#pragma unroll
        for (int q = 0; q < 4; ++q) { const LAS f32x4* g4 = (const LAS f32x4*)gw + ((j * 4 + q) * 4) * 64 + lane;
            const f32x4 g0 = g4[0], g1 = g4[64], g2 = g4[128], g3 = g4[192];
#pragma unroll
            for (int r = 0; r < 2; ++r) { const float h = v[r][j][q];
                ga[r][0] += h * g0.x; ga[r][1] += h * g0.y; ga[r][2] += h * g0.z; ga[r][3] += h * g0.w; ga[r][4] += h * g1.x; ga[r][5] += h * g1.y; ga[r][6] += h * g1.z; ga[r][7] += h * g1.w;
                ga[r][8] += h * g2.x; ga[r][9] += h * g2.y; ga[r][10] += h * g2.z; ga[r][11] += h * g2.w; ga[r][12] += h * g3.x; ga[r][13] += h * g3.y; ga[r][14] += h * g3.z; ga[r][15] += h * g3.w; }
            asm volatile("" : "+v"(ga[1][0]), "+v"(ga[1][1]), "+v"(ga[1][2]), "+v"(ga[1][3]), "+v"(ga[1][4]), "+v"(ga[1][5]), "+v"(ga[1][6]), "+v"(ga[1][7]), "+v"(ga[1][8]), "+v"(ga[1][9]),
                         "+v"(ga[1][10]), "+v"(ga[1][11]), "+v"(ga[1][12]), "+v"(ga[1][13]), "+v"(ga[1][14]), "+v"(ga[1][15]) :: "memory"); }
    const int gc_ = 4 * (lane >> 4) + (lane & 3);
#pragma unroll
    for (int r = 0; r < 2; ++r) { const float res = reduce16(ga[r], lane); if ((lane & 12) == 0) gout[r][gc_] = res; }
#endif
}
DI void p0_prologue(Frame& F) {
    const float* w_in = F.in[2];
    unsigned char* WIN = F.ws + WS_WIN; float* WSI = (float*)(F.ws + WS_WSI);
    constexpr int NSTRIP = 64 + 24;
    if (F.vcu < NSTRIP) { const int st = F.vcu;
        if (st < 64) q_strip(w_in, 2832, 32 * st, WIN, WSI, 32 * st, 1, F.lds, F.wave, F.lane);
        else q_strip(w_in + 2064, 2832, 32 * (st - 64), WIN, WSI, 2048 + 32 * (st - 64), 1, F.lds, F.wave, F.lane); }
    unsigned char* XN = F.ws + WS_XN; float* XSC = (float*)(F.ws + WS_XSC); float* GATES = (float*)(F.ws + WS_GATES);
    LAS float* gw = (LAS float*)(F.lds + 73728);
    for (int i = F.tid; i < 1024 * 4; i += NTHREADS) { const int k = i >> 2, c4 = i & 3, jj = k >> 8, qq = k & 3, ln = (k & 255) >> 2;
        *((LAS f32x4*)gw + ((jj * 4 + qq) * 4 + c4) * 64 + ln) = *(const f32x4*)(w_in + (size_t)k * 2832 + 2048 + c4 * 4); }
    __syncthreads();
    const int nst = (F.G < NSTRIP ? F.G : NSTRIP), NSLOT = nst * NWAVES + (F.G - nst) * NWAVES * 2;
    const int s0_ = (F.vcu < nst) ? F.vcu * NWAVES + F.wave : nst * NWAVES + ((F.vcu - nst) * NWAVES + F.wave) * 2, nmine = (F.vcu < nst) ? 1 : 2;
#pragma unroll 1
    for (int q = 0; q < nmine; ++q)
#pragma unroll 1
        for (int p = s0_ + q; p < TT / 2; p += NSLOT) { const int m = 2 * p;
            const float* const xr[2] = {F.in[0] + (size_t)m * DMODEL, F.in[0] + (size_t)(m + 1) * DMODEL}; unsigned char* const orw[2] = {XN + (size_t)m * DMODEL, XN + (size_t)(m + 1) * DMODEL};
            float* const xs[2] = {XSC + m, XSC + m + 1}; float* const go[2] = {GATES + (size_t)m * 16, GATES + (size_t)(m + 1) * 16};
            rms_rows_to_q8(xr, F.in[1], orw, xs, go, gw, F.lane); }
}

struct EpiProj {
    static constexpr bool PERM = true, AFTER_DRAIN = false;
    bf16 *qkva, *za, *qkvb; const float* wsi; const float* xsc;
    DI void operator()(const pg8::i32x4 (&acc)[2][2][4][2], const pg8::Unit& u, int wr, int wc, int fr, int fq) const {
        const int row0 = u.pm * 256 + wr * 64 + fr;
        const float* ws_ = wsi + u.pn * 256 + wc * 32 + 8 * fq;
        bf16* base; int ldc, colt;
        if (u.pn < 6) { base = qkva; ldc = 1536; colt = u.pn * 256; } else if (u.pn < 8) { base = za; ldc = 512; colt = (u.pn - 6) * 256; } else { base = qkvb; ldc = 768; colt = (u.pn - 8) * 256; }
        const int col0 = colt + wc * 32 + 8 * fq;
        f32x4 s0[2], s1[2];
#pragma unroll
        for (int bj = 0; bj < 2; ++bj) { s0[bj] = *(const f32x4*)(ws_ + bj * 128); s1[bj] = *(const f32x4*)(ws_ + bj * 128 + 4); }
        float rsc[2][4];
#pragma unroll
        for (int ai = 0; ai < 2; ++ai)
#pragma unroll
            for (int m = 0; m < 4; ++m) rsc[ai][m] = xsc[row0 + ai * 128 + m * 16];
#pragma unroll
        for (int ai = 0; ai < 2; ++ai)
#pragma unroll
            for (int m = 0; m < 4; ++m) { bf16* rowp = base + (size_t)(row0 + ai * 128 + m * 16) * ldc + col0; const float rr = rsc[ai][m];
#pragma unroll
                for (int bj = 0; bj < 2; ++bj) { const pg8::i32x4 a0 = acc[ai][bj][m][0], a1 = acc[ai][bj][m][1]; const f32x4 t0 = s0[bj] * rr, t1 = s1[bj] * rr; pg8::u32x4 w;
                    w.x = pg8::cvt_pk_bf16((float)a0[0] * t0[0], (float)a0[1] * t0[1]); w.y = pg8::cvt_pk_bf16((float)a0[2] * t0[2], (float)a0[3] * t0[3]);
                    w.z = pg8::cvt_pk_bf16((float)a1[0] * t1[0], (float)a1[1] * t1[1]); w.w = pg8::cvt_pk_bf16((float)a1[2] * t1[2], (float)a1[3] * t1[3]);
                    *(pg8::u32x4*)(rowp + bj * 128) = w; } }
    }
};
struct IdRows { DI int row(const pg8::Unit& u, int r) const { return u.pm * 256 + r; } };
struct EpiResid {
    static constexpr bool PERM = true, AFTER_DRAIN = false;
    const float* x; bf16* x1;
    DI void operator()(const pg8::f32x4 (&acc)[2][2][4][2], const pg8::Unit& u, int wr, int wc, int fr, int fq) const {
        const int row0 = u.pm * 256 + wr * 64 + fr, col0 = u.pn * 256 + wc * 32 + 8 * fq;
#pragma unroll
        for (int ai = 0; ai < 2; ++ai)
#pragma unroll
            for (int m = 0; m < 4; ++m) { const size_t off = (size_t)(row0 + ai * 128 + m * 16) * DMODEL + col0;
#pragma unroll
                for (int bj = 0; bj < 2; ++bj) { const pg8::f32x4 v0 = *(const pg8::f32x4*)(x + off + bj * 128) + acc[ai][bj][m][0], v1 = *(const pg8::f32x4*)(x + off + bj * 128 + 4) + acc[ai][bj][m][1]; pg8::u32x4 w;
                    w.x = pg8::cvt_pk_bf16(v0[0], v0[1]); w.y = pg8::cvt_pk_bf16(v0[2], v0[3]); w.z = pg8::cvt_pk_bf16(v1[0], v1[1]); w.w = pg8::cvt_pk_bf16(v1[2], v1[3]);
                    *(pg8::u32x4*)(x1 + off + bj * 128) = w; } }
    }
};
struct EpiGU {
    static constexpr bool PERM = true, AFTER_DRAIN = false;
    bf16* hid; const float* wsc; float ainv;
    DI void operator()(const pg8::i32x4 (&acc)[2][2][4][2], const pg8::Unit& u, int wr, int wc, int fr, int fq) const {
        const int row0 = u.pm * 256 + wr * 64 + fr; const int jt = u.pn & 3;
        const int ff0 = jt * 128 + wc * 16 + 4 * fq;
        const float* ws_ = wsc + u.ex * 1024 + jt * 256 + wc * 32 + 8 * fq;
        f32x4 s0[2], s1[2];
#pragma unroll
        for (int bj = 0; bj < 2; ++bj) { s0[bj] = *(const f32x4*)(ws_ + bj * 128) * ainv; s1[bj] = *(const f32x4*)(ws_ + bj * 128 + 4) * ainv; }
#pragma unroll
        for (int ai = 0; ai < 2; ++ai)
#pragma unroll
            for (int m = 0; m < 4; ++m) { bf16* rowp = hid + (size_t)(row0 + ai * 128 + m * 16) * FFE + ff0;
#pragma unroll
                for (int bj = 0; bj < 2; ++bj) { const pg8::i32x4 a0 = acc[ai][bj][m][0], a1 = acc[ai][bj][m][1];
                    const float g0 = (float)a0[0] * s0[bj][0], u0 = (float)a0[1] * s0[bj][1], g1 = (float)a0[2] * s0[bj][2], u1 = (float)a0[3] * s0[bj][3];
                    const float g2 = (float)a1[0] * s1[bj][0], u2 = (float)a1[1] * s1[bj][1], g3 = (float)a1[2] * s1[bj][2], u3 = (float)a1[3] * s1[bj][3];
                    v2u w; w.x = pg8::cvt_pk_bf16(siluf(g0) * u0, siluf(g1) * u1); w.y = pg8::cvt_pk_bf16(siluf(g2) * u2, siluf(g3) * u3);
                    *(v2u*)(rowp + bj * 64) = w; } }
    }
};
struct EpiY {
    static constexpr bool PERM = true, AFTER_DRAIN = false;
    bf16* y;
    DI void operator()(const pg8::f32x4 (&acc)[2][2][4][2], const pg8::Unit& u, int wr, int wc, int fr, int fq) const {
        const int row0 = u.pm * 256 + wr * 64 + fr; const int col0 = (u.pn & 3) * 256 + wc * 32 + 8 * fq;
#pragma unroll
        for (int ai = 0; ai < 2; ++ai)
#pragma unroll
            for (int m = 0; m < 4; ++m) { bf16* rowp = y + (size_t)(row0 + ai * 128 + m * 16) * DMODEL + col0;
#pragma unroll
                for (int bj = 0; bj < 2; ++bj) { const pg8::f32x4 v0 = acc[ai][bj][m][0], v1 = acc[ai][bj][m][1]; pg8::u32x4 w;
                    w.x = pg8::cvt_pk_bf16(v0[0], v0[1]); w.y = pg8::cvt_pk_bf16(v0[2], v0[3]); w.z = pg8::cvt_pk_bf16(v1[0], v1[1]); w.w = pg8::cvt_pk_bf16(v1[2], v1[3]);
                    *(pg8::u32x4*)(rowp + bj * 128) = w; } }
    }
};
constexpr int ETAB_OFF = 131072;
struct MoeOrder {
    const LAS unsigned* etab; int G, c, esplit, pnoff;
    DI bool next(int i, pg8::Unit& u) const {
        if (G % 8 != 0) {
            int L = i * G + c;
            for (int e = 0; e < NEXP; ++e) { const int n4 = 4 * (int)etab[2 * e + 1]; if (L < n4) { u.pm = (int)etab[2 * e] + (L >> 2); u.pn = (e < esplit ? 4 * e : pnoff + 4 * (e - esplit)) + (L & 3); u.ex = e; u.tq = L >> 2; return true; } L -= n4; }
            return false; }
        const int x = c & 7; int L = i * (G >> 3) + (c >> 3);
#pragma unroll
        for (int q = 0; q < NEXP / 8; ++q) { const int e = x + 8 * q; const int n4 = 4 * (int)etab[2 * e + 1];
            if (L < n4) { u.pm = (int)etab[2 * e] + (L >> 2); u.pn = (e < esplit ? 4 * e : pnoff + 4 * (e - esplit)) + (L & 3); u.ex = e; u.tq = L >> 2; return true; } L -= n4; }
        return false; }
    DI void a_ready(const pg8::Unit&) const {}
    DI void done(const pg8::Unit&) const {}
};
struct MoeRows {
    const int* list; const LAS unsigned* etab;
    DI int row(const pg8::Unit& u, int r) const {
        const int slot = u.tq * 256 + r, e = u.ex; if (slot >= (int)etab[64 + e]) return 0;
        const LAS unsigned* sp = etab + 96 + 8 * e; int sb = 0;
#pragma unroll
        for (int q = 1; q < 8; ++q) sb += (slot >= (int)sp[q]) ? 1 : 0;
        return list[(size_t)(e * 8 + sb) * TT + (slot - (int)sp[sb])]; }
};

DI void p2_rope(Frame& F) {
    const int gw = F.vcu * NWAVES + F.wave, NGW = F.G * NWAVES, lane = F.lane;
    const bf16* QKVB = (const bf16*)(F.ws + WS_QKVB);
    bf16* QR = (bf16*)((unsigned char*)F.out + DO_QR); bf16* KR = (bf16*)((unsigned char*)F.out + DO_KR); bf16* VR = (bf16*)((unsigned char*)F.out + DO_VR);
    const int pi = lane & 31, hsel = lane >> 5;
    const float qw0 = F.in[7][2 * pi], qw1 = F.in[7][2 * pi + 1], kw0 = F.in[8][2 * pi], kw1 = F.in[8][2 * pi + 1];
    const float invf = exp2f(-(float)(2 * (pi & 15)) * (13.287712379549449f / 32.0f));
    constexpr float C2 = 0.125f * 1.4426950408889634f;
    constexpr int NB4 = 4;
    for (int t0 = gw; t0 < TT; t0 += NB4 * NGW) {
        unsigned w[NB4][5], vw[NB4];
#pragma unroll
        for (int u = 0; u < NB4; ++u) { const int t = t0 + u * NGW; const unsigned* src = (const unsigned*)(QKVB + (size_t)(t < TT ? t : t0) * 768);
#pragma unroll
            for (int j = 0; j < 5; ++j) w[u][j] = src[(2 * j + hsel) * 32 + pi];
            vw[u] = src[320 + lane]; }
#pragma unroll
        for (int u = 0; u < NB4; ++u) {
            const int t = t0 + u * NGW; if (t >= TT) break;
            const int s_ = t & (SEQ - 1); const float pos = (pi < 16) ? (float)(s_ >> 6) : (float)(s_ & 63);
            const float ang = pos * invf;
            const float rev = ang * 0.15915494309189535f;
            const float sn = __builtin_amdgcn_sinf(rev), cs = __builtin_amdgcn_cosf(rev);
#pragma unroll
            for (int j = 0; j < 5; ++j) {
                const int head = 2 * j + hsel;
                const float x0 = bflo(w[u][j]), x1 = bfhi(w[u][j]);
                float ss = x0 * x0 + x1 * x1;
                ss = sum_x16(sum16(ss));
                const float rs = __builtin_amdgcn_rsqf(ss * (1.f / 64.f) + EPS);
                const bool isq = head < 8;
                const float y0 = x0 * rs * (isq ? qw0 : kw0), y1 = x1 * rs * (isq ? qw1 : kw1);
                float o0 = y0 * cs - y1 * sn, o1 = y0 * sn + y1 * cs;
                if (isq) { o0 *= C2; o1 *= C2; ((unsigned*)(QR + (size_t)t * 512))[head * 32 + pi] = pk2(o0, o1); }
                else { const int hk = head - 8, bq = t >> 13, sq = t & (SEQ - 1);
                    ((unsigned*)(KR + ((size_t)((bq * 2 + hk) * 128 + (sq >> 6)) * 8 + (pi >> 2)) * 512 + (sq & 63) * 8))[pi & 3] = pk2(o0, o1); }
            }
            { const int hk = lane >> 5, d = 2 * (lane & 31), bq = t >> 13, sq = t & (SEQ - 1), r = sq & 63;
              ((unsigned*)(VR + ((size_t)((bq * 2 + hk) * 128 + (sq >> 6)) * 8 + (d >> 5) * 4 + (r >> 4)) * 512 + ((r & 15) * 4 + ((d & 31) >> 3)) * 8))[(d & 7) >> 1] = vw[u]; }
        }
    }
}

constexpr int G_KNP = 0, G_QNP = 17408, G_KNTP = 34816, G_VCT = 53248;
constexpr int G_D0 = 71680, G_D1 = 71680 + 19456;
constexpr int GD_TBP = 0, GD_AP = 9216, GD_VEC = 18432;
constexpr int G_LM = 110592;
constexpr int G_GV = G_LM + 32768;
static_assert(G_GV + 2048 <= LDS_BYTES - 64, "gdn pre lds");

#define TRI_ROW(i, LC, LN) { \
        if ((i) + 1 < 64) { _Pragma("unroll") for (int j4 = 0; j4 < ((i) + 1 + 3) / 4 && j4 < 8; ++j4) LN[j4] = *(const LAS f32x4*)(L + ((i) + 1) * 64 + 4 * j4); } \
        _Pragma("unroll") for (int j4 = 8; j4 < ((i) + 3) / 4; ++j4) lt[j4 - 8] = *(const LAS f32x4*)(L + (i) * 64 + 4 * j4); \
        __builtin_amdgcn_sched_barrier(0); \
        f32x2_t a0 = {(lane == (i)) ? 1.0f : 0.0f, 0.f}, a1 = {0.f, 0.f}; \
        _Pragma("unroll") for (int j4 = 0; j4 < ((i) + 3) / 4; ++j4) { const f32x4 l = (j4 < 8) ? LC[j4 & 7] : lt[(j4 - 8) & 7]; \
            f32x2_t l0 = {l.x, (4 * j4 + 1 < (i)) ? l.y : 0.f}, l1 = {(4 * j4 + 2 < (i)) ? l.z : 0.f, (4 * j4 + 3 < (i)) ? l.w : 0.f}; \
            a0 -= l0 * xp[2 * j4]; if (4 * j4 + 2 < (i)) a1 -= l1 * xp[2 * j4 + 1]; } \
        const float a = (a0.x + a0.y) + (a1.x + a1.y); \
        if ((i) & 1) xp[(i) >> 1].y = a; else { xp[(i) >> 1].x = a; xp[(i) >> 1].y = 0.f; } \
        TBP[(REV ? 63 - (i) : (i)) * 72 + pc] = (bf16)(pk2(a * bcol, 0.f) & 0xffffu); \
        __builtin_amdgcn_sched_barrier(0); }
template <bool REV> DI void tri_inverse(LAS float* L, const LAS float* beta, LAS bf16* TBP, int lane) {
    f32x2_t xp[32];
    L = opaque(L); TBP = opaque(TBP); lane = opaque(lane);
    const float bcol = REV ? beta[63 - lane] : beta[lane];
    const int pc = REV ? permcol(63 - lane) : permcol(lane);
    f32x4 la[8], lb[8], lt[8];
#pragma unroll
    for (int ii = 0; ii < 64; ii += 2) { TRI_ROW(ii, la, lb) TRI_ROW(ii + 1, lb, la) }
}
#undef TRI_ROW

DI void gdn_conv(Frame& F, LAS unsigned char* lds, int t384, int b, int h, int n) {
    const bf16* QKVA = (const bf16*)(F.ws + WS_QKVA); const float* convw = F.in[3];
    const int cgp = t384 % 48, rg = t384 / 48, mat = cgp >> 4, cc = (cgp & 15) * 8;
    const int col = mat * 512 + h * 128 + cc;
    float w[5][8];
#pragma unroll
    for (int j = 0; j < 5; ++j) { const f32x4 a = *(const f32x4*)(convw + j * 1536 + col), bq = *(const f32x4*)(convw + j * 1536 + col + 4);
        w[j][0] = a.x; w[j][1] = a.y; w[j][2] = a.z; w[j][3] = a.w; w[j][4] = bq.x; w[j][5] = bq.y; w[j][6] = bq.z; w[j][7] = bq.w; }
    const int a4 = (cc >> 3) & 3, p0 = (cc & ~31) + 16 * (a4 & 1) + 4 * (a4 >> 1);
    const int ra = rg & 3, q0 = (rg >> 2) * 32 + 16 * (ra & 1) + 4 * (ra >> 1);
#pragma unroll
    for (int hf = 0; hf < 2; ++hf) {
        float o[4][8];
#pragma unroll
        for (int r = 0; r < 4; ++r)
#pragma unroll
            for (int c = 0; c < 8; ++c) o[r][c] = 0.f;
#pragma unroll
        for (int i = 0; i < 8; ++i) {
            const int pos = n * 64 + rg * 8 + hf * 4 - 2 + i;
            v4u raw = (v4u){0u, 0u, 0u, 0u};
            if (pos >= 0 && pos < SEQ) raw = *(const v4u*)(QKVA + (size_t)(b * SEQ + pos) * 1536 + col);
            float xin[8] = {bflo(raw.x), bfhi(raw.x), bflo(raw.y), bfhi(raw.y), bflo(raw.z), bfhi(raw.z), bflo(raw.w), bfhi(raw.w)};
#pragma unroll
            for (int j = 0; j < 5; ++j) { const int r = i - j; if (r >= 0 && r < 4) {
#pragma unroll
                for (int c = 0; c < 8; ++c) o[r][c] += w[j][c] * xin[c]; } }
        }
#pragma unroll
        for (int r = 0; r < 4; ++r) {
            float ss = 0.f;
#pragma unroll
            for (int c = 0; c < 8; ++c) { o[r][c] = siluf(o[r][c]); ss += o[r][c] * o[r][c]; }
            ss = sum16(ss);
            float sc = 1.0f;
            if (mat < 2) { sc = __builtin_amdgcn_rsqf(ss + EPS); if (mat == 0) sc *= 0.08838834764831845f; }
#pragma unroll
            for (int c = 0; c < 8; ++c) o[r][c] *= sc;
        }
        if (mat < 2) {
            LAS unsigned char* tile = lds + (mat == 0 ? G_QNP : G_KNP);
#pragma unroll
            for (int r = 0; r < 4; ++r) { const int c = rg * 8 + hf * 4 + r;
                v2u lo, hi2; lo.x = pk2(o[r][0], o[r][1]); lo.y = pk2(o[r][2], o[r][3]); hi2.x = pk2(o[r][4], o[r][5]); hi2.y = pk2(o[r][6], o[r][7]);
                *(LAS v2u*)(tile + c * 272 + p0 * 2) = lo; *(LAS v2u*)(tile + c * 272 + (p0 + 8) * 2) = hi2; }
        }
        if (mat >= 1) {
#pragma unroll
            for (int c = 0; c < 8; ++c) {
                v2u q4; q4.x = pk2(o[0][c], o[1][c]); q4.y = pk2(o[2][c], o[3][c]);
                if (mat == 1) *(LAS v2u*)(lds + G_KNTP + (cc + c) * 144 + (q0 + 8 * hf) * 2) = q4;
                else *(LAS v2u*)(lds + G_VCT + (cc + c) * 144 + rg * 16 + hf * 8) = q4;
            }
        }
    }
}
DI void gdn_gates(Frame& F, LAS unsigned char* lds, LAS float* gv, int lane, int b, int h, int n) {
    const float* gp = (const float*)(F.ws + WS_GATES) + (size_t)(b * SEQ + n * 64 + lane) * 16;
    const float bfv = gp[h], bbv = gp[4 + h], afv = gp[8 + h], abv = gp[12 + h];
    const float betaf = sigmoidf_(bfv), betab = sigmoidf_(bbv);
    const float xf = afv + F.in[5][h], xb = abv + F.in[5][4 + h];
    const float spf = fmaxf(xf, 0.f) + log1pf(__expf(-fabsf(xf))), spb = fmaxf(xb, 0.f) + log1pf(__expf(-fabsf(xb)));
    const float gf = -__expf(F.in[4][h]) * spf, gb = -__expf(F.in[4][4 + h]) * spb;
    float Gf = gf, Rb = gb;
#pragma unroll
    for (int o = 1; o < 64; o <<= 1) { const float u1 = __shfl_up(Gf, o); if (lane >= o) Gf += u1; const float d1 = __shfl_down(Rb, o); if (lane + o < 64) Rb += d1; }
    gv[lane] = Gf; gv[64 + lane] = Rb; gv[128 + lane] = betaf; gv[192 + lane] = betab;
    const float GfL = __shfl(Gf, 63), Rb0 = __shfl(Rb, 0);
    LAS float* v0 = (LAS float*)(lds + G_D0 + GD_VEC); LAS float* v1 = (LAS float*)(lds + G_D1 + GD_VEC);
    v0[lane] = __expf(Gf); v0[64 + lane] = __expf(GfL - Gf); v1[lane] = __expf(Rb); v1[64 + lane] = __expf(Rb0 - Rb);
    if (lane == 0) { v0[128] = __expf(GfL); v1[128] = __expf(Rb0); }
}
DI void p2_gdn_pre(Frame& F) {
    const int tid = F.tid, lane = F.lane, wave = F.wave;
    int task = F.vcu;
    if (task < 1024) {
        LAS unsigned char* lds = opaque(F.lds);
        const int b = task >> 9, h = (task >> 7) & 3, n = task & 127;
        if (wave >= 2) gdn_conv(F, lds, tid - 128, b, h, n);
        if (wave == 2) gdn_gates(F, lds, (LAS float*)(lds + G_GV), lane, b, h, n);
    }
    __syncthreads();
    int par = 0;
#pragma unroll 1
    for (; task < 1024; task += F.G, par ^= 1) {
        LAS unsigned char* lds = opaque(F.lds);
        const int b = task >> 9, h = (task >> 7) & 3, n = task & 127, bh = b * 4 + h;
        LAS float* gv = (LAS float*)(lds + G_GV + par * 1024);
        LAS float* sGf = gv; LAS float* sRb = gv + 64; LAS float* sBf = gv + 128; LAS float* sBb = gv + 192;
        {
            const int p = wave >> 2, mt = wave & 3, n16 = lane & 15, g = lane >> 4;
            const LAS unsigned char* At = lds + (p == 0 ? G_KNP : G_QNP) + (16 * mt + n16) * 272 + g * 16;
            bf16x8 af[4], bfr[16];
#pragma unroll
            for (int ks = 0; ks < 4; ++ks) af[ks] = *(const LAS bf16x8*)(At + ks * 64);
#pragma unroll
            for (int nt = 0; nt < 4; ++nt)
#pragma unroll
                for (int ks = 0; ks < 4; ++ks) bfr[nt * 4 + ks] = *(const LAS bf16x8*)(lds + G_KNP + (16 * nt + n16) * 272 + g * 16 + ks * 64);
            float Gc[4], Rc[4], Bfc[4], Bbc[4];
#pragma unroll
            for (int r = 0; r < 4; ++r) { const int c = 16 * mt + 4 * g + r; Gc[r] = sGf[c]; Rc[r] = sRb[c]; Bfc[r] = sBf[c]; Bbc[r] = sBb[c]; }
#pragma unroll
            for (int nt = 0; nt < 4; ++nt) {
                f32x4 acc = (f32x4){0.f, 0.f, 0.f, 0.f};
#pragma unroll
                for (int ks = 0; ks < 4; ++ks) acc = __builtin_amdgcn_mfma_f32_16x16x32_bf16(af[ks], bfr[nt * 4 + ks], acc, 0, 0, 0);
                const int s_ = 16 * nt + n16; const float Gs = sGf[s_], Rs = sRb[s_]; const int ps = permcol(s_);
#pragma unroll
                for (int r = 0; r < 4; ++r) {
                    const int c = 16 * mt + 4 * g + r; const float v = acc[r];
                    const float df = __expf(fminf(Gc[r] - Gs, 0.f)), db = __expf(fminf(Rc[r] - Rs, 0.f));
                    if (p == 0) {
                        ((LAS float*)(lds + G_LM))[c * 64 + s_] = Bfc[r] * v * df;
                        ((LAS float*)(lds + G_LM + 16384))[(63 - c) * 64 + (63 - s_)] = Bbc[r] * v * db;
                    } else {
                        ((LAS bf16*)(lds + G_D0 + GD_AP))[c * 72 + ps] = (bf16)(pk2(s_ <= c ? v * df : 0.f, 0.f) & 0xffffu);
                        ((LAS bf16*)(lds + G_D1 + GD_AP))[c * 72 + ps] = (bf16)(pk2(s_ >= c ? v * db : 0.f, 0.f) & 0xffffu);
                    }
                }
            }
        }
        __syncthreads();
        GAS v4u* gd0 = (GAS v4u*)(F.ws + WS_GD + (size_t)((bh * 2 + 0) * 128 + n) * GDN_D_BYTES);
        GAS v4u* gd1 = (GAS v4u*)(F.ws + WS_GD + (size_t)((bh * 2 + 1) * 128 + n) * GDN_D_BYTES);
        {
            GAS v4u* gsh = (GAS v4u*)(F.ws + WS_GSH + (size_t)(bh * 128 + n) * GDN_SH_BYTES);
#pragma unroll 3
            for (int i = tid; i < (int)(GDN_SH_BYTES / 16); i += NTHREADS) gsh[i] = *(const LAS v4u*)(lds + i * 16);
#pragma unroll 1
            for (int i = GD_AP / 16 + tid; i < (int)(GDN_D_BYTES / 16); i += NTHREADS) { gd0[i] = *(const LAS v4u*)(lds + G_D0 + i * 16); gd1[i] = *(const LAS v4u*)(lds + G_D1 + i * 16); }
        }
        __syncthreads();
        if (wave == 0) { tri_inverse<false>((LAS float*)(lds + G_LM), sBf, (LAS bf16*)(lds + G_D0 + GD_TBP), lane);
#pragma unroll 3
            for (int i = lane; i < GD_AP / 16; i += 64) gd0[i] = *(const LAS v4u*)(lds + G_D0 + i * 16); }
        else if (wave == 1) { tri_inverse<true>((LAS float*)(lds + G_LM + 16384), sBb, (LAS bf16*)(lds + G_D1 + GD_TBP), lane);
#pragma unroll 3
            for (int i = lane; i < GD_AP / 16; i += 64) gd1[i] = *(const LAS v4u*)(lds + G_D1 + i * 16); }
        else {
            const int t2 = task + F.G;
            if (t2 < 1024) { const int b2 = t2 >> 9, h2 = (t2 >> 7) & 3, n2 = t2 & 127;
                gdn_conv(F, lds, tid - 128, b2, h2, n2);
                if (wave == 2) gdn_gates(F, lds, (LAS float*)(lds + G_GV + (par ^ 1) * 1024), lane, b2, h2, n2); }
        }
        __syncthreads();
    }
}

DI bf16x8 pack8(const f32x4 a, const f32x4 b) {
    v4u p; p.x = pk2(a[0], a[1]); p.y = pk2(a[2], a[3]); p.z = pk2(b[0], b[1]); p.w = pk2(b[2], b[3]); return __builtin_bit_cast(bf16x8, p);
}
DI unsigned char* wgu_ptr(Frame& F, int e) { return F.ws + (e < WGU_SPLIT ? WS_WGU0 + (size_t)e * MiB : WS_WGU1 + (size_t)(e - WGU_SPLIT) * MiB); }
DI bf16* wd_ptr(Frame& F, int e) { return (bf16*)((unsigned char*)F.out + (e < WD_SPLIT ? DO_WD0 + (size_t)e * MiB : DO_WD1 + (size_t)(e - WD_SPLIT) * MiB)); }
constexpr int NG = 8, GSTEPS = 128 / NG;
#ifndef PASS1_QUOTA
#define PASS1_QUOTA 3
#endif
constexpr size_t WS_XB = 209 * MiB;
constexpr size_t WS_AOP = 217 * MiB;
constexpr size_t WS_SG = 221 * MiB;
constexpr int GS_SLOT = 54272, GS_Q = 17408, GS_VCT = 34816, GS_VEC = 53248, GS_TB = 18432, GS_AP = 27648;
static_assert(3 * GS_SLOT <= LDS_BYTES - 64, "scan ring");
static_assert(WS_SG + 8 * MiB <= 229 * MiB, "scan buffers");
DI void gs_dma(const unsigned char* src, unsigned lane16, unsigned lds_dst) {
    unsigned keep;
    asm volatile("s_mov_b32 %0, m0\n\ts_mov_b32 m0, %2\n\ts_nop 0\n\tglobal_load_lds_dwordx4 %1, %3\n\ts_mov_b32 m0, %0" : "=&s"(keep) : "v"(lane16), "s"(lds_dst), "s"(src) : "memory");
}
#define GS_WAITBAR(N) asm volatile("s_waitcnt vmcnt(%0) lgkmcnt(0)\n\ts_barrier" :: "n"(N) : "memory")
DI f32x4* gs_img(Frame& F, size_t base, int chain, int grp) { return (f32x4*)(F.ws + base) + (size_t)(chain * NG + grp) * (8 * 8 * 64); }
DI bf16* gs_aop(Frame& F, int chain, int grp) { return (bf16*)(F.ws + WS_AOP) + (size_t)(chain * NG + grp) * (8 * 4 * 64 * 8); }
DI void gs_start_state(Frame& F, int chain, int grp, f32x4 (&S)[8]);
template <int MODE> DI void gscan(Frame& F, const int chain, const int grp, f32x4* finalp, bf16* aop) {
    constexpr bool OUT = MODE == 0;
    constexpr int N1 = OUT ? 7 : (MODE == 1 ? 5 : 3), N2 = OUT ? 5 : 4, NST = OUT ? 16 : 0;
    const int lane = F.lane, n16 = lane & 15, g = lane >> 4, e = F.wave;
    const int bh = chain >> 1, dir = chain & 1, b = bh >> 2, h = bh & 3;
    const unsigned lds0 = (unsigned)(uintptr_t)opaque(F.lds), lane16 = (unsigned)lane * 16u;
    const unsigned char* shrec = F.ws + WS_GSH + (size_t)(bh * 128) * GDN_SH_BYTES; const unsigned char* drec = F.ws + WS_GD + (size_t)((bh * 2 + dir) * 128) * GDN_D_BYTES;
#define GS_ISSUE1(st_, slot_) do { const int sc_ = (st_) < 128 ? (st_) : 127; const int n_ = dir == 0 ? sc_ : 127 - sc_; const unsigned char* sh_ = shrec + (size_t)n_ * GDN_SH_BYTES; const unsigned char* dr_ = drec + (size_t)n_ * GDN_D_BYTES; \
        _Pragma("unroll") for (int j_ = 0; j_ < N1; ++j_) { const int q_ = e + 8 * j_; int p_; \
            if (MODE == 0) p_ = q_ < 53 ? q_ : 52; else if (MODE == 1) p_ = q_ < 17 ? q_ : (q_ < 35 ? q_ + 17 : 52); else p_ = q_ < 17 ? q_ : 52; \
            const unsigned char* src_ = p_ < 34 ? sh_ + p_ * 1024 : (p_ < 52 ? sh_ + G_VCT + (p_ - 34) * 1024 : dr_ + GD_VEC); \
            gs_dma(src_, lane16, (unsigned)__builtin_amdgcn_readfirstlane(lds0 + (unsigned)((slot_) * GS_SLOT + p_ * 1024))); } } while (0)
#define GS_ISSUE2(st_, slot_) do { const int sc_ = (st_) < 128 ? (st_) : 127; const int n_ = dir == 0 ? sc_ : 127 - sc_; const unsigned char* sh_ = shrec + (size_t)n_ * GDN_SH_BYTES; const unsigned char* dr_ = drec + (size_t)n_ * GDN_D_BYTES; \
        _Pragma("unroll") for (int j_ = 0; j_ < N2; ++j_) { const int q_ = e + 8 * j_; const int pm_ = OUT ? 35 : 26; const int p_ = q_ < pm_ ? q_ : pm_; \
            const unsigned char* src_ = p_ < 18 ? sh_ + G_KNTP + p_ * 1024 : dr_ + (p_ - 18) * 1024; \
            gs_dma(src_, lane16, (unsigned)__builtin_amdgcn_readfirstlane(lds0 + (unsigned)((slot_) * GS_SLOT + p_ * 1024))); } } while (0)
    const int st0 = grp * GSTEPS;
    bf16* Odir = (bf16*)((unsigned char*)F.out + (dir == 0 ? DO_OF : DO_OB));
    f32x4 S[8];
    if (MODE == 0 && grp > 0) gs_start_state(F, chain, grp, S);
    else {
#pragma unroll
        for (int i = 0; i < 8; ++i)
#pragma unroll
            for (int r = 0; r < 4; ++r) S[i][r] = (MODE == 2 && (16 * i + 4 * g + r) == (16 * e + n16)) ? 1.0f : 0.0f;
    }
    GS_ISSUE1(st0, 0); GS_ISSUE2(st0, 1);
    bf16x8 Sb[4];
#pragma unroll
    for (int i = 0; i < 4; ++i) Sb[i] = pack8(S[2 * i], S[2 * i + 1]);
    const unsigned aoff272 = n16 * 272 + g * 16, aoff144 = n16 * 144 + g * 16;
#define SB_() __builtin_amdgcn_sched_barrier(0)
#define LDR128(dst, base, off) asm volatile("ds_read_b128 %0, %1 offset:%2" : "=v"(dst) : "v"(base), "i"(off) : "memory")
#define LDR64(dst, base, off) asm volatile("ds_read_b64 %0, %1 offset:%2" : "=v"(dst) : "v"(base), "i"(off) : "memory")
#define LDR32(dst, base, off) asm volatile("ds_read_b32 %0, %1 offset:%2" : "=v"(dst) : "v"(base), "i"(off) : "memory")
    int sl1 = 0, sl2 = 1, sl3 = 2;
#pragma unroll 1
    for (int s = 0; s < GSTEPS; ++s) {
        const int st = st0 + s;
        if (OUT && s > 0) GS_WAITBAR(N2 + NST); else GS_WAITBAR(N2);
        GS_ISSUE1(s + 1 < GSTEPS ? st + 1 : st, sl3);
        const int n = dir == 0 ? st : 127 - st;
        const unsigned h1 = lds0 + (unsigned)sl1 * GS_SLOT, h2 = lds0 + (unsigned)sl2 * GS_SLOT;
        const unsigned bK = h1 + aoff272, bQ = h1 + GS_Q + aoff272, bKT = h2 + aoff144, bT = h2 + GS_TB + aoff144;
        const unsigned bV = h1 + GS_VCT + e * 2304 + n16 * 144 + g * 8, bvec = h1 + GS_VEC + g * 16, bd = h1 + GS_VEC;
        f32x4 eG[4], ks[4]; v2u vv[4]; float dch; bf16x8 fa[16];
        LDR128(eG[0], bvec, 0); LDR128(eG[1], bvec, 64); LDR128(eG[2], bvec, 128); LDR128(eG[3], bvec, 192);
        LDR128(ks[0], bvec, 256); LDR128(ks[1], bvec, 320); LDR128(ks[2], bvec, 384); LDR128(ks[3], bvec, 448);
        LDR32(dch, bd, 512);
        LDR64(vv[0], bV, 0); LDR64(vv[1], bV, 32); LDR64(vv[2], bV, 64); LDR64(vv[3], bV, 96);
#pragma unroll
        for (int m = 0; m < 4; ++m) { LDR128(fa[m * 4 + 0], bK, m * 4352 + 0); LDR128(fa[m * 4 + 1], bK, m * 4352 + 64); LDR128(fa[m * 4 + 2], bK, m * 4352 + 128); LDR128(fa[m * 4 + 3], bK, m * 4352 + 192); }
        bf16x8 fq[16];
        if (OUT) {
#pragma unroll
            for (int m = 0; m < 4; ++m) { LDR128(fq[m * 4 + 0], bQ, m * 4352 + 0); LDR128(fq[m * 4 + 1], bQ, m * 4352 + 64); LDR128(fq[m * 4 + 2], bQ, m * 4352 + 128); LDR128(fq[m * 4 + 3], bQ, m * 4352 + 192); }
            asm volatile("s_waitcnt lgkmcnt(15)" : "+v"(eG[0]), "+v"(eG[1]), "+v"(eG[2]), "+v"(eG[3]), "+v"(ks[0]), "+v"(ks[1]), "+v"(ks[2]), "+v"(ks[3]), "+v"(dch), "+v"(vv[0]), "+v"(vv[1]), "+v"(vv[2]), "+v"(vv[3]),
                         "+v"(fa[0]), "+v"(fa[1]), "+v"(fa[2]), "+v"(fa[3]), "+v"(fa[4]), "+v"(fa[5]), "+v"(fa[6]), "+v"(fa[7]), "+v"(fa[8]), "+v"(fa[9]), "+v"(fa[10]), "+v"(fa[11]), "+v"(fa[12]), "+v"(fa[13]), "+v"(fa[14]), "+v"(fa[15]) :: "memory");
        } else {
            asm volatile("s_waitcnt lgkmcnt(0)" : "+v"(eG[0]), "+v"(eG[1]), "+v"(eG[2]), "+v"(eG[3]), "+v"(ks[0]), "+v"(ks[1]), "+v"(ks[2]), "+v"(ks[3]), "+v"(dch), "+v"(vv[0]), "+v"(vv[1]), "+v"(vv[2]), "+v"(vv[3]),
                         "+v"(fa[0]), "+v"(fa[1]), "+v"(fa[2]), "+v"(fa[3]), "+v"(fa[4]), "+v"(fa[5]), "+v"(fa[6]), "+v"(fa[7]), "+v"(fa[8]), "+v"(fa[9]), "+v"(fa[10]), "+v"(fa[11]), "+v"(fa[12]), "+v"(fa[13]), "+v"(fa[14]), "+v"(fa[15]) :: "memory");
        }
        SB_();
        f32x4 KS[4];
#pragma unroll
        for (int m = 0; m < 4; ++m) KS[m] = (f32x4){0.f, 0.f, 0.f, 0.f};
#pragma unroll
        for (int i = 0; i < 4; ++i)
#pragma unroll
            for (int m = 0; m < 4; ++m) KS[m] = __builtin_amdgcn_mfma_f32_16x16x32_bf16(fa[m * 4 + i], Sb[i], KS[m], 0, 0, 0);
        SB_();
        if (OUT) {
            if (s > 0) asm volatile("s_waitcnt vmcnt(%16) lgkmcnt(0)\n\ts_barrier" : "+v"(fq[0]), "+v"(fq[1]), "+v"(fq[2]), "+v"(fq[3]), "+v"(fq[4]), "+v"(fq[5]), "+v"(fq[6]), "+v"(fq[7]), "+v"(fq[8]), "+v"(fq[9]), "+v"(fq[10]), "+v"(fq[11]), "+v"(fq[12]), "+v"(fq[13]), "+v"(fq[14]), "+v"(fq[15]) : "n"(N1 + NST) : "memory");
            else asm volatile("s_waitcnt vmcnt(%16) lgkmcnt(0)\n\ts_barrier" : "+v"(fq[0]), "+v"(fq[1]), "+v"(fq[2]), "+v"(fq[3]), "+v"(fq[4]), "+v"(fq[5]), "+v"(fq[6]), "+v"(fq[7]), "+v"(fq[8]), "+v"(fq[9]), "+v"(fq[10]), "+v"(fq[11]), "+v"(fq[12]), "+v"(fq[13]), "+v"(fq[14]), "+v"(fq[15]) : "n"(N1) : "memory");
        } else GS_WAITBAR(N1);
        GS_ISSUE2(s + 1 < GSTEPS ? st + 1 : st, sl1);
        bf16x8 ft[8];
#pragma unroll
        for (int m = 0; m < 4; ++m) { LDR128(ft[m * 2 + 0], bT, m * 2304 + 0); LDR128(ft[m * 2 + 1], bT, m * 2304 + 64); }
        SB_();
        f32x4 o[4];
        if (OUT) {
#pragma unroll
            for (int m = 0; m < 4; ++m) o[m] = (f32x4){0.f, 0.f, 0.f, 0.f};
#pragma unroll
            for (int i = 0; i < 4; ++i)
#pragma unroll
                for (int m = 0; m < 4; ++m) o[m] = __builtin_amdgcn_mfma_f32_16x16x32_bf16(fq[m * 4 + i], Sb[i], o[m], 0, 0, 0);
        }
        f32x4 rr[4];
#pragma unroll
        for (int m = 0; m < 4; ++m) {
            if (MODE == 2) { rr[m][0] = -eG[m][0] * KS[m][0]; rr[m][1] = -eG[m][1] * KS[m][1]; rr[m][2] = -eG[m][2] * KS[m][2]; rr[m][3] = -eG[m][3] * KS[m][3]; }
            else { rr[m][0] = bflo(vv[m].x) - eG[m][0] * KS[m][0]; rr[m][1] = bfhi(vv[m].x) - eG[m][1] * KS[m][1]; rr[m][2] = bflo(vv[m].y) - eG[m][2] * KS[m][2]; rr[m][3] = bfhi(vv[m].y) - eG[m][3] * KS[m][3]; } }
        bf16x8 rb[2]; rb[0] = pack8(rr[0], rr[1]); rb[1] = pack8(rr[2], rr[3]);
        SB_();
        bf16x8 fk[16];
#pragma unroll
        for (int jt = 0; jt < 8; ++jt) { LDR128(fk[jt * 2 + 0], bKT, jt * 2304 + 0); LDR128(fk[jt * 2 + 1], bKT, jt * 2304 + 64); }
        asm volatile("s_waitcnt lgkmcnt(15)" : "+v"(ft[0]), "+v"(ft[1]), "+v"(ft[2]), "+v"(ft[3]), "+v"(ft[4]), "+v"(ft[5]), "+v"(ft[6]), "+v"(ft[7]) :: "memory");
        SB_();
        f32x4 vn[4];
#pragma unroll
        for (int m = 0; m < 4; ++m) vn[m] = (f32x4){0.f, 0.f, 0.f, 0.f};
#pragma unroll
        for (int i = 0; i < 2; ++i)
#pragma unroll
            for (int m = 0; m < 4; ++m) vn[m] = __builtin_amdgcn_mfma_f32_16x16x32_bf16(ft[m * 2 + i], rb[i], vn[m], 0, 0, 0);
        if (OUT) {
#pragma unroll
            for (int m = 0; m < 4; ++m) o[m] = o[m] * eG[m];
        }
#pragma unroll
        for (int jt = 0; jt < 8; ++jt) S[jt] = S[jt] * dch;
        SB_();
        bf16x8 fp[8];
        if (OUT) {
#pragma unroll
            for (int m = 0; m < 4; ++m) { LDR128(fp[m * 2 + 0], bT, (GS_AP - GS_TB) + m * 2304 + 0); LDR128(fp[m * 2 + 1], bT, (GS_AP - GS_TB) + m * 2304 + 64); }
        }
        bf16x8 vnb[2]; vnb[0] = pack8(vn[0], vn[1]); vnb[1] = pack8(vn[2], vn[3]);
        bf16x8 vs[2]; vs[0] = pack8(vn[0] * ks[0], vn[1] * ks[1]); vs[1] = pack8(vn[2] * ks[2], vn[3] * ks[3]);
        if (OUT) asm volatile("s_waitcnt lgkmcnt(8)" : "+v"(fk[0]), "+v"(fk[1]), "+v"(fk[2]), "+v"(fk[3]), "+v"(fk[4]), "+v"(fk[5]), "+v"(fk[6]), "+v"(fk[7]), "+v"(fk[8]), "+v"(fk[9]), "+v"(fk[10]), "+v"(fk[11]), "+v"(fk[12]), "+v"(fk[13]), "+v"(fk[14]), "+v"(fk[15]) :: "memory");
        else asm volatile("s_waitcnt lgkmcnt(0)" : "+v"(fk[0]), "+v"(fk[1]), "+v"(fk[2]), "+v"(fk[3]), "+v"(fk[4]), "+v"(fk[5]), "+v"(fk[6]), "+v"(fk[7]), "+v"(fk[8]), "+v"(fk[9]), "+v"(fk[10]), "+v"(fk[11]), "+v"(fk[12]), "+v"(fk[13]), "+v"(fk[14]), "+v"(fk[15]) :: "memory");
        SB_();
#pragma unroll
        for (int i = 0; i < 2; ++i)
#pragma unroll
            for (int jt = 0; jt < 8; ++jt) S[jt] = __builtin_amdgcn_mfma_f32_16x16x32_bf16(fk[jt * 2 + i], vs[i], S[jt], 0, 0, 0);
        if (OUT) {
            asm volatile("s_waitcnt lgkmcnt(0)" : "+v"(fp[0]), "+v"(fp[1]), "+v"(fp[2]), "+v"(fp[3]), "+v"(fp[4]), "+v"(fp[5]), "+v"(fp[6]), "+v"(fp[7]) :: "memory");
#pragma unroll
            for (int i = 0; i < 2; ++i)
#pragma unroll
                for (int m = 0; m < 4; ++m) o[m] = __builtin_amdgcn_mfma_f32_16x16x32_bf16(fp[m * 2 + i], vnb[i], o[m], 0, 0, 0);
        }
#pragma unroll
        for (int i = 0; i < 4; ++i) Sb[i] = pack8(S[2 * i], S[2 * i + 1]);
        SB_();
        if (OUT) {
            bf16* op = Odir + (size_t)(b * SEQ + n * 64) * 512 + h * 128 + 16 * e + n16;
#pragma unroll
            for (int m = 0; m < 4; ++m)
#pragma unroll
                for (int r = 0; r < 4; ++r) op[(size_t)(16 * m + 4 * g + r) * 512] = (bf16)(pk2(o[m][r], 0.f) & 0xffffu);
        }
        { const int t_ = sl1; sl1 = sl3; sl3 = sl2; sl2 = t_; }
    }
#undef SB_
#undef LDR128
#undef LDR64
#undef LDR32
#undef GS_ISSUE1
#undef GS_ISSUE2
    if (finalp) {
#pragma unroll
        for (int i = 0; i < 8; ++i) finalp[(e * 8 + i) * 64 + lane] = S[i];
    }
    if (aop) {
#pragma unroll
        for (int jt = 0; jt < 8; ++jt)
#pragma unroll
            for (int r = 0; r < 4; ++r) aop[((jt * 4 + (e >> 1)) * 64 + 16 * (n16 >> 2) + 4 * g + r) * 8 + 4 * (e & 1) + (n16 & 3)] = (bf16)(pk2(S[jt][r], 0.f) & 0xffffu);
    }
    asm volatile("s_waitcnt vmcnt(0)" ::: "memory");
    __syncthreads();
}
DI void gs_start_state(Frame& F, int chain, int grp, f32x4 (&S)[8]) {
    const int lane = F.lane, e = F.wave;
    { const f32x4* b0 = gs_img(F, WS_XB, chain, 0);
#pragma unroll
      for (int i = 0; i < 8; ++i) S[i] = b0[(e * 8 + i) * 64 + lane]; }
#pragma unroll 1
    for (int gq = 1; gq < grp; ++gq) {
        const f32x4* bg = gs_img(F, WS_XB, chain, gq); const bf16x8* ag = (const bf16x8*)gs_aop(F, chain, gq);
        bf16x8 Sb[4];
#pragma unroll
        for (int i = 0; i < 4; ++i) Sb[i] = pack8(S[2 * i], S[2 * i + 1]);
#pragma unroll
        for (int jt = 0; jt < 8; ++jt) { f32x4 acc = bg[(e * 8 + jt) * 64 + lane];
#pragma unroll
            for (int i = 0; i < 4; ++i) acc = __builtin_amdgcn_mfma_f32_16x16x32_bf16(ag[(jt * 4 + i) * 64 + lane], Sb[i], acc, 0, 0, 0);
            S[jt] = acc; }
    }
}
constexpr int CV_QS = NEXP * 32, CV_WD = NEXP * 32, CV_WO = 64, CV_RT = 16, CV_ITEMS = CV_QS + CV_WD + CV_WO + CV_RT;
DI void conv_item(Frame& F, int it) {
    LAS float* scr = (LAS float*)(F.lds + F.wave * 16384);
    if (it < CV_QS) {
        const int e = it >> 5, mat = (it >> 4) & 1, nb = it & 15;
        q_strip((mat ? F.in[14] : F.in[13]) + (size_t)e * 1024 * 512, 512, 32 * nb, wgu_ptr(F, e), (float*)(F.ws + WS_WSC) + e * 1024, mat + 64 * nb, 2, F.lds, F.wave, F.lane);
    } else if (it < CV_QS + CV_WD) {
        const int w = (it - CV_QS) * 8 + F.wave, e = w >> 8, r = w & 255;
        p0_transpose_item(F.in[15] + (size_t)e * 512 * 1024, 1024, 32, wd_ptr(F, e), 512, 0, 1, scr, r, F.lane);
    } else if (it < CV_QS + CV_WD + CV_WO) {
        p0_transpose_item(F.in[9], 1024, 32, (bf16*)(F.ws + WS_WOUT), 1024, 0, 1, scr, (it - CV_QS - CV_WD) * 8 + F.wave, F.lane);
    } else {
        bf16* WRH = (bf16*)(F.ws + WS_WR); bf16* WRL = WRH + 48 * 1024; const float* wrg = F.in[11]; const float* wre = F.in[12];
        const int base = (it - CV_QS - CV_WD - CV_WO) * 3072;
#pragma unroll
        for (int q = 0; q < 6; ++q) { const int i = base + q * 512 + F.tid; const int j = i >> 10, k = i & 1023; float v = 0.f; if (j < 4) v = wrg[k * 4 + j]; else if (j < 36) v = wre[k * 32 + (j - 4)];
            const unsigned hh = f2bf(v); const float hv = __builtin_bit_cast(float, hh << 16); WRH[i] = (bf16)hh; WRL[i] = (bf16)f2bf(v - hv); }
    }
}
constexpr int CW_CONVQ = 12288;
static_assert(48 * PASS1_QUOTA <= CV_QS, "pass 1 may only take gate/up strips");
DI void conv_pull(Frame& F, int quota) {
    volatile LAS int* slot = (volatile LAS int*)(F.lds + MISC_OFF + 32);
    for (int n = 0; n < quota; ++n) {
        __syncthreads();
        if (F.tid == 0) *slot = (int)xb_add((unsigned*)(F.ws + WS_CTL) + CW_CONVQ, 1u);
        __syncthreads();
        const int it = *slot; if (it >= CV_ITEMS) break;
        conv_item(F, it);
    }
    __syncthreads();
}
DI void p4_pass1(Frame& F) {
    const int T = F.vcu, part = T & 1, cg = T >> 1, chain = cg / (NG - 1), grp = cg % (NG - 1);
    if (T < 16 * (NG - 1) * 2 && part == 0) gscan<1>(F, chain, grp, gs_img(F, WS_XB, chain, grp), nullptr);
    else if (T < 16 * (NG - 1) * 2 && grp > 0) gscan<2>(F, chain, grp, nullptr, gs_aop(F, chain, grp));
    else conv_pull(F, PASS1_QUOTA);
}
DI void p4_pass3(Frame& F) {
    if ((F.vcu & 1) == 0 && (F.vcu >> 1) < 16 * NG) { const int T = F.vcu >> 1; gscan<0>(F, T / NG, T % NG, nullptr, nullptr); }
    conv_pull(F, 1 << 30);
}

DI void p5_combine(Frame& F) {
    const int gw = F.vcu * NWAVES + F.wave, NGW = F.G * NWAVES, lane = F.lane;
    const bf16* OFp = (const bf16*)((unsigned char*)F.out + DO_OF); const bf16* OBp = (const bf16*)((unsigned char*)F.out + DO_OB);
    const bf16* ZA = (const bf16*)(F.ws + WS_ZA); bf16* OCAT = (bf16*)(F.ws + WS_OCAT);
    const float* nw = F.in[6] + (lane & 15) * 8;
    float w8[8];
#pragma unroll
    for (int c = 0; c < 8; ++c) w8[c] = nw[c];
    constexpr int NB4 = 4;
    for (int t0 = gw; t0 < TT; t0 += NB4 * NGW) {
        v4u a[NB4], bb[NB4], z[NB4];
#pragma unroll
        for (int u = 0; u < NB4; ++u) { const int t = (t0 + u * NGW < TT) ? t0 + u * NGW : t0;
            a[u] = *(const v4u*)(OFp + (size_t)t * 512 + lane * 8); bb[u] = *(const v4u*)(OBp + (size_t)t * 512 + lane * 8); z[u] = *(const v4u*)(ZA + (size_t)t * 512 + lane * 8); }
#pragma unroll
        for (int u = 0; u < NB4; ++u) {
            const int t = t0 + u * NGW; if (t >= TT) break;
            float o[8] = {bflo(a[u].x) + bflo(bb[u].x), bfhi(a[u].x) + bfhi(bb[u].x), bflo(a[u].y) + bflo(bb[u].y), bfhi(a[u].y) + bfhi(bb[u].y), bflo(a[u].z) + bflo(bb[u].z), bfhi(a[u].z) + bfhi(bb[u].z), bflo(a[u].w) + bflo(bb[u].w), bfhi(a[u].w) + bfhi(bb[u].w)};
            const float zz[8] = {bflo(z[u].x), bfhi(z[u].x), bflo(z[u].y), bfhi(z[u].y), bflo(z[u].z), bfhi(z[u].z), bflo(z[u].w), bfhi(z[u].w)};
            float ss = 0.f;
#pragma unroll
            for (int c = 0; c < 8; ++c) ss += o[c] * o[c];
            ss = sum16(ss);
            const float rn = __builtin_amdgcn_rsqf(ss * (1.f / 128.f) + EPS);
#pragma unroll
            for (int c = 0; c < 8; ++c) o[c] = o[c] * rn * w8[c] * siluf(zz[c]);
            v4u r; r.x = pk2(o[0], o[1]); r.y = pk2(o[2], o[3]); r.z = pk2(o[4], o[5]); r.w = pk2(o[6], o[7]);
            *(v4u*)(OCAT + (size_t)t * 1024 + lane * 8) = r;
        }
    }
}

struct TokRec { int e[2]; int row[2]; float gate[2]; };
DI void p7_route(Frame& F) {
    const int lane = F.lane, n16 = lane & 15, g = lane >> 4, wave = F.wave;
    const bf16* X1 = (const bf16*)(F.ws + WS_X1); const float* nfw = F.in[10];
    const bf16* WRH = (const bf16*)(F.ws + WS_WR); const bf16* WRL = WRH + 48 * 1024;
    unsigned char* HN = (unsigned char*)F.out + DO_HN; TokRec* TOK = (TokRec*)(F.ws + WS_TOK); unsigned* gcnt = (unsigned*)(F.ws + WS_CTL) + CW_CNT; int* LIST = (int*)(F.ws + WS_LIST);
    LAS float* lg = (LAS float*)(F.lds + (wave & 3) * 4096);
    LAS unsigned* hist = (LAS unsigned*)(F.lds + 16384); LAS unsigned* base = hist + 32;
    const int sub = blockIdx.x & 7;
    const float qsc = 127.0f / act_absmax(nfw, lane);
    for (int rt0 = blockIdx.x * 4; rt0 < TT / 16; rt0 += F.G * 4) {
        if (F.tid < 32) hist[F.tid] = 0u;
        __syncthreads();
        int ex1 = 0, ex2 = 0, tok = -1; unsigned l1 = 0, l2 = 0; float g1 = 0.f, g2 = 0.f;
        const int rt = rt0 + wave;
        if (wave < 4 && rt < TT / 16) {
            const int row = rt * 16 + n16; const bf16* xr = X1 + (size_t)row * DMODEL + 8 * g;
            float ss = 0.f;
#pragma unroll 16
            for (int i = 0; i < 32; ++i) { const v4u xw = *(const v4u*)(xr + 32 * i); const f32x4 a = {bflo(xw.x), bfhi(xw.x), bflo(xw.y), bfhi(xw.y)}, b2 = {bflo(xw.z), bfhi(xw.z), bflo(xw.w), bfhi(xw.w)};
                ss += (a.x * a.x + a.y * a.y) + (a.z * a.z + a.w * a.w) + (b2.x * b2.x + b2.y * b2.y) + (b2.z * b2.z + b2.w * b2.w); }
            ss = sum_x32(sum_x16(ss));
            const float rs = __builtin_amdgcn_rsqf(ss * (1.f / DMODEL) + EPS);
            f32x4 acc[3];
#pragma unroll
            for (int q = 0; q < 3; ++q) acc[q] = (f32x4){0.f, 0.f, 0.f, 0.f};
#pragma unroll 4
            for (int i = 0; i < 32; ++i) {
                const v4u xw = *(const v4u*)(xr + 32 * i); const f32x4 a = {bflo(xw.x), bfhi(xw.x), bflo(xw.y), bfhi(xw.y)}, b2 = {bflo(xw.z), bfhi(xw.z), bflo(xw.w), bfhi(xw.w)};
                const f32x4 wa = *(const f32x4*)(nfw + 32 * i + 8 * g), wb = *(const f32x4*)(nfw + 32 * i + 8 * g + 4);
                float hv[8] = {a.x * rs * wa.x, a.y * rs * wa.y, a.z * rs * wa.z, a.w * rs * wa.w, b2.x * rs * wb.x, b2.y * rs * wb.y, b2.z * rs * wb.z, b2.w * rs * wb.w};
                v4u hi, lo;
                hi.x = pk2(hv[0], hv[1]); hi.y = pk2(hv[2], hv[3]); hi.z = pk2(hv[4], hv[5]); hi.w = pk2(hv[6], hv[7]);
                lo.x = pk2(hv[0] - bflo(hi.x), hv[1] - bfhi(hi.x)); lo.y = pk2(hv[2] - bflo(hi.y), hv[3] - bfhi(hi.y));
                lo.z = pk2(hv[4] - bflo(hi.z), hv[5] - bfhi(hi.z)); lo.w = pk2(hv[6] - bflo(hi.w), hv[7] - bfhi(hi.w));
                { v2u q; q.x = q8x4(hv[0], hv[1], hv[2], hv[3], qsc); q.y = q8x4(hv[4], hv[5], hv[6], hv[7], qsc); *(v2u*)(HN + (size_t)row * DMODEL + 32 * i + 8 * g) = q; }
                const bf16x8 ah = __builtin_bit_cast(bf16x8, hi), al = __builtin_bit_cast(bf16x8, lo);
#pragma unroll
                for (int q = 0; q < 3; ++q) {
                    const bf16x8 bh = *(const bf16x8*)(WRH + (size_t)(16 * q + n16) * 1024 + 32 * i + 8 * g), bl = *(const bf16x8*)(WRL + (size_t)(16 * q + n16) * 1024 + 32 * i + 8 * g);
                    acc[q] = __builtin_amdgcn_mfma_f32_16x16x32_bf16(ah, bh, acc[q], 0, 0, 0);
                    acc[q] = __builtin_amdgcn_mfma_f32_16x16x32_bf16(ah, bl, acc[q], 0, 0, 0);
                    acc[q] = __builtin_amdgcn_mfma_f32_16x16x32_bf16(al, bh, acc[q], 0, 0, 0);
                }
            }
#pragma unroll
            for (int q = 0; q < 3; ++q)
#pragma unroll
                for (int r = 0; r < 4; ++r) lg[(4 * g + r) * 48 + 16 * q + n16] = acc[q][r];
            asm volatile("s_waitcnt lgkmcnt(0)" ::: "memory");
            if (lane < 16) {
                const LAS float* L = lg + lane * 48; tok = rt * 16 + lane;
                float gm = L[0]; int gs = 0;
#pragma unroll
                for (int q = 1; q < 4; ++q) if (L[q] > gm) { gm = L[q]; gs = q; }
                float gsum = 0.f;
#pragma unroll
                for (int q = 0; q < 4; ++q) gsum += __expf(L[q] - gm);
                const float gp_top = 1.0f / gsum;
                float fv[8];
#pragma unroll
                for (int q = 0; q < 8; ++q) { float v = L[4 + q]; v = (gs == 1) ? L[12 + q] : v; v = (gs == 2) ? L[20 + q] : v; v = (gs == 3) ? L[28 + q] : v; fv[q] = v; }
                float m1 = fv[0]; int i1 = 0;
#pragma unroll
                for (int q = 1; q < 8; ++q) if (fv[q] > m1) { m1 = fv[q]; i1 = q; }
                float m2 = -3.0e38f; int i2 = 0;
#pragma unroll
                for (int q = 0; q < 8; ++q) if (q != i1 && fv[q] > m2) { m2 = fv[q]; i2 = q; }
                const float e2 = __expf(m2 - m1); g1 = gp_top / (1.0f + e2); g2 = gp_top * e2 / (1.0f + e2);
                ex1 = gs * 8 + i1; ex2 = gs * 8 + i2;
                l1 = __hip_atomic_fetch_add(hist + ex1, 1u, __ATOMIC_RELAXED, __HIP_MEMORY_SCOPE_WORKGROUP); l2 = __hip_atomic_fetch_add(hist + ex2, 1u, __ATOMIC_RELAXED, __HIP_MEMORY_SCOPE_WORKGROUP);
            }
        }
        __syncthreads();
        if (F.tid < 32) { const unsigned hcount = hist[F.tid]; base[F.tid] = hcount ? atomicAdd(gcnt + F.tid * 8 + sub, hcount) : 0u; }
        __syncthreads();
        if (tok >= 0) {
            const int s1 = (int)(base[ex1] + l1), s2 = (int)(base[ex2] + l2);
            LIST[(size_t)(ex1 * 8 + sub) * TT + s1] = tok; LIST[(size_t)(ex2 * 8 + sub) * TT + s2] = tok;
            TokRec tr; tr.e[0] = ex1; tr.e[1] = ex2; tr.row[0] = (sub << 24) | s1; tr.row[1] = (sub << 24) | s2; tr.gate[0] = g1; tr.gate[1] = g2;
            TOK[tok] = tr;
        }
    }
}

DI void build_etab(Frame& F) {
    LAS unsigned* etab = (LAS unsigned*)(F.lds + ETAB_OFF);
    if (F.tid < 32) {
        const unsigned* gcnt = (const unsigned*)(F.ws + WS_CTL) + CW_CNT + F.tid * 8; unsigned acc = 0;
#pragma unroll
        for (int q = 0; q < 8; ++q) { const unsigned c = __hip_atomic_load(gcnt + q, __ATOMIC_RELAXED, __HIP_MEMORY_SCOPE_AGENT); etab[96 + 8 * F.tid + q] = acc; acc += c; }
        etab[64 + F.tid] = acc; etab[2 * F.tid + 1] = (acc + 255u) >> 8;
    }
    __syncthreads();
    if (F.tid == 0) { unsigned acc = 0; for (int e = 0; e < NEXP; ++e) { etab[2 * e] = acc; acc += etab[2 * e + 1]; } }
    if (F.wave == 1) { const float am = act_absmax(F.in[10], F.lane); if (F.lane == 0) ((LAS float*)etab)[352] = am * (1.0f / 127.0f); }
    __syncthreads();
}

DI void p11_final(Frame& F) {
    build_etab(F);
    const LAS unsigned* etab = (const LAS unsigned*)(F.lds + ETAB_OFF);
    const int gw = F.vcu * NWAVES + F.wave, NGW = F.G * NWAVES, lane = F.lane;
    const bf16* Y = (const bf16*)(F.ws + WS_XBUF); const TokRec* TOK = (const TokRec*)(F.ws + WS_TOK); const float* fw = F.in[16];
    const f32x4 w0 = *(const f32x4*)(fw + lane * 8), w1 = *(const f32x4*)(fw + lane * 8 + 4), w2 = *(const f32x4*)(fw + 512 + lane * 8), w3 = *(const f32x4*)(fw + 516 + lane * 8);
    constexpr int NB2 = 2;
    for (int t0 = gw; t0 < TT; t0 += NB2 * NGW) {
        TokRec tr[NB2]; v4u xa[NB2][2]; v4u ya[NB2][2][2];
#pragma unroll
        for (int u = 0; u < NB2; ++u) { const int t = (t0 + u * NGW < TT) ? t0 + u * NGW : t0; tr[u] = TOK[t];
            const bf16* xr = (const bf16*)(F.ws + WS_X1) + (size_t)t * DMODEL + lane * 8;
            xa[u][0] = *(const v4u*)(xr); xa[u][1] = *(const v4u*)(xr + 512); }
#pragma unroll
        for (int u = 0; u < NB2; ++u)
#pragma unroll
            for (int k = 0; k < 2; ++k) { const unsigned rk = (unsigned)tr[u].row[k]; const bf16* yr = Y + (size_t)(etab[2 * tr[u].e[k]] * 256u + etab[96 + 8 * tr[u].e[k] + (rk >> 24)] + (rk & 0xffffffu)) * DMODEL + lane * 8; ya[u][k][0] = *(const v4u*)(yr); ya[u][k][1] = *(const v4u*)(yr + 512); }
#pragma unroll
        for (int u = 0; u < NB2; ++u) {
            const int t = t0 + u * NGW; if (t >= TT) break;
            float v[16] = {bflo(xa[u][0].x), bfhi(xa[u][0].x), bflo(xa[u][0].y), bfhi(xa[u][0].y), bflo(xa[u][0].z), bfhi(xa[u][0].z), bflo(xa[u][0].w), bfhi(xa[u][0].w),
                           bflo(xa[u][1].x), bfhi(xa[u][1].x), bflo(xa[u][1].y), bfhi(xa[u][1].y), bflo(xa[u][1].z), bfhi(xa[u][1].z), bflo(xa[u][1].w), bfhi(xa[u][1].w)};
#pragma unroll
            for (int k = 0; k < 2; ++k) {
                const float gk = tr[u].gate[k]; const v4u y0 = ya[u][k][0], y1 = ya[u][k][1];
                v[0] += gk * bflo(y0.x); v[1] += gk * bfhi(y0.x); v[2] += gk * bflo(y0.y); v[3] += gk * bfhi(y0.y); v[4] += gk * bflo(y0.z); v[5] += gk * bfhi(y0.z); v[6] += gk * bflo(y0.w); v[7] += gk * bfhi(y0.w);
                v[8] += gk * bflo(y1.x); v[9] += gk * bfhi(y1.x); v[10] += gk * bflo(y1.y); v[11] += gk * bfhi(y1.y); v[12] += gk * bflo(y1.z); v[13] += gk * bfhi(y1.z); v[14] += gk * bflo(y1.w); v[15] += gk * bfhi(y1.w);
            }
            float ss = 0.f;
#pragma unroll
            for (int i = 0; i < 16; ++i) ss += v[i] * v[i];
            const float rs = __builtin_amdgcn_rsqf(wave_sum(ss) * (1.f / DMODEL) + EPS);
            float* orow = F.out + (size_t)t * DMODEL + lane * 8;
            *(f32x4*)(orow) = (f32x4){v[0] * rs * w0.x, v[1] * rs * w0.y, v[2] * rs * w0.z, v[3] * rs * w0.w};
            *(f32x4*)(orow + 4) = (f32x4){v[4] * rs * w1.x, v[5] * rs * w1.y, v[6] * rs * w1.z, v[7] * rs * w1.w};
            *(f32x4*)(orow + 512) = (f32x4){v[8] * rs * w2.x, v[9] * rs * w2.y, v[10] * rs * w2.z, v[11] * rs * w2.w};
            *(f32x4*)(orow + 516) = (f32x4){v[12] * rs * w3.x, v[13] * rs * w3.y, v[14] * rs * w3.z, v[15] * rs * w3.w};
        }
    }
}

struct Args { const float* in[17]; float* out; unsigned char* ws; int ph_lo, ph_hi; };
__global__ void __launch_bounds__(NTHREADS, 2) fwd_kernel(Args args) {
    extern __shared__ __attribute__((aligned(16))) unsigned char lds[];
    cg::grid_group grid = cg::this_grid();
    Frame F;
    F.lds = (LAS unsigned char*)lds; F.tid = threadIdx.x; F.lane = F.tid & 63; F.wave = __builtin_amdgcn_readfirstlane(F.tid >> 6);
    F.G = gridDim.x; { const int bx = blockIdx.x; F.vcu = (F.G % 8 == 0) ? (bx % 8) * (F.G / 8) + bx / 8 : bx; }
#pragma unroll
    for (int i = 0; i < 17; ++i) F.in[i] = args.in[i];
    F.out = args.out; F.ws = args.ws;
    const int lo = args.ph_lo, hi = args.ph_hi;
    if (F.tid < 16) ((volatile LAS unsigned*)(F.lds + MISC_OFF))[F.tid] = 0u;
    __syncthreads();
    XcdBarrier bar = xcd_barrier_post((unsigned*)(F.ws + WS_CTL) + CW_BAR, (volatile LAS unsigned*)(F.lds + MISC_OFF));
    if (lo > 1000) grid.sync();
#ifndef PHSEL
#define PHSEL 0xfff
#endif
#define IN(k) (((PHSEL >> (k)) & 1) && lo <= (k) && (k) < hi)
#define SEAM(k) do { if (IN(k) && IN((k) + 1)) xcd_barrier(bar); } while (0)
#ifndef REP_PH
#define REP_PH -1
#endif
#define REPS(k) for (int rep_ = 0; rep_ < ((k) == REP_PH ? 2 : 1); ++rep_, ((k) == REP_PH && rep_ < 2) ? xcd_barrier(bar) : (void)0)
    if (IN(0)) REPS(0) { p0_prologue(F); } SEAM(0);
    if (IN(1)) REPS(1) {
        pg8::Gemm gm{(const pg8::bf16_t*)(F.ws + WS_XN), (const pg8::bf16_t*)(F.ws + WS_WIN), TT, NPROJ, DMODEL / 2};
        pg8::StaticOrder S; S.init(TT, NPROJ, F.G, (int)blockIdx.x);
        EpiProj E{(bf16*)(F.ws + WS_QKVA), (bf16*)(F.ws + WS_ZA), (bf16*)(F.ws + WS_QKVB), (const float*)(F.ws + WS_WSI), (const float*)(F.ws + WS_XSC)};
        pg8::gemm_phase_gather<EpiProj, pg8::StaticOrder, IdRows, true, true>(F.lds, gm, S, E, IdRows{});
    } SEAM(1);
    if (IN(2)) REPS(2) {
#ifndef NO_ROPE
        p2_rope(F);
#ifdef PROBE_ROPE2
        xcd_barrier(bar); p2_rope(F);
#endif
#endif
#ifndef NO_PRE
        p2_gdn_pre(F);
#ifdef PROBE_PRE2
        xcd_barrier(bar); p2_gdn_pre(F);
#endif
#endif
    } SEAM(2);
    if (IN(3)) REPS(3) {
        const attn_body::AttnTensors AT{(const attn_body::bf16*)((unsigned char*)F.out + DO_QR), (const attn_body::bf16*)((unsigned char*)F.out + DO_KR), (const attn_body::bf16*)((unsigned char*)F.out + DO_VR),
                                        (attn_body::bf16*)(F.ws + WS_OCAT) + 512};
        const attn_body::StaticOrder S((int)F.G, (int)blockIdx.x);
#ifdef PROBE_ZERO_ATTN
        { (void)AT; (void)S; bf16* OC = (bf16*)(F.ws + WS_OCAT); const int gt = blockIdx.x * NTHREADS + F.tid, GT = F.G * NTHREADS;
          for (int i = gt; i < TT * 64; i += GT) { const int t = i >> 6, c = i & 63; *(v4u*)(OC + (size_t)t * 1024 + 512 + c * 8) = (v4u){0u, 0u, 0u, 0u}; } }
#else
        const float nshift = -(0.125f * 1.4426950408889634f * 64.f * 1.01f) * wave_max(fabsf(F.in[7][F.lane])) * wave_max(fabsf(F.in[8][F.lane]));
        attn_body::attn_phase<attn_body::StaticOrder>((char*)lds, AT, S, nshift);
#endif
    }
#if MK_PER_PHASE
    SEAM(3);
#endif
    if (IN(4)) { p4_pass1(F); xcd_barrier(bar); p4_pass3(F); } SEAM(4);
    if (IN(5)) REPS(5) { p5_combine(F); } SEAM(5);
    if (IN(6)) REPS(6) {
        pg8::Gemm gm{(const pg8::bf16_t*)(F.ws + WS_OCAT), (const pg8::bf16_t*)(F.ws + WS_WOUT), TT, DMODEL, DMODEL}; pg8::StaticOrder S; S.init(TT, DMODEL, F.G, (int)blockIdx.x);
        EpiResid E{F.in[0], (bf16*)(F.ws + WS_X1)};
        pg8::gemm_phase<EpiResid, pg8::StaticOrder, true, true>(F.lds, gm, S, E);
    } SEAM(6);
    if (IN(7)) { p7_route(F); } SEAM(7);
    if (IN(9)) REPS(9) {
        build_etab(F);
        pg8::Gemm gm{(const pg8::bf16_t*)((unsigned char*)F.out + DO_HN), (const pg8::bf16_t*)(F.ws + WS_WGU0), 0, 0, DMODEL / 2};
        MoeOrder S{(const LAS unsigned*)(F.lds + ETAB_OFF), F.G, (int)blockIdx.x, WGU_SPLIT, (int)((WS_WGU1 - WS_WGU0) / (256 * 1024))};
        MoeRows AM{(const int*)(F.ws + WS_LIST), (const LAS unsigned*)(F.lds + ETAB_OFF)};
        EpiGU E{(bf16*)(F.ws + WS_HID), (const float*)(F.ws + WS_WSC), ((const LAS float*)(F.lds + ETAB_OFF))[352]};
        pg8::gemm_phase_gather<EpiGU, MoeOrder, MoeRows, true, true>(F.lds, gm, S, E, AM);
    } SEAM(9);
    if (IN(10)) REPS(10) {
        pg8::Gemm gm{(const pg8::bf16_t*)(F.ws + WS_HID), (const pg8::bf16_t*)((unsigned char*)F.out + DO_WD0), 0, 0, FFE}; build_etab(F); MoeOrder S{(const LAS unsigned*)(F.lds + ETAB_OFF), F.G, (int)blockIdx.x, WD_SPLIT, (int)((DO_WD1 - DO_WD0) / (256 * 1024))};
        EpiY E{(bf16*)(F.ws + WS_XBUF)};
        pg8::gemm_phase<EpiY, MoeOrder, true, true>(F.lds, gm, S, E);
    } SEAM(10);
#ifdef EXTRA_SYNCS
    for (int q_ = 0; q_ < EXTRA_SYNCS; ++q_) xcd_barrier(bar);
#endif
    if (IN(11)) { p11_final(F); }
#undef IN
#undef SEAM
}

extern "C" void kernel_launch(void* const* d_in, const int* in_sizes, int n_in, void* d_out, int out_size, void* d_ws, size_t ws_size, hipStream_t stream) {
    static int grid = 0;
    if (grid == 0) {
        if (n_in != 17 || out_size != TT * DMODEL || ws_size < WS_END) { fprintf(stderr, "kernel_launch: unexpected problem (n_in %d out %d ws %zu)\n", n_in, out_size, ws_size); grid = -1; return; }
        int dev = 0, cus = 0, per_cu = 0;
        if (hipGetDevice(&dev) != hipSuccess || hipDeviceGetAttribute(&cus, hipDeviceAttributeMultiprocessorCount, dev) != hipSuccess) { grid = -1; return; }
        if (hipFuncSetAttribute((const void*)fwd_kernel, hipFuncAttributeMaxDynamicSharedMemorySize, LDS_BYTES) != hipSuccess) { fprintf(stderr, "hipFuncSetAttribute failed\n"); grid = -1; return; }
        if (hipOccupancyMaxActiveBlocksPerMultiprocessor(&per_cu, (const void*)fwd_kernel, NTHREADS, LDS_BYTES) != hipSuccess || per_cu < 1) { fprintf(stderr, "occupancy query: %d\n", per_cu); grid = -1; return; }
        if (cus < 256) { fprintf(stderr, "kernel_launch: %d CUs; the scan phase's task map needs 256 workgroups\n", cus); grid = -1; return; }
        grid = cus;
    }
    if (grid < 0) return;
    (void)hipMemsetAsync((char*)d_ws + WS_CTL, 0, CTL_ZERO_BYTES, stream);
    Args a{};
    for (int i = 0; i < 17; ++i) a.in[i] = (const float*)d_in[i];
    a.out = (float*)d_out; a.ws = (unsigned char*)d_ws;
#if MK_PER_PHASE
    for (int p = 0; p < N_PHASES; ++p) { a.ph_lo = p; a.ph_hi = p + 1; hipLaunchKernelGGL(fwd_kernel, dim3(grid), dim3(NTHREADS), LDS_BYTES, stream, a); }
#else
    a.ph_lo = 0; a.ph_hi = N_PHASES;
    void* kargs[] = {&a};
    hipError_t e = hipLaunchCooperativeKernel((void*)fwd_kernel, dim3(grid), dim3(NTHREADS), kargs, LDS_BYTES, stream);
    if (e != hipSuccess) fprintf(stderr, "cooperative launch failed: %s (grid %d)\n", hipGetErrorString(e), grid);
#endif
}
```

```cpp
#include <hip/hip_runtime.h>
#include <cstdio>
#include <cstdint>
namespace pg8 {
#define PG8_LAS __attribute__((address_space(3)))
typedef unsigned short bf16_t;
typedef short bf16x8 __attribute__((ext_vector_type(8)));
typedef float f32x4 __attribute__((ext_vector_type(4)));
typedef unsigned u32x4 __attribute__((ext_vector_type(4)));
constexpr int BM = 256, BK = 64, HALF = 128, HTB = HALF * BK * 2  , STAGE_BYTES = 8 * HTB, NXCD = 8, WGM = 8;

__host__ __device__ __forceinline__ int lds_byte(int r, int c) { const int st = (r >> 4) * 2 + (c >> 5), rr = r & 15, cc = c & 31, ob = rr * 64 + cc * 2; return st * 1024 + (ob ^ (((ob >> 9) & 1) << 5)); }
__host__ __device__ __forceinline__ void stage_rc(int b, int& R, int& C) { const int st = b / 1024, sb = b % 1024, swz = sb ^ (((sb >> 9) & 1) << 5); R = (st >> 1) * 16 + swz / 64; C = (st & 1) * 32 + (swz % 64) / 2; }
__host__ __device__ __forceinline__ int perm32(int rho) { const int n = rho >> 4, i = rho & 15; return 8 * (i >> 2) + 4 * n + (i & 3); }

struct Unit { int pm, pn, ex, tq; };
struct Gemm { const bf16_t* A; const bf16_t* Bt; int M, N, K; };

struct StaticOrder {
    int nM, nN, nwg, G, c;
    __host__ __device__ void init(int M, int N, int G_, int c_) { nM = M / BM; nN = N / BM; nwg = nM * nN; G = G_; c = c_; }
    __host__ __device__ bool next(int i, Unit& u) const {
        const long L = (long)i * G + c; if (L >= nwg) return false;
        int wgid = (int)L; { const int q = nwg / NXCD, r = nwg % NXCD, xcd = wgid % NXCD, off = wgid / NXCD; wgid = (xcd < r ? xcd * (q + 1) : r * (q + 1) + (xcd - r) * q) + off; }
        const int nig = WGM * nN, gid = wgid / nig, fm = gid * WGM, gsz = (nM - fm) < WGM ? (nM - fm) : WGM;
        u.pm = fm + ((wgid % nig) % gsz); u.pn = (wgid % nig) / gsz; return true;
    }
    __device__ __forceinline__ void a_ready(const Unit&) const {}
    __device__ __forceinline__ void done(const Unit&) const {}
};

__device__ __forceinline__ unsigned cvt_pk_bf16(float lo, float hi) { unsigned r; asm volatile("v_cvt_pk_bf16_f32 %0, %1, %2" : "=v"(r) : "v"(lo), "v"(hi)); return r; }
typedef float f32x2 __attribute__((ext_vector_type(2)));
template <class Epi, class Sched, bool ALIGN_EPI = false, bool SP2 = false>
__device__ __forceinline__ void gemm_phase(PG8_LAS unsigned char* lds, const Gemm g, const Sched& S, const Epi& E) {
    const int tid = threadIdx.x, wid = __builtin_amdgcn_readfirstlane(tid >> 6), lane = tid & 63, wr = wid >> 2, wc = wid & 3, fr = lane & 15, fq = lane >> 4;
    const int K = g.K, nt = K / BK;
    unsigned voffA[2], voffB[2];
#pragma unroll
    for (int i = 0; i < 2; ++i) { int R, C; stage_rc(tid * 16 + i * 8192, R, C); const int Rb = Epi::PERM ? ((R & ~31) + perm32(R & 31)) : R;
        voffA[i] = (unsigned)(R * K + C) * 2u; voffB[i] = (unsigned)(Rb * K + C) * 2u; }
    const size_t kstep = (size_t)(BK * 2);
    const size_t hstep = (size_t)HALF * K * 2;
    const size_t tstep = 2 * hstep;
    const unsigned ldsw = (unsigned)wid * 1024u;
    const int aoff = lds_byte(wr * 64 + fr, fq * 8), boff = lds_byte(wc * 32 + fr, fq * 8);
#define PG8_SA(b, h) (((b) * 2 + (h)) * HTB)
#define PG8_SB(b, h) ((4 + (b) * 2 + (h)) * HTB)
#define PG8_STAGE(bufoff, gbase, voff) do { _Pragma("unroll") for (int _i = 0; _i < 2; ++_i) \
        __builtin_amdgcn_global_load_lds((const unsigned*)((const char*)(gbase) + (voff)[_i]), (PG8_LAS unsigned*)(lds + (bufoff) + ldsw + _i * 8192), 16, 0, 0); } while (0)
#define PG8_LDA(dst, b, h) do { _Pragma("unroll") for (int m = 0; m < 4; ++m) _Pragma("unroll") for (int k = 0; k < 2; ++k) dst[m][k] = *(const PG8_LAS bf16x8*)(lds + PG8_SA(b, h) + aoff + m * 2048 + k * 1024); } while (0)
#define PG8_LDB(dst, b, h) do { _Pragma("unroll") for (int n = 0; n < 2; ++n) _Pragma("unroll") for (int k = 0; k < 2; ++k) dst[n][k] = *(const PG8_LAS bf16x8*)(lds + PG8_SB(b, h) + boff + n * 2048 + k * 1024); } while (0)
#define PG8_MMA(ai, bj, At, Bt) do { __builtin_amdgcn_s_setprio(1); _Pragma("unroll") for (int m = 0; m < 4; ++m) _Pragma("unroll") for (int n = 0; n < 2; ++n) _Pragma("unroll") for (int k = 0; k < 2; ++k) \
        acc[ai][bj][m][n] = __builtin_amdgcn_mfma_f32_16x16x32_bf16(Bt[n][k], At[m][k], acc[ai][bj][m][n], 0, 0, 0); __builtin_amdgcn_s_setprio(0); } while (0)
#define PG8_WAIT_V(n) asm volatile("s_waitcnt vmcnt(" #n ")" ::: "memory")
#define PG8_WAIT_L(n) asm volatile("s_waitcnt lgkmcnt(" #n ")" ::: "memory")
#define PG8_BAR __builtin_amdgcn_s_barrier()
#define PG8_SCHED __builtin_amdgcn_sched_barrier(0)
    Unit cur, nxt; int ui = 0;
    if (!S.next(0, cur)) return;
    f32x4 acc[2][2][4][2];
#pragma unroll
    for (int a = 0; a < 2; ++a)
#pragma unroll
        for (int b = 0; b < 2; ++b)
#pragma unroll
            for (int m = 0; m < 4; ++m)
#pragma unroll
                for (int n = 0; n < 2; ++n) acc[a][b][m][n] = (f32x4){0.f, 0.f, 0.f, 0.f};
    bf16x8 At[4][2], B0[2][2], B1[2][2];
    const char* cA = (const char*)g.A + (size_t)cur.pm * tstep; const char* cB = (const char*)g.Bt + (size_t)cur.pn * tstep;
    S.a_ready(cur);
    if constexpr (SP2) {
        PG8_STAGE(PG8_SB(0, 0), cB, voffB); PG8_STAGE(PG8_SB(0, 1), cB + hstep, voffB); PG8_STAGE(PG8_SA(0, 0), cA, voffA); PG8_STAGE(PG8_SA(0, 1), cA + hstep, voffA);
        if (wr == 1) PG8_BAR;
        PG8_WAIT_V(2); PG8_BAR;
        PG8_STAGE(PG8_SB(1, 0), cB + kstep, voffB); PG8_STAGE(PG8_SA(1, 0), cA + kstep, voffA); PG8_STAGE(PG8_SB(1, 1), cB + hstep + kstep, voffB);
        PG8_WAIT_V(6); PG8_BAR;
    } else {
        PG8_STAGE(PG8_SB(0, 0), cB, voffB); PG8_STAGE(PG8_SA(0, 0), cA, voffA); PG8_STAGE(PG8_SB(0, 1), cB + hstep, voffB); PG8_STAGE(PG8_SA(0, 1), cA + hstep, voffA);
        if (wr == 1) PG8_BAR;
        PG8_WAIT_V(4); PG8_BAR;
        PG8_STAGE(PG8_SB(1, 0), cB + kstep, voffB); PG8_STAGE(PG8_SA(1, 0), cA + kstep, voffA); PG8_STAGE(PG8_SB(1, 1), cB + hstep + kstep, voffB);
        PG8_WAIT_V(6); PG8_BAR;
    }
    for (;;) {
        const bool has_next = S.next(ui + 1, nxt);
        const char* nA = has_next ? (const char*)g.A + (size_t)nxt.pm * tstep : cA; const char* nB = has_next ? (const char*)g.Bt + (size_t)nxt.pn * tstep : cB;
        for (int t = 0; t < nt; t += 2) {
            const bool last = (t == nt - 2);
            const char* a1 = cA + (size_t)(t + 1) * kstep;
            const char* a2 = last ? nA : cA + (size_t)(t + 2) * kstep; const char* b2 = last ? nB : cB + (size_t)(t + 2) * kstep;
            const char* a3 = a2 + kstep; const char* b3 = b2 + kstep;
            if (last && has_next) S.a_ready(nxt);
            if constexpr (SP2) {
            PG8_LDB(B0, 0, 0); PG8_LDB(B1, 0, 1); PG8_SCHED; PG8_LDA(At, 0, 0); PG8_STAGE(PG8_SA(1, 1), a1 + hstep, voffA);
            PG8_WAIT_V(8); PG8_WAIT_L(0); PG8_BAR; PG8_MMA(0, 0, At, B0); PG8_MMA(0, 1, At, B1); PG8_BAR; PG8_SCHED;
            PG8_LDA(At, 0, 1); PG8_STAGE(PG8_SB(0, 0), b2, voffB); PG8_STAGE(PG8_SB(0, 1), b2 + hstep, voffB); PG8_STAGE(PG8_SA(0, 0), a2, voffA);
            PG8_WAIT_V(8); PG8_WAIT_L(0); PG8_BAR; PG8_MMA(1, 0, At, B0); PG8_MMA(1, 1, At, B1); PG8_BAR; PG8_SCHED;
            PG8_LDB(B0, 1, 0); PG8_LDB(B1, 1, 1); PG8_SCHED; PG8_LDA(At, 1, 0); PG8_STAGE(PG8_SA(0, 1), a2 + hstep, voffA);
            PG8_WAIT_V(8); PG8_WAIT_L(0); PG8_BAR; PG8_MMA(0, 0, At, B0); PG8_MMA(0, 1, At, B1); PG8_BAR; PG8_SCHED;
            PG8_LDA(At, 1, 1); PG8_STAGE(PG8_SB(1, 0), b3, voffB); PG8_STAGE(PG8_SB(1, 1), b3 + hstep, voffB); PG8_STAGE(PG8_SA(1, 0), a3, voffA);
            PG8_WAIT_V(8); PG8_WAIT_L(0); PG8_BAR; PG8_MMA(1, 0, At, B0); PG8_MMA(1, 1, At, B1); PG8_BAR; PG8_SCHED;
            } else {
            PG8_LDB(B0, 0, 0); PG8_SCHED; PG8_LDA(At, 0, 0); PG8_STAGE(PG8_SA(1, 1), a1 + hstep, voffA);
            PG8_WAIT_L(8); PG8_BAR; PG8_WAIT_L(0); PG8_MMA(0, 0, At, B0); PG8_BAR; PG8_SCHED;
            PG8_LDB(B1, 0, 1); PG8_STAGE(PG8_SB(0, 0), b2, voffB);
            PG8_BAR; PG8_WAIT_L(0); PG8_MMA(0, 1, At, B1); PG8_BAR;
            PG8_LDA(At, 0, 1); PG8_STAGE(PG8_SA(0, 0), a2, voffA);
            PG8_BAR; PG8_WAIT_L(0); PG8_MMA(1, 0, At, B0); PG8_BAR; PG8_SCHED;
            PG8_STAGE(PG8_SB(0, 1), b2 + hstep, voffB);
            PG8_WAIT_V(6); PG8_BAR; PG8_MMA(1, 1, At, B1); PG8_BAR;
            PG8_LDB(B0, 1, 0); PG8_SCHED; PG8_LDA(At, 1, 0); PG8_STAGE(PG8_SA(0, 1), a2 + hstep, voffA);
            PG8_WAIT_L(8); PG8_BAR; PG8_WAIT_L(0); PG8_MMA(0, 0, At, B0); PG8_BAR; PG8_SCHED;
            PG8_LDB(B1, 1, 1); PG8_STAGE(PG8_SB(1, 0), b3, voffB);
            PG8_BAR; PG8_WAIT_L(0); PG8_MMA(0, 1, At, B1); PG8_BAR;
            PG8_LDA(At, 1, 1); PG8_STAGE(PG8_SA(1, 0), a3, voffA);
            PG8_BAR; PG8_WAIT_L(0); PG8_MMA(1, 0, At, B0); PG8_BAR; PG8_SCHED;
            PG8_STAGE(PG8_SB(1, 1), b3 + hstep, voffB);
            PG8_WAIT_V(6); PG8_BAR; PG8_MMA(1, 1, At, B1); PG8_BAR;
            }
        }
        if constexpr (ALIGN_EPI) { if (wr == 0) PG8_BAR; }
        if constexpr (!Epi::AFTER_DRAIN) { E(acc, cur, wr, wc, fr, fq); S.done(cur); }
        if (!has_next) break;
#pragma unroll
        for (int a = 0; a < 2; ++a)
#pragma unroll
            for (int b = 0; b < 2; ++b)
#pragma unroll
                for (int m = 0; m < 4; ++m)
#pragma unroll
                    for (int n = 0; n < 2; ++n) acc[a][b][m][n] = (f32x4){0.f, 0.f, 0.f, 0.f};
        cur = nxt; cA = nA; cB = nB; ++ui;
        if constexpr (ALIGN_EPI) { if (wr == 1) PG8_BAR; }
    }
    PG8_WAIT_V(0);
    if constexpr (!ALIGN_EPI) { if (wr == 0) PG8_BAR; }
    PG8_BAR;
    if constexpr (Epi::AFTER_DRAIN) { E.fused(acc, cur, wr, wc, fr, fq, lds, wid, lane); S.done(cur); }
#undef PG8_SA
#undef PG8_SB
#undef PG8_STAGE
#undef PG8_LDA
#undef PG8_LDB
#undef PG8_MMA
#undef PG8_WAIT_V
#undef PG8_WAIT_L
#undef PG8_BAR
#undef PG8_SCHED
}
typedef int i32x4 __attribute__((ext_vector_type(4)));
template <bool I8> struct AccSel { typedef f32x4 type; };
template <> struct AccSel<true> { typedef i32x4 type; };
template <bool I8> __device__ __forceinline__ void mma_step(typename AccSel<I8>::type& c, const bf16x8& b, const bf16x8& a) {
    if constexpr (I8) c = __builtin_amdgcn_mfma_i32_16x16x64_i8(__builtin_bit_cast(i32x4, b), __builtin_bit_cast(i32x4, a), c, 0, 0, 0);
    else c = __builtin_amdgcn_mfma_f32_16x16x32_bf16(b, a, c, 0, 0, 0);
}
template <class Epi, class Sched, class AMap, bool ALIGN_EPI = false, bool I8 = false>
__device__ __forceinline__ void gemm_phase_gather(PG8_LAS unsigned char* lds, const Gemm g, const Sched& S, const Epi& E, const AMap& AM) {
    constexpr bool SP2 = true;
    const int tid = threadIdx.x, wid = __builtin_amdgcn_readfirstlane(tid >> 6), lane = tid & 63, wr = wid >> 2, wc = wid & 3, fr = lane & 15, fq = lane >> 4;
    const int K = g.K, nt = K / BK;
    unsigned voffA[2], voffB[2]; int rowA[2];
#pragma unroll
    for (int i = 0; i < 2; ++i) { int R, C; stage_rc(tid * 16 + i * 8192, R, C); const int Rb = Epi::PERM ? ((R & ~31) + perm32(R & 31)) : R;
        voffA[i] = (unsigned)C * 2u; voffB[i] = (unsigned)(Rb * K + C) * 2u; rowA[i] = R; }
    const size_t kstep = (size_t)(BK * 2);
    const size_t hstep = (size_t)HALF * K * 2;
    const size_t tstep = 2 * hstep;
    const unsigned ldsw = (unsigned)wid * 1024u;
    const int aoff = lds_byte(wr * 64 + fr, fq * 8), boff = lds_byte(wc * 32 + fr, fq * 8);
#define PG8_SA(b, h) (((b) * 2 + (h)) * HTB)
#define PG8_SB(b, h) ((4 + (b) * 2 + (h)) * HTB)
#define PG8_STAGE(bufoff, gbase, voff) do { _Pragma("unroll") for (int _i = 0; _i < 2; ++_i) \
        __builtin_amdgcn_global_load_lds((const unsigned*)((const char*)(gbase) + (voff)[_i]), (PG8_LAS unsigned*)(lds + (bufoff) + ldsw + _i * 8192), 16, 0, 0); } while (0)
#define PG8_LDA(dst, b, h) do { _Pragma("unroll") for (int m = 0; m < 4; ++m) _Pragma("unroll") for (int k = 0; k < 2; ++k) dst[m][k] = *(const PG8_LAS bf16x8*)(lds + PG8_SA(b, h) + aoff + m * 2048 + k * 1024); } while (0)
#define PG8_LDB(dst, b, h) do { _Pragma("unroll") for (int n = 0; n < 2; ++n) _Pragma("unroll") for (int k = 0; k < 2; ++k) dst[n][k] = *(const PG8_LAS bf16x8*)(lds + PG8_SB(b, h) + boff + n * 2048 + k * 1024); } while (0)
#define PG8_MMA(ai, bj, At, Bt) do { __builtin_amdgcn_s_setprio(1); _Pragma("unroll") for (int m = 0; m < 4; ++m) _Pragma("unroll") for (int n = 0; n < 2; ++n) _Pragma("unroll") for (int k = 0; k < 2; ++k) \
        mma_step<I8>(acc[ai][bj][m][n], Bt[n][k], At[m][k]); __builtin_amdgcn_s_setprio(0); } while (0)
#define PG8_WAIT_V(n) asm volatile("s_waitcnt vmcnt(" #n ")" ::: "memory")
#define PG8_WAIT_L(n) asm volatile("s_waitcnt lgkmcnt(" #n ")" ::: "memory")
#define PG8_BAR __builtin_amdgcn_s_barrier()
#define PG8_SCHED __builtin_amdgcn_sched_barrier(0)
    Unit cur, nxt; int ui = 0;
    if (!S.next(0, cur)) return;
    typedef typename AccSel<I8>::type acc_t;
    acc_t acc[2][2][4][2];
#pragma unroll
    for (int a = 0; a < 2; ++a)
#pragma unroll
        for (int b = 0; b < 2; ++b)
#pragma unroll
            for (int m = 0; m < 4; ++m)
#pragma unroll
                for (int n = 0; n < 2; ++n) acc[a][b][m][n] = (acc_t){0, 0, 0, 0};
    bf16x8 At[4][2], B0[2][2], B1[2][2];
    const char* cA = (const char*)g.A; const char* cB = (const char*)g.Bt + (size_t)cur.pn * tstep;
    unsigned vA0[2], vA1[2], nA0[2], nA1[2];
#pragma unroll
    for (int i = 0; i < 2; ++i) { vA0[i] = (unsigned)AM.row(cur, rowA[i]) * (unsigned)(K * 2) + voffA[i]; vA1[i] = (unsigned)AM.row(cur, HALF + rowA[i]) * (unsigned)(K * 2) + voffA[i]; }
    S.a_ready(cur);
    if constexpr (SP2) {
        PG8_STAGE(PG8_SB(0, 0), cB, voffB); PG8_STAGE(PG8_SB(0, 1), cB + hstep, voffB); PG8_STAGE(PG8_SA(0, 0), cA, vA0); PG8_STAGE(PG8_SA(0, 1), cA, vA1);
        if (wr == 1) PG8_BAR;
        PG8_WAIT_V(2); PG8_BAR;
        PG8_STAGE(PG8_SB(1, 0), cB + kstep, voffB); PG8_STAGE(PG8_SA(1, 0), cA + kstep, vA0); PG8_STAGE(PG8_SB(1, 1), cB + hstep + kstep, voffB);
        PG8_WAIT_V(6); PG8_BAR;
    } else {
        PG8_STAGE(PG8_SB(0, 0), cB, voffB); PG8_STAGE(PG8_SA(0, 0), cA, voffA); PG8_STAGE(PG8_SB(0, 1), cB + hstep, voffB); PG8_STAGE(PG8_SA(0, 1), cA + hstep, voffA);
        if (wr == 1) PG8_BAR;
        PG8_WAIT_V(4); PG8_BAR;
        PG8_STAGE(PG8_SB(1, 0), cB + kstep, voffB); PG8_STAGE(PG8_SA(1, 0), cA + kstep, voffA); PG8_STAGE(PG8_SB(1, 1), cB + hstep + kstep, voffB);
        PG8_WAIT_V(6); PG8_BAR;
    }
    for (;;) {
        const bool has_next = S.next(ui + 1, nxt);
        const char* nA = cA; const char* nB = has_next ? (const char*)g.Bt + (size_t)nxt.pn * tstep : cB;
#pragma unroll
        for (int i = 0; i < 2; ++i) { nA0[i] = has_next ? (unsigned)AM.row(nxt, rowA[i]) * (unsigned)(K * 2) + voffA[i] : vA0[i]; nA1[i] = has_next ? (unsigned)AM.row(nxt, HALF + rowA[i]) * (unsigned)(K * 2) + voffA[i] : vA1[i]; }
        for (int t = 0; t < nt; t += 2) {
            const bool last = (t == nt - 2);
            const char* a1 = cA + (size_t)(t + 1) * kstep;
            const char* a2 = last ? nA : cA + (size_t)(t + 2) * kstep; const char* b2 = last ? nB : cB + (size_t)(t + 2) * kstep;
            const char* a3 = a2 + kstep; const char* b3 = b2 + kstep;
            unsigned s0[2], s1[2];
#pragma unroll
            for (int i = 0; i < 2; ++i) { s0[i] = vA0[i]; s1[i] = vA1[i]; }
            if (last) {
#pragma unroll
                for (int i = 0; i < 2; ++i) { unsigned t0_ = nA0[i], t1_ = nA1[i]; asm volatile("" : "+v"(t0_), "+v"(t1_)); s0[i] = t0_; s1[i] = t1_; } }
            if (last && has_next) S.a_ready(nxt);
            if constexpr (SP2) {
            PG8_LDB(B0, 0, 0); PG8_LDB(B1, 0, 1); PG8_SCHED; PG8_LDA(At, 0, 0); PG8_STAGE(PG8_SA(1, 1), a1, vA1);
            PG8_WAIT_V(8); PG8_WAIT_L(0); PG8_BAR; PG8_MMA(0, 0, At, B0); PG8_MMA(0, 1, At, B1); PG8_BAR; PG8_SCHED;
            PG8_LDA(At, 0, 1); PG8_STAGE(PG8_SB(0, 0), b2, voffB); PG8_STAGE(PG8_SB(0, 1), b2 + hstep, voffB); PG8_STAGE(PG8_SA(0, 0), a2, s0);
            PG8_WAIT_V(8); PG8_WAIT_L(0); PG8_BAR; PG8_MMA(1, 0, At, B0); PG8_MMA(1, 1, At, B1); PG8_BAR; PG8_SCHED;
            PG8_LDB(B0, 1, 0); PG8_LDB(B1, 1, 1); PG8_SCHED; PG8_LDA(At, 1, 0); PG8_STAGE(PG8_SA(0, 1), a2, s1);
            PG8_WAIT_V(8); PG8_WAIT_L(0); PG8_BAR; PG8_MMA(0, 0, At, B0); PG8_MMA(0, 1, At, B1); PG8_BAR; PG8_SCHED;
            PG8_LDA(At, 1, 1); PG8_STAGE(PG8_SB(1, 0), b3, voffB); PG8_STAGE(PG8_SB(1, 1), b3 + hstep, voffB); PG8_STAGE(PG8_SA(1, 0), a3, s0);
            PG8_WAIT_V(8); PG8_WAIT_L(0); PG8_BAR; PG8_MMA(1, 0, At, B0); PG8_MMA(1, 1, At, B1); PG8_BAR; PG8_SCHED;
            } else {
            PG8_LDB(B0, 0, 0); PG8_SCHED; PG8_LDA(At, 0, 0); PG8_STAGE(PG8_SA(1, 1), a1 + hstep, voffA);
            PG8_WAIT_L(8); PG8_BAR; PG8_WAIT_L(0); PG8_MMA(0, 0, At, B0); PG8_BAR; PG8_SCHED;
            PG8_LDB(B1, 0, 1); PG8_STAGE(PG8_SB(0, 0), b2, voffB);
            PG8_BAR; PG8_WAIT_L(0); PG8_MMA(0, 1, At, B1); PG8_BAR;
            PG8_LDA(At, 0, 1); PG8_STAGE(PG8_SA(0, 0), a2, voffA);
            PG8_BAR; PG8_WAIT_L(0); PG8_MMA(1, 0, At, B0); PG8_BAR; PG8_SCHED;
            PG8_STAGE(PG8_SB(0, 1), b2 + hstep, voffB);
            PG8_WAIT_V(6); PG8_BAR; PG8_MMA(1, 1, At, B1); PG8_BAR;
            PG8_LDB(B0, 1, 0); PG8_SCHED; PG8_LDA(At, 1, 0); PG8_STAGE(PG8_SA(0, 1), a2 + hstep, voffA);
            PG8_WAIT_L(8); PG8_BAR; PG8_WAIT_L(0); PG8_MMA(0, 0, At, B0); PG8_BAR; PG8_SCHED;
            PG8_LDB(B1, 1, 1); PG8_STAGE(PG8_SB(1, 0), b3, voffB);
            PG8_BAR; PG8_WAIT_L(0); PG8_MMA(0, 1, At, B1); PG8_BAR;
            PG8_LDA(At, 1, 1); PG8_STAGE(PG8_SA(1, 0), a3, voffA);
            PG8_BAR; PG8_WAIT_L(0); PG8_MMA(1, 0, At, B0); PG8_BAR; PG8_SCHED;
            PG8_STAGE(PG8_SB(1, 1), b3 + hstep, voffB);
            PG8_WAIT_V(6); PG8_BAR; PG8_MMA(1, 1, At, B1); PG8_BAR;
            }
        }
        if constexpr (ALIGN_EPI) { if (wr == 0) PG8_BAR; }
        if constexpr (!Epi::AFTER_DRAIN) { E(acc, cur, wr, wc, fr, fq); S.done(cur); }
        if (!has_next) break;
#pragma unroll
        for (int a = 0; a < 2; ++a)
#pragma unroll
            for (int b = 0; b < 2; ++b)
#pragma unroll
                for (int m = 0; m < 4; ++m)
#pragma unroll
                    for (int n = 0; n < 2; ++n) acc[a][b][m][n] = (acc_t){0, 0, 0, 0};
        cur = nxt; cA = nA; cB = nB; ++ui;
#pragma unroll
        for (int i = 0; i < 2; ++i) { vA0[i] = nA0[i]; vA1[i] = nA1[i]; }
        if constexpr (ALIGN_EPI) { if (wr == 1) PG8_BAR; }
    }
    PG8_WAIT_V(0);
    if constexpr (!ALIGN_EPI) { if (wr == 0) PG8_BAR; }
    PG8_BAR;
    if constexpr (Epi::AFTER_DRAIN) { E.fused(acc, cur, wr, wc, fr, fq, lds, wid, lane); S.done(cur); }
#undef PG8_SA
#undef PG8_SB
#undef PG8_STAGE
#undef PG8_LDA
#undef PG8_LDB
#undef PG8_MMA
#undef PG8_WAIT_V
#undef PG8_WAIT_L
#undef PG8_BAR
#undef PG8_SCHED
}
}
#include <hip/hip_bf16.h>
#include <cmath>
namespace attn_body {
using bf16=__hip_bfloat16;
using bf16x8=__attribute__((ext_vector_type(8)))short;
using s16x4=__attribute__((ext_vector_type(4)))short;
using f32x16=__attribute__((ext_vector_type(16)))float;
using u32x4=__attribute__((ext_vector_type(4)))unsigned;
constexpr int BATCH=2,NHEAD=8,NKVH=2,SEQ=8192,D=64,QP=512,KP=128,OP=1024;
constexpr int NW=8,QBLK=32,QB=QBLK*NW,KVBLK=64,NQB=SEQ/QB;
constexpr int ATTN_UNIT_ROWS=QB;
__device__ __forceinline__ int crow(int r,int hi){return (r&3)+8*(r>>2)+4*hi;}
#define SBAR() __builtin_amdgcn_sched_barrier(0)
__device__ __forceinline__ void cmask(f32x16&p0,f32x16&p1,int jb,int qrel,int hi){
  const float NEG=-INFINITY; int kb=64*jb+4*hi;
  #pragma unroll
  for(int r=0;r<16;++r){int kv=kb+(r&3)+8*(r>>2); if(kv>qrel)p0[r]=NEG; if(kv+32>qrel)p1[r]=NEG;}
}

constexpr int NSLOT=3, SLOTB=8192;
constexpr int LDS_K=0, LDS_V=NSLOT*SLOTB, LDS_WS=2*NSLOT*SLOTB, LDS_OST=LDS_WS+NW*64*4, LDS_BYTES=LDS_OST+NW*4096;
constexpr float C2=0.125f*1.4426950408889634f;
__device__ __forceinline__ void glds16(const void*gsrc,unsigned lds_dst){unsigned keep;
  asm volatile("s_mov_b32 %0, m0\n\ts_mov_b32 m0, %2\n\ts_nop 0\n\tglobal_load_lds_dwordx4 %1, off\n\ts_mov_b32 m0, %0":"=&s"(keep):"v"(gsrc),"s"(lds_dst):"memory");}
__device__ __forceinline__ float max3f(float a,float b,float c){float r;asm("v_max3_f32 %0, %1, %2, %3":"=v"(r):"v"(a),"v"(b),"v"(c));return r;}
__device__ __forceinline__ float max2f(float a,float b){float r;asm("v_max_f32_e32 %0, %1, %2":"=v"(r):"v"(a),"v"(b));return r;}
__device__ __forceinline__ float fadd_s(float a,float b){float r;asm("v_add_f32_e32 %0, %1, %2":"=v"(r):"v"(a),"v"(b));return r;}
__device__ __forceinline__ float fsub_s(float a,float b){float r;asm("v_sub_f32_e32 %0, %1, %2":"=v"(r):"v"(a),"v"(b));return r;}
typedef float f32x2_t __attribute__((ext_vector_type(2))); typedef __bf16 bf16x2_t __attribute__((ext_vector_type(2)));
__device__ __forceinline__ unsigned cvtpk_s(float lo,float hi){f32x2_t v={lo,hi};bf16x2_t b=__builtin_convertvector(v,bf16x2_t);return __builtin_bit_cast(unsigned,b);}
#define WAIT_BAR(N) asm volatile("s_waitcnt vmcnt(" #N ") lgkmcnt(0)\n\ts_barrier":::"memory")

__device__ __forceinline__ void qkt(f32x16&p0,f32x16&p1,const char*Kslot,const bf16x8*qr,const f32x16&negm,int r32,int hi){
  const char*kb=Kslot+hi*1024+r32*16;
  #pragma unroll
  for(int d0=0;d0<4;++d0){
    const bf16x8 b0=*reinterpret_cast<const bf16x8*>(kb+d0*2048);
    const bf16x8 b1=*reinterpret_cast<const bf16x8*>(kb+d0*2048+512);
    if(d0==0){p0=__builtin_amdgcn_mfma_f32_32x32x16_bf16(b0,qr[0],negm,0,0,0);p1=__builtin_amdgcn_mfma_f32_32x32x16_bf16(b1,qr[0],negm,0,0,0);}
    else{p0=__builtin_amdgcn_mfma_f32_32x32x16_bf16(b0,qr[d0],p0,0,0,0);p1=__builtin_amdgcn_mfma_f32_32x32x16_bf16(b1,qr[d0],p1,0,0,0);}}
}
typedef __attribute__((address_space(3))) const char* lds_cptr;
typedef short v4i16_t __attribute__((ext_vector_type(4)));
__device__ __forceinline__ void kload8(bf16x8*kf,lds_cptr kp){
  kf[0]=*(const __attribute__((address_space(3))) bf16x8*)(kp);      kf[1]=*(const __attribute__((address_space(3))) bf16x8*)(kp+512);
  kf[2]=*(const __attribute__((address_space(3))) bf16x8*)(kp+2048); kf[3]=*(const __attribute__((address_space(3))) bf16x8*)(kp+2560);
  kf[4]=*(const __attribute__((address_space(3))) bf16x8*)(kp+4096); kf[5]=*(const __attribute__((address_space(3))) bf16x8*)(kp+4608);
  kf[6]=*(const __attribute__((address_space(3))) bf16x8*)(kp+6144); kf[7]=*(const __attribute__((address_space(3))) bf16x8*)(kp+6656);
}
__device__ __forceinline__ void kload2(bf16x8*kf,lds_cptr kp,int j){ kf[2*j]=*(const __attribute__((address_space(3))) bf16x8*)(kp+j*2048); kf[2*j+1]=*(const __attribute__((address_space(3))) bf16x8*)(kp+j*2048+512); }
__device__ __forceinline__ s16x4 vtr(lds_cptr p){ return __builtin_bit_cast(s16x4,__builtin_amdgcn_ds_read_tr16_b64_v4i16((__attribute__((address_space(3))) v4i16_t*)p)); }
__device__ __forceinline__ float rowmax(const f32x16&p0,const f32x16&p1){
  float a=max3f(p0[0],p0[1],p1[0]),b=max3f(p0[2],p0[3],p1[1]);a=max3f(a,p1[2],p1[3]);
  #pragma unroll
  for(int r=4;r<16;r+=4){a=max3f(a,p0[r],p0[r+1]);b=max3f(b,p0[r+2],p0[r+3]);a=max3f(a,p1[r],p1[r+1]);b=max3f(b,p1[r+2],p1[r+3]);}
  const float m=max2f(a,b);
  auto rr=__builtin_amdgcn_permlane32_swap(__float_as_uint(m),__float_as_uint(m),false,false);
  return max2f(__uint_as_float(rr[0]),__uint_as_float(rr[1]));
}
__device__ __forceinline__ void pv(f32x16*o,int vb,bf16x8 pa0,bf16x8 pa1,bf16x8 pa2,bf16x8 pa3){
  #pragma unroll
  for(int d0=0;d0<2;++d0){s16x4 lo[4],hi[4];
    #pragma unroll
    for(int ks=0;ks<4;++ks){
      asm volatile("ds_read_b64_tr_b16 %0,%1 offset:%c2":"=&v"(lo[ks]):"v"(vb),"i"(d0*4096+ks*1024):"memory");
      asm volatile("ds_read_b64_tr_b16 %0,%1 offset:%c2":"=&v"(hi[ks]):"v"(vb),"i"(d0*4096+ks*1024+512):"memory");}
    asm volatile("s_waitcnt lgkmcnt(0)":::"memory");SBAR();
    #define PK(k) (bf16x8){lo[k][0],lo[k][1],lo[k][2],lo[k][3],hi[k][0],hi[k][1],hi[k][2],hi[k][3]}
    o[d0]=__builtin_amdgcn_mfma_f32_32x32x16_bf16(pa0,PK(0),o[d0],0,0,0);
    o[d0]=__builtin_amdgcn_mfma_f32_32x32x16_bf16(pa1,PK(1),o[d0],0,0,0);
    o[d0]=__builtin_amdgcn_mfma_f32_32x32x16_bf16(pa2,PK(2),o[d0],0,0,0);
    o[d0]=__builtin_amdgcn_mfma_f32_32x32x16_bf16(pa3,PK(3),o[d0],0,0,0);
    #undef PK
  }
}

#ifndef ATTN_STORE16
#define ATTN_STORE16(p,v) (*(u32x4*)(p)=(v))
#endif
template<int THRL> __device__ __forceinline__ void attn_unit(int b,int h,int qb,const bf16*Q,const bf16*__restrict__ K,const bf16*__restrict__ V,bf16*O,char*shm,const float nshift){
  const int tid=threadIdx.x,lane=tid&63,r32=lane&31,hi=lane>>5; const int wid=__builtin_amdgcn_readfirstlane(tid>>6);
  const long rowbase=(long)b*SEQ; const int q0=qb*QB;
  const bf16*Qw=Q+(rowbase+q0+wid*QBLK)*QP+h*D;
  const int hk=h/(NHEAD/NKVH); const bf16*Kh=K+(long)(b*NKVH+hk)*SEQ*D,*Vh=V+(long)(b*NKVH+hk)*SEQ*D;
  const unsigned lds0=(unsigned)(uintptr_t)shm;
  float*wsf=(float*)(shm+LDS_WS)+wid*64;
  const bf16*ksrc=Kh+(wid*64+lane)*8;
  const bf16*vsrc=Vh+(wid*64+lane)*8;
  const unsigned kdst=lds0+LDS_K+wid*1024, vdst=lds0+LDS_V+wid*1024;
  #define DMA_K(t,slot) glds16(ksrc+(long)(t)*KVBLK*D,(unsigned)__builtin_amdgcn_readfirstlane(kdst+(slot)))
  #define DMA_V(t,slot) glds16(vsrc+(long)(t)*KVBLK*D,(unsigned)__builtin_amdgcn_readfirstlane(vdst+(slot)))
  const int vb0=(int)(lds0+LDS_V)+((lane>>4)&1)*32+(lane&3)*8+(4*hi+((lane&15)>>2))*64;
  const char*Kbase=shm+LDS_K; bf16x8 kf[8];
  const lds_cptr shm3=(lds_cptr)shm; const lds_cptr kp0=shm3+LDS_K+hi*1024+r32*16; const lds_cptr vp0=shm3+LDS_V+((lane>>4)&1)*32+(lane&3)*8+(4*hi+((lane&15)>>2))*64;
  constexpr int NT=SEQ/KVBLK;
  DMA_K(0,0);DMA_V(0,0);DMA_K(1,SLOTB);
  bf16x8 qr[4];
  #pragma unroll
  for(int d0=0;d0<4;++d0)qr[d0]=*reinterpret_cast<const bf16x8*>(&Qw[(long)r32*QP+d0*16+hi*8]);
  float l_reg=0.f;f32x16 o[2];o[0]=f32x16{};o[1]=f32x16{};f32x16 negm;
  _Pragma("unroll") for(int r=0;r<16;++r)negm[r]=nshift; asm volatile("":"+v"(negm));
  const int qrel=wid*QBLK+r32;
  #define CMASK(P0,P1,t) do{}while(0)
  #define START(P0,P1) do{ _Pragma("unroll") for(int r=0;r<16;++r)P0[r]=__builtin_amdgcn_exp2f(P0[r]); }while(0)
  f32x16 pA0,pA1,pB0,pB1;
  int sl_prev=0,sl_cur=0,sl_next=SLOTB;
  #define ROT() do{sl_prev=sl_cur;sl_cur=sl_next;sl_next=(sl_next==(NSLOT-1)*SLOTB)?0:sl_next+SLOTB;}while(0)
  DMA_K(2,2*SLOTB);
  WAIT_BAR(3);
  qkt(pA0,pA1,Kbase,qr,negm,r32,hi);asm volatile("s_nop 15\n\ts_nop 7":"+v"(pA0),"+v"(pA1));CMASK(pA0,pA1,0);
  START(pA0,pA1);
  _Pragma("unroll") for(int r=0;r<16;++r)pA1[r]=__builtin_amdgcn_exp2f(pA1[r]);
  WAIT_BAR(0);
  DMA_K(3,0);DMA_V(1,SLOTB);
  ROT();
  kload8(kf,kp0+sl_cur);
  WAIT_BAR(2);
  s16x4 vlo[8],vhi[8]; u32x4 pw0,pw1,pw2,pw3;
  #define PKW(P,B) cvtpk_s(P[B],P[B+1])
  #define PAF(k) __builtin_bit_cast(bf16x8,pw##k)
  #define VFR(i) (bf16x8){vlo[i][0],vlo[i][1],vlo[i][2],vlo[i][3],vhi[i][0],vhi[i][1],vhi[i][2],vhi[i][3]}
  #define PIN(x) asm volatile("":"+v"(x))
  #define GAPA(MF,A0,A1,A2,A3,W0,W1,PW) do{ MF; sacc+=A0; sacc+=A1; sacc+=A2; sacc+=A3; PIN(sacc); W0; W1; PIN(PW); SBAR(); }while(0)
  #define EX(v) __builtin_amdgcn_exp2f(v)
  #define GAPB(MF,X,B) do{ MF; X[B]=EX(X[B]); X[B+1]=EX(X[B+1]); X[B+2]=EX(X[B+2]); X[B+3]=EX(X[B+3]); PIN(X); SBAR(); }while(0)
  #define VRD(i) do{ vlo[i]=vtr(vp_+(((i)>>2)*4096+((i)&3)*1024)); vhi[i]=vtr(vp_+(((i)>>2)*4096+((i)&3)*1024+512)); }while(0)
  #define KRD(G,j) do{ if(G){ kload2(kf,kp0+sl_next,j); SBAR(); } }while(0)
  #define STEP(C0,C1,P0,P1,t,GK,GV,GL) do{ SBAR(); \
    const lds_cptr vp_=vp0+sl_prev; \
    VRD(0); SBAR(); float sacc=(P0[0]+P0[1]); \
    GAPA(C0=__builtin_amdgcn_mfma_f32_32x32x16_bf16(kf[0],qr[0],negm,0,0,0), P0[2],P0[3],P0[4],P0[5],     pw0[0]=PKW(P0,0), pw0[1]=PKW(P0,2), pw0); \
    VRD(4); SBAR(); GAPA(C1=__builtin_amdgcn_mfma_f32_32x32x16_bf16(kf[1],qr[0],negm,0,0,0), P0[6],P0[7],P0[8],P0[9],     pw0[2]=PKW(P0,4), pw0[3]=PKW(P0,6), pw0); \
    VRD(1); SBAR(); GAPA(C0=__builtin_amdgcn_mfma_f32_32x32x16_bf16(kf[2],qr[1],C0,0,0,0),   P0[10],P0[11],P0[12],P0[13], pw1[0]=PKW(P0,8), pw1[1]=PKW(P0,10), pw1); \
    VRD(5); SBAR(); GAPA(C1=__builtin_amdgcn_mfma_f32_32x32x16_bf16(kf[3],qr[1],C1,0,0,0),   P0[14],P0[15],P1[0],P1[1],   pw1[2]=PKW(P0,12),pw1[3]=PKW(P0,14), pw1); \
    VRD(2); SBAR(); GAPA(C0=__builtin_amdgcn_mfma_f32_32x32x16_bf16(kf[4],qr[2],C0,0,0,0),   P1[2],P1[3],P1[4],P1[5],     pw2[0]=PKW(P1,0), pw2[1]=PKW(P1,2), pw2); \
    VRD(6); SBAR(); GAPA(C1=__builtin_amdgcn_mfma_f32_32x32x16_bf16(kf[5],qr[2],C1,0,0,0),   P1[6],P1[7],P1[8],P1[9],     pw2[2]=PKW(P1,4), pw2[3]=PKW(P1,6), pw2); \
    VRD(3); SBAR(); GAPA(C0=__builtin_amdgcn_mfma_f32_32x32x16_bf16(kf[6],qr[3],C0,0,0,0),   P1[10],P1[11],P1[12],P1[13], pw3[0]=PKW(P1,8), pw3[1]=PKW(P1,10), pw3); \
    VRD(7); SBAR(); GAPA(C1=__builtin_amdgcn_mfma_f32_32x32x16_bf16(kf[7],qr[3],C1,0,0,0),   P1[14],P1[15],0.f,0.f,       pw3[2]=PKW(P1,12),pw3[3]=PKW(P1,14), pw3); \
    l_reg+=sacc; \
    if(GK){DMA_K((t)+3,sl_cur);} if(GV){DMA_V((t)+1,sl_next);} \
    CMASK(C0,C1,t); \
    SBAR(); \
    GAPB(o[0]=__builtin_amdgcn_mfma_f32_32x32x16_bf16(PAF(0),VFR(0),o[0],0,0,0), C0,0); \
    GAPB(o[1]=__builtin_amdgcn_mfma_f32_32x32x16_bf16(PAF(0),VFR(4),o[1],0,0,0), C0,4); \
    KRD(GL,0); GAPB(o[0]=__builtin_amdgcn_mfma_f32_32x32x16_bf16(PAF(1),VFR(1),o[0],0,0,0), C0,8); \
    KRD(GL,1); GAPB(o[1]=__builtin_amdgcn_mfma_f32_32x32x16_bf16(PAF(1),VFR(5),o[1],0,0,0), C0,12); \
    KRD(GL,2); GAPB(o[0]=__builtin_amdgcn_mfma_f32_32x32x16_bf16(PAF(2),VFR(2),o[0],0,0,0), C1,0); \
    KRD(GL,3); GAPB(o[1]=__builtin_amdgcn_mfma_f32_32x32x16_bf16(PAF(2),VFR(6),o[1],0,0,0), C1,4); \
    GAPB(o[0]=__builtin_amdgcn_mfma_f32_32x32x16_bf16(PAF(3),VFR(3),o[0],0,0,0), C1,8); \
    GAPB(o[1]=__builtin_amdgcn_mfma_f32_32x32x16_bf16(PAF(3),VFR(7),o[1],0,0,0), C1,12); \
    }while(0)
  int t=1;
  #undef CMASK
  #define CMASK(P0,P1,t) do{}while(0)
  for(;t+5<NT;t+=2){
    STEP(pB0,pB1,pA0,pA1,t,true,true,true);     WAIT_BAR(2); ROT();
    STEP(pA0,pA1,pB0,pB1,t+1,true,true,true);   WAIT_BAR(2); ROT();
  }
  #undef CMASK
  #define CMASK(P0,P1,t) do{}while(0)
  #define ENDW(tt) do{ if((tt)+3<NT){WAIT_BAR(2);} else if((tt)+2<NT){WAIT_BAR(1);} else {WAIT_BAR(0);} }while(0)
  for(;t+1<NT;t+=2){
    STEP(pB0,pB1,pA0,pA1,t,(t+3<NT),(t+1<NT),(t+1<NT));       ENDW(t);   ROT();
    STEP(pA0,pA1,pB0,pB1,t+1,(t+4<NT),(t+2<NT),(t+2<NT));     ENDW(t+1); ROT();
  }
  STEP(pB0,pB1,pA0,pA1,NT-1,false,false,false);
  { float sacc=pB0[0]+pB0[1]; _Pragma("unroll") for(int r=2;r<16;++r)sacc+=pB0[r]; _Pragma("unroll") for(int r=0;r<16;++r)sacc+=pB1[r]; l_reg+=sacc;
    pw0=(u32x4){PKW(pB0,0),PKW(pB0,2),PKW(pB0,4),PKW(pB0,6)};pw1=(u32x4){PKW(pB0,8),PKW(pB0,10),PKW(pB0,12),PKW(pB0,14)};pw2=(u32x4){PKW(pB1,0),PKW(pB1,2),PKW(pB1,4),PKW(pB1,6)};pw3=(u32x4){PKW(pB1,8),PKW(pB1,10),PKW(pB1,12),PKW(pB1,14)};
    SBAR(); pv(o,vb0+sl_cur,PAF(0),PAF(1),PAF(2),PAF(3)); }
  #undef PKW
  #undef PAF
  #undef VFR
  #undef PIN
  #undef GAPA
  #undef GAPB
  #undef EX
  #undef VRD
  #undef KRD
  #undef STEP
  #undef ENDW
  {auto rr=__builtin_amdgcn_permlane32_swap(__float_as_uint(l_reg),__float_as_uint(l_reg),false,false);l_reg=__uint_as_float(rr[0])+__uint_as_float(rr[1]);}
  if(hi==0)wsf[32+r32]=l_reg;asm volatile("s_waitcnt lgkmcnt(0)":::"memory");
  float rli[16];
  #pragma unroll
  for(int r=0;r<16;++r)rli[r]=__builtin_amdgcn_rcpf(wsf[32+crow(r,hi)]);
  bf16*Ow=O+(rowbase+q0+wid*QBLK)*OP+h*D;
  { bf16*stg=(bf16*)(shm+LDS_OST)+wid*2048;
    #pragma unroll
    for(int r=0;r<16;++r){const int orow=crow(r,hi);
      #pragma unroll
      for(int d0=0;d0<2;++d0)stg[orow*64+d0*32+r32]=__float2bfloat16(o[d0][r]*rli[r]);}
    asm volatile("s_waitcnt lgkmcnt(0)":::"memory");
    #pragma unroll
    for(int i=0;i<4;++i){const int row=i*8+(lane>>3),ch=lane&7; const u32x4 v=*(const u32x4*)(stg+row*64+ch*8); ATTN_STORE16(Ow+(long)row*OP+ch*8,v);} }
  asm volatile("s_waitcnt lgkmcnt(0)\n\ts_barrier":::"memory");
  #undef DMA_K
  #undef DMA_V
  #undef CMASK
  #undef START
  #undef ROT
}
constexpr int ATTN_LDS_BYTES=LDS_BYTES;
struct AttnTensors { const bf16* Q; const bf16* K; const bf16* V; bf16* O; };
struct AttnUnit { int bh; int qb; };
struct StaticOrder {
  int vcu, G;
  __device__ __forceinline__ explicit StaticOrder(int grid,int block):vcu((grid%8==0)?(block%8)*(grid/8)+block/8:block),G(grid){}
  __device__ __forceinline__ bool next(int i,AttnUnit&u)const{
    const int L=i*G+vcu; if(L>=BATCH*NHEAD*NQB)return false;
    if(G==256){ if(i>=2)return false; const int x=vcu>>5,j=vcu&31; const int b=x>>2,kvh=(x>>1)&1,hq=kvh*4+2*(x&1)+i; u.bh=b*NHEAD+hq; u.qb=j; return true; }
    u.bh=L/NQB; u.qb=L%NQB; return true; }
  __device__ __forceinline__ void a_ready(const AttnUnit&)const{}
  __device__ __forceinline__ void done(const AttnUnit&)const{}
};
template<class Sched,int THRL=8> __device__ __forceinline__ void attn_phase(char*lds,const AttnTensors&T,const Sched&S,const float nshift){
  AttnUnit u;
  for(int i=0;S.next(i,u);++i){ S.a_ready(u); attn_unit<THRL>(u.bh/NHEAD,u.bh%NHEAD,u.qb,T.Q,T.K,T.V,T.O,lds,nshift); S.done(u); }
}
#undef SBAR
#undef WAIT_BAR
}

#include <hip/hip_cooperative_groups.h>
namespace cg = cooperative_groups;
#ifndef MK_PER_PHASE
#define MK_PER_PHASE 0
#endif
constexpr int NWAVES = 8, NTHREADS = 512;
constexpr int NB = 2, SEQ = 8192, DMODEL = 1024, TT = NB * SEQ;
constexpr int NPROJ = 2816;
constexpr int NEXP = 32, FFE = 512;
constexpr float EPS = 1e-6f;
constexpr int N_PHASES = 12;

constexpr size_t MiB = 1u << 20;
constexpr size_t WS_CTL = 0, CTL_ZERO_BYTES = 64 * 1024;
constexpr size_t WS_WOUT = 1 * MiB;
constexpr size_t WS_LIST = 229 * MiB;
constexpr size_t WS_WR = 3 * MiB;
constexpr size_t WS_TOK = 3 * MiB + 256 * 1024;
constexpr size_t WS_GATES = 4 * MiB;
constexpr size_t WS_WIN = 5 * MiB;
constexpr size_t WS_WSI = 3 * MiB + 896 * 1024;
constexpr size_t WS_XSC = 3 * MiB + 912 * 1024;
constexpr size_t WS_A = 11 * MiB;
constexpr size_t WS_XN = WS_A;
constexpr size_t GDN_SH_BYTES = 71680, GDN_D_BYTES = 19456;
constexpr size_t WS_GSH = WS_A;
constexpr size_t WS_GD = WS_A + 1024 * GDN_SH_BYTES;
constexpr size_t WS_X1 = 5 * MiB;
constexpr size_t WS_HID = 69 * MiB;
constexpr size_t WS_XBUF = 109 * MiB;
constexpr size_t WS_B = 157 * MiB;
constexpr size_t WS_QKVA = WS_B;
constexpr size_t WS_QKVB = WS_B + 48 * MiB;
constexpr size_t WS_ZA = WS_B + 72 * MiB;
constexpr size_t WS_OCAT = WS_B;
constexpr size_t WS_WGU0 = 189 * MiB, WS_WGU1 = 245 * MiB; constexpr int WGU_SPLIT = 20;
constexpr size_t WS_WSC = 3 * MiB + 768 * 1024;
constexpr float ACT_CLIP = 6.0f;
constexpr size_t DO_WD0 = 0, DO_WD1 = 56 * MiB; constexpr int WD_SPLIT = 24;
constexpr size_t DO_HN = 24 * MiB;
constexpr size_t WS_END = 269 * MiB;
static_assert(WS_GD + 4096 * GDN_D_BYTES <= WS_B, "GDN records fit region A");
static_assert(WS_X1 + 64 * MiB <= WS_HID && WS_HID + 40928ull * 1024 <= WS_XBUF && WS_XBUF + 40928ull * 2048 <= WS_WGU0, "post-scan map");
static_assert(WS_WGU0 + WGU_SPLIT * MiB <= WS_B + 72 * MiB && WS_WGU1 + (32 - WGU_SPLIT) * MiB <= 269 * MiB, "WGU fragments");
constexpr size_t DO_QR = 0, DO_KR = 16 * MiB, DO_VR = 20 * MiB, DO_OF = 24 * MiB, DO_OB = 40 * MiB;
constexpr int CW_CNT = 2048;
constexpr int CW_NTILE = 128;
constexpr int CW_ETAB = 192;
constexpr int CW_HIDC = 8192;
constexpr int CW_XCC = 11264, CW_XBAD = 11600;
constexpr int CW_SCANQ = 1024;

constexpr int LDS_BYTES = 160 * 1024;

#define GAS __attribute__((address_space(1)))
#define LAS __attribute__((address_space(3)))
typedef unsigned short bf16;
typedef unsigned v4u __attribute__((ext_vector_type(4)));
typedef unsigned v2u __attribute__((ext_vector_type(2)));
typedef float f32x4 __attribute__((ext_vector_type(4)));
typedef short bf16x8 __attribute__((ext_vector_type(8)));
typedef short s16x4 __attribute__((ext_vector_type(4)));
#define DI __device__ __forceinline__

DI unsigned f2bf(float f) { unsigned u = __builtin_bit_cast(unsigned, f); return (u + 0x7fffu + ((u >> 16) & 1u)) >> 16; }
typedef float f32x2_t __attribute__((ext_vector_type(2))); typedef __bf16 bf16x2_t __attribute__((ext_vector_type(2)));
DI unsigned pk2(float lo, float hi) { f32x2_t v = {lo, hi}; bf16x2_t b = __builtin_convertvector(v, bf16x2_t); return __builtin_bit_cast(unsigned, b); }
DI float bf2f(unsigned short h) { return __builtin_bit_cast(float, (unsigned)h << 16); }
DI float bflo(unsigned w) { return __builtin_bit_cast(float, w << 16); }
DI float bfhi(unsigned w) { return __builtin_bit_cast(float, w & 0xffff0000u); }
DI unsigned q8x4(float a, float b, float c, float d, float sc) {
    const float M = 12582912.f;
    const unsigned ua = __builtin_bit_cast(unsigned, fminf(fmaxf(a * sc, -127.f), 127.f) + M), ub = __builtin_bit_cast(unsigned, fminf(fmaxf(b * sc, -127.f), 127.f) + M);
    const unsigned uc = __builtin_bit_cast(unsigned, fminf(fmaxf(c * sc, -127.f), 127.f) + M), ud = __builtin_bit_cast(unsigned, fminf(fmaxf(d * sc, -127.f), 127.f) + M);
    return (ua & 255u) | ((ub & 255u) << 8) | ((uc & 255u) << 16) | (ud << 24);
}
template <int CTRL> DI float dpp_f(float v) { return __builtin_bit_cast(float, __builtin_amdgcn_update_dpp(0, __builtin_bit_cast(int, v), CTRL, 0xf, 0xf, true)); }
#ifdef NO_DPP
DI float sum16(float v) { v += __shfl_xor(v, 1); v += __shfl_xor(v, 2); v += __shfl_xor(v, 4); v += __shfl_xor(v, 8); return v; }
DI float max16(float v) { v = fmaxf(v, __shfl_xor(v, 1)); v = fmaxf(v, __shfl_xor(v, 2)); v = fmaxf(v, __shfl_xor(v, 4)); v = fmaxf(v, __shfl_xor(v, 8)); return v; }
DI float get_x8(float v) { return __shfl_xor(v, 8); }
#else
DI float sum16(float v) { v += dpp_f<0xB1>(v); v += dpp_f<0x4E>(v); v += dpp_f<0x141>(v); v += dpp_f<0x140>(v); return v; }
DI float max16(float v) { v = fmaxf(v, dpp_f<0xB1>(v)); v = fmaxf(v, dpp_f<0x4E>(v)); v = fmaxf(v, dpp_f<0x141>(v)); v = fmaxf(v, dpp_f<0x140>(v)); return v; }
DI float get_x8(float v) { return dpp_f<0x128>(v); }
#endif
DI float sum_x16(float v) { return v + __shfl_xor(v, 16); }
DI float max_x16(float v) { return fmaxf(v, __shfl_xor(v, 16)); }
DI float sum_x32(float v) { return v + __shfl_xor(v, 32); }
DI float max_x32(float v) { return fmaxf(v, __shfl_xor(v, 32)); }
DI float wave_max(float v) { return max_x32(max_x16(max16(v))); }
DI float act_absmax(const float* nfw, int lane) {
    float m = 0.f;
#pragma unroll
    for (int i = 0; i < 16; ++i) m = fmaxf(m, fabsf(nfw[lane + 64 * i]));
    return ACT_CLIP * wave_max(m);
}
DI float wave_sum(float v) { return sum_x32(sum_x16(sum16(v))); }
DI float siluf(float x) { return x * __builtin_amdgcn_rcpf(1.0f + __expf(-x)); }
DI float sigmoidf_(float x) { return 1.0f / (1.0f + __expf(-x)); }
DI int perm32i(int idx) { return ((idx >> 2) & 3) * 8 + (idx >> 4) * 4 + (idx & 3); }
DI int permcol(int c) { return (c & ~31) + perm32i(c & 31); }
template <class T> DI T opaque(T p) { asm volatile("" : "+v"(p)); return p; }

typedef GAS unsigned gu32;
#define RLX_AGENT __ATOMIC_RELAXED, __HIP_MEMORY_SCOPE_AGENT
constexpr int CW_BAR = 4096;
constexpr int MISC_OFF = LDS_BYTES - 64;
#define XB_TMO      128
#define XB_XCNT(j)  (256  + 64 * (j))
#define XB_XSUB(j)  (1280 + 64 * (j))
#define XB_XGEN(j)  (2304 + 64 * (j))
#define XB_TOP      3328
#define XB_TOPGEN   3392
#define XCD_BAR_WORDS 3456
#define XB_SPIN_CAP (1u << 18)

__device__ __forceinline__ unsigned xb_ld(unsigned* p)              { return __hip_atomic_load(p, __ATOMIC_RELAXED, __HIP_MEMORY_SCOPE_AGENT); }
__device__ __forceinline__ unsigned xb_add(unsigned* p, unsigned v) { return __hip_atomic_fetch_add(p, v, __ATOMIC_RELAXED, __HIP_MEMORY_SCOPE_AGENT); }
__device__ __forceinline__ unsigned xb_xcc_id() { return (unsigned)__builtin_amdgcn_s_getreg((3 << 11) | 20) & 0xFu; }
#define XB_SPIN(cond, bar) do { unsigned _sp = 0; while (cond) { __builtin_amdgcn_s_sleep(1); \
    if ((++_sp & 255u) == 0u) { if (xb_ld(&(bar)[XB_TMO])) break; if (_sp > XB_SPIN_CAP) { atomicAdd(&(bar)[XB_TMO], 1u); break; } } } } while (0)

struct XcdBarrier {
    unsigned* bar; unsigned x;
    volatile LAS unsigned* st;
};

__device__ __forceinline__ XcdBarrier xcd_barrier_post(unsigned* bar, volatile LAS unsigned* st) {
    XcdBarrier b; b.bar = bar; b.x = xb_xcc_id(); b.st = st;
    if (threadIdx.x == 0) (void)xb_add(&bar[XB_XCNT(b.x)], 1u);
    return b;
}
__device__ __forceinline__ void xcd_barrier_complete(unsigned* bar, unsigned x, unsigned& nloc, unsigned& nx) {
    const unsigned G = gridDim.x * gridDim.y * gridDim.z;
    unsigned sum, cnt, mine, sp = 0u;
    for (;;) {
        sum = 0u; cnt = 0u; mine = 0u;
#pragma unroll
        for (unsigned j = 0; j < 16; ++j) { const unsigned c = xb_ld(&bar[XB_XCNT(j)]); sum += c; cnt += (c > 0u) ? 1u : 0u; mine = (j == x) ? c : mine; }
        if (sum == G) break;
        __builtin_amdgcn_s_sleep(1);
        if ((++sp & 255u) == 0u) { if (xb_ld(&bar[XB_TMO])) break; if (sp > XB_SPIN_CAP) { atomicAdd(&bar[XB_TMO], 1u); break; } }
    }
    nloc = mine > 0u ? mine : 1u; nx = cnt > 0u ? cnt : 1u;
}

__device__ __forceinline__ void xcd_barrier(const XcdBarrier& b) {
    asm volatile("s_waitcnt vmcnt(0)" ::: "memory");
    __syncthreads();
    if (threadIdx.x == 0) {
        unsigned* bar = b.bar;
        __builtin_amdgcn_s_waitcnt(0);
        unsigned nloc = b.st[0], nx = b.st[1];
        if (nloc == 0u) { xcd_barrier_complete(bar, b.x, nloc, nx); b.st[0] = nloc; b.st[1] = nx; }
        const unsigned old = xb_add(&bar[XB_XSUB(b.x)], 1u);
        const unsigned gen = old / nloc;
        if (old + 1u == (gen + 1u) * nloc) {
            __builtin_amdgcn_fence(__ATOMIC_RELEASE, "agent");
            asm volatile("s_waitcnt vmcnt(0)" ::: "memory");
            const unsigned og = xb_add(&bar[XB_TOP], 1u);
            const unsigned tg = og / nx;
            if (og + 1u == (tg + 1u) * nx) xb_add(&bar[XB_TOPGEN], 1u);
            else XB_SPIN(xb_ld(&bar[XB_TOPGEN]) == tg, bar);
            __builtin_amdgcn_fence(__ATOMIC_ACQUIRE, "agent");
            xb_add(&bar[XB_XGEN(b.x)], 1u);
            asm volatile("s_waitcnt vmcnt(0)" ::: "memory");
        } else {
            XB_SPIN(xb_ld(&bar[XB_XGEN(b.x)]) == gen, bar);
            __builtin_amdgcn_fence(__ATOMIC_ACQUIRE, "agent");
            asm volatile("s_waitcnt vmcnt(0)" ::: "memory");
        }
    }
    __syncthreads();
}

struct Frame {
    LAS unsigned char* lds;
    int tid, lane, wave, vcu, G;
    const float* in[17];
    float* out; unsigned char* ws;
};

DI void p0_transpose_item(const float* W, int ldw, int nblk, bf16* WT, int K, int row_off, int rmul, LAS float* scr, int item, int lane) {
    const int kb = item / nblk, nb = item % nblk, k0 = 64 * kb, n0 = 32 * nb;
    const int r8 = lane >> 3, c4 = (lane & 7) * 4;
    f32x4 v[8];
#pragma unroll
    for (int i = 0; i < 8; ++i) v[i] = __builtin_nontemporal_load((const f32x4*)(W + (size_t)(k0 + 8 * i + r8) * ldw + n0 + c4));
#pragma unroll
    for (int i = 0; i < 8; ++i) { LAS float* d = scr + (8 * i + r8) * 33 + c4; d[0] = v[i].x; d[1] = v[i].y; d[2] = v[i].z; d[3] = v[i].w; }
    asm volatile("s_waitcnt lgkmcnt(0)" ::: "memory");
    const int c = lane & 7;
#pragma unroll
    for (int j = 0; j < 4; ++j) { const int n = (lane >> 3) + 8 * j; const LAS float* s = scr + (8 * c) * 33 + n;
        v4u o; o.x = pk2(s[0 * 33], s[1 * 33]); o.y = pk2(s[2 * 33], s[3 * 33]); o.z = pk2(s[4 * 33], s[5 * 33]); o.w = pk2(s[6 * 33], s[7 * 33]);
        *(GAS v4u*)(WT + (size_t)(row_off + (n0 + n) * rmul) * K + k0 + 8 * c) = o; }
    asm volatile("s_waitcnt lgkmcnt(0)" ::: "memory");
}
template <int NR> DI void rms_rows_to_bf16(const float* const (&xrow)[NR], const float* w, bf16* const (&orow)[NR], int lane) {
    const GAS f32x4* wr = (const GAS f32x4*)w + lane;
    f32x4 v[NR][4];
#pragma unroll
    for (int r = 0; r < NR; ++r) { const GAS f32x4* xr = (const GAS f32x4*)xrow[r] + lane;
#pragma unroll
        for (int j = 0; j < 4; ++j) v[r][j] = xr[64 * j]; }
    f32x4 ww[4];
#pragma unroll
    for (int j = 0; j < 4; ++j) ww[j] = wr[64 * j];
#pragma unroll
    for (int r = 0; r < NR; ++r) {
        float s_ = 0.f;
#pragma unroll
        for (int j = 0; j < 4; ++j) s_ += (v[r][j].x * v[r][j].x + v[r][j].y * v[r][j].y) + (v[r][j].z * v[r][j].z + v[r][j].w * v[r][j].w);
        const float rs = __builtin_amdgcn_rsqf(wave_sum(s_) * (1.f / DMODEL) + EPS);
        GAS v2u* o8 = (GAS v2u*)orow[r] + lane;
#pragma unroll
        for (int j = 0; j < 4; ++j) { v2u o; o.x = pk2(v[r][j].x * rs * ww[j].x, v[r][j].y * rs * ww[j].y); o.y = pk2(v[r][j].z * rs * ww[j].z, v[r][j].w * rs * ww[j].w); o8[64 * j] = o; }
    }
}
DI void q_strip(const float* W, int ldw, int n0, unsigned char* WQ, float* wsc, int rowbase, int rmul, LAS unsigned char* lds, int wave, int lane) {
    LAS float* scr = (LAS float*)(lds + wave * 8704); LAS float* cmx = (LAS float*)(lds + 8 * 8704);
    const int r8 = lane >> 3, c4 = (lane & 7) * 4, kw = 128 * wave;
    f32x4 mx = (f32x4){0.f, 0.f, 0.f, 0.f};
#pragma unroll
    for (int i = 0; i < 16; ++i) { const f32x4 v = *(const f32x4*)(W + (size_t)(kw + 8 * i + r8) * ldw + n0 + c4);
        mx.x = fmaxf(mx.x, fabsf(v.x)); mx.y = fmaxf(mx.y, fabsf(v.y)); mx.z = fmaxf(mx.z, fabsf(v.z)); mx.w = fmaxf(mx.w, fabsf(v.w)); }
    mx.x = max_x32(max_x16(fmaxf(mx.x, get_x8(mx.x)))); mx.y = max_x32(max_x16(fmaxf(mx.y, get_x8(mx.y))));
    mx.z = max_x32(max_x16(fmaxf(mx.z, get_x8(mx.z)))); mx.w = max_x32(max_x16(fmaxf(mx.w, get_x8(mx.w))));
    if (lane < 8) *(LAS f32x4*)(cmx + wave * 32 + c4) = mx;
    __syncthreads();
    float sq[4];
#pragma unroll
    for (int j = 0; j < 4; ++j) { const int n = (lane >> 3) + 8 * j; float m = cmx[n];
#pragma unroll
        for (int w = 1; w < 8; ++w) m = fmaxf(m, cmx[w * 32 + n]);
        sq[j] = m > 0.f ? 127.0f / m : 0.f;
        if (wave == 0 && (lane & 7) == 0) wsc[rowbase + n * rmul] = m * (1.0f / 127.0f); }
    const int c = lane & 7;
#pragma unroll
    for (int kb = 0; kb < 2; ++kb) {
        const int k0 = kw + 64 * kb;
        f32x4 v[8];
#pragma unroll
        for (int i = 0; i < 8; ++i) v[i] = *(const f32x4*)(W + (size_t)(k0 + 8 * i + r8) * ldw + n0 + c4);
#pragma unroll
        for (int i = 0; i < 8; ++i) { LAS float* d = scr + (8 * i + r8) * 33 + c4; d[0] = v[i].x; d[1] = v[i].y; d[2] = v[i].z; d[3] = v[i].w; }
        asm volatile("s_waitcnt lgkmcnt(0)" ::: "memory");
#pragma unroll
        for (int j = 0; j < 4; ++j) { const int n = (lane >> 3) + 8 * j; const LAS float* t = scr + (8 * c) * 33 + n;
            v2u o; o.x = q8x4(t[0 * 33], t[1 * 33], t[2 * 33], t[3 * 33], sq[j]); o.y = q8x4(t[4 * 33], t[5 * 33], t[6 * 33], t[7 * 33], sq[j]);
            *(GAS v2u*)(WQ + (size_t)(rowbase + n * rmul) * 1024 + k0 + 8 * c) = o; }
        asm volatile("s_waitcnt lgkmcnt(0)" ::: "memory");
    }
    __syncthreads();
}
DI float reduce16(const float (&ga)[16], int lane) {
    float gb[8], gc[4];
    const bool h32 = (lane & 32) != 0, h16 = (lane & 16) != 0;
#pragma unroll
    for (int i = 0; i < 8; ++i) { const float lo = sum_x32(ga[i]), hi = sum_x32(ga[i + 8]); gb[i] = h32 ? hi : lo; }
#pragma unroll
    for (int i = 0; i < 4; ++i) { const float lo = sum_x16(gb[i]), hi = sum_x16(gb[i + 4]); gc[i] = h16 ? hi : lo; }
    float res = 0.f;
#pragma unroll
    for (int i = 0; i < 4; ++i) { const float t = sum16(gc[i]); res = ((lane & 3) == i) ? t : res; }
    return res;
}
DI void rms_rows_to_q8(const float* const (&xrow)[2], const float* w, unsigned char* const (&orow)[2], float* const (&xsc)[2], float* const (&gout)[2], const LAS float* gw_, int lane) {
    const LAS float* gw = gw_;
    gw = opaque(gw);
    const GAS f32x4* wr = (const GAS f32x4*)w + lane;
    f32x4 v[2][4];
#pragma unroll
    for (int r = 0; r < 2; ++r) { const GAS f32x4* xr = (const GAS f32x4*)xrow[r] + lane;
#pragma unroll
        for (int j = 0; j < 4; ++j) v[r][j] = xr[64 * j]; }
    f32x4 ww[4];
#pragma unroll
    for (int j = 0; j < 4; ++j) ww[j] = wr[64 * j];
#pragma unroll
    for (int r = 0; r < 2; ++r) {
        float s_ = 0.f;
#pragma unroll
        for (int j = 0; j < 4; ++j) s_ += (v[r][j].x * v[r][j].x + v[r][j].y * v[r][j].y) + (v[r][j].z * v[r][j].z + v[r][j].w * v[r][j].w);
        const float rs = __builtin_amdgcn_rsqf(wave_sum(s_) * (1.f / DMODEL) + EPS);
        float am = 0.f;
#pragma unroll
        for (int j = 0; j < 4; ++j) { v[r][j] = v[r][j] * ww[j] * rs; am = fmaxf(fmaxf(am, fmaxf(fabsf(v[r][j].x), fabsf(v[r][j].y))), fmaxf(fabsf(v[r][j].z), fabsf(v[r][j].w))); }
        am = wave_max(am);
        const float qsc = am > 0.f ? 127.0f / am : 0.f;
        if (lane == 0) *xsc[r] = am * (1.0f / 127.0f);
        GAS unsigned* o4 = (GAS unsigned*)orow[r] + lane;
#pragma unroll
        for (int j = 0; j < 4; ++j) o4[64 * j] = q8x4(v[r][j].x, v[r][j].y, v[r][j].z, v[r][j].w, qsc);
    }
#ifndef NO_GATES
    float ga[2][16];
#pragma unroll
    for (int c = 0; c < 16; ++c) { ga[0][c] = 0.f; ga[1][c] = 0.f; }
    asm volatile("" : "+v"(v[0][0]), "+v"(v[0][1]), "+v"(v[0][2]), "+v"(v[0][3]), "+v"(v[1][0]), "+v"(v[1][1]), "+v"(v[1][2]), "+v"(v[1][3]));
#pragma unroll
    for (int j = 0; j < 4; ++j)
#pragma unroll
        for (int q = 0; q < 4; ++q) { const LAS f32x4* g4 = (const LAS f32x4*)gw + ((j * 4 + q) * 4) * 64 + lane;
            const f32x4 g0 = g4[0], g1 = g4[64], g2 = g4[128], g3 = g4[192];
#pragma unroll
            for (int r = 0; r < 2; ++r) { const float h = v[r][j][q];
                ga[r][0] += h * g0.x; ga[r][1] += h * g0.y; ga[r][2] += h * g0.z; ga[r][3] += h * g0.w; ga[r][4] += h * g1.x; ga[r][5] += h * g1.y; ga[r][6] += h * g1.z; ga[r][7] += h * g1.w;
                ga[r][8] += h * g2.x; ga[r][9] += h * g2.y; ga[r][10] += h * g2.z; ga[r][11] += h * g2.w; ga[r][12] += h * g3.x; ga[r][13] += h * g3.y; ga[r][14] += h * g3.z; ga[r][15] += h * g3.w; }
            asm volatile("" : "+v"(ga[1][0]), "+v"(ga[1][1]), "+v"(ga[1][2]), "+v"(ga[1][3]), "+v"(ga[1][4]), "+v"(ga[1][5]), "+v"(ga[1][6]), "+v"(ga[1][7]), "+v"(ga[1][8]), "+v"(ga[1][9]),
                         "+v"(ga[1][10]), "+v"(ga[1][11]), "+v"(ga[1][12]), "+v"(ga[1][13]), "+v"(ga[1][14]), "+v"(ga[1][15]) :: "memory"); }
    const int gc_ = 4 * (lane >> 4) + (lane & 3);
#pragma unroll
    for (int r = 0; r < 2; ++r) { const float res = reduce16(ga[r], lane); if ((lane & 12) == 0) gout[r][gc_] = res; }
#endif
}
DI void p0_prologue(Frame& F) {
    const float* w_in = F.in[2];
    unsigned char* WIN = F.ws + WS_WIN; float* WSI = (float*)(F.ws + WS_WSI);
    constexpr int NSTRIP = 64 + 24;
    if (F.vcu < NSTRIP) { const int st = F.vcu;
        if (st < 64) q_strip(w_in, 2832, 32 * st, WIN, WSI, 32 * st, 1, F.lds, F.wave, F.lane);
        else q_strip(w_in + 2064, 2832, 32 * (st - 64), WIN, WSI, 2048 + 32 * (st - 64), 1, F.lds, F.wave, F.lane); }
    unsigned char* XN = F.ws + WS_XN; float* XSC = (float*)(F.ws + WS_XSC); float* GATES = (float*)(F.ws + WS_GATES);
    LAS float* gw = (LAS float*)(F.lds + 73728);
    for (int i = F.tid; i < 1024 * 4; i += NTHREADS) { const int k = i >> 2, c4 = i & 3, jj = k >> 8, qq = k & 3, ln = (k & 255) >> 2;
        *((LAS f32x4*)gw + ((jj * 4 + qq) * 4 + c4) * 64 + ln) = *(const f32x4*)(w_in + (size_t)k * 2832 + 2048 + c4 * 4); }
    __syncthreads();
    const int nst = (F.G < NSTRIP ? F.G : NSTRIP), NSLOT = nst * NWAVES + (F.G - nst) * NWAVES * 2;
    const int s0_ = (F.vcu < nst) ? F.vcu * NWAVES + F.wave : nst * NWAVES + ((F.vcu - nst) * NWAVES + F.wave) * 2, nmine = (F.vcu < nst) ? 1 : 2;
#pragma unroll 1
    for (int q = 0; q < nmine; ++q)
#pragma unroll 1
        for (int p = s0_ + q; p < TT / 2; p += NSLOT) { const int m = 2 * p;
            const float* const xr[2] = {F.in[0] + (size_t)m * DMODEL, F.in[0] + (size_t)(m + 1) * DMODEL}; unsigned char* const orw[2] = {XN + (size_t)m * DMODEL, XN + (size_t)(m + 1) * DMODEL};
            float* const xs[2] = {XSC + m, XSC + m + 1}; float* const go[2] = {GATES + (size_t)m * 16, GATES + (size_t)(m + 1) * 16};
            rms_rows_to_q8(xr, F.in[1], orw, xs, go, gw, F.lane); }
}

struct EpiProj {
    static constexpr bool PERM = true, AFTER_DRAIN = false;
    bf16 *qkva, *za, *qkvb; const float* wsi; const float* xsc;
    DI void operator()(const pg8::i32x4 (&acc)[2][2][4][2], const pg8::Unit& u, int wr, int wc, int fr, int fq) const {
        const int row0 = u.pm * 256 + wr * 64 + fr;
        const float* ws_ = wsi + u.pn * 256 + wc * 32 + 8 * fq;
        bf16* base; int ldc, colt;
        if (u.pn < 6) { base = qkva; ldc = 1536; colt = u.pn * 256; } else if (u.pn < 8) { base = za; ldc = 512; colt = (u.pn - 6) * 256; } else { base = qkvb; ldc = 768; colt = (u.pn - 8) * 256; }
        const int col0 = colt + wc * 32 + 8 * fq;
        f32x4 s0[2], s1[2];
#pragma unroll
        for (int bj = 0; bj < 2; ++bj) { s0[bj] = *(const f32x4*)(ws_ + bj * 128); s1[bj] = *(const f32x4*)(ws_ + bj * 128 + 4); }
        float rsc[2][4];
#pragma unroll
        for (int ai = 0; ai < 2; ++ai)
#pragma unroll
            for (int m = 0; m < 4; ++m) rsc[ai][m] = xsc[row0 + ai * 128 + m * 16];
#pragma unroll
        for (int ai = 0; ai < 2; ++ai)
#pragma unroll
            for (int m = 0; m < 4; ++m) { bf16* rowp = base + (size_t)(row0 + ai * 128 + m * 16) * ldc + col0; const float rr = rsc[ai][m];
#pragma unroll
                for (int bj = 0; bj < 2; ++bj) { const pg8::i32x4 a0 = acc[ai][bj][m][0], a1 = acc[ai][bj][m][1]; const f32x4 t0 = s0[bj] * rr, t1 = s1[bj] * rr; pg8::u32x4 w;
                    w.x = pg8::cvt_pk_bf16((float)a0[0] * t0[0], (float)a0[1] * t0[1]); w.y = pg8::cvt_pk_bf16((float)a0[2] * t0[2], (float)a0[3] * t0[3]);
                    w.z = pg8::cvt_pk_bf16((float)a1[0] * t1[0], (float)a1[1] * t1[1]); w.w = pg8::cvt_pk_bf16((float)a1[2] * t1[2], (float)a1[3] * t1[3]);
                    *(pg8::u32x4*)(rowp + bj * 128) = w; } }
    }
};
struct IdRows { DI int row(const pg8::Unit& u, int r) const { return u.pm * 256 + r; } };
struct EpiResid {
    static constexpr bool PERM = true, AFTER_DRAIN = false;
    const float* x; bf16* x1;
    DI void operator()(const pg8::f32x4 (&acc)[2][2][4][2], const pg8::Unit& u, int wr, int wc, int fr, int fq) const {
        const int row0 = u.pm * 256 + wr * 64 + fr, col0 = u.pn * 256 + wc * 32 + 8 * fq;
#pragma unroll
        for (int ai = 0; ai < 2; ++ai)
#pragma unroll
            for (int m = 0; m < 4; ++m) { const size_t off = (size_t)(row0 + ai * 128 + m * 16) * DMODEL + col0;
#pragma unroll
                for (int bj = 0; bj < 2; ++bj) { const pg8::f32x4 v0 = *(const pg8::f32x4*)(x + off + bj * 128) + acc[ai][bj][m][0], v1 = *(const pg8::f32x4*)(x + off + bj * 128 + 4) + acc[ai][bj][m][1]; pg8::u32x4 w;
                    w.x = pg8::cvt_pk_bf16(v0[0], v0[1]); w.y = pg8::cvt_pk_bf16(v0[2], v0[3]); w.z = pg8::cvt_pk_bf16(v1[0], v1[1]); w.w = pg8::cvt_pk_bf16(v1[2], v1[3]);
                    *(pg8::u32x4*)(x1 + off + bj * 128) = w; } }
    }
};
struct EpiGU {
    static constexpr bool PERM = true, AFTER_DRAIN = false;
    bf16* hid; const float* wsc; float ainv;
    DI void operator()(const pg8::i32x4 (&acc)[2][2][4][2], const pg8::Unit& u, int wr, int wc, int fr, int fq) const {
        const int row0 = u.pm * 256 + wr * 64 + fr; const int jt = u.pn & 3;
        const int ff0 = jt * 128 + wc * 16 + 4 * fq;
        const float* ws_ = wsc + u.ex * 1024 + jt * 256 + wc * 32 + 8 * fq;
        f32x4 s0[2], s1[2];
#pragma unroll
        for (int bj = 0; bj < 2; ++bj) { s0[bj] = *(const f32x4*)(ws_ + bj * 128) * ainv; s1[bj] = *(const f32x4*)(ws_ + bj * 128 + 4) * ainv; }
#pragma unroll
        for (int ai = 0; ai < 2; ++ai)
#pragma unroll
            for (int m = 0; m < 4; ++m) { bf16* rowp = hid + (size_t)(row0 + ai * 128 + m * 16) * FFE + ff0;
#pragma unroll
                for (int bj = 0; bj < 2; ++bj) { const pg8::i32x4 a0 = acc[ai][bj][m][0], a1 = acc[ai][bj][m][1];
                    const float g0 = (float)a0[0] * s0[bj][0], u0 = (float)a0[1] * s0[bj][1], g1 = (float)a0[2] * s0[bj][2], u1 = (float)a0[3] * s0[bj][3];
                    const float g2 = (float)a1[0] * s1[bj][0], u2 = (float)a1[1] * s1[bj][1], g3 = (float)a1[2] * s1[bj][2], u3 = (float)a1[3] * s1[bj][3];
                    v2u w; w.x = pg8::cvt_pk_bf16(siluf(g0) * u0, siluf(g1) * u1); w.y = pg8::cvt_pk_bf16(siluf(g2) * u2, siluf(g3) * u3);
                    *(v2u*)(rowp + bj * 64) = w; } }
    }
};
struct EpiY {
    static constexpr bool PERM = true, AFTER_DRAIN = false;
    bf16* y;
    DI void operator()(const pg8::f32x4 (&acc)[2][2][4][2], const pg8::Unit& u, int wr, int wc, int fr, int fq) const {
        const int row0 = u.pm * 256 + wr * 64 + fr; const int col0 = (u.pn & 3) * 256 + wc * 32 + 8 * fq;
#pragma unroll
        for (int ai = 0; ai < 2; ++ai)
#pragma unroll
            for (int m = 0; m < 4; ++m) { bf16* rowp = y + (size_t)(row0 + ai * 128 + m * 16) * DMODEL + col0;
#pragma unroll
                for (int bj = 0; bj < 2; ++bj) { const pg8::f32x4 v0 = acc[ai][bj][m][0], v1 = acc[ai][bj][m][1]; pg8::u32x4 w;
                    w.x = pg8::cvt_pk_bf16(v0[0], v0[1]); w.y = pg8::cvt_pk_bf16(v0[2], v0[3]); w.z = pg8::cvt_pk_bf16(v1[0], v1[1]); w.w = pg8::cvt_pk_bf16(v1[2], v1[3]);
                    *(pg8::u32x4*)(rowp + bj * 128) = w; } }
    }
};
constexpr int ETAB_OFF = 131072;
typedef GAS unsigned mo_gu32;
struct MoeOrder {
    const LAS unsigned* etab; int G, c, esplit, pnoff;
    mo_gu32* cnt; int mode, rot; mutable int pend;
    DI bool next(int i, pg8::Unit& u) const {
        if (G % 8 != 0) {
            int L = i * G + c;
            for (int e = 0; e < NEXP; ++e) { const int n4 = 4 * (int)etab[2 * e + 1]; if (L < n4) { u.pm = (int)etab[2 * e] + (L >> 2); u.pn = (e < esplit ? 4 * e : pnoff + 4 * (e - esplit)) + (L & 3); u.ex = e; u.tq = L >> 2; return true; } L -= n4; }
            return false; }
        const int x = c & 7, per = G >> 3; int k = (c >> 3) - rot; k += (k < 0) ? per : 0; int L = i * per + k;
#pragma unroll
        for (int q = 0; q < NEXP / 8; ++q) { const int e = x + 8 * q; const int n4 = 4 * (int)etab[2 * e + 1];
            if (L < n4) { u.pm = (int)etab[2 * e] + (L >> 2); u.pn = (e < esplit ? 4 * e : pnoff + 4 * (e - esplit)) + (L & 3); u.ex = e; u.tq = L >> 2; return true; } L -= n4; }
        return false; }
    DI int xcd_units() const { int n = 0; for (int q = 0; q < NEXP / 8; ++q) n += 4 * (int)etab[2 * ((c & 7) + 8 * q) + 1]; return n; }
    DI void publish(int pm) const { if ((threadIdx.x & 63) == 0) __hip_atomic_fetch_add(cnt + pm * 16, 1u, __ATOMIC_RELAXED, __HIP_MEMORY_SCOPE_AGENT); }
    DI void a_ready(const pg8::Unit& u) const {
        if (mode != 2) return;
        mo_gu32* w = cnt + u.pm * 16;
        for (unsigned spins = 0; spins < (1u << 22); ++spins) {
            if ((unsigned)__builtin_amdgcn_readfirstlane(__hip_atomic_load(w, __ATOMIC_RELAXED, __HIP_MEMORY_SCOPE_AGENT)) >= 32u) break;
            __builtin_amdgcn_s_sleep(1); }
    }
    DI void done(const pg8::Unit& u) const { if (mode != 1) return; if (pend >= 0) publish(pend); pend = u.pm; }
    DI void flush() const { if (mode == 1 && pend >= 0) { publish(pend); pend = -1; } }
};
struct MoeRows {
    const int* list; const LAS unsigned* etab;
    DI int row(const pg8::Unit& u, int r) const {
        const int slot = u.tq * 256 + r, e = u.ex; if (slot >= (int)etab[64 + e]) return 0;
        const LAS unsigned* sp = etab + 96 + 8 * e; int sb = 0;
#pragma unroll
        for (int q = 1; q < 8; ++q) sb += (slot >= (int)sp[q]) ? 1 : 0;
        return list[(size_t)(e * 8 + sb) * TT + (slot - (int)sp[sb])]; }
};

DI void p2_rope(Frame& F) {
    const int gw = F.vcu * NWAVES + F.wave, NGW = F.G * NWAVES, lane = F.lane;
    const bf16* QKVB = (const bf16*)(F.ws + WS_QKVB);
    bf16* QR = (bf16*)((unsigned char*)F.out + DO_QR); bf16* KR = (bf16*)((unsigned char*)F.out + DO_KR); bf16* VR = (bf16*)((unsigned char*)F.out + DO_VR);
    const int pi = lane & 31, hsel = lane >> 5;
    const float qw0 = F.in[7][2 * pi], qw1 = F.in[7][2 * pi + 1], kw0 = F.in[8][2 * pi], kw1 = F.in[8][2 * pi + 1];
    const float invf = exp2f(-(float)(2 * (pi & 15)) * (13.287712379549449f / 32.0f));
    constexpr float C2 = 0.125f * 1.4426950408889634f;
    constexpr int NB4 = 4;
    for (int t0 = gw; t0 < TT; t0 += NB4 * NGW) {
        unsigned w[NB4][5], vw[NB4];
#pragma unroll
        for (int u = 0; u < NB4; ++u) { const int t = t0 + u * NGW; const unsigned* src = (const unsigned*)(QKVB + (size_t)(t < TT ? t : t0) * 768);
#pragma unroll
            for (int j = 0; j < 5; ++j) w[u][j] = src[(2 * j + hsel) * 32 + pi];
            vw[u] = src[320 + lane]; }
#pragma unroll
        for (int u = 0; u < NB4; ++u) {
            const int t = t0 + u * NGW; if (t >= TT) break;
            const int s_ = t & (SEQ - 1); const float pos = (pi < 16) ? (float)(s_ >> 6) : (float)(s_ & 63);
            const float ang = pos * invf;
            const float rev = ang * 0.15915494309189535f;
            const float sn = __builtin_amdgcn_sinf(rev), cs = __builtin_amdgcn_cosf(rev);
#pragma unroll
            for (int j = 0; j < 5; ++j) {
                const int head = 2 * j + hsel;
                const float x0 = bflo(w[u][j]), x1 = bfhi(w[u][j]);
                float ss = x0 * x0 + x1 * x1;
                ss = sum_x16(sum16(ss));
                const float rs = __builtin_amdgcn_rsqf(ss * (1.f / 64.f) + EPS);
                const bool isq = head < 8;
                const float y0 = x0 * rs * (isq ? qw0 : kw0), y1 = x1 * rs * (isq ? qw1 : kw1);
                float o0 = y0 * cs - y1 * sn, o1 = y0 * sn + y1 * cs;
                if (isq) { o0 *= C2; o1 *= C2; ((unsigned*)(QR + (size_t)t * 512))[head * 32 + pi] = pk2(o0, o1); }
                else { const int hk = head - 8, bq = t >> 13, sq = t & (SEQ - 1);
                    ((unsigned*)(KR + ((size_t)((bq * 2 + hk) * 128 + (sq >> 6)) * 8 + (pi >> 2)) * 512 + (sq & 63) * 8))[pi & 3] = pk2(o0, o1); }
            }
            { const int hk = lane >> 5, d = 2 * (lane & 31), bq = t >> 13, sq = t & (SEQ - 1), r = sq & 63;
              ((unsigned*)(VR + ((size_t)((bq * 2 + hk) * 128 + (sq >> 6)) * 8 + (d >> 5) * 4 + (r >> 4)) * 512 + ((r & 15) * 4 + ((d & 31) >> 3)) * 8))[(d & 7) >> 1] = vw[u]; }
        }
    }
}

constexpr int G_KNP = 0, G_QNP = 17408, G_KNTP = 34816, G_VCT = 53248;
constexpr int G_D0 = 71680, G_D1 = 71680 + 19456;
constexpr int GD_TBP = 0, GD_AP = 9216, GD_VEC = 18432;
constexpr int G_LM = 110592;
constexpr int G_GV = G_LM + 32768;
static_assert(G_GV + 2048 <= LDS_BYTES - 64, "gdn pre lds");

#define TRI_ROW(i, LC, LN) { \
        if ((i) + 1 < 64) { _Pragma("unroll") for (int j4 = 0; j4 < ((i) + 1 + 3) / 4 && j4 < 8; ++j4) LN[j4] = *(const LAS f32x4*)(L + ((i) + 1) * 64 + 4 * j4); } \
        _Pragma("unroll") for (int j4 = 8; j4 < ((i) + 3) / 4; ++j4) lt[j4 - 8] = *(const LAS f32x4*)(L + (i) * 64 + 4 * j4); \
        __builtin_amdgcn_sched_barrier(0); \
        f32x2_t a0 = {(lane == (i)) ? 1.0f : 0.0f, 0.f}, a1 = {0.f, 0.f}; \
        _Pragma("unroll") for (int j4 = 0; j4 < ((i) + 3) / 4; ++j4) { const f32x4 l = (j4 < 8) ? LC[j4 & 7] : lt[(j4 - 8) & 7]; \
            f32x2_t l0 = {l.x, (4 * j4 + 1 < (i)) ? l.y : 0.f}, l1 = {(4 * j4 + 2 < (i)) ? l.z : 0.f, (4 * j4 + 3 < (i)) ? l.w : 0.f}; \
            a0 -= l0 * xp[2 * j4]; if (4 * j4 + 2 < (i)) a1 -= l1 * xp[2 * j4 + 1]; } \
        const float a = (a0.x + a0.y) + (a1.x + a1.y); \
        if ((i) & 1) xp[(i) >> 1].y = a; else { xp[(i) >> 1].x = a; xp[(i) >> 1].y = 0.f; } \
        TBP[(REV ? 63 - (i) : (i)) * 72 + pc] = (bf16)(pk2(a * bcol, 0.f) & 0xffffu); \
        __builtin_amdgcn_sched_barrier(0); }
template <bool REV> DI void tri_inverse(LAS float* L, const LAS float* beta, LAS bf16* TBP, int lane) {
    f32x2_t xp[32];
    L = opaque(L); TBP = opaque(TBP); lane = opaque(lane);
    const float bcol = REV ? beta[63 - lane] : beta[lane];
    const int pc = REV ? permcol(63 - lane) : permcol(lane);
    f32x4 la[8], lb[8], lt[8];
#pragma unroll
    for (int ii = 0; ii < 64; ii += 2) { TRI_ROW(ii, la, lb) TRI_ROW(ii + 1, lb, la) }
}
#undef TRI_ROW

DI void gdn_conv(Frame& F, LAS unsigned char* lds, int t384, int b, int h, int n) {
    const bf16* QKVA = (const bf16*)(F.ws + WS_QKVA); const float* convw = F.in[3];
    const int cgp = t384 % 48, rg = t384 / 48, mat = cgp >> 4, cc = (cgp & 15) * 8;
    const int col = mat * 512 + h * 128 + cc;
    float w[5][8];
#pragma unroll
    for (int j = 0; j < 5; ++j) { const f32x4 a = *(const f32x4*)(convw + j * 1536 + col), bq = *(const f32x4*)(convw + j * 1536 + col + 4);
        w[j][0] = a.x; w[j][1] = a.y; w[j][2] = a.z; w[j][3] = a.w; w[j][4] = bq.x; w[j][5] = bq.y; w[j][6] = bq.z; w[j][7] = bq.w; }
    const int a4 = (cc >> 3) & 3, p0 = (cc & ~31) + 16 * (a4 & 1) + 4 * (a4 >> 1);
    const int ra = rg & 3, q0 = (rg >> 2) * 32 + 16 * (ra & 1) + 4 * (ra >> 1);
#pragma unroll
    for (int hf = 0; hf < 2; ++hf) {
        float o[4][8];
#pragma unroll
        for (int r = 0; r < 4; ++r)
#pragma unroll
            for (int c = 0; c < 8; ++c) o[r][c] = 0.f;
#pragma unroll
        for (int i = 0; i < 8; ++i) {
            const int pos = n * 64 + rg * 8 + hf * 4 - 2 + i;
            v4u raw = (v4u){0u, 0u, 0u, 0u};
            if (pos >= 0 && pos < SEQ) raw = *(const v4u*)(QKVA + (size_t)(b * SEQ + pos) * 1536 + col);
            float xin[8] = {bflo(raw.x), bfhi(raw.x), bflo(raw.y), bfhi(raw.y), bflo(raw.z), bfhi(raw.z), bflo(raw.w), bfhi(raw.w)};
#pragma unroll
            for (int j = 0; j < 5; ++j) { const int r = i - j; if (r >= 0 && r < 4) {
#pragma unroll
                for (int c = 0; c < 8; ++c) o[r][c] += w[j][c] * xin[c]; } }
        }
#pragma unroll
        for (int r = 0; r < 4; ++r) {
            float ss = 0.f;
#pragma unroll
            for (int c = 0; c < 8; ++c) { o[r][c] = siluf(o[r][c]); ss += o[r][c] * o[r][c]; }
            ss = sum16(ss);
            float sc = 1.0f;
            if (mat < 2) { sc = __builtin_amdgcn_rsqf(ss + EPS); if (mat == 0) sc *= 0.08838834764831845f; }
#pragma unroll
            for (int c = 0; c < 8; ++c) o[r][c] *= sc;
        }
        if (mat < 2) {
            LAS unsigned char* tile = lds + (mat == 0 ? G_QNP : G_KNP);
#pragma unroll
            for (int r = 0; r < 4; ++r) { const int c = rg * 8 + hf * 4 + r;
                v2u lo, hi2; lo.x = pk2(o[r][0], o[r][1]); lo.y = pk2(o[r][2], o[r][3]); hi2.x = pk2(o[r][4], o[r][5]); hi2.y = pk2(o[r][6], o[r][7]);
                *(LAS v2u*)(tile + c * 272 + p0 * 2) = lo; *(LAS v2u*)(tile + c * 272 + (p0 + 8) * 2) = hi2; }
        }
        if (mat >= 1) {
#pragma unroll
            for (int c = 0; c < 8; ++c) {
                v2u q4; q4.x = pk2(o[0][c], o[1][c]); q4.y = pk2(o[2][c], o[3][c]);
                if (mat == 1) *(LAS v2u*)(lds + G_KNTP + (cc + c) * 144 + (q0 + 8 * hf) * 2) = q4;
                else *(LAS v2u*)(lds + G_VCT + (cc + c) * 144 + rg * 16 + hf * 8) = q4;
            }
        }
    }
}
DI void gdn_gates(Frame& F, LAS unsigned char* lds, LAS float* gv, int lane, int b, int h, int n) {
    const float* gp = (const float*)(F.ws + WS_GATES) + (size_t)(b * SEQ + n * 64 + lane) * 16;
    const float bfv = gp[h], bbv = gp[4 + h], afv = gp[8 + h], abv = gp[12 + h];
    const float betaf = sigmoidf_(bfv), betab = sigmoidf_(bbv);
    const float xf = afv + F.in[5][h], xb = abv + F.in[5][4 + h];
    const float spf = fmaxf(xf, 0.f) + log1pf(__expf(-fabsf(xf))), spb = fmaxf(xb, 0.f) + log1pf(__expf(-fabsf(xb)));
    const float gf = -__expf(F.in[4][h]) * spf, gb = -__expf(F.in[4][4 + h]) * spb;
    float Gf = gf, Rb = gb;
#pragma unroll
    for (int o = 1; o < 64; o <<= 1) { const float u1 = __shfl_up(Gf, o); if (lane >= o) Gf += u1; const float d1 = __shfl_down(Rb, o); if (lane + o < 64) Rb += d1; }
    gv[lane] = Gf; gv[64 + lane] = Rb; gv[128 + lane] = betaf; gv[192 + lane] = betab;
    const float GfL = __shfl(Gf, 63), Rb0 = __shfl(Rb, 0);
    LAS float* v0 = (LAS float*)(lds + G_D0 + GD_VEC); LAS float* v1 = (LAS float*)(lds + G_D1 + GD_VEC);
    v0[lane] = __expf(Gf); v0[64 + lane] = __expf(GfL - Gf); v1[lane] = __expf(Rb); v1[64 + lane] = __expf(Rb0 - Rb);
    if (lane == 0) { v0[128] = __expf(GfL); v1[128] = __expf(Rb0); }
}
DI void p2_gdn_pre(Frame& F) {
    const int tid = F.tid, lane = F.lane, wave = F.wave;
    int task = F.vcu;
    if (task < 1024) {
        LAS unsigned char* lds = opaque(F.lds);
        const int b = task >> 9, h = (task >> 7) & 3, n = task & 127;
        if (wave >= 2) gdn_conv(F, lds, tid - 128, b, h, n);
        if (wave == 2) gdn_gates(F, lds, (LAS float*)(lds + G_GV), lane, b, h, n);
    }
    __syncthreads();
    int par = 0;
#pragma unroll 1
    for (; task < 1024; task += F.G, par ^= 1) {
        LAS unsigned char* lds = opaque(F.lds);
        const int b = task >> 9, h = (task >> 7) & 3, n = task & 127, bh = b * 4 + h;
        LAS float* gv = (LAS float*)(lds + G_GV + par * 1024);
        LAS float* sGf = gv; LAS float* sRb = gv + 64; LAS float* sBf = gv + 128; LAS float* sBb = gv + 192;
        {
            const int p = wave >> 2, mt = wave & 3, n16 = lane & 15, g = lane >> 4;
            const LAS unsigned char* At = lds + (p == 0 ? G_KNP : G_QNP) + (16 * mt + n16) * 272 + g * 16;
            bf16x8 af[4], bfr[16];
#pragma unroll
            for (int ks = 0; ks < 4; ++ks) af[ks] = *(const LAS bf16x8*)(At + ks * 64);
#pragma unroll
            for (int nt = 0; nt < 4; ++nt)
#pragma unroll
                for (int ks = 0; ks < 4; ++ks) bfr[nt * 4 + ks] = *(const LAS bf16x8*)(lds + G_KNP + (16 * nt + n16) * 272 + g * 16 + ks * 64);
            float Gc[4], Rc[4], Bfc[4], Bbc[4];
#pragma unroll
            for (int r = 0; r < 4; ++r) { const int c = 16 * mt + 4 * g + r; Gc[r] = sGf[c]; Rc[r] = sRb[c]; Bfc[r] = sBf[c]; Bbc[r] = sBb[c]; }
#pragma unroll
            for (int nt = 0; nt < 4; ++nt) {
                f32x4 acc = (f32x4){0.f, 0.f, 0.f, 0.f};
#pragma unroll
                for (int ks = 0; ks < 4; ++ks) acc = __builtin_amdgcn_mfma_f32_16x16x32_bf16(af[ks], bfr[nt * 4 + ks], acc, 0, 0, 0);
                const int s_ = 16 * nt + n16; const float Gs = sGf[s_], Rs = sRb[s_]; const int ps = permcol(s_);
#pragma unroll
                for (int r = 0; r < 4; ++r) {
                    const int c = 16 * mt + 4 * g + r; const float v = acc[r];
                    const float df = __expf(fminf(Gc[r] - Gs, 0.f)), db = __expf(fminf(Rc[r] - Rs, 0.f));
                    if (p == 0) {
                        ((LAS float*)(lds + G_LM))[c * 64 + s_] = Bfc[r] * v * df;
                        ((LAS float*)(lds + G_LM + 16384))[(63 - c) * 64 + (63 - s_)] = Bbc[r] * v * db;
                    } else {
                        ((LAS bf16*)(lds + G_D0 + GD_AP))[c * 72 + ps] = (bf16)(pk2(s_ <= c ? v * df : 0.f, 0.f) & 0xffffu);
                        ((LAS bf16*)(lds + G_D1 + GD_AP))[c * 72 + ps] = (bf16)(pk2(s_ >= c ? v * db : 0.f, 0.f) & 0xffffu);
                    }
                }
            }
        }
        __syncthreads();
        GAS v4u* gd0 = (GAS v4u*)(F.ws + WS_GD + (size_t)((bh * 2 + 0) * 128 + n) * GDN_D_BYTES);
        GAS v4u* gd1 = (GAS v4u*)(F.ws + WS_GD + (size_t)((bh * 2 + 1) * 128 + n) * GDN_D_BYTES);
        {
            GAS v4u* gsh = (GAS v4u*)(F.ws + WS_GSH + (size_t)(bh * 128 + n) * GDN_SH_BYTES);
#pragma unroll 3
            for (int i = tid; i < (int)(GDN_SH_BYTES / 16); i += NTHREADS) gsh[i] = *(const LAS v4u*)(lds + i * 16);
#pragma unroll 1
            for (int i = GD_AP / 16 + tid; i < (int)(GDN_D_BYTES / 16); i += NTHREADS) { gd0[i] = *(const LAS v4u*)(lds + G_D0 + i * 16); gd1[i] = *(const LAS v4u*)(lds + G_D1 + i * 16); }
        }
        __syncthreads();
        if (wave == 0) { tri_inverse<false>((LAS float*)(lds + G_LM), sBf, (LAS bf16*)(lds + G_D0 + GD_TBP), lane);
#pragma unroll 3
            for (int i = lane; i < GD_AP / 16; i += 64) gd0[i] = *(const LAS v4u*)(lds + G_D0 + i * 16); }
        else if (wave == 1) { tri_inverse<true>((LAS float*)(lds + G_LM + 16384), sBb, (LAS bf16*)(lds + G_D1 + GD_TBP), lane);
#pragma unroll 3
            for (int i = lane; i < GD_AP / 16; i += 64) gd1[i] = *(const LAS v4u*)(lds + G_D1 + i * 16); }
        else {
            const int t2 = task + F.G;
            if (t2 < 1024) { const int b2 = t2 >> 9, h2 = (t2 >> 7) & 3, n2 = t2 & 127;
                gdn_conv(F, lds, tid - 128, b2, h2, n2);
                if (wave == 2) gdn_gates(F, lds, (LAS float*)(lds + G_GV + (par ^ 1) * 1024), lane, b2, h2, n2); }
        }
        __syncthreads();
    }
}

DI bf16x8 pack8(const f32x4 a, const f32x4 b) {
    v4u p; p.x = pk2(a[0], a[1]); p.y = pk2(a[2], a[3]); p.z = pk2(b[0], b[1]); p.w = pk2(b[2], b[3]); return __builtin_bit_cast(bf16x8, p);
}
DI unsigned char* wgu_ptr(Frame& F, int e) { return F.ws + (e < WGU_SPLIT ? WS_WGU0 + (size_t)e * MiB : WS_WGU1 + (size_t)(e - WGU_SPLIT) * MiB); }
DI bf16* wd_ptr(Frame& F, int e) { return (bf16*)((unsigned char*)F.out + (e < WD_SPLIT ? DO_WD0 + (size_t)e * MiB : DO_WD1 + (size_t)(e - WD_SPLIT) * MiB)); }
constexpr int NG = 8, GSTEPS = 128 / NG;
#ifndef PASS1_QUOTA
#define PASS1_QUOTA 3
#endif
constexpr size_t WS_XB = 209 * MiB;
constexpr size_t WS_AOP = 217 * MiB;
constexpr size_t WS_SG = 221 * MiB;
constexpr int GS_SLOT = 54272, GS_Q = 17408, GS_VCT = 34816, GS_VEC = 53248, GS_TB = 18432, GS_AP = 27648;
static_assert(3 * GS_SLOT <= LDS_BYTES - 64, "scan ring");
static_assert(WS_SG + 8 * MiB <= 229 * MiB, "scan buffers");
DI void gs_dma(const unsigned char* src, unsigned lane16, unsigned lds_dst) {
    unsigned keep;
    asm volatile("s_mov_b32 %0, m0\n\ts_mov_b32 m0, %2\n\ts_nop 0\n\tglobal_load_lds_dwordx4 %1, %3\n\ts_mov_b32 m0, %0" : "=&s"(keep) : "v"(lane16), "s"(lds_dst), "s"(src) : "memory");
}
#define GS_WAITBAR(N) asm volatile("s_waitcnt vmcnt(%0) lgkmcnt(0)\n\ts_barrier" :: "n"(N) : "memory")
DI f32x4* gs_img(Frame& F, size_t base, int chain, int grp) { return (f32x4*)(F.ws + base) + (size_t)(chain * NG + grp) * (8 * 8 * 64); }
DI bf16* gs_aop(Frame& F, int chain, int grp) { return (bf16*)(F.ws + WS_AOP) + (size_t)(chain * NG + grp) * (8 * 4 * 64 * 8); }
DI void gs_start_state(Frame& F, int chain, int grp, f32x4 (&S)[8]);
template <int MODE> DI void gscan(Frame& F, const int chain, const int grp, f32x4* finalp, bf16* aop) {
    constexpr bool OUT = MODE == 0;
    constexpr int N1 = OUT ? 7 : (MODE == 1 ? 5 : 3), N2 = OUT ? 5 : 4, NST = OUT ? 16 : 0;
    const int lane = F.lane, n16 = lane & 15, g = lane >> 4, e = F.wave;
    const int bh = chain >> 1, dir = chain & 1, b = bh >> 2, h = bh & 3;
    const unsigned lds0 = (unsigned)(uintptr_t)opaque(F.lds), lane16 = (unsigned)lane * 16u;
    const unsigned char* shrec = F.ws + WS_GSH + (size_t)(bh * 128) * GDN_SH_BYTES; const unsigned char* drec = F.ws + WS_GD + (size_t)((bh * 2 + dir) * 128) * GDN_D_BYTES;
#define GS_ISSUE1(st_, slot_) do { const int sc_ = (st_) < 128 ? (st_) : 127; const int n_ = dir == 0 ? sc_ : 127 - sc_; const unsigned char* sh_ = shrec + (size_t)n_ * GDN_SH_BYTES; const unsigned char* dr_ = drec + (size_t)n_ * GDN_D_BYTES; \
        _Pragma("unroll") for (int j_ = 0; j_ < N1; ++j_) { const int q_ = e + 8 * j_; int p_; \
            if (MODE == 0) p_ = q_ < 53 ? q_ : 52; else if (MODE == 1) p_ = q_ < 17 ? q_ : (q_ < 35 ? q_ + 17 : 52); else p_ = q_ < 17 ? q_ : 52; \
            const unsigned char* src_ = p_ < 34 ? sh_ + p_ * 1024 : (p_ < 52 ? sh_ + G_VCT + (p_ - 34) * 1024 : dr_ + GD_VEC); \
            gs_dma(src_, lane16, (unsigned)__builtin_amdgcn_readfirstlane(lds0 + (unsigned)((slot_) * GS_SLOT + p_ * 1024))); } } while (0)
#define GS_ISSUE2(st_, slot_) do { const int sc_ = (st_) < 128 ? (st_) : 127; const int n_ = dir == 0 ? sc_ : 127 - sc_; const unsigned char* sh_ = shrec + (size_t)n_ * GDN_SH_BYTES; const unsigned char* dr_ = drec + (size_t)n_ * GDN_D_BYTES; \
        _Pragma("unroll") for (int j_ = 0; j_ < N2; ++j_) { const int q_ = e + 8 * j_; const int pm_ = OUT ? 35 : 26; const int p_ = q_ < pm_ ? q_ : pm_; \
            const unsigned char* src_ = p_ < 18 ? sh_ + G_KNTP + p_ * 1024 : dr_ + (p_ - 18) * 1024; \
            gs_dma(src_, lane16, (unsigned)__builtin_amdgcn_readfirstlane(lds0 + (unsigned)((slot_) * GS_SLOT + p_ * 1024))); } } while (0)
    const int st0 = grp * GSTEPS;
    bf16* Odir = (bf16*)((unsigned char*)F.out + (dir == 0 ? DO_OF : DO_OB));
    f32x4 S[8];
    if (MODE == 0 && grp > 0) gs_start_state(F, chain, grp, S);
    else {
#pragma unroll
        for (int i = 0; i < 8; ++i)
#pragma unroll
            for (int r = 0; r < 4; ++r) S[i][r] = (MODE == 2 && (16 * i + 4 * g + r) == (16 * e + n16)) ? 1.0f : 0.0f;
    }
    GS_ISSUE1(st0, 0); GS_ISSUE2(st0, 1);
    bf16x8 Sb[4];
#pragma unroll
    for (int i = 0; i < 4; ++i) Sb[i] = pack8(S[2 * i], S[2 * i + 1]);
    const unsigned aoff272 = n16 * 272 + g * 16, aoff144 = n16 * 144 + g * 16;
#define SB_() __builtin_amdgcn_sched_barrier(0)
#define LDR128(dst, base, off) asm volatile("ds_read_b128 %0, %1 offset:%2" : "=v"(dst) : "v"(base), "i"(off) : "memory")
#define LDR64(dst, base, off) asm volatile("ds_read_b64 %0, %1 offset:%2" : "=v"(dst) : "v"(base), "i"(off) : "memory")
#define LDR32(dst, base, off) asm volatile("ds_read_b32 %0, %1 offset:%2" : "=v"(dst) : "v"(base), "i"(off) : "memory")
    int sl1 = 0, sl2 = 1, sl3 = 2;
#pragma unroll 1
    for (int s = 0; s < GSTEPS; ++s) {
        const int st = st0 + s;
        if (OUT && s > 0) GS_WAITBAR(N2 + NST); else GS_WAITBAR(N2);
        GS_ISSUE1(s + 1 < GSTEPS ? st + 1 : st, sl3);
        const int n = dir == 0 ? st : 127 - st;
        const unsigned h1 = lds0 + (unsigned)sl1 * GS_SLOT, h2 = lds0 + (unsigned)sl2 * GS_SLOT;
        const unsigned bK = h1 + aoff272, bQ = h1 + GS_Q + aoff272, bKT = h2 + aoff144, bT = h2 + GS_TB + aoff144;
        const unsigned bV = h1 + GS_VCT + e * 2304 + n16 * 144 + g * 8, bvec = h1 + GS_VEC + g * 16, bd = h1 + GS_VEC;
        f32x4 eG[4], ks[4]; v2u vv[4]; float dch; bf16x8 fa[16];
        LDR128(eG[0], bvec, 0); LDR128(eG[1], bvec, 64); LDR128(eG[2], bvec, 128); LDR128(eG[3], bvec, 192);
        LDR128(ks[0], bvec, 256); LDR128(ks[1], bvec, 320); LDR128(ks[2], bvec, 384); LDR128(ks[3], bvec, 448);
        LDR32(dch, bd, 512);
        LDR64(vv[0], bV, 0); LDR64(vv[1], bV, 32); LDR64(vv[2], bV, 64); LDR64(vv[3], bV, 96);
#pragma unroll
        for (int m = 0; m < 4; ++m) { LDR128(fa[m * 4 + 0], bK, m * 4352 + 0); LDR128(fa[m * 4 + 1], bK, m * 4352 + 64); LDR128(fa[m * 4 + 2], bK, m * 4352 + 128); LDR128(fa[m * 4 + 3], bK, m * 4352 + 192); }
        bf16x8 fq[16];
        if (OUT) {
#pragma unroll
            for (int m = 0; m < 4; ++m) { LDR128(fq[m * 4 + 0], bQ, m * 4352 + 0); LDR128(fq[m * 4 + 1], bQ, m * 4352 + 64); LDR128(fq[m * 4 + 2], bQ, m * 4352 + 128); LDR128(fq[m * 4 + 3], bQ, m * 4352 + 192); }
            asm volatile("s_waitcnt lgkmcnt(15)" : "+v"(eG[0]), "+v"(eG[1]), "+v"(eG[2]), "+v"(eG[3]), "+v"(ks[0]), "+v"(ks[1]), "+v"(ks[2]), "+v"(ks[3]), "+v"(dch), "+v"(vv[0]), "+v"(vv[1]), "+v"(vv[2]), "+v"(vv[3]),
                         "+v"(fa[0]), "+v"(fa[1]), "+v"(fa[2]), "+v"(fa[3]), "+v"(fa[4]), "+v"(fa[5]), "+v"(fa[6]), "+v"(fa[7]), "+v"(fa[8]), "+v"(fa[9]), "+v"(fa[10]), "+v"(fa[11]), "+v"(fa[12]), "+v"(fa[13]), "+v"(fa[14]), "+v"(fa[15]) :: "memory");
        } else {
            asm volatile("s_waitcnt lgkmcnt(0)" : "+v"(eG[0]), "+v"(eG[1]), "+v"(eG[2]), "+v"(eG[3]), "+v"(ks[0]), "+v"(ks[1]), "+v"(ks[2]), "+v"(ks[3]), "+v"(dch), "+v"(vv[0]), "+v"(vv[1]), "+v"(vv[2]), "+v"(vv[3]),
                         "+v"(fa[0]), "+v"(fa[1]), "+v"(fa[2]), "+v"(fa[3]), "+v"(fa[4]), "+v"(fa[5]), "+v"(fa[6]), "+v"(fa[7]), "+v"(fa[8]), "+v"(fa[9]), "+v"(fa[10]), "+v"(fa[11]), "+v"(fa[12]), "+v"(fa[13]), "+v"(fa[14]), "+v"(fa[15]) :: "memory");
        }
        SB_();
        f32x4 KS[4];
#pragma unroll
        for (int m = 0; m < 4; ++m) KS[m] = (f32x4){0.f, 0.f, 0.f, 0.f};
#pragma unroll
        for (int i = 0; i < 4; ++i)
#pragma unroll
            for (int m = 0; m < 4; ++m) KS[m] = __builtin_amdgcn_mfma_f32_16x16x32_bf16(fa[m * 4 + i], Sb[i], KS[m], 0, 0, 0);
        SB_();
        if (OUT) {
            if (s > 0) asm volatile("s_waitcnt vmcnt(%16) lgkmcnt(0)\n\ts_barrier" : "+v"(fq[0]), "+v"(fq[1]), "+v"(fq[2]), "+v"(fq[3]), "+v"(fq[4]), "+v"(fq[5]), "+v"(fq[6]), "+v"(fq[7]), "+v"(fq[8]), "+v"(fq[9]), "+v"(fq[10]), "+v"(fq[11]), "+v"(fq[12]), "+v"(fq[13]), "+v"(fq[14]), "+v"(fq[15]) : "n"(N1 + NST) : "memory");
            else asm volatile("s_waitcnt vmcnt(%16) lgkmcnt(0)\n\ts_barrier" : "+v"(fq[0]), "+v"(fq[1]), "+v"(fq[2]), "+v"(fq[3]), "+v"(fq[4]), "+v"(fq[5]), "+v"(fq[6]), "+v"(fq[7]), "+v"(fq[8]), "+v"(fq[9]), "+v"(fq[10]), "+v"(fq[11]), "+v"(fq[12]), "+v"(fq[13]), "+v"(fq[14]), "+v"(fq[15]) : "n"(N1) : "memory");
        } else GS_WAITBAR(N1);
        GS_ISSUE2(s + 1 < GSTEPS ? st + 1 : st, sl1);
        bf16x8 ft[8];
#pragma unroll
        for (int m = 0; m < 4; ++m) { LDR128(ft[m * 2 + 0], bT, m * 2304 + 0); LDR128(ft[m * 2 + 1], bT, m * 2304 + 64); }
        SB_();
        f32x4 o[4];
        if (OUT) {
#pragma unroll
            for (int m = 0; m < 4; ++m) o[m] = (f32x4){0.f, 0.f, 0.f, 0.f};
#pragma unroll
            for (int i = 0; i < 4; ++i)
#pragma unroll
                for (int m = 0; m < 4; ++m) o[m] = __builtin_amdgcn_mfma_f32_16x16x32_bf16(fq[m * 4 + i], Sb[i], o[m], 0, 0, 0);
        }
        f32x4 rr[4];
#pragma unroll
        for (int m = 0; m < 4; ++m) {
            if (MODE == 2) { rr[m][0] = -eG[m][0] * KS[m][0]; rr[m][1] = -eG[m][1] * KS[m][1]; rr[m][2] = -eG[m][2] * KS[m][2]; rr[m][3] = -eG[m][3] * KS[m][3]; }
            else { rr[m][0] = bflo(vv[m].x) - eG[m][0] * KS[m][0]; rr[m][1] = bfhi(vv[m].x) - eG[m][1] * KS[m][1]; rr[m][2] = bflo(vv[m].y) - eG[m][2] * KS[m][2]; rr[m][3] = bfhi(vv[m].y) - eG[m][3] * KS[m][3]; } }
        bf16x8 rb[2]; rb[0] = pack8(rr[0], rr[1]); rb[1] = pack8(rr[2], rr[3]);
        SB_();
        bf16x8 fk[16];
#pragma unroll
        for (int jt = 0; jt < 8; ++jt) { LDR128(fk[jt * 2 + 0], bKT, jt * 2304 + 0); LDR128(fk[jt * 2 + 1], bKT, jt * 2304 + 64); }
        asm volatile("s_waitcnt lgkmcnt(15)" : "+v"(ft[0]), "+v"(ft[1]), "+v"(ft[2]), "+v"(ft[3]), "+v"(ft[4]), "+v"(ft[5]), "+v"(ft[6]), "+v"(ft[7]) :: "memory");
        SB_();
        f32x4 vn[4];
#pragma unroll
        for (int m = 0; m < 4; ++m) vn[m] = (f32x4){0.f, 0.f, 0.f, 0.f};
#pragma unroll
        for (int i = 0; i < 2; ++i)
#pragma unroll
            for (int m = 0; m < 4; ++m) vn[m] = __builtin_amdgcn_mfma_f32_16x16x32_bf16(ft[m * 2 + i], rb[i], vn[m], 0, 0, 0);
        if (OUT) {
#pragma unroll
            for (int m = 0; m < 4; ++m) o[m] = o[m] * eG[m];
        }
#pragma unroll
        for (int jt = 0; jt < 8; ++jt) S[jt] = S[jt] * dch;
        SB_();
        bf16x8 fp[8];
        if (OUT) {
#pragma unroll
            for (int m = 0; m < 4; ++m) { LDR128(fp[m * 2 + 0], bT, (GS_AP - GS_TB) + m * 2304 + 0); LDR128(fp[m * 2 + 1], bT, (GS_AP - GS_TB) + m * 2304 + 64); }
        }
        bf16x8 vnb[2]; vnb[0] = pack8(vn[0], vn[1]); vnb[1] = pack8(vn[2], vn[3]);
        bf16x8 vs[2]; vs[0] = pack8(vn[0] * ks[0], vn[1] * ks[1]); vs[1] = pack8(vn[2] * ks[2], vn[3] * ks[3]);
        if (OUT) asm volatile("s_waitcnt lgkmcnt(8)" : "+v"(fk[0]), "+v"(fk[1]), "+v"(fk[2]), "+v"(fk[3]), "+v"(fk[4]), "+v"(fk[5]), "+v"(fk[6]), "+v"(fk[7]), "+v"(fk[8]), "+v"(fk[9]), "+v"(fk[10]), "+v"(fk[11]), "+v"(fk[12]), "+v"(fk[13]), "+v"(fk[14]), "+v"(fk[15]) :: "memory");
        else asm volatile("s_waitcnt lgkmcnt(0)" : "+v"(fk[0]), "+v"(fk[1]), "+v"(fk[2]), "+v"(fk[3]), "+v"(fk[4]), "+v"(fk[5]), "+v"(fk[6]), "+v"(fk[7]), "+v"(fk[8]), "+v"(fk[9]), "+v"(fk[10]), "+v"(fk[11]), "+v"(fk[12]), "+v"(fk[13]), "+v"(fk[14]), "+v"(fk[15]) :: "memory");
        SB_();
#pragma unroll
        for (int i = 0; i < 2; ++i)
#pragma unroll
            for (int jt = 0; jt < 8; ++jt) S[jt] = __builtin_amdgcn_mfma_f32_16x16x32_bf16(fk[jt * 2 + i], vs[i], S[jt], 0, 0, 0);
        if (OUT) {
            asm volatile("s_waitcnt lgkmcnt(0)" : "+v"(fp[0]), "+v"(fp[1]), "+v"(fp[2]), "+v"(fp[3]), "+v"(fp[4]), "+v"(fp[5]), "+v"(fp[6]), "+v"(fp[7]) :: "memory");
#pragma unroll
            for (int i = 0; i < 2; ++i)
#pragma unroll
                for (int m = 0; m < 4; ++m) o[m] = __builtin_amdgcn_mfma_f32_16x16x32_bf16(fp[m * 2 + i], vnb[i], o[m], 0, 0, 0);
        }
#pragma unroll
        for (int i = 0; i < 4; ++i) Sb[i] = pack8(S[2 * i], S[2 * i + 1]);
        SB_();
        if (OUT) {
            bf16* op = Odir + (size_t)(b * SEQ + n * 64) * 512 + h * 128 + 16 * e + n16;
#pragma unroll
            for (int m = 0; m < 4; ++m)
#pragma unroll
                for (int r = 0; r < 4; ++r) op[(size_t)(16 * m + 4 * g + r) * 512] = (bf16)(pk2(o[m][r], 0.f) & 0xffffu);
        }
        { const int t_ = sl1; sl1 = sl3; sl3 = sl2; sl2 = t_; }
    }
#undef SB_
#undef LDR128
#undef LDR64
#undef LDR32
#undef GS_ISSUE1
#undef GS_ISSUE2
    if (finalp) {
#pragma unroll
        for (int i = 0; i < 8; ++i) finalp[(e * 8 + i) * 64 + lane] = S[i];
    }
    if (aop) {
#pragma unroll
        for (int jt = 0; jt < 8; ++jt)
#pragma unroll
            for (int r = 0; r < 4; ++r) aop[((jt * 4 + (e >> 1)) * 64 + 16 * (n16 >> 2) + 4 * g + r) * 8 + 4 * (e & 1) + (n16 & 3)] = (bf16)(pk2(S[jt][r], 0.f) & 0xffffu);
    }
    asm volatile("s_waitcnt vmcnt(0)" ::: "memory");
    __syncthreads();
}
DI void gs_start_state(Frame& F, int chain, int grp, f32x4 (&S)[8]) {
    const int lane = F.lane, e = F.wave;
    { const f32x4* b0 = gs_img(F, WS_XB, chain, 0);
#pragma unroll
      for (int i = 0; i < 8; ++i) S[i] = b0[(e * 8 + i) * 64 + lane]; }
#pragma unroll 1
    for (int gq = 1; gq < grp; ++gq) {
        const f32x4* bg = gs_img(F, WS_XB, chain, gq); const bf16x8* ag = (const bf16x8*)gs_aop(F, chain, gq);
        bf16x8 Sb[4];
#pragma unroll
        for (int i = 0; i < 4; ++i) Sb[i] = pack8(S[2 * i], S[2 * i + 1]);
#pragma unroll
        for (int jt = 0; jt < 8; ++jt) { f32x4 acc = bg[(e * 8 + jt) * 64 + lane];
#pragma unroll
            for (int i = 0; i < 4; ++i) acc = __builtin_amdgcn_mfma_f32_16x16x32_bf16(ag[(jt * 4 + i) * 64 + lane], Sb[i], acc, 0, 0, 0);
            S[jt] = acc; }
    }
}
constexpr int CV_QS = NEXP * 32, CV_WD = NEXP * 32, CV_WO = 64, CV_RT = 16, CV_ITEMS = CV_QS + CV_WD + CV_WO + CV_RT;
DI void conv_item(Frame& F, int it) {
    LAS float* scr = (LAS float*)(F.lds + F.wave * 16384);
    if (it < CV_QS) {
        const int e = it >> 5, mat = (it >> 4) & 1, nb = it & 15;
        q_strip((mat ? F.in[14] : F.in[13]) + (size_t)e * 1024 * 512, 512, 32 * nb, wgu_ptr(F, e), (float*)(F.ws + WS_WSC) + e * 1024, mat + 64 * nb, 2, F.lds, F.wave, F.lane);
    } else if (it < CV_QS + CV_WD) {
        const int w = (it - CV_QS) * 8 + F.wave, e = w >> 8, r = w & 255;
        p0_transpose_item(F.in[15] + (size_t)e * 512 * 1024, 1024, 32, wd_ptr(F, e), 512, 0, 1, scr, r, F.lane);
    } else if (it < CV_QS + CV_WD + CV_WO) {
        p0_transpose_item(F.in[9], 1024, 32, (bf16*)(F.ws + WS_WOUT), 1024, 0, 1, scr, (it - CV_QS - CV_WD) * 8 + F.wave, F.lane);
    } else {
        bf16* WRH = (bf16*)(F.ws + WS_WR); bf16* WRL = WRH + 48 * 1024; const float* wrg = F.in[11]; const float* wre = F.in[12];
        const int base = (it - CV_QS - CV_WD - CV_WO) * 3072;
#pragma unroll
        for (int q = 0; q < 6; ++q) { const int i = base + q * 512 + F.tid; const int j = i >> 10, k = i & 1023; float v = 0.f; if (j < 4) v = wrg[k * 4 + j]; else if (j < 36) v = wre[k * 32 + (j - 4)];
            const unsigned hh = f2bf(v); const float hv = __builtin_bit_cast(float, hh << 16); WRH[i] = (bf16)hh; WRL[i] = (bf16)f2bf(v - hv); }
    }
}
constexpr int CW_CONVQ = 12288;
static_assert(48 * PASS1_QUOTA <= CV_QS, "pass 1 may only take gate/up strips");
DI void conv_pull(Frame& F, int quota) {
    volatile LAS int* slot = (volatile LAS int*)(F.lds + MISC_OFF + 32);
    for (int n = 0; n < quota; ++n) {
        __syncthreads();
        if (F.tid == 0) *slot = (int)xb_add((unsigned*)(F.ws + WS_CTL) + CW_CONVQ, 1u);
        __syncthreads();
        const int it = *slot; if (it >= CV_ITEMS) break;
        conv_item(F, it);
    }
    __syncthreads();
}
DI void p4_pass1(Frame& F) {
    const int T = F.vcu, part = T & 1, cg = T >> 1, chain = cg / (NG - 1), grp = cg % (NG - 1);
    if (T < 16 * (NG - 1) * 2 && part == 0) gscan<1>(F, chain, grp, gs_img(F, WS_XB, chain, grp), nullptr);
    else if (T < 16 * (NG - 1) * 2 && grp > 0) gscan<2>(F, chain, grp, nullptr, gs_aop(F, chain, grp));
    else conv_pull(F, PASS1_QUOTA);
}
DI void p4_pass3(Frame& F) {
    if ((F.vcu & 1) == 0 && (F.vcu >> 1) < 16 * NG) { const int T = F.vcu >> 1; gscan<0>(F, T / NG, T % NG, nullptr, nullptr); }
    conv_pull(F, 1 << 30);
}

DI void p5_combine(Frame& F) {
    const int gw = F.vcu * NWAVES + F.wave, NGW = F.G * NWAVES, lane = F.lane;
    const bf16* OFp = (const bf16*)((unsigned char*)F.out + DO_OF); const bf16* OBp = (const bf16*)((unsigned char*)F.out + DO_OB);
    const bf16* ZA = (const bf16*)(F.ws + WS_ZA); bf16* OCAT = (bf16*)(F.ws + WS_OCAT);
    const float* nw = F.in[6] + (lane & 15) * 8;
    float w8[8];
#pragma unroll
    for (int c = 0; c < 8; ++c) w8[c] = nw[c];
    constexpr int NB4 = 4;
    for (int t0 = gw; t0 < TT; t0 += NB4 * NGW) {
        v4u a[NB4], bb[NB4], z[NB4];
#pragma unroll
        for (int u = 0; u < NB4; ++u) { const int t = (t0 + u * NGW < TT) ? t0 + u * NGW : t0;
            a[u] = *(const v4u*)(OFp + (size_t)t * 512 + lane * 8); bb[u] = *(const v4u*)(OBp + (size_t)t * 512 + lane * 8); z[u] = *(const v4u*)(ZA + (size_t)t * 512 + lane * 8); }
#pragma unroll
        for (int u = 0; u < NB4; ++u) {
            const int t = t0 + u * NGW; if (t >= TT) break;
            float o[8] = {bflo(a[u].x) + bflo(bb[u].x), bfhi(a[u].x) + bfhi(bb[u].x), bflo(a[u].y) + bflo(bb[u].y), bfhi(a[u].y) + bfhi(bb[u].y), bflo(a[u].z) + bflo(bb[u].z), bfhi(a[u].z) + bfhi(bb[u].z), bflo(a[u].w) + bflo(bb[u].w), bfhi(a[u].w) + bfhi(bb[u].w)};
            const float zz[8] = {bflo(z[u].x), bfhi(z[u].x), bflo(z[u].y), bfhi(z[u].y), bflo(z[u].z), bfhi(z[u].z), bflo(z[u].w), bfhi(z[u].w)};
            float ss = 0.f;
#pragma unroll
            for (int c = 0; c < 8; ++c) ss += o[c] * o[c];
            ss = sum16(ss);
            const float rn = __builtin_amdgcn_rsqf(ss * (1.f / 128.f) + EPS);
#pragma unroll
            for (int c = 0; c < 8; ++c) o[c] = o[c] * rn * w8[c] * siluf(zz[c]);
            v4u r; r.x = pk2(o[0], o[1]); r.y = pk2(o[2], o[3]); r.z = pk2(o[4], o[5]); r.w = pk2(o[6], o[7]);
            *(v4u*)(OCAT + (size_t)t * 1024 + lane * 8) = r;
        }
    }
}

struct TokRec { int e[2]; int row[2]; float gate[2]; };
DI void p7_route(Frame& F) {
    const int lane = F.lane, n16 = lane & 15, g = lane >> 4, wave = F.wave;
    const bf16* X1 = (const bf16*)(F.ws + WS_X1); const float* nfw = F.in[10];
    const bf16* WRH = (const bf16*)(F.ws + WS_WR); const bf16* WRL = WRH + 48 * 1024;
    unsigned char* HN = (unsigned char*)F.out + DO_HN; TokRec* TOK = (TokRec*)(F.ws + WS_TOK); unsigned* gcnt = (unsigned*)(F.ws + WS_CTL) + CW_CNT; int* LIST = (int*)(F.ws + WS_LIST);
    LAS float* lg = (LAS float*)(F.lds + (wave & 3) * 4096);
    LAS unsigned* hist = (LAS unsigned*)(F.lds + 16384); LAS unsigned* base = hist + 32;
    const int sub = blockIdx.x & 7;
    const float qsc = 127.0f / act_absmax(nfw, lane);
    for (int rt0 = blockIdx.x * 4; rt0 < TT / 16; rt0 += F.G * 4) {
        if (F.tid < 32) hist[F.tid] = 0u;
        __syncthreads();
        int ex1 = 0, ex2 = 0, tok = -1; unsigned l1 = 0, l2 = 0; float g1 = 0.f, g2 = 0.f;
        const int rt = rt0 + wave;
        if (wave < 4 && rt < TT / 16) {
            const int row = rt * 16 + n16; const bf16* xr = X1 + (size_t)row * DMODEL + 8 * g;
            float ss = 0.f;
#pragma unroll 16
            for (int i = 0; i < 32; ++i) { const v4u xw = *(const v4u*)(xr + 32 * i); const f32x4 a = {bflo(xw.x), bfhi(xw.x), bflo(xw.y), bfhi(xw.y)}, b2 = {bflo(xw.z), bfhi(xw.z), bflo(xw.w), bfhi(xw.w)};
                ss += (a.x * a.x + a.y * a.y) + (a.z * a.z + a.w * a.w) + (b2.x * b2.x + b2.y * b2.y) + (b2.z * b2.z + b2.w * b2.w); }
            ss = sum_x32(sum_x16(ss));
            const float rs = __builtin_amdgcn_rsqf(ss * (1.f / DMODEL) + EPS);
            f32x4 acc[3];
#pragma unroll
            for (int q = 0; q < 3; ++q) acc[q] = (f32x4){0.f, 0.f, 0.f, 0.f};
#pragma unroll 4
            for (int i = 0; i < 32; ++i) {
                const v4u xw = *(const v4u*)(xr + 32 * i); const f32x4 a = {bflo(xw.x), bfhi(xw.x), bflo(xw.y), bfhi(xw.y)}, b2 = {bflo(xw.z), bfhi(xw.z), bflo(xw.w), bfhi(xw.w)};
                const f32x4 wa = *(const f32x4*)(nfw + 32 * i + 8 * g), wb = *(const f32x4*)(nfw + 32 * i + 8 * g + 4);
                float hv[8] = {a.x * rs * wa.x, a.y * rs * wa.y, a.z * rs * wa.z, a.w * rs * wa.w, b2.x * rs * wb.x, b2.y * rs * wb.y, b2.z * rs * wb.z, b2.w * rs * wb.w};
                v4u hi, lo;
                hi.x = pk2(hv[0], hv[1]); hi.y = pk2(hv[2], hv[3]); hi.z = pk2(hv[4], hv[5]); hi.w = pk2(hv[6], hv[7]);
                lo.x = pk2(hv[0] - bflo(hi.x), hv[1] - bfhi(hi.x)); lo.y = pk2(hv[2] - bflo(hi.y), hv[3] - bfhi(hi.y));
                lo.z = pk2(hv[4] - bflo(hi.z), hv[5] - bfhi(hi.z)); lo.w = pk2(hv[6] - bflo(hi.w), hv[7] - bfhi(hi.w));
                { v2u q; q.x = q8x4(hv[0], hv[1], hv[2], hv[3], qsc); q.y = q8x4(hv[4], hv[5], hv[6], hv[7], qsc); *(v2u*)(HN + (size_t)row * DMODEL + 32 * i + 8 * g) = q; }
                const bf16x8 ah = __builtin_bit_cast(bf16x8, hi), al = __builtin_bit_cast(bf16x8, lo);
#pragma unroll
                for (int q = 0; q < 3; ++q) {
                    const bf16x8 bh = *(const bf16x8*)(WRH + (size_t)(16 * q + n16) * 1024 + 32 * i + 8 * g), bl = *(const bf16x8*)(WRL + (size_t)(16 * q + n16) * 1024 + 32 * i + 8 * g);
                    acc[q] = __builtin_amdgcn_mfma_f32_16x16x32_bf16(ah, bh, acc[q], 0, 0, 0);
                    acc[q] = __builtin_amdgcn_mfma_f32_16x16x32_bf16(ah, bl, acc[q], 0, 0, 0);
                    acc[q] = __builtin_amdgcn_mfma_f32_16x16x32_bf16(al, bh, acc[q], 0, 0, 0);
                }
            }
#pragma unroll
            for (int q = 0; q < 3; ++q)
#pragma unroll
                for (int r = 0; r < 4; ++r) lg[(4 * g + r) * 48 + 16 * q + n16] = acc[q][r];
            asm volatile("s_waitcnt lgkmcnt(0)" ::: "memory");
            if (lane < 16) {
                const LAS float* L = lg + lane * 48; tok = rt * 16 + lane;
                float gm = L[0]; int gs = 0;
#pragma unroll
                for (int q = 1; q < 4; ++q) if (L[q] > gm) { gm = L[q]; gs = q; }
                float gsum = 0.f;
#pragma unroll
                for (int q = 0; q < 4; ++q) gsum += __expf(L[q] - gm);
                const float gp_top = 1.0f / gsum;
                float fv[8];
#pragma unroll
                for (int q = 0; q < 8; ++q) { float v = L[4 + q]; v = (gs == 1) ? L[12 + q] : v; v = (gs == 2) ? L[20 + q] : v; v = (gs == 3) ? L[28 + q] : v; fv[q] = v; }
                float m1 = fv[0]; int i1 = 0;
#pragma unroll
                for (int q = 1; q < 8; ++q) if (fv[q] > m1) { m1 = fv[q]; i1 = q; }
                float m2 = -3.0e38f; int i2 = 0;
#pragma unroll
                for (int q = 0; q < 8; ++q) if (q != i1 && fv[q] > m2) { m2 = fv[q]; i2 = q; }
                const float e2 = __expf(m2 - m1); g1 = gp_top / (1.0f + e2); g2 = gp_top * e2 / (1.0f + e2);
                ex1 = gs * 8 + i1; ex2 = gs * 8 + i2;
                l1 = __hip_atomic_fetch_add(hist + ex1, 1u, __ATOMIC_RELAXED, __HIP_MEMORY_SCOPE_WORKGROUP); l2 = __hip_atomic_fetch_add(hist + ex2, 1u, __ATOMIC_RELAXED, __HIP_MEMORY_SCOPE_WORKGROUP);
            }
        }
        __syncthreads();
        if (F.tid < 32) { const unsigned hcount = hist[F.tid]; base[F.tid] = hcount ? atomicAdd(gcnt + F.tid * 8 + sub, hcount) : 0u; }
        __syncthreads();
        if (tok >= 0) {
            const int s1 = (int)(base[ex1] + l1), s2 = (int)(base[ex2] + l2);
            LIST[(size_t)(ex1 * 8 + sub) * TT + s1] = tok; LIST[(size_t)(ex2 * 8 + sub) * TT + s2] = tok;
            TokRec tr; tr.e[0] = ex1; tr.e[1] = ex2; tr.row[0] = (sub << 24) | s1; tr.row[1] = (sub << 24) | s2; tr.gate[0] = g1; tr.gate[1] = g2;
            TOK[tok] = tr;
        }
    }
}

DI void build_etab(Frame& F) {
    LAS unsigned* etab = (LAS unsigned*)(F.lds + ETAB_OFF);
    if (F.tid < 32) {
        const unsigned* gcnt = (const unsigned*)(F.ws + WS_CTL) + CW_CNT + F.tid * 8; unsigned acc = 0;
#pragma unroll
        for (int q = 0; q < 8; ++q) { const unsigned c = __hip_atomic_load(gcnt + q, __ATOMIC_RELAXED, __HIP_MEMORY_SCOPE_AGENT); etab[96 + 8 * F.tid + q] = acc; acc += c; }
        etab[64 + F.tid] = acc; etab[2 * F.tid + 1] = (acc + 255u) >> 8;
    }
    __syncthreads();
    if (F.tid == 0) { unsigned acc = 0; for (int e = 0; e < NEXP; ++e) { etab[2 * e] = acc; acc += etab[2 * e + 1]; } }
    if (F.wave == 1) { const float am = act_absmax(F.in[10], F.lane); if (F.lane == 0) ((LAS float*)etab)[352] = am * (1.0f / 127.0f); }
    __syncthreads();
}

DI void p11_final(Frame& F) {
    build_etab(F);
    const LAS unsigned* etab = (const LAS unsigned*)(F.lds + ETAB_OFF);
    const int gw = F.vcu * NWAVES + F.wave, NGW = F.G * NWAVES, lane = F.lane;
    const bf16* Y = (const bf16*)(F.ws + WS_XBUF); const TokRec* TOK = (const TokRec*)(F.ws + WS_TOK); const float* fw = F.in[16];
    const f32x4 w0 = *(const f32x4*)(fw + lane * 8), w1 = *(const f32x4*)(fw + lane * 8 + 4), w2 = *(const f32x4*)(fw + 512 + lane * 8), w3 = *(const f32x4*)(fw + 516 + lane * 8);
    constexpr int NB2 = 2;
    for (int t0 = gw; t0 < TT; t0 += NB2 * NGW) {
        TokRec tr[NB2]; v4u xa[NB2][2]; v4u ya[NB2][2][2];
#pragma unroll
        for (int u = 0; u < NB2; ++u) { const int t = (t0 + u * NGW < TT) ? t0 + u * NGW : t0; tr[u] = TOK[t];
            const bf16* xr = (const bf16*)(F.ws + WS_X1) + (size_t)t * DMODEL + lane * 8;
            xa[u][0] = *(const v4u*)(xr); xa[u][1] = *(const v4u*)(xr + 512); }
#pragma unroll
        for (int u = 0; u < NB2; ++u)
#pragma unroll
            for (int k = 0; k < 2; ++k) { const unsigned rk = (unsigned)tr[u].row[k]; const bf16* yr = Y + (size_t)(etab[2 * tr[u].e[k]] * 256u + etab[96 + 8 * tr[u].e[k] + (rk >> 24)] + (rk & 0xffffffu)) * DMODEL + lane * 8; ya[u][k][0] = *(const v4u*)(yr); ya[u][k][1] = *(const v4u*)(yr + 512); }
#pragma unroll
        for (int u = 0; u < NB2; ++u) {
            const int t = t0 + u * NGW; if (t >= TT) break;
            float v[16] = {bflo(xa[u][0].x), bfhi(xa[u][0].x), bflo(xa[u][0].y), bfhi(xa[u][0].y), bflo(xa[u][0].z), bfhi(xa[u][0].z), bflo(xa[u][0].w), bfhi(xa[u][0].w),
                           bflo(xa[u][1].x), bfhi(xa[u][1].x), bflo(xa[u][1].y), bfhi(xa[u][1].y), bflo(xa[u][1].z), bfhi(xa[u][1].z), bflo(xa[u][1].w), bfhi(xa[u][1].w)};
#pragma unroll
            for (int k = 0; k < 2; ++k) {
                const float gk = tr[u].gate[k]; const v4u y0 = ya[u][k][0], y1 = ya[u][k][1];
                v[0] += gk * bflo(y0.x); v[1] += gk * bfhi(y0.x); v[2] += gk * bflo(y0.y); v[3] += gk * bfhi(y0.y); v[4] += gk * bflo(y0.z); v[5] += gk * bfhi(y0.z); v[6] += gk * bflo(y0.w); v[7] += gk * bfhi(y0.w);
                v[8] += gk * bflo(y1.x); v[9] += gk * bfhi(y1.x); v[10] += gk * bflo(y1.y); v[11] += gk * bfhi(y1.y); v[12] += gk * bflo(y1.z); v[13] += gk * bfhi(y1.z); v[14] += gk * bflo(y1.w); v[15] += gk * bfhi(y1.w);
            }
            float ss = 0.f;
#pragma unroll
            for (int i = 0; i < 16; ++i) ss += v[i] * v[i];
            const float rs = __builtin_amdgcn_rsqf(wave_sum(ss) * (1.f / DMODEL) + EPS);
            float* orow = F.out + (size_t)t * DMODEL + lane * 8;
            *(f32x4*)(orow) = (f32x4){v[0] * rs * w0.x, v[1] * rs * w0.y, v[2] * rs * w0.z, v[3] * rs * w0.w};
            *(f32x4*)(orow + 4) = (f32x4){v[4] * rs * w1.x, v[5] * rs * w1.y, v[6] * rs * w1.z, v[7] * rs * w1.w};
            *(f32x4*)(orow + 512) = (f32x4){v[8] * rs * w2.x, v[9] * rs * w2.y, v[10] * rs * w2.z, v[11] * rs * w2.w};
            *(f32x4*)(orow + 516) = (f32x4){v[12] * rs * w3.x, v[13] * rs * w3.y, v[14] * rs * w3.z, v[15] * rs * w3.w};
        }
    }
}

struct Args { const float* in[17]; float* out; unsigned char* ws; int ph_lo, ph_hi; };
__global__ void __launch_bounds__(NTHREADS, 2) fwd_kernel(Args args) {
    extern __shared__ __attribute__((aligned(16))) unsigned char lds[];
    cg::grid_group grid = cg::this_grid();
    Frame F;
    F.lds = (LAS unsigned char*)lds; F.tid = threadIdx.x; F.lane = F.tid & 63; F.wave = __builtin_amdgcn_readfirstlane(F.tid >> 6);
    F.G = gridDim.x; { const int bx = blockIdx.x; F.vcu = (F.G % 8 == 0) ? (bx % 8) * (F.G / 8) + bx / 8 : bx; }
#pragma unroll
    for (int i = 0; i < 17; ++i) F.in[i] = args.in[i];
    F.out = args.out; F.ws = args.ws;
    const int lo = args.ph_lo, hi = args.ph_hi;
    if (F.tid < 16) ((volatile LAS unsigned*)(F.lds + MISC_OFF))[F.tid] = 0u;
    __syncthreads();
    XcdBarrier bar = xcd_barrier_post((unsigned*)(F.ws + WS_CTL) + CW_BAR, (volatile LAS unsigned*)(F.lds + MISC_OFF));
    if (lo > 1000) grid.sync();
#ifndef PHSEL
#define PHSEL 0xfff
#endif
#define IN(k) (((PHSEL >> (k)) & 1) && lo <= (k) && (k) < hi)
#define SEAM(k) do { if (IN(k) && IN((k) + 1)) xcd_barrier(bar); } while (0)
#ifndef REP_PH
#define REP_PH -1
#endif
#define REPS(k) for (int rep_ = 0; rep_ < ((k) == REP_PH ? 2 : 1); ++rep_, ((k) == REP_PH && rep_ < 2) ? xcd_barrier(bar) : (void)0)
    if (F.tid == 0) __hip_atomic_store((unsigned*)(F.ws + WS_CTL) + CW_XCC + blockIdx.x, (xb_xcc_id() & 15u) + 1u, __ATOMIC_RELAXED, __HIP_MEMORY_SCOPE_AGENT);
    if (IN(0)) REPS(0) { p0_prologue(F); } SEAM(0);
    if (F.tid < 32 && (F.G % 8 == 0) && IN(0) && IN(1)) {
        const int j = (int)(blockIdx.x & 7) + 8 * F.tid;
        if (j < F.G) { const unsigned other = __hip_atomic_load((unsigned*)(F.ws + WS_CTL) + CW_XCC + j, __ATOMIC_RELAXED, __HIP_MEMORY_SCOPE_AGENT);
            if (other != (xb_xcc_id() & 15u) + 1u) __hip_atomic_fetch_or((unsigned*)(F.ws + WS_CTL) + CW_XBAD, 1u, __ATOMIC_RELAXED, __HIP_MEMORY_SCOPE_AGENT); } }
    if (IN(1)) REPS(1) {
        pg8::Gemm gm{(const pg8::bf16_t*)(F.ws + WS_XN), (const pg8::bf16_t*)(F.ws + WS_WIN), TT, NPROJ, DMODEL / 2};
        pg8::StaticOrder S; S.init(TT, NPROJ, F.G, (int)blockIdx.x);
        EpiProj E{(bf16*)(F.ws + WS_QKVA), (bf16*)(F.ws + WS_ZA), (bf16*)(F.ws + WS_QKVB), (const float*)(F.ws + WS_WSI), (const float*)(F.ws + WS_XSC)};
        pg8::gemm_phase_gather<EpiProj, pg8::StaticOrder, IdRows, true, true>(F.lds, gm, S, E, IdRows{});
    } SEAM(1);
    if (IN(2)) REPS(2) {
#ifndef NO_ROPE
        p2_rope(F);
#ifdef PROBE_ROPE2
        xcd_barrier(bar); p2_rope(F);
#endif
#endif
#ifndef NO_PRE
        p2_gdn_pre(F);
#ifdef PROBE_PRE2
        xcd_barrier(bar); p2_gdn_pre(F);
#endif
#endif
    } SEAM(2);
    if (IN(3)) REPS(3) {
        const attn_body::AttnTensors AT{(const attn_body::bf16*)((unsigned char*)F.out + DO_QR), (const attn_body::bf16*)((unsigned char*)F.out + DO_KR), (const attn_body::bf16*)((unsigned char*)F.out + DO_VR),
                                        (attn_body::bf16*)(F.ws + WS_OCAT) + 512};
        const attn_body::StaticOrder S((int)F.G, (int)blockIdx.x);
#ifdef PROBE_ZERO_ATTN
        { (void)AT; (void)S; bf16* OC = (bf16*)(F.ws + WS_OCAT); const int gt = blockIdx.x * NTHREADS + F.tid, GT = F.G * NTHREADS;
          for (int i = gt; i < TT * 64; i += GT) { const int t = i >> 6, c = i & 63; *(v4u*)(OC + (size_t)t * 1024 + 512 + c * 8) = (v4u){0u, 0u, 0u, 0u}; } }
#else
        const float nshift = -(0.125f * 1.4426950408889634f * 64.f * 1.01f) * wave_max(fabsf(F.in[7][F.lane])) * wave_max(fabsf(F.in[8][F.lane]));
        attn_body::attn_phase<attn_body::StaticOrder>((char*)lds, AT, S, nshift);
#endif
    }
#if MK_PER_PHASE
    SEAM(3);
#endif
    if (IN(4)) { p4_pass1(F); xcd_barrier(bar); p4_pass3(F); } SEAM(4);
    if (IN(5)) REPS(5) { p5_combine(F); } SEAM(5);
    if (IN(6)) REPS(6) {
        pg8::Gemm gm{(const pg8::bf16_t*)(F.ws + WS_OCAT), (const pg8::bf16_t*)(F.ws + WS_WOUT), TT, DMODEL, DMODEL}; pg8::StaticOrder S; S.init(TT, DMODEL, F.G, (int)blockIdx.x);
        EpiResid E{F.in[0], (bf16*)(F.ws + WS_X1)};
        pg8::gemm_phase<EpiResid, pg8::StaticOrder, true, true>(F.lds, gm, S, E);
    } SEAM(6);
    if (IN(7)) { p7_route(F); } SEAM(7);
    const bool handoff = !MK_PER_PHASE && (F.G % 8 == 0) && IN(0) && IN(1) && IN(9) && IN(10) &&
        __builtin_amdgcn_readfirstlane(__hip_atomic_load((unsigned*)(F.ws + WS_CTL) + CW_XBAD, __ATOMIC_RELAXED, __HIP_MEMORY_SCOPE_AGENT)) == 0u;
    if (IN(9)) REPS(9) {
        build_etab(F);
        pg8::Gemm gm{(const pg8::bf16_t*)((unsigned char*)F.out + DO_HN), (const pg8::bf16_t*)(F.ws + WS_WGU0), 0, 0, DMODEL / 2};
        MoeOrder S{(const LAS unsigned*)(F.lds + ETAB_OFF), F.G, (int)blockIdx.x, WGU_SPLIT, (int)((WS_WGU1 - WS_WGU0) / (256 * 1024)), (mo_gu32*)((unsigned*)(F.ws + WS_CTL) + CW_HIDC), handoff ? 1 : 0, 0, -1};
        MoeRows AM{(const int*)(F.ws + WS_LIST), (const LAS unsigned*)(F.lds + ETAB_OFF)};
        EpiGU E{(bf16*)(F.ws + WS_HID), (const float*)(F.ws + WS_WSC), ((const LAS float*)(F.lds + ETAB_OFF))[352]};
        pg8::gemm_phase_gather<EpiGU, MoeOrder, MoeRows, true, true>(F.lds, gm, S, E, AM);
        S.flush();
    }
    if (!handoff) SEAM(9);
    if (IN(10)) REPS(10) {
        pg8::Gemm gm{(const pg8::bf16_t*)(F.ws + WS_HID), (const pg8::bf16_t*)((unsigned char*)F.out + DO_WD0), 0, 0, FFE}; build_etab(F);
        MoeOrder S{(const LAS unsigned*)(F.lds + ETAB_OFF), F.G, (int)blockIdx.x, WD_SPLIT, (int)((DO_WD1 - DO_WD0) / (256 * 1024)), (mo_gu32*)((unsigned*)(F.ws + WS_CTL) + CW_HIDC), handoff ? 2 : 0, 0, -1};
        if (handoff) S.rot = S.xcd_units() % (F.G >> 3);
        EpiY E{(bf16*)(F.ws + WS_XBUF)};
        pg8::gemm_phase<EpiY, MoeOrder, true, true>(F.lds, gm, S, E);
    } SEAM(10);
#ifdef EXTRA_SYNCS
    for (int q_ = 0; q_ < EXTRA_SYNCS; ++q_) xcd_barrier(bar);
#endif
    if (IN(11)) { p11_final(F); }
#undef IN
#undef SEAM
}

extern "C" void kernel_launch(void* const* d_in, const int* in_sizes, int n_in, void* d_out, int out_size, void* d_ws, size_t ws_size, hipStream_t stream) {
    static int grid = 0;
    if (grid == 0) {
        if (n_in != 17 || out_size != TT * DMODEL || ws_size < WS_END) { fprintf(stderr, "kernel_launch: unexpected problem (n_in %d out %d ws %zu)\n", n_in, out_size, ws_size); grid = -1; return; }
        int dev = 0, cus = 0, per_cu = 0;
        if (hipGetDevice(&dev) != hipSuccess || hipDeviceGetAttribute(&cus, hipDeviceAttributeMultiprocessorCount, dev) != hipSuccess) { grid = -1; return; }
        if (hipFuncSetAttribute((const void*)fwd_kernel, hipFuncAttributeMaxDynamicSharedMemorySize, LDS_BYTES) != hipSuccess) { fprintf(stderr, "hipFuncSetAttribute failed\n"); grid = -1; return; }
        if (hipOccupancyMaxActiveBlocksPerMultiprocessor(&per_cu, (const void*)fwd_kernel, NTHREADS, LDS_BYTES) != hipSuccess || per_cu < 1) { fprintf(stderr, "occupancy query: %d\n", per_cu); grid = -1; return; }
        if (cus < 256) { fprintf(stderr, "kernel_launch: %d CUs; the scan phase's task map needs 256 workgroups\n", cus); grid = -1; return; }
        grid = cus;
    }
    if (grid < 0) return;
    (void)hipMemsetAsync((char*)d_ws + WS_CTL, 0, CTL_ZERO_BYTES, stream);
    Args a{};
    for (int i = 0; i < 17; ++i) a.in[i] = (const float*)d_in[i];
    a.out = (float*)d_out; a.ws = (unsigned char*)d_ws;
#if MK_PER_PHASE
    for (int p = 0; p < N_PHASES; ++p) { a.ph_lo = p; a.ph_hi = p + 1; hipLaunchKernelGGL(fwd_kernel, dim3(grid), dim3(NTHREADS), LDS_BYTES, stream, a); }
#else
    a.ph_lo = 0; a.ph_hi = N_PHASES;
    void* kargs[] = {&a};
    hipError_t e = hipLaunchCooperativeKernel((void*)fwd_kernel, dim3(grid), dim3(NTHREADS), kargs, LDS_BYTES, stream);
    if (e != hipSuccess) fprintf(stderr, "cooperative launch failed: %s (grid %d)\n", hipGetErrorString(e), grid);
#endif
}
```

```cpp
#include <hip/hip_runtime.h>
#include <cstdio>
#include <cstdint>
namespace pg8 {
#define PG8_LAS __attribute__((address_space(3)))
typedef unsigned short bf16_t;
typedef short bf16x8 __attribute__((ext_vector_type(8)));
typedef float f32x4 __attribute__((ext_vector_type(4)));
typedef unsigned u32x4 __attribute__((ext_vector_type(4)));
constexpr int BM = 256, BK = 64, HALF = 128, HTB = HALF * BK * 2  , STAGE_BYTES = 8 * HTB, NXCD = 8, WGM = 8;

__host__ __device__ __forceinline__ int lds_byte(int r, int c) { const int st = (r >> 4) * 2 + (c >> 5), rr = r & 15, cc = c & 31, ob = rr * 64 + cc * 2; return st * 1024 + (ob ^ (((ob >> 9) & 1) << 5)); }
__host__ __device__ __forceinline__ void stage_rc(int b, int& R, int& C) { const int st = b / 1024, sb = b % 1024, swz = sb ^ (((sb >> 9) & 1) << 5); R = (st >> 1) * 16 + swz / 64; C = (st & 1) * 32 + (swz % 64) / 2; }
__host__ __device__ __forceinline__ int perm32(int rho) { const int n = rho >> 4, i = rho & 15; return 8 * (i >> 2) + 4 * n + (i & 3); }

struct Unit { int pm, pn, ex, tq; };
struct Gemm { const bf16_t* A; const bf16_t* Bt; int M, N, K; };

struct StaticOrder {
    int nM, nN, nwg, G, c;
    __host__ __device__ void init(int M, int N, int G_, int c_) { nM = M / BM; nN = N / BM; nwg = nM * nN; G = G_; c = c_; }
    __host__ __device__ bool next(int i, Unit& u) const {
        const long L = (long)i * G + c; if (L >= nwg) return false;
        int wgid = (int)L; { const int q = nwg / NXCD, r = nwg % NXCD, xcd = wgid % NXCD, off = wgid / NXCD; wgid = (xcd < r ? xcd * (q + 1) : r * (q + 1) + (xcd - r) * q) + off; }
        const int nig = WGM * nN, gid = wgid / nig, fm = gid * WGM, gsz = (nM - fm) < WGM ? (nM - fm) : WGM;
        u.pm = fm + ((wgid % nig) % gsz); u.pn = (wgid % nig) / gsz; return true;
    }
    __device__ __forceinline__ void a_ready(const Unit&) const {}
    __device__ __forceinline__ void done(const Unit&) const {}
};

__device__ __forceinline__ unsigned cvt_pk_bf16(float lo, float hi) { unsigned r; asm volatile("v_cvt_pk_bf16_f32 %0, %1, %2" : "=v"(r) : "v"(lo), "v"(hi)); return r; }
typedef float f32x2 __attribute__((ext_vector_type(2)));
template <class Epi, class Sched, bool ALIGN_EPI = false, bool SP2 = false>
__device__ __forceinline__ void gemm_phase(PG8_LAS unsigned char* lds, const Gemm g, const Sched& S, const Epi& E) {
    const int tid = threadIdx.x, wid = __builtin_amdgcn_readfirstlane(tid >> 6), lane = tid & 63, wr = wid >> 2, wc = wid & 3, fr = lane & 15, fq = lane >> 4;
    const int K = g.K, nt = K / BK;
    unsigned voffA[2], voffB[2];
#pragma unroll
    for (int i = 0; i < 2; ++i) { int R, C; stage_rc(tid * 16 + i * 8192, R, C); const int Rb = Epi::PERM ? ((R & ~31) + perm32(R & 31)) : R;
        voffA[i] = (unsigned)(R * K + C) * 2u; voffB[i] = (unsigned)(Rb * K + C) * 2u; }
    const size_t kstep = (size_t)(BK * 2);
    const size_t hstep = (size_t)HALF * K * 2;
    const size_t tstep = 2 * hstep;
    const unsigned ldsw = (unsigned)wid * 1024u;
    const int aoff = lds_byte(wr * 64 + fr, fq * 8), boff = lds_byte(wc * 32 + fr, fq * 8);
#define PG8_SA(b, h) (((b) * 2 + (h)) * HTB)
#define PG8_SB(b, h) ((4 + (b) * 2 + (h)) * HTB)
#define PG8_STAGE(bufoff, gbase, voff) do { _Pragma("unroll") for (int _i = 0; _i < 2; ++_i) \
        __builtin_amdgcn_global_load_lds((const unsigned*)((const char*)(gbase) + (voff)[_i]), (PG8_LAS unsigned*)(lds + (bufoff) + ldsw + _i * 8192), 16, 0, 0); } while (0)
#define PG8_LDA(dst, b, h) do { _Pragma("unroll") for (int m = 0; m < 4; ++m) _Pragma("unroll") for (int k = 0; k < 2; ++k) dst[m][k] = *(const PG8_LAS bf16x8*)(lds + PG8_SA(b, h) + aoff + m * 2048 + k * 1024); } while (0)
#define PG8_LDB(dst, b, h) do { _Pragma("unroll") for (int n = 0; n < 2; ++n) _Pragma("unroll") for (int k = 0; k < 2; ++k) dst[n][k] = *(const PG8_LAS bf16x8*)(lds + PG8_SB(b, h) + boff + n * 2048 + k * 1024); } while (0)
#define PG8_MMA(ai, bj, At, Bt) do { __builtin_amdgcn_s_setprio(1); _Pragma("unroll") for (int m = 0; m < 4; ++m) _Pragma("unroll") for (int n = 0; n < 2; ++n) _Pragma("unroll") for (int k = 0; k < 2; ++k) \
        acc[ai][bj][m][n] = __builtin_amdgcn_mfma_f32_16x16x32_bf16(Bt[n][k], At[m][k], acc[ai][bj][m][n], 0, 0, 0); __builtin_amdgcn_s_setprio(0); } while (0)
#define PG8_WAIT_V(n) asm volatile("s_waitcnt vmcnt(" #n ")" ::: "memory")
#define PG8_WAIT_L(n) asm volatile("s_waitcnt lgkmcnt(" #n ")" ::: "memory")
#define PG8_BAR __builtin_amdgcn_s_barrier()
#define PG8_SCHED __builtin_amdgcn_sched_barrier(0)
    Unit cur, nxt; int ui = 0;
    if (!S.next(0, cur)) return;
    f32x4 acc[2][2][4][2];
#pragma unroll
    for (int a = 0; a < 2; ++a)
#pragma unroll
        for (int b = 0; b < 2; ++b)
#pragma unroll
            for (int m = 0; m < 4; ++m)
#pragma unroll
                for (int n = 0; n < 2; ++n) acc[a][b][m][n] = (f32x4){0.f, 0.f, 0.f, 0.f};
    bf16x8 At[4][2], B0[2][2], B1[2][2];
    const char* cA = (const char*)g.A + (size_t)cur.pm * tstep; const char* cB = (const char*)g.Bt + (size_t)cur.pn * tstep;
    S.a_ready(cur);
    if constexpr (SP2) {
        PG8_STAGE(PG8_SB(0, 0), cB, voffB); PG8_STAGE(PG8_SB(0, 1), cB + hstep, voffB); PG8_STAGE(PG8_SA(0, 0), cA, voffA); PG8_STAGE(PG8_SA(0, 1), cA + hstep, voffA);
        if (wr == 1) PG8_BAR;
        PG8_WAIT_V(2); PG8_BAR;
        PG8_STAGE(PG8_SB(1, 0), cB + kstep, voffB); PG8_STAGE(PG8_SA(1, 0), cA + kstep, voffA); PG8_STAGE(PG8_SB(1, 1), cB + hstep + kstep, voffB);
        PG8_WAIT_V(6); PG8_BAR;
    } else {
        PG8_STAGE(PG8_SB(0, 0), cB, voffB); PG8_STAGE(PG8_SA(0, 0), cA, voffA); PG8_STAGE(PG8_SB(0, 1), cB + hstep, voffB); PG8_STAGE(PG8_SA(0, 1), cA + hstep, voffA);
        if (wr == 1) PG8_BAR;
        PG8_WAIT_V(4); PG8_BAR;
        PG8_STAGE(PG8_SB(1, 0), cB + kstep, voffB); PG8_STAGE(PG8_SA(1, 0), cA + kstep, voffA); PG8_STAGE(PG8_SB(1, 1), cB + hstep + kstep, voffB);
        PG8_WAIT_V(6); PG8_BAR;
    }
    for (;;) {
        const bool has_next = S.next(ui + 1, nxt);
        const char* nA = has_next ? (const char*)g.A + (size_t)nxt.pm * tstep : cA; const char* nB = has_next ? (const char*)g.Bt + (size_t)nxt.pn * tstep : cB;
        for (int t = 0; t < nt; t += 2) {
            const bool last = (t == nt - 2);
            const char* a1 = cA + (size_t)(t + 1) * kstep;
            const char* a2 = last ? nA : cA + (size_t)(t + 2) * kstep; const char* b2 = last ? nB : cB + (size_t)(t + 2) * kstep;
            const char* a3 = a2 + kstep; const char* b3 = b2 + kstep;
            if (last && has_next) S.a_ready(nxt);
            if constexpr (SP2) {
            PG8_LDB(B0, 0, 0); PG8_LDB(B1, 0, 1); PG8_SCHED; PG8_LDA(At, 0, 0); PG8_STAGE(PG8_SA(1, 1), a1 + hstep, voffA);
            PG8_WAIT_V(8); PG8_WAIT_L(0); PG8_BAR; PG8_MMA(0, 0, At, B0); PG8_MMA(0, 1, At, B1); PG8_BAR; PG8_SCHED;
            PG8_LDA(At, 0, 1); PG8_STAGE(PG8_SB(0, 0), b2, voffB); PG8_STAGE(PG8_SB(0, 1), b2 + hstep, voffB); PG8_STAGE(PG8_SA(0, 0), a2, voffA);
            PG8_WAIT_V(8); PG8_WAIT_L(0); PG8_BAR; PG8_MMA(1, 0, At, B0); PG8_MMA(1, 1, At, B1); PG8_BAR; PG8_SCHED;
            PG8_LDB(B0, 1, 0); PG8_LDB(B1, 1, 1); PG8_SCHED; PG8_LDA(At, 1, 0); PG8_STAGE(PG8_SA(0, 1), a2 + hstep, voffA);
            PG8_WAIT_V(8); PG8_WAIT_L(0); PG8_BAR; PG8_MMA(0, 0, At, B0); PG8_MMA(0, 1, At, B1); PG8_BAR; PG8_SCHED;
            PG8_LDA(At, 1, 1); PG8_STAGE(PG8_SB(1, 0), b3, voffB); PG8_STAGE(PG8_SB(1, 1), b3 + hstep, voffB); PG8_STAGE(PG8_SA(1, 0), a3, voffA);
            PG8_WAIT_V(8); PG8_WAIT_L(0); PG8_BAR; PG8_MMA(1, 0, At, B0); PG8_MMA(1, 1, At, B1); PG8_BAR; PG8_SCHED;
            } else {
            PG8_LDB(B0, 0, 0); PG8_SCHED; PG8_LDA(At, 0, 0); PG8_STAGE(PG8_SA(1, 1), a1 + hstep, voffA);
            PG8_WAIT_L(8); PG8_BAR; PG8_WAIT_L(0); PG8_MMA(0, 0, At, B0); PG8_BAR; PG8_SCHED;
            PG8_LDB(B1, 0, 1); PG8_STAGE(PG8_SB(0, 0), b2, voffB);
            PG8_BAR; PG8_WAIT_L(0); PG8_MMA(0, 1, At, B1); PG8_BAR;
            PG8_LDA(At, 0, 1); PG8_STAGE(PG8_SA(0, 0), a2, voffA);
            PG8_BAR; PG8_WAIT_L(0); PG8_MMA(1, 0, At, B0); PG8_BAR; PG8_SCHED;
            PG8_STAGE(PG8_SB(0, 1), b2 + hstep, voffB);
            PG8_WAIT_V(6); PG8_BAR; PG8_MMA(1, 1, At, B1); PG8_BAR;
            PG8_LDB(B0, 1, 0); PG8_SCHED; PG8_LDA(At, 1, 0); PG8_STAGE(PG8_SA(0, 1), a2 + hstep, voffA);
            PG8_WAIT_L(8); PG8_BAR; PG8_WAIT_L(0); PG8_MMA(0, 0, At, B0); PG8_BAR; PG8_SCHED;
            PG8_LDB(B1, 1, 1); PG8_STAGE(PG8_SB(1, 0), b3, voffB);
            PG8_BAR; PG8_WAIT_L(0); PG8_MMA(0, 1, At, B1); PG8_BAR;
            PG8_LDA(At, 1, 1); PG8_STAGE(PG8_SA(1, 0), a3, voffA);
            PG8_BAR; PG8_WAIT_L(0); PG8_MMA(1, 0, At, B0); PG8_BAR; PG8_SCHED;
            PG8_STAGE(PG8_SB(1, 1), b3 + hstep, voffB);
            PG8_WAIT_V(6); PG8_BAR; PG8_MMA(1, 1, At, B1); PG8_BAR;
            }
        }
        if constexpr (ALIGN_EPI) { if (wr == 0) PG8_BAR; }
        if constexpr (!Epi::AFTER_DRAIN) { E(acc, cur, wr, wc, fr, fq); S.done(cur); }
        if (!has_next) break;
#pragma unroll
        for (int a = 0; a < 2; ++a)
#pragma unroll
            for (int b = 0; b < 2; ++b)
#pragma unroll
                for (int m = 0; m < 4; ++m)
#pragma unroll
                    for (int n = 0; n < 2; ++n) acc[a][b][m][n] = (f32x4){0.f, 0.f, 0.f, 0.f};
        cur = nxt; cA = nA; cB = nB; ++ui;
        if constexpr (ALIGN_EPI) { if (wr == 1) PG8_BAR; }
    }
    PG8_WAIT_V(0);
    if constexpr (!ALIGN_EPI) { if (wr == 0) PG8_BAR; }
    PG8_BAR;
    if constexpr (Epi::AFTER_DRAIN) { E.fused(acc, cur, wr, wc, fr, fq, lds, wid, lane); S.done(cur); }
#undef PG8_SA
#undef PG8_SB
#undef PG8_STAGE
#undef PG8_LDA
#undef PG8_LDB
#undef PG8_MMA
#undef PG8_WAIT_V
#undef PG8_WAIT_L
#undef PG8_BAR
#undef PG8_SCHED
}
typedef int i32x4 __attribute__((ext_vector_type(4)));
template <bool I8> struct AccSel { typedef f32x4 type; };
template <> struct AccSel<true> { typedef i32x4 type; };
template <bool I8> __device__ __forceinline__ void mma_step(typename AccSel<I8>::type& c, const bf16x8& b, const bf16x8& a) {
    if constexpr (I8) c = __builtin_amdgcn_mfma_i32_16x16x64_i8(__builtin_bit_cast(i32x4, b), __builtin_bit_cast(i32x4, a), c, 0, 0, 0);
    else c = __builtin_amdgcn_mfma_f32_16x16x32_bf16(b, a, c, 0, 0, 0);
}
template <class Epi, class Sched, class AMap, bool ALIGN_EPI = false, bool I8 = false>
__device__ __forceinline__ void gemm_phase_gather(PG8_LAS unsigned char* lds, const Gemm g, const Sched& S, const Epi& E, const AMap& AM) {
    constexpr bool SP2 = true;
    const int tid = threadIdx.x, wid = __builtin_amdgcn_readfirstlane(tid >> 6), lane = tid & 63, wr = wid >> 2, wc = wid & 3, fr = lane & 15, fq = lane >> 4;
    const int K = g.K, nt = K / BK;
    unsigned voffA[2], voffB[2]; int rowA[2];
#pragma unroll
    for (int i = 0; i < 2; ++i) { int R, C; stage_rc(tid * 16 + i * 8192, R, C); const int Rb = Epi::PERM ? ((R & ~31) + perm32(R & 31)) : R;
        voffA[i] = (unsigned)C * 2u; voffB[i] = (unsigned)(Rb * K + C) * 2u; rowA[i] = R; }
    const size_t kstep = (size_t)(BK * 2);
    const size_t hstep = (size_t)HALF * K * 2;
    const size_t tstep = 2 * hstep;
    const unsigned ldsw = (unsigned)wid * 1024u;
    const int aoff = lds_byte(wr * 64 + fr, fq * 8), boff = lds_byte(wc * 32 + fr, fq * 8);
#define PG8_SA(b, h) (((b) * 2 + (h)) * HTB)
#define PG8_SB(b, h) ((4 + (b) * 2 + (h)) * HTB)
#define PG8_STAGE(bufoff, gbase, voff) do { _Pragma("unroll") for (int _i = 0; _i < 2; ++_i) \
        __builtin_amdgcn_global_load_lds((const unsigned*)((const char*)(gbase) + (voff)[_i]), (PG8_LAS unsigned*)(lds + (bufoff) + ldsw + _i * 8192), 16, 0, 0); } while (0)
#define PG8_LDA(dst, b, h) do { _Pragma("unroll") for (int m = 0; m < 4; ++m) _Pragma("unroll") for (int k = 0; k < 2; ++k) dst[m][k] = *(const PG8_LAS bf16x8*)(lds + PG8_SA(b, h) + aoff + m * 2048 + k * 1024); } while (0)
#define PG8_LDB(dst, b, h) do { _Pragma("unroll") for (int n = 0; n < 2; ++n) _Pragma("unroll") for (int k = 0; k < 2; ++k) dst[n][k] = *(const PG8_LAS bf16x8*)(lds + PG8_SB(b, h) + boff + n * 2048 + k * 1024); } while (0)
#define PG8_MMA(ai, bj, At, Bt) do { __builtin_amdgcn_s_setprio(1); _Pragma("unroll") for (int m = 0; m < 4; ++m) _Pragma("unroll") for (int n = 0; n < 2; ++n) _Pragma("unroll") for (int k = 0; k < 2; ++k) \
        mma_step<I8>(acc[ai][bj][m][n], Bt[n][k], At[m][k]); __builtin_amdgcn_s_setprio(0); } while (0)
#define PG8_WAIT_V(n) asm volatile("s_waitcnt vmcnt(" #n ")" ::: "memory")
#define PG8_WAIT_L(n) asm volatile("s_waitcnt lgkmcnt(" #n ")" ::: "memory")
#define PG8_BAR __builtin_amdgcn_s_barrier()
#define PG8_SCHED __builtin_amdgcn_sched_barrier(0)
    Unit cur, nxt; int ui = 0;
    if (!S.next(0, cur)) return;
    typedef typename AccSel<I8>::type acc_t;
    acc_t acc[2][2][4][2];
#pragma unroll
    for (int a = 0; a < 2; ++a)
#pragma unroll
        for (int b = 0; b < 2; ++b)
#pragma unroll
            for (int m = 0; m < 4; ++m)
#pragma unroll
                for (int n = 0; n < 2; ++n) acc[a][b][m][n] = (acc_t){0, 0, 0, 0};
    bf16x8 At[4][2], B0[2][2], B1[2][2];
    const char* cA = (const char*)g.A; const char* cB = (const char*)g.Bt + (size_t)cur.pn * tstep;
    unsigned vA0[2], vA1[2], nA0[2], nA1[2];
#pragma unroll
    for (int i = 0; i < 2; ++i) { vA0[i] = (unsigned)AM.row(cur, rowA[i]) * (unsigned)(K * 2) + voffA[i]; vA1[i] = (unsigned)AM.row(cur, HALF + rowA[i]) * (unsigned)(K * 2) + voffA[i]; }
    S.a_ready(cur);
    if constexpr (SP2) {
        PG8_STAGE(PG8_SB(0, 0), cB, voffB); PG8_STAGE(PG8_SB(0, 1), cB + hstep, voffB); PG8_STAGE(PG8_SA(0, 0), cA, vA0); PG8_STAGE(PG8_SA(0, 1), cA, vA1);
        if (wr == 1) PG8_BAR;
        PG8_WAIT_V(2); PG8_BAR;
        PG8_STAGE(PG8_SB(1, 0), cB + kstep, voffB); PG8_STAGE(PG8_SA(1, 0), cA + kstep, vA0); PG8_STAGE(PG8_SB(1, 1), cB + hstep + kstep, voffB);
        PG8_WAIT_V(6); PG8_BAR;
    } else {
        PG8_STAGE(PG8_SB(0, 0), cB, voffB); PG8_STAGE(PG8_SA(0, 0), cA, voffA); PG8_STAGE(PG8_SB(0, 1), cB + hstep, voffB); PG8_STAGE(PG8_SA(0, 1), cA + hstep, voffA);
        if (wr == 1) PG8_BAR;
        PG8_WAIT_V(4); PG8_BAR;
        PG8_STAGE(PG8_SB(1, 0), cB + kstep, voffB); PG8_STAGE(PG8_SA(1, 0), cA + kstep, voffA); PG8_STAGE(PG8_SB(1, 1), cB + hstep + kstep, voffB);
        PG8_WAIT_V(6); PG8_BAR;
    }
    for (;;) {
        const bool has_next = S.next(ui + 1, nxt);
        const char* nA = cA; const char* nB = has_next ? (const char*)g.Bt + (size_t)nxt.pn * tstep : cB;
#pragma unroll
        for (int i = 0; i < 2; ++i) { nA0[i] = has_next ? (unsigned)AM.row(nxt, rowA[i]) * (unsigned)(K * 2) + voffA[i] : vA0[i]; nA1[i] = has_next ? (unsigned)AM.row(nxt, HALF + rowA[i]) * (unsigned)(K * 2) + voffA[i] : vA1[i]; }
        for (int t = 0; t < nt; t += 2) {
            const bool last = (t == nt - 2);
            const char* a1 = cA + (size_t)(t + 1) * kstep;
            const char* a2 = last ? nA : cA + (size_t)(t + 2) * kstep; const char* b2 = last ? nB : cB + (size_t)(t + 2) * kstep;
            const char* a3 = a2 + kstep; const char* b3 = b2 + kstep;
            unsigned s0[2], s1[2];
#pragma unroll
            for (int i = 0; i < 2; ++i) { s0[i] = vA0[i]; s1[i] = vA1[i]; }
            if (last) {
#pragma unroll
                for (int i = 0; i < 2; ++i) { unsigned t0_ = nA0[i], t1_ = nA1[i]; asm volatile("" : "+v"(t0_), "+v"(t1_)); s0[i] = t0_; s1[i] = t1_; } }
            if (last && has_next) S.a_ready(nxt);
            if constexpr (SP2) {
            PG8_LDB(B0, 0, 0); PG8_LDB(B1, 0, 1); PG8_SCHED; PG8_LDA(At, 0, 0); PG8_STAGE(PG8_SA(1, 1), a1, vA1);
            PG8_WAIT_V(8); PG8_WAIT_L(0); PG8_BAR; PG8_MMA(0, 0, At, B0); PG8_MMA(0, 1, At, B1); PG8_BAR; PG8_SCHED;
            PG8_LDA(At, 0, 1); PG8_STAGE(PG8_SB(0, 0), b2, voffB); PG8_STAGE(PG8_SB(0, 1), b2 + hstep, voffB); PG8_STAGE(PG8_SA(0, 0), a2, s0);
            PG8_WAIT_V(8); PG8_WAIT_L(0); PG8_BAR; PG8_MMA(1, 0, At, B0); PG8_MMA(1, 1, At, B1); PG8_BAR; PG8_SCHED;
            PG8_LDB(B0, 1, 0); PG8_LDB(B1, 1, 1); PG8_SCHED; PG8_LDA(At, 1, 0); PG8_STAGE(PG8_SA(0, 1), a2, s1);
            PG8_WAIT_V(8); PG8_WAIT_L(0); PG8_BAR; PG8_MMA(0, 0, At, B0); PG8_MMA(0, 1, At, B1); PG8_BAR; PG8_SCHED;
            PG8_LDA(At, 1, 1); PG8_STAGE(PG8_SB(1, 0), b3, voffB); PG8_STAGE(PG8_SB(1, 1), b3 + hstep, voffB); PG8_STAGE(PG8_SA(1, 0), a3, s0);
            PG8_WAIT_V(8); PG8_WAIT_L(0); PG8_BAR; PG8_MMA(1, 0, At, B0); PG8_MMA(1, 1, At, B1); PG8_BAR; PG8_SCHED;
            } else {
            PG8_LDB(B0, 0, 0); PG8_SCHED; PG8_LDA(At, 0, 0); PG8_STAGE(PG8_SA(1, 1), a1 + hstep, voffA);
            PG8_WAIT_L(8); PG8_BAR; PG8_WAIT_L(0); PG8_MMA(0, 0, At, B0); PG8_BAR; PG8_SCHED;
            PG8_LDB(B1, 0, 1); PG8_STAGE(PG8_SB(0, 0), b2, voffB);
            PG8_BAR; PG8_WAIT_L(0); PG8_MMA(0, 1, At, B1); PG8_BAR;
            PG8_LDA(At, 0, 1); PG8_STAGE(PG8_SA(0, 0), a2, voffA);
            PG8_BAR; PG8_WAIT_L(0); PG8_MMA(1, 0, At, B0); PG8_BAR; PG8_SCHED;
            PG8_STAGE(PG8_SB(0, 1), b2 + hstep, voffB);
            PG8_WAIT_V(6); PG8_BAR; PG8_MMA(1, 1, At, B1); PG8_BAR;
            PG8_LDB(B0, 1, 0); PG8_SCHED; PG8_LDA(At, 1, 0); PG8_STAGE(PG8_SA(0, 1), a2 + hstep, voffA);
            PG8_WAIT_L(8); PG8_BAR; PG8_WAIT_L(0); PG8_MMA(0, 0, At, B0); PG8_BAR; PG8_SCHED;
            PG8_LDB(B1, 1, 1); PG8_STAGE(PG8_SB(1, 0), b3, voffB);
            PG8_BAR; PG8_WAIT_L(0); PG8_MMA(0, 1, At, B1); PG8_BAR;
            PG8_LDA(At, 1, 1); PG8_STAGE(PG8_SA(1, 0), a3, voffA);
            PG8_BAR; PG8_WAIT_L(0); PG8_MMA(1, 0, At, B0); PG8_BAR; PG8_SCHED;
            PG8_STAGE(PG8_SB(1, 1), b3 + hstep, voffB);
            PG8_WAIT_V(6); PG8_BAR; PG8_MMA(1, 1, At, B1); PG8_BAR;
            }
        }
        if constexpr (ALIGN_EPI) { if (wr == 0) PG8_BAR; }
        if constexpr (!Epi::AFTER_DRAIN) { E(acc, cur, wr, wc, fr, fq); S.done(cur); }
        if (!has_next) break;
#pragma unroll
        for (int a = 0; a < 2; ++a)
#pragma unroll
            for (int b = 0; b < 2; ++b)
#pragma unroll
                for (int m = 0; m < 4; ++m)
#pragma unroll
                    for (int n = 0; n < 2; ++n) acc[a][b][m][n] = (acc_t){0, 0, 0, 0};
        cur = nxt; cA = nA; cB = nB; ++ui;
#pragma unroll
        for (int i = 0; i < 2; ++i) { vA0[i] = nA0[i]; vA1[i] = nA1[i]; }
        if constexpr (ALIGN_EPI) { if (wr == 1) PG8_BAR; }
    }
    PG8_WAIT_V(0);
    if constexpr (!ALIGN_EPI) { if (wr == 0) PG8_BAR; }
    PG8_BAR;
    if constexpr (Epi::AFTER_DRAIN) { E.fused(acc, cur, wr, wc, fr, fq, lds, wid, lane); S.done(cur); }
#undef PG8_SA
#undef PG8_SB
#undef PG8_STAGE
#undef PG8_LDA
#undef PG8_LDB
#undef PG8_MMA
#undef PG8_WAIT_V
#undef PG8_WAIT_L
#undef PG8_BAR
#undef PG8_SCHED
}
}
#include <hip/hip_bf16.h>
#include <cmath>
namespace attn_body {
using bf16=__hip_bfloat16;
using bf16x8=__attribute__((ext_vector_type(8)))short;
using s16x4=__attribute__((ext_vector_type(4)))short;
using f32x16=__attribute__((ext_vector_type(16)))float;
using u32x4=__attribute__((ext_vector_type(4)))unsigned;
constexpr int BATCH=2,NHEAD=8,NKVH=2,SEQ=8192,D=64,QP=512,KP=128,OP=1024;
constexpr int NW=8,QBLK=32,QB=QBLK*NW,KVBLK=64,NQB=SEQ/QB;
constexpr int ATTN_UNIT_ROWS=QB;
__device__ __forceinline__ int crow(int r,int hi){return (r&3)+8*(r>>2)+4*hi;}
#define SBAR() __builtin_amdgcn_sched_barrier(0)
__device__ __forceinline__ void cmask(f32x16&p0,f32x16&p1,int jb,int qrel,int hi){
  const float NEG=-INFINITY; int kb=64*jb+4*hi;
  #pragma unroll
  for(int r=0;r<16;++r){int kv=kb+(r&3)+8*(r>>2); if(kv>qrel)p0[r]=NEG; if(kv+32>qrel)p1[r]=NEG;}
}

constexpr int NSLOT=3, SLOTB=8192;
constexpr int LDS_K=0, LDS_V=NSLOT*SLOTB, LDS_WS=2*NSLOT*SLOTB, LDS_OST=LDS_WS+NW*64*4, LDS_BYTES=LDS_OST+NW*4096;
constexpr float C2=0.125f*1.4426950408889634f;
__device__ __forceinline__ void glds16(const void*gsrc,unsigned lds_dst){unsigned keep;
  asm volatile("s_mov_b32 %0, m0\n\ts_mov_b32 m0, %2\n\ts_nop 0\n\tglobal_load_lds_dwordx4 %1, off\n\ts_mov_b32 m0, %0":"=&s"(keep):"v"(gsrc),"s"(lds_dst):"memory");}
__device__ __forceinline__ float max3f(float a,float b,float c){float r;asm("v_max3_f32 %0, %1, %2, %3":"=v"(r):"v"(a),"v"(b),"v"(c));return r;}
__device__ __forceinline__ float max2f(float a,float b){float r;asm("v_max_f32_e32 %0, %1, %2":"=v"(r):"v"(a),"v"(b));return r;}
__device__ __forceinline__ float fadd_s(float a,float b){float r;asm("v_add_f32_e32 %0, %1, %2":"=v"(r):"v"(a),"v"(b));return r;}
__device__ __forceinline__ float fsub_s(float a,float b){float r;asm("v_sub_f32_e32 %0, %1, %2":"=v"(r):"v"(a),"v"(b));return r;}
typedef float f32x2_t __attribute__((ext_vector_type(2))); typedef __bf16 bf16x2_t __attribute__((ext_vector_type(2)));
__device__ __forceinline__ unsigned cvtpk_s(float lo,float hi){f32x2_t v={lo,hi};bf16x2_t b=__builtin_convertvector(v,bf16x2_t);return __builtin_bit_cast(unsigned,b);}
#define WAIT_BAR(N) asm volatile("s_waitcnt vmcnt(" #N ") lgkmcnt(0)\n\ts_barrier":::"memory")

__device__ __forceinline__ void qkt(f32x16&p0,f32x16&p1,const char*Kslot,const bf16x8*qr,const f32x16&negm,int r32,int hi){
  const char*kb=Kslot+hi*1024+r32*16;
  #pragma unroll
  for(int d0=0;d0<4;++d0){
    const bf16x8 b0=*reinterpret_cast<const bf16x8*>(kb+d0*2048);
    const bf16x8 b1=*reinterpret_cast<const bf16x8*>(kb+d0*2048+512);
    if(d0==0){p0=__builtin_amdgcn_mfma_f32_32x32x16_bf16(b0,qr[0],negm,0,0,0);p1=__builtin_amdgcn_mfma_f32_32x32x16_bf16(b1,qr[0],negm,0,0,0);}
    else{p0=__builtin_amdgcn_mfma_f32_32x32x16_bf16(b0,qr[d0],p0,0,0,0);p1=__builtin_amdgcn_mfma_f32_32x32x16_bf16(b1,qr[d0],p1,0,0,0);}}
}
typedef __attribute__((address_space(3))) const char* lds_cptr;
typedef short v4i16_t __attribute__((ext_vector_type(4)));
__device__ __forceinline__ void kload8(bf16x8*kf,lds_cptr kp){
  kf[0]=*(const __attribute__((address_space(3))) bf16x8*)(kp);      kf[1]=*(const __attribute__((address_space(3))) bf16x8*)(kp+512);
  kf[2]=*(const __attribute__((address_space(3))) bf16x8*)(kp+2048); kf[3]=*(const __attribute__((address_space(3))) bf16x8*)(kp+2560);
  kf[4]=*(const __attribute__((address_space(3))) bf16x8*)(kp+4096); kf[5]=*(const __attribute__((address_space(3))) bf16x8*)(kp+4608);
  kf[6]=*(const __attribute__((address_space(3))) bf16x8*)(kp+6144); kf[7]=*(const __attribute__((address_space(3))) bf16x8*)(kp+6656);
}
__device__ __forceinline__ void kload2(bf16x8*kf,lds_cptr kp,int j){ kf[2*j]=*(const __attribute__((address_space(3))) bf16x8*)(kp+j*2048); kf[2*j+1]=*(const __attribute__((address_space(3))) bf16x8*)(kp+j*2048+512); }
__device__ __forceinline__ s16x4 vtr(lds_cptr p){ return __builtin_bit_cast(s16x4,__builtin_amdgcn_ds_read_tr16_b64_v4i16((__attribute__((address_space(3))) v4i16_t*)p)); }
__device__ __forceinline__ float rowmax(const f32x16&p0,const f32x16&p1){
  float a=max3f(p0[0],p0[1],p1[0]),b=max3f(p0[2],p0[3],p1[1]);a=max3f(a,p1[2],p1[3]);
  #pragma unroll
  for(int r=4;r<16;r+=4){a=max3f(a,p0[r],p0[r+1]);b=max3f(b,p0[r+2],p0[r+3]);a=max3f(a,p1[r],p1[r+1]);b=max3f(b,p1[r+2],p1[r+3]);}
  const float m=max2f(a,b);
  auto rr=__builtin_amdgcn_permlane32_swap(__float_as_uint(m),__float_as_uint(m),false,false);
  return max2f(__uint_as_float(rr[0]),__uint_as_float(rr[1]));
}
__device__ __forceinline__ void pv(f32x16*o,int vb,bf16x8 pa0,bf16x8 pa1,bf16x8 pa2,bf16x8 pa3){
  #pragma unroll
  for(int d0=0;d0<2;++d0){s16x4 lo[4],hi[4];
    #pragma unroll
    for(int ks=0;ks<4;++ks){
      asm volatile("ds_read_b64_tr_b16 %0,%1 offset:%c2":"=&v"(lo[ks]):"v"(vb),"i"(d0*4096+ks*1024):"memory");
      asm volatile("ds_read_b64_tr_b16 %0,%1 offset:%c2":"=&v"(hi[ks]):"v"(vb),"i"(d0*4096+ks*1024+512):"memory");}
    asm volatile("s_waitcnt lgkmcnt(0)":::"memory");SBAR();
    #define PK(k) (bf16x8){lo[k][0],lo[k][1],lo[k][2],lo[k][3],hi[k][0],hi[k][1],hi[k][2],hi[k][3]}
    o[d0]=__builtin_amdgcn_mfma_f32_32x32x16_bf16(pa0,PK(0),o[d0],0,0,0);
    o[d0]=__builtin_amdgcn_mfma_f32_32x32x16_bf16(pa1,PK(1),o[d0],0,0,0);
    o[d0]=__builtin_amdgcn_mfma_f32_32x32x16_bf16(pa2,PK(2),o[d0],0,0,0);
    o[d0]=__builtin_amdgcn_mfma_f32_32x32x16_bf16(pa3,PK(3),o[d0],0,0,0);
    #undef PK
  }
}

#ifndef ATTN_STORE16
#define ATTN_STORE16(p,v) (*(u32x4*)(p)=(v))
#endif
template<int THRL> __device__ __forceinline__ void attn_unit(int b,int h,int qb,const bf16*Q,const bf16*__restrict__ K,const bf16*__restrict__ V,bf16*O,char*shm,const float nshift){
  const int tid=threadIdx.x,lane=tid&63,r32=lane&31,hi=lane>>5; const int wid=__builtin_amdgcn_readfirstlane(tid>>6);
  const long rowbase=(long)b*SEQ; const int q0=qb*QB;
  const bf16*Qw=Q+(rowbase+q0+wid*QBLK)*QP+h*D;
  const int hk=h/(NHEAD/NKVH); const bf16*Kh=K+(long)(b*NKVH+hk)*SEQ*D,*Vh=V+(long)(b*NKVH+hk)*SEQ*D;
  const unsigned lds0=(unsigned)(uintptr_t)shm;
  float*wsf=(float*)(shm+LDS_WS)+wid*64;
  const bf16*ksrc=Kh+(wid*64+lane)*8;
  const bf16*vsrc=Vh+(wid*64+lane)*8;
  const unsigned kdst=lds0+LDS_K+wid*1024, vdst=lds0+LDS_V+wid*1024;
  #define DMA_K(t,slot) glds16(ksrc+(long)(t)*KVBLK*D,(unsigned)__builtin_amdgcn_readfirstlane(kdst+(slot)))
  #define DMA_V(t,slot) glds16(vsrc+(long)(t)*KVBLK*D,(unsigned)__builtin_amdgcn_readfirstlane(vdst+(slot)))
  const int vb0=(int)(lds0+LDS_V)+((lane>>4)&1)*32+(lane&3)*8+(4*hi+((lane&15)>>2))*64;
  const char*Kbase=shm+LDS_K; bf16x8 kf[8];
  const lds_cptr shm3=(lds_cptr)shm; const lds_cptr kp0=shm3+LDS_K+hi*1024+r32*16; const lds_cptr vp0=shm3+LDS_V+((lane>>4)&1)*32+(lane&3)*8+(4*hi+((lane&15)>>2))*64;
  constexpr int NT=SEQ/KVBLK;
  DMA_K(0,0);DMA_V(0,0);DMA_K(1,SLOTB);
  bf16x8 qr[4];
  #pragma unroll
  for(int d0=0;d0<4;++d0)qr[d0]=*reinterpret_cast<const bf16x8*>(&Qw[(long)r32*QP+d0*16+hi*8]);
  float l_reg=0.f;f32x16 o[2];o[0]=f32x16{};o[1]=f32x16{};f32x16 negm;
  _Pragma("unroll") for(int r=0;r<16;++r)negm[r]=nshift; asm volatile("":"+v"(negm));
  const int qrel=wid*QBLK+r32;
  #define CMASK(P0,P1,t) do{}while(0)
  #define START(P0,P1) do{ _Pragma("unroll") for(int r=0;r<16;++r)P0[r]=__builtin_amdgcn_exp2f(P0[r]); }while(0)
  f32x16 pA0,pA1,pB0,pB1;
  int sl_prev=0,sl_cur=0,sl_next=SLOTB;
  #define ROT() do{sl_prev=sl_cur;sl_cur=sl_next;sl_next=(sl_next==(NSLOT-1)*SLOTB)?0:sl_next+SLOTB;}while(0)
  DMA_K(2,2*SLOTB);
  WAIT_BAR(3);
  qkt(pA0,pA1,Kbase,qr,negm,r32,hi);asm volatile("s_nop 15\n\ts_nop 7":"+v"(pA0),"+v"(pA1));CMASK(pA0,pA1,0);
  START(pA0,pA1);
  _Pragma("unroll") for(int r=0;r<16;++r)pA1[r]=__builtin_amdgcn_exp2f(pA1[r]);
  WAIT_BAR(0);
  DMA_K(3,0);DMA_V(1,SLOTB);
  ROT();
  kload8(kf,kp0+sl_cur);
  WAIT_BAR(2);
  s16x4 vlo[8],vhi[8]; u32x4 pw0,pw1,pw2,pw3;
  #define PKW(P,B) cvtpk_s(P[B],P[B+1])
  #define PAF(k) __builtin_bit_cast(bf16x8,pw##k)
  #define VFR(i) (bf16x8){vlo[i][0],vlo[i][1],vlo[i][2],vlo[i][3],vhi[i][0],vhi[i][1],vhi[i][2],vhi[i][3]}
  #define PIN(x) asm volatile("":"+v"(x))
  #define GAPA(MF,A0,A1,A2,A3,W0,W1,PW) do{ MF; sacc+=A0; sacc+=A1; sacc+=A2; sacc+=A3; PIN(sacc); W0; W1; PIN(PW); SBAR(); }while(0)
  #define EX(v) __builtin_amdgcn_exp2f(v)
  #define GAPB(MF,X,B) do{ MF; X[B]=EX(X[B]); X[B+1]=EX(X[B+1]); X[B+2]=EX(X[B+2]); X[B+3]=EX(X[B+3]); PIN(X); SBAR(); }while(0)
  #define VRD(i) do{ vlo[i]=vtr(vp_+(((i)>>2)*4096+((i)&3)*1024)); vhi[i]=vtr(vp_+(((i)>>2)*4096+((i)&3)*1024+512)); }while(0)
  #define KRD(G,j) do{ if(G){ kload2(kf,kp0+sl_next,j); SBAR(); } }while(0)
  #define STEP(C0,C1,P0,P1,t,GK,GV,GL) do{ SBAR(); \
    const lds_cptr vp_=vp0+sl_prev; \
    VRD(0); SBAR(); float sacc=(P0[0]+P0[1]); \
    GAPA(C0=__builtin_amdgcn_mfma_f32_32x32x16_bf16(kf[0],qr[0],negm,0,0,0), P0[2],P0[3],P0[4],P0[5],     pw0[0]=PKW(P0,0), pw0[1]=PKW(P0,2), pw0); \
    VRD(4); SBAR(); GAPA(C1=__builtin_amdgcn_mfma_f32_32x32x16_bf16(kf[1],qr[0],negm,0,0,0), P0[6],P0[7],P0[8],P0[9],     pw0[2]=PKW(P0,4), pw0[3]=PKW(P0,6), pw0); \
    VRD(1); SBAR(); GAPA(C0=__builtin_amdgcn_mfma_f32_32x32x16_bf16(kf[2],qr[1],C0,0,0,0),   P0[10],P0[11],P0[12],P0[13], pw1[0]=PKW(P0,8), pw1[1]=PKW(P0,10), pw1); \
    VRD(5); SBAR(); GAPA(C1=__builtin_amdgcn_mfma_f32_32x32x16_bf16(kf[3],qr[1],C1,0,0,0),   P0[14],P0[15],P1[0],P1[1],   pw1[2]=PKW(P0,12),pw1[3]=PKW(P0,14), pw1); \
    VRD(2); SBAR(); GAPA(C0=__builtin_amdgcn_mfma_f32_32x32x16_bf16(kf[4],qr[2],C0,0,0,0),   P1[2],P1[3],P1[4],P1[5],     pw2[0]=PKW(P1,0), pw2[1]=PKW(P1,2), pw2); \
    VRD(6); SBAR(); GAPA(C1=__builtin_amdgcn_mfma_f32_32x32x16_bf16(kf[5],qr[2],C1,0,0,0),   P1[6],P1[7],P1[8],P1[9],     pw2[2]=PKW(P1,4), pw2[3]=PKW(P1,6), pw2); \
    VRD(3); SBAR(); GAPA(C0=__builtin_amdgcn_mfma_f32_32x32x16_bf16(kf[6],qr[3],C0,0,0,0),   P1[10],P1[11],P1[12],P1[13], pw3[0]=PKW(P1,8), pw3[1]=PKW(P1,10), pw3); \
    VRD(7); SBAR(); GAPA(C1=__builtin_amdgcn_mfma_f32_32x32x16_bf16(kf[7],qr[3],C1,0,0,0),   P1[14],P1[15],0.f,0.f,       pw3[2]=PKW(P1,12),pw3[3]=PKW(P1,14), pw3); \
    l_reg+=sacc; \
    if(GK){DMA_K((t)+3,sl_cur);} if(GV){DMA_V((t)+1,sl_next);} \
    CMASK(C0,C1,t); \
    SBAR(); \
    GAPB(o[0]=__builtin_amdgcn_mfma_f32_32x32x16_bf16(PAF(0),VFR(0),o[0],0,0,0), C0,0); \
    GAPB(o[1]=__builtin_amdgcn_mfma_f32_32x32x16_bf16(PAF(0),VFR(4),o[1],0,0,0), C0,4); \
    KRD(GL,0); GAPB(o[0]=__builtin_amdgcn_mfma_f32_32x32x16_bf16(PAF(1),VFR(1),o[0],0,0,0), C0,8); \
    KRD(GL,1); GAPB(o[1]=__builtin_amdgcn_mfma_f32_32x32x16_bf16(PAF(1),VFR(5),o[1],0,0,0), C0,12); \
    KRD(GL,2); GAPB(o[0]=__builtin_amdgcn_mfma_f32_32x32x16_bf16(PAF(2),VFR(2),o[0],0,0,0), C1,0); \
    KRD(GL,3); GAPB(o[1]=__builtin_amdgcn_mfma_f32_32x32x16_bf16(PAF(2),VFR(6),o[1],0,0,0), C1,4); \
    GAPB(o[0]=__builtin_amdgcn_mfma_f32_32x32x16_bf16(PAF(3),VFR(3),o[0],0,0,0), C1,8); \
    GAPB(o[1]=__builtin_amdgcn_mfma_f32_32x32x16_bf16(PAF(3),VFR(7),o[1],0,0,0), C1,12); \
    }while(0)
  int t=1;
  #undef CMASK
  #define CMASK(P0,P1,t) do{}while(0)
  for(;t+5<NT;t+=2){
    STEP(pB0,pB1,pA0,pA1,t,true,true,true);     WAIT_BAR(2); ROT();
    STEP(pA0,pA1,pB0,pB1,t+1,true,true,true);   WAIT_BAR(2); ROT();
  }
  #undef CMASK
  #define CMASK(P0,P1,t) do{}while(0)
  #define ENDW(tt) do{ if((tt)+3<NT){WAIT_BAR(2);} else if((tt)+2<NT){WAIT_BAR(1);} else {WAIT_BAR(0);} }while(0)
  for(;t+1<NT;t+=2){
    STEP(pB0,pB1,pA0,pA1,t,(t+3<NT),(t+1<NT),(t+1<NT));       ENDW(t);   ROT();
    STEP(pA0,pA1,pB0,pB1,t+1,(t+4<NT),(t+2<NT),(t+2<NT));     ENDW(t+1); ROT();
  }
  STEP(pB0,pB1,pA0,pA1,NT-1,false,false,false);
  { float sacc=pB0[0]+pB0[1]; _Pragma("unroll") for(int r=2;r<16;++r)sacc+=pB0[r]; _Pragma("unroll") for(int r=0;r<16;++r)sacc+=pB1[r]; l_reg+=sacc;
    pw0=(u32x4){PKW(pB0,0),PKW(pB0,2),PKW(pB0,4),PKW(pB0,6)};pw1=(u32x4){PKW(pB0,8),PKW(pB0,10),PKW(pB0,12),PKW(pB0,14)};pw2=(u32x4){PKW(pB1,0),PKW(pB1,2),PKW(pB1,4),PKW(pB1,6)};pw3=(u32x4){PKW(pB1,8),PKW(pB1,10),PKW(pB1,12),PKW(pB1,14)};
    SBAR(); pv(o,vb0+sl_cur,PAF(0),PAF(1),PAF(2),PAF(3)); }
  #undef PKW
  #undef PAF
  #undef VFR
  #undef PIN
  #undef GAPA
  #undef GAPB
  #undef EX
  #undef VRD
  #undef KRD
  #undef STEP
  #undef ENDW
  {auto rr=__builtin_amdgcn_permlane32_swap(__float_as_uint(l_reg),__float_as_uint(l_reg),false,false);l_reg=__uint_as_float(rr[0])+__uint_as_float(rr[1]);}
  if(hi==0)wsf[32+r32]=l_reg;asm volatile("s_waitcnt lgkmcnt(0)":::"memory");
  float rli[16];
  #pragma unroll
  for(int r=0;r<16;++r)rli[r]=__builtin_amdgcn_rcpf(wsf[32+crow(r,hi)]);
  bf16*Ow=O+(rowbase+q0+wid*QBLK)*OP+h*D;
  { bf16*stg=(bf16*)(shm+LDS_OST)+wid*2048;
    #pragma unroll
    for(int r=0;r<16;++r){const int orow=crow(r,hi);
      #pragma unroll
      for(int d0=0;d0<2;++d0)stg[orow*64+d0*32+r32]=__float2bfloat16(o[d0][r]*rli[r]);}
    asm volatile("s_waitcnt lgkmcnt(0)":::"memory");
    #pragma unroll
    for(int i=0;i<4;++i){const int row=i*8+(lane>>3),ch=lane&7; const u32x4 v=*(const u32x4*)(stg+row*64+ch*8); ATTN_STORE16(Ow+(long)row*OP+ch*8,v);} }
  asm volatile("s_waitcnt lgkmcnt(0)\n\ts_barrier":::"memory");
  #undef DMA_K
  #undef DMA_V
  #undef CMASK
  #undef START
  #undef ROT
}
constexpr int ATTN_LDS_BYTES=LDS_BYTES;
struct AttnTensors { const bf16* Q; const bf16* K; const bf16* V; bf16* O; };
struct AttnUnit { int bh; int qb; };
struct StaticOrder {
  int vcu, G;
  __device__ __forceinline__ explicit StaticOrder(int grid,int block):vcu((grid%8==0)?(block%8)*(grid/8)+block/8:block),G(grid){}
  __device__ __forceinline__ bool next(int i,AttnUnit&u)const{
    const int L=i*G+vcu; if(L>=BATCH*NHEAD*NQB)return false;
    if(G==256){ if(i>=2)return false; const int x=vcu>>5,j=vcu&31; const int b=x>>2,kvh=(x>>1)&1,hq=kvh*4+2*(x&1)+i; u.bh=b*NHEAD+hq; u.qb=j; return true; }
    u.bh=L/NQB; u.qb=L%NQB; return true; }
  __device__ __forceinline__ void a_ready(const AttnUnit&)const{}
  __device__ __forceinline__ void done(const AttnUnit&)const{}
};
template<class Sched,int THRL=8> __device__ __forceinline__ void attn_phase(char*lds,const AttnTensors&T,const Sched&S,const float nshift){
  AttnUnit u;
  for(int i=0;S.next(i,u);++i){ S.a_ready(u); attn_unit<THRL>(u.bh/NHEAD,u.bh%NHEAD,u.qb,T.Q,T.K,T.V,T.O,lds,nshift); S.done(u); }
}
#undef SBAR
#undef WAIT_BAR
}

#include <hip/hip_cooperative_groups.h>
namespace cg = cooperative_groups;
#ifndef MK_PER_PHASE
#define MK_PER_PHASE 0
#endif
constexpr int NWAVES = 8, NTHREADS = 512;
constexpr int NB = 2, SEQ = 8192, DMODEL = 1024, TT = NB * SEQ;
constexpr int NPROJ = 2816;
constexpr int NEXP = 32, FFE = 512;
constexpr float EPS = 1e-6f;
constexpr int N_PHASES = 12;

constexpr size_t MiB = 1u << 20;
constexpr size_t WS_CTL = 0, CTL_ZERO_BYTES = 64 * 1024;
constexpr size_t WS_WOUT = 1 * MiB;
constexpr size_t WS_LIST = 229 * MiB;
constexpr size_t WS_WR = 3 * MiB;
constexpr size_t WS_TOK = 3 * MiB + 256 * 1024;
constexpr size_t WS_GATES = 4 * MiB;
constexpr size_t WS_WIN = 5 * MiB;
constexpr size_t WS_WSI = 3 * MiB + 896 * 1024;
constexpr size_t WS_XSC = 3 * MiB + 912 * 1024;
constexpr size_t WS_A = 11 * MiB;
constexpr size_t WS_XN = WS_A;
constexpr size_t GDN_SH_BYTES = 71680, GDN_D_BYTES = 19456;
constexpr size_t WS_GSH = WS_A;
constexpr size_t WS_GD = WS_A + 1024 * GDN_SH_BYTES;
constexpr size_t WS_X1 = 5 * MiB;
constexpr size_t WS_HID = 69 * MiB;
constexpr size_t WS_XBUF = 109 * MiB;
constexpr size_t WS_B = 157 * MiB;
constexpr size_t WS_QKVA = WS_B;
constexpr size_t WS_QKVB = WS_B + 48 * MiB;
constexpr size_t WS_ZA = WS_B + 72 * MiB;
constexpr size_t WS_OCAT = WS_B;
constexpr size_t WS_WGU0 = 189 * MiB, WS_WGU1 = 245 * MiB; constexpr int WGU_SPLIT = 20;
constexpr size_t WS_WSC = 3 * MiB + 768 * 1024;
constexpr float ACT_CLIP = 6.0f;
constexpr size_t DO_WD0 = 0, DO_WD1 = 56 * MiB; constexpr int WD_SPLIT = 24;
constexpr size_t DO_HN = 24 * MiB;
constexpr size_t WS_END = 269 * MiB;
static_assert(WS_GD + 4096 * GDN_D_BYTES <= WS_B, "GDN records fit region A");
static_assert(WS_X1 + 64 * MiB <= WS_HID && WS_HID + 40928ull * 1024 <= WS_XBUF && WS_XBUF + 40928ull * 2048 <= WS_WGU0, "post-scan map");
static_assert(WS_WGU0 + WGU_SPLIT * MiB <= WS_B + 72 * MiB && WS_WGU1 + (32 - WGU_SPLIT) * MiB <= 269 * MiB, "WGU fragments");
constexpr size_t DO_QR = 0, DO_KR = 16 * MiB, DO_VR = 20 * MiB, DO_OF = 24 * MiB, DO_OB = 40 * MiB;
constexpr int CW_CNT = 2048;
constexpr int CW_NTILE = 128;
constexpr int CW_ETAB = 192;
constexpr int CW_HIDC = 8192;
constexpr int CW_XCC = 11264, CW_XBAD = 11600;
constexpr int CW_SCANQ = 1024;

constexpr int LDS_BYTES = 160 * 1024;

#define GAS __attribute__((address_space(1)))
#define LAS __attribute__((address_space(3)))
typedef unsigned short bf16;
typedef unsigned v4u __attribute__((ext_vector_type(4)));
typedef unsigned v2u __attribute__((ext_vector_type(2)));
typedef float f32x4 __attribute__((ext_vector_type(4)));
typedef short bf16x8 __attribute__((ext_vector_type(8)));
typedef short s16x4 __attribute__((ext_vector_type(4)));
#define DI __device__ __forceinline__

DI unsigned f2bf(float f) { unsigned u = __builtin_bit_cast(unsigned, f); return (u + 0x7fffu + ((u >> 16) & 1u)) >> 16; }
typedef float f32x2_t __attribute__((ext_vector_type(2))); typedef __bf16 bf16x2_t __attribute__((ext_vector_type(2)));
DI unsigned pk2(float lo, float hi) { f32x2_t v = {lo, hi}; bf16x2_t b = __builtin_convertvector(v, bf16x2_t); return __builtin_bit_cast(unsigned, b); }
DI float bf2f(unsigned short h) { return __builtin_bit_cast(float, (unsigned)h << 16); }
DI float bflo(unsigned w) { return __builtin_bit_cast(float, w << 16); }
DI float bfhi(unsigned w) { return __builtin_bit_cast(float, w & 0xffff0000u); }
DI unsigned q8x4(float a, float b, float c, float d, float sc) {
    const float M = 12582912.f;
    const unsigned ua = __builtin_bit_cast(unsigned, fminf(fmaxf(a * sc, -127.f), 127.f) + M), ub = __builtin_bit_cast(unsigned, fminf(fmaxf(b * sc, -127.f), 127.f) + M);
    const unsigned uc = __builtin_bit_cast(unsigned, fminf(fmaxf(c * sc, -127.f), 127.f) + M), ud = __builtin_bit_cast(unsigned, fminf(fmaxf(d * sc, -127.f), 127.f) + M);
    return (ua & 255u) | ((ub & 255u) << 8) | ((uc & 255u) << 16) | (ud << 24);
}
template <int CTRL> DI float dpp_f(float v) { return __builtin_bit_cast(float, __builtin_amdgcn_update_dpp(0, __builtin_bit_cast(int, v), CTRL, 0xf, 0xf, true)); }
#ifdef NO_DPP
DI float sum16(float v) { v += __shfl_xor(v, 1); v += __shfl_xor(v, 2); v += __shfl_xor(v, 4); v += __shfl_xor(v, 8); return v; }
DI float max16(float v) { v = fmaxf(v, __shfl_xor(v, 1)); v = fmaxf(v, __shfl_xor(v, 2)); v = fmaxf(v, __shfl_xor(v, 4)); v = fmaxf(v, __shfl_xor(v, 8)); return v; }
DI float get_x8(float v) { return __shfl_xor(v, 8); }
#else
DI float sum16(float v) { v += dpp_f<0xB1>(v); v += dpp_f<0x4E>(v); v += dpp_f<0x141>(v); v += dpp_f<0x140>(v); return v; }
DI float max16(float v) { v = fmaxf(v, dpp_f<0xB1>(v)); v = fmaxf(v, dpp_f<0x4E>(v)); v = fmaxf(v, dpp_f<0x141>(v)); v = fmaxf(v, dpp_f<0x140>(v)); return v; }
DI float get_x8(float v) { return dpp_f<0x128>(v); }
#endif
DI float sum_x16(float v) { return v + __shfl_xor(v, 16); }
DI float max_x16(float v) { return fmaxf(v, __shfl_xor(v, 16)); }
DI float sum_x32(float v) { return v + __shfl_xor(v, 32); }
DI float max_x32(float v) { return fmaxf(v, __shfl_xor(v, 32)); }
DI float wave_max(float v) { return max_x32(max_x16(max16(v))); }
DI float act_absmax(const float* nfw, int lane) {
    float m = 0.f;
#pragma unroll
    for (int i = 0; i < 16; ++i) m = fmaxf(m, fabsf(nfw[lane + 64 * i]));
    return ACT_CLIP * wave_max(m);
}
DI float wave_sum(float v) { return sum_x32(sum_x16(sum16(v))); }
DI float siluf(float x) { return x * __builtin_amdgcn_rcpf(1.0f + __expf(-x)); }
DI float sigmoidf_(float x) { return 1.0f / (1.0f + __expf(-x)); }
DI int perm32i(int idx) { return ((idx >> 2) & 3) * 8 + (idx >> 4) * 4 + (idx & 3); }
DI int permcol(int c) { return (c & ~31) + perm32i(c & 31); }
template <class T> DI T opaque(T p) { asm volatile("" : "+v"(p)); return p; }

typedef GAS unsigned gu32;
#define RLX_AGENT __ATOMIC_RELAXED, __HIP_MEMORY_SCOPE_AGENT
constexpr int CW_BAR = 4096;
constexpr int MISC_OFF = LDS_BYTES - 64;
#define XB_TMO      128
#define XB_XCNT(j)  (256  + 64 * (j))
#define XB_XSUB(j)  (1280 + 64 * (j))
#define XB_XGEN(j)  (2304 + 64 * (j))
#define XB_TOP      3328
#define XB_TOPGEN   3392
#define XCD_BAR_WORDS 3456
#define XB_SPIN_CAP (1u << 18)

__device__ __forceinline__ unsigned xb_ld(unsigned* p)              { return __hip_atomic_load(p, __ATOMIC_RELAXED, __HIP_MEMORY_SCOPE_AGENT); }
__device__ __forceinline__ unsigned xb_add(unsigned* p, unsigned v) { return __hip_atomic_fetch_add(p, v, __ATOMIC_RELAXED, __HIP_MEMORY_SCOPE_AGENT); }
__device__ __forceinline__ unsigned xb_xcc_id() { return (unsigned)__builtin_amdgcn_s_getreg((3 << 11) | 20) & 0xFu; }
#define XB_SPIN(cond, bar) do { unsigned _sp = 0; while (cond) { __builtin_amdgcn_s_sleep(1); \
    if ((++_sp & 255u) == 0u) { if (xb_ld(&(bar)[XB_TMO])) break; if (_sp > XB_SPIN_CAP) { atomicAdd(&(bar)[XB_TMO], 1u); break; } } } } while (0)

struct XcdBarrier {
    unsigned* bar; unsigned x;
    volatile LAS unsigned* st;
};

__device__ __forceinline__ XcdBarrier xcd_barrier_post(unsigned* bar, volatile LAS unsigned* st) {
    XcdBarrier b; b.bar = bar; b.x = xb_xcc_id(); b.st = st;
    if (threadIdx.x == 0) (void)xb_add(&bar[XB_XCNT(b.x)], 1u);
    return b;
}
__device__ __forceinline__ void xcd_barrier_complete(unsigned* bar, unsigned x, unsigned& nloc, unsigned& nx) {
    const unsigned G = gridDim.x * gridDim.y * gridDim.z;
    unsigned sum, cnt, mine, sp = 0u;
    for (;;) {
        sum = 0u; cnt = 0u; mine = 0u;
#pragma unroll
        for (unsigned j = 0; j < 16; ++j) { const unsigned c = xb_ld(&bar[XB_XCNT(j)]); sum += c; cnt += (c > 0u) ? 1u : 0u; mine = (j == x) ? c : mine; }
        if (sum == G) break;
        __builtin_amdgcn_s_sleep(1);
        if ((++sp & 255u) == 0u) { if (xb_ld(&bar[XB_TMO])) break; if (sp > XB_SPIN_CAP) { atomicAdd(&bar[XB_TMO], 1u); break; } }
    }
    nloc = mine > 0u ? mine : 1u; nx = cnt > 0u ? cnt : 1u;
}

__device__ __forceinline__ void xcd_barrier(const XcdBarrier& b) {
    asm volatile("s_waitcnt vmcnt(0)" ::: "memory");
    __syncthreads();
    if (threadIdx.x == 0) {
        unsigned* bar = b.bar;
        __builtin_amdgcn_s_waitcnt(0);
        unsigned nloc = b.st[0], nx = b.st[1];
        if (nloc == 0u) { xcd_barrier_complete(bar, b.x, nloc, nx); b.st[0] = nloc; b.st[1] = nx; }
        const unsigned old = xb_add(&bar[XB_XSUB(b.x)], 1u);
        const unsigned gen = old / nloc;
        if (old + 1u == (gen + 1u) * nloc) {
            __builtin_amdgcn_fence(__ATOMIC_RELEASE, "agent");
            asm volatile("s_waitcnt vmcnt(0)" ::: "memory");
            const unsigned og = xb_add(&bar[XB_TOP], 1u);
            const unsigned tg = og / nx;
            if (og + 1u == (tg + 1u) * nx) xb_add(&bar[XB_TOPGEN], 1u);
            else XB_SPIN(xb_ld(&bar[XB_TOPGEN]) == tg, bar);
            __builtin_amdgcn_fence(__ATOMIC_ACQUIRE, "agent");
            xb_add(&bar[XB_XGEN(b.x)], 1u);
            asm volatile("s_waitcnt vmcnt(0)" ::: "memory");
        } else {
            XB_SPIN(xb_ld(&bar[XB_XGEN(b.x)]) == gen, bar);
            __builtin_amdgcn_fence(__ATOMIC_ACQUIRE, "agent");
            asm volatile("s_waitcnt vmcnt(0)" ::: "memory");
        }
    }
    __syncthreads();
}

struct Frame {
    LAS unsigned char* lds;
    int tid, lane, wave, vcu, G;
    const float* in[17];
    float* out; unsigned char* ws;
};

DI void p0_transpose_item(const float* W, int ldw, int nblk, bf16* WT, int K, int row_off, int rmul, LAS float* scr, int item, int lane) {
    const int kb = item / nblk, nb = item % nblk, k0 = 64 * kb, n0 = 32 * nb;
    const int r8 = lane >> 3, c4 = (lane & 7) * 4;
    f32x4 v[8];
#pragma unroll
    for (int i = 0; i < 8; ++i) v[i] = __builtin_nontemporal_load((const f32x4*)(W + (size_t)(k0 + 8 * i + r8) * ldw + n0 + c4));
#pragma unroll
    for (int i = 0; i < 8; ++i) { LAS float* d = scr + (8 * i + r8) * 33 + c4; d[0] = v[i].x; d[1] = v[i].y; d[2] = v[i].z; d[3] = v[i].w; }
    asm volatile("s_waitcnt lgkmcnt(0)" ::: "memory");
    const int c = lane & 7;
#pragma unroll
    for (int j = 0; j < 4; ++j) { const int n = (lane >> 3) + 8 * j; const LAS float* s = scr + (8 * c) * 33 + n;
        v4u o; o.x = pk2(s[0 * 33], s[1 * 33]); o.y = pk2(s[2 * 33], s[3 * 33]); o.z = pk2(s[4 * 33], s[5 * 33]); o.w = pk2(s[6 * 33], s[7 * 33]);
        *(GAS v4u*)(WT + (size_t)(row_off + (n0 + n) * rmul) * K + k0 + 8 * c) = o; }
    asm volatile("s_waitcnt lgkmcnt(0)" ::: "memory");
}
template <int NR> DI void rms_rows_to_bf16(const float* const (&xrow)[NR], const float* w, bf16* const (&orow)[NR], int lane) {
    const GAS f32x4* wr = (const GAS f32x4*)w + lane;
    f32x4 v[NR][4];
#pragma unroll
    for (int r = 0; r < NR; ++r) { const GAS f32x4* xr = (const GAS f32x4*)xrow[r] + lane;
#pragma unroll
        for (int j = 0; j < 4; ++j) v[r][j] = xr[64 * j]; }
    f32x4 ww[4];
#pragma unroll
    for (int j = 0; j < 4; ++j) ww[j] = wr[64 * j];
#pragma unroll
    for (int r = 0; r < NR; ++r) {
        float s_ = 0.f;
#pragma unroll
        for (int j = 0; j < 4; ++j) s_ += (v[r][j].x * v[r][j].x + v[r][j].y * v[r][j].y) + (v[r][j].z * v[r][j].z + v[r][j].w * v[r][j].w);
        const float rs = __builtin_amdgcn_rsqf(wave_sum(s_) * (1.f / DMODEL) + EPS);
        GAS v2u* o8 = (GAS v2u*)orow[r] + lane;
#pragma unroll
        for (int j = 0; j < 4; ++j) { v2u o; o.x = pk2(v[r][j].x * rs * ww[j].x, v[r][j].y * rs * ww[j].y); o.y = pk2(v[r][j].z * rs * ww[j].z, v[r][j].w * rs * ww[j].w); o8[64 * j] = o; }
    }
}
DI void q_strip(const float* W, int ldw, int n0, unsigned char* WQ, float* wsc, int rowbase, int rmul, LAS unsigned char* lds, int wave, int lane) {
    LAS float* scr = (LAS float*)(lds + wave * 8704); LAS float* cmx = (LAS float*)(lds + 8 * 8704);
    const int r8 = lane >> 3, c4 = (lane & 7) * 4, kw = 128 * wave;
    f32x4 mx = (f32x4){0.f, 0.f, 0.f, 0.f};
#pragma unroll
    for (int i = 0; i < 16; ++i) { const f32x4 v = *(const f32x4*)(W + (size_t)(kw + 8 * i + r8) * ldw + n0 + c4);
        mx.x = fmaxf(mx.x, fabsf(v.x)); mx.y = fmaxf(mx.y, fabsf(v.y)); mx.z = fmaxf(mx.z, fabsf(v.z)); mx.w = fmaxf(mx.w, fabsf(v.w)); }
    mx.x = max_x32(max_x16(fmaxf(mx.x, get_x8(mx.x)))); mx.y = max_x32(max_x16(fmaxf(mx.y, get_x8(mx.y))));
    mx.z = max_x32(max_x16(fmaxf(mx.z, get_x8(mx.z)))); mx.w = max_x32(max_x16(fmaxf(mx.w, get_x8(mx.w))));
    if (lane < 8) *(LAS f32x4*)(cmx + wave * 32 + c4) = mx;
    __syncthreads();
    float sq[4];
#pragma unroll
    for (int j = 0; j < 4; ++j) { const int n = (lane >> 3) + 8 * j; float m = cmx[n];
#pragma unroll
        for (int w = 1; w < 8; ++w) m = fmaxf(m, cmx[w * 32 + n]);
        sq[j] = m > 0.f ? 127.0f / m : 0.f;
        if (wave == 0 && (lane & 7) == 0) wsc[rowbase + n * rmul] = m * (1.0f / 127.0f); }
    const int c = lane & 7;
#pragma unroll
    for (int kb = 0; kb < 2; ++kb) {
        const int k0 = kw + 64 * kb;
        f32x4 v[8];
#pragma unroll
        for (int i = 0; i < 8; ++i) v[i] = *(const f32x4*)(W + (size_t)(k0 + 8 * i + r8) * ldw + n0 + c4);
#pragma unroll
        for (int i = 0; i < 8; ++i) { LAS float* d = scr + (8 * i + r8) * 33 + c4; d[0] = v[i].x; d[1] = v[i].y; d[2] = v[i].z; d[3] = v[i].w; }
        asm volatile("s_waitcnt lgkmcnt(0)" ::: "memory");
#pragma unroll
        for (int j = 0; j < 4; ++j) { const int n = (lane >> 3) + 8 * j; const LAS float* t = scr + (8 * c) * 33 + n;
            v2u o; o.x = q8x4(t[0 * 33], t[1 * 33], t[2 * 33], t[3 * 33], sq[j]); o.y = q8x4(t[4 * 33], t[5 * 33], t[6 * 33], t[7 * 33], sq[j]);
            *(GAS v2u*)(WQ + (size_t)(rowbase + n * rmul) * 1024 + k0 + 8 * c) = o; }
        asm volatile("s_waitcnt lgkmcnt(0)" ::: "memory");
    }
    __syncthreads();
}
DI float reduce16(const float (&ga)[16], int lane) {
    float gb[8], gc[4];
    const bool h32 = (lane & 32) != 0, h16 = (lane & 16) != 0;
#pragma unroll
    for (int i = 0; i < 8; ++i) { const float lo = sum_x32(ga[i]), hi = sum_x32(ga[i + 8]); gb[i] = h32 ? hi : lo; }
#pragma unroll
    for (int i = 0; i < 4; ++i) { const float lo = sum_x16(gb[i]), hi = sum_x16(gb[i + 4]); gc[i] = h16 ? hi : lo; }
    float res = 0.f;
#pragma unroll
    for (int i = 0; i < 4; ++i) { const float t = sum16(gc[i]); res = ((lane & 3) == i) ? t : res; }
    return res;
}
DI void p0_load_rows(const float* x0, f32x4 (&v)[2][4], int lane) {
#pragma unroll
    for (int r = 0; r < 2; ++r) { const GAS f32x4* xr = (const GAS f32x4*)(x0 + (size_t)r * DMODEL) + lane;
#pragma unroll
        for (int j = 0; j < 4; ++j) v[r][j] = xr[64 * j]; }
}
DI void rms_rows_to_q8(f32x4 (&v)[2][4], const f32x4 (&ww)[4], unsigned char* const (&orow)[2], float* const (&xsc)[2], float* const (&gout)[2], const LAS float* gw_, int lane) {
    const LAS float* gw = gw_;
    gw = opaque(gw);
#pragma unroll
    for (int r = 0; r < 2; ++r) {
        float s_ = 0.f;
#pragma unroll
        for (int j = 0; j < 4; ++j) s_ += (v[r][j].x * v[r][j].x + v[r][j].y * v[r][j].y) + (v[r][j].z * v[r][j].z + v[r][j].w * v[r][j].w);
        const float rs = __builtin_amdgcn_rsqf(wave_sum(s_) * (1.f / DMODEL) + EPS);
        float am = 0.f;
#pragma unroll
        for (int j = 0; j < 4; ++j) { v[r][j] = v[r][j] * ww[j] * rs; am = fmaxf(fmaxf(am, fmaxf(fabsf(v[r][j].x), fabsf(v[r][j].y))), fmaxf(fabsf(v[r][j].z), fabsf(v[r][j].w))); }
        am = wave_max(am);
        const float qsc = am > 0.f ? 127.0f / am : 0.f;
        if (lane == 0) *xsc[r] = am * (1.0f / 127.0f);
        GAS unsigned* o4 = (GAS unsigned*)orow[r] + lane;
#pragma unroll
        for (int j = 0; j < 4; ++j) o4[64 * j] = q8x4(v[r][j].x, v[r][j].y, v[r][j].z, v[r][j].w, qsc);
    }
#ifndef NO_GATES
    float ga[2][16];
#pragma unroll
    for (int c = 0; c < 16; ++c) { ga[0][c] = 0.f; ga[1][c] = 0.f; }
    asm volatile("" : "+v"(v[0][0]), "+v"(v[0][1]), "+v"(v[0][2]), "+v"(v[0][3]), "+v"(v[1][0]), "+v"(v[1][1]), "+v"(v[1][2]), "+v"(v[1][3]));
#pragma unroll
    for (int j = 0; j < 4; ++j)
#pragma unroll
        for (int q = 0; q < 4; ++q) { const LAS f32x4* g4 = (const LAS f32x4*)gw + ((j * 4 + q) * 4) * 64 + lane;
            const f32x4 g0 = g4[0], g1 = g4[64], g2 = g4[128], g3 = g4[192];
#pragma unroll
            for (int r = 0; r < 2; ++r) { const float h = v[r][j][q];
                ga[r][0] += h * g0.x; ga[r][1] += h * g0.y; ga[r][2] += h * g0.z; ga[r][3] += h * g0.w; ga[r][4] += h * g1.x; ga[r][5] += h * g1.y; ga[r][6] += h * g1.z; ga[r][7] += h * g1.w;
                ga[r][8] += h * g2.x; ga[r][9] += h * g2.y; ga[r][10] += h * g2.z; ga[r][11] += h * g2.w; ga[r][12] += h * g3.x; ga[r][13] += h * g3.y; ga[r][14] += h * g3.z; ga[r][15] += h * g3.w; }
            asm volatile("" : "+v"(ga[1][0]), "+v"(ga[1][1]), "+v"(ga[1][2]), "+v"(ga[1][3]), "+v"(ga[1][4]), "+v"(ga[1][5]), "+v"(ga[1][6]), "+v"(ga[1][7]), "+v"(ga[1][8]), "+v"(ga[1][9]),
                         "+v"(ga[1][10]), "+v"(ga[1][11]), "+v"(ga[1][12]), "+v"(ga[1][13]), "+v"(ga[1][14]), "+v"(ga[1][15]) :: "memory"); }
    const int gc_ = 4 * (lane >> 4) + (lane & 3);
#pragma unroll
    for (int r = 0; r < 2; ++r) { const float res = reduce16(ga[r], lane); if ((lane & 12) == 0) gout[r][gc_] = res; }
#endif
}
DI void p0_prologue(Frame& F) {
    const float* w_in = F.in[2];
    unsigned char* WIN = F.ws + WS_WIN; float* WSI = (float*)(F.ws + WS_WSI);
    constexpr int NSTRIP = 64 + 24;
    if (F.vcu < NSTRIP) { const int st = F.vcu;
        if (st < 64) q_strip(w_in, 2832, 32 * st, WIN, WSI, 32 * st, 1, F.lds, F.wave, F.lane);
        else q_strip(w_in + 2064, 2832, 32 * (st - 64), WIN, WSI, 2048 + 32 * (st - 64), 1, F.lds, F.wave, F.lane); }
    unsigned char* XN = F.ws + WS_XN; float* XSC = (float*)(F.ws + WS_XSC); float* GATES = (float*)(F.ws + WS_GATES);
    LAS float* gw = (LAS float*)(F.lds + 73728);
    for (int i = F.tid; i < 1024 * 4; i += NTHREADS) { const int k = i >> 2, c4 = i & 3, jj = k >> 8, qq = k & 3, ln = (k & 255) >> 2;
        *((LAS f32x4*)gw + ((jj * 4 + qq) * 4 + c4) * 64 + ln) = *(const f32x4*)(w_in + (size_t)k * 2832 + 2048 + c4 * 4); }
    __syncthreads();
    const int nst = (F.G < NSTRIP ? F.G : NSTRIP), NSLOT = nst * NWAVES + (F.G - nst) * NWAVES * 2;
    const int s0_ = (F.vcu < nst) ? F.vcu * NWAVES + F.wave : nst * NWAVES + ((F.vcu - nst) * NWAVES + F.wave) * 2, nmine = (F.vcu < nst) ? 1 : 2;
#pragma unroll 1
    for (int q = 0; q < 1; ++q) {
        f32x4 ww[4];
#pragma unroll
        for (int j = 0; j < 4; ++j) ww[j] = ((const GAS f32x4*)F.in[1] + F.lane)[64 * j];
        f32x4 va[2][4], vb[2][4];
        int it = 0; int p = s0_;
        if (p < TT / 2) p0_load_rows(F.in[0] + (size_t)(2 * p) * DMODEL, va, F.lane);
#define P0_NEXT(pn_) ((nmine == 2) ? (((it) & 1) ? (pn_) - 1 + NSLOT : (pn_) + 1) : (pn_) + NSLOT)
#define P0_WORK(V, pc_) { const int m = 2 * (pc_); unsigned char* const orw[2] = {XN + (size_t)m * DMODEL, XN + (size_t)(m + 1) * DMODEL}; \
            float* const xs[2] = {XSC + m, XSC + m + 1}; float* const go[2] = {GATES + (size_t)m * 16, GATES + (size_t)(m + 1) * 16}; rms_rows_to_q8(V, ww, orw, xs, go, gw, F.lane); }
#pragma unroll 1
        while (p < TT / 2) {
            int pn = P0_NEXT(p); ++it;
            if (pn < TT / 2) p0_load_rows(F.in[0] + (size_t)(2 * pn) * DMODEL, vb, F.lane);
            P0_WORK(va, p);
            p = pn; if (p >= TT / 2) break;
            pn = P0_NEXT(p); ++it;
            if (pn < TT / 2) p0_load_rows(F.in[0] + (size_t)(2 * pn) * DMODEL, va, F.lane);
            P0_WORK(vb, p);
            p = pn;
        }
#undef P0_NEXT
#undef P0_WORK
    }
}

struct EpiProj {
    static constexpr bool PERM = true, AFTER_DRAIN = false;
    bf16 *qkva, *za, *qkvb; const float* wsi; const float* xsc;
    DI void operator()(const pg8::i32x4 (&acc)[2][2][4][2], const pg8::Unit& u, int wr, int wc, int fr, int fq) const {
        const int row0 = u.pm * 256 + wr * 64 + fr;
        const float* ws_ = wsi + u.pn * 256 + wc * 32 + 8 * fq;
        bf16* base; int ldc, colt;
        if (u.pn < 6) { base = qkva; ldc = 1536; colt = u.pn * 256; } else if (u.pn < 8) { base = za; ldc = 512; colt = (u.pn - 6) * 256; } else { base = qkvb; ldc = 768; colt = (u.pn - 8) * 256; }
        const int col0 = colt + wc * 32 + 8 * fq;
        f32x4 s0[2], s1[2];
#pragma unroll
        for (int bj = 0; bj < 2; ++bj) { s0[bj] = *(const f32x4*)(ws_ + bj * 128); s1[bj] = *(const f32x4*)(ws_ + bj * 128 + 4); }
        float rsc[2][4];
#pragma unroll
        for (int ai = 0; ai < 2; ++ai)
#pragma unroll
            for (int m = 0; m < 4; ++m) rsc[ai][m] = xsc[row0 + ai * 128 + m * 16];
#pragma unroll
        for (int ai = 0; ai < 2; ++ai)
#pragma unroll
            for (int m = 0; m < 4; ++m) { bf16* rowp = base + (size_t)(row0 + ai * 128 + m * 16) * ldc + col0; const float rr = rsc[ai][m];
#pragma unroll
                for (int bj = 0; bj < 2; ++bj) { const pg8::i32x4 a0 = acc[ai][bj][m][0], a1 = acc[ai][bj][m][1]; const f32x4 t0 = s0[bj] * rr, t1 = s1[bj] * rr; pg8::u32x4 w;
                    w.x = pg8::cvt_pk_bf16((float)a0[0] * t0[0], (float)a0[1] * t0[1]); w.y = pg8::cvt_pk_bf16((float)a0[2] * t0[2], (float)a0[3] * t0[3]);
                    w.z = pg8::cvt_pk_bf16((float)a1[0] * t1[0], (float)a1[1] * t1[1]); w.w = pg8::cvt_pk_bf16((float)a1[2] * t1[2], (float)a1[3] * t1[3]);
                    *(pg8::u32x4*)(rowp + bj * 128) = w; } }
    }
};
struct IdRows { DI int row(const pg8::Unit& u, int r) const { return u.pm * 256 + r; } };
struct EpiResid {
    static constexpr bool PERM = true, AFTER_DRAIN = false;
    const float* x; bf16* x1;
    DI void operator()(const pg8::f32x4 (&acc)[2][2][4][2], const pg8::Unit& u, int wr, int wc, int fr, int fq) const {
        const int row0 = u.pm * 256 + wr * 64 + fr, col0 = u.pn * 256 + wc * 32 + 8 * fq;
#pragma unroll
        for (int ai = 0; ai < 2; ++ai)
#pragma unroll
            for (int m = 0; m < 4; ++m) { const size_t off = (size_t)(row0 + ai * 128 + m * 16) * DMODEL + col0;
#pragma unroll
                for (int bj = 0; bj < 2; ++bj) { const pg8::f32x4 v0 = *(const pg8::f32x4*)(x + off + bj * 128) + acc[ai][bj][m][0], v1 = *(const pg8::f32x4*)(x + off + bj * 128 + 4) + acc[ai][bj][m][1]; pg8::u32x4 w;
                    w.x = pg8::cvt_pk_bf16(v0[0], v0[1]); w.y = pg8::cvt_pk_bf16(v0[2], v0[3]); w.z = pg8::cvt_pk_bf16(v1[0], v1[1]); w.w = pg8::cvt_pk_bf16(v1[2], v1[3]);
                    *(pg8::u32x4*)(x1 + off + bj * 128) = w; } }
    }
};
struct EpiGU {
    static constexpr bool PERM = true, AFTER_DRAIN = false;
    bf16* hid; const float* wsc; float ainv;
    DI void operator()(const pg8::i32x4 (&acc)[2][2][4][2], const pg8::Unit& u, int wr, int wc, int fr, int fq) const {
        const int row0 = u.pm * 256 + wr * 64 + fr; const int jt = u.pn & 3;
        const int ff0 = jt * 128 + wc * 16 + 4 * fq;
        const float* ws_ = wsc + u.ex * 1024 + jt * 256 + wc * 32 + 8 * fq;
        f32x4 s0[2], s1[2];
#pragma unroll
        for (int bj = 0; bj < 2; ++bj) { s0[bj] = *(const f32x4*)(ws_ + bj * 128) * ainv; s1[bj] = *(const f32x4*)(ws_ + bj * 128 + 4) * ainv; }
#pragma unroll
        for (int ai = 0; ai < 2; ++ai)
#pragma unroll
            for (int m = 0; m < 4; ++m) { bf16* rowp = hid + (size_t)(row0 + ai * 128 + m * 16) * FFE + ff0;
#pragma unroll
                for (int bj = 0; bj < 2; ++bj) { const pg8::i32x4 a0 = acc[ai][bj][m][0], a1 = acc[ai][bj][m][1];
                    const float g0 = (float)a0[0] * s0[bj][0], u0 = (float)a0[1] * s0[bj][1], g1 = (float)a0[2] * s0[bj][2], u1 = (float)a0[3] * s0[bj][3];
                    const float g2 = (float)a1[0] * s1[bj][0], u2 = (float)a1[1] * s1[bj][1], g3 = (float)a1[2] * s1[bj][2], u3 = (float)a1[3] * s1[bj][3];
                    v2u w; w.x = pg8::cvt_pk_bf16(siluf(g0) * u0, siluf(g1) * u1); w.y = pg8::cvt_pk_bf16(siluf(g2) * u2, siluf(g3) * u3);
                    *(v2u*)(rowp + bj * 64) = w; } }
    }
};
struct EpiY {
    static constexpr bool PERM = true, AFTER_DRAIN = false;
    bf16* y;
    DI void operator()(const pg8::f32x4 (&acc)[2][2][4][2], const pg8::Unit& u, int wr, int wc, int fr, int fq) const {
        const int row0 = u.pm * 256 + wr * 64 + fr; const int col0 = (u.pn & 3) * 256 + wc * 32 + 8 * fq;
#pragma unroll
        for (int ai = 0; ai < 2; ++ai)
#pragma unroll
            for (int m = 0; m < 4; ++m) { bf16* rowp = y + (size_t)(row0 + ai * 128 + m * 16) * DMODEL + col0;
#pragma unroll
                for (int bj = 0; bj < 2; ++bj) { const pg8::f32x4 v0 = acc[ai][bj][m][0], v1 = acc[ai][bj][m][1]; pg8::u32x4 w;
                    w.x = pg8::cvt_pk_bf16(v0[0], v0[1]); w.y = pg8::cvt_pk_bf16(v0[2], v0[3]); w.z = pg8::cvt_pk_bf16(v1[0], v1[1]); w.w = pg8::cvt_pk_bf16(v1[2], v1[3]);
                    *(pg8::u32x4*)(rowp + bj * 128) = w; } }
    }
};
constexpr int ETAB_OFF = 131072;
typedef GAS unsigned mo_gu32;
struct MoeOrder {
    const LAS unsigned* etab; int G, c, esplit, pnoff;
    mo_gu32* cnt; int mode, rot; mutable int pend;
    DI bool next(int i, pg8::Unit& u) const {
        if (G % 8 != 0) {
            int L = i * G + c;
            for (int e = 0; e < NEXP; ++e) { const int n4 = 4 * (int)etab[2 * e + 1]; if (L < n4) { u.pm = (int)etab[2 * e] + (L >> 2); u.pn = (e < esplit ? 4 * e : pnoff + 4 * (e - esplit)) + (L & 3); u.ex = e; u.tq = L >> 2; return true; } L -= n4; }
            return false; }
        const int x = c & 7, per = G >> 3; int k = (c >> 3) - rot; k += (k < 0) ? per : 0; int L = i * per + k;
#pragma unroll
        for (int q = 0; q < NEXP / 8; ++q) { const int e = x + 8 * q; const int n4 = 4 * (int)etab[2 * e + 1];
            if (L < n4) { u.pm = (int)etab[2 * e] + (L >> 2); u.pn = (e < esplit ? 4 * e : pnoff + 4 * (e - esplit)) + (L & 3); u.ex = e; u.tq = L >> 2; return true; } L -= n4; }
        return false; }
    DI int xcd_units() const { int n = 0; for (int q = 0; q < NEXP / 8; ++q) n += 4 * (int)etab[2 * ((c & 7) + 8 * q) + 1]; return n; }
    DI void publish(int pm) const { if ((threadIdx.x & 63) == 0) __hip_atomic_fetch_add(cnt + pm * 16, 1u, __ATOMIC_RELAXED, __HIP_MEMORY_SCOPE_AGENT); }
    DI void a_ready(const pg8::Unit& u) const {
        if (mode != 2) return;
        mo_gu32* w = cnt + u.pm * 16;
        for (unsigned spins = 0; spins < (1u << 22); ++spins) {
            if ((unsigned)__builtin_amdgcn_readfirstlane(__hip_atomic_load(w, __ATOMIC_RELAXED, __HIP_MEMORY_SCOPE_AGENT)) >= 32u) break;
            __builtin_amdgcn_s_sleep(1); }
    }
    DI void done(const pg8::Unit& u) const { if (mode != 1) return; if (pend >= 0) publish(pend); pend = u.pm; }
    DI void flush() const { if (mode == 1 && pend >= 0) { publish(pend); pend = -1; } }
};
struct MoeRows {
    const int* list; const LAS unsigned* etab;
    DI int row(const pg8::Unit& u, int r) const {
        const int slot = u.tq * 256 + r, e = u.ex; if (slot >= (int)etab[64 + e]) return 0;
        const LAS unsigned* sp = etab + 96 + 8 * e; int sb = 0;
#pragma unroll
        for (int q = 1; q < 8; ++q) sb += (slot >= (int)sp[q]) ? 1 : 0;
        return list[(size_t)(e * 8 + sb) * TT + (slot - (int)sp[sb])]; }
};

DI void p2_rope(Frame& F) {
    const int gw = F.vcu * NWAVES + F.wave, NGW = F.G * NWAVES, lane = F.lane;
    const bf16* QKVB = (const bf16*)(F.ws + WS_QKVB);
    bf16* QR = (bf16*)((unsigned char*)F.out + DO_QR); bf16* KR = (bf16*)((unsigned char*)F.out + DO_KR); bf16* VR = (bf16*)((unsigned char*)F.out + DO_VR);
    const int pi = lane & 31, hsel = lane >> 5;
    const float qw0 = F.in[7][2 * pi], qw1 = F.in[7][2 * pi + 1], kw0 = F.in[8][2 * pi], kw1 = F.in[8][2 * pi + 1];
    const float invf = exp2f(-(float)(2 * (pi & 15)) * (13.287712379549449f / 32.0f));
    constexpr float C2 = 0.125f * 1.4426950408889634f;
    constexpr int NB4 = 4;
    for (int t0 = gw; t0 < TT; t0 += NB4 * NGW) {
        unsigned w[NB4][5], vw[NB4];
#pragma unroll
        for (int u = 0; u < NB4; ++u) { const int t = t0 + u * NGW; const unsigned* src = (const unsigned*)(QKVB + (size_t)(t < TT ? t : t0) * 768);
#pragma unroll
            for (int j = 0; j < 5; ++j) w[u][j] = src[(2 * j + hsel) * 32 + pi];
            vw[u] = src[320 + lane]; }
#pragma unroll
        for (int u = 0; u < NB4; ++u) {
            const int t = t0 + u * NGW; if (t >= TT) break;
            const int s_ = t & (SEQ - 1); const float pos = (pi < 16) ? (float)(s_ >> 6) : (float)(s_ & 63);
            const float ang = pos * invf;
            const float rev = ang * 0.15915494309189535f;
            const float sn = __builtin_amdgcn_sinf(rev), cs = __builtin_amdgcn_cosf(rev);
#pragma unroll
            for (int j = 0; j < 5; ++j) {
                const int head = 2 * j + hsel;
                const float x0 = bflo(w[u][j]), x1 = bfhi(w[u][j]);
                float ss = x0 * x0 + x1 * x1;
                ss = sum_x16(sum16(ss));
                const float rs = __builtin_amdgcn_rsqf(ss * (1.f / 64.f) + EPS);
                const bool isq = head < 8;
                const float y0 = x0 * rs * (isq ? qw0 : kw0), y1 = x1 * rs * (isq ? qw1 : kw1);
                float o0 = y0 * cs - y1 * sn, o1 = y0 * sn + y1 * cs;
                if (isq) { o0 *= C2; o1 *= C2; ((unsigned*)(QR + (size_t)t * 512))[head * 32 + pi] = pk2(o0, o1); }
                else { const int hk = head - 8, bq = t >> 13, sq = t & (SEQ - 1);
                    ((unsigned*)(KR + ((size_t)((bq * 2 + hk) * 128 + (sq >> 6)) * 8 + (pi >> 2)) * 512 + (sq & 63) * 8))[pi & 3] = pk2(o0, o1); }
            }
            { const int hk = lane >> 5, d = 2 * (lane & 31), bq = t >> 13, sq = t & (SEQ - 1), r = sq & 63;
              ((unsigned*)(VR + ((size_t)((bq * 2 + hk) * 128 + (sq >> 6)) * 8 + (d >> 5) * 4 + (r >> 4)) * 512 + ((r & 15) * 4 + ((d & 31) >> 3)) * 8))[(d & 7) >> 1] = vw[u]; }
        }
    }
}

constexpr int G_KNP = 0, G_QNP = 17408, G_KNTP = 34816, G_VCT = 53248;
constexpr int G_D0 = 71680, G_D1 = 71680 + 19456;
constexpr int GD_TBP = 0, GD_AP = 9216, GD_VEC = 18432;
constexpr int G_LM = 110592;
constexpr int G_GV = G_LM + 32768;
static_assert(G_GV + 2048 <= LDS_BYTES - 64, "gdn pre lds");

#define TRI_ROW(i, LC, LN) { \
        if ((i) + 1 < 64) { _Pragma("unroll") for (int j4 = 0; j4 < ((i) + 1 + 3) / 4 && j4 < 8; ++j4) LN[j4] = *(const LAS f32x4*)(L + ((i) + 1) * 64 + 4 * j4); } \
        _Pragma("unroll") for (int j4 = 8; j4 < ((i) + 3) / 4; ++j4) lt[j4 - 8] = *(const LAS f32x4*)(L + (i) * 64 + 4 * j4); \
        __builtin_amdgcn_sched_barrier(0); \
        f32x2_t a0 = {(lane == (i)) ? 1.0f : 0.0f, 0.f}, a1 = {0.f, 0.f}; \
        _Pragma("unroll") for (int j4 = 0; j4 < ((i) + 3) / 4; ++j4) { const f32x4 l = (j4 < 8) ? LC[j4 & 7] : lt[(j4 - 8) & 7]; \
            f32x2_t l0 = {l.x, (4 * j4 + 1 < (i)) ? l.y : 0.f}, l1 = {(4 * j4 + 2 < (i)) ? l.z : 0.f, (4 * j4 + 3 < (i)) ? l.w : 0.f}; \
            a0 -= l0 * xp[2 * j4]; if (4 * j4 + 2 < (i)) a1 -= l1 * xp[2 * j4 + 1]; } \
        const float a = (a0.x + a0.y) + (a1.x + a1.y); \
        if ((i) & 1) xp[(i) >> 1].y = a; else { xp[(i) >> 1].x = a; xp[(i) >> 1].y = 0.f; } \
        TBP[(REV ? 63 - (i) : (i)) * 72 + pc] = (bf16)(pk2(a * bcol, 0.f) & 0xffffu); \
        __builtin_amdgcn_sched_barrier(0); }
template <bool REV> DI void tri_inverse(LAS float* L, const LAS float* beta, LAS bf16* TBP, int lane) {
    f32x2_t xp[32];
    L = opaque(L); TBP = opaque(TBP); lane = opaque(lane);
    const float bcol = REV ? beta[63 - lane] : beta[lane];
    const int pc = REV ? permcol(63 - lane) : permcol(lane);
    f32x4 la[8], lb[8], lt[8];
#pragma unroll
    for (int ii = 0; ii < 64; ii += 2) { TRI_ROW(ii, la, lb) TRI_ROW(ii + 1, lb, la) }
}
#undef TRI_ROW

DI void gdn_conv(Frame& F, LAS unsigned char* lds, int t384, int b, int h, int n) {
    const bf16* QKVA = (const bf16*)(F.ws + WS_QKVA); const float* convw = F.in[3];
    const int cgp = t384 % 48, rg = t384 / 48, mat = cgp >> 4, cc = (cgp & 15) * 8;
    const int col = mat * 512 + h * 128 + cc;
    float w[5][8];
#pragma unroll
    for (int j = 0; j < 5; ++j) { const f32x4 a = *(const f32x4*)(convw + j * 1536 + col), bq = *(const f32x4*)(convw + j * 1536 + col + 4);
        w[j][0] = a.x; w[j][1] = a.y; w[j][2] = a.z; w[j][3] = a.w; w[j][4] = bq.x; w[j][5] = bq.y; w[j][6] = bq.z; w[j][7] = bq.w; }
    const int a4 = (cc >> 3) & 3, p0 = (cc & ~31) + 16 * (a4 & 1) + 4 * (a4 >> 1);
    const int ra = rg & 3, q0 = (rg >> 2) * 32 + 16 * (ra & 1) + 4 * (ra >> 1);
#pragma unroll
    for (int hf = 0; hf < 2; ++hf) {
        float o[4][8];
#pragma unroll
        for (int r = 0; r < 4; ++r)
#pragma unroll
            for (int c = 0; c < 8; ++c) o[r][c] = 0.f;
#pragma unroll
        for (int i = 0; i < 8; ++i) {
            const int pos = n * 64 + rg * 8 + hf * 4 - 2 + i;
            v4u raw = (v4u){0u, 0u, 0u, 0u};
            if (pos >= 0 && pos < SEQ) raw = *(const v4u*)(QKVA + (size_t)(b * SEQ + pos) * 1536 + col);
            float xin[8] = {bflo(raw.x), bfhi(raw.x), bflo(raw.y), bfhi(raw.y), bflo(raw.z), bfhi(raw.z), bflo(raw.w), bfhi(raw.w)};
#pragma unroll
            for (int j = 0; j < 5; ++j) { const int r = i - j; if (r >= 0 && r < 4) {
#pragma unroll
                for (int c = 0; c < 8; ++c) o[r][c] += w[j][c] * xin[c]; } }
        }
#pragma unroll
        for (int r = 0; r < 4; ++r) {
            float ss = 0.f;
#pragma unroll
            for (int c = 0; c < 8; ++c) { o[r][c] = siluf(o[r][c]); ss += o[r][c] * o[r][c]; }
            ss = sum16(ss);
            float sc = 1.0f;
            if (mat < 2) { sc = __builtin_amdgcn_rsqf(ss + EPS); if (mat == 0) sc *= 0.08838834764831845f; }
#pragma unroll
            for (int c = 0; c < 8; ++c) o[r][c] *= sc;
        }
        if (mat < 2) {
            LAS unsigned char* tile = lds + (mat == 0 ? G_QNP : G_KNP);
#pragma unroll
            for (int r = 0; r < 4; ++r) { const int c = rg * 8 + hf * 4 + r;
                v2u lo, hi2; lo.x = pk2(o[r][0], o[r][1]); lo.y = pk2(o[r][2], o[r][3]); hi2.x = pk2(o[r][4], o[r][5]); hi2.y = pk2(o[r][6], o[r][7]);
                *(LAS v2u*)(tile + c * 272 + p0 * 2) = lo; *(LAS v2u*)(tile + c * 272 + (p0 + 8) * 2) = hi2; }
        }
        if (mat >= 1) {
#pragma unroll
            for (int c = 0; c < 8; ++c) {
                v2u q4; q4.x = pk2(o[0][c], o[1][c]); q4.y = pk2(o[2][c], o[3][c]);
                if (mat == 1) *(LAS v2u*)(lds + G_KNTP + (cc + c) * 144 + (q0 + 8 * hf) * 2) = q4;
                else *(LAS v2u*)(lds + G_VCT + (cc + c) * 144 + rg * 16 + hf * 8) = q4;
            }
        }
    }
}
DI void gdn_gates(Frame& F, LAS unsigned char* lds, LAS float* gv, int lane, int b, int h, int n) {
    const float* gp = (const float*)(F.ws + WS_GATES) + (size_t)(b * SEQ + n * 64 + lane) * 16;
    const float bfv = gp[h], bbv = gp[4 + h], afv = gp[8 + h], abv = gp[12 + h];
    const float betaf = sigmoidf_(bfv), betab = sigmoidf_(bbv);
    const float xf = afv + F.in[5][h], xb = abv + F.in[5][4 + h];
    const float spf = fmaxf(xf, 0.f) + log1pf(__expf(-fabsf(xf))), spb = fmaxf(xb, 0.f) + log1pf(__expf(-fabsf(xb)));
    const float gf = -__expf(F.in[4][h]) * spf, gb = -__expf(F.in[4][4 + h]) * spb;
    float Gf = gf, Rb = gb;
#pragma unroll
    for (int o = 1; o < 64; o <<= 1) { const float u1 = __shfl_up(Gf, o); if (lane >= o) Gf += u1; const float d1 = __shfl_down(Rb, o); if (lane + o < 64) Rb += d1; }
    gv[lane] = Gf; gv[64 + lane] = Rb; gv[128 + lane] = betaf; gv[192 + lane] = betab;
    const float GfL = __shfl(Gf, 63), Rb0 = __shfl(Rb, 0);
    LAS float* v0 = (LAS float*)(lds + G_D0 + GD_VEC); LAS float* v1 = (LAS float*)(lds + G_D1 + GD_VEC);
    v0[lane] = __expf(Gf); v0[64 + lane] = __expf(GfL - Gf); v1[lane] = __expf(Rb); v1[64 + lane] = __expf(Rb0 - Rb);
    if (lane == 0) { v0[128] = __expf(GfL); v1[128] = __expf(Rb0); }
}
DI void p2_gdn_pre(Frame& F) {
    const int tid = F.tid, lane = F.lane, wave = F.wave;
    int task = F.vcu;
    if (task < 1024) {
        LAS unsigned char* lds = opaque(F.lds);
        const int b = task >> 9, h = (task >> 7) & 3, n = task & 127;
        if (wave >= 2) gdn_conv(F, lds, tid - 128, b, h, n);
        if (wave == 2) gdn_gates(F, lds, (LAS float*)(lds + G_GV), lane, b, h, n);
    }
    __syncthreads();
    int par = 0;
#pragma unroll 1
    for (; task < 1024; task += F.G, par ^= 1) {
        LAS unsigned char* lds = opaque(F.lds);
        const int b = task >> 9, h = (task >> 7) & 3, n = task & 127, bh = b * 4 + h;
        LAS float* gv = (LAS float*)(lds + G_GV + par * 1024);
        LAS float* sGf = gv; LAS float* sRb = gv + 64; LAS float* sBf = gv + 128; LAS float* sBb = gv + 192;
        {
            const int p = wave >> 2, mt = wave & 3, n16 = lane & 15, g = lane >> 4;
            const LAS unsigned char* At = lds + (p == 0 ? G_KNP : G_QNP) + (16 * mt + n16) * 272 + g * 16;
            bf16x8 af[4], bfr[16];
#pragma unroll
            for (int ks = 0; ks < 4; ++ks) af[ks] = *(const LAS bf16x8*)(At + ks * 64);
#pragma unroll
            for (int nt = 0; nt < 4; ++nt)
#pragma unroll
                for (int ks = 0; ks < 4; ++ks) bfr[nt * 4 + ks] = *(const LAS bf16x8*)(lds + G_KNP + (16 * nt + n16) * 272 + g * 16 + ks * 64);
            float Gc[4], Rc[4], Bfc[4], Bbc[4];
#pragma unroll
            for (int r = 0; r < 4; ++r) { const int c = 16 * mt + 4 * g + r; Gc[r] = sGf[c]; Rc[r] = sRb[c]; Bfc[r] = sBf[c]; Bbc[r] = sBb[c]; }
#pragma unroll
            for (int nt = 0; nt < 4; ++nt) {
                f32x4 acc = (f32x4){0.f, 0.f, 0.f, 0.f};
#pragma unroll
                for (int ks = 0; ks < 4; ++ks) acc = __builtin_amdgcn_mfma_f32_16x16x32_bf16(af[ks], bfr[nt * 4 + ks], acc, 0, 0, 0);
                const int s_ = 16 * nt + n16; const float Gs = sGf[s_], Rs = sRb[s_]; const int ps = permcol(s_);
#pragma unroll
                for (int r = 0; r < 4; ++r) {
                    const int c = 16 * mt + 4 * g + r; const float v = acc[r];
                    const float df = __expf(fminf(Gc[r] - Gs, 0.f)), db = __expf(fminf(Rc[r] - Rs, 0.f));
                    if (p == 0) {
                        ((LAS float*)(lds + G_LM))[c * 64 + s_] = Bfc[r] * v * df;
                        ((LAS float*)(lds + G_LM + 16384))[(63 - c) * 64 + (63 - s_)] = Bbc[r] * v * db;
                    } else {
                        ((LAS bf16*)(lds + G_D0 + GD_AP))[c * 72 + ps] = (bf16)(pk2(s_ <= c ? v * df : 0.f, 0.f) & 0xffffu);
                        ((LAS bf16*)(lds + G_D1 + GD_AP))[c * 72 + ps] = (bf16)(pk2(s_ >= c ? v * db : 0.f, 0.f) & 0xffffu);
                    }
                }
            }
        }
        __syncthreads();
        GAS v4u* gd0 = (GAS v4u*)(F.ws + WS_GD + (size_t)((bh * 2 + 0) * 128 + n) * GDN_D_BYTES);
        GAS v4u* gd1 = (GAS v4u*)(F.ws + WS_GD + (size_t)((bh * 2 + 1) * 128 + n) * GDN_D_BYTES);
        {
            GAS v4u* gsh = (GAS v4u*)(F.ws + WS_GSH + (size_t)(bh * 128 + n) * GDN_SH_BYTES);
#pragma unroll 3
            for (int i = tid; i < (int)(GDN_SH_BYTES / 16); i += NTHREADS) gsh[i] = *(const LAS v4u*)(lds + i * 16);
#pragma unroll 1
            for (int i = GD_AP / 16 + tid; i < (int)(GDN_D_BYTES / 16); i += NTHREADS) { gd0[i] = *(const LAS v4u*)(lds + G_D0 + i * 16); gd1[i] = *(const LAS v4u*)(lds + G_D1 + i * 16); }
        }
        __syncthreads();
        if (wave == 0) { tri_inverse<false>((LAS float*)(lds + G_LM), sBf, (LAS bf16*)(lds + G_D0 + GD_TBP), lane);
#pragma unroll 3
            for (int i = lane; i < GD_AP / 16; i += 64) gd0[i] = *(const LAS v4u*)(lds + G_D0 + i * 16); }
        else if (wave == 1) { tri_inverse<true>((LAS float*)(lds + G_LM + 16384), sBb, (LAS bf16*)(lds + G_D1 + GD_TBP), lane);
#pragma unroll 3
            for (int i = lane; i < GD_AP / 16; i += 64) gd1[i] = *(const LAS v4u*)(lds + G_D1 + i * 16); }
        else {
            const int t2 = task + F.G;
            if (t2 < 1024) { const int b2 = t2 >> 9, h2 = (t2 >> 7) & 3, n2 = t2 & 127;
                gdn_conv(F, lds, tid - 128, b2, h2, n2);
                if (wave == 2) gdn_gates(F, lds, (LAS float*)(lds + G_GV + (par ^ 1) * 1024), lane, b2, h2, n2); }
        }
        __syncthreads();
    }
}

DI bf16x8 pack8(const f32x4 a, const f32x4 b) {
    v4u p; p.x = pk2(a[0], a[1]); p.y = pk2(a[2], a[3]); p.z = pk2(b[0], b[1]); p.w = pk2(b[2], b[3]); return __builtin_bit_cast(bf16x8, p);
}
DI unsigned char* wgu_ptr(Frame& F, int e) { return F.ws + (e < WGU_SPLIT ? WS_WGU0 + (size_t)e * MiB : WS_WGU1 + (size_t)(e - WGU_SPLIT) * MiB); }
DI bf16* wd_ptr(Frame& F, int e) { return (bf16*)((unsigned char*)F.out + (e < WD_SPLIT ? DO_WD0 + (size_t)e * MiB : DO_WD1 + (size_t)(e - WD_SPLIT) * MiB)); }
constexpr int NG = 8, GSTEPS = 128 / NG;
#ifndef PASS1_QUOTA
#define PASS1_QUOTA 3
#endif
constexpr size_t WS_XB = 209 * MiB;
constexpr size_t WS_AOP = 217 * MiB;
constexpr size_t WS_SG = 221 * MiB;
constexpr int GS_SLOT = 54272, GS_Q = 17408, GS_VCT = 34816, GS_VEC = 53248, GS_TB = 18432, GS_AP = 27648;
static_assert(3 * GS_SLOT <= LDS_BYTES - 64, "scan ring");
static_assert(WS_SG + 8 * MiB <= 229 * MiB, "scan buffers");
DI void gs_dma(const unsigned char* src, unsigned lane16, unsigned lds_dst) {
    unsigned keep;
    asm volatile("s_mov_b32 %0, m0\n\ts_mov_b32 m0, %2\n\ts_nop 0\n\tglobal_load_lds_dwordx4 %1, %3\n\ts_mov_b32 m0, %0" : "=&s"(keep) : "v"(lane16), "s"(lds_dst), "s"(src) : "memory");
}
#define GS_WAITBAR(N) asm volatile("s_waitcnt vmcnt(%0) lgkmcnt(0)\n\ts_barrier" :: "n"(N) : "memory")
DI f32x4* gs_img(Frame& F, size_t base, int chain, int grp) { return (f32x4*)(F.ws + base) + (size_t)(chain * NG + grp) * (8 * 8 * 64); }
DI bf16* gs_aop(Frame& F, int chain, int grp) { return (bf16*)(F.ws + WS_AOP) + (size_t)(chain * NG + grp) * (8 * 4 * 64 * 8); }
DI void gs_start_state(Frame& F, int chain, int grp, f32x4 (&S)[8]);
template <int MODE> DI void gscan(Frame& F, const int chain, const int grp, f32x4* finalp, bf16* aop) {
    constexpr bool OUT = MODE == 0;
    constexpr int N1 = OUT ? 7 : (MODE == 1 ? 5 : 3), N2 = OUT ? 5 : 4, NST = OUT ? 16 : 0;
    const int lane = F.lane, n16 = lane & 15, g = lane >> 4, e = F.wave;
    const int bh = chain >> 1, dir = chain & 1, b = bh >> 2, h = bh & 3;
    const unsigned lds0 = (unsigned)(uintptr_t)opaque(F.lds), lane16 = (unsigned)lane * 16u;
    const unsigned char* shrec = F.ws + WS_GSH + (size_t)(bh * 128) * GDN_SH_BYTES; const unsigned char* drec = F.ws + WS_GD + (size_t)((bh * 2 + dir) * 128) * GDN_D_BYTES;
#define GS_ISSUE1(st_, slot_) do { const int sc_ = (st_) < 128 ? (st_) : 127; const int n_ = dir == 0 ? sc_ : 127 - sc_; const unsigned char* sh_ = shrec + (size_t)n_ * GDN_SH_BYTES; const unsigned char* dr_ = drec + (size_t)n_ * GDN_D_BYTES; \
        _Pragma("unroll") for (int j_ = 0; j_ < N1; ++j_) { const int q_ = e + 8 * j_; int p_; \
            if (MODE == 0) p_ = q_ < 53 ? q_ : 52; else if (MODE == 1) p_ = q_ < 17 ? q_ : (q_ < 35 ? q_ + 17 : 52); else p_ = q_ < 17 ? q_ : 52; \
            const unsigned char* src_ = p_ < 34 ? sh_ + p_ * 1024 : (p_ < 52 ? sh_ + G_VCT + (p_ - 34) * 1024 : dr_ + GD_VEC); \
            gs_dma(src_, lane16, (unsigned)__builtin_amdgcn_readfirstlane(lds0 + (unsigned)((slot_) * GS_SLOT + p_ * 1024))); } } while (0)
#define GS_ISSUE2(st_, slot_) do { const int sc_ = (st_) < 128 ? (st_) : 127; const int n_ = dir == 0 ? sc_ : 127 - sc_; const unsigned char* sh_ = shrec + (size_t)n_ * GDN_SH_BYTES; const unsigned char* dr_ = drec + (size_t)n_ * GDN_D_BYTES; \
        _Pragma("unroll") for (int j_ = 0; j_ < N2; ++j_) { const int q_ = e + 8 * j_; const int pm_ = OUT ? 35 : 26; const int p_ = q_ < pm_ ? q_ : pm_; \
            const unsigned char* src_ = p_ < 18 ? sh_ + G_KNTP + p_ * 1024 : dr_ + (p_ - 18) * 1024; \
            gs_dma(src_, lane16, (unsigned)__builtin_amdgcn_readfirstlane(lds0 + (unsigned)((slot_) * GS_SLOT + p_ * 1024))); } } while (0)
    const int st0 = grp * GSTEPS;
    bf16* Odir = (bf16*)((unsigned char*)F.out + (dir == 0 ? DO_OF : DO_OB));
    f32x4 S[8];
    if (MODE == 0 && grp > 0) gs_start_state(F, chain, grp, S);
    else {
#pragma unroll
        for (int i = 0; i < 8; ++i)
#pragma unroll
            for (int r = 0; r < 4; ++r) S[i][r] = (MODE == 2 && (16 * i + 4 * g + r) == (16 * e + n16)) ? 1.0f : 0.0f;
    }
    GS_ISSUE1(st0, 0); GS_ISSUE2(st0, 1);
    bf16x8 Sb[4];
#pragma unroll
    for (int i = 0; i < 4; ++i) Sb[i] = pack8(S[2 * i], S[2 * i + 1]);
    const unsigned aoff272 = n16 * 272 + g * 16, aoff144 = n16 * 144 + g * 16;
#define SB_() __builtin_amdgcn_sched_barrier(0)
#define LDR128(dst, base, off) asm volatile("ds_read_b128 %0, %1 offset:%2" : "=v"(dst) : "v"(base), "i"(off) : "memory")
#define LDR64(dst, base, off) asm volatile("ds_read_b64 %0, %1 offset:%2" : "=v"(dst) : "v"(base), "i"(off) : "memory")
#define LDR32(dst, base, off) asm volatile("ds_read_b32 %0, %1 offset:%2" : "=v"(dst) : "v"(base), "i"(off) : "memory")
    int sl1 = 0, sl2 = 1, sl3 = 2;
#pragma unroll 1
    for (int s = 0; s < GSTEPS; ++s) {
        const int st = st0 + s;
        if (OUT && s > 0) GS_WAITBAR(N2 + NST); else GS_WAITBAR(N2);
        GS_ISSUE1(s + 1 < GSTEPS ? st + 1 : st, sl3);
        const int n = dir == 0 ? st : 127 - st;
        const unsigned h1 = lds0 + (unsigned)sl1 * GS_SLOT, h2 = lds0 + (unsigned)sl2 * GS_SLOT;
        const unsigned bK = h1 + aoff272, bQ = h1 + GS_Q + aoff272, bKT = h2 + aoff144, bT = h2 + GS_TB + aoff144;
        const unsigned bV = h1 + GS_VCT + e * 2304 + n16 * 144 + g * 8, bvec = h1 + GS_VEC + g * 16, bd = h1 + GS_VEC;
        f32x4 eG[4], ks[4]; v2u vv[4]; float dch; bf16x8 fa[16];
        LDR128(eG[0], bvec, 0); LDR128(eG[1], bvec, 64); LDR128(eG[2], bvec, 128); LDR128(eG[3], bvec, 192);
        LDR128(ks[0], bvec, 256); LDR128(ks[1], bvec, 320); LDR128(ks[2], bvec, 384); LDR128(ks[3], bvec, 448);
        LDR32(dch, bd, 512);
        LDR64(vv[0], bV, 0); LDR64(vv[1], bV, 32); LDR64(vv[2], bV, 64); LDR64(vv[3], bV, 96);
#pragma unroll
        for (int m = 0; m < 4; ++m) { LDR128(fa[m * 4 + 0], bK, m * 4352 + 0); LDR128(fa[m * 4 + 1], bK, m * 4352 + 64); LDR128(fa[m * 4 + 2], bK, m * 4352 + 128); LDR128(fa[m * 4 + 3], bK, m * 4352 + 192); }
        bf16x8 fq[16];
        if (OUT) {
#pragma unroll
            for (int m = 0; m < 4; ++m) { LDR128(fq[m * 4 + 0], bQ, m * 4352 + 0); LDR128(fq[m * 4 + 1], bQ, m * 4352 + 64); LDR128(fq[m * 4 + 2], bQ, m * 4352 + 128); LDR128(fq[m * 4 + 3], bQ, m * 4352 + 192); }
            asm volatile("s_waitcnt lgkmcnt(15)" : "+v"(eG[0]), "+v"(eG[1]), "+v"(eG[2]), "+v"(eG[3]), "+v"(ks[0]), "+v"(ks[1]), "+v"(ks[2]), "+v"(ks[3]), "+v"(dch), "+v"(vv[0]), "+v"(vv[1]), "+v"(vv[2]), "+v"(vv[3]),
                         "+v"(fa[0]), "+v"(fa[1]), "+v"(fa[2]), "+v"(fa[3]), "+v"(fa[4]), "+v"(fa[5]), "+v"(fa[6]), "+v"(fa[7]), "+v"(fa[8]), "+v"(fa[9]), "+v"(fa[10]), "+v"(fa[11]), "+v"(fa[12]), "+v"(fa[13]), "+v"(fa[14]), "+v"(fa[15]) :: "memory");
        } else {
            asm volatile("s_waitcnt lgkmcnt(0)" : "+v"(eG[0]), "+v"(eG[1]), "+v"(eG[2]), "+v"(eG[3]), "+v"(ks[0]), "+v"(ks[1]), "+v"(ks[2]), "+v"(ks[3]), "+v"(dch), "+v"(vv[0]), "+v"(vv[1]), "+v"(vv[2]), "+v"(vv[3]),
                         "+v"(fa[0]), "+v"(fa[1]), "+v"(fa[2]), "+v"(fa[3]), "+v"(fa[4]), "+v"(fa[5]), "+v"(fa[6]), "+v"(fa[7]), "+v"(fa[8]), "+v"(fa[9]), "+v"(fa[10]), "+v"(fa[11]), "+v"(fa[12]), "+v"(fa[13]), "+v"(fa[14]), "+v"(fa[15]) :: "memory");
        }
        SB_();
        f32x4 KS[4];
#pragma unroll
        for (int m = 0; m < 4; ++m) KS[m] = (f32x4){0.f, 0.f, 0.f, 0.f};
#pragma unroll
        for (int i = 0; i < 4; ++i)
#pragma unroll
            for (int m = 0; m < 4; ++m) KS[m] = __builtin_amdgcn_mfma_f32_16x16x32_bf16(fa[m * 4 + i], Sb[i], KS[m], 0, 0, 0);
        SB_();
        if (OUT) {
            if (s > 0) asm volatile("s_waitcnt vmcnt(%16) lgkmcnt(0)\n\ts_barrier" : "+v"(fq[0]), "+v"(fq[1]), "+v"(fq[2]), "+v"(fq[3]), "+v"(fq[4]), "+v"(fq[5]), "+v"(fq[6]), "+v"(fq[7]), "+v"(fq[8]), "+v"(fq[9]), "+v"(fq[10]), "+v"(fq[11]), "+v"(fq[12]), "+v"(fq[13]), "+v"(fq[14]), "+v"(fq[15]) : "n"(N1 + NST) : "memory");
            else asm volatile("s_waitcnt vmcnt(%16) lgkmcnt(0)\n\ts_barrier" : "+v"(fq[0]), "+v"(fq[1]), "+v"(fq[2]), "+v"(fq[3]), "+v"(fq[4]), "+v"(fq[5]), "+v"(fq[6]), "+v"(fq[7]), "+v"(fq[8]), "+v"(fq[9]), "+v"(fq[10]), "+v"(fq[11]), "+v"(fq[12]), "+v"(fq[13]), "+v"(fq[14]), "+v"(fq[15]) : "n"(N1) : "memory");
        } else GS_WAITBAR(N1);
        GS_ISSUE2(s + 1 < GSTEPS ? st + 1 : st, sl1);
        bf16x8 ft[8];
#pragma unroll
        for (int m = 0; m < 4; ++m) { LDR128(ft[m * 2 + 0], bT, m * 2304 + 0); LDR128(ft[m * 2 + 1], bT, m * 2304 + 64); }
        SB_();
        f32x4 o[4];
        if (OUT) {
#pragma unroll
            for (int m = 0; m < 4; ++m) o[m] = (f32x4){0.f, 0.f, 0.f, 0.f};
#pragma unroll
            for (int i = 0; i < 4; ++i)
#pragma unroll
                for (int m = 0; m < 4; ++m) o[m] = __builtin_amdgcn_mfma_f32_16x16x32_bf16(fq[m * 4 + i], Sb[i], o[m], 0, 0, 0);
        }
        f32x4 rr[4];
#pragma unroll
        for (int m = 0; m < 4; ++m) {
            if (MODE == 2) { rr[m][0] = -eG[m][0] * KS[m][0]; rr[m][1] = -eG[m][1] * KS[m][1]; rr[m][2] = -eG[m][2] * KS[m][2]; rr[m][3] = -eG[m][3] * KS[m][3]; }
            else { rr[m][0] = bflo(vv[m].x) - eG[m][0] * KS[m][0]; rr[m][1] = bfhi(vv[m].x) - eG[m][1] * KS[m][1]; rr[m][2] = bflo(vv[m].y) - eG[m][2] * KS[m][2]; rr[m][3] = bfhi(vv[m].y) - eG[m][3] * KS[m][3]; } }
        bf16x8 rb[2]; rb[0] = pack8(rr[0], rr[1]); rb[1] = pack8(rr[2], rr[3]);
        SB_();
        bf16x8 fk[16];
#pragma unroll
        for (int jt = 0; jt < 8; ++jt) { LDR128(fk[jt * 2 + 0], bKT, jt * 2304 + 0); LDR128(fk[jt * 2 + 1], bKT, jt * 2304 + 64); }
        asm volatile("s_waitcnt lgkmcnt(15)" : "+v"(ft[0]), "+v"(ft[1]), "+v"(ft[2]), "+v"(ft[3]), "+v"(ft[4]), "+v"(ft[5]), "+v"(ft[6]), "+v"(ft[7]) :: "memory");
        SB_();
        f32x4 vn[4];
#pragma unroll
        for (int m = 0; m < 4; ++m) vn[m] = (f32x4){0.f, 0.f, 0.f, 0.f};
#pragma unroll
        for (int i = 0; i < 2; ++i)
#pragma unroll
            for (int m = 0; m < 4; ++m) vn[m] = __builtin_amdgcn_mfma_f32_16x16x32_bf16(ft[m * 2 + i], rb[i], vn[m], 0, 0, 0);
        if (OUT) {
#pragma unroll
            for (int m = 0; m < 4; ++m) o[m] = o[m] * eG[m];
        }
#pragma unroll
        for (int jt = 0; jt < 8; ++jt) S[jt] = S[jt] * dch;
        SB_();
        bf16x8 fp[8];
        if (OUT) {
#pragma unroll
            for (int m = 0; m < 4; ++m) { LDR128(fp[m * 2 + 0], bT, (GS_AP - GS_TB) + m * 2304 + 0); LDR128(fp[m * 2 + 1], bT, (GS_AP - GS_TB) + m * 2304 + 64); }
        }
        bf16x8 vnb[2]; vnb[0] = pack8(vn[0], vn[1]); vnb[1] = pack8(vn[2], vn[3]);
        bf16x8 vs[2]; vs[0] = pack8(vn[0] * ks[0], vn[1] * ks[1]); vs[1] = pack8(vn[2] * ks[2], vn[3] * ks[3]);
        if (OUT) asm volatile("s_waitcnt lgkmcnt(8)" : "+v"(fk[0]), "+v"(fk[1]), "+v"(fk[2]), "+v"(fk[3]), "+v"(fk[4]), "+v"(fk[5]), "+v"(fk[6]), "+v"(fk[7]), "+v"(fk[8]), "+v"(fk[9]), "+v"(fk[10]), "+v"(fk[11]), "+v"(fk[12]), "+v"(fk[13]), "+v"(fk[14]), "+v"(fk[15]) :: "memory");
        else asm volatile("s_waitcnt lgkmcnt(0)" : "+v"(fk[0]), "+v"(fk[1]), "+v"(fk[2]), "+v"(fk[3]), "+v"(fk[4]), "+v"(fk[5]), "+v"(fk[6]), "+v"(fk[7]), "+v"(fk[8]), "+v"(fk[9]), "+v"(fk[10]), "+v"(fk[11]), "+v"(fk[12]), "+v"(fk[13]), "+v"(fk[14]), "+v"(fk[15]) :: "memory");
        SB_();
#pragma unroll
        for (int i = 0; i < 2; ++i)
#pragma unroll
            for (int jt = 0; jt < 8; ++jt) S[jt] = __builtin_amdgcn_mfma_f32_16x16x32_bf16(fk[jt * 2 + i], vs[i], S[jt], 0, 0, 0);
        if (OUT) {
            asm volatile("s_waitcnt lgkmcnt(0)" : "+v"(fp[0]), "+v"(fp[1]), "+v"(fp[2]), "+v"(fp[3]), "+v"(fp[4]), "+v"(fp[5]), "+v"(fp[6]), "+v"(fp[7]) :: "memory");
#pragma unroll
            for (int i = 0; i < 2; ++i)
#pragma unroll
                for (int m = 0; m < 4; ++m) o[m] = __builtin_amdgcn_mfma_f32_16x16x32_bf16(fp[m * 2 + i], vnb[i], o[m], 0, 0, 0);
        }
#pragma unroll
        for (int i = 0; i < 4; ++i) Sb[i] = pack8(S[2 * i], S[2 * i + 1]);
        SB_();
        if (OUT) {
            bf16* op = Odir + (size_t)(b * SEQ + n * 64) * 512 + h * 128 + 16 * e + n16;
#pragma unroll
            for (int m = 0; m < 4; ++m)
#pragma unroll
                for (int r = 0; r < 4; ++r) op[(size_t)(16 * m + 4 * g + r) * 512] = (bf16)(pk2(o[m][r], 0.f) & 0xffffu);
        }
        { const int t_ = sl1; sl1 = sl3; sl3 = sl2; sl2 = t_; }
    }
#undef SB_
#undef LDR128
#undef LDR64
#undef LDR32
#undef GS_ISSUE1
#undef GS_ISSUE2
    if (finalp) {
#pragma unroll
        for (int i = 0; i < 8; ++i) finalp[(e * 8 + i) * 64 + lane] = S[i];
    }
    if (aop) {
#pragma unroll
        for (int jt = 0; jt < 8; ++jt)
#pragma unroll
            for (int r = 0; r < 4; ++r) aop[((jt * 4 + (e >> 1)) * 64 + 16 * (n16 >> 2) + 4 * g + r) * 8 + 4 * (e & 1) + (n16 & 3)] = (bf16)(pk2(S[jt][r], 0.f) & 0xffffu);
    }
    asm volatile("s_waitcnt vmcnt(0)" ::: "memory");
    __syncthreads();
}
DI void gs_start_state(Frame& F, int chain, int grp, f32x4 (&S)[8]) {
    const int lane = F.lane, e = F.wave;
    { const f32x4* b0 = gs_img(F, WS_XB, chain, 0);
#pragma unroll
      for (int i = 0; i < 8; ++i) S[i] = b0[(e * 8 + i) * 64 + lane]; }
#pragma unroll 1
    for (int gq = 1; gq < grp; ++gq) {
        const f32x4* bg = gs_img(F, WS_XB, chain, gq); const bf16x8* ag = (const bf16x8*)gs_aop(F, chain, gq);
        bf16x8 Sb[4];
#pragma unroll
        for (int i = 0; i < 4; ++i) Sb[i] = pack8(S[2 * i], S[2 * i + 1]);
#pragma unroll
        for (int jt = 0; jt < 8; ++jt) { f32x4 acc = bg[(e * 8 + jt) * 64 + lane];
#pragma unroll
            for (int i = 0; i < 4; ++i) acc = __builtin_amdgcn_mfma_f32_16x16x32_bf16(ag[(jt * 4 + i) * 64 + lane], Sb[i], acc, 0, 0, 0);
            S[jt] = acc; }
    }
}
constexpr int CV_QS = NEXP * 32, CV_WD = NEXP * 32, CV_WO = 64, CV_RT = 16, CV_ITEMS = CV_QS + CV_WD + CV_WO + CV_RT;
DI void conv_item(Frame& F, int it) {
    LAS float* scr = (LAS float*)(F.lds + F.wave * 16384);
    if (it < CV_QS) {
        const int e = it >> 5, mat = (it >> 4) & 1, nb = it & 15;
        q_strip((mat ? F.in[14] : F.in[13]) + (size_t)e * 1024 * 512, 512, 32 * nb, wgu_ptr(F, e), (float*)(F.ws + WS_WSC) + e * 1024, mat + 64 * nb, 2, F.lds, F.wave, F.lane);
    } else if (it < CV_QS + CV_WD) {
        const int w = (it - CV_QS) * 8 + F.wave, e = w >> 8, r = w & 255;
        p0_transpose_item(F.in[15] + (size_t)e * 512 * 1024, 1024, 32, wd_ptr(F, e), 512, 0, 1, scr, r, F.lane);
    } else if (it < CV_QS + CV_WD + CV_WO) {
        p0_transpose_item(F.in[9], 1024, 32, (bf16*)(F.ws + WS_WOUT), 1024, 0, 1, scr, (it - CV_QS - CV_WD) * 8 + F.wave, F.lane);
    } else {
        bf16* WRH = (bf16*)(F.ws + WS_WR); bf16* WRL = WRH + 48 * 1024; const float* wrg = F.in[11]; const float* wre = F.in[12];
        const int base = (it - CV_QS - CV_WD - CV_WO) * 3072;
#pragma unroll
        for (int q = 0; q < 6; ++q) { const int i = base + q * 512 + F.tid; const int j = i >> 10, k = i & 1023; float v = 0.f; if (j < 4) v = wrg[k * 4 + j]; else if (j < 36) v = wre[k * 32 + (j - 4)];
            const unsigned hh = f2bf(v); const float hv = __builtin_bit_cast(float, hh << 16); WRH[i] = (bf16)hh; WRL[i] = (bf16)f2bf(v - hv); }
    }
}
constexpr int CW_CONVQ = 12288;
static_assert(48 * PASS1_QUOTA <= CV_QS, "pass 1 may only take gate/up strips");
DI void conv_pull(Frame& F, int quota) {
    volatile LAS int* slot = (volatile LAS int*)(F.lds + MISC_OFF + 32);
    for (int n = 0; n < quota; ++n) {
        __syncthreads();
        if (F.tid == 0) *slot = (int)xb_add((unsigned*)(F.ws + WS_CTL) + CW_CONVQ, 1u);
        __syncthreads();
        const int it = *slot; if (it >= CV_ITEMS) break;
        conv_item(F, it);
    }
    __syncthreads();
}
DI void p4_pass1(Frame& F) {
    const int T = F.vcu, part = T & 1, cg = T >> 1, chain = cg / (NG - 1), grp = cg % (NG - 1);
    if (T < 16 * (NG - 1) * 2 && part == 0) gscan<1>(F, chain, grp, gs_img(F, WS_XB, chain, grp), nullptr);
    else if (T < 16 * (NG - 1) * 2 && grp > 0) gscan<2>(F, chain, grp, nullptr, gs_aop(F, chain, grp));
    else conv_pull(F, PASS1_QUOTA);
}
DI void p4_pass3(Frame& F) {
    if ((F.vcu & 1) == 0 && (F.vcu >> 1) < 16 * NG) { const int T = F.vcu >> 1; gscan<0>(F, T / NG, T % NG, nullptr, nullptr); }
    conv_pull(F, 1 << 30);
}

DI void p5_combine(Frame& F) {
    const int gw = F.vcu * NWAVES + F.wave, NGW = F.G * NWAVES, lane = F.lane;
    const bf16* OFp = (const bf16*)((unsigned char*)F.out + DO_OF); const bf16* OBp = (const bf16*)((unsigned char*)F.out + DO_OB);
    const bf16* ZA = (const bf16*)(F.ws + WS_ZA); bf16* OCAT = (bf16*)(F.ws + WS_OCAT);
    const float* nw = F.in[6] + (lane & 15) * 8;
    float w8[8];
#pragma unroll
    for (int c = 0; c < 8; ++c) w8[c] = nw[c];
    constexpr int NB4 = 4;
    for (int t0 = gw; t0 < TT; t0 += NB4 * NGW) {
        v4u a[NB4], bb[NB4], z[NB4];
#pragma unroll
        for (int u = 0; u < NB4; ++u) { const int t = (t0 + u * NGW < TT) ? t0 + u * NGW : t0;
            a[u] = *(const v4u*)(OFp + (size_t)t * 512 + lane * 8); bb[u] = *(const v4u*)(OBp + (size_t)t * 512 + lane * 8); z[u] = *(const v4u*)(ZA + (size_t)t * 512 + lane * 8); }
#pragma unroll
        for (int u = 0; u < NB4; ++u) {
            const int t = t0 + u * NGW; if (t >= TT) break;
            float o[8] = {bflo(a[u].x) + bflo(bb[u].x), bfhi(a[u].x) + bfhi(bb[u].x), bflo(a[u].y) + bflo(bb[u].y), bfhi(a[u].y) + bfhi(bb[u].y), bflo(a[u].z) + bflo(bb[u].z), bfhi(a[u].z) + bfhi(bb[u].z), bflo(a[u].w) + bflo(bb[u].w), bfhi(a[u].w) + bfhi(bb[u].w)};
            const float zz[8] = {bflo(z[u].x), bfhi(z[u].x), bflo(z[u].y), bfhi(z[u].y), bflo(z[u].z), bfhi(z[u].z), bflo(z[u].w), bfhi(z[u].w)};
            float ss = 0.f;
#pragma unroll
            for (int c = 0; c < 8; ++c) ss += o[c] * o[c];
            ss = sum16(ss);
            const float rn = __builtin_amdgcn_rsqf(ss * (1.f / 128.f) + EPS);
#pragma unroll
            for (int c = 0; c < 8; ++c) o[c] = o[c] * rn * w8[c] * siluf(zz[c]);
            v4u r; r.x = pk2(o[0], o[1]); r.y = pk2(o[2], o[3]); r.z = pk2(o[4], o[5]); r.w = pk2(o[6], o[7]);
            *(v4u*)(OCAT + (size_t)t * 1024 + lane * 8) = r;
        }
    }
}

struct TokRec { int e[2]; int row[2]; float gate[2]; };
DI void p7_route(Frame& F) {
    const int lane = F.lane, n16 = lane & 15, g = lane >> 4, wave = F.wave;
    const bf16* X1 = (const bf16*)(F.ws + WS_X1); const float* nfw = F.in[10];
    const bf16* WRH = (const bf16*)(F.ws + WS_WR); const bf16* WRL = WRH + 48 * 1024;
    unsigned char* HN = (unsigned char*)F.out + DO_HN; TokRec* TOK = (TokRec*)(F.ws + WS_TOK); unsigned* gcnt = (unsigned*)(F.ws + WS_CTL) + CW_CNT; int* LIST = (int*)(F.ws + WS_LIST);
    LAS float* lg = (LAS float*)(F.lds + (wave & 3) * 4096);
    LAS unsigned* hist = (LAS unsigned*)(F.lds + 16384); LAS unsigned* base = hist + 32;
    const int sub = blockIdx.x & 7;
    const float qsc = 127.0f / act_absmax(nfw, lane);
    for (int rt0 = blockIdx.x * 4; rt0 < TT / 16; rt0 += F.G * 4) {
        if (F.tid < 32) hist[F.tid] = 0u;
        __syncthreads();
        int ex1 = 0, ex2 = 0, tok = -1; unsigned l1 = 0, l2 = 0; float g1 = 0.f, g2 = 0.f;
        const int rt = rt0 + wave;
        const bool act = wave < 4 && rt < TT / 16;
        const int row = (act ? rt : rt0) * 16 + n16; const bf16* xr = X1 + (size_t)row * DMODEL + 8 * g;
        constexpr int P7_WOFF = 32768, P7_WCH = 26624;
        unsigned wsrc[4];
#pragma unroll
        for (int j = 0; j < 4; ++j) { const int pp = (wave + 8 * j) < 25 ? (wave + 8 * j) : 25; int G = pp * 64 + lane; G = G > 1631 ? 1631 : G;
            const int mat = G / 816, rem = G - mat * 816, r = rem / 17, c = rem - 17 * r;
            wsrc[j] = (unsigned)(mat * 98304 + r * 2048 + (c < 16 ? c : 15) * 16); }
        const unsigned ldsw0 = (unsigned)(uintptr_t)F.lds + P7_WOFF;
#define P7_DMA(ch_, buf_) do { _Pragma("unroll") for (int j = 0; j < 4; ++j) gs_dma((const unsigned char*)WRH, wsrc[j] + (unsigned)(ch_) * 256u, (unsigned)__builtin_amdgcn_readfirstlane(ldsw0 + (unsigned)((buf_) * P7_WCH + ((wave + 8 * j) < 25 ? (wave + 8 * j) : 25) * 1024))); } while (0)
        P7_DMA(0, 0); P7_DMA(1, 1);
        float rs = 0.f;
        if (act) {
            float ss = 0.f;
#pragma unroll 16
            for (int i = 0; i < 32; ++i) { const v4u xw = *(const v4u*)(xr + 32 * i); const f32x4 a = {bflo(xw.x), bfhi(xw.x), bflo(xw.y), bfhi(xw.y)}, b2 = {bflo(xw.z), bfhi(xw.z), bflo(xw.w), bfhi(xw.w)};
                ss += (a.x * a.x + a.y * a.y) + (a.z * a.z + a.w * a.w) + (b2.x * b2.x + b2.y * b2.y) + (b2.z * b2.z + b2.w * b2.w); }
            ss = sum_x32(sum_x16(ss));
            rs = __builtin_amdgcn_rsqf(ss * (1.f / DMODEL) + EPS);
        }
        f32x4 acc[3];
#pragma unroll
        for (int q = 0; q < 3; ++q) acc[q] = (f32x4){0.f, 0.f, 0.f, 0.f};
        struct P7In { v4u xw[4]; f32x4 wa[4], wb[4]; };
#define P7_LOAD(D, ch_) do { _Pragma("unroll") for (int ii = 0; ii < 4; ++ii) { const int i_ = 4 * (ch_) + ii; D.xw[ii] = *(const v4u*)(xr + 32 * i_); D.wa[ii] = *(const f32x4*)(nfw + 32 * i_ + 8 * g); D.wb[ii] = *(const f32x4*)(nfw + 32 * i_ + 8 * g + 4); } } while (0)
#define P7_COMP(D, ch_, buf_) do { const LAS unsigned char* wb_ = F.lds + P7_WOFF + (buf_) * P7_WCH + n16 * 272 + g * 16; \
            _Pragma("unroll") for (int ii = 0; ii < 4; ++ii) { const int i_ = 4 * (ch_) + ii; \
                const v4u xw = D.xw[ii]; const f32x4 a = {bflo(xw.x), bfhi(xw.x), bflo(xw.y), bfhi(xw.y)}, b2 = {bflo(xw.z), bfhi(xw.z), bflo(xw.w), bfhi(xw.w)}; const f32x4 wa = D.wa[ii], wb = D.wb[ii]; \
                float hv[8] = {a.x * rs * wa.x, a.y * rs * wa.y, a.z * rs * wa.z, a.w * rs * wa.w, b2.x * rs * wb.x, b2.y * rs * wb.y, b2.z * rs * wb.z, b2.w * rs * wb.w}; \
                v4u hi, lo; \
                hi.x = pk2(hv[0], hv[1]); hi.y = pk2(hv[2], hv[3]); hi.z = pk2(hv[4], hv[5]); hi.w = pk2(hv[6], hv[7]);            \
                lo.x = pk2(hv[0] - bflo(hi.x), hv[1] - bfhi(hi.x)); lo.y = pk2(hv[2] - bflo(hi.y), hv[3] - bfhi(hi.y));             \
                lo.z = pk2(hv[4] - bflo(hi.z), hv[5] - bfhi(hi.z)); lo.w = pk2(hv[6] - bflo(hi.w), hv[7] - bfhi(hi.w)); \
                { v2u q; q.x = q8x4(hv[0], hv[1], hv[2], hv[3], qsc); q.y = q8x4(hv[4], hv[5], hv[6], hv[7], qsc); *(v2u*)(HN + (size_t)row * DMODEL + 32 * i_ + 8 * g) = q; } \
                const bf16x8 ah = __builtin_bit_cast(bf16x8, hi), al = __builtin_bit_cast(bf16x8, lo); \
                _Pragma("unroll") for (int q = 0; q < 3; ++q) { \
                    const bf16x8 bh = *(const LAS bf16x8*)(wb_ + q * 4352 + ii * 64), bl = *(const LAS bf16x8*)(wb_ + 13056 + q * 4352 + ii * 64); \
                    acc[q] = __builtin_amdgcn_mfma_f32_16x16x32_bf16(ah, bh, acc[q], 0, 0, 0); \
                    acc[q] = __builtin_amdgcn_mfma_f32_16x16x32_bf16(ah, bl, acc[q], 0, 0, 0); \
                    acc[q] = __builtin_amdgcn_mfma_f32_16x16x32_bf16(al, bh, acc[q], 0, 0, 0); } } } while (0)
#define P7_BODY(DC, DN, ch_, cur_, nn_) do { if (act) asm volatile("s_waitcnt vmcnt(36)" ::: "memory"); else asm volatile("s_waitcnt vmcnt(4)" ::: "memory"); \
            if ((ch_) >= 6) asm volatile("s_waitcnt vmcnt(0)" ::: "memory");            \
            __builtin_amdgcn_s_barrier(); asm volatile("" ::: "memory"); \
            if ((ch_) + 2 < 8) P7_DMA((ch_) + 2, nn_); \
            if (act) { if ((ch_) + 1 < 8) P7_LOAD(DN, (ch_) + 1); P7_COMP(DC, ch_, cur_); } \
            asm volatile("" ::: "memory"); } while (0)
        P7In XA, XB;
        if (act) P7_LOAD(XA, 0);
        int b0 = 0, b1 = 1, b2 = 2;
#pragma unroll 1
        for (int ch = 0; ch < 8; ch += 2) { P7_BODY(XA, XB, ch, b0, b2); P7_BODY(XB, XA, ch + 1, b1, b0); { const int t_ = b0; b0 = b2; b2 = b1; b1 = t_; } }
#undef P7_LOAD
#undef P7_COMP
#undef P7_BODY
#undef P7_DMA
        if (act) {
#pragma unroll
            for (int q = 0; q < 3; ++q)
#pragma unroll
                for (int r = 0; r < 4; ++r) lg[(4 * g + r) * 48 + 16 * q + n16] = acc[q][r];
            asm volatile("s_waitcnt lgkmcnt(0)" ::: "memory");
            if (lane < 16) {
                const LAS float* L = lg + lane * 48; tok = rt * 16 + lane;
                float gm = L[0]; int gs = 0;
#pragma unroll
                for (int q = 1; q < 4; ++q) if (L[q] > gm) { gm = L[q]; gs = q; }
                float gsum = 0.f;
#pragma unroll
                for (int q = 0; q < 4; ++q) gsum += __expf(L[q] - gm);
                const float gp_top = 1.0f / gsum;
                float fv[8];
#pragma unroll
                for (int q = 0; q < 8; ++q) { float v = L[4 + q]; v = (gs == 1) ? L[12 + q] : v; v = (gs == 2) ? L[20 + q] : v; v = (gs == 3) ? L[28 + q] : v; fv[q] = v; }
                float m1 = fv[0]; int i1 = 0;
#pragma unroll
                for (int q = 1; q < 8; ++q) if (fv[q] > m1) { m1 = fv[q]; i1 = q; }
                float m2 = -3.0e38f; int i2 = 0;
#pragma unroll
                for (int q = 0; q < 8; ++q) if (q != i1 && fv[q] > m2) { m2 = fv[q]; i2 = q; }
                const float e2 = __expf(m2 - m1); g1 = gp_top / (1.0f + e2); g2 = gp_top * e2 / (1.0f + e2);
                ex1 = gs * 8 + i1; ex2 = gs * 8 + i2;
                l1 = __hip_atomic_fetch_add(hist + ex1, 1u, __ATOMIC_RELAXED, __HIP_MEMORY_SCOPE_WORKGROUP); l2 = __hip_atomic_fetch_add(hist + ex2, 1u, __ATOMIC_RELAXED, __HIP_MEMORY_SCOPE_WORKGROUP);
            }
        }
        __syncthreads();
        if (F.tid < 32) { const unsigned hcount = hist[F.tid]; base[F.tid] = hcount ? atomicAdd(gcnt + F.tid * 8 + sub, hcount) : 0u; }
        __syncthreads();
        if (tok >= 0) {
            const int s1 = (int)(base[ex1] + l1), s2 = (int)(base[ex2] + l2);
            LIST[(size_t)(ex1 * 8 + sub) * TT + s1] = tok; LIST[(size_t)(ex2 * 8 + sub) * TT + s2] = tok;
            TokRec tr; tr.e[0] = ex1; tr.e[1] = ex2; tr.row[0] = (sub << 24) | s1; tr.row[1] = (sub << 24) | s2; tr.gate[0] = g1; tr.gate[1] = g2;
            TOK[tok] = tr;
        }
    }
}

DI void build_etab(Frame& F) {
    LAS unsigned* etab = (LAS unsigned*)(F.lds + ETAB_OFF);
    if (F.tid < 32) {
        const unsigned* gcnt = (const unsigned*)(F.ws + WS_CTL) + CW_CNT + F.tid * 8; unsigned acc = 0;
#pragma unroll
        for (int q = 0; q < 8; ++q) { const unsigned c = __hip_atomic_load(gcnt + q, __ATOMIC_RELAXED, __HIP_MEMORY_SCOPE_AGENT); etab[96 + 8 * F.tid + q] = acc; acc += c; }
        etab[64 + F.tid] = acc; etab[2 * F.tid + 1] = (acc + 255u) >> 8;
    }
    __syncthreads();
    if (F.tid == 0) { unsigned acc = 0; for (int e = 0; e < NEXP; ++e) { etab[2 * e] = acc; acc += etab[2 * e + 1]; } }
    if (F.wave == 1) { const float am = act_absmax(F.in[10], F.lane); if (F.lane == 0) ((LAS float*)etab)[352] = am * (1.0f / 127.0f); }
    __syncthreads();
}

DI void p11_final(Frame& F) {
    build_etab(F);
    const LAS unsigned* etab = (const LAS unsigned*)(F.lds + ETAB_OFF);
    const int gw = F.vcu * NWAVES + F.wave, NGW = F.G * NWAVES, lane = F.lane;
    const bf16* Y = (const bf16*)(F.ws + WS_XBUF); const TokRec* TOK = (const TokRec*)(F.ws + WS_TOK); const float* fw = F.in[16];
    const f32x4 w0 = *(const f32x4*)(fw + lane * 8), w1 = *(const f32x4*)(fw + lane * 8 + 4), w2 = *(const f32x4*)(fw + 512 + lane * 8), w3 = *(const f32x4*)(fw + 516 + lane * 8);
    constexpr int NB2 = 2;
    for (int t0 = gw; t0 < TT; t0 += NB2 * NGW) {
        TokRec tr[NB2]; v4u xa[NB2][2]; v4u ya[NB2][2][2];
#pragma unroll
        for (int u = 0; u < NB2; ++u) { const int t = (t0 + u * NGW < TT) ? t0 + u * NGW : t0; tr[u] = TOK[t];
            const bf16* xr = (const bf16*)(F.ws + WS_X1) + (size_t)t * DMODEL + lane * 8;
            xa[u][0] = *(const v4u*)(xr); xa[u][1] = *(const v4u*)(xr + 512); }
#pragma unroll
        for (int u = 0; u < NB2; ++u)
#pragma unroll
            for (int k = 0; k < 2; ++k) { const unsigned rk = (unsigned)tr[u].row[k]; const bf16* yr = Y + (size_t)(etab[2 * tr[u].e[k]] * 256u + etab[96 + 8 * tr[u].e[k] + (rk >> 24)] + (rk & 0xffffffu)) * DMODEL + lane * 8; ya[u][k][0] = *(const v4u*)(yr); ya[u][k][1] = *(const v4u*)(yr + 512); }
#pragma unroll
        for (int u = 0; u < NB2; ++u) {
            const int t = t0 + u * NGW; if (t >= TT) break;
            float v[16] = {bflo(xa[u][0].x), bfhi(xa[u][0].x), bflo(xa[u][0].y), bfhi(xa[u][0].y), bflo(xa[u][0].z), bfhi(xa[u][0].z), bflo(xa[u][0].w), bfhi(xa[u][0].w),
                           bflo(xa[u][1].x), bfhi(xa[u][1].x), bflo(xa[u][1].y), bfhi(xa[u][1].y), bflo(xa[u][1].z), bfhi(xa[u][1].z), bflo(xa[u][1].w), bfhi(xa[u][1].w)};
#pragma unroll
            for (int k = 0; k < 2; ++k) {
                const float gk = tr[u].gate[k]; const v4u y0 = ya[u][k][0], y1 = ya[u][k][1];
                v[0] += gk * bflo(y0.x); v[1] += gk * bfhi(y0.x); v[2] += gk * bflo(y0.y); v[3] += gk * bfhi(y0.y); v[4] += gk * bflo(y0.z); v[5] += gk * bfhi(y0.z); v[6] += gk * bflo(y0.w); v[7] += gk * bfhi(y0.w);
                v[8] += gk * bflo(y1.x); v[9] += gk * bfhi(y1.x); v[10] += gk * bflo(y1.y); v[11] += gk * bfhi(y1.y); v[12] += gk * bflo(y1.z); v[13] += gk * bfhi(y1.z); v[14] += gk * bflo(y1.w); v[15] += gk * bfhi(y1.w);
            }
            float ss = 0.f;
#pragma unroll
            for (int i = 0; i < 16; ++i) ss += v[i] * v[i];
            const float rs = __builtin_amdgcn_rsqf(wave_sum(ss) * (1.f / DMODEL) + EPS);
            float* orow = F.out + (size_t)t * DMODEL + lane * 8;
            *(f32x4*)(orow) = (f32x4){v[0] * rs * w0.x, v[1] * rs * w0.y, v[2] * rs * w0.z, v[3] * rs * w0.w};
            *(f32x4*)(orow + 4) = (f32x4){v[4] * rs * w1.x, v[5] * rs * w1.y, v[6] * rs * w1.z, v[7] * rs * w1.w};
            *(f32x4*)(orow + 512) = (f32x4){v[8] * rs * w2.x, v[9] * rs * w2.y, v[10] * rs * w2.z, v[11] * rs * w2.w};
            *(f32x4*)(orow + 516) = (f32x4){v[12] * rs * w3.x, v[13] * rs * w3.y, v[14] * rs * w3.z, v[15] * rs * w3.w};
        }
    }
}

struct Args { const float* in[17]; float* out; unsigned char* ws; int ph_lo, ph_hi; };
__global__ void __launch_bounds__(NTHREADS, 2) fwd_kernel(Args args) {
    extern __shared__ __attribute__((aligned(16))) unsigned char lds[];
    cg::grid_group grid = cg::this_grid();
    Frame F;
    F.lds = (LAS unsigned char*)lds; F.tid = threadIdx.x; F.lane = F.tid & 63; F.wave = __builtin_amdgcn_readfirstlane(F.tid >> 6);
    F.G = gridDim.x; { const int bx = blockIdx.x; F.vcu = (F.G % 8 == 0) ? (bx % 8) * (F.G / 8) + bx / 8 : bx; }
#pragma unroll
    for (int i = 0; i < 17; ++i) F.in[i] = args.in[i];
    F.out = args.out; F.ws = args.ws;
    const int lo = args.ph_lo, hi = args.ph_hi;
    if (F.tid < 16) ((volatile LAS unsigned*)(F.lds + MISC_OFF))[F.tid] = 0u;
    __syncthreads();
    XcdBarrier bar = xcd_barrier_post((unsigned*)(F.ws + WS_CTL) + CW_BAR, (volatile LAS unsigned*)(F.lds + MISC_OFF));
    if (lo > 1000) grid.sync();
#ifndef PHSEL
#define PHSEL 0xfff
#endif
#define IN(k) (((PHSEL >> (k)) & 1) && lo <= (k) && (k) < hi)
#define SEAM(k) do { if (IN(k) && IN((k) + 1)) xcd_barrier(bar); } while (0)
#ifndef REP_PH
#define REP_PH -1
#endif
#define REPS(k) for (int rep_ = 0; rep_ < ((k) == REP_PH ? 2 : 1); ++rep_, ((k) == REP_PH && rep_ < 2) ? xcd_barrier(bar) : (void)0)
    if (F.tid == 0) __hip_atomic_store((unsigned*)(F.ws + WS_CTL) + CW_XCC + blockIdx.x, (xb_xcc_id() & 15u) + 1u, __ATOMIC_RELAXED, __HIP_MEMORY_SCOPE_AGENT);
    if (IN(0)) REPS(0) { p0_prologue(F); } SEAM(0);
    if (F.tid < 32 && (F.G % 8 == 0) && IN(0) && IN(1)) {
        const int j = (int)(blockIdx.x & 7) + 8 * F.tid;
        if (j < F.G) { const unsigned other = __hip_atomic_load((unsigned*)(F.ws + WS_CTL) + CW_XCC + j, __ATOMIC_RELAXED, __HIP_MEMORY_SCOPE_AGENT);
            if (other != (xb_xcc_id() & 15u) + 1u) __hip_atomic_fetch_or((unsigned*)(F.ws + WS_CTL) + CW_XBAD, 1u, __ATOMIC_RELAXED, __HIP_MEMORY_SCOPE_AGENT); } }
    if (IN(1)) REPS(1) {
        pg8::Gemm gm{(const pg8::bf16_t*)(F.ws + WS_XN), (const pg8::bf16_t*)(F.ws + WS_WIN), TT, NPROJ, DMODEL / 2};
        pg8::StaticOrder S; S.init(TT, NPROJ, F.G, (int)blockIdx.x);
        EpiProj E{(bf16*)(F.ws + WS_QKVA), (bf16*)(F.ws + WS_ZA), (bf16*)(F.ws + WS_QKVB), (const float*)(F.ws + WS_WSI), (const float*)(F.ws + WS_XSC)};
        pg8::gemm_phase_gather<EpiProj, pg8::StaticOrder, IdRows, true, true>(F.lds, gm, S, E, IdRows{});
    } SEAM(1);
    if (IN(2)) REPS(2) {
#ifndef NO_ROPE
        p2_rope(F);
#ifdef PROBE_ROPE2
        xcd_barrier(bar); p2_rope(F);
#endif
#endif
#ifndef NO_PRE
        p2_gdn_pre(F);
#ifdef PROBE_PRE2
        xcd_barrier(bar); p2_gdn_pre(F);
#endif
#endif
    } SEAM(2);
    if (IN(3)) REPS(3) {
        const attn_body::AttnTensors AT{(const attn_body::bf16*)((unsigned char*)F.out + DO_QR), (const attn_body::bf16*)((unsigned char*)F.out + DO_KR), (const attn_body::bf16*)((unsigned char*)F.out + DO_VR),
                                        (attn_body::bf16*)(F.ws + WS_OCAT) + 512};
        const attn_body::StaticOrder S((int)F.G, (int)blockIdx.x);
#ifdef PROBE_ZERO_ATTN
        { (void)AT; (void)S; bf16* OC = (bf16*)(F.ws + WS_OCAT); const int gt = blockIdx.x * NTHREADS + F.tid, GT = F.G * NTHREADS;
          for (int i = gt; i < TT * 64; i += GT) { const int t = i >> 6, c = i & 63; *(v4u*)(OC + (size_t)t * 1024 + 512 + c * 8) = (v4u){0u, 0u, 0u, 0u}; } }
#else
        const float nshift = -(0.125f * 1.4426950408889634f * 64.f * 1.01f) * wave_max(fabsf(F.in[7][F.lane])) * wave_max(fabsf(F.in[8][F.lane]));
        attn_body::attn_phase<attn_body::StaticOrder>((char*)lds, AT, S, nshift);
#endif
    }
#if MK_PER_PHASE
    SEAM(3);
#endif
    if (IN(4)) { p4_pass1(F); xcd_barrier(bar); p4_pass3(F); } SEAM(4);
    if (IN(5)) REPS(5) { p5_combine(F); } SEAM(5);
    if (IN(6)) REPS(6) {
        pg8::Gemm gm{(const pg8::bf16_t*)(F.ws + WS_OCAT), (const pg8::bf16_t*)(F.ws + WS_WOUT), TT, DMODEL, DMODEL}; pg8::StaticOrder S; S.init(TT, DMODEL, F.G, (int)blockIdx.x);
        EpiResid E{F.in[0], (bf16*)(F.ws + WS_X1)};
        pg8::gemm_phase<EpiResid, pg8::StaticOrder, true, true>(F.lds, gm, S, E);
    } SEAM(6);
    if (IN(7)) { p7_route(F); } SEAM(7);
    const bool handoff = !MK_PER_PHASE && (F.G % 8 == 0) && IN(0) && IN(1) && IN(9) && IN(10) &&
        __builtin_amdgcn_readfirstlane(__hip_atomic_load((unsigned*)(F.ws + WS_CTL) + CW_XBAD, __ATOMIC_RELAXED, __HIP_MEMORY_SCOPE_AGENT)) == 0u;
    if (IN(9)) REPS(9) {
        build_etab(F);
        pg8::Gemm gm{(const pg8::bf16_t*)((unsigned char*)F.out + DO_HN), (const pg8::bf16_t*)(F.ws + WS_WGU0), 0, 0, DMODEL / 2};
        MoeOrder S{(const LAS unsigned*)(F.lds + ETAB_OFF), F.G, (int)blockIdx.x, WGU_SPLIT, (int)((WS_WGU1 - WS_WGU0) / (256 * 1024)), (mo_gu32*)((unsigned*)(F.ws + WS_CTL) + CW_HIDC), handoff ? 1 : 0, 0, -1};
        MoeRows AM{(const int*)(F.ws + WS_LIST), (const LAS unsigned*)(F.lds + ETAB_OFF)};
        EpiGU E{(bf16*)(F.ws + WS_HID), (const float*)(F.ws + WS_WSC), ((const LAS float*)(F.lds + ETAB_OFF))[352]};
        pg8::gemm_phase_gather<EpiGU, MoeOrder, MoeRows, true, true>(F.lds, gm, S, E, AM);
        S.flush();
    }
    if (!handoff) SEAM(9);
    if (IN(10)) REPS(10) {
        pg8::Gemm gm{(const pg8::bf16_t*)(F.ws + WS_HID), (const pg8::bf16_t*)((unsigned char*)F.out + DO_WD0), 0, 0, FFE}; build_etab(F);
        MoeOrder S{(const LAS unsigned*)(F.lds + ETAB_OFF), F.G, (int)blockIdx.x, WD_SPLIT, (int)((DO_WD1 - DO_WD0) / (256 * 1024)), (mo_gu32*)((unsigned*)(F.ws + WS_CTL) + CW_HIDC), handoff ? 2 : 0, 0, -1};
        if (handoff) S.rot = S.xcd_units() % (F.G >> 3);
        EpiY E{(bf16*)(F.ws + WS_XBUF)};
        pg8::gemm_phase<EpiY, MoeOrder, true, true>(F.lds, gm, S, E);
    } SEAM(10);
#ifdef EXTRA_SYNCS
    for (int q_ = 0; q_ < EXTRA_SYNCS; ++q_) xcd_barrier(bar);
#endif
    if (IN(11)) { p11_final(F); }
#undef IN
#undef SEAM
}

extern "C" void kernel_launch(void* const* d_in, const int* in_sizes, int n_in, void* d_out, int out_size, void* d_ws, size_t ws_size, hipStream_t stream) {
    static int grid = 0;
    if (grid == 0) {
        if (n_in != 17 || out_size != TT * DMODEL || ws_size < WS_END) { fprintf(stderr, "kernel_launch: unexpected problem (n_in %d out %d ws %zu)\n", n_in, out_size, ws_size); grid = -1; return; }
        int dev = 0, cus = 0, per_cu = 0;
        if (hipGetDevice(&dev) != hipSuccess || hipDeviceGetAttribute(&cus, hipDeviceAttributeMultiprocessorCount, dev) != hipSuccess) { grid = -1; return; }
        if (hipFuncSetAttribute((const void*)fwd_kernel, hipFuncAttributeMaxDynamicSharedMemorySize, LDS_BYTES) != hipSuccess) { fprintf(stderr, "hipFuncSetAttribute failed\n"); grid = -1; return; }
        if (hipOccupancyMaxActiveBlocksPerMultiprocessor(&per_cu, (const void*)fwd_kernel, NTHREADS, LDS_BYTES) != hipSuccess || per_cu < 1) { fprintf(stderr, "occupancy query: %d\n", per_cu); grid = -1; return; }
        if (cus < 256) { fprintf(stderr, "kernel_launch: %d CUs; the scan phase's task map needs 256 workgroups\n", cus); grid = -1; return; }
        grid = cus;
    }
    if (grid < 0) return;
    (void)hipMemsetAsync((char*)d_ws + WS_CTL, 0, CTL_ZERO_BYTES, stream);
    Args a{};
    for (int i = 0; i < 17; ++i) a.in[i] = (const float*)d_in[i];
    a.out = (float*)d_out; a.ws = (unsigned char*)d_ws;
#if MK_PER_PHASE
    for (int p = 0; p < N_PHASES; ++p) { a.ph_lo = p; a.ph_hi = p + 1; hipLaunchKernelGGL(fwd_kernel, dim3(grid), dim3(NTHREADS), LDS_BYTES, stream, a); }
#else
    a.ph_lo = 0; a.ph_hi = N_PHASES;
    void* kargs[] = {&a};
    hipError_t e = hipLaunchCooperativeKernel((void*)fwd_kernel, dim3(grid), dim3(NTHREADS), kargs, LDS_BYTES, stream);
    if (e != hipSuccess) fprintf(stderr, "cooperative launch failed: %s (grid %d)\n", hipGetErrorString(e), grid);
#endif
}
```

```cpp
#include <hip/hip_runtime.h>
#include <cstdio>
#include <cstdint>
namespace pg8 {
#define PG8_LAS __attribute__((address_space(3)))
typedef unsigned short bf16_t;
typedef short bf16x8 __attribute__((ext_vector_type(8)));
typedef float f32x4 __attribute__((ext_vector_type(4)));
typedef unsigned u32x4 __attribute__((ext_vector_type(4)));
constexpr int BM = 256, BK = 64, HALF = 128, HTB = HALF * BK * 2  , STAGE_BYTES = 8 * HTB, NXCD = 8, WGM = 8;

__host__ __device__ __forceinline__ int lds_byte(int r, int c) { const int st = (r >> 4) * 2 + (c >> 5), rr = r & 15, cc = c & 31, ob = rr * 64 + cc * 2; return st * 1024 + (ob ^ (((ob >> 9) & 1) << 5)); }
__host__ __device__ __forceinline__ void stage_rc(int b, int& R, int& C) { const int st = b / 1024, sb = b % 1024, swz = sb ^ (((sb >> 9) & 1) << 5); R = (st >> 1) * 16 + swz / 64; C = (st & 1) * 32 + (swz % 64) / 2; }
__host__ __device__ __forceinline__ int perm32(int rho) { const int n = rho >> 4, i = rho & 15; return 8 * (i >> 2) + 4 * n + (i & 3); }

struct Unit { int pm, pn, ex, tq; };
struct Gemm { const bf16_t* A; const bf16_t* Bt; int M, N, K; };

struct StaticOrder {
    int nM, nN, nwg, G, c;
    __host__ __device__ void init(int M, int N, int G_, int c_) { nM = M / BM; nN = N / BM; nwg = nM * nN; G = G_; c = c_; }
    __host__ __device__ bool next(int i, Unit& u) const {
        const long L = (long)i * G + c; if (L >= nwg) return false;
        int wgid = (int)L; { const int q = nwg / NXCD, r = nwg % NXCD, xcd = wgid % NXCD, off = wgid / NXCD; wgid = (xcd < r ? xcd * (q + 1) : r * (q + 1) + (xcd - r) * q) + off; }
        const int nig = WGM * nN, gid = wgid / nig, fm = gid * WGM, gsz = (nM - fm) < WGM ? (nM - fm) : WGM;
        u.pm = fm + ((wgid % nig) % gsz); u.pn = (wgid % nig) / gsz; return true;
    }
    __device__ __forceinline__ void a_ready(const Unit&) const {}
    __device__ __forceinline__ void done(const Unit&) const {}
};

__device__ __forceinline__ unsigned cvt_pk_bf16(float lo, float hi) { unsigned r; asm volatile("v_cvt_pk_bf16_f32 %0, %1, %2" : "=v"(r) : "v"(lo), "v"(hi)); return r; }
typedef float f32x2 __attribute__((ext_vector_type(2)));
template <class Epi, class Sched, bool ALIGN_EPI = false, bool SP2 = false>
__device__ __forceinline__ void gemm_phase(PG8_LAS unsigned char* lds, const Gemm g, const Sched& S, const Epi& E) {
    const int tid = threadIdx.x, wid = __builtin_amdgcn_readfirstlane(tid >> 6), lane = tid & 63, wr = wid >> 2, wc = wid & 3, fr = lane & 15, fq = lane >> 4;
    const int K = g.K, nt = K / BK;
    unsigned voffA[2], voffB[2];
#pragma unroll
    for (int i = 0; i < 2; ++i) { int R, C; stage_rc(tid * 16 + i * 8192, R, C); const int Rb = Epi::PERM ? ((R & ~31) + perm32(R & 31)) : R;
        voffA[i] = (unsigned)(R * K + C) * 2u; voffB[i] = (unsigned)(Rb * K + C) * 2u; }
    const size_t kstep = (size_t)(BK * 2);
    const size_t hstep = (size_t)HALF * K * 2;
    const size_t tstep = 2 * hstep;
    const unsigned ldsw = (unsigned)wid * 1024u;
    const int aoff = lds_byte(wr * 64 + fr, fq * 8), boff = lds_byte(wc * 32 + fr, fq * 8);
#define PG8_SA(b, h) (((b) * 2 + (h)) * HTB)
#define PG8_SB(b, h) ((4 + (b) * 2 + (h)) * HTB)
#define PG8_STAGE(bufoff, gbase, voff) do { _Pragma("unroll") for (int _i = 0; _i < 2; ++_i) \
        __builtin_amdgcn_global_load_lds((const unsigned*)((const char*)(gbase) + (voff)[_i]), (PG8_LAS unsigned*)(lds + (bufoff) + ldsw + _i * 8192), 16, 0, 0); } while (0)
#define PG8_LDA(dst, b, h) do { _Pragma("unroll") for (int m = 0; m < 4; ++m) _Pragma("unroll") for (int k = 0; k < 2; ++k) dst[m][k] = *(const PG8_LAS bf16x8*)(lds + PG8_SA(b, h) + aoff + m * 2048 + k * 1024); } while (0)
#define PG8_LDB(dst, b, h) do { _Pragma("unroll") for (int n = 0; n < 2; ++n) _Pragma("unroll") for (int k = 0; k < 2; ++k) dst[n][k] = *(const PG8_LAS bf16x8*)(lds + PG8_SB(b, h) + boff + n * 2048 + k * 1024); } while (0)
#define PG8_MMA(ai, bj, At, Bt) do { __builtin_amdgcn_s_setprio(1); _Pragma("unroll") for (int m = 0; m < 4; ++m) _Pragma("unroll") for (int n = 0; n < 2; ++n) _Pragma("unroll") for (int k = 0; k < 2; ++k) \
        acc[ai][bj][m][n] = __builtin_amdgcn_mfma_f32_16x16x32_bf16(Bt[n][k], At[m][k], acc[ai][bj][m][n], 0, 0, 0); __builtin_amdgcn_s_setprio(0); } while (0)
#define PG8_WAIT_V(n) asm volatile("s_waitcnt vmcnt(" #n ")" ::: "memory")
#define PG8_WAIT_L(n) asm volatile("s_waitcnt lgkmcnt(" #n ")" ::: "memory")
#define PG8_BAR __builtin_amdgcn_s_barrier()
#define PG8_SCHED __builtin_amdgcn_sched_barrier(0)
    Unit cur, nxt; int ui = 0;
    if (!S.next(0, cur)) return;
    f32x4 acc[2][2][4][2];
#pragma unroll
    for (int a = 0; a < 2; ++a)
#pragma unroll
        for (int b = 0; b < 2; ++b)
#pragma unroll
            for (int m = 0; m < 4; ++m)
#pragma unroll
                for (int n = 0; n < 2; ++n) acc[a][b][m][n] = (f32x4){0.f, 0.f, 0.f, 0.f};
    bf16x8 At[4][2], B0[2][2], B1[2][2];
    const char* cA = (const char*)g.A + (size_t)cur.pm * tstep; const char* cB = (const char*)g.Bt + (size_t)cur.pn * tstep;
    S.a_ready(cur);
    if constexpr (SP2) {
        PG8_STAGE(PG8_SB(0, 0), cB, voffB); PG8_STAGE(PG8_SB(0, 1), cB + hstep, voffB); PG8_STAGE(PG8_SA(0, 0), cA, voffA); PG8_STAGE(PG8_SA(0, 1), cA + hstep, voffA);
        if (wr == 1) PG8_BAR;
        PG8_WAIT_V(2); PG8_BAR;
        PG8_STAGE(PG8_SB(1, 0), cB + kstep, voffB); PG8_STAGE(PG8_SA(1, 0), cA + kstep, voffA); PG8_STAGE(PG8_SB(1, 1), cB + hstep + kstep, voffB);
        PG8_WAIT_V(6); PG8_BAR;
    } else {
        PG8_STAGE(PG8_SB(0, 0), cB, voffB); PG8_STAGE(PG8_SA(0, 0), cA, voffA); PG8_STAGE(PG8_SB(0, 1), cB + hstep, voffB); PG8_STAGE(PG8_SA(0, 1), cA + hstep, voffA);
        if (wr == 1) PG8_BAR;
        PG8_WAIT_V(4); PG8_BAR;
        PG8_STAGE(PG8_SB(1, 0), cB + kstep, voffB); PG8_STAGE(PG8_SA(1, 0), cA + kstep, voffA); PG8_STAGE(PG8_SB(1, 1), cB + hstep + kstep, voffB);
        PG8_WAIT_V(6); PG8_BAR;
    }
    for (;;) {
        const bool has_next = S.next(ui + 1, nxt);
        const char* nA = has_next ? (const char*)g.A + (size_t)nxt.pm * tstep : cA; const char* nB = has_next ? (const char*)g.Bt + (size_t)nxt.pn * tstep : cB;
        for (int t = 0; t < nt; t += 2) {
            const bool last = (t == nt - 2);
            const char* a1 = cA + (size_t)(t + 1) * kstep;
            const char* a2 = last ? nA : cA + (size_t)(t + 2) * kstep; const char* b2 = last ? nB : cB + (size_t)(t + 2) * kstep;
            const char* a3 = a2 + kstep; const char* b3 = b2 + kstep;
            if (last && has_next) S.a_ready(nxt);
            if constexpr (SP2) {
            PG8_LDB(B0, 0, 0); PG8_LDB(B1, 0, 1); PG8_SCHED; PG8_LDA(At, 0, 0); PG8_STAGE(PG8_SA(1, 1), a1 + hstep, voffA);
            PG8_WAIT_V(8); PG8_WAIT_L(0); PG8_BAR; PG8_MMA(0, 0, At, B0); PG8_MMA(0, 1, At, B1); PG8_BAR; PG8_SCHED;
            PG8_LDA(At, 0, 1); PG8_STAGE(PG8_SB(0, 0), b2, voffB); PG8_STAGE(PG8_SB(0, 1), b2 + hstep, voffB); PG8_STAGE(PG8_SA(0, 0), a2, voffA);
            PG8_WAIT_V(8); PG8_WAIT_L(0); PG8_BAR; PG8_MMA(1, 0, At, B0); PG8_MMA(1, 1, At, B1); PG8_BAR; PG8_SCHED;
            PG8_LDB(B0, 1, 0); PG8_LDB(B1, 1, 1); PG8_SCHED; PG8_LDA(At, 1, 0); PG8_STAGE(PG8_SA(0, 1), a2 + hstep, voffA);
            PG8_WAIT_V(8); PG8_WAIT_L(0); PG8_BAR; PG8_MMA(0, 0, At, B0); PG8_MMA(0, 1, At, B1); PG8_BAR; PG8_SCHED;
            PG8_LDA(At, 1, 1); PG8_STAGE(PG8_SB(1, 0), b3, voffB); PG8_STAGE(PG8_SB(1, 1), b3 + hstep, voffB); PG8_STAGE(PG8_SA(1, 0), a3, voffA);
            PG8_WAIT_V(8); PG8_WAIT_L(0); PG8_BAR; PG8_MMA(1, 0, At, B0); PG8_MMA(1, 1, At, B1); PG8_BAR; PG8_SCHED;
            } else {
            PG8_LDB(B0, 0, 0); PG8_SCHED; PG8_LDA(At, 0, 0); PG8_STAGE(PG8_SA(1, 1), a1 + hstep, voffA);
            PG8_WAIT_L(8); PG8_BAR; PG8_WAIT_L(0); PG8_MMA(0, 0, At, B0); PG8_BAR; PG8_SCHED;
            PG8_LDB(B1, 0, 1); PG8_STAGE(PG8_SB(0, 0), b2, voffB);
            PG8_BAR; PG8_WAIT_L(0); PG8_MMA(0, 1, At, B1); PG8_BAR;
            PG8_LDA(At, 0, 1); PG8_STAGE(PG8_SA(0, 0), a2, voffA);
            PG8_BAR; PG8_WAIT_L(0); PG8_MMA(1, 0, At, B0); PG8_BAR; PG8_SCHED;
            PG8_STAGE(PG8_SB(0, 1), b2 + hstep, voffB);
            PG8_WAIT_V(6); PG8_BAR; PG8_MMA(1, 1, At, B1); PG8_BAR;
            PG8_LDB(B0, 1, 0); PG8_SCHED; PG8_LDA(At, 1, 0); PG8_STAGE(PG8_SA(0, 1), a2 + hstep, voffA);
            PG8_WAIT_L(8); PG8_BAR; PG8_WAIT_L(0); PG8_MMA(0, 0, At, B0); PG8_BAR; PG8_SCHED;
            PG8_LDB(B1, 1, 1); PG8_STAGE(PG8_SB(1, 0), b3, voffB);
            PG8_BAR; PG8_WAIT_L(0); PG8_MMA(0, 1, At, B1); PG8_BAR;
            PG8_LDA(At, 1, 1); PG8_STAGE(PG8_SA(1, 0), a3, voffA);
            PG8_BAR; PG8_WAIT_L(0); PG8_MMA(1, 0, At, B0); PG8_BAR; PG8_SCHED;
            PG8_STAGE(PG8_SB(1, 1), b3 + hstep, voffB);
            PG8_WAIT_V(6); PG8_BAR; PG8_MMA(1, 1, At, B1); PG8_BAR;
            }
        }
        if constexpr (ALIGN_EPI) { if (wr == 0) PG8_BAR; }
        if constexpr (!Epi::AFTER_DRAIN) { E(acc, cur, wr, wc, fr, fq); S.done(cur); }
        if (!has_next) break;
#pragma unroll
        for (int a = 0; a < 2; ++a)
#pragma unroll
            for (int b = 0; b < 2; ++b)
#pragma unroll
                for (int m = 0; m < 4; ++m)
#pragma unroll
                    for (int n = 0; n < 2; ++n) acc[a][b][m][n] = (f32x4){0.f, 0.f, 0.f, 0.f};
        cur = nxt; cA = nA; cB = nB; ++ui;
        if constexpr (ALIGN_EPI) { if (wr == 1) PG8_BAR; }
    }
    PG8_WAIT_V(0);
    if constexpr (!ALIGN_EPI) { if (wr == 0) PG8_BAR; }
    PG8_BAR;
    if constexpr (Epi::AFTER_DRAIN) { E.fused(acc, cur, wr, wc, fr, fq, lds, wid, lane); S.done(cur); }
#undef PG8_SA
#undef PG8_SB
#undef PG8_STAGE
#undef PG8_LDA
#undef PG8_LDB
#undef PG8_MMA
#undef PG8_WAIT_V
#undef PG8_WAIT_L
#undef PG8_BAR
#undef PG8_SCHED
}
typedef int i32x4 __attribute__((ext_vector_type(4)));
template <bool I8> struct AccSel { typedef f32x4 type; };
template <> struct AccSel<true> { typedef i32x4 type; };
template <bool I8> __device__ __forceinline__ void mma_step(typename AccSel<I8>::type& c, const bf16x8& b, const bf16x8& a) {
    if constexpr (I8) c = __builtin_amdgcn_mfma_i32_16x16x64_i8(__builtin_bit_cast(i32x4, b), __builtin_bit_cast(i32x4, a), c, 0, 0, 0);
    else c = __builtin_amdgcn_mfma_f32_16x16x32_bf16(b, a, c, 0, 0, 0);
}
template <class Epi, class Sched, class AMap, bool ALIGN_EPI = false, bool I8 = false>
__device__ __forceinline__ void gemm_phase_gather(PG8_LAS unsigned char* lds, const Gemm g, const Sched& S, const Epi& E, const AMap& AM) {
    constexpr bool SP2 = true;
    const int tid = threadIdx.x, wid = __builtin_amdgcn_readfirstlane(tid >> 6), lane = tid & 63, wr = wid >> 2, wc = wid & 3, fr = lane & 15, fq = lane >> 4;
    const int K = g.K, nt = K / BK;
    unsigned voffA[2], voffB[2]; int rowA[2];
#pragma unroll
    for (int i = 0; i < 2; ++i) { int R, C; stage_rc(tid * 16 + i * 8192, R, C); const int Rb = Epi::PERM ? ((R & ~31) + perm32(R & 31)) : R;
        voffA[i] = (unsigned)C * 2u; voffB[i] = (unsigned)(Rb * K + C) * 2u; rowA[i] = R; }
    const size_t kstep = (size_t)(BK * 2);
    const size_t hstep = (size_t)HALF * K * 2;
    const size_t tstep = 2 * hstep;
    const unsigned ldsw = (unsigned)wid * 1024u;
    const int aoff = lds_byte(wr * 64 + fr, fq * 8), boff = lds_byte(wc * 32 + fr, fq * 8);
#define PG8_SA(b, h) (((b) * 2 + (h)) * HTB)
#define PG8_SB(b, h) ((4 + (b) * 2 + (h)) * HTB)
#define PG8_STAGE(bufoff, gbase, voff) do { _Pragma("unroll") for (int _i = 0; _i < 2; ++_i) \
        __builtin_amdgcn_global_load_lds((const unsigned*)((const char*)(gbase) + (voff)[_i]), (PG8_LAS unsigned*)(lds + (bufoff) + ldsw + _i * 8192), 16, 0, 0); } while (0)
#define PG8_LDA(dst, b, h) do { _Pragma("unroll") for (int m = 0; m < 4; ++m) _Pragma("unroll") for (int k = 0; k < 2; ++k) dst[m][k] = *(const PG8_LAS bf16x8*)(lds + PG8_SA(b, h) + aoff + m * 2048 + k * 1024); } while (0)
#define PG8_LDB(dst, b, h) do { _Pragma("unroll") for (int n = 0; n < 2; ++n) _Pragma("unroll") for (int k = 0; k < 2; ++k) dst[n][k] = *(const PG8_LAS bf16x8*)(lds + PG8_SB(b, h) + boff + n * 2048 + k * 1024); } while (0)
#define PG8_MMA(ai, bj, At, Bt) do { __builtin_amdgcn_s_setprio(1); _Pragma("unroll") for (int m = 0; m < 4; ++m) _Pragma("unroll") for (int n = 0; n < 2; ++n) _Pragma("unroll") for (int k = 0; k < 2; ++k) \
        mma_step<I8>(acc[ai][bj][m][n], Bt[n][k], At[m][k]); __builtin_amdgcn_s_setprio(0); } while (0)
#define PG8_WAIT_V(n) asm volatile("s_waitcnt vmcnt(" #n ")" ::: "memory")
#define PG8_WAIT_L(n) asm volatile("s_waitcnt lgkmcnt(" #n ")" ::: "memory")
#define PG8_BAR __builtin_amdgcn_s_barrier()
#define PG8_SCHED __builtin_amdgcn_sched_barrier(0)
    Unit cur, nxt; int ui = 0;
    if (!S.next(0, cur)) return;
    typedef typename AccSel<I8>::type acc_t;
    acc_t acc[2][2][4][2];
#pragma unroll
    for (int a = 0; a < 2; ++a)
#pragma unroll
        for (int b = 0; b < 2; ++b)
#pragma unroll
            for (int m = 0; m < 4; ++m)
#pragma unroll
                for (int n = 0; n < 2; ++n) acc[a][b][m][n] = (acc_t){0, 0, 0, 0};
    bf16x8 At[4][2], B0[2][2], B1[2][2];
    const char* cA = (const char*)g.A; const char* cB = (const char*)g.Bt + (size_t)cur.pn * tstep;
    unsigned vA0[2], vA1[2], nA0[2], nA1[2];
#pragma unroll
    for (int i = 0; i < 2; ++i) { vA0[i] = (unsigned)AM.row(cur, rowA[i]) * (unsigned)(K * 2) + voffA[i]; vA1[i] = (unsigned)AM.row(cur, HALF + rowA[i]) * (unsigned)(K * 2) + voffA[i]; }
    S.a_ready(cur);
    if constexpr (SP2) {
        PG8_STAGE(PG8_SB(0, 0), cB, voffB); PG8_STAGE(PG8_SB(0, 1), cB + hstep, voffB); PG8_STAGE(PG8_SA(0, 0), cA, vA0); PG8_STAGE(PG8_SA(0, 1), cA, vA1);
        if (wr == 1) PG8_BAR;
        PG8_WAIT_V(2); PG8_BAR;
        PG8_STAGE(PG8_SB(1, 0), cB + kstep, voffB); PG8_STAGE(PG8_SA(1, 0), cA + kstep, vA0); PG8_STAGE(PG8_SB(1, 1), cB + hstep + kstep, voffB);
        PG8_WAIT_V(6); PG8_BAR;
    } else {
        PG8_STAGE(PG8_SB(0, 0), cB, voffB); PG8_STAGE(PG8_SA(0, 0), cA, voffA); PG8_STAGE(PG8_SB(0, 1), cB + hstep, voffB); PG8_STAGE(PG8_SA(0, 1), cA + hstep, voffA);
        if (wr == 1) PG8_BAR;
        PG8_WAIT_V(4); PG8_BAR;
        PG8_STAGE(PG8_SB(1, 0), cB + kstep, voffB); PG8_STAGE(PG8_SA(1, 0), cA + kstep, voffA); PG8_STAGE(PG8_SB(1, 1), cB + hstep + kstep, voffB);
        PG8_WAIT_V(6); PG8_BAR;
    }
    for (;;) {
        const bool has_next = S.next(ui + 1, nxt);
        const char* nA = cA; const char* nB = has_next ? (const char*)g.Bt + (size_t)nxt.pn * tstep : cB;
#pragma unroll
        for (int i = 0; i < 2; ++i) { nA0[i] = has_next ? (unsigned)AM.row(nxt, rowA[i]) * (unsigned)(K * 2) + voffA[i] : vA0[i]; nA1[i] = has_next ? (unsigned)AM.row(nxt, HALF + rowA[i]) * (unsigned)(K * 2) + voffA[i] : vA1[i]; }
        for (int t = 0; t < nt; t += 2) {
            const bool last = (t == nt - 2);
            const char* a1 = cA + (size_t)(t + 1) * kstep;
            const char* a2 = last ? nA : cA + (size_t)(t + 2) * kstep; const char* b2 = last ? nB : cB + (size_t)(t + 2) * kstep;
            const char* a3 = a2 + kstep; const char* b3 = b2 + kstep;
            unsigned s0[2], s1[2];
#pragma unroll
            for (int i = 0; i < 2; ++i) { s0[i] = vA0[i]; s1[i] = vA1[i]; }
            if (last) {
#pragma unroll
                for (int i = 0; i < 2; ++i) { unsigned t0_ = nA0[i], t1_ = nA1[i]; asm volatile("" : "+v"(t0_), "+v"(t1_)); s0[i] = t0_; s1[i] = t1_; } }
            if (last && has_next) S.a_ready(nxt);
            if constexpr (SP2) {
            PG8_LDB(B0, 0, 0); PG8_LDB(B1, 0, 1); PG8_SCHED; PG8_LDA(At, 0, 0); PG8_STAGE(PG8_SA(1, 1), a1, vA1);
            PG8_WAIT_V(8); PG8_WAIT_L(0); PG8_BAR; PG8_MMA(0, 0, At, B0); PG8_MMA(0, 1, At, B1); PG8_BAR; PG8_SCHED;
            PG8_LDA(At, 0, 1); PG8_STAGE(PG8_SB(0, 0), b2, voffB); PG8_STAGE(PG8_SB(0, 1), b2 + hstep, voffB); PG8_STAGE(PG8_SA(0, 0), a2, s0);
            PG8_WAIT_V(8); PG8_WAIT_L(0); PG8_BAR; PG8_MMA(1, 0, At, B0); PG8_MMA(1, 1, At, B1); PG8_BAR; PG8_SCHED;
            PG8_LDB(B0, 1, 0); PG8_LDB(B1, 1, 1); PG8_SCHED; PG8_LDA(At, 1, 0); PG8_STAGE(PG8_SA(0, 1), a2, s1);
            PG8_WAIT_V(8); PG8_WAIT_L(0); PG8_BAR; PG8_MMA(0, 0, At, B0); PG8_MMA(0, 1, At, B1); PG8_BAR; PG8_SCHED;
            PG8_LDA(At, 1, 1); PG8_STAGE(PG8_SB(1, 0), b3, voffB); PG8_STAGE(PG8_SB(1, 1), b3 + hstep, voffB); PG8_STAGE(PG8_SA(1, 0), a3, s0);
            PG8_WAIT_V(8); PG8_WAIT_L(0); PG8_BAR; PG8_MMA(1, 0, At, B0); PG8_MMA(1, 1, At, B1); PG8_BAR; PG8_SCHED;
            } else {
            PG8_LDB(B0, 0, 0); PG8_SCHED; PG8_LDA(At, 0, 0); PG8_STAGE(PG8_SA(1, 1), a1 + hstep, voffA);
            PG8_WAIT_L(8); PG8_BAR; PG8_WAIT_L(0); PG8_MMA(0, 0, At, B0); PG8_BAR; PG8_SCHED;
            PG8_LDB(B1, 0, 1); PG8_STAGE(PG8_SB(0, 0), b2, voffB);
            PG8_BAR; PG8_WAIT_L(0); PG8_MMA(0, 1, At, B1); PG8_BAR;
            PG8_LDA(At, 0, 1); PG8_STAGE(PG8_SA(0, 0), a2, voffA);
            PG8_BAR; PG8_WAIT_L(0); PG8_MMA(1, 0, At, B0); PG8_BAR; PG8_SCHED;
            PG8_STAGE(PG8_SB(0, 1), b2 + hstep, voffB);
            PG8_WAIT_V(6); PG8_BAR; PG8_MMA(1, 1, At, B1); PG8_BAR;
            PG8_LDB(B0, 1, 0); PG8_SCHED; PG8_LDA(At, 1, 0); PG8_STAGE(PG8_SA(0, 1), a2 + hstep, voffA);
            PG8_WAIT_L(8); PG8_BAR; PG8_WAIT_L(0); PG8_MMA(0, 0, At, B0); PG8_BAR; PG8_SCHED;
            PG8_LDB(B1, 1, 1); PG8_STAGE(PG8_SB(1, 0), b3, voffB);
            PG8_BAR; PG8_WAIT_L(0); PG8_MMA(0, 1, At, B1); PG8_BAR;
            PG8_LDA(At, 1, 1); PG8_STAGE(PG8_SA(1, 0), a3, voffA);
            PG8_BAR; PG8_WAIT_L(0); PG8_MMA(1, 0, At, B0); PG8_BAR; PG8_SCHED;
            PG8_STAGE(PG8_SB(1, 1), b3 + hstep, voffB);
            PG8_WAIT_V(6); PG8_BAR; PG8_MMA(1, 1, At, B1); PG8_BAR;
            }
        }
        if constexpr (ALIGN_EPI) { if (wr == 0) PG8_BAR; }
        if constexpr (!Epi::AFTER_DRAIN) { E(acc, cur, wr, wc, fr, fq); S.done(cur); }
        if (!has_next) break;
#pragma unroll
        for (int a = 0; a < 2; ++a)
#pragma unroll
            for (int b = 0; b < 2; ++b)
#pragma unroll
                for (int m = 0; m < 4; ++m)
#pragma unroll
                    for (int n = 0; n < 2; ++n) acc[a][b][m][n] = (acc_t){0, 0, 0, 0};
        cur = nxt; cA = nA; cB = nB; ++ui;
#pragma unroll
        for (int i = 0; i < 2; ++i) { vA0[i] = nA0[i]; vA1[i] = nA1[i]; }
        if constexpr (ALIGN_EPI) { if (wr == 1) PG8_BAR; }
    }
    PG8_WAIT_V(0);
    if constexpr (!ALIGN_EPI) { if (wr == 0) PG8_BAR; }
    PG8_BAR;
    if constexpr (Epi::AFTER_DRAIN) { E.fused(acc, cur, wr, wc, fr, fq, lds, wid, lane); S.done(cur); }
#undef PG8_SA
#undef PG8_SB
#undef PG8_STAGE
#undef PG8_LDA
#undef PG8_LDB
#undef PG8_MMA
#undef PG8_WAIT_V
#undef PG8_WAIT_L
#undef PG8_BAR
#undef PG8_SCHED
}
}
#include <hip/hip_bf16.h>
#include <cmath>
namespace attn_body {
using bf16=__hip_bfloat16;
using bf16x8=__attribute__((ext_vector_type(8)))short;
using s16x4=__attribute__((ext_vector_type(4)))short;
using f32x16=__attribute__((ext_vector_type(16)))float;
using u32x4=__attribute__((ext_vector_type(4)))unsigned;
constexpr int BATCH=2,NHEAD=8,NKVH=2,SEQ=8192,D=64,QP=512,KP=128,OP=1024;
constexpr int NW=8,QBLK=32,QB=QBLK*NW,KVBLK=64,NQB=SEQ/QB;
constexpr int ATTN_UNIT_ROWS=QB;
__device__ __forceinline__ int crow(int r,int hi){return (r&3)+8*(r>>2)+4*hi;}
#define SBAR() __builtin_amdgcn_sched_barrier(0)
__device__ __forceinline__ void cmask(f32x16&p0,f32x16&p1,int jb,int qrel,int hi){
  const float NEG=-INFINITY; int kb=64*jb+4*hi;
  #pragma unroll
  for(int r=0;r<16;++r){int kv=kb+(r&3)+8*(r>>2); if(kv>qrel)p0[r]=NEG; if(kv+32>qrel)p1[r]=NEG;}
}

constexpr int NSLOT=3, SLOTB=8192;
constexpr int LDS_K=0, LDS_V=NSLOT*SLOTB, LDS_WS=2*NSLOT*SLOTB, LDS_OST=LDS_WS+NW*64*4, LDS_BYTES=LDS_OST+NW*4096;
constexpr float C2=0.125f*1.4426950408889634f;
__device__ __forceinline__ void glds16(const void*gsrc,unsigned lds_dst){unsigned keep;
  asm volatile("s_mov_b32 %0, m0\n\ts_mov_b32 m0, %2\n\ts_nop 0\n\tglobal_load_lds_dwordx4 %1, off\n\ts_mov_b32 m0, %0":"=&s"(keep):"v"(gsrc),"s"(lds_dst):"memory");}
__device__ __forceinline__ float max3f(float a,float b,float c){float r;asm("v_max3_f32 %0, %1, %2, %3":"=v"(r):"v"(a),"v"(b),"v"(c));return r;}
__device__ __forceinline__ float max2f(float a,float b){float r;asm("v_max_f32_e32 %0, %1, %2":"=v"(r):"v"(a),"v"(b));return r;}
__device__ __forceinline__ float fadd_s(float a,float b){float r;asm("v_add_f32_e32 %0, %1, %2":"=v"(r):"v"(a),"v"(b));return r;}
__device__ __forceinline__ float fsub_s(float a,float b){float r;asm("v_sub_f32_e32 %0, %1, %2":"=v"(r):"v"(a),"v"(b));return r;}
typedef float f32x2_t __attribute__((ext_vector_type(2))); typedef __bf16 bf16x2_t __attribute__((ext_vector_type(2)));
__device__ __forceinline__ unsigned cvtpk_s(float lo,float hi){f32x2_t v={lo,hi};bf16x2_t b=__builtin_convertvector(v,bf16x2_t);return __builtin_bit_cast(unsigned,b);}
#define WAIT_BAR(N) asm volatile("s_waitcnt vmcnt(" #N ") lgkmcnt(0)\n\ts_barrier":::"memory")

__device__ __forceinline__ void qkt(f32x16&p0,f32x16&p1,const char*Kslot,const bf16x8*qr,const f32x16&negm,int r32,int hi){
  const char*kb=Kslot+hi*1024+r32*16;
  #pragma unroll
  for(int d0=0;d0<4;++d0){
    const bf16x8 b0=*reinterpret_cast<const bf16x8*>(kb+d0*2048);
    const bf16x8 b1=*reinterpret_cast<const bf16x8*>(kb+d0*2048+512);
    if(d0==0){p0=__builtin_amdgcn_mfma_f32_32x32x16_bf16(b0,qr[0],negm,0,0,0);p1=__builtin_amdgcn_mfma_f32_32x32x16_bf16(b1,qr[0],negm,0,0,0);}
    else{p0=__builtin_amdgcn_mfma_f32_32x32x16_bf16(b0,qr[d0],p0,0,0,0);p1=__builtin_amdgcn_mfma_f32_32x32x16_bf16(b1,qr[d0],p1,0,0,0);}}
}
typedef __attribute__((address_space(3))) const char* lds_cptr;
typedef short v4i16_t __attribute__((ext_vector_type(4)));
__device__ __forceinline__ void kload8(bf16x8*kf,lds_cptr kp){
  kf[0]=*(const __attribute__((address_space(3))) bf16x8*)(kp);      kf[1]=*(const __attribute__((address_space(3))) bf16x8*)(kp+512);
  kf[2]=*(const __attribute__((address_space(3))) bf16x8*)(kp+2048); kf[3]=*(const __attribute__((address_space(3))) bf16x8*)(kp+2560);
  kf[4]=*(const __attribute__((address_space(3))) bf16x8*)(kp+4096); kf[5]=*(const __attribute__((address_space(3))) bf16x8*)(kp+4608);
  kf[6]=*(const __attribute__((address_space(3))) bf16x8*)(kp+6144); kf[7]=*(const __attribute__((address_space(3))) bf16x8*)(kp+6656);
}
__device__ __forceinline__ void kload2(bf16x8*kf,lds_cptr kp,int j){ kf[2*j]=*(const __attribute__((address_space(3))) bf16x8*)(kp+j*2048); kf[2*j+1]=*(const __attribute__((address_space(3))) bf16x8*)(kp+j*2048+512); }
__device__ __forceinline__ s16x4 vtr(lds_cptr p){ return __builtin_bit_cast(s16x4,__builtin_amdgcn_ds_read_tr16_b64_v4i16((__attribute__((address_space(3))) v4i16_t*)p)); }
__device__ __forceinline__ float rowmax(const f32x16&p0,const f32x16&p1){
  float a=max3f(p0[0],p0[1],p1[0]),b=max3f(p0[2],p0[3],p1[1]);a=max3f(a,p1[2],p1[3]);
  #pragma unroll
  for(int r=4;r<16;r+=4){a=max3f(a,p0[r],p0[r+1]);b=max3f(b,p0[r+2],p0[r+3]);a=max3f(a,p1[r],p1[r+1]);b=max3f(b,p1[r+2],p1[r+3]);}
  const float m=max2f(a,b);
  auto rr=__builtin_amdgcn_permlane32_swap(__float_as_uint(m),__float_as_uint(m),false,false);
  return max2f(__uint_as_float(rr[0]),__uint_as_float(rr[1]));
}
__device__ __forceinline__ void pv(f32x16*o,int vb,bf16x8 pa0,bf16x8 pa1,bf16x8 pa2,bf16x8 pa3){
  #pragma unroll
  for(int d0=0;d0<2;++d0){s16x4 lo[4],hi[4];
    #pragma unroll
    for(int ks=0;ks<4;++ks){
      asm volatile("ds_read_b64_tr_b16 %0,%1 offset:%c2":"=&v"(lo[ks]):"v"(vb),"i"(d0*4096+ks*1024):"memory");
      asm volatile("ds_read_b64_tr_b16 %0,%1 offset:%c2":"=&v"(hi[ks]):"v"(vb),"i"(d0*4096+ks*1024+512):"memory");}
    asm volatile("s_waitcnt lgkmcnt(0)":::"memory");SBAR();
    #define PK(k) (bf16x8){lo[k][0],lo[k][1],lo[k][2],lo[k][3],hi[k][0],hi[k][1],hi[k][2],hi[k][3]}
    o[d0]=__builtin_amdgcn_mfma_f32_32x32x16_bf16(pa0,PK(0),o[d0],0,0,0);
    o[d0]=__builtin_amdgcn_mfma_f32_32x32x16_bf16(pa1,PK(1),o[d0],0,0,0);
    o[d0]=__builtin_amdgcn_mfma_f32_32x32x16_bf16(pa2,PK(2),o[d0],0,0,0);
    o[d0]=__builtin_amdgcn_mfma_f32_32x32x16_bf16(pa3,PK(3),o[d0],0,0,0);
    #undef PK
  }
}

#ifndef ATTN_STORE16
#define ATTN_STORE16(p,v) (*(u32x4*)(p)=(v))
#endif
template<int THRL> __device__ __forceinline__ void attn_unit(int b,int h,int qb,const bf16*Q,const bf16*__restrict__ K,const bf16*__restrict__ V,bf16*O,char*shm,const float nshift){
  const int tid=threadIdx.x,lane=tid&63,r32=lane&31,hi=lane>>5; const int wid=__builtin_amdgcn_readfirstlane(tid>>6);
  const long rowbase=(long)b*SEQ; const int q0=qb*QB;
  const bf16*Qw=Q+(rowbase+q0+wid*QBLK)*QP+h*D;
  const int hk=h/(NHEAD/NKVH); const bf16*Kh=K+(long)(b*NKVH+hk)*SEQ*D,*Vh=V+(long)(b*NKVH+hk)*SEQ*D;
  const unsigned lds0=(unsigned)(uintptr_t)shm;
  float*wsf=(float*)(shm+LDS_WS)+wid*64;
  const bf16*ksrc=Kh+(wid*64+lane)*8;
  const bf16*vsrc=Vh+(wid*64+lane)*8;
  const unsigned kdst=lds0+LDS_K+wid*1024, vdst=lds0+LDS_V+wid*1024;
  #define DMA_K(t,slot) glds16(ksrc+(long)(t)*KVBLK*D,(unsigned)__builtin_amdgcn_readfirstlane(kdst+(slot)))
  #define DMA_V(t,slot) glds16(vsrc+(long)(t)*KVBLK*D,(unsigned)__builtin_amdgcn_readfirstlane(vdst+(slot)))
  const int vb0=(int)(lds0+LDS_V)+((lane>>4)&1)*32+(lane&3)*8+(4*hi+((lane&15)>>2))*64;
  const char*Kbase=shm+LDS_K; bf16x8 kf[8];
  const lds_cptr shm3=(lds_cptr)shm; const lds_cptr kp0=shm3+LDS_K+hi*1024+r32*16; const lds_cptr vp0=shm3+LDS_V+((lane>>4)&1)*32+(lane&3)*8+(4*hi+((lane&15)>>2))*64;
  constexpr int NT=SEQ/KVBLK;
  DMA_K(0,0);DMA_V(0,0);DMA_K(1,SLOTB);
  bf16x8 qr[4];
  #pragma unroll
  for(int d0=0;d0<4;++d0)qr[d0]=*reinterpret_cast<const bf16x8*>(&Qw[(long)r32*QP+d0*16+hi*8]);
  float l_reg=0.f;f32x16 o[2];o[0]=f32x16{};o[1]=f32x16{};f32x16 negm;
  _Pragma("unroll") for(int r=0;r<16;++r)negm[r]=nshift; asm volatile("":"+v"(negm));
  const int qrel=wid*QBLK+r32;
  #define CMASK(P0,P1,t) do{}while(0)
  #define START(P0,P1) do{ _Pragma("unroll") for(int r=0;r<16;++r)P0[r]=__builtin_amdgcn_exp2f(P0[r]); }while(0)
  f32x16 pA0,pA1,pB0,pB1;
  int sl_prev=0,sl_cur=0,sl_next=SLOTB;
  #define ROT() do{sl_prev=sl_cur;sl_cur=sl_next;sl_next=(sl_next==(NSLOT-1)*SLOTB)?0:sl_next+SLOTB;}while(0)
  DMA_K(2,2*SLOTB);
  WAIT_BAR(3);
  qkt(pA0,pA1,Kbase,qr,negm,r32,hi);asm volatile("s_nop 15\n\ts_nop 7":"+v"(pA0),"+v"(pA1));CMASK(pA0,pA1,0);
  START(pA0,pA1);
  _Pragma("unroll") for(int r=0;r<16;++r)pA1[r]=__builtin_amdgcn_exp2f(pA1[r]);
  WAIT_BAR(0);
  DMA_K(3,0);DMA_V(1,SLOTB);
  ROT();
  kload8(kf,kp0+sl_cur);
  WAIT_BAR(2);
  s16x4 vlo[8],vhi[8]; u32x4 pw0,pw1,pw2,pw3;
  #define PKW(P,B) cvtpk_s(P[B],P[B+1])
  #define PAF(k) __builtin_bit_cast(bf16x8,pw##k)
  #define VFR(i) (bf16x8){vlo[i][0],vlo[i][1],vlo[i][2],vlo[i][3],vhi[i][0],vhi[i][1],vhi[i][2],vhi[i][3]}
  #define PIN(x) asm volatile("":"+v"(x))
  #define GAPA(MF,A0,A1,A2,A3,W0,W1,PW) do{ MF; sacc+=A0; sacc+=A1; sacc+=A2; sacc+=A3; PIN(sacc); W0; W1; PIN(PW); SBAR(); }while(0)
  #define EX(v) __builtin_amdgcn_exp2f(v)
  #define GAPB(MF,X,B) do{ MF; X[B]=EX(X[B]); X[B+1]=EX(X[B+1]); X[B+2]=EX(X[B+2]); X[B+3]=EX(X[B+3]); PIN(X); SBAR(); }while(0)
  #define VRD(i) do{ vlo[i]=vtr(vp_+(((i)>>2)*4096+((i)&3)*1024)); vhi[i]=vtr(vp_+(((i)>>2)*4096+((i)&3)*1024+512)); }while(0)
  #define KRD(G,j) do{ if(G){ kload2(kf,kp0+sl_next,j); SBAR(); } }while(0)
  #define STEP(C0,C1,P0,P1,t,GK,GV,GL) do{ SBAR(); \
    const lds_cptr vp_=vp0+sl_prev; \
    VRD(0); SBAR(); float sacc=(P0[0]+P0[1]); \
    GAPA(C0=__builtin_amdgcn_mfma_f32_32x32x16_bf16(kf[0],qr[0],negm,0,0,0), P0[2],P0[3],P0[4],P0[5],     pw0[0]=PKW(P0,0), pw0[1]=PKW(P0,2), pw0); \
    VRD(4); SBAR(); GAPA(C1=__builtin_amdgcn_mfma_f32_32x32x16_bf16(kf[1],qr[0],negm,0,0,0), P0[6],P0[7],P0[8],P0[9],     pw0[2]=PKW(P0,4), pw0[3]=PKW(P0,6), pw0); \
    VRD(1); SBAR(); GAPA(C0=__builtin_amdgcn_mfma_f32_32x32x16_bf16(kf[2],qr[1],C0,0,0,0),   P0[10],P0[11],P0[12],P0[13], pw1[0]=PKW(P0,8), pw1[1]=PKW(P0,10), pw1); \
    VRD(5); SBAR(); GAPA(C1=__builtin_amdgcn_mfma_f32_32x32x16_bf16(kf[3],qr[1],C1,0,0,0),   P0[14],P0[15],P1[0],P1[1],   pw1[2]=PKW(P0,12),pw1[3]=PKW(P0,14), pw1); \
    VRD(2); SBAR(); GAPA(C0=__builtin_amdgcn_mfma_f32_32x32x16_bf16(kf[4],qr[2],C0,0,0,0),   P1[2],P1[3],P1[4],P1[5],     pw2[0]=PKW(P1,0), pw2[1]=PKW(P1,2), pw2); \
    VRD(6); SBAR(); GAPA(C1=__builtin_amdgcn_mfma_f32_32x32x16_bf16(kf[5],qr[2],C1,0,0,0),   P1[6],P1[7],P1[8],P1[9],     pw2[2]=PKW(P1,4), pw2[3]=PKW(P1,6), pw2); \
    VRD(3); SBAR(); GAPA(C0=__builtin_amdgcn_mfma_f32_32x32x16_bf16(kf[6],qr[3],C0,0,0,0),   P1[10],P1[11],P1[12],P1[13], pw3[0]=PKW(P1,8), pw3[1]=PKW(P1,10), pw3); \
    VRD(7); SBAR(); GAPA(C1=__builtin_amdgcn_mfma_f32_32x32x16_bf16(kf[7],qr[3],C1,0,0,0),   P1[14],P1[15],0.f,0.f,       pw3[2]=PKW(P1,12),pw3[3]=PKW(P1,14), pw3); \
    l_reg+=sacc; \
    if(GK){DMA_K((t)+3,sl_cur);} if(GV){DMA_V((t)+1,sl_next);} \
    CMASK(C0,C1,t); \
    SBAR(); \
    GAPB(o[0]=__builtin_amdgcn_mfma_f32_32x32x16_bf16(PAF(0),VFR(0),o[0],0,0,0), C0,0); \
    GAPB(o[1]=__builtin_amdgcn_mfma_f32_32x32x16_bf16(PAF(0),VFR(4),o[1],0,0,0), C0,4); \
    KRD(GL,0); GAPB(o[0]=__builtin_amdgcn_mfma_f32_32x32x16_bf16(PAF(1),VFR(1),o[0],0,0,0), C0,8); \
    KRD(GL,1); GAPB(o[1]=__builtin_amdgcn_mfma_f32_32x32x16_bf16(PAF(1),VFR(5),o[1],0,0,0), C0,12); \
    KRD(GL,2); GAPB(o[0]=__builtin_amdgcn_mfma_f32_32x32x16_bf16(PAF(2),VFR(2),o[0],0,0,0), C1,0); \
    KRD(GL,3); GAPB(o[1]=__builtin_amdgcn_mfma_f32_32x32x16_bf16(PAF(2),VFR(6),o[1],0,0,0), C1,4); \
    GAPB(o[0]=__builtin_amdgcn_mfma_f32_32x32x16_bf16(PAF(3),VFR(3),o[0],0,0,0), C1,8); \
    GAPB(o[1]=__builtin_amdgcn_mfma_f32_32x32x16_bf16(PAF(3),VFR(7),o[1],0,0,0), C1,12); \
    }while(0)
  int t=1;
  #undef CMASK
  #define CMASK(P0,P1,t) do{}while(0)
  for(;t+5<NT;t+=2){
    STEP(pB0,pB1,pA0,pA1,t,true,true,true);     WAIT_BAR(2); ROT();
    STEP(pA0,pA1,pB0,pB1,t+1,true,true,true);   WAIT_BAR(2); ROT();
  }
  #undef CMASK
  #define CMASK(P0,P1,t) do{}while(0)
  #define ENDW(tt) do{ if((tt)+3<NT){WAIT_BAR(2);} else if((tt)+2<NT){WAIT_BAR(1);} else {WAIT_BAR(0);} }while(0)
  for(;t+1<NT;t+=2){
    STEP(pB0,pB1,pA0,pA1,t,(t+3<NT),(t+1<NT),(t+1<NT));       ENDW(t);   ROT();
    STEP(pA0,pA1,pB0,pB1,t+1,(t+4<NT),(t+2<NT),(t+2<NT));     ENDW(t+1); ROT();
  }
  STEP(pB0,pB1,pA0,pA1,NT-1,false,false,false);
  { float sacc=pB0[0]+pB0[1]; _Pragma("unroll") for(int r=2;r<16;++r)sacc+=pB0[r]; _Pragma("unroll") for(int r=0;r<16;++r)sacc+=pB1[r]; l_reg+=sacc;
    pw0=(u32x4){PKW(pB0,0),PKW(pB0,2),PKW(pB0,4),PKW(pB0,6)};pw1=(u32x4){PKW(pB0,8),PKW(pB0,10),PKW(pB0,12),PKW(pB0,14)};pw2=(u32x4){PKW(pB1,0),PKW(pB1,2),PKW(pB1,4),PKW(pB1,6)};pw3=(u32x4){PKW(pB1,8),PKW(pB1,10),PKW(pB1,12),PKW(pB1,14)};
    SBAR(); pv(o,vb0+sl_cur,PAF(0),PAF(1),PAF(2),PAF(3)); }
  #undef PKW
  #undef PAF
  #undef VFR
  #undef PIN
  #undef GAPA
  #undef GAPB
  #undef EX
  #undef VRD
  #undef KRD
  #undef STEP
  #undef ENDW
  {auto rr=__builtin_amdgcn_permlane32_swap(__float_as_uint(l_reg),__float_as_uint(l_reg),false,false);l_reg=__uint_as_float(rr[0])+__uint_as_float(rr[1]);}
  if(hi==0)wsf[32+r32]=l_reg;asm volatile("s_waitcnt lgkmcnt(0)":::"memory");
  float rli[16];
  #pragma unroll
  for(int r=0;r<16;++r)rli[r]=__builtin_amdgcn_rcpf(wsf[32+crow(r,hi)]);
  bf16*Ow=O+(rowbase+q0+wid*QBLK)*OP+h*D;
  { bf16*stg=(bf16*)(shm+LDS_OST)+wid*2048;
    #pragma unroll
    for(int r=0;r<16;++r){const int orow=crow(r,hi);
      #pragma unroll
      for(int d0=0;d0<2;++d0)stg[orow*64+d0*32+r32]=__float2bfloat16(o[d0][r]*rli[r]);}
    asm volatile("s_waitcnt lgkmcnt(0)":::"memory");
    #pragma unroll
    for(int i=0;i<4;++i){const int row=i*8+(lane>>3),ch=lane&7; const u32x4 v=*(const u32x4*)(stg+row*64+ch*8); ATTN_STORE16(Ow+(long)row*OP+ch*8,v);} }
  asm volatile("s_waitcnt lgkmcnt(0)\n\ts_barrier":::"memory");
  #undef DMA_K
  #undef DMA_V
  #undef CMASK
  #undef START
  #undef ROT
}
constexpr int ATTN_LDS_BYTES=LDS_BYTES;
struct AttnTensors { const bf16* Q; const bf16* K; const bf16* V; bf16* O; };
struct AttnUnit { int bh; int qb; };
struct StaticOrder {
  int vcu, G;
  __device__ __forceinline__ explicit StaticOrder(int grid,int block):vcu((grid%8==0)?(block%8)*(grid/8)+block/8:block),G(grid){}
  __device__ __forceinline__ bool next(int i,AttnUnit&u)const{
    const int L=i*G+vcu; if(L>=BATCH*NHEAD*NQB)return false;
    if(G==256){ if(i>=2)return false; const int x=vcu>>5,j=vcu&31; const int b=x>>2,kvh=(x>>1)&1,hq=kvh*4+2*(x&1)+i; u.bh=b*NHEAD+hq; u.qb=j; return true; }
    u.bh=L/NQB; u.qb=L%NQB; return true; }
  __device__ __forceinline__ void a_ready(const AttnUnit&)const{}
  __device__ __forceinline__ void done(const AttnUnit&)const{}
};
template<class Sched,int THRL=8> __device__ __forceinline__ void attn_phase(char*lds,const AttnTensors&T,const Sched&S,const float nshift){
  AttnUnit u;
  for(int i=0;S.next(i,u);++i){ S.a_ready(u); attn_unit<THRL>(u.bh/NHEAD,u.bh%NHEAD,u.qb,T.Q,T.K,T.V,T.O,lds,nshift); S.done(u); }
}
#undef SBAR
#undef WAIT_BAR
}

#include <hip/hip_cooperative_groups.h>
namespace cg = cooperative_groups;
#ifndef MK_PER_PHASE
#define MK_PER_PHASE 0
#endif
constexpr int NWAVES = 8, NTHREADS = 512;
constexpr int NB = 2, SEQ = 8192, DMODEL = 1024, TT = NB * SEQ;
constexpr int NPROJ = 2816;
constexpr int NEXP = 32, FFE = 512;
constexpr float EPS = 1e-6f;
constexpr int N_PHASES = 12;

constexpr size_t MiB = 1u << 20;
constexpr size_t WS_CTL = 0, CTL_ZERO_BYTES = 64 * 1024;
constexpr size_t WS_WOUT = 1 * MiB;
constexpr size_t WS_LIST = 229 * MiB;
constexpr size_t WS_WR = 3 * MiB;
constexpr size_t WS_TOK = 3 * MiB + 256 * 1024;
constexpr size_t WS_GATES = 4 * MiB;
constexpr size_t WS_WIN = 5 * MiB;
constexpr size_t WS_WSI = 3 * MiB + 896 * 1024;
constexpr size_t WS_XSC = 3 * MiB + 912 * 1024;
constexpr size_t WS_A = 11 * MiB;
constexpr size_t WS_XN = WS_A;
constexpr size_t GDN_SH_BYTES = 71680, GDN_D_BYTES = 19456;
constexpr size_t WS_GSH = WS_A;
constexpr size_t WS_GD = WS_A + 1024 * GDN_SH_BYTES;
constexpr size_t WS_X1 = 5 * MiB;
constexpr size_t WS_HID = 69 * MiB;
constexpr size_t WS_XBUF = 109 * MiB;
constexpr size_t WS_B = 157 * MiB;
constexpr size_t WS_QKVA = WS_B;
constexpr size_t WS_QKVB = WS_B + 48 * MiB;
constexpr size_t WS_ZA = WS_B + 72 * MiB;
constexpr size_t WS_OCAT = WS_B;
constexpr size_t WS_WGU0 = 189 * MiB, WS_WGU1 = 245 * MiB; constexpr int WGU_SPLIT = 20;
constexpr size_t WS_WSC = 3 * MiB + 768 * 1024;
constexpr float ACT_CLIP = 6.0f;
constexpr size_t DO_WD0 = 0, DO_WD1 = 56 * MiB; constexpr int WD_SPLIT = 24;
constexpr size_t DO_HN = 24 * MiB;
constexpr size_t WS_END = 269 * MiB;
static_assert(WS_GD + 4096 * GDN_D_BYTES <= WS_B, "GDN records fit region A");
static_assert(WS_X1 + 64 * MiB <= WS_HID && WS_HID + 40928ull * 1024 <= WS_XBUF && WS_XBUF + 40928ull * 2048 <= WS_WGU0, "post-scan map");
static_assert(WS_WGU0 + WGU_SPLIT * MiB <= WS_B + 72 * MiB && WS_WGU1 + (32 - WGU_SPLIT) * MiB <= 269 * MiB, "WGU fragments");
constexpr size_t DO_QR = 0, DO_KR = 16 * MiB, DO_VR = 20 * MiB, DO_OF = 24 * MiB, DO_OB = 40 * MiB;
constexpr int CW_CNT = 2048;
constexpr int CW_NTILE = 128;
constexpr int CW_ETAB = 192;
constexpr int CW_HIDC = 8192;
constexpr int CW_XCC = 11264, CW_XBAD = 11600;
constexpr int CW_SCANQ = 1024;

constexpr int LDS_BYTES = 160 * 1024;

#define GAS __attribute__((address_space(1)))
#define LAS __attribute__((address_space(3)))
typedef unsigned short bf16;
typedef unsigned v4u __attribute__((ext_vector_type(4)));
typedef unsigned v2u __attribute__((ext_vector_type(2)));
typedef float f32x4 __attribute__((ext_vector_type(4)));
typedef short bf16x8 __attribute__((ext_vector_type(8)));
typedef short s16x4 __attribute__((ext_vector_type(4)));
#define DI __device__ __forceinline__

DI unsigned f2bf(float f) { unsigned u = __builtin_bit_cast(unsigned, f); return (u + 0x7fffu + ((u >> 16) & 1u)) >> 16; }
typedef float f32x2_t __attribute__((ext_vector_type(2))); typedef __bf16 bf16x2_t __attribute__((ext_vector_type(2)));
DI unsigned pk2(float lo, float hi) { f32x2_t v = {lo, hi}; bf16x2_t b = __builtin_convertvector(v, bf16x2_t); return __builtin_bit_cast(unsigned, b); }
DI float bf2f(unsigned short h) { return __builtin_bit_cast(float, (unsigned)h << 16); }
DI float bflo(unsigned w) { return __builtin_bit_cast(float, w << 16); }
DI float bfhi(unsigned w) { return __builtin_bit_cast(float, w & 0xffff0000u); }
DI unsigned q8x4(float a, float b, float c, float d, float sc) {
    const float M = 12582912.f;
    const unsigned ua = __builtin_bit_cast(unsigned, fminf(fmaxf(a * sc, -127.f), 127.f) + M), ub = __builtin_bit_cast(unsigned, fminf(fmaxf(b * sc, -127.f), 127.f) + M);
    const unsigned uc = __builtin_bit_cast(unsigned, fminf(fmaxf(c * sc, -127.f), 127.f) + M), ud = __builtin_bit_cast(unsigned, fminf(fmaxf(d * sc, -127.f), 127.f) + M);
    return (ua & 255u) | ((ub & 255u) << 8) | ((uc & 255u) << 16) | (ud << 24);
}
template <int CTRL> DI float dpp_f(float v) { return __builtin_bit_cast(float, __builtin_amdgcn_update_dpp(0, __builtin_bit_cast(int, v), CTRL, 0xf, 0xf, true)); }
#ifdef NO_DPP
DI float sum16(float v) { v += __shfl_xor(v, 1); v += __shfl_xor(v, 2); v += __shfl_xor(v, 4); v += __shfl_xor(v, 8); return v; }
DI float max16(float v) { v = fmaxf(v, __shfl_xor(v, 1)); v = fmaxf(v, __shfl_xor(v, 2)); v = fmaxf(v, __shfl_xor(v, 4)); v = fmaxf(v, __shfl_xor(v, 8)); return v; }
DI float get_x8(float v) { return __shfl_xor(v, 8); }
#else
DI float sum16(float v) { v += dpp_f<0xB1>(v); v += dpp_f<0x4E>(v); v += dpp_f<0x141>(v); v += dpp_f<0x140>(v); return v; }
DI float max16(float v) { v = fmaxf(v, dpp_f<0xB1>(v)); v = fmaxf(v, dpp_f<0x4E>(v)); v = fmaxf(v, dpp_f<0x141>(v)); v = fmaxf(v, dpp_f<0x140>(v)); return v; }
DI float get_x8(float v) { return dpp_f<0x128>(v); }
#endif
DI float sum_x16(float v) { return v + __shfl_xor(v, 16); }
DI float max_x16(float v) { return fmaxf(v, __shfl_xor(v, 16)); }
DI float sum_x32(float v) { return v + __shfl_xor(v, 32); }
DI float max_x32(float v) { return fmaxf(v, __shfl_xor(v, 32)); }
DI float wave_max(float v) { return max_x32(max_x16(max16(v))); }
DI float act_absmax(const float* nfw, int lane) {
    float m = 0.f;
#pragma unroll
    for (int i = 0; i < 16; ++i) m = fmaxf(m, fabsf(nfw[lane + 64 * i]));
    return ACT_CLIP * wave_max(m);
}
DI float wave_sum(float v) { return sum_x32(sum_x16(sum16(v))); }
DI float siluf(float x) { return x * __builtin_amdgcn_rcpf(1.0f + __expf(-x)); }
DI float sigmoidf_(float x) { return 1.0f / (1.0f + __expf(-x)); }
DI int perm32i(int idx) { return ((idx >> 2) & 3) * 8 + (idx >> 4) * 4 + (idx & 3); }
DI int permcol(int c) { return (c & ~31) + perm32i(c & 31); }
template <class T> DI T opaque(T p) { asm volatile("" : "+v"(p)); return p; }

typedef GAS unsigned gu32;
#define RLX_AGENT __ATOMIC_RELAXED, __HIP_MEMORY_SCOPE_AGENT
constexpr int CW_BAR = 4096;
constexpr int MISC_OFF = LDS_BYTES - 64;
#define XB_TMO      128
#define XB_XCNT(j)  (256  + 64 * (j))
#define XB_XSUB(j)  (1280 + 64 * (j))
#define XB_XGEN(j)  (2304 + 64 * (j))
#define XB_TOP      3328
#define XB_TOPGEN   3392
#define XCD_BAR_WORDS 3456
#define XB_SPIN_CAP (1u << 18)

__device__ __forceinline__ unsigned xb_ld(unsigned* p)              { return __hip_atomic_load(p, __ATOMIC_RELAXED, __HIP_MEMORY_SCOPE_AGENT); }
__device__ __forceinline__ unsigned xb_add(unsigned* p, unsigned v) { return __hip_atomic_fetch_add(p, v, __ATOMIC_RELAXED, __HIP_MEMORY_SCOPE_AGENT); }
__device__ __forceinline__ unsigned xb_xcc_id() { return (unsigned)__builtin_amdgcn_s_getreg((3 << 11) | 20) & 0xFu; }
#define XB_SPIN(cond, bar) do { unsigned _sp = 0; while (cond) { __builtin_amdgcn_s_sleep(1); \
    if ((++_sp & 255u) == 0u) { if (xb_ld(&(bar)[XB_TMO])) break; if (_sp > XB_SPIN_CAP) { atomicAdd(&(bar)[XB_TMO], 1u); break; } } } } while (0)

struct XcdBarrier {
    unsigned* bar; unsigned x;
    volatile LAS unsigned* st;
};

__device__ __forceinline__ XcdBarrier xcd_barrier_post(unsigned* bar, volatile LAS unsigned* st) {
    XcdBarrier b; b.bar = bar; b.x = xb_xcc_id(); b.st = st;
    if (threadIdx.x == 0) (void)xb_add(&bar[XB_XCNT(b.x)], 1u);
    return b;
}
__device__ __forceinline__ void xcd_barrier_complete(unsigned* bar, unsigned x, unsigned& nloc, unsigned& nx) {
    const unsigned G = gridDim.x * gridDim.y * gridDim.z;
    unsigned sum, cnt, mine, sp = 0u;
    for (;;) {
        sum = 0u; cnt = 0u; mine = 0u;
#pragma unroll
        for (unsigned j = 0; j < 16; ++j) { const unsigned c = xb_ld(&bar[XB_XCNT(j)]); sum += c; cnt += (c > 0u) ? 1u : 0u; mine = (j == x) ? c : mine; }
        if (sum == G) break;
        __builtin_amdgcn_s_sleep(1);
        if ((++sp & 255u) == 0u) { if (xb_ld(&bar[XB_TMO])) break; if (sp > XB_SPIN_CAP) { atomicAdd(&bar[XB_TMO], 1u); break; } }
    }
    nloc = mine > 0u ? mine : 1u; nx = cnt > 0u ? cnt : 1u;
}

__device__ __forceinline__ void xcd_barrier(const XcdBarrier& b) {
    asm volatile("s_waitcnt vmcnt(0)" ::: "memory");
    __syncthreads();
    if (threadIdx.x == 0) {
        unsigned* bar = b.bar;
        __builtin_amdgcn_s_waitcnt(0);
        unsigned nloc = b.st[0], nx = b.st[1];
        if (nloc == 0u) { xcd_barrier_complete(bar, b.x, nloc, nx); b.st[0] = nloc; b.st[1] = nx; }
        const unsigned old = xb_add(&bar[XB_XSUB(b.x)], 1u);
        const unsigned gen = old / nloc;
        if (old + 1u == (gen + 1u) * nloc) {
            __builtin_amdgcn_fence(__ATOMIC_RELEASE, "agent");
            asm volatile("s_waitcnt vmcnt(0)" ::: "memory");
            const unsigned og = xb_add(&bar[XB_TOP], 1u);
            const unsigned tg = og / nx;
            if (og + 1u == (tg + 1u) * nx) xb_add(&bar[XB_TOPGEN], 1u);
            else XB_SPIN(xb_ld(&bar[XB_TOPGEN]) == tg, bar);
            __builtin_amdgcn_fence(__ATOMIC_ACQUIRE, "agent");
            xb_add(&bar[XB_XGEN(b.x)], 1u);
            asm volatile("s_waitcnt vmcnt(0)" ::: "memory");
        } else {
            XB_SPIN(xb_ld(&bar[XB_XGEN(b.x)]) == gen, bar);
            __builtin_amdgcn_fence(__ATOMIC_ACQUIRE, "agent");
            asm volatile("s_waitcnt vmcnt(0)" ::: "memory");
        }
    }
    __syncthreads();
}

struct Frame {
    LAS unsigned char* lds;
    int tid, lane, wave, vcu, G;
    const float* in[17];
    float* out; unsigned char* ws;
};

DI void p0_transpose_item(const float* W, int ldw, int nblk, bf16* WT, int K, int row_off, int rmul, LAS float* scr, int item, int lane) {
    const int kb = item / nblk, nb = item % nblk, k0 = 64 * kb, n0 = 32 * nb;
    const int r8 = lane >> 3, c4 = (lane & 7) * 4;
    f32x4 v[8];
#pragma unroll
    for (int i = 0; i < 8; ++i) v[i] = __builtin_nontemporal_load((const f32x4*)(W + (size_t)(k0 + 8 * i + r8) * ldw + n0 + c4));
#pragma unroll
    for (int i = 0; i < 8; ++i) { LAS float* d = scr + (8 * i + r8) * 33 + c4; d[0] = v[i].x; d[1] = v[i].y; d[2] = v[i].z; d[3] = v[i].w; }
    asm volatile("s_waitcnt lgkmcnt(0)" ::: "memory");
    const int c = lane & 7;
#pragma unroll
    for (int j = 0; j < 4; ++j) { const int n = (lane >> 3) + 8 * j; const LAS float* s = scr + (8 * c) * 33 + n;
        v4u o; o.x = pk2(s[0 * 33], s[1 * 33]); o.y = pk2(s[2 * 33], s[3 * 33]); o.z = pk2(s[4 * 33], s[5 * 33]); o.w = pk2(s[6 * 33], s[7 * 33]);
        *(GAS v4u*)(WT + (size_t)(row_off + (n0 + n) * rmul) * K + k0 + 8 * c) = o; }
    asm volatile("s_waitcnt lgkmcnt(0)" ::: "memory");
}
template <int NR> DI void rms_rows_to_bf16(const float* const (&xrow)[NR], const float* w, bf16* const (&orow)[NR], int lane) {
    const GAS f32x4* wr = (const GAS f32x4*)w + lane;
    f32x4 v[NR][4];
#pragma unroll
    for (int r = 0; r < NR; ++r) { const GAS f32x4* xr = (const GAS f32x4*)xrow[r] + lane;
#pragma unroll
        for (int j = 0; j < 4; ++j) v[r][j] = xr[64 * j]; }
    f32x4 ww[4];
#pragma unroll
    for (int j = 0; j < 4; ++j) ww[j] = wr[64 * j];
#pragma unroll
    for (int r = 0; r < NR; ++r) {
        float s_ = 0.f;
#pragma unroll
        for (int j = 0; j < 4; ++j) s_ += (v[r][j].x * v[r][j].x + v[r][j].y * v[r][j].y) + (v[r][j].z * v[r][j].z + v[r][j].w * v[r][j].w);
        const float rs = __builtin_amdgcn_rsqf(wave_sum(s_) * (1.f / DMODEL) + EPS);
        GAS v2u* o8 = (GAS v2u*)orow[r] + lane;
#pragma unroll
        for (int j = 0; j < 4; ++j) { v2u o; o.x = pk2(v[r][j].x * rs * ww[j].x, v[r][j].y * rs * ww[j].y); o.y = pk2(v[r][j].z * rs * ww[j].z, v[r][j].w * rs * ww[j].w); o8[64 * j] = o; }
    }
}
DI void q_strip(const float* W, int ldw, int n0, unsigned char* WQ, float* wsc, int rowbase, int rmul, LAS unsigned char* lds, int wave, int lane) {
    LAS float* scr = (LAS float*)(lds + wave * 8704); LAS float* cmx = (LAS float*)(lds + 8 * 8704);
    const int r8 = lane >> 3, c4 = (lane & 7) * 4, kw = 128 * wave;
    f32x4 mx = (f32x4){0.f, 0.f, 0.f, 0.f};
#pragma unroll
    for (int i = 0; i < 16; ++i) { const f32x4 v = *(const f32x4*)(W + (size_t)(kw + 8 * i + r8) * ldw + n0 + c4);
        mx.x = fmaxf(mx.x, fabsf(v.x)); mx.y = fmaxf(mx.y, fabsf(v.y)); mx.z = fmaxf(mx.z, fabsf(v.z)); mx.w = fmaxf(mx.w, fabsf(v.w)); }
    mx.x = max_x32(max_x16(fmaxf(mx.x, get_x8(mx.x)))); mx.y = max_x32(max_x16(fmaxf(mx.y, get_x8(mx.y))));
    mx.z = max_x32(max_x16(fmaxf(mx.z, get_x8(mx.z)))); mx.w = max_x32(max_x16(fmaxf(mx.w, get_x8(mx.w))));
    if (lane < 8) *(LAS f32x4*)(cmx + wave * 32 + c4) = mx;
    __syncthreads();
    float sq[4];
#pragma unroll
    for (int j = 0; j < 4; ++j) { const int n = (lane >> 3) + 8 * j; float m = cmx[n];
#pragma unroll
        for (int w = 1; w < 8; ++w) m = fmaxf(m, cmx[w * 32 + n]);
        sq[j] = m > 0.f ? 127.0f / m : 0.f;
        if (wave == 0 && (lane & 7) == 0) wsc[rowbase + n * rmul] = m * (1.0f / 127.0f); }
    const int c = lane & 7;
#pragma unroll
    for (int kb = 0; kb < 2; ++kb) {
        const int k0 = kw + 64 * kb;
        f32x4 v[8];
#pragma unroll
        for (int i = 0; i < 8; ++i) v[i] = *(const f32x4*)(W + (size_t)(k0 + 8 * i + r8) * ldw + n0 + c4);
#pragma unroll
        for (int i = 0; i < 8; ++i) { LAS float* d = scr + (8 * i + r8) * 33 + c4; d[0] = v[i].x; d[1] = v[i].y; d[2] = v[i].z; d[3] = v[i].w; }
        asm volatile("s_waitcnt lgkmcnt(0)" ::: "memory");
#pragma unroll
        for (int j = 0; j < 4; ++j) { const int n = (lane >> 3) + 8 * j; const LAS float* t = scr + (8 * c) * 33 + n;
            v2u o; o.x = q8x4(t[0 * 33], t[1 * 33], t[2 * 33], t[3 * 33], sq[j]); o.y = q8x4(t[4 * 33], t[5 * 33], t[6 * 33], t[7 * 33], sq[j]);
            *(GAS v2u*)(WQ + (size_t)(rowbase + n * rmul) * 1024 + k0 + 8 * c) = o; }
        asm volatile("s_waitcnt lgkmcnt(0)" ::: "memory");
    }
    __syncthreads();
}
DI float reduce16(const float (&ga)[16], int lane) {
    float gb[8], gc[4];
    const bool h32 = (lane & 32) != 0, h16 = (lane & 16) != 0;
#pragma unroll
    for (int i = 0; i < 8; ++i) { const float lo = sum_x32(ga[i]), hi = sum_x32(ga[i + 8]); gb[i] = h32 ? hi : lo; }
#pragma unroll
    for (int i = 0; i < 4; ++i) { const float lo = sum_x16(gb[i]), hi = sum_x16(gb[i + 4]); gc[i] = h16 ? hi : lo; }
    float res = 0.f;
#pragma unroll
    for (int i = 0; i < 4; ++i) { const float t = sum16(gc[i]); res = ((lane & 3) == i) ? t : res; }
    return res;
}
DI void p0_load_rows(const float* x0, f32x4 (&v)[2][4], int lane) {
#pragma unroll
    for (int r = 0; r < 2; ++r) { const GAS f32x4* xr = (const GAS f32x4*)(x0 + (size_t)r * DMODEL) + lane;
#pragma unroll
        for (int j = 0; j < 4; ++j) v[r][j] = xr[64 * j]; }
}
DI void rms_rows_to_q8(f32x4 (&v)[2][4], const f32x4 (&ww)[4], unsigned char* const (&orow)[2], float* const (&xsc)[2], float* const (&gout)[2], const LAS float* gw_, int lane) {
    const LAS float* gw = gw_;
    gw = opaque(gw);
#pragma unroll
    for (int r = 0; r < 2; ++r) {
        float s_ = 0.f;
#pragma unroll
        for (int j = 0; j < 4; ++j) s_ += (v[r][j].x * v[r][j].x + v[r][j].y * v[r][j].y) + (v[r][j].z * v[r][j].z + v[r][j].w * v[r][j].w);
        const float rs = __builtin_amdgcn_rsqf(wave_sum(s_) * (1.f / DMODEL) + EPS);
        float am = 0.f;
#pragma unroll
        for (int j = 0; j < 4; ++j) { v[r][j] = v[r][j] * ww[j] * rs; am = fmaxf(fmaxf(am, fmaxf(fabsf(v[r][j].x), fabsf(v[r][j].y))), fmaxf(fabsf(v[r][j].z), fabsf(v[r][j].w))); }
        am = wave_max(am);
        const float qsc = am > 0.f ? 127.0f / am : 0.f;
        if (lane == 0) *xsc[r] = am * (1.0f / 127.0f);
        GAS unsigned* o4 = (GAS unsigned*)orow[r] + lane;
#pragma unroll
        for (int j = 0; j < 4; ++j) o4[64 * j] = q8x4(v[r][j].x, v[r][j].y, v[r][j].z, v[r][j].w, qsc);
    }
#ifndef NO_GATES
    f32x2_t ga2[2][8];
#pragma unroll
    for (int c = 0; c < 8; ++c) { ga2[0][c] = (f32x2_t){0.f, 0.f}; ga2[1][c] = (f32x2_t){0.f, 0.f}; }
    asm volatile("" : "+v"(v[0][0]), "+v"(v[0][1]), "+v"(v[0][2]), "+v"(v[0][3]), "+v"(v[1][0]), "+v"(v[1][1]), "+v"(v[1][2]), "+v"(v[1][3]));
#pragma unroll
    for (int j = 0; j < 4; ++j)
#pragma unroll
        for (int q = 0; q < 4; ++q) { const LAS f32x4* g4 = (const LAS f32x4*)gw + ((j * 4 + q) * 4) * 64 + lane;
            const f32x4 g0 = g4[0], g1 = g4[64], g2 = g4[128], g3 = g4[192];
            const f32x2_t w0 = {g0.x, g0.y}, w1 = {g0.z, g0.w}, w2 = {g1.x, g1.y}, w3 = {g1.z, g1.w}, w4 = {g2.x, g2.y}, w5 = {g2.z, g2.w}, w6 = {g3.x, g3.y}, w7 = {g3.z, g3.w};
#pragma unroll
            for (int r = 0; r < 2; ++r) { const float h = v[r][j][q]; const f32x2_t h2 = {h, h};
                ga2[r][0] += h2 * w0; ga2[r][1] += h2 * w1; ga2[r][2] += h2 * w2; ga2[r][3] += h2 * w3; ga2[r][4] += h2 * w4; ga2[r][5] += h2 * w5; ga2[r][6] += h2 * w6; ga2[r][7] += h2 * w7; }
            asm volatile("" : "+v"(ga2[1][0]), "+v"(ga2[1][1]), "+v"(ga2[1][2]), "+v"(ga2[1][3]), "+v"(ga2[1][4]), "+v"(ga2[1][5]), "+v"(ga2[1][6]), "+v"(ga2[1][7]) :: "memory"); }
    const int gc_ = 4 * (lane >> 4) + (lane & 3);
#pragma unroll
    for (int r = 0; r < 2; ++r) { float ga[16];
#pragma unroll
        for (int c = 0; c < 8; ++c) { ga[2 * c] = ga2[r][c].x; ga[2 * c + 1] = ga2[r][c].y; }
        const float res = reduce16(ga, lane); if ((lane & 12) == 0) gout[r][gc_] = res; }
#endif
}
DI void p0_prologue(Frame& F) {
    const float* w_in = F.in[2];
    unsigned char* WIN = F.ws + WS_WIN; float* WSI = (float*)(F.ws + WS_WSI);
    constexpr int NSTRIP = 64 + 24;
    if (F.vcu < NSTRIP) { const int st = F.vcu;
        if (st < 64) q_strip(w_in, 2832, 32 * st, WIN, WSI, 32 * st, 1, F.lds, F.wave, F.lane);
        else q_strip(w_in + 2064, 2832, 32 * (st - 64), WIN, WSI, 2048 + 32 * (st - 64), 1, F.lds, F.wave, F.lane); }
    unsigned char* XN = F.ws + WS_XN; float* XSC = (float*)(F.ws + WS_XSC); float* GATES = (float*)(F.ws + WS_GATES);
    constexpr int GWL = 73728, GWP = 2064, GWM = 16 * GWP;
    { LAS unsigned char* gwl = F.lds + GWL;
      for (int i = F.tid; i < 512 * 4; i += NTHREADS) { const int k = (i >> 2) * 2, c4 = i & 3;
          const f32x4 w0_ = *(const f32x4*)(w_in + (size_t)k * 2832 + 2048 + c4 * 4), w1_ = *(const f32x4*)(w_in + (size_t)(k + 1) * 2832 + 2048 + c4 * 4);
#pragma unroll
          for (int j = 0; j < 4; ++j) { const unsigned hh = pk2(w0_[j], w1_[j]); const unsigned ll = pk2(w0_[j] - bflo(hh), w1_[j] - bfhi(hh));
              *(LAS unsigned*)(gwl + (c4 * 4 + j) * GWP + k * 2) = hh; *(LAS unsigned*)(gwl + GWM + (c4 * 4 + j) * GWP + k * 2) = ll; } } }
    __syncthreads();
    constexpr int PXO = 0, PAO = 4096;
    const int lane = F.lane, n16 = lane & 15, g = lane >> 4, wv = F.wave;
    LAS float* px = (LAS float*)(F.lds + PXO); LAS f32x4* pa = (LAS f32x4*)(F.lds + PAO);
#pragma unroll 1
    for (int T0 = F.vcu * 4; T0 < TT / 16; T0 += F.G * 4) {
        f32x4 xa[4][4], xb[4][4], wa[4], wb[4];
#pragma unroll
        for (int t = 0; t < 4; ++t) { const float* xr = F.in[0] + (size_t)((T0 + t) * 16 + n16) * DMODEL + 128 * wv + 8 * g;
#pragma unroll
            for (int i = 0; i < 4; ++i) { xa[t][i] = __builtin_nontemporal_load((const f32x4*)(xr + 32 * i)); xb[t][i] = __builtin_nontemporal_load((const f32x4*)(xr + 32 * i + 4)); } }
        { const float* nw = F.in[1] + 128 * wv + 8 * g;
#pragma unroll
          for (int i = 0; i < 4; ++i) { wa[i] = *(const f32x4*)(nw + 32 * i); wb[i] = *(const f32x4*)(nw + 32 * i + 4); } }
#pragma unroll
        for (int t = 0; t < 4; ++t) { float ss = 0.f, am = 0.f;
#pragma unroll
            for (int i = 0; i < 4; ++i) { const f32x4 a = xa[t][i], b2 = xb[t][i];
                ss += (a.x * a.x + a.y * a.y) + (a.z * a.z + a.w * a.w) + (b2.x * b2.x + b2.y * b2.y) + (b2.z * b2.z + b2.w * b2.w);
                am = fmaxf(fmaxf(fmaxf(am, fmaxf(fabsf(a.x * wa[i].x), fabsf(a.y * wa[i].y))), fmaxf(fabsf(a.z * wa[i].z), fabsf(a.w * wa[i].w))), fmaxf(fmaxf(fabsf(b2.x * wb[i].x), fabsf(b2.y * wb[i].y)), fmaxf(fabsf(b2.z * wb[i].z), fabsf(b2.w * wb[i].w)))); }
            ss = sum_x32(sum_x16(ss)); am = max_x32(max_x16(am));
            if (g == 0) { px[((t * 8 + wv) * 16 + n16) * 2] = ss; px[((t * 8 + wv) * 16 + n16) * 2 + 1] = am; } }
        __syncthreads();
        const LAS unsigned char* wl_ = F.lds + GWL + n16 * GWP + 256 * wv + g * 16;
#pragma unroll
        for (int t = 0; t < 4; ++t) { float ss = 0.f, am = 0.f;
#pragma unroll
            for (int w = 0; w < 8; ++w) { ss += px[((t * 8 + w) * 16 + n16) * 2]; am = fmaxf(am, px[((t * 8 + w) * 16 + n16) * 2 + 1]); }
            const int row = (T0 + t) * 16 + n16;
            const float rs = __builtin_amdgcn_rsqf(ss * (1.f / DMODEL) + EPS);
            const float amax = am * rs, qsc = amax > 0.f ? 127.0f / amax : 0.f;
            if (g == 0 && wv == 0) XSC[row] = amax * (1.0f / 127.0f);
            f32x4 acc = (f32x4){0.f, 0.f, 0.f, 0.f};
#pragma unroll
            for (int i = 0; i < 4; ++i) { const f32x4 a = xa[t][i], b2 = xb[t][i];
                float hv[8] = {a.x * rs * wa[i].x, a.y * rs * wa[i].y, a.z * rs * wa[i].z, a.w * rs * wa[i].w, b2.x * rs * wb[i].x, b2.y * rs * wb[i].y, b2.z * rs * wb[i].z, b2.w * rs * wb[i].w};
                v4u hi, lo;
                hi.x = pk2(hv[0], hv[1]); hi.y = pk2(hv[2], hv[3]); hi.z = pk2(hv[4], hv[5]); hi.w = pk2(hv[6], hv[7]);
                lo.x = pk2(hv[0] - bflo(hi.x), hv[1] - bfhi(hi.x)); lo.y = pk2(hv[2] - bflo(hi.y), hv[3] - bfhi(hi.y));
                lo.z = pk2(hv[4] - bflo(hi.z), hv[5] - bfhi(hi.z)); lo.w = pk2(hv[6] - bflo(hi.w), hv[7] - bfhi(hi.w));
                { v2u q; q.x = q8x4(hv[0], hv[1], hv[2], hv[3], qsc); q.y = q8x4(hv[4], hv[5], hv[6], hv[7], qsc); *(v2u*)(XN + (size_t)row * DMODEL + 128 * wv + 32 * i + 8 * g) = q; }
                const bf16x8 ah = __builtin_bit_cast(bf16x8, hi), al = __builtin_bit_cast(bf16x8, lo);
                const bf16x8 bh = *(const LAS bf16x8*)(wl_ + i * 64), bl = *(const LAS bf16x8*)(wl_ + GWM + i * 64);
                acc = __builtin_amdgcn_mfma_f32_16x16x32_bf16(ah, bh, acc, 0, 0, 0);
                acc = __builtin_amdgcn_mfma_f32_16x16x32_bf16(ah, bl, acc, 0, 0, 0);
                acc = __builtin_amdgcn_mfma_f32_16x16x32_bf16(al, bh, acc, 0, 0, 0); }
            pa[(t * 8 + wv) * 64 + lane] = acc; }
        __syncthreads();
        if (wv < 4) { const int t = wv; f32x4 acc = pa[(t * 8) * 64 + lane];
#pragma unroll
            for (int w = 1; w < 8; ++w) acc += pa[(t * 8 + w) * 64 + lane];
#pragma unroll
            for (int r = 0; r < 4; ++r) GATES[(size_t)((T0 + t) * 16 + 4 * g + r) * 16 + n16] = acc[r]; }
        __syncthreads();
    }
}

struct EpiProj {
    static constexpr bool PERM = true, AFTER_DRAIN = false;
    bf16 *qkva, *za, *qkvb; const float* wsi; const float* xsc;
    DI void operator()(const pg8::i32x4 (&acc)[2][2][4][2], const pg8::Unit& u, int wr, int wc, int fr, int fq) const {
        const int row0 = u.pm * 256 + wr * 64 + fr;
        const float* ws_ = wsi + u.pn * 256 + wc * 32 + 8 * fq;
        bf16* base; int ldc, colt;
        if (u.pn < 6) { base = qkva; ldc = 1536; colt = u.pn * 256; } else if (u.pn < 8) { base = za; ldc = 512; colt = (u.pn - 6) * 256; } else { base = qkvb; ldc = 768; colt = (u.pn - 8) * 256; }
        const int col0 = colt + wc * 32 + 8 * fq;
        f32x4 s0[2], s1[2];
#pragma unroll
        for (int bj = 0; bj < 2; ++bj) { s0[bj] = *(const f32x4*)(ws_ + bj * 128); s1[bj] = *(const f32x4*)(ws_ + bj * 128 + 4); }
        float rsc[2][4];
#pragma unroll
        for (int ai = 0; ai < 2; ++ai)
#pragma unroll
            for (int m = 0; m < 4; ++m) rsc[ai][m] = xsc[row0 + ai * 128 + m * 16];
#pragma unroll
        for (int ai = 0; ai < 2; ++ai)
#pragma unroll
            for (int m = 0; m < 4; ++m) { bf16* rowp = base + (size_t)(row0 + ai * 128 + m * 16) * ldc + col0; const float rr = rsc[ai][m];
#pragma unroll
                for (int bj = 0; bj < 2; ++bj) { const pg8::i32x4 a0 = acc[ai][bj][m][0], a1 = acc[ai][bj][m][1]; const f32x4 t0 = s0[bj] * rr, t1 = s1[bj] * rr; pg8::u32x4 w;
                    w.x = pg8::cvt_pk_bf16((float)a0[0] * t0[0], (float)a0[1] * t0[1]); w.y = pg8::cvt_pk_bf16((float)a0[2] * t0[2], (float)a0[3] * t0[3]);
                    w.z = pg8::cvt_pk_bf16((float)a1[0] * t1[0], (float)a1[1] * t1[1]); w.w = pg8::cvt_pk_bf16((float)a1[2] * t1[2], (float)a1[3] * t1[3]);
                    *(pg8::u32x4*)(rowp + bj * 128) = w; } }
    }
};
struct IdRows { DI int row(const pg8::Unit& u, int r) const { return u.pm * 256 + r; } };
struct EpiResid {
    static constexpr bool PERM = true, AFTER_DRAIN = false;
    const float* x; bf16* x1;
    DI void operator()(const pg8::f32x4 (&acc)[2][2][4][2], const pg8::Unit& u, int wr, int wc, int fr, int fq) const {
        const int row0 = u.pm * 256 + wr * 64 + fr, col0 = u.pn * 256 + wc * 32 + 8 * fq;
#pragma unroll
        for (int ai = 0; ai < 2; ++ai)
#pragma unroll
            for (int m = 0; m < 4; ++m) { const size_t off = (size_t)(row0 + ai * 128 + m * 16) * DMODEL + col0;
#pragma unroll
                for (int bj = 0; bj < 2; ++bj) { const pg8::f32x4 v0 = *(const pg8::f32x4*)(x + off + bj * 128) + acc[ai][bj][m][0], v1 = *(const pg8::f32x4*)(x + off + bj * 128 + 4) + acc[ai][bj][m][1]; pg8::u32x4 w;
                    w.x = pg8::cvt_pk_bf16(v0[0], v0[1]); w.y = pg8::cvt_pk_bf16(v0[2], v0[3]); w.z = pg8::cvt_pk_bf16(v1[0], v1[1]); w.w = pg8::cvt_pk_bf16(v1[2], v1[3]);
                    *(pg8::u32x4*)(x1 + off + bj * 128) = w; } }
    }
};
struct EpiGU {
    static constexpr bool PERM = true, AFTER_DRAIN = false;
    bf16* hid; const float* wsc; float ainv;
    DI void operator()(const pg8::i32x4 (&acc)[2][2][4][2], const pg8::Unit& u, int wr, int wc, int fr, int fq) const {
        const int row0 = u.pm * 256 + wr * 64 + fr; const int jt = u.pn & 3;
        const int ff0 = jt * 128 + wc * 16 + 4 * fq;
        const float* ws_ = wsc + u.ex * 1024 + jt * 256 + wc * 32 + 8 * fq;
        f32x4 s0[2], s1[2];
#pragma unroll
        for (int bj = 0; bj < 2; ++bj) { s0[bj] = *(const f32x4*)(ws_ + bj * 128) * ainv; s1[bj] = *(const f32x4*)(ws_ + bj * 128 + 4) * ainv; }
#pragma unroll
        for (int ai = 0; ai < 2; ++ai)
#pragma unroll
            for (int m = 0; m < 4; ++m) { bf16* rowp = hid + (size_t)(row0 + ai * 128 + m * 16) * FFE + ff0;
#pragma unroll
                for (int bj = 0; bj < 2; ++bj) { const pg8::i32x4 a0 = acc[ai][bj][m][0], a1 = acc[ai][bj][m][1];
                    const float g0 = (float)a0[0] * s0[bj][0], u0 = (float)a0[1] * s0[bj][1], g1 = (float)a0[2] * s0[bj][2], u1 = (float)a0[3] * s0[bj][3];
                    const float g2 = (float)a1[0] * s1[bj][0], u2 = (float)a1[1] * s1[bj][1], g3 = (float)a1[2] * s1[bj][2], u3 = (float)a1[3] * s1[bj][3];
                    v2u w; w.x = pg8::cvt_pk_bf16(siluf(g0) * u0, siluf(g1) * u1); w.y = pg8::cvt_pk_bf16(siluf(g2) * u2, siluf(g3) * u3);
                    *(v2u*)(rowp + bj * 64) = w; } }
    }
};
struct EpiY {
    static constexpr bool PERM = true, AFTER_DRAIN = false;
    bf16* y;
    DI void operator()(const pg8::f32x4 (&acc)[2][2][4][2], const pg8::Unit& u, int wr, int wc, int fr, int fq) const {
        const int row0 = u.pm * 256 + wr * 64 + fr; const int col0 = (u.pn & 3) * 256 + wc * 32 + 8 * fq;
#pragma unroll
        for (int ai = 0; ai < 2; ++ai)
#pragma unroll
            for (int m = 0; m < 4; ++m) { bf16* rowp = y + (size_t)(row0 + ai * 128 + m * 16) * DMODEL + col0;
#pragma unroll
                for (int bj = 0; bj < 2; ++bj) { const pg8::f32x4 v0 = acc[ai][bj][m][0], v1 = acc[ai][bj][m][1]; pg8::u32x4 w;
                    w.x = pg8::cvt_pk_bf16(v0[0], v0[1]); w.y = pg8::cvt_pk_bf16(v0[2], v0[3]); w.z = pg8::cvt_pk_bf16(v1[0], v1[1]); w.w = pg8::cvt_pk_bf16(v1[2], v1[3]);
                    *(pg8::u32x4*)(rowp + bj * 128) = w; } }
    }
};
constexpr int ETAB_OFF = 131072;
typedef GAS unsigned mo_gu32;
struct MoeOrder {
    const LAS unsigned* etab; int G, c, esplit, pnoff;
    mo_gu32* cnt; int mode, rot; mutable int pend;
    DI bool next(int i, pg8::Unit& u) const {
        if (G % 8 != 0) {
            int L = i * G + c;
            for (int e = 0; e < NEXP; ++e) { const int n4 = 4 * (int)etab[2 * e + 1]; if (L < n4) { u.pm = (int)etab[2 * e] + (L >> 2); u.pn = (e < esplit ? 4 * e : pnoff + 4 * (e - esplit)) + (L & 3); u.ex = e; u.tq = L >> 2; return true; } L -= n4; }
            return false; }
        const int x = c & 7, per = G >> 3; int k = (c >> 3) - rot; k += (k < 0) ? per : 0; int L = i * per + k;
#pragma unroll
        for (int q = 0; q < NEXP / 8; ++q) { const int e = x + 8 * q; const int n4 = 4 * (int)etab[2 * e + 1];
            if (L < n4) { u.pm = (int)etab[2 * e] + (L >> 2); u.pn = (e < esplit ? 4 * e : pnoff + 4 * (e - esplit)) + (L & 3); u.ex = e; u.tq = L >> 2; return true; } L -= n4; }
        return false; }
    DI int xcd_units() const { int n = 0; for (int q = 0; q < NEXP / 8; ++q) n += 4 * (int)etab[2 * ((c & 7) + 8 * q) + 1]; return n; }
    DI void publish(int pm) const { if ((threadIdx.x & 63) == 0) __hip_atomic_fetch_add(cnt + pm * 16, 1u, __ATOMIC_RELAXED, __HIP_MEMORY_SCOPE_AGENT); }
    DI void a_ready(const pg8::Unit& u) const {
        if (mode != 2) return;
        mo_gu32* w = cnt + u.pm * 16;
        for (unsigned spins = 0; spins < (1u << 22); ++spins) {
            if ((unsigned)__builtin_amdgcn_readfirstlane(__hip_atomic_load(w, __ATOMIC_RELAXED, __HIP_MEMORY_SCOPE_AGENT)) >= 32u) break;
            __builtin_amdgcn_s_sleep(1); }
    }
    DI void done(const pg8::Unit& u) const { if (mode != 1) return; if (pend >= 0) publish(pend); pend = u.pm; }
    DI void flush() const { if (mode == 1 && pend >= 0) { publish(pend); pend = -1; } }
};
struct MoeRows {
    const int* list; const LAS unsigned* etab;
    DI int row(const pg8::Unit& u, int r) const {
        const int slot = u.tq * 256 + r, e = u.ex; if (slot >= (int)etab[64 + e]) return 0;
        const LAS unsigned* sp = etab + 96 + 8 * e; int sb = 0;
#pragma unroll
        for (int q = 1; q < 8; ++q) sb += (slot >= (int)sp[q]) ? 1 : 0;
        return list[(size_t)(e * 8 + sb) * TT + (slot - (int)sp[sb])]; }
};

DI void p2_rope(Frame& F) {
    const int gw = F.vcu * NWAVES + F.wave, NGW = F.G * NWAVES, lane = F.lane;
    const bf16* QKVB = (const bf16*)(F.ws + WS_QKVB);
    bf16* QR = (bf16*)((unsigned char*)F.out + DO_QR); bf16* KR = (bf16*)((unsigned char*)F.out + DO_KR); bf16* VR = (bf16*)((unsigned char*)F.out + DO_VR);
    const int pi = lane & 31, hsel = lane >> 5;
    const float qw0 = F.in[7][2 * pi], qw1 = F.in[7][2 * pi + 1], kw0 = F.in[8][2 * pi], kw1 = F.in[8][2 * pi + 1];
    const float invf = exp2f(-(float)(2 * (pi & 15)) * (13.287712379549449f / 32.0f));
    constexpr float C2 = 0.125f * 1.4426950408889634f;
    constexpr int NB4 = 4;
    for (int t0 = gw; t0 < TT; t0 += NB4 * NGW) {
        unsigned w[NB4][5], vw[NB4];
#pragma unroll
        for (int u = 0; u < NB4; ++u) { const int t = t0 + u * NGW; const unsigned* src = (const unsigned*)(QKVB + (size_t)(t < TT ? t : t0) * 768);
#pragma unroll
            for (int j = 0; j < 5; ++j) w[u][j] = src[(2 * j + hsel) * 32 + pi];
            vw[u] = src[320 + lane]; }
#pragma unroll
        for (int u = 0; u < NB4; ++u) {
            const int t = t0 + u * NGW; if (t >= TT) break;
            const int s_ = t & (SEQ - 1); const float pos = (pi < 16) ? (float)(s_ >> 6) : (float)(s_ & 63);
            const float ang = pos * invf;
            const float rev = ang * 0.15915494309189535f;
            const float sn = __builtin_amdgcn_sinf(rev), cs = __builtin_amdgcn_cosf(rev);
#pragma unroll
            for (int j = 0; j < 5; ++j) {
                const int head = 2 * j + hsel;
                const float x0 = bflo(w[u][j]), x1 = bfhi(w[u][j]);
                float ss = x0 * x0 + x1 * x1;
                ss = sum_x16(sum16(ss));
                const float rs = __builtin_amdgcn_rsqf(ss * (1.f / 64.f) + EPS);
                const bool isq = head < 8;
                const float y0 = x0 * rs * (isq ? qw0 : kw0), y1 = x1 * rs * (isq ? qw1 : kw1);
                float o0 = y0 * cs - y1 * sn, o1 = y0 * sn + y1 * cs;
                if (isq) { o0 *= C2; o1 *= C2; ((unsigned*)(QR + (size_t)t * 512))[head * 32 + pi] = pk2(o0, o1); }
                else { const int hk = head - 8, bq = t >> 13, sq = t & (SEQ - 1);
                    ((unsigned*)(KR + ((size_t)((bq * 2 + hk) * 128 + (sq >> 6)) * 8 + (pi >> 2)) * 512 + (sq & 63) * 8))[pi & 3] = pk2(o0, o1); }
            }
            { const int hk = lane >> 5, d = 2 * (lane & 31), bq = t >> 13, sq = t & (SEQ - 1), r = sq & 63;
              ((unsigned*)(VR + ((size_t)((bq * 2 + hk) * 128 + (sq >> 6)) * 8 + (d >> 5) * 4 + (r >> 4)) * 512 + ((r & 15) * 4 + ((d & 31) >> 3)) * 8))[(d & 7) >> 1] = vw[u]; }
        }
    }
}

constexpr int G_KNP = 0, G_QNP = 17408, G_KNTP = 34816, G_VCT = 53248;
constexpr int G_D0 = 71680, G_D1 = 71680 + 19456;
constexpr int GD_TBP = 0, GD_AP = 9216, GD_VEC = 18432;
constexpr int G_LM = 110592;
constexpr int G_GV = G_LM + 32768;
static_assert(G_GV + 2048 <= LDS_BYTES - 64, "gdn pre lds");

#define TRI_ROW(i, LC, LN) { \
        if ((i) + 1 < 64) { _Pragma("unroll") for (int j4 = 0; j4 < ((i) + 1 + 3) / 4 && j4 < 8; ++j4) LN[j4] = *(const LAS f32x4*)(L + ((i) + 1) * 64 + 4 * j4); } \
        _Pragma("unroll") for (int j4 = 8; j4 < ((i) + 3) / 4; ++j4) lt[j4 - 8] = *(const LAS f32x4*)(L + (i) * 64 + 4 * j4); \
        __builtin_amdgcn_sched_barrier(0); \
        f32x2_t a0 = {(lane == (i)) ? 1.0f : 0.0f, 0.f}, a1 = {0.f, 0.f}; \
        _Pragma("unroll") for (int j4 = 0; j4 < ((i) + 3) / 4; ++j4) { const f32x4 l = (j4 < 8) ? LC[j4 & 7] : lt[(j4 - 8) & 7]; \
            f32x2_t l0 = {l.x, (4 * j4 + 1 < (i)) ? l.y : 0.f}, l1 = {(4 * j4 + 2 < (i)) ? l.z : 0.f, (4 * j4 + 3 < (i)) ? l.w : 0.f}; \
            a0 -= l0 * xp[2 * j4]; if (4 * j4 + 2 < (i)) a1 -= l1 * xp[2 * j4 + 1]; } \
        const float a = (a0.x + a0.y) + (a1.x + a1.y); \
        if ((i) & 1) xp[(i) >> 1].y = a; else { xp[(i) >> 1].x = a; xp[(i) >> 1].y = 0.f; } \
        TBP[(REV ? 63 - (i) : (i)) * 72 + pc] = (bf16)(pk2(a * bcol, 0.f) & 0xffffu); \
        __builtin_amdgcn_sched_barrier(0); }
template <bool REV> DI void tri_inverse(LAS float* L, const LAS float* beta, LAS bf16* TBP, int lane) {
    f32x2_t xp[32];
    L = opaque(L); TBP = opaque(TBP); lane = opaque(lane);
    const float bcol = REV ? beta[63 - lane] : beta[lane];
    const int pc = REV ? permcol(63 - lane) : permcol(lane);
    f32x4 la[8], lb[8], lt[8];
#pragma unroll
    for (int ii = 0; ii < 64; ii += 2) { TRI_ROW(ii, la, lb) TRI_ROW(ii + 1, lb, la) }
}
#undef TRI_ROW

DI void gdn_conv(Frame& F, LAS unsigned char* lds, int t384, int b, int h, int n) {
    const bf16* QKVA = (const bf16*)(F.ws + WS_QKVA); const float* convw = F.in[3];
    const int cgp = t384 % 48, rg = t384 / 48, mat = cgp >> 4, cc = (cgp & 15) * 8;
    const int col = mat * 512 + h * 128 + cc;
    float w[5][8];
#pragma unroll
    for (int j = 0; j < 5; ++j) { const f32x4 a = *(const f32x4*)(convw + j * 1536 + col), bq = *(const f32x4*)(convw + j * 1536 + col + 4);
        w[j][0] = a.x; w[j][1] = a.y; w[j][2] = a.z; w[j][3] = a.w; w[j][4] = bq.x; w[j][5] = bq.y; w[j][6] = bq.z; w[j][7] = bq.w; }
    const int a4 = (cc >> 3) & 3, p0 = (cc & ~31) + 16 * (a4 & 1) + 4 * (a4 >> 1);
    const int ra = rg & 3, q0 = (rg >> 2) * 32 + 16 * (ra & 1) + 4 * (ra >> 1);
    v4u rawr[12];
#pragma unroll
    for (int i = 0; i < 12; ++i) { const int pos = n * 64 + rg * 8 - 2 + i; rawr[i] = (v4u){0u, 0u, 0u, 0u};
        if (pos >= 0 && pos < SEQ) rawr[i] = *(const v4u*)(QKVA + (size_t)(b * SEQ + pos) * 1536 + col); }
#pragma unroll
    for (int hf = 0; hf < 2; ++hf) {
        float o[4][8];
#pragma unroll
        for (int r = 0; r < 4; ++r)
#pragma unroll
            for (int c = 0; c < 8; ++c) o[r][c] = 0.f;
#pragma unroll
        for (int i = 0; i < 8; ++i) {
            const v4u raw = rawr[hf * 4 + i];
            float xin[8] = {bflo(raw.x), bfhi(raw.x), bflo(raw.y), bfhi(raw.y), bflo(raw.z), bfhi(raw.z), bflo(raw.w), bfhi(raw.w)};
#pragma unroll
            for (int j = 0; j < 5; ++j) { const int r = i - j; if (r >= 0 && r < 4) {
#pragma unroll
                for (int c = 0; c < 8; ++c) o[r][c] += w[j][c] * xin[c]; } }
        }
#pragma unroll
        for (int r = 0; r < 4; ++r) {
            float ss = 0.f;
#pragma unroll
            for (int c = 0; c < 8; ++c) { o[r][c] = siluf(o[r][c]); ss += o[r][c] * o[r][c]; }
            ss = sum16(ss);
            float sc = 1.0f;
            if (mat < 2) { sc = __builtin_amdgcn_rsqf(ss + EPS); if (mat == 0) sc *= 0.08838834764831845f; }
#pragma unroll
            for (int c = 0; c < 8; ++c) o[r][c] *= sc;
        }
        if (mat < 2) {
            LAS unsigned char* tile = lds + (mat == 0 ? G_QNP : G_KNP);
#pragma unroll
            for (int r = 0; r < 4; ++r) { const int c = rg * 8 + hf * 4 + r;
                v2u lo, hi2; lo.x = pk2(o[r][0], o[r][1]); lo.y = pk2(o[r][2], o[r][3]); hi2.x = pk2(o[r][4], o[r][5]); hi2.y = pk2(o[r][6], o[r][7]);
                *(LAS v2u*)(tile + c * 272 + p0 * 2) = lo; *(LAS v2u*)(tile + c * 272 + (p0 + 8) * 2) = hi2; }
        }
        if (mat >= 1) {
#pragma unroll
            for (int c = 0; c < 8; ++c) {
                v2u q4; q4.x = pk2(o[0][c], o[1][c]); q4.y = pk2(o[2][c], o[3][c]);
                if (mat == 1) *(LAS v2u*)(lds + G_KNTP + (cc + c) * 144 + (q0 + 8 * hf) * 2) = q4;
                else *(LAS v2u*)(lds + G_VCT + (cc + c) * 144 + rg * 16 + hf * 8) = q4;
            }
        }
    }
}
DI void gdn_gates(Frame& F, LAS unsigned char* lds, LAS float* gv, int lane, int b, int h, int n) {
    const float* gp = (const float*)(F.ws + WS_GATES) + (size_t)(b * SEQ + n * 64 + lane) * 16;
    const float bfv = gp[h], bbv = gp[4 + h], afv = gp[8 + h], abv = gp[12 + h];
    const float betaf = sigmoidf_(bfv), betab = sigmoidf_(bbv);
    const float xf = afv + F.in[5][h], xb = abv + F.in[5][4 + h];
    const float spf = fmaxf(xf, 0.f) + log1pf(__expf(-fabsf(xf))), spb = fmaxf(xb, 0.f) + log1pf(__expf(-fabsf(xb)));
    const float gf = -__expf(F.in[4][h]) * spf, gb = -__expf(F.in[4][4 + h]) * spb;
    float Gf = gf, Rb = gb;
#pragma unroll
    for (int o = 1; o < 64; o <<= 1) { const float u1 = __shfl_up(Gf, o); if (lane >= o) Gf += u1; const float d1 = __shfl_down(Rb, o); if (lane + o < 64) Rb += d1; }
    gv[lane] = Gf; gv[64 + lane] = Rb; gv[128 + lane] = betaf; gv[192 + lane] = betab;
    const float GfL = __shfl(Gf, 63), Rb0 = __shfl(Rb, 0);
    LAS float* v0 = (LAS float*)(lds + G_D0 + GD_VEC); LAS float* v1 = (LAS float*)(lds + G_D1 + GD_VEC);
    v0[lane] = __expf(Gf); v0[64 + lane] = __expf(GfL - Gf); v1[lane] = __expf(Rb); v1[64 + lane] = __expf(Rb0 - Rb);
    if (lane == 0) { v0[128] = __expf(GfL); v1[128] = __expf(Rb0); }
}
DI void p2_gdn_pre(Frame& F) {
    const int tid = F.tid, lane = F.lane, wave = F.wave;
    int task = F.vcu;
    if (task < 1024) {
        LAS unsigned char* lds = opaque(F.lds);
        const int b = task >> 9, h = (task >> 7) & 3, n = task & 127;
        if (wave >= 2) gdn_conv(F, lds, tid - 128, b, h, n);
        if (wave == 2) gdn_gates(F, lds, (LAS float*)(lds + G_GV), lane, b, h, n);
    }
    __syncthreads();
    int par = 0;
#pragma unroll 1
    for (; task < 1024; task += F.G, par ^= 1) {
        LAS unsigned char* lds = opaque(F.lds);
        const int b = task >> 9, h = (task >> 7) & 3, n = task & 127, bh = b * 4 + h;
        LAS float* gv = (LAS float*)(lds + G_GV + par * 1024);
        LAS float* sGf = gv; LAS float* sRb = gv + 64; LAS float* sBf = gv + 128; LAS float* sBb = gv + 192;
        {
            const int p = wave >> 2, mt = wave & 3, n16 = lane & 15, g = lane >> 4;
            const LAS unsigned char* At = lds + (p == 0 ? G_KNP : G_QNP) + (16 * mt + n16) * 272 + g * 16;
            bf16x8 af[4], bfr[16];
#pragma unroll
            for (int ks = 0; ks < 4; ++ks) af[ks] = *(const LAS bf16x8*)(At + ks * 64);
#pragma unroll
            for (int nt = 0; nt < 4; ++nt)
#pragma unroll
                for (int ks = 0; ks < 4; ++ks) bfr[nt * 4 + ks] = *(const LAS bf16x8*)(lds + G_KNP + (16 * nt + n16) * 272 + g * 16 + ks * 64);
            float Gc[4], Rc[4], Bfc[4], Bbc[4];
#pragma unroll
            for (int r = 0; r < 4; ++r) { const int c = 16 * mt + 4 * g + r; Gc[r] = sGf[c]; Rc[r] = sRb[c]; Bfc[r] = sBf[c]; Bbc[r] = sBb[c]; }
#pragma unroll
            for (int nt = 0; nt < 4; ++nt) {
                f32x4 acc = (f32x4){0.f, 0.f, 0.f, 0.f};
#pragma unroll
                for (int ks = 0; ks < 4; ++ks) acc = __builtin_amdgcn_mfma_f32_16x16x32_bf16(af[ks], bfr[nt * 4 + ks], acc, 0, 0, 0);
                const int s_ = 16 * nt + n16; const float Gs = sGf[s_], Rs = sRb[s_]; const int ps = permcol(s_);
#pragma unroll
                for (int r = 0; r < 4; ++r) {
                    const int c = 16 * mt + 4 * g + r; const float v = acc[r];
                    const float df = __expf(fminf(Gc[r] - Gs, 0.f)), db = __expf(fminf(Rc[r] - Rs, 0.f));
                    if (p == 0) {
                        ((LAS float*)(lds + G_LM))[c * 64 + s_] = Bfc[r] * v * df;
                        ((LAS float*)(lds + G_LM + 16384))[(63 - c) * 64 + (63 - s_)] = Bbc[r] * v * db;
                    } else {
                        ((LAS bf16*)(lds + G_D0 + GD_AP))[c * 72 + ps] = (bf16)(pk2(s_ <= c ? v * df : 0.f, 0.f) & 0xffffu);
                        ((LAS bf16*)(lds + G_D1 + GD_AP))[c * 72 + ps] = (bf16)(pk2(s_ >= c ? v * db : 0.f, 0.f) & 0xffffu);
                    }
                }
            }
        }
        asm volatile("s_waitcnt lgkmcnt(0)\n\ts_barrier" ::: "memory");
        GAS v4u* gd0 = (GAS v4u*)(F.ws + WS_GD + (size_t)((bh * 2 + 0) * 128 + n) * GDN_D_BYTES);
        GAS v4u* gd1 = (GAS v4u*)(F.ws + WS_GD + (size_t)((bh * 2 + 1) * 128 + n) * GDN_D_BYTES);
        {
            GAS v4u* gsh = (GAS v4u*)(F.ws + WS_GSH + (size_t)(bh * 128 + n) * GDN_SH_BYTES);
#pragma unroll 3
            for (int i = tid; i < (int)(GDN_SH_BYTES / 16); i += NTHREADS) gsh[i] = *(const LAS v4u*)(lds + i * 16);
#pragma unroll 1
            for (int i = GD_AP / 16 + tid; i < (int)(GDN_D_BYTES / 16); i += NTHREADS) { gd0[i] = *(const LAS v4u*)(lds + G_D0 + i * 16); gd1[i] = *(const LAS v4u*)(lds + G_D1 + i * 16); }
        }
        asm volatile("s_waitcnt lgkmcnt(0)\n\ts_barrier" ::: "memory");
        if (wave == 0) { tri_inverse<false>((LAS float*)(lds + G_LM), sBf, (LAS bf16*)(lds + G_D0 + GD_TBP), lane);
#pragma unroll 3
            for (int i = lane; i < GD_AP / 16; i += 64) gd0[i] = *(const LAS v4u*)(lds + G_D0 + i * 16); }
        else if (wave == 1) { tri_inverse<true>((LAS float*)(lds + G_LM + 16384), sBb, (LAS bf16*)(lds + G_D1 + GD_TBP), lane);
#pragma unroll 3
            for (int i = lane; i < GD_AP / 16; i += 64) gd1[i] = *(const LAS v4u*)(lds + G_D1 + i * 16); }
        else {
            const int t2 = task + F.G;
            if (t2 < 1024) { const int b2 = t2 >> 9, h2 = (t2 >> 7) & 3, n2 = t2 & 127;
                gdn_conv(F, lds, tid - 128, b2, h2, n2);
                if (wave == 2) gdn_gates(F, lds, (LAS float*)(lds + G_GV + (par ^ 1) * 1024), lane, b2, h2, n2); }
        }
        asm volatile("s_waitcnt lgkmcnt(0)\n\ts_barrier" ::: "memory");
    }
}

DI bf16x8 pack8(const f32x4 a, const f32x4 b) {
    v4u p; p.x = pk2(a[0], a[1]); p.y = pk2(a[2], a[3]); p.z = pk2(b[0], b[1]); p.w = pk2(b[2], b[3]); return __builtin_bit_cast(bf16x8, p);
}
DI unsigned char* wgu_ptr(Frame& F, int e) { return F.ws + (e < WGU_SPLIT ? WS_WGU0 + (size_t)e * MiB : WS_WGU1 + (size_t)(e - WGU_SPLIT) * MiB); }
DI bf16* wd_ptr(Frame& F, int e) { return (bf16*)((unsigned char*)F.out + (e < WD_SPLIT ? DO_WD0 + (size_t)e * MiB : DO_WD1 + (size_t)(e - WD_SPLIT) * MiB)); }
constexpr int NG = 8, GSTEPS = 128 / NG;
#ifndef PASS1_QUOTA
#define PASS1_QUOTA 3
#endif
constexpr size_t WS_XB = 209 * MiB;
constexpr size_t WS_AOP = 217 * MiB;
constexpr size_t WS_SG = 221 * MiB;
constexpr int GS_SLOT = 54272, GS_Q = 17408, GS_VCT = 34816, GS_VEC = 53248, GS_TB = 18432, GS_AP = 27648;
static_assert(3 * GS_SLOT <= LDS_BYTES - 64, "scan ring");
static_assert(WS_SG + 8 * MiB <= 229 * MiB, "scan buffers");
DI void gs_dma(const unsigned char* src, unsigned lane16, unsigned lds_dst) {
    unsigned keep;
    asm volatile("s_mov_b32 %0, m0\n\ts_mov_b32 m0, %2\n\ts_nop 0\n\tglobal_load_lds_dwordx4 %1, %3\n\ts_mov_b32 m0, %0" : "=&s"(keep) : "v"(lane16), "s"(lds_dst), "s"(src) : "memory");
}
#define GS_WAITBAR(N) asm volatile("s_waitcnt vmcnt(%0) lgkmcnt(0)\n\ts_barrier" :: "n"(N) : "memory")
DI f32x4* gs_img(Frame& F, size_t base, int chain, int grp) { return (f32x4*)(F.ws + base) + (size_t)(chain * NG + grp) * (8 * 8 * 64); }
DI bf16* gs_aop(Frame& F, int chain, int grp) { return (bf16*)(F.ws + WS_AOP) + (size_t)(chain * NG + grp) * (8 * 4 * 64 * 8); }
DI void gs_start_state(Frame& F, int chain, int grp, f32x4 (&S)[8]);
template <int MODE> DI void gscan(Frame& F, const int chain, const int grp, f32x4* finalp, bf16* aop) {
    constexpr bool OUT = MODE == 0;
    constexpr int N1 = OUT ? 7 : (MODE == 1 ? 5 : 3), N2 = OUT ? 5 : 4, NST = OUT ? 16 : 0;
    const int lane = F.lane, n16 = lane & 15, g = lane >> 4, e = F.wave;
    const int bh = chain >> 1, dir = chain & 1, b = bh >> 2, h = bh & 3;
    const unsigned lds0 = (unsigned)(uintptr_t)opaque(F.lds), lane16 = (unsigned)lane * 16u;
    const unsigned char* shrec = F.ws + WS_GSH + (size_t)(bh * 128) * GDN_SH_BYTES; const unsigned char* drec = F.ws + WS_GD + (size_t)((bh * 2 + dir) * 128) * GDN_D_BYTES;
#define GS_ISSUE1(st_, slot_) do { const int sc_ = (st_) < 128 ? (st_) : 127; const int n_ = dir == 0 ? sc_ : 127 - sc_; const unsigned char* sh_ = shrec + (size_t)n_ * GDN_SH_BYTES; const unsigned char* dr_ = drec + (size_t)n_ * GDN_D_BYTES; \
        _Pragma("unroll") for (int j_ = 0; j_ < N1; ++j_) { const int q_ = e + 8 * j_; int p_; \
            if (MODE == 0) p_ = q_ < 53 ? q_ : 52; else if (MODE == 1) p_ = q_ < 17 ? q_ : (q_ < 35 ? q_ + 17 : 52); else p_ = q_ < 17 ? q_ : 52; \
            const unsigned char* src_ = p_ < 34 ? sh_ + p_ * 1024 : (p_ < 52 ? sh_ + G_VCT + (p_ - 34) * 1024 : dr_ + GD_VEC); \
            gs_dma(src_, lane16, (unsigned)__builtin_amdgcn_readfirstlane(lds0 + (unsigned)((slot_) * GS_SLOT + p_ * 1024))); } } while (0)
#define GS_ISSUE2(st_, slot_) do { const int sc_ = (st_) < 128 ? (st_) : 127; const int n_ = dir == 0 ? sc_ : 127 - sc_; const unsigned char* sh_ = shrec + (size_t)n_ * GDN_SH_BYTES; const unsigned char* dr_ = drec + (size_t)n_ * GDN_D_BYTES; \
        _Pragma("unroll") for (int j_ = 0; j_ < N2; ++j_) { const int q_ = e + 8 * j_; const int pm_ = OUT ? 35 : 26; const int p_ = q_ < pm_ ? q_ : pm_; \
            const unsigned char* src_ = p_ < 18 ? sh_ + G_KNTP + p_ * 1024 : dr_ + (p_ - 18) * 1024; \
            gs_dma(src_, lane16, (unsigned)__builtin_amdgcn_readfirstlane(lds0 + (unsigned)((slot_) * GS_SLOT + p_ * 1024))); } } while (0)
    const int st0 = grp * GSTEPS;
    bf16* Odir = (bf16*)((unsigned char*)F.out + (dir == 0 ? DO_OF : DO_OB));
    f32x4 S[8];
    if (MODE == 0 && grp > 0) gs_start_state(F, chain, grp, S);
    else {
#pragma unroll
        for (int i = 0; i < 8; ++i)
#pragma unroll
            for (int r = 0; r < 4; ++r) S[i][r] = (MODE == 2 && (16 * i + 4 * g + r) == (16 * e + n16)) ? 1.0f : 0.0f;
    }
    GS_ISSUE1(st0, 0); GS_ISSUE2(st0, 1);
    bf16x8 Sb[4];
#pragma unroll
    for (int i = 0; i < 4; ++i) Sb[i] = pack8(S[2 * i], S[2 * i + 1]);
    const unsigned aoff272 = n16 * 272 + g * 16, aoff144 = n16 * 144 + g * 16;
#define SB_() __builtin_amdgcn_sched_barrier(0)
#define LDR128(dst, base, off) asm volatile("ds_read_b128 %0, %1 offset:%2" : "=v"(dst) : "v"(base), "i"(off) : "memory")
#define LDR64(dst, base, off) asm volatile("ds_read_b64 %0, %1 offset:%2" : "=v"(dst) : "v"(base), "i"(off) : "memory")
#define LDR32(dst, base, off) asm volatile("ds_read_b32 %0, %1 offset:%2" : "=v"(dst) : "v"(base), "i"(off) : "memory")
    int sl1 = 0, sl2 = 1, sl3 = 2;
#pragma unroll 1
    for (int s = 0; s < GSTEPS; ++s) {
        const int st = st0 + s;
        if (OUT && s > 0) GS_WAITBAR(N2 + NST); else GS_WAITBAR(N2);
        GS_ISSUE1(s + 1 < GSTEPS ? st + 1 : st, sl3);
        const int n = dir == 0 ? st : 127 - st;
        const unsigned h1 = lds0 + (unsigned)sl1 * GS_SLOT, h2 = lds0 + (unsigned)sl2 * GS_SLOT;
        const unsigned bK = h1 + aoff272, bQ = h1 + GS_Q + aoff272, bKT = h2 + aoff144, bT = h2 + GS_TB + aoff144;
        const unsigned bV = h1 + GS_VCT + e * 2304 + n16 * 144 + g * 8, bvec = h1 + GS_VEC + g * 16, bd = h1 + GS_VEC;
        f32x4 eG[4], ks[4]; v2u vv[4]; float dch; bf16x8 fa[16];
        LDR128(eG[0], bvec, 0); LDR128(eG[1], bvec, 64); LDR128(eG[2], bvec, 128); LDR128(eG[3], bvec, 192);
        LDR128(ks[0], bvec, 256); LDR128(ks[1], bvec, 320); LDR128(ks[2], bvec, 384); LDR128(ks[3], bvec, 448);
        LDR32(dch, bd, 512);
        LDR64(vv[0], bV, 0); LDR64(vv[1], bV, 32); LDR64(vv[2], bV, 64); LDR64(vv[3], bV, 96);
#pragma unroll
        for (int m = 0; m < 4; ++m) { LDR128(fa[m * 4 + 0], bK, m * 4352 + 0); LDR128(fa[m * 4 + 1], bK, m * 4352 + 64); LDR128(fa[m * 4 + 2], bK, m * 4352 + 128); LDR128(fa[m * 4 + 3], bK, m * 4352 + 192); }
        bf16x8 fq[16];
        if (OUT) {
#pragma unroll
            for (int m = 0; m < 4; ++m) { LDR128(fq[m * 4 + 0], bQ, m * 4352 + 0); LDR128(fq[m * 4 + 1], bQ, m * 4352 + 64); LDR128(fq[m * 4 + 2], bQ, m * 4352 + 128); LDR128(fq[m * 4 + 3], bQ, m * 4352 + 192); }
            asm volatile("s_waitcnt lgkmcnt(15)" : "+v"(eG[0]), "+v"(eG[1]), "+v"(eG[2]), "+v"(eG[3]), "+v"(ks[0]), "+v"(ks[1]), "+v"(ks[2]), "+v"(ks[3]), "+v"(dch), "+v"(vv[0]), "+v"(vv[1]), "+v"(vv[2]), "+v"(vv[3]),
                         "+v"(fa[0]), "+v"(fa[1]), "+v"(fa[2]), "+v"(fa[3]), "+v"(fa[4]), "+v"(fa[5]), "+v"(fa[6]), "+v"(fa[7]), "+v"(fa[8]), "+v"(fa[9]), "+v"(fa[10]), "+v"(fa[11]), "+v"(fa[12]), "+v"(fa[13]), "+v"(fa[14]), "+v"(fa[15]) :: "memory");
        } else {
            asm volatile("s_waitcnt lgkmcnt(0)" : "+v"(eG[0]), "+v"(eG[1]), "+v"(eG[2]), "+v"(eG[3]), "+v"(ks[0]), "+v"(ks[1]), "+v"(ks[2]), "+v"(ks[3]), "+v"(dch), "+v"(vv[0]), "+v"(vv[1]), "+v"(vv[2]), "+v"(vv[3]),
                         "+v"(fa[0]), "+v"(fa[1]), "+v"(fa[2]), "+v"(fa[3]), "+v"(fa[4]), "+v"(fa[5]), "+v"(fa[6]), "+v"(fa[7]), "+v"(fa[8]), "+v"(fa[9]), "+v"(fa[10]), "+v"(fa[11]), "+v"(fa[12]), "+v"(fa[13]), "+v"(fa[14]), "+v"(fa[15]) :: "memory");
        }
        SB_();
        f32x4 KS[4];
#pragma unroll
        for (int m = 0; m < 4; ++m) KS[m] = (f32x4){0.f, 0.f, 0.f, 0.f};
#pragma unroll
        for (int i = 0; i < 4; ++i)
#pragma unroll
            for (int m = 0; m < 4; ++m) KS[m] = __builtin_amdgcn_mfma_f32_16x16x32_bf16(fa[m * 4 + i], Sb[i], KS[m], 0, 0, 0);
        SB_();
        if (OUT) {
            if (s > 0) asm volatile("s_waitcnt vmcnt(%16) lgkmcnt(0)\n\ts_barrier" : "+v"(fq[0]), "+v"(fq[1]), "+v"(fq[2]), "+v"(fq[3]), "+v"(fq[4]), "+v"(fq[5]), "+v"(fq[6]), "+v"(fq[7]), "+v"(fq[8]), "+v"(fq[9]), "+v"(fq[10]), "+v"(fq[11]), "+v"(fq[12]), "+v"(fq[13]), "+v"(fq[14]), "+v"(fq[15]) : "n"(N1 + NST) : "memory");
            else asm volatile("s_waitcnt vmcnt(%16) lgkmcnt(0)\n\ts_barrier" : "+v"(fq[0]), "+v"(fq[1]), "+v"(fq[2]), "+v"(fq[3]), "+v"(fq[4]), "+v"(fq[5]), "+v"(fq[6]), "+v"(fq[7]), "+v"(fq[8]), "+v"(fq[9]), "+v"(fq[10]), "+v"(fq[11]), "+v"(fq[12]), "+v"(fq[13]), "+v"(fq[14]), "+v"(fq[15]) : "n"(N1) : "memory");
        } else GS_WAITBAR(N1);
        GS_ISSUE2(s + 1 < GSTEPS ? st + 1 : st, sl1);
        bf16x8 ft[8];
#pragma unroll
        for (int m = 0; m < 4; ++m) { LDR128(ft[m * 2 + 0], bT, m * 2304 + 0); LDR128(ft[m * 2 + 1], bT, m * 2304 + 64); }
        SB_();
        f32x4 o[4];
        if (OUT) {
#pragma unroll
            for (int m = 0; m < 4; ++m) o[m] = (f32x4){0.f, 0.f, 0.f, 0.f};
#pragma unroll
            for (int i = 0; i < 4; ++i)
#pragma unroll
                for (int m = 0; m < 4; ++m) o[m] = __builtin_amdgcn_mfma_f32_16x16x32_bf16(fq[m * 4 + i], Sb[i], o[m], 0, 0, 0);
        }
        f32x4 rr[4];
#pragma unroll
        for (int m = 0; m < 4; ++m) {
            if (MODE == 2) { rr[m][0] = -eG[m][0] * KS[m][0]; rr[m][1] = -eG[m][1] * KS[m][1]; rr[m][2] = -eG[m][2] * KS[m][2]; rr[m][3] = -eG[m][3] * KS[m][3]; }
            else { rr[m][0] = bflo(vv[m].x) - eG[m][0] * KS[m][0]; rr[m][1] = bfhi(vv[m].x) - eG[m][1] * KS[m][1]; rr[m][2] = bflo(vv[m].y) - eG[m][2] * KS[m][2]; rr[m][3] = bfhi(vv[m].y) - eG[m][3] * KS[m][3]; } }
        bf16x8 rb[2]; rb[0] = pack8(rr[0], rr[1]); rb[1] = pack8(rr[2], rr[3]);
        SB_();
        bf16x8 fk[16];
#pragma unroll
        for (int jt = 0; jt < 8; ++jt) { LDR128(fk[jt * 2 + 0], bKT, jt * 2304 + 0); LDR128(fk[jt * 2 + 1], bKT, jt * 2304 + 64); }
        asm volatile("s_waitcnt lgkmcnt(15)" : "+v"(ft[0]), "+v"(ft[1]), "+v"(ft[2]), "+v"(ft[3]), "+v"(ft[4]), "+v"(ft[5]), "+v"(ft[6]), "+v"(ft[7]) :: "memory");
        SB_();
        f32x4 vn[4];
#pragma unroll
        for (int m = 0; m < 4; ++m) vn[m] = (f32x4){0.f, 0.f, 0.f, 0.f};
#pragma unroll
        for (int i = 0; i < 2; ++i)
#pragma unroll
            for (int m = 0; m < 4; ++m) vn[m] = __builtin_amdgcn_mfma_f32_16x16x32_bf16(ft[m * 2 + i], rb[i], vn[m], 0, 0, 0);
        if (OUT) {
#pragma unroll
            for (int m = 0; m < 4; ++m) o[m] = o[m] * eG[m];
        }
#pragma unroll
        for (int jt = 0; jt < 8; ++jt) S[jt] = S[jt] * dch;
        SB_();
        bf16x8 fp[8];
        if (OUT) {
#pragma unroll
            for (int m = 0; m < 4; ++m) { LDR128(fp[m * 2 + 0], bT, (GS_AP - GS_TB) + m * 2304 + 0); LDR128(fp[m * 2 + 1], bT, (GS_AP - GS_TB) + m * 2304 + 64); }
        }
        bf16x8 vnb[2]; vnb[0] = pack8(vn[0], vn[1]); vnb[1] = pack8(vn[2], vn[3]);
        bf16x8 vs[2]; vs[0] = pack8(vn[0] * ks[0], vn[1] * ks[1]); vs[1] = pack8(vn[2] * ks[2], vn[3] * ks[3]);
        if (OUT) asm volatile("s_waitcnt lgkmcnt(8)" : "+v"(fk[0]), "+v"(fk[1]), "+v"(fk[2]), "+v"(fk[3]), "+v"(fk[4]), "+v"(fk[5]), "+v"(fk[6]), "+v"(fk[7]), "+v"(fk[8]), "+v"(fk[9]), "+v"(fk[10]), "+v"(fk[11]), "+v"(fk[12]), "+v"(fk[13]), "+v"(fk[14]), "+v"(fk[15]) :: "memory");
        else asm volatile("s_waitcnt lgkmcnt(0)" : "+v"(fk[0]), "+v"(fk[1]), "+v"(fk[2]), "+v"(fk[3]), "+v"(fk[4]), "+v"(fk[5]), "+v"(fk[6]), "+v"(fk[7]), "+v"(fk[8]), "+v"(fk[9]), "+v"(fk[10]), "+v"(fk[11]), "+v"(fk[12]), "+v"(fk[13]), "+v"(fk[14]), "+v"(fk[15]) :: "memory");
        SB_();
#pragma unroll
        for (int i = 0; i < 2; ++i)
#pragma unroll
            for (int jt = 0; jt < 8; ++jt) S[jt] = __builtin_amdgcn_mfma_f32_16x16x32_bf16(fk[jt * 2 + i], vs[i], S[jt], 0, 0, 0);
        if (OUT) {
            asm volatile("s_waitcnt lgkmcnt(0)" : "+v"(fp[0]), "+v"(fp[1]), "+v"(fp[2]), "+v"(fp[3]), "+v"(fp[4]), "+v"(fp[5]), "+v"(fp[6]), "+v"(fp[7]) :: "memory");
#pragma unroll
            for (int i = 0; i < 2; ++i)
#pragma unroll
                for (int m = 0; m < 4; ++m) o[m] = __builtin_amdgcn_mfma_f32_16x16x32_bf16(fp[m * 2 + i], vnb[i], o[m], 0, 0, 0);
        }
#pragma unroll
        for (int i = 0; i < 4; ++i) Sb[i] = pack8(S[2 * i], S[2 * i + 1]);
        SB_();
        if (OUT) {
            bf16* op = Odir + (size_t)(b * SEQ + n * 64) * 512 + h * 128 + 16 * e + n16;
#pragma unroll
            for (int m = 0; m < 4; ++m)
#pragma unroll
                for (int r = 0; r < 4; ++r) op[(size_t)(16 * m + 4 * g + r) * 512] = (bf16)(pk2(o[m][r], 0.f) & 0xffffu);
        }
        { const int t_ = sl1; sl1 = sl3; sl3 = sl2; sl2 = t_; }
    }
#undef SB_
#undef LDR128
#undef LDR64
#undef LDR32
#undef GS_ISSUE1
#undef GS_ISSUE2
    if (finalp) {
#pragma unroll
        for (int i = 0; i < 8; ++i) finalp[(e * 8 + i) * 64 + lane] = S[i];
    }
    if (aop) {
#pragma unroll
        for (int jt = 0; jt < 8; ++jt)
#pragma unroll
            for (int r = 0; r < 4; ++r) aop[((jt * 4 + (e >> 1)) * 64 + 16 * (n16 >> 2) + 4 * g + r) * 8 + 4 * (e & 1) + (n16 & 3)] = (bf16)(pk2(S[jt][r], 0.f) & 0xffffu);
    }
    asm volatile("s_waitcnt vmcnt(0)" ::: "memory");
    __syncthreads();
}
DI void gs_start_state(Frame& F, int chain, int grp, f32x4 (&S)[8]) {
    const int lane = F.lane, e = F.wave;
    { const f32x4* b0 = gs_img(F, WS_XB, chain, 0);
#pragma unroll
      for (int i = 0; i < 8; ++i) S[i] = b0[(e * 8 + i) * 64 + lane]; }
#pragma unroll 1
    for (int gq = 1; gq < grp; ++gq) {
        const f32x4* bg = gs_img(F, WS_XB, chain, gq); const bf16x8* ag = (const bf16x8*)gs_aop(F, chain, gq);
        bf16x8 Sb[4];
#pragma unroll
        for (int i = 0; i < 4; ++i) Sb[i] = pack8(S[2 * i], S[2 * i + 1]);
#pragma unroll
        for (int jt = 0; jt < 8; ++jt) { f32x4 acc = bg[(e * 8 + jt) * 64 + lane];
#pragma unroll
            for (int i = 0; i < 4; ++i) acc = __builtin_amdgcn_mfma_f32_16x16x32_bf16(ag[(jt * 4 + i) * 64 + lane], Sb[i], acc, 0, 0, 0);
            S[jt] = acc; }
    }
}
constexpr int CV_QS = NEXP * 32, CV_WD = NEXP * 32, CV_WO = 64, CV_RT = 16, CV_ITEMS = CV_QS + CV_WD + CV_WO + CV_RT;
DI void conv_item(Frame& F, int it) {
    LAS float* scr = (LAS float*)(F.lds + F.wave * 16384);
    if (it < CV_QS) {
        const int e = it >> 5, mat = (it >> 4) & 1, nb = it & 15;
        q_strip((mat ? F.in[14] : F.in[13]) + (size_t)e * 1024 * 512, 512, 32 * nb, wgu_ptr(F, e), (float*)(F.ws + WS_WSC) + e * 1024, mat + 64 * nb, 2, F.lds, F.wave, F.lane);
    } else if (it < CV_QS + CV_WD) {
        const int w = (it - CV_QS) * 8 + F.wave, e = w >> 8, r = w & 255;
        p0_transpose_item(F.in[15] + (size_t)e * 512 * 1024, 1024, 32, wd_ptr(F, e), 512, 0, 1, scr, r, F.lane);
    } else if (it < CV_QS + CV_WD + CV_WO) {
        p0_transpose_item(F.in[9], 1024, 32, (bf16*)(F.ws + WS_WOUT), 1024, 0, 1, scr, (it - CV_QS - CV_WD) * 8 + F.wave, F.lane);
    } else {
        bf16* WRH = (bf16*)(F.ws + WS_WR); bf16* WRL = WRH + 48 * 1024; const float* wrg = F.in[11]; const float* wre = F.in[12];
        const int base = (it - CV_QS - CV_WD - CV_WO) * 3072;
#pragma unroll
        for (int q = 0; q < 6; ++q) { const int i = base + q * 512 + F.tid; const int j = i >> 10, k = i & 1023; float v = 0.f; if (j < 4) v = wrg[k * 4 + j]; else if (j < 36) v = wre[k * 32 + (j - 4)];
            const unsigned hh = f2bf(v); const float hv = __builtin_bit_cast(float, hh << 16); WRH[i] = (bf16)hh; WRL[i] = (bf16)f2bf(v - hv); }
    }
}
constexpr int CW_CONVQ = 12288;
static_assert(48 * PASS1_QUOTA <= CV_QS, "pass 1 may only take gate/up strips");
DI void conv_pull(Frame& F, int quota) {
    volatile LAS int* slot = (volatile LAS int*)(F.lds + MISC_OFF + 32);
    unsigned* q = (unsigned*)(F.ws + WS_CTL) + CW_CONVQ;
    __syncthreads();
    if (quota <= 0) return;
    if (F.tid == 0) *slot = (int)xb_add(q, 1u);
    __syncthreads();
    for (int n = 0; n < quota; ++n) {
        const int it = *slot; if (it >= CV_ITEMS) break;
        const bool more = n + 1 < quota; unsigned nx = 0u;
        if (F.tid == 0 && more) nx = xb_add(q, 1u);
        conv_item(F, it);
        __syncthreads();
        if (F.tid == 0) *slot = more ? (int)nx : CV_ITEMS;
        __syncthreads();
    }
    __syncthreads();
}
DI void p4_pass1(Frame& F) {
    const int T = F.vcu, part = T & 1, cg = T >> 1, chain = cg / (NG - 1), grp = cg % (NG - 1);
    if (T < 16 * (NG - 1) * 2 && part == 0) gscan<1>(F, chain, grp, gs_img(F, WS_XB, chain, grp), nullptr);
    else if (T < 16 * (NG - 1) * 2 && grp > 0) gscan<2>(F, chain, grp, nullptr, gs_aop(F, chain, grp));
    else conv_pull(F, PASS1_QUOTA);
}
DI void p4_pass3(Frame& F) {
    if ((F.vcu & 1) == 0 && (F.vcu >> 1) < 16 * NG) { const int T = F.vcu >> 1; gscan<0>(F, T / NG, T % NG, nullptr, nullptr); }
    conv_pull(F, 1 << 30);
}

DI void p5_combine(Frame& F) {
    const int gw = F.vcu * NWAVES + F.wave, NGW = F.G * NWAVES, lane = F.lane;
    const bf16* OFp = (const bf16*)((unsigned char*)F.out + DO_OF); const bf16* OBp = (const bf16*)((unsigned char*)F.out + DO_OB);
    const bf16* ZA = (const bf16*)(F.ws + WS_ZA); bf16* OCAT = (bf16*)(F.ws + WS_OCAT);
    const float* nw = F.in[6] + (lane & 15) * 8;
    float w8[8];
#pragma unroll
    for (int c = 0; c < 8; ++c) w8[c] = nw[c];
    constexpr int NB4 = 4;
    for (int t0 = gw; t0 < TT; t0 += NB4 * NGW) {
        v4u a[NB4], bb[NB4], z[NB4];
#pragma unroll
        for (int u = 0; u < NB4; ++u) { const int t = (t0 + u * NGW < TT) ? t0 + u * NGW : t0;
            a[u] = *(const v4u*)(OFp + (size_t)t * 512 + lane * 8); bb[u] = *(const v4u*)(OBp + (size_t)t * 512 + lane * 8); z[u] = *(const v4u*)(ZA + (size_t)t * 512 + lane * 8); }
#pragma unroll
        for (int u = 0; u < NB4; ++u) {
            const int t = t0 + u * NGW; if (t >= TT) break;
            float o[8] = {bflo(a[u].x) + bflo(bb[u].x), bfhi(a[u].x) + bfhi(bb[u].x), bflo(a[u].y) + bflo(bb[u].y), bfhi(a[u].y) + bfhi(bb[u].y), bflo(a[u].z) + bflo(bb[u].z), bfhi(a[u].z) + bfhi(bb[u].z), bflo(a[u].w) + bflo(bb[u].w), bfhi(a[u].w) + bfhi(bb[u].w)};
            const float zz[8] = {bflo(z[u].x), bfhi(z[u].x), bflo(z[u].y), bfhi(z[u].y), bflo(z[u].z), bfhi(z[u].z), bflo(z[u].w), bfhi(z[u].w)};
            float ss = 0.f;
#pragma unroll
            for (int c = 0; c < 8; ++c) ss += o[c] * o[c];
            ss = sum16(ss);
            const float rn = __builtin_amdgcn_rsqf(ss * (1.f / 128.f) + EPS);
#pragma unroll
            for (int c = 0; c < 8; ++c) o[c] = o[c] * rn * w8[c] * siluf(zz[c]);
            v4u r; r.x = pk2(o[0], o[1]); r.y = pk2(o[2], o[3]); r.z = pk2(o[4], o[5]); r.w = pk2(o[6], o[7]);
            *(v4u*)(OCAT + (size_t)t * 1024 + lane * 8) = r;
        }
    }
}

struct TokRec { int e[2]; int row[2]; float gate[2]; };
DI void p7_route(Frame& F) {
    const int lane = F.lane, n16 = lane & 15, g = lane >> 4, wave = F.wave;
    const bf16* X1 = (const bf16*)(F.ws + WS_X1); const float* nfw = F.in[10];
    const bf16* WRH = (const bf16*)(F.ws + WS_WR); const bf16* WRL = WRH + 48 * 1024;
    unsigned char* HN = (unsigned char*)F.out + DO_HN; TokRec* TOK = (TokRec*)(F.ws + WS_TOK); unsigned* gcnt = (unsigned*)(F.ws + WS_CTL) + CW_CNT; int* LIST = (int*)(F.ws + WS_LIST);
    LAS float* lg = (LAS float*)(F.lds + (wave & 3) * 4096);
    LAS unsigned* hist = (LAS unsigned*)(F.lds + 16384); LAS unsigned* base = hist + 32;
    const int sub = blockIdx.x & 7;
    const float qsc = 127.0f / act_absmax(nfw, lane);
    for (int rt0 = blockIdx.x * 4; rt0 < TT / 16; rt0 += F.G * 4) {
        if (F.tid < 32) hist[F.tid] = 0u;
        __syncthreads();
        int ex1 = 0, ex2 = 0, tok = -1; unsigned l1 = 0, l2 = 0; float g1 = 0.f, g2 = 0.f;
        const int rt = rt0 + (wave & 3), par = wave >> 2;
        const bool valid = rt < TT / 16, act = wave < 4 && valid;
        const int row = (valid ? rt : rt0) * 16 + n16; const bf16* xr = X1 + (size_t)row * DMODEL + 8 * g;
        constexpr int P7_WOFF = 32768, P7_WCH = 26624, P7_XO = P7_WOFF + 2 * P7_WCH;
        static_assert(P7_XO + 512 + 4 * 64 * 48 <= LDS_BYTES - 64, "p7 lds");
        unsigned wsrc[4];
#pragma unroll
        for (int j = 0; j < 4; ++j) { const int pp = (wave + 8 * j) < 25 ? (wave + 8 * j) : 25; int G = pp * 64 + lane; G = G > 1631 ? 1631 : G;
            const int mat = G / 816, rem = G - mat * 816, r = rem / 17, c = rem - 17 * r;
            wsrc[j] = (unsigned)(mat * 98304 + r * 2048 + (c < 16 ? c : 15) * 16); }
        const unsigned ldsw0 = (unsigned)(uintptr_t)F.lds + P7_WOFF;
#define P7_DMA(ch_, buf_) do { _Pragma("unroll") for (int j = 0; j < 4; ++j) gs_dma((const unsigned char*)WRH + (ch_) * 256, wsrc[j], (unsigned)__builtin_amdgcn_readfirstlane(ldsw0 + (unsigned)((buf_) * P7_WCH + ((wave + 8 * j) < 25 ? (wave + 8 * j) : 25) * 1024))); } while (0)
        P7_DMA(0, 0);
        v4u xw[16];
#pragma unroll
        for (int j = 0; j < 4; ++j)
#pragma unroll
            for (int ii = 0; ii < 4; ++ii) xw[j * 4 + ii] = *(const v4u*)(xr + 128 * (2 * j + par) + 32 * ii);
        float ss = 0.f;
#pragma unroll
        for (int q = 0; q < 16; ++q) { const v4u w_ = xw[q]; const f32x4 a = {bflo(w_.x), bfhi(w_.x), bflo(w_.y), bfhi(w_.y)}, b2 = {bflo(w_.z), bfhi(w_.z), bflo(w_.w), bfhi(w_.w)};
            ss += (a.x * a.x + a.y * a.y) + (a.z * a.z + a.w * a.w) + (b2.x * b2.x + b2.y * b2.y) + (b2.z * b2.z + b2.w * b2.w); }
        ss = sum_x32(sum_x16(ss));
        LAS float* pxs = (LAS float*)(F.lds + P7_XO);
        if (g == 0) pxs[wave * 16 + n16] = ss;
        __syncthreads();
        ss += pxs[(wave ^ 4) * 16 + n16];
        const float rs = __builtin_amdgcn_rsqf(ss * (1.f / DMODEL) + EPS);
        f32x4 acc[3];
#pragma unroll
        for (int q = 0; q < 3; ++q) acc[q] = (f32x4){0.f, 0.f, 0.f, 0.f};
#define P7_COMP(ch_, buf_) do { const LAS unsigned char* wb_ = F.lds + P7_WOFF + (buf_) * P7_WCH + n16 * 272 + g * 16; \
            _Pragma("unroll") for (int ii = 0; ii < 4; ++ii) { const int i_ = 4 * (ch_) + ii; \
                const v4u xv_ = xw[ii]; const f32x4 a = {bflo(xv_.x), bfhi(xv_.x), bflo(xv_.y), bfhi(xv_.y)}, b2 = {bflo(xv_.z), bfhi(xv_.z), bflo(xv_.w), bfhi(xv_.w)}; \
                const f32x4 wa = *(const f32x4*)(nfw + 32 * i_ + 8 * g), wb = *(const f32x4*)(nfw + 32 * i_ + 8 * g + 4); \
                float hv[8] = {a.x * rs * wa.x, a.y * rs * wa.y, a.z * rs * wa.z, a.w * rs * wa.w, b2.x * rs * wb.x, b2.y * rs * wb.y, b2.z * rs * wb.z, b2.w * rs * wb.w}; \
                v4u hi, lo; \
                hi.x = pk2(hv[0], hv[1]); hi.y = pk2(hv[2], hv[3]); hi.z = pk2(hv[4], hv[5]); hi.w = pk2(hv[6], hv[7]);            \
                lo.x = pk2(hv[0] - bflo(hi.x), hv[1] - bfhi(hi.x)); lo.y = pk2(hv[2] - bflo(hi.y), hv[3] - bfhi(hi.y));             \
                lo.z = pk2(hv[4] - bflo(hi.z), hv[5] - bfhi(hi.z)); lo.w = pk2(hv[6] - bflo(hi.w), hv[7] - bfhi(hi.w)); \
                if (valid) { v2u q; q.x = q8x4(hv[0], hv[1], hv[2], hv[3], qsc); q.y = q8x4(hv[4], hv[5], hv[6], hv[7], qsc); *(v2u*)(HN + (size_t)row * DMODEL + 32 * i_ + 8 * g) = q; } \
                const bf16x8 ah = __builtin_bit_cast(bf16x8, hi), al = __builtin_bit_cast(bf16x8, lo); \
                _Pragma("unroll") for (int q = 0; q < 3; ++q) { \
                    const bf16x8 bh = *(const LAS bf16x8*)(wb_ + q * 4352 + ii * 64), bl = *(const LAS bf16x8*)(wb_ + 13056 + q * 4352 + ii * 64); \
                    acc[q] = __builtin_amdgcn_mfma_f32_16x16x32_bf16(ah, bh, acc[q], 0, 0, 0); \
                    acc[q] = __builtin_amdgcn_mfma_f32_16x16x32_bf16(ah, bl, acc[q], 0, 0, 0); \
                    acc[q] = __builtin_amdgcn_mfma_f32_16x16x32_bf16(al, bh, acc[q], 0, 0, 0); } } } while (0)
#define P7_BODY(ch_, par_) do { asm volatile("s_waitcnt vmcnt(0)" ::: "memory"); __builtin_amdgcn_s_barrier(); asm volatile("" ::: "memory"); \
            if ((ch_) + 1 < 8) P7_DMA((ch_) + 1, (par_) ^ 1); \
            if (par == (par_)) P7_COMP(ch_, par_); \
            asm volatile("" ::: "memory"); } while (0)
#pragma unroll 1
        for (int cpair = 0; cpair < 4; ++cpair) { const int che_ = 2 * cpair, cho_ = 2 * cpair + 1;
            P7_BODY(che_, 0); P7_BODY(cho_, 1);
#pragma unroll
            for (int q = 0; q < 12; ++q) xw[q] = xw[q + 4]; }
#undef P7_COMP
#undef P7_BODY
#undef P7_DMA
        { LAS f32x4* pac = (LAS f32x4*)(F.lds + P7_XO + 512);
          if (par == 1) {
#pragma unroll
              for (int q = 0; q < 3; ++q) pac[((wave & 3) * 64 + lane) * 3 + q] = acc[q]; }
          __syncthreads();
          if (par == 0) {
#pragma unroll
              for (int q = 0; q < 3; ++q) acc[q] += pac[((wave & 3) * 64 + lane) * 3 + q]; } }
        if (act) {
#pragma unroll
            for (int q = 0; q < 3; ++q)
#pragma unroll
                for (int r = 0; r < 4; ++r) lg[(4 * g + r) * 48 + 16 * q + n16] = acc[q][r];
            asm volatile("s_waitcnt lgkmcnt(0)" ::: "memory");
            if (lane < 16) {
                const LAS float* L = lg + lane * 48; tok = rt * 16 + lane;
                float gm = L[0]; int gs = 0;
#pragma unroll
                for (int q = 1; q < 4; ++q) if (L[q] > gm) { gm = L[q]; gs = q; }
                float gsum = 0.f;
#pragma unroll
                for (int q = 0; q < 4; ++q) gsum += __expf(L[q] - gm);
                const float gp_top = 1.0f / gsum;
                float fv[8];
#pragma unroll
                for (int q = 0; q < 8; ++q) { float v = L[4 + q]; v = (gs == 1) ? L[12 + q] : v; v = (gs == 2) ? L[20 + q] : v; v = (gs == 3) ? L[28 + q] : v; fv[q] = v; }
                float m1 = fv[0]; int i1 = 0;
#pragma unroll
                for (int q = 1; q < 8; ++q) if (fv[q] > m1) { m1 = fv[q]; i1 = q; }
                float m2 = -3.0e38f; int i2 = 0;
#pragma unroll
                for (int q = 0; q < 8; ++q) if (q != i1 && fv[q] > m2) { m2 = fv[q]; i2 = q; }
                const float e2 = __expf(m2 - m1); g1 = gp_top / (1.0f + e2); g2 = gp_top * e2 / (1.0f + e2);
                ex1 = gs * 8 + i1; ex2 = gs * 8 + i2;
                l1 = __hip_atomic_fetch_add(hist + ex1, 1u, __ATOMIC_RELAXED, __HIP_MEMORY_SCOPE_WORKGROUP); l2 = __hip_atomic_fetch_add(hist + ex2, 1u, __ATOMIC_RELAXED, __HIP_MEMORY_SCOPE_WORKGROUP);
            }
        }
        __syncthreads();
        if (F.tid < 32) { const unsigned hcount = hist[F.tid]; base[F.tid] = hcount ? atomicAdd(gcnt + F.tid * 8 + sub, hcount) : 0u; }
        __syncthreads();
        if (tok >= 0) {
            const int s1 = (int)(base[ex1] + l1), s2 = (int)(base[ex2] + l2);
            LIST[(size_t)(ex1 * 8 + sub) * TT + s1] = tok; LIST[(size_t)(ex2 * 8 + sub) * TT + s2] = tok;
            TokRec tr; tr.e[0] = ex1; tr.e[1] = ex2; tr.row[0] = (sub << 24) | s1; tr.row[1] = (sub << 24) | s2; tr.gate[0] = g1; tr.gate[1] = g2;
            TOK[tok] = tr;
        }
    }
}

DI void build_etab(Frame& F) {
    LAS unsigned* etab = (LAS unsigned*)(F.lds + ETAB_OFF);
    if (F.tid < 32) {
        const unsigned* gcnt = (const unsigned*)(F.ws + WS_CTL) + CW_CNT + F.tid * 8; unsigned acc = 0;
#pragma unroll
        for (int q = 0; q < 8; ++q) { const unsigned c = __hip_atomic_load(gcnt + q, __ATOMIC_RELAXED, __HIP_MEMORY_SCOPE_AGENT); etab[96 + 8 * F.tid + q] = acc; acc += c; }
        etab[64 + F.tid] = acc; etab[2 * F.tid + 1] = (acc + 255u) >> 8;
    }
    __syncthreads();
    if (F.tid == 0) { unsigned acc = 0; for (int e = 0; e < NEXP; ++e) { etab[2 * e] = acc; acc += etab[2 * e + 1]; } }
    if (F.wave == 1) { const float am = act_absmax(F.in[10], F.lane); if (F.lane == 0) ((LAS float*)etab)[352] = am * (1.0f / 127.0f); }
    __syncthreads();
}

DI void p11_final(Frame& F) {
    build_etab(F);
    const LAS unsigned* etab = (const LAS unsigned*)(F.lds + ETAB_OFF);
    const int gw = F.vcu * NWAVES + F.wave, NGW = F.G * NWAVES, lane = F.lane;
    const bf16* Y = (const bf16*)(F.ws + WS_XBUF); const TokRec* TOK = (const TokRec*)(F.ws + WS_TOK); const float* fw = F.in[16];
    const f32x4 w0 = *(const f32x4*)(fw + lane * 8), w1 = *(const f32x4*)(fw + lane * 8 + 4), w2 = *(const f32x4*)(fw + 512 + lane * 8), w3 = *(const f32x4*)(fw + 516 + lane * 8);
    constexpr int NB2 = 2;
    for (int t0 = gw; t0 < TT; t0 += NB2 * NGW) {
        TokRec tr[NB2]; v4u xa[NB2][2]; v4u ya[NB2][2][2];
#pragma unroll
        for (int u = 0; u < NB2; ++u) { const int t = (t0 + u * NGW < TT) ? t0 + u * NGW : t0; tr[u] = TOK[t];
            const bf16* xr = (const bf16*)(F.ws + WS_X1) + (size_t)t * DMODEL + lane * 8;
            xa[u][0] = *(const v4u*)(xr); xa[u][1] = *(const v4u*)(xr + 512); }
#pragma unroll
        for (int u = 0; u < NB2; ++u)
#pragma unroll
            for (int k = 0; k < 2; ++k) { const unsigned rk = (unsigned)tr[u].row[k]; const bf16* yr = Y + (size_t)(etab[2 * tr[u].e[k]] * 256u + etab[96 + 8 * tr[u].e[k] + (rk >> 24)] + (rk & 0xffffffu)) * DMODEL + lane * 8; ya[u][k][0] = *(const v4u*)(yr); ya[u][k][1] = *(const v4u*)(yr + 512); }
#pragma unroll
        for (int u = 0; u < NB2; ++u) {
            const int t = t0 + u * NGW; if (t >= TT) break;
            float v[16] = {bflo(xa[u][0].x), bfhi(xa[u][0].x), bflo(xa[u][0].y), bfhi(xa[u][0].y), bflo(xa[u][0].z), bfhi(xa[u][0].z), bflo(xa[u][0].w), bfhi(xa[u][0].w),
                           bflo(xa[u][1].x), bfhi(xa[u][1].x), bflo(xa[u][1].y), bfhi(xa[u][1].y), bflo(xa[u][1].z), bfhi(xa[u][1].z), bflo(xa[u][1].w), bfhi(xa[u][1].w)};
#pragma unroll
            for (int k = 0; k < 2; ++k) {
                const float gk = tr[u].gate[k]; const v4u y0 = ya[u][k][0], y1 = ya[u][k][1];
                v[0] += gk * bflo(y0.x); v[1] += gk * bfhi(y0.x); v[2] += gk * bflo(y0.y); v[3] += gk * bfhi(y0.y); v[4] += gk * bflo(y0.z); v[5] += gk * bfhi(y0.z); v[6] += gk * bflo(y0.w); v[7] += gk * bfhi(y0.w);
                v[8] += gk * bflo(y1.x); v[9] += gk * bfhi(y1.x); v[10] += gk * bflo(y1.y); v[11] += gk * bfhi(y1.y); v[12] += gk * bflo(y1.z); v[13] += gk * bfhi(y1.z); v[14] += gk * bflo(y1.w); v[15] += gk * bfhi(y1.w);
            }
            float ss = 0.f;
#pragma unroll
            for (int i = 0; i < 16; ++i) ss += v[i] * v[i];
            const float rs = __builtin_amdgcn_rsqf(wave_sum(ss) * (1.f / DMODEL) + EPS);
            float* orow = F.out + (size_t)t * DMODEL + lane * 8;
            __builtin_nontemporal_store((f32x4){v[0] * rs * w0.x, v[1] * rs * w0.y, v[2] * rs * w0.z, v[3] * rs * w0.w}, (f32x4*)(orow));
            __builtin_nontemporal_store((f32x4){v[4] * rs * w1.x, v[5] * rs * w1.y, v[6] * rs * w1.z, v[7] * rs * w1.w}, (f32x4*)(orow + 4));
            __builtin_nontemporal_store((f32x4){v[8] * rs * w2.x, v[9] * rs * w2.y, v[10] * rs * w2.z, v[11] * rs * w2.w}, (f32x4*)(orow + 512));
            __builtin_nontemporal_store((f32x4){v[12] * rs * w3.x, v[13] * rs * w3.y, v[14] * rs * w3.z, v[15] * rs * w3.w}, (f32x4*)(orow + 516));
        }
    }
}

struct Args { const float* in[17]; float* out; unsigned char* ws; int ph_lo, ph_hi; };
__global__ void __launch_bounds__(NTHREADS, 2) fwd_kernel(Args args) {
    extern __shared__ __attribute__((aligned(16))) unsigned char lds[];
    cg::grid_group grid = cg::this_grid();
    Frame F;
    F.lds = (LAS unsigned char*)lds; F.tid = threadIdx.x; F.lane = F.tid & 63; F.wave = __builtin_amdgcn_readfirstlane(F.tid >> 6);
    F.G = gridDim.x; { const int bx = blockIdx.x; F.vcu = (F.G % 8 == 0) ? (bx % 8) * (F.G / 8) + bx / 8 : bx; }
#pragma unroll
    for (int i = 0; i < 17; ++i) F.in[i] = args.in[i];
    F.out = args.out; F.ws = args.ws;
    const int lo = args.ph_lo, hi = args.ph_hi;
    if (F.tid < 16) ((volatile LAS unsigned*)(F.lds + MISC_OFF))[F.tid] = 0u;
    __syncthreads();
    XcdBarrier bar = xcd_barrier_post((unsigned*)(F.ws + WS_CTL) + CW_BAR, (volatile LAS unsigned*)(F.lds + MISC_OFF));
    if (lo > 1000) grid.sync();
#ifndef PHSEL
#define PHSEL 0xfff
#endif
#define IN(k) (((PHSEL >> (k)) & 1) && lo <= (k) && (k) < hi)
#define SEAM(k) do { if (IN(k) && IN((k) + 1)) xcd_barrier(bar); } while (0)
#ifndef REP_PH
#define REP_PH -1
#endif
#define REPS(k) for (int rep_ = 0; rep_ < ((k) == REP_PH ? 2 : 1); ++rep_, ((k) == REP_PH && rep_ < 2) ? xcd_barrier(bar) : (void)0)
    if (F.tid == 0) __hip_atomic_store((unsigned*)(F.ws + WS_CTL) + CW_XCC + blockIdx.x, (xb_xcc_id() & 15u) + 1u, __ATOMIC_RELAXED, __HIP_MEMORY_SCOPE_AGENT);
    if (IN(0)) REPS(0) { p0_prologue(F); } SEAM(0);
    if (F.tid < 32 && (F.G % 8 == 0) && IN(0) && IN(1)) {
        const int j = (int)(blockIdx.x & 7) + 8 * F.tid;
        if (j < F.G) { const unsigned other = __hip_atomic_load((unsigned*)(F.ws + WS_CTL) + CW_XCC + j, __ATOMIC_RELAXED, __HIP_MEMORY_SCOPE_AGENT);
            if (other != (xb_xcc_id() & 15u) + 1u) __hip_atomic_fetch_or((unsigned*)(F.ws + WS_CTL) + CW_XBAD, 1u, __ATOMIC_RELAXED, __HIP_MEMORY_SCOPE_AGENT); } }
    if (IN(1)) REPS(1) {
        pg8::Gemm gm{(const pg8::bf16_t*)(F.ws + WS_XN), (const pg8::bf16_t*)(F.ws + WS_WIN), TT, NPROJ, DMODEL / 2};
        pg8::StaticOrder S; S.init(TT, NPROJ, F.G, (int)blockIdx.x);
        EpiProj E{(bf16*)(F.ws + WS_QKVA), (bf16*)(F.ws + WS_ZA), (bf16*)(F.ws + WS_QKVB), (const float*)(F.ws + WS_WSI), (const float*)(F.ws + WS_XSC)};
        pg8::gemm_phase_gather<EpiProj, pg8::StaticOrder, IdRows, true, true>(F.lds, gm, S, E, IdRows{});
    } SEAM(1);
    if (IN(2)) REPS(2) {
#ifndef NO_ROPE
        p2_rope(F);
#ifdef PROBE_ROPE2
        xcd_barrier(bar); p2_rope(F);
#endif
#endif
#ifndef NO_PRE
        p2_gdn_pre(F);
#ifdef PROBE_PRE2
        xcd_barrier(bar); p2_gdn_pre(F);
#endif
#endif
    } SEAM(2);
    if (IN(3)) REPS(3) {
        const attn_body::AttnTensors AT{(const attn_body::bf16*)((unsigned char*)F.out + DO_QR), (const attn_body::bf16*)((unsigned char*)F.out + DO_KR), (const attn_body::bf16*)((unsigned char*)F.out + DO_VR),
                                        (attn_body::bf16*)(F.ws + WS_OCAT) + 512};
        const attn_body::StaticOrder S((int)F.G, (int)blockIdx.x);
#ifdef PROBE_ZERO_ATTN
        { (void)AT; (void)S; bf16* OC = (bf16*)(F.ws + WS_OCAT); const int gt = blockIdx.x * NTHREADS + F.tid, GT = F.G * NTHREADS;
          for (int i = gt; i < TT * 64; i += GT) { const int t = i >> 6, c = i & 63; *(v4u*)(OC + (size_t)t * 1024 + 512 + c * 8) = (v4u){0u, 0u, 0u, 0u}; } }
#else
        const float nshift = -(0.125f * 1.4426950408889634f * 64.f * 1.01f) * wave_max(fabsf(F.in[7][F.lane])) * wave_max(fabsf(F.in[8][F.lane]));
        attn_body::attn_phase<attn_body::StaticOrder>((char*)lds, AT, S, nshift);
#endif
    }
#if MK_PER_PHASE
    SEAM(3);
#endif
    if (IN(4)) { p4_pass1(F); xcd_barrier(bar); p4_pass3(F); } SEAM(4);
    if (IN(5)) REPS(5) { p5_combine(F); } SEAM(5);
    if (IN(6)) REPS(6) {
        pg8::Gemm gm{(const pg8::bf16_t*)(F.ws + WS_OCAT), (const pg8::bf16_t*)(F.ws + WS_WOUT), TT, DMODEL, DMODEL}; pg8::StaticOrder S; S.init(TT, DMODEL, F.G, (int)blockIdx.x);
        EpiResid E{F.in[0], (bf16*)(F.ws + WS_X1)};
        pg8::gemm_phase<EpiResid, pg8::StaticOrder, true, true>(F.lds, gm, S, E);
    } SEAM(6);
    if (IN(7)) { p7_route(F); } SEAM(7);
    const bool handoff = !MK_PER_PHASE && (F.G % 8 == 0) && IN(0) && IN(1) && IN(9) && IN(10) &&
        __builtin_amdgcn_readfirstlane(__hip_atomic_load((unsigned*)(F.ws + WS_CTL) + CW_XBAD, __ATOMIC_RELAXED, __HIP_MEMORY_SCOPE_AGENT)) == 0u;
    if (IN(9)) REPS(9) {
        build_etab(F);
        pg8::Gemm gm{(const pg8::bf16_t*)((unsigned char*)F.out + DO_HN), (const pg8::bf16_t*)(F.ws + WS_WGU0), 0, 0, DMODEL / 2};
        MoeOrder S{(const LAS unsigned*)(F.lds + ETAB_OFF), F.G, (int)blockIdx.x, WGU_SPLIT, (int)((WS_WGU1 - WS_WGU0) / (256 * 1024)), (mo_gu32*)((unsigned*)(F.ws + WS_CTL) + CW_HIDC), handoff ? 1 : 0, 0, -1};
        MoeRows AM{(const int*)(F.ws + WS_LIST), (const LAS unsigned*)(F.lds + ETAB_OFF)};
        EpiGU E{(bf16*)(F.ws + WS_HID), (const float*)(F.ws + WS_WSC), ((const LAS float*)(F.lds + ETAB_OFF))[352]};
        pg8::gemm_phase_gather<EpiGU, MoeOrder, MoeRows, true, true>(F.lds, gm, S, E, AM);
        S.flush();
    }
    if (!handoff) SEAM(9);
    if (IN(10)) REPS(10) {
        pg8::Gemm gm{(const pg8::bf16_t*)(F.ws + WS_HID), (const pg8::bf16_t*)((unsigned char*)F.out + DO_WD0), 0, 0, FFE}; build_etab(F);
        MoeOrder S{(const LAS unsigned*)(F.lds + ETAB_OFF), F.G, (int)blockIdx.x, WD_SPLIT, (int)((DO_WD1 - DO_WD0) / (256 * 1024)), (mo_gu32*)((unsigned*)(F.ws + WS_CTL) + CW_HIDC), handoff ? 2 : 0, 0, -1};
        if (handoff) S.rot = S.xcd_units() % (F.G >> 3);
        EpiY E{(bf16*)(F.ws + WS_XBUF)};
        pg8::gemm_phase<EpiY, MoeOrder, true, true>(F.lds, gm, S, E);
    } SEAM(10);
#ifdef EXTRA_SYNCS
    for (int q_ = 0; q_ < EXTRA_SYNCS; ++q_) xcd_barrier(bar);
#endif
    if (IN(11)) { p11_final(F); }
#undef IN
#undef SEAM
}

extern "C" void kernel_launch(void* const* d_in, const int* in_sizes, int n_in, void* d_out, int out_size, void* d_ws, size_t ws_size, hipStream_t stream) {
    static int grid = 0;
    if (grid == 0) {
        if (n_in != 17 || out_size != TT * DMODEL || ws_size < WS_END) { fprintf(stderr, "kernel_launch: unexpected problem (n_in %d out %d ws %zu)\n", n_in, out_size, ws_size); grid = -1; return; }
        int dev = 0, cus = 0, per_cu = 0;
        if (hipGetDevice(&dev) != hipSuccess || hipDeviceGetAttribute(&cus, hipDeviceAttributeMultiprocessorCount, dev) != hipSuccess) { grid = -1; return; }
        if (hipFuncSetAttribute((const void*)fwd_kernel, hipFuncAttributeMaxDynamicSharedMemorySize, LDS_BYTES) != hipSuccess) { fprintf(stderr, "hipFuncSetAttribute failed\n"); grid = -1; return; }
        if (hipOccupancyMaxActiveBlocksPerMultiprocessor(&per_cu, (const void*)fwd_kernel, NTHREADS, LDS_BYTES) != hipSuccess || per_cu < 1) { fprintf(stderr, "occupancy query: %d\n", per_cu); grid = -1; return; }
        if (cus < 256) { fprintf(stderr, "kernel_launch: %d CUs; the scan phase's task map needs 256 workgroups\n", cus); grid = -1; return; }
        grid = cus;
    }
    if (grid < 0) return;
    (void)hipMemsetAsync((char*)d_ws + WS_CTL, 0, CTL_ZERO_BYTES, stream);
    Args a{};
    for (int i = 0; i < 17; ++i) a.in[i] = (const float*)d_in[i];
    a.out = (float*)d_out; a.ws = (unsigned char*)d_ws;
#if MK_PER_PHASE
    for (int p = 0; p < N_PHASES; ++p) { a.ph_lo = p; a.ph_hi = p + 1; hipLaunchKernelGGL(fwd_kernel, dim3(grid), dim3(NTHREADS), LDS_BYTES, stream, a); }
#else
    a.ph_lo = 0; a.ph_hi = N_PHASES;
    void* kargs[] = {&a};
    hipError_t e = hipLaunchCooperativeKernel((void*)fwd_kernel, dim3(grid), dim3(NTHREADS), kargs, LDS_BYTES, stream);
    if (e != hipSuccess) fprintf(stderr, "cooperative launch failed: %s (grid %d)\n", hipGetErrorString(e), grid);
#endif
}
```
